# Optimizing an MI355X kernel written in HIP

```python
import math
import jax, jax.numpy as jnp
from jax import lax
import numpy as np

D_MODEL = 1024
BATCH = 8
SEQ = 4096
DEPTH = 4

N_MIXERS = 4
HEADS = 4
GROUP_WIDTH = D_MODEL // N_MIXERS
HEAD_DIM = GROUP_WIDTH // HEADS
D_MIX = N_MIXERS * GROUP_WIDTH
DIFF_DIM = HEAD_DIM // 2
ROPE_DIM = DIFF_DIM // 4
ROPE_THETA = 500000.0
POS_OFFSET_MAX = 1024
CONV_WIDTH = 3
GLA_RANK = 16
GLA_TAU = 16.0
CHUNK = 64
Q_BLOCK = 128
N_EXPERTS = 16
N_EXPERT_GROUPS = 4
EXPERTS_PER_GROUP = N_EXPERTS // N_EXPERT_GROUPS
TOP_K = 2
D_EXPERT = D_MODEL // 2
ALPHA = (2 * DEPTH) ** 0.25
BETA = (8 * DEPTH) ** -0.25
EPS = 1e-6
GW = GROUP_WIDTH
IN_SPLITS = (GW, GW, GW, GW, HEADS, HEADS, GW, GW, GW, GW, GW, GW, GW, GW, GW, GW, GLA_RANK)
P_IN = sum(IN_SPLITS)

kernel_name = 'hybrid_parallel_heads_moe'


def layer_norm(x, g, b):
    xf = x.astype(jnp.float32)
    mu = xf.mean(-1, keepdims=True)
    var = jnp.square(xf - mu).mean(-1, keepdims=True)
    return ((xf - mu) * lax.rsqrt(var + EPS) * g + b).astype(x.dtype)


def rms_norm(x, g, out_dtype):
    xf = x.astype(jnp.float32)
    return (xf * lax.rsqrt(jnp.square(xf).mean(-1, keepdims=True) + EPS) * g).astype(out_dtype)


def rope_partial(x, cos, sin):
    half = ROPE_DIM // 2
    x1, x2, rest = x[..., :half], x[..., half:ROPE_DIM], x[..., ROPE_DIM:]
    return jnp.concatenate([x1 * cos - x2 * sin, x2 * cos + x1 * sin, rest], axis=-1)


def to_chunks(x):
    B, T = x.shape[:2]
    x = x.reshape((B, T // CHUNK, CHUNK) + x.shape[2:])
    return x.transpose((1, 0, 3, 2) + tuple(range(4, x.ndim)))


def from_chunks(x):
    x = x.transpose((1, 0, 3, 2) + tuple(range(4, x.ndim)))
    return x.reshape((x.shape[0], x.shape[1] * x.shape[2]) + x.shape[3:])


def mlstm_chunkwise(q, k, v, log_i, log_f):
    B, T, H, d = q.shape
    causal = jnp.tril(jnp.ones((CHUNK, CHUNK), dtype=bool))

    def step(carry, xs):
        C, n, m = carry
        qb, kb, vb, li, lf = xs
        b = jnp.cumsum(lf, axis=-1)
        dmat = jnp.where(causal, b[..., :, None] - b[..., None, :] + li[..., None, :], -jnp.inf)
        inter = b + m[..., None]
        m_row = jnp.maximum(inter, dmat.max(-1))
        s = jnp.einsum('bhjd,bhld->bhjl', qb, kb) * jnp.exp(dmat - m_row[..., None])
        w_int = jnp.exp(inter - m_row)
        num = jnp.einsum('bhjl,bhle->bhje', s, vb) + w_int[..., None] * jnp.einsum('bhjd,bhde->bhje', qb, C)
        den = s.sum(-1) + w_int * jnp.einsum('bhjd,bhd->bhj', qb, n)
        h = num / jnp.maximum(jnp.abs(den), jnp.exp(-m_row))[..., None]
        b_end = b[..., -1]
        dk = b_end[..., None] - b + li
        m_new = jnp.maximum(b_end + m, dk.max(-1))
        wl = jnp.exp(dk - m_new[..., None])
        decay = jnp.exp(b_end + m - m_new)
        C = decay[..., None, None] * C + jnp.einsum('bhl,bhld,bhle->bhde', wl, kb, vb)
        n = decay[..., None] * n + jnp.einsum('bhl,bhld->bhd', wl, kb)
        return (C, n, m_new), h

    init = (jnp.zeros((B, H, d, d), jnp.float32), jnp.zeros((B, H, d), jnp.float32),
            jnp.zeros((B, H), jnp.float32))
    xs = (to_chunks(q), to_chunks(k), to_chunks(v), to_chunks(log_i), to_chunks(log_f))
    _, h = lax.scan(step, init, xs)
    return from_chunks(h)


def gla_chunkwise(q, k, v, log_a):
    B, T, H, dk = q.shape
    dv = v.shape[-1]
    causal = jnp.tril(jnp.ones((CHUNK, CHUNK), dtype=bool))

    def step(S, xs):
        qb, kb, vb, lab = xs
        b = jnp.cumsum(lab, axis=2)
        diff = jnp.where(causal[:, :, None], b[:, :, :, None, :] - b[:, :, None, :, :], -jnp.inf)
        att = jnp.einsum('bhjd,bhld,bhjld->bhjl', qb, kb, jnp.exp(diff))
        o = jnp.einsum('bhjl,bhle->bhje', att, vb) + jnp.einsum('bhjd,bhde->bhje', qb * jnp.exp(b), S)
        b_end = b[:, :, -1]
        S = jnp.exp(b_end)[..., None] * S + jnp.einsum('bhld,bhle->bhde', kb * jnp.exp(b_end[:, :, None, :] - b), vb)
        return S, o

    init = jnp.zeros((B, H, dk, dv), jnp.float32)
    _, o = lax.scan(step, init, (to_chunks(q), to_chunks(k), to_chunks(v), to_chunks(log_a)))
    return from_chunks(o)


def causal_short_conv(s, w, bias):
    out = lax.conv_general_dilated(s, w[:, None, :].astype(s.dtype), window_strides=(1,),
                                   padding=((CONV_WIDTH - 1, 0),),
                                   dimension_numbers=('NWC', 'WIO', 'NWC'),
                                   feature_group_count=s.shape[-1])
    return out + bias


def diff_attention(q, k, v, lam, lam_init, norm_g, cos, sin):
    B, T, H = q.shape[:3]
    qh = rope_partial(q, cos, sin).transpose(0, 2, 3, 1, 4)
    kh = rope_partial(k, cos, sin).transpose(0, 2, 3, 1, 4)
    vh = v.transpose(0, 2, 1, 3)
    key_pos = jnp.arange(T)
    scale = DIFF_DIM ** -0.5

    def block(i):
        start = i * Q_BLOCK
        qb = lax.dynamic_slice_in_dim(qh, start, Q_BLOCK, axis=3)
        s = jnp.einsum('bhcqd,bhckd->bhcqk', qb, kh).astype(jnp.float32) * scale
        q_pos = start + jnp.arange(Q_BLOCK)
        s = jnp.where(key_pos[None, :] <= q_pos[:, None], s, -jnp.inf)
        p = jax.nn.softmax(s, axis=-1)
        a = p[:, :, 0] - lam * p[:, :, 1]
        return jnp.einsum('bhqk,bhkd->bhqd', a.astype(vh.dtype), vh)

    o = lax.map(block, jnp.arange(T // Q_BLOCK))
    o = o.transpose(1, 0, 3, 2, 4).reshape(B, T, H, HEAD_DIM)
    o = rms_norm(o, norm_g, v.dtype) * (1.0 - lam_init)
    return o.reshape(B, T, H * HEAD_DIM)


def hybrid_mixer(u, w_in, w_out, b_i, b_f, mlstm_g, conv_w, conv_b, lq1, lk1, lq2, lk2, diff_g, lam_init,
                 w_a2, b_a, gla_g, cos, sin):
    B, T, _ = u.shape
    f32 = jnp.float32
    split_points = [int(v) for v in np.cumsum(IN_SPLITS)[:-1]]
    (mq, mk, mv, mo, mi, mf, cb, cc, ch, dq, dk, dv, gq, gk, gv, gr, ga) = jnp.split(u @ w_in, split_points, axis=-1)
    heads = lambda t: t.reshape(B, T, HEADS, HEAD_DIM)
    h_a = mlstm_chunkwise(heads(mq).astype(f32) * HEAD_DIM ** -0.5, heads(mk).astype(f32), heads(mv).astype(f32),
                          (mi + b_i).astype(f32), jax.nn.log_sigmoid((mf + b_f).astype(f32)))
    y_a = jax.nn.sigmoid(mo) * rms_norm(h_a, mlstm_g, u.dtype).reshape(B, T, GW)
    y_b = cb * causal_short_conv(cc * ch, conv_w, conv_b)
    lam = jnp.exp(jnp.sum(lq1 * lk1)) - jnp.exp(jnp.sum(lq2 * lk2)) + lam_init
    y_c = diff_attention(dq.reshape(B, T, HEADS, 2, DIFF_DIM), dk.reshape(B, T, HEADS, 2, DIFF_DIM), heads(dv),
                         lam, lam_init, diff_g, cos, sin)
    log_a = jax.nn.log_sigmoid((ga @ w_a2 + b_a).astype(f32)) / GLA_TAU
    o_d = gla_chunkwise(heads(gq).astype(f32) * HEAD_DIM ** -0.5, heads(gk).astype(f32), heads(gv).astype(f32),
                        heads(log_a))
    y_d = rms_norm(o_d, gla_g, u.dtype).reshape(B, T, GW) * jax.nn.silu(gr)
    return jnp.concatenate([y_a, y_b, y_c, y_d], axis=-1) @ w_out


def moe(u, router_w, router_bias, w_gate, w_up, w_down):
    B, T, D = u.shape
    t = u.reshape(B * T, D)
    scores = jax.nn.sigmoid((t @ router_w).astype(jnp.float32))
    biased = scores + router_bias.astype(jnp.float32)
    grouped = biased.reshape(-1, N_EXPERT_GROUPS, EXPERTS_PER_GROUP)
    group_score = lax.top_k(grouped, TOP_K)[0].sum(-1)
    _, g_idx = lax.top_k(group_score, 1)
    in_group = (jnp.arange(N_EXPERTS)[None, :] // EXPERTS_PER_GROUP) == g_idx
    _, e_idx = lax.top_k(jnp.where(in_group, biased, -jnp.inf), TOP_K)
    sel = jnp.take_along_axis(scores, e_idx, axis=-1)
    gates = sel / sel.sum(-1, keepdims=True)
    combine = (jax.nn.one_hot(e_idx, N_EXPERTS, dtype=jnp.float32) * gates[..., None]).sum(1).astype(u.dtype)
    y = jnp.zeros_like(t)
    for e in range(N_EXPERTS):
        h = jax.nn.silu(t @ w_gate[e]) * (t @ w_up[e])
        y = y + combine[:, e:e + 1] * (h @ w_down[e])
    return y.reshape(B, T, D)


def setup_inputs(seed: int = 0) -> dict:
    key = jax.random.key(seed)
    ks = jax.random.split(key, 32)
    nrm = lambda k, shape, s: jax.random.normal(k, shape, jnp.float32) * s
    x = nrm(ks[0], (BATCH, SEQ, D_MODEL), 1.0)
    c = nrm(ks[1], (BATCH, D_MODEL), 1.0)
    offsets = jax.random.randint(ks[2], (BATCH, 1), 0, POS_OFFSET_MAX, dtype=jnp.int32)
    positions = offsets + jnp.arange(SEQ, dtype=jnp.int32)[None, :]
    return {
        'x': x,
        'c': c,
        'positions': positions,
        'w_ada': nrm(ks[3], (DEPTH, D_MODEL, 6 * D_MODEL), 0.1 * D_MODEL ** -0.5),
        'b_ada': nrm(ks[4], (DEPTH, 6 * D_MODEL), 0.01),
        'w_in': nrm(ks[5], (DEPTH, D_MODEL, P_IN), D_MODEL ** -0.5),
        'w_out': nrm(ks[6], (DEPTH, D_MIX, D_MODEL), BETA * D_MIX ** -0.5),
        'mlstm_b_i': nrm(ks[7], (DEPTH, HEADS), 0.1),
        'mlstm_b_f': jax.random.uniform(ks[8], (DEPTH, HEADS), jnp.float32, 3.0, 6.0),
        'mlstm_norm_g': 1.0 + nrm(ks[9], (DEPTH, HEAD_DIM), 0.01),
        'conv_w': nrm(ks[10], (DEPTH, CONV_WIDTH, GW), CONV_WIDTH ** -0.5),
        'conv_b': nrm(ks[11], (DEPTH, GW), 0.01),
        'diff_lambda_q1': nrm(ks[12], (DEPTH, DIFF_DIM), 0.1),
        'diff_lambda_k1': nrm(ks[13], (DEPTH, DIFF_DIM), 0.1),
        'diff_lambda_q2': nrm(ks[14], (DEPTH, DIFF_DIM), 0.1),
        'diff_lambda_k2': nrm(ks[15], (DEPTH, DIFF_DIM), 0.1),
        'diff_norm_g': 1.0 + nrm(ks[16], (DEPTH, HEAD_DIM), 0.01),
        'gla_w_a2': nrm(ks[17], (DEPTH, GLA_RANK, GW), GLA_RANK ** -0.5),
        'gla_b_a': nrm(ks[18], (DEPTH, GW), 0.5),
        'gla_norm_g': 1.0 + nrm(ks[19], (DEPTH, HEAD_DIM), 0.01),
        'ln1_g': 1.0 + nrm(ks[20], (DEPTH, D_MODEL), 0.01),
        'ln1_b': nrm(ks[21], (DEPTH, D_MODEL), 0.01),
        'ln2_g': 1.0 + nrm(ks[22], (DEPTH, D_MODEL), 0.01),
        'ln2_b': nrm(ks[23], (DEPTH, D_MODEL), 0.01),
        'router_w': nrm(ks[24], (D_MODEL, N_EXPERTS), D_MODEL ** -0.5),
        'router_bias': nrm(ks[25], (N_EXPERTS,), 0.01),
        'exp_w_gate': nrm(ks[26], (DEPTH, N_EXPERTS, D_MODEL, D_EXPERT), D_MODEL ** -0.5),
        'exp_w_up': nrm(ks[27], (DEPTH, N_EXPERTS, D_MODEL, D_EXPERT), D_MODEL ** -0.5),
        'exp_w_down': nrm(ks[28], (DEPTH, N_EXPERTS, D_EXPERT, D_MODEL), BETA * D_EXPERT ** -0.5),
    }


def reference(x, c, positions, w_ada, b_ada, w_in, w_out, mlstm_b_i, mlstm_b_f, mlstm_norm_g, conv_w, conv_b,
              diff_lambda_q1, diff_lambda_k1, diff_lambda_q2, diff_lambda_k2, diff_norm_g, gla_w_a2, gla_b_a,
              gla_norm_g, ln1_g, ln1_b, ln2_g, ln2_b, router_w, router_bias, exp_w_gate, exp_w_up, exp_w_down):
    f32 = jnp.float32
    inv_freq = ROPE_THETA ** (-jnp.arange(0, ROPE_DIM, 2, dtype=f32) / ROPE_DIM)
    ang = positions.astype(f32)[..., None] * inv_freq
    cos = jnp.cos(ang)[:, :, None, None, :].astype(x.dtype)
    sin = jnp.sin(ang)[:, :, None, None, :].astype(x.dtype)
    c_act = jax.nn.silu(c)
    for l in range(DEPTH):
        lam_init = 0.8 - 0.6 * math.exp(-0.3 * l)
        mod = c_act @ w_ada[l] + b_ada[l]
        sh1, sc1, g1, sh2, sc2, g2 = [m[:, None, :] for m in jnp.split(mod, 6, axis=-1)]
        u = x * (1.0 + sc1) + sh1
        y = hybrid_mixer(u, w_in[l], w_out[l], mlstm_b_i[l], mlstm_b_f[l], mlstm_norm_g[l], conv_w[l], conv_b[l],
                         diff_lambda_q1[l], diff_lambda_k1[l], diff_lambda_q2[l], diff_lambda_k2[l], diff_norm_g[l],
                         lam_init, gla_w_a2[l], gla_b_a[l], gla_norm_g[l], cos, sin)
        x = layer_norm(ALPHA * x + (1.0 + g1) * y, ln1_g[l], ln1_b[l])
        u = x * (1.0 + sc2) + sh2
        y = moe(u, router_w, router_bias, exp_w_gate[l], exp_w_up[l], exp_w_down[l])
        x = layer_norm(ALPHA * x + (1.0 + g2) * y, ln2_g[l], ln2_b[l])
    return x
```

```cpp
#include <hip/hip_runtime.h>
#include <hip/hip_bf16.h>
#include <cstdio>
#include <cstdint>
#include <cmath>

#ifndef MK_ONE_LAUNCH
#define MK_ONE_LAUNCH 0
#endif
#ifndef PHM
#define PHM 0xFFFF
#endif
#define PHON(n) (((PHM) >> (n)) & 1)

#define LAS __attribute__((address_space(3)))
#define GAS __attribute__((address_space(1)))
typedef unsigned short bf16_t;
typedef short bf16x8 __attribute__((ext_vector_type(8)));
typedef float f32x4 __attribute__((ext_vector_type(4)));
typedef float f32x2 __attribute__((ext_vector_type(2)));
typedef unsigned u32x4 __attribute__((ext_vector_type(4)));
typedef unsigned u32x2 __attribute__((ext_vector_type(2)));
typedef GAS unsigned gu32;

constexpr int NB = 8, SEQ = 4096, NTOK = NB * SEQ, DM = 1024, DEPTH = 4, NH = 4, HD = 64, PIN = 3608, PP = 3840, NE = 16, DE = 512;
constexpr int NCH = SEQ / 64;
constexpr float ALPHA = 1.6817928305074290f;
constexpr float LN_EPS = 1e-6f;
constexpr float ATT_C2 = 0.17677669529663687f * 1.4426950408889634f;
constexpr int NBUCKET = 24, LCAP = NTOK;
constexpr int C_MQ = 0, C_MK = 256, C_MV = 512, C_MO = 768, C_CB = 1024, C_CC = 1280, C_CH = 1536, C_DQ = 1792, C_DK = 2048, C_DV = 2304,
              C_GQ = 2560, C_GK = 2816, C_GV = 3072, C_GR = 3328, C_GA = 3584, C_MI = 3600, C_MF = 3604;

constexpr size_t MiB = 1u << 20;
constexpr size_t WS_CTL = 0, CTL_ZERO_BYTES = 1 * MiB;
constexpr size_t WS_MOD = 1 * MiB;
constexpr size_t WS_ROPE = 2 * MiB;
constexpr size_t WS_WIN = 3 * MiB;
constexpr size_t WS_WOUT = 33 * MiB;
constexpr size_t WS_WGU = 41 * MiB;
constexpr size_t WS_WD = 73 * MiB;
constexpr size_t WS_LTOK = 89 * MiB;
constexpr size_t WS_LGATE = 92 * MiB;
constexpr size_t WS_SM = 98 * MiB;
constexpr size_t WS_PROJ = 100 * MiB;
constexpr size_t WS_XR = 340 * MiB;
constexpr size_t WS_U = 468 * MiB;
constexpr size_t WS_YCAT = 532 * MiB;
constexpr size_t WS_END = 596 * MiB;
constexpr size_t SM_N = 0, SM_BC = 512 * 1024, SM_DM = 520 * 1024, SM_MS = 528 * 1024, SM_GBE = 1 * MiB;
constexpr int CW_TMO = 0, CW_CODE = 1, CW_ZPAGE = 256, CW_BAR = 4096, CW_CNT = 16384;
constexpr int RING_BYTES = 131072, LDSCTL_OFF = RING_BYTES, MISC_OFF = LDSCTL_OFF + 320, MOE_TB_OFF = LDSCTL_OFF + 1024, LDS_BYTES = 147456;

#define RLX_AGENT __ATOMIC_RELAXED, __HIP_MEMORY_SCOPE_AGENT
#define LDS_WAIT() asm volatile("s_waitcnt lgkmcnt(0)" ::: "memory")
#define VM_WAIT() asm volatile("s_waitcnt vmcnt(0)" ::: "memory")

__device__ __forceinline__ unsigned f2bf(float f) { unsigned u = __builtin_bit_cast(unsigned, f); return (u + 0x7fffu + ((u >> 16) & 1u)) >> 16; }
__device__ __forceinline__ unsigned pk2(float lo, float hi) { typedef __bf16 bf2 __attribute__((ext_vector_type(2))); f32x2 v = {lo, hi}; bf2 b = __builtin_convertvector(v, bf2); return __builtin_bit_cast(unsigned, b); }
__device__ __forceinline__ float bf2f(unsigned b) { return __builtin_bit_cast(float, b << 16); }
__device__ __forceinline__ float bflo(unsigned w) { return __builtin_bit_cast(float, w << 16); }
__device__ __forceinline__ float bfhi(unsigned w) { return __builtin_bit_cast(float, w & 0xffff0000u); }
__device__ __forceinline__ float wave_sum(float v) {
#pragma unroll
    for (int o = 1; o < 64; o <<= 1) v += __shfl_xor(v, o);
    return v;
}
__device__ __forceinline__ float wave_max(float v) {
#pragma unroll
    for (int o = 1; o < 64; o <<= 1) v = fmaxf(v, __shfl_xor(v, o));
    return v;
}
__device__ __forceinline__ float logsig(float z) { return fminf(z, 0.f) - __logf(1.f + __expf(-fabsf(z))); }
__device__ __forceinline__ float sigmoidf_(float z) { return 1.f / (1.f + __expf(-z)); }

#define XB_TMO      128
#define XB_XCNT(j)  (256  + 64 * (j))
#define XB_XSUB(j)  (1280 + 64 * (j))
#define XB_XGEN(j)  (2304 + 64 * (j))
#define XB_TOP      3328
#define XB_TOPGEN   3392
#define XCD_BAR_WORDS 3456
#define XB_SPIN_CAP (1u << 18)
__device__ __forceinline__ unsigned xb_ld(unsigned* p)              { return __hip_atomic_load(p, __ATOMIC_RELAXED, __HIP_MEMORY_SCOPE_AGENT); }
__device__ __forceinline__ unsigned xb_add(unsigned* p, unsigned v) { return __hip_atomic_fetch_add(p, v, __ATOMIC_RELAXED, __HIP_MEMORY_SCOPE_AGENT); }
__device__ __forceinline__ unsigned xb_xcc_id() { return (unsigned)__builtin_amdgcn_s_getreg((3 << 11) | 20) & 0xFu; }
#define XB_SPIN(cond, bar) do { unsigned _sp = 0; while (cond) { __builtin_amdgcn_s_sleep(1); \
    if ((++_sp & 255u) == 0u) { if (xb_ld(&(bar)[XB_TMO])) break; if (_sp > XB_SPIN_CAP) { atomicAdd(&(bar)[XB_TMO], 1u); break; } } } } while (0)
struct XcdBarrier { unsigned* bar; unsigned x; volatile LAS unsigned* st; };
__device__ __forceinline__ XcdBarrier xcd_barrier_post(unsigned* bar, volatile LAS unsigned* st) {
    XcdBarrier b; b.bar = bar; b.x = xb_xcc_id(); b.st = st;
    if (threadIdx.x == 0) (void)xb_add(&bar[XB_XCNT(b.x)], 1u);
    return b;
}
__device__ __forceinline__ void xcd_barrier_complete(unsigned* bar, unsigned x, unsigned& nloc, unsigned& nx) {
    const unsigned G = gridDim.x * gridDim.y * gridDim.z;
    unsigned sum, cnt, mine, sp = 0u;
    for (;;) {
        sum = 0u; cnt = 0u; mine = 0u;
#pragma unroll
        for (unsigned j = 0; j < 16; ++j) { const unsigned c = xb_ld(&bar[XB_XCNT(j)]); sum += c; cnt += (c > 0u) ? 1u : 0u; mine = (j == x) ? c : mine; }
        if (sum == G) break;
        __builtin_amdgcn_s_sleep(1);
        if ((++sp & 255u) == 0u) { if (xb_ld(&bar[XB_TMO])) break; if (sp > XB_SPIN_CAP) { atomicAdd(&bar[XB_TMO], 1u); break; } }
    }
    nloc = mine > 0u ? mine : 1u; nx = cnt > 0u ? cnt : 1u;
}
__device__ __forceinline__ void xcd_barrier(const XcdBarrier& b) {
    asm volatile("s_waitcnt vmcnt(0)" ::: "memory");
    __syncthreads();
    if (threadIdx.x == 0) {
        unsigned* bar = b.bar;
        __builtin_amdgcn_s_waitcnt(0);
        unsigned nloc = b.st[0], nx = b.st[1];
        if (nloc == 0u) { xcd_barrier_complete(bar, b.x, nloc, nx); b.st[0] = nloc; b.st[1] = nx; }
        const unsigned old = xb_add(&bar[XB_XSUB(b.x)], 1u);
        const unsigned gen = old / nloc;
        if (old + 1u == (gen + 1u) * nloc) {
            __builtin_amdgcn_fence(__ATOMIC_RELEASE, "agent");
            asm volatile("s_waitcnt vmcnt(0)" ::: "memory");
            const unsigned og = xb_add(&bar[XB_TOP], 1u);
            const unsigned tg = og / nx;
            if (og + 1u == (tg + 1u) * nx) xb_add(&bar[XB_TOPGEN], 1u);
            else XB_SPIN(xb_ld(&bar[XB_TOPGEN]) == tg, bar);
            __builtin_amdgcn_fence(__ATOMIC_ACQUIRE, "agent");
            xb_add(&bar[XB_XGEN(b.x)], 1u);
            asm volatile("s_waitcnt vmcnt(0)" ::: "memory");
        } else {
            XB_SPIN(xb_ld(&bar[XB_XGEN(b.x)]) == gen, bar);
            __builtin_amdgcn_fence(__ATOMIC_ACQUIRE, "agent");
            asm volatile("s_waitcnt vmcnt(0)" ::: "memory");
        }
    }
    __syncthreads();
}

namespace gm {
constexpr int BM = 256, BK = 64, HALF = 128, HTB = HALF * BK * 2, NT = 16, NXCD = 8, WGM = 8;
__host__ __device__ __forceinline__ int lds_byte(int r, int c) { const int st = (r >> 4) * 2 + (c >> 5), rr = r & 15, cc = c & 31, ob = rr * 64 + cc * 2; return st * 1024 + (ob ^ (((ob >> 9) & 1) << 5)); }
__host__ __device__ __forceinline__ void stage_rc(int b, int& R, int& C) { const int st = b / 1024, sb = b % 1024, swz = sb ^ (((sb >> 9) & 1) << 5); R = (st >> 1) * 16 + swz / 64; C = (st & 1) * 32 + (swz % 64) / 2; }
__host__ __device__ __forceinline__ int perm32(int rho) { const int n = rho >> 4, i = rho & 15; return 8 * (i >> 2) + 4 * n + (i & 3); }
struct Unit { int pm, pn, bk, tb; };
struct Src { const char* a; const char* b0; const char* b1; unsigned va[2][2]; };
struct StaticOrder {
    int nM, nN, nwg, G, c;
    __device__ void init(int M, int N, int G_, int c_) { nM = M / BM; nN = N / BM; nwg = nM * nN; G = G_; c = c_; }
    __device__ __forceinline__ bool next(int i, Unit& u) const {
        const long L = (long)i * G + c; if (L >= nwg) return false;
        int wgid = (int)L; { const int q = nwg / NXCD, r = nwg % NXCD, xcd = wgid % NXCD, off = wgid / NXCD; wgid = (xcd < r ? xcd * (q + 1) : r * (q + 1) + (xcd - r) * q) + off; }
        const int nig = WGM * nN, gid = wgid / nig, fm = gid * WGM, gsz = (nM - fm) < WGM ? (nM - fm) : WGM;
        u.pm = fm + ((wgid % nig) % gsz); u.pn = (wgid % nig) / gsz; u.bk = 0; u.tb = 0; return true;
    }
};

template <class Kind>
__device__ __forceinline__ void gemm_phase(LAS unsigned char* lds, const Kind& Kd) {
    int tid_ = threadIdx.x; asm volatile("" : "+v"(tid_));
    const int tid = tid_, wid = __builtin_amdgcn_readfirstlane(tid >> 6), lane = tid & 63, wr = wid >> 2, wc = wid & 3, fr = lane & 15, fq = lane >> 4;
    int R[2], C[2]; unsigned voffB[2];
#pragma unroll
    for (int i = 0; i < 2; ++i) { stage_rc(tid * 16 + i * 8192, R[i], C[i]); const int Rb = Kind::PERM ? ((R[i] & ~31) + perm32(R[i] & 31)) : R[i]; voffB[i] = (unsigned)(Rb * Kind::LDB + C[i]) * 2u; }
    const size_t hstepB = (size_t)HALF * Kind::LDB * 2;
    const unsigned ldsw = (unsigned)wid * 1024u;
    const int aoff = lds_byte(wr * 64 + fr, fq * 8), boff = lds_byte(wc * 32 + fr, fq * 8);
#define G_SA(b, h) (((b) * 2 + (h)) * HTB)
#define G_SB(b, h) ((4 + (b) * 2 + (h)) * HTB)
#define G_STAGE_A(bufoff, S, t, h) do { const char* _g = (S).a + (size_t)(t) * 128; _Pragma("unroll") for (int _i = 0; _i < 2; ++_i) \
        __builtin_amdgcn_global_load_lds((const unsigned*)(_g + (S).va[h][_i]), (LAS unsigned*)(lds + (bufoff) + ldsw + _i * 8192), 16, 0, 0); } while (0)
#define G_STAGE_B(bufoff, S, t, h) do { const char* _g = (((t) < 8) ? (S).b0 + (size_t)(t) * 128 : (S).b1 + (size_t)((t) - 8) * 128) + (h) * hstepB; _Pragma("unroll") for (int _i = 0; _i < 2; ++_i) \
        __builtin_amdgcn_global_load_lds((const unsigned*)(_g + voffB[_i]), (LAS unsigned*)(lds + (bufoff) + ldsw + _i * 8192), 16, 0, 0); } while (0)
#define G_LDA(dst, b, h) do { _Pragma("unroll") for (int m = 0; m < 4; ++m) _Pragma("unroll") for (int k = 0; k < 2; ++k) dst[m][k] = *(const LAS bf16x8*)(lds + G_SA(b, h) + aoff + m * 2048 + k * 1024); } while (0)
#define G_LDB(dst, b, h) do { _Pragma("unroll") for (int n = 0; n < 2; ++n) _Pragma("unroll") for (int k = 0; k < 2; ++k) dst[n][k] = *(const LAS bf16x8*)(lds + G_SB(b, h) + boff + n * 2048 + k * 1024); } while (0)
#define G_MMA(ai, bj, At, Bt) do { __builtin_amdgcn_s_setprio(1); _Pragma("unroll") for (int m = 0; m < 4; ++m) _Pragma("unroll") for (int n = 0; n < 2; ++n) _Pragma("unroll") for (int k = 0; k < 2; ++k) \
        acc[ai][bj][m][n] = __builtin_amdgcn_mfma_f32_16x16x32_bf16(Bt[n][k], At[m][k], acc[ai][bj][m][n], 0, 0, 0); __builtin_amdgcn_s_setprio(0); } while (0)
#define G_WAIT_V(n) asm volatile("s_waitcnt vmcnt(" #n ")" ::: "memory")
#define G_WAIT_L(n) asm volatile("s_waitcnt lgkmcnt(" #n ")" ::: "memory")
#define G_BAR __builtin_amdgcn_s_barrier()
#define G_SCHED __builtin_amdgcn_sched_barrier(0)
    Unit cur, nxt; Src sc, sn; int ui = 0;
    if (!Kd.next(0, cur)) return;
    Kd.src(cur, sc, R, C);
    f32x4 acc[2][2][4][2];
#pragma unroll
    for (int a = 0; a < 2; ++a)
#pragma unroll
        for (int b = 0; b < 2; ++b)
#pragma unroll
            for (int m = 0; m < 4; ++m)
#pragma unroll
                for (int n = 0; n < 2; ++n) acc[a][b][m][n] = (f32x4){0.f, 0.f, 0.f, 0.f};
    bf16x8 At[4][2], B0[2][2], B1[2][2];
    G_STAGE_B(G_SB(0, 0), sc, 0, 0); G_STAGE_B(G_SB(0, 1), sc, 0, 1); G_STAGE_A(G_SA(0, 0), sc, 0, 0); G_STAGE_A(G_SA(0, 1), sc, 0, 1);
    if (wr == 1) G_BAR;
    G_WAIT_V(2); G_BAR;
    G_STAGE_B(G_SB(1, 0), sc, 1, 0); G_STAGE_A(G_SA(1, 0), sc, 1, 0); G_STAGE_B(G_SB(1, 1), sc, 1, 1);
    G_WAIT_V(6); G_BAR;
    for (;;) {
        const bool has_next = Kd.next(ui + 1, nxt);
        if (has_next) Kd.src(nxt, sn, R, C); else sn = sc;
        for (int t = 0; t < NT; t += 2) {
            const bool last = (t == NT - 2);
            Src s2; s2.a = last ? sn.a : sc.a; s2.b0 = last ? sn.b0 : sc.b0; s2.b1 = last ? sn.b1 : sc.b1;
            s2.va[0][0] = last ? sn.va[0][0] : sc.va[0][0]; s2.va[0][1] = last ? sn.va[0][1] : sc.va[0][1]; s2.va[1][0] = last ? sn.va[1][0] : sc.va[1][0]; s2.va[1][1] = last ? sn.va[1][1] : sc.va[1][1];
            const int t2 = last ? 0 : t + 2, t3 = t2 + 1;
            G_LDB(B0, 0, 0); G_LDB(B1, 0, 1); G_SCHED; G_LDA(At, 0, 0); G_STAGE_A(G_SA(1, 1), sc, t + 1, 1);
            G_WAIT_V(8); G_WAIT_L(0); G_BAR; G_MMA(0, 0, At, B0); G_MMA(0, 1, At, B1); G_BAR; G_SCHED;
            G_LDA(At, 0, 1); G_STAGE_B(G_SB(0, 0), s2, t2, 0); G_STAGE_B(G_SB(0, 1), s2, t2, 1); G_STAGE_A(G_SA(0, 0), s2, t2, 0);
            G_WAIT_V(8); G_WAIT_L(0); G_BAR; G_MMA(1, 0, At, B0); G_MMA(1, 1, At, B1); G_BAR; G_SCHED;
            G_LDB(B0, 1, 0); G_LDB(B1, 1, 1); G_SCHED; G_LDA(At, 1, 0); G_STAGE_A(G_SA(0, 1), s2, t2, 1);
            G_WAIT_V(8); G_WAIT_L(0); G_BAR; G_MMA(0, 0, At, B0); G_MMA(0, 1, At, B1); G_BAR; G_SCHED;
            G_LDA(At, 1, 1); G_STAGE_B(G_SB(1, 0), s2, t3, 0); G_STAGE_B(G_SB(1, 1), s2, t3, 1); G_STAGE_A(G_SA(1, 0), s2, t3, 0);
            G_WAIT_V(8); G_WAIT_L(0); G_BAR; G_MMA(1, 0, At, B0); G_MMA(1, 1, At, B1); G_BAR; G_SCHED;
        }
        if (wr == 0) G_BAR;
        Kd.epi(acc, cur, wr, wc, fr, fq);
        if (!has_next) break;
#pragma unroll
        for (int a = 0; a < 2; ++a)
#pragma unroll
            for (int b = 0; b < 2; ++b)
#pragma unroll
                for (int m = 0; m < 4; ++m)
#pragma unroll
                    for (int n = 0; n < 2; ++n) acc[a][b][m][n] = (f32x4){0.f, 0.f, 0.f, 0.f};
        cur = nxt; sc = sn; ++ui;
        if (wr == 1) G_BAR;
    }
    G_WAIT_V(0);
    G_BAR;
#undef G_SA
#undef G_SB
#undef G_STAGE_A
#undef G_STAGE_B
#undef G_LDA
#undef G_LDB
#undef G_MMA
#undef G_WAIT_V
#undef G_WAIT_L
#undef G_BAR
#undef G_SCHED
}

__device__ __forceinline__ void src_direct(Src& s, const bf16_t* A, int row0, const int (&R)[2], const int (&C)[2]) {
    s.a = (const char*)(A + (size_t)row0 * 1024);
#pragma unroll
    for (int h = 0; h < 2; ++h)
#pragma unroll
        for (int i = 0; i < 2; ++i) s.va[h][i] = (unsigned)((h * HALF + R[i]) * 1024 + C[i]) * 2u;
}

struct K1 {
    static constexpr bool PERM = true; static constexpr int LDB = 1024;
    StaticOrder S; const bf16_t* A; const bf16_t* Bt; bf16_t* O; const float* rope;
    __device__ __forceinline__ bool next(int i, Unit& u) const { return S.next(i, u); }
    __device__ __forceinline__ void src(const Unit& u, Src& s, const int (&R)[2], const int (&C)[2]) const {
        src_direct(s, A, u.pm * BM, R, C); s.b0 = (const char*)(Bt + (size_t)u.pn * BM * 1024); s.b1 = s.b0 + 1024;
    }
    __device__ __forceinline__ void epi(const f32x4 (&acc)[2][2][4][2], const Unit& u, int wr, int wc, int fr, int fq) const {
        const int row0 = u.pm * BM + wr * 64 + fr, col0 = u.pn * BM + wc * 32 + 8 * fq;
        const int ty = (u.pn == 0 || u.pn == 10) ? 1 : (u.pn == 7) ? 2 : (u.pn == 8) ? 3 : 0;
#pragma unroll
        for (int ai = 0; ai < 2; ++ai)
#pragma unroll
            for (int m = 0; m < 4; ++m) {
                const int row = row0 + ai * HALF + m * 16;
                f32x4 cs = (f32x4){1.f, 1.f, 1.f, 1.f}, sn = (f32x4){0.f, 0.f, 0.f, 0.f};
                if (ty >= 2) { cs = *(const f32x4*)(rope + (size_t)row * 8); sn = *(const f32x4*)(rope + (size_t)row * 8 + 4); }
                bf16_t* rowp = O + (size_t)row * PP + col0;
#pragma unroll
                for (int bj = 0; bj < 2; ++bj) {
                    f32x4 v0 = acc[ai][bj][m][0], v1 = acc[ai][bj][m][1];
                    if (ty == 1) { v0 = v0 * 0.125f; v1 = v1 * 0.125f; }
                    if (ty >= 2) {
                        if (fq == 0) { const f32x4 x1 = v0, x2 = v1; v0 = x1 * cs - x2 * sn; v1 = x2 * cs + x1 * sn; }
                        if (ty == 2) { v0 = v0 * ATT_C2; v1 = v1 * ATT_C2; }
                    }
                    u32x4 w; w.x = pk2(v0[0], v0[1]); w.y = pk2(v0[2], v0[3]); w.z = pk2(v1[0], v1[1]); w.w = pk2(v1[2], v1[3]);
                    *(u32x4*)(rowp + bj * HALF) = w;
                }
            }
    }
};
struct K2 {
    static constexpr bool PERM = false; static constexpr int LDB = 1024;
    StaticOrder S; const bf16_t* A; const bf16_t* Bt; const float* xin; float* xout; const float* modl;
    __device__ __forceinline__ bool next(int i, Unit& u) const { return S.next(i, u); }
    __device__ __forceinline__ void src(const Unit& u, Src& s, const int (&R)[2], const int (&C)[2]) const {
        src_direct(s, A, u.pm * BM, R, C); s.b0 = (const char*)(Bt + (size_t)u.pn * BM * 1024); s.b1 = s.b0 + 1024;
    }
    __device__ __forceinline__ void epi(const f32x4 (&acc)[2][2][4][2], const Unit& u, int wr, int wc, int fr, int fq) const {
        const int row0 = u.pm * BM + wr * 64 + fr, col0 = u.pn * BM + wc * 32 + 4 * fq;
        const float* g1 = modl + (size_t)(u.pm >> 4) * 6144 + 2 * 1024;
        f32x4 gv[2][2];
#pragma unroll
        for (int bj = 0; bj < 2; ++bj)
#pragma unroll
            for (int n = 0; n < 2; ++n) gv[bj][n] = *(const f32x4*)(g1 + col0 + bj * HALF + n * 16) + 1.0f;
#pragma unroll
        for (int ai = 0; ai < 2; ++ai)
#pragma unroll
            for (int m = 0; m < 4; ++m) {
                const size_t off = (size_t)(row0 + ai * HALF + m * 16) * DM + col0;
#pragma unroll
                for (int bj = 0; bj < 2; ++bj)
#pragma unroll
                    for (int n = 0; n < 2; ++n) {
                        const f32x4 xv = *(const f32x4*)(xin + off + bj * HALF + n * 16);
                        *(f32x4*)(xout + off + bj * HALF + n * 16) = xv * ALPHA + gv[bj][n] * acc[ai][bj][m][n];
                    }
            }
    }
};
__device__ __forceinline__ int pair_i(int p) { return p < 3 ? 0 : (p < 5 ? 1 : 2); }
__device__ __forceinline__ int pair_j(int p) { return p < 3 ? p + 1 : (p < 5 ? p - 1 : 3); }
struct K4 {
    static constexpr bool PERM = true; static constexpr int LDB = 1024;
    const bf16_t* U; const bf16_t* Wgu; bf16_t* H; const int* ltok; const float* lgate; const LAS int* tb; int G, vcu;
    __device__ __forceinline__ bool next(int i, Unit& u) const {
        const int L = i * G + vcu; const int nt = tb[32 + NBUCKET]; if (L >= nt * 8) return false;
        const int rt = L >> 3; int k = 0;
        for (int q = 1; q < NBUCKET; ++q) k = (tb[32 + q] <= rt) ? q : k;
        u.pm = rt; u.pn = L & 7; u.bk = k; u.tb = rt - tb[32 + k]; return true;
    }
    __device__ __forceinline__ void src(const Unit& u, Src& s, const int (&R)[2], const int (&C)[2]) const {
        const int cnt = tb[u.bk]; s.a = (const char*)U;
#pragma unroll
        for (int h = 0; h < 2; ++h)
#pragma unroll
            for (int i = 0; i < 2; ++i) { const int pos = u.tb * BM + h * HALF + R[i]; const int tok = ltok[(size_t)u.bk * LCAP + (pos < cnt ? pos : 0)]; s.va[h][i] = (unsigned)(tok * 1024 + C[i]) * 2u; }
        const int grp = u.bk / 6, p = u.bk % 6, sl = u.pn >> 2; const int e = grp * 4 + (sl ? pair_j(p) : pair_i(p));
        s.b0 = (const char*)(Wgu + ((size_t)e * 1024 + (size_t)(u.pn & 3) * BM) * 1024); s.b1 = s.b0 + 1024;
    }
    __device__ __forceinline__ void epi(const f32x4 (&acc)[2][2][4][2], const Unit& u, int wr, int wc, int fr, int fq) const {
        const int cnt = tb[u.bk], sl = u.pn >> 2; const int colo = sl * 512 + (u.pn & 3) * 128 + wc * 32 + 8 * fq;
#pragma unroll
        for (int ai = 0; ai < 2; ++ai)
#pragma unroll
            for (int m = 0; m < 4; ++m) {
                const int r = ai * HALF + wr * 64 + m * 16 + fr, pos = u.tb * BM + r;
                const float gt = (pos < cnt) ? lgate[((size_t)u.bk * LCAP + pos) * 2 + sl] : 0.f;
                float hv[8];
#pragma unroll
                for (int n = 0; n < 2; ++n)
#pragma unroll
                    for (int j = 0; j < 4; ++j) { const float g = acc[ai][0][m][n][j], up = acc[ai][1][m][n][j]; hv[n * 4 + j] = g * __builtin_amdgcn_rcpf(1.f + __expf(-g)) * up * gt; }
                u32x4 w; w.x = pk2(hv[0], hv[1]); w.y = pk2(hv[2], hv[3]); w.z = pk2(hv[4], hv[5]); w.w = pk2(hv[6], hv[7]);
                *(u32x4*)(H + (size_t)(u.pm * BM + r) * 1024 + colo) = w;
            }
    }
};
struct K5 {
    static constexpr bool PERM = false; static constexpr int LDB = 512;
    const bf16_t* H; const bf16_t* Wd; float* XR; const int* ltok; const float* modl; const LAS int* tb; int G, vcu;
    __device__ __forceinline__ bool next(int i, Unit& u) const {
        const int L = i * G + vcu; const int nt = tb[32 + NBUCKET]; if (L >= nt * 4) return false;
        const int rt = L >> 2; int k = 0;
        for (int q = 1; q < NBUCKET; ++q) k = (tb[32 + q] <= rt) ? q : k;
        u.pm = rt; u.pn = L & 3; u.bk = k; u.tb = rt - tb[32 + k]; return true;
    }
    __device__ __forceinline__ void src(const Unit& u, Src& s, const int (&R)[2], const int (&C)[2]) const {
        src_direct(s, H, u.pm * BM, R, C);
        const int grp = u.bk / 6, p = u.bk % 6;
        s.b0 = (const char*)(Wd + ((size_t)(grp * 4 + pair_i(p)) * 1024 + (size_t)u.pn * BM) * 512);
        s.b1 = (const char*)(Wd + ((size_t)(grp * 4 + pair_j(p)) * 1024 + (size_t)u.pn * BM) * 512);
    }
    __device__ __forceinline__ void epi(const f32x4 (&acc)[2][2][4][2], const Unit& u, int wr, int wc, int fr, int fq) const {
        const int cnt = tb[u.bk], col0 = u.pn * BM + wc * 32 + 4 * fq;
#pragma unroll
        for (int ai = 0; ai < 2; ++ai)
#pragma unroll
            for (int m = 0; m < 4; ++m) {
                const int pos = u.tb * BM + ai * HALF + wr * 64 + m * 16 + fr;
                if (pos < cnt) {
                    const int tok = ltok[(size_t)u.bk * LCAP + pos];
                    const float* g2 = modl + (size_t)(tok >> 12) * 6144 + 5 * 1024 + col0;
                    float* xr = XR + (size_t)tok * DM + col0;
#pragma unroll
                    for (int bj = 0; bj < 2; ++bj)
#pragma unroll
                        for (int n = 0; n < 2; ++n) {
                            const f32x4 gv = *(const f32x4*)(g2 + bj * HALF + n * 16) + 1.0f;
                            const f32x4 xv = *(const f32x4*)(xr + bj * HALF + n * 16);
                            *(f32x4*)(xr + bj * HALF + n * 16) = xv * ALPHA + gv * acc[ai][bj][m][n];
                        }
                }
                if (m & 1) asm volatile("" ::: "memory");
            }
    }
};
}

namespace attn_body {
using bf16 = __hip_bfloat16;
using s16x4 = __attribute__((ext_vector_type(4))) short;
using f32x16 = __attribute__((ext_vector_type(16))) float;
constexpr int D = 64, PITCH = PP;
constexpr int NW = 8, QBLK = 32, QB = QBLK * NW, KVBLK = 64;
__device__ __forceinline__ int crow(int r, int hi) { return (r & 3) + 8 * (r >> 2) + 4 * hi; }
#define SBAR() __builtin_amdgcn_sched_barrier(0)
__device__ __forceinline__ void cmask(f32x16& p0, f32x16& p1, int jb, int qrel, int hi) {
    const float NEG = -INFINITY; int kb = 64 * jb + 4 * hi;
#pragma unroll
    for (int r = 0; r < 16; ++r) { int kv = kb + (r & 3) + 8 * (r >> 2); if (kv > qrel) p0[r] = NEG; if (kv + 32 > qrel) p1[r] = NEG; }
}
constexpr int NSLOT = 3, SLOTB = 8192;
constexpr int LDS_K = 0, LDS_V = NSLOT * SLOTB, LDS_WS = 2 * NSLOT * SLOTB, LDS_OST = LDS_WS + NW * 64 * 4, ATT_LDS_BYTES = LDS_OST + NW * 8192;
__device__ __forceinline__ void glds16(const void* gsrc, unsigned lds_dst) { unsigned keep;
    asm volatile("s_mov_b32 %0, m0\n\ts_mov_b32 m0, %2\n\ts_nop 0\n\tglobal_load_lds_dwordx4 %1, off\n\ts_mov_b32 m0, %0" : "=&s"(keep) : "v"(gsrc), "s"(lds_dst) : "memory"); }
__device__ __forceinline__ float max3f(float a, float b, float c) { float r; asm("v_max3_f32 %0, %1, %2, %3" : "=v"(r) : "v"(a), "v"(b), "v"(c)); return r; }
__device__ __forceinline__ float max2f(float a, float b) { float r; asm("v_max_f32_e32 %0, %1, %2" : "=v"(r) : "v"(a), "v"(b)); return r; }
__device__ __forceinline__ float fadd_s(float a, float b) { float r; asm("v_add_f32_e32 %0, %1, %2" : "=v"(r) : "v"(a), "v"(b)); return r; }
__device__ __forceinline__ float fsub_s(float a, float b) { float r; asm("v_sub_f32_e32 %0, %1, %2" : "=v"(r) : "v"(a), "v"(b)); return r; }
typedef float f32x2_t __attribute__((ext_vector_type(2))); typedef __bf16 bf16x2_t __attribute__((ext_vector_type(2)));
__device__ __forceinline__ unsigned cvtpk_s(float lo, float hi) { f32x2_t v = {lo, hi}; bf16x2_t b = __builtin_convertvector(v, bf16x2_t); return __builtin_bit_cast(unsigned, b); }
#define WAIT_BAR(N) asm volatile("s_waitcnt vmcnt(" #N ") lgkmcnt(0)\n\ts_barrier" ::: "memory")
__device__ __forceinline__ void qkt(f32x16& p0, f32x16& p1, const char* Kslot, const bf16x8* qr, const f32x16& negm, int r32, int hi) {
    const char* kb = Kslot + hi * 1024 + r32 * 16;
#pragma unroll
    for (int d0 = 0; d0 < 2; ++d0) {
        const bf16x8 b0 = *reinterpret_cast<const bf16x8*>(kb + d0 * 2048);
        const bf16x8 b1 = *reinterpret_cast<const bf16x8*>(kb + d0 * 2048 + 512);
        if (d0 == 0) { p0 = __builtin_amdgcn_mfma_f32_32x32x16_bf16(b0, qr[0], negm, 0, 0, 0); p1 = __builtin_amdgcn_mfma_f32_32x32x16_bf16(b1, qr[0], negm, 0, 0, 0); }
        else { p0 = __builtin_amdgcn_mfma_f32_32x32x16_bf16(b0, qr[d0], p0, 0, 0, 0); p1 = __builtin_amdgcn_mfma_f32_32x32x16_bf16(b1, qr[d0], p1, 0, 0, 0); } }
}
typedef __attribute__((address_space(3))) const char* lds_cptr;
typedef short v4i16_t __attribute__((ext_vector_type(4)));
__device__ __forceinline__ void kload8(bf16x8* kf, lds_cptr kp) {
    kf[0] = *(const __attribute__((address_space(3))) bf16x8*)(kp);        kf[1] = *(const __attribute__((address_space(3))) bf16x8*)(kp + 512);
    kf[2] = *(const __attribute__((address_space(3))) bf16x8*)(kp + 2048); kf[3] = *(const __attribute__((address_space(3))) bf16x8*)(kp + 2560);
}
__device__ __forceinline__ void kload2(bf16x8* kf, lds_cptr kp, int j) { kf[2 * j] = *(const __attribute__((address_space(3))) bf16x8*)(kp + j * 2048); kf[2 * j + 1] = *(const __attribute__((address_space(3))) bf16x8*)(kp + j * 2048 + 512); }
__device__ __forceinline__ s16x4 vtr(lds_cptr p) { return __builtin_bit_cast(s16x4, __builtin_amdgcn_ds_read_tr16_b64_v4i16((__attribute__((address_space(3))) v4i16_t*)p)); }
__device__ __forceinline__ float rowmax(const f32x16& p0, const f32x16& p1) {
    float a = max3f(p0[0], p0[1], p1[0]), b = max3f(p0[2], p0[3], p1[1]); a = max3f(a, p1[2], p1[3]);
#pragma unroll
    for (int r = 4; r < 16; r += 4) { a = max3f(a, p0[r], p0[r + 1]); b = max3f(b, p0[r + 2], p0[r + 3]); a = max3f(a, p1[r], p1[r + 1]); b = max3f(b, p1[r + 2], p1[r + 3]); }
    const float m = max2f(a, b);
    auto rr = __builtin_amdgcn_permlane32_swap(__float_as_uint(m), __float_as_uint(m), false, false);
    return max2f(__uint_as_float(rr[0]), __uint_as_float(rr[1]));
}
__device__ __forceinline__ void pv(f32x16* o, int vb, bf16x8 pa0, bf16x8 pa1, bf16x8 pa2, bf16x8 pa3) {
#pragma unroll
    for (int d0 = 0; d0 < 2; ++d0) { s16x4 lo[4], hi[4];
#pragma unroll
        for (int ks = 0; ks < 4; ++ks) {
            asm volatile("ds_read_b64_tr_b16 %0,%1 offset:%c2" : "=&v"(lo[ks]) : "v"(vb), "i"(d0 * 4096 + ks * 1024) : "memory");
            asm volatile("ds_read_b64_tr_b16 %0,%1 offset:%c2" : "=&v"(hi[ks]) : "v"(vb), "i"(d0 * 4096 + ks * 1024 + 512) : "memory"); }
        asm volatile("s_waitcnt lgkmcnt(0)" ::: "memory"); SBAR();
#define PK(k) (bf16x8){lo[k][0], lo[k][1], lo[k][2], lo[k][3], hi[k][0], hi[k][1], hi[k][2], hi[k][3]}
        o[d0] = __builtin_amdgcn_mfma_f32_32x32x16_bf16(pa0, PK(0), o[d0], 0, 0, 0);
        o[d0] = __builtin_amdgcn_mfma_f32_32x32x16_bf16(pa1, PK(1), o[d0], 0, 0, 0);
        o[d0] = __builtin_amdgcn_mfma_f32_32x32x16_bf16(pa2, PK(2), o[d0], 0, 0, 0);
        o[d0] = __builtin_amdgcn_mfma_f32_32x32x16_bf16(pa3, PK(3), o[d0], 0, 0, 0);
#undef PK
    }
}
struct AttnParams { const bf16* Q; const bf16* K; const bf16* V; const bf16* zpage; bf16_t* Y; const float* gnorm; float lam, osc; };
template <int THRL, int comp> __device__ __forceinline__ void attn_unit(int b, int h, int qb, const AttnParams& P, char* shm) {
    const bf16* Q = P.Q; const bf16* __restrict__ K = P.K; const bf16* __restrict__ V = P.V;
    int tid_ = threadIdx.x; asm volatile("" : "+v"(tid_));
    const int tid = tid_, lane = tid & 63, r32 = lane & 31, hi = lane >> 5; const int wid = __builtin_amdgcn_readfirstlane(tid >> 6);
    const long rowbase = (long)b * SEQ; const int q0 = qb * QB;
    const bf16* Qw = Q + (rowbase + q0 + wid * QBLK) * PITCH + h * D;
    const bf16* Kh = K + rowbase * PITCH + h * D, *Vh = V + rowbase * PITCH + h * D;
    const unsigned lds0 = (unsigned)(uintptr_t)shm;
    float* wsf = (float*)(shm + LDS_WS) + wid * 64;
    const bf16* ksrc = Kh + (long)(32 * (wid & 1) + (lane & 31)) * PITCH + comp * 32 + (wid >> 1) * 8;
    const bf16* vsrc = Vh + (long)(16 * (wid & 3) + (lane >> 2)) * PITCH + (wid >> 2) * 32 + (lane & 3) * 8;
    const unsigned kdst = lds0 + LDS_K + (wid >> 1) * 1024 + (wid & 1) * 512, vdst = lds0 + LDS_V + wid * 1024;
#define DMA_K(t, slot) do { if (lane < 32) glds16(ksrc + (long)(t) * KVBLK * PITCH, (unsigned)__builtin_amdgcn_readfirstlane(kdst + (slot))); } while (0)
#define DMA_V(t, slot) glds16(vsrc + (long)(t) * KVBLK * PITCH, (unsigned)__builtin_amdgcn_readfirstlane(vdst + (slot)))
    const int vb0 = (int)(lds0 + LDS_V) + ((lane >> 4) & 1) * 32 + (lane & 3) * 8 + (4 * hi + ((lane & 15) >> 2)) * 64;
    const char* Kbase = shm + LDS_K; bf16x8 kf[4];
    const lds_cptr shm3 = (lds_cptr)shm; const lds_cptr kp0 = shm3 + LDS_K + hi * 1024 + r32 * 16; const lds_cptr vp0 = shm3 + LDS_V + ((lane >> 4) & 1) * 32 + (lane & 3) * 8 + (4 * hi + ((lane & 15) >> 2)) * 64;
    const int NT = (q0 + QB) / KVBLK;
    DMA_K(0, 0); DMA_V(0, 0); DMA_K(1, SLOTB);
    bf16x8 qr[2];
#pragma unroll
    for (int d0 = 0; d0 < 2; ++d0) qr[d0] = *reinterpret_cast<const bf16x8*>(&Qw[(long)r32 * PITCH + comp * 32 + d0 * 16 + hi * 8]);
    float mhat = 0.f, l_reg = 0.f; f32x16 o[2]; o[0] = f32x16{}; o[1] = f32x16{}; f32x16 negm = f32x16{}; asm volatile("" : "+v"(negm));
    const int qrel = wid * QBLK + r32;
#define CMASK(P0, P1, t) do { int jb_ = (t) - (NT - 4); if (jb_ >= 0) cmask(P0, P1, jb_, qrel, hi); } while (0)
    bool resc = false;
#define START(P0, P1) do { const float rm = rowmax(P0, P1); resc = false; \
    { const float dl = rm; mhat = fadd_s(mhat, dl); \
      _Pragma("unroll") for (int r = 0; r < 16; ++r) { P0[r] = fsub_s(P0[r], dl); P1[r] = fsub_s(P1[r], dl); } \
      _Pragma("unroll") for (int r = 0; r < 16; ++r) negm[r] = -mhat; asm volatile("" : "+v"(negm)); } \
    _Pragma("unroll") for (int r = 0; r < 16; ++r) P0[r] = __builtin_amdgcn_exp2f(P0[r]); } while (0)
#define RESC() do { if (resc) { asm volatile("s_waitcnt lgkmcnt(0)" ::: "memory"); \
      _Pragma("unroll") for (int d_ = 0; d_ < 2; ++d_) _Pragma("unroll") for (int r = 0; r < 16; ++r) o[d_][r] *= wsf[crow(r, hi)]; } } while (0)
    f32x16 pA0, pA1, pB0, pB1;
    int sl_prev = 0, sl_cur = 0, sl_next = SLOTB;
#define ROT() do { sl_prev = sl_cur; sl_cur = sl_next; sl_next = (sl_next == (NSLOT - 1) * SLOTB) ? 0 : sl_next + SLOTB; } while (0)
    DMA_K(2, 2 * SLOTB);
    WAIT_BAR(3);
    qkt(pA0, pA1, Kbase, qr, negm, r32, hi); asm volatile("s_nop 15\n\ts_nop 7" : "+v"(pA0), "+v"(pA1)); CMASK(pA0, pA1, 0);
    START(pA0, pA1);
    _Pragma("unroll") for (int r = 0; r < 16; ++r) pA1[r] = __builtin_amdgcn_exp2f(pA1[r]);
    WAIT_BAR(0);
    DMA_K(3, 0); DMA_V(1, SLOTB);
    ROT();
    kload8(kf, kp0 + sl_cur);
    WAIT_BAR(2);
    s16x4 vlo[8], vhi[8]; u32x4 pw0, pw1, pw2, pw3;
#define PKW(P, B) cvtpk_s(P[B], P[B + 1])
#define PAF(k) __builtin_bit_cast(bf16x8, pw##k)
#define VFR(i) (bf16x8){vlo[i][0], vlo[i][1], vlo[i][2], vlo[i][3], vhi[i][0], vhi[i][1], vhi[i][2], vhi[i][3]}
#define PIN(x) asm volatile("" : "+v"(x))
#define MX3(a, b, c) __builtin_fmaxf(__builtin_fmaxf((a), (b)), (c))
#define GAPA(MF, A0, A1, A2, A3, W0, W1, PW) do { MF; sacc += A0; sacc += A1; sacc += A2; sacc += A3; PIN(sacc); W0; W1; PIN(PW); SBAR(); } while (0)
#define EX(v) __builtin_amdgcn_exp2f(v)
#define GAPB(MF, X, B) do { MF; X[B] = EX(X[B]); X[B + 1] = EX(X[B + 1]); X[B + 2] = EX(X[B + 2]); X[B + 3] = EX(X[B + 3]); PIN(X); SBAR(); } while (0)
#define VRD(i) do { vlo[i] = vtr(vp_ + (((i) >> 2) * 4096 + ((i) & 3) * 1024)); vhi[i] = vtr(vp_ + (((i) >> 2) * 4096 + ((i) & 3) * 1024 + 512)); } while (0)
#define KRD(G, j) do { if (G) { kload2(kf, kp0 + sl_next, j); SBAR(); } } while (0)
#define STEP(C0, C1, P0, P1, t, GK, GV, GL) do { SBAR(); \
    const lds_cptr vp_ = vp0 + sl_prev; \
    VRD(0); SBAR(); float sacc = (P0[0] + P0[1]); \
    GAPA(C0 = __builtin_amdgcn_mfma_f32_32x32x16_bf16(kf[0], qr[0], negm, 0, 0, 0), P0[2], P0[3], P0[4], P0[5],     pw0[0] = PKW(P0, 0), pw0[1] = PKW(P0, 2), pw0); \
    VRD(4); SBAR(); GAPA(C1 = __builtin_amdgcn_mfma_f32_32x32x16_bf16(kf[1], qr[0], negm, 0, 0, 0), P0[6], P0[7], P0[8], P0[9],     pw0[2] = PKW(P0, 4), pw0[3] = PKW(P0, 6), pw0); \
    VRD(1); SBAR(); GAPA(C0 = __builtin_amdgcn_mfma_f32_32x32x16_bf16(kf[2], qr[1], C0, 0, 0, 0),   P0[10], P0[11], P0[12], P0[13], pw1[0] = PKW(P0, 8), pw1[1] = PKW(P0, 10), pw1); \
    VRD(5); SBAR(); GAPA(C1 = __builtin_amdgcn_mfma_f32_32x32x16_bf16(kf[3], qr[1], C1, 0, 0, 0),   P0[14], P0[15], P1[0], P1[1],   pw1[2] = PKW(P0, 12), pw1[3] = PKW(P0, 14), pw1); \
    VRD(2); SBAR(); GAPA(,   P1[2], P1[3], P1[4], P1[5],     pw2[0] = PKW(P1, 0), pw2[1] = PKW(P1, 2), pw2); \
    VRD(6); SBAR(); GAPA(,   P1[6], P1[7], P1[8], P1[9],     pw2[2] = PKW(P1, 4), pw2[3] = PKW(P1, 6), pw2); \
    VRD(3); SBAR(); GAPA(,   P1[10], P1[11], P1[12], P1[13], pw3[0] = PKW(P1, 8), pw3[1] = PKW(P1, 10), pw3); \
    VRD(7); SBAR(); GAPA(,   P1[14], P1[15], 0.f, 0.f,       pw3[2] = PKW(P1, 12), pw3[3] = PKW(P1, 14), pw3); \
    l_reg += sacc; \
    if (GK) { DMA_K((t) + 3, sl_cur); } if (GV) { DMA_V((t) + 1, sl_next); } \
    CMASK(C0, C1, t); \
    { float a = MX3(C0[0], C0[1], C1[0]), b = MX3(C0[2], C0[3], C1[1]); a = MX3(a, C1[2], C1[3]); \
      _Pragma("unroll") for (int r = 4; r < 16; r += 4) { a = MX3(a, C0[r], C0[r + 1]); b = MX3(b, C0[r + 2], C0[r + 3]); a = MX3(a, C1[r], C1[r + 1]); b = MX3(b, C1[r + 2], C1[r + 3]); } \
      float rm = __builtin_fmaxf(a, b); { auto rr = __builtin_amdgcn_permlane32_swap(__float_as_uint(rm), __float_as_uint(rm), false, false); rm = __builtin_fmaxf(__uint_as_float(rr[0]), __uint_as_float(rr[1])); } \
      resc = false; \
      if (__builtin_expect(__any(rm > (float)THRL), 0)) { const float dl = __builtin_fmaxf(rm, 0.f); mhat += dl; \
        _Pragma("unroll") for (int r = 0; r < 16; ++r) { C0[r] -= dl; C1[r] -= dl; } \
        _Pragma("unroll") for (int r = 0; r < 16; ++r) negm[r] = -mhat; asm volatile("" : "+v"(negm)); \
        const float f = __builtin_amdgcn_exp2f(-dl); l_reg *= f; if (hi == 0) wsf[r32] = f; resc = true; } } \
    SBAR(); \
    GAPB(o[0] = __builtin_amdgcn_mfma_f32_32x32x16_bf16(PAF(0), VFR(0), o[0], 0, 0, 0), C0, 0); \
    GAPB(o[1] = __builtin_amdgcn_mfma_f32_32x32x16_bf16(PAF(0), VFR(4), o[1], 0, 0, 0), C0, 4); \
    KRD(GL, 0); GAPB(o[0] = __builtin_amdgcn_mfma_f32_32x32x16_bf16(PAF(1), VFR(1), o[0], 0, 0, 0), C0, 8); \
    KRD(GL, 1); GAPB(o[1] = __builtin_amdgcn_mfma_f32_32x32x16_bf16(PAF(1), VFR(5), o[1], 0, 0, 0), C0, 12); \
    GAPB(o[0] = __builtin_amdgcn_mfma_f32_32x32x16_bf16(PAF(2), VFR(2), o[0], 0, 0, 0), C1, 0); \
    GAPB(o[1] = __builtin_amdgcn_mfma_f32_32x32x16_bf16(PAF(2), VFR(6), o[1], 0, 0, 0), C1, 4); \
    GAPB(o[0] = __builtin_amdgcn_mfma_f32_32x32x16_bf16(PAF(3), VFR(3), o[0], 0, 0, 0), C1, 8); \
    GAPB(o[1] = __builtin_amdgcn_mfma_f32_32x32x16_bf16(PAF(3), VFR(7), o[1], 0, 0, 0), C1, 12); \
    } while (0)
    int t = 1;
#undef CMASK
#define CMASK(P0, P1, t) do {} while (0)
    for (; t + 5 < NT; t += 2) {
        STEP(pB0, pB1, pA0, pA1, t, true, true, true);     WAIT_BAR(2); RESC(); ROT();
        STEP(pA0, pA1, pB0, pB1, t + 1, true, true, true); WAIT_BAR(2); RESC(); ROT();
    }
#undef CMASK
#define CMASK(P0, P1, t) do { int jb_ = (t) - (NT - 4); if (jb_ >= 0) cmask(P0, P1, jb_, qrel, hi); } while (0)
#define ENDW(tt) do { if ((tt) + 3 < NT) { WAIT_BAR(2); } else if ((tt) + 2 < NT) { WAIT_BAR(1); } else { WAIT_BAR(0); } } while (0)
    for (; t + 1 < NT; t += 2) {
        STEP(pB0, pB1, pA0, pA1, t, (t + 3 < NT), (t + 1 < NT), (t + 1 < NT));         ENDW(t);     RESC(); ROT();
        STEP(pA0, pA1, pB0, pB1, t + 1, (t + 4 < NT), (t + 2 < NT), (t + 2 < NT));     ENDW(t + 1); RESC(); ROT();
    }
    STEP(pB0, pB1, pA0, pA1, NT - 1, false, false, false); RESC();
    { float sacc = pB0[0] + pB0[1]; _Pragma("unroll") for (int r = 2; r < 16; ++r) sacc += pB0[r]; _Pragma("unroll") for (int r = 0; r < 16; ++r) sacc += pB1[r]; l_reg += sacc;
      pw0 = (u32x4){PKW(pB0, 0), PKW(pB0, 2), PKW(pB0, 4), PKW(pB0, 6)}; pw1 = (u32x4){PKW(pB0, 8), PKW(pB0, 10), PKW(pB0, 12), PKW(pB0, 14)}; pw2 = (u32x4){PKW(pB1, 0), PKW(pB1, 2), PKW(pB1, 4), PKW(pB1, 6)}; pw3 = (u32x4){PKW(pB1, 8), PKW(pB1, 10), PKW(pB1, 12), PKW(pB1, 14)};
      SBAR(); pv(o, vb0 + sl_cur, PAF(0), PAF(1), PAF(2), PAF(3)); }
#undef PKW
#undef PAF
#undef VFR
#undef PIN
#undef MX3
#undef GAPA
#undef GAPB
#undef EX
#undef VRD
#undef KRD
#undef STEP
#undef ENDW
    { auto rr = __builtin_amdgcn_permlane32_swap(__float_as_uint(l_reg), __float_as_uint(l_reg), false, false); l_reg = __uint_as_float(rr[0]) + __uint_as_float(rr[1]); }
    if (hi == 0) wsf[32 + r32] = l_reg; asm volatile("s_waitcnt lgkmcnt(0)" ::: "memory");
    float rli[16];
#pragma unroll
    for (int r = 0; r < 16; ++r) rli[r] = __builtin_amdgcn_rcpf(wsf[32 + crow(r, hi)]);
    float* stg = (float*)(shm + LDS_OST) + wid * 2048;
    if (comp == 0) {
#pragma unroll
        for (int r = 0; r < 16; ++r) { const int orow = crow(r, hi);
#pragma unroll
            for (int d0 = 0; d0 < 2; ++d0) stg[orow * 64 + d0 * 32 + r32] = o[d0][r] * rli[r]; }
    } else {
        const float lam = P.lam;
#pragma unroll
        for (int r = 0; r < 16; ++r) { const int orow = crow(r, hi);
#pragma unroll
            for (int d0 = 0; d0 < 2; ++d0) { const int ix = orow * 64 + d0 * 32 + r32; stg[ix] = stg[ix] - lam * (o[d0][r] * rli[r]); } }
        asm volatile("s_waitcnt lgkmcnt(0)" ::: "memory");
        bf16_t* Yw = P.Y + (rowbase + q0 + wid * QBLK) * DM + h * D;
        const int ch = lane & 7;
        const f32x4 g0 = *(const f32x4*)(P.gnorm + ch * 8), g1 = *(const f32x4*)(P.gnorm + ch * 8 + 4);
#pragma unroll
        for (int i = 0; i < 4; ++i) { const int row = i * 8 + (lane >> 3);
            const f32x4 a = *(const f32x4*)(stg + row * 64 + ch * 8), c = *(const f32x4*)(stg + row * 64 + ch * 8 + 4);
            float ss = (a[0] * a[0] + a[1] * a[1]) + (a[2] * a[2] + a[3] * a[3]) + (c[0] * c[0] + c[1] * c[1]) + (c[2] * c[2] + c[3] * c[3]);
            ss += __shfl_xor(ss, 1); ss += __shfl_xor(ss, 2); ss += __shfl_xor(ss, 4);
            const float rs = __builtin_amdgcn_rsqf(ss * (1.f / 64.f) + LN_EPS) * P.osc;
            u32x4 w; w.x = pk2(a[0] * rs * g0[0], a[1] * rs * g0[1]); w.y = pk2(a[2] * rs * g0[2], a[3] * rs * g0[3]); w.z = pk2(c[0] * rs * g1[0], c[1] * rs * g1[1]); w.w = pk2(c[2] * rs * g1[2], c[3] * rs * g1[3]);
            *(u32x4*)(Yw + (long)row * DM + ch * 8) = w; }
    }
    asm volatile("s_waitcnt lgkmcnt(0)\n\ts_barrier" ::: "memory");
#undef DMA_K
#undef DMA_V
#undef CMASK
#undef START
#undef RESC
#undef ROT
}
#undef SBAR
#undef WAIT_BAR
}

struct Frame {
    LAS unsigned char* lds; volatile LAS unsigned* MISC; gu32* ctl;
    int tid, lane, wave, vcu, G;
};
struct Args {
    const float* in[29]; float* out; unsigned char* ws; int ph_lo, ph_hi;
};
enum { I_X = 0, I_C, I_POS, I_WADA, I_BADA, I_WIN, I_WOUT, I_MBI, I_MBF, I_MG, I_CONVW, I_CONVB, I_LQ1, I_LK1, I_LQ2, I_LK2, I_DG, I_WA2, I_BA, I_GG, I_LN1G, I_LN1B, I_LN2G, I_LN2B,
       I_RW, I_RB, I_EWG, I_EWU, I_EWD };

__device__ __forceinline__ void tr_item(const float* W, int ldw, int K, bf16_t* WT, int drow0, int scol, int k0, LAS float* scr, int lane) {
#pragma unroll 8
    for (int i = 0; i < 32; ++i) { const int kk = 2 * i + (lane >> 5); scr[kk * 33 + (lane & 31)] = (scol >= 0) ? W[(size_t)(k0 + kk) * ldw + scol] : 0.f; }
    LDS_WAIT(); asm volatile("" ::: "memory");
    const int c = lane & 7;
#pragma unroll
    for (int j = 0; j < 4; ++j) { const int n = (lane >> 3) + 8 * j; const LAS float* s = scr + (8 * c) * 33 + n;
        u32x4 o; o.x = pk2(s[0 * 33], s[1 * 33]); o.y = pk2(s[2 * 33], s[3 * 33]); o.z = pk2(s[4 * 33], s[5 * 33]); o.w = pk2(s[6 * 33], s[7 * 33]);
        *(GAS u32x4*)(WT + (size_t)(drow0 + n) * K + k0 + 8 * c) = o; }
    LDS_WAIT(); asm volatile("" ::: "memory");
}
__device__ __forceinline__ int win_src_col(int n) {
    if (n < 1024) return n;
    if (n < 3584) return n + 8;
    const int i = n - 3584;
    if (i < 16) return 3592 + i;
    if (i < 20) return 1024 + (i - 16);
    if (i < 24) return 1028 + (i - 20);
    return -1;
}

namespace rec {
constexpr int PT = 72;
constexpr int TB = 64 * PT * 2;
constexpr int OFF_T0 = 0, OFF_T1 = TB, OFF_T2 = 2 * TB, OFF_T3 = 3 * TB, OFF_T4 = 4 * TB, OFF_T5 = 5 * TB;
constexpr int OFF_BM = 6 * TB;
constexpr int OFF_HM = OFF_BM + 16384;
constexpr int OFF_VEC = OFF_HM + 64 * 68 * 4;
constexpr int V_G = 0, V_M = 64, V_WI = 128, V_EM = 192, V_DI = 256, V_N = 320, V_BE = 384, V_SEG = 448, V_GA = 960;
static_assert(OFF_VEC + (960 + 1024) * 4 <= RING_BYTES, "rec LDS");

__device__ __forceinline__ void mm64(f32x4 (&acc)[2], const LAS bf16_t* A, const LAS bf16_t* Bt, int wid, int lane) {
    const int tm = wid >> 1, tn0 = (wid & 1) * 2, lr = lane & 15, lq = lane >> 4;
#pragma unroll
    for (int ks = 0; ks < 2; ++ks) {
        const bf16x8 a = *(const LAS bf16x8*)(A + (tm * 16 + lr) * PT + ks * 32 + lq * 8);
#pragma unroll
        for (int t = 0; t < 2; ++t) { const bf16x8 b = *(const LAS bf16x8*)(Bt + ((tn0 + t) * 16 + lr) * PT + ks * 32 + lq * 8);
            acc[t] = __builtin_amdgcn_mfma_f32_16x16x32_bf16(a, b, acc[t], 0, 0, 0); }
    }
}
__device__ __forceinline__ float scan_add(float v, int lane) {
#pragma unroll
    for (int o = 1; o < 64; o <<= 1) { const float t = __shfl_up(v, o); if (lane >= o) v += t; }
    return v;
}
__device__ __forceinline__ float scan_max(float v, int lane) {
#pragma unroll
    for (int o = 1; o < 64; o <<= 1) { const float t = __shfl_up(v, o); if (lane >= o) v = fmaxf(v, t); }
    return v;
}
__device__ __forceinline__ void st_tr8(LAS bf16_t* T, int l, int ch, u32x4 w) {
    T[(ch * 8 + 0) * PT + l] = (bf16_t)(w.x & 0xffffu); T[(ch * 8 + 1) * PT + l] = (bf16_t)(w.x >> 16);
    T[(ch * 8 + 2) * PT + l] = (bf16_t)(w.y & 0xffffu); T[(ch * 8 + 3) * PT + l] = (bf16_t)(w.y >> 16);
    T[(ch * 8 + 4) * PT + l] = (bf16_t)(w.z & 0xffffu); T[(ch * 8 + 5) * PT + l] = (bf16_t)(w.z >> 16);
    T[(ch * 8 + 6) * PT + l] = (bf16_t)(w.w & 0xffffu); T[(ch * 8 + 7) * PT + l] = (bf16_t)(w.w >> 16);
}
__device__ __forceinline__ void unpack8(u32x4 w, float (&f)[8]) {
    f[0] = bflo(w.x); f[1] = bfhi(w.x); f[2] = bflo(w.y); f[3] = bfhi(w.y); f[4] = bflo(w.z); f[5] = bfhi(w.z); f[6] = bflo(w.w); f[7] = bfhi(w.w);
}
template <int GATE  >
__device__ __forceinline__ void finalize(const LAS float* HM, const LAS float* rowscale, const float* gnorm, const bf16_t* gate, bf16_t* out, int tid) {
    const int j = tid >> 3, ch = tid & 7;
    const f32x4 a = *(const LAS f32x4*)(HM + j * 68 + ch * 8), c = *(const LAS f32x4*)(HM + j * 68 + ch * 8 + 4);
    const float rsc = rowscale ? rowscale[j] : 1.f;
    float v[8] = {a[0] * rsc, a[1] * rsc, a[2] * rsc, a[3] * rsc, c[0] * rsc, c[1] * rsc, c[2] * rsc, c[3] * rsc};
    float ss = 0.f;
#pragma unroll
    for (int i = 0; i < 8; ++i) ss += v[i] * v[i];
    ss += __shfl_xor(ss, 1); ss += __shfl_xor(ss, 2); ss += __shfl_xor(ss, 4);
    const float rs = __builtin_amdgcn_rsqf(ss * (1.f / 64.f) + LN_EPS);
    const u32x4 gw = *(const u32x4*)(gate + (size_t)j * PP + ch * 8);
    float gt[8]; unpack8(gw, gt);
    const f32x4 g0 = *(const f32x4*)(gnorm + ch * 8), g1 = *(const f32x4*)(gnorm + ch * 8 + 4);
    const float gn[8] = {g0[0], g0[1], g0[2], g0[3], g1[0], g1[1], g1[2], g1[3]};
    float y[8];
#pragma unroll
    for (int i = 0; i < 8; ++i) { const float sg = 1.f / (1.f + __expf(-gt[i])); const float gv = GATE ? gt[i] * sg : sg; y[i] = v[i] * rs * gn[i] * gv; }
    u32x4 w; w.x = pk2(y[0], y[1]); w.y = pk2(y[2], y[3]); w.z = pk2(y[4], y[5]); w.w = pk2(y[6], y[7]);
    *(u32x4*)(out + (size_t)j * DM + ch * 8) = w;
}

struct RecP {
    const bf16_t* proj; float* stm; float* stg; float* smN; float* smBC; float* smDM; float* smMS; float* smGBE; bf16_t* ycat;
    const float* mbi; const float* mbf; const float* mg; const float* wa2; const float* ba; const float* gg;
};

__device__ __forceinline__ void mlstm_gates(const RecP& P, int row0, int h, int lane, float& bcum, float& g) {
    const bf16_t* pr = P.proj + (size_t)(row0 + lane) * PP;
    const float li = bf2f(pr[C_MI + h]) + P.mbi[h];
    const float lf = logsig(bf2f(pr[C_MF + h]) + P.mbf[h]);
    bcum = scan_add(lf, lane); g = li - bcum;
}

__device__ __forceinline__ void mlstm_local(const RecP& P, LAS unsigned char* lds, int ci, int tid, int wid, int lane) {
    const int bh = ci >> 6, c = ci & 63, b = bh >> 2, h = bh & 3, row0 = b * SEQ + c * 64;
    LAS bf16_t* KT = (LAS bf16_t*)(lds + OFF_T0); LAS bf16_t* VT = (LAS bf16_t*)(lds + OFF_T1); LAS float* vec = (LAS float*)(lds + OFF_VEC);
    const int l = tid >> 3, ch = tid & 7;
    const u32x4 kw = *(const u32x4*)(P.proj + (size_t)(row0 + l) * PP + C_MK + h * 64 + ch * 8);
    const u32x4 vw = *(const u32x4*)(P.proj + (size_t)(row0 + l) * PP + C_MV + h * 64 + ch * 8);
    if (wid == 0) {
        float bc, g; mlstm_gates(P, row0, h, lane, bc, g);
        const float gmax = wave_max(g), bend = __shfl(bc, 63);
        vec[V_G + lane] = __expf(g - gmax);
        if (lane == 0) { P.smBC[ci] = bend; P.smDM[ci] = bend + gmax; }
    }
    __syncthreads();
    { const float w = vec[V_G + l]; float kf[8]; unpack8(kw, kf);
      u32x4 ks; ks.x = pk2(kf[0] * w, kf[1] * w); ks.y = pk2(kf[2] * w, kf[3] * w); ks.z = pk2(kf[4] * w, kf[5] * w); ks.w = pk2(kf[6] * w, kf[7] * w);
      st_tr8(KT, l, ch, ks); st_tr8(VT, l, ch, vw); }
    __syncthreads();
    f32x4 acc[2] = {(f32x4){0.f, 0.f, 0.f, 0.f}, (f32x4){0.f, 0.f, 0.f, 0.f}};
    mm64(acc, VT, KT, wid, lane);
    { const int tm = wid >> 1, tn0 = (wid & 1) * 2, lr = lane & 15, lq = lane >> 4; float* dst = P.stm + (size_t)ci * 4096;
#pragma unroll
      for (int t = 0; t < 2; ++t)
#pragma unroll
          for (int r = 0; r < 4; ++r) dst[(tm * 16 + lq * 4 + r) * 64 + (tn0 + t) * 16 + lr] = acc[t][r]; }
    if (tid < 64) { float s = 0.f;
#pragma unroll
        for (int q = 0; q < 8; ++q) { const u32x4 w = *(const LAS u32x4*)(KT + tid * PT + q * 8); float f[8]; unpack8(w, f);
#pragma unroll
            for (int i = 0; i < 8; ++i) s += f[i]; }
        P.smN[(size_t)ci * 64 + tid] = s; }
    __syncthreads();
}
__device__ __forceinline__ void mlstm_out(const RecP& P, LAS unsigned char* lds, int ci, int tid, int wid, int lane) {
    const int bh = ci >> 6, c = ci & 63, b = bh >> 2, h = bh & 3, row0 = b * SEQ + c * 64;
    LAS bf16_t* Qm = (LAS bf16_t*)(lds + OFF_T0); LAS bf16_t* Km = (LAS bf16_t*)(lds + OFF_T1); LAS bf16_t* VT = (LAS bf16_t*)(lds + OFF_T2);
    LAS bf16_t* CT = (LAS bf16_t*)(lds + OFF_T3); LAS bf16_t* Sm = (LAS bf16_t*)(lds + OFF_T4);
    LAS float* HM = (LAS float*)(lds + OFF_HM); LAS float* vec = (LAS float*)(lds + OFF_VEC);
    const int l = tid >> 3, ch = tid & 7;
    { const bf16_t* pr = P.proj + (size_t)(row0 + l) * PP + h * 64 + ch * 8;
      const u32x4 qw = *(const u32x4*)(pr + C_MQ), kw = *(const u32x4*)(pr + C_MK), vw = *(const u32x4*)(pr + C_MV);
      *(LAS u32x4*)(Qm + l * PT + ch * 8) = qw; *(LAS u32x4*)(Km + l * PT + ch * 8) = kw; st_tr8(VT, l, ch, vw);
      const float* cs = P.stm + (size_t)ci * 4096 + l * 64 + ch * 8;
      const f32x4 c0 = *(const f32x4*)cs, c1 = *(const f32x4*)(cs + 4);
      u32x4 cw; cw.x = pk2(c0[0], c0[1]); cw.y = pk2(c0[2], c0[3]); cw.z = pk2(c1[0], c1[1]); cw.w = pk2(c1[2], c1[3]);
      *(LAS u32x4*)(CT + l * PT + ch * 8) = cw; }
    if (wid == 0) {
        float bc, g; mlstm_gates(P, row0, h, lane, bc, g);
        const float pm = scan_max(g, lane), m = P.smMS[ci], M = fmaxf(m, pm);
        vec[V_G + lane] = g; vec[V_M + lane] = M; vec[V_WI + lane] = __expf(m - M); vec[V_EM + lane] = __expf(-bc - M);
        vec[V_N + lane] = P.smN[(size_t)ci * 64 + lane];
    }
    __syncthreads();
    { f32x4 acc[2] = {(f32x4){0.f, 0.f, 0.f, 0.f}, (f32x4){0.f, 0.f, 0.f, 0.f}};
      mm64(acc, Qm, Km, wid, lane);
      const int tm = wid >> 1, tn0 = (wid & 1) * 2, lr = lane & 15, lq = lane >> 4;
#pragma unroll
      for (int t = 0; t < 2; ++t) { const int ll = (tn0 + t) * 16 + lr; const float gl = vec[V_G + ll];
#pragma unroll
          for (int r = 0; r < 4; ++r) { const int j = tm * 16 + lq * 4 + r; const float s = (ll <= j) ? acc[t][r] * __expf(gl - vec[V_M + j]) : 0.f; Sm[j * PT + ll] = (bf16_t)f2bf(s); } } }
    __syncthreads();
    { f32x4 a1[2] = {(f32x4){0.f, 0.f, 0.f, 0.f}, (f32x4){0.f, 0.f, 0.f, 0.f}}, a2[2] = {(f32x4){0.f, 0.f, 0.f, 0.f}, (f32x4){0.f, 0.f, 0.f, 0.f}};
      mm64(a1, Sm, VT, wid, lane); mm64(a2, Qm, CT, wid, lane);
      const int tm = wid >> 1, tn0 = (wid & 1) * 2, lr = lane & 15, lq = lane >> 4;
#pragma unroll
      for (int t = 0; t < 2; ++t)
#pragma unroll
          for (int r = 0; r < 4; ++r) { const int j = tm * 16 + lq * 4 + r; HM[j * 68 + (tn0 + t) * 16 + lr] = a1[t][r] + vec[V_WI + j] * a2[t][r]; } }
    if (tid < 64) { float ds = 0.f, qn = 0.f;
#pragma unroll
        for (int q = 0; q < 8; ++q) { const u32x4 w = *(const LAS u32x4*)(Sm + tid * PT + q * 8); float f[8]; unpack8(w, f);
            const u32x4 qw = *(const LAS u32x4*)(Qm + tid * PT + q * 8); float qf[8]; unpack8(qw, qf);
#pragma unroll
            for (int i = 0; i < 8; ++i) { ds += f[i]; qn += qf[i] * vec[V_N + q * 8 + i]; } }
        const float den = ds + vec[V_WI + tid] * qn;
        vec[V_DI + tid] = 1.f / fmaxf(fabsf(den), vec[V_EM + tid]); }
    __syncthreads();
    finalize<0>(HM, vec + V_DI, P.mg, P.proj + (size_t)row0 * PP + C_MO + h * 64, P.ycat + (size_t)row0 * DM + h * 64, tid);
    __syncthreads();
}
__device__ __forceinline__ void gla_bmat(const RecP& P, LAS unsigned char* lds, int row0, int h, int tid, int wid) {
    LAS float* BM = (LAS float*)(lds + OFF_BM); LAS float* vec = (LAS float*)(lds + OFF_VEC);
    if (tid < 128) { const int l = tid >> 1, hf = tid & 1; const u32x4 w = *(const u32x4*)(P.proj + (size_t)(row0 + l) * PP + C_GA + hf * 8); float f[8]; unpack8(w, f);
#pragma unroll
        for (int i = 0; i < 8; ++i) vec[V_GA + l * 16 + hf * 8 + i] = f[i]; }
    const int dcol = tid & 63;
    float wv[16];
#pragma unroll
    for (int r = 0; r < 16; ++r) wv[r] = P.wa2[r * 256 + h * 64 + dcol];
    const float bav = P.ba[h * 64 + dcol];
    __syncthreads();
    float cs[8]; float cacc = 0.f;
#pragma unroll
    for (int i = 0; i < 8; ++i) { const int l = wid * 8 + i; float z = bav;
#pragma unroll
        for (int r = 0; r < 16; ++r) z += vec[V_GA + l * 16 + r] * wv[r];
        cacc += logsig(z) * (1.f / 16.f); cs[i] = cacc; }
    vec[V_SEG + wid * 64 + dcol] = cacc;
    __syncthreads();
    float off = 0.f, tot = 0.f;
#pragma unroll
    for (int s = 0; s < 8; ++s) { const float v = vec[V_SEG + s * 64 + dcol]; tot += v; if (s < wid) off += v; }
#pragma unroll
    for (int i = 0; i < 8; ++i) BM[(wid * 8 + i) * 64 + dcol] = off + cs[i];
    if (wid == 0) vec[V_BE + dcol] = tot;
    __syncthreads();
}
__device__ __forceinline__ void gla_local(const RecP& P, LAS unsigned char* lds, int ci, int tid, int wid, int lane) {
    const int bh = ci >> 6, c = ci & 63, b = bh >> 2, h = bh & 3, row0 = b * SEQ + c * 64;
    LAS bf16_t* KT = (LAS bf16_t*)(lds + OFF_T0); LAS bf16_t* VT = (LAS bf16_t*)(lds + OFF_T1);
    LAS float* BM = (LAS float*)(lds + OFF_BM); LAS float* vec = (LAS float*)(lds + OFF_VEC);
    const int l = tid >> 3, ch = tid & 7;
    const u32x4 kw = *(const u32x4*)(P.proj + (size_t)(row0 + l) * PP + C_GK + h * 64 + ch * 8);
    const u32x4 vw = *(const u32x4*)(P.proj + (size_t)(row0 + l) * PP + C_GV + h * 64 + ch * 8);
    gla_bmat(P, lds, row0, h, tid, wid);
    if (tid < 64) P.smGBE[(size_t)ci * 64 + tid] = vec[V_BE + tid];
    { float kf[8]; unpack8(kw, kf); float ks[8];
#pragma unroll
      for (int i = 0; i < 8; ++i) { const int d = ch * 8 + i; ks[i] = kf[i] * __expf(vec[V_BE + d] - BM[l * 64 + d]); }
      u32x4 kk; kk.x = pk2(ks[0], ks[1]); kk.y = pk2(ks[2], ks[3]); kk.z = pk2(ks[4], ks[5]); kk.w = pk2(ks[6], ks[7]);
      st_tr8(KT, l, ch, kk); st_tr8(VT, l, ch, vw); }
    __syncthreads();
    f32x4 acc[2] = {(f32x4){0.f, 0.f, 0.f, 0.f}, (f32x4){0.f, 0.f, 0.f, 0.f}};
    mm64(acc, VT, KT, wid, lane);
    { const int tm = wid >> 1, tn0 = (wid & 1) * 2, lr = lane & 15, lq = lane >> 4; float* dst = P.stg + (size_t)ci * 4096;
#pragma unroll
      for (int t = 0; t < 2; ++t)
#pragma unroll
          for (int r = 0; r < 4; ++r) dst[(tm * 16 + lq * 4 + r) * 64 + (tn0 + t) * 16 + lr] = acc[t][r]; }
    __syncthreads();
}
__device__ __forceinline__ void gla_out(const RecP& P, LAS unsigned char* lds, int ci, int tid, int wid, int lane) {
    const int bh = ci >> 6, c = ci & 63, b = bh >> 2, h = bh & 3, row0 = b * SEQ + c * 64;
    LAS bf16_t* Qm = (LAS bf16_t*)(lds + OFF_T0); LAS bf16_t* Km = (LAS bf16_t*)(lds + OFF_T1); LAS bf16_t* VT = (LAS bf16_t*)(lds + OFF_T2);
    LAS bf16_t* ST = (LAS bf16_t*)(lds + OFF_T3); LAS bf16_t* Sm = (LAS bf16_t*)(lds + OFF_T4);
    LAS float* BM = (LAS float*)(lds + OFF_BM); LAS float* HM = (LAS float*)(lds + OFF_HM);
    const int l = tid >> 3, ch = tid & 7;
    const bf16_t* pr = P.proj + (size_t)(row0 + l) * PP + h * 64 + ch * 8;
    const u32x4 qw = *(const u32x4*)(pr + C_GQ), kw = *(const u32x4*)(pr + C_GK), vw = *(const u32x4*)(pr + C_GV);
    const float* ss = P.stg + (size_t)ci * 4096 + l * 64 + ch * 8;
    const f32x4 s0 = *(const f32x4*)ss, s1 = *(const f32x4*)(ss + 4);
    gla_bmat(P, lds, row0, h, tid, wid);
    { float qf[8], kf[8]; unpack8(qw, qf); unpack8(kw, kf); float qs[8], ks[8];
#pragma unroll
      for (int i = 0; i < 8; ++i) { const float bv = BM[l * 64 + ch * 8 + i]; qs[i] = qf[i] * __expf(bv); ks[i] = kf[i] * __expf(-bv); }
      u32x4 qq, kk; qq.x = pk2(qs[0], qs[1]); qq.y = pk2(qs[2], qs[3]); qq.z = pk2(qs[4], qs[5]); qq.w = pk2(qs[6], qs[7]);
      kk.x = pk2(ks[0], ks[1]); kk.y = pk2(ks[2], ks[3]); kk.z = pk2(ks[4], ks[5]); kk.w = pk2(ks[6], ks[7]);
      *(LAS u32x4*)(Qm + l * PT + ch * 8) = qq; *(LAS u32x4*)(Km + l * PT + ch * 8) = kk; st_tr8(VT, l, ch, vw);
      u32x4 cw; cw.x = pk2(s0[0], s0[1]); cw.y = pk2(s0[2], s0[3]); cw.z = pk2(s1[0], s1[1]); cw.w = pk2(s1[2], s1[3]);
      *(LAS u32x4*)(ST + l * PT + ch * 8) = cw; }
    __syncthreads();
    { f32x4 acc[2] = {(f32x4){0.f, 0.f, 0.f, 0.f}, (f32x4){0.f, 0.f, 0.f, 0.f}};
      mm64(acc, Qm, Km, wid, lane);
      const int tm = wid >> 1, tn0 = (wid & 1) * 2, lr = lane & 15, lq = lane >> 4;
#pragma unroll
      for (int t = 0; t < 2; ++t) { const int ll = (tn0 + t) * 16 + lr;
#pragma unroll
          for (int r = 0; r < 4; ++r) { const int j = tm * 16 + lq * 4 + r; Sm[j * PT + ll] = (bf16_t)f2bf((ll <= j) ? acc[t][r] : 0.f); } } }
    __syncthreads();
    { f32x4 acc[2] = {(f32x4){0.f, 0.f, 0.f, 0.f}, (f32x4){0.f, 0.f, 0.f, 0.f}};
      mm64(acc, Sm, VT, wid, lane); mm64(acc, Qm, ST, wid, lane);
      const int tm = wid >> 1, tn0 = (wid & 1) * 2, lr = lane & 15, lq = lane >> 4;
#pragma unroll
      for (int t = 0; t < 2; ++t)
#pragma unroll
          for (int r = 0; r < 4; ++r) HM[(tm * 16 + lq * 4 + r) * 68 + (tn0 + t) * 16 + lr] = acc[t][r]; }
    __syncthreads();
    finalize<1>(HM, nullptr, P.gg, P.proj + (size_t)row0 * PP + C_GR + h * 64, P.ycat + (size_t)row0 * DM + 768 + h * 64, tid);
    __syncthreads();
}
}

constexpr int N_PHASES = 2 + 9 * DEPTH;
__global__ void __launch_bounds__(512, 2) mega_fwd(Args args) {
    extern __shared__ __attribute__((aligned(16))) unsigned char lds_raw[];
    Frame F;
    F.lds = (LAS unsigned char*)lds_raw;
    F.MISC = (volatile LAS unsigned*)(F.lds + MISC_OFF);
    F.tid = threadIdx.x; F.lane = F.tid & 63; F.wave = __builtin_amdgcn_readfirstlane(F.tid >> 6);
    F.G = gridDim.x; { const int bx = blockIdx.x; F.vcu = (F.G % 8 == 0) ? (bx % 8) * (F.G / 8) + bx / 8 : bx; }
    unsigned char* ws = args.ws;
    F.ctl = (gu32*)(ws + WS_CTL);
    for (int u = F.tid; u < (LDS_BYTES - LDSCTL_OFF) / 4; u += 512) ((LAS unsigned*)(F.lds + LDSCTL_OFF))[u] = 0u;
    __syncthreads();
#if MK_ONE_LAUNCH
    XcdBarrier bar = xcd_barrier_post((unsigned*)(F.ctl + CW_BAR), F.MISC + 8);
#define GRID_BAR() xcd_barrier(bar)
#else
#define GRID_BAR() do {} while (0)
#endif
    const int lo = args.ph_lo, hi = args.ph_hi;
#define IN(k) (lo <= (k) && (k) < hi)
#define SEAM(k) do { if (IN(k) && IN((k) + 1)) GRID_BAR(); } while (0)
    const int NGW = F.G * 8;
#define PHASE_IDS() int tid = F.tid; asm volatile("" : "+v"(tid)); const int lane = tid & 63, wid = __builtin_amdgcn_readfirstlane(tid >> 6); const int gw = F.vcu * 8 + wid; (void)lane; (void)gw
    float* const MOD = (float*)(ws + WS_MOD); float* const ROPE = (float*)(ws + WS_ROPE);
    bf16_t* const WIN = (bf16_t*)(ws + WS_WIN); bf16_t* const WOUT = (bf16_t*)(ws + WS_WOUT); bf16_t* const WGU = (bf16_t*)(ws + WS_WGU); bf16_t* const WD = (bf16_t*)(ws + WS_WD);
    int* const LTOK = (int*)(ws + WS_LTOK); float* const LGATE = (float*)(ws + WS_LGATE);
    bf16_t* const PROJ = (bf16_t*)(ws + WS_PROJ); bf16_t* const HB = (bf16_t*)(ws + WS_PROJ); float* const XR = (float*)(ws + WS_XR);
    bf16_t* const UB = (bf16_t*)(ws + WS_U); bf16_t* const YCAT = (bf16_t*)(ws + WS_YCAT);
    float* const STM = (float*)(ws + WS_U); float* const STG = (float*)(ws + WS_U + 32 * MiB);
    float* const smN = (float*)(ws + WS_SM + SM_N); float* const smBC = (float*)(ws + WS_SM + SM_BC); float* const smDM = (float*)(ws + WS_SM + SM_DM);
    float* const smMS = (float*)(ws + WS_SM + SM_MS); float* const smGBE = (float*)(ws + WS_SM + SM_GBE);
    const float* const x_in = args.in[I_X];

    if (IN(0) && PHON(0)) {
        PHASE_IDS();
        {
            LAS float* cact = (LAS float*)F.lds;
            LAS float* part = (LAS float*)(F.lds + 32768);
            const float* cc = args.in[I_C];
            for (int i = tid; i < NB * DM; i += 512) { const int b = i >> 10, k = i & 1023; const float v = cc[i]; cact[k * 8 + b] = v / (1.f + __expf(-v)); }
            __syncthreads();
            for (int it = F.vcu; it < DEPTH * 96; it += F.G) {
                const int l = it / 96, j0 = (it % 96) * 64;
                const float* W = args.in[I_WADA] + (size_t)l * DM * 6144 + j0 + lane;
                float a[8] = {0.f, 0.f, 0.f, 0.f, 0.f, 0.f, 0.f, 0.f};
#pragma unroll 8
                for (int kk = 0; kk < 128; ++kk) { const int k = wid * 128 + kk; const float w = W[(size_t)k * 6144];
                    const f32x4 c0 = *(const LAS f32x4*)(cact + k * 8), c1 = *(const LAS f32x4*)(cact + k * 8 + 4);
                    a[0] += c0[0] * w; a[1] += c0[1] * w; a[2] += c0[2] * w; a[3] += c0[3] * w; a[4] += c1[0] * w; a[5] += c1[1] * w; a[6] += c1[2] * w; a[7] += c1[3] * w; }
#pragma unroll
                for (int b = 0; b < 8; ++b) part[(wid * 8 + b) * 64 + lane] = a[b];
                __syncthreads();
                { const int b = tid >> 6, j = tid & 63; float s = args.in[I_BADA][(size_t)l * 6144 + j0 + j];
#pragma unroll
                  for (int w = 0; w < 8; ++w) s += part[(w * 8 + b) * 64 + j];
                  MOD[((size_t)l * NB + b) * 6144 + j0 + j] = s; }
                __syncthreads();
            }
        }
        {
            const int* pos = (const int*)args.in[I_POS];
            for (int i = blockIdx.x * 512 + tid; i < NTOK * 4; i += F.G * 512) { const int row = i >> 2, f = i & 3;
                const float invf = (float)pow(500000.0, -0.25 * (double)f); const float ang = (float)pos[row] * invf;
                ROPE[(size_t)row * 8 + f] = (float)cos((double)ang); ROPE[(size_t)row * 8 + 4 + f] = (float)sin((double)ang); }
        }
        {
            LAS float* scr = (LAS float*)(F.lds + 65536 + wid * 8704);
            constexpr int I_IN = (DM / 64) * (PP / 32), I_OUT = (DM / 64) * (DM / 32);
            for (int it = gw; it < DEPTH * (I_IN + I_OUT); it += NGW) {
                const int l = it / (I_IN + I_OUT); int r = it % (I_IN + I_OUT);
                if (r < I_IN) { const int kb = r / (PP / 32), nb = r % (PP / 32);
                    tr_item(args.in[I_WIN] + (size_t)l * DM * PIN, PIN, DM, WIN + (size_t)l * PP * DM, nb * 32, win_src_col(nb * 32 + (lane & 31)), kb * 64, scr, lane); }
                else { r -= I_IN; const int kb = r / (DM / 32), nb = r % (DM / 32);
                    tr_item(args.in[I_WOUT] + (size_t)l * DM * DM, DM, DM, WOUT + (size_t)l * DM * DM, nb * 32, nb * 32 + (lane & 31), kb * 64, scr, lane); }
            }
        }
    }
    SEAM(0);
    if (IN(1) && PHON(1)) {
        PHASE_IDS();
        const int b = F.vcu >> 5; const float* md = MOD + (size_t)b * 6144;
        f32x4 sh[4], sc[4];
#pragma unroll
        for (int j = 0; j < 4; ++j) { sh[j] = *(const f32x4*)(md + 4 * lane + 256 * j); sc[j] = *(const f32x4*)(md + 1024 + 4 * lane + 256 * j) + 1.0f; }
        for (int i = 0; i < 16; ++i) { const int row = F.vcu * 128 + wid * 16 + i;
#pragma unroll
            for (int j = 0; j < 4; ++j) { const f32x4 v = *(const f32x4*)(x_in + (size_t)row * DM + 4 * lane + 256 * j); const f32x4 u = v * sc[j] + sh[j];
                u32x2 w; w.x = pk2(u[0], u[1]); w.y = pk2(u[2], u[3]); *(u32x2*)(UB + (size_t)row * DM + 4 * lane + 256 * j) = w; } }
    }
    SEAM(1);

    for (int l = 0; l < DEPTH; ++l) {
        const int pb = 2 + 9 * l;
        const float* modl = MOD + (size_t)l * NB * 6144;
#define MAKE_RP() rec::RecP RP; RP.proj = PROJ; RP.stm = STM; RP.stg = STG; RP.smN = smN; RP.smBC = smBC; RP.smDM = smDM; RP.smMS = smMS; RP.smGBE = smGBE; RP.ycat = YCAT; \
        RP.mbi = args.in[I_MBI] + l * 4; RP.mbf = args.in[I_MBF] + l * 4; RP.mg = args.in[I_MG] + l * 64; RP.wa2 = args.in[I_WA2] + (size_t)l * 16 * 256; RP.ba = args.in[I_BA] + l * 256; RP.gg = args.in[I_GG] + l * 64;
        if (IN(pb + 0) && PHON(2)) {
            gm::K1 k; k.S.init(NTOK, PP, F.G, (int)blockIdx.x); k.A = UB; k.Bt = WIN + (size_t)l * PP * DM; k.O = PROJ; k.rope = ROPE;
            gm::gemm_phase<gm::K1>(F.lds, k);
        }
        SEAM(pb + 0);
        if (IN(pb + 1) && PHON(3)) {
            PHASE_IDS();
            MAKE_RP();
            for (int it = F.vcu; it < 4096; it += F.G) { if (it < 2048) rec::mlstm_local(RP, F.lds, it, tid, wid, lane); else rec::gla_local(RP, F.lds, it - 2048, tid, wid, lane); }
        }
        SEAM(pb + 1);
        if (IN(pb + 2) && PHON(4)) {
            PHASE_IDS();
            const int gt = blockIdx.x * 512 + tid, NGT = F.G * 512;
            for (int idx = gt; idx < 32 * 4096; idx += NGT) {
                const int bh = idx >> 12, el = idx & 4095; float* p = STM + (size_t)bh * 64 * 4096 + el; const float* bc = smBC + bh * 64; const float* dm = smDM + bh * 64;
                float C = 0.f, m = 0.f;
#pragma unroll 8
                for (int c = 0; c < NCH; ++c) { const float u = p[(size_t)c * 4096]; p[(size_t)c * 4096] = C; if (el == 0) smMS[bh * 64 + c] = m;
                    const float B = bc[c], Dm = dm[c], mn = fmaxf(B + m, Dm); C = __expf(B + m - mn) * C + __expf(Dm - mn) * u; m = mn; }
            }
            for (int idx = gt; idx < 32 * 64; idx += NGT) {
                const int bh = idx >> 6, el = idx & 63; float* p = smN + (size_t)bh * 64 * 64 + el; const float* bc = smBC + bh * 64; const float* dm = smDM + bh * 64;
                float C = 0.f, m = 0.f;
#pragma unroll 8
                for (int c = 0; c < NCH; ++c) { const float u = p[c * 64]; p[c * 64] = C;
                    const float B = bc[c], Dm = dm[c], mn = fmaxf(B + m, Dm); C = __expf(B + m - mn) * C + __expf(Dm - mn) * u; m = mn; }
            }
            for (int idx = gt; idx < 32 * 4096; idx += NGT) {
                const int bh = idx >> 12, el = idx & 4095, d = el & 63; float* p = STG + (size_t)bh * 64 * 4096 + el; const float* be = smGBE + (size_t)bh * 64 * 64 + d;
                float S = 0.f;
#pragma unroll 8
                for (int c = 0; c < NCH; ++c) { const float u = p[(size_t)c * 4096]; p[(size_t)c * 4096] = S; S = __expf(be[c * 64]) * S + u; }
            }
            {
                LAS float* scr = (LAS float*)(F.lds + 65536 + wid * 8704);
                constexpr int I_G = (DM / 64) * (1024 / 32), I_D = (DE / 64) * (DM / 32);
                for (int it = gw; it < NE * (I_G + I_D); it += NGW) {
                    const int e = it / (I_G + I_D); int r = it % (I_G + I_D);
                    if (r < I_G) { const int kb = r / 32, nb = r % 32, n0 = nb * 32, tt = n0 >> 8, rr = n0 & 255;
                        const float* W = (rr < 128 ? args.in[I_EWG] : args.in[I_EWU]) + ((size_t)l * NE + e) * DM * DE;
                        tr_item(W, DE, DM, WGU + (size_t)e * 1024 * 1024, n0, tt * 128 + (rr & 127) + (lane & 31), kb * 64, scr, lane); }
                    else { r -= I_G; const int kb = r / 32, nb = r % 32;
                        tr_item(args.in[I_EWD] + ((size_t)l * NE + e) * DE * DM, DM, DE, WD + (size_t)e * 1024 * 512, nb * 32, nb * 32 + (lane & 31), kb * 64, scr, lane); }
                }
            }
        }
        SEAM(pb + 2);
        if (IN(pb + 3) && PHON(5)) {
            PHASE_IDS();
            if (PHON(10)) {
                float d1 = 0.f, d2 = 0.f;
                for (int i = 0; i < 32; ++i) { d1 += args.in[I_LQ1][l * 32 + i] * args.in[I_LK1][l * 32 + i]; d2 += args.in[I_LQ2][l * 32 + i] * args.in[I_LK2][l * 32 + i]; }
                const float lam_init = 0.8f - 0.6f * expf(-0.3f * (float)l);
                attn_body::AttnParams AP; AP.Q = (const attn_body::bf16*)(PROJ + C_DQ); AP.K = (const attn_body::bf16*)(PROJ + C_DK); AP.V = (const attn_body::bf16*)(PROJ + C_DV);
                AP.zpage = (const attn_body::bf16*)(F.ctl + CW_ZPAGE); AP.Y = YCAT + 512; AP.gnorm = args.in[I_DG] + l * 64; AP.lam = expf(d1) - expf(d2) + lam_init; AP.osc = 1.f - lam_init;
                const int bh = F.vcu >> 3, s = F.vcu & 7;
                if (F.G == 256) {
                    for (int i = 0; i < 2; ++i) { const int qb = (i == 0) ? s : 15 - s;
                        attn_body::attn_unit<8, 0>(bh >> 2, bh & 3, qb, AP, (char*)lds_raw); attn_body::attn_unit<8, 1>(bh >> 2, bh & 3, qb, AP, (char*)lds_raw); }
                } else {
                    for (int u = F.vcu; u < 512; u += F.G) { const int bh2 = u >> 4, qb = u & 15;
                        attn_body::attn_unit<8, 0>(bh2 >> 2, bh2 & 3, qb, AP, (char*)lds_raw); attn_body::attn_unit<8, 1>(bh2 >> 2, bh2 & 3, qb, AP, (char*)lds_raw); }
                }
            }
            __syncthreads();
            MAKE_RP();
            if (PHON(11)) for (int it = F.vcu; it < 4096; it += F.G) { if (it < 2048) rec::mlstm_out(RP, F.lds, it, tid, wid, lane); else rec::gla_out(RP, F.lds, it - 2048, tid, wid, lane); }
            if (PHON(12)) {
                const float* cw = args.in[I_CONVW] + (size_t)l * 3 * 256; const float* cbias = args.in[I_CONVB] + l * 256;
                for (int it = F.vcu; it < NTOK / 64; it += F.G) {
                    for (int p = tid; p < 64 * 32; p += 512) { const int r = p >> 5, chn = p & 31, row = it * 64 + r, t = row & (SEQ - 1);
                        const bf16_t* pr = PROJ + (size_t)row * PP + chn * 8;
                        float s0[8], s1[8], s2[8], cbv[8];
                        { float a[8], bq[8]; rec::unpack8(*(const u32x4*)(pr + C_CC), a); rec::unpack8(*(const u32x4*)(pr + C_CH), bq);
#pragma unroll
                          for (int i = 0; i < 8; ++i) s2[i] = a[i] * bq[i]; }
                        if (t >= 1) { float a[8], bq[8]; rec::unpack8(*(const u32x4*)(pr - PP + C_CC), a); rec::unpack8(*(const u32x4*)(pr - PP + C_CH), bq);
#pragma unroll
                          for (int i = 0; i < 8; ++i) s1[i] = a[i] * bq[i]; } else {
#pragma unroll
                          for (int i = 0; i < 8; ++i) s1[i] = 0.f; }
                        if (t >= 2) { float a[8], bq[8]; rec::unpack8(*(const u32x4*)(pr - 2 * PP + C_CC), a); rec::unpack8(*(const u32x4*)(pr - 2 * PP + C_CH), bq);
#pragma unroll
                          for (int i = 0; i < 8; ++i) s0[i] = a[i] * bq[i]; } else {
#pragma unroll
                          for (int i = 0; i < 8; ++i) s0[i] = 0.f; }
                        rec::unpack8(*(const u32x4*)(pr + C_CB), cbv);
                        float y[8];
#pragma unroll
                        for (int i = 0; i < 8; ++i) { const int cch = chn * 8 + i; y[i] = cbv[i] * (cw[cch] * s0[i] + cw[256 + cch] * s1[i] + cw[512 + cch] * s2[i] + cbias[cch]); }
                        u32x4 w; w.x = pk2(y[0], y[1]); w.y = pk2(y[2], y[3]); w.z = pk2(y[4], y[5]); w.w = pk2(y[6], y[7]);
                        *(u32x4*)(YCAT + (size_t)row * DM + 256 + chn * 8) = w; }
                }
            }
        }
        SEAM(pb + 3);
        if (IN(pb + 4) && PHON(6)) {
            gm::K2 k; k.S.init(NTOK, DM, F.G, (int)blockIdx.x); k.A = YCAT; k.Bt = WOUT + (size_t)l * DM * DM; k.xin = (l == 0) ? x_in : XR; k.xout = XR; k.modl = modl;
            gm::gemm_phase<gm::K2>(F.lds, k);
        }
        SEAM(pb + 4);
        if (IN(pb + 5) && PHON(7)) {
            PHASE_IDS();
            LAS float* rwT = (LAS float*)F.lds;
            { const float* rw = args.in[I_RW]; for (int i = tid; i < DM * NE; i += 512) rwT[(i & 15) * 1024 + (i >> 4)] = rw[i]; }
            __syncthreads();
            const int b = F.vcu >> 5; const float* md = modl + (size_t)b * 6144;
            const float* lg = args.in[I_LN1G] + l * DM; const float* lb = args.in[I_LN1B] + l * DM;
            f32x4 gv[4], bv[4], sh[4], sc[4];
#pragma unroll
            for (int j = 0; j < 4; ++j) { const int cix = 4 * lane + 256 * j; gv[j] = *(const f32x4*)(lg + cix); bv[j] = *(const f32x4*)(lb + cix); sh[j] = *(const f32x4*)(md + 3 * 1024 + cix); sc[j] = *(const f32x4*)(md + 4 * 1024 + cix) + 1.0f; }
            LAS float* rbl = (LAS float*)(F.lds + 65536);
            if (tid < 16) rbl[tid] = args.in[I_RB][tid];
            __syncthreads();
            gu32* cntw = F.ctl + CW_CNT + (size_t)l * NBUCKET * 64;
            for (int i = 0; i < 16; ++i) { const int row = F.vcu * 128 + wid * 16 + i;
                f32x4 v[4]; float s = 0.f;
#pragma unroll
                for (int j = 0; j < 4; ++j) { v[j] = *(const f32x4*)(XR + (size_t)row * DM + 4 * lane + 256 * j); s += (v[j][0] + v[j][1]) + (v[j][2] + v[j][3]); }
                const float mean = wave_sum(s) * (1.f / DM); float s2 = 0.f;
#pragma unroll
                for (int j = 0; j < 4; ++j) { v[j] = v[j] - mean; s2 += (v[j][0] * v[j][0] + v[j][1] * v[j][1]) + (v[j][2] * v[j][2] + v[j][3] * v[j][3]); }
                const float rstd = 1.f / sqrtf(wave_sum(s2) * (1.f / DM) + LN_EPS);
#pragma unroll
                for (int j = 0; j < 4; ++j) { const f32x4 xn = v[j] * rstd * gv[j] + bv[j]; *(f32x4*)(XR + (size_t)row * DM + 4 * lane + 256 * j) = xn;
                    const f32x4 u = xn * sc[j] + sh[j]; v[j] = u; u32x2 w; w.x = pk2(u[0], u[1]); w.y = pk2(u[2], u[3]); *(u32x2*)(UB + (size_t)row * DM + 4 * lane + 256 * j) = w; }
                int bg = 0; float bgs = -INFINITY; float gb0 = 0.f, gb1 = 0.f, gb2 = 0.f, gb3 = 0.f, gs0 = 0.f, gs1 = 0.f, gs2 = 0.f, gs3 = 0.f;
#pragma unroll 1
                for (int g = 0; g < 4; ++g) {
                    float cb[4], cs[4];
#pragma unroll
                    for (int q = 0; q < 4; ++q) { const LAS float* rr = rwT + (g * 4 + q) * 1024 + 4 * lane; float p = 0.f;
#pragma unroll
                        for (int j = 0; j < 4; ++j) { const f32x4 r4 = *(const LAS f32x4*)(rr + 256 * j); p += (v[j][0] * r4[0] + v[j][1] * r4[1]) + (v[j][2] * r4[2] + v[j][3] * r4[3]); }
                        const float lgt = wave_sum(p); cs[q] = 1.f / (1.f + __expf(-lgt)); cb[q] = cs[q] + rbl[g * 4 + q]; }
                    const float h1 = fmaxf(cb[0], cb[1]), l1 = fminf(cb[0], cb[1]), h2 = fmaxf(cb[2], cb[3]), l2 = fminf(cb[2], cb[3]);
                    const float top = fmaxf(h1, h2), sec = fmaxf(fminf(h1, h2), (h1 >= h2) ? l1 : l2); const float gsc = top + sec;
                    if (gsc > bgs) { bgs = gsc; bg = g; gb0 = cb[0]; gb1 = cb[1]; gb2 = cb[2]; gb3 = cb[3]; gs0 = cs[0]; gs1 = cs[1]; gs2 = cs[2]; gs3 = cs[3]; }
                }
                int e1 = 0; float m1 = gb0;
                if (gb1 > m1) { m1 = gb1; e1 = 1; } if (gb2 > m1) { m1 = gb2; e1 = 2; } if (gb3 > m1) { m1 = gb3; e1 = 3; }
                int e2 = -1; float m2 = -INFINITY;
                if (e1 != 0 && gb0 > m2) { m2 = gb0; e2 = 0; } if (e1 != 1 && gb1 > m2) { m2 = gb1; e2 = 1; } if (e1 != 2 && gb2 > m2) { m2 = gb2; e2 = 2; } if (e1 != 3 && gb3 > m2) { m2 = gb3; e2 = 3; }
                const int ei = e1 < e2 ? e1 : e2, ej = e1 < e2 ? e2 : e1;
                const float si = (ei == 0) ? gs0 : (ei == 1) ? gs1 : (ei == 2) ? gs2 : gs3, sj = (ej == 0) ? gs0 : (ej == 1) ? gs1 : (ej == 2) ? gs2 : gs3;
                const int pr_ = (ei == 0) ? ej - 1 : (ei == 1) ? ej + 1 : 5; const int bk = bg * 6 + pr_;
                if (lane == 0) { const unsigned pos = __hip_atomic_fetch_add(cntw + bk * 64, 1u, RLX_AGENT);
                    LTOK[(size_t)bk * LCAP + pos] = row; const float inv = 1.f / (si + sj); LGATE[((size_t)bk * LCAP + pos) * 2] = si * inv; LGATE[((size_t)bk * LCAP + pos) * 2 + 1] = sj * inv; }
            }
            __syncthreads();
        }
        SEAM(pb + 5);
        if ((IN(pb + 6) || IN(pb + 7)) && PHON(8)) {
            PHASE_IDS();
            LAS int* tb = (LAS int*)(F.lds + MOE_TB_OFF);
            if (tid == 0) { gu32* cntw = F.ctl + CW_CNT + (size_t)l * NBUCKET * 64; int acc = 0;
                for (int k = 0; k < NBUCKET; ++k) { const int c = (int)__hip_atomic_load(cntw + k * 64, RLX_AGENT); tb[k] = c; tb[32 + k] = acc; acc += (c + 255) >> 8; }
                tb[32 + NBUCKET] = acc; }
            __syncthreads();
            if (IN(pb + 6)) {
                gm::K4 k; k.U = UB; k.Wgu = WGU; k.H = HB; k.ltok = LTOK; k.lgate = LGATE; k.tb = tb; k.G = F.G; k.vcu = F.vcu;
                gm::gemm_phase<gm::K4>(F.lds, k);
            }
            SEAM(pb + 6);
            if (IN(pb + 7)) {
                gm::K5 k; k.H = HB; k.Wd = WD; k.XR = XR; k.ltok = LTOK; k.modl = modl; k.tb = tb; k.G = F.G; k.vcu = F.vcu;
                gm::gemm_phase<gm::K5>(F.lds, k);
            }
        }
        SEAM(pb + 7);
        if (IN(pb + 8) && PHON(9)) {
            PHASE_IDS();
            const int b = F.vcu >> 5; const bool lastl = (l == DEPTH - 1);
            const float* md = MOD + ((size_t)(lastl ? l : l + 1) * NB + b) * 6144;
            const float* lg = args.in[I_LN2G] + l * DM; const float* lb = args.in[I_LN2B] + l * DM;
            f32x4 gv[4], bv[4], sh[4], sc[4];
#pragma unroll
            for (int j = 0; j < 4; ++j) { const int cix = 4 * lane + 256 * j; gv[j] = *(const f32x4*)(lg + cix); bv[j] = *(const f32x4*)(lb + cix); sh[j] = *(const f32x4*)(md + cix); sc[j] = *(const f32x4*)(md + 1024 + cix) + 1.0f; }
            float* dst = lastl ? args.out : XR;
            for (int i = 0; i < 16; ++i) { const int row = F.vcu * 128 + wid * 16 + i;
                f32x4 v[4]; float s = 0.f;
#pragma unroll
                for (int j = 0; j < 4; ++j) { v[j] = *(const f32x4*)(XR + (size_t)row * DM + 4 * lane + 256 * j); s += (v[j][0] + v[j][1]) + (v[j][2] + v[j][3]); }
                const float mean = wave_sum(s) * (1.f / DM); float s2 = 0.f;
#pragma unroll
                for (int j = 0; j < 4; ++j) { v[j] = v[j] - mean; s2 += (v[j][0] * v[j][0] + v[j][1] * v[j][1]) + (v[j][2] * v[j][2] + v[j][3] * v[j][3]); }
                const float rstd = 1.f / sqrtf(wave_sum(s2) * (1.f / DM) + LN_EPS);
#pragma unroll
                for (int j = 0; j < 4; ++j) { const f32x4 xn = v[j] * rstd * gv[j] + bv[j]; *(f32x4*)(dst + (size_t)row * DM + 4 * lane + 256 * j) = xn;
                    if (!lastl) { const f32x4 u = xn * sc[j] + sh[j]; u32x2 w; w.x = pk2(u[0], u[1]); w.y = pk2(u[2], u[3]); *(u32x2*)(UB + (size_t)row * DM + 4 * lane + 256 * j) = w; } }
            }
        }
        SEAM(pb + 8);
    }
#undef IN
#undef SEAM
}

extern "C" void kernel_launch(void* const* d_in, const int* in_sizes, int n_in, void* d_out, int out_size, void* d_ws, size_t ws_size, hipStream_t stream) {
    static int grid = 0;
    if (grid == 0) {
        if (n_in != 29 || in_sizes[0] != NTOK * DM || out_size != NTOK * DM || ws_size < WS_END) {
            fprintf(stderr, "kernel_launch: unexpected shapes (n_in %d, in0 %d, out %d, ws %zu need %zu); nothing launched\n", n_in, n_in > 0 ? in_sizes[0] : -1, out_size, ws_size, (size_t)WS_END); grid = -1; return; }
        int dev = 0, cus = 0, per_cu = 0;
        if (hipGetDevice(&dev) != hipSuccess || hipDeviceGetAttribute(&cus, hipDeviceAttributeMultiprocessorCount, dev) != hipSuccess) { grid = -1; return; }
        if (hipFuncSetAttribute((const void*)mega_fwd, hipFuncAttributeMaxDynamicSharedMemorySize, LDS_BYTES) != hipSuccess) { fprintf(stderr, "kernel_launch: hipFuncSetAttribute failed\n"); grid = -1; return; }
        if (hipOccupancyMaxActiveBlocksPerMultiprocessor(&per_cu, (const void*)mega_fwd, 512, LDS_BYTES) != hipSuccess || per_cu < 1) { fprintf(stderr, "kernel_launch: occupancy query reports %d\n", per_cu); }
        (void)hipGetLastError();
        grid = cus;
        if (grid != 256) fprintf(stderr, "kernel_launch: %d CUs (row phases assume 256)\n", grid);
    }
    if (grid < 0) return;
    if (hipMemsetAsync((char*)d_ws + WS_CTL, 0, CTL_ZERO_BYTES, stream) != hipSuccess) return;
    Args a{};
    for (int i = 0; i < 29; ++i) a.in[i] = (const float*)d_in[i];
    a.out = (float*)d_out; a.ws = (unsigned char*)d_ws;
#if MK_ONE_LAUNCH
    a.ph_lo = 0; a.ph_hi = N_PHASES;
    hipLaunchKernelGGL(mega_fwd, dim3(grid), dim3(512), LDS_BYTES, stream, a);
#else
    for (int p = 0; p < N_PHASES; ++p) { a.ph_lo = p; a.ph_hi = p + 1; hipLaunchKernelGGL(mega_fwd, dim3(grid), dim3(512), LDS_BYTES, stream, a); }
#endif
}
```

```cpp
#include <hip/hip_runtime.h>
#include <hip/hip_bf16.h>
#include <cstdio>
#include <cstdint>
#include <cmath>

#ifndef MK_ONE_LAUNCH
#define MK_ONE_LAUNCH 1
#endif
#ifndef PHM
#define PHM 0xFFFF
#endif
#define PHON(n) (((PHM) >> (n)) & 1)

#define LAS __attribute__((address_space(3)))
#define GAS __attribute__((address_space(1)))
typedef unsigned short bf16_t;
typedef short bf16x8 __attribute__((ext_vector_type(8)));
typedef float f32x4 __attribute__((ext_vector_type(4)));
typedef float f32x2 __attribute__((ext_vector_type(2)));
typedef unsigned u32x4 __attribute__((ext_vector_type(4)));
typedef unsigned u32x2 __attribute__((ext_vector_type(2)));
typedef GAS unsigned gu32;

constexpr int NB = 8, SEQ = 4096, NTOK = NB * SEQ, DM = 1024, DEPTH = 4, NH = 4, HD = 64, PIN = 3608, PP = 3840, NE = 16, DE = 512;
constexpr int NCH = SEQ / 64;
constexpr float ALPHA = 1.6817928305074290f;
constexpr float LN_EPS = 1e-6f;
constexpr float ATT_C2 = 0.17677669529663687f * 1.4426950408889634f;
constexpr int NBUCKET = 24, LCAP = NTOK;
constexpr int C_MQ = 0, C_MK = 256, C_MV = 512, C_MO = 768, C_CB = 1024, C_CC = 1280, C_CH = 1536, C_DQ = 1792, C_DK = 2048, C_DV = 2304,
              C_GQ = 2560, C_GK = 2816, C_GV = 3072, C_GR = 3328, C_GA = 3584, C_MI = 3600, C_MF = 3604;

constexpr size_t MiB = 1u << 20;
constexpr size_t WS_CTL = 0, CTL_ZERO_BYTES = 1 * MiB;
constexpr size_t WS_MOD = 1 * MiB;
constexpr size_t WS_ROPE = 2 * MiB;
constexpr size_t WS_WIN = 3 * MiB;
constexpr size_t WS_WOUT = 33 * MiB;
constexpr size_t WS_WGU = 41 * MiB;
constexpr size_t WS_WD = 73 * MiB;
constexpr size_t WS_LTOK = 89 * MiB;
constexpr size_t WS_LGATE = 92 * MiB;
constexpr size_t WS_SM = 98 * MiB;
constexpr size_t WS_PROJ = 100 * MiB;
constexpr size_t WS_XR = 340 * MiB;
constexpr size_t WS_U = 468 * MiB;
constexpr size_t WS_YCAT = 532 * MiB;
constexpr size_t WS_END = 596 * MiB;
constexpr size_t SM_N = 0, SM_BC = 512 * 1024, SM_DM = 520 * 1024, SM_MS = 528 * 1024, SM_GBE = 1 * MiB;
constexpr int CW_TMO = 0, CW_CODE = 1, CW_ZPAGE = 256, CW_BAR = 4096, CW_CNT = 16384;
constexpr int RING_BYTES = 131072, LDSCTL_OFF = RING_BYTES, MISC_OFF = LDSCTL_OFF + 320, MOE_TB_OFF = LDSCTL_OFF + 1024, LDS_BYTES = 147456;

#define RLX_AGENT __ATOMIC_RELAXED, __HIP_MEMORY_SCOPE_AGENT
#define LDS_WAIT() asm volatile("s_waitcnt lgkmcnt(0)" ::: "memory")
#define VM_WAIT() asm volatile("s_waitcnt vmcnt(0)" ::: "memory")

__device__ __forceinline__ unsigned f2bf(float f) { unsigned u = __builtin_bit_cast(unsigned, f); return (u + 0x7fffu + ((u >> 16) & 1u)) >> 16; }
__device__ __forceinline__ unsigned pk2(float lo, float hi) { typedef __bf16 bf2 __attribute__((ext_vector_type(2))); f32x2 v = {lo, hi}; bf2 b = __builtin_convertvector(v, bf2); return __builtin_bit_cast(unsigned, b); }
__device__ __forceinline__ float bf2f(unsigned b) { return __builtin_bit_cast(float, b << 16); }
__device__ __forceinline__ float bflo(unsigned w) { return __builtin_bit_cast(float, w << 16); }
__device__ __forceinline__ float bfhi(unsigned w) { return __builtin_bit_cast(float, w & 0xffff0000u); }
__device__ __forceinline__ float wave_sum(float v) {
#pragma unroll
    for (int o = 1; o < 64; o <<= 1) v += __shfl_xor(v, o);
    return v;
}
__device__ __forceinline__ float wave_max(float v) {
#pragma unroll
    for (int o = 1; o < 64; o <<= 1) v = fmaxf(v, __shfl_xor(v, o));
    return v;
}
__device__ __forceinline__ float logsig(float z) { return fminf(z, 0.f) - __logf(1.f + __expf(-fabsf(z))); }
__device__ __forceinline__ float sigmoidf_(float z) { return 1.f / (1.f + __expf(-z)); }

#define XB_TMO      128
#define XB_XCNT(j)  (256  + 64 * (j))
#define XB_XSUB(j)  (1280 + 64 * (j))
#define XB_XGEN(j)  (2304 + 64 * (j))
#define XB_TOP      3328
#define XB_TOPGEN   3392
#define XCD_BAR_WORDS 3456
#define XB_SPIN_CAP (1u << 18)
__device__ __forceinline__ unsigned xb_ld(unsigned* p)              { return __hip_atomic_load(p, __ATOMIC_RELAXED, __HIP_MEMORY_SCOPE_AGENT); }
__device__ __forceinline__ unsigned xb_add(unsigned* p, unsigned v) { return __hip_atomic_fetch_add(p, v, __ATOMIC_RELAXED, __HIP_MEMORY_SCOPE_AGENT); }
__device__ __forceinline__ unsigned xb_xcc_id() { return (unsigned)__builtin_amdgcn_s_getreg((3 << 11) | 20) & 0xFu; }
#define XB_SPIN(cond, bar) do { unsigned _sp = 0; while (cond) { __builtin_amdgcn_s_sleep(1); \
    if ((++_sp & 255u) == 0u) { if (xb_ld(&(bar)[XB_TMO])) break; if (_sp > XB_SPIN_CAP) { atomicAdd(&(bar)[XB_TMO], 1u); break; } } } } while (0)
struct XcdBarrier { unsigned* bar; unsigned x; volatile LAS unsigned* st; };
__device__ __forceinline__ XcdBarrier xcd_barrier_post(unsigned* bar, volatile LAS unsigned* st) {
    XcdBarrier b; b.bar = bar; b.x = xb_xcc_id(); b.st = st;
    if (threadIdx.x == 0) (void)xb_add(&bar[XB_XCNT(b.x)], 1u);
    return b;
}
__device__ __forceinline__ void xcd_barrier_complete(unsigned* bar, unsigned x, unsigned& nloc, unsigned& nx) {
    const unsigned G = gridDim.x * gridDim.y * gridDim.z;
    unsigned sum, cnt, mine, sp = 0u;
    for (;;) {
        sum = 0u; cnt = 0u; mine = 0u;
#pragma unroll
        for (unsigned j = 0; j < 16; ++j) { const unsigned c = xb_ld(&bar[XB_XCNT(j)]); sum += c; cnt += (c > 0u) ? 1u : 0u; mine = (j == x) ? c : mine; }
        if (sum == G) break;
        __builtin_amdgcn_s_sleep(1);
        if ((++sp & 255u) == 0u) { if (xb_ld(&bar[XB_TMO])) break; if (sp > XB_SPIN_CAP) { atomicAdd(&bar[XB_TMO], 1u); break; } }
    }
    nloc = mine > 0u ? mine : 1u; nx = cnt > 0u ? cnt : 1u;
}
__device__ __forceinline__ void xcd_barrier(const XcdBarrier& b) {
    asm volatile("s_waitcnt vmcnt(0)" ::: "memory");
    __syncthreads();
    if (threadIdx.x == 0) {
        unsigned* bar = b.bar;
        __builtin_amdgcn_s_waitcnt(0);
        unsigned nloc = b.st[0], nx = b.st[1];
        if (nloc == 0u) { xcd_barrier_complete(bar, b.x, nloc, nx); b.st[0] = nloc; b.st[1] = nx; }
        const unsigned old = xb_add(&bar[XB_XSUB(b.x)], 1u);
        const unsigned gen = old / nloc;
        if (old + 1u == (gen + 1u) * nloc) {
            __builtin_amdgcn_fence(__ATOMIC_RELEASE, "agent");
            asm volatile("s_waitcnt vmcnt(0)" ::: "memory");
            const unsigned og = xb_add(&bar[XB_TOP], 1u);
            const unsigned tg = og / nx;
            if (og + 1u == (tg + 1u) * nx) xb_add(&bar[XB_TOPGEN], 1u);
            else XB_SPIN(xb_ld(&bar[XB_TOPGEN]) == tg, bar);
            __builtin_amdgcn_fence(__ATOMIC_ACQUIRE, "agent");
            xb_add(&bar[XB_XGEN(b.x)], 1u);
            asm volatile("s_waitcnt vmcnt(0)" ::: "memory");
        } else {
            XB_SPIN(xb_ld(&bar[XB_XGEN(b.x)]) == gen, bar);
            __builtin_amdgcn_fence(__ATOMIC_ACQUIRE, "agent");
            asm volatile("s_waitcnt vmcnt(0)" ::: "memory");
        }
    }
    __syncthreads();
}

namespace gm {
constexpr int BM = 256, BK = 64, HALF = 128, HTB = HALF * BK * 2, NT = 16, NXCD = 8, WGM = 8;
__host__ __device__ __forceinline__ int lds_byte(int r, int c) { const int st = (r >> 4) * 2 + (c >> 5), rr = r & 15, cc = c & 31, ob = rr * 64 + cc * 2; return st * 1024 + (ob ^ (((ob >> 9) & 1) << 5)); }
__host__ __device__ __forceinline__ void stage_rc(int b, int& R, int& C) { const int st = b / 1024, sb = b % 1024, swz = sb ^ (((sb >> 9) & 1) << 5); R = (st >> 1) * 16 + swz / 64; C = (st & 1) * 32 + (swz % 64) / 2; }
__host__ __device__ __forceinline__ int perm32(int rho) { const int n = rho >> 4, i = rho & 15; return 8 * (i >> 2) + 4 * n + (i & 3); }
struct Unit { int pm, pn, bk, tb; };
struct Src { const char* a; const char* b0; const char* b1; unsigned va[2][2]; };
struct StaticOrder {
    int nM, nN, nwg, G, c;
    __device__ void init(int M, int N, int G_, int c_) { nM = M / BM; nN = N / BM; nwg = nM * nN; G = G_; c = c_; }
    __device__ __forceinline__ bool next(int i, Unit& u) const {
        const long L = (long)i * G + c; if (L >= nwg) return false;
        int wgid = (int)L; { const int q = nwg / NXCD, r = nwg % NXCD, xcd = wgid % NXCD, off = wgid / NXCD; wgid = (xcd < r ? xcd * (q + 1) : r * (q + 1) + (xcd - r) * q) + off; }
        const int nig = WGM * nN, gid = wgid / nig, fm = gid * WGM, gsz = (nM - fm) < WGM ? (nM - fm) : WGM;
        u.pm = fm + ((wgid % nig) % gsz); u.pn = (wgid % nig) / gsz; u.bk = 0; u.tb = 0; return true;
    }
};

template <class Kind>
__device__ __forceinline__ void gemm_phase(LAS unsigned char* lds, const Kind& Kd) {
    int tid_ = threadIdx.x; asm volatile("" : "+v"(tid_));
    const int tid = tid_, wid = __builtin_amdgcn_readfirstlane(tid >> 6), lane = tid & 63, wr = wid >> 2, wc = wid & 3, fr = lane & 15, fq = lane >> 4;
    int R[2], C[2]; unsigned voffB[2];
#pragma unroll
    for (int i = 0; i < 2; ++i) { stage_rc(tid * 16 + i * 8192, R[i], C[i]); const int Rb = Kind::PERM ? ((R[i] & ~31) + perm32(R[i] & 31)) : R[i]; voffB[i] = (unsigned)(Rb * Kind::LDB + C[i]) * 2u; }
    const size_t hstepB = (size_t)HALF * Kind::LDB * 2;
    const unsigned ldsw = (unsigned)wid * 1024u;
    const int aoff = lds_byte(wr * 64 + fr, fq * 8), boff = lds_byte(wc * 32 + fr, fq * 8);
#define G_SA(b, h) (((b) * 2 + (h)) * HTB)
#define G_SB(b, h) ((4 + (b) * 2 + (h)) * HTB)
#define G_STAGE_A(bufoff, S, t, h) do { const char* _g = (S).a + (size_t)(t) * 128; _Pragma("unroll") for (int _i = 0; _i < 2; ++_i) \
        __builtin_amdgcn_global_load_lds((const unsigned*)(_g + (S).va[h][_i]), (LAS unsigned*)(lds + (bufoff) + ldsw + _i * 8192), 16, 0, 0); } while (0)
#define G_STAGE_B(bufoff, S, t, h) do { const char* _g = (((t) < 8) ? (S).b0 + (size_t)(t) * 128 : (S).b1 + (size_t)((t) - 8) * 128) + (h) * hstepB; _Pragma("unroll") for (int _i = 0; _i < 2; ++_i) \
        __builtin_amdgcn_global_load_lds((const unsigned*)(_g + voffB[_i]), (LAS unsigned*)(lds + (bufoff) + ldsw + _i * 8192), 16, 0, 0); } while (0)
#define G_LDA(dst, b, h) do { _Pragma("unroll") for (int m = 0; m < 4; ++m) _Pragma("unroll") for (int k = 0; k < 2; ++k) dst[m][k] = *(const LAS bf16x8*)(lds + G_SA(b, h) + aoff + m * 2048 + k * 1024); } while (0)
#define G_LDB(dst, b, h) do { _Pragma("unroll") for (int n = 0; n < 2; ++n) _Pragma("unroll") for (int k = 0; k < 2; ++k) dst[n][k] = *(const LAS bf16x8*)(lds + G_SB(b, h) + boff + n * 2048 + k * 1024); } while (0)
#define G_MMA(ai, bj, At, Bt) do { __builtin_amdgcn_s_setprio(1); _Pragma("unroll") for (int m = 0; m < 4; ++m) _Pragma("unroll") for (int n = 0; n < 2; ++n) _Pragma("unroll") for (int k = 0; k < 2; ++k) \
        acc[ai][bj][m][n] = __builtin_amdgcn_mfma_f32_16x16x32_bf16(Bt[n][k], At[m][k], acc[ai][bj][m][n], 0, 0, 0); __builtin_amdgcn_s_setprio(0); } while (0)
#define G_WAIT_V(n) asm volatile("s_waitcnt vmcnt(" #n ")" ::: "memory")
#define G_WAIT_L(n) asm volatile("s_waitcnt lgkmcnt(" #n ")" ::: "memory")
#define G_BAR __builtin_amdgcn_s_barrier()
#define G_SCHED __builtin_amdgcn_sched_barrier(0)
    Unit cur, nxt; Src sc, sn; int ui = 0;
    if (!Kd.next(0, cur)) return;
    Kd.src(cur, sc, R, C);
    f32x4 acc[2][2][4][2];
#pragma unroll
    for (int a = 0; a < 2; ++a)
#pragma unroll
        for (int b = 0; b < 2; ++b)
#pragma unroll
            for (int m = 0; m < 4; ++m)
#pragma unroll
                for (int n = 0; n < 2; ++n) acc[a][b][m][n] = (f32x4){0.f, 0.f, 0.f, 0.f};
    bf16x8 At[4][2], B0[2][2], B1[2][2];
    G_STAGE_B(G_SB(0, 0), sc, 0, 0); G_STAGE_B(G_SB(0, 1), sc, 0, 1); G_STAGE_A(G_SA(0, 0), sc, 0, 0); G_STAGE_A(G_SA(0, 1), sc, 0, 1);
    if (wr == 1) G_BAR;
    G_WAIT_V(2); G_BAR;
    G_STAGE_B(G_SB(1, 0), sc, 1, 0); G_STAGE_A(G_SA(1, 0), sc, 1, 0); G_STAGE_B(G_SB(1, 1), sc, 1, 1);
    G_WAIT_V(6); G_BAR;
    for (;;) {
        const bool has_next = Kd.next(ui + 1, nxt);
        if (has_next) Kd.src(nxt, sn, R, C); else sn = sc;
        for (int t = 0; t < NT; t += 2) {
            const bool last = (t == NT - 2);
            Src s2; s2.a = last ? sn.a : sc.a; s2.b0 = last ? sn.b0 : sc.b0; s2.b1 = last ? sn.b1 : sc.b1;
            s2.va[0][0] = last ? sn.va[0][0] : sc.va[0][0]; s2.va[0][1] = last ? sn.va[0][1] : sc.va[0][1]; s2.va[1][0] = last ? sn.va[1][0] : sc.va[1][0]; s2.va[1][1] = last ? sn.va[1][1] : sc.va[1][1];
            const int t2 = last ? 0 : t + 2, t3 = t2 + 1;
            G_LDB(B0, 0, 0); G_LDB(B1, 0, 1); G_SCHED; G_LDA(At, 0, 0); G_STAGE_A(G_SA(1, 1), sc, t + 1, 1);
            G_WAIT_V(8); G_WAIT_L(0); G_BAR; G_MMA(0, 0, At, B0); G_MMA(0, 1, At, B1); G_BAR; G_SCHED;
            G_LDA(At, 0, 1); G_STAGE_B(G_SB(0, 0), s2, t2, 0); G_STAGE_B(G_SB(0, 1), s2, t2, 1); G_STAGE_A(G_SA(0, 0), s2, t2, 0);
            G_WAIT_V(8); G_WAIT_L(0); G_BAR; G_MMA(1, 0, At, B0); G_MMA(1, 1, At, B1); G_BAR; G_SCHED;
            G_LDB(B0, 1, 0); G_LDB(B1, 1, 1); G_SCHED; G_LDA(At, 1, 0); G_STAGE_A(G_SA(0, 1), s2, t2, 1);
            G_WAIT_V(8); G_WAIT_L(0); G_BAR; G_MMA(0, 0, At, B0); G_MMA(0, 1, At, B1); G_BAR; G_SCHED;
            G_LDA(At, 1, 1); G_STAGE_B(G_SB(1, 0), s2, t3, 0); G_STAGE_B(G_SB(1, 1), s2, t3, 1); G_STAGE_A(G_SA(1, 0), s2, t3, 0);
            G_WAIT_V(8); G_WAIT_L(0); G_BAR; G_MMA(1, 0, At, B0); G_MMA(1, 1, At, B1); G_BAR; G_SCHED;
        }
        if (wr == 0) G_BAR;
        Kd.epi(acc, cur, wr, wc, fr, fq);
        if (!has_next) break;
#pragma unroll
        for (int a = 0; a < 2; ++a)
#pragma unroll
            for (int b = 0; b < 2; ++b)
#pragma unroll
                for (int m = 0; m < 4; ++m)
#pragma unroll
                    for (int n = 0; n < 2; ++n) acc[a][b][m][n] = (f32x4){0.f, 0.f, 0.f, 0.f};
        cur = nxt; sc = sn; ++ui;
        if (wr == 1) G_BAR;
    }
    G_WAIT_V(0);
    G_BAR;
#undef G_SA
#undef G_SB
#undef G_STAGE_A
#undef G_STAGE_B
#undef G_LDA
#undef G_LDB
#undef G_MMA
#undef G_WAIT_V
#undef G_WAIT_L
#undef G_BAR
#undef G_SCHED
}

__device__ __forceinline__ void src_direct(Src& s, const bf16_t* A, int row0, const int (&R)[2], const int (&C)[2]) {
    s.a = (const char*)(A + (size_t)row0 * 1024);
#pragma unroll
    for (int h = 0; h < 2; ++h)
#pragma unroll
        for (int i = 0; i < 2; ++i) s.va[h][i] = (unsigned)((h * HALF + R[i]) * 1024 + C[i]) * 2u;
}

struct K1 {
    static constexpr bool PERM = true; static constexpr int LDB = 1024;
    StaticOrder S; const bf16_t* A; const bf16_t* Bt; bf16_t* O; const float* rope;
    __device__ __forceinline__ bool next(int i, Unit& u) const { return S.next(i, u); }
    __device__ __forceinline__ void src(const Unit& u, Src& s, const int (&R)[2], const int (&C)[2]) const {
        src_direct(s, A, u.pm * BM, R, C); s.b0 = (const char*)(Bt + (size_t)u.pn * BM * 1024); s.b1 = s.b0 + 1024;
    }
    __device__ __forceinline__ void epi(const f32x4 (&acc)[2][2][4][2], const Unit& u, int wr, int wc, int fr, int fq) const {
        const int row0 = u.pm * BM + wr * 64 + fr, col0 = u.pn * BM + wc * 32 + 8 * fq;
        const int ty = (u.pn == 0 || u.pn == 10) ? 1 : (u.pn == 7) ? 2 : (u.pn == 8) ? 3 : 0;
#pragma unroll
        for (int ai = 0; ai < 2; ++ai)
#pragma unroll
            for (int m = 0; m < 4; ++m) {
                const int row = row0 + ai * HALF + m * 16;
                f32x4 cs = (f32x4){1.f, 1.f, 1.f, 1.f}, sn = (f32x4){0.f, 0.f, 0.f, 0.f};
                if (ty >= 2) { cs = *(const f32x4*)(rope + (size_t)row * 8); sn = *(const f32x4*)(rope + (size_t)row * 8 + 4); }
                bf16_t* rowp = O + (size_t)row * PP + col0;
#pragma unroll
                for (int bj = 0; bj < 2; ++bj) {
                    f32x4 v0 = acc[ai][bj][m][0], v1 = acc[ai][bj][m][1];
                    if (ty == 1) { v0 = v0 * 0.125f; v1 = v1 * 0.125f; }
                    if (ty >= 2) {
                        if (fq == 0) { const f32x4 x1 = v0, x2 = v1; v0 = x1 * cs - x2 * sn; v1 = x2 * cs + x1 * sn; }
                        if (ty == 2) { v0 = v0 * ATT_C2; v1 = v1 * ATT_C2; }
                    }
                    u32x4 w; w.x = pk2(v0[0], v0[1]); w.y = pk2(v0[2], v0[3]); w.z = pk2(v1[0], v1[1]); w.w = pk2(v1[2], v1[3]);
                    *(u32x4*)(rowp + bj * HALF) = w;
                }
            }
    }
};
struct K2 {
    static constexpr bool PERM = false; static constexpr int LDB = 1024;
    StaticOrder S; const bf16_t* A; const bf16_t* Bt; const float* xin; float* xout; const float* modl;
    __device__ __forceinline__ bool next(int i, Unit& u) const { return S.next(i, u); }
    __device__ __forceinline__ void src(const Unit& u, Src& s, const int (&R)[2], const int (&C)[2]) const {
        src_direct(s, A, u.pm * BM, R, C); s.b0 = (const char*)(Bt + (size_t)u.pn * BM * 1024); s.b1 = s.b0 + 1024;
    }
    __device__ __forceinline__ void epi(const f32x4 (&acc)[2][2][4][2], const Unit& u, int wr, int wc, int fr, int fq) const {
        const int row0 = u.pm * BM + wr * 64 + fr, col0 = u.pn * BM + wc * 32 + 4 * fq;
        const float* g1 = modl + (size_t)(u.pm >> 4) * 6144 + 2 * 1024;
        f32x4 gv[2][2];
#pragma unroll
        for (int bj = 0; bj < 2; ++bj)
#pragma unroll
            for (int n = 0; n < 2; ++n) gv[bj][n] = *(const f32x4*)(g1 + col0 + bj * HALF + n * 16) + 1.0f;
#pragma unroll
        for (int ai = 0; ai < 2; ++ai)
#pragma unroll
            for (int m = 0; m < 4; ++m) {
                const size_t off = (size_t)(row0 + ai * HALF + m * 16) * DM + col0;
#pragma unroll
                for (int bj = 0; bj < 2; ++bj)
#pragma unroll
                    for (int n = 0; n < 2; ++n) {
                        const f32x4 xv = *(const f32x4*)(xin + off + bj * HALF + n * 16);
                        *(f32x4*)(xout + off + bj * HALF + n * 16) = xv * ALPHA + gv[bj][n] * acc[ai][bj][m][n];
                    }
            }
    }
};
__device__ __forceinline__ int pair_i(int p) { return p < 3 ? 0 : (p < 5 ? 1 : 2); }
__device__ __forceinline__ int pair_j(int p) { return p < 3 ? p + 1 : (p < 5 ? p - 1 : 3); }
struct K4 {
    static constexpr bool PERM = true; static constexpr int LDB = 1024;
    const bf16_t* U; const bf16_t* Wgu; bf16_t* H; const int* ltok; const float* lgate; const LAS int* tb; int G, vcu;
    __device__ __forceinline__ bool next(int i, Unit& u) const {
        const int L = i * G + vcu; const int nt = tb[32 + NBUCKET]; if (L >= nt * 8) return false;
        const int rt = L >> 3; int k = 0;
        for (int q = 1; q < NBUCKET; ++q) k = (tb[32 + q] <= rt) ? q : k;
        u.pm = rt; u.pn = L & 7; u.bk = k; u.tb = rt - tb[32 + k]; return true;
    }
    __device__ __forceinline__ void src(const Unit& u, Src& s, const int (&R)[2], const int (&C)[2]) const {
        const int cnt = tb[u.bk]; s.a = (const char*)U;
#pragma unroll
        for (int h = 0; h < 2; ++h)
#pragma unroll
            for (int i = 0; i < 2; ++i) { const int pos = u.tb * BM + h * HALF + R[i]; const int tok = ltok[(size_t)u.bk * LCAP + (pos < cnt ? pos : 0)]; s.va[h][i] = (unsigned)(tok * 1024 + C[i]) * 2u; }
        const int grp = u.bk / 6, p = u.bk % 6, sl = u.pn >> 2; const int e = grp * 4 + (sl ? pair_j(p) : pair_i(p));
        s.b0 = (const char*)(Wgu + ((size_t)e * 1024 + (size_t)(u.pn & 3) * BM) * 1024); s.b1 = s.b0 + 1024;
    }
    __device__ __forceinline__ void epi(const f32x4 (&acc)[2][2][4][2], const Unit& u, int wr, int wc, int fr, int fq) const {
        const int cnt = tb[u.bk], sl = u.pn >> 2; const int colo = sl * 512 + (u.pn & 3) * 128 + wc * 32 + 8 * fq;
#pragma unroll
        for (int ai = 0; ai < 2; ++ai)
#pragma unroll
            for (int m = 0; m < 4; ++m) {
                const int r = ai * HALF + wr * 64 + m * 16 + fr, pos = u.tb * BM + r;
                const float gt = (pos < cnt) ? lgate[((size_t)u.bk * LCAP + pos) * 2 + sl] : 0.f;
                float hv[8];
#pragma unroll
                for (int n = 0; n < 2; ++n)
#pragma unroll
                    for (int j = 0; j < 4; ++j) { const float g = acc[ai][0][m][n][j], up = acc[ai][1][m][n][j]; hv[n * 4 + j] = g * __builtin_amdgcn_rcpf(1.f + __expf(-g)) * up * gt; }
                u32x4 w; w.x = pk2(hv[0], hv[1]); w.y = pk2(hv[2], hv[3]); w.z = pk2(hv[4], hv[5]); w.w = pk2(hv[6], hv[7]);
                *(u32x4*)(H + (size_t)(u.pm * BM + r) * 1024 + colo) = w;
            }
    }
};
struct K5 {
    static constexpr bool PERM = false; static constexpr int LDB = 512;
    const bf16_t* H; const bf16_t* Wd; float* XR; const int* ltok; const float* modl; const LAS int* tb; int G, vcu;
    __device__ __forceinline__ bool next(int i, Unit& u) const {
        const int L = i * G + vcu; const int nt = tb[32 + NBUCKET]; if (L >= nt * 4) return false;
        const int rt = L >> 2; int k = 0;
        for (int q = 1; q < NBUCKET; ++q) k = (tb[32 + q] <= rt) ? q : k;
        u.pm = rt; u.pn = L & 3; u.bk = k; u.tb = rt - tb[32 + k]; return true;
    }
    __device__ __forceinline__ void src(const Unit& u, Src& s, const int (&R)[2], const int (&C)[2]) const {
        src_direct(s, H, u.pm * BM, R, C);
        const int grp = u.bk / 6, p = u.bk % 6;
        s.b0 = (const char*)(Wd + ((size_t)(grp * 4 + pair_i(p)) * 1024 + (size_t)u.pn * BM) * 512);
        s.b1 = (const char*)(Wd + ((size_t)(grp * 4 + pair_j(p)) * 1024 + (size_t)u.pn * BM) * 512);
    }
    __device__ __forceinline__ void epi(const f32x4 (&acc)[2][2][4][2], const Unit& u, int wr, int wc, int fr, int fq) const {
        const int cnt = tb[u.bk], col0 = u.pn * BM + wc * 32 + 4 * fq;
#pragma unroll
        for (int ai = 0; ai < 2; ++ai)
#pragma unroll
            for (int m = 0; m < 4; ++m) {
                const int pos = u.tb * BM + ai * HALF + wr * 64 + m * 16 + fr;
                if (pos < cnt) {
                    const int tok = ltok[(size_t)u.bk * LCAP + pos];
                    const float* g2 = modl + (size_t)(tok >> 12) * 6144 + 5 * 1024 + col0;
                    float* xr = XR + (size_t)tok * DM + col0;
#pragma unroll
                    for (int bj = 0; bj < 2; ++bj)
#pragma unroll
                        for (int n = 0; n < 2; ++n) {
                            const f32x4 gv = *(const f32x4*)(g2 + bj * HALF + n * 16) + 1.0f;
                            const f32x4 xv = *(const f32x4*)(xr + bj * HALF + n * 16);
                            *(f32x4*)(xr + bj * HALF + n * 16) = xv * ALPHA + gv * acc[ai][bj][m][n];
                        }
                }
                if (m & 1) asm volatile("" ::: "memory");
            }
    }
};
}

namespace attn_body {
using bf16 = __hip_bfloat16;
using s16x4 = __attribute__((ext_vector_type(4))) short;
using f32x16 = __attribute__((ext_vector_type(16))) float;
constexpr int D = 64, PITCH = PP;
constexpr int NW = 8, QBLK = 32, QB = QBLK * NW, KVBLK = 64;
__device__ __forceinline__ int crow(int r, int hi) { return (r & 3) + 8 * (r >> 2) + 4 * hi; }
#define SBAR() __builtin_amdgcn_sched_barrier(0)
__device__ __forceinline__ void cmask(f32x16& p0, f32x16& p1, int jb, int qrel, int hi) {
    const float NEG = -INFINITY; int kb = 64 * jb + 4 * hi;
#pragma unroll
    for (int r = 0; r < 16; ++r) { int kv = kb + (r & 3) + 8 * (r >> 2); if (kv > qrel) p0[r] = NEG; if (kv + 32 > qrel) p1[r] = NEG; }
}
constexpr int NSLOT = 3, SLOTB = 8192;
constexpr int LDS_K = 0, LDS_V = NSLOT * SLOTB, LDS_WS = 2 * NSLOT * SLOTB, LDS_OST = LDS_WS + NW * 64 * 4, ATT_LDS_BYTES = LDS_OST + NW * 8192;
__device__ __forceinline__ void glds16(const void* gsrc, unsigned lds_dst) { unsigned keep;
    asm volatile("s_mov_b32 %0, m0\n\ts_mov_b32 m0, %2\n\ts_nop 0\n\tglobal_load_lds_dwordx4 %1, off\n\ts_mov_b32 m0, %0" : "=&s"(keep) : "v"(gsrc), "s"(lds_dst) : "memory"); }
__device__ __forceinline__ float max3f(float a, float b, float c) { float r; asm("v_max3_f32 %0, %1, %2, %3" : "=v"(r) : "v"(a), "v"(b), "v"(c)); return r; }
__device__ __forceinline__ float max2f(float a, float b) { float r; asm("v_max_f32_e32 %0, %1, %2" : "=v"(r) : "v"(a), "v"(b)); return r; }
__device__ __forceinline__ float fadd_s(float a, float b) { float r; asm("v_add_f32_e32 %0, %1, %2" : "=v"(r) : "v"(a), "v"(b)); return r; }
__device__ __forceinline__ float fsub_s(float a, float b) { float r; asm("v_sub_f32_e32 %0, %1, %2" : "=v"(r) : "v"(a), "v"(b)); return r; }
typedef float f32x2_t __attribute__((ext_vector_type(2))); typedef __bf16 bf16x2_t __attribute__((ext_vector_type(2)));
__device__ __forceinline__ unsigned cvtpk_s(float lo, float hi) { f32x2_t v = {lo, hi}; bf16x2_t b = __builtin_convertvector(v, bf16x2_t); return __builtin_bit_cast(unsigned, b); }
#define WAIT_BAR(N) asm volatile("s_waitcnt vmcnt(" #N ") lgkmcnt(0)\n\ts_barrier" ::: "memory")
__device__ __forceinline__ void qkt(f32x16& p0, f32x16& p1, const char* Kslot, const bf16x8* qr, const f32x16& negm, int r32, int hi) {
    const char* kb = Kslot + hi * 1024 + r32 * 16;
#pragma unroll
    for (int d0 = 0; d0 < 2; ++d0) {
        const bf16x8 b0 = *reinterpret_cast<const bf16x8*>(kb + d0 * 2048);
        const bf16x8 b1 = *reinterpret_cast<const bf16x8*>(kb + d0 * 2048 + 512);
        if (d0 == 0) { p0 = __builtin_amdgcn_mfma_f32_32x32x16_bf16(b0, qr[0], negm, 0, 0, 0); p1 = __builtin_amdgcn_mfma_f32_32x32x16_bf16(b1, qr[0], negm, 0, 0, 0); }
        else { p0 = __builtin_amdgcn_mfma_f32_32x32x16_bf16(b0, qr[d0], p0, 0, 0, 0); p1 = __builtin_amdgcn_mfma_f32_32x32x16_bf16(b1, qr[d0], p1, 0, 0, 0); } }
}
typedef __attribute__((address_space(3))) const char* lds_cptr;
typedef short v4i16_t __attribute__((ext_vector_type(4)));
__device__ __forceinline__ void kload8(bf16x8* kf, lds_cptr kp) {
    kf[0] = *(const __attribute__((address_space(3))) bf16x8*)(kp);        kf[1] = *(const __attribute__((address_space(3))) bf16x8*)(kp + 512);
    kf[2] = *(const __attribute__((address_space(3))) bf16x8*)(kp + 2048); kf[3] = *(const __attribute__((address_space(3))) bf16x8*)(kp + 2560);
}
__device__ __forceinline__ void kload2(bf16x8* kf, lds_cptr kp, int j) { kf[2 * j] = *(const __attribute__((address_space(3))) bf16x8*)(kp + j * 2048); kf[2 * j + 1] = *(const __attribute__((address_space(3))) bf16x8*)(kp + j * 2048 + 512); }
__device__ __forceinline__ s16x4 vtr(lds_cptr p) { return __builtin_bit_cast(s16x4, __builtin_amdgcn_ds_read_tr16_b64_v4i16((__attribute__((address_space(3))) v4i16_t*)p)); }
__device__ __forceinline__ float rowmax(const f32x16& p0, const f32x16& p1) {
    float a = max3f(p0[0], p0[1], p1[0]), b = max3f(p0[2], p0[3], p1[1]); a = max3f(a, p1[2], p1[3]);
#pragma unroll
    for (int r = 4; r < 16; r += 4) { a = max3f(a, p0[r], p0[r + 1]); b = max3f(b, p0[r + 2], p0[r + 3]); a = max3f(a, p1[r], p1[r + 1]); b = max3f(b, p1[r + 2], p1[r + 3]); }
    const float m = max2f(a, b);
    auto rr = __builtin_amdgcn_permlane32_swap(__float_as_uint(m), __float_as_uint(m), false, false);
    return max2f(__uint_as_float(rr[0]), __uint_as_float(rr[1]));
}
__device__ __forceinline__ void pv(f32x16* o, int vb, bf16x8 pa0, bf16x8 pa1, bf16x8 pa2, bf16x8 pa3) {
#pragma unroll
    for (int d0 = 0; d0 < 2; ++d0) { s16x4 lo[4], hi[4];
#pragma unroll
        for (int ks = 0; ks < 4; ++ks) {
            asm volatile("ds_read_b64_tr_b16 %0,%1 offset:%c2" : "=&v"(lo[ks]) : "v"(vb), "i"(d0 * 4096 + ks * 1024) : "memory");
            asm volatile("ds_read_b64_tr_b16 %0,%1 offset:%c2" : "=&v"(hi[ks]) : "v"(vb), "i"(d0 * 4096 + ks * 1024 + 512) : "memory"); }
        asm volatile("s_waitcnt lgkmcnt(0)" ::: "memory"); SBAR();
#define PK(k) (bf16x8){lo[k][0], lo[k][1], lo[k][2], lo[k][3], hi[k][0], hi[k][1], hi[k][2], hi[k][3]}
        o[d0] = __builtin_amdgcn_mfma_f32_32x32x16_bf16(pa0, PK(0), o[d0], 0, 0, 0);
        o[d0] = __builtin_amdgcn_mfma_f32_32x32x16_bf16(pa1, PK(1), o[d0], 0, 0, 0);
        o[d0] = __builtin_amdgcn_mfma_f32_32x32x16_bf16(pa2, PK(2), o[d0], 0, 0, 0);
        o[d0] = __builtin_amdgcn_mfma_f32_32x32x16_bf16(pa3, PK(3), o[d0], 0, 0, 0);
#undef PK
    }
}
struct AttnParams { const bf16* Q; const bf16* K; const bf16* V; const bf16* zpage; bf16_t* Y; const float* gnorm; float lam, osc; };
template <int THRL, int comp> __device__ __forceinline__ void attn_unit(int b, int h, int qb, const AttnParams& P, char* shm) {
    const bf16* Q = P.Q; const bf16* __restrict__ K = P.K; const bf16* __restrict__ V = P.V;
    int tid_ = threadIdx.x; asm volatile("" : "+v"(tid_));
    const int tid = tid_, lane = tid & 63, r32 = lane & 31, hi = lane >> 5; const int wid = __builtin_amdgcn_readfirstlane(tid >> 6);
    const long rowbase = (long)b * SEQ; const int q0 = qb * QB;
    const bf16* Qw = Q + (rowbase + q0 + wid * QBLK) * PITCH + h * D;
    const bf16* Kh = K + rowbase * PITCH + h * D, *Vh = V + rowbase * PITCH + h * D;
    const unsigned lds0 = (unsigned)(uintptr_t)shm;
    float* wsf = (float*)(shm + LDS_WS) + wid * 64;
    const bf16* ksrc = Kh + (long)(32 * (wid & 1) + (lane & 31)) * PITCH + comp * 32 + (wid >> 1) * 8;
    const bf16* vsrc = Vh + (long)(16 * (wid & 3) + (lane >> 2)) * PITCH + (wid >> 2) * 32 + (lane & 3) * 8;
    const unsigned kdst = lds0 + LDS_K + (wid >> 1) * 1024 + (wid & 1) * 512, vdst = lds0 + LDS_V + wid * 1024;
#define DMA_K(t, slot) do { if (lane < 32) glds16(ksrc + (long)(t) * KVBLK * PITCH, (unsigned)__builtin_amdgcn_readfirstlane(kdst + (slot))); } while (0)
#define DMA_V(t, slot) glds16(vsrc + (long)(t) * KVBLK * PITCH, (unsigned)__builtin_amdgcn_readfirstlane(vdst + (slot)))
    const int vb0 = (int)(lds0 + LDS_V) + ((lane >> 4) & 1) * 32 + (lane & 3) * 8 + (4 * hi + ((lane & 15) >> 2)) * 64;
    const char* Kbase = shm + LDS_K; bf16x8 kf[4];
    const lds_cptr shm3 = (lds_cptr)shm; const lds_cptr kp0 = shm3 + LDS_K + hi * 1024 + r32 * 16; const lds_cptr vp0 = shm3 + LDS_V + ((lane >> 4) & 1) * 32 + (lane & 3) * 8 + (4 * hi + ((lane & 15) >> 2)) * 64;
    const int NT = (q0 + QB) / KVBLK;
    DMA_K(0, 0); DMA_V(0, 0); DMA_K(1, SLOTB);
    bf16x8 qr[2];
#pragma unroll
    for (int d0 = 0; d0 < 2; ++d0) qr[d0] = *reinterpret_cast<const bf16x8*>(&Qw[(long)r32 * PITCH + comp * 32 + d0 * 16 + hi * 8]);
    float mhat = 0.f, l_reg = 0.f; f32x16 o[2]; o[0] = f32x16{}; o[1] = f32x16{}; f32x16 negm = f32x16{}; asm volatile("" : "+v"(negm));
    const int qrel = wid * QBLK + r32;
#define CMASK(P0, P1, t) do { int jb_ = (t) - (NT - 4); if (jb_ >= 0) cmask(P0, P1, jb_, qrel, hi); } while (0)
    bool resc = false;
#define START(P0, P1) do { const float rm = rowmax(P0, P1); resc = false; \
    { const float dl = rm; mhat = fadd_s(mhat, dl); \
      _Pragma("unroll") for (int r = 0; r < 16; ++r) { P0[r] = fsub_s(P0[r], dl); P1[r] = fsub_s(P1[r], dl); } \
      _Pragma("unroll") for (int r = 0; r < 16; ++r) negm[r] = -mhat; asm volatile("" : "+v"(negm)); } \
    _Pragma("unroll") for (int r = 0; r < 16; ++r) P0[r] = __builtin_amdgcn_exp2f(P0[r]); } while (0)
#define RESC() do { if (resc) { asm volatile("s_waitcnt lgkmcnt(0)" ::: "memory"); \
      _Pragma("unroll") for (int d_ = 0; d_ < 2; ++d_) _Pragma("unroll") for (int r = 0; r < 16; ++r) o[d_][r] *= wsf[crow(r, hi)]; } } while (0)
    f32x16 pA0, pA1, pB0, pB1;
    int sl_prev = 0, sl_cur = 0, sl_next = SLOTB;
#define ROT() do { sl_prev = sl_cur; sl_cur = sl_next; sl_next = (sl_next == (NSLOT - 1) * SLOTB) ? 0 : sl_next + SLOTB; } while (0)
    DMA_K(2, 2 * SLOTB);
    WAIT_BAR(3);
    qkt(pA0, pA1, Kbase, qr, negm, r32, hi); asm volatile("s_nop 15\n\ts_nop 7" : "+v"(pA0), "+v"(pA1)); CMASK(pA0, pA1, 0);
    START(pA0, pA1);
    _Pragma("unroll") for (int r = 0; r < 16; ++r) pA1[r] = __builtin_amdgcn_exp2f(pA1[r]);
    WAIT_BAR(0);
    DMA_K(3, 0); DMA_V(1, SLOTB);
    ROT();
    kload8(kf, kp0 + sl_cur);
    WAIT_BAR(2);
    s16x4 vlo[8], vhi[8]; u32x4 pw0, pw1, pw2, pw3;
#define PKW(P, B) cvtpk_s(P[B], P[B + 1])
#define PAF(k) __builtin_bit_cast(bf16x8, pw##k)
#define VFR(i) (bf16x8){vlo[i][0], vlo[i][1], vlo[i][2], vlo[i][3], vhi[i][0], vhi[i][1], vhi[i][2], vhi[i][3]}
#define PIN(x) asm volatile("" : "+v"(x))
#define MX3(a, b, c) __builtin_fmaxf(__builtin_fmaxf((a), (b)), (c))
#define GAPA(MF, A0, A1, A2, A3, W0, W1, PW) do { MF; sacc += A0; sacc += A1; sacc += A2; sacc += A3; PIN(sacc); W0; W1; PIN(PW); SBAR(); } while (0)
#define EX(v) __builtin_amdgcn_exp2f(v)
#define GAPB(MF, X, B) do { MF; X[B] = EX(X[B]); X[B + 1] = EX(X[B + 1]); X[B + 2] = EX(X[B + 2]); X[B + 3] = EX(X[B + 3]); PIN(X); SBAR(); } while (0)
#define VRD(i) do { vlo[i] = vtr(vp_ + (((i) >> 2) * 4096 + ((i) & 3) * 1024)); vhi[i] = vtr(vp_ + (((i) >> 2) * 4096 + ((i) & 3) * 1024 + 512)); } while (0)
#define KRD(G, j) do { if (G) { kload2(kf, kp0 + sl_next, j); SBAR(); } } while (0)
#define STEP(C0, C1, P0, P1, t, GK, GV, GL) do { SBAR(); \
    const lds_cptr vp_ = vp0 + sl_prev; \
    VRD(0); SBAR(); float sacc = (P0[0] + P0[1]); \
    GAPA(C0 = __builtin_amdgcn_mfma_f32_32x32x16_bf16(kf[0], qr[0], negm, 0, 0, 0), P0[2], P0[3], P0[4], P0[5],     pw0[0] = PKW(P0, 0), pw0[1] = PKW(P0, 2), pw0); \
    VRD(4); SBAR(); GAPA(C1 = __builtin_amdgcn_mfma_f32_32x32x16_bf16(kf[1], qr[0], negm, 0, 0, 0), P0[6], P0[7], P0[8], P0[9],     pw0[2] = PKW(P0, 4), pw0[3] = PKW(P0, 6), pw0); \
    VRD(1); SBAR(); GAPA(C0 = __builtin_amdgcn_mfma_f32_32x32x16_bf16(kf[2], qr[1], C0, 0, 0, 0),   P0[10], P0[11], P0[12], P0[13], pw1[0] = PKW(P0, 8), pw1[1] = PKW(P0, 10), pw1); \
    VRD(5); SBAR(); GAPA(C1 = __builtin_amdgcn_mfma_f32_32x32x16_bf16(kf[3], qr[1], C1, 0, 0, 0),   P0[14], P0[15], P1[0], P1[1],   pw1[2] = PKW(P0, 12), pw1[3] = PKW(P0, 14), pw1); \
    VRD(2); SBAR(); GAPA(,   P1[2], P1[3], P1[4], P1[5],     pw2[0] = PKW(P1, 0), pw2[1] = PKW(P1, 2), pw2); \
    VRD(6); SBAR(); GAPA(,   P1[6], P1[7], P1[8], P1[9],     pw2[2] = PKW(P1, 4), pw2[3] = PKW(P1, 6), pw2); \
    VRD(3); SBAR(); GAPA(,   P1[10], P1[11], P1[12], P1[13], pw3[0] = PKW(P1, 8), pw3[1] = PKW(P1, 10), pw3); \
    VRD(7); SBAR(); GAPA(,   P1[14], P1[15], 0.f, 0.f,       pw3[2] = PKW(P1, 12), pw3[3] = PKW(P1, 14), pw3); \
    l_reg += sacc; \
    if (GK) { DMA_K((t) + 3, sl_cur); } if (GV) { DMA_V((t) + 1, sl_next); } \
    CMASK(C0, C1, t); \
    { float a = MX3(C0[0], C0[1], C1[0]), b = MX3(C0[2], C0[3], C1[1]); a = MX3(a, C1[2], C1[3]); \
      _Pragma("unroll") for (int r = 4; r < 16; r += 4) { a = MX3(a, C0[r], C0[r + 1]); b = MX3(b, C0[r + 2], C0[r + 3]); a = MX3(a, C1[r], C1[r + 1]); b = MX3(b, C1[r + 2], C1[r + 3]); } \
      float rm = __builtin_fmaxf(a, b); { auto rr = __builtin_amdgcn_permlane32_swap(__float_as_uint(rm), __float_as_uint(rm), false, false); rm = __builtin_fmaxf(__uint_as_float(rr[0]), __uint_as_float(rr[1])); } \
      resc = false; \
      if (__builtin_expect(__any(rm > (float)THRL), 0)) { const float dl = __builtin_fmaxf(rm, 0.f); mhat += dl; \
        _Pragma("unroll") for (int r = 0; r < 16; ++r) { C0[r] -= dl; C1[r] -= dl; } \
        _Pragma("unroll") for (int r = 0; r < 16; ++r) negm[r] = -mhat; asm volatile("" : "+v"(negm)); \
        const float f = __builtin_amdgcn_exp2f(-dl); l_reg *= f; if (hi == 0) wsf[r32] = f; resc = true; } } \
    SBAR(); \
    GAPB(o[0] = __builtin_amdgcn_mfma_f32_32x32x16_bf16(PAF(0), VFR(0), o[0], 0, 0, 0), C0, 0); \
    GAPB(o[1] = __builtin_amdgcn_mfma_f32_32x32x16_bf16(PAF(0), VFR(4), o[1], 0, 0, 0), C0, 4); \
    KRD(GL, 0); GAPB(o[0] = __builtin_amdgcn_mfma_f32_32x32x16_bf16(PAF(1), VFR(1), o[0], 0, 0, 0), C0, 8); \
    KRD(GL, 1); GAPB(o[1] = __builtin_amdgcn_mfma_f32_32x32x16_bf16(PAF(1), VFR(5), o[1], 0, 0, 0), C0, 12); \
    GAPB(o[0] = __builtin_amdgcn_mfma_f32_32x32x16_bf16(PAF(2), VFR(2), o[0], 0, 0, 0), C1, 0); \
    GAPB(o[1] = __builtin_amdgcn_mfma_f32_32x32x16_bf16(PAF(2), VFR(6), o[1], 0, 0, 0), C1, 4); \
    GAPB(o[0] = __builtin_amdgcn_mfma_f32_32x32x16_bf16(PAF(3), VFR(3), o[0], 0, 0, 0), C1, 8); \
    GAPB(o[1] = __builtin_amdgcn_mfma_f32_32x32x16_bf16(PAF(3), VFR(7), o[1], 0, 0, 0), C1, 12); \
    } while (0)
    int t = 1;
#undef CMASK
#define CMASK(P0, P1, t) do {} while (0)
    for (; t + 5 < NT; t += 2) {
        STEP(pB0, pB1, pA0, pA1, t, true, true, true);     WAIT_BAR(2); RESC(); ROT();
        STEP(pA0, pA1, pB0, pB1, t + 1, true, true, true); WAIT_BAR(2); RESC(); ROT();
    }
#undef CMASK
#define CMASK(P0, P1, t) do { int jb_ = (t) - (NT - 4); if (jb_ >= 0) cmask(P0, P1, jb_, qrel, hi); } while (0)
#define ENDW(tt) do { if ((tt) + 3 < NT) { WAIT_BAR(2); } else if ((tt) + 2 < NT) { WAIT_BAR(1); } else { WAIT_BAR(0); } } while (0)
    for (; t + 1 < NT; t += 2) {
        STEP(pB0, pB1, pA0, pA1, t, (t + 3 < NT), (t + 1 < NT), (t + 1 < NT));         ENDW(t);     RESC(); ROT();
        STEP(pA0, pA1, pB0, pB1, t + 1, (t + 4 < NT), (t + 2 < NT), (t + 2 < NT));     ENDW(t + 1); RESC(); ROT();
    }
    STEP(pB0, pB1, pA0, pA1, NT - 1, false, false, false); RESC();
    { float sacc = pB0[0] + pB0[1]; _Pragma("unroll") for (int r = 2; r < 16; ++r) sacc += pB0[r]; _Pragma("unroll") for (int r = 0; r < 16; ++r) sacc += pB1[r]; l_reg += sacc;
      pw0 = (u32x4){PKW(pB0, 0), PKW(pB0, 2), PKW(pB0, 4), PKW(pB0, 6)}; pw1 = (u32x4){PKW(pB0, 8), PKW(pB0, 10), PKW(pB0, 12), PKW(pB0, 14)}; pw2 = (u32x4){PKW(pB1, 0), PKW(pB1, 2), PKW(pB1, 4), PKW(pB1, 6)}; pw3 = (u32x4){PKW(pB1, 8), PKW(pB1, 10), PKW(pB1, 12), PKW(pB1, 14)};
      SBAR(); pv(o, vb0 + sl_cur, PAF(0), PAF(1), PAF(2), PAF(3)); }
#undef PKW
#undef PAF
#undef VFR
#undef PIN
#undef MX3
#undef GAPA
#undef GAPB
#undef EX
#undef VRD
#undef KRD
#undef STEP
#undef ENDW
    { auto rr = __builtin_amdgcn_permlane32_swap(__float_as_uint(l_reg), __float_as_uint(l_reg), false, false); l_reg = __uint_as_float(rr[0]) + __uint_as_float(rr[1]); }
    if (hi == 0) wsf[32 + r32] = l_reg; asm volatile("s_waitcnt lgkmcnt(0)" ::: "memory");
    float rli[16];
#pragma unroll
    for (int r = 0; r < 16; ++r) rli[r] = __builtin_amdgcn_rcpf(wsf[32 + crow(r, hi)]);
    float* stg = (float*)(shm + LDS_OST) + wid * 2048;
    if (comp == 0) {
#pragma unroll
        for (int r = 0; r < 16; ++r) { const int orow = crow(r, hi);
#pragma unroll
            for (int d0 = 0; d0 < 2; ++d0) stg[orow * 64 + d0 * 32 + r32] = o[d0][r] * rli[r]; }
    } else {
        const float lam = P.lam;
#pragma unroll
        for (int r = 0; r < 16; ++r) { const int orow = crow(r, hi);
#pragma unroll
            for (int d0 = 0; d0 < 2; ++d0) { const int ix = orow * 64 + d0 * 32 + r32; stg[ix] = stg[ix] - lam * (o[d0][r] * rli[r]); } }
        asm volatile("s_waitcnt lgkmcnt(0)" ::: "memory");
        bf16_t* Yw = P.Y + (rowbase + q0 + wid * QBLK) * DM + h * D;
        const int ch = lane & 7;
        const f32x4 g0 = *(const f32x4*)(P.gnorm + ch * 8), g1 = *(const f32x4*)(P.gnorm + ch * 8 + 4);
#pragma unroll
        for (int i = 0; i < 4; ++i) { const int row = i * 8 + (lane >> 3);
            const f32x4 a = *(const f32x4*)(stg + row * 64 + ch * 8), c = *(const f32x4*)(stg + row * 64 + ch * 8 + 4);
            float ss = (a[0] * a[0] + a[1] * a[1]) + (a[2] * a[2] + a[3] * a[3]) + (c[0] * c[0] + c[1] * c[1]) + (c[2] * c[2] + c[3] * c[3]);
            ss += __shfl_xor(ss, 1); ss += __shfl_xor(ss, 2); ss += __shfl_xor(ss, 4);
            const float rs = __builtin_amdgcn_rsqf(ss * (1.f / 64.f) + LN_EPS) * P.osc;
            u32x4 w; w.x = pk2(a[0] * rs * g0[0], a[1] * rs * g0[1]); w.y = pk2(a[2] * rs * g0[2], a[3] * rs * g0[3]); w.z = pk2(c[0] * rs * g1[0], c[1] * rs * g1[1]); w.w = pk2(c[2] * rs * g1[2], c[3] * rs * g1[3]);
            *(u32x4*)(Yw + (long)row * DM + ch * 8) = w; }
    }
    asm volatile("s_waitcnt lgkmcnt(0)\n\ts_barrier" ::: "memory");
#undef DMA_K
#undef DMA_V
#undef CMASK
#undef START
#undef RESC
#undef ROT
}
#undef SBAR
#undef WAIT_BAR
}

struct Frame {
    LAS unsigned char* lds; volatile LAS unsigned* MISC; gu32* ctl;
    int tid, lane, wave, vcu, G;
};
struct Args {
    const float* in[29]; float* out; unsigned char* ws; int ph_lo, ph_hi;
};
enum { I_X = 0, I_C, I_POS, I_WADA, I_BADA, I_WIN, I_WOUT, I_MBI, I_MBF, I_MG, I_CONVW, I_CONVB, I_LQ1, I_LK1, I_LQ2, I_LK2, I_DG, I_WA2, I_BA, I_GG, I_LN1G, I_LN1B, I_LN2G, I_LN2B,
       I_RW, I_RB, I_EWG, I_EWU, I_EWD };

__device__ __forceinline__ void tr_item(const float* W, int ldw, int K, bf16_t* WT, int drow0, int scol, int k0, LAS float* scr, int lane) {
#pragma unroll 8
    for (int i = 0; i < 32; ++i) { const int kk = 2 * i + (lane >> 5); scr[kk * 33 + (lane & 31)] = (scol >= 0) ? W[(size_t)(k0 + kk) * ldw + scol] : 0.f; }
    LDS_WAIT(); asm volatile("" ::: "memory");
    const int c = lane & 7;
#pragma unroll
    for (int j = 0; j < 4; ++j) { const int n = (lane >> 3) + 8 * j; const LAS float* s = scr + (8 * c) * 33 + n;
        u32x4 o; o.x = pk2(s[0 * 33], s[1 * 33]); o.y = pk2(s[2 * 33], s[3 * 33]); o.z = pk2(s[4 * 33], s[5 * 33]); o.w = pk2(s[6 * 33], s[7 * 33]);
        *(GAS u32x4*)(WT + (size_t)(drow0 + n) * K + k0 + 8 * c) = o; }
    LDS_WAIT(); asm volatile("" ::: "memory");
}
__device__ __forceinline__ int win_src_col(int n) {
    if (n < 1024) return n;
    if (n < 3584) return n + 8;
    const int i = n - 3584;
    if (i < 16) return 3592 + i;
    if (i < 20) return 1024 + (i - 16);
    if (i < 24) return 1028 + (i - 20);
    return -1;
}

namespace rec {
constexpr int PT = 72;
constexpr int TB = 64 * PT * 2;
constexpr int OFF_T0 = 0, OFF_T1 = TB, OFF_T2 = 2 * TB, OFF_T3 = 3 * TB, OFF_T4 = 4 * TB, OFF_T5 = 5 * TB;
constexpr int OFF_BM = 6 * TB;
constexpr int OFF_HM = OFF_BM + 16384;
constexpr int OFF_VEC = OFF_HM + 64 * 68 * 4;
constexpr int V_G = 0, V_M = 64, V_WI = 128, V_EM = 192, V_DI = 256, V_N = 320, V_BE = 384, V_SEG = 448, V_GA = 960;
static_assert(OFF_VEC + (960 + 1024) * 4 <= RING_BYTES, "rec LDS");

__device__ __forceinline__ void mm64(f32x4 (&acc)[2], const LAS bf16_t* A, const LAS bf16_t* Bt, int wid, int lane) {
    const int tm = wid >> 1, tn0 = (wid & 1) * 2, lr = lane & 15, lq = lane >> 4;
#pragma unroll
    for (int ks = 0; ks < 2; ++ks) {
        const bf16x8 a = *(const LAS bf16x8*)(A + (tm * 16 + lr) * PT + ks * 32 + lq * 8);
#pragma unroll
        for (int t = 0; t < 2; ++t) { const bf16x8 b = *(const LAS bf16x8*)(Bt + ((tn0 + t) * 16 + lr) * PT + ks * 32 + lq * 8);
            acc[t] = __builtin_amdgcn_mfma_f32_16x16x32_bf16(a, b, acc[t], 0, 0, 0); }
    }
}
__device__ __forceinline__ float scan_add(float v, int lane) {
#pragma unroll
    for (int o = 1; o < 64; o <<= 1) { const float t = __shfl_up(v, o); if (lane >= o) v += t; }
    return v;
}
__device__ __forceinline__ float scan_max(float v, int lane) {
#pragma unroll
    for (int o = 1; o < 64; o <<= 1) { const float t = __shfl_up(v, o); if (lane >= o) v = fmaxf(v, t); }
    return v;
}
__device__ __forceinline__ void st_tr8(LAS bf16_t* T, int l, int ch, u32x4 w) {
    T[(ch * 8 + 0) * PT + l] = (bf16_t)(w.x & 0xffffu); T[(ch * 8 + 1) * PT + l] = (bf16_t)(w.x >> 16);
    T[(ch * 8 + 2) * PT + l] = (bf16_t)(w.y & 0xffffu); T[(ch * 8 + 3) * PT + l] = (bf16_t)(w.y >> 16);
    T[(ch * 8 + 4) * PT + l] = (bf16_t)(w.z & 0xffffu); T[(ch * 8 + 5) * PT + l] = (bf16_t)(w.z >> 16);
    T[(ch * 8 + 6) * PT + l] = (bf16_t)(w.w & 0xffffu); T[(ch * 8 + 7) * PT + l] = (bf16_t)(w.w >> 16);
}
__device__ __forceinline__ void unpack8(u32x4 w, float (&f)[8]) {
    f[0] = bflo(w.x); f[1] = bfhi(w.x); f[2] = bflo(w.y); f[3] = bfhi(w.y); f[4] = bflo(w.z); f[5] = bfhi(w.z); f[6] = bflo(w.w); f[7] = bfhi(w.w);
}
template <int GATE  >
__device__ __forceinline__ void finalize(const LAS float* HM, const LAS float* rowscale, const float* gnorm, const bf16_t* gate, bf16_t* out, int tid) {
    const int j = tid >> 3, ch = tid & 7;
    const f32x4 a = *(const LAS f32x4*)(HM + j * 68 + ch * 8), c = *(const LAS f32x4*)(HM + j * 68 + ch * 8 + 4);
    const float rsc = rowscale ? rowscale[j] : 1.f;
    float v[8] = {a[0] * rsc, a[1] * rsc, a[2] * rsc, a[3] * rsc, c[0] * rsc, c[1] * rsc, c[2] * rsc, c[3] * rsc};
    float ss = 0.f;
#pragma unroll
    for (int i = 0; i < 8; ++i) ss += v[i] * v[i];
    ss += __shfl_xor(ss, 1); ss += __shfl_xor(ss, 2); ss += __shfl_xor(ss, 4);
    const float rs = __builtin_amdgcn_rsqf(ss * (1.f / 64.f) + LN_EPS);
    const u32x4 gw = *(const u32x4*)(gate + (size_t)j * PP + ch * 8);
    float gt[8]; unpack8(gw, gt);
    const f32x4 g0 = *(const f32x4*)(gnorm + ch * 8), g1 = *(const f32x4*)(gnorm + ch * 8 + 4);
    const float gn[8] = {g0[0], g0[1], g0[2], g0[3], g1[0], g1[1], g1[2], g1[3]};
    float y[8];
#pragma unroll
    for (int i = 0; i < 8; ++i) { const float sg = 1.f / (1.f + __expf(-gt[i])); const float gv = GATE ? gt[i] * sg : sg; y[i] = v[i] * rs * gn[i] * gv; }
    u32x4 w; w.x = pk2(y[0], y[1]); w.y = pk2(y[2], y[3]); w.z = pk2(y[4], y[5]); w.w = pk2(y[6], y[7]);
    *(u32x4*)(out + (size_t)j * DM + ch * 8) = w;
}

struct RecP {
    const bf16_t* proj; float* stm; float* stg; float* smN; float* smBC; float* smDM; float* smMS; float* smGBE; bf16_t* ycat;
    const float* mbi; const float* mbf; const float* mg; const float* wa2; const float* ba; const float* gg;
};

__device__ __forceinline__ void mlstm_gates(const RecP& P, int row0, int h, int lane, float& bcum, float& g) {
    const bf16_t* pr = P.proj + (size_t)(row0 + lane) * PP;
    const float li = bf2f(pr[C_MI + h]) + P.mbi[h];
    const float lf = logsig(bf2f(pr[C_MF + h]) + P.mbf[h]);
    bcum = scan_add(lf, lane); g = li - bcum;
}

__device__ __forceinline__ void mlstm_local(const RecP& P, LAS unsigned char* lds, int ci, int tid, int wid, int lane) {
    const int bh = ci >> 6, c = ci & 63, b = bh >> 2, h = bh & 3, row0 = b * SEQ + c * 64;
    LAS bf16_t* KT = (LAS bf16_t*)(lds + OFF_T0); LAS bf16_t* VT = (LAS bf16_t*)(lds + OFF_T1); LAS float* vec = (LAS float*)(lds + OFF_VEC);
    const int l = tid >> 3, ch = tid & 7;
    const u32x4 kw = *(const u32x4*)(P.proj + (size_t)(row0 + l) * PP + C_MK + h * 64 + ch * 8);
    const u32x4 vw = *(const u32x4*)(P.proj + (size_t)(row0 + l) * PP + C_MV + h * 64 + ch * 8);
    if (wid == 0) {
        float bc, g; mlstm_gates(P, row0, h, lane, bc, g);
        const float gmax = wave_max(g), bend = __shfl(bc, 63);
        vec[V_G + lane] = __expf(g - gmax);
        if (lane == 0) { P.smBC[ci] = bend; P.smDM[ci] = bend + gmax; }
    }
    __syncthreads();
    { const float w = vec[V_G + l]; float kf[8]; unpack8(kw, kf);
      u32x4 ks; ks.x = pk2(kf[0] * w, kf[1] * w); ks.y = pk2(kf[2] * w, kf[3] * w); ks.z = pk2(kf[4] * w, kf[5] * w); ks.w = pk2(kf[6] * w, kf[7] * w);
      st_tr8(KT, l, ch, ks); st_tr8(VT, l, ch, vw); }
    __syncthreads();
    f32x4 acc[2] = {(f32x4){0.f, 0.f, 0.f, 0.f}, (f32x4){0.f, 0.f, 0.f, 0.f}};
    mm64(acc, VT, KT, wid, lane);
    { const int tm = wid >> 1, tn0 = (wid & 1) * 2, lr = lane & 15, lq = lane >> 4; float* dst = P.stm + (size_t)ci * 4096;
#pragma unroll
      for (int t = 0; t < 2; ++t)
#pragma unroll
          for (int r = 0; r < 4; ++r) dst[(tm * 16 + lq * 4 + r) * 64 + (tn0 + t) * 16 + lr] = acc[t][r]; }
    if (tid < 64) { float s = 0.f;
#pragma unroll
        for (int q = 0; q < 8; ++q) { const u32x4 w = *(const LAS u32x4*)(KT + tid * PT + q * 8); float f[8]; unpack8(w, f);
#pragma unroll
            for (int i = 0; i < 8; ++i) s += f[i]; }
        P.smN[(size_t)ci * 64 + tid] = s; }
    __syncthreads();
}
__device__ __forceinline__ void mlstm_out(const RecP& P, LAS unsigned char* lds, int ci, int tid, int wid, int lane) {
    const int bh = ci >> 6, c = ci & 63, b = bh >> 2, h = bh & 3, row0 = b * SEQ + c * 64;
    LAS bf16_t* Qm = (LAS bf16_t*)(lds + OFF_T0); LAS bf16_t* Km = (LAS bf16_t*)(lds + OFF_T1); LAS bf16_t* VT = (LAS bf16_t*)(lds + OFF_T2);
    LAS bf16_t* CT = (LAS bf16_t*)(lds + OFF_T3); LAS bf16_t* Sm = (LAS bf16_t*)(lds + OFF_T4);
    LAS float* HM = (LAS float*)(lds + OFF_HM); LAS float* vec = (LAS float*)(lds + OFF_VEC);
    const int l = tid >> 3, ch = tid & 7;
    { const bf16_t* pr = P.proj + (size_t)(row0 + l) * PP + h * 64 + ch * 8;
      const u32x4 qw = *(const u32x4*)(pr + C_MQ), kw = *(const u32x4*)(pr + C_MK), vw = *(const u32x4*)(pr + C_MV);
      *(LAS u32x4*)(Qm + l * PT + ch * 8) = qw; *(LAS u32x4*)(Km + l * PT + ch * 8) = kw; st_tr8(VT, l, ch, vw);
      const float* cs = P.stm + (size_t)ci * 4096 + l * 64 + ch * 8;
      const f32x4 c0 = *(const f32x4*)cs, c1 = *(const f32x4*)(cs + 4);
      u32x4 cw; cw.x = pk2(c0[0], c0[1]); cw.y = pk2(c0[2], c0[3]); cw.z = pk2(c1[0], c1[1]); cw.w = pk2(c1[2], c1[3]);
      *(LAS u32x4*)(CT + l * PT + ch * 8) = cw; }
    if (wid == 0) {
        float bc, g; mlstm_gates(P, row0, h, lane, bc, g);
        const float pm = scan_max(g, lane), m = P.smMS[ci], M = fmaxf(m, pm);
        vec[V_G + lane] = g; vec[V_M + lane] = M; vec[V_WI + lane] = __expf(m - M); vec[V_EM + lane] = __expf(-bc - M);
        vec[V_N + lane] = P.smN[(size_t)ci * 64 + lane];
    }
    __syncthreads();
    { f32x4 acc[2] = {(f32x4){0.f, 0.f, 0.f, 0.f}, (f32x4){0.f, 0.f, 0.f, 0.f}};
      mm64(acc, Qm, Km, wid, lane);
      const int tm = wid >> 1, tn0 = (wid & 1) * 2, lr = lane & 15, lq = lane >> 4;
#pragma unroll
      for (int t = 0; t < 2; ++t) { const int ll = (tn0 + t) * 16 + lr; const float gl = vec[V_G + ll];
#pragma unroll
          for (int r = 0; r < 4; ++r) { const int j = tm * 16 + lq * 4 + r; const float s = (ll <= j) ? acc[t][r] * __expf(gl - vec[V_M + j]) : 0.f; Sm[j * PT + ll] = (bf16_t)f2bf(s); } } }
    __syncthreads();
    { f32x4 a1[2] = {(f32x4){0.f, 0.f, 0.f, 0.f}, (f32x4){0.f, 0.f, 0.f, 0.f}}, a2[2] = {(f32x4){0.f, 0.f, 0.f, 0.f}, (f32x4){0.f, 0.f, 0.f, 0.f}};
      mm64(a1, Sm, VT, wid, lane); mm64(a2, Qm, CT, wid, lane);
      const int tm = wid >> 1, tn0 = (wid & 1) * 2, lr = lane & 15, lq = lane >> 4;
#pragma unroll
      for (int t = 0; t < 2; ++t)
#pragma unroll
          for (int r = 0; r < 4; ++r) { const int j = tm * 16 + lq * 4 + r; HM[j * 68 + (tn0 + t) * 16 + lr] = a1[t][r] + vec[V_WI + j] * a2[t][r]; } }
    if (tid < 64) { float ds = 0.f, qn = 0.f;
#pragma unroll
        for (int q = 0; q < 8; ++q) { const u32x4 w = *(const LAS u32x4*)(Sm + tid * PT + q * 8); float f[8]; unpack8(w, f);
            const u32x4 qw = *(const LAS u32x4*)(Qm + tid * PT + q * 8); float qf[8]; unpack8(qw, qf);
#pragma unroll
            for (int i = 0; i < 8; ++i) { ds += f[i]; qn += qf[i] * vec[V_N + q * 8 + i]; } }
        const float den = ds + vec[V_WI + tid] * qn;
        vec[V_DI + tid] = 1.f / fmaxf(fabsf(den), vec[V_EM + tid]); }
    __syncthreads();
    finalize<0>(HM, vec + V_DI, P.mg, P.proj + (size_t)row0 * PP + C_MO + h * 64, P.ycat + (size_t)row0 * DM + h * 64, tid);
    __syncthreads();
}
__device__ __forceinline__ void gla_bmat(const RecP& P, LAS unsigned char* lds, int row0, int h, int tid, int wid) {
    LAS float* BM = (LAS float*)(lds + OFF_BM); LAS float* vec = (LAS float*)(lds + OFF_VEC);
    if (tid < 128) { const int l = tid >> 1, hf = tid & 1; const u32x4 w = *(const u32x4*)(P.proj + (size_t)(row0 + l) * PP + C_GA + hf * 8); float f[8]; unpack8(w, f);
#pragma unroll
        for (int i = 0; i < 8; ++i) vec[V_GA + l * 16 + hf * 8 + i] = f[i]; }
    const int dcol = tid & 63;
    float wv[16];
#pragma unroll
    for (int r = 0; r < 16; ++r) wv[r] = P.wa2[r * 256 + h * 64 + dcol];
    const float bav = P.ba[h * 64 + dcol];
    __syncthreads();
    float cs[8]; float cacc = 0.f;
#pragma unroll
    for (int i = 0; i < 8; ++i) { const int l = wid * 8 + i; float z = bav;
#pragma unroll
        for (int r = 0; r < 16; ++r) z += vec[V_GA + l * 16 + r] * wv[r];
        cacc += logsig(z) * (1.f / 16.f); cs[i] = cacc; }
    vec[V_SEG + wid * 64 + dcol] = cacc;
    __syncthreads();
    float off = 0.f, tot = 0.f;
#pragma unroll
    for (int s = 0; s < 8; ++s) { const float v = vec[V_SEG + s * 64 + dcol]; tot += v; if (s < wid) off += v; }
#pragma unroll
    for (int i = 0; i < 8; ++i) BM[(wid * 8 + i) * 64 + dcol] = off + cs[i];
    if (wid == 0) vec[V_BE + dcol] = tot;
    __syncthreads();
}
__device__ __forceinline__ void gla_local(const RecP& P, LAS unsigned char* lds, int ci, int tid, int wid, int lane) {
    const int bh = ci >> 6, c = ci & 63, b = bh >> 2, h = bh & 3, row0 = b * SEQ + c * 64;
    LAS bf16_t* KT = (LAS bf16_t*)(lds + OFF_T0); LAS bf16_t* VT = (LAS bf16_t*)(lds + OFF_T1);
    LAS float* BM = (LAS float*)(lds + OFF_BM); LAS float* vec = (LAS float*)(lds + OFF_VEC);
    const int l = tid >> 3, ch = tid & 7;
    const u32x4 kw = *(const u32x4*)(P.proj + (size_t)(row0 + l) * PP + C_GK + h * 64 + ch * 8);
    const u32x4 vw = *(const u32x4*)(P.proj + (size_t)(row0 + l) * PP + C_GV + h * 64 + ch * 8);
    gla_bmat(P, lds, row0, h, tid, wid);
    if (tid < 64) P.smGBE[(size_t)ci * 64 + tid] = vec[V_BE + tid];
    { float kf[8]; unpack8(kw, kf); float ks[8];
#pragma unroll
      for (int i = 0; i < 8; ++i) { const int d = ch * 8 + i; ks[i] = kf[i] * __expf(vec[V_BE + d] - BM[l * 64 + d]); }
      u32x4 kk; kk.x = pk2(ks[0], ks[1]); kk.y = pk2(ks[2], ks[3]); kk.z = pk2(ks[4], ks[5]); kk.w = pk2(ks[6], ks[7]);
      st_tr8(KT, l, ch, kk); st_tr8(VT, l, ch, vw); }
    __syncthreads();
    f32x4 acc[2] = {(f32x4){0.f, 0.f, 0.f, 0.f}, (f32x4){0.f, 0.f, 0.f, 0.f}};
    mm64(acc, VT, KT, wid, lane);
    { const int tm = wid >> 1, tn0 = (wid & 1) * 2, lr = lane & 15, lq = lane >> 4; float* dst = P.stg + (size_t)ci * 4096;
#pragma unroll
      for (int t = 0; t < 2; ++t)
#pragma unroll
          for (int r = 0; r < 4; ++r) dst[(tm * 16 + lq * 4 + r) * 64 + (tn0 + t) * 16 + lr] = acc[t][r]; }
    __syncthreads();
}
__device__ __forceinline__ void gla_out(const RecP& P, LAS unsigned char* lds, int ci, int tid, int wid, int lane) {
    const int bh = ci >> 6, c = ci & 63, b = bh >> 2, h = bh & 3, row0 = b * SEQ + c * 64;
    LAS bf16_t* Qm = (LAS bf16_t*)(lds + OFF_T0); LAS bf16_t* Km = (LAS bf16_t*)(lds + OFF_T1); LAS bf16_t* VT = (LAS bf16_t*)(lds + OFF_T2);
    LAS bf16_t* ST = (LAS bf16_t*)(lds + OFF_T3); LAS bf16_t* Sm = (LAS bf16_t*)(lds + OFF_T4);
    LAS float* BM = (LAS float*)(lds + OFF_BM); LAS float* HM = (LAS float*)(lds + OFF_HM);
    const int l = tid >> 3, ch = tid & 7;
    const bf16_t* pr = P.proj + (size_t)(row0 + l) * PP + h * 64 + ch * 8;
    const u32x4 qw = *(const u32x4*)(pr + C_GQ), kw = *(const u32x4*)(pr + C_GK), vw = *(const u32x4*)(pr + C_GV);
    const float* ss = P.stg + (size_t)ci * 4096 + l * 64 + ch * 8;
    const f32x4 s0 = *(const f32x4*)ss, s1 = *(const f32x4*)(ss + 4);
    gla_bmat(P, lds, row0, h, tid, wid);
    { float qf[8], kf[8]; unpack8(qw, qf); unpack8(kw, kf); float qs[8], ks[8];
#pragma unroll
      for (int i = 0; i < 8; ++i) { const float bv = BM[l * 64 + ch * 8 + i]; qs[i] = qf[i] * __expf(bv); ks[i] = kf[i] * __expf(-bv); }
      u32x4 qq, kk; qq.x = pk2(qs[0], qs[1]); qq.y = pk2(qs[2], qs[3]); qq.z = pk2(qs[4], qs[5]); qq.w = pk2(qs[6], qs[7]);
      kk.x = pk2(ks[0], ks[1]); kk.y = pk2(ks[2], ks[3]); kk.z = pk2(ks[4], ks[5]); kk.w = pk2(ks[6], ks[7]);
      *(LAS u32x4*)(Qm + l * PT + ch * 8) = qq; *(LAS u32x4*)(Km + l * PT + ch * 8) = kk; st_tr8(VT, l, ch, vw);
      u32x4 cw; cw.x = pk2(s0[0], s0[1]); cw.y = pk2(s0[2], s0[3]); cw.z = pk2(s1[0], s1[1]); cw.w = pk2(s1[2], s1[3]);
      *(LAS u32x4*)(ST + l * PT + ch * 8) = cw; }
    __syncthreads();
    { f32x4 acc[2] = {(f32x4){0.f, 0.f, 0.f, 0.f}, (f32x4){0.f, 0.f, 0.f, 0.f}};
      mm64(acc, Qm, Km, wid, lane);
      const int tm = wid >> 1, tn0 = (wid & 1) * 2, lr = lane & 15, lq = lane >> 4;
#pragma unroll
      for (int t = 0; t < 2; ++t) { const int ll = (tn0 + t) * 16 + lr;
#pragma unroll
          for (int r = 0; r < 4; ++r) { const int j = tm * 16 + lq * 4 + r; Sm[j * PT + ll] = (bf16_t)f2bf((ll <= j) ? acc[t][r] : 0.f); } } }
    __syncthreads();
    { f32x4 acc[2] = {(f32x4){0.f, 0.f, 0.f, 0.f}, (f32x4){0.f, 0.f, 0.f, 0.f}};
      mm64(acc, Sm, VT, wid, lane); mm64(acc, Qm, ST, wid, lane);
      const int tm = wid >> 1, tn0 = (wid & 1) * 2, lr = lane & 15, lq = lane >> 4;
#pragma unroll
      for (int t = 0; t < 2; ++t)
#pragma unroll
          for (int r = 0; r < 4; ++r) HM[(tm * 16 + lq * 4 + r) * 68 + (tn0 + t) * 16 + lr] = acc[t][r]; }
    __syncthreads();
    finalize<1>(HM, nullptr, P.gg, P.proj + (size_t)row0 * PP + C_GR + h * 64, P.ycat + (size_t)row0 * DM + 768 + h * 64, tid);
    __syncthreads();
}
}

constexpr int N_PHASES = 2 + 9 * DEPTH;
__global__ void __launch_bounds__(512, 2) mega_fwd(Args args) {
    extern __shared__ __attribute__((aligned(16))) unsigned char lds_raw[];
    Frame F;
    F.lds = (LAS unsigned char*)lds_raw;
    F.MISC = (volatile LAS unsigned*)(F.lds + MISC_OFF);
    F.tid = threadIdx.x; F.lane = F.tid & 63; F.wave = __builtin_amdgcn_readfirstlane(F.tid >> 6);
    F.G = gridDim.x; { const int bx = blockIdx.x; F.vcu = (F.G % 8 == 0) ? (bx % 8) * (F.G / 8) + bx / 8 : bx; }
    unsigned char* ws = args.ws;
    F.ctl = (gu32*)(ws + WS_CTL);
    for (int u = F.tid; u < (LDS_BYTES - LDSCTL_OFF) / 4; u += 512) ((LAS unsigned*)(F.lds + LDSCTL_OFF))[u] = 0u;
    __syncthreads();
#if MK_ONE_LAUNCH
    XcdBarrier bar = xcd_barrier_post((unsigned*)(F.ctl + CW_BAR), F.MISC + 8);
#define GRID_BAR() xcd_barrier(bar)
#else
#define GRID_BAR() do {} while (0)
#endif
    const int lo = args.ph_lo, hi = args.ph_hi;
#define IN(k) (lo <= (k) && (k) < hi)
#define SEAM(k) do { if (IN(k) && IN((k) + 1)) GRID_BAR(); } while (0)
    const int NGW = F.G * 8;
#define PHASE_IDS() int tid = F.tid; asm volatile("" : "+v"(tid)); const int lane = tid & 63, wid = __builtin_amdgcn_readfirstlane(tid >> 6); const int gw = F.vcu * 8 + wid; (void)lane; (void)gw
    float* const MOD = (float*)(ws + WS_MOD); float* const ROPE = (float*)(ws + WS_ROPE);
    bf16_t* const WIN = (bf16_t*)(ws + WS_WIN); bf16_t* const WOUT = (bf16_t*)(ws + WS_WOUT); bf16_t* const WGU = (bf16_t*)(ws + WS_WGU); bf16_t* const WD = (bf16_t*)(ws + WS_WD);
    int* const LTOK = (int*)(ws + WS_LTOK); float* const LGATE = (float*)(ws + WS_LGATE);
    bf16_t* const PROJ = (bf16_t*)(ws + WS_PROJ); bf16_t* const HB = (bf16_t*)(ws + WS_PROJ); float* const XR = (float*)(ws + WS_XR);
    bf16_t* const UB = (bf16_t*)(ws + WS_U); bf16_t* const YCAT = (bf16_t*)(ws + WS_YCAT);
    float* const STM = (float*)(ws + WS_U); float* const STG = (float*)(ws + WS_U + 32 * MiB);
    float* const smN = (float*)(ws + WS_SM + SM_N); float* const smBC = (float*)(ws + WS_SM + SM_BC); float* const smDM = (float*)(ws + WS_SM + SM_DM);
    float* const smMS = (float*)(ws + WS_SM + SM_MS); float* const smGBE = (float*)(ws + WS_SM + SM_GBE);
    const float* const x_in = args.in[I_X];

    if (IN(0) && PHON(0)) {
        PHASE_IDS();
        {
            LAS float* cact = (LAS float*)F.lds;
            LAS float* part = (LAS float*)(F.lds + 32768);
            const float* cc = args.in[I_C];
            for (int i = tid; i < NB * DM; i += 512) { const int b = i >> 10, k = i & 1023; const float v = cc[i]; cact[k * 8 + b] = v / (1.f + __expf(-v)); }
            __syncthreads();
            for (int it = F.vcu; it < DEPTH * 96; it += F.G) {
                const int l = it / 96, j0 = (it % 96) * 64;
                const float* W = args.in[I_WADA] + (size_t)l * DM * 6144 + j0 + lane;
                float a[8] = {0.f, 0.f, 0.f, 0.f, 0.f, 0.f, 0.f, 0.f};
#pragma unroll 8
                for (int kk = 0; kk < 128; ++kk) { const int k = wid * 128 + kk; const float w = W[(size_t)k * 6144];
                    const f32x4 c0 = *(const LAS f32x4*)(cact + k * 8), c1 = *(const LAS f32x4*)(cact + k * 8 + 4);
                    a[0] += c0[0] * w; a[1] += c0[1] * w; a[2] += c0[2] * w; a[3] += c0[3] * w; a[4] += c1[0] * w; a[5] += c1[1] * w; a[6] += c1[2] * w; a[7] += c1[3] * w; }
#pragma unroll
                for (int b = 0; b < 8; ++b) part[(wid * 8 + b) * 64 + lane] = a[b];
                __syncthreads();
                { const int b = tid >> 6, j = tid & 63; float s = args.in[I_BADA][(size_t)l * 6144 + j0 + j];
#pragma unroll
                  for (int w = 0; w < 8; ++w) s += part[(w * 8 + b) * 64 + j];
                  MOD[((size_t)l * NB + b) * 6144 + j0 + j] = s; }
                __syncthreads();
            }
        }
        {
            const int* pos = (const int*)args.in[I_POS];
            for (int i = blockIdx.x * 512 + tid; i < NTOK * 4; i += F.G * 512) { const int row = i >> 2, f = i & 3;
                const float invf = (float)pow(500000.0, -0.25 * (double)f); const float ang = (float)pos[row] * invf;
                ROPE[(size_t)row * 8 + f] = (float)cos((double)ang); ROPE[(size_t)row * 8 + 4 + f] = (float)sin((double)ang); }
        }
        {
            LAS float* scr = (LAS float*)(F.lds + 49152 + wid * 8704);
            constexpr int I_IN = (DM / 64) * (PP / 32), I_OUT = (DM / 64) * (DM / 32);
            for (int it = gw; it < DEPTH * (I_IN + I_OUT); it += NGW) {
                const int l = it / (I_IN + I_OUT); int r = it % (I_IN + I_OUT);
                if (r < I_IN) { const int kb = r / (PP / 32), nb = r % (PP / 32);
                    tr_item(args.in[I_WIN] + (size_t)l * DM * PIN, PIN, DM, WIN + (size_t)l * PP * DM, nb * 32, win_src_col(nb * 32 + (lane & 31)), kb * 64, scr, lane); }
                else { r -= I_IN; const int kb = r / (DM / 32), nb = r % (DM / 32);
                    tr_item(args.in[I_WOUT] + (size_t)l * DM * DM, DM, DM, WOUT + (size_t)l * DM * DM, nb * 32, nb * 32 + (lane & 31), kb * 64, scr, lane); }
            }
        }
    }
    SEAM(0);
    if (IN(1) && PHON(1)) {
        PHASE_IDS();
        const int b = F.vcu >> 5; const float* md = MOD + (size_t)b * 6144;
        f32x4 sh[4], sc[4];
#pragma unroll
        for (int j = 0; j < 4; ++j) { sh[j] = *(const f32x4*)(md + 4 * lane + 256 * j); sc[j] = *(const f32x4*)(md + 1024 + 4 * lane + 256 * j) + 1.0f; }
        for (int i = 0; i < 16; ++i) { const int row = F.vcu * 128 + wid * 16 + i;
#pragma unroll
            for (int j = 0; j < 4; ++j) { const f32x4 v = *(const f32x4*)(x_in + (size_t)row * DM + 4 * lane + 256 * j); const f32x4 u = v * sc[j] + sh[j];
                u32x2 w; w.x = pk2(u[0], u[1]); w.y = pk2(u[2], u[3]); *(u32x2*)(UB + (size_t)row * DM + 4 * lane + 256 * j) = w; } }
    }
    SEAM(1);

    for (int l = 0; l < DEPTH; ++l) {
        const int pb = 2 + 9 * l;
        const float* modl = MOD + (size_t)l * NB * 6144;
#define MAKE_RP() rec::RecP RP; RP.proj = PROJ; RP.stm = STM; RP.stg = STG; RP.smN = smN; RP.smBC = smBC; RP.smDM = smDM; RP.smMS = smMS; RP.smGBE = smGBE; RP.ycat = YCAT; \
        RP.mbi = args.in[I_MBI] + l * 4; RP.mbf = args.in[I_MBF] + l * 4; RP.mg = args.in[I_MG] + l * 64; RP.wa2 = args.in[I_WA2] + (size_t)l * 16 * 256; RP.ba = args.in[I_BA] + l * 256; RP.gg = args.in[I_GG] + l * 64;
        if (IN(pb + 0) && PHON(2)) {
            gm::K1 k; k.S.init(NTOK, PP, F.G, (int)blockIdx.x); k.A = UB; k.Bt = WIN + (size_t)l * PP * DM; k.O = PROJ; k.rope = ROPE;
            gm::gemm_phase<gm::K1>(F.lds, k);
        }
        SEAM(pb + 0);
        if (IN(pb + 1) && PHON(3)) {
            PHASE_IDS();
            MAKE_RP();
            for (int it = F.vcu; it < 4096; it += F.G) { if (it < 2048) rec::mlstm_local(RP, F.lds, it, tid, wid, lane); else rec::gla_local(RP, F.lds, it - 2048, tid, wid, lane); }
        }
        SEAM(pb + 1);
        if (IN(pb + 2) && PHON(4)) {
            PHASE_IDS();
            const int gt = blockIdx.x * 512 + tid, NGT = F.G * 512;
            for (int idx = gt; idx < 32 * 4096; idx += NGT) {
                const int bh = idx >> 12, el = idx & 4095; float* p = STM + (size_t)bh * 64 * 4096 + el; const float* bc = smBC + bh * 64; const float* dm = smDM + bh * 64;
                float C = 0.f, m = 0.f;
#pragma unroll 8
                for (int c = 0; c < NCH; ++c) { const float u = p[(size_t)c * 4096]; p[(size_t)c * 4096] = C; if (el == 0) smMS[bh * 64 + c] = m;
                    const float B = bc[c], Dm = dm[c], mn = fmaxf(B + m, Dm); C = __expf(B + m - mn) * C + __expf(Dm - mn) * u; m = mn; }
            }
            for (int idx = gt; idx < 32 * 64; idx += NGT) {
                const int bh = idx >> 6, el = idx & 63; float* p = smN + (size_t)bh * 64 * 64 + el; const float* bc = smBC + bh * 64; const float* dm = smDM + bh * 64;
                float C = 0.f, m = 0.f;
#pragma unroll 8
                for (int c = 0; c < NCH; ++c) { const float u = p[c * 64]; p[c * 64] = C;
                    const float B = bc[c], Dm = dm[c], mn = fmaxf(B + m, Dm); C = __expf(B + m - mn) * C + __expf(Dm - mn) * u; m = mn; }
            }
            for (int idx = gt; idx < 32 * 4096; idx += NGT) {
                const int bh = idx >> 12, el = idx & 4095, d = el & 63; float* p = STG + (size_t)bh * 64 * 4096 + el; const float* be = smGBE + (size_t)bh * 64 * 64 + d;
                float S = 0.f;
#pragma unroll 8
                for (int c = 0; c < NCH; ++c) { const float u = p[(size_t)c * 4096]; p[(size_t)c * 4096] = S; S = __expf(be[c * 64]) * S + u; }
            }
            {
                LAS float* scr = (LAS float*)(F.lds + 49152 + wid * 8704);
                constexpr int I_G = (DM / 64) * (1024 / 32), I_D = (DE / 64) * (DM / 32);
                for (int it = gw; it < NE * (I_G + I_D); it += NGW) {
                    const int e = it / (I_G + I_D); int r = it % (I_G + I_D);
                    if (r < I_G) { const int kb = r / 32, nb = r % 32, n0 = nb * 32, tt = n0 >> 8, rr = n0 & 255;
                        const float* W = (rr < 128 ? args.in[I_EWG] : args.in[I_EWU]) + ((size_t)l * NE + e) * DM * DE;
                        tr_item(W, DE, DM, WGU + (size_t)e * 1024 * 1024, n0, tt * 128 + (rr & 127) + (lane & 31), kb * 64, scr, lane); }
                    else { r -= I_G; const int kb = r / 32, nb = r % 32;
                        tr_item(args.in[I_EWD] + ((size_t)l * NE + e) * DE * DM, DM, DE, WD + (size_t)e * 1024 * 512, nb * 32, nb * 32 + (lane & 31), kb * 64, scr, lane); }
                }
            }
        }
        SEAM(pb + 2);
        if (IN(pb + 3) && PHON(5)) {
            PHASE_IDS();
            if (PHON(10)) {
                float d1 = 0.f, d2 = 0.f;
                for (int i = 0; i < 32; ++i) { d1 += args.in[I_LQ1][l * 32 + i] * args.in[I_LK1][l * 32 + i]; d2 += args.in[I_LQ2][l * 32 + i] * args.in[I_LK2][l * 32 + i]; }
                const float lam_init = 0.8f - 0.6f * expf(-0.3f * (float)l);
                attn_body::AttnParams AP; AP.Q = (const attn_body::bf16*)(PROJ + C_DQ); AP.K = (const attn_body::bf16*)(PROJ + C_DK); AP.V = (const attn_body::bf16*)(PROJ + C_DV);
                AP.zpage = (const attn_body::bf16*)(F.ctl + CW_ZPAGE); AP.Y = YCAT + 512; AP.gnorm = args.in[I_DG] + l * 64; AP.lam = expf(d1) - expf(d2) + lam_init; AP.osc = 1.f - lam_init;
                const int bh = F.vcu >> 3, s = F.vcu & 7;
                if (F.G == 256) {
                    for (int i = 0; i < 2; ++i) { const int qb = (i == 0) ? s : 15 - s;
                        attn_body::attn_unit<8, 0>(bh >> 2, bh & 3, qb, AP, (char*)lds_raw); attn_body::attn_unit<8, 1>(bh >> 2, bh & 3, qb, AP, (char*)lds_raw); }
                } else {
                    for (int u = F.vcu; u < 512; u += F.G) { const int bh2 = u >> 4, qb = u & 15;
                        attn_body::attn_unit<8, 0>(bh2 >> 2, bh2 & 3, qb, AP, (char*)lds_raw); attn_body::attn_unit<8, 1>(bh2 >> 2, bh2 & 3, qb, AP, (char*)lds_raw); }
                }
            }
            __syncthreads();
            MAKE_RP();
            if (PHON(11)) for (int it = F.vcu; it < 4096; it += F.G) { if (it < 2048) rec::mlstm_out(RP, F.lds, it, tid, wid, lane); else rec::gla_out(RP, F.lds, it - 2048, tid, wid, lane); }
            if (PHON(12)) {
                const float* cw = args.in[I_CONVW] + (size_t)l * 3 * 256; const float* cbias = args.in[I_CONVB] + l * 256;
                for (int it = F.vcu; it < NTOK / 64; it += F.G) {
                    for (int p = tid; p < 64 * 32; p += 512) { const int r = p >> 5, chn = p & 31, row = it * 64 + r, t = row & (SEQ - 1);
                        const bf16_t* pr = PROJ + (size_t)row * PP + chn * 8;
                        float s0[8], s1[8], s2[8], cbv[8];
                        { float a[8], bq[8]; rec::unpack8(*(const u32x4*)(pr + C_CC), a); rec::unpack8(*(const u32x4*)(pr + C_CH), bq);
#pragma unroll
                          for (int i = 0; i < 8; ++i) s2[i] = a[i] * bq[i]; }
                        if (t >= 1) { float a[8], bq[8]; rec::unpack8(*(const u32x4*)(pr - PP + C_CC), a); rec::unpack8(*(const u32x4*)(pr - PP + C_CH), bq);
#pragma unroll
                          for (int i = 0; i < 8; ++i) s1[i] = a[i] * bq[i]; } else {
#pragma unroll
                          for (int i = 0; i < 8; ++i) s1[i] = 0.f; }
                        if (t >= 2) { float a[8], bq[8]; rec::unpack8(*(const u32x4*)(pr - 2 * PP + C_CC), a); rec::unpack8(*(const u32x4*)(pr - 2 * PP + C_CH), bq);
#pragma unroll
                          for (int i = 0; i < 8; ++i) s0[i] = a[i] * bq[i]; } else {
#pragma unroll
                          for (int i = 0; i < 8; ++i) s0[i] = 0.f; }
                        rec::unpack8(*(const u32x4*)(pr + C_CB), cbv);
                        float y[8];
#pragma unroll
                        for (int i = 0; i < 8; ++i) { const int cch = chn * 8 + i; y[i] = cbv[i] * (cw[cch] * s0[i] + cw[256 + cch] * s1[i] + cw[512 + cch] * s2[i] + cbias[cch]); }
                        u32x4 w; w.x = pk2(y[0], y[1]); w.y = pk2(y[2], y[3]); w.z = pk2(y[4], y[5]); w.w = pk2(y[6], y[7]);
                        *(u32x4*)(YCAT + (size_t)row * DM + 256 + chn * 8) = w; }
                }
            }
        }
        SEAM(pb + 3);
        if (IN(pb + 4) && PHON(6)) {
            gm::K2 k; k.S.init(NTOK, DM, F.G, (int)blockIdx.x); k.A = YCAT; k.Bt = WOUT + (size_t)l * DM * DM; k.xin = (l == 0) ? x_in : XR; k.xout = XR; k.modl = modl;
            gm::gemm_phase<gm::K2>(F.lds, k);
        }
        SEAM(pb + 4);
        if (IN(pb + 5) && PHON(7)) {
            PHASE_IDS();
            LAS float* rwT = (LAS float*)F.lds;
            { const float* rw = args.in[I_RW]; for (int i = tid; i < DM * NE; i += 512) rwT[(i & 15) * 1024 + (i >> 4)] = rw[i]; }
            __syncthreads();
            const int b = F.vcu >> 5; const float* md = modl + (size_t)b * 6144;
            const float* lg = args.in[I_LN1G] + l * DM; const float* lb = args.in[I_LN1B] + l * DM;
            f32x4 gv[4], bv[4], sh[4], sc[4];
#pragma unroll
            for (int j = 0; j < 4; ++j) { const int cix = 4 * lane + 256 * j; gv[j] = *(const f32x4*)(lg + cix); bv[j] = *(const f32x4*)(lb + cix); sh[j] = *(const f32x4*)(md + 3 * 1024 + cix); sc[j] = *(const f32x4*)(md + 4 * 1024 + cix) + 1.0f; }
            LAS float* rbl = (LAS float*)(F.lds + 65536);
            if (tid < 16) rbl[tid] = args.in[I_RB][tid];
            __syncthreads();
            gu32* cntw = F.ctl + CW_CNT + (size_t)l * NBUCKET * 64;
            for (int i = 0; i < 16; ++i) { const int row = F.vcu * 128 + wid * 16 + i;
                f32x4 v[4]; float s = 0.f;
#pragma unroll
                for (int j = 0; j < 4; ++j) { v[j] = *(const f32x4*)(XR + (size_t)row * DM + 4 * lane + 256 * j); s += (v[j][0] + v[j][1]) + (v[j][2] + v[j][3]); }
                const float mean = wave_sum(s) * (1.f / DM); float s2 = 0.f;
#pragma unroll
                for (int j = 0; j < 4; ++j) { v[j] = v[j] - mean; s2 += (v[j][0] * v[j][0] + v[j][1] * v[j][1]) + (v[j][2] * v[j][2] + v[j][3] * v[j][3]); }
                const float rstd = 1.f / sqrtf(wave_sum(s2) * (1.f / DM) + LN_EPS);
#pragma unroll
                for (int j = 0; j < 4; ++j) { const f32x4 xn = v[j] * rstd * gv[j] + bv[j]; *(f32x4*)(XR + (size_t)row * DM + 4 * lane + 256 * j) = xn;
                    const f32x4 u = xn * sc[j] + sh[j]; v[j] = u; u32x2 w; w.x = pk2(u[0], u[1]); w.y = pk2(u[2], u[3]); *(u32x2*)(UB + (size_t)row * DM + 4 * lane + 256 * j) = w; }
                int bg = 0; float bgs = -INFINITY; float gb0 = 0.f, gb1 = 0.f, gb2 = 0.f, gb3 = 0.f, gs0 = 0.f, gs1 = 0.f, gs2 = 0.f, gs3 = 0.f;
#pragma unroll 1
                for (int g = 0; g < 4; ++g) {
                    float cb[4], cs[4];
#pragma unroll
                    for (int q = 0; q < 4; ++q) { const LAS float* rr = rwT + (g * 4 + q) * 1024 + 4 * lane; float p = 0.f;
#pragma unroll
                        for (int j = 0; j < 4; ++j) { const f32x4 r4 = *(const LAS f32x4*)(rr + 256 * j); p += (v[j][0] * r4[0] + v[j][1] * r4[1]) + (v[j][2] * r4[2] + v[j][3] * r4[3]); }
                        const float lgt = wave_sum(p); cs[q] = 1.f / (1.f + __expf(-lgt)); cb[q] = cs[q] + rbl[g * 4 + q]; }
                    const float h1 = fmaxf(cb[0], cb[1]), l1 = fminf(cb[0], cb[1]), h2 = fmaxf(cb[2], cb[3]), l2 = fminf(cb[2], cb[3]);
                    const float top = fmaxf(h1, h2), sec = fmaxf(fminf(h1, h2), (h1 >= h2) ? l1 : l2); const float gsc = top + sec;
                    if (gsc > bgs) { bgs = gsc; bg = g; gb0 = cb[0]; gb1 = cb[1]; gb2 = cb[2]; gb3 = cb[3]; gs0 = cs[0]; gs1 = cs[1]; gs2 = cs[2]; gs3 = cs[3]; }
                }
                int e1 = 0; float m1 = gb0;
                if (gb1 > m1) { m1 = gb1; e1 = 1; } if (gb2 > m1) { m1 = gb2; e1 = 2; } if (gb3 > m1) { m1 = gb3; e1 = 3; }
                int e2 = -1; float m2 = -INFINITY;
                if (e1 != 0 && gb0 > m2) { m2 = gb0; e2 = 0; } if (e1 != 1 && gb1 > m2) { m2 = gb1; e2 = 1; } if (e1 != 2 && gb2 > m2) { m2 = gb2; e2 = 2; } if (e1 != 3 && gb3 > m2) { m2 = gb3; e2 = 3; }
                const int ei = e1 < e2 ? e1 : e2, ej = e1 < e2 ? e2 : e1;
                const float si = (ei == 0) ? gs0 : (ei == 1) ? gs1 : (ei == 2) ? gs2 : gs3, sj = (ej == 0) ? gs0 : (ej == 1) ? gs1 : (ej == 2) ? gs2 : gs3;
                const int pr_ = (ei == 0) ? ej - 1 : (ei == 1) ? ej + 1 : 5; const int bk = bg * 6 + pr_;
                if (lane == 0) { const unsigned pos = __hip_atomic_fetch_add(cntw + bk * 64, 1u, RLX_AGENT);
                    LTOK[(size_t)bk * LCAP + pos] = row; const float inv = 1.f / (si + sj); LGATE[((size_t)bk * LCAP + pos) * 2] = si * inv; LGATE[((size_t)bk * LCAP + pos) * 2 + 1] = sj * inv; }
            }
            __syncthreads();
        }
        SEAM(pb + 5);
        if ((IN(pb + 6) || IN(pb + 7)) && PHON(8)) {
            PHASE_IDS();
            LAS int* tb = (LAS int*)(F.lds + MOE_TB_OFF);
            if (tid == 0) { gu32* cntw = F.ctl + CW_CNT + (size_t)l * NBUCKET * 64; int acc = 0;
                for (int k = 0; k < NBUCKET; ++k) { const int c = (int)__hip_atomic_load(cntw + k * 64, RLX_AGENT); tb[k] = c; tb[32 + k] = acc; acc += (c + 255) >> 8; }
                tb[32 + NBUCKET] = acc; }
            __syncthreads();
            if (IN(pb + 6)) {
                gm::K4 k; k.U = UB; k.Wgu = WGU; k.H = HB; k.ltok = LTOK; k.lgate = LGATE; k.tb = tb; k.G = F.G; k.vcu = F.vcu;
                gm::gemm_phase<gm::K4>(F.lds, k);
            }
            SEAM(pb + 6);
            if (IN(pb + 7)) {
                gm::K5 k; k.H = HB; k.Wd = WD; k.XR = XR; k.ltok = LTOK; k.modl = modl; k.tb = tb; k.G = F.G; k.vcu = F.vcu;
                gm::gemm_phase<gm::K5>(F.lds, k);
            }
        }
        SEAM(pb + 7);
        if (IN(pb + 8) && PHON(9)) {
            PHASE_IDS();
            const int b = F.vcu >> 5; const bool lastl = (l == DEPTH - 1);
            const float* md = MOD + ((size_t)(lastl ? l : l + 1) * NB + b) * 6144;
            const float* lg = args.in[I_LN2G] + l * DM; const float* lb = args.in[I_LN2B] + l * DM;
            f32x4 gv[4], bv[4], sh[4], sc[4];
#pragma unroll
            for (int j = 0; j < 4; ++j) { const int cix = 4 * lane + 256 * j; gv[j] = *(const f32x4*)(lg + cix); bv[j] = *(const f32x4*)(lb + cix); sh[j] = *(const f32x4*)(md + cix); sc[j] = *(const f32x4*)(md + 1024 + cix) + 1.0f; }
            float* dst = lastl ? args.out : XR;
            for (int i = 0; i < 16; ++i) { const int row = F.vcu * 128 + wid * 16 + i;
                f32x4 v[4]; float s = 0.f;
#pragma unroll
                for (int j = 0; j < 4; ++j) { v[j] = *(const f32x4*)(XR + (size_t)row * DM + 4 * lane + 256 * j); s += (v[j][0] + v[j][1]) + (v[j][2] + v[j][3]); }
                const float mean = wave_sum(s) * (1.f / DM); float s2 = 0.f;
#pragma unroll
                for (int j = 0; j < 4; ++j) { v[j] = v[j] - mean; s2 += (v[j][0] * v[j][0] + v[j][1] * v[j][1]) + (v[j][2] * v[j][2] + v[j][3] * v[j][3]); }
                const float rstd = 1.f / sqrtf(wave_sum(s2) * (1.f / DM) + LN_EPS);
#pragma unroll
                for (int j = 0; j < 4; ++j) { const f32x4 xn = v[j] * rstd * gv[j] + bv[j]; *(f32x4*)(dst + (size_t)row * DM + 4 * lane + 256 * j) = xn;
                    if (!lastl) { const f32x4 u = xn * sc[j] + sh[j]; u32x2 w; w.x = pk2(u[0], u[1]); w.y = pk2(u[2], u[3]); *(u32x2*)(UB + (size_t)row * DM + 4 * lane + 256 * j) = w; } }
            }
        }
        SEAM(pb + 8);
    }
#undef IN
#undef SEAM
}

extern "C" void kernel_launch(void* const* d_in, const int* in_sizes, int n_in, void* d_out, int out_size, void* d_ws, size_t ws_size, hipStream_t stream) {
    static int grid = 0;
    if (grid == 0) {
        if (n_in != 29 || in_sizes[0] != NTOK * DM || out_size != NTOK * DM || ws_size < WS_END) {
            fprintf(stderr, "kernel_launch: unexpected shapes (n_in %d, in0 %d, out %d, ws %zu need %zu); nothing launched\n", n_in, n_in > 0 ? in_sizes[0] : -1, out_size, ws_size, (size_t)WS_END); grid = -1; return; }
        int dev = 0, cus = 0, per_cu = 0;
        if (hipGetDevice(&dev) != hipSuccess || hipDeviceGetAttribute(&cus, hipDeviceAttributeMultiprocessorCount, dev) != hipSuccess) { grid = -1; return; }
        if (hipFuncSetAttribute((const void*)mega_fwd, hipFuncAttributeMaxDynamicSharedMemorySize, LDS_BYTES) != hipSuccess) { fprintf(stderr, "kernel_launch: hipFuncSetAttribute failed\n"); grid = -1; return; }
        if (hipOccupancyMaxActiveBlocksPerMultiprocessor(&per_cu, (const void*)mega_fwd, 512, LDS_BYTES) != hipSuccess || per_cu < 1) { fprintf(stderr, "kernel_launch: occupancy query reports %d\n", per_cu); }
        (void)hipGetLastError();
        grid = cus;
        if (grid != 256) fprintf(stderr, "kernel_launch: %d CUs (row phases assume 256)\n", grid);
    }
    if (grid < 0) return;
    if (hipMemsetAsync((char*)d_ws + WS_CTL, 0, CTL_ZERO_BYTES, stream) != hipSuccess) return;
    Args a{};
    for (int i = 0; i < 29; ++i) a.in[i] = (const float*)d_in[i];
    a.out = (float*)d_out; a.ws = (unsigned char*)d_ws;
#if MK_ONE_LAUNCH
    a.ph_lo = 0; a.ph_hi = N_PHASES;
    hipLaunchKernelGGL(mega_fwd, dim3(grid), dim3(512), LDS_BYTES, stream, a);
#else
    for (int p = 0; p < N_PHASES; ++p) { a.ph_lo = p; a.ph_hi = p + 1; hipLaunchKernelGGL(mega_fwd, dim3(grid), dim3(512), LDS_BYTES, stream, a); }
#endif
}
```

```cpp
#include <hip/hip_runtime.h>
#include <hip/hip_bf16.h>
#include <cstdio>
#include <cstdint>
#include <cmath>

#ifndef MK_ONE_LAUNCH
#define MK_ONE_LAUNCH 1
#endif
#ifndef PHM
#define PHM 0xFFFF
#endif
#define PHON(n) (((PHM) >> (n)) & 1)
#ifndef REPM
#define REPM 0x3
#endif
#define NREP(n) ((((REPM) >> (n)) & 1) ? 2 : 1)

#define LAS __attribute__((address_space(3)))
#define GAS __attribute__((address_space(1)))
typedef unsigned short bf16_t;
typedef short bf16x8 __attribute__((ext_vector_type(8)));
typedef float f32x4 __attribute__((ext_vector_type(4)));
typedef float f32x2 __attribute__((ext_vector_type(2)));
typedef unsigned u32x4 __attribute__((ext_vector_type(4)));
typedef unsigned u32x2 __attribute__((ext_vector_type(2)));
typedef GAS unsigned gu32;

constexpr int NB = 8, SEQ = 4096, NTOK = NB * SEQ, DM = 1024, DEPTH = 4, NH = 4, HD = 64, PIN = 3608, PP = 3584, PW = 3840, NE = 16, DE = 512;
constexpr int NCH = SEQ / 64;
constexpr float ALPHA = 1.6817928305074290f;
constexpr float LN_EPS = 1e-6f;
constexpr float ATT_C2 = 0.17677669529663687f * 1.4426950408889634f;
constexpr int NBUCKET = 24, LCAP = NTOK;
constexpr int C_MQ = 0, C_MK = 256, C_MV = 512, C_MO = 768, C_CB = 1024, C_CC = 1280, C_CH = 1536, C_DQ = 1792, C_DK = 2048, C_DV = 2304,
              C_GQ = 2560, C_GK = 2816, C_GV = 3072, C_GR = 3328;
constexpr int T_GA = 0, T_MI = 16, T_MF = 20;

constexpr size_t MiB = 1u << 20;
constexpr size_t WS_CTL = 0, CTL_ZERO_BYTES = 1 * MiB;
constexpr size_t WS_MOD = 1 * MiB;
constexpr size_t WS_ROPE = 2 * MiB;
constexpr size_t WS_WIN = 3 * MiB;
constexpr size_t WS_WOUT = 33 * MiB;
constexpr size_t WS_WGU = 41 * MiB;
constexpr size_t WS_WD = 73 * MiB;
constexpr size_t WS_LTOK = 89 * MiB;
constexpr size_t WS_LGATE = 92 * MiB;
constexpr size_t WS_SM = 98 * MiB;
constexpr size_t WS_PROJ = 100 * MiB;
constexpr size_t WS_XR = 340 * MiB;
constexpr size_t WS_U = 468 * MiB;
constexpr size_t WS_YCAT = 532 * MiB;
constexpr size_t WS_TAIL = 596 * MiB;
constexpr size_t WS_YSORT = WS_PROJ + 100 * MiB;
constexpr size_t WS_END = 600 * MiB;
constexpr size_t SM_N = 0, SM_BC = 512 * 1024, SM_DM = 520 * 1024, SM_MS = 528 * 1024, SM_GBE = 1 * MiB, SM_TS = 1536 * 1024;
constexpr int CW_TMO = 0, CW_CODE = 1, CW_ZPAGE = 256, CW_BAR = 4096, CW_CNT = 16384;
constexpr int RING_BYTES = 131072, LDSCTL_OFF = RING_BYTES, MISC_OFF = LDSCTL_OFF + 320, MOE_TB_OFF = LDSCTL_OFF + 1024, LDS_BYTES = 147456;

#define RLX_AGENT __ATOMIC_RELAXED, __HIP_MEMORY_SCOPE_AGENT
#define LDS_WAIT() asm volatile("s_waitcnt lgkmcnt(0)" ::: "memory")
#define VM_WAIT() asm volatile("s_waitcnt vmcnt(0)" ::: "memory")

__device__ __forceinline__ unsigned f2bf(float f) { unsigned u = __builtin_bit_cast(unsigned, f); return (u + 0x7fffu + ((u >> 16) & 1u)) >> 16; }
__device__ __forceinline__ unsigned pk2(float lo, float hi) { typedef __bf16 bf2 __attribute__((ext_vector_type(2))); f32x2 v = {lo, hi}; bf2 b = __builtin_convertvector(v, bf2); return __builtin_bit_cast(unsigned, b); }
__device__ __forceinline__ float bf2f(unsigned b) { return __builtin_bit_cast(float, b << 16); }
__device__ __forceinline__ float bflo(unsigned w) { return __builtin_bit_cast(float, w << 16); }
__device__ __forceinline__ float bfhi(unsigned w) { return __builtin_bit_cast(float, w & 0xffff0000u); }
__device__ __forceinline__ float wave_sum(float v) {
#pragma unroll
    for (int o = 1; o < 64; o <<= 1) v += __shfl_xor(v, o);
    return v;
}
__device__ __forceinline__ float wave_max(float v) {
#pragma unroll
    for (int o = 1; o < 64; o <<= 1) v = fmaxf(v, __shfl_xor(v, o));
    return v;
}
__device__ __forceinline__ float logsig(float z) { return fminf(z, 0.f) - __logf(1.f + __expf(-fabsf(z))); }
__device__ __forceinline__ float sigmoidf_(float z) { return 1.f / (1.f + __expf(-z)); }

#define XB_TMO      128
#define XB_XCNT(j)  (256  + 64 * (j))
#define XB_XSUB(j)  (1280 + 64 * (j))
#define XB_XGEN(j)  (2304 + 64 * (j))
#define XB_TOP      3328
#define XB_TOPGEN   3392
#define XCD_BAR_WORDS 3456
#define XB_SPIN_CAP (1u << 18)
__device__ __forceinline__ unsigned xb_ld(unsigned* p)              { return __hip_atomic_load(p, __ATOMIC_RELAXED, __HIP_MEMORY_SCOPE_AGENT); }
__device__ __forceinline__ unsigned xb_add(unsigned* p, unsigned v) { return __hip_atomic_fetch_add(p, v, __ATOMIC_RELAXED, __HIP_MEMORY_SCOPE_AGENT); }
__device__ __forceinline__ unsigned xb_xcc_id() { return (unsigned)__builtin_amdgcn_s_getreg((3 << 11) | 20) & 0xFu; }
#define XB_SPIN(cond, bar) do { unsigned _sp = 0; while (cond) { __builtin_amdgcn_s_sleep(1); \
    if ((++_sp & 255u) == 0u) { if (xb_ld(&(bar)[XB_TMO])) break; if (_sp > XB_SPIN_CAP) { atomicAdd(&(bar)[XB_TMO], 1u); break; } } } } while (0)
struct XcdBarrier { unsigned* bar; unsigned x; volatile LAS unsigned* st; };
__device__ __forceinline__ XcdBarrier xcd_barrier_post(unsigned* bar, volatile LAS unsigned* st) {
    XcdBarrier b; b.bar = bar; b.x = xb_xcc_id(); b.st = st;
    if (threadIdx.x == 0) (void)xb_add(&bar[XB_XCNT(b.x)], 1u);
    return b;
}
__device__ __forceinline__ void xcd_barrier_complete(unsigned* bar, unsigned x, unsigned& nloc, unsigned& nx) {
    const unsigned G = gridDim.x * gridDim.y * gridDim.z;
    unsigned sum, cnt, mine, sp = 0u;
    for (;;) {
        sum = 0u; cnt = 0u; mine = 0u;
#pragma unroll
        for (unsigned j = 0; j < 16; ++j) { const unsigned c = xb_ld(&bar[XB_XCNT(j)]); sum += c; cnt += (c > 0u) ? 1u : 0u; mine = (j == x) ? c : mine; }
        if (sum == G) break;
        __builtin_amdgcn_s_sleep(1);
        if ((++sp & 255u) == 0u) { if (xb_ld(&bar[XB_TMO])) break; if (sp > XB_SPIN_CAP) { atomicAdd(&bar[XB_TMO], 1u); break; } }
    }
    nloc = mine > 0u ? mine : 1u; nx = cnt > 0u ? cnt : 1u;
}
__device__ __forceinline__ void xcd_barrier(const XcdBarrier& b) {
    asm volatile("s_waitcnt vmcnt(0)" ::: "memory");
    __syncthreads();
    if (threadIdx.x == 0) {
        unsigned* bar = b.bar;
        __builtin_amdgcn_s_waitcnt(0);
        unsigned nloc = b.st[0], nx = b.st[1];
        if (nloc == 0u) { xcd_barrier_complete(bar, b.x, nloc, nx); b.st[0] = nloc; b.st[1] = nx; }
        const unsigned old = xb_add(&bar[XB_XSUB(b.x)], 1u);
        const unsigned gen = old / nloc;
        if (old + 1u == (gen + 1u) * nloc) {
            __builtin_amdgcn_fence(__ATOMIC_RELEASE, "agent");
            asm volatile("s_waitcnt vmcnt(0)" ::: "memory");
            const unsigned og = xb_add(&bar[XB_TOP], 1u);
            const unsigned tg = og / nx;
            if (og + 1u == (tg + 1u) * nx) xb_add(&bar[XB_TOPGEN], 1u);
            else XB_SPIN(xb_ld(&bar[XB_TOPGEN]) == tg, bar);
            __builtin_amdgcn_fence(__ATOMIC_ACQUIRE, "agent");
            xb_add(&bar[XB_XGEN(b.x)], 1u);
            asm volatile("s_waitcnt vmcnt(0)" ::: "memory");
        } else {
            XB_SPIN(xb_ld(&bar[XB_XGEN(b.x)]) == gen, bar);
            __builtin_amdgcn_fence(__ATOMIC_ACQUIRE, "agent");
            asm volatile("s_waitcnt vmcnt(0)" ::: "memory");
        }
    }
    __syncthreads();
}

namespace gm {
constexpr int BM = 256, BK = 64, HALF = 128, HTB = HALF * BK * 2, NT = 16, NXCD = 8, WGM = 8;
__host__ __device__ __forceinline__ int lds_byte(int r, int c) { const int st = (r >> 4) * 2 + (c >> 5), rr = r & 15, cc = c & 31, ob = rr * 64 + cc * 2; return st * 1024 + (ob ^ (((ob >> 9) & 1) << 5)); }
__host__ __device__ __forceinline__ void stage_rc(int b, int& R, int& C) { const int st = b / 1024, sb = b % 1024, swz = sb ^ (((sb >> 9) & 1) << 5); R = (st >> 1) * 16 + swz / 64; C = (st & 1) * 32 + (swz % 64) / 2; }
__host__ __device__ __forceinline__ int perm32(int rho) { const int n = rho >> 4, i = rho & 15; return 8 * (i >> 2) + 4 * n + (i & 3); }
struct Unit { int pm, pn, bk, tb; };
struct Src { const char* a; const char* b0; const char* b1; unsigned va[2][2]; };
struct StaticOrder {
    int nM, nN, nwg, G, c;
    __device__ void init(int M, int N, int G_, int c_) { nM = M / BM; nN = N / BM; nwg = nM * nN; G = G_; c = c_; }
    __device__ __forceinline__ bool next(int i, Unit& u) const {
        const long L = (long)i * G + c; if (L >= nwg) return false;
        int wgid = (int)L; { const int q = nwg / NXCD, r = nwg % NXCD, xcd = wgid % NXCD, off = wgid / NXCD; wgid = (xcd < r ? xcd * (q + 1) : r * (q + 1) + (xcd - r) * q) + off; }
        const int nig = WGM * nN, gid = wgid / nig, fm = gid * WGM, gsz = (nM - fm) < WGM ? (nM - fm) : WGM;
        u.pm = fm + ((wgid % nig) % gsz); u.pn = (wgid % nig) / gsz; u.bk = 0; u.tb = 0; return true;
    }
};

template <class Kind>
__device__ __forceinline__ void gemm_phase(LAS unsigned char* lds, const Kind& Kd) {
    int tid_ = threadIdx.x; asm volatile("" : "+v"(tid_));
    const int tid = tid_, wid = __builtin_amdgcn_readfirstlane(tid >> 6), lane = tid & 63, wr = wid >> 2, wc = wid & 3, fr = lane & 15, fq = lane >> 4;
    int R[2], C[2]; unsigned voffB[2];
#pragma unroll
    for (int i = 0; i < 2; ++i) { stage_rc(tid * 16 + i * 8192, R[i], C[i]); const int Rb = Kind::PERM ? ((R[i] & ~31) + perm32(R[i] & 31)) : R[i]; voffB[i] = (unsigned)(Rb * Kind::LDB + C[i]) * 2u; }
    const size_t hstepB = (size_t)HALF * Kind::LDB * 2;
    const unsigned ldsw = (unsigned)wid * 1024u;
    const int aoff = lds_byte(wr * 64 + fr, fq * 8), boff = lds_byte(wc * 32 + fr, fq * 8);
#define G_SA(b, h) (((b) * 2 + (h)) * HTB)
#define G_SB(b, h) ((4 + (b) * 2 + (h)) * HTB)
#define G_STAGE_A(bufoff, S, t, h) do { const char* _g = (S).a + (size_t)(t) * 128; _Pragma("unroll") for (int _i = 0; _i < 2; ++_i) \
        __builtin_amdgcn_global_load_lds((const unsigned*)(_g + (S).va[h][_i]), (LAS unsigned*)(lds + (bufoff) + ldsw + _i * 8192), 16, 0, 0); } while (0)
#define G_STAGE_B(bufoff, S, t, h) do { const char* _g = (((t) < 8) ? (S).b0 + (size_t)(t) * 128 : (S).b1 + (size_t)((t) - 8) * 128) + (h) * hstepB; _Pragma("unroll") for (int _i = 0; _i < 2; ++_i) \
        __builtin_amdgcn_global_load_lds((const unsigned*)(_g + voffB[_i]), (LAS unsigned*)(lds + (bufoff) + ldsw + _i * 8192), 16, 0, 0); } while (0)
#define G_LDA(dst, b, h) do { _Pragma("unroll") for (int m = 0; m < 4; ++m) _Pragma("unroll") for (int k = 0; k < 2; ++k) dst[m][k] = *(const LAS bf16x8*)(lds + G_SA(b, h) + aoff + m * 2048 + k * 1024); } while (0)
#define G_LDB(dst, b, h) do { _Pragma("unroll") for (int n = 0; n < 2; ++n) _Pragma("unroll") for (int k = 0; k < 2; ++k) dst[n][k] = *(const LAS bf16x8*)(lds + G_SB(b, h) + boff + n * 2048 + k * 1024); } while (0)
#define G_MMA(ai, bj, At, Bt) do { __builtin_amdgcn_s_setprio(1); _Pragma("unroll") for (int m = 0; m < 4; ++m) _Pragma("unroll") for (int n = 0; n < 2; ++n) _Pragma("unroll") for (int k = 0; k < 2; ++k) \
        acc[ai][bj][m][n] = __builtin_amdgcn_mfma_f32_16x16x32_bf16(Bt[n][k], At[m][k], acc[ai][bj][m][n], 0, 0, 0); __builtin_amdgcn_s_setprio(0); } while (0)
#define G_WAIT_V(n) asm volatile("s_waitcnt vmcnt(" #n ")" ::: "memory")
#define G_WAIT_L(n) asm volatile("s_waitcnt lgkmcnt(" #n ")" ::: "memory")
#define G_BAR __builtin_amdgcn_s_barrier()
#define G_SCHED __builtin_amdgcn_sched_barrier(0)
    Unit cur, nxt; Src sc, sn; int ui = 0;
    if (!Kd.next(0, cur)) return;
    Kd.src(cur, sc, R, C);
    f32x4 acc[2][2][4][2];
#pragma unroll
    for (int a = 0; a < 2; ++a)
#pragma unroll
        for (int b = 0; b < 2; ++b)
#pragma unroll
            for (int m = 0; m < 4; ++m)
#pragma unroll
                for (int n = 0; n < 2; ++n) acc[a][b][m][n] = (f32x4){0.f, 0.f, 0.f, 0.f};
    bf16x8 At[4][2], B0[2][2], B1[2][2];
    G_STAGE_B(G_SB(0, 0), sc, 0, 0); G_STAGE_B(G_SB(0, 1), sc, 0, 1); G_STAGE_A(G_SA(0, 0), sc, 0, 0); G_STAGE_A(G_SA(0, 1), sc, 0, 1);
    if (wr == 1) G_BAR;
    G_WAIT_V(2); G_BAR;
    G_STAGE_B(G_SB(1, 0), sc, 1, 0); G_STAGE_A(G_SA(1, 0), sc, 1, 0); G_STAGE_B(G_SB(1, 1), sc, 1, 1);
    G_WAIT_V(6); G_BAR;
    for (;;) {
        const bool has_next = Kd.next(ui + 1, nxt);
        if (has_next) Kd.src(nxt, sn, R, C); else sn = sc;
        for (int t = 0; t < NT; t += 2) {
            const bool last = (t == NT - 2);
            Src s2; s2.a = last ? sn.a : sc.a; s2.b0 = last ? sn.b0 : sc.b0; s2.b1 = last ? sn.b1 : sc.b1;
            s2.va[0][0] = last ? sn.va[0][0] : sc.va[0][0]; s2.va[0][1] = last ? sn.va[0][1] : sc.va[0][1]; s2.va[1][0] = last ? sn.va[1][0] : sc.va[1][0]; s2.va[1][1] = last ? sn.va[1][1] : sc.va[1][1];
            const int t2 = last ? 0 : t + 2, t3 = t2 + 1;
            G_LDB(B0, 0, 0); G_LDB(B1, 0, 1); G_SCHED; G_LDA(At, 0, 0); G_STAGE_A(G_SA(1, 1), sc, t + 1, 1);
            G_WAIT_V(8); G_WAIT_L(0); G_BAR; G_MMA(0, 0, At, B0); G_MMA(0, 1, At, B1); G_BAR; G_SCHED;
            G_LDA(At, 0, 1); G_STAGE_B(G_SB(0, 0), s2, t2, 0); G_STAGE_B(G_SB(0, 1), s2, t2, 1); G_STAGE_A(G_SA(0, 0), s2, t2, 0);
            G_WAIT_V(8); G_WAIT_L(0); G_BAR; G_MMA(1, 0, At, B0); G_MMA(1, 1, At, B1); G_BAR; G_SCHED;
            G_LDB(B0, 1, 0); G_LDB(B1, 1, 1); G_SCHED; G_LDA(At, 1, 0); G_STAGE_A(G_SA(0, 1), s2, t2, 1);
            G_WAIT_V(8); G_WAIT_L(0); G_BAR; G_MMA(0, 0, At, B0); G_MMA(0, 1, At, B1); G_BAR; G_SCHED;
            G_LDA(At, 1, 1); G_STAGE_B(G_SB(1, 0), s2, t3, 0); G_STAGE_B(G_SB(1, 1), s2, t3, 1); G_STAGE_A(G_SA(1, 0), s2, t3, 0);
            G_WAIT_V(8); G_WAIT_L(0); G_BAR; G_MMA(1, 0, At, B0); G_MMA(1, 1, At, B1); G_BAR; G_SCHED;
        }
        if (wr == 0) G_BAR;
        Kd.epi(acc, cur, wr, wc, fr, fq);
        if (!has_next) break;
#pragma unroll
        for (int a = 0; a < 2; ++a)
#pragma unroll
            for (int b = 0; b < 2; ++b)
#pragma unroll
                for (int m = 0; m < 4; ++m)
#pragma unroll
                    for (int n = 0; n < 2; ++n) acc[a][b][m][n] = (f32x4){0.f, 0.f, 0.f, 0.f};
        cur = nxt; sc = sn; ++ui;
        if (wr == 1) G_BAR;
    }
    G_WAIT_V(0);
    G_BAR;
#undef G_SA
#undef G_SB
#undef G_STAGE_A
#undef G_STAGE_B
#undef G_LDA
#undef G_LDB
#undef G_MMA
#undef G_WAIT_V
#undef G_WAIT_L
#undef G_BAR
#undef G_SCHED
}

__device__ __forceinline__ void src_direct(Src& s, const bf16_t* A, int row0, const int (&R)[2], const int (&C)[2]) {
    s.a = (const char*)(A + (size_t)row0 * 1024);
#pragma unroll
    for (int h = 0; h < 2; ++h)
#pragma unroll
        for (int i = 0; i < 2; ++i) s.va[h][i] = (unsigned)((h * HALF + R[i]) * 1024 + C[i]) * 2u;
}

struct K1 {
    static constexpr bool PERM = true; static constexpr int LDB = 1024;
    StaticOrder S; const bf16_t* A; const bf16_t* Bt; bf16_t* O; const float* rope;
    __device__ __forceinline__ bool next(int i, Unit& u) const { return S.next(i, u); }
    __device__ __forceinline__ void src(const Unit& u, Src& s, const int (&R)[2], const int (&C)[2]) const {
        src_direct(s, A, u.pm * BM, R, C); s.b0 = (const char*)(Bt + (size_t)u.pn * BM * 1024); s.b1 = s.b0 + 1024;
    }
    __device__ __forceinline__ void epi(const f32x4 (&acc)[2][2][4][2], const Unit& u, int wr, int wc, int fr, int fq) const {
        const int row0 = u.pm * BM + wr * 64 + fr, col0 = u.pn * BM + wc * 32 + 8 * fq;
        const int ty = (u.pn == 0 || u.pn == 10) ? 1 : (u.pn == 7) ? 2 : (u.pn == 8) ? 3 : 0;
#pragma unroll
        for (int ai = 0; ai < 2; ++ai)
#pragma unroll
            for (int m = 0; m < 4; ++m) {
                const int row = row0 + ai * HALF + m * 16;
                f32x4 cs = (f32x4){1.f, 1.f, 1.f, 1.f}, sn = (f32x4){0.f, 0.f, 0.f, 0.f};
                if (ty >= 2) { cs = *(const f32x4*)(rope + (size_t)row * 8); sn = *(const f32x4*)(rope + (size_t)row * 8 + 4); }
                bf16_t* rowp = O + (size_t)row * PP + col0;
#pragma unroll
                for (int bj = 0; bj < 2; ++bj) {
                    f32x4 v0 = acc[ai][bj][m][0], v1 = acc[ai][bj][m][1];
                    if (ty == 1) { v0 = v0 * 0.125f; v1 = v1 * 0.125f; }
                    if (ty >= 2) {
                        if (fq == 0) { const f32x4 x1 = v0, x2 = v1; v0 = x1 * cs - x2 * sn; v1 = x2 * cs + x1 * sn; }
                        if (ty == 2) { v0 = v0 * ATT_C2; v1 = v1 * ATT_C2; }
                    }
                    u32x4 w; w.x = pk2(v0[0], v0[1]); w.y = pk2(v0[2], v0[3]); w.z = pk2(v1[0], v1[1]); w.w = pk2(v1[2], v1[3]);
                    *(u32x4*)(rowp + bj * HALF) = w;
                }
            }
    }
};
struct K2 {
    static constexpr bool PERM = true; static constexpr int LDB = 1024;
    StaticOrder S; const bf16_t* A; const bf16_t* Bt; bf16_t* O;
    __device__ __forceinline__ bool next(int i, Unit& u) const { return S.next(i, u); }
    __device__ __forceinline__ void src(const Unit& u, Src& s, const int (&R)[2], const int (&C)[2]) const {
        src_direct(s, A, u.pm * BM, R, C); s.b0 = (const char*)(Bt + (size_t)u.pn * BM * 1024); s.b1 = s.b0 + 1024;
    }
    __device__ __forceinline__ void epi(const f32x4 (&acc)[2][2][4][2], const Unit& u, int wr, int wc, int fr, int fq) const {
        const int row0 = u.pm * BM + wr * 64 + fr, col0 = u.pn * BM + wc * 32 + 8 * fq;
#pragma unroll
        for (int ai = 0; ai < 2; ++ai)
#pragma unroll
            for (int m = 0; m < 4; ++m) { bf16_t* rowp = O + (size_t)(row0 + ai * HALF + m * 16) * DM + col0;
#pragma unroll
                for (int bj = 0; bj < 2; ++bj) { const f32x4 v0 = acc[ai][bj][m][0], v1 = acc[ai][bj][m][1];
                    u32x4 w; w.x = pk2(v0[0], v0[1]); w.y = pk2(v0[2], v0[3]); w.z = pk2(v1[0], v1[1]); w.w = pk2(v1[2], v1[3]);
                    *(u32x4*)(rowp + bj * HALF) = w; } }
    }
};
__device__ __forceinline__ int pair_i(int p) { return p < 3 ? 0 : (p < 5 ? 1 : 2); }
__device__ __forceinline__ int pair_j(int p) { return p < 3 ? p + 1 : (p < 5 ? p - 1 : 3); }
struct K4 {
    static constexpr bool PERM = true; static constexpr int LDB = 1024;
    const bf16_t* U; const bf16_t* Wgu; bf16_t* H; const int* ltok; const float* lgate; const LAS int* tb; int G, vcu;
    __device__ __forceinline__ bool next(int i, Unit& u) const {
        const int L = i * G + vcu; const int nt = tb[32 + NBUCKET]; if (L >= nt * 8) return false;
        const int rt = L >> 3; int k = 0;
        for (int q = 1; q < NBUCKET; ++q) k = (tb[32 + q] <= rt) ? q : k;
        u.pm = rt; u.pn = L & 7; u.bk = k; u.tb = rt - tb[32 + k]; return true;
    }
    __device__ __forceinline__ void src(const Unit& u, Src& s, const int (&R)[2], const int (&C)[2]) const {
        const int cnt = tb[u.bk]; s.a = (const char*)U;
#pragma unroll
        for (int h = 0; h < 2; ++h)
#pragma unroll
            for (int i = 0; i < 2; ++i) { const int pos = u.tb * BM + h * HALF + R[i]; const int tok = ltok[(size_t)u.bk * LCAP + (pos < cnt ? pos : 0)]; s.va[h][i] = (unsigned)(tok * 1024 + C[i]) * 2u; }
        const int grp = u.bk / 6, p = u.bk % 6, sl = u.pn >> 2; const int e = grp * 4 + (sl ? pair_j(p) : pair_i(p));
        s.b0 = (const char*)(Wgu + ((size_t)e * 1024 + (size_t)(u.pn & 3) * BM) * 1024); s.b1 = s.b0 + 1024;
    }
    __device__ __forceinline__ void epi(const f32x4 (&acc)[2][2][4][2], const Unit& u, int wr, int wc, int fr, int fq) const {
        const int cnt = tb[u.bk], sl = u.pn >> 2; const int colo = sl * 512 + (u.pn & 3) * 128 + wc * 32 + 8 * fq;
#pragma unroll
        for (int ai = 0; ai < 2; ++ai)
#pragma unroll
            for (int m = 0; m < 4; ++m) {
                const int r = ai * HALF + wr * 64 + m * 16 + fr, pos = u.tb * BM + r;
                const float gt = (pos < cnt) ? lgate[((size_t)u.bk * LCAP + pos) * 2 + sl] : 0.f;
                float hv[8];
#pragma unroll
                for (int n = 0; n < 2; ++n)
#pragma unroll
                    for (int j = 0; j < 4; ++j) { const float g = acc[ai][0][m][n][j], up = acc[ai][1][m][n][j]; hv[n * 4 + j] = g * __builtin_amdgcn_rcpf(1.f + __expf(-g)) * up * gt; }
                u32x4 w; w.x = pk2(hv[0], hv[1]); w.y = pk2(hv[2], hv[3]); w.z = pk2(hv[4], hv[5]); w.w = pk2(hv[6], hv[7]);
                *(u32x4*)(H + (size_t)(u.pm * BM + r) * 1024 + colo) = w;
            }
    }
};
struct K5 {
    static constexpr bool PERM = true; static constexpr int LDB = 512;
    const bf16_t* H; const bf16_t* Wd; bf16_t* Y; const LAS int* tb; int G, vcu;
    __device__ __forceinline__ bool next(int i, Unit& u) const {
        const int L = i * G + vcu; const int nt = tb[32 + NBUCKET]; if (L >= nt * 4) return false;
        const int rt = L >> 2; int k = 0;
        for (int q = 1; q < NBUCKET; ++q) k = (tb[32 + q] <= rt) ? q : k;
        u.pm = rt; u.pn = L & 3; u.bk = k; u.tb = rt - tb[32 + k]; return true;
    }
    __device__ __forceinline__ void src(const Unit& u, Src& s, const int (&R)[2], const int (&C)[2]) const {
        src_direct(s, H, u.pm * BM, R, C);
        const int grp = u.bk / 6, p = u.bk % 6;
        s.b0 = (const char*)(Wd + ((size_t)(grp * 4 + pair_i(p)) * 1024 + (size_t)u.pn * BM) * 512);
        s.b1 = (const char*)(Wd + ((size_t)(grp * 4 + pair_j(p)) * 1024 + (size_t)u.pn * BM) * 512);
    }
    __device__ __forceinline__ void epi(const f32x4 (&acc)[2][2][4][2], const Unit& u, int wr, int wc, int fr, int fq) const {
        const int row0 = u.pm * BM + wr * 64 + fr, col0 = u.pn * BM + wc * 32 + 8 * fq;
#pragma unroll
        for (int ai = 0; ai < 2; ++ai)
#pragma unroll
            for (int m = 0; m < 4; ++m) { bf16_t* rowp = Y + (size_t)(row0 + ai * HALF + m * 16) * DM + col0;
#pragma unroll
                for (int bj = 0; bj < 2; ++bj) { const f32x4 v0 = acc[ai][bj][m][0], v1 = acc[ai][bj][m][1];
                    u32x4 w; w.x = pk2(v0[0], v0[1]); w.y = pk2(v0[2], v0[3]); w.z = pk2(v1[0], v1[1]); w.w = pk2(v1[2], v1[3]);
                    *(u32x4*)(rowp + bj * HALF) = w; } }
    }
};
}

namespace attn_body {
using bf16 = __hip_bfloat16;
using s16x4 = __attribute__((ext_vector_type(4))) short;
using f32x16 = __attribute__((ext_vector_type(16))) float;
constexpr int D = 64, PITCH = PP;
constexpr int NW = 8, QBLK = 32, QB = QBLK * NW, KVBLK = 64;
__device__ __forceinline__ int crow(int r, int hi) { return (r & 3) + 8 * (r >> 2) + 4 * hi; }
#define SBAR() __builtin_amdgcn_sched_barrier(0)
__device__ __forceinline__ void cmask(f32x16& p0, f32x16& p1, int jb, int qrel, int hi) {
    const float NEG = -INFINITY; int kb = 64 * jb + 4 * hi;
#pragma unroll
    for (int r = 0; r < 16; ++r) { int kv = kb + (r & 3) + 8 * (r >> 2); if (kv > qrel) p0[r] = NEG; if (kv + 32 > qrel) p1[r] = NEG; }
}
constexpr int NSLOT = 3, SLOTB = 8192;
constexpr int LDS_K = 0, LDS_V = NSLOT * SLOTB, LDS_WS = 2 * NSLOT * SLOTB, LDS_OST = LDS_WS + NW * 64 * 4, ATT_LDS_BYTES = LDS_OST + NW * 8192;
__device__ __forceinline__ void glds16(const void* gsrc, unsigned lds_dst) { unsigned keep;
    asm volatile("s_mov_b32 %0, m0\n\ts_mov_b32 m0, %2\n\ts_nop 0\n\tglobal_load_lds_dwordx4 %1, off\n\ts_mov_b32 m0, %0" : "=&s"(keep) : "v"(gsrc), "s"(lds_dst) : "memory"); }
__device__ __forceinline__ float max3f(float a, float b, float c) { float r; asm("v_max3_f32 %0, %1, %2, %3" : "=v"(r) : "v"(a), "v"(b), "v"(c)); return r; }
__device__ __forceinline__ float max2f(float a, float b) { float r; asm("v_max_f32_e32 %0, %1, %2" : "=v"(r) : "v"(a), "v"(b)); return r; }
__device__ __forceinline__ float fadd_s(float a, float b) { float r; asm("v_add_f32_e32 %0, %1, %2" : "=v"(r) : "v"(a), "v"(b)); return r; }
__device__ __forceinline__ float fsub_s(float a, float b) { float r; asm("v_sub_f32_e32 %0, %1, %2" : "=v"(r) : "v"(a), "v"(b)); return r; }
typedef float f32x2_t __attribute__((ext_vector_type(2))); typedef __bf16 bf16x2_t __attribute__((ext_vector_type(2)));
__device__ __forceinline__ unsigned cvtpk_s(float lo, float hi) { f32x2_t v = {lo, hi}; bf16x2_t b = __builtin_convertvector(v, bf16x2_t); return __builtin_bit_cast(unsigned, b); }
#define WAIT_BAR(N) asm volatile("s_waitcnt vmcnt(" #N ") lgkmcnt(0)\n\ts_barrier" ::: "memory")
__device__ __forceinline__ void qkt(f32x16& p0, f32x16& p1, const char* Kslot, const bf16x8* qr, const f32x16& negm, int r32, int hi) {
    const char* kb = Kslot + hi * 1024 + r32 * 16;
#pragma unroll
    for (int d0 = 0; d0 < 2; ++d0) {
        const bf16x8 b0 = *reinterpret_cast<const bf16x8*>(kb + d0 * 2048);
        const bf16x8 b1 = *reinterpret_cast<const bf16x8*>(kb + d0 * 2048 + 512);
        if (d0 == 0) { p0 = __builtin_amdgcn_mfma_f32_32x32x16_bf16(b0, qr[0], negm, 0, 0, 0); p1 = __builtin_amdgcn_mfma_f32_32x32x16_bf16(b1, qr[0], negm, 0, 0, 0); }
        else { p0 = __builtin_amdgcn_mfma_f32_32x32x16_bf16(b0, qr[d0], p0, 0, 0, 0); p1 = __builtin_amdgcn_mfma_f32_32x32x16_bf16(b1, qr[d0], p1, 0, 0, 0); } }
}
typedef __attribute__((address_space(3))) const char* lds_cptr;
typedef short v4i16_t __attribute__((ext_vector_type(4)));
__device__ __forceinline__ void kload8(bf16x8* kf, lds_cptr kp) {
    kf[0] = *(const __attribute__((address_space(3))) bf16x8*)(kp);        kf[1] = *(const __attribute__((address_space(3))) bf16x8*)(kp + 512);
    kf[2] = *(const __attribute__((address_space(3))) bf16x8*)(kp + 2048); kf[3] = *(const __attribute__((address_space(3))) bf16x8*)(kp + 2560);
}
__device__ __forceinline__ void kload2(bf16x8* kf, lds_cptr kp, int j) { kf[2 * j] = *(const __attribute__((address_space(3))) bf16x8*)(kp + j * 2048); kf[2 * j + 1] = *(const __attribute__((address_space(3))) bf16x8*)(kp + j * 2048 + 512); }
__device__ __forceinline__ s16x4 vtr(lds_cptr p) { return __builtin_bit_cast(s16x4, __builtin_amdgcn_ds_read_tr16_b64_v4i16((__attribute__((address_space(3))) v4i16_t*)p)); }
__device__ __forceinline__ float rowmax(const f32x16& p0, const f32x16& p1) {
    float a = max3f(p0[0], p0[1], p1[0]), b = max3f(p0[2], p0[3], p1[1]); a = max3f(a, p1[2], p1[3]);
#pragma unroll
    for (int r = 4; r < 16; r += 4) { a = max3f(a, p0[r], p0[r + 1]); b = max3f(b, p0[r + 2], p0[r + 3]); a = max3f(a, p1[r], p1[r + 1]); b = max3f(b, p1[r + 2], p1[r + 3]); }
    const float m = max2f(a, b);
    auto rr = __builtin_amdgcn_permlane32_swap(__float_as_uint(m), __float_as_uint(m), false, false);
    return max2f(__uint_as_float(rr[0]), __uint_as_float(rr[1]));
}
__device__ __forceinline__ void pv(f32x16* o, int vb, bf16x8 pa0, bf16x8 pa1, bf16x8 pa2, bf16x8 pa3) {
#pragma unroll
    for (int d0 = 0; d0 < 2; ++d0) { s16x4 lo[4], hi[4];
#pragma unroll
        for (int ks = 0; ks < 4; ++ks) {
            asm volatile("ds_read_b64_tr_b16 %0,%1 offset:%c2" : "=&v"(lo[ks]) : "v"(vb), "i"(d0 * 4096 + ks * 1024) : "memory");
            asm volatile("ds_read_b64_tr_b16 %0,%1 offset:%c2" : "=&v"(hi[ks]) : "v"(vb), "i"(d0 * 4096 + ks * 1024 + 512) : "memory"); }
        asm volatile("s_waitcnt lgkmcnt(0)" ::: "memory"); SBAR();
#define PK(k) (bf16x8){lo[k][0], lo[k][1], lo[k][2], lo[k][3], hi[k][0], hi[k][1], hi[k][2], hi[k][3]}
        o[d0] = __builtin_amdgcn_mfma_f32_32x32x16_bf16(pa0, PK(0), o[d0], 0, 0, 0);
        o[d0] = __builtin_amdgcn_mfma_f32_32x32x16_bf16(pa1, PK(1), o[d0], 0, 0, 0);
        o[d0] = __builtin_amdgcn_mfma_f32_32x32x16_bf16(pa2, PK(2), o[d0], 0, 0, 0);
        o[d0] = __builtin_amdgcn_mfma_f32_32x32x16_bf16(pa3, PK(3), o[d0], 0, 0, 0);
#undef PK
    }
}
struct AttnParams { const bf16* Q; const bf16* K; const bf16* V; const bf16* zpage; bf16_t* Y; const float* gnorm; float lam, osc; };
template <int THRL, int comp> __device__ __forceinline__ void attn_unit(int b, int h, int qb, const AttnParams& P, char* shm) {
    const bf16* Q = P.Q; const bf16* __restrict__ K = P.K; const bf16* __restrict__ V = P.V;
    int tid_ = threadIdx.x; asm volatile("" : "+v"(tid_));
    const int tid = tid_, lane = tid & 63, r32 = lane & 31, hi = lane >> 5; const int wid = __builtin_amdgcn_readfirstlane(tid >> 6);
    const long rowbase = (long)b * SEQ; const int q0 = qb * QB;
    const bf16* Qw = Q + (rowbase + q0 + wid * QBLK) * PITCH + h * D;
    const bf16* Kh = K + rowbase * PITCH + h * D, *Vh = V + rowbase * PITCH + h * D;
    const unsigned lds0 = (unsigned)(uintptr_t)shm;
    float* wsf = (float*)(shm + LDS_WS) + wid * 64;
    const bf16* ksrc = Kh + (long)(32 * (wid & 1) + (lane & 31)) * PITCH + comp * 32 + (wid >> 1) * 8;
    const bf16* vsrc = Vh + (long)(16 * (wid & 3) + (lane >> 2)) * PITCH + (wid >> 2) * 32 + (lane & 3) * 8;
    const unsigned kdst = lds0 + LDS_K + (wid >> 1) * 1024 + (wid & 1) * 512, vdst = lds0 + LDS_V + wid * 1024;
#define DMA_K(t, slot) do { if (lane < 32) glds16(ksrc + (long)(t) * KVBLK * PITCH, (unsigned)__builtin_amdgcn_readfirstlane(kdst + (slot))); } while (0)
#define DMA_V(t, slot) glds16(vsrc + (long)(t) * KVBLK * PITCH, (unsigned)__builtin_amdgcn_readfirstlane(vdst + (slot)))
    const int vb0 = (int)(lds0 + LDS_V) + ((lane >> 4) & 1) * 32 + (lane & 3) * 8 + (4 * hi + ((lane & 15) >> 2)) * 64;
    const char* Kbase = shm + LDS_K; bf16x8 kf[4];
    const lds_cptr shm3 = (lds_cptr)shm; const lds_cptr kp0 = shm3 + LDS_K + hi * 1024 + r32 * 16; const lds_cptr vp0 = shm3 + LDS_V + ((lane >> 4) & 1) * 32 + (lane & 3) * 8 + (4 * hi + ((lane & 15) >> 2)) * 64;
    const int NT = (q0 + QB) / KVBLK;
    DMA_K(0, 0); DMA_V(0, 0); DMA_K(1, SLOTB);
    bf16x8 qr[2];
#pragma unroll
    for (int d0 = 0; d0 < 2; ++d0) qr[d0] = *reinterpret_cast<const bf16x8*>(&Qw[(long)r32 * PITCH + comp * 32 + d0 * 16 + hi * 8]);
    float mhat = 0.f, l_reg = 0.f; f32x16 o[2]; o[0] = f32x16{}; o[1] = f32x16{}; f32x16 negm = f32x16{}; asm volatile("" : "+v"(negm));
    const int qrel = wid * QBLK + r32;
#define CMASK(P0, P1, t) do { int jb_ = (t) - (NT - 4); if (jb_ >= 0) cmask(P0, P1, jb_, qrel, hi); } while (0)
    bool resc = false;
#define START(P0, P1) do { const float rm = rowmax(P0, P1); resc = false; \
    { const float dl = rm; mhat = fadd_s(mhat, dl); \
      _Pragma("unroll") for (int r = 0; r < 16; ++r) { P0[r] = fsub_s(P0[r], dl); P1[r] = fsub_s(P1[r], dl); } \
      _Pragma("unroll") for (int r = 0; r < 16; ++r) negm[r] = -mhat; asm volatile("" : "+v"(negm)); } \
    _Pragma("unroll") for (int r = 0; r < 16; ++r) P0[r] = __builtin_amdgcn_exp2f(P0[r]); } while (0)
#define RESC() do { if (resc) { asm volatile("s_waitcnt lgkmcnt(0)" ::: "memory"); \
      _Pragma("unroll") for (int d_ = 0; d_ < 2; ++d_) _Pragma("unroll") for (int r = 0; r < 16; ++r) o[d_][r] *= wsf[crow(r, hi)]; } } while (0)
    f32x16 pA0, pA1, pB0, pB1;
    int sl_prev = 0, sl_cur = 0, sl_next = SLOTB;
#define ROT() do { sl_prev = sl_cur; sl_cur = sl_next; sl_next = (sl_next == (NSLOT - 1) * SLOTB) ? 0 : sl_next + SLOTB; } while (0)
    DMA_K(2, 2 * SLOTB);
    WAIT_BAR(3);
    qkt(pA0, pA1, Kbase, qr, negm, r32, hi); asm volatile("s_nop 15\n\ts_nop 7" : "+v"(pA0), "+v"(pA1)); CMASK(pA0, pA1, 0);
    START(pA0, pA1);
    _Pragma("unroll") for (int r = 0; r < 16; ++r) pA1[r] = __builtin_amdgcn_exp2f(pA1[r]);
    WAIT_BAR(0);
    DMA_K(3, 0); DMA_V(1, SLOTB);
    ROT();
    kload8(kf, kp0 + sl_cur);
    WAIT_BAR(2);
    s16x4 vlo[8], vhi[8]; u32x4 pw0, pw1, pw2, pw3;
#define PKW(P, B) cvtpk_s(P[B], P[B + 1])
#define PAF(k) __builtin_bit_cast(bf16x8, pw##k)
#define VFR(i) (bf16x8){vlo[i][0], vlo[i][1], vlo[i][2], vlo[i][3], vhi[i][0], vhi[i][1], vhi[i][2], vhi[i][3]}
#define PIN(x) asm volatile("" : "+v"(x))
#define MX3(a, b, c) __builtin_fmaxf(__builtin_fmaxf((a), (b)), (c))
#define GAPA(MF, A0, A1, A2, A3, W0, W1, PW) do { MF; sacc += A0; sacc += A1; sacc += A2; sacc += A3; PIN(sacc); W0; W1; PIN(PW); SBAR(); } while (0)
#define EX(v) __builtin_amdgcn_exp2f(v)
#define GAPB(MF, X, B) do { MF; X[B] = EX(X[B]); X[B + 1] = EX(X[B + 1]); X[B + 2] = EX(X[B + 2]); X[B + 3] = EX(X[B + 3]); PIN(X); SBAR(); } while (0)
#define VRD(i) do { vlo[i] = vtr(vp_ + (((i) >> 2) * 4096 + ((i) & 3) * 1024)); vhi[i] = vtr(vp_ + (((i) >> 2) * 4096 + ((i) & 3) * 1024 + 512)); } while (0)
#define KRD(G, j) do { if (G) { kload2(kf, kp0 + sl_next, j); SBAR(); } } while (0)
#define STEP(C0, C1, P0, P1, t, GK, GV, GL) do { SBAR(); \
    const lds_cptr vp_ = vp0 + sl_prev; \
    VRD(0); SBAR(); float sacc = (P0[0] + P0[1]); \
    GAPA(C0 = __builtin_amdgcn_mfma_f32_32x32x16_bf16(kf[0], qr[0], negm, 0, 0, 0), P0[2], P0[3], P0[4], P0[5],     pw0[0] = PKW(P0, 0), pw0[1] = PKW(P0, 2), pw0); \
    VRD(4); SBAR(); GAPA(C1 = __builtin_amdgcn_mfma_f32_32x32x16_bf16(kf[1], qr[0], negm, 0, 0, 0), P0[6], P0[7], P0[8], P0[9],     pw0[2] = PKW(P0, 4), pw0[3] = PKW(P0, 6), pw0); \
    VRD(1); SBAR(); GAPA(C0 = __builtin_amdgcn_mfma_f32_32x32x16_bf16(kf[2], qr[1], C0, 0, 0, 0),   P0[10], P0[11], P0[12], P0[13], pw1[0] = PKW(P0, 8), pw1[1] = PKW(P0, 10), pw1); \
    VRD(5); SBAR(); GAPA(C1 = __builtin_amdgcn_mfma_f32_32x32x16_bf16(kf[3], qr[1], C1, 0, 0, 0),   P0[14], P0[15], P1[0], P1[1],   pw1[2] = PKW(P0, 12), pw1[3] = PKW(P0, 14), pw1); \
    VRD(2); SBAR(); GAPA(,   P1[2], P1[3], P1[4], P1[5],     pw2[0] = PKW(P1, 0), pw2[1] = PKW(P1, 2), pw2); \
    VRD(6); SBAR(); GAPA(,   P1[6], P1[7], P1[8], P1[9],     pw2[2] = PKW(P1, 4), pw2[3] = PKW(P1, 6), pw2); \
    VRD(3); SBAR(); GAPA(,   P1[10], P1[11], P1[12], P1[13], pw3[0] = PKW(P1, 8), pw3[1] = PKW(P1, 10), pw3); \
    VRD(7); SBAR(); GAPA(,   P1[14], P1[15], 0.f, 0.f,       pw3[2] = PKW(P1, 12), pw3[3] = PKW(P1, 14), pw3); \
    l_reg += sacc; \
    if (GK) { DMA_K((t) + 3, sl_cur); } if (GV) { DMA_V((t) + 1, sl_next); } \
    CMASK(C0, C1, t); \
    { float a = MX3(C0[0], C0[1], C1[0]), b = MX3(C0[2], C0[3], C1[1]); a = MX3(a, C1[2], C1[3]); \
      _Pragma("unroll") for (int r = 4; r < 16; r += 4) { a = MX3(a, C0[r], C0[r + 1]); b = MX3(b, C0[r + 2], C0[r + 3]); a = MX3(a, C1[r], C1[r + 1]); b = MX3(b, C1[r + 2], C1[r + 3]); } \
      float rm = __builtin_fmaxf(a, b); { auto rr = __builtin_amdgcn_permlane32_swap(__float_as_uint(rm), __float_as_uint(rm), false, false); rm = __builtin_fmaxf(__uint_as_float(rr[0]), __uint_as_float(rr[1])); } \
      resc = false; \
      if (__builtin_expect(__any(rm > (float)THRL), 0)) { const float dl = __builtin_fmaxf(rm, 0.f); mhat += dl; \
        _Pragma("unroll") for (int r = 0; r < 16; ++r) { C0[r] -= dl; C1[r] -= dl; } \
        _Pragma("unroll") for (int r = 0; r < 16; ++r) negm[r] = -mhat; asm volatile("" : "+v"(negm)); \
        const float f = __builtin_amdgcn_exp2f(-dl); l_reg *= f; if (hi == 0) wsf[r32] = f; resc = true; } } \
    SBAR(); \
    GAPB(o[0] = __builtin_amdgcn_mfma_f32_32x32x16_bf16(PAF(0), VFR(0), o[0], 0, 0, 0), C0, 0); \
    GAPB(o[1] = __builtin_amdgcn_mfma_f32_32x32x16_bf16(PAF(0), VFR(4), o[1], 0, 0, 0), C0, 4); \
    KRD(GL, 0); GAPB(o[0] = __builtin_amdgcn_mfma_f32_32x32x16_bf16(PAF(1), VFR(1), o[0], 0, 0, 0), C0, 8); \
    KRD(GL, 1); GAPB(o[1] = __builtin_amdgcn_mfma_f32_32x32x16_bf16(PAF(1), VFR(5), o[1], 0, 0, 0), C0, 12); \
    GAPB(o[0] = __builtin_amdgcn_mfma_f32_32x32x16_bf16(PAF(2), VFR(2), o[0], 0, 0, 0), C1, 0); \
    GAPB(o[1] = __builtin_amdgcn_mfma_f32_32x32x16_bf16(PAF(2), VFR(6), o[1], 0, 0, 0), C1, 4); \
    GAPB(o[0] = __builtin_amdgcn_mfma_f32_32x32x16_bf16(PAF(3), VFR(3), o[0], 0, 0, 0), C1, 8); \
    GAPB(o[1] = __builtin_amdgcn_mfma_f32_32x32x16_bf16(PAF(3), VFR(7), o[1], 0, 0, 0), C1, 12); \
    } while (0)
    int t = 1;
#undef CMASK
#define CMASK(P0, P1, t) do {} while (0)
    for (; t + 5 < NT; t += 2) {
        STEP(pB0, pB1, pA0, pA1, t, true, true, true);     WAIT_BAR(2); RESC(); ROT();
        STEP(pA0, pA1, pB0, pB1, t + 1, true, true, true); WAIT_BAR(2); RESC(); ROT();
    }
#undef CMASK
#define CMASK(P0, P1, t) do { int jb_ = (t) - (NT - 4); if (jb_ >= 0) cmask(P0, P1, jb_, qrel, hi); } while (0)
#define ENDW(tt) do { if ((tt) + 3 < NT) { WAIT_BAR(2); } else if ((tt) + 2 < NT) { WAIT_BAR(1); } else { WAIT_BAR(0); } } while (0)
    for (; t + 1 < NT; t += 2) {
        STEP(pB0, pB1, pA0, pA1, t, (t + 3 < NT), (t + 1 < NT), (t + 1 < NT));         ENDW(t);     RESC(); ROT();
        STEP(pA0, pA1, pB0, pB1, t + 1, (t + 4 < NT), (t + 2 < NT), (t + 2 < NT));     ENDW(t + 1); RESC(); ROT();
    }
    STEP(pB0, pB1, pA0, pA1, NT - 1, false, false, false); RESC();
    { float sacc = pB0[0] + pB0[1]; _Pragma("unroll") for (int r = 2; r < 16; ++r) sacc += pB0[r]; _Pragma("unroll") for (int r = 0; r < 16; ++r) sacc += pB1[r]; l_reg += sacc;
      pw0 = (u32x4){PKW(pB0, 0), PKW(pB0, 2), PKW(pB0, 4), PKW(pB0, 6)}; pw1 = (u32x4){PKW(pB0, 8), PKW(pB0, 10), PKW(pB0, 12), PKW(pB0, 14)}; pw2 = (u32x4){PKW(pB1, 0), PKW(pB1, 2), PKW(pB1, 4), PKW(pB1, 6)}; pw3 = (u32x4){PKW(pB1, 8), PKW(pB1, 10), PKW(pB1, 12), PKW(pB1, 14)};
      SBAR(); pv(o, vb0 + sl_cur, PAF(0), PAF(1), PAF(2), PAF(3)); }
#undef PKW
#undef PAF
#undef VFR
#undef PIN
#undef MX3
#undef GAPA
#undef GAPB
#undef EX
#undef VRD
#undef KRD
#undef STEP
#undef ENDW
    { auto rr = __builtin_amdgcn_permlane32_swap(__float_as_uint(l_reg), __float_as_uint(l_reg), false, false); l_reg = __uint_as_float(rr[0]) + __uint_as_float(rr[1]); }
    if (hi == 0) wsf[32 + r32] = l_reg; asm volatile("s_waitcnt lgkmcnt(0)" ::: "memory");
    float rli[16];
#pragma unroll
    for (int r = 0; r < 16; ++r) rli[r] = __builtin_amdgcn_rcpf(wsf[32 + crow(r, hi)]);
    float* stg = (float*)(shm + LDS_OST) + wid * 2048;
    if (comp == 0) {
#pragma unroll
        for (int r = 0; r < 16; ++r) { const int orow = crow(r, hi);
#pragma unroll
            for (int d0 = 0; d0 < 2; ++d0) stg[orow * 64 + d0 * 32 + r32] = o[d0][r] * rli[r]; }
    } else {
        const float lam = P.lam;
#pragma unroll
        for (int r = 0; r < 16; ++r) { const int orow = crow(r, hi);
#pragma unroll
            for (int d0 = 0; d0 < 2; ++d0) { const int ix = orow * 64 + d0 * 32 + r32; stg[ix] = stg[ix] - lam * (o[d0][r] * rli[r]); } }
        asm volatile("s_waitcnt lgkmcnt(0)" ::: "memory");
        bf16_t* Yw = P.Y + (rowbase + q0 + wid * QBLK) * DM + h * D;
        const int ch = lane & 7;
        const f32x4 g0 = *(const f32x4*)(P.gnorm + ch * 8), g1 = *(const f32x4*)(P.gnorm + ch * 8 + 4);
#pragma unroll
        for (int i = 0; i < 4; ++i) { const int row = i * 8 + (lane >> 3);
            const f32x4 a = *(const f32x4*)(stg + row * 64 + ch * 8), c = *(const f32x4*)(stg + row * 64 + ch * 8 + 4);
            float ss = (a[0] * a[0] + a[1] * a[1]) + (a[2] * a[2] + a[3] * a[3]) + (c[0] * c[0] + c[1] * c[1]) + (c[2] * c[2] + c[3] * c[3]);
            ss += __shfl_xor(ss, 1); ss += __shfl_xor(ss, 2); ss += __shfl_xor(ss, 4);
            const float rs = __builtin_amdgcn_rsqf(ss * (1.f / 64.f) + LN_EPS) * P.osc;
            u32x4 w; w.x = pk2(a[0] * rs * g0[0], a[1] * rs * g0[1]); w.y = pk2(a[2] * rs * g0[2], a[3] * rs * g0[3]); w.z = pk2(c[0] * rs * g1[0], c[1] * rs * g1[1]); w.w = pk2(c[2] * rs * g1[2], c[3] * rs * g1[3]);
            *(u32x4*)(Yw + (long)row * DM + ch * 8) = w; }
    }
    asm volatile("s_waitcnt lgkmcnt(0)\n\ts_barrier" ::: "memory");
#undef DMA_K
#undef DMA_V
#undef CMASK
#undef START
#undef RESC
#undef ROT
}
#undef SBAR
#undef WAIT_BAR
}

struct Frame {
    LAS unsigned char* lds; volatile LAS unsigned* MISC; gu32* ctl;
    int tid, lane, wave, vcu, G;
};
struct Args {
    const float* in[29]; float* out; unsigned char* ws; int ph_lo, ph_hi;
};
enum { I_X = 0, I_C, I_POS, I_WADA, I_BADA, I_WIN, I_WOUT, I_MBI, I_MBF, I_MG, I_CONVW, I_CONVB, I_LQ1, I_LK1, I_LQ2, I_LK2, I_DG, I_WA2, I_BA, I_GG, I_LN1G, I_LN1B, I_LN2G, I_LN2B,
       I_RW, I_RB, I_EWG, I_EWU, I_EWD };

__device__ __forceinline__ void tr_item(const float* W, int ldw, int K, bf16_t* WT, int drow0, int scol, int k0, LAS float* scr, int lane) {
#pragma unroll 8
    for (int i = 0; i < 32; ++i) { const int kk = 2 * i + (lane >> 5); scr[kk * 33 + (lane & 31)] = (scol >= 0) ? W[(size_t)(k0 + kk) * ldw + scol] : 0.f; }
    LDS_WAIT(); asm volatile("" ::: "memory");
    const int c = lane & 7;
#pragma unroll
    for (int j = 0; j < 4; ++j) { const int n = (lane >> 3) + 8 * j; const LAS float* s = scr + (8 * c) * 33 + n;
        u32x4 o; o.x = pk2(s[0 * 33], s[1 * 33]); o.y = pk2(s[2 * 33], s[3 * 33]); o.z = pk2(s[4 * 33], s[5 * 33]); o.w = pk2(s[6 * 33], s[7 * 33]);
        *(GAS u32x4*)(WT + (size_t)(drow0 + n) * K + k0 + 8 * c) = o; }
    LDS_WAIT(); asm volatile("" ::: "memory");
}
__device__ __forceinline__ void tr_item4(const float* W, int ldw, int K, bf16_t* WT, int drow0, int scol0, int k0, LAS float* scr, int lane) {
    const int kq = lane >> 3, nq = (lane & 7) * 4;
    f32x4 v[8];
#pragma unroll
    for (int i = 0; i < 8; ++i) v[i] = *(const f32x4*)(W + (size_t)(k0 + i * 8 + kq) * ldw + scol0 + nq);
#pragma unroll
    for (int i = 0; i < 8; ++i) { LAS float* d = scr + (i * 8 + kq) * 33 + nq; d[0] = v[i][0]; d[1] = v[i][1]; d[2] = v[i][2]; d[3] = v[i][3]; }
    LDS_WAIT(); asm volatile("" ::: "memory");
    const int c = lane & 7;
#pragma unroll
    for (int j = 0; j < 4; ++j) { const int n = (lane >> 3) + 8 * j; const LAS float* s = scr + (8 * c) * 33 + n;
        u32x4 o; o.x = pk2(s[0 * 33], s[1 * 33]); o.y = pk2(s[2 * 33], s[3 * 33]); o.z = pk2(s[4 * 33], s[5 * 33]); o.w = pk2(s[6 * 33], s[7 * 33]);
        *(GAS u32x4*)(WT + (size_t)(drow0 + n) * K + k0 + 8 * c) = o; }
    LDS_WAIT(); asm volatile("" ::: "memory");
}
template <int NTL>
__device__ __forceinline__ void rows16_mm(f32x4 (&acc)[NTL], const bf16_t* A, const LAS bf16_t* Bt, int pitch, int lane) {
    const int lr = lane & 15, lq = lane >> 4;
    const bf16_t* ap = A + (size_t)lr * 1024 + lq * 8;
#pragma unroll 8
    for (int ks = 0; ks < 32; ++ks) {
        const bf16x8 a = *(const bf16x8*)(ap + ks * 32);
#pragma unroll
        for (int t = 0; t < NTL; ++t) { const bf16x8 b = *(const LAS bf16x8*)(Bt + (t * 16 + lr) * pitch + ks * 32 + lq * 8); acc[t] = __builtin_amdgcn_mfma_f32_16x16x32_bf16(a, b, acc[t], 0, 0, 0); }
    }
}
constexpr int TBP = 1056;
__device__ __forceinline__ void tail16(const bf16_t* Urow0, const LAS bf16_t* Wt, float* tail_row0, int lane) {
    f32x4 acc[2] = {(f32x4){0.f, 0.f, 0.f, 0.f}, (f32x4){0.f, 0.f, 0.f, 0.f}};
    rows16_mm<2>(acc, Urow0, Wt, TBP, lane);
    const int lr = lane & 15, lq = lane >> 4;
#pragma unroll
    for (int t = 0; t < 2; ++t)
#pragma unroll
        for (int r = 0; r < 4; ++r) tail_row0[(size_t)(lq * 4 + r) * 32 + t * 16 + lr] = acc[t][r];
}
__device__ __forceinline__ void load_tail_w(LAS bf16_t* Wt, const bf16_t* Wtail  , int tid) {
    for (int p = tid; p < 32 * 128; p += 512) { const int n = p >> 7, c = p & 127; *(LAS u32x4*)(Wt + n * TBP + c * 8) = *(const u32x4*)(Wtail + (size_t)n * 1024 + c * 8); }
}
__device__ __forceinline__ int win_src_col(int n) {
    if (n < 1024) return n;
    if (n < 3584) return n + 8;
    const int i = n - 3584;
    if (i < 16) return 3592 + i;
    if (i < 20) return 1024 + (i - 16);
    if (i < 24) return 1028 + (i - 20);
    return -1;
}

namespace rec {
constexpr int PT = 72;
constexpr int TB = 64 * PT * 2;
constexpr int OFF_T0 = 0, OFF_T1 = TB, OFF_T2 = 2 * TB, OFF_T3 = 3 * TB, OFF_T4 = 4 * TB, OFF_T5 = 5 * TB;
constexpr int OFF_BM = 6 * TB;
constexpr int OFF_HM = OFF_BM + 16384;
constexpr int OFF_VEC = OFF_HM + 64 * 68 * 4;
constexpr int V_G = 0, V_M = 64, V_WI = 128, V_EM = 192, V_DI = 256, V_N = 320, V_BE = 384, V_SEG = 448, V_GA = 960;
static_assert(OFF_VEC + (960 + 1024) * 4 <= RING_BYTES, "rec LDS");

__device__ __forceinline__ void mm64(f32x4 (&acc)[2], const LAS bf16_t* A, const LAS bf16_t* Bt, int wid, int lane) {
    const int tm = wid >> 1, tn0 = (wid & 1) * 2, lr = lane & 15, lq = lane >> 4;
#pragma unroll
    for (int ks = 0; ks < 2; ++ks) {
        const bf16x8 a = *(const LAS bf16x8*)(A + (tm * 16 + lr) * PT + ks * 32 + lq * 8);
#pragma unroll
        for (int t = 0; t < 2; ++t) { const bf16x8 b = *(const LAS bf16x8*)(Bt + ((tn0 + t) * 16 + lr) * PT + ks * 32 + lq * 8);
            acc[t] = __builtin_amdgcn_mfma_f32_16x16x32_bf16(a, b, acc[t], 0, 0, 0); }
    }
}
__device__ __forceinline__ float scan_add(float v, int lane) {
#pragma unroll
    for (int o = 1; o < 64; o <<= 1) { const float t = __shfl_up(v, o); if (lane >= o) v += t; }
    return v;
}
__device__ __forceinline__ float scan_max(float v, int lane) {
#pragma unroll
    for (int o = 1; o < 64; o <<= 1) { const float t = __shfl_up(v, o); if (lane >= o) v = fmaxf(v, t); }
    return v;
}
__device__ __forceinline__ void st_tr8(LAS bf16_t* T, int l, int ch, u32x4 w) {
    T[(ch * 8 + 0) * PT + l] = (bf16_t)(w.x & 0xffffu); T[(ch * 8 + 1) * PT + l] = (bf16_t)(w.x >> 16);
    T[(ch * 8 + 2) * PT + l] = (bf16_t)(w.y & 0xffffu); T[(ch * 8 + 3) * PT + l] = (bf16_t)(w.y >> 16);
    T[(ch * 8 + 4) * PT + l] = (bf16_t)(w.z & 0xffffu); T[(ch * 8 + 5) * PT + l] = (bf16_t)(w.z >> 16);
    T[(ch * 8 + 6) * PT + l] = (bf16_t)(w.w & 0xffffu); T[(ch * 8 + 7) * PT + l] = (bf16_t)(w.w >> 16);
}
__device__ __forceinline__ void unpack8(u32x4 w, float (&f)[8]) {
    f[0] = bflo(w.x); f[1] = bfhi(w.x); f[2] = bflo(w.y); f[3] = bfhi(w.y); f[4] = bflo(w.z); f[5] = bfhi(w.z); f[6] = bflo(w.w); f[7] = bfhi(w.w);
}
template <int GATE  >
__device__ __forceinline__ void finalize(const LAS float* HM, const LAS float* rowscale, const float* gnorm, const bf16_t* gate, bf16_t* out, int tid) {
    const int j = tid >> 3, ch = tid & 7;
    const f32x4 a = *(const LAS f32x4*)(HM + j * 68 + ch * 8), c = *(const LAS f32x4*)(HM + j * 68 + ch * 8 + 4);
    const float rsc = rowscale ? rowscale[j] : 1.f;
    float v[8] = {a[0] * rsc, a[1] * rsc, a[2] * rsc, a[3] * rsc, c[0] * rsc, c[1] * rsc, c[2] * rsc, c[3] * rsc};
    float ss = 0.f;
#pragma unroll
    for (int i = 0; i < 8; ++i) ss += v[i] * v[i];
    ss += __shfl_xor(ss, 1); ss += __shfl_xor(ss, 2); ss += __shfl_xor(ss, 4);
    const float rs = __builtin_amdgcn_rsqf(ss * (1.f / 64.f) + LN_EPS);
    const u32x4 gw = *(const u32x4*)(gate + (size_t)j * PP + ch * 8);
    float gt[8]; unpack8(gw, gt);
    const f32x4 g0 = *(const f32x4*)(gnorm + ch * 8), g1 = *(const f32x4*)(gnorm + ch * 8 + 4);
    const float gn[8] = {g0[0], g0[1], g0[2], g0[3], g1[0], g1[1], g1[2], g1[3]};
    float y[8];
#pragma unroll
    for (int i = 0; i < 8; ++i) { const float sg = 1.f / (1.f + __expf(-gt[i])); const float gv = GATE ? gt[i] * sg : sg; y[i] = v[i] * rs * gn[i] * gv; }
    u32x4 w; w.x = pk2(y[0], y[1]); w.y = pk2(y[2], y[3]); w.z = pk2(y[4], y[5]); w.w = pk2(y[6], y[7]);
    *(u32x4*)(out + (size_t)j * DM + ch * 8) = w;
}

struct RecP {
    const bf16_t* proj; const float* tail; float* stm; float* stg; float* smN; float* smBC; float* smDM; float* smMS; float* smGBE; bf16_t* ycat;
    const float* mbi; const float* mbf; const float* mg; const float* wa2; const float* ba; const float* gg;
};

__device__ __forceinline__ void mlstm_gates(const RecP& P, int row0, int h, int lane, float& bcum, float& g) {
    const float* pr = P.tail + (size_t)(row0 + lane) * 32;
    const float li = pr[T_MI + h] + P.mbi[h];
    const float lf = logsig(pr[T_MF + h] + P.mbf[h]);
    bcum = scan_add(lf, lane); g = li - bcum;
}

__device__ __forceinline__ void mlstm_local(const RecP& P, LAS unsigned char* lds, int ci, int tid, int wid, int lane) {
    const int bh = ci >> 6, c = ci & 63, b = bh >> 2, h = bh & 3, row0 = b * SEQ + c * 64;
    LAS bf16_t* KT = (LAS bf16_t*)(lds + OFF_T0); LAS bf16_t* VT = (LAS bf16_t*)(lds + OFF_T1); LAS float* vec = (LAS float*)(lds + OFF_VEC);
    const int l = tid >> 3, ch = tid & 7;
    const u32x4 kw = *(const u32x4*)(P.proj + (size_t)(row0 + l) * PP + C_MK + h * 64 + ch * 8);
    const u32x4 vw = *(const u32x4*)(P.proj + (size_t)(row0 + l) * PP + C_MV + h * 64 + ch * 8);
    if (wid == 0) {
        float bc, g; mlstm_gates(P, row0, h, lane, bc, g);
        const float gmax = wave_max(g), bend = __shfl(bc, 63);
        vec[V_G + lane] = __expf(g - gmax);
        if (lane == 0) { P.smBC[ci] = bend; P.smDM[ci] = bend + gmax; }
    }
    __syncthreads();
    { const float w = vec[V_G + l]; float kf[8]; unpack8(kw, kf);
      u32x4 ks; ks.x = pk2(kf[0] * w, kf[1] * w); ks.y = pk2(kf[2] * w, kf[3] * w); ks.z = pk2(kf[4] * w, kf[5] * w); ks.w = pk2(kf[6] * w, kf[7] * w);
      st_tr8(KT, l, ch, ks); st_tr8(VT, l, ch, vw); }
    __syncthreads();
    f32x4 acc[2] = {(f32x4){0.f, 0.f, 0.f, 0.f}, (f32x4){0.f, 0.f, 0.f, 0.f}};
    mm64(acc, VT, KT, wid, lane);
    { const int tm = wid >> 1, tn0 = (wid & 1) * 2, lr = lane & 15, lq = lane >> 4; float* dst = P.stm + (size_t)ci * 4096;
#pragma unroll
      for (int t = 0; t < 2; ++t)
#pragma unroll
          for (int r = 0; r < 4; ++r) dst[(tm * 16 + lq * 4 + r) * 64 + (tn0 + t) * 16 + lr] = acc[t][r]; }
    if (tid < 64) { float s = 0.f;
#pragma unroll
        for (int q = 0; q < 8; ++q) { const u32x4 w = *(const LAS u32x4*)(KT + tid * PT + q * 8); float f[8]; unpack8(w, f);
#pragma unroll
            for (int i = 0; i < 8; ++i) s += f[i]; }
        P.smN[(size_t)ci * 64 + tid] = s; }
    __syncthreads();
}
__device__ __forceinline__ void mlstm_out(const RecP& P, LAS unsigned char* lds, int ci, int tid, int wid, int lane) {
    const int bh = ci >> 6, c = ci & 63, b = bh >> 2, h = bh & 3, row0 = b * SEQ + c * 64;
    LAS bf16_t* Qm = (LAS bf16_t*)(lds + OFF_T0); LAS bf16_t* Km = (LAS bf16_t*)(lds + OFF_T1); LAS bf16_t* VT = (LAS bf16_t*)(lds + OFF_T2);
    LAS bf16_t* CT = (LAS bf16_t*)(lds + OFF_T3); LAS bf16_t* Sm = (LAS bf16_t*)(lds + OFF_T4);
    LAS float* HM = (LAS float*)(lds + OFF_HM); LAS float* vec = (LAS float*)(lds + OFF_VEC);
    const int l = tid >> 3, ch = tid & 7;
    { const bf16_t* pr = P.proj + (size_t)(row0 + l) * PP + h * 64 + ch * 8;
      const u32x4 qw = *(const u32x4*)(pr + C_MQ), kw = *(const u32x4*)(pr + C_MK), vw = *(const u32x4*)(pr + C_MV);
      *(LAS u32x4*)(Qm + l * PT + ch * 8) = qw; *(LAS u32x4*)(Km + l * PT + ch * 8) = kw; st_tr8(VT, l, ch, vw);
      const float* cs = P.stm + (size_t)ci * 4096 + l * 64 + ch * 8;
      const f32x4 c0 = *(const f32x4*)cs, c1 = *(const f32x4*)(cs + 4);
      u32x4 cw; cw.x = pk2(c0[0], c0[1]); cw.y = pk2(c0[2], c0[3]); cw.z = pk2(c1[0], c1[1]); cw.w = pk2(c1[2], c1[3]);
      *(LAS u32x4*)(CT + l * PT + ch * 8) = cw; }
    if (wid == 0) {
        float bc, g; mlstm_gates(P, row0, h, lane, bc, g);
        const float pm = scan_max(g, lane), m = P.smMS[ci], M = fmaxf(m, pm);
        vec[V_G + lane] = g; vec[V_M + lane] = M; vec[V_WI + lane] = __expf(m - M); vec[V_EM + lane] = __expf(-bc - M);
        vec[V_N + lane] = P.smN[(size_t)ci * 64 + lane];
    }
    __syncthreads();
    { f32x4 acc[2] = {(f32x4){0.f, 0.f, 0.f, 0.f}, (f32x4){0.f, 0.f, 0.f, 0.f}};
      mm64(acc, Qm, Km, wid, lane);
      const int tm = wid >> 1, tn0 = (wid & 1) * 2, lr = lane & 15, lq = lane >> 4;
#pragma unroll
      for (int t = 0; t < 2; ++t) { const int ll = (tn0 + t) * 16 + lr; const float gl = vec[V_G + ll];
#pragma unroll
          for (int r = 0; r < 4; ++r) { const int j = tm * 16 + lq * 4 + r; const float s = (ll <= j) ? acc[t][r] * __expf(gl - vec[V_M + j]) : 0.f; Sm[j * PT + ll] = (bf16_t)f2bf(s); } } }
    __syncthreads();
    { f32x4 a1[2] = {(f32x4){0.f, 0.f, 0.f, 0.f}, (f32x4){0.f, 0.f, 0.f, 0.f}}, a2[2] = {(f32x4){0.f, 0.f, 0.f, 0.f}, (f32x4){0.f, 0.f, 0.f, 0.f}};
      mm64(a1, Sm, VT, wid, lane); mm64(a2, Qm, CT, wid, lane);
      const int tm = wid >> 1, tn0 = (wid & 1) * 2, lr = lane & 15, lq = lane >> 4;
#pragma unroll
      for (int t = 0; t < 2; ++t)
#pragma unroll
          for (int r = 0; r < 4; ++r) { const int j = tm * 16 + lq * 4 + r; HM[j * 68 + (tn0 + t) * 16 + lr] = a1[t][r] + vec[V_WI + j] * a2[t][r]; } }
    if (tid < 64) { float ds = 0.f, qn = 0.f;
#pragma unroll
        for (int q = 0; q < 8; ++q) { const u32x4 w = *(const LAS u32x4*)(Sm + tid * PT + q * 8); float f[8]; unpack8(w, f);
            const u32x4 qw = *(const LAS u32x4*)(Qm + tid * PT + q * 8); float qf[8]; unpack8(qw, qf);
#pragma unroll
            for (int i = 0; i < 8; ++i) { ds += f[i]; qn += qf[i] * vec[V_N + q * 8 + i]; } }
        const float den = ds + vec[V_WI + tid] * qn;
        vec[V_DI + tid] = 1.f / fmaxf(fabsf(den), vec[V_EM + tid]); }
    __syncthreads();
    finalize<0>(HM, vec + V_DI, P.mg, P.proj + (size_t)row0 * PP + C_MO + h * 64, P.ycat + (size_t)row0 * DM + h * 64, tid);
    __syncthreads();
}
__device__ __forceinline__ void gla_bmat(const RecP& P, LAS unsigned char* lds, int row0, int h, int tid, int wid) {
    LAS float* BM = (LAS float*)(lds + OFF_BM); LAS float* vec = (LAS float*)(lds + OFF_VEC);
    if (tid < 256) { const int l = tid >> 2, q = tid & 3; const f32x4 w = *(const f32x4*)(P.tail + (size_t)(row0 + l) * 32 + T_GA + q * 4);
        vec[V_GA + l * 16 + q * 4 + 0] = w[0]; vec[V_GA + l * 16 + q * 4 + 1] = w[1]; vec[V_GA + l * 16 + q * 4 + 2] = w[2]; vec[V_GA + l * 16 + q * 4 + 3] = w[3]; }
    const int dcol = tid & 63;
    float wv[16];
#pragma unroll
    for (int r = 0; r < 16; ++r) wv[r] = P.wa2[r * 256 + h * 64 + dcol];
    const float bav = P.ba[h * 64 + dcol];
    __syncthreads();
    float cs[8]; float cacc = 0.f;
#pragma unroll
    for (int i = 0; i < 8; ++i) { const int l = wid * 8 + i; float z = bav;
#pragma unroll
        for (int r = 0; r < 16; ++r) z += vec[V_GA + l * 16 + r] * wv[r];
        cacc += logsig(z) * (1.f / 16.f); cs[i] = cacc; }
    vec[V_SEG + wid * 64 + dcol] = cacc;
    __syncthreads();
    float off = 0.f, tot = 0.f;
#pragma unroll
    for (int s = 0; s < 8; ++s) { const float v = vec[V_SEG + s * 64 + dcol]; tot += v; if (s < wid) off += v; }
#pragma unroll
    for (int i = 0; i < 8; ++i) BM[(wid * 8 + i) * 64 + dcol] = off + cs[i];
    if (wid == 0) vec[V_BE + dcol] = tot;
    __syncthreads();
}
__device__ __forceinline__ void gla_local(const RecP& P, LAS unsigned char* lds, int ci, int tid, int wid, int lane) {
    const int bh = ci >> 6, c = ci & 63, b = bh >> 2, h = bh & 3, row0 = b * SEQ + c * 64;
    LAS bf16_t* KT = (LAS bf16_t*)(lds + OFF_T0); LAS bf16_t* VT = (LAS bf16_t*)(lds + OFF_T1);
    LAS float* BM = (LAS float*)(lds + OFF_BM); LAS float* vec = (LAS float*)(lds + OFF_VEC);
    const int l = tid >> 3, ch = tid & 7;
    const u32x4 kw = *(const u32x4*)(P.proj + (size_t)(row0 + l) * PP + C_GK + h * 64 + ch * 8);
    const u32x4 vw = *(const u32x4*)(P.proj + (size_t)(row0 + l) * PP + C_GV + h * 64 + ch * 8);
    gla_bmat(P, lds, row0, h, tid, wid);
    if (tid < 64) P.smGBE[(size_t)ci * 64 + tid] = vec[V_BE + tid];
    { float kf[8]; unpack8(kw, kf); float ks[8];
#pragma unroll
      for (int i = 0; i < 8; ++i) { const int d = ch * 8 + i; ks[i] = kf[i] * __expf(vec[V_BE + d] - BM[l * 64 + d]); }
      u32x4 kk; kk.x = pk2(ks[0], ks[1]); kk.y = pk2(ks[2], ks[3]); kk.z = pk2(ks[4], ks[5]); kk.w = pk2(ks[6], ks[7]);
      st_tr8(KT, l, ch, kk); st_tr8(VT, l, ch, vw); }
    __syncthreads();
    f32x4 acc[2] = {(f32x4){0.f, 0.f, 0.f, 0.f}, (f32x4){0.f, 0.f, 0.f, 0.f}};
    mm64(acc, VT, KT, wid, lane);
    { const int tm = wid >> 1, tn0 = (wid & 1) * 2, lr = lane & 15, lq = lane >> 4; float* dst = P.stg + (size_t)ci * 4096;
#pragma unroll
      for (int t = 0; t < 2; ++t)
#pragma unroll
          for (int r = 0; r < 4; ++r) dst[(tm * 16 + lq * 4 + r) * 64 + (tn0 + t) * 16 + lr] = acc[t][r]; }
    __syncthreads();
}
__device__ __forceinline__ void gla_out(const RecP& P, LAS unsigned char* lds, int ci, int tid, int wid, int lane) {
    const int bh = ci >> 6, c = ci & 63, b = bh >> 2, h = bh & 3, row0 = b * SEQ + c * 64;
    LAS bf16_t* Qm = (LAS bf16_t*)(lds + OFF_T0); LAS bf16_t* Km = (LAS bf16_t*)(lds + OFF_T1); LAS bf16_t* VT = (LAS bf16_t*)(lds + OFF_T2);
    LAS bf16_t* ST = (LAS bf16_t*)(lds + OFF_T3); LAS bf16_t* Sm = (LAS bf16_t*)(lds + OFF_T4);
    LAS float* BM = (LAS float*)(lds + OFF_BM); LAS float* HM = (LAS float*)(lds + OFF_HM);
    const int l = tid >> 3, ch = tid & 7;
    const bf16_t* pr = P.proj + (size_t)(row0 + l) * PP + h * 64 + ch * 8;
    const u32x4 qw = *(const u32x4*)(pr + C_GQ), kw = *(const u32x4*)(pr + C_GK), vw = *(const u32x4*)(pr + C_GV);
    const float* ss = P.stg + (size_t)ci * 4096 + l * 64 + ch * 8;
    const f32x4 s0 = *(const f32x4*)ss, s1 = *(const f32x4*)(ss + 4);
    gla_bmat(P, lds, row0, h, tid, wid);
    { float qf[8], kf[8]; unpack8(qw, qf); unpack8(kw, kf); float qs[8], ks[8];
#pragma unroll
      for (int i = 0; i < 8; ++i) { const float bv = BM[l * 64 + ch * 8 + i]; qs[i] = qf[i] * __expf(bv); ks[i] = kf[i] * __expf(-bv); }
      u32x4 qq, kk; qq.x = pk2(qs[0], qs[1]); qq.y = pk2(qs[2], qs[3]); qq.z = pk2(qs[4], qs[5]); qq.w = pk2(qs[6], qs[7]);
      kk.x = pk2(ks[0], ks[1]); kk.y = pk2(ks[2], ks[3]); kk.z = pk2(ks[4], ks[5]); kk.w = pk2(ks[6], ks[7]);
      *(LAS u32x4*)(Qm + l * PT + ch * 8) = qq; *(LAS u32x4*)(Km + l * PT + ch * 8) = kk; st_tr8(VT, l, ch, vw);
      u32x4 cw; cw.x = pk2(s0[0], s0[1]); cw.y = pk2(s0[2], s0[3]); cw.z = pk2(s1[0], s1[1]); cw.w = pk2(s1[2], s1[3]);
      *(LAS u32x4*)(ST + l * PT + ch * 8) = cw; }
    __syncthreads();
    { f32x4 acc[2] = {(f32x4){0.f, 0.f, 0.f, 0.f}, (f32x4){0.f, 0.f, 0.f, 0.f}};
      mm64(acc, Qm, Km, wid, lane);
      const int tm = wid >> 1, tn0 = (wid & 1) * 2, lr = lane & 15, lq = lane >> 4;
#pragma unroll
      for (int t = 0; t < 2; ++t) { const int ll = (tn0 + t) * 16 + lr;
#pragma unroll
          for (int r = 0; r < 4; ++r) { const int j = tm * 16 + lq * 4 + r; Sm[j * PT + ll] = (bf16_t)f2bf((ll <= j) ? acc[t][r] : 0.f); } } }
    __syncthreads();
    { f32x4 acc[2] = {(f32x4){0.f, 0.f, 0.f, 0.f}, (f32x4){0.f, 0.f, 0.f, 0.f}};
      mm64(acc, Sm, VT, wid, lane); mm64(acc, Qm, ST, wid, lane);
      const int tm = wid >> 1, tn0 = (wid & 1) * 2, lr = lane & 15, lq = lane >> 4;
#pragma unroll
      for (int t = 0; t < 2; ++t)
#pragma unroll
          for (int r = 0; r < 4; ++r) HM[(tm * 16 + lq * 4 + r) * 68 + (tn0 + t) * 16 + lr] = acc[t][r]; }
    __syncthreads();
    finalize<1>(HM, nullptr, P.gg, P.proj + (size_t)row0 * PP + C_GR + h * 64, P.ycat + (size_t)row0 * DM + 768 + h * 64, tid);
    __syncthreads();
}
}

constexpr int N_PHASES = 2 + 9 * DEPTH;
__global__ void __launch_bounds__(512, 2) mega_fwd(Args args) {
    extern __shared__ __attribute__((aligned(16))) unsigned char lds_raw[];
    Frame F;
    F.lds = (LAS unsigned char*)lds_raw;
    F.MISC = (volatile LAS unsigned*)(F.lds + MISC_OFF);
    F.tid = threadIdx.x; F.lane = F.tid & 63; F.wave = __builtin_amdgcn_readfirstlane(F.tid >> 6);
    F.G = gridDim.x; { const int bx = blockIdx.x; F.vcu = (F.G % 8 == 0) ? (bx % 8) * (F.G / 8) + bx / 8 : bx; }
    typedef const __attribute__((address_space(4))) Args* CArgs;
    const CArgs ap0 = (CArgs)__builtin_amdgcn_kernarg_segment_ptr();
    F.ctl = (gu32*)(args.ws + WS_CTL);
    for (int u = F.tid; u < (LDS_BYTES - LDSCTL_OFF) / 4; u += 512) ((LAS unsigned*)(F.lds + LDSCTL_OFF))[u] = 0u;
    __syncthreads();
#if MK_ONE_LAUNCH
    XcdBarrier bar = xcd_barrier_post((unsigned*)(F.ctl + CW_BAR), F.MISC + 8);
#define GRID_BAR() xcd_barrier(bar)
#else
#define GRID_BAR() do {} while (0)
#endif
    const int lo = args.ph_lo, hi = args.ph_hi;
#define IN(k) (lo <= (k) && (k) < hi)
#define SEAM(k) do { if (IN(k) && IN((k) + 1)) GRID_BAR(); } while (0)
    const int NGW = F.G * 8;
#define PHASE_IDS() int tid = threadIdx.x; asm volatile("" : "+v"(tid)); const int lane = tid & 63, wid = __builtin_amdgcn_readfirstlane(tid >> 6); const int gw = F.vcu * 8 + wid; (void)lane; (void)gw; \
    CArgs ap = ap0; asm volatile("" : "+s"(ap)); unsigned char* ws = ap->ws; (void)ws
#define AIN(i) (ap->in[i])
#define MOD ((float*)(ws + WS_MOD))
#define ROPE ((float*)(ws + WS_ROPE))
#define WIN ((bf16_t*)(ws + WS_WIN))
#define WOUT ((bf16_t*)(ws + WS_WOUT))
#define WGU ((bf16_t*)(ws + WS_WGU))
#define WD ((bf16_t*)(ws + WS_WD))
#define LTOK ((int*)(ws + WS_LTOK))
#define LGATE ((float*)(ws + WS_LGATE))
#define PROJ ((bf16_t*)(ws + WS_PROJ))
#define HB ((bf16_t*)(ws + WS_PROJ))
#define XB ((bf16_t*)(ws + WS_XR))
#define YSORT ((bf16_t*)(ws + WS_YSORT))
#define TAILB ((float*)(ws + WS_TAIL))
#define TOKSLOT ((int*)(ws + WS_SM + SM_TS))
#define UB ((bf16_t*)(ws + WS_U))
#define YCAT ((bf16_t*)(ws + WS_YCAT))
#define STM ((float*)(ws + WS_U))
#define STG ((float*)(ws + WS_U + 32 * MiB))
#define G_smN ((float*)(ws + WS_SM + SM_N))
#define G_smBC ((float*)(ws + WS_SM + SM_BC))
#define G_smDM ((float*)(ws + WS_SM + SM_DM))
#define G_smMS ((float*)(ws + WS_SM + SM_MS))
#define G_smGBE ((float*)(ws + WS_SM + SM_GBE))
#define x_in AIN(I_X)

    if (IN(0) && PHON(0)) {
        PHASE_IDS();
        {
            LAS float* cact = (LAS float*)F.lds;
            LAS float* part = (LAS float*)(F.lds + 32768);
            const float* cc = AIN(I_C);
            for (int i = tid; i < NB * DM; i += 512) { const int b = i >> 10, k = i & 1023; const float v = cc[i]; cact[k * 8 + b] = v / (1.f + __expf(-v)); }
            __syncthreads();
            for (int it = F.vcu; it < DEPTH * 96; it += F.G) {
                const int l = it / 96, j0 = (it % 96) * 64;
                const float* W = AIN(I_WADA) + (size_t)l * DM * 6144 + j0 + lane;
                float a[8] = {0.f, 0.f, 0.f, 0.f, 0.f, 0.f, 0.f, 0.f};
#pragma unroll 8
                for (int kk = 0; kk < 128; ++kk) { const int k = wid * 128 + kk; const float w = W[(size_t)k * 6144];
                    const f32x4 c0 = *(const LAS f32x4*)(cact + k * 8), c1 = *(const LAS f32x4*)(cact + k * 8 + 4);
                    a[0] += c0[0] * w; a[1] += c0[1] * w; a[2] += c0[2] * w; a[3] += c0[3] * w; a[4] += c1[0] * w; a[5] += c1[1] * w; a[6] += c1[2] * w; a[7] += c1[3] * w; }
#pragma unroll
                for (int b = 0; b < 8; ++b) part[(wid * 8 + b) * 64 + lane] = a[b];
                __syncthreads();
                { const int b = tid >> 6, j = tid & 63; float s = AIN(I_BADA)[(size_t)l * 6144 + j0 + j];
#pragma unroll
                  for (int w = 0; w < 8; ++w) s += part[(w * 8 + b) * 64 + j];
                  MOD[((size_t)l * NB + b) * 6144 + j0 + j] = s; }
                __syncthreads();
            }
        }
        {
            const int* pos = (const int*)AIN(I_POS);
            for (int i = blockIdx.x * 512 + tid; i < NTOK * 4; i += F.G * 512) { const int row = i >> 2, f = i & 3;
                const float invf = (float)pow(500000.0, -0.25 * (double)f); const float ang = (float)pos[row] * invf;
                ROPE[(size_t)row * 8 + f] = (float)cos((double)ang); ROPE[(size_t)row * 8 + 4 + f] = (float)sin((double)ang); }
        }
        {
            LAS float* scr = (LAS float*)(F.lds + 49152 + wid * 8704);
            constexpr int I_IN = (DM / 64) * (PW / 32), I_OUT = (DM / 64) * (DM / 32);
            for (int it = gw; it < DEPTH * (I_IN + I_OUT); it += NGW) {
                const int l = it / (I_IN + I_OUT); int r = it % (I_IN + I_OUT);
                if (r < I_IN) { const int kb = r / (PW / 32), nb = r % (PW / 32);
                    if (nb < 112) tr_item4(AIN(I_WIN) + (size_t)l * DM * PIN, PIN, DM, WIN + (size_t)l * PW * DM, nb * 32, win_src_col(nb * 32), kb * 64, scr, lane);
                    else tr_item(AIN(I_WIN) + (size_t)l * DM * PIN, PIN, DM, WIN + (size_t)l * PW * DM, nb * 32, win_src_col(nb * 32 + (lane & 31)), kb * 64, scr, lane); }
                else { r -= I_IN; const int kb = r / (DM / 32), nb = r % (DM / 32);
                    tr_item4(AIN(I_WOUT) + (size_t)l * DM * DM, DM, DM, WOUT + (size_t)l * DM * DM, nb * 32, nb * 32, kb * 64, scr, lane); }
            }
        }
    }
    SEAM(0);
    if (IN(1) && PHON(1)) {
        PHASE_IDS();
        LAS bf16_t* Wt = (LAS bf16_t*)F.lds; load_tail_w(Wt, WIN + (size_t)PP * DM, tid);
        const int b = F.vcu >> 5; const float* md = MOD + (size_t)b * 6144;
        f32x4 sh[4], sc[4];
#pragma unroll
        for (int j = 0; j < 4; ++j) { sh[j] = *(const f32x4*)(md + 4 * lane + 256 * j); sc[j] = *(const f32x4*)(md + 1024 + 4 * lane + 256 * j) + 1.0f; }
        const int rowb = F.vcu * 128 + wid * 16;
        for (int i = 0; i < 16; ++i) { const int row = rowb + i;
#pragma unroll
            for (int j = 0; j < 4; ++j) { const f32x4 v = *(const f32x4*)(x_in + (size_t)row * DM + 4 * lane + 256 * j); const f32x4 u = v * sc[j] + sh[j];
                u32x2 w; w.x = pk2(u[0], u[1]); w.y = pk2(u[2], u[3]); *(u32x2*)(UB + (size_t)row * DM + 4 * lane + 256 * j) = w; } }
        VM_WAIT(); __syncthreads();
        tail16(UB + (size_t)rowb * DM, Wt, TAILB + (size_t)rowb * 32, lane);
    }
    SEAM(1);

    for (int l = 0; l < DEPTH; ++l) {
        const int pb = 2 + 9 * l;
#define modl (MOD + (size_t)l * NB * 6144)
#define MAKE_RP() rec::RecP RP; RP.proj = PROJ; RP.tail = TAILB; RP.stm = STM; RP.stg = STG; RP.smN = G_smN; RP.smBC = G_smBC; RP.smDM = G_smDM; RP.smMS = G_smMS; RP.smGBE = G_smGBE; RP.ycat = YCAT; \
        RP.mbi = AIN(I_MBI) + l * 4; RP.mbf = AIN(I_MBF) + l * 4; RP.mg = AIN(I_MG) + l * 64; RP.wa2 = AIN(I_WA2) + (size_t)l * 16 * 256; RP.ba = AIN(I_BA) + l * 256; RP.gg = AIN(I_GG) + l * 64;
        if (IN(pb + 0) && PHON(2)) {
            PHASE_IDS(); (void)tid;
            gm::K1 k; k.S.init(NTOK, PP, F.G, (int)blockIdx.x); k.A = UB; k.Bt = WIN + (size_t)l * PW * DM; k.O = PROJ; k.rope = ROPE;
            for (int rp = 0; rp < NREP(2); ++rp) gm::gemm_phase<gm::K1>(F.lds, k);
        }
        SEAM(pb + 0);
        if (IN(pb + 1) && PHON(3)) {
            PHASE_IDS();
            MAKE_RP();
            for (int rp = 0; rp < NREP(3); ++rp)
            for (int it = F.vcu; it < 4096; it += F.G) { if (it < 2048) rec::mlstm_local(RP, F.lds, it, tid, wid, lane); else rec::gla_local(RP, F.lds, it - 2048, tid, wid, lane); }
        }
        SEAM(pb + 1);
        if (IN(pb + 2) && PHON(4)) {
            PHASE_IDS();
            const int gt = blockIdx.x * 512 + tid, NGT = F.G * 512;
            for (int rp = 0; rp < NREP(4); ++rp) { const bool dry = (rp + 1 < NREP(4)); float* const DW = (float*)YCAT;
            for (int idx = gt; idx < 32 * 4096; idx += NGT) {
                const int bh = idx >> 12, el = idx & 4095; float* p = STM + (size_t)bh * 64 * 4096 + el; const float* bc = G_smBC + bh * 64; const float* dm = G_smDM + bh * 64;
                float C = 0.f, m = 0.f;
#pragma unroll 8
                for (int c = 0; c < NCH; ++c) { const float u = p[(size_t)c * 4096]; (dry ? DW + (size_t)bh * 64 * 4096 + el : p)[(size_t)c * 4096] = C; if (el == 0) G_smMS[bh * 64 + c] = m;
                    const float B = bc[c], Dm = dm[c], mn = fmaxf(B + m, Dm); C = __expf(B + m - mn) * C + __expf(Dm - mn) * u; m = mn; }
            }
            for (int idx = gt; idx < 32 * 64; idx += NGT) {
                const int bh = idx >> 6, el = idx & 63; float* p = G_smN + (size_t)bh * 64 * 64 + el; const float* bc = G_smBC + bh * 64; const float* dm = G_smDM + bh * 64;
                float C = 0.f, m = 0.f;
#pragma unroll 8
                for (int c = 0; c < NCH; ++c) { const float u = p[c * 64]; (dry ? DW + (size_t)bh * 64 * 64 + el : p)[c * 64] = C;
                    const float B = bc[c], Dm = dm[c], mn = fmaxf(B + m, Dm); C = __expf(B + m - mn) * C + __expf(Dm - mn) * u; m = mn; }
            }
            for (int idx = gt; idx < 32 * 4096; idx += NGT) {
                const int bh = idx >> 12, el = idx & 4095, d = el & 63; float* p = STG + (size_t)bh * 64 * 4096 + el; const float* be = G_smGBE + (size_t)bh * 64 * 64 + d;
                float S = 0.f;
#pragma unroll 8
                for (int c = 0; c < NCH; ++c) { const float u = p[(size_t)c * 4096]; (dry ? DW + 8 * 1024 * 1024 + (size_t)bh * 64 * 4096 + el : p)[(size_t)c * 4096] = S; S = __expf(be[c * 64]) * S + u; }
            }
            }
            for (int rp = 0; rp < NREP(13); ++rp) {
                LAS float* scr = (LAS float*)(F.lds + 49152 + wid * 8704);
                constexpr int I_G = (DM / 64) * (1024 / 32), I_D = (DE / 64) * (DM / 32);
                for (int it = gw; it < NE * (I_G + I_D); it += NGW) {
                    const int e = it / (I_G + I_D); int r = it % (I_G + I_D);
                    if (r < I_G) { const int kb = r / 32, nb = r % 32, n0 = nb * 32, tt = n0 >> 8, rr = n0 & 255;
                        const float* W = (rr < 128 ? AIN(I_EWG) : AIN(I_EWU)) + ((size_t)l * NE + e) * DM * DE;
                        tr_item4(W, DE, DM, WGU + (size_t)e * 1024 * 1024, n0, tt * 128 + (rr & 127), kb * 64, scr, lane); }
                    else { r -= I_G; const int kb = r / 32, nb = r % 32;
                        tr_item4(AIN(I_EWD) + ((size_t)l * NE + e) * DE * DM, DM, DE, WD + (size_t)e * 1024 * 512, nb * 32, nb * 32, kb * 64, scr, lane); }
                }
            }
        }
        SEAM(pb + 2);
        if (IN(pb + 3) && PHON(5)) {
            PHASE_IDS();
            if (PHON(10)) {
                float d1 = 0.f, d2 = 0.f;
                for (int i = 0; i < 32; ++i) { d1 += AIN(I_LQ1)[l * 32 + i] * AIN(I_LK1)[l * 32 + i]; d2 += AIN(I_LQ2)[l * 32 + i] * AIN(I_LK2)[l * 32 + i]; }
                const float lam_init = 0.8f - 0.6f * expf(-0.3f * (float)l);
                attn_body::AttnParams AP; AP.Q = (const attn_body::bf16*)(PROJ + C_DQ); AP.K = (const attn_body::bf16*)(PROJ + C_DK); AP.V = (const attn_body::bf16*)(PROJ + C_DV);
                AP.zpage = (const attn_body::bf16*)(F.ctl + CW_ZPAGE); AP.Y = YCAT + 512; AP.gnorm = AIN(I_DG) + l * 64; AP.lam = expf(d1) - expf(d2) + lam_init; AP.osc = 1.f - lam_init;
                const int bh = F.vcu >> 3, s = F.vcu & 7;
                if (F.G == 256) {
                    for (int rp = 0; rp < NREP(10); ++rp)
                    for (int i = 0; i < 2; ++i) { const int qb = (i == 0) ? s : 15 - s;
                        attn_body::attn_unit<8, 0>(bh >> 2, bh & 3, qb, AP, (char*)lds_raw); attn_body::attn_unit<8, 1>(bh >> 2, bh & 3, qb, AP, (char*)lds_raw); }
                } else {
                    for (int u = F.vcu; u < 512; u += F.G) { const int bh2 = u >> 4, qb = u & 15;
                        attn_body::attn_unit<8, 0>(bh2 >> 2, bh2 & 3, qb, AP, (char*)lds_raw); attn_body::attn_unit<8, 1>(bh2 >> 2, bh2 & 3, qb, AP, (char*)lds_raw); }
                }
            }
            __syncthreads();
            MAKE_RP();
            if (PHON(11)) for (int rp = 0; rp < NREP(11); ++rp) for (int it = F.vcu; it < 4096; it += F.G) { if (it < 2048) rec::mlstm_out(RP, F.lds, it, tid, wid, lane); else rec::gla_out(RP, F.lds, it - 2048, tid, wid, lane); }
            if (PHON(12)) for (int rp = 0; rp < NREP(12); ++rp) {
                const float* cw = AIN(I_CONVW) + (size_t)l * 3 * 256; const float* cbias = AIN(I_CONVB) + l * 256;
                for (int it = F.vcu; it < NTOK / 64; it += F.G) {
                    for (int p = tid; p < 64 * 32; p += 512) { const int r = p >> 5, chn = p & 31, row = it * 64 + r, t = row & (SEQ - 1);
                        const bf16_t* pr = PROJ + (size_t)row * PP + chn * 8;
                        float s0[8], s1[8], s2[8], cbv[8];
                        { float a[8], bq[8]; rec::unpack8(*(const u32x4*)(pr + C_CC), a); rec::unpack8(*(const u32x4*)(pr + C_CH), bq);
#pragma unroll
                          for (int i = 0; i < 8; ++i) s2[i] = a[i] * bq[i]; }
                        if (t >= 1) { float a[8], bq[8]; rec::unpack8(*(const u32x4*)(pr - PP + C_CC), a); rec::unpack8(*(const u32x4*)(pr - PP + C_CH), bq);
#pragma unroll
                          for (int i = 0; i < 8; ++i) s1[i] = a[i] * bq[i]; } else {
#pragma unroll
                          for (int i = 0; i < 8; ++i) s1[i] = 0.f; }
                        if (t >= 2) { float a[8], bq[8]; rec::unpack8(*(const u32x4*)(pr - 2 * PP + C_CC), a); rec::unpack8(*(const u32x4*)(pr - 2 * PP + C_CH), bq);
#pragma unroll
                          for (int i = 0; i < 8; ++i) s0[i] = a[i] * bq[i]; } else {
#pragma unroll
                          for (int i = 0; i < 8; ++i) s0[i] = 0.f; }
                        rec::unpack8(*(const u32x4*)(pr + C_CB), cbv);
                        float y[8];
#pragma unroll
                        for (int i = 0; i < 8; ++i) { const int cch = chn * 8 + i; y[i] = cbv[i] * (cw[cch] * s0[i] + cw[256 + cch] * s1[i] + cw[512 + cch] * s2[i] + cbias[cch]); }
                        u32x4 w; w.x = pk2(y[0], y[1]); w.y = pk2(y[2], y[3]); w.z = pk2(y[4], y[5]); w.w = pk2(y[6], y[7]);
                        *(u32x4*)(YCAT + (size_t)row * DM + 256 + chn * 8) = w; }
                }
            }
        }
        SEAM(pb + 3);
        if (IN(pb + 4) && PHON(6)) {
            PHASE_IDS(); (void)tid;
            gm::K2 k; k.S.init(NTOK, DM, F.G, (int)blockIdx.x); k.A = YCAT; k.Bt = WOUT + (size_t)l * DM * DM; k.O = UB;
            gm::gemm_phase<gm::K2>(F.lds, k);
        }
        SEAM(pb + 4);
        if (IN(pb + 5) && PHON(7)) {
            PHASE_IDS();
            LAS bf16_t* Rt = (LAS bf16_t*)F.lds;
            LAS float* lgs = (LAS float*)(F.lds + 32 * TBP * 2) + wid * 256;
            { const float* rw = AIN(I_RW); for (int i = tid; i < DM * NE; i += 512) { const int k = i >> 4, e = i & 15; const float w = rw[i]; const unsigned hb = f2bf(w); const float lo = w - bf2f(hb);
                Rt[e * TBP + k] = (bf16_t)hb; Rt[(16 + e) * TBP + k] = (bf16_t)f2bf(lo); } }
            const int b = F.vcu >> 5; const float* md = modl + (size_t)b * 6144;
            const float* lg = AIN(I_LN1G) + l * DM; const float* lb = AIN(I_LN1B) + l * DM;
            f32x4 gv[4], bv[4], sh[4], sc[4], g1[4];
#pragma unroll
            for (int j = 0; j < 4; ++j) { const int cix = 4 * lane + 256 * j; gv[j] = *(const f32x4*)(lg + cix); bv[j] = *(const f32x4*)(lb + cix); g1[j] = *(const f32x4*)(md + 2 * 1024 + cix) + 1.0f;
                sh[j] = *(const f32x4*)(md + 3 * 1024 + cix); sc[j] = *(const f32x4*)(md + 4 * 1024 + cix) + 1.0f; }
            const int rowb = F.vcu * 128 + wid * 16;
            for (int i = 0; i < 16; ++i) { const int row = rowb + i;
                f32x4 v[4]; float s = 0.f;
#pragma unroll
                for (int j = 0; j < 4; ++j) { const size_t o = (size_t)row * DM + 4 * lane + 256 * j;
                    f32x4 xv; if (l == 0) xv = *(const f32x4*)(x_in + o); else { const u32x2 xw = *(const u32x2*)(XB + o); xv = (f32x4){bflo(xw.x), bfhi(xw.x), bflo(xw.y), bfhi(xw.y)}; }
                    const u32x2 yw = *(const u32x2*)(UB + o); const f32x4 yv = (f32x4){bflo(yw.x), bfhi(yw.x), bflo(yw.y), bfhi(yw.y)};
                    v[j] = xv * ALPHA + g1[j] * yv; s += (v[j][0] + v[j][1]) + (v[j][2] + v[j][3]); }
                const float mean = wave_sum(s) * (1.f / DM); float s2 = 0.f;
#pragma unroll
                for (int j = 0; j < 4; ++j) { v[j] = v[j] - mean; s2 += (v[j][0] * v[j][0] + v[j][1] * v[j][1]) + (v[j][2] * v[j][2] + v[j][3] * v[j][3]); }
                const float rstd = 1.f / sqrtf(wave_sum(s2) * (1.f / DM) + LN_EPS);
#pragma unroll
                for (int j = 0; j < 4; ++j) { const size_t o = (size_t)row * DM + 4 * lane + 256 * j; const f32x4 xn = v[j] * rstd * gv[j] + bv[j];
                    u32x2 xw; xw.x = pk2(xn[0], xn[1]); xw.y = pk2(xn[2], xn[3]); *(u32x2*)(XB + o) = xw;
                    const f32x4 u = xn * sc[j] + sh[j]; u32x2 w; w.x = pk2(u[0], u[1]); w.y = pk2(u[2], u[3]); *(u32x2*)(UB + o) = w; }
            }
            VM_WAIT(); __syncthreads();
            { f32x4 acc[2] = {(f32x4){0.f, 0.f, 0.f, 0.f}, (f32x4){0.f, 0.f, 0.f, 0.f}};
              rows16_mm<2>(acc, UB + (size_t)rowb * DM, Rt, TBP, lane);
              const int lr = lane & 15, lq = lane >> 4;
#pragma unroll
              for (int r = 0; r < 4; ++r) lgs[(lq * 4 + r) * 16 + lr] = acc[0][r] + acc[1][r]; }
            LDS_WAIT(); asm volatile("" ::: "memory");
            if (lane < 16) {
                const int row = rowb + lane; const float* rb = AIN(I_RB);
                float sco[16], bia[16];
#pragma unroll
                for (int q = 0; q < 4; ++q) { const f32x4 t4 = *(const LAS f32x4*)(lgs + lane * 16 + q * 4);
#pragma unroll
                    for (int c = 0; c < 4; ++c) { const float sg = 1.f / (1.f + __expf(-t4[c])); sco[q * 4 + c] = sg; bia[q * 4 + c] = sg + rb[q * 4 + c]; } }
                int bg = 0; float bgs = -INFINITY;
#pragma unroll
                for (int g = 0; g < 4; ++g) { const float a0 = bia[4 * g], a1 = bia[4 * g + 1], a2 = bia[4 * g + 2], a3 = bia[4 * g + 3];
                    const float h1 = fmaxf(a0, a1), l1 = fminf(a0, a1), h2 = fmaxf(a2, a3), l2 = fminf(a2, a3);
                    const float top = fmaxf(h1, h2), sec = fmaxf(fminf(h1, h2), (h1 >= h2) ? l1 : l2); const float gsc = top + sec;
                    if (gsc > bgs) { bgs = gsc; bg = g; } }
                float gb[4], gsx[4];
#pragma unroll
                for (int q = 0; q < 4; ++q) { gb[q] = (bg == 0) ? bia[q] : (bg == 1) ? bia[4 + q] : (bg == 2) ? bia[8 + q] : bia[12 + q]; gsx[q] = (bg == 0) ? sco[q] : (bg == 1) ? sco[4 + q] : (bg == 2) ? sco[8 + q] : sco[12 + q]; }
                int e1 = 0; float m1 = gb[0];
#pragma unroll
                for (int q = 1; q < 4; ++q) if (gb[q] > m1) { m1 = gb[q]; e1 = q; }
                int e2 = -1; float m2 = -INFINITY;
#pragma unroll
                for (int q = 0; q < 4; ++q) if (q != e1 && gb[q] > m2) { m2 = gb[q]; e2 = q; }
                const int ei = e1 < e2 ? e1 : e2, ej = e1 < e2 ? e2 : e1;
                const float si = (ei == 0) ? gsx[0] : (ei == 1) ? gsx[1] : (ei == 2) ? gsx[2] : gsx[3], sj = (ej == 0) ? gsx[0] : (ej == 1) ? gsx[1] : (ej == 2) ? gsx[2] : gsx[3];
                const int pr_ = (ei == 0) ? ej - 1 : (ei == 1) ? ej + 1 : 5; const int bk = bg * 6 + pr_;
                gu32* cntw = F.ctl + CW_CNT + (size_t)l * NBUCKET * 64;
                const unsigned pos = __hip_atomic_fetch_add(cntw + bk * 64, 1u, RLX_AGENT);
                LTOK[(size_t)bk * LCAP + pos] = row; const float inv = 1.f / (si + sj); LGATE[((size_t)bk * LCAP + pos) * 2] = si * inv; LGATE[((size_t)bk * LCAP + pos) * 2 + 1] = sj * inv;
                TOKSLOT[row] = (bk << 16) | (int)pos;
            }
            __syncthreads();
        }
        SEAM(pb + 5);
        if ((IN(pb + 6) || IN(pb + 7)) && PHON(8)) {
            PHASE_IDS();
            LAS int* tb = (LAS int*)(F.lds + MOE_TB_OFF);
            if (tid == 0) { gu32* cntw = F.ctl + CW_CNT + (size_t)l * NBUCKET * 64; int acc = 0;
                for (int k = 0; k < NBUCKET; ++k) { const int c = (int)__hip_atomic_load(cntw + k * 64, RLX_AGENT); tb[k] = c; tb[32 + k] = acc; acc += (c + 255) >> 8; }
                tb[32 + NBUCKET] = acc; }
            __syncthreads();
            if (IN(pb + 6)) {
                gm::K4 k; k.U = UB; k.Wgu = WGU; k.H = HB; k.ltok = LTOK; k.lgate = LGATE; k.tb = tb; k.G = F.G; k.vcu = F.vcu;
                for (int rp = 0; rp < NREP(8); ++rp) gm::gemm_phase<gm::K4>(F.lds, k);
            }
            SEAM(pb + 6);
            if (IN(pb + 7)) {
                gm::K5 k; k.H = HB; k.Wd = WD; k.Y = YSORT; k.tb = tb; k.G = F.G; k.vcu = F.vcu;
                gm::gemm_phase<gm::K5>(F.lds, k);
            }
        }
        SEAM(pb + 7);
        if (IN(pb + 8) && PHON(9)) {
            PHASE_IDS();
            const int b = F.vcu >> 5; const bool lastl = (l == DEPTH - 1);
            LAS bf16_t* Wt = (LAS bf16_t*)F.lds; LAS int* t0 = (LAS int*)(F.lds + MOE_TB_OFF);
            if (!lastl) load_tail_w(Wt, WIN + ((size_t)(l + 1) * PW + PP) * DM, tid);
            if (tid == 0) { gu32* cntw = F.ctl + CW_CNT + (size_t)l * NBUCKET * 64; int acc = 0;
                for (int k = 0; k < NBUCKET; ++k) { const int c = (int)__hip_atomic_load(cntw + k * 64, RLX_AGENT); t0[32 + k] = acc; acc += (c + 255) >> 8; } }
            __syncthreads();
            const float* mdn = MOD + ((size_t)(lastl ? l : l + 1) * NB + b) * 6144; const float* md = modl + (size_t)b * 6144;
            const float* lg = AIN(I_LN2G) + l * DM; const float* lb = AIN(I_LN2B) + l * DM;
            f32x4 gv[4], bv[4], sh[4], sc[4], g2[4];
#pragma unroll
            for (int j = 0; j < 4; ++j) { const int cix = 4 * lane + 256 * j; gv[j] = *(const f32x4*)(lg + cix); bv[j] = *(const f32x4*)(lb + cix); g2[j] = *(const f32x4*)(md + 5 * 1024 + cix) + 1.0f;
                sh[j] = *(const f32x4*)(mdn + cix); sc[j] = *(const f32x4*)(mdn + 1024 + cix) + 1.0f; }
            const int rowb = F.vcu * 128 + wid * 16;
            for (int i = 0; i < 16; ++i) { const int row = rowb + i;
                const int ts = TOKSLOT[row]; const size_t yrow = (size_t)t0[32 + (ts >> 16)] * 256 + (ts & 0xffff);
                f32x4 v[4]; float s = 0.f;
#pragma unroll
                for (int j = 0; j < 4; ++j) { const int cix = 4 * lane + 256 * j;
                    const u32x2 xw = *(const u32x2*)(XB + (size_t)row * DM + cix); const f32x4 xv = (f32x4){bflo(xw.x), bfhi(xw.x), bflo(xw.y), bfhi(xw.y)};
                    const u32x2 yw = *(const u32x2*)(YSORT + yrow * DM + cix); const f32x4 yv = (f32x4){bflo(yw.x), bfhi(yw.x), bflo(yw.y), bfhi(yw.y)};
                    v[j] = xv * ALPHA + g2[j] * yv; s += (v[j][0] + v[j][1]) + (v[j][2] + v[j][3]); }
                const float mean = wave_sum(s) * (1.f / DM); float s2 = 0.f;
#pragma unroll
                for (int j = 0; j < 4; ++j) { v[j] = v[j] - mean; s2 += (v[j][0] * v[j][0] + v[j][1] * v[j][1]) + (v[j][2] * v[j][2] + v[j][3] * v[j][3]); }
                const float rstd = 1.f / sqrtf(wave_sum(s2) * (1.f / DM) + LN_EPS);
#pragma unroll
                for (int j = 0; j < 4; ++j) { const size_t o = (size_t)row * DM + 4 * lane + 256 * j; const f32x4 xn = v[j] * rstd * gv[j] + bv[j];
                    if (lastl) *(f32x4*)(ap->out + o) = xn;
                    else { u32x2 xw; xw.x = pk2(xn[0], xn[1]); xw.y = pk2(xn[2], xn[3]); *(u32x2*)(XB + o) = xw;
                        const f32x4 u = xn * sc[j] + sh[j]; u32x2 w; w.x = pk2(u[0], u[1]); w.y = pk2(u[2], u[3]); *(u32x2*)(UB + o) = w; } }
            }
            if (!lastl) { VM_WAIT(); __syncthreads(); tail16(UB + (size_t)rowb * DM, Wt, TAILB + (size_t)rowb * 32, lane); }
        }
        SEAM(pb + 8);
    }
#undef IN
#undef SEAM
}

extern "C" void kernel_launch(void* const* d_in, const int* in_sizes, int n_in, void* d_out, int out_size, void* d_ws, size_t ws_size, hipStream_t stream) {
    static int grid = 0;
    if (grid == 0) {
        if (n_in != 29 || in_sizes[0] != NTOK * DM || out_size != NTOK * DM || ws_size < WS_END) {
            fprintf(stderr, "kernel_launch: unexpected shapes (n_in %d, in0 %d, out %d, ws %zu need %zu); nothing launched\n", n_in, n_in > 0 ? in_sizes[0] : -1, out_size, ws_size, (size_t)WS_END); grid = -1; return; }
        int dev = 0, cus = 0, per_cu = 0;
        if (hipGetDevice(&dev) != hipSuccess || hipDeviceGetAttribute(&cus, hipDeviceAttributeMultiprocessorCount, dev) != hipSuccess) { grid = -1; return; }
        if (hipFuncSetAttribute((const void*)mega_fwd, hipFuncAttributeMaxDynamicSharedMemorySize, LDS_BYTES) != hipSuccess) { fprintf(stderr, "kernel_launch: hipFuncSetAttribute failed\n"); grid = -1; return; }
        if (hipOccupancyMaxActiveBlocksPerMultiprocessor(&per_cu, (const void*)mega_fwd, 512, LDS_BYTES) != hipSuccess || per_cu < 1) { fprintf(stderr, "kernel_launch: occupancy query reports %d\n", per_cu); }
        (void)hipGetLastError();
        grid = cus;
        if (grid != 256) fprintf(stderr, "kernel_launch: %d CUs (row phases assume 256)\n", grid);
    }
    if (grid < 0) return;
    if (hipMemsetAsync((char*)d_ws + WS_CTL, 0, CTL_ZERO_BYTES, stream) != hipSuccess) return;
    Args a{};
    for (int i = 0; i < 29; ++i) a.in[i] = (const float*)d_in[i];
    a.out = (float*)d_out; a.ws = (unsigned char*)d_ws;
#if MK_ONE_LAUNCH
    a.ph_lo = 0; a.ph_hi = N_PHASES;
    hipLaunchKernelGGL(mega_fwd, dim3(grid), dim3(512), LDS_BYTES, stream, a);
#else
    for (int p = 0; p < N_PHASES; ++p) { a.ph_lo = p; a.ph_hi = p + 1; hipLaunchKernelGGL(mega_fwd, dim3(grid), dim3(512), LDS_BYTES, stream, a); }
#endif
}
```

```cpp
#include <hip/hip_runtime.h>
#include <hip/hip_bf16.h>
#include <cstdio>
#include <cstdint>
#include <cmath>

#ifndef MK_ONE_LAUNCH
#define MK_ONE_LAUNCH 1
#endif
#ifndef PHM
#define PHM 0xFFFF
#endif
#define PHON(n) (((PHM) >> (n)) & 1)
#ifndef REPM
#define REPM 0
#endif
#define NREP(n) ((((REPM) >> (n)) & 1) ? 2 : 1)

#define LAS __attribute__((address_space(3)))
#define GAS __attribute__((address_space(1)))
typedef unsigned short bf16_t;
typedef short bf16x8 __attribute__((ext_vector_type(8)));
typedef float f32x4 __attribute__((ext_vector_type(4)));
typedef float f32x2 __attribute__((ext_vector_type(2)));
typedef unsigned u32x4 __attribute__((ext_vector_type(4)));
typedef unsigned u32x2 __attribute__((ext_vector_type(2)));
typedef GAS unsigned gu32;

constexpr int NB = 8, SEQ = 4096, NTOK = NB * SEQ, DM = 1024, DEPTH = 4, NH = 4, HD = 64, PIN = 3608, PP = 3584, PW = 3840, NE = 16, DE = 512;
constexpr int NCH = SEQ / 64;
constexpr float ALPHA = 1.6817928305074290f;
constexpr float LN_EPS = 1e-6f;
constexpr float ATT_C2 = 0.17677669529663687f * 1.4426950408889634f;
constexpr int NBUCKET = 24, LCAP = NTOK;
constexpr int C_MQ = 0, C_MK = 256, C_MV = 512, C_MO = 768, C_CB = 1024, C_CC = 1280, C_CH = 1536, C_DQ = 1792, C_DK = 2048, C_DV = 2304,
              C_GQ = 2560, C_GK = 2816, C_GV = 3072, C_GR = 3328;
constexpr int T_GA = 0, T_MI = 16, T_MF = 20;

constexpr size_t MiB = 1u << 20;
constexpr size_t WS_CTL = 0, CTL_ZERO_BYTES = 1 * MiB;
constexpr size_t WS_MOD = 1 * MiB;
constexpr size_t WS_ROPE = 2 * MiB;
constexpr size_t WS_WIN = 3 * MiB;
constexpr size_t WS_WOUT = 33 * MiB;
constexpr size_t WS_WGU = 41 * MiB;
constexpr size_t WS_WD = 73 * MiB;
constexpr size_t WS_LTOK = 89 * MiB;
constexpr size_t WS_LGATE = 92 * MiB;
constexpr size_t WS_SM = 98 * MiB;
constexpr size_t WS_PROJ = 100 * MiB;
constexpr size_t WS_XR = 340 * MiB;
constexpr size_t WS_U = 468 * MiB;
constexpr size_t WS_YCAT = 532 * MiB;
constexpr size_t WS_TAIL = 596 * MiB;
constexpr size_t WS_YSORT = WS_PROJ + 100 * MiB;
constexpr size_t WS_END = 600 * MiB;
constexpr size_t SM_N = 0, SM_BC = 512 * 1024, SM_DM = 520 * 1024, SM_MS = 528 * 1024, SM_GBE = 1 * MiB, SM_TS = 1536 * 1024;
constexpr int CW_TMO = 0, CW_CODE = 1, CW_ZPAGE = 256, CW_BAR = 4096, CW_CNT = 16384;
constexpr int RING_BYTES = 131072, LDSCTL_OFF = RING_BYTES, MISC_OFF = LDSCTL_OFF + 320, MOE_TB_OFF = LDSCTL_OFF + 1024, LDS_BYTES = 147456;

#define RLX_AGENT __ATOMIC_RELAXED, __HIP_MEMORY_SCOPE_AGENT
#define LDS_WAIT() asm volatile("s_waitcnt lgkmcnt(0)" ::: "memory")
#define VM_WAIT() asm volatile("s_waitcnt vmcnt(0)" ::: "memory")

__device__ __forceinline__ unsigned f2bf(float f) { unsigned u = __builtin_bit_cast(unsigned, f); return (u + 0x7fffu + ((u >> 16) & 1u)) >> 16; }
__device__ __forceinline__ unsigned pk2(float lo, float hi) { typedef __bf16 bf2 __attribute__((ext_vector_type(2))); f32x2 v = {lo, hi}; bf2 b = __builtin_convertvector(v, bf2); return __builtin_bit_cast(unsigned, b); }
__device__ __forceinline__ float bf2f(unsigned b) { return __builtin_bit_cast(float, b << 16); }
__device__ __forceinline__ float bflo(unsigned w) { return __builtin_bit_cast(float, w << 16); }
__device__ __forceinline__ float bfhi(unsigned w) { return __builtin_bit_cast(float, w & 0xffff0000u); }
__device__ __forceinline__ float wave_sum(float v) {
#pragma unroll
    for (int o = 1; o < 64; o <<= 1) v += __shfl_xor(v, o);
    return v;
}
__device__ __forceinline__ float wave_max(float v) {
#pragma unroll
    for (int o = 1; o < 64; o <<= 1) v = fmaxf(v, __shfl_xor(v, o));
    return v;
}
__device__ __forceinline__ float logsig(float z) { return fminf(z, 0.f) - __logf(1.f + __expf(-fabsf(z))); }
__device__ __forceinline__ float sigmoidf_(float z) { return 1.f / (1.f + __expf(-z)); }

#define XB_TMO      128
#define XB_XCNT(j)  (256  + 64 * (j))
#define XB_XSUB(j)  (1280 + 64 * (j))
#define XB_XGEN(j)  (2304 + 64 * (j))
#define XB_TOP      3328
#define XB_TOPGEN   3392
#define XCD_BAR_WORDS 3456
#define XB_SPIN_CAP (1u << 18)
__device__ __forceinline__ unsigned xb_ld(unsigned* p)              { return __hip_atomic_load(p, __ATOMIC_RELAXED, __HIP_MEMORY_SCOPE_AGENT); }
__device__ __forceinline__ unsigned xb_add(unsigned* p, unsigned v) { return __hip_atomic_fetch_add(p, v, __ATOMIC_RELAXED, __HIP_MEMORY_SCOPE_AGENT); }
__device__ __forceinline__ unsigned xb_xcc_id() { return (unsigned)__builtin_amdgcn_s_getreg((3 << 11) | 20) & 0xFu; }
#define XB_SPIN(cond, bar) do { unsigned _sp = 0; while (cond) { __builtin_amdgcn_s_sleep(1); \
    if ((++_sp & 255u) == 0u) { if (xb_ld(&(bar)[XB_TMO])) break; if (_sp > XB_SPIN_CAP) { atomicAdd(&(bar)[XB_TMO], 1u); break; } } } } while (0)
struct XcdBarrier { unsigned* bar; unsigned x; volatile LAS unsigned* st; };
__device__ __forceinline__ XcdBarrier xcd_barrier_post(unsigned* bar, volatile LAS unsigned* st) {
    XcdBarrier b; b.bar = bar; b.x = xb_xcc_id(); b.st = st;
    if (threadIdx.x == 0) (void)xb_add(&bar[XB_XCNT(b.x)], 1u);
    return b;
}
__device__ __forceinline__ void xcd_barrier_complete(unsigned* bar, unsigned x, unsigned& nloc, unsigned& nx) {
    const unsigned G = gridDim.x * gridDim.y * gridDim.z;
    unsigned sum, cnt, mine, sp = 0u;
    for (;;) {
        sum = 0u; cnt = 0u; mine = 0u;
#pragma unroll
        for (unsigned j = 0; j < 16; ++j) { const unsigned c = xb_ld(&bar[XB_XCNT(j)]); sum += c; cnt += (c > 0u) ? 1u : 0u; mine = (j == x) ? c : mine; }
        if (sum == G) break;
        __builtin_amdgcn_s_sleep(1);
        if ((++sp & 255u) == 0u) { if (xb_ld(&bar[XB_TMO])) break; if (sp > XB_SPIN_CAP) { atomicAdd(&bar[XB_TMO], 1u); break; } }
    }
    nloc = mine > 0u ? mine : 1u; nx = cnt > 0u ? cnt : 1u;
}
__device__ __forceinline__ void xcd_barrier(const XcdBarrier& b) {
    asm volatile("s_waitcnt vmcnt(0)" ::: "memory");
    __syncthreads();
    if (threadIdx.x == 0) {
        unsigned* bar = b.bar;
        __builtin_amdgcn_s_waitcnt(0);
        unsigned nloc = b.st[0], nx = b.st[1];
        if (nloc == 0u) { xcd_barrier_complete(bar, b.x, nloc, nx); b.st[0] = nloc; b.st[1] = nx; }
        const unsigned old = xb_add(&bar[XB_XSUB(b.x)], 1u);
        const unsigned gen = old / nloc;
        if (old + 1u == (gen + 1u) * nloc) {
            __builtin_amdgcn_fence(__ATOMIC_RELEASE, "agent");
            asm volatile("s_waitcnt vmcnt(0)" ::: "memory");
            const unsigned og = xb_add(&bar[XB_TOP], 1u);
            const unsigned tg = og / nx;
            if (og + 1u == (tg + 1u) * nx) xb_add(&bar[XB_TOPGEN], 1u);
            else XB_SPIN(xb_ld(&bar[XB_TOPGEN]) == tg, bar);
            __builtin_amdgcn_fence(__ATOMIC_ACQUIRE, "agent");
            xb_add(&bar[XB_XGEN(b.x)], 1u);
            asm volatile("s_waitcnt vmcnt(0)" ::: "memory");
        } else {
            XB_SPIN(xb_ld(&bar[XB_XGEN(b.x)]) == gen, bar);
            __builtin_amdgcn_fence(__ATOMIC_ACQUIRE, "agent");
            asm volatile("s_waitcnt vmcnt(0)" ::: "memory");
        }
    }
    __syncthreads();
}

namespace gm {
constexpr int BM = 256, BK = 64, HALF = 128, HTB = HALF * BK * 2, NT = 16, NXCD = 8, WGM = 8;
__host__ __device__ __forceinline__ int lds_byte(int r, int c) { const int st = (r >> 4) * 2 + (c >> 5), rr = r & 15, cc = c & 31, ob = rr * 64 + cc * 2; return st * 1024 + (ob ^ (((ob >> 9) & 1) << 5)); }
__host__ __device__ __forceinline__ void stage_rc(int b, int& R, int& C) { const int st = b / 1024, sb = b % 1024, swz = sb ^ (((sb >> 9) & 1) << 5); R = (st >> 1) * 16 + swz / 64; C = (st & 1) * 32 + (swz % 64) / 2; }
__host__ __device__ __forceinline__ int perm32(int rho) { const int n = rho >> 4, i = rho & 15; return 8 * (i >> 2) + 4 * n + (i & 3); }
struct Unit { int pm, pn, bk, tb; };
struct Src { const char* a; const char* b0; const char* b1; unsigned va[2][2]; };
struct StaticOrder {
    int nM, nN, nwg, G, c;
    __device__ void init(int M, int N, int G_, int c_) { nM = M / BM; nN = N / BM; nwg = nM * nN; G = G_; c = c_; }
    __device__ __forceinline__ bool next(int i, Unit& u) const {
        const long L = (long)i * G + c; if (L >= nwg) return false;
        int wgid = (int)L; { const int q = nwg / NXCD, r = nwg % NXCD, xcd = wgid % NXCD, off = wgid / NXCD; wgid = (xcd < r ? xcd * (q + 1) : r * (q + 1) + (xcd - r) * q) + off; }
        const int nig = WGM * nN, gid = wgid / nig, fm = gid * WGM, gsz = (nM - fm) < WGM ? (nM - fm) : WGM;
        u.pm = fm + ((wgid % nig) % gsz); u.pn = (wgid % nig) / gsz; u.bk = 0; u.tb = 0; return true;
    }
};

template <class Kind>
__device__ __forceinline__ void gemm_phase(LAS unsigned char* lds, const Kind& Kd) {
    int tid_ = threadIdx.x; asm volatile("" : "+v"(tid_));
    const int tid = tid_, wid = __builtin_amdgcn_readfirstlane(tid >> 6), lane = tid & 63, wr = wid >> 2, wc = wid & 3, fr = lane & 15, fq = lane >> 4;
    int R[2], C[2]; unsigned voffB[2];
#pragma unroll
    for (int i = 0; i < 2; ++i) { stage_rc(tid * 16 + i * 8192, R[i], C[i]); const int Rb = Kind::PERM ? ((R[i] & ~31) + perm32(R[i] & 31)) : R[i]; voffB[i] = (unsigned)(Rb * Kind::LDB + C[i]) * 2u; }
    const size_t hstepB = (size_t)HALF * Kind::LDB * 2;
    const unsigned ldsw = (unsigned)wid * 1024u;
    const int aoff = lds_byte(wr * 64 + fr, fq * 8), boff = lds_byte(wc * 32 + fr, fq * 8);
#define G_SA(b, h) (((b) * 2 + (h)) * HTB)
#define G_SB(b, h) ((4 + (b) * 2 + (h)) * HTB)
#define G_STAGE_A(bufoff, S, t, h) do { const char* _g = (S).a + (size_t)(t) * 128; _Pragma("unroll") for (int _i = 0; _i < 2; ++_i) \
        __builtin_amdgcn_global_load_lds((const unsigned*)(_g + (S).va[h][_i]), (LAS unsigned*)(lds + (bufoff) + ldsw + _i * 8192), 16, 0, 0); } while (0)
#define G_STAGE_B(bufoff, S, t, h) do { const char* _g = (((t) < 8) ? (S).b0 + (size_t)(t) * 128 : (S).b1 + (size_t)((t) - 8) * 128) + (h) * hstepB; _Pragma("unroll") for (int _i = 0; _i < 2; ++_i) \
        __builtin_amdgcn_global_load_lds((const unsigned*)(_g + voffB[_i]), (LAS unsigned*)(lds + (bufoff) + ldsw + _i * 8192), 16, 0, 0); } while (0)
#define G_LDA(dst, b, h) do { _Pragma("unroll") for (int m = 0; m < 4; ++m) _Pragma("unroll") for (int k = 0; k < 2; ++k) dst[m][k] = *(const LAS bf16x8*)(lds + G_SA(b, h) + aoff + m * 2048 + k * 1024); } while (0)
#define G_LDB(dst, b, h) do { _Pragma("unroll") for (int n = 0; n < 2; ++n) _Pragma("unroll") for (int k = 0; k < 2; ++k) dst[n][k] = *(const LAS bf16x8*)(lds + G_SB(b, h) + boff + n * 2048 + k * 1024); } while (0)
#define G_MMA(ai, bj, At, Bt) do { __builtin_amdgcn_s_setprio(1); _Pragma("unroll") for (int m = 0; m < 4; ++m) _Pragma("unroll") for (int n = 0; n < 2; ++n) _Pragma("unroll") for (int k = 0; k < 2; ++k) \
        acc[ai][bj][m][n] = __builtin_amdgcn_mfma_f32_16x16x32_bf16(Bt[n][k], At[m][k], acc[ai][bj][m][n], 0, 0, 0); __builtin_amdgcn_s_setprio(0); } while (0)
#define G_WAIT_V(n) asm volatile("s_waitcnt vmcnt(" #n ")" ::: "memory")
#define G_WAIT_L(n) asm volatile("s_waitcnt lgkmcnt(" #n ")" ::: "memory")
#define G_BAR __builtin_amdgcn_s_barrier()
#define G_SCHED __builtin_amdgcn_sched_barrier(0)
    Unit cur, nxt; Src sc, sn; int ui = 0;
    if (!Kd.next(0, cur)) return;
    Kd.src(cur, sc, R, C);
    f32x4 acc[2][2][4][2];
#pragma unroll
    for (int a = 0; a < 2; ++a)
#pragma unroll
        for (int b = 0; b < 2; ++b)
#pragma unroll
            for (int m = 0; m < 4; ++m)
#pragma unroll
                for (int n = 0; n < 2; ++n) acc[a][b][m][n] = (f32x4){0.f, 0.f, 0.f, 0.f};
    bf16x8 At[4][2], B0[2][2], B1[2][2];
    G_STAGE_B(G_SB(0, 0), sc, 0, 0); G_STAGE_B(G_SB(0, 1), sc, 0, 1); G_STAGE_A(G_SA(0, 0), sc, 0, 0); G_STAGE_A(G_SA(0, 1), sc, 0, 1);
    if (wr == 1) G_BAR;
    G_WAIT_V(2); G_BAR;
    G_STAGE_B(G_SB(1, 0), sc, 1, 0); G_STAGE_A(G_SA(1, 0), sc, 1, 0); G_STAGE_B(G_SB(1, 1), sc, 1, 1);
    G_WAIT_V(6); G_BAR;
    for (;;) {
        const bool has_next = Kd.next(ui + 1, nxt);
        if (has_next) Kd.src(nxt, sn, R, C); else sn = sc;
        for (int t = 0; t < NT; t += 2) {
            const bool last = (t == NT - 2);
            Src s2; s2.a = last ? sn.a : sc.a; s2.b0 = last ? sn.b0 : sc.b0; s2.b1 = last ? sn.b1 : sc.b1;
            s2.va[0][0] = last ? sn.va[0][0] : sc.va[0][0]; s2.va[0][1] = last ? sn.va[0][1] : sc.va[0][1]; s2.va[1][0] = last ? sn.va[1][0] : sc.va[1][0]; s2.va[1][1] = last ? sn.va[1][1] : sc.va[1][1];
            const int t2 = last ? 0 : t + 2, t3 = t2 + 1;
            G_LDB(B0, 0, 0); G_LDB(B1, 0, 1); G_SCHED; G_LDA(At, 0, 0); G_STAGE_A(G_SA(1, 1), sc, t + 1, 1);
            G_WAIT_V(8); G_WAIT_L(0); G_BAR; G_MMA(0, 0, At, B0); G_MMA(0, 1, At, B1); G_BAR; G_SCHED;
            G_LDA(At, 0, 1); G_STAGE_B(G_SB(0, 0), s2, t2, 0); G_STAGE_B(G_SB(0, 1), s2, t2, 1); G_STAGE_A(G_SA(0, 0), s2, t2, 0);
            G_WAIT_V(8); G_WAIT_L(0); G_BAR; G_MMA(1, 0, At, B0); G_MMA(1, 1, At, B1); G_BAR; G_SCHED;
            G_LDB(B0, 1, 0); G_LDB(B1, 1, 1); G_SCHED; G_LDA(At, 1, 0); G_STAGE_A(G_SA(0, 1), s2, t2, 1);
            G_WAIT_V(8); G_WAIT_L(0); G_BAR; G_MMA(0, 0, At, B0); G_MMA(0, 1, At, B1); G_BAR; G_SCHED;
            G_LDA(At, 1, 1); G_STAGE_B(G_SB(1, 0), s2, t3, 0); G_STAGE_B(G_SB(1, 1), s2, t3, 1); G_STAGE_A(G_SA(1, 0), s2, t3, 0);
            G_WAIT_V(8); G_WAIT_L(0); G_BAR; G_MMA(1, 0, At, B0); G_MMA(1, 1, At, B1); G_BAR; G_SCHED;
        }
        if (wr == 0) G_BAR;
        Kd.epi(acc, cur, wr, wc, fr, fq);
        if (!has_next) break;
#pragma unroll
        for (int a = 0; a < 2; ++a)
#pragma unroll
            for (int b = 0; b < 2; ++b)
#pragma unroll
                for (int m = 0; m < 4; ++m)
#pragma unroll
                    for (int n = 0; n < 2; ++n) acc[a][b][m][n] = (f32x4){0.f, 0.f, 0.f, 0.f};
        cur = nxt; sc = sn; ++ui;
        if (wr == 1) G_BAR;
    }
    G_WAIT_V(0);
    G_BAR;
#undef G_SA
#undef G_SB
#undef G_STAGE_A
#undef G_STAGE_B
#undef G_LDA
#undef G_LDB
#undef G_MMA
#undef G_WAIT_V
#undef G_WAIT_L
#undef G_BAR
#undef G_SCHED
}

__device__ __forceinline__ void src_direct(Src& s, const bf16_t* A, int row0, const int (&R)[2], const int (&C)[2]) {
    s.a = (const char*)(A + (size_t)row0 * 1024);
#pragma unroll
    for (int h = 0; h < 2; ++h)
#pragma unroll
        for (int i = 0; i < 2; ++i) s.va[h][i] = (unsigned)((h * HALF + R[i]) * 1024 + C[i]) * 2u;
}

struct K1 {
    static constexpr bool PERM = true; static constexpr int LDB = 1024;
    StaticOrder S; const bf16_t* A; const bf16_t* Bt; bf16_t* O; const float* rope;
    __device__ __forceinline__ bool next(int i, Unit& u) const { return S.next(i, u); }
    __device__ __forceinline__ void src(const Unit& u, Src& s, const int (&R)[2], const int (&C)[2]) const {
        src_direct(s, A, u.pm * BM, R, C); s.b0 = (const char*)(Bt + (size_t)u.pn * BM * 1024); s.b1 = s.b0 + 1024;
    }
    __device__ __forceinline__ void epi(const f32x4 (&acc)[2][2][4][2], const Unit& u, int wr, int wc, int fr, int fq) const {
        const int row0 = u.pm * BM + wr * 64 + fr, col0 = u.pn * BM + wc * 32 + 8 * fq;
        const int ty = (u.pn == 0 || u.pn == 10) ? 1 : (u.pn == 7) ? 2 : (u.pn == 8) ? 3 : 0;
#pragma unroll
        for (int ai = 0; ai < 2; ++ai)
#pragma unroll
            for (int m = 0; m < 4; ++m) {
                const int row = row0 + ai * HALF + m * 16;
                f32x4 cs = (f32x4){1.f, 1.f, 1.f, 1.f}, sn = (f32x4){0.f, 0.f, 0.f, 0.f};
                if (ty >= 2) { cs = *(const f32x4*)(rope + (size_t)row * 8); sn = *(const f32x4*)(rope + (size_t)row * 8 + 4); }
                bf16_t* rowp = O + (size_t)row * PP + col0;
#pragma unroll
                for (int bj = 0; bj < 2; ++bj) {
                    f32x4 v0 = acc[ai][bj][m][0], v1 = acc[ai][bj][m][1];
                    if (ty == 1) { v0 = v0 * 0.125f; v1 = v1 * 0.125f; }
                    if (ty >= 2) {
                        if (fq == 0) { const f32x4 x1 = v0, x2 = v1; v0 = x1 * cs - x2 * sn; v1 = x2 * cs + x1 * sn; }
                        if (ty == 2) { v0 = v0 * ATT_C2; v1 = v1 * ATT_C2; }
                    }
                    u32x4 w; w.x = pk2(v0[0], v0[1]); w.y = pk2(v0[2], v0[3]); w.z = pk2(v1[0], v1[1]); w.w = pk2(v1[2], v1[3]);
                    *(u32x4*)(rowp + bj * HALF) = w;
                }
            }
    }
};
struct K2 {
    static constexpr bool PERM = true; static constexpr int LDB = 1024;
    StaticOrder S; const bf16_t* A; const bf16_t* Bt; bf16_t* O;
    __device__ __forceinline__ bool next(int i, Unit& u) const { return S.next(i, u); }
    __device__ __forceinline__ void src(const Unit& u, Src& s, const int (&R)[2], const int (&C)[2]) const {
        src_direct(s, A, u.pm * BM, R, C); s.b0 = (const char*)(Bt + (size_t)u.pn * BM * 1024); s.b1 = s.b0 + 1024;
    }
    __device__ __forceinline__ void epi(const f32x4 (&acc)[2][2][4][2], const Unit& u, int wr, int wc, int fr, int fq) const {
        const int row0 = u.pm * BM + wr * 64 + fr, col0 = u.pn * BM + wc * 32 + 8 * fq;
#pragma unroll
        for (int ai = 0; ai < 2; ++ai)
#pragma unroll
            for (int m = 0; m < 4; ++m) { bf16_t* rowp = O + (size_t)(row0 + ai * HALF + m * 16) * DM + col0;
#pragma unroll
                for (int bj = 0; bj < 2; ++bj) { const f32x4 v0 = acc[ai][bj][m][0], v1 = acc[ai][bj][m][1];
                    u32x4 w; w.x = pk2(v0[0], v0[1]); w.y = pk2(v0[2], v0[3]); w.z = pk2(v1[0], v1[1]); w.w = pk2(v1[2], v1[3]);
                    *(u32x4*)(rowp + bj * HALF) = w; } }
    }
};
__device__ __forceinline__ int pair_i(int p) { return p < 3 ? 0 : (p < 5 ? 1 : 2); }
__device__ __forceinline__ int pair_j(int p) { return p < 3 ? p + 1 : (p < 5 ? p - 1 : 3); }
struct K4 {
    static constexpr bool PERM = true; static constexpr int LDB = 1024;
    const bf16_t* U; const bf16_t* Wgu; bf16_t* H; const int* ltok; const float* lgate; const LAS int* tb; int G, vcu;
    __device__ __forceinline__ bool next(int i, Unit& u) const {
        const int L = i * G + vcu; const int nt = tb[32 + NBUCKET]; if (L >= nt * 8) return false;
        const int rt = L >> 3; int k = 0;
        for (int q = 1; q < NBUCKET; ++q) k = (tb[32 + q] <= rt) ? q : k;
        u.pm = rt; u.pn = L & 7; u.bk = k; u.tb = rt - tb[32 + k]; return true;
    }
    __device__ __forceinline__ void src(const Unit& u, Src& s, const int (&R)[2], const int (&C)[2]) const {
        const int cnt = tb[u.bk]; s.a = (const char*)U;
#pragma unroll
        for (int h = 0; h < 2; ++h)
#pragma unroll
            for (int i = 0; i < 2; ++i) { const int pos = u.tb * BM + h * HALF + R[i]; const int tok = ltok[(size_t)u.bk * LCAP + (pos < cnt ? pos : 0)]; s.va[h][i] = (unsigned)(tok * 1024 + C[i]) * 2u; }
        const int grp = u.bk / 6, p = u.bk % 6, sl = u.pn >> 2; const int e = grp * 4 + (sl ? pair_j(p) : pair_i(p));
        s.b0 = (const char*)(Wgu + ((size_t)e * 1024 + (size_t)(u.pn & 3) * BM) * 1024); s.b1 = s.b0 + 1024;
    }
    __device__ __forceinline__ void epi(const f32x4 (&acc)[2][2][4][2], const Unit& u, int wr, int wc, int fr, int fq) const {
        const int cnt = tb[u.bk], sl = u.pn >> 2; const int colo = sl * 512 + (u.pn & 3) * 128 + wc * 32 + 8 * fq;
#pragma unroll
        for (int ai = 0; ai < 2; ++ai)
#pragma unroll
            for (int m = 0; m < 4; ++m) {
                const int r = ai * HALF + wr * 64 + m * 16 + fr, pos = u.tb * BM + r;
                const float gt = (pos < cnt) ? lgate[((size_t)u.bk * LCAP + pos) * 2 + sl] : 0.f;
                float hv[8];
#pragma unroll
                for (int n = 0; n < 2; ++n)
#pragma unroll
                    for (int j = 0; j < 4; ++j) { const float g = acc[ai][0][m][n][j], up = acc[ai][1][m][n][j]; hv[n * 4 + j] = g * __builtin_amdgcn_rcpf(1.f + __expf(-g)) * up * gt; }
                u32x4 w; w.x = pk2(hv[0], hv[1]); w.y = pk2(hv[2], hv[3]); w.z = pk2(hv[4], hv[5]); w.w = pk2(hv[6], hv[7]);
                *(u32x4*)(H + (size_t)(u.pm * BM + r) * 1024 + colo) = w;
            }
    }
};
struct K5 {
    static constexpr bool PERM = true; static constexpr int LDB = 512;
    const bf16_t* H; const bf16_t* Wd; bf16_t* Y; const LAS int* tb; int G, vcu;
    __device__ __forceinline__ bool next(int i, Unit& u) const {
        const int L = i * G + vcu; const int nt = tb[32 + NBUCKET]; if (L >= nt * 4) return false;
        const int rt = L >> 2; int k = 0;
        for (int q = 1; q < NBUCKET; ++q) k = (tb[32 + q] <= rt) ? q : k;
        u.pm = rt; u.pn = L & 3; u.bk = k; u.tb = rt - tb[32 + k]; return true;
    }
    __device__ __forceinline__ void src(const Unit& u, Src& s, const int (&R)[2], const int (&C)[2]) const {
        src_direct(s, H, u.pm * BM, R, C);
        const int grp = u.bk / 6, p = u.bk % 6;
        s.b0 = (const char*)(Wd + ((size_t)(grp * 4 + pair_i(p)) * 1024 + (size_t)u.pn * BM) * 512);
        s.b1 = (const char*)(Wd + ((size_t)(grp * 4 + pair_j(p)) * 1024 + (size_t)u.pn * BM) * 512);
    }
    __device__ __forceinline__ void epi(const f32x4 (&acc)[2][2][4][2], const Unit& u, int wr, int wc, int fr, int fq) const {
        const int row0 = u.pm * BM + wr * 64 + fr, col0 = u.pn * BM + wc * 32 + 8 * fq;
#pragma unroll
        for (int ai = 0; ai < 2; ++ai)
#pragma unroll
            for (int m = 0; m < 4; ++m) { bf16_t* rowp = Y + (size_t)(row0 + ai * HALF + m * 16) * DM + col0;
#pragma unroll
                for (int bj = 0; bj < 2; ++bj) { const f32x4 v0 = acc[ai][bj][m][0], v1 = acc[ai][bj][m][1];
                    u32x4 w; w.x = pk2(v0[0], v0[1]); w.y = pk2(v0[2], v0[3]); w.z = pk2(v1[0], v1[1]); w.w = pk2(v1[2], v1[3]);
                    *(u32x4*)(rowp + bj * HALF) = w; } }
    }
};
}

namespace attn_body {
using bf16 = __hip_bfloat16;
using s16x4 = __attribute__((ext_vector_type(4))) short;
using f32x16 = __attribute__((ext_vector_type(16))) float;
constexpr int D = 64, PITCH = PP;
constexpr int NW = 8, QBLK = 32, QB = QBLK * NW, KVBLK = 64;
__device__ __forceinline__ int crow(int r, int hi) { return (r & 3) + 8 * (r >> 2) + 4 * hi; }
#define SBAR() __builtin_amdgcn_sched_barrier(0)
__device__ __forceinline__ void cmask(f32x16& p0, f32x16& p1, int jb, int qrel, int hi) {
    const float NEG = -INFINITY; int kb = 64 * jb + 4 * hi;
#pragma unroll
    for (int r = 0; r < 16; ++r) { int kv = kb + (r & 3) + 8 * (r >> 2); if (kv > qrel) p0[r] = NEG; if (kv + 32 > qrel) p1[r] = NEG; }
}
constexpr int NSLOT = 3, SLOTB = 8192;
constexpr int LDS_K = 0, LDS_V = NSLOT * SLOTB, LDS_WS = 2 * NSLOT * SLOTB, LDS_OST = LDS_WS + NW * 64 * 4, ATT_LDS_BYTES = LDS_OST + NW * 8192;
__device__ __forceinline__ void glds16(const void* gsrc, unsigned lds_dst) { unsigned keep;
    asm volatile("s_mov_b32 %0, m0\n\ts_mov_b32 m0, %2\n\ts_nop 0\n\tglobal_load_lds_dwordx4 %1, off\n\ts_mov_b32 m0, %0" : "=&s"(keep) : "v"(gsrc), "s"(lds_dst) : "memory"); }
__device__ __forceinline__ float max3f(float a, float b, float c) { float r; asm("v_max3_f32 %0, %1, %2, %3" : "=v"(r) : "v"(a), "v"(b), "v"(c)); return r; }
__device__ __forceinline__ float max2f(float a, float b) { float r; asm("v_max_f32_e32 %0, %1, %2" : "=v"(r) : "v"(a), "v"(b)); return r; }
__device__ __forceinline__ float fadd_s(float a, float b) { float r; asm("v_add_f32_e32 %0, %1, %2" : "=v"(r) : "v"(a), "v"(b)); return r; }
__device__ __forceinline__ float fsub_s(float a, float b) { float r; asm("v_sub_f32_e32 %0, %1, %2" : "=v"(r) : "v"(a), "v"(b)); return r; }
typedef float f32x2_t __attribute__((ext_vector_type(2))); typedef __bf16 bf16x2_t __attribute__((ext_vector_type(2)));
__device__ __forceinline__ unsigned cvtpk_s(float lo, float hi) { f32x2_t v = {lo, hi}; bf16x2_t b = __builtin_convertvector(v, bf16x2_t); return __builtin_bit_cast(unsigned, b); }
#define WAIT_BAR(N) asm volatile("s_waitcnt vmcnt(" #N ") lgkmcnt(0)\n\ts_barrier" ::: "memory")
__device__ __forceinline__ void qkt(f32x16& p0, f32x16& p1, const char* Kslot, const bf16x8* qr, const f32x16& negm, int r32, int hi) {
    const char* kb = Kslot + hi * 1024 + r32 * 16;
#pragma unroll
    for (int d0 = 0; d0 < 2; ++d0) {
        const bf16x8 b0 = *reinterpret_cast<const bf16x8*>(kb + d0 * 2048);
        const bf16x8 b1 = *reinterpret_cast<const bf16x8*>(kb + d0 * 2048 + 512);
        if (d0 == 0) { p0 = __builtin_amdgcn_mfma_f32_32x32x16_bf16(b0, qr[0], negm, 0, 0, 0); p1 = __builtin_amdgcn_mfma_f32_32x32x16_bf16(b1, qr[0], negm, 0, 0, 0); }
        else { p0 = __builtin_amdgcn_mfma_f32_32x32x16_bf16(b0, qr[d0], p0, 0, 0, 0); p1 = __builtin_amdgcn_mfma_f32_32x32x16_bf16(b1, qr[d0], p1, 0, 0, 0); } }
}
typedef __attribute__((address_space(3))) const char* lds_cptr;
typedef short v4i16_t __attribute__((ext_vector_type(4)));
__device__ __forceinline__ void kload8(bf16x8* kf, lds_cptr kp) {
    kf[0] = *(const __attribute__((address_space(3))) bf16x8*)(kp);        kf[1] = *(const __attribute__((address_space(3))) bf16x8*)(kp + 512);
    kf[2] = *(const __attribute__((address_space(3))) bf16x8*)(kp + 2048); kf[3] = *(const __attribute__((address_space(3))) bf16x8*)(kp + 2560);
}
__device__ __forceinline__ void kload2(bf16x8* kf, lds_cptr kp, int j) { kf[2 * j] = *(const __attribute__((address_space(3))) bf16x8*)(kp + j * 2048); kf[2 * j + 1] = *(const __attribute__((address_space(3))) bf16x8*)(kp + j * 2048 + 512); }
__device__ __forceinline__ s16x4 vtr(lds_cptr p) { return __builtin_bit_cast(s16x4, __builtin_amdgcn_ds_read_tr16_b64_v4i16((__attribute__((address_space(3))) v4i16_t*)p)); }
__device__ __forceinline__ float rowmax(const f32x16& p0, const f32x16& p1) {
    float a = max3f(p0[0], p0[1], p1[0]), b = max3f(p0[2], p0[3], p1[1]); a = max3f(a, p1[2], p1[3]);
#pragma unroll
    for (int r = 4; r < 16; r += 4) { a = max3f(a, p0[r], p0[r + 1]); b = max3f(b, p0[r + 2], p0[r + 3]); a = max3f(a, p1[r], p1[r + 1]); b = max3f(b, p1[r + 2], p1[r + 3]); }
    const float m = max2f(a, b);
    auto rr = __builtin_amdgcn_permlane32_swap(__float_as_uint(m), __float_as_uint(m), false, false);
    return max2f(__uint_as_float(rr[0]), __uint_as_float(rr[1]));
}
__device__ __forceinline__ void pv(f32x16* o, int vb, bf16x8 pa0, bf16x8 pa1, bf16x8 pa2, bf16x8 pa3) {
#pragma unroll
    for (int d0 = 0; d0 < 2; ++d0) { s16x4 lo[4], hi[4];
#pragma unroll
        for (int ks = 0; ks < 4; ++ks) {
            asm volatile("ds_read_b64_tr_b16 %0,%1 offset:%c2" : "=&v"(lo[ks]) : "v"(vb), "i"(d0 * 4096 + ks * 1024) : "memory");
            asm volatile("ds_read_b64_tr_b16 %0,%1 offset:%c2" : "=&v"(hi[ks]) : "v"(vb), "i"(d0 * 4096 + ks * 1024 + 512) : "memory"); }
        asm volatile("s_waitcnt lgkmcnt(0)" ::: "memory"); SBAR();
#define PK(k) (bf16x8){lo[k][0], lo[k][1], lo[k][2], lo[k][3], hi[k][0], hi[k][1], hi[k][2], hi[k][3]}
        o[d0] = __builtin_amdgcn_mfma_f32_32x32x16_bf16(pa0, PK(0), o[d0], 0, 0, 0);
        o[d0] = __builtin_amdgcn_mfma_f32_32x32x16_bf16(pa1, PK(1), o[d0], 0, 0, 0);
        o[d0] = __builtin_amdgcn_mfma_f32_32x32x16_bf16(pa2, PK(2), o[d0], 0, 0, 0);
        o[d0] = __builtin_amdgcn_mfma_f32_32x32x16_bf16(pa3, PK(3), o[d0], 0, 0, 0);
#undef PK
    }
}
struct AttnParams { const bf16* Q; const bf16* K; const bf16* V; const bf16* zpage; bf16_t* Y; const float* gnorm; float lam, osc; };
template <int THRL, int comp> __device__ __forceinline__ void attn_unit(int b, int h, int qb, const AttnParams& P, char* shm) {
    const bf16* Q = P.Q; const bf16* __restrict__ K = P.K; const bf16* __restrict__ V = P.V;
    int tid_ = threadIdx.x; asm volatile("" : "+v"(tid_));
    const int tid = tid_, lane = tid & 63, r32 = lane & 31, hi = lane >> 5; const int wid = __builtin_amdgcn_readfirstlane(tid >> 6);
    const long rowbase = (long)b * SEQ; const int q0 = qb * QB;
    const bf16* Qw = Q + (rowbase + q0 + wid * QBLK) * PITCH + h * D;
    const bf16* Kh = K + rowbase * PITCH + h * D, *Vh = V + rowbase * PITCH + h * D;
    const unsigned lds0 = (unsigned)(uintptr_t)shm;
    float* wsf = (float*)(shm + LDS_WS) + wid * 64;
    const bf16* ksrc = Kh + (long)(32 * (wid & 1) + (lane & 31)) * PITCH + comp * 32 + (wid >> 1) * 8;
    const bf16* vsrc = Vh + (long)(16 * (wid & 3) + (lane >> 2)) * PITCH + (wid >> 2) * 32 + (lane & 3) * 8;
    const unsigned kdst = lds0 + LDS_K + (wid >> 1) * 1024 + (wid & 1) * 512, vdst = lds0 + LDS_V + wid * 1024;
#define DMA_K(t, slot) do { if (lane < 32) glds16(ksrc + (long)(t) * KVBLK * PITCH, (unsigned)__builtin_amdgcn_readfirstlane(kdst + (slot))); } while (0)
#define DMA_V(t, slot) glds16(vsrc + (long)(t) * KVBLK * PITCH, (unsigned)__builtin_amdgcn_readfirstlane(vdst + (slot)))
    const int vb0 = (int)(lds0 + LDS_V) + ((lane >> 4) & 1) * 32 + (lane & 3) * 8 + (4 * hi + ((lane & 15) >> 2)) * 64;
    const char* Kbase = shm + LDS_K; bf16x8 kf[4];
    const lds_cptr shm3 = (lds_cptr)shm; const lds_cptr kp0 = shm3 + LDS_K + hi * 1024 + r32 * 16; const lds_cptr vp0 = shm3 + LDS_V + ((lane >> 4) & 1) * 32 + (lane & 3) * 8 + (4 * hi + ((lane & 15) >> 2)) * 64;
    const int NT = (q0 + QB) / KVBLK;
    DMA_K(0, 0); DMA_V(0, 0); DMA_K(1, SLOTB);
    bf16x8 qr[2];
#pragma unroll
    for (int d0 = 0; d0 < 2; ++d0) qr[d0] = *reinterpret_cast<const bf16x8*>(&Qw[(long)r32 * PITCH + comp * 32 + d0 * 16 + hi * 8]);
    float mhat = 0.f, l_reg = 0.f; f32x16 o[2]; o[0] = f32x16{}; o[1] = f32x16{}; f32x16 negm = f32x16{}; asm volatile("" : "+v"(negm));
    const int qrel = wid * QBLK + r32;
#define CMASK(P0, P1, t) do { int jb_ = (t) - (NT - 4); if (jb_ >= 0) cmask(P0, P1, jb_, qrel, hi); } while (0)
    bool resc = false;
#define START(P0, P1) do { const float rm = rowmax(P0, P1); resc = false; \
    { const float dl = rm; mhat = fadd_s(mhat, dl); \
      _Pragma("unroll") for (int r = 0; r < 16; ++r) { P0[r] = fsub_s(P0[r], dl); P1[r] = fsub_s(P1[r], dl); } \
      _Pragma("unroll") for (int r = 0; r < 16; ++r) negm[r] = -mhat; asm volatile("" : "+v"(negm)); } \
    _Pragma("unroll") for (int r = 0; r < 16; ++r) P0[r] = __builtin_amdgcn_exp2f(P0[r]); } while (0)
#define RESC() do { if (resc) { asm volatile("s_waitcnt lgkmcnt(0)" ::: "memory"); \
      _Pragma("unroll") for (int d_ = 0; d_ < 2; ++d_) _Pragma("unroll") for (int r = 0; r < 16; ++r) o[d_][r] *= wsf[crow(r, hi)]; } } while (0)
    f32x16 pA0, pA1, pB0, pB1;
    int sl_prev = 0, sl_cur = 0, sl_next = SLOTB;
#define ROT() do { sl_prev = sl_cur; sl_cur = sl_next; sl_next = (sl_next == (NSLOT - 1) * SLOTB) ? 0 : sl_next + SLOTB; } while (0)
    DMA_K(2, 2 * SLOTB);
    WAIT_BAR(3);
    qkt(pA0, pA1, Kbase, qr, negm, r32, hi); asm volatile("s_nop 15\n\ts_nop 7" : "+v"(pA0), "+v"(pA1)); CMASK(pA0, pA1, 0);
    START(pA0, pA1);
    _Pragma("unroll") for (int r = 0; r < 16; ++r) pA1[r] = __builtin_amdgcn_exp2f(pA1[r]);
    WAIT_BAR(0);
    DMA_K(3, 0); DMA_V(1, SLOTB);
    ROT();
    kload8(kf, kp0 + sl_cur);
    WAIT_BAR(2);
    s16x4 vlo[8], vhi[8]; u32x4 pw0, pw1, pw2, pw3;
#define PKW(P, B) cvtpk_s(P[B], P[B + 1])
#define PAF(k) __builtin_bit_cast(bf16x8, pw##k)
#define VFR(i) (bf16x8){vlo[i][0], vlo[i][1], vlo[i][2], vlo[i][3], vhi[i][0], vhi[i][1], vhi[i][2], vhi[i][3]}
#define PIN(x) asm volatile("" : "+v"(x))
#define MX3(a, b, c) __builtin_fmaxf(__builtin_fmaxf((a), (b)), (c))
#define GAPA(MF, A0, A1, A2, A3, W0, W1, PW) do { MF; sacc += A0; sacc += A1; sacc += A2; sacc += A3; PIN(sacc); W0; W1; PIN(PW); SBAR(); } while (0)
#define EX(v) __builtin_amdgcn_exp2f(v)
#define GAPB(MF, X, B) do { MF; X[B] = EX(X[B]); X[B + 1] = EX(X[B + 1]); X[B + 2] = EX(X[B + 2]); X[B + 3] = EX(X[B + 3]); PIN(X); SBAR(); } while (0)
#define VRD(i) do { vlo[i] = vtr(vp_ + (((i) >> 2) * 4096 + ((i) & 3) * 1024)); vhi[i] = vtr(vp_ + (((i) >> 2) * 4096 + ((i) & 3) * 1024 + 512)); } while (0)
#define KRD(G, j) do { if (G) { kload2(kf, kp0 + sl_next, j); SBAR(); } } while (0)
#define STEP(C0, C1, P0, P1, t, GK, GV, GL) do { SBAR(); \
    const lds_cptr vp_ = vp0 + sl_prev; \
    VRD(0); SBAR(); float sacc = (P0[0] + P0[1]); \
    GAPA(C0 = __builtin_amdgcn_mfma_f32_32x32x16_bf16(kf[0], qr[0], negm, 0, 0, 0), P0[2], P0[3], P0[4], P0[5],     pw0[0] = PKW(P0, 0), pw0[1] = PKW(P0, 2), pw0); \
    VRD(4); SBAR(); GAPA(C1 = __builtin_amdgcn_mfma_f32_32x32x16_bf16(kf[1], qr[0], negm, 0, 0, 0), P0[6], P0[7], P0[8], P0[9],     pw0[2] = PKW(P0, 4), pw0[3] = PKW(P0, 6), pw0); \
    VRD(1); SBAR(); GAPA(C0 = __builtin_amdgcn_mfma_f32_32x32x16_bf16(kf[2], qr[1], C0, 0, 0, 0),   P0[10], P0[11], P0[12], P0[13], pw1[0] = PKW(P0, 8), pw1[1] = PKW(P0, 10), pw1); \
    VRD(5); SBAR(); GAPA(C1 = __builtin_amdgcn_mfma_f32_32x32x16_bf16(kf[3], qr[1], C1, 0, 0, 0),   P0[14], P0[15], P1[0], P1[1],   pw1[2] = PKW(P0, 12), pw1[3] = PKW(P0, 14), pw1); \
    VRD(2); SBAR(); GAPA(,   P1[2], P1[3], P1[4], P1[5],     pw2[0] = PKW(P1, 0), pw2[1] = PKW(P1, 2), pw2); \
    VRD(6); SBAR(); GAPA(,   P1[6], P1[7], P1[8], P1[9],     pw2[2] = PKW(P1, 4), pw2[3] = PKW(P1, 6), pw2); \
    VRD(3); SBAR(); GAPA(,   P1[10], P1[11], P1[12], P1[13], pw3[0] = PKW(P1, 8), pw3[1] = PKW(P1, 10), pw3); \
    VRD(7); SBAR(); GAPA(,   P1[14], P1[15], 0.f, 0.f,       pw3[2] = PKW(P1, 12), pw3[3] = PKW(P1, 14), pw3); \
    l_reg += sacc; \
    if (GK) { DMA_K((t) + 3, sl_cur); } if (GV) { DMA_V((t) + 1, sl_next); } \
    CMASK(C0, C1, t); \
    { float a = MX3(C0[0], C0[1], C1[0]), b = MX3(C0[2], C0[3], C1[1]); a = MX3(a, C1[2], C1[3]); \
      _Pragma("unroll") for (int r = 4; r < 16; r += 4) { a = MX3(a, C0[r], C0[r + 1]); b = MX3(b, C0[r + 2], C0[r + 3]); a = MX3(a, C1[r], C1[r + 1]); b = MX3(b, C1[r + 2], C1[r + 3]); } \
      float rm = __builtin_fmaxf(a, b); { auto rr = __builtin_amdgcn_permlane32_swap(__float_as_uint(rm), __float_as_uint(rm), false, false); rm = __builtin_fmaxf(__uint_as_float(rr[0]), __uint_as_float(rr[1])); } \
      resc = false; \
      if (__builtin_expect(__any(rm > (float)THRL), 0)) { const float dl = __builtin_fmaxf(rm, 0.f); mhat += dl; \
        _Pragma("unroll") for (int r = 0; r < 16; ++r) { C0[r] -= dl; C1[r] -= dl; } \
        _Pragma("unroll") for (int r = 0; r < 16; ++r) negm[r] = -mhat; asm volatile("" : "+v"(negm)); \
        const float f = __builtin_amdgcn_exp2f(-dl); l_reg *= f; if (hi == 0) wsf[r32] = f; resc = true; } } \
    SBAR(); \
    GAPB(o[0] = __builtin_amdgcn_mfma_f32_32x32x16_bf16(PAF(0), VFR(0), o[0], 0, 0, 0), C0, 0); \
    GAPB(o[1] = __builtin_amdgcn_mfma_f32_32x32x16_bf16(PAF(0), VFR(4), o[1], 0, 0, 0), C0, 4); \
    KRD(GL, 0); GAPB(o[0] = __builtin_amdgcn_mfma_f32_32x32x16_bf16(PAF(1), VFR(1), o[0], 0, 0, 0), C0, 8); \
    KRD(GL, 1); GAPB(o[1] = __builtin_amdgcn_mfma_f32_32x32x16_bf16(PAF(1), VFR(5), o[1], 0, 0, 0), C0, 12); \
    GAPB(o[0] = __builtin_amdgcn_mfma_f32_32x32x16_bf16(PAF(2), VFR(2), o[0], 0, 0, 0), C1, 0); \
    GAPB(o[1] = __builtin_amdgcn_mfma_f32_32x32x16_bf16(PAF(2), VFR(6), o[1], 0, 0, 0), C1, 4); \
    GAPB(o[0] = __builtin_amdgcn_mfma_f32_32x32x16_bf16(PAF(3), VFR(3), o[0], 0, 0, 0), C1, 8); \
    GAPB(o[1] = __builtin_amdgcn_mfma_f32_32x32x16_bf16(PAF(3), VFR(7), o[1], 0, 0, 0), C1, 12); \
    } while (0)
    int t = 1;
#undef CMASK
#define CMASK(P0, P1, t) do {} while (0)
    for (; t + 5 < NT; t += 2) {
        STEP(pB0, pB1, pA0, pA1, t, true, true, true);     WAIT_BAR(2); RESC(); ROT();
        STEP(pA0, pA1, pB0, pB1, t + 1, true, true, true); WAIT_BAR(2); RESC(); ROT();
    }
#undef CMASK
#define CMASK(P0, P1, t) do { int jb_ = (t) - (NT - 4); if (jb_ >= 0) cmask(P0, P1, jb_, qrel, hi); } while (0)
#define ENDW(tt) do { if ((tt) + 3 < NT) { WAIT_BAR(2); } else if ((tt) + 2 < NT) { WAIT_BAR(1); } else { WAIT_BAR(0); } } while (0)
    for (; t + 1 < NT; t += 2) {
        STEP(pB0, pB1, pA0, pA1, t, (t + 3 < NT), (t + 1 < NT), (t + 1 < NT));         ENDW(t);     RESC(); ROT();
        STEP(pA0, pA1, pB0, pB1, t + 1, (t + 4 < NT), (t + 2 < NT), (t + 2 < NT));     ENDW(t + 1); RESC(); ROT();
    }
    STEP(pB0, pB1, pA0, pA1, NT - 1, false, false, false); RESC();
    { float sacc = pB0[0] + pB0[1]; _Pragma("unroll") for (int r = 2; r < 16; ++r) sacc += pB0[r]; _Pragma("unroll") for (int r = 0; r < 16; ++r) sacc += pB1[r]; l_reg += sacc;
      pw0 = (u32x4){PKW(pB0, 0), PKW(pB0, 2), PKW(pB0, 4), PKW(pB0, 6)}; pw1 = (u32x4){PKW(pB0, 8), PKW(pB0, 10), PKW(pB0, 12), PKW(pB0, 14)}; pw2 = (u32x4){PKW(pB1, 0), PKW(pB1, 2), PKW(pB1, 4), PKW(pB1, 6)}; pw3 = (u32x4){PKW(pB1, 8), PKW(pB1, 10), PKW(pB1, 12), PKW(pB1, 14)};
      SBAR(); pv(o, vb0 + sl_cur, PAF(0), PAF(1), PAF(2), PAF(3)); }
#undef PKW
#undef PAF
#undef VFR
#undef PIN
#undef MX3
#undef GAPA
#undef GAPB
#undef EX
#undef VRD
#undef KRD
#undef STEP
#undef ENDW
    { auto rr = __builtin_amdgcn_permlane32_swap(__float_as_uint(l_reg), __float_as_uint(l_reg), false, false); l_reg = __uint_as_float(rr[0]) + __uint_as_float(rr[1]); }
    if (hi == 0) wsf[32 + r32] = l_reg; asm volatile("s_waitcnt lgkmcnt(0)" ::: "memory");
    float rli[16];
#pragma unroll
    for (int r = 0; r < 16; ++r) rli[r] = __builtin_amdgcn_rcpf(wsf[32 + crow(r, hi)]);
    float* stg = (float*)(shm + LDS_OST) + wid * 2048;
    if (comp == 0) {
#pragma unroll
        for (int r = 0; r < 16; ++r) { const int orow = crow(r, hi);
#pragma unroll
            for (int d0 = 0; d0 < 2; ++d0) stg[orow * 64 + d0 * 32 + r32] = o[d0][r] * rli[r]; }
    } else {
        const float lam = P.lam;
#pragma unroll
        for (int r = 0; r < 16; ++r) { const int orow = crow(r, hi);
#pragma unroll
            for (int d0 = 0; d0 < 2; ++d0) { const int ix = orow * 64 + d0 * 32 + r32; stg[ix] = stg[ix] - lam * (o[d0][r] * rli[r]); } }
        asm volatile("s_waitcnt lgkmcnt(0)" ::: "memory");
        bf16_t* Yw = P.Y + (rowbase + q0 + wid * QBLK) * DM + h * D;
        const int ch = lane & 7;
        const f32x4 g0 = *(const f32x4*)(P.gnorm + ch * 8), g1 = *(const f32x4*)(P.gnorm + ch * 8 + 4);
#pragma unroll
        for (int i = 0; i < 4; ++i) { const int row = i * 8 + (lane >> 3);
            const f32x4 a = *(const f32x4*)(stg + row * 64 + ch * 8), c = *(const f32x4*)(stg + row * 64 + ch * 8 + 4);
            float ss = (a[0] * a[0] + a[1] * a[1]) + (a[2] * a[2] + a[3] * a[3]) + (c[0] * c[0] + c[1] * c[1]) + (c[2] * c[2] + c[3] * c[3]);
            ss += __shfl_xor(ss, 1); ss += __shfl_xor(ss, 2); ss += __shfl_xor(ss, 4);
            const float rs = __builtin_amdgcn_rsqf(ss * (1.f / 64.f) + LN_EPS) * P.osc;
            u32x4 w; w.x = pk2(a[0] * rs * g0[0], a[1] * rs * g0[1]); w.y = pk2(a[2] * rs * g0[2], a[3] * rs * g0[3]); w.z = pk2(c[0] * rs * g1[0], c[1] * rs * g1[1]); w.w = pk2(c[2] * rs * g1[2], c[3] * rs * g1[3]);
            *(u32x4*)(Yw + (long)row * DM + ch * 8) = w; }
    }
    asm volatile("s_waitcnt lgkmcnt(0)\n\ts_barrier" ::: "memory");
#undef DMA_K
#undef DMA_V
#undef CMASK
#undef START
#undef RESC
#undef ROT
}
#undef SBAR
#undef WAIT_BAR
}

struct Frame {
    LAS unsigned char* lds; volatile LAS unsigned* MISC; gu32* ctl;
    int tid, lane, wave, vcu, G;
};
struct Args {
    const float* in[29]; float* out; unsigned char* ws; int ph_lo, ph_hi;
};
enum { I_X = 0, I_C, I_POS, I_WADA, I_BADA, I_WIN, I_WOUT, I_MBI, I_MBF, I_MG, I_CONVW, I_CONVB, I_LQ1, I_LK1, I_LQ2, I_LK2, I_DG, I_WA2, I_BA, I_GG, I_LN1G, I_LN1B, I_LN2G, I_LN2B,
       I_RW, I_RB, I_EWG, I_EWU, I_EWD };

__device__ __forceinline__ void tr_item(const float* W, int ldw, int K, bf16_t* WT, int drow0, int scol, int k0, LAS float* scr, int lane) {
#pragma unroll 8
    for (int i = 0; i < 32; ++i) { const int kk = 2 * i + (lane >> 5); scr[kk * 33 + (lane & 31)] = (scol >= 0) ? W[(size_t)(k0 + kk) * ldw + scol] : 0.f; }
    LDS_WAIT(); asm volatile("" ::: "memory");
    const int c = lane & 7;
#pragma unroll
    for (int j = 0; j < 4; ++j) { const int n = (lane >> 3) + 8 * j; const LAS float* s = scr + (8 * c) * 33 + n;
        u32x4 o; o.x = pk2(s[0 * 33], s[1 * 33]); o.y = pk2(s[2 * 33], s[3 * 33]); o.z = pk2(s[4 * 33], s[5 * 33]); o.w = pk2(s[6 * 33], s[7 * 33]);
        *(GAS u32x4*)(WT + (size_t)(drow0 + n) * K + k0 + 8 * c) = o; }
    LDS_WAIT(); asm volatile("" ::: "memory");
}
__device__ __forceinline__ void tr_item4(const float* W, int ldw, int K, bf16_t* WT, int drow0, int scol0, int k0, LAS float* scr, int lane) {
    const int kq = lane >> 3, nq = (lane & 7) * 4;
    f32x4 v[8];
#pragma unroll
    for (int i = 0; i < 8; ++i) v[i] = *(const f32x4*)(W + (size_t)(k0 + i * 8 + kq) * ldw + scol0 + nq);
#pragma unroll
    for (int i = 0; i < 8; ++i) { LAS float* d = scr + (i * 8 + kq) * 33 + nq; d[0] = v[i][0]; d[1] = v[i][1]; d[2] = v[i][2]; d[3] = v[i][3]; }
    LDS_WAIT(); asm volatile("" ::: "memory");
    const int c = lane & 7;
#pragma unroll
    for (int j = 0; j < 4; ++j) { const int n = (lane >> 3) + 8 * j; const LAS float* s = scr + (8 * c) * 33 + n;
        u32x4 o; o.x = pk2(s[0 * 33], s[1 * 33]); o.y = pk2(s[2 * 33], s[3 * 33]); o.z = pk2(s[4 * 33], s[5 * 33]); o.w = pk2(s[6 * 33], s[7 * 33]);
        *(GAS u32x4*)(WT + (size_t)(drow0 + n) * K + k0 + 8 * c) = o; }
    LDS_WAIT(); asm volatile("" ::: "memory");
}
template <int NTL>
__device__ __forceinline__ void rows16_mm(f32x4 (&acc)[NTL], const bf16_t* A, const LAS bf16_t* Bt, int pitch, int lane) {
    const int lr = lane & 15, lq = lane >> 4;
    const bf16_t* ap = A + (size_t)lr * 1024 + lq * 8;
#pragma unroll 8
    for (int ks = 0; ks < 32; ++ks) {
        const bf16x8 a = *(const bf16x8*)(ap + ks * 32);
#pragma unroll
        for (int t = 0; t < NTL; ++t) { const bf16x8 b = *(const LAS bf16x8*)(Bt + (t * 16 + lr) * pitch + ks * 32 + lq * 8); acc[t] = __builtin_amdgcn_mfma_f32_16x16x32_bf16(a, b, acc[t], 0, 0, 0); }
    }
}
constexpr int TBP = 1056;
__device__ __forceinline__ void tail16(const bf16_t* Urow0, const LAS bf16_t* Wt, float* tail_row0, int lane) {
    f32x4 acc[2] = {(f32x4){0.f, 0.f, 0.f, 0.f}, (f32x4){0.f, 0.f, 0.f, 0.f}};
    rows16_mm<2>(acc, Urow0, Wt, TBP, lane);
    const int lr = lane & 15, lq = lane >> 4;
#pragma unroll
    for (int t = 0; t < 2; ++t)
#pragma unroll
        for (int r = 0; r < 4; ++r) tail_row0[(size_t)(lq * 4 + r) * 32 + t * 16 + lr] = acc[t][r];
}
__device__ __forceinline__ void load_tail_w(LAS bf16_t* Wt, const bf16_t* Wtail  , int tid) {
    for (int p = tid; p < 32 * 128; p += 512) { const int n = p >> 7, c = p & 127; *(LAS u32x4*)(Wt + n * TBP + c * 8) = *(const u32x4*)(Wtail + (size_t)n * 1024 + c * 8); }
}
__device__ __forceinline__ int win_src_col(int n) {
    if (n < 1024) return n;
    if (n < 3584) return n + 8;
    const int i = n - 3584;
    if (i < 16) return 3592 + i;
    if (i < 20) return 1024 + (i - 16);
    if (i < 24) return 1028 + (i - 20);
    return -1;
}

namespace rec {
constexpr int PT = 72;
constexpr int TB = 64 * PT * 2;
constexpr int OFF_T0 = 0, OFF_T1 = TB, OFF_T2 = 2 * TB, OFF_T3 = 3 * TB, OFF_T4 = 4 * TB, OFF_T5 = 5 * TB;
constexpr int OFF_BM = 6 * TB;
constexpr int OFF_HM = OFF_BM + 16384;
constexpr int OFF_VEC = OFF_HM + 64 * 68 * 4;
constexpr int V_G = 0, V_M = 64, V_WI = 128, V_EM = 192, V_DI = 256, V_N = 320, V_BE = 384, V_SEG = 448, V_GA = 960;
static_assert(OFF_VEC + (960 + 1024) * 4 <= RING_BYTES, "rec LDS");

__device__ __forceinline__ void mm64(f32x4 (&acc)[2], const LAS bf16_t* A, const LAS bf16_t* Bt, int wid, int lane) {
    const int tm = wid >> 1, tn0 = (wid & 1) * 2, lr = lane & 15, lq = lane >> 4;
#pragma unroll
    for (int ks = 0; ks < 2; ++ks) {
        const bf16x8 a = *(const LAS bf16x8*)(A + (tm * 16 + lr) * PT + ks * 32 + lq * 8);
#pragma unroll
        for (int t = 0; t < 2; ++t) { const bf16x8 b = *(const LAS bf16x8*)(Bt + ((tn0 + t) * 16 + lr) * PT + ks * 32 + lq * 8);
            acc[t] = __builtin_amdgcn_mfma_f32_16x16x32_bf16(a, b, acc[t], 0, 0, 0); }
    }
}
__device__ __forceinline__ float scan_add(float v, int lane) {
#pragma unroll
    for (int o = 1; o < 64; o <<= 1) { const float t = __shfl_up(v, o); if (lane >= o) v += t; }
    return v;
}
__device__ __forceinline__ float scan_max(float v, int lane) {
#pragma unroll
    for (int o = 1; o < 64; o <<= 1) { const float t = __shfl_up(v, o); if (lane >= o) v = fmaxf(v, t); }
    return v;
}
__device__ __forceinline__ void st_tr8(LAS bf16_t* T, int l, int ch, u32x4 w) {
    T[(ch * 8 + 0) * PT + l] = (bf16_t)(w.x & 0xffffu); T[(ch * 8 + 1) * PT + l] = (bf16_t)(w.x >> 16);
    T[(ch * 8 + 2) * PT + l] = (bf16_t)(w.y & 0xffffu); T[(ch * 8 + 3) * PT + l] = (bf16_t)(w.y >> 16);
    T[(ch * 8 + 4) * PT + l] = (bf16_t)(w.z & 0xffffu); T[(ch * 8 + 5) * PT + l] = (bf16_t)(w.z >> 16);
    T[(ch * 8 + 6) * PT + l] = (bf16_t)(w.w & 0xffffu); T[(ch * 8 + 7) * PT + l] = (bf16_t)(w.w >> 16);
}
__device__ __forceinline__ void unpack8(u32x4 w, float (&f)[8]) {
    f[0] = bflo(w.x); f[1] = bfhi(w.x); f[2] = bflo(w.y); f[3] = bfhi(w.y); f[4] = bflo(w.z); f[5] = bfhi(w.z); f[6] = bflo(w.w); f[7] = bfhi(w.w);
}
template <int GATE  >
__device__ __forceinline__ void finalize(const LAS float* HM, const LAS float* rowscale, const float* gnorm, const bf16_t* gate, bf16_t* out, int tid) {
    const int j = tid >> 3, ch = tid & 7;
    const f32x4 a = *(const LAS f32x4*)(HM + j * 68 + ch * 8), c = *(const LAS f32x4*)(HM + j * 68 + ch * 8 + 4);
    const float rsc = rowscale ? rowscale[j] : 1.f;
    float v[8] = {a[0] * rsc, a[1] * rsc, a[2] * rsc, a[3] * rsc, c[0] * rsc, c[1] * rsc, c[2] * rsc, c[3] * rsc};
    float ss = 0.f;
#pragma unroll
    for (int i = 0; i < 8; ++i) ss += v[i] * v[i];
    ss += __shfl_xor(ss, 1); ss += __shfl_xor(ss, 2); ss += __shfl_xor(ss, 4);
    const float rs = __builtin_amdgcn_rsqf(ss * (1.f / 64.f) + LN_EPS);
    const u32x4 gw = *(const u32x4*)(gate + (size_t)j * PP + ch * 8);
    float gt[8]; unpack8(gw, gt);
    const f32x4 g0 = *(const f32x4*)(gnorm + ch * 8), g1 = *(const f32x4*)(gnorm + ch * 8 + 4);
    const float gn[8] = {g0[0], g0[1], g0[2], g0[3], g1[0], g1[1], g1[2], g1[3]};
    float y[8];
#pragma unroll
    for (int i = 0; i < 8; ++i) { const float sg = 1.f / (1.f + __expf(-gt[i])); const float gv = GATE ? gt[i] * sg : sg; y[i] = v[i] * rs * gn[i] * gv; }
    u32x4 w; w.x = pk2(y[0], y[1]); w.y = pk2(y[2], y[3]); w.z = pk2(y[4], y[5]); w.w = pk2(y[6], y[7]);
    *(u32x4*)(out + (size_t)j * DM + ch * 8) = w;
}

struct RecP {
    const bf16_t* proj; const float* tail; const bf16_t* csm; const bf16_t* csg; float* stm; float* stg; float* smN; float* smBC; float* smDM; float* smMS; float* smGBE; bf16_t* ycat;
    const float* mbi; const float* mbf; const float* mg; const float* wa2; const float* ba; const float* gg;
};

struct MLoc { u32x4 k, v; float mi, mf; };
struct MOut { u32x4 q, k, v, st, mo; float mi, mf, m, n; };
struct GLoc { u32x4 k, v; f32x4 ga; };
struct GOut { u32x4 q, k, v, st, gr; f32x4 ga; };
struct GW { float wv[16]; float bav; };

__device__ __forceinline__ void ld_mloc(MLoc& L, const RecP& P, int ci, int tid, int wid, int lane) {
    const int bh = ci >> 6, c = ci & 63, b = bh >> 2, h = bh & 3, row0 = b * SEQ + c * 64, l = tid >> 3, ch = tid & 7;
    const bf16_t* pr = P.proj + (size_t)(row0 + l) * PP + h * 64 + ch * 8;
    L.k = *(const u32x4*)(pr + C_MK); L.v = *(const u32x4*)(pr + C_MV);
    if (wid == 0) { const float* tp = P.tail + (size_t)(row0 + lane) * 32; L.mi = tp[T_MI + h]; L.mf = tp[T_MF + h]; } else { L.mi = 0.f; L.mf = 0.f; }
}
__device__ __forceinline__ void ld_mout(MOut& L, const RecP& P, int ci, int tid, int wid, int lane) {
    const int bh = ci >> 6, c = ci & 63, b = bh >> 2, h = bh & 3, row0 = b * SEQ + c * 64, l = tid >> 3, ch = tid & 7;
    const bf16_t* pr = P.proj + (size_t)(row0 + l) * PP + h * 64 + ch * 8;
    L.q = *(const u32x4*)(pr + C_MQ); L.k = *(const u32x4*)(pr + C_MK); L.v = *(const u32x4*)(pr + C_MV); L.mo = *(const u32x4*)(pr + C_MO);
    L.st = *(const u32x4*)(P.csm + (size_t)ci * 4096 + l * 64 + ch * 8);
    if (wid == 0) { const float* tp = P.tail + (size_t)(row0 + lane) * 32; L.mi = tp[T_MI + h]; L.mf = tp[T_MF + h]; L.m = P.smMS[ci]; L.n = P.smN[(size_t)ci * 64 + lane]; } else { L.mi = 0.f; L.mf = 0.f; L.m = 0.f; L.n = 0.f; }
}
__device__ __forceinline__ void ld_gloc(GLoc& L, const RecP& P, int ci, int tid) {
    const int bh = ci >> 6, c = ci & 63, b = bh >> 2, h = bh & 3, row0 = b * SEQ + c * 64, l = tid >> 3, ch = tid & 7;
    const bf16_t* pr = P.proj + (size_t)(row0 + l) * PP + h * 64 + ch * 8;
    L.k = *(const u32x4*)(pr + C_GK); L.v = *(const u32x4*)(pr + C_GV);
    L.ga = (tid < 256) ? *(const f32x4*)(P.tail + (size_t)(row0 + (tid >> 2)) * 32 + T_GA + (tid & 3) * 4) : (f32x4){0.f, 0.f, 0.f, 0.f};
}
__device__ __forceinline__ void ld_gout(GOut& L, const RecP& P, int ci, int tid) {
    const int bh = ci >> 6, c = ci & 63, b = bh >> 2, h = bh & 3, row0 = b * SEQ + c * 64, l = tid >> 3, ch = tid & 7;
    const bf16_t* pr = P.proj + (size_t)(row0 + l) * PP + h * 64 + ch * 8;
    L.q = *(const u32x4*)(pr + C_GQ); L.k = *(const u32x4*)(pr + C_GK); L.v = *(const u32x4*)(pr + C_GV); L.gr = *(const u32x4*)(pr + C_GR);
    L.st = *(const u32x4*)(P.csg + (size_t)ci * 4096 + l * 64 + ch * 8);
    L.ga = (tid < 256) ? *(const f32x4*)(P.tail + (size_t)(row0 + (tid >> 2)) * 32 + T_GA + (tid & 3) * 4) : (f32x4){0.f, 0.f, 0.f, 0.f};
}
__device__ __forceinline__ void ld_gw(GW& W, const RecP& P, int h, int tid) {
    const int dcol = tid & 63;
#pragma unroll
    for (int r = 0; r < 16; ++r) W.wv[r] = P.wa2[r * 256 + h * 64 + dcol];
    W.bav = P.ba[h * 64 + dcol];
}
template <int GATE  >
__device__ __forceinline__ void finalize2(const LAS float* HM, const LAS float* rowscale, const float* gnorm, u32x4 gw, bf16_t* out, int tid) {
    const int j = tid >> 3, ch = tid & 7;
    const f32x4 a = *(const LAS f32x4*)(HM + j * 68 + ch * 8), c = *(const LAS f32x4*)(HM + j * 68 + ch * 8 + 4);
    const float rsc = rowscale ? rowscale[j] : 1.f;
    float v[8] = {a[0] * rsc, a[1] * rsc, a[2] * rsc, a[3] * rsc, c[0] * rsc, c[1] * rsc, c[2] * rsc, c[3] * rsc};
    float ss = 0.f;
#pragma unroll
    for (int i = 0; i < 8; ++i) ss += v[i] * v[i];
    ss += __shfl_xor(ss, 1); ss += __shfl_xor(ss, 2); ss += __shfl_xor(ss, 4);
    const float rs = __builtin_amdgcn_rsqf(ss * (1.f / 64.f) + LN_EPS);
    float gt[8]; unpack8(gw, gt);
    const f32x4 g0 = *(const f32x4*)(gnorm + ch * 8), g1 = *(const f32x4*)(gnorm + ch * 8 + 4);
    const float gn[8] = {g0[0], g0[1], g0[2], g0[3], g1[0], g1[1], g1[2], g1[3]};
    float y[8];
#pragma unroll
    for (int i = 0; i < 8; ++i) { const float sg = 1.f / (1.f + __expf(-gt[i])); const float gv = GATE ? gt[i] * sg : sg; y[i] = v[i] * rs * gn[i] * gv; }
    u32x4 w; w.x = pk2(y[0], y[1]); w.y = pk2(y[2], y[3]); w.z = pk2(y[4], y[5]); w.w = pk2(y[6], y[7]);
    *(u32x4*)(out + (size_t)j * DM + ch * 8) = w;
}
__device__ __forceinline__ void mlstm_local(const MLoc& L, const RecP& P, LAS unsigned char* lds, int ci, int tid, int wid, int lane) {
    const int h = (ci >> 6) & 3;
    LAS bf16_t* KT = (LAS bf16_t*)(lds + OFF_T0); LAS bf16_t* VT = (LAS bf16_t*)(lds + OFF_T1); LAS float* vec = (LAS float*)(lds + OFF_VEC);
    const int l = tid >> 3, ch = tid & 7;
    if (wid == 0) {
        const float li = L.mi + P.mbi[h], lf = logsig(L.mf + P.mbf[h]);
        const float bc = scan_add(lf, lane), g = li - bc;
        const float gmax = wave_max(g), bend = __shfl(bc, 63);
        vec[V_G + lane] = __expf(g - gmax);
        if (lane == 0) { P.smBC[ci] = bend; P.smDM[ci] = bend + gmax; }
    }
    __syncthreads();
    { const float w = vec[V_G + l]; float kf[8]; unpack8(L.k, kf);
      u32x4 ks; ks.x = pk2(kf[0] * w, kf[1] * w); ks.y = pk2(kf[2] * w, kf[3] * w); ks.z = pk2(kf[4] * w, kf[5] * w); ks.w = pk2(kf[6] * w, kf[7] * w);
      st_tr8(KT, l, ch, ks); st_tr8(VT, l, ch, L.v); }
    __syncthreads();
    f32x4 acc[2] = {(f32x4){0.f, 0.f, 0.f, 0.f}, (f32x4){0.f, 0.f, 0.f, 0.f}};
    mm64(acc, VT, KT, wid, lane);
    { const int tm = wid >> 1, tn0 = (wid & 1) * 2, lr = lane & 15, lq = lane >> 4; float* dst = P.stm + (size_t)ci * 4096;
#pragma unroll
      for (int t = 0; t < 2; ++t)
#pragma unroll
          for (int r = 0; r < 4; ++r) dst[(tm * 16 + lq * 4 + r) * 64 + (tn0 + t) * 16 + lr] = acc[t][r]; }
    if (tid < 64) { float s = 0.f;
#pragma unroll
        for (int q = 0; q < 8; ++q) { const u32x4 w = *(const LAS u32x4*)(KT + tid * PT + q * 8); float f[8]; unpack8(w, f);
#pragma unroll
            for (int i = 0; i < 8; ++i) s += f[i]; }
        P.smN[(size_t)ci * 64 + tid] = s; }
    __syncthreads();
}
__device__ __forceinline__ void mlstm_out(const MOut& L, const RecP& P, LAS unsigned char* lds, int ci, int tid, int wid, int lane) {
    const int bh = ci >> 6, c = ci & 63, b = bh >> 2, h = bh & 3, row0 = b * SEQ + c * 64;
    LAS bf16_t* Qm = (LAS bf16_t*)(lds + OFF_T0); LAS bf16_t* Km = (LAS bf16_t*)(lds + OFF_T1); LAS bf16_t* VT = (LAS bf16_t*)(lds + OFF_T2);
    LAS bf16_t* CT = (LAS bf16_t*)(lds + OFF_T3); LAS bf16_t* Sm = (LAS bf16_t*)(lds + OFF_T4);
    LAS float* HM = (LAS float*)(lds + OFF_HM); LAS float* vec = (LAS float*)(lds + OFF_VEC);
    const int l = tid >> 3, ch = tid & 7;
    *(LAS u32x4*)(Qm + l * PT + ch * 8) = L.q; *(LAS u32x4*)(Km + l * PT + ch * 8) = L.k; st_tr8(VT, l, ch, L.v); *(LAS u32x4*)(CT + l * PT + ch * 8) = L.st;
    if (wid == 0) {
        const float li = L.mi + P.mbi[h], lf = logsig(L.mf + P.mbf[h]);
        const float bc = scan_add(lf, lane), g = li - bc;
        const float pm = scan_max(g, lane), m = L.m, M = fmaxf(m, pm);
        vec[V_G + lane] = g; vec[V_M + lane] = M; vec[V_WI + lane] = __expf(m - M); vec[V_EM + lane] = __expf(-bc - M);
        vec[V_N + lane] = L.n;
    }
    __syncthreads();
    { f32x4 acc[2] = {(f32x4){0.f, 0.f, 0.f, 0.f}, (f32x4){0.f, 0.f, 0.f, 0.f}};
      mm64(acc, Qm, Km, wid, lane);
      const int tm = wid >> 1, tn0 = (wid & 1) * 2, lr = lane & 15, lq = lane >> 4;
#pragma unroll
      for (int t = 0; t < 2; ++t) { const int ll = (tn0 + t) * 16 + lr; const float gl = vec[V_G + ll];
#pragma unroll
          for (int r = 0; r < 4; ++r) { const int j = tm * 16 + lq * 4 + r; const float s = (ll <= j) ? acc[t][r] * __expf(gl - vec[V_M + j]) : 0.f; Sm[j * PT + ll] = (bf16_t)f2bf(s); } } }
    __syncthreads();
    { f32x4 a1[2] = {(f32x4){0.f, 0.f, 0.f, 0.f}, (f32x4){0.f, 0.f, 0.f, 0.f}}, a2[2] = {(f32x4){0.f, 0.f, 0.f, 0.f}, (f32x4){0.f, 0.f, 0.f, 0.f}};
      mm64(a1, Sm, VT, wid, lane); mm64(a2, Qm, CT, wid, lane);
      const int tm = wid >> 1, tn0 = (wid & 1) * 2, lr = lane & 15, lq = lane >> 4;
#pragma unroll
      for (int t = 0; t < 2; ++t)
#pragma unroll
          for (int r = 0; r < 4; ++r) { const int j = tm * 16 + lq * 4 + r; HM[j * 68 + (tn0 + t) * 16 + lr] = a1[t][r] + vec[V_WI + j] * a2[t][r]; } }
    if (tid < 64) { float ds = 0.f, qn = 0.f;
#pragma unroll
        for (int q = 0; q < 8; ++q) { const u32x4 w = *(const LAS u32x4*)(Sm + tid * PT + q * 8); float f[8]; unpack8(w, f);
            const u32x4 qw = *(const LAS u32x4*)(Qm + tid * PT + q * 8); float qf[8]; unpack8(qw, qf);
#pragma unroll
            for (int i = 0; i < 8; ++i) { ds += f[i]; qn += qf[i] * vec[V_N + q * 8 + i]; } }
        const float den = ds + vec[V_WI + tid] * qn;
        vec[V_DI + tid] = 1.f / fmaxf(fabsf(den), vec[V_EM + tid]); }
    __syncthreads();
    finalize2<0>(HM, vec + V_DI, P.mg, L.mo, P.ycat + (size_t)row0 * DM + h * 64, tid);
    __syncthreads();
}
__device__ __forceinline__ void gla_bmat(const f32x4 ga, const GW& W, LAS unsigned char* lds, int tid, int wid) {
    LAS float* BM = (LAS float*)(lds + OFF_BM); LAS float* vec = (LAS float*)(lds + OFF_VEC);
    if (tid < 256) { const int l = tid >> 2, q = tid & 3; vec[V_GA + l * 16 + q * 4 + 0] = ga[0]; vec[V_GA + l * 16 + q * 4 + 1] = ga[1]; vec[V_GA + l * 16 + q * 4 + 2] = ga[2]; vec[V_GA + l * 16 + q * 4 + 3] = ga[3]; }
    const int dcol = tid & 63;
    __syncthreads();
    float cs[8]; float cacc = 0.f;
#pragma unroll
    for (int i = 0; i < 8; ++i) { const int l = wid * 8 + i; float z = W.bav;
#pragma unroll
        for (int r = 0; r < 16; ++r) z += vec[V_GA + l * 16 + r] * W.wv[r];
        cacc += logsig(z) * (1.f / 16.f); cs[i] = cacc; }
    vec[V_SEG + wid * 64 + dcol] = cacc;
    __syncthreads();
    float off = 0.f, tot = 0.f;
#pragma unroll
    for (int s = 0; s < 8; ++s) { const float v = vec[V_SEG + s * 64 + dcol]; tot += v; if (s < wid) off += v; }
#pragma unroll
    for (int i = 0; i < 8; ++i) BM[(wid * 8 + i) * 64 + dcol] = off + cs[i];
    if (wid == 0) vec[V_BE + dcol] = tot;
    __syncthreads();
}
__device__ __forceinline__ void gla_local(const GLoc& L, const GW& W, const RecP& P, LAS unsigned char* lds, int ci, int tid, int wid, int lane) {
    LAS bf16_t* KT = (LAS bf16_t*)(lds + OFF_T0); LAS bf16_t* VT = (LAS bf16_t*)(lds + OFF_T1);
    LAS float* BM = (LAS float*)(lds + OFF_BM); LAS float* vec = (LAS float*)(lds + OFF_VEC);
    const int l = tid >> 3, ch = tid & 7;
    gla_bmat(L.ga, W, lds, tid, wid);
    if (tid < 64) P.smGBE[(size_t)ci * 64 + tid] = vec[V_BE + tid];
    { float kf[8]; unpack8(L.k, kf); float ks[8];
#pragma unroll
      for (int i = 0; i < 8; ++i) { const int d = ch * 8 + i; ks[i] = kf[i] * __expf(vec[V_BE + d] - BM[l * 64 + d]); }
      u32x4 kk; kk.x = pk2(ks[0], ks[1]); kk.y = pk2(ks[2], ks[3]); kk.z = pk2(ks[4], ks[5]); kk.w = pk2(ks[6], ks[7]);
      st_tr8(KT, l, ch, kk); st_tr8(VT, l, ch, L.v); }
    __syncthreads();
    f32x4 acc[2] = {(f32x4){0.f, 0.f, 0.f, 0.f}, (f32x4){0.f, 0.f, 0.f, 0.f}};
    mm64(acc, VT, KT, wid, lane);
    { const int tm = wid >> 1, tn0 = (wid & 1) * 2, lr = lane & 15, lq = lane >> 4; float* dst = P.stg + (size_t)ci * 4096;
#pragma unroll
      for (int t = 0; t < 2; ++t)
#pragma unroll
          for (int r = 0; r < 4; ++r) dst[(tm * 16 + lq * 4 + r) * 64 + (tn0 + t) * 16 + lr] = acc[t][r]; }
    __syncthreads();
}
__device__ __forceinline__ void gla_out(const GOut& L, const GW& W, const RecP& P, LAS unsigned char* lds, int ci, int tid, int wid, int lane) {
    const int bh = ci >> 6, c = ci & 63, b = bh >> 2, h = bh & 3, row0 = b * SEQ + c * 64;
    LAS bf16_t* Qm = (LAS bf16_t*)(lds + OFF_T0); LAS bf16_t* Km = (LAS bf16_t*)(lds + OFF_T1); LAS bf16_t* VT = (LAS bf16_t*)(lds + OFF_T2);
    LAS bf16_t* ST = (LAS bf16_t*)(lds + OFF_T3); LAS bf16_t* Sm = (LAS bf16_t*)(lds + OFF_T4);
    LAS float* BM = (LAS float*)(lds + OFF_BM); LAS float* HM = (LAS float*)(lds + OFF_HM);
    const int l = tid >> 3, ch = tid & 7;
    gla_bmat(L.ga, W, lds, tid, wid);
    { float qf[8], kf[8]; unpack8(L.q, qf); unpack8(L.k, kf); float qs[8], ks[8];
#pragma unroll
      for (int i = 0; i < 8; ++i) { const float bv = BM[l * 64 + ch * 8 + i]; qs[i] = qf[i] * __expf(bv); ks[i] = kf[i] * __expf(-bv); }
      u32x4 qq, kk; qq.x = pk2(qs[0], qs[1]); qq.y = pk2(qs[2], qs[3]); qq.z = pk2(qs[4], qs[5]); qq.w = pk2(qs[6], qs[7]);
      kk.x = pk2(ks[0], ks[1]); kk.y = pk2(ks[2], ks[3]); kk.z = pk2(ks[4], ks[5]); kk.w = pk2(ks[6], ks[7]);
      *(LAS u32x4*)(Qm + l * PT + ch * 8) = qq; *(LAS u32x4*)(Km + l * PT + ch * 8) = kk; st_tr8(VT, l, ch, L.v);
      *(LAS u32x4*)(ST + l * PT + ch * 8) = L.st; }
    __syncthreads();
    { f32x4 acc[2] = {(f32x4){0.f, 0.f, 0.f, 0.f}, (f32x4){0.f, 0.f, 0.f, 0.f}};
      mm64(acc, Qm, Km, wid, lane);
      const int tm = wid >> 1, tn0 = (wid & 1) * 2, lr = lane & 15, lq = lane >> 4;
#pragma unroll
      for (int t = 0; t < 2; ++t) { const int ll = (tn0 + t) * 16 + lr;
#pragma unroll
          for (int r = 0; r < 4; ++r) { const int j = tm * 16 + lq * 4 + r; Sm[j * PT + ll] = (bf16_t)f2bf((ll <= j) ? acc[t][r] : 0.f); } } }
    __syncthreads();
    { f32x4 acc[2] = {(f32x4){0.f, 0.f, 0.f, 0.f}, (f32x4){0.f, 0.f, 0.f, 0.f}};
      mm64(acc, Sm, VT, wid, lane); mm64(acc, Qm, ST, wid, lane);
      const int tm = wid >> 1, tn0 = (wid & 1) * 2, lr = lane & 15, lq = lane >> 4;
#pragma unroll
      for (int t = 0; t < 2; ++t)
#pragma unroll
          for (int r = 0; r < 4; ++r) HM[(tm * 16 + lq * 4 + r) * 68 + (tn0 + t) * 16 + lr] = acc[t][r]; }
    __syncthreads();
    finalize2<1>(HM, nullptr, P.gg, L.gr, P.ycat + (size_t)row0 * DM + 768 + h * 64, tid);
    __syncthreads();
}
}

constexpr int N_PHASES = 2 + 9 * DEPTH;
__global__ void __launch_bounds__(512, 2) mega_fwd(Args args) {
    extern __shared__ __attribute__((aligned(16))) unsigned char lds_raw[];
    Frame F;
    F.lds = (LAS unsigned char*)lds_raw;
    F.MISC = (volatile LAS unsigned*)(F.lds + MISC_OFF);
    F.tid = threadIdx.x; F.lane = F.tid & 63; F.wave = __builtin_amdgcn_readfirstlane(F.tid >> 6);
    F.G = gridDim.x; { const int bx = blockIdx.x; F.vcu = (F.G % 8 == 0) ? (bx % 8) * (F.G / 8) + bx / 8 : bx; }
    typedef const __attribute__((address_space(4))) Args* CArgs;
    const CArgs ap0 = (CArgs)__builtin_amdgcn_kernarg_segment_ptr();
    F.ctl = (gu32*)(args.ws + WS_CTL);
    for (int u = F.tid; u < (LDS_BYTES - LDSCTL_OFF) / 4; u += 512) ((LAS unsigned*)(F.lds + LDSCTL_OFF))[u] = 0u;
    __syncthreads();
#if MK_ONE_LAUNCH
    XcdBarrier bar = xcd_barrier_post((unsigned*)(F.ctl + CW_BAR), F.MISC + 8);
#define GRID_BAR() xcd_barrier(bar)
#else
#define GRID_BAR() do {} while (0)
#endif
    const int lo = args.ph_lo, hi = args.ph_hi;
#define IN(k) (lo <= (k) && (k) < hi)
#define SEAM(k) do { if (IN(k) && IN((k) + 1)) { GRID_BAR(); if (NREP(15) == 2) GRID_BAR(); } } while (0)
    const int NGW = F.G * 8;
#define PHASE_IDS() int tid = threadIdx.x; asm volatile("" : "+v"(tid)); const int lane = tid & 63, wid = __builtin_amdgcn_readfirstlane(tid >> 6); const int gw = F.vcu * 8 + wid; (void)lane; (void)gw; \
    CArgs ap = ap0; asm volatile("" : "+s"(ap)); unsigned char* ws = ap->ws; (void)ws
#define AIN(i) (ap->in[i])
#define MOD ((float*)(ws + WS_MOD))
#define ROPE ((float*)(ws + WS_ROPE))
#define WIN ((bf16_t*)(ws + WS_WIN))
#define WOUT ((bf16_t*)(ws + WS_WOUT))
#define WGU ((bf16_t*)(ws + WS_WGU))
#define WD ((bf16_t*)(ws + WS_WD))
#define LTOK ((int*)(ws + WS_LTOK))
#define LGATE ((float*)(ws + WS_LGATE))
#define PROJ ((bf16_t*)(ws + WS_PROJ))
#define HB ((bf16_t*)(ws + WS_PROJ))
#define XB ((bf16_t*)(ws + WS_XR))
#define YSORT ((bf16_t*)(ws + WS_YSORT))
#define TAILB ((float*)(ws + WS_TAIL))
#define TOKSLOT ((int*)(ws + WS_SM + SM_TS))
#define UB ((bf16_t*)(ws + WS_U))
#define YCAT ((bf16_t*)(ws + WS_YCAT))
#define STM ((float*)(ws + WS_U))
#define STG ((float*)(ws + WS_U + 32 * MiB))
#define CSM ((bf16_t*)(ws + WS_XR + 64 * MiB))
#define CSG ((bf16_t*)(ws + WS_XR + 80 * MiB))
#define G_smN ((float*)(ws + WS_SM + SM_N))
#define G_smBC ((float*)(ws + WS_SM + SM_BC))
#define G_smDM ((float*)(ws + WS_SM + SM_DM))
#define G_smMS ((float*)(ws + WS_SM + SM_MS))
#define G_smGBE ((float*)(ws + WS_SM + SM_GBE))
#define x_in AIN(I_X)

    if (IN(0) && PHON(0)) for (int rp0 = 0; rp0 < NREP(0); ++rp0) {
        PHASE_IDS();
        {
            LAS float* cact = (LAS float*)F.lds;
            LAS float* part = (LAS float*)(F.lds + 32768);
            const float* cc = AIN(I_C);
            for (int i = tid; i < NB * DM; i += 512) { const int b = i >> 10, k = i & 1023; const float v = cc[i]; cact[k * 8 + b] = v / (1.f + __expf(-v)); }
            __syncthreads();
            for (int it = F.vcu; it < DEPTH * 96; it += F.G) {
                const int l = it / 96, j0 = (it % 96) * 64;
                const float* W = AIN(I_WADA) + (size_t)l * DM * 6144 + j0 + lane;
                float a[8] = {0.f, 0.f, 0.f, 0.f, 0.f, 0.f, 0.f, 0.f};
#pragma unroll 8
                for (int kk = 0; kk < 128; ++kk) { const int k = wid * 128 + kk; const float w = W[(size_t)k * 6144];
                    const f32x4 c0 = *(const LAS f32x4*)(cact + k * 8), c1 = *(const LAS f32x4*)(cact + k * 8 + 4);
                    a[0] += c0[0] * w; a[1] += c0[1] * w; a[2] += c0[2] * w; a[3] += c0[3] * w; a[4] += c1[0] * w; a[5] += c1[1] * w; a[6] += c1[2] * w; a[7] += c1[3] * w; }
#pragma unroll
                for (int b = 0; b < 8; ++b) part[(wid * 8 + b) * 64 + lane] = a[b];
                __syncthreads();
                { const int b = tid >> 6, j = tid & 63; float s = AIN(I_BADA)[(size_t)l * 6144 + j0 + j];
#pragma unroll
                  for (int w = 0; w < 8; ++w) s += part[(w * 8 + b) * 64 + j];
                  MOD[((size_t)l * NB + b) * 6144 + j0 + j] = s; }
                __syncthreads();
            }
        }
        {
            const int* pos = (const int*)AIN(I_POS);
            for (int i = blockIdx.x * 512 + tid; i < NTOK * 4; i += F.G * 512) { const int row = i >> 2, f = i & 3;
                const float invf = (float)pow(500000.0, -0.25 * (double)f); const float ang = (float)pos[row] * invf;
                ROPE[(size_t)row * 8 + f] = (float)cos((double)ang); ROPE[(size_t)row * 8 + 4 + f] = (float)sin((double)ang); }
        }
        {
            LAS float* scr = (LAS float*)(F.lds + 49152 + wid * 8704);
            constexpr int I_IN = (DM / 64) * (PW / 32), I_OUT = (DM / 64) * (DM / 32);
            for (int it = gw; it < DEPTH * (I_IN + I_OUT); it += NGW) {
                const int l = it / (I_IN + I_OUT); int r = it % (I_IN + I_OUT);
                if (r < I_IN) { const int kb = r / (PW / 32), nb = r % (PW / 32);
                    if (nb < 112) tr_item4(AIN(I_WIN) + (size_t)l * DM * PIN, PIN, DM, WIN + (size_t)l * PW * DM, nb * 32, win_src_col(nb * 32), kb * 64, scr, lane);
                    else tr_item(AIN(I_WIN) + (size_t)l * DM * PIN, PIN, DM, WIN + (size_t)l * PW * DM, nb * 32, win_src_col(nb * 32 + (lane & 31)), kb * 64, scr, lane); }
                else { r -= I_IN; const int kb = r / (DM / 32), nb = r % (DM / 32);
                    tr_item4(AIN(I_WOUT) + (size_t)l * DM * DM, DM, DM, WOUT + (size_t)l * DM * DM, nb * 32, nb * 32, kb * 64, scr, lane); }
            }
        }
    }
    SEAM(0);
    if (IN(1) && PHON(1)) {
        PHASE_IDS();
        LAS bf16_t* Wt = (LAS bf16_t*)F.lds; load_tail_w(Wt, WIN + (size_t)PP * DM, tid);
        const int b = F.vcu >> 5; const float* md = MOD + (size_t)b * 6144;
        f32x4 sh[4], sc[4];
#pragma unroll
        for (int j = 0; j < 4; ++j) { sh[j] = *(const f32x4*)(md + 4 * lane + 256 * j); sc[j] = *(const f32x4*)(md + 1024 + 4 * lane + 256 * j) + 1.0f; }
        const int rowb = F.vcu * 128 + wid * 16;
        for (int i = 0; i < 16; ++i) { const int row = rowb + i;
#pragma unroll
            for (int j = 0; j < 4; ++j) { const f32x4 v = *(const f32x4*)(x_in + (size_t)row * DM + 4 * lane + 256 * j); const f32x4 u = v * sc[j] + sh[j];
                u32x2 w; w.x = pk2(u[0], u[1]); w.y = pk2(u[2], u[3]); *(u32x2*)(UB + (size_t)row * DM + 4 * lane + 256 * j) = w; } }
        VM_WAIT(); __syncthreads();
        tail16(UB + (size_t)rowb * DM, Wt, TAILB + (size_t)rowb * 32, lane);
    }
    SEAM(1);

    for (int l = 0; l < DEPTH; ++l) {
        const int pb = 2 + 9 * l;
#define modl (MOD + (size_t)l * NB * 6144)
#define MAKE_RP() rec::RecP RP; RP.proj = PROJ; RP.tail = TAILB; RP.csm = CSM; RP.csg = CSG; RP.stm = STM; RP.stg = STG; RP.smN = G_smN; RP.smBC = G_smBC; RP.smDM = G_smDM; RP.smMS = G_smMS; RP.smGBE = G_smGBE; RP.ycat = YCAT; \
        RP.mbi = AIN(I_MBI) + l * 4; RP.mbf = AIN(I_MBF) + l * 4; RP.mg = AIN(I_MG) + l * 64; RP.wa2 = AIN(I_WA2) + (size_t)l * 16 * 256; RP.ba = AIN(I_BA) + l * 256; RP.gg = AIN(I_GG) + l * 64;
        if (IN(pb + 0) && PHON(2)) {
            PHASE_IDS(); (void)tid;
            gm::K1 k; k.S.init(NTOK, PP, F.G, (int)blockIdx.x); k.A = UB; k.Bt = WIN + (size_t)l * PW * DM; k.O = PROJ; k.rope = ROPE;
            for (int rp = 0; rp < NREP(2); ++rp) gm::gemm_phase<gm::K1>(F.lds, k);
        }
        SEAM(pb + 0);
        if (IN(pb + 1) && PHON(3)) {
            PHASE_IDS();
            MAKE_RP();
            for (int rp = 0; rp < NREP(3); ++rp) {
                { rec::MLoc cur; int it = F.vcu; rec::ld_mloc(cur, RP, it, tid, wid, lane); rec::MLoc nxt = cur;
                  for (; it < 2048; it += F.G) { const int itn = it + F.G; if (itn < 2048) rec::ld_mloc(nxt, RP, itn, tid, wid, lane); rec::mlstm_local(cur, RP, F.lds, it, tid, wid, lane); cur = nxt; } }
                { rec::GW gwt; rec::ld_gw(gwt, RP, (F.vcu >> 6) & 3, tid);
                  rec::GLoc cur; int it = F.vcu; rec::ld_gloc(cur, RP, it, tid); rec::GLoc nxt = cur;
                  for (; it < 2048; it += F.G) { const int itn = it + F.G; if (itn < 2048) rec::ld_gloc(nxt, RP, itn, tid); rec::gla_local(cur, gwt, RP, F.lds, it, tid, wid, lane); cur = nxt; } }
            }
        }
        SEAM(pb + 1);
        if (IN(pb + 2) && PHON(4)) {
            PHASE_IDS();
            const int gt = blockIdx.x * 512 + tid, NGT = F.G * 512;
            for (int rp = 0; rp < NREP(4); ++rp) { const bool dry = (rp + 1 < NREP(4)); float* const DW = (float*)YCAT;
            for (int idx = gt; idx < 32 * 4096; idx += NGT) {
                const int bh = idx >> 12, el = idx & 4095; float* p = STM + (size_t)bh * 64 * 4096 + el; const float* bc = G_smBC + bh * 64; const float* dm = G_smDM + bh * 64;
                float C = 0.f, m = 0.f;
#pragma unroll 8
                for (int c = 0; c < NCH; ++c) { const float u = p[(size_t)c * 4096]; (dry ? (bf16_t*)DW : CSM)[((size_t)bh * 64 + c) * 4096 + el] = (bf16_t)f2bf(C); if (el == 0) G_smMS[bh * 64 + c] = m;
                    const float B = bc[c], Dm = dm[c], mn = fmaxf(B + m, Dm); C = __expf(B + m - mn) * C + __expf(Dm - mn) * u; m = mn; }
            }
            for (int idx = gt; idx < 32 * 64; idx += NGT) {
                const int bh = idx >> 6, el = idx & 63; float* p = G_smN + (size_t)bh * 64 * 64 + el; const float* bc = G_smBC + bh * 64; const float* dm = G_smDM + bh * 64;
                float C = 0.f, m = 0.f;
#pragma unroll 8
                for (int c = 0; c < NCH; ++c) { const float u = p[c * 64]; (dry ? DW + (size_t)bh * 64 * 64 + el : p)[c * 64] = C;
                    const float B = bc[c], Dm = dm[c], mn = fmaxf(B + m, Dm); C = __expf(B + m - mn) * C + __expf(Dm - mn) * u; m = mn; }
            }
            for (int idx = gt; idx < 32 * 4096; idx += NGT) {
                const int bh = idx >> 12, el = idx & 4095, d = el & 63; float* p = STG + (size_t)bh * 64 * 4096 + el; const float* be = G_smGBE + (size_t)bh * 64 * 64 + d;
                float S = 0.f;
#pragma unroll 8
                for (int c = 0; c < NCH; ++c) { const float u = p[(size_t)c * 4096]; (dry ? (bf16_t*)DW + 8 * 1024 * 1024 : CSG)[((size_t)bh * 64 + c) * 4096 + el] = (bf16_t)f2bf(S); S = __expf(be[c * 64]) * S + u; }
            }
            }
            for (int rp = 0; rp < NREP(13); ++rp) {
                LAS float* scr = (LAS float*)(F.lds + 49152 + wid * 8704);
                constexpr int I_G = (DM / 64) * (1024 / 32), I_D = (DE / 64) * (DM / 32);
                for (int it = gw; it < NE * (I_G + I_D); it += NGW) {
                    const int e = it / (I_G + I_D); int r = it % (I_G + I_D);
                    if (r < I_G) { const int kb = r / 32, nb = r % 32, n0 = nb * 32, tt = n0 >> 8, rr = n0 & 255;
                        const float* W = (rr < 128 ? AIN(I_EWG) : AIN(I_EWU)) + ((size_t)l * NE + e) * DM * DE;
                        tr_item4(W, DE, DM, WGU + (size_t)e * 1024 * 1024, n0, tt * 128 + (rr & 127), kb * 64, scr, lane); }
                    else { r -= I_G; const int kb = r / 32, nb = r % 32;
                        tr_item4(AIN(I_EWD) + ((size_t)l * NE + e) * DE * DM, DM, DE, WD + (size_t)e * 1024 * 512, nb * 32, nb * 32, kb * 64, scr, lane); }
                }
            }
        }
        SEAM(pb + 2);
        if (IN(pb + 3) && PHON(5)) {
            PHASE_IDS();
            if (PHON(10)) {
                float d1 = 0.f, d2 = 0.f;
                for (int i = 0; i < 32; ++i) { d1 += AIN(I_LQ1)[l * 32 + i] * AIN(I_LK1)[l * 32 + i]; d2 += AIN(I_LQ2)[l * 32 + i] * AIN(I_LK2)[l * 32 + i]; }
                const float lam_init = 0.8f - 0.6f * expf(-0.3f * (float)l);
                attn_body::AttnParams AP; AP.Q = (const attn_body::bf16*)(PROJ + C_DQ); AP.K = (const attn_body::bf16*)(PROJ + C_DK); AP.V = (const attn_body::bf16*)(PROJ + C_DV);
                AP.zpage = (const attn_body::bf16*)(F.ctl + CW_ZPAGE); AP.Y = YCAT + 512; AP.gnorm = AIN(I_DG) + l * 64; AP.lam = expf(d1) - expf(d2) + lam_init; AP.osc = 1.f - lam_init;
                const int bh = F.vcu >> 3, s = F.vcu & 7;
                if (F.G == 256) {
                    for (int rp = 0; rp < NREP(10); ++rp)
                    for (int i = 0; i < 2; ++i) { const int qb = (i == 0) ? s : 15 - s;
                        attn_body::attn_unit<8, 0>(bh >> 2, bh & 3, qb, AP, (char*)lds_raw); attn_body::attn_unit<8, 1>(bh >> 2, bh & 3, qb, AP, (char*)lds_raw); }
                } else {
                    for (int u = F.vcu; u < 512; u += F.G) { const int bh2 = u >> 4, qb = u & 15;
                        attn_body::attn_unit<8, 0>(bh2 >> 2, bh2 & 3, qb, AP, (char*)lds_raw); attn_body::attn_unit<8, 1>(bh2 >> 2, bh2 & 3, qb, AP, (char*)lds_raw); }
                }
            }
            __syncthreads();
            {
            PHASE_IDS();
            MAKE_RP();
            if (PHON(11)) for (int rp = 0; rp < NREP(11); ++rp) {
                { rec::MOut cur; int it = F.vcu; rec::ld_mout(cur, RP, it, tid, wid, lane); rec::MOut nxt = cur;
                  for (; it < 2048; it += F.G) { const int itn = it + F.G; if (itn < 2048) rec::ld_mout(nxt, RP, itn, tid, wid, lane); rec::mlstm_out(cur, RP, F.lds, it, tid, wid, lane); cur = nxt; } }
                { rec::GW gwt; rec::ld_gw(gwt, RP, (F.vcu >> 6) & 3, tid);
                  rec::GOut cur; int it = F.vcu; rec::ld_gout(cur, RP, it, tid); rec::GOut nxt = cur;
                  for (; it < 2048; it += F.G) { const int itn = it + F.G; if (itn < 2048) rec::ld_gout(nxt, RP, itn, tid); rec::gla_out(cur, gwt, RP, F.lds, it, tid, wid, lane); cur = nxt; } }
            }
            if (PHON(12)) for (int rp = 0; rp < NREP(12); ++rp) {
                const float* cw = AIN(I_CONVW) + (size_t)l * 3 * 256; const float* cbias = AIN(I_CONVB) + l * 256;
                for (int it = F.vcu; it < NTOK / 64; it += F.G) {
                    for (int p = tid; p < 64 * 32; p += 512) { const int r = p >> 5, chn = p & 31, row = it * 64 + r, t = row & (SEQ - 1);
                        const bf16_t* pr = PROJ + (size_t)row * PP + chn * 8;
                        float s0[8], s1[8], s2[8], cbv[8];
                        { float a[8], bq[8]; rec::unpack8(*(const u32x4*)(pr + C_CC), a); rec::unpack8(*(const u32x4*)(pr + C_CH), bq);
#pragma unroll
                          for (int i = 0; i < 8; ++i) s2[i] = a[i] * bq[i]; }
                        if (t >= 1) { float a[8], bq[8]; rec::unpack8(*(const u32x4*)(pr - PP + C_CC), a); rec::unpack8(*(const u32x4*)(pr - PP + C_CH), bq);
#pragma unroll
                          for (int i = 0; i < 8; ++i) s1[i] = a[i] * bq[i]; } else {
#pragma unroll
                          for (int i = 0; i < 8; ++i) s1[i] = 0.f; }
                        if (t >= 2) { float a[8], bq[8]; rec::unpack8(*(const u32x4*)(pr - 2 * PP + C_CC), a); rec::unpack8(*(const u32x4*)(pr - 2 * PP + C_CH), bq);
#pragma unroll
                          for (int i = 0; i < 8; ++i) s0[i] = a[i] * bq[i]; } else {
#pragma unroll
                          for (int i = 0; i < 8; ++i) s0[i] = 0.f; }
                        rec::unpack8(*(const u32x4*)(pr + C_CB), cbv);
                        float y[8];
#pragma unroll
                        for (int i = 0; i < 8; ++i) { const int cch = chn * 8 + i; y[i] = cbv[i] * (cw[cch] * s0[i] + cw[256 + cch] * s1[i] + cw[512 + cch] * s2[i] + cbias[cch]); }
                        u32x4 w; w.x = pk2(y[0], y[1]); w.y = pk2(y[2], y[3]); w.z = pk2(y[4], y[5]); w.w = pk2(y[6], y[7]);
                        *(u32x4*)(YCAT + (size_t)row * DM + 256 + chn * 8) = w; }
                }
            }
            }
        }
        SEAM(pb + 3);
        if (IN(pb + 4) && PHON(6)) {
            PHASE_IDS(); (void)tid;
            gm::K2 k; k.S.init(NTOK, DM, F.G, (int)blockIdx.x); k.A = YCAT; k.Bt = WOUT + (size_t)l * DM * DM; k.O = UB;
            gm::gemm_phase<gm::K2>(F.lds, k);
        }
        SEAM(pb + 4);
        if (IN(pb + 5) && PHON(7)) {
            PHASE_IDS();
            LAS bf16_t* Rt = (LAS bf16_t*)F.lds;
            LAS float* lgs = (LAS float*)(F.lds + 32 * TBP * 2) + wid * 256;
            { const float* rw = AIN(I_RW); for (int i = tid; i < DM * NE; i += 512) { const int k = i >> 4, e = i & 15; const float w = rw[i]; const unsigned hb = f2bf(w); const float lo = w - bf2f(hb);
                Rt[e * TBP + k] = (bf16_t)hb; Rt[(16 + e) * TBP + k] = (bf16_t)f2bf(lo); } }
            const int b = F.vcu >> 5; const float* md = modl + (size_t)b * 6144;
            const float* lg = AIN(I_LN1G) + l * DM; const float* lb = AIN(I_LN1B) + l * DM;
            f32x4 gv[4], bv[4], sh[4], sc[4], g1[4];
#pragma unroll
            for (int j = 0; j < 4; ++j) { const int cix = 4 * lane + 256 * j; gv[j] = *(const f32x4*)(lg + cix); bv[j] = *(const f32x4*)(lb + cix); g1[j] = *(const f32x4*)(md + 2 * 1024 + cix) + 1.0f;
                sh[j] = *(const f32x4*)(md + 3 * 1024 + cix); sc[j] = *(const f32x4*)(md + 4 * 1024 + cix) + 1.0f; }
            const int rowb = F.vcu * 128 + wid * 16;
            for (int i = 0; i < 16; ++i) { const int row = rowb + i;
                f32x4 v[4]; float s = 0.f;
#pragma unroll
                for (int j = 0; j < 4; ++j) { const size_t o = (size_t)row * DM + 4 * lane + 256 * j;
                    f32x4 xv; if (l == 0) xv = *(const f32x4*)(x_in + o); else { const u32x2 xw = *(const u32x2*)(XB + o); xv = (f32x4){bflo(xw.x), bfhi(xw.x), bflo(xw.y), bfhi(xw.y)}; }
                    const u32x2 yw = *(const u32x2*)(UB + o); const f32x4 yv = (f32x4){bflo(yw.x), bfhi(yw.x), bflo(yw.y), bfhi(yw.y)};
                    v[j] = xv * ALPHA + g1[j] * yv; s += (v[j][0] + v[j][1]) + (v[j][2] + v[j][3]); }
                const float mean = wave_sum(s) * (1.f / DM); float s2 = 0.f;
#pragma unroll
                for (int j = 0; j < 4; ++j) { v[j] = v[j] - mean; s2 += (v[j][0] * v[j][0] + v[j][1] * v[j][1]) + (v[j][2] * v[j][2] + v[j][3] * v[j][3]); }
                const float rstd = 1.f / sqrtf(wave_sum(s2) * (1.f / DM) + LN_EPS);
#pragma unroll
                for (int j = 0; j < 4; ++j) { const size_t o = (size_t)row * DM + 4 * lane + 256 * j; const f32x4 xn = v[j] * rstd * gv[j] + bv[j];
                    u32x2 xw; xw.x = pk2(xn[0], xn[1]); xw.y = pk2(xn[2], xn[3]); *(u32x2*)(XB + o) = xw;
                    const f32x4 u = xn * sc[j] + sh[j]; u32x2 w; w.x = pk2(u[0], u[1]); w.y = pk2(u[2], u[3]); *(u32x2*)(UB + o) = w; }
            }
            VM_WAIT(); __syncthreads();
            { f32x4 acc[2] = {(f32x4){0.f, 0.f, 0.f, 0.f}, (f32x4){0.f, 0.f, 0.f, 0.f}};
              rows16_mm<2>(acc, UB + (size_t)rowb * DM, Rt, TBP, lane);
              const int lr = lane & 15, lq = lane >> 4;
#pragma unroll
              for (int r = 0; r < 4; ++r) lgs[(lq * 4 + r) * 16 + lr] = acc[0][r] + acc[1][r]; }
            LDS_WAIT(); asm volatile("" ::: "memory");
            if (lane < 16) {
                const int row = rowb + lane; const float* rb = AIN(I_RB);
                float sco[16], bia[16];
#pragma unroll
                for (int q = 0; q < 4; ++q) { const f32x4 t4 = *(const LAS f32x4*)(lgs + lane * 16 + q * 4);
#pragma unroll
                    for (int c = 0; c < 4; ++c) { const float sg = 1.f / (1.f + __expf(-t4[c])); sco[q * 4 + c] = sg; bia[q * 4 + c] = sg + rb[q * 4 + c]; } }
                int bg = 0; float bgs = -INFINITY;
#pragma unroll
                for (int g = 0; g < 4; ++g) { const float a0 = bia[4 * g], a1 = bia[4 * g + 1], a2 = bia[4 * g + 2], a3 = bia[4 * g + 3];
                    const float h1 = fmaxf(a0, a1), l1 = fminf(a0, a1), h2 = fmaxf(a2, a3), l2 = fminf(a2, a3);
                    const float top = fmaxf(h1, h2), sec = fmaxf(fminf(h1, h2), (h1 >= h2) ? l1 : l2); const float gsc = top + sec;
                    if (gsc > bgs) { bgs = gsc; bg = g; } }
                float gb[4], gsx[4];
#pragma unroll
                for (int q = 0; q < 4; ++q) { gb[q] = (bg == 0) ? bia[q] : (bg == 1) ? bia[4 + q] : (bg == 2) ? bia[8 + q] : bia[12 + q]; gsx[q] = (bg == 0) ? sco[q] : (bg == 1) ? sco[4 + q] : (bg == 2) ? sco[8 + q] : sco[12 + q]; }
                int e1 = 0; float m1 = gb[0];
#pragma unroll
                for (int q = 1; q < 4; ++q) if (gb[q] > m1) { m1 = gb[q]; e1 = q; }
                int e2 = -1; float m2 = -INFINITY;
#pragma unroll
                for (int q = 0; q < 4; ++q) if (q != e1 && gb[q] > m2) { m2 = gb[q]; e2 = q; }
                const int ei = e1 < e2 ? e1 : e2, ej = e1 < e2 ? e2 : e1;
                const float si = (ei == 0) ? gsx[0] : (ei == 1) ? gsx[1] : (ei == 2) ? gsx[2] : gsx[3], sj = (ej == 0) ? gsx[0] : (ej == 1) ? gsx[1] : (ej == 2) ? gsx[2] : gsx[3];
                const int pr_ = (ei == 0) ? ej - 1 : (ei == 1) ? ej + 1 : 5; const int bk = bg * 6 + pr_;
                gu32* cntw = F.ctl + CW_CNT + (size_t)l * NBUCKET * 64;
                const unsigned pos = __hip_atomic_fetch_add(cntw + bk * 64, 1u, RLX_AGENT);
                LTOK[(size_t)bk * LCAP + pos] = row; const float inv = 1.f / (si + sj); LGATE[((size_t)bk * LCAP + pos) * 2] = si * inv; LGATE[((size_t)bk * LCAP + pos) * 2 + 1] = sj * inv;
                TOKSLOT[row] = (bk << 16) | (int)pos;
            }
            __syncthreads();
        }
        SEAM(pb + 5);
        if ((IN(pb + 6) || IN(pb + 7)) && PHON(8)) {
            PHASE_IDS();
            LAS int* tb = (LAS int*)(F.lds + MOE_TB_OFF);
            if (tid == 0) { gu32* cntw = F.ctl + CW_CNT + (size_t)l * NBUCKET * 64; int acc = 0;
                for (int k = 0; k < NBUCKET; ++k) { const int c = (int)__hip_atomic_load(cntw + k * 64, RLX_AGENT); tb[k] = c; tb[32 + k] = acc; acc += (c + 255) >> 8; }
                tb[32 + NBUCKET] = acc; }
            __syncthreads();
            if (IN(pb + 6)) {
                gm::K4 k; k.U = UB; k.Wgu = WGU; k.H = HB; k.ltok = LTOK; k.lgate = LGATE; k.tb = tb; k.G = F.G; k.vcu = F.vcu;
                for (int rp = 0; rp < NREP(8); ++rp) gm::gemm_phase<gm::K4>(F.lds, k);
            }
            SEAM(pb + 6);
            if (IN(pb + 7)) {
                gm::K5 k; k.H = HB; k.Wd = WD; k.Y = YSORT; k.tb = tb; k.G = F.G; k.vcu = F.vcu;
                gm::gemm_phase<gm::K5>(F.lds, k);
            }
        }
        SEAM(pb + 7);
        if (IN(pb + 8) && PHON(9)) {
            PHASE_IDS();
            const int b = F.vcu >> 5; const bool lastl = (l == DEPTH - 1);
            LAS bf16_t* Wt = (LAS bf16_t*)F.lds; LAS int* t0 = (LAS int*)(F.lds + MOE_TB_OFF);
            if (!lastl) load_tail_w(Wt, WIN + ((size_t)(l + 1) * PW + PP) * DM, tid);
            if (tid == 0) { gu32* cntw = F.ctl + CW_CNT + (size_t)l * NBUCKET * 64; int acc = 0;
                for (int k = 0; k < NBUCKET; ++k) { const int c = (int)__hip_atomic_load(cntw + k * 64, RLX_AGENT); t0[32 + k] = acc; acc += (c + 255) >> 8; } }
            __syncthreads();
            const float* mdn = MOD + ((size_t)(lastl ? l : l + 1) * NB + b) * 6144; const float* md = modl + (size_t)b * 6144;
            const float* lg = AIN(I_LN2G) + l * DM; const float* lb = AIN(I_LN2B) + l * DM;
            f32x4 gv[4], bv[4], sh[4], sc[4], g2[4];
#pragma unroll
            for (int j = 0; j < 4; ++j) { const int cix = 4 * lane + 256 * j; gv[j] = *(const f32x4*)(lg + cix); bv[j] = *(const f32x4*)(lb + cix); g2[j] = *(const f32x4*)(md + 5 * 1024 + cix) + 1.0f;
                sh[j] = *(const f32x4*)(mdn + cix); sc[j] = *(const f32x4*)(mdn + 1024 + cix) + 1.0f; }
            const int rowb = F.vcu * 128 + wid * 16;
            for (int i = 0; i < 16; ++i) { const int row = rowb + i;
                const int ts = TOKSLOT[row]; const size_t yrow = (size_t)t0[32 + (ts >> 16)] * 256 + (ts & 0xffff);
                f32x4 v[4]; float s = 0.f;
#pragma unroll
                for (int j = 0; j < 4; ++j) { const int cix = 4 * lane + 256 * j;
                    const u32x2 xw = *(const u32x2*)(XB + (size_t)row * DM + cix); const f32x4 xv = (f32x4){bflo(xw.x), bfhi(xw.x), bflo(xw.y), bfhi(xw.y)};
                    const u32x2 yw = *(const u32x2*)(YSORT + yrow * DM + cix); const f32x4 yv = (f32x4){bflo(yw.x), bfhi(yw.x), bflo(yw.y), bfhi(yw.y)};
                    v[j] = xv * ALPHA + g2[j] * yv; s += (v[j][0] + v[j][1]) + (v[j][2] + v[j][3]); }
                const float mean = wave_sum(s) * (1.f / DM); float s2 = 0.f;
#pragma unroll
                for (int j = 0; j < 4; ++j) { v[j] = v[j] - mean; s2 += (v[j][0] * v[j][0] + v[j][1] * v[j][1]) + (v[j][2] * v[j][2] + v[j][3] * v[j][3]); }
                const float rstd = 1.f / sqrtf(wave_sum(s2) * (1.f / DM) + LN_EPS);
#pragma unroll
                for (int j = 0; j < 4; ++j) { const size_t o = (size_t)row * DM + 4 * lane + 256 * j; const f32x4 xn = v[j] * rstd * gv[j] + bv[j];
                    if (lastl) *(f32x4*)(ap->out + o) = xn;
                    else { u32x2 xw; xw.x = pk2(xn[0], xn[1]); xw.y = pk2(xn[2], xn[3]); *(u32x2*)(XB + o) = xw;
                        const f32x4 u = xn * sc[j] + sh[j]; u32x2 w; w.x = pk2(u[0], u[1]); w.y = pk2(u[2], u[3]); *(u32x2*)(UB + o) = w; } }
            }
            if (!lastl) { VM_WAIT(); __syncthreads(); tail16(UB + (size_t)rowb * DM, Wt, TAILB + (size_t)rowb * 32, lane); }
        }
        SEAM(pb + 8);
    }
#undef IN
#undef SEAM
}

extern "C" void kernel_launch(void* const* d_in, const int* in_sizes, int n_in, void* d_out, int out_size, void* d_ws, size_t ws_size, hipStream_t stream) {
    static int grid = 0;
    if (grid == 0) {
        if (n_in != 29 || in_sizes[0] != NTOK * DM || out_size != NTOK * DM || ws_size < WS_END) {
            fprintf(stderr, "kernel_launch: unexpected shapes (n_in %d, in0 %d, out %d, ws %zu need %zu); nothing launched\n", n_in, n_in > 0 ? in_sizes[0] : -1, out_size, ws_size, (size_t)WS_END); grid = -1; return; }
        int dev = 0, cus = 0, per_cu = 0;
        if (hipGetDevice(&dev) != hipSuccess || hipDeviceGetAttribute(&cus, hipDeviceAttributeMultiprocessorCount, dev) != hipSuccess) { grid = -1; return; }
        if (hipFuncSetAttribute((const void*)mega_fwd, hipFuncAttributeMaxDynamicSharedMemorySize, LDS_BYTES) != hipSuccess) { fprintf(stderr, "kernel_launch: hipFuncSetAttribute failed\n"); grid = -1; return; }
        if (hipOccupancyMaxActiveBlocksPerMultiprocessor(&per_cu, (const void*)mega_fwd, 512, LDS_BYTES) != hipSuccess || per_cu < 1) { fprintf(stderr, "kernel_launch: occupancy query reports %d\n", per_cu); }
        (void)hipGetLastError();
        grid = cus;
        if (grid != 256) fprintf(stderr, "kernel_launch: %d CUs (row phases assume 256)\n", grid);
    }
    if (grid < 0) return;
    if (hipMemsetAsync((char*)d_ws + WS_CTL, 0, CTL_ZERO_BYTES, stream) != hipSuccess) return;
    Args a{};
    for (int i = 0; i < 29; ++i) a.in[i] = (const float*)d_in[i];
    a.out = (float*)d_out; a.ws = (unsigned char*)d_ws;
#if MK_ONE_LAUNCH
    a.ph_lo = 0; a.ph_hi = N_PHASES;
    hipLaunchKernelGGL(mega_fwd, dim3(grid), dim3(512), LDS_BYTES, stream, a);
#else
    for (int p = 0; p < N_PHASES; ++p) { a.ph_lo = p; a.ph_hi = p + 1; hipLaunchKernelGGL(mega_fwd, dim3(grid), dim3(512), LDS_BYTES, stream, a); }
#endif
}
```

```cpp
#include <hip/hip_runtime.h>
#include <hip/hip_bf16.h>
#include <cstdio>
#include <cstdint>
#include <cmath>

#ifndef MK_ONE_LAUNCH
#define MK_ONE_LAUNCH 1
#endif
#ifndef PHM
#define PHM 0xFFFF
#endif
#define PHON(n) (((PHM) >> (n)) & 1)
#ifndef REPM
#define REPM 0
#endif
#define NREP(n) ((((REPM) >> (n)) & 1) ? 2 : 1)

#define LAS __attribute__((address_space(3)))
#define GAS __attribute__((address_space(1)))
typedef unsigned short bf16_t;
typedef short bf16x8 __attribute__((ext_vector_type(8)));
typedef float f32x4 __attribute__((ext_vector_type(4)));
typedef float f32x2 __attribute__((ext_vector_type(2)));
typedef unsigned u32x4 __attribute__((ext_vector_type(4)));
typedef unsigned u32x2 __attribute__((ext_vector_type(2)));
typedef GAS unsigned gu32;

constexpr int NB = 8, SEQ = 4096, NTOK = NB * SEQ, DM = 1024, DEPTH = 4, NH = 4, HD = 64, PIN = 3608, PP = 3584, PW = 3840, NE = 16, DE = 512;
constexpr int NCH = SEQ / 64;
constexpr float ALPHA = 1.6817928305074290f;
constexpr float LN_EPS = 1e-6f;
constexpr float ATT_C2 = 0.17677669529663687f * 1.4426950408889634f;
constexpr int NBUCKET = 24, LCAP = NTOK;
constexpr int C_MQ = 0, C_MK = 256, C_MV = 512, C_MO = 768, C_CB = 1024, C_CC = 1280, C_CH = 1536, C_DQ = 1792, C_DK = 2048, C_DV = 2304,
              C_GQ = 2560, C_GK = 2816, C_GV = 3072, C_GR = 3328;
constexpr int T_GA = 0, T_MI = 16, T_MF = 20;

constexpr size_t MiB = 1u << 20;
constexpr size_t WS_CTL = 0, CTL_ZERO_BYTES = 1 * MiB;
constexpr size_t WS_MOD = 1 * MiB;
constexpr size_t WS_ROPE = 2 * MiB;
constexpr size_t WS_WIN = 3 * MiB;
constexpr size_t WS_WOUT = 33 * MiB;
constexpr size_t WS_WGU = 41 * MiB;
constexpr size_t WS_WD = 73 * MiB;
constexpr size_t WS_LTOK = 89 * MiB;
constexpr size_t WS_LGATE = 92 * MiB;
constexpr size_t WS_SM = 98 * MiB;
constexpr size_t WS_PROJ = 100 * MiB;
constexpr size_t WS_XR = 340 * MiB;
constexpr size_t WS_U = 468 * MiB;
constexpr size_t WS_YCAT = 532 * MiB;
constexpr size_t WS_TAIL = 596 * MiB;
constexpr size_t WS_YSORT = WS_PROJ + 100 * MiB;
constexpr size_t WS_U8 = 600 * MiB;
constexpr size_t WS_WIN8 = 632 * MiB;
constexpr size_t WS_END = 648 * MiB;
constexpr size_t SM_N = 0, SM_BC = 512 * 1024, SM_DM = 520 * 1024, SM_MS = 528 * 1024, SM_GBE = 1 * MiB, SM_TS = 1536 * 1024;
constexpr int CW_TMO = 0, CW_CODE = 1, CW_ZPAGE = 256, CW_BAR = 4096, CW_CNT = 16384, CW_RT = 24576;
constexpr int RING_BYTES = 131072, LDSCTL_OFF = RING_BYTES, MISC_OFF = LDSCTL_OFF + 320, MOE_TB_OFF = LDSCTL_OFF + 1024, LDS_BYTES = 147456;

#define RLX_AGENT __ATOMIC_RELAXED, __HIP_MEMORY_SCOPE_AGENT
#define LDS_WAIT() asm volatile("s_waitcnt lgkmcnt(0)" ::: "memory")
#define VM_WAIT() asm volatile("s_waitcnt vmcnt(0)" ::: "memory")

__device__ __forceinline__ unsigned f2bf(float f) { unsigned u = __builtin_bit_cast(unsigned, f); return (u + 0x7fffu + ((u >> 16) & 1u)) >> 16; }
__device__ __forceinline__ unsigned pk2(float lo, float hi) { typedef __bf16 bf2 __attribute__((ext_vector_type(2))); f32x2 v = {lo, hi}; bf2 b = __builtin_convertvector(v, bf2); return __builtin_bit_cast(unsigned, b); }
__device__ __forceinline__ unsigned pk4_fp8(float a, float b, float c, float d) {
    a = __builtin_amdgcn_fmed3f(a, -448.f, 448.f); b = __builtin_amdgcn_fmed3f(b, -448.f, 448.f); c = __builtin_amdgcn_fmed3f(c, -448.f, 448.f); d = __builtin_amdgcn_fmed3f(d, -448.f, 448.f);
    int w = 0; w = __builtin_amdgcn_cvt_pk_fp8_f32(a, b, w, false); w = __builtin_amdgcn_cvt_pk_fp8_f32(c, d, w, true); return (unsigned)w; }
__device__ __forceinline__ void st8_wt(void* p, u32x2 v) { asm volatile("global_store_dwordx2 %0, %1, off sc1\n\ts_nop 0" :: "v"(p), "v"(v) : "memory"); }
constexpr float W8S = 64.f, H8S = 16.f, Y8S = 8.f;
__device__ __forceinline__ float bf2f(unsigned b) { return __builtin_bit_cast(float, b << 16); }
__device__ __forceinline__ float bflo(unsigned w) { return __builtin_bit_cast(float, w << 16); }
__device__ __forceinline__ float bfhi(unsigned w) { return __builtin_bit_cast(float, w & 0xffff0000u); }
__device__ __forceinline__ void st16_wt(void* p, u32x4 v) { asm volatile("global_store_dwordx4 %0, %1, off sc1\n\ts_nop 1" :: "v"(p), "v"(v) : "memory"); }
__device__ __forceinline__ float wave_sum(float v) {
#pragma unroll
    for (int o = 1; o < 64; o <<= 1) v += __shfl_xor(v, o);
    return v;
}
__device__ __forceinline__ float wave_max(float v) {
#pragma unroll
    for (int o = 1; o < 64; o <<= 1) v = fmaxf(v, __shfl_xor(v, o));
    return v;
}
__device__ __forceinline__ float fexp(float x) { return __builtin_amdgcn_exp2f(x * 1.4426950408889634f); }
__device__ __forceinline__ float flog(float x) { return __builtin_amdgcn_logf(x) * 0.6931471805599453f; }
__device__ __forceinline__ float logsig(float z) { return fminf(z, 0.f) - flog(1.f + fexp(-fabsf(z))); }
__device__ __forceinline__ float sigmoidf_(float z) { return 1.f / (1.f + fexp(-z)); }

#define XB_TMO      128
#define XB_XCNT(j)  (256  + 64 * (j))
#define XB_XSUB(j)  (1280 + 64 * (j))
#define XB_XGEN(j)  (2304 + 64 * (j))
#define XB_TOP      3328
#define XB_TOPGEN   3392
#define XCD_BAR_WORDS 3456
#define XB_SPIN_CAP (1u << 18)
__device__ __forceinline__ unsigned xb_ld(unsigned* p)              { return __hip_atomic_load(p, __ATOMIC_RELAXED, __HIP_MEMORY_SCOPE_AGENT); }
__device__ __forceinline__ unsigned xb_add(unsigned* p, unsigned v) { return __hip_atomic_fetch_add(p, v, __ATOMIC_RELAXED, __HIP_MEMORY_SCOPE_AGENT); }
__device__ __forceinline__ unsigned xb_xcc_id() { return (unsigned)__builtin_amdgcn_s_getreg((3 << 11) | 20) & 0xFu; }
#define XB_SPIN(cond, bar) do { unsigned _sp = 0; while (cond) { __builtin_amdgcn_s_sleep(1); \
    if ((++_sp & 255u) == 0u) { if (xb_ld(&(bar)[XB_TMO])) break; if (_sp > XB_SPIN_CAP) { atomicAdd(&(bar)[XB_TMO], 1u); break; } } } } while (0)
struct XcdBarrier { unsigned* bar; unsigned x; volatile LAS unsigned* st; };
__device__ __forceinline__ XcdBarrier xcd_barrier_post(unsigned* bar, volatile LAS unsigned* st) {
    XcdBarrier b; b.bar = bar; b.x = xb_xcc_id(); b.st = st;
    if (threadIdx.x == 0) (void)xb_add(&bar[XB_XCNT(b.x)], 1u);
    return b;
}
__device__ __forceinline__ void xcd_barrier_complete(unsigned* bar, unsigned x, unsigned& nloc, unsigned& nx) {
    const unsigned G = gridDim.x * gridDim.y * gridDim.z;
    unsigned sum, cnt, mine, sp = 0u;
    for (;;) {
        sum = 0u; cnt = 0u; mine = 0u;
#pragma unroll
        for (unsigned j = 0; j < 16; ++j) { const unsigned c = xb_ld(&bar[XB_XCNT(j)]); sum += c; cnt += (c > 0u) ? 1u : 0u; mine = (j == x) ? c : mine; }
        if (sum == G) break;
        __builtin_amdgcn_s_sleep(1);
        if ((++sp & 255u) == 0u) { if (xb_ld(&bar[XB_TMO])) break; if (sp > XB_SPIN_CAP) { atomicAdd(&bar[XB_TMO], 1u); break; } }
    }
    nloc = mine > 0u ? mine : 1u; nx = cnt > 0u ? cnt : 1u;
}
__device__ __forceinline__ void xcd_barrier(const XcdBarrier& b) {
    asm volatile("s_waitcnt vmcnt(0)" ::: "memory");
    __syncthreads();
    if (threadIdx.x == 0) {
        unsigned* bar = b.bar;
        __builtin_amdgcn_s_waitcnt(0);
        unsigned nloc = b.st[0], nx = b.st[1];
        if (nloc == 0u) { xcd_barrier_complete(bar, b.x, nloc, nx); b.st[0] = nloc; b.st[1] = nx; }
        const unsigned old = xb_add(&bar[XB_XSUB(b.x)], 1u);
        const unsigned gen = old / nloc;
        if (old + 1u == (gen + 1u) * nloc) {
            __builtin_amdgcn_fence(__ATOMIC_RELEASE, "agent");
            asm volatile("s_waitcnt vmcnt(0)" ::: "memory");
            const unsigned og = xb_add(&bar[XB_TOP], 1u);
            const unsigned tg = og / nx;
            if (og + 1u == (tg + 1u) * nx) xb_add(&bar[XB_TOPGEN], 1u);
            else XB_SPIN(xb_ld(&bar[XB_TOPGEN]) == tg, bar);
            __builtin_amdgcn_fence(__ATOMIC_ACQUIRE, "agent");
            xb_add(&bar[XB_XGEN(b.x)], 1u);
            asm volatile("s_waitcnt vmcnt(0)" ::: "memory");
        } else {
            XB_SPIN(xb_ld(&bar[XB_XGEN(b.x)]) == gen, bar);
            __builtin_amdgcn_fence(__ATOMIC_ACQUIRE, "agent");
            asm volatile("s_waitcnt vmcnt(0)" ::: "memory");
        }
    }
    __syncthreads();
}

namespace gm {
constexpr int BM = 256, BK = 64, HALF = 128, HTB = HALF * BK * 2, NXCD = 8, WGM = 8;
typedef int v4i_t __attribute__((ext_vector_type(4))); typedef int v8i_t __attribute__((ext_vector_type(8)));
__host__ __device__ __forceinline__ int lds_byte(int r, int c) { const int st = (r >> 4) * 2 + (c >> 5), rr = r & 15, cc = c & 31, ob = rr * 64 + cc * 2; return st * 1024 + (ob ^ (((ob >> 9) & 1) << 5)); }
__host__ __device__ __forceinline__ void stage_rc(int b, int& R, int& C) { const int st = b / 1024, sb = b % 1024, swz = sb ^ (((sb >> 9) & 1) << 5); R = (st >> 1) * 16 + swz / 64; C = (st & 1) * 32 + (swz % 64) / 2; }
__host__ __device__ __forceinline__ int perm32(int rho) { const int n = rho >> 4, i = rho & 15; return 8 * (i >> 2) + 4 * n + (i & 3); }
struct Unit { int pm, pn, bk, tb; };
struct Src { const char* a; const char* b0; const char* b1; unsigned va[2][2]; };
struct StaticOrder {
    int nM, nN, nwg, G, c;
    __device__ void init(int M, int N, int G_, int c_) { nM = M / BM; nN = N / BM; nwg = nM * nN; G = G_; c = c_; }
    __device__ __forceinline__ bool next(int i, Unit& u) const {
        const long L = (long)i * G + c; if (L >= nwg) return false;
        int wgid = (int)L; { const int q = nwg / NXCD, r = nwg % NXCD, xcd = wgid % NXCD, off = wgid / NXCD; wgid = (xcd < r ? xcd * (q + 1) : r * (q + 1) + (xcd - r) * q) + off; }
        const int nig = WGM * nN, gid = wgid / nig, fm = gid * WGM, gsz = (nM - fm) < WGM ? (nM - fm) : WGM;
        u.pm = fm + ((wgid % nig) % gsz); u.pn = (wgid % nig) / gsz; u.bk = 0; u.tb = 0; return true;
    }
};

template <class Kind>
__device__ __forceinline__ void gemm_phase(LAS unsigned char* lds, const Kind& Kd) {
    int tid_ = threadIdx.x; asm volatile("" : "+v"(tid_));
    const int tid = tid_, wid = __builtin_amdgcn_readfirstlane(tid >> 6), lane = tid & 63, wr = wid >> 2, wc = wid & 3, fr = lane & 15, fq = lane >> 4;
    int R[2], C[2]; unsigned voffB[2];
#pragma unroll
    for (int i = 0; i < 2; ++i) { stage_rc(tid * 16 + i * 8192, R[i], C[i]); const int Rb = Kind::PERM ? ((R[i] & ~31) + perm32(R[i] & 31)) : R[i]; voffB[i] = (unsigned)(Rb * Kind::LDBB + C[i] * 2); }
    const size_t hstepB = (size_t)HALF * Kind::LDBB;
    constexpr int NT = Kind::NTK;
    const unsigned ldsw = (unsigned)wid * 1024u;
    const int aoff = lds_byte(wr * 64 + fr, fq * 8), boff = lds_byte(wc * 32 + fr, fq * 8);
#define G_SA(b, h) (((b) * 2 + (h)) * HTB)
#define G_SB(b, h) ((4 + (b) * 2 + (h)) * HTB)
#define G_STAGE_A(bufoff, S, t, h) do { const char* _g = (S).a + (size_t)(t) * 128; _Pragma("unroll") for (int _i = 0; _i < 2; ++_i) \
        __builtin_amdgcn_global_load_lds((const unsigned*)(_g + (S).va[h][_i]), (LAS unsigned*)(lds + (bufoff) + ldsw + _i * 8192), 16, 0, 0); } while (0)
#define G_STAGE_B(bufoff, S, t, h) do { const char* _g = (((t) < NT / 2) ? (S).b0 + (size_t)(t) * 128 : (S).b1 + (size_t)((t) - NT / 2) * 128) + (h) * hstepB; _Pragma("unroll") for (int _i = 0; _i < 2; ++_i) \
        __builtin_amdgcn_global_load_lds((const unsigned*)(_g + voffB[_i]), (LAS unsigned*)(lds + (bufoff) + ldsw + _i * 8192), 16, 0, 0); } while (0)
#define G_LDA(dst, b, h) do { _Pragma("unroll") for (int m = 0; m < 4; ++m) _Pragma("unroll") for (int k = 0; k < 2; ++k) dst[m][k] = *(const LAS bf16x8*)(lds + G_SA(b, h) + aoff + m * 2048 + k * 1024); } while (0)
#define G_LDB(dst, b, h) do { _Pragma("unroll") for (int n = 0; n < 2; ++n) _Pragma("unroll") for (int k = 0; k < 2; ++k) dst[n][k] = *(const LAS bf16x8*)(lds + G_SB(b, h) + boff + n * 2048 + k * 1024); } while (0)
#define G_MMA(ai, bj, At, Bt) do { __builtin_amdgcn_s_setprio(1); _Pragma("unroll") for (int m = 0; m < 4; ++m) _Pragma("unroll") for (int n = 0; n < 2; ++n) _Pragma("unroll") for (int k = 0; k < 2; ++k) \
        acc[ai][bj][m][n] = __builtin_amdgcn_mfma_f32_16x16x32_bf16(Bt[n][k], At[m][k], acc[ai][bj][m][n], 0, 0, 0); __builtin_amdgcn_s_setprio(0); } while (0)
#define G_LDA8(dst, b, h) do { _Pragma("unroll") for (int m = 0; m < 4; ++m) { const v4i_t _lo = *(const LAS v4i_t*)(lds + G_SA(b, h) + aoff + m * 2048), _hi = *(const LAS v4i_t*)(lds + G_SA(b, h) + aoff + m * 2048 + 1024); \
        dst[m] = __builtin_shufflevector(_lo, _hi, 0, 1, 2, 3, 4, 5, 6, 7); } } while (0)
#define G_LDB8(dst, b, h) do { _Pragma("unroll") for (int n = 0; n < 2; ++n) { const v4i_t _lo = *(const LAS v4i_t*)(lds + G_SB(b, h) + boff + n * 2048), _hi = *(const LAS v4i_t*)(lds + G_SB(b, h) + boff + n * 2048 + 1024); \
        dst[n] = __builtin_shufflevector(_lo, _hi, 0, 1, 2, 3, 4, 5, 6, 7); } } while (0)
#define G_MMA8(ai, bj, A8_, B8_) do { __builtin_amdgcn_s_setprio(1); _Pragma("unroll") for (int m = 0; m < 4; ++m) _Pragma("unroll") for (int n = 0; n < 2; ++n) \
        asm volatile("v_mfma_scale_f32_16x16x128_f8f6f4 %0, %1, %2, %0, %3, %3 op_sel_hi:[0,0,0]" : "+v"(acc[ai][bj][m][n]) : "v"(B8_[n]), "v"(A8_[m]), "v"(sc1v)); __builtin_amdgcn_s_setprio(0); } while (0)
#define X_LDA(b, h) do { if constexpr (Kind::FP8) G_LDA8(A8, b, h); else G_LDA(At, b, h); } while (0)
#define X_LDB0(b, h) do { if constexpr (Kind::FP8) G_LDB8(B08, b, h); else G_LDB(B0, b, h); } while (0)
#define X_LDB1(b, h) do { if constexpr (Kind::FP8) G_LDB8(B18, b, h); else G_LDB(B1, b, h); } while (0)
#define X_MM0(ai, bj) do { if constexpr (Kind::FP8) G_MMA8(ai, bj, A8, B08); else G_MMA(ai, bj, At, B0); } while (0)
#define X_MM1(ai, bj) do { if constexpr (Kind::FP8) G_MMA8(ai, bj, A8, B18); else G_MMA(ai, bj, At, B1); } while (0)
#define G_WAIT_V(n) asm volatile("s_waitcnt vmcnt(" #n ")" ::: "memory")
#define G_WAIT_L(n) asm volatile("s_waitcnt lgkmcnt(" #n ")" ::: "memory")
#define G_WAIT_R() do { if (relax) asm volatile("s_waitcnt vmcnt(%0)" :: "n"(8 + Kind::NST) : "memory"); else G_WAIT_V(8); } while (0)
#define G_BAR __builtin_amdgcn_s_barrier()
#define G_SCHED __builtin_amdgcn_sched_barrier(0)
    Unit cur, nxt; Src sc, sn; int ui = 0; int pend = -1;
    if (!Kd.next(0, cur)) return;
    Kd.src(cur, sc, R, C);
    Kd.a_ready(cur, wid);
    f32x4 acc[2][2][4][2];
#pragma unroll
    for (int a = 0; a < 2; ++a)
#pragma unroll
        for (int b = 0; b < 2; ++b)
#pragma unroll
            for (int m = 0; m < 4; ++m)
#pragma unroll
                for (int n = 0; n < 2; ++n) acc[a][b][m][n] = (f32x4){0.f, 0.f, 0.f, 0.f};
    bf16x8 At[4][2], B0[2][2], B1[2][2]; v8i_t A8[4], B08[2], B18[2]; int sc1v = 0x7f7f7f7f; asm volatile("" : "+v"(sc1v));
    G_STAGE_B(G_SB(0, 0), sc, 0, 0); G_STAGE_B(G_SB(0, 1), sc, 0, 1); G_STAGE_A(G_SA(0, 0), sc, 0, 0); G_STAGE_A(G_SA(0, 1), sc, 0, 1);
    if (wr == 1) G_BAR;
    G_WAIT_V(2); G_BAR;
    G_STAGE_B(G_SB(1, 0), sc, 1, 0); G_STAGE_A(G_SA(1, 0), sc, 1, 0); G_STAGE_B(G_SB(1, 1), sc, 1, 1); G_STAGE_A(G_SA(1, 1), sc, 1, 1);
    G_WAIT_V(8); G_BAR;
    bool after_epi = false;
    for (;;) {
        const bool has_next = Kd.next(ui + 1, nxt);
        if (has_next) Kd.src(nxt, sn, R, C); else sn = sc;
#pragma unroll 1
        for (int t = 0; t < NT; t += 2) {
            const bool last = (t == NT - 2);
            if (last && has_next) Kd.a_ready(nxt, wid);
            Src s2; s2.a = last ? sn.a : sc.a; s2.b0 = last ? sn.b0 : sc.b0; s2.b1 = last ? sn.b1 : sc.b1;
            s2.va[0][0] = last ? sn.va[0][0] : sc.va[0][0]; s2.va[0][1] = last ? sn.va[0][1] : sc.va[0][1]; s2.va[1][0] = last ? sn.va[1][0] : sc.va[1][0]; s2.va[1][1] = last ? sn.va[1][1] : sc.va[1][1];
            const int t2 = last ? 0 : t + 2, t3 = t2 + 1;
            const bool relax = after_epi && (t == 0);
            X_LDB0(0, 0); X_LDB1(0, 1); G_SCHED; X_LDA(0, 0);
            G_WAIT_R(); G_WAIT_L(0); G_BAR; X_MM0(0, 0); X_MM1(0, 1); G_BAR; G_SCHED;
            X_LDA(0, 1); G_STAGE_B(G_SB(0, 0), s2, t2, 0); G_STAGE_B(G_SB(0, 1), s2, t2, 1); G_STAGE_A(G_SA(0, 0), s2, t2, 0);
            G_WAIT_R(); G_WAIT_L(0); G_BAR; X_MM0(1, 0); X_MM1(1, 1); G_BAR; G_SCHED;
            X_LDB0(1, 0); X_LDB1(1, 1); G_SCHED; X_LDA(1, 0); G_STAGE_A(G_SA(0, 1), s2, t2, 1);
            G_WAIT_R(); G_WAIT_L(0); G_BAR; X_MM0(0, 0); X_MM1(0, 1); G_BAR; G_SCHED;
            X_LDA(1, 1); G_STAGE_B(G_SB(1, 0), s2, t3, 0); G_STAGE_B(G_SB(1, 1), s2, t3, 1); G_STAGE_A(G_SA(1, 0), s2, t3, 0);
            G_WAIT_V(8); G_WAIT_L(0); G_BAR; X_MM0(1, 0); X_MM1(1, 1); G_BAR; G_STAGE_A(G_SA(1, 1), s2, t3, 1); G_SCHED;
        }
        if (wr == 0) G_BAR;
        if (Kind::PUBLISH) { if (pend >= 0) Kd.publish(pend); pend = cur.pm; }
        if (Kind::FP8) asm volatile("s_nop 15\n\ts_nop 15" ::: "memory");
        Kd.epi(acc, cur, wr, wc, fr, fq);
        if (!has_next) break;
#pragma unroll
        for (int a = 0; a < 2; ++a)
#pragma unroll
            for (int b = 0; b < 2; ++b)
#pragma unroll
                for (int m = 0; m < 4; ++m)
#pragma unroll
                    for (int n = 0; n < 2; ++n) acc[a][b][m][n] = (f32x4){0.f, 0.f, 0.f, 0.f};
        cur = nxt; sc = sn; ++ui; after_epi = true;
        if (wr == 1) G_BAR;
    }
    G_WAIT_V(0);
    if (Kind::PUBLISH) { if (pend >= 0) Kd.publish(pend); }
    G_BAR;
#undef G_SA
#undef G_SB
#undef G_STAGE_A
#undef G_STAGE_B
#undef G_LDA
#undef G_LDB
#undef G_MMA
#undef G_MMA8
#undef G_LDA8
#undef G_LDB8
#undef X_LDA
#undef X_LDB0
#undef X_LDB1
#undef X_MM0
#undef X_MM1
#undef G_WAIT_V
#undef G_WAIT_L
#undef G_WAIT_R
#undef G_BAR
#undef G_SCHED
}

__device__ __forceinline__ void src_direct(Src& s, const void* A, int row0, const int (&R)[2], const int (&C)[2], int pitchb = 2048) {
    s.a = (const char*)A + (size_t)row0 * pitchb;
#pragma unroll
    for (int h = 0; h < 2; ++h)
#pragma unroll
        for (int i = 0; i < 2; ++i) s.va[h][i] = (unsigned)((h * HALF + R[i]) * pitchb + C[i] * 2);
}

template <bool F8> struct K1 {
    static constexpr bool PERM = true, PUBLISH = false, FP8 = F8; static constexpr int LDBB = F8 ? 1024 : 2048, NTK = F8 ? 8 : 16, NST = 16;
    __device__ __forceinline__ void publish(int) const {}
    __device__ __forceinline__ void a_ready(const Unit&, int) const {}
    __device__ __forceinline__ void done(const Unit&) const {}
    StaticOrder S; const void* A; const void* Bt; bf16_t* O; const float* rope;
    __device__ __forceinline__ bool next(int i, Unit& u) const { return S.next(i, u); }
    __device__ __forceinline__ void src(const Unit& u, Src& s, const int (&R)[2], const int (&C)[2]) const {
        src_direct(s, A, u.pm * BM, R, C, F8 ? 1024 : 2048); s.b0 = (const char*)Bt + (size_t)u.pn * BM * (F8 ? 1024 : 2048); s.b1 = s.b0 + (F8 ? 512 : 1024);
    }
    __device__ __forceinline__ void epi(const f32x4 (&acc)[2][2][4][2], const Unit& u, int wr, int wc, int fr, int fq) const {
        const int row0 = u.pm * BM + wr * 64 + fr, col0 = u.pn * BM + wc * 32 + 8 * fq;
        if (u.pn == 7 || u.pn == 8) {
#pragma unroll
            for (int ai = 0; ai < 2; ++ai)
#pragma unroll
                for (int m = 0; m < 4; ++m) {
                    const int row = row0 + ai * HALF + m * 16;
                    const f32x4 cs = *(const f32x4*)(rope + (size_t)row * 8), sn = *(const f32x4*)(rope + (size_t)row * 8 + 4);
                    bf16_t* rowp = O + (size_t)row * PP + col0;
#pragma unroll
                    for (int bj = 0; bj < 2; ++bj) {
                        f32x4 v0 = acc[ai][bj][m][0], v1 = acc[ai][bj][m][1]; if (F8) { v0 = v0 * (1.f / W8S); v1 = v1 * (1.f / W8S); }
                        if (fq == 0) { const f32x4 x1 = v0, x2 = v1; v0 = x1 * cs - x2 * sn; v1 = x2 * cs + x1 * sn; }
                        u32x4 w; w.x = pk2(v0[0], v0[1]); w.y = pk2(v0[2], v0[3]); w.z = pk2(v1[0], v1[1]); w.w = pk2(v1[2], v1[3]);
                        *(u32x4*)(rowp + bj * HALF) = w;
                    }
                }
        } else {
#pragma unroll
            for (int ai = 0; ai < 2; ++ai)
#pragma unroll
                for (int m = 0; m < 4; ++m) { bf16_t* rowp = O + (size_t)(row0 + ai * HALF + m * 16) * PP + col0;
#pragma unroll
                    for (int bj = 0; bj < 2; ++bj) { f32x4 v0 = acc[ai][bj][m][0], v1 = acc[ai][bj][m][1]; if (F8) { v0 = v0 * (1.f / W8S); v1 = v1 * (1.f / W8S); }
                        u32x4 w; w.x = pk2(v0[0], v0[1]); w.y = pk2(v0[2], v0[3]); w.z = pk2(v1[0], v1[1]); w.w = pk2(v1[2], v1[3]);
                        *(u32x4*)(rowp + bj * HALF) = w; } }
        }
    }
};
struct K2 {
    static constexpr bool PERM = true, PUBLISH = false, FP8 = true; static constexpr int LDBB = 1024, NTK = 8, NST = 16;
    __device__ __forceinline__ void publish(int) const {}
    __device__ __forceinline__ void a_ready(const Unit&, int) const {}
    __device__ __forceinline__ void done(const Unit&) const {}
    StaticOrder S; const unsigned char* A; const unsigned char* Bt; bf16_t* O;
    __device__ __forceinline__ bool next(int i, Unit& u) const { return S.next(i, u); }
    __device__ __forceinline__ void src(const Unit& u, Src& s, const int (&R)[2], const int (&C)[2]) const {
        src_direct(s, A, u.pm * BM, R, C, 1024); s.b0 = (const char*)(Bt + (size_t)u.pn * BM * 1024); s.b1 = s.b0 + 512;
    }
    __device__ __forceinline__ void epi(const f32x4 (&acc)[2][2][4][2], const Unit& u, int wr, int wc, int fr, int fq) const {
        const int row0 = u.pm * BM + wr * 64 + fr, col0 = u.pn * BM + wc * 32 + 8 * fq;
#pragma unroll
        for (int ai = 0; ai < 2; ++ai)
#pragma unroll
            for (int m = 0; m < 4; ++m) { bf16_t* rowp = O + (size_t)(row0 + ai * HALF + m * 16) * DM + col0;
#pragma unroll
                for (int bj = 0; bj < 2; ++bj) { const f32x4 v0 = acc[ai][bj][m][0] * (1.f / (W8S * Y8S)), v1 = acc[ai][bj][m][1] * (1.f / (W8S * Y8S));
                    u32x4 w; w.x = pk2(v0[0], v0[1]); w.y = pk2(v0[2], v0[3]); w.z = pk2(v1[0], v1[1]); w.w = pk2(v1[2], v1[3]);
                    *(u32x4*)(rowp + bj * HALF) = w; } }
    }
};
__device__ __forceinline__ int pair_i(int p) { return p < 3 ? 0 : (p < 5 ? 1 : 2); }
__device__ __forceinline__ int pair_j(int p) { return p < 3 ? p + 1 : (p < 5 ? p - 1 : 3); }
struct K4 {
    static constexpr bool PERM = true, PUBLISH = false, FP8 = true; static constexpr int LDBB = 1024, NTK = 8, NST = 8;
    const unsigned char* U; const unsigned char* Wgu; unsigned char* H; const int* ltok; const float* lgate; const LAS int* tb; int G, vcu; gu32* rtc;
    __device__ __forceinline__ void a_ready(const Unit&, int) const {}
    __device__ __forceinline__ void done(const Unit&) const {}
    __device__ __forceinline__ void publish(int pm) const { if ((threadIdx.x & 63) == 0) __hip_atomic_fetch_add(rtc + 64 * pm, 1u, RLX_AGENT); }
    __device__ __forceinline__ bool next(int i, Unit& u) const {
        const int L = i * G + vcu; const int nt = tb[32 + NBUCKET]; if (L >= nt * 8) return false;
        const int rt = L >> 3; int k = 0;
        for (int q = 1; q < NBUCKET; ++q) k = (tb[32 + q] <= rt) ? q : k;
        u.pm = rt; u.pn = L & 7; u.bk = k; u.tb = rt - tb[32 + k]; return true;
    }
    __device__ __forceinline__ void src(const Unit& u, Src& s, const int (&R)[2], const int (&C)[2]) const {
        const int cnt = tb[u.bk]; s.a = (const char*)U;
#pragma unroll
        for (int h = 0; h < 2; ++h)
#pragma unroll
            for (int i = 0; i < 2; ++i) { const int pos = u.tb * BM + h * HALF + R[i]; const int tok = ltok[(size_t)u.bk * LCAP + (pos < cnt ? pos : 0)]; s.va[h][i] = (unsigned)(tok * 1024 + C[i] * 2); }
        const int grp = u.bk / 6, p = u.bk % 6, sl = u.pn >> 2; const int e = grp * 4 + (sl ? pair_j(p) : pair_i(p));
        s.b0 = (const char*)(Wgu + ((size_t)e * 1024 + (size_t)(u.pn & 3) * BM) * 1024); s.b1 = s.b0 + 512;
    }
    __device__ __forceinline__ void epi(const f32x4 (&acc)[2][2][4][2], const Unit& u, int wr, int wc, int fr, int fq) const {
        const int cnt = tb[u.bk], sl = u.pn >> 2; const int colo = sl * 512 + (u.pn & 3) * 128 + wc * 32 + 8 * fq;
#pragma unroll
        for (int ai = 0; ai < 2; ++ai)
#pragma unroll
            for (int m = 0; m < 4; ++m) {
                const int r = ai * HALF + wr * 64 + m * 16 + fr, pos = u.tb * BM + r;
                const float gt = (pos < cnt) ? lgate[((size_t)u.bk * LCAP + pos) * 2 + sl] : 0.f;
                float hv[8];
#pragma unroll
                for (int n = 0; n < 2; ++n)
#pragma unroll
                    for (int j = 0; j < 4; ++j) { const float g = acc[ai][0][m][n][j] * (1.f / W8S), up = acc[ai][1][m][n][j] * (1.f / W8S); hv[n * 4 + j] = g * __builtin_amdgcn_rcpf(1.f + fexp(-g)) * up * (gt * H8S); }
                u32x2 w; w.x = pk4_fp8(hv[0], hv[1], hv[2], hv[3]); w.y = pk4_fp8(hv[4], hv[5], hv[6], hv[7]);
                *(u32x2*)(H + (size_t)(u.pm * BM + r) * 1024 + colo) = w;
            }
    }
};
struct K5 {
    static constexpr bool PERM = true, PUBLISH = false, FP8 = true; static constexpr int LDBB = 512, NTK = 8, NST = 16;
    __device__ __forceinline__ void publish(int) const {}
    const unsigned char* H; const unsigned char* Wd; bf16_t* Y; const LAS int* tb; int G, vcu; gu32* rtc; gu32* tmo;
    __device__ __forceinline__ void done(const Unit&) const {}
    __device__ __forceinline__ void a_ready(const Unit& u, int wid) const { return;
        if (wid == 0) {
            const unsigned long long t0 = __builtin_amdgcn_s_memrealtime(); unsigned polls = 0;
            while ((unsigned)__builtin_amdgcn_readfirstlane(__hip_atomic_load(rtc + 64 * u.pm, RLX_AGENT)) < 64u) {
                if ((++polls & 255u) == 0u && __builtin_amdgcn_readfirstlane(__hip_atomic_load(tmo, RLX_AGENT)) != 0u) break;
                if (__builtin_amdgcn_s_memrealtime() - t0 > 2000000ull) { if ((threadIdx.x & 63) == 0) __hip_atomic_store(tmo, 1u, RLX_AGENT); break; }
                __builtin_amdgcn_s_sleep(2); }
            __builtin_amdgcn_fence(__ATOMIC_ACQUIRE, "agent");
            asm volatile("s_waitcnt vmcnt(0)" ::: "memory");
        }
        asm volatile("" ::: "memory"); __builtin_amdgcn_s_barrier(); asm volatile("" ::: "memory");
    }
    __device__ __forceinline__ bool next(int i, Unit& u) const {
        const int nt = tb[32 + NBUCKET]; const int n4 = nt * 8; const int i0 = 0; (void)n4;
        const int L = (i + i0) * G + vcu; if (L >= nt * 4) return false;
        const int rt = L >> 2; int k = 0;
        for (int q = 1; q < NBUCKET; ++q) k = (tb[32 + q] <= rt) ? q : k;
        u.pm = rt; u.pn = L & 3; u.bk = k; u.tb = rt - tb[32 + k]; return true;
    }
    __device__ __forceinline__ void src(const Unit& u, Src& s, const int (&R)[2], const int (&C)[2]) const {
        src_direct(s, H, u.pm * BM, R, C, 1024);
        const int grp = u.bk / 6, p = u.bk % 6;
        s.b0 = (const char*)(Wd + ((size_t)(grp * 4 + pair_i(p)) * 1024 + (size_t)u.pn * BM) * 512);
        s.b1 = (const char*)(Wd + ((size_t)(grp * 4 + pair_j(p)) * 1024 + (size_t)u.pn * BM) * 512);
    }
    __device__ __forceinline__ void epi(const f32x4 (&acc)[2][2][4][2], const Unit& u, int wr, int wc, int fr, int fq) const {
        const int row0 = u.pm * BM + wr * 64 + fr, col0 = u.pn * BM + wc * 32 + 8 * fq;
#pragma unroll
        for (int ai = 0; ai < 2; ++ai)
#pragma unroll
            for (int m = 0; m < 4; ++m) { bf16_t* rowp = Y + (size_t)(row0 + ai * HALF + m * 16) * DM + col0;
#pragma unroll
                for (int bj = 0; bj < 2; ++bj) { const f32x4 v0 = acc[ai][bj][m][0] * (1.f / (W8S * H8S)), v1 = acc[ai][bj][m][1] * (1.f / (W8S * H8S));
                    u32x4 w; w.x = pk2(v0[0], v0[1]); w.y = pk2(v0[2], v0[3]); w.z = pk2(v1[0], v1[1]); w.w = pk2(v1[2], v1[3]);
                    *(u32x4*)(rowp + bj * HALF) = w; } }
    }
};
}

namespace attn_body {
using bf16 = __hip_bfloat16;
using s16x4 = __attribute__((ext_vector_type(4))) short;
using f32x16 = __attribute__((ext_vector_type(16))) float;
constexpr int D = 64, PITCH = PP;
constexpr int NW = 8, QBLK = 32, QB = QBLK * NW, KVBLK = 64;
__device__ __forceinline__ int crow(int r, int hi) { return (r & 3) + 8 * (r >> 2) + 4 * hi; }
#define SBAR() __builtin_amdgcn_sched_barrier(0)
__device__ __forceinline__ void cmask(f32x16& p0, f32x16& p1, int jb, int qrel, int hi) {
    const float NEG = -INFINITY; int kb = 64 * jb + 4 * hi;
#pragma unroll
    for (int r = 0; r < 16; ++r) { int kv = kb + (r & 3) + 8 * (r >> 2); if (kv > qrel) p0[r] = NEG; if (kv + 32 > qrel) p1[r] = NEG; }
}
constexpr int NSLOT = 3, SLOTB = 8192;
constexpr int LDS_K = 0, LDS_V = NSLOT * SLOTB, LDS_WS = 2 * NSLOT * SLOTB, LDS_OST = LDS_WS + NW * 64 * 4, ATT_LDS_BYTES = LDS_OST + NW * 8192;
__device__ __forceinline__ void glds16(const void* gsrc, unsigned lds_dst) { unsigned keep;
    asm volatile("s_mov_b32 %0, m0\n\ts_mov_b32 m0, %2\n\ts_nop 0\n\tglobal_load_lds_dwordx4 %1, off\n\ts_mov_b32 m0, %0" : "=&s"(keep) : "v"(gsrc), "s"(lds_dst) : "memory"); }
__device__ __forceinline__ float max3f(float a, float b, float c) { float r; asm("v_max3_f32 %0, %1, %2, %3" : "=v"(r) : "v"(a), "v"(b), "v"(c)); return r; }
__device__ __forceinline__ float max2f(float a, float b) { float r; asm("v_max_f32_e32 %0, %1, %2" : "=v"(r) : "v"(a), "v"(b)); return r; }
__device__ __forceinline__ float fadd_s(float a, float b) { float r; asm("v_add_f32_e32 %0, %1, %2" : "=v"(r) : "v"(a), "v"(b)); return r; }
__device__ __forceinline__ float fsub_s(float a, float b) { float r; asm("v_sub_f32_e32 %0, %1, %2" : "=v"(r) : "v"(a), "v"(b)); return r; }
typedef float f32x2_t __attribute__((ext_vector_type(2))); typedef __bf16 bf16x2_t __attribute__((ext_vector_type(2)));
__device__ __forceinline__ unsigned cvtpk_s(float lo, float hi) { f32x2_t v = {lo, hi}; bf16x2_t b = __builtin_convertvector(v, bf16x2_t); return __builtin_bit_cast(unsigned, b); }
#define WAIT_BAR(N) asm volatile("s_waitcnt vmcnt(" #N ") lgkmcnt(0)\n\ts_barrier" ::: "memory")
__device__ __forceinline__ void qkt(f32x16& p0, f32x16& p1, const char* Kslot, const bf16x8* qr, const f32x16& negm, int r32, int hi) {
    const char* kb = Kslot + hi * 1024 + r32 * 16;
#pragma unroll
    for (int d0 = 0; d0 < 2; ++d0) {
        const bf16x8 b0 = *reinterpret_cast<const bf16x8*>(kb + d0 * 2048);
        const bf16x8 b1 = *reinterpret_cast<const bf16x8*>(kb + d0 * 2048 + 512);
        if (d0 == 0) { p0 = __builtin_amdgcn_mfma_f32_32x32x16_bf16(b0, qr[0], negm, 0, 0, 0); p1 = __builtin_amdgcn_mfma_f32_32x32x16_bf16(b1, qr[0], negm, 0, 0, 0); }
        else { p0 = __builtin_amdgcn_mfma_f32_32x32x16_bf16(b0, qr[d0], p0, 0, 0, 0); p1 = __builtin_amdgcn_mfma_f32_32x32x16_bf16(b1, qr[d0], p1, 0, 0, 0); } }
}
typedef __attribute__((address_space(3))) const char* lds_cptr;
typedef short v4i16_t __attribute__((ext_vector_type(4)));
__device__ __forceinline__ void kload8(bf16x8* kf, lds_cptr kp) {
    kf[0] = *(const __attribute__((address_space(3))) bf16x8*)(kp);        kf[1] = *(const __attribute__((address_space(3))) bf16x8*)(kp + 512);
    kf[2] = *(const __attribute__((address_space(3))) bf16x8*)(kp + 2048); kf[3] = *(const __attribute__((address_space(3))) bf16x8*)(kp + 2560);
}
__device__ __forceinline__ void kload2(bf16x8* kf, lds_cptr kp, int j) { kf[2 * j] = *(const __attribute__((address_space(3))) bf16x8*)(kp + j * 2048); kf[2 * j + 1] = *(const __attribute__((address_space(3))) bf16x8*)(kp + j * 2048 + 512); }
__device__ __forceinline__ s16x4 vtr(lds_cptr p) { return __builtin_bit_cast(s16x4, __builtin_amdgcn_ds_read_tr16_b64_v4i16((__attribute__((address_space(3))) v4i16_t*)p)); }
__device__ __forceinline__ float rowmax(const f32x16& p0, const f32x16& p1) {
    float a = max3f(p0[0], p0[1], p1[0]), b = max3f(p0[2], p0[3], p1[1]); a = max3f(a, p1[2], p1[3]);
#pragma unroll
    for (int r = 4; r < 16; r += 4) { a = max3f(a, p0[r], p0[r + 1]); b = max3f(b, p0[r + 2], p0[r + 3]); a = max3f(a, p1[r], p1[r + 1]); b = max3f(b, p1[r + 2], p1[r + 3]); }
    const float m = max2f(a, b);
    auto rr = __builtin_amdgcn_permlane32_swap(__float_as_uint(m), __float_as_uint(m), false, false);
    return max2f(__uint_as_float(rr[0]), __uint_as_float(rr[1]));
}
__device__ __forceinline__ void pv(f32x16* o, int vb, bf16x8 pa0, bf16x8 pa1, bf16x8 pa2, bf16x8 pa3) {
#pragma unroll
    for (int d0 = 0; d0 < 2; ++d0) { s16x4 lo[4], hi[4];
#pragma unroll
        for (int ks = 0; ks < 4; ++ks) {
            asm volatile("ds_read_b64_tr_b16 %0,%1 offset:%c2" : "=&v"(lo[ks]) : "v"(vb), "i"(d0 * 4096 + ks * 1024) : "memory");
            asm volatile("ds_read_b64_tr_b16 %0,%1 offset:%c2" : "=&v"(hi[ks]) : "v"(vb), "i"(d0 * 4096 + ks * 1024 + 512) : "memory"); }
        asm volatile("s_waitcnt lgkmcnt(0)" ::: "memory"); SBAR();
#define PK(k) (bf16x8){lo[k][0], lo[k][1], lo[k][2], lo[k][3], hi[k][0], hi[k][1], hi[k][2], hi[k][3]}
        o[d0] = __builtin_amdgcn_mfma_f32_32x32x16_bf16(pa0, PK(0), o[d0], 0, 0, 0);
        o[d0] = __builtin_amdgcn_mfma_f32_32x32x16_bf16(pa1, PK(1), o[d0], 0, 0, 0);
        o[d0] = __builtin_amdgcn_mfma_f32_32x32x16_bf16(pa2, PK(2), o[d0], 0, 0, 0);
        o[d0] = __builtin_amdgcn_mfma_f32_32x32x16_bf16(pa3, PK(3), o[d0], 0, 0, 0);
#undef PK
    }
}
struct AttnParams { const bf16* Q; const bf16* K; const bf16* V; const bf16* zpage; bf16_t* Y; const float* gnorm; float lam, osc; };
template <int THRL, int comp> __device__ __forceinline__ void attn_unit(int b, int h, int qb, const AttnParams& P, char* shm) {
    const bf16* Q = P.Q; const bf16* __restrict__ K = P.K; const bf16* __restrict__ V = P.V;
    int tid_ = threadIdx.x; asm volatile("" : "+v"(tid_));
    const int tid = tid_, lane = tid & 63, r32 = lane & 31, hi = lane >> 5; const int wid = __builtin_amdgcn_readfirstlane(tid >> 6);
    const long rowbase = (long)b * SEQ; const int q0 = qb * QB;
    const bf16* Qw = Q + (rowbase + q0 + wid * QBLK) * PITCH + h * D;
    const bf16* Kh = K + rowbase * PITCH + h * D, *Vh = V + rowbase * PITCH + h * D;
    const unsigned lds0 = (unsigned)(uintptr_t)shm;
    float* wsf = (float*)(shm + LDS_WS) + wid * 64;
    const bf16* ksrc = Kh + (long)(32 * (wid & 1) + (lane & 31)) * PITCH + comp * 32 + (wid >> 1) * 8;
    const bf16* vsrc = Vh + (long)(16 * (wid & 3) + (lane >> 2)) * PITCH + (wid >> 2) * 32 + (lane & 3) * 8;
    const unsigned kdst = lds0 + LDS_K + (wid >> 1) * 1024 + (wid & 1) * 512, vdst = lds0 + LDS_V + wid * 1024;
#define DMA_K(t, slot) do { if (lane < 32) glds16(ksrc + (long)(t) * KVBLK * PITCH, (unsigned)__builtin_amdgcn_readfirstlane(kdst + (slot))); } while (0)
#define DMA_V(t, slot) glds16(vsrc + (long)(t) * KVBLK * PITCH, (unsigned)__builtin_amdgcn_readfirstlane(vdst + (slot)))
    const int vb0 = (int)(lds0 + LDS_V) + ((lane >> 4) & 1) * 32 + (lane & 3) * 8 + (4 * hi + ((lane & 15) >> 2)) * 64;
    const char* Kbase = shm + LDS_K; bf16x8 kf[4];
    const lds_cptr shm3 = (lds_cptr)shm; const lds_cptr kp0 = shm3 + LDS_K + hi * 1024 + r32 * 16; const lds_cptr vp0 = shm3 + LDS_V + ((lane >> 4) & 1) * 32 + (lane & 3) * 8 + (4 * hi + ((lane & 15) >> 2)) * 64;
    const int NT = (q0 + QB) / KVBLK;
    if (wid >= 4) __builtin_amdgcn_s_setprio(1);
    DMA_K(0, 0); DMA_V(0, 0); DMA_K(1, SLOTB);
    bf16x8 qr[2];
#pragma unroll
    for (int d0 = 0; d0 < 2; ++d0) qr[d0] = *reinterpret_cast<const bf16x8*>(&Qw[(long)r32 * PITCH + comp * 32 + d0 * 16 + hi * 8]);
    float mhat = 0.f, l_reg = 0.f; f32x16 o[2]; o[0] = f32x16{}; o[1] = f32x16{}; f32x16 negm = f32x16{}; asm volatile("" : "+v"(negm));
    const int qrel = wid * QBLK + r32;
#define CMASK(P0, P1, t) do { int jb_ = (t) - (NT - 4); if (jb_ >= 0) cmask(P0, P1, jb_, qrel, hi); } while (0)
    bool resc = false;
#define START(P0, P1) do { const float rm = rowmax(P0, P1); resc = false; \
    { const float dl = rm; mhat = fadd_s(mhat, dl); \
      _Pragma("unroll") for (int r = 0; r < 16; ++r) { P0[r] = fsub_s(P0[r], dl); P1[r] = fsub_s(P1[r], dl); } \
      _Pragma("unroll") for (int r = 0; r < 16; ++r) negm[r] = -mhat; asm volatile("" : "+v"(negm)); } \
    _Pragma("unroll") for (int r = 0; r < 16; ++r) P0[r] = __builtin_amdgcn_exp2f(P0[r]); } while (0)
#define RESC() do { if (resc) { asm volatile("s_waitcnt lgkmcnt(0)" ::: "memory"); \
      _Pragma("unroll") for (int d_ = 0; d_ < 2; ++d_) _Pragma("unroll") for (int r = 0; r < 16; ++r) o[d_][r] *= wsf[crow(r, hi)]; } } while (0)
    f32x16 pA0, pA1, pB0, pB1;
    int sl_prev = 0, sl_cur = 0, sl_next = SLOTB;
#define ROT() do { sl_prev = sl_cur; sl_cur = sl_next; sl_next = (sl_next == (NSLOT - 1) * SLOTB) ? 0 : sl_next + SLOTB; } while (0)
    DMA_K(2, 2 * SLOTB);
    WAIT_BAR(3);
    qkt(pA0, pA1, Kbase, qr, negm, r32, hi); asm volatile("s_nop 15\n\ts_nop 7" : "+v"(pA0), "+v"(pA1)); CMASK(pA0, pA1, 0);
    START(pA0, pA1);
    _Pragma("unroll") for (int r = 0; r < 16; ++r) pA1[r] = __builtin_amdgcn_exp2f(pA1[r]);
    WAIT_BAR(0);
    DMA_K(3, 0); DMA_V(1, SLOTB);
    ROT();
    kload8(kf, kp0 + sl_cur);
    WAIT_BAR(2);
    s16x4 vlo[8], vhi[8]; u32x4 pw0, pw1, pw2, pw3;
#define PKW(P, B) cvtpk_s(P[B], P[B + 1])
#define PAF(k) __builtin_bit_cast(bf16x8, pw##k)
#define VFR(i) (bf16x8){vlo[i][0], vlo[i][1], vlo[i][2], vlo[i][3], vhi[i][0], vhi[i][1], vhi[i][2], vhi[i][3]}
#define PIN(x) asm volatile("" : "+v"(x))
#define MX3(a, b, c) __builtin_fmaxf(__builtin_fmaxf((a), (b)), (c))
#define GAPA(MF, A0, A1, A2, A3, W0, W1, PW) do { MF; sacc += A0; sacc += A1; sacc += A2; sacc += A3; PIN(sacc); W0; W1; PIN(PW); SBAR(); } while (0)
#define EX(v) __builtin_amdgcn_exp2f(v)
#define GAPB(MF, X, B) do { MF; X[B] = EX(X[B]); X[B + 1] = EX(X[B + 1]); X[B + 2] = EX(X[B + 2]); X[B + 3] = EX(X[B + 3]); PIN(X); SBAR(); } while (0)
#define VRD(i) do { vlo[i] = vtr(vp_ + (((i) >> 2) * 4096 + ((i) & 3) * 1024)); vhi[i] = vtr(vp_ + (((i) >> 2) * 4096 + ((i) & 3) * 1024 + 512)); } while (0)
#define KRD(G, j) do { if (G) { kload2(kf, kp0 + sl_next, j); SBAR(); } } while (0)
#define STEP(C0, C1, P0, P1, t, GK, GV, GL) do { SBAR(); \
    const lds_cptr vp_ = vp0 + sl_prev; \
    VRD(0); SBAR(); float sacc = (P0[0] + P0[1]); \
    GAPA(C0 = __builtin_amdgcn_mfma_f32_32x32x16_bf16(kf[0], qr[0], negm, 0, 0, 0), P0[2], P0[3], P0[4], P0[5],     pw0[0] = PKW(P0, 0), pw0[1] = PKW(P0, 2), pw0); \
    VRD(4); SBAR(); GAPA(C1 = __builtin_amdgcn_mfma_f32_32x32x16_bf16(kf[1], qr[0], negm, 0, 0, 0), P0[6], P0[7], P0[8], P0[9],     pw0[2] = PKW(P0, 4), pw0[3] = PKW(P0, 6), pw0); \
    VRD(1); SBAR(); GAPA(C0 = __builtin_amdgcn_mfma_f32_32x32x16_bf16(kf[2], qr[1], C0, 0, 0, 0),   P0[10], P0[11], P0[12], P0[13], pw1[0] = PKW(P0, 8), pw1[1] = PKW(P0, 10), pw1); \
    VRD(5); SBAR(); GAPA(C1 = __builtin_amdgcn_mfma_f32_32x32x16_bf16(kf[3], qr[1], C1, 0, 0, 0),   P0[14], P0[15], P1[0], P1[1],   pw1[2] = PKW(P0, 12), pw1[3] = PKW(P0, 14), pw1); \
    VRD(2); SBAR(); GAPA(,   P1[2], P1[3], P1[4], P1[5],     pw2[0] = PKW(P1, 0), pw2[1] = PKW(P1, 2), pw2); \
    VRD(6); SBAR(); GAPA(,   P1[6], P1[7], P1[8], P1[9],     pw2[2] = PKW(P1, 4), pw2[3] = PKW(P1, 6), pw2); \
    VRD(3); SBAR(); GAPA(,   P1[10], P1[11], P1[12], P1[13], pw3[0] = PKW(P1, 8), pw3[1] = PKW(P1, 10), pw3); \
    VRD(7); SBAR(); GAPA(,   P1[14], P1[15], 0.f, 0.f,       pw3[2] = PKW(P1, 12), pw3[3] = PKW(P1, 14), pw3); \
    l_reg += sacc; \
    if (GK) { DMA_K((t) + 3, sl_cur); } if (GV) { DMA_V((t) + 1, sl_next); } \
    CMASK(C0, C1, t); \
    { float a = MX3(C0[0], C0[1], C1[0]), b = MX3(C0[2], C0[3], C1[1]); a = MX3(a, C1[2], C1[3]); \
      _Pragma("unroll") for (int r = 4; r < 16; r += 4) { a = MX3(a, C0[r], C0[r + 1]); b = MX3(b, C0[r + 2], C0[r + 3]); a = MX3(a, C1[r], C1[r + 1]); b = MX3(b, C1[r + 2], C1[r + 3]); } \
      float rm = __builtin_fmaxf(a, b); { auto rr = __builtin_amdgcn_permlane32_swap(__float_as_uint(rm), __float_as_uint(rm), false, false); rm = __builtin_fmaxf(__uint_as_float(rr[0]), __uint_as_float(rr[1])); } \
      resc = false; \
      if (__builtin_expect(__any(rm > (float)THRL), 0)) { const float dl = __builtin_fmaxf(rm, 0.f); mhat += dl; \
        _Pragma("unroll") for (int r = 0; r < 16; ++r) { C0[r] -= dl; C1[r] -= dl; } \
        _Pragma("unroll") for (int r = 0; r < 16; ++r) negm[r] = -mhat; asm volatile("" : "+v"(negm)); \
        const float f = __builtin_amdgcn_exp2f(-dl); l_reg *= f; if (hi == 0) wsf[r32] = f; resc = true; } } \
    SBAR(); \
    GAPB(o[0] = __builtin_amdgcn_mfma_f32_32x32x16_bf16(PAF(0), VFR(0), o[0], 0, 0, 0), C0, 0); \
    GAPB(o[1] = __builtin_amdgcn_mfma_f32_32x32x16_bf16(PAF(0), VFR(4), o[1], 0, 0, 0), C0, 4); \
    KRD(GL, 0); GAPB(o[0] = __builtin_amdgcn_mfma_f32_32x32x16_bf16(PAF(1), VFR(1), o[0], 0, 0, 0), C0, 8); \
    KRD(GL, 1); GAPB(o[1] = __builtin_amdgcn_mfma_f32_32x32x16_bf16(PAF(1), VFR(5), o[1], 0, 0, 0), C0, 12); \
    GAPB(o[0] = __builtin_amdgcn_mfma_f32_32x32x16_bf16(PAF(2), VFR(2), o[0], 0, 0, 0), C1, 0); \
    GAPB(o[1] = __builtin_amdgcn_mfma_f32_32x32x16_bf16(PAF(2), VFR(6), o[1], 0, 0, 0), C1, 4); \
    GAPB(o[0] = __builtin_amdgcn_mfma_f32_32x32x16_bf16(PAF(3), VFR(3), o[0], 0, 0, 0), C1, 8); \
    GAPB(o[1] = __builtin_amdgcn_mfma_f32_32x32x16_bf16(PAF(3), VFR(7), o[1], 0, 0, 0), C1, 12); \
    } while (0)
    int t = 1;
#undef CMASK
#define CMASK(P0, P1, t) do {} while (0)
    for (; t + 5 < NT; t += 2) {
        STEP(pB0, pB1, pA0, pA1, t, true, true, true);     WAIT_BAR(2); RESC(); ROT();
        STEP(pA0, pA1, pB0, pB1, t + 1, true, true, true); WAIT_BAR(2); RESC(); ROT();
    }
#undef CMASK
#define CMASK(P0, P1, t) do { int jb_ = (t) - (NT - 4); if (jb_ >= 0) cmask(P0, P1, jb_, qrel, hi); } while (0)
#define ENDW(tt) do { if ((tt) + 3 < NT) { WAIT_BAR(2); } else if ((tt) + 2 < NT) { WAIT_BAR(1); } else { WAIT_BAR(0); } } while (0)
    for (; t + 1 < NT; t += 2) {
        STEP(pB0, pB1, pA0, pA1, t, (t + 3 < NT), (t + 1 < NT), (t + 1 < NT));         ENDW(t);     RESC(); ROT();
        STEP(pA0, pA1, pB0, pB1, t + 1, (t + 4 < NT), (t + 2 < NT), (t + 2 < NT));     ENDW(t + 1); RESC(); ROT();
    }
    STEP(pB0, pB1, pA0, pA1, NT - 1, false, false, false); RESC();
    { float sacc = pB0[0] + pB0[1]; _Pragma("unroll") for (int r = 2; r < 16; ++r) sacc += pB0[r]; _Pragma("unroll") for (int r = 0; r < 16; ++r) sacc += pB1[r]; l_reg += sacc;
      pw0 = (u32x4){PKW(pB0, 0), PKW(pB0, 2), PKW(pB0, 4), PKW(pB0, 6)}; pw1 = (u32x4){PKW(pB0, 8), PKW(pB0, 10), PKW(pB0, 12), PKW(pB0, 14)}; pw2 = (u32x4){PKW(pB1, 0), PKW(pB1, 2), PKW(pB1, 4), PKW(pB1, 6)}; pw3 = (u32x4){PKW(pB1, 8), PKW(pB1, 10), PKW(pB1, 12), PKW(pB1, 14)};
      SBAR(); pv(o, vb0 + sl_cur, PAF(0), PAF(1), PAF(2), PAF(3)); }
#undef PKW
#undef PAF
#undef VFR
#undef PIN
#undef MX3
#undef GAPA
#undef GAPB
#undef EX
#undef VRD
#undef KRD
#undef STEP
#undef ENDW
    { auto rr = __builtin_amdgcn_permlane32_swap(__float_as_uint(l_reg), __float_as_uint(l_reg), false, false); l_reg = __uint_as_float(rr[0]) + __uint_as_float(rr[1]); }
    if (hi == 0) wsf[32 + r32] = l_reg; asm volatile("s_waitcnt lgkmcnt(0)" ::: "memory");
    float rli[16];
#pragma unroll
    for (int r = 0; r < 16; ++r) rli[r] = __builtin_amdgcn_rcpf(wsf[32 + crow(r, hi)]);
    float* stg = (float*)(shm + LDS_OST) + wid * 2048;
    if (comp == 0) {
#pragma unroll
        for (int r = 0; r < 16; ++r) { const int orow = crow(r, hi);
#pragma unroll
            for (int d0 = 0; d0 < 2; ++d0) stg[orow * 64 + d0 * 32 + r32] = o[d0][r] * rli[r]; }
    } else {
        const float lam = P.lam;
#pragma unroll
        for (int r = 0; r < 16; ++r) { const int orow = crow(r, hi);
#pragma unroll
            for (int d0 = 0; d0 < 2; ++d0) { const int ix = orow * 64 + d0 * 32 + r32; stg[ix] = stg[ix] - lam * (o[d0][r] * rli[r]); } }
        asm volatile("s_waitcnt lgkmcnt(0)" ::: "memory");
        unsigned char* Yw = (unsigned char*)P.Y + (rowbase + q0 + wid * QBLK) * DM + h * D;
        const int ch = lane & 7;
        const f32x4 g0 = *(const f32x4*)(P.gnorm + ch * 8), g1 = *(const f32x4*)(P.gnorm + ch * 8 + 4);
#pragma unroll
        for (int i = 0; i < 4; ++i) { const int row = i * 8 + (lane >> 3);
            const f32x4 a = *(const f32x4*)(stg + row * 64 + ch * 8), c = *(const f32x4*)(stg + row * 64 + ch * 8 + 4);
            float ss = (a[0] * a[0] + a[1] * a[1]) + (a[2] * a[2] + a[3] * a[3]) + (c[0] * c[0] + c[1] * c[1]) + (c[2] * c[2] + c[3] * c[3]);
            ss += __shfl_xor(ss, 1); ss += __shfl_xor(ss, 2); ss += __shfl_xor(ss, 4);
            const float rs = __builtin_amdgcn_rsqf(ss * (1.f / 64.f) + LN_EPS) * P.osc;
            const float rq = rs * Y8S; u32x2 w; w.x = pk4_fp8(a[0] * rq * g0[0], a[1] * rq * g0[1], a[2] * rq * g0[2], a[3] * rq * g0[3]); w.y = pk4_fp8(c[0] * rq * g1[0], c[1] * rq * g1[1], c[2] * rq * g1[2], c[3] * rq * g1[3]);
            *(u32x2*)(Yw + (long)row * DM + ch * 8) = w; }
    }
    __builtin_amdgcn_s_setprio(0);
    asm volatile("s_waitcnt lgkmcnt(0)\n\ts_barrier" ::: "memory");
#undef DMA_K
#undef DMA_V
#undef CMASK
#undef START
#undef RESC
#undef ROT
}
#undef SBAR
#undef WAIT_BAR
}

struct Frame {
    LAS unsigned char* lds; volatile LAS unsigned* MISC; gu32* ctl;
    int tid, lane, wave, vcu, G;
};
struct Args {
    const float* in[29]; float* out; unsigned char* ws; int ph_lo, ph_hi;
};
enum { I_X = 0, I_C, I_POS, I_WADA, I_BADA, I_WIN, I_WOUT, I_MBI, I_MBF, I_MG, I_CONVW, I_CONVB, I_LQ1, I_LK1, I_LQ2, I_LK2, I_DG, I_WA2, I_BA, I_GG, I_LN1G, I_LN1B, I_LN2G, I_LN2B,
       I_RW, I_RB, I_EWG, I_EWU, I_EWD };

__device__ __forceinline__ void tr_item(const float* W, int ldw, int K, bf16_t* WT, int drow0, int scol, int k0, LAS float* scr, int lane) {
#pragma unroll 8
    for (int i = 0; i < 32; ++i) { const int kk = 2 * i + (lane >> 5); scr[kk * 33 + (lane & 31)] = (scol >= 0) ? W[(size_t)(k0 + kk) * ldw + scol] : 0.f; }
    LDS_WAIT(); asm volatile("" ::: "memory");
    const int c = lane & 7;
#pragma unroll
    for (int j = 0; j < 4; ++j) { const int n = (lane >> 3) + 8 * j; const LAS float* s = scr + (8 * c) * 33 + n;
        u32x4 o; o.x = pk2(s[0 * 33], s[1 * 33]); o.y = pk2(s[2 * 33], s[3 * 33]); o.z = pk2(s[4 * 33], s[5 * 33]); o.w = pk2(s[6 * 33], s[7 * 33]);
        *(GAS u32x4*)(WT + (size_t)(drow0 + n) * K + k0 + 8 * c) = o; }
    LDS_WAIT(); asm volatile("" ::: "memory");
}
__device__ __forceinline__ void tr_item4(const float* W, int ldw, int K, bf16_t* WT, int drow0, int scol0, int k0, LAS float* scr, int lane, float wsc = 1.f) {
    const int kq = lane >> 3, nq = (lane & 7) * 4;
    f32x4 v[8];
#pragma unroll
    for (int i = 0; i < 8; ++i) v[i] = *(const f32x4*)(W + (size_t)(k0 + i * 8 + kq) * ldw + scol0 + nq);
#pragma unroll
    for (int i = 0; i < 8; ++i) { LAS float* d = scr + (i * 8 + kq) * 33 + nq; d[0] = v[i][0] * wsc; d[1] = v[i][1] * wsc; d[2] = v[i][2] * wsc; d[3] = v[i][3] * wsc; }
    LDS_WAIT(); asm volatile("" ::: "memory");
    const int c = lane & 7;
#pragma unroll
    for (int j = 0; j < 4; ++j) { const int n = (lane >> 3) + 8 * j; const LAS float* s = scr + (8 * c) * 33 + n;
        u32x4 o; o.x = pk2(s[0 * 33], s[1 * 33]); o.y = pk2(s[2 * 33], s[3 * 33]); o.z = pk2(s[4 * 33], s[5 * 33]); o.w = pk2(s[6 * 33], s[7 * 33]);
        *(GAS u32x4*)(WT + (size_t)(drow0 + n) * K + k0 + 8 * c) = o; }
    LDS_WAIT(); asm volatile("" ::: "memory");
}
struct TrD { const float* src; bf16_t* dst; unsigned char* dst8; int ldw, K, drow0, k0; float wsc; };
__device__ __forceinline__ void tr_load4(const TrD& d, f32x4 (&v)[8], int lane) {
    const int kq = lane >> 3, nq = (lane & 7) * 4;
#pragma unroll
    for (int i = 0; i < 8; ++i) v[i] = *(const f32x4*)(d.src + (size_t)(i * 8 + kq) * d.ldw + nq);
}
__device__ __forceinline__ void tr_finish4(const TrD& d, const f32x4 (&v)[8], LAS float* scr, int lane) {
    const int kq = lane >> 3, nq = (lane & 7) * 4;
#pragma unroll
    for (int i = 0; i < 8; ++i) { LAS float* p = scr + (i * 8 + kq) * 33 + nq; p[0] = v[i][0] * d.wsc; p[1] = v[i][1] * d.wsc; p[2] = v[i][2] * d.wsc; p[3] = v[i][3] * d.wsc; }
    LDS_WAIT(); asm volatile("" ::: "memory");
    const int c = lane & 7;
#pragma unroll
    for (int j = 0; j < 4; ++j) { const int n = (lane >> 3) + 8 * j; const LAS float* s = scr + (8 * c) * 33 + n;
        u32x4 o; o.x = pk2(s[0 * 33], s[1 * 33]); o.y = pk2(s[2 * 33], s[3 * 33]); o.z = pk2(s[4 * 33], s[5 * 33]); o.w = pk2(s[6 * 33], s[7 * 33]);
        *(GAS u32x4*)(d.dst + (size_t)(d.drow0 + n) * d.K + d.k0 + 8 * c) = o; }
    LDS_WAIT(); asm volatile("" ::: "memory");
}
__device__ __forceinline__ void tr_finish8(const TrD& d, const f32x4 (&v)[8], LAS float* scr, int lane) {
    const int kq = lane >> 3, nq = (lane & 7) * 4;
#pragma unroll
    for (int i = 0; i < 8; ++i) { LAS float* p = scr + (i * 8 + kq) * 33 + nq; p[0] = v[i][0] * d.wsc; p[1] = v[i][1] * d.wsc; p[2] = v[i][2] * d.wsc; p[3] = v[i][3] * d.wsc; }
    LDS_WAIT(); asm volatile("" ::: "memory");
    const int c = lane & 7; unsigned char* dst8 = (unsigned char*)d.dst;
#pragma unroll
    for (int j = 0; j < 4; ++j) { const int n = (lane >> 3) + 8 * j; const LAS float* s = scr + (8 * c) * 33 + n;
        u32x2 o; o.x = pk4_fp8(s[0 * 33], s[1 * 33], s[2 * 33], s[3 * 33]); o.y = pk4_fp8(s[4 * 33], s[5 * 33], s[6 * 33], s[7 * 33]);
        *(GAS u32x2*)(dst8 + (size_t)(d.drow0 + n) * d.K + d.k0 + 8 * c) = o; }
    LDS_WAIT(); asm volatile("" ::: "memory");
}
template <int NTL>
__device__ __forceinline__ void rows16_mm(f32x4 (&acc)[NTL], const bf16_t* A, const LAS bf16_t* Bt, int pitch, int lane) {
    const int lr = lane & 15, lq = lane >> 4;
    const bf16_t* ap = A + (size_t)lr * 1024 + lq * 8;
#pragma unroll 8
    for (int ks = 0; ks < 32; ++ks) {
        const bf16x8 a = *(const bf16x8*)(ap + ks * 32);
#pragma unroll
        for (int t = 0; t < NTL; ++t) { const bf16x8 b = *(const LAS bf16x8*)(Bt + (t * 16 + lr) * pitch + ks * 32 + lq * 8); acc[t] = __builtin_amdgcn_mfma_f32_16x16x32_bf16(a, b, acc[t], 0, 0, 0); }
    }
}
constexpr int TBP = 1056;
__device__ __forceinline__ void tail16(const bf16_t* Urow0, const LAS bf16_t* Wt, float* tail_row0, int lane) {
    f32x4 acc[2] = {(f32x4){0.f, 0.f, 0.f, 0.f}, (f32x4){0.f, 0.f, 0.f, 0.f}};
    rows16_mm<2>(acc, Urow0, Wt, TBP, lane);
    const int lr = lane & 15, lq = lane >> 4;
#pragma unroll
    for (int t = 0; t < 2; ++t)
#pragma unroll
        for (int r = 0; r < 4; ++r) tail_row0[(size_t)(lq * 4 + r) * 32 + t * 16 + lr] = acc[t][r];
}
__device__ __forceinline__ void load_tail_w(LAS bf16_t* Wt, const bf16_t* Wtail  , int tid) {
    for (int p = tid; p < 32 * 128; p += 512) { const int n = p >> 7, c = p & 127; *(LAS u32x4*)(Wt + n * TBP + c * 8) = *(const u32x4*)(Wtail + (size_t)n * 1024 + c * 8); }
}
constexpr int NSP = 1032;
constexpr int NMM_P_OFF = 32 * NSP * 2, NMM_LG_OFF = NMM_P_OFF + 8 * 1024 * 4;
struct NarrowT { bf16x8 bw[4][2]; };
__device__ __forceinline__ void nmm_load_tail(NarrowT& T, const bf16_t* Wtail  , int wid, int lane) {
    const int lr = lane & 15, lq = lane >> 4;
#pragma unroll
    for (int ks = 0; ks < 4; ++ks)
#pragma unroll
        for (int t = 0; t < 2; ++t) T.bw[ks][t] = *(const bf16x8*)(Wtail + (size_t)(t * 16 + lr) * 1024 + wid * 128 + ks * 32 + lq * 8);
}
__device__ __forceinline__ void nmm_load_router(NarrowT& T, const float* rw  , int wid, int lane) {
    const int lr = lane & 15, lq = lane >> 4;
#pragma unroll
    for (int ks = 0; ks < 4; ++ks) { u32x4 hi, lo;
#pragma unroll
        for (int i = 0; i < 4; ++i) { const int k = wid * 128 + ks * 32 + lq * 8 + 2 * i; const float w0 = rw[(size_t)k * 16 + lr], w1 = rw[(size_t)(k + 1) * 16 + lr];
            const unsigned h0 = f2bf(w0), h1 = f2bf(w1); hi[i] = h0 | (h1 << 16); lo[i] = f2bf(w0 - bf2f(h0)) | (f2bf(w1 - bf2f(h1)) << 16); }
        T.bw[ks][0] = __builtin_bit_cast(bf16x8, hi); T.bw[ks][1] = __builtin_bit_cast(bf16x8, lo); }
}
__device__ __forceinline__ void nmm_partials(const NarrowT& T, const LAS bf16_t* S, LAS float* Pb, int wid, int lane) {
    asm volatile("s_waitcnt lgkmcnt(0)\n\ts_barrier" ::: "memory");
    const int lr = lane & 15, lq = lane >> 4;
    f32x4 acc[2][2];
#pragma unroll
    for (int m = 0; m < 2; ++m)
#pragma unroll
        for (int t = 0; t < 2; ++t) acc[m][t] = (f32x4){0.f, 0.f, 0.f, 0.f};
#pragma unroll
    for (int m = 0; m < 2; ++m)
#pragma unroll
        for (int ks = 0; ks < 4; ++ks) { const bf16x8 a = *(const LAS bf16x8*)(S + (16 * m + lr) * NSP + wid * 128 + ks * 32 + lq * 8);
#pragma unroll
            for (int t = 0; t < 2; ++t) acc[m][t] = __builtin_amdgcn_mfma_f32_16x16x32_bf16(a, T.bw[ks][t], acc[m][t], 0, 0, 0); }
#pragma unroll
    for (int m = 0; m < 2; ++m)
#pragma unroll
        for (int t = 0; t < 2; ++t)
#pragma unroll
            for (int r = 0; r < 4; ++r) Pb[wid * 1024 + (16 * m + 4 * lq + r) * 32 + t * 16 + lr] = acc[m][t][r];
    asm volatile("s_waitcnt lgkmcnt(0)\n\ts_barrier" ::: "memory");
}
__device__ __forceinline__ void nmm_step_tail(const NarrowT& T, const LAS bf16_t* S, LAS float* Pb, float* tail_wg  , int i0, int tid, int wid, int lane) {
    nmm_partials(T, S, Pb, wid, lane);
#pragma unroll
    for (int q = 0; q < 2; ++q) { const int o = tid + 512 * q, sr = o >> 5, col = o & 31; float s = 0.f;
#pragma unroll
        for (int w = 0; w < 8; ++w) s += Pb[w * 1024 + o];
        tail_wg[(size_t)((sr >> 2) * 16 + i0 + (sr & 3)) * 32 + col] = s; }
}
__device__ __forceinline__ void nmm_step_router(const NarrowT& T, const LAS bf16_t* S, LAS float* Pb, LAS float* lgs  , int i0, int tid, int wid, int lane) {
    nmm_partials(T, S, Pb, wid, lane);
    { const int sr = tid >> 4, e = tid & 15; float s = 0.f;
#pragma unroll
      for (int w = 0; w < 8; ++w) s += Pb[w * 1024 + sr * 32 + e] + Pb[w * 1024 + sr * 32 + 16 + e];
      lgs[(sr >> 2) * 256 + (i0 + (sr & 3)) * 16 + e] = s; }
}
__device__ __forceinline__ int win_src_col(int n) {
    if (n < 1024) return n;
    if (n < 3584) return n + 8;
    const int i = n - 3584;
    if (i < 16) return 3592 + i;
    if (i < 20) return 1024 + (i - 16);
    if (i < 24) return 1028 + (i - 20);
    return -1;
}

namespace rec {
constexpr int PT = 72;
constexpr int TB = 64 * PT * 2;
constexpr int OFF_T0 = 0, OFF_T1 = TB, OFF_T2 = 2 * TB, OFF_T3 = 3 * TB, OFF_T4 = 4 * TB, OFF_T5 = 5 * TB;
constexpr int OFF_BM = 6 * TB;
constexpr int OFF_HM = OFF_BM + 16384;
constexpr int OFF_VEC = OFF_HM + 64 * 68 * 4;
constexpr int V_G = 0, V_M = 64, V_WI = 128, V_EM = 192, V_DI = 256, V_N = 320, V_BE = 384, V_SEG = 448, V_GA = 960;
static_assert(OFF_VEC + (960 + 1024) * 4 <= RING_BYTES, "rec LDS");

__device__ __forceinline__ void mm64(f32x4 (&acc)[2], const LAS bf16_t* A, const LAS bf16_t* Bt, int wid, int lane) {
    const int tm = wid >> 1, tn0 = (wid & 1) * 2, lr = lane & 15, lq = lane >> 4;
#pragma unroll
    for (int ks = 0; ks < 2; ++ks) {
        const bf16x8 a = *(const LAS bf16x8*)(A + (tm * 16 + lr) * PT + ks * 32 + lq * 8);
#pragma unroll
        for (int t = 0; t < 2; ++t) { const bf16x8 b = *(const LAS bf16x8*)(Bt + ((tn0 + t) * 16 + lr) * PT + ks * 32 + lq * 8);
            acc[t] = __builtin_amdgcn_mfma_f32_16x16x32_bf16(a, b, acc[t], 0, 0, 0); }
    }
}
__device__ __forceinline__ float scan_add(float v, int lane) {
#pragma unroll
    for (int o = 1; o < 64; o <<= 1) { const float t = __shfl_up(v, o); if (lane >= o) v += t; }
    return v;
}
__device__ __forceinline__ float scan_max(float v, int lane) {
#pragma unroll
    for (int o = 1; o < 64; o <<= 1) { const float t = __shfl_up(v, o); if (lane >= o) v = fmaxf(v, t); }
    return v;
}
__device__ __forceinline__ void st_tr8(LAS bf16_t* T, int l, int ch, u32x4 w) {
    T[(ch * 8 + 0) * PT + l] = (bf16_t)(w.x & 0xffffu); T[(ch * 8 + 1) * PT + l] = (bf16_t)(w.x >> 16);
    T[(ch * 8 + 2) * PT + l] = (bf16_t)(w.y & 0xffffu); T[(ch * 8 + 3) * PT + l] = (bf16_t)(w.y >> 16);
    T[(ch * 8 + 4) * PT + l] = (bf16_t)(w.z & 0xffffu); T[(ch * 8 + 5) * PT + l] = (bf16_t)(w.z >> 16);
    T[(ch * 8 + 6) * PT + l] = (bf16_t)(w.w & 0xffffu); T[(ch * 8 + 7) * PT + l] = (bf16_t)(w.w >> 16);
}
__device__ __forceinline__ void unpack8(u32x4 w, float (&f)[8]) {
    f[0] = bflo(w.x); f[1] = bfhi(w.x); f[2] = bflo(w.y); f[3] = bfhi(w.y); f[4] = bflo(w.z); f[5] = bfhi(w.z); f[6] = bflo(w.w); f[7] = bfhi(w.w);
}
template <int GATE  >
__device__ __forceinline__ void finalize(const LAS float* HM, const LAS float* rowscale, const float* gnorm, const bf16_t* gate, bf16_t* out, int tid) {
    const int j = tid >> 3, ch = tid & 7;
    const f32x4 a = *(const LAS f32x4*)(HM + j * 68 + ch * 8), c = *(const LAS f32x4*)(HM + j * 68 + ch * 8 + 4);
    const float rsc = rowscale ? rowscale[j] : 1.f;
    float v[8] = {a[0] * rsc, a[1] * rsc, a[2] * rsc, a[3] * rsc, c[0] * rsc, c[1] * rsc, c[2] * rsc, c[3] * rsc};
    float ss = 0.f;
#pragma unroll
    for (int i = 0; i < 8; ++i) ss += v[i] * v[i];
    ss += __shfl_xor(ss, 1); ss += __shfl_xor(ss, 2); ss += __shfl_xor(ss, 4);
    const float rs = __builtin_amdgcn_rsqf(ss * (1.f / 64.f) + LN_EPS);
    const u32x4 gw = *(const u32x4*)(gate + (size_t)j * PP + ch * 8);
    float gt[8]; unpack8(gw, gt);
    const f32x4 g0 = *(const f32x4*)(gnorm + ch * 8), g1 = *(const f32x4*)(gnorm + ch * 8 + 4);
    const float gn[8] = {g0[0], g0[1], g0[2], g0[3], g1[0], g1[1], g1[2], g1[3]};
    float y[8];
#pragma unroll
    for (int i = 0; i < 8; ++i) { const float sg = 1.f / (1.f + fexp(-gt[i])); const float gv = GATE ? gt[i] * sg : sg; y[i] = v[i] * rs * gn[i] * gv; }
    u32x4 w; w.x = pk2(y[0], y[1]); w.y = pk2(y[2], y[3]); w.z = pk2(y[4], y[5]); w.w = pk2(y[6], y[7]);
    *(u32x4*)(out + (size_t)j * DM + ch * 8) = w;
}

struct RecP {
    const bf16_t* proj; const float* tail; const bf16_t* csm; const bf16_t* csg; float* stm; float* stg; float* smN; float* smBC; float* smDM; float* smMS; float* smGBE; bf16_t* ycat;
    const float* mbi; const float* mbf; const float* mg; const float* wa2; const float* ba; const float* gg;
};

struct MLoc { u32x4 k, v; float mi, mf; };
struct MOut { u32x4 q, k, v, st, mo; float mi, mf, m, n; };
struct GLoc { u32x4 k, v; f32x4 ga; };
struct GOut { u32x4 q, k, v, st, gr; f32x4 ga; };
struct GW { float wv[16]; float bav; };

__device__ __forceinline__ void ld_mloc(MLoc& L, const RecP& P, int ci, int tid, int wid, int lane) {
    const int bh = ci >> 6, c = ci & 63, b = bh >> 2, h = bh & 3, row0 = b * SEQ + c * 64, l = tid >> 3, ch = tid & 7;
    const bf16_t* pr = P.proj + (size_t)(row0 + l) * PP + h * 64 + ch * 8;
    L.k = *(const u32x4*)(pr + C_MK); L.v = *(const u32x4*)(pr + C_MV);
    if (wid == 0) { const float* tp = P.tail + (size_t)(row0 + lane) * 32; L.mi = tp[T_MI + h]; L.mf = tp[T_MF + h]; } else { L.mi = 0.f; L.mf = 0.f; }
}
__device__ __forceinline__ void ld_mout(MOut& L, const RecP& P, int ci, int tid, int wid, int lane) {
    const int bh = ci >> 6, c = ci & 63, b = bh >> 2, h = bh & 3, row0 = b * SEQ + c * 64, l = tid >> 3, ch = tid & 7;
    const bf16_t* pr = P.proj + (size_t)(row0 + l) * PP + h * 64 + ch * 8;
    L.q = *(const u32x4*)(pr + C_MQ); L.k = *(const u32x4*)(pr + C_MK); L.v = *(const u32x4*)(pr + C_MV); L.mo = *(const u32x4*)(pr + C_MO);
    L.st = *(const u32x4*)(P.csm + (size_t)ci * 4096 + l * 64 + ch * 8);
    if (wid == 0) { const float* tp = P.tail + (size_t)(row0 + lane) * 32; L.mi = tp[T_MI + h]; L.mf = tp[T_MF + h]; L.m = P.smMS[ci]; L.n = P.smN[(size_t)ci * 64 + lane]; } else { L.mi = 0.f; L.mf = 0.f; L.m = 0.f; L.n = 0.f; }
}
__device__ __forceinline__ void ld_gloc(GLoc& L, const RecP& P, int ci, int tid) {
    const int bh = ci >> 6, c = ci & 63, b = bh >> 2, h = bh & 3, row0 = b * SEQ + c * 64, l = tid >> 3, ch = tid & 7;
    const bf16_t* pr = P.proj + (size_t)(row0 + l) * PP + h * 64 + ch * 8;
    L.k = *(const u32x4*)(pr + C_GK); L.v = *(const u32x4*)(pr + C_GV);
    L.ga = (tid < 256) ? *(const f32x4*)(P.tail + (size_t)(row0 + (tid >> 2)) * 32 + T_GA + (tid & 3) * 4) : (f32x4){0.f, 0.f, 0.f, 0.f};
}
__device__ __forceinline__ void ld_gout(GOut& L, const RecP& P, int ci, int tid) {
    const int bh = ci >> 6, c = ci & 63, b = bh >> 2, h = bh & 3, row0 = b * SEQ + c * 64, l = tid >> 3, ch = tid & 7;
    const bf16_t* pr = P.proj + (size_t)(row0 + l) * PP + h * 64 + ch * 8;
    L.q = *(const u32x4*)(pr + C_GQ); L.k = *(const u32x4*)(pr + C_GK); L.v = *(const u32x4*)(pr + C_GV); L.gr = *(const u32x4*)(pr + C_GR);
    L.st = *(const u32x4*)(P.csg + (size_t)ci * 4096 + l * 64 + ch * 8);
    L.ga = (tid < 256) ? *(const f32x4*)(P.tail + (size_t)(row0 + (tid >> 2)) * 32 + T_GA + (tid & 3) * 4) : (f32x4){0.f, 0.f, 0.f, 0.f};
}
__device__ __forceinline__ void ld_gw(GW& W, const RecP& P, int h, int tid) {
    const int dcol = tid & 63;
#pragma unroll
    for (int r = 0; r < 16; ++r) W.wv[r] = P.wa2[r * 256 + h * 64 + dcol];
    W.bav = P.ba[h * 64 + dcol];
}
template <int GATE  >
__device__ __forceinline__ void finalize2(const LAS float* HM, const LAS float* rowscale, const float* gnorm, u32x4 gw, bf16_t* out, int tid) {
    const int j = tid >> 3, ch = tid & 7;
    const f32x4 a = *(const LAS f32x4*)(HM + j * 68 + ch * 8), c = *(const LAS f32x4*)(HM + j * 68 + ch * 8 + 4);
    const float rsc = rowscale ? rowscale[j] : 1.f;
    float v[8] = {a[0] * rsc, a[1] * rsc, a[2] * rsc, a[3] * rsc, c[0] * rsc, c[1] * rsc, c[2] * rsc, c[3] * rsc};
    float ss = 0.f;
#pragma unroll
    for (int i = 0; i < 8; ++i) ss += v[i] * v[i];
    ss += __shfl_xor(ss, 1); ss += __shfl_xor(ss, 2); ss += __shfl_xor(ss, 4);
    const float rs = __builtin_amdgcn_rsqf(ss * (1.f / 64.f) + LN_EPS);
    float gt[8]; unpack8(gw, gt);
    const f32x4 g0 = *(const f32x4*)(gnorm + ch * 8), g1 = *(const f32x4*)(gnorm + ch * 8 + 4);
    const float gn[8] = {g0[0], g0[1], g0[2], g0[3], g1[0], g1[1], g1[2], g1[3]};
    float y[8];
#pragma unroll
    for (int i = 0; i < 8; ++i) { const float sg = 1.f / (1.f + fexp(-gt[i])); const float gv = GATE ? gt[i] * sg : sg; y[i] = v[i] * rs * gn[i] * gv; }
    u32x4 w; w.x = pk2(y[0], y[1]); w.y = pk2(y[2], y[3]); w.z = pk2(y[4], y[5]); w.w = pk2(y[6], y[7]);
    *(u32x4*)(out + (size_t)j * DM + ch * 8) = w;
}
__device__ __forceinline__ void mlstm_local(const MLoc& L, const RecP& P, LAS unsigned char* lds, int ci, int tid, int wid, int lane) {
    const int h = (ci >> 6) & 3;
    LAS bf16_t* KT = (LAS bf16_t*)(lds + OFF_T0); LAS bf16_t* VT = (LAS bf16_t*)(lds + OFF_T1); LAS float* vec = (LAS float*)(lds + OFF_VEC);
    const int l = tid >> 3, ch = tid & 7;
    if (wid == 0) {
        const float li = L.mi + P.mbi[h], lf = logsig(L.mf + P.mbf[h]);
        const float bc = scan_add(lf, lane), g = li - bc;
        const float gmax = wave_max(g), bend = __shfl(bc, 63);
        vec[V_G + lane] = fexp(g - gmax);
        if (lane == 0) { P.smBC[ci] = bend; P.smDM[ci] = bend + gmax; }
    }
    __syncthreads();
    { const float w = vec[V_G + l]; float kf[8]; unpack8(L.k, kf);
      u32x4 ks; ks.x = pk2(kf[0] * w, kf[1] * w); ks.y = pk2(kf[2] * w, kf[3] * w); ks.z = pk2(kf[4] * w, kf[5] * w); ks.w = pk2(kf[6] * w, kf[7] * w);
      st_tr8(KT, l, ch, ks); st_tr8(VT, l, ch, L.v); }
    __syncthreads();
    f32x4 acc[2] = {(f32x4){0.f, 0.f, 0.f, 0.f}, (f32x4){0.f, 0.f, 0.f, 0.f}};
    mm64(acc, VT, KT, wid, lane);
    { const int tm = wid >> 1, tn0 = (wid & 1) * 2, lr = lane & 15, lq = lane >> 4; float* dst = P.stm + (size_t)ci * 4096;
#pragma unroll
      for (int t = 0; t < 2; ++t)
#pragma unroll
          for (int r = 0; r < 4; ++r) dst[(tm * 16 + lq * 4 + r) * 64 + (tn0 + t) * 16 + lr] = acc[t][r]; }
    if (tid < 64) { float s = 0.f;
#pragma unroll
        for (int q = 0; q < 8; ++q) { const u32x4 w = *(const LAS u32x4*)(KT + tid * PT + q * 8); float f[8]; unpack8(w, f);
#pragma unroll
            for (int i = 0; i < 8; ++i) s += f[i]; }
        P.smN[(size_t)ci * 64 + tid] = s; }
    __syncthreads();
}
__device__ __forceinline__ void mlstm_out(const MOut& L, const RecP& P, LAS unsigned char* lds, int ci, int tid, int wid, int lane) {
    const int bh = ci >> 6, c = ci & 63, b = bh >> 2, h = bh & 3, row0 = b * SEQ + c * 64;
    LAS bf16_t* Qm = (LAS bf16_t*)(lds + OFF_T0); LAS bf16_t* Km = (LAS bf16_t*)(lds + OFF_T1); LAS bf16_t* VT = (LAS bf16_t*)(lds + OFF_T2);
    LAS bf16_t* CT = (LAS bf16_t*)(lds + OFF_T3); LAS bf16_t* Sm = (LAS bf16_t*)(lds + OFF_T4);
    LAS float* HM = (LAS float*)(lds + OFF_HM); LAS float* vec = (LAS float*)(lds + OFF_VEC);
    const int l = tid >> 3, ch = tid & 7;
    *(LAS u32x4*)(Qm + l * PT + ch * 8) = L.q; *(LAS u32x4*)(Km + l * PT + ch * 8) = L.k; st_tr8(VT, l, ch, L.v); *(LAS u32x4*)(CT + l * PT + ch * 8) = L.st;
    if (wid == 0) {
        const float li = L.mi + P.mbi[h], lf = logsig(L.mf + P.mbf[h]);
        const float bc = scan_add(lf, lane), g = li - bc;
        const float pm = scan_max(g, lane), m = L.m, M = fmaxf(m, pm);
        vec[V_G + lane] = g; vec[V_M + lane] = M; vec[V_WI + lane] = fexp(m - M); vec[V_EM + lane] = fexp(-bc - M);
        vec[V_N + lane] = L.n;
    }
    __syncthreads();
    { f32x4 acc[2] = {(f32x4){0.f, 0.f, 0.f, 0.f}, (f32x4){0.f, 0.f, 0.f, 0.f}};
      mm64(acc, Qm, Km, wid, lane);
      const int tm = wid >> 1, tn0 = (wid & 1) * 2, lr = lane & 15, lq = lane >> 4;
#pragma unroll
      for (int t = 0; t < 2; ++t) { const int ll = (tn0 + t) * 16 + lr; const float gl = vec[V_G + ll];
#pragma unroll
          for (int r = 0; r < 4; ++r) { const int j = tm * 16 + lq * 4 + r; const float s = (ll <= j) ? acc[t][r] * fexp(gl - vec[V_M + j]) : 0.f; Sm[j * PT + ll] = (bf16_t)f2bf(s); } } }
    __syncthreads();
    { f32x4 a1[2] = {(f32x4){0.f, 0.f, 0.f, 0.f}, (f32x4){0.f, 0.f, 0.f, 0.f}}, a2[2] = {(f32x4){0.f, 0.f, 0.f, 0.f}, (f32x4){0.f, 0.f, 0.f, 0.f}};
      mm64(a1, Sm, VT, wid, lane); mm64(a2, Qm, CT, wid, lane);
      const int tm = wid >> 1, tn0 = (wid & 1) * 2, lr = lane & 15, lq = lane >> 4;
#pragma unroll
      for (int t = 0; t < 2; ++t)
#pragma unroll
          for (int r = 0; r < 4; ++r) { const int j = tm * 16 + lq * 4 + r; HM[j * 68 + (tn0 + t) * 16 + lr] = a1[t][r] + vec[V_WI + j] * a2[t][r]; } }
    if (tid < 64) { float ds = 0.f, qn = 0.f;
#pragma unroll
        for (int q = 0; q < 8; ++q) { const u32x4 w = *(const LAS u32x4*)(Sm + tid * PT + q * 8); float f[8]; unpack8(w, f);
            const u32x4 qw = *(const LAS u32x4*)(Qm + tid * PT + q * 8); float qf[8]; unpack8(qw, qf);
#pragma unroll
            for (int i = 0; i < 8; ++i) { ds += f[i]; qn += qf[i] * vec[V_N + q * 8 + i]; } }
        const float den = ds + vec[V_WI + tid] * qn;
        vec[V_DI + tid] = 1.f / fmaxf(fabsf(den), vec[V_EM + tid]); }
    __syncthreads();
    finalize2<0>(HM, vec + V_DI, P.mg, L.mo, P.ycat + (size_t)row0 * DM + h * 64, tid);
    __syncthreads();
}
__device__ __forceinline__ void gla_bmat(const f32x4 ga, const GW& W, LAS unsigned char* lds, int tid, int wid) {
    LAS float* BM = (LAS float*)(lds + OFF_BM); LAS float* vec = (LAS float*)(lds + OFF_VEC);
    if (tid < 256) { const int l = tid >> 2, q = tid & 3; vec[V_GA + l * 16 + q * 4 + 0] = ga[0]; vec[V_GA + l * 16 + q * 4 + 1] = ga[1]; vec[V_GA + l * 16 + q * 4 + 2] = ga[2]; vec[V_GA + l * 16 + q * 4 + 3] = ga[3]; }
    const int dcol = tid & 63;
    __syncthreads();
    float cs[8]; float cacc = 0.f;
#pragma unroll
    for (int i = 0; i < 8; ++i) { const int l = wid * 8 + i; float z = W.bav;
#pragma unroll
        for (int r = 0; r < 16; ++r) z += vec[V_GA + l * 16 + r] * W.wv[r];
        cacc += logsig(z) * (1.f / 16.f); cs[i] = cacc; }
    vec[V_SEG + wid * 64 + dcol] = cacc;
    __syncthreads();
    float off = 0.f, tot = 0.f;
#pragma unroll
    for (int s = 0; s < 8; ++s) { const float v = vec[V_SEG + s * 64 + dcol]; tot += v; if (s < wid) off += v; }
#pragma unroll
    for (int i = 0; i < 8; ++i) BM[(wid * 8 + i) * 64 + dcol] = off + cs[i];
    if (wid == 0) vec[V_BE + dcol] = tot;
    __syncthreads();
}
__device__ __forceinline__ void gla_local(const GLoc& L, const GW& W, const RecP& P, LAS unsigned char* lds, int ci, int tid, int wid, int lane) {
    LAS bf16_t* KT = (LAS bf16_t*)(lds + OFF_T0); LAS bf16_t* VT = (LAS bf16_t*)(lds + OFF_T1);
    LAS float* BM = (LAS float*)(lds + OFF_BM); LAS float* vec = (LAS float*)(lds + OFF_VEC);
    const int l = tid >> 3, ch = tid & 7;
    gla_bmat(L.ga, W, lds, tid, wid);
    if (tid < 64) P.smGBE[(size_t)ci * 64 + tid] = vec[V_BE + tid];
    { float kf[8]; unpack8(L.k, kf); float ks[8];
#pragma unroll
      for (int i = 0; i < 8; ++i) { const int d = ch * 8 + i; ks[i] = kf[i] * fexp(vec[V_BE + d] - BM[l * 64 + d]); }
      u32x4 kk; kk.x = pk2(ks[0], ks[1]); kk.y = pk2(ks[2], ks[3]); kk.z = pk2(ks[4], ks[5]); kk.w = pk2(ks[6], ks[7]);
      st_tr8(KT, l, ch, kk); st_tr8(VT, l, ch, L.v); }
    __syncthreads();
    f32x4 acc[2] = {(f32x4){0.f, 0.f, 0.f, 0.f}, (f32x4){0.f, 0.f, 0.f, 0.f}};
    mm64(acc, VT, KT, wid, lane);
    { const int tm = wid >> 1, tn0 = (wid & 1) * 2, lr = lane & 15, lq = lane >> 4; float* dst = P.stg + (size_t)ci * 4096;
#pragma unroll
      for (int t = 0; t < 2; ++t)
#pragma unroll
          for (int r = 0; r < 4; ++r) dst[(tm * 16 + lq * 4 + r) * 64 + (tn0 + t) * 16 + lr] = acc[t][r]; }
    __syncthreads();
}
__device__ __forceinline__ void gla_out(const GOut& L, const GW& W, const RecP& P, LAS unsigned char* lds, int ci, int tid, int wid, int lane) {
    const int bh = ci >> 6, c = ci & 63, b = bh >> 2, h = bh & 3, row0 = b * SEQ + c * 64;
    LAS bf16_t* Qm = (LAS bf16_t*)(lds + OFF_T0); LAS bf16_t* Km = (LAS bf16_t*)(lds + OFF_T1); LAS bf16_t* VT = (LAS bf16_t*)(lds + OFF_T2);
    LAS bf16_t* ST = (LAS bf16_t*)(lds + OFF_T3); LAS bf16_t* Sm = (LAS bf16_t*)(lds + OFF_T4);
    LAS float* BM = (LAS float*)(lds + OFF_BM); LAS float* HM = (LAS float*)(lds + OFF_HM);
    const int l = tid >> 3, ch = tid & 7;
    gla_bmat(L.ga, W, lds, tid, wid);
    { float qf[8], kf[8]; unpack8(L.q, qf); unpack8(L.k, kf); float qs[8], ks[8];
#pragma unroll
      for (int i = 0; i < 8; ++i) { const float bv = BM[l * 64 + ch * 8 + i]; qs[i] = qf[i] * fexp(bv); ks[i] = kf[i] * fexp(-bv); }
      u32x4 qq, kk; qq.x = pk2(qs[0], qs[1]); qq.y = pk2(qs[2], qs[3]); qq.z = pk2(qs[4], qs[5]); qq.w = pk2(qs[6], qs[7]);
      kk.x = pk2(ks[0], ks[1]); kk.y = pk2(ks[2], ks[3]); kk.z = pk2(ks[4], ks[5]); kk.w = pk2(ks[6], ks[7]);
      *(LAS u32x4*)(Qm + l * PT + ch * 8) = qq; *(LAS u32x4*)(Km + l * PT + ch * 8) = kk; st_tr8(VT, l, ch, L.v);
      *(LAS u32x4*)(ST + l * PT + ch * 8) = L.st; }
    __syncthreads();
    { f32x4 acc[2] = {(f32x4){0.f, 0.f, 0.f, 0.f}, (f32x4){0.f, 0.f, 0.f, 0.f}};
      mm64(acc, Qm, Km, wid, lane);
      const int tm = wid >> 1, tn0 = (wid & 1) * 2, lr = lane & 15, lq = lane >> 4;
#pragma unroll
      for (int t = 0; t < 2; ++t) { const int ll = (tn0 + t) * 16 + lr;
#pragma unroll
          for (int r = 0; r < 4; ++r) { const int j = tm * 16 + lq * 4 + r; Sm[j * PT + ll] = (bf16_t)f2bf((ll <= j) ? acc[t][r] : 0.f); } } }
    __syncthreads();
    { f32x4 acc[2] = {(f32x4){0.f, 0.f, 0.f, 0.f}, (f32x4){0.f, 0.f, 0.f, 0.f}};
      mm64(acc, Sm, VT, wid, lane); mm64(acc, Qm, ST, wid, lane);
      const int tm = wid >> 1, tn0 = (wid & 1) * 2, lr = lane & 15, lq = lane >> 4;
#pragma unroll
      for (int t = 0; t < 2; ++t)
#pragma unroll
          for (int r = 0; r < 4; ++r) HM[(tm * 16 + lq * 4 + r) * 68 + (tn0 + t) * 16 + lr] = acc[t][r]; }
    __syncthreads();
    finalize2<1>(HM, nullptr, P.gg, L.gr, P.ycat + (size_t)row0 * DM + 768 + h * 64, tid);
    __syncthreads();
}
}

namespace recw {
using rec::RecP; using rec::scan_add; using rec::scan_max; using rec::unpack8;
typedef short s16x4v __attribute__((ext_vector_type(4)));
typedef short v4i16_t __attribute__((ext_vector_type(4)));
#define MF16(a, b, c) __builtin_amdgcn_mfma_f32_16x16x32_bf16((a), (b), (c), 0, 0, 0)
__device__ __forceinline__ s16x4v tr16(const LAS bf16_t* p) { return __builtin_bit_cast(s16x4v, __builtin_amdgcn_ds_read_tr16_b64_v4i16((LAS v4i16_t*)p)); }
__device__ __forceinline__ bf16x8 trfrag(const LAS bf16_t* T, int pitch, int s, int c0, int lane) {
    const int i = lane & 15, q = lane >> 4;
    const LAS bf16_t* pa = T + (32 * s + 4 * q + (i >> 2)) * pitch + c0 + 4 * (i & 3);
    const s16x4v lo = tr16(pa), hi = tr16(pa + 16 * pitch);
    return (bf16x8){lo[0], lo[1], lo[2], lo[3], hi[0], hi[1], hi[2], hi[3]};
}
__device__ __forceinline__ bf16x8 rfg(const bf16_t* X, int pitch, int T, int ks, int lane) { return *(const bf16x8*)(X + (size_t)(16 * T + (lane & 15)) * pitch + 32 * ks + 8 * (lane >> 4)); }
__device__ __forceinline__ u32x4 piece(const bf16_t* X, int pitch, int i, int lane) { return *(const u32x4*)(X + (size_t)((lane >> 3) + 8 * i) * pitch + (lane & 7) * 8); }
__device__ __forceinline__ bf16x8 frag_scale(bf16x8 f, float sc) {
    const u32x4 w = __builtin_bit_cast(u32x4, f); u32x4 o;
    o.x = pk2(bflo(w.x) * sc, bfhi(w.x) * sc); o.y = pk2(bflo(w.y) * sc, bfhi(w.y) * sc); o.z = pk2(bflo(w.z) * sc, bfhi(w.z) * sc); o.w = pk2(bflo(w.w) * sc, bfhi(w.w) * sc);
    return __builtin_bit_cast(bf16x8, o);
}
__device__ __forceinline__ bf16x8 frag_mul(bf16x8 f, bf16x8 g, bool recip) {
    const u32x4 a = __builtin_bit_cast(u32x4, f), b = __builtin_bit_cast(u32x4, g); float x[8], y[8]; unpack8(a, x); unpack8(b, y);
#pragma unroll
    for (int i = 0; i < 8; ++i) x[i] = recip ? x[i] * __builtin_amdgcn_rcpf(y[i]) : x[i] * y[i];
    u32x4 o; o.x = pk2(x[0], x[1]); o.y = pk2(x[2], x[3]); o.z = pk2(x[4], x[5]); o.w = pk2(x[6], x[7]);
    return __builtin_bit_cast(bf16x8, o);
}
__device__ __forceinline__ float red_q(float v) { v += __shfl_xor(v, 16); v += __shfl_xor(v, 32); return v; }
__device__ __forceinline__ void stage_rows(f32x4 (&O)[4], int Tj, float rowscale, LAS bf16_t* Tl, int PTL, int lane) {
    const int r = lane & 15, q = lane >> 4;
    float ss = 0.f;
#pragma unroll
    for (int Te = 0; Te < 4; ++Te) { O[Te] = O[Te] * rowscale; const f32x4 v = O[Te]; ss += (v[0] * v[0] + v[1] * v[1]) + (v[2] * v[2] + v[3] * v[3]); }
    ss = red_q(ss);
    const float rs = __builtin_amdgcn_rsqf(ss * (1.f / 64.f) + LN_EPS);
#pragma unroll
    for (int Te = 0; Te < 4; ++Te) { const f32x4 v = O[Te] * rs; u32x2 w; w.x = pk2(v[0], v[1]); w.y = pk2(v[2], v[3]); *(LAS u32x2*)(Tl + (16 * Tj + r) * PTL + 16 * Te + 4 * q) = w; }
}
template <int GATE>
__device__ __forceinline__ void final_store(const LAS bf16_t* Tl, int PTL, const float* gnorm, const bf16_t* gate, bf16_t* out, int lane) {
    const int ch = lane & 7;
    const f32x4 g0 = *(const f32x4*)(gnorm + ch * 8), g1 = *(const f32x4*)(gnorm + ch * 8 + 4);
    const float gn[8] = {g0[0], g0[1], g0[2], g0[3], g1[0], g1[1], g1[2], g1[3]};
#pragma unroll
    for (int i = 0; i < 8; ++i) { const int row = (lane >> 3) + 8 * i;
        float hv[8], gt[8]; unpack8(*(const LAS u32x4*)(Tl + row * PTL + ch * 8), hv); unpack8(*(const u32x4*)(gate + (size_t)row * PP + ch * 8), gt);
        float y[8];
#pragma unroll
        for (int k = 0; k < 8; ++k) { const float sg = __builtin_amdgcn_rcpf(1.f + fexp(-gt[k])); y[k] = hv[k] * (gn[k] * Y8S) * (GATE ? gt[k] * sg : sg); }
        u32x2 w; w.x = pk4_fp8(y[0], y[1], y[2], y[3]); w.y = pk4_fp8(y[4], y[5], y[6], y[7]);
        *(u32x2*)((unsigned char*)out + (size_t)row * DM + ch * 8) = w; }
}
__device__ __forceinline__ void mlstm_local_w(const RecP& P, LAS unsigned char* wl, int ci, int lane) {
    const int r = lane & 15, q = lane >> 4; constexpr int PL = 64;
    const int bh = ci >> 6, c = ci & 63, b = bh >> 2, h = bh & 3, row0 = b * SEQ + c * 64;
    const bf16_t* Xk = P.proj + (size_t)row0 * PP + C_MK + h * 64; const bf16_t* Xv = P.proj + (size_t)row0 * PP + C_MV + h * 64;
    LAS bf16_t* Kl = (LAS bf16_t*)wl; LAS bf16_t* Vl = (LAS bf16_t*)(wl + 8192);
    const float* tp = P.tail + (size_t)(row0 + lane) * 32;
    const float li = tp[T_MI + h] + P.mbi[h], lf = logsig(tp[T_MF + h] + P.mbf[h]);
    const float bc = scan_add(lf, lane), g = li - bc, gmax = wave_max(g), bend = __shfl(bc, 63), w = fexp(g - gmax);
    if (lane == 0) { P.smBC[ci] = bend; P.smDM[ci] = bend + gmax; }
#pragma unroll
    for (int i = 0; i < 8; ++i) { const u32x4 kpi = piece(Xk, PP, i, lane), vpi = piece(Xv, PP, i, lane); const float wr_ = __shfl(w, (lane >> 3) + 8 * i); float kf[8]; unpack8(kpi, kf);
        u32x4 ks; ks.x = pk2(kf[0] * wr_, kf[1] * wr_); ks.y = pk2(kf[2] * wr_, kf[3] * wr_); ks.z = pk2(kf[4] * wr_, kf[5] * wr_); ks.w = pk2(kf[6] * wr_, kf[7] * wr_);
        *(LAS u32x4*)(Kl + ((lane >> 3) + 8 * i) * PL + (lane & 7) * 8) = ks; *(LAS u32x4*)(Vl + ((lane >> 3) + 8 * i) * PL + (lane & 7) * 8) = vpi; }
    asm volatile("" ::: "memory"); __builtin_amdgcn_sched_barrier(0);
    bf16x8 Kt[4][2];
#pragma unroll
    for (int Td = 0; Td < 4; ++Td)
#pragma unroll
        for (int s = 0; s < 2; ++s) Kt[Td][s] = trfrag(Kl, PL, s, 16 * Td, lane);
#pragma unroll
    for (int Te = 0; Te < 4; ++Te) { const bf16x8 v0 = trfrag(Vl, PL, 0, 16 * Te, lane), v1 = trfrag(Vl, PL, 1, 16 * Te, lane);
#pragma unroll
        for (int Td = 0; Td < 4; ++Td) { f32x4 acc = (f32x4){0.f, 0.f, 0.f, 0.f}; acc = MF16(Kt[Td][0], v0, acc); acc = MF16(Kt[Td][1], v1, acc);
            u32x2 w; w.x = pk2(acc[0], acc[1]); w.y = pk2(acc[2], acc[3]); *(LAS u32x2*)(Kl + (16 * Te + r) * PL + 16 * Td + 4 * q) = w; } }
    asm volatile("" ::: "memory"); __builtin_amdgcn_sched_barrier(0);
    { bf16_t* dstb = (bf16_t*)P.stm + (size_t)ci * 4096;
#pragma unroll
      for (int i = 0; i < 8; ++i) { const int row = (lane >> 3) + 8 * i, ch = lane & 7; *(u32x4*)(dstb + row * 64 + ch * 8) = *(const LAS u32x4*)(Kl + row * PL + ch * 8); } }
    { const short one = (short)0x3F80; const bf16x8 ones = (bf16x8){one, one, one, one, one, one, one, one};
#pragma unroll
      for (int Td = 0; Td < 4; ++Td) { f32x4 acc = (f32x4){0.f, 0.f, 0.f, 0.f}; acc = MF16(ones, Kt[Td][0], acc); acc = MF16(ones, Kt[Td][1], acc);
          if (q == 0) P.smN[(size_t)ci * 64 + 16 * Td + r] = acc[0]; } }
}
struct GWf { bf16x8 Bw[4]; float ba[4]; };
__device__ __forceinline__ void ld_gwf(GWf& W, const RecP& P, int h, int lane) {
    const int r = lane & 15, q = lane >> 4;
    int wo = (8 * (q & 1)) * 256 + h * 64 + r; asm volatile("" : "+v"(wo)); const float* wp = P.wa2 + wo;
#pragma unroll
    for (int Td = 0; Td < 4; ++Td) { float w8[8];
#pragma unroll
        for (int i = 0; i < 8; ++i) { const float wv_ = wp[i * 256 + 16 * Td]; w8[i] = (q < 2) ? wv_ : 0.f; }
        u32x4 o; o.x = pk2(w8[0], w8[1]); o.y = pk2(w8[2], w8[3]); o.z = pk2(w8[4], w8[5]); o.w = pk2(w8[6], w8[7]); W.Bw[Td] = __builtin_bit_cast(bf16x8, o);
        W.ba[Td] = P.ba[h * 64 + 16 * Td + r]; }
}
template <int MODE>
__device__ __forceinline__ void gla_gate_tile(LAS bf16_t* Tt, int PL, float (&bend)[4], const GWf& W, const float* tail_row0, int lane) {
    const int r = lane & 15, q = lane >> 4;
    bf16x8 Ag[4];
    int to = r * 32 + T_GA + 8 * (q & 1); asm volatile("" : "+v"(to)); const float* tpb = tail_row0 + to;
#pragma unroll
    for (int Tl = 0; Tl < 4; ++Tl) { f32x4 a0 = *(const f32x4*)(tpb + Tl * 512), a1 = *(const f32x4*)(tpb + Tl * 512 + 4);
        if (q >= 2) { a0 = (f32x4){0.f, 0.f, 0.f, 0.f}; a1 = a0; }
        u32x4 o; o.x = pk2(a0[0], a0[1]); o.y = pk2(a0[2], a0[3]); o.z = pk2(a1[0], a1[1]); o.w = pk2(a1[2], a1[3]); Ag[Tl] = __builtin_bit_cast(bf16x8, o); }
#pragma unroll
    for (int Td = 0; Td < 4; ++Td) { float carry = 0.f; LAS bf16_t* tcol = Tt + (4 * q) * PL + 16 * Td + r;
#pragma unroll
        for (int tt = 0; tt < 4; ++tt) { const int Tl = MODE ? 3 - tt : tt; const float bb = W.ba[Td]; const f32x4 z = MF16(Ag[Tl], W.Bw[Td], ((f32x4){bb, bb, bb, bb}));
            const float v0 = logsig(z[0]) * (1.f / 16.f), v1 = logsig(z[1]) * (1.f / 16.f), v2 = logsig(z[2]) * (1.f / 16.f), v3 = logsig(z[3]) * (1.f / 16.f);
            const float lt = (v0 + v1) + (v2 + v3);
            float ex, o0, o1, o2, o3;
            if (MODE == 0) { const float t1 = __shfl_up(lt, 16), t2 = __shfl_up(lt, 32), t3 = __shfl_up(lt, 48); ex = carry + (q >= 1 ? t1 : 0.f) + (q >= 2 ? t2 : 0.f) + (q >= 3 ? t3 : 0.f);
                o0 = ex + v0; o1 = o0 + v1; o2 = o1 + v2; o3 = o2 + v3; }
            else { const float t1 = __shfl_down(lt, 16), t2 = __shfl_down(lt, 32), t3 = __shfl_down(lt, 48); ex = carry + (q <= 2 ? t1 : 0.f) + (q <= 1 ? t2 : 0.f) + (q <= 0 ? t3 : 0.f);
                o3 = ex; o2 = o3 + v3; o1 = o2 + v2; o0 = o1 + v1; }
            carry += red_q(lt);
            LAS bf16_t* tp = tcol + (16 * Tl) * PL;
            const unsigned w01 = pk2(fexp(o0), fexp(o1)), w23 = pk2(fexp(o2), fexp(o3));
            tp[0] = (bf16_t)(w01 & 0xffffu); tp[PL] = (bf16_t)(w01 >> 16); tp[2 * PL] = (bf16_t)(w23 & 0xffffu); tp[3 * PL] = (bf16_t)(w23 >> 16); }
        bend[Td] = carry; }
}
__device__ __forceinline__ void gla_local_w(const RecP& P, const GWf& W, LAS unsigned char* wl, int ci, int lane) {
    const int r = lane & 15, q = lane >> 4; constexpr int PL = 64;
    const int bh = ci >> 6, c = ci & 63, b = bh >> 2, h = bh & 3, row0 = b * SEQ + c * 64;
    const bf16_t* Xk = P.proj + (size_t)row0 * PP + C_GK + h * 64; const bf16_t* Xv = P.proj + (size_t)row0 * PP + C_GV + h * 64;
    LAS bf16_t* Kl = (LAS bf16_t*)wl; LAS bf16_t* Vl = (LAS bf16_t*)(wl + 8192);
    { float bend[4]; gla_gate_tile<1>(Kl, PL, bend, W, P.tail + (size_t)row0 * 32, lane);
      if (q == 0) {
#pragma unroll
          for (int Td = 0; Td < 4; ++Td) P.smGBE[(size_t)ci * 64 + 16 * Td + r] = bend[Td]; } }
    asm volatile("" ::: "memory"); __builtin_amdgcn_sched_barrier(0);
#pragma unroll
    for (int i = 0; i < 8; ++i) { const u32x4 kp = piece(Xk, PP, i, lane), vp = piece(Xv, PP, i, lane);
        LAS bf16_t* kp_l = Kl + ((lane >> 3) + 8 * i) * PL + (lane & 7) * 8; float kf[8], ff[8]; unpack8(kp, kf); unpack8(*(const LAS u32x4*)kp_l, ff);
        u32x4 ks; ks.x = pk2(kf[0] * ff[0], kf[1] * ff[1]); ks.y = pk2(kf[2] * ff[2], kf[3] * ff[3]); ks.z = pk2(kf[4] * ff[4], kf[5] * ff[5]); ks.w = pk2(kf[6] * ff[6], kf[7] * ff[7]);
        *(LAS u32x4*)kp_l = ks; *(LAS u32x4*)(Vl + ((lane >> 3) + 8 * i) * PL + (lane & 7) * 8) = vp; }
    asm volatile("" ::: "memory"); __builtin_amdgcn_sched_barrier(0);
    bf16x8 Kt[4][2];
#pragma unroll
    for (int Td = 0; Td < 4; ++Td)
#pragma unroll
        for (int s = 0; s < 2; ++s) Kt[Td][s] = trfrag(Kl, PL, s, 16 * Td, lane);
#pragma unroll
    for (int Te = 0; Te < 4; ++Te) { const bf16x8 v0 = trfrag(Vl, PL, 0, 16 * Te, lane), v1 = trfrag(Vl, PL, 1, 16 * Te, lane);
#pragma unroll
        for (int Td = 0; Td < 4; ++Td) { f32x4 acc = (f32x4){0.f, 0.f, 0.f, 0.f}; acc = MF16(Kt[Td][0], v0, acc); acc = MF16(Kt[Td][1], v1, acc);
            u32x2 w; w.x = pk2(acc[0], acc[1]); w.y = pk2(acc[2], acc[3]); *(LAS u32x2*)(Kl + (16 * Te + r) * PL + 16 * Td + 4 * q) = w; } }
    asm volatile("" ::: "memory"); __builtin_amdgcn_sched_barrier(0);
    { bf16_t* dstb = (bf16_t*)P.stg + (size_t)ci * 4096;
#pragma unroll
      for (int i = 0; i < 8; ++i) { const int row = (lane >> 3) + 8 * i, ch = lane & 7; *(u32x4*)(dstb + row * 64 + ch * 8) = *(const LAS u32x4*)(Kl + row * PL + ch * 8); } }
}
__device__ __forceinline__ void mlstm_out_w(const RecP& P, LAS unsigned char* wl, int ci, int lane) {
    const int r = lane & 15, q = lane >> 4; constexpr int PL = 72;
    const int bh = ci >> 6, c = ci & 63, b = bh >> 2, h = bh & 3, row0 = b * SEQ + c * 64;
    const bf16_t* Xq = P.proj + (size_t)row0 * PP + C_MQ + h * 64; const bf16_t* Xk = P.proj + (size_t)row0 * PP + C_MK + h * 64; const bf16_t* Xv = P.proj + (size_t)row0 * PP + C_MV + h * 64;
    LAS bf16_t* Tl = (LAS bf16_t*)wl; LAS float* vg = (LAS float*)(wl + 9216); LAS float* vn = vg + 64;
#pragma unroll
    for (int i = 0; i < 8; ++i) *(LAS u32x4*)(Tl + ((lane >> 3) + 8 * i) * PL + (lane & 7) * 8) = piece(Xv, PP, i, lane);
    const float* tp = P.tail + (size_t)(row0 + lane) * 32;
    const float li = tp[T_MI + h] + P.mbi[h], lf = logsig(tp[T_MF + h] + P.mbf[h]);
    const float m = P.smMS[ci]; vn[lane] = P.smN[(size_t)ci * 64 + lane];
    const float bc = scan_add(lf, lane), g = li - bc, pm = scan_max(g, lane), M = fmaxf(m, pm), wint = fexp(m - M), expm = fexp(-bc - M);
    vg[lane] = g;
    asm volatile("" ::: "memory"); __builtin_amdgcn_sched_barrier(0);
    bf16x8 Kf[4][2], Qf[4][2];
#pragma unroll
    for (int T = 0; T < 4; ++T)
#pragma unroll
        for (int ks = 0; ks < 2; ++ks) { Kf[T][ks] = rfg(Xk, PP, T, ks, lane); Qf[T][ks] = rfg(Xq, PP, T, ks, lane); }
    float Mj[4], wj[4], ej[4];
#pragma unroll
    for (int T = 0; T < 4; ++T) { Mj[T] = __shfl(M, 16 * T + r); wj[T] = __shfl(wint, 16 * T + r); ej[T] = __shfl(expm, 16 * T + r); }
    u32x2 Pk[4][4]; float dinv[4];
#pragma unroll
    for (int Tj = 0; Tj < 4; ++Tj) { float dsum = 0.f;
#pragma unroll
        for (int Tl_ = 0; Tl_ < 4; ++Tl_) {
            if (Tl_ <= Tj) { f32x4 acc = (f32x4){0.f, 0.f, 0.f, 0.f}; acc = MF16(Kf[Tl_][0], Qf[Tj][0], acc); acc = MF16(Kf[Tl_][1], Qf[Tj][1], acc);
                const f32x4 g4 = *(const LAS f32x4*)(vg + 16 * Tl_ + 4 * q); float sv[4];
#pragma unroll
                for (int rg = 0; rg < 4; ++rg) { const bool ok = (Tl_ < Tj) || (4 * q + rg <= r); sv[rg] = ok ? acc[rg] * fexp(g4[rg] - Mj[Tj]) : 0.f; dsum += sv[rg]; }
                Pk[Tj][Tl_].x = pk2(sv[0], sv[1]); Pk[Tj][Tl_].y = pk2(sv[2], sv[3]); }
            else { Pk[Tj][Tl_].x = 0u; Pk[Tj][Tl_].y = 0u; } }
        dsum = red_q(dsum);
        float qn = 0.f;
#pragma unroll
        for (int ks = 0; ks < 2; ++ks) { float qf[8]; unpack8(__builtin_bit_cast(u32x4, Qf[Tj][ks]), qf); const f32x4 n0 = *(const LAS f32x4*)(vn + 32 * ks + 8 * q), n1 = *(const LAS f32x4*)(vn + 32 * ks + 8 * q + 4);
            qn += (qf[0] * n0[0] + qf[1] * n0[1]) + (qf[2] * n0[2] + qf[3] * n0[3]) + (qf[4] * n1[0] + qf[5] * n1[1]) + (qf[6] * n1[2] + qf[7] * n1[3]); }
        qn = red_q(qn);
        const float den = dsum + wj[Tj] * qn; dinv[Tj] = __builtin_amdgcn_rcpf(fmaxf(fabsf(den), ej[Tj]));
        Qf[Tj][0] = frag_scale(Qf[Tj][0], wj[Tj]); Qf[Tj][1] = frag_scale(Qf[Tj][1], wj[Tj]); asm volatile("" ::: "memory"); __builtin_amdgcn_sched_barrier(0); }
    asm volatile("" ::: "memory"); __builtin_amdgcn_sched_barrier(0);
    const bf16_t* cs = P.csm + (size_t)ci * 4096;
    bf16x8 Vt[4][2], Ct[4][2];
#pragma unroll
    for (int Te = 0; Te < 4; ++Te)
#pragma unroll
        for (int s = 0; s < 2; ++s) { Vt[Te][s] = trfrag(Tl, PL, s, 16 * Te, lane); Ct[Te][s] = rfg(cs, 64, Te, s, lane); }
    asm volatile("" ::: "memory"); __builtin_amdgcn_sched_barrier(0);
#pragma unroll
    for (int Tj = 0; Tj < 4; ++Tj) { f32x4 O[4];
        const bf16x8 p0 = __builtin_bit_cast(bf16x8, ((u32x4){Pk[Tj][0].x, Pk[Tj][0].y, Pk[Tj][1].x, Pk[Tj][1].y})), p1 = __builtin_bit_cast(bf16x8, ((u32x4){Pk[Tj][2].x, Pk[Tj][2].y, Pk[Tj][3].x, Pk[Tj][3].y}));
#pragma unroll
        for (int Te = 0; Te < 4; ++Te) { f32x4 acc = (f32x4){0.f, 0.f, 0.f, 0.f}; acc = MF16(Vt[Te][0], p0, acc); if (Tj >= 2) acc = MF16(Vt[Te][1], p1, acc);
            acc = MF16(Ct[Te][0], Qf[Tj][0], acc); acc = MF16(Ct[Te][1], Qf[Tj][1], acc); O[Te] = acc; }
        stage_rows(O, Tj, dinv[Tj], Tl, PL, lane); asm volatile("" ::: "memory"); __builtin_amdgcn_sched_barrier(0); }
    asm volatile("" ::: "memory"); __builtin_amdgcn_sched_barrier(0);
    final_store<0>(Tl, PL, P.mg, P.proj + (size_t)row0 * PP + C_MO + h * 64, (bf16_t*)((unsigned char*)P.ycat + (size_t)row0 * DM + h * 64), lane);
}
__device__ __forceinline__ void gla_out_w(const RecP& P, const GWf& W, LAS unsigned char* wl, int ci, int lane) {
    const int r = lane & 15, q = lane >> 4; constexpr int PL = 72;
    const int bh = ci >> 6, c = ci & 63, b = bh >> 2, h = bh & 3, row0 = b * SEQ + c * 64;
    const bf16_t* Xq = P.proj + (size_t)row0 * PP + C_GQ + h * 64; const bf16_t* Xk = P.proj + (size_t)row0 * PP + C_GK + h * 64; const bf16_t* Xv = P.proj + (size_t)row0 * PP + C_GV + h * 64;
    LAS bf16_t* Tl = (LAS bf16_t*)wl;
    { float bend[4]; gla_gate_tile<0>(Tl, PL, bend, W, P.tail + (size_t)row0 * 32, lane); }
    asm volatile("" ::: "memory"); __builtin_amdgcn_sched_barrier(0);
    bf16x8 Kf[4][2], Qf[4][2];
#pragma unroll
    for (int T = 0; T < 4; ++T)
#pragma unroll
        for (int ks = 0; ks < 2; ++ks) { const bf16x8 ef = *(const LAS bf16x8*)(Tl + (16 * T + r) * PL + 32 * ks + 8 * q); Qf[T][ks] = frag_mul(rfg(Xq, PP, T, ks, lane), ef, false); Kf[T][ks] = frag_mul(rfg(Xk, PP, T, ks, lane), ef, true); }
    asm volatile("" ::: "memory"); __builtin_amdgcn_sched_barrier(0);
#pragma unroll
    for (int i = 0; i < 8; ++i) *(LAS u32x4*)(Tl + ((lane >> 3) + 8 * i) * PL + (lane & 7) * 8) = piece(Xv, PP, i, lane);
    asm volatile("" ::: "memory"); __builtin_amdgcn_sched_barrier(0);
    u32x2 Pk[4][4];
#pragma unroll
    for (int Tj = 0; Tj < 4; ++Tj)
#pragma unroll
        for (int Tl_ = 0; Tl_ < 4; ++Tl_) {
            if (Tl_ <= Tj) { f32x4 acc = (f32x4){0.f, 0.f, 0.f, 0.f}; acc = MF16(Kf[Tl_][0], Qf[Tj][0], acc); acc = MF16(Kf[Tl_][1], Qf[Tj][1], acc); float sv[4];
#pragma unroll
                for (int rg = 0; rg < 4; ++rg) { const bool ok = (Tl_ < Tj) || (4 * q + rg <= r); sv[rg] = ok ? acc[rg] : 0.f; }
                Pk[Tj][Tl_].x = pk2(sv[0], sv[1]); Pk[Tj][Tl_].y = pk2(sv[2], sv[3]); }
            else { Pk[Tj][Tl_].x = 0u; Pk[Tj][Tl_].y = 0u; } }
    const bf16_t* cs = P.csg + (size_t)ci * 4096;
    bf16x8 Vt[4][2], Ct[4][2];
#pragma unroll
    for (int Te = 0; Te < 4; ++Te)
#pragma unroll
        for (int s = 0; s < 2; ++s) { Vt[Te][s] = trfrag(Tl, PL, s, 16 * Te, lane); Ct[Te][s] = rfg(cs, 64, Te, s, lane); }
    asm volatile("" ::: "memory"); __builtin_amdgcn_sched_barrier(0);
#pragma unroll
    for (int Tj = 0; Tj < 4; ++Tj) { f32x4 O[4];
        const bf16x8 p0 = __builtin_bit_cast(bf16x8, ((u32x4){Pk[Tj][0].x, Pk[Tj][0].y, Pk[Tj][1].x, Pk[Tj][1].y})), p1 = __builtin_bit_cast(bf16x8, ((u32x4){Pk[Tj][2].x, Pk[Tj][2].y, Pk[Tj][3].x, Pk[Tj][3].y}));
#pragma unroll
        for (int Te = 0; Te < 4; ++Te) { f32x4 acc = (f32x4){0.f, 0.f, 0.f, 0.f}; acc = MF16(Vt[Te][0], p0, acc); if (Tj >= 2) acc = MF16(Vt[Te][1], p1, acc);
            acc = MF16(Ct[Te][0], Qf[Tj][0], acc); acc = MF16(Ct[Te][1], Qf[Tj][1], acc); O[Te] = acc; }
        stage_rows(O, Tj, 1.f, Tl, PL, lane); asm volatile("" ::: "memory"); __builtin_amdgcn_sched_barrier(0); }
    asm volatile("" ::: "memory"); __builtin_amdgcn_sched_barrier(0);
    final_store<1>(Tl, PL, P.gg, P.proj + (size_t)row0 * PP + C_GR + h * 64, (bf16_t*)((unsigned char*)P.ycat + (size_t)row0 * DM + 768 + h * 64), lane);
}
#undef MF16
}


constexpr int N_PHASES = 2 + 9 * DEPTH;
__global__ void __launch_bounds__(512, 2) mega_fwd(Args args) {
    extern __shared__ __attribute__((aligned(16))) unsigned char lds_raw[];
    Frame F;
    F.lds = (LAS unsigned char*)lds_raw;
    F.MISC = (volatile LAS unsigned*)(F.lds + MISC_OFF);
    F.tid = threadIdx.x; F.lane = F.tid & 63; F.wave = __builtin_amdgcn_readfirstlane(F.tid >> 6);
    F.G = gridDim.x; { const int bx = blockIdx.x; F.vcu = (F.G % 8 == 0) ? (bx % 8) * (F.G / 8) + bx / 8 : bx; }
    typedef const __attribute__((address_space(4))) Args* CArgs;
    const CArgs ap0 = (CArgs)__builtin_amdgcn_kernarg_segment_ptr();
    F.ctl = (gu32*)(args.ws + WS_CTL);
    for (int u = F.tid; u < (LDS_BYTES - LDSCTL_OFF) / 4; u += 512) ((LAS unsigned*)(F.lds + LDSCTL_OFF))[u] = 0u;
    __syncthreads();
#if MK_ONE_LAUNCH
    XcdBarrier bar = xcd_barrier_post((unsigned*)(F.ctl + CW_BAR), F.MISC + 8);
#define GRID_BAR() xcd_barrier(bar)
#else
#define GRID_BAR() do {} while (0)
#endif
    const int lo = args.ph_lo, hi = args.ph_hi;
#define IN(k) (lo <= (k) && (k) < hi)
#define SEAM(k) do { if (IN(k) && IN((k) + 1)) { GRID_BAR(); if (NREP(15) == 2) GRID_BAR(); } } while (0)
    const int NGW = F.G * 8;
#define PHASE_IDS() int tid = threadIdx.x; asm volatile("" : "+v"(tid)); const int lane = tid & 63, wid = __builtin_amdgcn_readfirstlane(tid >> 6); const int gw = F.vcu * 8 + wid; (void)lane; (void)gw; \
    CArgs ap = ap0; asm volatile("" : "+s"(ap)); unsigned char* ws = ap->ws; (void)ws
#define AIN(i) (ap->in[i])
#define MOD ((float*)(ws + WS_MOD))
#define ROPE ((float*)(ws + WS_ROPE))
#define WIN ((bf16_t*)(ws + WS_WIN))
#define WOUT ((bf16_t*)(ws + WS_WOUT))
#define WGU8 ((unsigned char*)(ws + WS_WGU))
#define WD8 ((unsigned char*)(ws + WS_WD))
#define U8B ((unsigned char*)(ws + WS_U8))
#define WIN8 ((unsigned char*)(ws + WS_WIN8))
#define H8B ((unsigned char*)(ws + WS_PROJ))
#define LTOK ((int*)(ws + WS_LTOK))
#define LGATE ((float*)(ws + WS_LGATE))
#define PROJ ((bf16_t*)(ws + WS_PROJ))
#define HB ((bf16_t*)(ws + WS_PROJ))
#define XB ((bf16_t*)(ws + WS_XR))
#define YSORT ((bf16_t*)(ws + WS_YSORT))
#define TAILB ((float*)(ws + WS_TAIL))
#define TOKSLOT ((int*)(ws + WS_SM + SM_TS))
#define UB ((bf16_t*)(ws + WS_U))
#define YCAT ((bf16_t*)(ws + WS_YCAT))
#define STM ((float*)(ws + WS_U))
#define STG ((float*)(ws + WS_U + 32 * MiB))
#define CSM ((bf16_t*)(ws + WS_XR + 64 * MiB))
#define CSG ((bf16_t*)(ws + WS_XR + 80 * MiB))
#define G_smN ((float*)(ws + WS_SM + SM_N))
#define G_smBC ((float*)(ws + WS_SM + SM_BC))
#define G_smDM ((float*)(ws + WS_SM + SM_DM))
#define G_smMS ((float*)(ws + WS_SM + SM_MS))
#define G_smGBE ((float*)(ws + WS_SM + SM_GBE))
#define x_in AIN(I_X)

    if (IN(0) && PHON(0)) for (int rp0 = 0; rp0 < NREP(0); ++rp0) {
        PHASE_IDS();
        {
            LAS float* cact = (LAS float*)F.lds;
            LAS float* part = (LAS float*)(F.lds + 32768);
            const float* cc = AIN(I_C);
            for (int i = tid; i < NB * DM; i += 512) { const int b = i >> 10, k = i & 1023; const float v = cc[i]; cact[k * 8 + b] = v / (1.f + fexp(-v)); }
            __syncthreads();
            for (int it = F.vcu; it < DEPTH * 96; it += F.G) {
                const int l = it / 96, j0 = (it % 96) * 64;
                const float* W = AIN(I_WADA) + (size_t)l * DM * 6144 + j0 + lane;
                float a[8] = {0.f, 0.f, 0.f, 0.f, 0.f, 0.f, 0.f, 0.f};
#pragma unroll 32
                for (int kk = 0; kk < 128; ++kk) { const int k = wid * 128 + kk; const float w = W[(size_t)k * 6144];
                    const f32x4 c0 = *(const LAS f32x4*)(cact + k * 8), c1 = *(const LAS f32x4*)(cact + k * 8 + 4);
                    a[0] += c0[0] * w; a[1] += c0[1] * w; a[2] += c0[2] * w; a[3] += c0[3] * w; a[4] += c1[0] * w; a[5] += c1[1] * w; a[6] += c1[2] * w; a[7] += c1[3] * w; }
#pragma unroll
                for (int b = 0; b < 8; ++b) part[(wid * 8 + b) * 64 + lane] = a[b];
                __syncthreads();
                { const int b = tid >> 6, j = tid & 63; float s = AIN(I_BADA)[(size_t)l * 6144 + j0 + j];
#pragma unroll
                  for (int w = 0; w < 8; ++w) s += part[(w * 8 + b) * 64 + j];
                  MOD[((size_t)l * NB + b) * 6144 + j0 + j] = s; }
                __syncthreads();
            }
        }
        {
            const int* pos = (const int*)AIN(I_POS);
            for (int i = blockIdx.x * 512 + tid; i < NTOK * 4; i += F.G * 512) { const int row = i >> 2, f = i & 3;
                const float invf = (float)pow(500000.0, -0.25 * (double)f); const float ang = (float)pos[row] * invf;
                ROPE[(size_t)row * 8 + f] = (float)cos((double)ang); ROPE[(size_t)row * 8 + 4 + f] = (float)sin((double)ang); }
        }
        {
            LAS float* scr = (LAS float*)(F.lds + 49152 + wid * 8704);
            constexpr int I_IN = (DM / 64) * (PW / 32), I_OUT = (DM / 64) * (DM / 32);
            auto dec0 = [&](int it, TrD& d) { const int l = it / (I_IN + I_OUT); int r = it % (I_IN + I_OUT);
                if (r < I_IN) { const int kb = r / (PW / 32), nb = r % (PW / 32); const int nbe = (nb < 112) ? nb : 0; const int tl = nbe >> 3;
                    d.wsc = (tl == 0 || tl == 10) ? 0.125f : (tl == 7) ? ATT_C2 : 1.f;
                    d.src = AIN(I_WIN) + (size_t)l * DM * PIN + (size_t)(kb * 64) * PIN + win_src_col(nbe * 32); d.ldw = PIN; d.K = DM; d.dst = WIN + (size_t)l * PW * DM; d.dst8 = WIN8 + (size_t)l * PP * DM; d.drow0 = nbe * 32; d.k0 = kb * 64;
                    return nb < 112; }
                r -= I_IN; const int kb = r / (DM / 32), nb = r % (DM / 32); d.wsc = 1.f;
                d.src = AIN(I_WOUT) + (size_t)l * DM * DM + (size_t)(kb * 64) * DM + nb * 32; d.wsc = W8S; d.dst8 = nullptr; d.ldw = DM; d.K = DM; d.dst = (bf16_t*)((unsigned char*)WOUT + (size_t)l * DM * DM); d.drow0 = nb * 32; d.k0 = kb * 64; return true; };
            { TrD dc, dn; f32x4 vc[8], vn[8]; int it = gw; bool okc = dec0(it, dc); tr_load4(dc, vc, lane); dn = dc; bool okn = okc;
#pragma unroll
              for (int i = 0; i < 8; ++i) vn[i] = vc[i];
              for (; it < DEPTH * (I_IN + I_OUT); it += NGW) { const int itn = it + NGW;
                  if (itn < DEPTH * (I_IN + I_OUT)) { okn = dec0(itn, dn); tr_load4(dn, vn, lane); }
                  if (okc) { if (dc.ldw == DM) tr_finish8(dc, vc, scr, lane); else { TrD d8 = dc; d8.dst = (bf16_t*)dc.dst8; d8.wsc = dc.wsc * W8S; tr_finish8(d8, vc, scr, lane); } }
                  dc = dn; okc = okn;
#pragma unroll
                  for (int i = 0; i < 8; ++i) vc[i] = vn[i]; } }
            for (int it = gw; it < DEPTH * (DM / 64) * 8; it += NGW) { const int l = it / ((DM / 64) * 8), r = it % ((DM / 64) * 8), kb = r >> 3, nb = 112 + (r & 7);
                tr_item(AIN(I_WIN) + (size_t)l * DM * PIN, PIN, DM, WIN + (size_t)l * PW * DM, nb * 32, win_src_col(nb * 32 + (lane & 31)), kb * 64, scr, lane); }
        }
    }
    SEAM(0);
    if (IN(1) && PHON(1)) {
        PHASE_IDS();
        NarrowT NT_; nmm_load_tail(NT_, WIN + (size_t)PP * DM, wid, lane);
        LAS bf16_t* Sst = (LAS bf16_t*)F.lds; LAS float* Pb = (LAS float*)(F.lds + NMM_P_OFF);
        const int b = F.vcu >> 5; const float* md = MOD + (size_t)b * 6144;
        f32x4 sh[4], sc[4];
#pragma unroll
        for (int j = 0; j < 4; ++j) { sh[j] = *(const f32x4*)(md + 4 * lane + 256 * j); sc[j] = *(const f32x4*)(md + 1024 + 4 * lane + 256 * j) + 1.0f; }
        const int rowb = F.vcu * 128 + wid * 16;
        for (int i = 0; i < 16; i += 4) { f32x4 v[4][4];
#pragma unroll
            for (int rr = 0; rr < 4; ++rr)
#pragma unroll
                for (int j = 0; j < 4; ++j) v[rr][j] = *(const f32x4*)(x_in + (size_t)(rowb + i + rr) * DM + 4 * lane + 256 * j);
#pragma unroll
            for (int rr = 0; rr < 4; ++rr)
#pragma unroll
                for (int j = 0; j < 4; ++j) { const f32x4 u = v[rr][j] * sc[j] + sh[j];
                    u32x2 w; w.x = pk2(u[0], u[1]); w.y = pk2(u[2], u[3]); *(LAS u32x2*)(Sst + (wid * 4 + rr) * NSP + 4 * lane + 256 * j) = w;
                    *(unsigned*)(U8B + (size_t)(rowb + i + rr) * DM + 4 * lane + 256 * j) = pk4_fp8(u[0], u[1], u[2], u[3]); }
            nmm_step_tail(NT_, Sst, Pb, TAILB + (size_t)(F.vcu * 128) * 32, i, tid, wid, lane); }
    }
    SEAM(1);

    for (int l = 0; l < DEPTH; ++l) {
        const int pb = 2 + 9 * l;
#define modl (MOD + (size_t)l * NB * 6144)
#define MAKE_RP() rec::RecP RP; RP.proj = PROJ; RP.tail = TAILB; RP.csm = CSM; RP.csg = CSG; RP.stm = STM; RP.stg = STG; RP.smN = G_smN; RP.smBC = G_smBC; RP.smDM = G_smDM; RP.smMS = G_smMS; RP.smGBE = G_smGBE; RP.ycat = YCAT; \
        RP.mbi = AIN(I_MBI) + l * 4; RP.mbf = AIN(I_MBF) + l * 4; RP.mg = AIN(I_MG) + l * 64; RP.wa2 = AIN(I_WA2) + (size_t)l * 16 * 256; RP.ba = AIN(I_BA) + l * 256; RP.gg = AIN(I_GG) + l * 64;
        if (IN(pb + 0) && PHON(2)) {
            PHASE_IDS(); (void)tid;
            { gm::K1<true> k; k.S.init(NTOK, PP, F.G, (int)blockIdx.x); k.A = U8B; k.Bt = WIN8 + (size_t)l * PP * DM; k.O = PROJ; k.rope = ROPE;
                gm::gemm_phase<gm::K1<true>>(F.lds, k); }
        }
        SEAM(pb + 0);
        if (IN(pb + 1) && PHON(3)) {
            PHASE_IDS();
            MAKE_RP();
            for (int rp = 0; rp < NREP(3); ++rp) {
                LAS unsigned char* wl = F.lds + wid * 16384;
                recw::GWf gwf; recw::ld_gwf(gwf, RP, (gw >> 6) & 3, lane);
                for (int ci = gw; ci < 2048; ci += NGW) { int lane_ = lane; asm volatile("" : "+v"(lane_)); if (PHON(13)) recw::mlstm_local_w(RP, wl, ci, lane_); asm volatile("" ::: "memory"); __builtin_amdgcn_sched_barrier(0); if (PHON(14)) recw::gla_local_w(RP, gwf, wl, ci, lane_); }
            }
        }
        SEAM(pb + 1);
        if (IN(pb + 2) && PHON(4)) {
            PHASE_IDS();
            const int gt = blockIdx.x * 512 + tid, NGT = F.G * 512;
            for (int task = gt; task < 66048; task += NGT) {
                if (task < 32768) {
                    const int bh = task >> 10, el = (task & 1023) * 4; const bf16_t* p = (const bf16_t*)STM + (size_t)bh * 64 * 4096 + el; bf16_t* o = CSM + (size_t)bh * 64 * 4096 + el;
                    const float* bc = G_smBC + bh * 64; const float* dm = G_smDM + bh * 64;
                    f32x4 C = (f32x4){0.f, 0.f, 0.f, 0.f}; float m = 0.f;
#pragma unroll 16
                    for (int c = 0; c < NCH; ++c) { const u32x2 uw = *(const u32x2*)(p + (size_t)c * 4096); const f32x4 u = (f32x4){bflo(uw.x), bfhi(uw.x), bflo(uw.y), bfhi(uw.y)}; u32x2 w; w.x = pk2(C[0], C[1]); w.y = pk2(C[2], C[3]); *(u32x2*)(o + (size_t)c * 4096) = w;
                        if (el == 0) G_smMS[bh * 64 + c] = m;
                        const float B = bc[c], Dm = dm[c], mn = fmaxf(B + m, Dm); C = C * fexp(B + m - mn) + u * fexp(Dm - mn); m = mn; }
                } else if (task < 65536) {
                    const int t2 = task - 32768, bh = t2 >> 10, el = (t2 & 1023) * 4, d = el & 63; const bf16_t* p = (const bf16_t*)STG + (size_t)bh * 64 * 4096 + el; bf16_t* o = CSG + (size_t)bh * 64 * 4096 + el;
                    const float* be = G_smGBE + (size_t)bh * 64 * 64 + d;
                    f32x4 S = (f32x4){0.f, 0.f, 0.f, 0.f};
#pragma unroll 16
                    for (int c = 0; c < NCH; ++c) { const u32x2 uw = *(const u32x2*)(p + (size_t)c * 4096); const f32x4 u = (f32x4){bflo(uw.x), bfhi(uw.x), bflo(uw.y), bfhi(uw.y)}; const f32x4 b4 = *(const f32x4*)(be + c * 64);
                        u32x2 w; w.x = pk2(S[0], S[1]); w.y = pk2(S[2], S[3]); *(u32x2*)(o + (size_t)c * 4096) = w;
                        S = (f32x4){fexp(b4[0]) * S[0] + u[0], fexp(b4[1]) * S[1] + u[1], fexp(b4[2]) * S[2] + u[2], fexp(b4[3]) * S[3] + u[3]}; }
                } else {
                    const int t3 = task - 65536, bh = t3 >> 4, el = (t3 & 15) * 4; float* p = G_smN + (size_t)bh * 64 * 64 + el; const float* bc = G_smBC + bh * 64; const float* dm = G_smDM + bh * 64;
                    f32x4 C = (f32x4){0.f, 0.f, 0.f, 0.f}; float m = 0.f;
#pragma unroll 8
                    for (int c = 0; c < NCH; ++c) { const f32x4 u = *(const f32x4*)(p + c * 64); *(f32x4*)(p + c * 64) = C;
                        const float B = bc[c], Dm = dm[c], mn = fmaxf(B + m, Dm); C = C * fexp(B + m - mn) + u * fexp(Dm - mn); m = mn; }
                }
            }
            for (int rp = 0; rp < NREP(13); ++rp) {
                LAS float* scr = (LAS float*)(F.lds + 49152 + wid * 8704);
                constexpr int I_G = (DM / 64) * (1024 / 32), I_D = (DE / 64) * (DM / 32);
                auto dece = [&](int it, TrD& d) { const int e = it / (I_G + I_D); int r = it % (I_G + I_D); d.wsc = W8S; d.dst8 = nullptr;
                    if (r < I_G) { const int kb = r / 32, nb = r % 32, n0 = nb * 32, tt = n0 >> 8, rr = n0 & 255;
                        d.src = (rr < 128 ? AIN(I_EWG) : AIN(I_EWU)) + ((size_t)l * NE + e) * DM * DE + (size_t)(kb * 64) * DE + tt * 128 + (rr & 127); d.ldw = DE; d.K = DM; d.dst = (bf16_t*)(WGU8 + (size_t)e * 1024 * 1024); d.drow0 = n0; d.k0 = kb * 64; }
                    else { r -= I_G; const int kb = r / 32, nb = r % 32;
                        d.src = AIN(I_EWD) + ((size_t)l * NE + e) * DE * DM + (size_t)(kb * 64) * DM + nb * 32; d.ldw = DM; d.K = DE; d.dst = (bf16_t*)(WD8 + (size_t)e * 1024 * 512); d.drow0 = nb * 32; d.k0 = kb * 64; } };
                TrD dc, dn; f32x4 vc[8], vn[8]; int it = gw; dece(it, dc); tr_load4(dc, vc, lane); dn = dc;
#pragma unroll
                for (int i = 0; i < 8; ++i) vn[i] = vc[i];
                for (; it < NE * (I_G + I_D); it += NGW) { const int itn = it + NGW;
                    if (itn < NE * (I_G + I_D)) { dece(itn, dn); tr_load4(dn, vn, lane); }
                    tr_finish8(dc, vc, scr, lane);
                    dc = dn;
#pragma unroll
                    for (int i = 0; i < 8; ++i) vc[i] = vn[i]; }
            }
        }
        SEAM(pb + 2);
        if (IN(pb + 3) && PHON(5)) {
            PHASE_IDS();
            if (PHON(10)) {
                float d1 = 0.f, d2 = 0.f;
                for (int i = 0; i < 32; ++i) { d1 += AIN(I_LQ1)[l * 32 + i] * AIN(I_LK1)[l * 32 + i]; d2 += AIN(I_LQ2)[l * 32 + i] * AIN(I_LK2)[l * 32 + i]; }
                const float lam_init = 0.8f - 0.6f * expf(-0.3f * (float)l);
                attn_body::AttnParams AP; AP.Q = (const attn_body::bf16*)(PROJ + C_DQ); AP.K = (const attn_body::bf16*)(PROJ + C_DK); AP.V = (const attn_body::bf16*)(PROJ + C_DV);
                AP.zpage = (const attn_body::bf16*)(F.ctl + CW_ZPAGE); AP.Y = (bf16_t*)((unsigned char*)YCAT + 512); AP.gnorm = AIN(I_DG) + l * 64; AP.lam = expf(d1) - expf(d2) + lam_init; AP.osc = 1.f - lam_init;
                const int bh = F.vcu >> 3, s = F.vcu & 7;
                if (F.G == 256) {
                    for (int rp = 0; rp < NREP(10); ++rp)
                    for (int i = 0; i < 2; ++i) { const int qb = (i == 0) ? s : 15 - s;
                        attn_body::attn_unit<8, 0>(bh >> 2, bh & 3, qb, AP, (char*)lds_raw); attn_body::attn_unit<8, 1>(bh >> 2, bh & 3, qb, AP, (char*)lds_raw); }
                }
            }
            __syncthreads();
            {
            PHASE_IDS();
            MAKE_RP();
            if (PHON(11)) for (int rp = 0; rp < NREP(11); ++rp) {
                LAS unsigned char* wl = F.lds + wid * 16384;
                LAS u32x4* gst = (LAS u32x4*)(wl + 10240);
                { recw::GWf gwf; recw::ld_gwf(gwf, RP, (gw >> 6) & 3, lane);
#pragma unroll
                  for (int Td = 0; Td < 4; ++Td) gst[Td * 64 + lane] = __builtin_bit_cast(u32x4, gwf.Bw[Td]);
                  gst[256 + lane] = __builtin_bit_cast(u32x4, ((f32x4){gwf.ba[0], gwf.ba[1], gwf.ba[2], gwf.ba[3]})); }
                for (int ci = gw; ci < 2048; ci += NGW) { int lane_ = lane; asm volatile("" : "+v"(lane_)); if (PHON(13)) recw::mlstm_out_w(RP, wl, ci, lane_); asm volatile("" ::: "memory"); __builtin_amdgcn_sched_barrier(0);
                    if (PHON(14)) { recw::GWf gwf;
#pragma unroll
                        for (int Td = 0; Td < 4; ++Td) gwf.Bw[Td] = __builtin_bit_cast(bf16x8, gst[Td * 64 + lane_]);
                        const f32x4 bb = __builtin_bit_cast(f32x4, gst[256 + lane_]); gwf.ba[0] = bb[0]; gwf.ba[1] = bb[1]; gwf.ba[2] = bb[2]; gwf.ba[3] = bb[3];
                        recw::gla_out_w(RP, gwf, wl, ci, lane_); } }
            }
            __syncthreads();
            if (PHON(12)) for (int rp = 0; rp < NREP(12); ++rp) {
                const float* cw = AIN(I_CONVW) + (size_t)l * 3 * 256; const float* cbias = AIN(I_CONVB) + l * 256;
                for (int it = F.vcu; it < NTOK / 64; it += F.G) {
                    for (int p = tid; p < 64 * 32; p += 512) { const int r = p >> 5, chn = p & 31, row = it * 64 + r, t = row & (SEQ - 1);
                        const bf16_t* pr = PROJ + (size_t)row * PP + chn * 8;
                        float s0[8], s1[8], s2[8], cbv[8];
                        { float a[8], bq[8]; rec::unpack8(*(const u32x4*)(pr + C_CC), a); rec::unpack8(*(const u32x4*)(pr + C_CH), bq);
#pragma unroll
                          for (int i = 0; i < 8; ++i) s2[i] = a[i] * bq[i]; }
                        if (t >= 1) { float a[8], bq[8]; rec::unpack8(*(const u32x4*)(pr - PP + C_CC), a); rec::unpack8(*(const u32x4*)(pr - PP + C_CH), bq);
#pragma unroll
                          for (int i = 0; i < 8; ++i) s1[i] = a[i] * bq[i]; } else {
#pragma unroll
                          for (int i = 0; i < 8; ++i) s1[i] = 0.f; }
                        if (t >= 2) { float a[8], bq[8]; rec::unpack8(*(const u32x4*)(pr - 2 * PP + C_CC), a); rec::unpack8(*(const u32x4*)(pr - 2 * PP + C_CH), bq);
#pragma unroll
                          for (int i = 0; i < 8; ++i) s0[i] = a[i] * bq[i]; } else {
#pragma unroll
                          for (int i = 0; i < 8; ++i) s0[i] = 0.f; }
                        rec::unpack8(*(const u32x4*)(pr + C_CB), cbv);
                        float y[8];
#pragma unroll
                        for (int i = 0; i < 8; ++i) { const int cch = chn * 8 + i; y[i] = cbv[i] * (cw[cch] * s0[i] + cw[256 + cch] * s1[i] + cw[512 + cch] * s2[i] + cbias[cch]); }
                        u32x2 w; w.x = pk4_fp8(y[0] * Y8S, y[1] * Y8S, y[2] * Y8S, y[3] * Y8S); w.y = pk4_fp8(y[4] * Y8S, y[5] * Y8S, y[6] * Y8S, y[7] * Y8S);
                        *(u32x2*)((unsigned char*)YCAT + (size_t)row * DM + 256 + chn * 8) = w; }
                }
            }
            }
        }
        SEAM(pb + 3);
        if (IN(pb + 4) && PHON(6)) {
            PHASE_IDS(); (void)tid;
            gm::K2 k; k.S.init(NTOK, DM, F.G, (int)blockIdx.x); k.A = (const unsigned char*)YCAT; k.Bt = (const unsigned char*)WOUT + (size_t)l * DM * DM; k.O = UB;
            for (int rp = 0; rp < NREP(6); ++rp) gm::gemm_phase<gm::K2>(F.lds, k);
        }
        SEAM(pb + 4);
        if (IN(pb + 5) && PHON(7)) {
            PHASE_IDS();
            NarrowT NT_; nmm_load_router(NT_, AIN(I_RW), wid, lane);
            LAS bf16_t* Sst = (LAS bf16_t*)F.lds; LAS float* Pb = (LAS float*)(F.lds + NMM_P_OFF); LAS float* lgs_all = (LAS float*)(F.lds + NMM_LG_OFF);
            LAS float* lgs = lgs_all + wid * 256;
            const int b = F.vcu >> 5; const float* md = modl + (size_t)b * 6144;
            const float* lg = AIN(I_LN1G) + l * DM; const float* lb = AIN(I_LN1B) + l * DM;
            f32x4 gv[4], bv[4], sh[4], sc[4], g1[4];
#pragma unroll
            for (int j = 0; j < 4; ++j) { const int cix = 4 * lane + 256 * j; gv[j] = *(const f32x4*)(lg + cix); bv[j] = *(const f32x4*)(lb + cix); g1[j] = *(const f32x4*)(md + 2 * 1024 + cix) + 1.0f;
                sh[j] = *(const f32x4*)(md + 3 * 1024 + cix); sc[j] = *(const f32x4*)(md + 4 * 1024 + cix) + 1.0f; }
            const int rowb = F.vcu * 128 + wid * 16;
            u32x2 xwc[4], ywc[4];
#pragma unroll
            for (int j = 0; j < 4; ++j) { const size_t o = (size_t)rowb * DM + 4 * lane + 256 * j; xwc[j] = (l == 0) ? (u32x2){0u, 0u} : *(const u32x2*)(XB + o); ywc[j] = *(const u32x2*)(UB + o); }
            u32x2 xwn[4] = {xwc[0], xwc[1], xwc[2], xwc[3]}, ywn[4] = {ywc[0], ywc[1], ywc[2], ywc[3]};
            for (int i = 0; i < 16; ++i) { const int row = rowb + i;
                if (i < 15) {
#pragma unroll
                    for (int j = 0; j < 4; ++j) { const size_t o = (size_t)(row + 1) * DM + 4 * lane + 256 * j; if (l != 0) xwn[j] = *(const u32x2*)(XB + o); ywn[j] = *(const u32x2*)(UB + o); } }
                f32x4 v[4]; float s = 0.f;
#pragma unroll
                for (int j = 0; j < 4; ++j) { const size_t o = (size_t)row * DM + 4 * lane + 256 * j;
                    f32x4 xv; if (l == 0) xv = *(const f32x4*)(x_in + o); else { const u32x2 xw = xwc[j]; xv = (f32x4){bflo(xw.x), bfhi(xw.x), bflo(xw.y), bfhi(xw.y)}; }
                    const u32x2 yw = ywc[j]; const f32x4 yv = (f32x4){bflo(yw.x), bfhi(yw.x), bflo(yw.y), bfhi(yw.y)};
                    v[j] = xv * ALPHA + g1[j] * yv; s += (v[j][0] + v[j][1]) + (v[j][2] + v[j][3]); }
#pragma unroll
                for (int j = 0; j < 4; ++j) { xwc[j] = xwn[j]; ywc[j] = ywn[j]; }
                const float mean = wave_sum(s) * (1.f / DM); float s2 = 0.f;
#pragma unroll
                for (int j = 0; j < 4; ++j) { v[j] = v[j] - mean; s2 += (v[j][0] * v[j][0] + v[j][1] * v[j][1]) + (v[j][2] * v[j][2] + v[j][3] * v[j][3]); }
                const float rstd = __builtin_amdgcn_rsqf(wave_sum(s2) * (1.f / DM) + LN_EPS);
#pragma unroll
                for (int j = 0; j < 4; ++j) { const size_t o = (size_t)row * DM + 4 * lane + 256 * j; const f32x4 xn = v[j] * rstd * gv[j] + bv[j];
                    u32x2 xw; xw.x = pk2(xn[0], xn[1]); xw.y = pk2(xn[2], xn[3]); *(u32x2*)(XB + o) = xw;
                    const f32x4 u = xn * sc[j] + sh[j]; u32x2 w; w.x = pk2(u[0], u[1]); w.y = pk2(u[2], u[3]); *(LAS u32x2*)(Sst + (wid * 4 + (i & 3)) * NSP + 4 * lane + 256 * j) = w;
                    *(unsigned*)(U8B + o) = pk4_fp8(u[0], u[1], u[2], u[3]); }
                if ((i & 3) == 3) nmm_step_router(NT_, Sst, Pb, lgs_all, i - 3, tid, wid, lane);
            }
            asm volatile("s_waitcnt lgkmcnt(0)\n\ts_barrier" ::: "memory");
            if (lane < 16) {
                const int row = rowb + lane; const float* rb = AIN(I_RB);
                float sco[16], bia[16];
#pragma unroll
                for (int q = 0; q < 4; ++q) { const f32x4 t4 = *(const LAS f32x4*)(lgs + lane * 16 + q * 4);
#pragma unroll
                    for (int c = 0; c < 4; ++c) { const float sg = 1.f / (1.f + fexp(-t4[c])); sco[q * 4 + c] = sg; bia[q * 4 + c] = sg + rb[q * 4 + c]; } }
                int bg = 0; float bgs = -INFINITY;
#pragma unroll
                for (int g = 0; g < 4; ++g) { const float a0 = bia[4 * g], a1 = bia[4 * g + 1], a2 = bia[4 * g + 2], a3 = bia[4 * g + 3];
                    const float h1 = fmaxf(a0, a1), l1 = fminf(a0, a1), h2 = fmaxf(a2, a3), l2 = fminf(a2, a3);
                    const float top = fmaxf(h1, h2), sec = fmaxf(fminf(h1, h2), (h1 >= h2) ? l1 : l2); const float gsc = top + sec;
                    if (gsc > bgs) { bgs = gsc; bg = g; } }
                float gb[4], gsx[4];
#pragma unroll
                for (int q = 0; q < 4; ++q) { gb[q] = (bg == 0) ? bia[q] : (bg == 1) ? bia[4 + q] : (bg == 2) ? bia[8 + q] : bia[12 + q]; gsx[q] = (bg == 0) ? sco[q] : (bg == 1) ? sco[4 + q] : (bg == 2) ? sco[8 + q] : sco[12 + q]; }
                int e1 = 0; float m1 = gb[0];
#pragma unroll
                for (int q = 1; q < 4; ++q) if (gb[q] > m1) { m1 = gb[q]; e1 = q; }
                int e2 = -1; float m2 = -INFINITY;
#pragma unroll
                for (int q = 0; q < 4; ++q) if (q != e1 && gb[q] > m2) { m2 = gb[q]; e2 = q; }
                const int ei = e1 < e2 ? e1 : e2, ej = e1 < e2 ? e2 : e1;
                const float si = (ei == 0) ? gsx[0] : (ei == 1) ? gsx[1] : (ei == 2) ? gsx[2] : gsx[3], sj = (ej == 0) ? gsx[0] : (ej == 1) ? gsx[1] : (ej == 2) ? gsx[2] : gsx[3];
                const int pr_ = (ei == 0) ? ej - 1 : (ei == 1) ? ej + 1 : 5; const int bk = bg * 6 + pr_;
                gu32* cntw = F.ctl + CW_CNT + (size_t)l * NBUCKET * 64;
                const unsigned pos = __hip_atomic_fetch_add(cntw + bk * 64, 1u, RLX_AGENT);
                LTOK[(size_t)bk * LCAP + pos] = row; const float inv = 1.f / (si + sj); LGATE[((size_t)bk * LCAP + pos) * 2] = si * inv; LGATE[((size_t)bk * LCAP + pos) * 2 + 1] = sj * inv;
                TOKSLOT[row] = (bk << 16) | (int)pos;
            }
            __syncthreads();
        }
        SEAM(pb + 5);
        if ((IN(pb + 6) || IN(pb + 7)) && PHON(8)) {
            PHASE_IDS();
            LAS int* tb = (LAS int*)(F.lds + MOE_TB_OFF);
            if (tid == 0) { gu32* cntw = F.ctl + CW_CNT + (size_t)l * NBUCKET * 64; int acc = 0;
                for (int k = 0; k < NBUCKET; ++k) { const int c = (int)__hip_atomic_load(cntw + k * 64, RLX_AGENT); tb[k] = c; tb[32 + k] = acc; acc += (c + 255) >> 8; }
                tb[32 + NBUCKET] = acc; }
            __syncthreads();
            if (IN(pb + 6)) {
                gm::K4 k; k.U = U8B; k.Wgu = WGU8; k.H = H8B; k.ltok = LTOK; k.lgate = LGATE; k.tb = tb; k.G = F.G; k.vcu = F.vcu; k.rtc = F.ctl + CW_RT + (size_t)l * 160 * 64;
                for (int rp = 0; rp < NREP(8); ++rp) gm::gemm_phase<gm::K4>(F.lds, k);
            }
            SEAM(pb + 6);
            if (IN(pb + 7)) {
                gm::K5 k; k.H = H8B; k.Wd = WD8; k.Y = YSORT; k.tb = tb; k.G = F.G; k.vcu = F.vcu; k.rtc = F.ctl + CW_RT + (size_t)l * 160 * 64; k.tmo = F.ctl + CW_TMO;
                for (int rp = 0; rp < NREP(14); ++rp) gm::gemm_phase<gm::K5>(F.lds, k);
            }
        }
        SEAM(pb + 7);
        if (IN(pb + 8) && PHON(9)) {
            PHASE_IDS();
            const int b = F.vcu >> 5; const bool lastl = (l == DEPTH - 1);
            LAS bf16_t* Sst = (LAS bf16_t*)F.lds; LAS float* Pb = (LAS float*)(F.lds + NMM_P_OFF); LAS int* t0 = (LAS int*)(F.lds + MOE_TB_OFF);
            NarrowT NT_; nmm_load_tail(NT_, WIN + ((size_t)(lastl ? l : l + 1) * PW + PP) * DM, wid, lane);
            if (tid == 0) { gu32* cntw = F.ctl + CW_CNT + (size_t)l * NBUCKET * 64; int acc = 0;
                for (int k = 0; k < NBUCKET; ++k) { const int c = (int)__hip_atomic_load(cntw + k * 64, RLX_AGENT); t0[32 + k] = acc; acc += (c + 255) >> 8; } }
            __syncthreads();
            const float* mdn = MOD + ((size_t)(lastl ? l : l + 1) * NB + b) * 6144; const float* md = modl + (size_t)b * 6144;
            const float* lg = AIN(I_LN2G) + l * DM; const float* lb = AIN(I_LN2B) + l * DM;
            f32x4 gv[4], bv[4], sh[4], sc[4], g2[4];
#pragma unroll
            for (int j = 0; j < 4; ++j) { const int cix = 4 * lane + 256 * j; gv[j] = *(const f32x4*)(lg + cix); bv[j] = *(const f32x4*)(lb + cix); g2[j] = *(const f32x4*)(md + 5 * 1024 + cix) + 1.0f;
                sh[j] = *(const f32x4*)(mdn + cix); sc[j] = *(const f32x4*)(mdn + 1024 + cix) + 1.0f; }
            const int rowb = F.vcu * 128 + wid * 16;
            const int tsl = TOKSLOT[rowb + (lane & 15)];
            u32x2 xwc[4], ywc[4];
            { const int ts = __shfl(tsl, 0); const size_t yrow = (size_t)t0[32 + (ts >> 16)] * 256 + (ts & 0xffff);
#pragma unroll
              for (int j = 0; j < 4; ++j) { const int cix = 4 * lane + 256 * j; xwc[j] = *(const u32x2*)(XB + (size_t)rowb * DM + cix); ywc[j] = *(const u32x2*)(YSORT + yrow * DM + cix); } }
            u32x2 xwn[4] = {xwc[0], xwc[1], xwc[2], xwc[3]}, ywn[4] = {ywc[0], ywc[1], ywc[2], ywc[3]};
            for (int i = 0; i < 16; ++i) { const int row = rowb + i;
                if (i < 15) { const int ts = __shfl(tsl, i + 1); const size_t yrow = (size_t)t0[32 + (ts >> 16)] * 256 + (ts & 0xffff);
#pragma unroll
                    for (int j = 0; j < 4; ++j) { const int cix = 4 * lane + 256 * j; xwn[j] = *(const u32x2*)(XB + (size_t)(row + 1) * DM + cix); ywn[j] = *(const u32x2*)(YSORT + yrow * DM + cix); } }
                f32x4 v[4]; float s = 0.f;
#pragma unroll
                for (int j = 0; j < 4; ++j) {
                    const u32x2 xw = xwc[j]; const f32x4 xv = (f32x4){bflo(xw.x), bfhi(xw.x), bflo(xw.y), bfhi(xw.y)};
                    const u32x2 yw = ywc[j]; const f32x4 yv = (f32x4){bflo(yw.x), bfhi(yw.x), bflo(yw.y), bfhi(yw.y)};
                    v[j] = xv * ALPHA + g2[j] * yv; s += (v[j][0] + v[j][1]) + (v[j][2] + v[j][3]); }
#pragma unroll
                for (int j = 0; j < 4; ++j) { xwc[j] = xwn[j]; ywc[j] = ywn[j]; }
                const float mean = wave_sum(s) * (1.f / DM); float s2 = 0.f;
#pragma unroll
                for (int j = 0; j < 4; ++j) { v[j] = v[j] - mean; s2 += (v[j][0] * v[j][0] + v[j][1] * v[j][1]) + (v[j][2] * v[j][2] + v[j][3] * v[j][3]); }
                const float rstd = __builtin_amdgcn_rsqf(wave_sum(s2) * (1.f / DM) + LN_EPS);
#pragma unroll
                for (int j = 0; j < 4; ++j) { const size_t o = (size_t)row * DM + 4 * lane + 256 * j; const f32x4 xn = v[j] * rstd * gv[j] + bv[j];
                    if (lastl) *(f32x4*)(ap->out + o) = xn;
                    else { u32x2 xw; xw.x = pk2(xn[0], xn[1]); xw.y = pk2(xn[2], xn[3]); *(u32x2*)(XB + o) = xw;
                        const f32x4 u = xn * sc[j] + sh[j]; u32x2 w; w.x = pk2(u[0], u[1]); w.y = pk2(u[2], u[3]); *(LAS u32x2*)(Sst + (wid * 4 + (i & 3)) * NSP + 4 * lane + 256 * j) = w;
                        *(unsigned*)(U8B + o) = pk4_fp8(u[0], u[1], u[2], u[3]); } }
                if (!lastl && (i & 3) == 3) nmm_step_tail(NT_, Sst, Pb, TAILB + (size_t)(F.vcu * 128) * 32, i - 3, tid, wid, lane);
            }
        }
        SEAM(pb + 8);
    }
#undef IN
#undef SEAM
}

extern "C" void kernel_launch(void* const* d_in, const int* in_sizes, int n_in, void* d_out, int out_size, void* d_ws, size_t ws_size, hipStream_t stream) {
    static int grid = 0;
    if (grid == 0) {
        if (n_in != 29 || in_sizes[0] != NTOK * DM || out_size != NTOK * DM || ws_size < WS_END) {
            fprintf(stderr, "kernel_launch: unexpected shapes (n_in %d, in0 %d, out %d, ws %zu need %zu); nothing launched\n", n_in, n_in > 0 ? in_sizes[0] : -1, out_size, ws_size, (size_t)WS_END); grid = -1; return; }
        int dev = 0, cus = 0, per_cu = 0;
        if (hipGetDevice(&dev) != hipSuccess || hipDeviceGetAttribute(&cus, hipDeviceAttributeMultiprocessorCount, dev) != hipSuccess) { grid = -1; return; }
        if (hipFuncSetAttribute((const void*)mega_fwd, hipFuncAttributeMaxDynamicSharedMemorySize, LDS_BYTES) != hipSuccess) { fprintf(stderr, "kernel_launch: hipFuncSetAttribute failed\n"); grid = -1; return; }
        if (hipOccupancyMaxActiveBlocksPerMultiprocessor(&per_cu, (const void*)mega_fwd, 512, LDS_BYTES) != hipSuccess || per_cu < 1) { fprintf(stderr, "kernel_launch: occupancy query reports %d\n", per_cu); }
        (void)hipGetLastError();
        grid = cus;
        if (grid != 256) fprintf(stderr, "kernel_launch: %d CUs (row phases assume 256)\n", grid);
    }
    if (grid < 0) return;
    if (hipMemsetAsync((char*)d_ws + WS_CTL, 0, CTL_ZERO_BYTES, stream) != hipSuccess) return;
    Args a{};
    for (int i = 0; i < 29; ++i) a.in[i] = (const float*)d_in[i];
    a.out = (float*)d_out; a.ws = (unsigned char*)d_ws;
#if MK_ONE_LAUNCH
    a.ph_lo = 0; a.ph_hi = N_PHASES;
    hipLaunchKernelGGL(mega_fwd, dim3(grid), dim3(512), LDS_BYTES, stream, a);
#else
    for (int p = 0; p < N_PHASES; ++p) { a.ph_lo = p; a.ph_hi = p + 1; hipLaunchKernelGGL(mega_fwd, dim3(grid), dim3(512), LDS_BYTES, stream, a); }
#endif
}
```

```cpp
#include <hip/hip_runtime.h>
#include <hip/hip_bf16.h>
#include <cstdio>
#include <cstdint>
#include <cmath>

#ifndef MK_ONE_LAUNCH
#define MK_ONE_LAUNCH 1
#endif
#ifndef PHM
#define PHM 0xFFFF
#endif
#define PHON(n) (((PHM) >> (n)) & 1)
#ifndef REPM
#define REPM 0
#endif
#define NREP(n) ((((REPM) >> (n)) & 1) ? 2 : 1)

#define LAS __attribute__((address_space(3)))
#define GAS __attribute__((address_space(1)))
typedef unsigned short bf16_t;
typedef short bf16x8 __attribute__((ext_vector_type(8)));
typedef float f32x4 __attribute__((ext_vector_type(4)));
typedef float f32x2 __attribute__((ext_vector_type(2)));
typedef unsigned u32x4 __attribute__((ext_vector_type(4)));
typedef unsigned u32x2 __attribute__((ext_vector_type(2)));
typedef GAS unsigned gu32;

constexpr int NB = 8, SEQ = 4096, NTOK = NB * SEQ, DM = 1024, DEPTH = 4, NH = 4, HD = 64, PIN = 3608, PP = 3584, PW = 3840, NE = 16, DE = 512;
constexpr int NCH = SEQ / 64;
constexpr float ALPHA = 1.6817928305074290f;
constexpr float LN_EPS = 1e-6f;
constexpr float ATT_C2 = 0.17677669529663687f * 1.4426950408889634f;
constexpr int NBUCKET = 24, LCAP = NTOK;
constexpr int C_MQ = 0, C_MK = 256, C_MV = 512, C_MO = 768, C_CB = 1024, C_CC = 1280, C_CH = 1536, C_DQ = 1792, C_DK = 2048, C_DV = 2304,
              C_GQ = 2560, C_GK = 2816, C_GV = 3072, C_GR = 3328;
constexpr int T_GA = 0, T_MI = 16, T_MF = 20;

constexpr size_t MiB = 1u << 20;
constexpr size_t WS_CTL = 0, CTL_ZERO_BYTES = 1 * MiB;
constexpr size_t WS_MOD = 1 * MiB;
constexpr size_t WS_ROPE = 2 * MiB;
constexpr size_t WS_WIN = 3 * MiB;
constexpr size_t WS_WOUT = 33 * MiB;
constexpr size_t WS_WGU = 41 * MiB;
constexpr size_t WS_WD = 73 * MiB;
constexpr size_t WS_LTOK = 89 * MiB;
constexpr size_t WS_LGATE = 92 * MiB;
constexpr size_t WS_SM = 98 * MiB;
constexpr size_t WS_PROJ = 100 * MiB;
constexpr size_t WS_XR = 340 * MiB;
constexpr size_t WS_U = 468 * MiB;
constexpr size_t WS_YCAT = 532 * MiB;
constexpr size_t WS_TAIL = 596 * MiB;
constexpr size_t WS_YSORT = WS_PROJ + 100 * MiB;
constexpr size_t WS_U8 = 600 * MiB;
constexpr size_t WS_WIN8 = 632 * MiB;
constexpr size_t WS_END = 648 * MiB;
constexpr size_t SM_N = 0, SM_BC = 512 * 1024, SM_DM = 520 * 1024, SM_MS = 528 * 1024, SM_GBE = 1 * MiB, SM_TS = 1536 * 1024;
constexpr int CW_TMO = 0, CW_CODE = 1, CW_ZPAGE = 256, CW_BAR = 4096, CW_CNT = 16384, CW_RT = 24576;
constexpr int RING_BYTES = 131072, LDSCTL_OFF = RING_BYTES, MISC_OFF = LDSCTL_OFF + 320, MOE_TB_OFF = LDSCTL_OFF + 1024, LDS_BYTES = 147456;

#define RLX_AGENT __ATOMIC_RELAXED, __HIP_MEMORY_SCOPE_AGENT
#define LDS_WAIT() asm volatile("s_waitcnt lgkmcnt(0)" ::: "memory")
#define VM_WAIT() asm volatile("s_waitcnt vmcnt(0)" ::: "memory")

__device__ __forceinline__ unsigned f2bf(float f) { unsigned u = __builtin_bit_cast(unsigned, f); return (u + 0x7fffu + ((u >> 16) & 1u)) >> 16; }
__device__ __forceinline__ unsigned pk2(float lo, float hi) { typedef __bf16 bf2 __attribute__((ext_vector_type(2))); f32x2 v = {lo, hi}; bf2 b = __builtin_convertvector(v, bf2); return __builtin_bit_cast(unsigned, b); }
__device__ __forceinline__ unsigned pk4_fp8(float a, float b, float c, float d) {
    a = __builtin_amdgcn_fmed3f(a, -448.f, 448.f); b = __builtin_amdgcn_fmed3f(b, -448.f, 448.f); c = __builtin_amdgcn_fmed3f(c, -448.f, 448.f); d = __builtin_amdgcn_fmed3f(d, -448.f, 448.f);
    int w = 0; w = __builtin_amdgcn_cvt_pk_fp8_f32(a, b, w, false); w = __builtin_amdgcn_cvt_pk_fp8_f32(c, d, w, true); return (unsigned)w; }
__device__ __forceinline__ void st8_wt(void* p, u32x2 v) { asm volatile("global_store_dwordx2 %0, %1, off sc1\n\ts_nop 0" :: "v"(p), "v"(v) : "memory"); }
constexpr float W8S = 64.f, H8S = 16.f, Y8S = 8.f;
__device__ __forceinline__ float bf2f(unsigned b) { return __builtin_bit_cast(float, b << 16); }
__device__ __forceinline__ float bflo(unsigned w) { return __builtin_bit_cast(float, w << 16); }
__device__ __forceinline__ float bfhi(unsigned w) { return __builtin_bit_cast(float, w & 0xffff0000u); }
__device__ __forceinline__ void st16_wt(void* p, u32x4 v) { asm volatile("global_store_dwordx4 %0, %1, off sc1\n\ts_nop 1" :: "v"(p), "v"(v) : "memory"); }
__device__ __forceinline__ float wave_sum(float v) {
#pragma unroll
    for (int o = 1; o < 64; o <<= 1) v += __shfl_xor(v, o);
    return v;
}
__device__ __forceinline__ float wave_max(float v) {
#pragma unroll
    for (int o = 1; o < 64; o <<= 1) v = fmaxf(v, __shfl_xor(v, o));
    return v;
}
__device__ __forceinline__ float fexp(float x) { return __builtin_amdgcn_exp2f(x * 1.4426950408889634f); }
__device__ __forceinline__ float flog(float x) { return __builtin_amdgcn_logf(x) * 0.6931471805599453f; }
__device__ __forceinline__ float logsig(float z) { return fminf(z, 0.f) - flog(1.f + fexp(-fabsf(z))); }
__device__ __forceinline__ float sigmoidf_(float z) { return 1.f / (1.f + fexp(-z)); }

#define XB_TMO      128
#define XB_XCNT(j)  (256  + 64 * (j))
#define XB_XSUB(j)  (1280 + 64 * (j))
#define XB_XGEN(j)  (2304 + 64 * (j))
#define XB_TOP      3328
#define XB_TOPGEN   3392
#define XCD_BAR_WORDS 3456
#define XB_SPIN_CAP (1u << 18)
__device__ __forceinline__ unsigned xb_ld(unsigned* p)              { return __hip_atomic_load(p, __ATOMIC_RELAXED, __HIP_MEMORY_SCOPE_AGENT); }
__device__ __forceinline__ unsigned xb_add(unsigned* p, unsigned v) { return __hip_atomic_fetch_add(p, v, __ATOMIC_RELAXED, __HIP_MEMORY_SCOPE_AGENT); }
__device__ __forceinline__ unsigned xb_xcc_id() { return (unsigned)__builtin_amdgcn_s_getreg((3 << 11) | 20) & 0xFu; }
#define XB_SPIN(cond, bar) do { unsigned _sp = 0; while (cond) { __builtin_amdgcn_s_sleep(1); \
    if ((++_sp & 255u) == 0u) { if (xb_ld(&(bar)[XB_TMO])) break; if (_sp > XB_SPIN_CAP) { atomicAdd(&(bar)[XB_TMO], 1u); break; } } } } while (0)
struct XcdBarrier { unsigned* bar; unsigned x; volatile LAS unsigned* st; };
__device__ __forceinline__ XcdBarrier xcd_barrier_post(unsigned* bar, volatile LAS unsigned* st) {
    XcdBarrier b; b.bar = bar; b.x = xb_xcc_id(); b.st = st;
    if (threadIdx.x == 0) (void)xb_add(&bar[XB_XCNT(b.x)], 1u);
    return b;
}
__device__ __forceinline__ void xcd_barrier_complete(unsigned* bar, unsigned x, unsigned& nloc, unsigned& nx) {
    const unsigned G = gridDim.x * gridDim.y * gridDim.z;
    unsigned sum, cnt, mine, sp = 0u;
    for (;;) {
        sum = 0u; cnt = 0u; mine = 0u;
#pragma unroll
        for (unsigned j = 0; j < 16; ++j) { const unsigned c = xb_ld(&bar[XB_XCNT(j)]); sum += c; cnt += (c > 0u) ? 1u : 0u; mine = (j == x) ? c : mine; }
        if (sum == G) break;
        __builtin_amdgcn_s_sleep(1);
        if ((++sp & 255u) == 0u) { if (xb_ld(&bar[XB_TMO])) break; if (sp > XB_SPIN_CAP) { atomicAdd(&bar[XB_TMO], 1u); break; } }
    }
    nloc = mine > 0u ? mine : 1u; nx = cnt > 0u ? cnt : 1u;
}
__device__ __forceinline__ void xcd_barrier(const XcdBarrier& b) {
    asm volatile("s_waitcnt vmcnt(0)" ::: "memory");
    __syncthreads();
    if (threadIdx.x == 0) {
        unsigned* bar = b.bar;
        __builtin_amdgcn_s_waitcnt(0);
        unsigned nloc = b.st[0], nx = b.st[1];
        if (nloc == 0u) { xcd_barrier_complete(bar, b.x, nloc, nx); b.st[0] = nloc; b.st[1] = nx; }
        const unsigned old = xb_add(&bar[XB_XSUB(b.x)], 1u);
        const unsigned gen = old / nloc;
        if (old + 1u == (gen + 1u) * nloc) {
            __builtin_amdgcn_fence(__ATOMIC_RELEASE, "agent");
            asm volatile("s_waitcnt vmcnt(0)" ::: "memory");
            const unsigned og = xb_add(&bar[XB_TOP], 1u);
            const unsigned tg = og / nx;
            if (og + 1u == (tg + 1u) * nx) xb_add(&bar[XB_TOPGEN], 1u);
            else XB_SPIN(xb_ld(&bar[XB_TOPGEN]) == tg, bar);
            __builtin_amdgcn_fence(__ATOMIC_ACQUIRE, "agent");
            xb_add(&bar[XB_XGEN(b.x)], 1u);
            asm volatile("s_waitcnt vmcnt(0)" ::: "memory");
        } else {
            XB_SPIN(xb_ld(&bar[XB_XGEN(b.x)]) == gen, bar);
            __builtin_amdgcn_fence(__ATOMIC_ACQUIRE, "agent");
            asm volatile("s_waitcnt vmcnt(0)" ::: "memory");
        }
    }
    __syncthreads();
}

namespace gm {
constexpr int BM = 256, BK = 64, HALF = 128, HTB = HALF * BK * 2, NXCD = 8, WGM = 8;
typedef int v4i_t __attribute__((ext_vector_type(4))); typedef int v8i_t __attribute__((ext_vector_type(8)));
__host__ __device__ __forceinline__ int lds_byte(int r, int c) { const int st = (r >> 4) * 2 + (c >> 5), rr = r & 15, cc = c & 31, ob = rr * 64 + cc * 2; return st * 1024 + (ob ^ (((ob >> 9) & 1) << 5)); }
__host__ __device__ __forceinline__ void stage_rc(int b, int& R, int& C) { const int st = b / 1024, sb = b % 1024, swz = sb ^ (((sb >> 9) & 1) << 5); R = (st >> 1) * 16 + swz / 64; C = (st & 1) * 32 + (swz % 64) / 2; }
__host__ __device__ __forceinline__ int perm32(int rho) { const int n = rho >> 4, i = rho & 15; return 8 * (i >> 2) + 4 * n + (i & 3); }
struct Unit { int pm, pn, bk, tb; };
struct Src { const char* a; const char* b0; const char* b1; unsigned va[2][2]; };
struct StaticOrder {
    int nM, nN, nwg, G, c;
    __device__ void init(int M, int N, int G_, int c_) { nM = M / BM; nN = N / BM; nwg = nM * nN; G = G_; c = c_; }
    __device__ __forceinline__ bool next(int i, Unit& u) const {
        const long L = (long)i * G + c; if (L >= nwg) return false;
        int wgid = (int)L; { const int q = nwg / NXCD, r = nwg % NXCD, xcd = wgid % NXCD, off = wgid / NXCD; wgid = (xcd < r ? xcd * (q + 1) : r * (q + 1) + (xcd - r) * q) + off; }
        const int nig = WGM * nN, gid = wgid / nig, fm = gid * WGM, gsz = (nM - fm) < WGM ? (nM - fm) : WGM;
        u.pm = fm + ((wgid % nig) % gsz); u.pn = (wgid % nig) / gsz; u.bk = 0; u.tb = 0; return true;
    }
};

template <class Kind>
__device__ __forceinline__ void gemm_phase(LAS unsigned char* lds, const Kind& Kd) {
    int tid_ = threadIdx.x; asm volatile("" : "+v"(tid_));
    const int tid = tid_, wid = __builtin_amdgcn_readfirstlane(tid >> 6), lane = tid & 63, wr = wid >> 2, wc = wid & 3, fr = lane & 15, fq = lane >> 4;
    int R[2], C[2]; unsigned voffB[2];
#pragma unroll
    for (int i = 0; i < 2; ++i) { stage_rc(tid * 16 + i * 8192, R[i], C[i]); const int Rb = Kind::PERM ? ((R[i] & ~31) + perm32(R[i] & 31)) : R[i]; voffB[i] = (unsigned)(Rb * Kind::LDBB + C[i] * 2); }
    const size_t hstepB = (size_t)HALF * Kind::LDBB;
    constexpr int NT = Kind::NTK;
    const unsigned ldsw = (unsigned)wid * 1024u;
    const int aoff = lds_byte(wr * 64 + fr, fq * 8), boff = lds_byte(wc * 32 + fr, fq * 8);
#define G_SA(b, h) (((b) * 2 + (h)) * HTB)
#define G_SB(b, h) ((4 + (b) * 2 + (h)) * HTB)
#define G_STAGE_A(bufoff, S, t, h) do { const char* _g = (S).a + (size_t)(t) * 128; _Pragma("unroll") for (int _i = 0; _i < 2; ++_i) \
        __builtin_amdgcn_global_load_lds((const unsigned*)(_g + (S).va[h][_i]), (LAS unsigned*)(lds + (bufoff) + ldsw + _i * 8192), 16, 0, 0); } while (0)
#define G_STAGE_B(bufoff, S, t, h) do { const char* _g = (((t) < NT / 2) ? (S).b0 + (size_t)(t) * 128 : (S).b1 + (size_t)((t) - NT / 2) * 128) + (h) * hstepB; _Pragma("unroll") for (int _i = 0; _i < 2; ++_i) \
        __builtin_amdgcn_global_load_lds((const unsigned*)(_g + voffB[_i]), (LAS unsigned*)(lds + (bufoff) + ldsw + _i * 8192), 16, 0, 0); } while (0)
#define G_LDA(dst, b, h) do { _Pragma("unroll") for (int m = 0; m < 4; ++m) _Pragma("unroll") for (int k = 0; k < 2; ++k) dst[m][k] = *(const LAS bf16x8*)(lds + G_SA(b, h) + aoff + m * 2048 + k * 1024); } while (0)
#define G_LDB(dst, b, h) do { _Pragma("unroll") for (int n = 0; n < 2; ++n) _Pragma("unroll") for (int k = 0; k < 2; ++k) dst[n][k] = *(const LAS bf16x8*)(lds + G_SB(b, h) + boff + n * 2048 + k * 1024); } while (0)
#define G_MMA(ai, bj, At, Bt) do { __builtin_amdgcn_s_setprio(1); _Pragma("unroll") for (int m = 0; m < 4; ++m) _Pragma("unroll") for (int n = 0; n < 2; ++n) _Pragma("unroll") for (int k = 0; k < 2; ++k) \
        acc[ai][bj][m][n] = __builtin_amdgcn_mfma_f32_16x16x32_bf16(Bt[n][k], At[m][k], acc[ai][bj][m][n], 0, 0, 0); __builtin_amdgcn_s_setprio(0); } while (0)
#define G_LDA8(dst, b, h) do { _Pragma("unroll") for (int m = 0; m < 4; ++m) { const v4i_t _lo = *(const LAS v4i_t*)(lds + G_SA(b, h) + aoff + m * 2048), _hi = *(const LAS v4i_t*)(lds + G_SA(b, h) + aoff + m * 2048 + 1024); \
        dst[m] = __builtin_shufflevector(_lo, _hi, 0, 1, 2, 3, 4, 5, 6, 7); } } while (0)
#define G_LDB8(dst, b, h) do { _Pragma("unroll") for (int n = 0; n < 2; ++n) { const v4i_t _lo = *(const LAS v4i_t*)(lds + G_SB(b, h) + boff + n * 2048), _hi = *(const LAS v4i_t*)(lds + G_SB(b, h) + boff + n * 2048 + 1024); \
        dst[n] = __builtin_shufflevector(_lo, _hi, 0, 1, 2, 3, 4, 5, 6, 7); } } while (0)
#define G_MMA8(ai, bj, A8_, B8_) do { __builtin_amdgcn_s_setprio(1); _Pragma("unroll") for (int m = 0; m < 4; ++m) _Pragma("unroll") for (int n = 0; n < 2; ++n) \
        asm volatile("v_mfma_scale_f32_16x16x128_f8f6f4 %0, %1, %2, %0, %3, %3 op_sel_hi:[0,0,0]" : "+v"(acc[ai][bj][m][n]) : "v"(B8_[n]), "v"(A8_[m]), "v"(sc1v)); __builtin_amdgcn_s_setprio(0); } while (0)
#define X_LDA(b, h) do { if constexpr (Kind::FP8) G_LDA8(A8, b, h); else G_LDA(At, b, h); } while (0)
#define X_LDB0(b, h) do { if constexpr (Kind::FP8) G_LDB8(B08, b, h); else G_LDB(B0, b, h); } while (0)
#define X_LDB1(b, h) do { if constexpr (Kind::FP8) G_LDB8(B18, b, h); else G_LDB(B1, b, h); } while (0)
#define X_MM0(ai, bj) do { if constexpr (Kind::FP8) G_MMA8(ai, bj, A8, B08); else G_MMA(ai, bj, At, B0); } while (0)
#define X_MM1(ai, bj) do { if constexpr (Kind::FP8) G_MMA8(ai, bj, A8, B18); else G_MMA(ai, bj, At, B1); } while (0)
#define G_WAIT_V(n) asm volatile("s_waitcnt vmcnt(" #n ")" ::: "memory")
#define G_WAIT_L(n) asm volatile("s_waitcnt lgkmcnt(" #n ")" ::: "memory")
#define G_BAR __builtin_amdgcn_s_barrier()
#define G_SCHED __builtin_amdgcn_sched_barrier(0)
    Unit cur, nxt; Src sc, sn; int ui = 0; int pend = -1;
    if (!Kd.next(0, cur)) return;
    Kd.src(cur, sc, R, C);
    Kd.a_ready(cur, wid);
    f32x4 acc[2][2][4][2];
#pragma unroll
    for (int a = 0; a < 2; ++a)
#pragma unroll
        for (int b = 0; b < 2; ++b)
#pragma unroll
            for (int m = 0; m < 4; ++m)
#pragma unroll
                for (int n = 0; n < 2; ++n) acc[a][b][m][n] = (f32x4){0.f, 0.f, 0.f, 0.f};
    bf16x8 At[4][2], B0[2][2], B1[2][2]; v8i_t A8[4], B08[2], B18[2]; int sc1v = 0x7f7f7f7f; asm volatile("" : "+v"(sc1v));
    G_STAGE_B(G_SB(0, 0), sc, 0, 0); G_STAGE_B(G_SB(0, 1), sc, 0, 1); G_STAGE_A(G_SA(0, 0), sc, 0, 0); G_STAGE_A(G_SA(0, 1), sc, 0, 1);
    if (wr == 1) G_BAR;
    G_WAIT_V(2); G_BAR;
    G_STAGE_B(G_SB(1, 0), sc, 1, 0); G_STAGE_A(G_SA(1, 0), sc, 1, 0); G_STAGE_B(G_SB(1, 1), sc, 1, 1);
    G_WAIT_V(6); G_BAR;
    for (;;) {
        const bool has_next = Kd.next(ui + 1, nxt);
        if (has_next) Kd.src(nxt, sn, R, C); else sn = sc;
#pragma unroll 1
        for (int t = 0; t < NT; t += 2) {
            const bool last = (t == NT - 2);
            if (last && has_next) Kd.a_ready(nxt, wid);
            Src s2; s2.a = last ? sn.a : sc.a; s2.b0 = last ? sn.b0 : sc.b0; s2.b1 = last ? sn.b1 : sc.b1;
            s2.va[0][0] = last ? sn.va[0][0] : sc.va[0][0]; s2.va[0][1] = last ? sn.va[0][1] : sc.va[0][1]; s2.va[1][0] = last ? sn.va[1][0] : sc.va[1][0]; s2.va[1][1] = last ? sn.va[1][1] : sc.va[1][1];
            const int t2 = last ? 0 : t + 2, t3 = t2 + 1;
            X_LDB0(0, 0); X_LDB1(0, 1); G_SCHED; X_LDA(0, 0); G_STAGE_A(G_SA(1, 1), sc, t + 1, 1);
            G_WAIT_V(8); G_WAIT_L(0); G_BAR; X_MM0(0, 0); X_MM1(0, 1); G_BAR; G_SCHED;
            X_LDA(0, 1); G_STAGE_B(G_SB(0, 0), s2, t2, 0); G_STAGE_B(G_SB(0, 1), s2, t2, 1); G_STAGE_A(G_SA(0, 0), s2, t2, 0);
            G_WAIT_V(8); G_WAIT_L(0); G_BAR; X_MM0(1, 0); X_MM1(1, 1); G_BAR; G_SCHED;
            X_LDB0(1, 0); X_LDB1(1, 1); G_SCHED; X_LDA(1, 0); G_STAGE_A(G_SA(0, 1), s2, t2, 1);
            G_WAIT_V(8); G_WAIT_L(0); G_BAR; X_MM0(0, 0); X_MM1(0, 1); G_BAR; G_SCHED;
            X_LDA(1, 1); G_STAGE_B(G_SB(1, 0), s2, t3, 0); G_STAGE_B(G_SB(1, 1), s2, t3, 1); G_STAGE_A(G_SA(1, 0), s2, t3, 0);
            G_WAIT_V(8); G_WAIT_L(0); G_BAR; X_MM0(1, 0); X_MM1(1, 1); G_BAR; G_SCHED;
        }
        if (wr == 0) G_BAR;
        if (Kind::PUBLISH) { if (pend >= 0) Kd.publish(pend); pend = cur.pm; }
        if (Kind::FP8) asm volatile("s_nop 15\n\ts_nop 15" ::: "memory");
        Kd.epi(acc, cur, wr, wc, fr, fq);
        if (!has_next) break;
#pragma unroll
        for (int a = 0; a < 2; ++a)
#pragma unroll
            for (int b = 0; b < 2; ++b)
#pragma unroll
                for (int m = 0; m < 4; ++m)
#pragma unroll
                    for (int n = 0; n < 2; ++n) acc[a][b][m][n] = (f32x4){0.f, 0.f, 0.f, 0.f};
        cur = nxt; sc = sn; ++ui;
        if (wr == 1) G_BAR;
    }
    G_WAIT_V(0);
    if (Kind::PUBLISH) { if (pend >= 0) Kd.publish(pend); }
    G_BAR;
#undef G_SA
#undef G_SB
#undef G_STAGE_A
#undef G_STAGE_B
#undef G_LDA
#undef G_LDB
#undef G_MMA
#undef G_MMA8
#undef G_LDA8
#undef G_LDB8
#undef X_LDA
#undef X_LDB0
#undef X_LDB1
#undef X_MM0
#undef X_MM1
#undef G_WAIT_V
#undef G_WAIT_L
#undef G_BAR
#undef G_SCHED
}

__device__ __forceinline__ void src_direct(Src& s, const void* A, int row0, const int (&R)[2], const int (&C)[2], int pitchb = 2048) {
    s.a = (const char*)A + (size_t)row0 * pitchb;
#pragma unroll
    for (int h = 0; h < 2; ++h)
#pragma unroll
        for (int i = 0; i < 2; ++i) s.va[h][i] = (unsigned)((h * HALF + R[i]) * pitchb + C[i] * 2);
}

template <bool F8> struct K1 {
    static constexpr bool PERM = true, PUBLISH = false, FP8 = F8; static constexpr int LDBB = F8 ? 1024 : 2048, NTK = F8 ? 8 : 16;
    __device__ __forceinline__ void publish(int) const {}
    __device__ __forceinline__ void a_ready(const Unit&, int) const {}
    __device__ __forceinline__ void done(const Unit&) const {}
    StaticOrder S; const void* A; const void* Bt; bf16_t* O; const float* rope; bf16_t* VT;
    __device__ __forceinline__ bool next(int i, Unit& u) const { return S.next(i, u); }
    __device__ __forceinline__ void src(const Unit& u, Src& s, const int (&R)[2], const int (&C)[2]) const {
        if (F8 && u.pn == C_DV / BM) {
            src_direct(s, Bt, C_DV, R, C, 1024); s.b0 = (const char*)A + (size_t)u.pm * BM * 1024; s.b1 = s.b0 + 512; return; }
        src_direct(s, A, u.pm * BM, R, C, F8 ? 1024 : 2048); s.b0 = (const char*)Bt + (size_t)u.pn * BM * (F8 ? 1024 : 2048); s.b1 = s.b0 + (F8 ? 512 : 1024);
    }
    __device__ __forceinline__ void epi(const f32x4 (&acc)[2][2][4][2], const Unit& u, int wr, int wc, int fr, int fq) const {
        const int row0 = u.pm * BM + wr * 64 + fr, col0 = u.pn * BM + wc * 32 + 8 * fq;
        if (F8 && u.pn == C_DV / BM) {
#pragma unroll
            for (int ai = 0; ai < 2; ++ai)
#pragma unroll
                for (int m = 0; m < 4; ++m) { const int c = ai * HALF + wr * 64 + m * 16 + fr;
#pragma unroll
                    for (int bj = 0; bj < 2; ++bj) { const int tok = u.pm * BM + bj * HALF + wc * 32 + 8 * fq;
                        bf16_t* rowp = VT + ((size_t)(((tok >> 12) * 4 + (c >> 6)) * 64 + (c & 63))) * SEQ + (tok & 4080);
                        const f32x4 v0 = acc[ai][bj][m][0], v1 = acc[ai][bj][m][1];
                        u32x2 w0, w1; w0.x = pk2(v0[0], v0[1]); w0.y = pk2(v0[2], v0[3]); w1.x = pk2(v1[0], v1[1]); w1.y = pk2(v1[2], v1[3]);
                        *(u32x2*)(rowp + ((fq & 1) ? 4 : 0)) = w0; *(u32x2*)(rowp + ((fq & 1) ? 12 : 8)) = w1; } }
        } else if (u.pn == 7 || u.pn == 8) {
#pragma unroll
            for (int ai = 0; ai < 2; ++ai)
#pragma unroll
                for (int m = 0; m < 4; ++m) {
                    const int row = row0 + ai * HALF + m * 16;
                    const f32x4 cs = *(const f32x4*)(rope + (size_t)row * 8), sn = *(const f32x4*)(rope + (size_t)row * 8 + 4);
                    bf16_t* rowp = O + (size_t)row * PP + col0;
#pragma unroll
                    for (int bj = 0; bj < 2; ++bj) {
                        f32x4 v0 = acc[ai][bj][m][0], v1 = acc[ai][bj][m][1]; if (F8) { v0 = v0 * (1.f / W8S); v1 = v1 * (1.f / W8S); }
                        if (fq == 0) { const f32x4 x1 = v0, x2 = v1; v0 = x1 * cs - x2 * sn; v1 = x2 * cs + x1 * sn; }
                        u32x4 w; w.x = pk2(v0[0], v0[1]); w.y = pk2(v0[2], v0[3]); w.z = pk2(v1[0], v1[1]); w.w = pk2(v1[2], v1[3]);
                        *(u32x4*)(rowp + bj * HALF) = w;
                    }
                }
        } else {
#pragma unroll
            for (int ai = 0; ai < 2; ++ai)
#pragma unroll
                for (int m = 0; m < 4; ++m) { bf16_t* rowp = O + (size_t)(row0 + ai * HALF + m * 16) * PP + col0;
#pragma unroll
                    for (int bj = 0; bj < 2; ++bj) { f32x4 v0 = acc[ai][bj][m][0], v1 = acc[ai][bj][m][1]; if (F8) { v0 = v0 * (1.f / W8S); v1 = v1 * (1.f / W8S); }
                        u32x4 w; w.x = pk2(v0[0], v0[1]); w.y = pk2(v0[2], v0[3]); w.z = pk2(v1[0], v1[1]); w.w = pk2(v1[2], v1[3]);
                        *(u32x4*)(rowp + bj * HALF) = w; } }
        }
    }
};
struct K2 {
    static constexpr bool PERM = true, PUBLISH = false, FP8 = true; static constexpr int LDBB = 1024, NTK = 8;
    __device__ __forceinline__ void publish(int) const {}
    __device__ __forceinline__ void a_ready(const Unit&, int) const {}
    __device__ __forceinline__ void done(const Unit&) const {}
    StaticOrder S; const unsigned char* A; const unsigned char* Bt; bf16_t* O;
    __device__ __forceinline__ bool next(int i, Unit& u) const { return S.next(i, u); }
    __device__ __forceinline__ void src(const Unit& u, Src& s, const int (&R)[2], const int (&C)[2]) const {
        src_direct(s, A, u.pm * BM, R, C, 1024); s.b0 = (const char*)(Bt + (size_t)u.pn * BM * 1024); s.b1 = s.b0 + 512;
    }
    __device__ __forceinline__ void epi(const f32x4 (&acc)[2][2][4][2], const Unit& u, int wr, int wc, int fr, int fq) const {
        const int row0 = u.pm * BM + wr * 64 + fr, col0 = u.pn * BM + wc * 32 + 8 * fq;
#pragma unroll
        for (int ai = 0; ai < 2; ++ai)
#pragma unroll
            for (int m = 0; m < 4; ++m) { bf16_t* rowp = O + (size_t)(row0 + ai * HALF + m * 16) * DM + col0;
#pragma unroll
                for (int bj = 0; bj < 2; ++bj) { const f32x4 v0 = acc[ai][bj][m][0] * (1.f / (W8S * Y8S)), v1 = acc[ai][bj][m][1] * (1.f / (W8S * Y8S));
                    u32x4 w; w.x = pk2(v0[0], v0[1]); w.y = pk2(v0[2], v0[3]); w.z = pk2(v1[0], v1[1]); w.w = pk2(v1[2], v1[3]);
                    *(u32x4*)(rowp + bj * HALF) = w; } }
    }
};
__device__ __forceinline__ int pair_i(int p) { return p < 3 ? 0 : (p < 5 ? 1 : 2); }
__device__ __forceinline__ int pair_j(int p) { return p < 3 ? p + 1 : (p < 5 ? p - 1 : 3); }
struct K4 {
    static constexpr bool PERM = true, PUBLISH = false, FP8 = true; static constexpr int LDBB = 1024, NTK = 8;
    const unsigned char* U; const unsigned char* Wgu; unsigned char* H; const int* ltok; const float* lgate; const LAS int* tb; int G, vcu; gu32* rtc;
    __device__ __forceinline__ void a_ready(const Unit&, int) const {}
    __device__ __forceinline__ void done(const Unit&) const {}
    __device__ __forceinline__ void publish(int pm) const { if ((threadIdx.x & 63) == 0) __hip_atomic_fetch_add(rtc + 64 * pm, 1u, RLX_AGENT); }
    __device__ __forceinline__ bool next(int i, Unit& u) const {
        const int L = i * G + vcu; const int nt = tb[32 + NBUCKET]; if (L >= nt * 8) return false;
        const int rt = L >> 3; int k = 0;
        for (int q = 1; q < NBUCKET; ++q) k = (tb[32 + q] <= rt) ? q : k;
        u.pm = rt; u.pn = L & 7; u.bk = k; u.tb = rt - tb[32 + k]; return true;
    }
    __device__ __forceinline__ void src(const Unit& u, Src& s, const int (&R)[2], const int (&C)[2]) const {
        const int cnt = tb[u.bk]; s.a = (const char*)U;
#pragma unroll
        for (int h = 0; h < 2; ++h)
#pragma unroll
            for (int i = 0; i < 2; ++i) { const int pos = u.tb * BM + h * HALF + R[i]; const int tok = ltok[(size_t)u.bk * LCAP + (pos < cnt ? pos : 0)]; s.va[h][i] = (unsigned)(tok * 1024 + C[i] * 2); }
        const int grp = u.bk / 6, p = u.bk % 6, sl = u.pn >> 2; const int e = grp * 4 + (sl ? pair_j(p) : pair_i(p));
        s.b0 = (const char*)(Wgu + ((size_t)e * 1024 + (size_t)(u.pn & 3) * BM) * 1024); s.b1 = s.b0 + 512;
    }
    __device__ __forceinline__ void epi(const f32x4 (&acc)[2][2][4][2], const Unit& u, int wr, int wc, int fr, int fq) const {
        const int cnt = tb[u.bk], sl = u.pn >> 2; const int colo = sl * 512 + (u.pn & 3) * 128 + wc * 32 + 8 * fq;
#pragma unroll
        for (int ai = 0; ai < 2; ++ai)
#pragma unroll
            for (int m = 0; m < 4; ++m) {
                const int r = ai * HALF + wr * 64 + m * 16 + fr, pos = u.tb * BM + r;
                const float gt = (pos < cnt) ? lgate[((size_t)u.bk * LCAP + pos) * 2 + sl] : 0.f;
                float hv[8];
#pragma unroll
                for (int n = 0; n < 2; ++n)
#pragma unroll
                    for (int j = 0; j < 4; ++j) { const float g = acc[ai][0][m][n][j] * (1.f / W8S), up = acc[ai][1][m][n][j] * (1.f / W8S); hv[n * 4 + j] = g * __builtin_amdgcn_rcpf(1.f + fexp(-g)) * up * (gt * H8S); }
                u32x2 w; w.x = pk4_fp8(hv[0], hv[1], hv[2], hv[3]); w.y = pk4_fp8(hv[4], hv[5], hv[6], hv[7]);
                *(u32x2*)(H + (size_t)(u.pm * BM + r) * 1024 + colo) = w;
            }
    }
};
struct K5 {
    static constexpr bool PERM = true, PUBLISH = false, FP8 = true; static constexpr int LDBB = 512, NTK = 8;
    __device__ __forceinline__ void publish(int) const {}
    const unsigned char* H; const unsigned char* Wd; bf16_t* Y; const LAS int* tb; int G, vcu; gu32* rtc; gu32* tmo;
    __device__ __forceinline__ void done(const Unit&) const {}
    __device__ __forceinline__ void a_ready(const Unit& u, int wid) const { return;
        if (wid == 0) {
            const unsigned long long t0 = __builtin_amdgcn_s_memrealtime(); unsigned polls = 0;
            while ((unsigned)__builtin_amdgcn_readfirstlane(__hip_atomic_load(rtc + 64 * u.pm, RLX_AGENT)) < 64u) {
                if ((++polls & 255u) == 0u && __builtin_amdgcn_readfirstlane(__hip_atomic_load(tmo, RLX_AGENT)) != 0u) break;
                if (__builtin_amdgcn_s_memrealtime() - t0 > 2000000ull) { if ((threadIdx.x & 63) == 0) __hip_atomic_store(tmo, 1u, RLX_AGENT); break; }
                __builtin_amdgcn_s_sleep(2); }
            __builtin_amdgcn_fence(__ATOMIC_ACQUIRE, "agent");
            asm volatile("s_waitcnt vmcnt(0)" ::: "memory");
        }
        asm volatile("" ::: "memory"); __builtin_amdgcn_s_barrier(); asm volatile("" ::: "memory");
    }
    __device__ __forceinline__ bool next(int i, Unit& u) const {
        const int nt = tb[32 + NBUCKET]; const int n4 = nt * 8; const int i0 = 0; (void)n4;
        const int L = (i + i0) * G + vcu; if (L >= nt * 4) return false;
        const int rt = L >> 2; int k = 0;
        for (int q = 1; q < NBUCKET; ++q) k = (tb[32 + q] <= rt) ? q : k;
        u.pm = rt; u.pn = L & 3; u.bk = k; u.tb = rt - tb[32 + k]; return true;
    }
    __device__ __forceinline__ void src(const Unit& u, Src& s, const int (&R)[2], const int (&C)[2]) const {
        src_direct(s, H, u.pm * BM, R, C, 1024);
        const int grp = u.bk / 6, p = u.bk % 6;
        s.b0 = (const char*)(Wd + ((size_t)(grp * 4 + pair_i(p)) * 1024 + (size_t)u.pn * BM) * 512);
        s.b1 = (const char*)(Wd + ((size_t)(grp * 4 + pair_j(p)) * 1024 + (size_t)u.pn * BM) * 512);
    }
    __device__ __forceinline__ void epi(const f32x4 (&acc)[2][2][4][2], const Unit& u, int wr, int wc, int fr, int fq) const {
        const int row0 = u.pm * BM + wr * 64 + fr, col0 = u.pn * BM + wc * 32 + 8 * fq;
#pragma unroll
        for (int ai = 0; ai < 2; ++ai)
#pragma unroll
            for (int m = 0; m < 4; ++m) { bf16_t* rowp = Y + (size_t)(row0 + ai * HALF + m * 16) * DM + col0;
#pragma unroll
                for (int bj = 0; bj < 2; ++bj) { const f32x4 v0 = acc[ai][bj][m][0] * (1.f / (W8S * H8S)), v1 = acc[ai][bj][m][1] * (1.f / (W8S * H8S));
                    u32x4 w; w.x = pk2(v0[0], v0[1]); w.y = pk2(v0[2], v0[3]); w.z = pk2(v1[0], v1[1]); w.w = pk2(v1[2], v1[3]);
                    *(u32x4*)(rowp + bj * HALF) = w; } }
    }
};
}

namespace attn_body {
using bf16 = __hip_bfloat16;
using s16x4 = __attribute__((ext_vector_type(4))) short;
using f32x16 = __attribute__((ext_vector_type(16))) float;
constexpr int D = 64, PITCH = PP;
constexpr int NW = 8, QBLK = 32, QB = QBLK * NW, KVBLK = 64;
__device__ __forceinline__ int crow(int r, int hi) { return (r & 3) + 8 * (r >> 2) + 4 * hi; }
#define SBAR() __builtin_amdgcn_sched_barrier(0)
__device__ __forceinline__ void cmask(f32x16& p0, f32x16& p1, int jb, int qrel, int hi) {
    const float NEG = -INFINITY; int kb = 64 * jb + 4 * hi;
#pragma unroll
    for (int r = 0; r < 16; ++r) { int kv = kb + (r & 3) + 8 * (r >> 2); if (kv > qrel) p0[r] = NEG; if (kv + 32 > qrel) p1[r] = NEG; }
}
constexpr int NSLOT = 3, SLOTB = 8192;
constexpr int LDS_K = 0, LDS_V = NSLOT * SLOTB, LDS_WS = 2 * NSLOT * SLOTB, LDS_OST = LDS_WS + NW * 64 * 4, ATT_LDS_BYTES = LDS_OST + NW * 8192;
__device__ __forceinline__ void glds16(const void* gsrc, unsigned lds_dst) { unsigned keep;
    asm volatile("s_mov_b32 %0, m0\n\ts_mov_b32 m0, %2\n\ts_nop 0\n\tglobal_load_lds_dwordx4 %1, off\n\ts_mov_b32 m0, %0" : "=&s"(keep) : "v"(gsrc), "s"(lds_dst) : "memory"); }
__device__ __forceinline__ float max3f(float a, float b, float c) { float r; asm("v_max3_f32 %0, %1, %2, %3" : "=v"(r) : "v"(a), "v"(b), "v"(c)); return r; }
__device__ __forceinline__ float max2f(float a, float b) { float r; asm("v_max_f32_e32 %0, %1, %2" : "=v"(r) : "v"(a), "v"(b)); return r; }
__device__ __forceinline__ float fadd_s(float a, float b) { float r; asm("v_add_f32_e32 %0, %1, %2" : "=v"(r) : "v"(a), "v"(b)); return r; }
__device__ __forceinline__ float fsub_s(float a, float b) { float r; asm("v_sub_f32_e32 %0, %1, %2" : "=v"(r) : "v"(a), "v"(b)); return r; }
typedef float f32x2_t __attribute__((ext_vector_type(2))); typedef __bf16 bf16x2_t __attribute__((ext_vector_type(2)));
__device__ __forceinline__ unsigned cvtpk_s(float lo, float hi) { f32x2_t v = {lo, hi}; bf16x2_t b = __builtin_convertvector(v, bf16x2_t); return __builtin_bit_cast(unsigned, b); }
#define WAIT_BAR(N) asm volatile("s_waitcnt vmcnt(" #N ") lgkmcnt(0)\n\ts_barrier" ::: "memory")
__device__ __forceinline__ void qkt(f32x16& p0, f32x16& p1, const char* Kslot, const bf16x8* qr, const f32x16& negm, int r32, int hi) {
    const char* kb = Kslot + hi * 1024 + r32 * 16;
#pragma unroll
    for (int d0 = 0; d0 < 2; ++d0) {
        const bf16x8 b0 = *reinterpret_cast<const bf16x8*>(kb + d0 * 2048);
        const bf16x8 b1 = *reinterpret_cast<const bf16x8*>(kb + d0 * 2048 + 512);
        if (d0 == 0) { p0 = __builtin_amdgcn_mfma_f32_32x32x16_bf16(b0, qr[0], negm, 0, 0, 0); p1 = __builtin_amdgcn_mfma_f32_32x32x16_bf16(b1, qr[0], negm, 0, 0, 0); }
        else { p0 = __builtin_amdgcn_mfma_f32_32x32x16_bf16(b0, qr[d0], p0, 0, 0, 0); p1 = __builtin_amdgcn_mfma_f32_32x32x16_bf16(b1, qr[d0], p1, 0, 0, 0); } }
}
typedef __attribute__((address_space(3))) const char* lds_cptr;
typedef short v4i16_t __attribute__((ext_vector_type(4)));
__device__ __forceinline__ void kload8(bf16x8* kf, lds_cptr kp) {
    kf[0] = *(const __attribute__((address_space(3))) bf16x8*)(kp);        kf[1] = *(const __attribute__((address_space(3))) bf16x8*)(kp + 512);
    kf[2] = *(const __attribute__((address_space(3))) bf16x8*)(kp + 2048); kf[3] = *(const __attribute__((address_space(3))) bf16x8*)(kp + 2560);
}
__device__ __forceinline__ void kload2(bf16x8* kf, lds_cptr kp, int j) { kf[2 * j] = *(const __attribute__((address_space(3))) bf16x8*)(kp + j * 2048); kf[2 * j + 1] = *(const __attribute__((address_space(3))) bf16x8*)(kp + j * 2048 + 512); }
__device__ __forceinline__ s16x4 vtr(lds_cptr p) { return __builtin_bit_cast(s16x4, __builtin_amdgcn_ds_read_tr16_b64_v4i16((__attribute__((address_space(3))) v4i16_t*)p)); }
__device__ __forceinline__ float rowmax(const f32x16& p0, const f32x16& p1) {
    float a = max3f(p0[0], p0[1], p1[0]), b = max3f(p0[2], p0[3], p1[1]); a = max3f(a, p1[2], p1[3]);
#pragma unroll
    for (int r = 4; r < 16; r += 4) { a = max3f(a, p0[r], p0[r + 1]); b = max3f(b, p0[r + 2], p0[r + 3]); a = max3f(a, p1[r], p1[r + 1]); b = max3f(b, p1[r + 2], p1[r + 3]); }
    const float m = max2f(a, b);
    auto rr = __builtin_amdgcn_permlane32_swap(__float_as_uint(m), __float_as_uint(m), false, false);
    return max2f(__uint_as_float(rr[0]), __uint_as_float(rr[1]));
}
__device__ __forceinline__ void pv(f32x16* o, lds_cptr vp, bf16x8 pa0, bf16x8 pa1, bf16x8 pa2, bf16x8 pa3) {
#pragma unroll
    for (int d0 = 0; d0 < 2; ++d0) { bf16x8 vf[4];
#pragma unroll
        for (int ks = 0; ks < 4; ++ks) vf[ks] = *(const __attribute__((address_space(3))) bf16x8*)(vp + (ks * 2 + d0) * 1024);
        o[d0] = __builtin_amdgcn_mfma_f32_32x32x16_bf16(pa0, vf[0], o[d0], 0, 0, 0);
        o[d0] = __builtin_amdgcn_mfma_f32_32x32x16_bf16(pa1, vf[1], o[d0], 0, 0, 0);
        o[d0] = __builtin_amdgcn_mfma_f32_32x32x16_bf16(pa2, vf[2], o[d0], 0, 0, 0);
        o[d0] = __builtin_amdgcn_mfma_f32_32x32x16_bf16(pa3, vf[3], o[d0], 0, 0, 0);
    }
}
struct AttnParams { const bf16* Q; const bf16* K; const bf16* V; const bf16* zpage; bf16_t* Y; const float* gnorm; float lam, osc; };
template <int THRL, int comp> __device__ __forceinline__ void attn_unit(int b, int h, int qb, const AttnParams& P, char* shm) {
    const bf16* Q = P.Q; const bf16* __restrict__ K = P.K; const bf16* __restrict__ V = P.V;
    int tid_ = threadIdx.x; asm volatile("" : "+v"(tid_));
    const int tid = tid_, lane = tid & 63, r32 = lane & 31, hi = lane >> 5; const int wid = __builtin_amdgcn_readfirstlane(tid >> 6);
    const long rowbase = (long)b * SEQ; const int q0 = qb * QB;
    const bf16* Qw = Q + (rowbase + q0 + wid * QBLK) * PITCH + h * D;
    const bf16* Kh = K + rowbase * PITCH + h * D, *Vh = V + rowbase * PITCH + h * D;
    const unsigned lds0 = (unsigned)(uintptr_t)shm;
    float* wsf = (float*)(shm + LDS_WS) + wid * 64;
    const bf16* ksrc = Kh + (long)(32 * (wid & 1) + (lane & 31)) * PITCH + comp * 32 + (wid >> 1) * 8;
    const bf16* vsrc = V + ((long)((b * 4 + h) * 64 + 32 * (wid & 1) + (lane & 31))) * SEQ + (2 * (wid >> 1) + (lane >> 5)) * 8;
    const unsigned kdst = lds0 + LDS_K + (wid >> 1) * 1024 + (wid & 1) * 512, vdst = lds0 + LDS_V + wid * 1024;
#define DMA_K(t, slot) do { if (lane < 32) glds16(ksrc + (long)(t) * KVBLK * PITCH, (unsigned)__builtin_amdgcn_readfirstlane(kdst + (slot))); } while (0)
#define DMA_V(t, slot) glds16(vsrc + (long)(t) * KVBLK, (unsigned)__builtin_amdgcn_readfirstlane(vdst + (slot)))
    const char* Kbase = shm + LDS_K; bf16x8 kf[4];
    const lds_cptr shm3 = (lds_cptr)shm; const lds_cptr kp0 = shm3 + LDS_K + hi * 1024 + r32 * 16; const lds_cptr vp0 = shm3 + LDS_V + lane * 16;
    const int NT = (q0 + QB) / KVBLK;
    if (wid >= 4) __builtin_amdgcn_s_setprio(1);
    DMA_K(0, 0); DMA_V(0, 0); DMA_K(1, SLOTB);
    bf16x8 qr[2];
#pragma unroll
    for (int d0 = 0; d0 < 2; ++d0) qr[d0] = *reinterpret_cast<const bf16x8*>(&Qw[(long)r32 * PITCH + comp * 32 + d0 * 16 + hi * 8]);
    float mhat = 0.f, l_reg = 0.f; f32x16 o[2]; o[0] = f32x16{}; o[1] = f32x16{}; f32x16 negm = f32x16{}; asm volatile("" : "+v"(negm));
    const int qrel = wid * QBLK + r32;
#define CMASK(P0, P1, t) do { int jb_ = (t) - (NT - 4); if (jb_ >= 0) cmask(P0, P1, jb_, qrel, hi); } while (0)
    bool resc = false;
#define START(P0, P1) do { const float rm = rowmax(P0, P1); resc = false; \
    { const float dl = rm; mhat = fadd_s(mhat, dl); \
      _Pragma("unroll") for (int r = 0; r < 16; ++r) { P0[r] = fsub_s(P0[r], dl); P1[r] = fsub_s(P1[r], dl); } \
      _Pragma("unroll") for (int r = 0; r < 16; ++r) negm[r] = -mhat; asm volatile("" : "+v"(negm)); } \
    _Pragma("unroll") for (int r = 0; r < 16; ++r) P0[r] = __builtin_amdgcn_exp2f(P0[r]); } while (0)
#define RESC() do { if (resc) { asm volatile("s_waitcnt lgkmcnt(0)" ::: "memory"); \
      _Pragma("unroll") for (int d_ = 0; d_ < 2; ++d_) _Pragma("unroll") for (int r = 0; r < 16; ++r) o[d_][r] *= wsf[crow(r, hi)]; } } while (0)
    f32x16 pA0, pA1, pB0, pB1;
    int sl_prev = 0, sl_cur = 0, sl_next = SLOTB;
#define ROT() do { sl_prev = sl_cur; sl_cur = sl_next; sl_next = (sl_next == (NSLOT - 1) * SLOTB) ? 0 : sl_next + SLOTB; } while (0)
    DMA_K(2, 2 * SLOTB);
    WAIT_BAR(3);
    qkt(pA0, pA1, Kbase, qr, negm, r32, hi); asm volatile("s_nop 15\n\ts_nop 7" : "+v"(pA0), "+v"(pA1)); CMASK(pA0, pA1, 0);
    START(pA0, pA1);
    _Pragma("unroll") for (int r = 0; r < 16; ++r) pA1[r] = __builtin_amdgcn_exp2f(pA1[r]);
    WAIT_BAR(0);
    DMA_K(3, 0); DMA_V(1, SLOTB);
    ROT();
    kload8(kf, kp0 + sl_cur);
    WAIT_BAR(2);
    bf16x8 vfr[8]; u32x4 pw0, pw1, pw2, pw3;
#define PKW(P, B) cvtpk_s(P[B], P[B + 1])
#define PAF(k) __builtin_bit_cast(bf16x8, pw##k)
#define VFR(i) vfr[i]
#define PIN(x) asm volatile("" : "+v"(x))
#define MX3(a, b, c) __builtin_fmaxf(__builtin_fmaxf((a), (b)), (c))
#define GAPA(MF, A0, A1, A2, A3, W0, W1, PW) do { MF; sacc += A0; sacc += A1; sacc += A2; sacc += A3; PIN(sacc); W0; W1; PIN(PW); SBAR(); } while (0)
#define EX(v) __builtin_amdgcn_exp2f(v)
#define GAPB(MF, X, B) do { MF; X[B] = EX(X[B]); X[B + 1] = EX(X[B + 1]); X[B + 2] = EX(X[B + 2]); X[B + 3] = EX(X[B + 3]); PIN(X); SBAR(); } while (0)
#define VRD(i) do { vfr[i] = *(const __attribute__((address_space(3))) bf16x8*)(vp_ + ((((i) & 3) * 2 + ((i) >> 2)) * 1024)); } while (0)
#define KRD(G, j) do { if (G) { kload2(kf, kp0 + sl_next, j); SBAR(); } } while (0)
#define STEP(C0, C1, P0, P1, t, GK, GV, GL) do { SBAR(); \
    const lds_cptr vp_ = vp0 + sl_prev; \
    VRD(0); SBAR(); float sacc = (P0[0] + P0[1]); \
    GAPA(C0 = __builtin_amdgcn_mfma_f32_32x32x16_bf16(kf[0], qr[0], negm, 0, 0, 0), P0[2], P0[3], P0[4], P0[5],     pw0[0] = PKW(P0, 0), pw0[1] = PKW(P0, 2), pw0); \
    VRD(4); SBAR(); GAPA(C1 = __builtin_amdgcn_mfma_f32_32x32x16_bf16(kf[1], qr[0], negm, 0, 0, 0), P0[6], P0[7], P0[8], P0[9],     pw0[2] = PKW(P0, 4), pw0[3] = PKW(P0, 6), pw0); \
    VRD(1); SBAR(); GAPA(C0 = __builtin_amdgcn_mfma_f32_32x32x16_bf16(kf[2], qr[1], C0, 0, 0, 0),   P0[10], P0[11], P0[12], P0[13], pw1[0] = PKW(P0, 8), pw1[1] = PKW(P0, 10), pw1); \
    VRD(5); SBAR(); GAPA(C1 = __builtin_amdgcn_mfma_f32_32x32x16_bf16(kf[3], qr[1], C1, 0, 0, 0),   P0[14], P0[15], P1[0], P1[1],   pw1[2] = PKW(P0, 12), pw1[3] = PKW(P0, 14), pw1); \
    VRD(2); SBAR(); GAPA(,   P1[2], P1[3], P1[4], P1[5],     pw2[0] = PKW(P1, 0), pw2[1] = PKW(P1, 2), pw2); \
    VRD(6); SBAR(); GAPA(,   P1[6], P1[7], P1[8], P1[9],     pw2[2] = PKW(P1, 4), pw2[3] = PKW(P1, 6), pw2); \
    VRD(3); SBAR(); GAPA(,   P1[10], P1[11], P1[12], P1[13], pw3[0] = PKW(P1, 8), pw3[1] = PKW(P1, 10), pw3); \
    VRD(7); SBAR(); GAPA(,   P1[14], P1[15], 0.f, 0.f,       pw3[2] = PKW(P1, 12), pw3[3] = PKW(P1, 14), pw3); \
    l_reg += sacc; \
    if (GK) { DMA_K((t) + 3, sl_cur); } if (GV) { DMA_V((t) + 1, sl_next); } \
    CMASK(C0, C1, t); \
    { float a = MX3(C0[0], C0[1], C1[0]), b = MX3(C0[2], C0[3], C1[1]); a = MX3(a, C1[2], C1[3]); \
      _Pragma("unroll") for (int r = 4; r < 16; r += 4) { a = MX3(a, C0[r], C0[r + 1]); b = MX3(b, C0[r + 2], C0[r + 3]); a = MX3(a, C1[r], C1[r + 1]); b = MX3(b, C1[r + 2], C1[r + 3]); } \
      float rm = __builtin_fmaxf(a, b); { auto rr = __builtin_amdgcn_permlane32_swap(__float_as_uint(rm), __float_as_uint(rm), false, false); rm = __builtin_fmaxf(__uint_as_float(rr[0]), __uint_as_float(rr[1])); } \
      resc = false; \
      if (__builtin_expect(__any(rm > (float)THRL), 0)) { const float dl = __builtin_fmaxf(rm, 0.f); mhat += dl; \
        _Pragma("unroll") for (int r = 0; r < 16; ++r) { C0[r] -= dl; C1[r] -= dl; } \
        _Pragma("unroll") for (int r = 0; r < 16; ++r) negm[r] = -mhat; asm volatile("" : "+v"(negm)); \
        const float f = __builtin_amdgcn_exp2f(-dl); l_reg *= f; if (hi == 0) wsf[r32] = f; resc = true; } } \
    SBAR(); \
    GAPB(o[0] = __builtin_amdgcn_mfma_f32_32x32x16_bf16(PAF(0), VFR(0), o[0], 0, 0, 0), C0, 0); \
    GAPB(o[1] = __builtin_amdgcn_mfma_f32_32x32x16_bf16(PAF(0), VFR(4), o[1], 0, 0, 0), C0, 4); \
    KRD(GL, 0); GAPB(o[0] = __builtin_amdgcn_mfma_f32_32x32x16_bf16(PAF(1), VFR(1), o[0], 0, 0, 0), C0, 8); \
    KRD(GL, 1); GAPB(o[1] = __builtin_amdgcn_mfma_f32_32x32x16_bf16(PAF(1), VFR(5), o[1], 0, 0, 0), C0, 12); \
    GAPB(o[0] = __builtin_amdgcn_mfma_f32_32x32x16_bf16(PAF(2), VFR(2), o[0], 0, 0, 0), C1, 0); \
    GAPB(o[1] = __builtin_amdgcn_mfma_f32_32x32x16_bf16(PAF(2), VFR(6), o[1], 0, 0, 0), C1, 4); \
    GAPB(o[0] = __builtin_amdgcn_mfma_f32_32x32x16_bf16(PAF(3), VFR(3), o[0], 0, 0, 0), C1, 8); \
    GAPB(o[1] = __builtin_amdgcn_mfma_f32_32x32x16_bf16(PAF(3), VFR(7), o[1], 0, 0, 0), C1, 12); \
    } while (0)
    int t = 1;
#undef CMASK
#define CMASK(P0, P1, t) do {} while (0)
    for (; t + 5 < NT; t += 2) {
        STEP(pB0, pB1, pA0, pA1, t, true, true, true);     WAIT_BAR(2); RESC(); ROT();
        STEP(pA0, pA1, pB0, pB1, t + 1, true, true, true); WAIT_BAR(2); RESC(); ROT();
    }
#undef CMASK
#define CMASK(P0, P1, t) do { int jb_ = (t) - (NT - 4); if (jb_ >= 0) cmask(P0, P1, jb_, qrel, hi); } while (0)
#define ENDW(tt) do { if ((tt) + 3 < NT) { WAIT_BAR(2); } else if ((tt) + 2 < NT) { WAIT_BAR(1); } else { WAIT_BAR(0); } } while (0)
    for (; t + 1 < NT; t += 2) {
        STEP(pB0, pB1, pA0, pA1, t, (t + 3 < NT), (t + 1 < NT), (t + 1 < NT));         ENDW(t);     RESC(); ROT();
        STEP(pA0, pA1, pB0, pB1, t + 1, (t + 4 < NT), (t + 2 < NT), (t + 2 < NT));     ENDW(t + 1); RESC(); ROT();
    }
    STEP(pB0, pB1, pA0, pA1, NT - 1, false, false, false); RESC();
    { float sacc = pB0[0] + pB0[1]; _Pragma("unroll") for (int r = 2; r < 16; ++r) sacc += pB0[r]; _Pragma("unroll") for (int r = 0; r < 16; ++r) sacc += pB1[r]; l_reg += sacc;
      pw0 = (u32x4){PKW(pB0, 0), PKW(pB0, 2), PKW(pB0, 4), PKW(pB0, 6)}; pw1 = (u32x4){PKW(pB0, 8), PKW(pB0, 10), PKW(pB0, 12), PKW(pB0, 14)}; pw2 = (u32x4){PKW(pB1, 0), PKW(pB1, 2), PKW(pB1, 4), PKW(pB1, 6)}; pw3 = (u32x4){PKW(pB1, 8), PKW(pB1, 10), PKW(pB1, 12), PKW(pB1, 14)};
      SBAR(); pv(o, vp0 + sl_cur, PAF(0), PAF(1), PAF(2), PAF(3)); }
#undef PKW
#undef PAF
#undef VFR
#undef PIN
#undef MX3
#undef GAPA
#undef GAPB
#undef EX
#undef VRD
#undef KRD
#undef STEP
#undef ENDW
    { auto rr = __builtin_amdgcn_permlane32_swap(__float_as_uint(l_reg), __float_as_uint(l_reg), false, false); l_reg = __uint_as_float(rr[0]) + __uint_as_float(rr[1]); }
    if (hi == 0) wsf[32 + r32] = l_reg; asm volatile("s_waitcnt lgkmcnt(0)" ::: "memory");
    float rli[16];
#pragma unroll
    for (int r = 0; r < 16; ++r) rli[r] = __builtin_amdgcn_rcpf(wsf[32 + crow(r, hi)]);
    float* stg = (float*)(shm + LDS_OST) + wid * 2048;
    if (comp == 0) {
#pragma unroll
        for (int r = 0; r < 16; ++r) { const int orow = crow(r, hi);
#pragma unroll
            for (int d0 = 0; d0 < 2; ++d0) stg[orow * 64 + d0 * 32 + r32] = o[d0][r] * rli[r]; }
    } else {
        const float lam = P.lam;
#pragma unroll
        for (int r = 0; r < 16; ++r) { const int orow = crow(r, hi);
#pragma unroll
            for (int d0 = 0; d0 < 2; ++d0) { const int ix = orow * 64 + d0 * 32 + r32; stg[ix] = stg[ix] - lam * (o[d0][r] * rli[r]); } }
        asm volatile("s_waitcnt lgkmcnt(0)" ::: "memory");
        unsigned char* Yw = (unsigned char*)P.Y + (rowbase + q0 + wid * QBLK) * DM + h * D;
        const int ch = lane & 7;
        const f32x4 g0 = *(const f32x4*)(P.gnorm + ch * 8), g1 = *(const f32x4*)(P.gnorm + ch * 8 + 4);
#pragma unroll
        for (int i = 0; i < 4; ++i) { const int row = i * 8 + (lane >> 3);
            const f32x4 a = *(const f32x4*)(stg + row * 64 + ch * 8), c = *(const f32x4*)(stg + row * 64 + ch * 8 + 4);
            float ss = (a[0] * a[0] + a[1] * a[1]) + (a[2] * a[2] + a[3] * a[3]) + (c[0] * c[0] + c[1] * c[1]) + (c[2] * c[2] + c[3] * c[3]);
            ss += __shfl_xor(ss, 1); ss += __shfl_xor(ss, 2); ss += __shfl_xor(ss, 4);
            const float rs = __builtin_amdgcn_rsqf(ss * (1.f / 64.f) + LN_EPS) * P.osc;
            const float rq = rs * Y8S; u32x2 w; w.x = pk4_fp8(a[0] * rq * g0[0], a[1] * rq * g0[1], a[2] * rq * g0[2], a[3] * rq * g0[3]); w.y = pk4_fp8(c[0] * rq * g1[0], c[1] * rq * g1[1], c[2] * rq * g1[2], c[3] * rq * g1[3]);
            *(u32x2*)(Yw + (long)row * DM + ch * 8) = w; }
    }
    __builtin_amdgcn_s_setprio(0);
    asm volatile("s_waitcnt lgkmcnt(0)\n\ts_barrier" ::: "memory");
#undef DMA_K
#undef DMA_V
#undef CMASK
#undef START
#undef RESC
#undef ROT
}
#undef SBAR
#undef WAIT_BAR
}

struct Frame {
    LAS unsigned char* lds; volatile LAS unsigned* MISC; gu32* ctl;
    int tid, lane, wave, vcu, G;
};
struct Args {
    const float* in[29]; float* out; unsigned char* ws; int ph_lo, ph_hi;
};
enum { I_X = 0, I_C, I_POS, I_WADA, I_BADA, I_WIN, I_WOUT, I_MBI, I_MBF, I_MG, I_CONVW, I_CONVB, I_LQ1, I_LK1, I_LQ2, I_LK2, I_DG, I_WA2, I_BA, I_GG, I_LN1G, I_LN1B, I_LN2G, I_LN2B,
       I_RW, I_RB, I_EWG, I_EWU, I_EWD };

__device__ __forceinline__ void tr_item(const float* W, int ldw, int K, bf16_t* WT, int drow0, int scol, int k0, LAS float* scr, int lane) {
#pragma unroll 8
    for (int i = 0; i < 32; ++i) { const int kk = 2 * i + (lane >> 5); scr[kk * 33 + (lane & 31)] = (scol >= 0) ? W[(size_t)(k0 + kk) * ldw + scol] : 0.f; }
    LDS_WAIT(); asm volatile("" ::: "memory");
    const int c = lane & 7;
#pragma unroll
    for (int j = 0; j < 4; ++j) { const int n = (lane >> 3) + 8 * j; const LAS float* s = scr + (8 * c) * 33 + n;
        u32x4 o; o.x = pk2(s[0 * 33], s[1 * 33]); o.y = pk2(s[2 * 33], s[3 * 33]); o.z = pk2(s[4 * 33], s[5 * 33]); o.w = pk2(s[6 * 33], s[7 * 33]);
        *(GAS u32x4*)(WT + (size_t)(drow0 + n) * K + k0 + 8 * c) = o; }
    LDS_WAIT(); asm volatile("" ::: "memory");
}
__device__ __forceinline__ void tr_item4(const float* W, int ldw, int K, bf16_t* WT, int drow0, int scol0, int k0, LAS float* scr, int lane, float wsc = 1.f) {
    const int kq = lane >> 3, nq = (lane & 7) * 4;
    f32x4 v[8];
#pragma unroll
    for (int i = 0; i < 8; ++i) v[i] = *(const f32x4*)(W + (size_t)(k0 + i * 8 + kq) * ldw + scol0 + nq);
#pragma unroll
    for (int i = 0; i < 8; ++i) { LAS float* d = scr + (i * 8 + kq) * 33 + nq; d[0] = v[i][0] * wsc; d[1] = v[i][1] * wsc; d[2] = v[i][2] * wsc; d[3] = v[i][3] * wsc; }
    LDS_WAIT(); asm volatile("" ::: "memory");
    const int c = lane & 7;
#pragma unroll
    for (int j = 0; j < 4; ++j) { const int n = (lane >> 3) + 8 * j; const LAS float* s = scr + (8 * c) * 33 + n;
        u32x4 o; o.x = pk2(s[0 * 33], s[1 * 33]); o.y = pk2(s[2 * 33], s[3 * 33]); o.z = pk2(s[4 * 33], s[5 * 33]); o.w = pk2(s[6 * 33], s[7 * 33]);
        *(GAS u32x4*)(WT + (size_t)(drow0 + n) * K + k0 + 8 * c) = o; }
    LDS_WAIT(); asm volatile("" ::: "memory");
}
struct TrD { const float* src; bf16_t* dst; unsigned char* dst8; int ldw, K, drow0, k0; float wsc; };
__device__ __forceinline__ void tr_load4(const TrD& d, f32x4 (&v)[8], int lane) {
    const int kq = lane >> 3, nq = (lane & 7) * 4;
#pragma unroll
    for (int i = 0; i < 8; ++i) v[i] = *(const f32x4*)(d.src + (size_t)(i * 8 + kq) * d.ldw + nq);
}
__device__ __forceinline__ void tr_finish4(const TrD& d, const f32x4 (&v)[8], LAS float* scr, int lane) {
    const int kq = lane >> 3, nq = (lane & 7) * 4;
#pragma unroll
    for (int i = 0; i < 8; ++i) { LAS float* p = scr + (i * 8 + kq) * 33 + nq; p[0] = v[i][0] * d.wsc; p[1] = v[i][1] * d.wsc; p[2] = v[i][2] * d.wsc; p[3] = v[i][3] * d.wsc; }
    LDS_WAIT(); asm volatile("" ::: "memory");
    const int c = lane & 7;
#pragma unroll
    for (int j = 0; j < 4; ++j) { const int n = (lane >> 3) + 8 * j; const LAS float* s = scr + (8 * c) * 33 + n;
        u32x4 o; o.x = pk2(s[0 * 33], s[1 * 33]); o.y = pk2(s[2 * 33], s[3 * 33]); o.z = pk2(s[4 * 33], s[5 * 33]); o.w = pk2(s[6 * 33], s[7 * 33]);
        *(GAS u32x4*)(d.dst + (size_t)(d.drow0 + n) * d.K + d.k0 + 8 * c) = o; }
    LDS_WAIT(); asm volatile("" ::: "memory");
}
__device__ __forceinline__ void tr_finish8(const TrD& d, const f32x4 (&v)[8], LAS float* scr, int lane) {
    const int kq = lane >> 3, nq = (lane & 7) * 4;
#pragma unroll
    for (int i = 0; i < 8; ++i) { LAS float* p = scr + (i * 8 + kq) * 33 + nq; p[0] = v[i][0] * d.wsc; p[1] = v[i][1] * d.wsc; p[2] = v[i][2] * d.wsc; p[3] = v[i][3] * d.wsc; }
    LDS_WAIT(); asm volatile("" ::: "memory");
    const int c = lane & 7; unsigned char* dst8 = (unsigned char*)d.dst;
#pragma unroll
    for (int j = 0; j < 4; ++j) { const int n = (lane >> 3) + 8 * j; const LAS float* s = scr + (8 * c) * 33 + n;
        u32x2 o; o.x = pk4_fp8(s[0 * 33], s[1 * 33], s[2 * 33], s[3 * 33]); o.y = pk4_fp8(s[4 * 33], s[5 * 33], s[6 * 33], s[7 * 33]);
        *(GAS u32x2*)(dst8 + (size_t)(d.drow0 + n) * d.K + d.k0 + 8 * c) = o; }
    LDS_WAIT(); asm volatile("" ::: "memory");
}
template <int NTL>
__device__ __forceinline__ void rows16_mm(f32x4 (&acc)[NTL], const bf16_t* A, const LAS bf16_t* Bt, int pitch, int lane) {
    const int lr = lane & 15, lq = lane >> 4;
    const bf16_t* ap = A + (size_t)lr * 1024 + lq * 8;
#pragma unroll 8
    for (int ks = 0; ks < 32; ++ks) {
        const bf16x8 a = *(const bf16x8*)(ap + ks * 32);
#pragma unroll
        for (int t = 0; t < NTL; ++t) { const bf16x8 b = *(const LAS bf16x8*)(Bt + (t * 16 + lr) * pitch + ks * 32 + lq * 8); acc[t] = __builtin_amdgcn_mfma_f32_16x16x32_bf16(a, b, acc[t], 0, 0, 0); }
    }
}
constexpr int TBP = 1056;
__device__ __forceinline__ void tail16(const bf16_t* Urow0, const LAS bf16_t* Wt, float* tail_row0, int lane) {
    f32x4 acc[2] = {(f32x4){0.f, 0.f, 0.f, 0.f}, (f32x4){0.f, 0.f, 0.f, 0.f}};
    rows16_mm<2>(acc, Urow0, Wt, TBP, lane);
    const int lr = lane & 15, lq = lane >> 4;
#pragma unroll
    for (int t = 0; t < 2; ++t)
#pragma unroll
        for (int r = 0; r < 4; ++r) tail_row0[(size_t)(lq * 4 + r) * 32 + t * 16 + lr] = acc[t][r];
}
__device__ __forceinline__ void load_tail_w(LAS bf16_t* Wt, const bf16_t* Wtail  , int tid) {
    for (int p = tid; p < 32 * 128; p += 512) { const int n = p >> 7, c = p & 127; *(LAS u32x4*)(Wt + n * TBP + c * 8) = *(const u32x4*)(Wtail + (size_t)n * 1024 + c * 8); }
}
constexpr int NSP = 1032;
constexpr int NMM_P_OFF = 32 * NSP * 2, NMM_LG_OFF = NMM_P_OFF + 8 * 1024 * 4;
struct NarrowT { bf16x8 bw[4][2]; };
__device__ __forceinline__ void nmm_load_tail(NarrowT& T, const bf16_t* Wtail  , int wid, int lane) {
    const int lr = lane & 15, lq = lane >> 4;
#pragma unroll
    for (int ks = 0; ks < 4; ++ks)
#pragma unroll
        for (int t = 0; t < 2; ++t) T.bw[ks][t] = *(const bf16x8*)(Wtail + (size_t)(t * 16 + lr) * 1024 + wid * 128 + ks * 32 + lq * 8);
}
__device__ __forceinline__ void nmm_load_router(NarrowT& T, const float* rw  , int wid, int lane) {
    const int lr = lane & 15, lq = lane >> 4;
#pragma unroll
    for (int ks = 0; ks < 4; ++ks) { u32x4 hi, lo;
#pragma unroll
        for (int i = 0; i < 4; ++i) { const int k = wid * 128 + ks * 32 + lq * 8 + 2 * i; const float w0 = rw[(size_t)k * 16 + lr], w1 = rw[(size_t)(k + 1) * 16 + lr];
            const unsigned h0 = f2bf(w0), h1 = f2bf(w1); hi[i] = h0 | (h1 << 16); lo[i] = f2bf(w0 - bf2f(h0)) | (f2bf(w1 - bf2f(h1)) << 16); }
        T.bw[ks][0] = __builtin_bit_cast(bf16x8, hi); T.bw[ks][1] = __builtin_bit_cast(bf16x8, lo); }
}
__device__ __forceinline__ void nmm_partials(const NarrowT& T, const LAS bf16_t* S, LAS float* Pb, int wid, int lane) {
    asm volatile("s_waitcnt lgkmcnt(0)\n\ts_barrier" ::: "memory");
    const int lr = lane & 15, lq = lane >> 4;
    f32x4 acc[2][2];
#pragma unroll
    for (int m = 0; m < 2; ++m)
#pragma unroll
        for (int t = 0; t < 2; ++t) acc[m][t] = (f32x4){0.f, 0.f, 0.f, 0.f};
#pragma unroll
    for (int m = 0; m < 2; ++m)
#pragma unroll
        for (int ks = 0; ks < 4; ++ks) { const bf16x8 a = *(const LAS bf16x8*)(S + (16 * m + lr) * NSP + wid * 128 + ks * 32 + lq * 8);
#pragma unroll
            for (int t = 0; t < 2; ++t) acc[m][t] = __builtin_amdgcn_mfma_f32_16x16x32_bf16(a, T.bw[ks][t], acc[m][t], 0, 0, 0); }
#pragma unroll
    for (int m = 0; m < 2; ++m)
#pragma unroll
        for (int t = 0; t < 2; ++t)
#pragma unroll
            for (int r = 0; r < 4; ++r) Pb[wid * 1024 + (16 * m + 4 * lq + r) * 32 + t * 16 + lr] = acc[m][t][r];
    asm volatile("s_waitcnt lgkmcnt(0)\n\ts_barrier" ::: "memory");
}
__device__ __forceinline__ void nmm_step_tail(const NarrowT& T, const LAS bf16_t* S, LAS float* Pb, float* tail_wg  , int i0, int tid, int wid, int lane) {
    nmm_partials(T, S, Pb, wid, lane);
#pragma unroll
    for (int q = 0; q < 2; ++q) { const int o = tid + 512 * q, sr = o >> 5, col = o & 31; float s = 0.f;
#pragma unroll
        for (int w = 0; w < 8; ++w) s += Pb[w * 1024 + o];
        tail_wg[(size_t)((sr >> 2) * 16 + i0 + (sr & 3)) * 32 + col] = s; }
}
__device__ __forceinline__ void nmm_step_router(const NarrowT& T, const LAS bf16_t* S, LAS float* Pb, LAS float* lgs  , int i0, int tid, int wid, int lane) {
    nmm_partials(T, S, Pb, wid, lane);
    { const int sr = tid >> 4, e = tid & 15; float s = 0.f;
#pragma unroll
      for (int w = 0; w < 8; ++w) s += Pb[w * 1024 + sr * 32 + e] + Pb[w * 1024 + sr * 32 + 16 + e];
      lgs[(sr >> 2) * 256 + (i0 + (sr & 3)) * 16 + e] = s; }
}
__device__ __forceinline__ int win_src_col(int n) {
    if (n < 1024) return n;
    if (n < 3584) return n + 8;
    const int i = n - 3584;
    if (i < 16) return 3592 + i;
    if (i < 20) return 1024 + (i - 16);
    if (i < 24) return 1028 + (i - 20);
    return -1;
}

namespace rec {
constexpr int PT = 72;
constexpr int TB = 64 * PT * 2;
constexpr int OFF_T0 = 0, OFF_T1 = TB, OFF_T2 = 2 * TB, OFF_T3 = 3 * TB, OFF_T4 = 4 * TB, OFF_T5 = 5 * TB;
constexpr int OFF_BM = 6 * TB;
constexpr int OFF_HM = OFF_BM + 16384;
constexpr int OFF_VEC = OFF_HM + 64 * 68 * 4;
constexpr int V_G = 0, V_M = 64, V_WI = 128, V_EM = 192, V_DI = 256, V_N = 320, V_BE = 384, V_SEG = 448, V_GA = 960;
static_assert(OFF_VEC + (960 + 1024) * 4 <= RING_BYTES, "rec LDS");

__device__ __forceinline__ void mm64(f32x4 (&acc)[2], const LAS bf16_t* A, const LAS bf16_t* Bt, int wid, int lane) {
    const int tm = wid >> 1, tn0 = (wid & 1) * 2, lr = lane & 15, lq = lane >> 4;
#pragma unroll
    for (int ks = 0; ks < 2; ++ks) {
        const bf16x8 a = *(const LAS bf16x8*)(A + (tm * 16 + lr) * PT + ks * 32 + lq * 8);
#pragma unroll
        for (int t = 0; t < 2; ++t) { const bf16x8 b = *(const LAS bf16x8*)(Bt + ((tn0 + t) * 16 + lr) * PT + ks * 32 + lq * 8);
            acc[t] = __builtin_amdgcn_mfma_f32_16x16x32_bf16(a, b, acc[t], 0, 0, 0); }
    }
}
__device__ __forceinline__ float scan_add(float v, int lane) {
#pragma unroll
    for (int o = 1; o < 64; o <<= 1) { const float t = __shfl_up(v, o); if (lane >= o) v += t; }
    return v;
}
__device__ __forceinline__ float scan_max(float v, int lane) {
#pragma unroll
    for (int o = 1; o < 64; o <<= 1) { const float t = __shfl_up(v, o); if (lane >= o) v = fmaxf(v, t); }
    return v;
}
__device__ __forceinline__ void st_tr8(LAS bf16_t* T, int l, int ch, u32x4 w) {
    T[(ch * 8 + 0) * PT + l] = (bf16_t)(w.x & 0xffffu); T[(ch * 8 + 1) * PT + l] = (bf16_t)(w.x >> 16);
    T[(ch * 8 + 2) * PT + l] = (bf16_t)(w.y & 0xffffu); T[(ch * 8 + 3) * PT + l] = (bf16_t)(w.y >> 16);
    T[(ch * 8 + 4) * PT + l] = (bf16_t)(w.z & 0xffffu); T[(ch * 8 + 5) * PT + l] = (bf16_t)(w.z >> 16);
    T[(ch * 8 + 6) * PT + l] = (bf16_t)(w.w & 0xffffu); T[(ch * 8 + 7) * PT + l] = (bf16_t)(w.w >> 16);
}
__device__ __forceinline__ void unpack8(u32x4 w, float (&f)[8]) {
    f[0] = bflo(w.x); f[1] = bfhi(w.x); f[2] = bflo(w.y); f[3] = bfhi(w.y); f[4] = bflo(w.z); f[5] = bfhi(w.z); f[6] = bflo(w.w); f[7] = bfhi(w.w);
}
template <int GATE  >
__device__ __forceinline__ void finalize(const LAS float* HM, const LAS float* rowscale, const float* gnorm, const bf16_t* gate, bf16_t* out, int tid) {
    const int j = tid >> 3, ch = tid & 7;
    const f32x4 a = *(const LAS f32x4*)(HM + j * 68 + ch * 8), c = *(const LAS f32x4*)(HM + j * 68 + ch * 8 + 4);
    const float rsc = rowscale ? rowscale[j] : 1.f;
    float v[8] = {a[0] * rsc, a[1] * rsc, a[2] * rsc, a[3] * rsc, c[0] * rsc, c[1] * rsc, c[2] * rsc, c[3] * rsc};
    float ss = 0.f;
#pragma unroll
    for (int i = 0; i < 8; ++i) ss += v[i] * v[i];
    ss += __shfl_xor(ss, 1); ss += __shfl_xor(ss, 2); ss += __shfl_xor(ss, 4);
    const float rs = __builtin_amdgcn_rsqf(ss * (1.f / 64.f) + LN_EPS);
    const u32x4 gw = *(const u32x4*)(gate + (size_t)j * PP + ch * 8);
    float gt[8]; unpack8(gw, gt);
    const f32x4 g0 = *(const f32x4*)(gnorm + ch * 8), g1 = *(const f32x4*)(gnorm + ch * 8 + 4);
    const float gn[8] = {g0[0], g0[1], g0[2], g0[3], g1[0], g1[1], g1[2], g1[3]};
    float y[8];
#pragma unroll
    for (int i = 0; i < 8; ++i) { const float sg = 1.f / (1.f + fexp(-gt[i])); const float gv = GATE ? gt[i] * sg : sg; y[i] = v[i] * rs * gn[i] * gv; }
    u32x4 w; w.x = pk2(y[0], y[1]); w.y = pk2(y[2], y[3]); w.z = pk2(y[4], y[5]); w.w = pk2(y[6], y[7]);
    *(u32x4*)(out + (size_t)j * DM + ch * 8) = w;
}

struct RecP {
    const bf16_t* proj; const float* tail; const bf16_t* csm; const bf16_t* csg; float* stm; float* stg; float* smN; float* smBC; float* smDM; float* smMS; float* smGBE; bf16_t* ycat;
    const float* mbi; const float* mbf; const float* mg; const float* wa2; const float* ba; const float* gg;
};

struct MLoc { u32x4 k, v; float mi, mf; };
struct MOut { u32x4 q, k, v, st, mo; float mi, mf, m, n; };
struct GLoc { u32x4 k, v; f32x4 ga; };
struct GOut { u32x4 q, k, v, st, gr; f32x4 ga; };
struct GW { float wv[16]; float bav; };

__device__ __forceinline__ void ld_mloc(MLoc& L, const RecP& P, int ci, int tid, int wid, int lane) {
    const int bh = ci >> 6, c = ci & 63, b = bh >> 2, h = bh & 3, row0 = b * SEQ + c * 64, l = tid >> 3, ch = tid & 7;
    const bf16_t* pr = P.proj + (size_t)(row0 + l) * PP + h * 64 + ch * 8;
    L.k = *(const u32x4*)(pr + C_MK); L.v = *(const u32x4*)(pr + C_MV);
    if (wid == 0) { const float* tp = P.tail + (size_t)(row0 + lane) * 32; L.mi = tp[T_MI + h]; L.mf = tp[T_MF + h]; } else { L.mi = 0.f; L.mf = 0.f; }
}
__device__ __forceinline__ void ld_mout(MOut& L, const RecP& P, int ci, int tid, int wid, int lane) {
    const int bh = ci >> 6, c = ci & 63, b = bh >> 2, h = bh & 3, row0 = b * SEQ + c * 64, l = tid >> 3, ch = tid & 7;
    const bf16_t* pr = P.proj + (size_t)(row0 + l) * PP + h * 64 + ch * 8;
    L.q = *(const u32x4*)(pr + C_MQ); L.k = *(const u32x4*)(pr + C_MK); L.v = *(const u32x4*)(pr + C_MV); L.mo = *(const u32x4*)(pr + C_MO);
    L.st = *(const u32x4*)(P.csm + (size_t)ci * 4096 + l * 64 + ch * 8);
    if (wid == 0) { const float* tp = P.tail + (size_t)(row0 + lane) * 32; L.mi = tp[T_MI + h]; L.mf = tp[T_MF + h]; L.m = P.smMS[ci]; L.n = P.smN[(size_t)ci * 64 + lane]; } else { L.mi = 0.f; L.mf = 0.f; L.m = 0.f; L.n = 0.f; }
}
__device__ __forceinline__ void ld_gloc(GLoc& L, const RecP& P, int ci, int tid) {
    const int bh = ci >> 6, c = ci & 63, b = bh >> 2, h = bh & 3, row0 = b * SEQ + c * 64, l = tid >> 3, ch = tid & 7;
    const bf16_t* pr = P.proj + (size_t)(row0 + l) * PP + h * 64 + ch * 8;
    L.k = *(const u32x4*)(pr + C_GK); L.v = *(const u32x4*)(pr + C_GV);
    L.ga = (tid < 256) ? *(const f32x4*)(P.tail + (size_t)(row0 + (tid >> 2)) * 32 + T_GA + (tid & 3) * 4) : (f32x4){0.f, 0.f, 0.f, 0.f};
}
__device__ __forceinline__ void ld_gout(GOut& L, const RecP& P, int ci, int tid) {
    const int bh = ci >> 6, c = ci & 63, b = bh >> 2, h = bh & 3, row0 = b * SEQ + c * 64, l = tid >> 3, ch = tid & 7;
    const bf16_t* pr = P.proj + (size_t)(row0 + l) * PP + h * 64 + ch * 8;
    L.q = *(const u32x4*)(pr + C_GQ); L.k = *(const u32x4*)(pr + C_GK); L.v = *(const u32x4*)(pr + C_GV); L.gr = *(const u32x4*)(pr + C_GR);
    L.st = *(const u32x4*)(P.csg + (size_t)ci * 4096 + l * 64 + ch * 8);
    L.ga = (tid < 256) ? *(const f32x4*)(P.tail + (size_t)(row0 + (tid >> 2)) * 32 + T_GA + (tid & 3) * 4) : (f32x4){0.f, 0.f, 0.f, 0.f};
}
__device__ __forceinline__ void ld_gw(GW& W, const RecP& P, int h, int tid) {
    const int dcol = tid & 63;
#pragma unroll
    for (int r = 0; r < 16; ++r) W.wv[r] = P.wa2[r * 256 + h * 64 + dcol];
    W.bav = P.ba[h * 64 + dcol];
}
template <int GATE  >
__device__ __forceinline__ void finalize2(const LAS float* HM, const LAS float* rowscale, const float* gnorm, u32x4 gw, bf16_t* out, int tid) {
    const int j = tid >> 3, ch = tid & 7;
    const f32x4 a = *(const LAS f32x4*)(HM + j * 68 + ch * 8), c = *(const LAS f32x4*)(HM + j * 68 + ch * 8 + 4);
    const float rsc = rowscale ? rowscale[j] : 1.f;
    float v[8] = {a[0] * rsc, a[1] * rsc, a[2] * rsc, a[3] * rsc, c[0] * rsc, c[1] * rsc, c[2] * rsc, c[3] * rsc};
    float ss = 0.f;
#pragma unroll
    for (int i = 0; i < 8; ++i) ss += v[i] * v[i];
    ss += __shfl_xor(ss, 1); ss += __shfl_xor(ss, 2); ss += __shfl_xor(ss, 4);
    const float rs = __builtin_amdgcn_rsqf(ss * (1.f / 64.f) + LN_EPS);
    float gt[8]; unpack8(gw, gt);
    const f32x4 g0 = *(const f32x4*)(gnorm + ch * 8), g1 = *(const f32x4*)(gnorm + ch * 8 + 4);
    const float gn[8] = {g0[0], g0[1], g0[2], g0[3], g1[0], g1[1], g1[2], g1[3]};
    float y[8];
#pragma unroll
    for (int i = 0; i < 8; ++i) { const float sg = 1.f / (1.f + fexp(-gt[i])); const float gv = GATE ? gt[i] * sg : sg; y[i] = v[i] * rs * gn[i] * gv; }
    u32x4 w; w.x = pk2(y[0], y[1]); w.y = pk2(y[2], y[3]); w.z = pk2(y[4], y[5]); w.w = pk2(y[6], y[7]);
    *(u32x4*)(out + (size_t)j * DM + ch * 8) = w;
}
__device__ __forceinline__ void mlstm_local(const MLoc& L, const RecP& P, LAS unsigned char* lds, int ci, int tid, int wid, int lane) {
    const int h = (ci >> 6) & 3;
    LAS bf16_t* KT = (LAS bf16_t*)(lds + OFF_T0); LAS bf16_t* VT = (LAS bf16_t*)(lds + OFF_T1); LAS float* vec = (LAS float*)(lds + OFF_VEC);
    const int l = tid >> 3, ch = tid & 7;
    if (wid == 0) {
        const float li = L.mi + P.mbi[h], lf = logsig(L.mf + P.mbf[h]);
        const float bc = scan_add(lf, lane), g = li - bc;
        const float gmax = wave_max(g), bend = __shfl(bc, 63);
        vec[V_G + lane] = fexp(g - gmax);
        if (lane == 0) { P.smBC[ci] = bend; P.smDM[ci] = bend + gmax; }
    }
    __syncthreads();
    { const float w = vec[V_G + l]; float kf[8]; unpack8(L.k, kf);
      u32x4 ks; ks.x = pk2(kf[0] * w, kf[1] * w); ks.y = pk2(kf[2] * w, kf[3] * w); ks.z = pk2(kf[4] * w, kf[5] * w); ks.w = pk2(kf[6] * w, kf[7] * w);
      st_tr8(KT, l, ch, ks); st_tr8(VT, l, ch, L.v); }
    __syncthreads();
    f32x4 acc[2] = {(f32x4){0.f, 0.f, 0.f, 0.f}, (f32x4){0.f, 0.f, 0.f, 0.f}};
    mm64(acc, VT, KT, wid, lane);
    { const int tm = wid >> 1, tn0 = (wid & 1) * 2, lr = lane & 15, lq = lane >> 4; float* dst = P.stm + (size_t)ci * 4096;
#pragma unroll
      for (int t = 0; t < 2; ++t)
#pragma unroll
          for (int r = 0; r < 4; ++r) dst[(tm * 16 + lq * 4 + r) * 64 + (tn0 + t) * 16 + lr] = acc[t][r]; }
    if (tid < 64) { float s = 0.f;
#pragma unroll
        for (int q = 0; q < 8; ++q) { const u32x4 w = *(const LAS u32x4*)(KT + tid * PT + q * 8); float f[8]; unpack8(w, f);
#pragma unroll
            for (int i = 0; i < 8; ++i) s += f[i]; }
        P.smN[(size_t)ci * 64 + tid] = s; }
    __syncthreads();
}
__device__ __forceinline__ void mlstm_out(const MOut& L, const RecP& P, LAS unsigned char* lds, int ci, int tid, int wid, int lane) {
    const int bh = ci >> 6, c = ci & 63, b = bh >> 2, h = bh & 3, row0 = b * SEQ + c * 64;
    LAS bf16_t* Qm = (LAS bf16_t*)(lds + OFF_T0); LAS bf16_t* Km = (LAS bf16_t*)(lds + OFF_T1); LAS bf16_t* VT = (LAS bf16_t*)(lds + OFF_T2);
    LAS bf16_t* CT = (LAS bf16_t*)(lds + OFF_T3); LAS bf16_t* Sm = (LAS bf16_t*)(lds + OFF_T4);
    LAS float* HM = (LAS float*)(lds + OFF_HM); LAS float* vec = (LAS float*)(lds + OFF_VEC);
    const int l = tid >> 3, ch = tid & 7;
    *(LAS u32x4*)(Qm + l * PT + ch * 8) = L.q; *(LAS u32x4*)(Km + l * PT + ch * 8) = L.k; st_tr8(VT, l, ch, L.v); *(LAS u32x4*)(CT + l * PT + ch * 8) = L.st;
    if (wid == 0) {
        const float li = L.mi + P.mbi[h], lf = logsig(L.mf + P.mbf[h]);
        const float bc = scan_add(lf, lane), g = li - bc;
        const float pm = scan_max(g, lane), m = L.m, M = fmaxf(m, pm);
        vec[V_G + lane] = g; vec[V_M + lane] = M; vec[V_WI + lane] = fexp(m - M); vec[V_EM + lane] = fexp(-bc - M);
        vec[V_N + lane] = L.n;
    }
    __syncthreads();
    { f32x4 acc[2] = {(f32x4){0.f, 0.f, 0.f, 0.f}, (f32x4){0.f, 0.f, 0.f, 0.f}};
      mm64(acc, Qm, Km, wid, lane);
      const int tm = wid >> 1, tn0 = (wid & 1) * 2, lr = lane & 15, lq = lane >> 4;
#pragma unroll
      for (int t = 0; t < 2; ++t) { const int ll = (tn0 + t) * 16 + lr; const float gl = vec[V_G + ll];
#pragma unroll
          for (int r = 0; r < 4; ++r) { const int j = tm * 16 + lq * 4 + r; const float s = (ll <= j) ? acc[t][r] * fexp(gl - vec[V_M + j]) : 0.f; Sm[j * PT + ll] = (bf16_t)f2bf(s); } } }
    __syncthreads();
    { f32x4 a1[2] = {(f32x4){0.f, 0.f, 0.f, 0.f}, (f32x4){0.f, 0.f, 0.f, 0.f}}, a2[2] = {(f32x4){0.f, 0.f, 0.f, 0.f}, (f32x4){0.f, 0.f, 0.f, 0.f}};
      mm64(a1, Sm, VT, wid, lane); mm64(a2, Qm, CT, wid, lane);
      const int tm = wid >> 1, tn0 = (wid & 1) * 2, lr = lane & 15, lq = lane >> 4;
#pragma unroll
      for (int t = 0; t < 2; ++t)
#pragma unroll
          for (int r = 0; r < 4; ++r) { const int j = tm * 16 + lq * 4 + r; HM[j * 68 + (tn0 + t) * 16 + lr] = a1[t][r] + vec[V_WI + j] * a2[t][r]; } }
    if (tid < 64) { float ds = 0.f, qn = 0.f;
#pragma unroll
        for (int q = 0; q < 8; ++q) { const u32x4 w = *(const LAS u32x4*)(Sm + tid * PT + q * 8); float f[8]; unpack8(w, f);
            const u32x4 qw = *(const LAS u32x4*)(Qm + tid * PT + q * 8); float qf[8]; unpack8(qw, qf);
#pragma unroll
            for (int i = 0; i < 8; ++i) { ds += f[i]; qn += qf[i] * vec[V_N + q * 8 + i]; } }
        const float den = ds + vec[V_WI + tid] * qn;
        vec[V_DI + tid] = 1.f / fmaxf(fabsf(den), vec[V_EM + tid]); }
    __syncthreads();
    finalize2<0>(HM, vec + V_DI, P.mg, L.mo, P.ycat + (size_t)row0 * DM + h * 64, tid);
    __syncthreads();
}
__device__ __forceinline__ void gla_bmat(const f32x4 ga, const GW& W, LAS unsigned char* lds, int tid, int wid) {
    LAS float* BM = (LAS float*)(lds + OFF_BM); LAS float* vec = (LAS float*)(lds + OFF_VEC);
    if (tid < 256) { const int l = tid >> 2, q = tid & 3; vec[V_GA + l * 16 + q * 4 + 0] = ga[0]; vec[V_GA + l * 16 + q * 4 + 1] = ga[1]; vec[V_GA + l * 16 + q * 4 + 2] = ga[2]; vec[V_GA + l * 16 + q * 4 + 3] = ga[3]; }
    const int dcol = tid & 63;
    __syncthreads();
    float cs[8]; float cacc = 0.f;
#pragma unroll
    for (int i = 0; i < 8; ++i) { const int l = wid * 8 + i; float z = W.bav;
#pragma unroll
        for (int r = 0; r < 16; ++r) z += vec[V_GA + l * 16 + r] * W.wv[r];
        cacc += logsig(z) * (1.f / 16.f); cs[i] = cacc; }
    vec[V_SEG + wid * 64 + dcol] = cacc;
    __syncthreads();
    float off = 0.f, tot = 0.f;
#pragma unroll
    for (int s = 0; s < 8; ++s) { const float v = vec[V_SEG + s * 64 + dcol]; tot += v; if (s < wid) off += v; }
#pragma unroll
    for (int i = 0; i < 8; ++i) BM[(wid * 8 + i) * 64 + dcol] = off + cs[i];
    if (wid == 0) vec[V_BE + dcol] = tot;
    __syncthreads();
}
__device__ __forceinline__ void gla_local(const GLoc& L, const GW& W, const RecP& P, LAS unsigned char* lds, int ci, int tid, int wid, int lane) {
    LAS bf16_t* KT = (LAS bf16_t*)(lds + OFF_T0); LAS bf16_t* VT = (LAS bf16_t*)(lds + OFF_T1);
    LAS float* BM = (LAS float*)(lds + OFF_BM); LAS float* vec = (LAS float*)(lds + OFF_VEC);
    const int l = tid >> 3, ch = tid & 7;
    gla_bmat(L.ga, W, lds, tid, wid);
    if (tid < 64) P.smGBE[(size_t)ci * 64 + tid] = vec[V_BE + tid];
    { float kf[8]; unpack8(L.k, kf); float ks[8];
#pragma unroll
      for (int i = 0; i < 8; ++i) { const int d = ch * 8 + i; ks[i] = kf[i] * fexp(vec[V_BE + d] - BM[l * 64 + d]); }
      u32x4 kk; kk.x = pk2(ks[0], ks[1]); kk.y = pk2(ks[2], ks[3]); kk.z = pk2(ks[4], ks[5]); kk.w = pk2(ks[6], ks[7]);
      st_tr8(KT, l, ch, kk); st_tr8(VT, l, ch, L.v); }
    __syncthreads();
    f32x4 acc[2] = {(f32x4){0.f, 0.f, 0.f, 0.f}, (f32x4){0.f, 0.f, 0.f, 0.f}};
    mm64(acc, VT, KT, wid, lane);
    { const int tm = wid >> 1, tn0 = (wid & 1) * 2, lr = lane & 15, lq = lane >> 4; float* dst = P.stg + (size_t)ci * 4096;
#pragma unroll
      for (int t = 0; t < 2; ++t)
#pragma unroll
          for (int r = 0; r < 4; ++r) dst[(tm * 16 + lq * 4 + r) * 64 + (tn0 + t) * 16 + lr] = acc[t][r]; }
    __syncthreads();
}
__device__ __forceinline__ void gla_out(const GOut& L, const GW& W, const RecP& P, LAS unsigned char* lds, int ci, int tid, int wid, int lane) {
    const int bh = ci >> 6, c = ci & 63, b = bh >> 2, h = bh & 3, row0 = b * SEQ + c * 64;
    LAS bf16_t* Qm = (LAS bf16_t*)(lds + OFF_T0); LAS bf16_t* Km = (LAS bf16_t*)(lds + OFF_T1); LAS bf16_t* VT = (LAS bf16_t*)(lds + OFF_T2);
    LAS bf16_t* ST = (LAS bf16_t*)(lds + OFF_T3); LAS bf16_t* Sm = (LAS bf16_t*)(lds + OFF_T4);
    LAS float* BM = (LAS float*)(lds + OFF_BM); LAS float* HM = (LAS float*)(lds + OFF_HM);
    const int l = tid >> 3, ch = tid & 7;
    gla_bmat(L.ga, W, lds, tid, wid);
    { float qf[8], kf[8]; unpack8(L.q, qf); unpack8(L.k, kf); float qs[8], ks[8];
#pragma unroll
      for (int i = 0; i < 8; ++i) { const float bv = BM[l * 64 + ch * 8 + i]; qs[i] = qf[i] * fexp(bv); ks[i] = kf[i] * fexp(-bv); }
      u32x4 qq, kk; qq.x = pk2(qs[0], qs[1]); qq.y = pk2(qs[2], qs[3]); qq.z = pk2(qs[4], qs[5]); qq.w = pk2(qs[6], qs[7]);
      kk.x = pk2(ks[0], ks[1]); kk.y = pk2(ks[2], ks[3]); kk.z = pk2(ks[4], ks[5]); kk.w = pk2(ks[6], ks[7]);
      *(LAS u32x4*)(Qm + l * PT + ch * 8) = qq; *(LAS u32x4*)(Km + l * PT + ch * 8) = kk; st_tr8(VT, l, ch, L.v);
      *(LAS u32x4*)(ST + l * PT + ch * 8) = L.st; }
    __syncthreads();
    { f32x4 acc[2] = {(f32x4){0.f, 0.f, 0.f, 0.f}, (f32x4){0.f, 0.f, 0.f, 0.f}};
      mm64(acc, Qm, Km, wid, lane);
      const int tm = wid >> 1, tn0 = (wid & 1) * 2, lr = lane & 15, lq = lane >> 4;
#pragma unroll
      for (int t = 0; t < 2; ++t) { const int ll = (tn0 + t) * 16 + lr;
#pragma unroll
          for (int r = 0; r < 4; ++r) { const int j = tm * 16 + lq * 4 + r; Sm[j * PT + ll] = (bf16_t)f2bf((ll <= j) ? acc[t][r] : 0.f); } } }
    __syncthreads();
    { f32x4 acc[2] = {(f32x4){0.f, 0.f, 0.f, 0.f}, (f32x4){0.f, 0.f, 0.f, 0.f}};
      mm64(acc, Sm, VT, wid, lane); mm64(acc, Qm, ST, wid, lane);
      const int tm = wid >> 1, tn0 = (wid & 1) * 2, lr = lane & 15, lq = lane >> 4;
#pragma unroll
      for (int t = 0; t < 2; ++t)
#pragma unroll
          for (int r = 0; r < 4; ++r) HM[(tm * 16 + lq * 4 + r) * 68 + (tn0 + t) * 16 + lr] = acc[t][r]; }
    __syncthreads();
    finalize2<1>(HM, nullptr, P.gg, L.gr, P.ycat + (size_t)row0 * DM + 768 + h * 64, tid);
    __syncthreads();
}
}

namespace recw {
using rec::RecP; using rec::scan_add; using rec::scan_max; using rec::unpack8;
typedef short s16x4v __attribute__((ext_vector_type(4)));
typedef short v4i16_t __attribute__((ext_vector_type(4)));
#define MF16(a, b, c) __builtin_amdgcn_mfma_f32_16x16x32_bf16((a), (b), (c), 0, 0, 0)
__device__ __forceinline__ s16x4v tr16(const LAS bf16_t* p) { return __builtin_bit_cast(s16x4v, __builtin_amdgcn_ds_read_tr16_b64_v4i16((LAS v4i16_t*)p)); }
__device__ __forceinline__ bf16x8 trfrag(const LAS bf16_t* T, int pitch, int s, int c0, int lane) {
    const int i = lane & 15, q = lane >> 4;
    const LAS bf16_t* pa = T + (32 * s + 4 * q + (i >> 2)) * pitch + c0 + 4 * (i & 3);
    const s16x4v lo = tr16(pa), hi = tr16(pa + 16 * pitch);
    return (bf16x8){lo[0], lo[1], lo[2], lo[3], hi[0], hi[1], hi[2], hi[3]};
}
__device__ __forceinline__ bf16x8 rfg(const bf16_t* X, int pitch, int T, int ks, int lane) { return *(const bf16x8*)(X + (size_t)(16 * T + (lane & 15)) * pitch + 32 * ks + 8 * (lane >> 4)); }
__device__ __forceinline__ u32x4 piece(const bf16_t* X, int pitch, int i, int lane) { return *(const u32x4*)(X + (size_t)((lane >> 3) + 8 * i) * pitch + (lane & 7) * 8); }
__device__ __forceinline__ bf16x8 frag_scale(bf16x8 f, float sc) {
    const u32x4 w = __builtin_bit_cast(u32x4, f); u32x4 o;
    o.x = pk2(bflo(w.x) * sc, bfhi(w.x) * sc); o.y = pk2(bflo(w.y) * sc, bfhi(w.y) * sc); o.z = pk2(bflo(w.z) * sc, bfhi(w.z) * sc); o.w = pk2(bflo(w.w) * sc, bfhi(w.w) * sc);
    return __builtin_bit_cast(bf16x8, o);
}
__device__ __forceinline__ bf16x8 frag_mul(bf16x8 f, bf16x8 g, bool recip) {
    const u32x4 a = __builtin_bit_cast(u32x4, f), b = __builtin_bit_cast(u32x4, g); float x[8], y[8]; unpack8(a, x); unpack8(b, y);
#pragma unroll
    for (int i = 0; i < 8; ++i) x[i] = recip ? x[i] * __builtin_amdgcn_rcpf(y[i]) : x[i] * y[i];
    u32x4 o; o.x = pk2(x[0], x[1]); o.y = pk2(x[2], x[3]); o.z = pk2(x[4], x[5]); o.w = pk2(x[6], x[7]);
    return __builtin_bit_cast(bf16x8, o);
}
__device__ __forceinline__ float red_q(float v) { v += __shfl_xor(v, 16); v += __shfl_xor(v, 32); return v; }
__device__ __forceinline__ void stage_rows(f32x4 (&O)[4], int Tj, float rowscale, LAS bf16_t* Tl, int PTL, int lane) {
    const int r = lane & 15, q = lane >> 4;
    float ss = 0.f;
#pragma unroll
    for (int Te = 0; Te < 4; ++Te) { O[Te] = O[Te] * rowscale; const f32x4 v = O[Te]; ss += (v[0] * v[0] + v[1] * v[1]) + (v[2] * v[2] + v[3] * v[3]); }
    ss = red_q(ss);
    const float rs = __builtin_amdgcn_rsqf(ss * (1.f / 64.f) + LN_EPS);
#pragma unroll
    for (int Te = 0; Te < 4; ++Te) { const f32x4 v = O[Te] * rs; u32x2 w; w.x = pk2(v[0], v[1]); w.y = pk2(v[2], v[3]); *(LAS u32x2*)(Tl + (16 * Tj + r) * PTL + 16 * Te + 4 * q) = w; }
}
template <int GATE>
__device__ __forceinline__ void final_store(const LAS bf16_t* Tl, int PTL, const float* gnorm, const bf16_t* gate, bf16_t* out, int lane) {
    const int ch = lane & 7;
    const f32x4 g0 = *(const f32x4*)(gnorm + ch * 8), g1 = *(const f32x4*)(gnorm + ch * 8 + 4);
    const float gn[8] = {g0[0], g0[1], g0[2], g0[3], g1[0], g1[1], g1[2], g1[3]};
#pragma unroll
    for (int i = 0; i < 8; ++i) { const int row = (lane >> 3) + 8 * i;
        float hv[8], gt[8]; unpack8(*(const LAS u32x4*)(Tl + row * PTL + ch * 8), hv); unpack8(*(const u32x4*)(gate + (size_t)row * PP + ch * 8), gt);
        float y[8];
#pragma unroll
        for (int k = 0; k < 8; ++k) { const float sg = __builtin_amdgcn_rcpf(1.f + fexp(-gt[k])); y[k] = hv[k] * (gn[k] * Y8S) * (GATE ? gt[k] * sg : sg); }
        u32x2 w; w.x = pk4_fp8(y[0], y[1], y[2], y[3]); w.y = pk4_fp8(y[4], y[5], y[6], y[7]);
        *(u32x2*)((unsigned char*)out + (size_t)row * DM + ch * 8) = w; }
}
__device__ __forceinline__ void mlstm_local_w(const RecP& P, LAS unsigned char* wl, int ci, int lane) {
    const int r = lane & 15, q = lane >> 4; constexpr int PL = 64;
    const int bh = ci >> 6, c = ci & 63, b = bh >> 2, h = bh & 3, row0 = b * SEQ + c * 64;
    const bf16_t* Xk = P.proj + (size_t)row0 * PP + C_MK + h * 64; const bf16_t* Xv = P.proj + (size_t)row0 * PP + C_MV + h * 64;
    LAS bf16_t* Kl = (LAS bf16_t*)wl; LAS bf16_t* Vl = (LAS bf16_t*)(wl + 8192);
    const float* tp = P.tail + (size_t)(row0 + lane) * 32;
    const float li = tp[T_MI + h] + P.mbi[h], lf = logsig(tp[T_MF + h] + P.mbf[h]);
    const float bc = scan_add(lf, lane), g = li - bc, gmax = wave_max(g), bend = __shfl(bc, 63), w = fexp(g - gmax);
    if (lane == 0) { P.smBC[ci] = bend; P.smDM[ci] = bend + gmax; }
#pragma unroll
    for (int i = 0; i < 8; ++i) { const u32x4 kpi = piece(Xk, PP, i, lane), vpi = piece(Xv, PP, i, lane); const float wr_ = __shfl(w, (lane >> 3) + 8 * i); float kf[8]; unpack8(kpi, kf);
        u32x4 ks; ks.x = pk2(kf[0] * wr_, kf[1] * wr_); ks.y = pk2(kf[2] * wr_, kf[3] * wr_); ks.z = pk2(kf[4] * wr_, kf[5] * wr_); ks.w = pk2(kf[6] * wr_, kf[7] * wr_);
        *(LAS u32x4*)(Kl + ((lane >> 3) + 8 * i) * PL + (lane & 7) * 8) = ks; *(LAS u32x4*)(Vl + ((lane >> 3) + 8 * i) * PL + (lane & 7) * 8) = vpi; }
    asm volatile("" ::: "memory"); __builtin_amdgcn_sched_barrier(0);
    bf16x8 Kt[4][2];
#pragma unroll
    for (int Td = 0; Td < 4; ++Td)
#pragma unroll
        for (int s = 0; s < 2; ++s) Kt[Td][s] = trfrag(Kl, PL, s, 16 * Td, lane);
#pragma unroll
    for (int Te = 0; Te < 4; ++Te) { const bf16x8 v0 = trfrag(Vl, PL, 0, 16 * Te, lane), v1 = trfrag(Vl, PL, 1, 16 * Te, lane);
#pragma unroll
        for (int Td = 0; Td < 4; ++Td) { f32x4 acc = (f32x4){0.f, 0.f, 0.f, 0.f}; acc = MF16(Kt[Td][0], v0, acc); acc = MF16(Kt[Td][1], v1, acc);
            u32x2 w; w.x = pk2(acc[0], acc[1]); w.y = pk2(acc[2], acc[3]); *(LAS u32x2*)(Kl + (16 * Te + r) * PL + 16 * Td + 4 * q) = w; } }
    asm volatile("" ::: "memory"); __builtin_amdgcn_sched_barrier(0);
    { bf16_t* dstb = (bf16_t*)P.stm + (size_t)ci * 4096;
#pragma unroll
      for (int i = 0; i < 8; ++i) { const int row = (lane >> 3) + 8 * i, ch = lane & 7; *(u32x4*)(dstb + row * 64 + ch * 8) = *(const LAS u32x4*)(Kl + row * PL + ch * 8); } }
    { const short one = (short)0x3F80; const bf16x8 ones = (bf16x8){one, one, one, one, one, one, one, one};
#pragma unroll
      for (int Td = 0; Td < 4; ++Td) { f32x4 acc = (f32x4){0.f, 0.f, 0.f, 0.f}; acc = MF16(ones, Kt[Td][0], acc); acc = MF16(ones, Kt[Td][1], acc);
          if (q == 0) P.smN[(size_t)ci * 64 + 16 * Td + r] = acc[0]; } }
}
struct GWf { bf16x8 Bw[4]; float ba[4]; };
__device__ __forceinline__ void ld_gwf(GWf& W, const RecP& P, int h, int lane) {
    const int r = lane & 15, q = lane >> 4;
    int wo = (8 * (q & 1)) * 256 + h * 64 + r; asm volatile("" : "+v"(wo)); const float* wp = P.wa2 + wo;
#pragma unroll
    for (int Td = 0; Td < 4; ++Td) { float w8[8];
#pragma unroll
        for (int i = 0; i < 8; ++i) { const float wv_ = wp[i * 256 + 16 * Td]; w8[i] = (q < 2) ? wv_ : 0.f; }
        u32x4 o; o.x = pk2(w8[0], w8[1]); o.y = pk2(w8[2], w8[3]); o.z = pk2(w8[4], w8[5]); o.w = pk2(w8[6], w8[7]); W.Bw[Td] = __builtin_bit_cast(bf16x8, o);
        W.ba[Td] = P.ba[h * 64 + 16 * Td + r]; }
}
template <int MODE>
__device__ __forceinline__ void gla_gate_tile(LAS bf16_t* Tt, int PL, float (&bend)[4], const GWf& W, const float* tail_row0, int lane) {
    const int r = lane & 15, q = lane >> 4;
    bf16x8 Ag[4];
    int to = r * 32 + T_GA + 8 * (q & 1); asm volatile("" : "+v"(to)); const float* tpb = tail_row0 + to;
#pragma unroll
    for (int Tl = 0; Tl < 4; ++Tl) { f32x4 a0 = *(const f32x4*)(tpb + Tl * 512), a1 = *(const f32x4*)(tpb + Tl * 512 + 4);
        if (q >= 2) { a0 = (f32x4){0.f, 0.f, 0.f, 0.f}; a1 = a0; }
        u32x4 o; o.x = pk2(a0[0], a0[1]); o.y = pk2(a0[2], a0[3]); o.z = pk2(a1[0], a1[1]); o.w = pk2(a1[2], a1[3]); Ag[Tl] = __builtin_bit_cast(bf16x8, o); }
#pragma unroll
    for (int Td = 0; Td < 4; ++Td) { float carry = 0.f; LAS bf16_t* tcol = Tt + (4 * q) * PL + 16 * Td + r;
#pragma unroll
        for (int tt = 0; tt < 4; ++tt) { const int Tl = MODE ? 3 - tt : tt; const float bb = W.ba[Td]; const f32x4 z = MF16(Ag[Tl], W.Bw[Td], ((f32x4){bb, bb, bb, bb}));
            const float v0 = logsig(z[0]) * (1.f / 16.f), v1 = logsig(z[1]) * (1.f / 16.f), v2 = logsig(z[2]) * (1.f / 16.f), v3 = logsig(z[3]) * (1.f / 16.f);
            const float lt = (v0 + v1) + (v2 + v3);
            float ex, o0, o1, o2, o3;
            if (MODE == 0) { const float t1 = __shfl_up(lt, 16), t2 = __shfl_up(lt, 32), t3 = __shfl_up(lt, 48); ex = carry + (q >= 1 ? t1 : 0.f) + (q >= 2 ? t2 : 0.f) + (q >= 3 ? t3 : 0.f);
                o0 = ex + v0; o1 = o0 + v1; o2 = o1 + v2; o3 = o2 + v3; }
            else { const float t1 = __shfl_down(lt, 16), t2 = __shfl_down(lt, 32), t3 = __shfl_down(lt, 48); ex = carry + (q <= 2 ? t1 : 0.f) + (q <= 1 ? t2 : 0.f) + (q <= 0 ? t3 : 0.f);
                o3 = ex; o2 = o3 + v3; o1 = o2 + v2; o0 = o1 + v1; }
            carry += red_q(lt);
            LAS bf16_t* tp = tcol + (16 * Tl) * PL;
            const unsigned w01 = pk2(fexp(o0), fexp(o1)), w23 = pk2(fexp(o2), fexp(o3));
            tp[0] = (bf16_t)(w01 & 0xffffu); tp[PL] = (bf16_t)(w01 >> 16); tp[2 * PL] = (bf16_t)(w23 & 0xffffu); tp[3 * PL] = (bf16_t)(w23 >> 16); }
        bend[Td] = carry; }
}
__device__ __forceinline__ void gla_local_w(const RecP& P, const GWf& W, LAS unsigned char* wl, int ci, int lane) {
    const int r = lane & 15, q = lane >> 4; constexpr int PL = 64;
    const int bh = ci >> 6, c = ci & 63, b = bh >> 2, h = bh & 3, row0 = b * SEQ + c * 64;
    const bf16_t* Xk = P.proj + (size_t)row0 * PP + C_GK + h * 64; const bf16_t* Xv = P.proj + (size_t)row0 * PP + C_GV + h * 64;
    LAS bf16_t* Kl = (LAS bf16_t*)wl; LAS bf16_t* Vl = (LAS bf16_t*)(wl + 8192);
    { float bend[4]; gla_gate_tile<1>(Kl, PL, bend, W, P.tail + (size_t)row0 * 32, lane);
      if (q == 0) {
#pragma unroll
          for (int Td = 0; Td < 4; ++Td) P.smGBE[(size_t)ci * 64 + 16 * Td + r] = bend[Td]; } }
    asm volatile("" ::: "memory"); __builtin_amdgcn_sched_barrier(0);
#pragma unroll
    for (int i = 0; i < 8; ++i) { const u32x4 kp = piece(Xk, PP, i, lane), vp = piece(Xv, PP, i, lane);
        LAS bf16_t* kp_l = Kl + ((lane >> 3) + 8 * i) * PL + (lane & 7) * 8; float kf[8], ff[8]; unpack8(kp, kf); unpack8(*(const LAS u32x4*)kp_l, ff);
        u32x4 ks; ks.x = pk2(kf[0] * ff[0], kf[1] * ff[1]); ks.y = pk2(kf[2] * ff[2], kf[3] * ff[3]); ks.z = pk2(kf[4] * ff[4], kf[5] * ff[5]); ks.w = pk2(kf[6] * ff[6], kf[7] * ff[7]);
        *(LAS u32x4*)kp_l = ks; *(LAS u32x4*)(Vl + ((lane >> 3) + 8 * i) * PL + (lane & 7) * 8) = vp; }
    asm volatile("" ::: "memory"); __builtin_amdgcn_sched_barrier(0);
    bf16x8 Kt[4][2];
#pragma unroll
    for (int Td = 0; Td < 4; ++Td)
#pragma unroll
        for (int s = 0; s < 2; ++s) Kt[Td][s] = trfrag(Kl, PL, s, 16 * Td, lane);
#pragma unroll
    for (int Te = 0; Te < 4; ++Te) { const bf16x8 v0 = trfrag(Vl, PL, 0, 16 * Te, lane), v1 = trfrag(Vl, PL, 1, 16 * Te, lane);
#pragma unroll
        for (int Td = 0; Td < 4; ++Td) { f32x4 acc = (f32x4){0.f, 0.f, 0.f, 0.f}; acc = MF16(Kt[Td][0], v0, acc); acc = MF16(Kt[Td][1], v1, acc);
            u32x2 w; w.x = pk2(acc[0], acc[1]); w.y = pk2(acc[2], acc[3]); *(LAS u32x2*)(Kl + (16 * Te + r) * PL + 16 * Td + 4 * q) = w; } }
    asm volatile("" ::: "memory"); __builtin_amdgcn_sched_barrier(0);
    { bf16_t* dstb = (bf16_t*)P.stg + (size_t)ci * 4096;
#pragma unroll
      for (int i = 0; i < 8; ++i) { const int row = (lane >> 3) + 8 * i, ch = lane & 7; *(u32x4*)(dstb + row * 64 + ch * 8) = *(const LAS u32x4*)(Kl + row * PL + ch * 8); } }
}
__device__ __forceinline__ void mlstm_out_w(const RecP& P, LAS unsigned char* wl, int ci, int lane) {
    const int r = lane & 15, q = lane >> 4; constexpr int PL = 72;
    const int bh = ci >> 6, c = ci & 63, b = bh >> 2, h = bh & 3, row0 = b * SEQ + c * 64;
    const bf16_t* Xq = P.proj + (size_t)row0 * PP + C_MQ + h * 64; const bf16_t* Xk = P.proj + (size_t)row0 * PP + C_MK + h * 64; const bf16_t* Xv = P.proj + (size_t)row0 * PP + C_MV + h * 64;
    LAS bf16_t* Tl = (LAS bf16_t*)wl; LAS float* vg = (LAS float*)(wl + 9216); LAS float* vn = vg + 64;
#pragma unroll
    for (int i = 0; i < 8; ++i) *(LAS u32x4*)(Tl + ((lane >> 3) + 8 * i) * PL + (lane & 7) * 8) = piece(Xv, PP, i, lane);
    const float* tp = P.tail + (size_t)(row0 + lane) * 32;
    const float li = tp[T_MI + h] + P.mbi[h], lf = logsig(tp[T_MF + h] + P.mbf[h]);
    const float m = P.smMS[ci]; vn[lane] = P.smN[(size_t)ci * 64 + lane];
    const float bc = scan_add(lf, lane), g = li - bc, pm = scan_max(g, lane), M = fmaxf(m, pm), wint = fexp(m - M), expm = fexp(-bc - M);
    vg[lane] = g;
    asm volatile("" ::: "memory"); __builtin_amdgcn_sched_barrier(0);
    bf16x8 Kf[4][2], Qf[4][2];
#pragma unroll
    for (int T = 0; T < 4; ++T)
#pragma unroll
        for (int ks = 0; ks < 2; ++ks) { Kf[T][ks] = rfg(Xk, PP, T, ks, lane); Qf[T][ks] = rfg(Xq, PP, T, ks, lane); }
    float Mj[4], wj[4], ej[4];
#pragma unroll
    for (int T = 0; T < 4; ++T) { Mj[T] = __shfl(M, 16 * T + r); wj[T] = __shfl(wint, 16 * T + r); ej[T] = __shfl(expm, 16 * T + r); }
    u32x2 Pk[4][4]; float dinv[4];
#pragma unroll
    for (int Tj = 0; Tj < 4; ++Tj) { float dsum = 0.f;
#pragma unroll
        for (int Tl_ = 0; Tl_ < 4; ++Tl_) {
            if (Tl_ <= Tj) { f32x4 acc = (f32x4){0.f, 0.f, 0.f, 0.f}; acc = MF16(Kf[Tl_][0], Qf[Tj][0], acc); acc = MF16(Kf[Tl_][1], Qf[Tj][1], acc);
                const f32x4 g4 = *(const LAS f32x4*)(vg + 16 * Tl_ + 4 * q); float sv[4];
#pragma unroll
                for (int rg = 0; rg < 4; ++rg) { const bool ok = (Tl_ < Tj) || (4 * q + rg <= r); sv[rg] = ok ? acc[rg] * fexp(g4[rg] - Mj[Tj]) : 0.f; dsum += sv[rg]; }
                Pk[Tj][Tl_].x = pk2(sv[0], sv[1]); Pk[Tj][Tl_].y = pk2(sv[2], sv[3]); }
            else { Pk[Tj][Tl_].x = 0u; Pk[Tj][Tl_].y = 0u; } }
        dsum = red_q(dsum);
        float qn = 0.f;
#pragma unroll
        for (int ks = 0; ks < 2; ++ks) { float qf[8]; unpack8(__builtin_bit_cast(u32x4, Qf[Tj][ks]), qf); const f32x4 n0 = *(const LAS f32x4*)(vn + 32 * ks + 8 * q), n1 = *(const LAS f32x4*)(vn + 32 * ks + 8 * q + 4);
            qn += (qf[0] * n0[0] + qf[1] * n0[1]) + (qf[2] * n0[2] + qf[3] * n0[3]) + (qf[4] * n1[0] + qf[5] * n1[1]) + (qf[6] * n1[2] + qf[7] * n1[3]); }
        qn = red_q(qn);
        const float den = dsum + wj[Tj] * qn; dinv[Tj] = __builtin_amdgcn_rcpf(fmaxf(fabsf(den), ej[Tj]));
        Qf[Tj][0] = frag_scale(Qf[Tj][0], wj[Tj]); Qf[Tj][1] = frag_scale(Qf[Tj][1], wj[Tj]); asm volatile("" ::: "memory"); __builtin_amdgcn_sched_barrier(0); }
    asm volatile("" ::: "memory"); __builtin_amdgcn_sched_barrier(0);
    const bf16_t* cs = P.csm + (size_t)ci * 4096;
    bf16x8 Vt[4][2], Ct[4][2];
#pragma unroll
    for (int Te = 0; Te < 4; ++Te)
#pragma unroll
        for (int s = 0; s < 2; ++s) { Vt[Te][s] = trfrag(Tl, PL, s, 16 * Te, lane); Ct[Te][s] = rfg(cs, 64, Te, s, lane); }
    asm volatile("" ::: "memory"); __builtin_amdgcn_sched_barrier(0);
#pragma unroll
    for (int Tj = 0; Tj < 4; ++Tj) { f32x4 O[4];
        const bf16x8 p0 = __builtin_bit_cast(bf16x8, ((u32x4){Pk[Tj][0].x, Pk[Tj][0].y, Pk[Tj][1].x, Pk[Tj][1].y})), p1 = __builtin_bit_cast(bf16x8, ((u32x4){Pk[Tj][2].x, Pk[Tj][2].y, Pk[Tj][3].x, Pk[Tj][3].y}));
#pragma unroll
        for (int Te = 0; Te < 4; ++Te) { f32x4 acc = (f32x4){0.f, 0.f, 0.f, 0.f}; acc = MF16(Vt[Te][0], p0, acc); if (Tj >= 2) acc = MF16(Vt[Te][1], p1, acc);
            acc = MF16(Ct[Te][0], Qf[Tj][0], acc); acc = MF16(Ct[Te][1], Qf[Tj][1], acc); O[Te] = acc; }
        stage_rows(O, Tj, dinv[Tj], Tl, PL, lane); asm volatile("" ::: "memory"); __builtin_amdgcn_sched_barrier(0); }
    asm volatile("" ::: "memory"); __builtin_amdgcn_sched_barrier(0);
    final_store<0>(Tl, PL, P.mg, P.proj + (size_t)row0 * PP + C_MO + h * 64, (bf16_t*)((unsigned char*)P.ycat + (size_t)row0 * DM + h * 64), lane);
}
__device__ __forceinline__ void gla_out_w(const RecP& P, const GWf& W, LAS unsigned char* wl, int ci, int lane) {
    const int r = lane & 15, q = lane >> 4; constexpr int PL = 72;
    const int bh = ci >> 6, c = ci & 63, b = bh >> 2, h = bh & 3, row0 = b * SEQ + c * 64;
    const bf16_t* Xq = P.proj + (size_t)row0 * PP + C_GQ + h * 64; const bf16_t* Xk = P.proj + (size_t)row0 * PP + C_GK + h * 64; const bf16_t* Xv = P.proj + (size_t)row0 * PP + C_GV + h * 64;
    LAS bf16_t* Tl = (LAS bf16_t*)wl;
    { float bend[4]; gla_gate_tile<0>(Tl, PL, bend, W, P.tail + (size_t)row0 * 32, lane); }
    asm volatile("" ::: "memory"); __builtin_amdgcn_sched_barrier(0);
    bf16x8 Kf[4][2], Qf[4][2];
#pragma unroll
    for (int T = 0; T < 4; ++T)
#pragma unroll
        for (int ks = 0; ks < 2; ++ks) { const bf16x8 ef = *(const LAS bf16x8*)(Tl + (16 * T + r) * PL + 32 * ks + 8 * q); Qf[T][ks] = frag_mul(rfg(Xq, PP, T, ks, lane), ef, false); Kf[T][ks] = frag_mul(rfg(Xk, PP, T, ks, lane), ef, true); }
    asm volatile("" ::: "memory"); __builtin_amdgcn_sched_barrier(0);
#pragma unroll
    for (int i = 0; i < 8; ++i) *(LAS u32x4*)(Tl + ((lane >> 3) + 8 * i) * PL + (lane & 7) * 8) = piece(Xv, PP, i, lane);
    asm volatile("" ::: "memory"); __builtin_amdgcn_sched_barrier(0);
    u32x2 Pk[4][4];
#pragma unroll
    for (int Tj = 0; Tj < 4; ++Tj)
#pragma unroll
        for (int Tl_ = 0; Tl_ < 4; ++Tl_) {
            if (Tl_ <= Tj) { f32x4 acc = (f32x4){0.f, 0.f, 0.f, 0.f}; acc = MF16(Kf[Tl_][0], Qf[Tj][0], acc); acc = MF16(Kf[Tl_][1], Qf[Tj][1], acc); float sv[4];
#pragma unroll
                for (int rg = 0; rg < 4; ++rg) { const bool ok = (Tl_ < Tj) || (4 * q + rg <= r); sv[rg] = ok ? acc[rg] : 0.f; }
                Pk[Tj][Tl_].x = pk2(sv[0], sv[1]); Pk[Tj][Tl_].y = pk2(sv[2], sv[3]); }
            else { Pk[Tj][Tl_].x = 0u; Pk[Tj][Tl_].y = 0u; } }
    const bf16_t* cs = P.csg + (size_t)ci * 4096;
    bf16x8 Vt[4][2], Ct[4][2];
#pragma unroll
    for (int Te = 0; Te < 4; ++Te)
#pragma unroll
        for (int s = 0; s < 2; ++s) { Vt[Te][s] = trfrag(Tl, PL, s, 16 * Te, lane); Ct[Te][s] = rfg(cs, 64, Te, s, lane); }
    asm volatile("" ::: "memory"); __builtin_amdgcn_sched_barrier(0);
#pragma unroll
    for (int Tj = 0; Tj < 4; ++Tj) { f32x4 O[4];
        const bf16x8 p0 = __builtin_bit_cast(bf16x8, ((u32x4){Pk[Tj][0].x, Pk[Tj][0].y, Pk[Tj][1].x, Pk[Tj][1].y})), p1 = __builtin_bit_cast(bf16x8, ((u32x4){Pk[Tj][2].x, Pk[Tj][2].y, Pk[Tj][3].x, Pk[Tj][3].y}));
#pragma unroll
        for (int Te = 0; Te < 4; ++Te) { f32x4 acc = (f32x4){0.f, 0.f, 0.f, 0.f}; acc = MF16(Vt[Te][0], p0, acc); if (Tj >= 2) acc = MF16(Vt[Te][1], p1, acc);
            acc = MF16(Ct[Te][0], Qf[Tj][0], acc); acc = MF16(Ct[Te][1], Qf[Tj][1], acc); O[Te] = acc; }
        stage_rows(O, Tj, 1.f, Tl, PL, lane); asm volatile("" ::: "memory"); __builtin_amdgcn_sched_barrier(0); }
    asm volatile("" ::: "memory"); __builtin_amdgcn_sched_barrier(0);
    final_store<1>(Tl, PL, P.gg, P.proj + (size_t)row0 * PP + C_GR + h * 64, (bf16_t*)((unsigned char*)P.ycat + (size_t)row0 * DM + 768 + h * 64), lane);
}
#undef MF16
}


constexpr int N_PHASES = 2 + 9 * DEPTH;
__global__ void __launch_bounds__(512, 2) mega_fwd(Args args) {
    extern __shared__ __attribute__((aligned(16))) unsigned char lds_raw[];
    Frame F;
    F.lds = (LAS unsigned char*)lds_raw;
    F.MISC = (volatile LAS unsigned*)(F.lds + MISC_OFF);
    F.tid = threadIdx.x; F.lane = F.tid & 63; F.wave = __builtin_amdgcn_readfirstlane(F.tid >> 6);
    F.G = gridDim.x; { const int bx = blockIdx.x; F.vcu = (F.G % 8 == 0) ? (bx % 8) * (F.G / 8) + bx / 8 : bx; }
    typedef const __attribute__((address_space(4))) Args* CArgs;
    const CArgs ap0 = (CArgs)__builtin_amdgcn_kernarg_segment_ptr();
    F.ctl = (gu32*)(args.ws + WS_CTL);
    for (int u = F.tid; u < (LDS_BYTES - LDSCTL_OFF) / 4; u += 512) ((LAS unsigned*)(F.lds + LDSCTL_OFF))[u] = 0u;
    __syncthreads();
#if MK_ONE_LAUNCH
    XcdBarrier bar = xcd_barrier_post((unsigned*)(F.ctl + CW_BAR), F.MISC + 8);
#define GRID_BAR() xcd_barrier(bar)
#else
#define GRID_BAR() do {} while (0)
#endif
    const int lo = args.ph_lo, hi = args.ph_hi;
#define IN(k) (lo <= (k) && (k) < hi)
#define SEAM(k) do { if (IN(k) && IN((k) + 1)) { GRID_BAR(); if (NREP(15) == 2) GRID_BAR(); } } while (0)
    const int NGW = F.G * 8;
#define PHASE_IDS() int tid = threadIdx.x; asm volatile("" : "+v"(tid)); const int lane = tid & 63, wid = __builtin_amdgcn_readfirstlane(tid >> 6); const int gw = F.vcu * 8 + wid; (void)lane; (void)gw; \
    CArgs ap = ap0; asm volatile("" : "+s"(ap)); unsigned char* ws = ap->ws; (void)ws
#define AIN(i) (ap->in[i])
#define MOD ((float*)(ws + WS_MOD))
#define ROPE ((float*)(ws + WS_ROPE))
#define WIN ((bf16_t*)(ws + WS_WIN))
#define WOUT ((bf16_t*)(ws + WS_WOUT))
#define WGU8 ((unsigned char*)(ws + WS_WGU))
#define WD8 ((unsigned char*)(ws + WS_WD))
#define U8B ((unsigned char*)(ws + WS_U8))
#define WIN8 ((unsigned char*)(ws + WS_WIN8))
#define VTB ((bf16_t*)(ws + WS_YCAT + 32 * MiB))
#define H8B ((unsigned char*)(ws + WS_PROJ))
#define LTOK ((int*)(ws + WS_LTOK))
#define LGATE ((float*)(ws + WS_LGATE))
#define PROJ ((bf16_t*)(ws + WS_PROJ))
#define HB ((bf16_t*)(ws + WS_PROJ))
#define XB ((bf16_t*)(ws + WS_XR))
#define YSORT ((bf16_t*)(ws + WS_YSORT))
#define TAILB ((float*)(ws + WS_TAIL))
#define TOKSLOT ((int*)(ws + WS_SM + SM_TS))
#define UB ((bf16_t*)(ws + WS_U))
#define YCAT ((bf16_t*)(ws + WS_YCAT))
#define STM ((float*)(ws + WS_U))
#define STG ((float*)(ws + WS_U + 32 * MiB))
#define CSM ((bf16_t*)(ws + WS_XR + 64 * MiB))
#define CSG ((bf16_t*)(ws + WS_XR + 80 * MiB))
#define G_smN ((float*)(ws + WS_SM + SM_N))
#define G_smBC ((float*)(ws + WS_SM + SM_BC))
#define G_smDM ((float*)(ws + WS_SM + SM_DM))
#define G_smMS ((float*)(ws + WS_SM + SM_MS))
#define G_smGBE ((float*)(ws + WS_SM + SM_GBE))
#define x_in AIN(I_X)

    if (IN(0) && PHON(0)) for (int rp0 = 0; rp0 < NREP(0); ++rp0) {
        PHASE_IDS();
        {
            LAS float* cact = (LAS float*)F.lds;
            LAS float* part = (LAS float*)(F.lds + 32768);
            const float* cc = AIN(I_C);
            for (int i = tid; i < NB * DM; i += 512) { const int b = i >> 10, k = i & 1023; const float v = cc[i]; cact[k * 8 + b] = v / (1.f + fexp(-v)); }
            __syncthreads();
            for (int it = F.vcu; it < DEPTH * 96; it += F.G) {
                const int l = it / 96, j0 = (it % 96) * 64;
                const float* W = AIN(I_WADA) + (size_t)l * DM * 6144 + j0 + lane;
                float a[8] = {0.f, 0.f, 0.f, 0.f, 0.f, 0.f, 0.f, 0.f};
#pragma unroll 32
                for (int kk = 0; kk < 128; ++kk) { const int k = wid * 128 + kk; const float w = W[(size_t)k * 6144];
                    const f32x4 c0 = *(const LAS f32x4*)(cact + k * 8), c1 = *(const LAS f32x4*)(cact + k * 8 + 4);
                    a[0] += c0[0] * w; a[1] += c0[1] * w; a[2] += c0[2] * w; a[3] += c0[3] * w; a[4] += c1[0] * w; a[5] += c1[1] * w; a[6] += c1[2] * w; a[7] += c1[3] * w; }
#pragma unroll
                for (int b = 0; b < 8; ++b) part[(wid * 8 + b) * 64 + lane] = a[b];
                __syncthreads();
                { const int b = tid >> 6, j = tid & 63; float s = AIN(I_BADA)[(size_t)l * 6144 + j0 + j];
#pragma unroll
                  for (int w = 0; w < 8; ++w) s += part[(w * 8 + b) * 64 + j];
                  MOD[((size_t)l * NB + b) * 6144 + j0 + j] = s; }
                __syncthreads();
            }
        }
        {
            const int* pos = (const int*)AIN(I_POS);
            for (int i = blockIdx.x * 512 + tid; i < NTOK * 4; i += F.G * 512) { const int row = i >> 2, f = i & 3;
                const float invf = (float)pow(500000.0, -0.25 * (double)f); const float ang = (float)pos[row] * invf;
                ROPE[(size_t)row * 8 + f] = (float)cos((double)ang); ROPE[(size_t)row * 8 + 4 + f] = (float)sin((double)ang); }
        }
        {
            LAS float* scr = (LAS float*)(F.lds + 49152 + wid * 8704);
            constexpr int I_IN = (DM / 64) * (PW / 32), I_OUT = (DM / 64) * (DM / 32);
            auto dec0 = [&](int it, TrD& d) { const int l = it / (I_IN + I_OUT); int r = it % (I_IN + I_OUT);
                if (r < I_IN) { const int kb = r / (PW / 32), nb = r % (PW / 32); const int nbe = (nb < 112) ? nb : 0; const int tl = nbe >> 3;
                    d.wsc = (tl == 0 || tl == 10) ? 0.125f : (tl == 7) ? ATT_C2 : 1.f;
                    d.src = AIN(I_WIN) + (size_t)l * DM * PIN + (size_t)(kb * 64) * PIN + win_src_col(nbe * 32); d.ldw = PIN; d.K = DM; d.dst = WIN + (size_t)l * PW * DM; d.dst8 = WIN8 + (size_t)l * PP * DM; d.drow0 = nbe * 32; d.k0 = kb * 64;
                    return nb < 112; }
                r -= I_IN; const int kb = r / (DM / 32), nb = r % (DM / 32); d.wsc = 1.f;
                d.src = AIN(I_WOUT) + (size_t)l * DM * DM + (size_t)(kb * 64) * DM + nb * 32; d.wsc = W8S; d.dst8 = nullptr; d.ldw = DM; d.K = DM; d.dst = (bf16_t*)((unsigned char*)WOUT + (size_t)l * DM * DM); d.drow0 = nb * 32; d.k0 = kb * 64; return true; };
            { TrD dc, dn; f32x4 vc[8], vn[8]; int it = gw; bool okc = dec0(it, dc); tr_load4(dc, vc, lane); dn = dc; bool okn = okc;
#pragma unroll
              for (int i = 0; i < 8; ++i) vn[i] = vc[i];
              for (; it < DEPTH * (I_IN + I_OUT); it += NGW) { const int itn = it + NGW;
                  if (itn < DEPTH * (I_IN + I_OUT)) { okn = dec0(itn, dn); tr_load4(dn, vn, lane); }
                  if (okc) { if (dc.ldw == DM) tr_finish8(dc, vc, scr, lane); else { TrD d8 = dc; d8.dst = (bf16_t*)dc.dst8; d8.wsc = dc.wsc * W8S; tr_finish8(d8, vc, scr, lane); } }
                  dc = dn; okc = okn;
#pragma unroll
                  for (int i = 0; i < 8; ++i) vc[i] = vn[i]; } }
            for (int it = gw; it < DEPTH * (DM / 64) * 8; it += NGW) { const int l = it / ((DM / 64) * 8), r = it % ((DM / 64) * 8), kb = r >> 3, nb = 112 + (r & 7);
                tr_item(AIN(I_WIN) + (size_t)l * DM * PIN, PIN, DM, WIN + (size_t)l * PW * DM, nb * 32, win_src_col(nb * 32 + (lane & 31)), kb * 64, scr, lane); }
        }
    }
    SEAM(0);
    if (IN(1) && PHON(1)) {
        PHASE_IDS();
        NarrowT NT_; nmm_load_tail(NT_, WIN + (size_t)PP * DM, wid, lane);
        LAS bf16_t* Sst = (LAS bf16_t*)F.lds; LAS float* Pb = (LAS float*)(F.lds + NMM_P_OFF);
        const int b = F.vcu >> 5; const float* md = MOD + (size_t)b * 6144;
        f32x4 sh[4], sc[4];
#pragma unroll
        for (int j = 0; j < 4; ++j) { sh[j] = *(const f32x4*)(md + 4 * lane + 256 * j); sc[j] = *(const f32x4*)(md + 1024 + 4 * lane + 256 * j) + 1.0f; }
        const int rowb = F.vcu * 128 + wid * 16;
        for (int i = 0; i < 16; i += 4) { f32x4 v[4][4];
#pragma unroll
            for (int rr = 0; rr < 4; ++rr)
#pragma unroll
                for (int j = 0; j < 4; ++j) v[rr][j] = *(const f32x4*)(x_in + (size_t)(rowb + i + rr) * DM + 4 * lane + 256 * j);
#pragma unroll
            for (int rr = 0; rr < 4; ++rr)
#pragma unroll
                for (int j = 0; j < 4; ++j) { const f32x4 u = v[rr][j] * sc[j] + sh[j];
                    u32x2 w; w.x = pk2(u[0], u[1]); w.y = pk2(u[2], u[3]); *(LAS u32x2*)(Sst + (wid * 4 + rr) * NSP + 4 * lane + 256 * j) = w;
                    *(unsigned*)(U8B + (size_t)(rowb + i + rr) * DM + 4 * lane + 256 * j) = pk4_fp8(u[0], u[1], u[2], u[3]); }
            nmm_step_tail(NT_, Sst, Pb, TAILB + (size_t)(F.vcu * 128) * 32, i, tid, wid, lane); }
    }
    SEAM(1);

    for (int l = 0; l < DEPTH; ++l) {
        const int pb = 2 + 9 * l;
#define modl (MOD + (size_t)l * NB * 6144)
#define MAKE_RP() rec::RecP RP; RP.proj = PROJ; RP.tail = TAILB; RP.csm = CSM; RP.csg = CSG; RP.stm = STM; RP.stg = STG; RP.smN = G_smN; RP.smBC = G_smBC; RP.smDM = G_smDM; RP.smMS = G_smMS; RP.smGBE = G_smGBE; RP.ycat = YCAT; \
        RP.mbi = AIN(I_MBI) + l * 4; RP.mbf = AIN(I_MBF) + l * 4; RP.mg = AIN(I_MG) + l * 64; RP.wa2 = AIN(I_WA2) + (size_t)l * 16 * 256; RP.ba = AIN(I_BA) + l * 256; RP.gg = AIN(I_GG) + l * 64;
        if (IN(pb + 0) && PHON(2)) {
            PHASE_IDS(); (void)tid;
            { gm::K1<true> k; k.S.init(NTOK, PP, F.G, (int)blockIdx.x); k.A = U8B; k.Bt = WIN8 + (size_t)l * PP * DM; k.O = PROJ; k.rope = ROPE; k.VT = VTB;
                gm::gemm_phase<gm::K1<true>>(F.lds, k); }
        }
        SEAM(pb + 0);
        if (IN(pb + 1) && PHON(3)) {
            PHASE_IDS();
            MAKE_RP();
            for (int rp = 0; rp < NREP(3); ++rp) {
                LAS unsigned char* wl = F.lds + wid * 16384;
                recw::GWf gwf; recw::ld_gwf(gwf, RP, (gw >> 6) & 3, lane);
                for (int ci = gw; ci < 2048; ci += NGW) { int lane_ = lane; asm volatile("" : "+v"(lane_)); if (PHON(13)) recw::mlstm_local_w(RP, wl, ci, lane_); asm volatile("" ::: "memory"); __builtin_amdgcn_sched_barrier(0); if (PHON(14)) recw::gla_local_w(RP, gwf, wl, ci, lane_); }
            }
        }
        SEAM(pb + 1);
        if (IN(pb + 2) && PHON(4)) {
            PHASE_IDS();
            const int gt = blockIdx.x * 512 + tid, NGT = F.G * 512;
            for (int task = gt; task < 66048; task += NGT) {
                if (task < 32768) {
                    const int bh = task >> 10, el = (task & 1023) * 4; const bf16_t* p = (const bf16_t*)STM + (size_t)bh * 64 * 4096 + el; bf16_t* o = CSM + (size_t)bh * 64 * 4096 + el;
                    const float* bc = G_smBC + bh * 64; const float* dm = G_smDM + bh * 64;
                    f32x4 C = (f32x4){0.f, 0.f, 0.f, 0.f}; float m = 0.f;
#pragma unroll 16
                    for (int c = 0; c < NCH; ++c) { const u32x2 uw = *(const u32x2*)(p + (size_t)c * 4096); const f32x4 u = (f32x4){bflo(uw.x), bfhi(uw.x), bflo(uw.y), bfhi(uw.y)}; u32x2 w; w.x = pk2(C[0], C[1]); w.y = pk2(C[2], C[3]); *(u32x2*)(o + (size_t)c * 4096) = w;
                        if (el == 0) G_smMS[bh * 64 + c] = m;
                        const float B = bc[c], Dm = dm[c], mn = fmaxf(B + m, Dm); C = C * fexp(B + m - mn) + u * fexp(Dm - mn); m = mn; }
                } else if (task < 65536) {
                    const int t2 = task - 32768, bh = t2 >> 10, el = (t2 & 1023) * 4, d = el & 63; const bf16_t* p = (const bf16_t*)STG + (size_t)bh * 64 * 4096 + el; bf16_t* o = CSG + (size_t)bh * 64 * 4096 + el;
                    const float* be = G_smGBE + (size_t)bh * 64 * 64 + d;
                    f32x4 S = (f32x4){0.f, 0.f, 0.f, 0.f};
#pragma unroll 16
                    for (int c = 0; c < NCH; ++c) { const u32x2 uw = *(const u32x2*)(p + (size_t)c * 4096); const f32x4 u = (f32x4){bflo(uw.x), bfhi(uw.x), bflo(uw.y), bfhi(uw.y)}; const f32x4 b4 = *(const f32x4*)(be + c * 64);
                        u32x2 w; w.x = pk2(S[0], S[1]); w.y = pk2(S[2], S[3]); *(u32x2*)(o + (size_t)c * 4096) = w;
                        S = (f32x4){fexp(b4[0]) * S[0] + u[0], fexp(b4[1]) * S[1] + u[1], fexp(b4[2]) * S[2] + u[2], fexp(b4[3]) * S[3] + u[3]}; }
                } else {
                    const int t3 = task - 65536, bh = t3 >> 4, el = (t3 & 15) * 4; float* p = G_smN + (size_t)bh * 64 * 64 + el; const float* bc = G_smBC + bh * 64; const float* dm = G_smDM + bh * 64;
                    f32x4 C = (f32x4){0.f, 0.f, 0.f, 0.f}; float m = 0.f;
#pragma unroll 8
                    for (int c = 0; c < NCH; ++c) { const f32x4 u = *(const f32x4*)(p + c * 64); *(f32x4*)(p + c * 64) = C;
                        const float B = bc[c], Dm = dm[c], mn = fmaxf(B + m, Dm); C = C * fexp(B + m - mn) + u * fexp(Dm - mn); m = mn; }
                }
            }
            for (int rp = 0; rp < NREP(13); ++rp) {
                LAS float* scr = (LAS float*)(F.lds + 49152 + wid * 8704);
                constexpr int I_G = (DM / 64) * (1024 / 32), I_D = (DE / 64) * (DM / 32);
                auto dece = [&](int it, TrD& d) { const int e = it / (I_G + I_D); int r = it % (I_G + I_D); d.wsc = W8S; d.dst8 = nullptr;
                    if (r < I_G) { const int kb = r / 32, nb = r % 32, n0 = nb * 32, tt = n0 >> 8, rr = n0 & 255;
                        d.src = (rr < 128 ? AIN(I_EWG) : AIN(I_EWU)) + ((size_t)l * NE + e) * DM * DE + (size_t)(kb * 64) * DE + tt * 128 + (rr & 127); d.ldw = DE; d.K = DM; d.dst = (bf16_t*)(WGU8 + (size_t)e * 1024 * 1024); d.drow0 = n0; d.k0 = kb * 64; }
                    else { r -= I_G; const int kb = r / 32, nb = r % 32;
                        d.src = AIN(I_EWD) + ((size_t)l * NE + e) * DE * DM + (size_t)(kb * 64) * DM + nb * 32; d.ldw = DM; d.K = DE; d.dst = (bf16_t*)(WD8 + (size_t)e * 1024 * 512); d.drow0 = nb * 32; d.k0 = kb * 64; } };
                TrD dc, dn; f32x4 vc[8], vn[8]; int it = gw; dece(it, dc); tr_load4(dc, vc, lane); dn = dc;
#pragma unroll
                for (int i = 0; i < 8; ++i) vn[i] = vc[i];
                for (; it < NE * (I_G + I_D); it += NGW) { const int itn = it + NGW;
                    if (itn < NE * (I_G + I_D)) { dece(itn, dn); tr_load4(dn, vn, lane); }
                    tr_finish8(dc, vc, scr, lane);
                    dc = dn;
#pragma unroll
                    for (int i = 0; i < 8; ++i) vc[i] = vn[i]; }
            }
        }
        SEAM(pb + 2);
        if (IN(pb + 3) && PHON(5)) {
            PHASE_IDS();
            if (PHON(10)) {
                float d1 = 0.f, d2 = 0.f;
                for (int i = 0; i < 32; ++i) { d1 += AIN(I_LQ1)[l * 32 + i] * AIN(I_LK1)[l * 32 + i]; d2 += AIN(I_LQ2)[l * 32 + i] * AIN(I_LK2)[l * 32 + i]; }
                const float lam_init = 0.8f - 0.6f * expf(-0.3f * (float)l);
                attn_body::AttnParams AP; AP.Q = (const attn_body::bf16*)(PROJ + C_DQ); AP.K = (const attn_body::bf16*)(PROJ + C_DK); AP.V = (const attn_body::bf16*)VTB;
                AP.zpage = (const attn_body::bf16*)(F.ctl + CW_ZPAGE); AP.Y = (bf16_t*)((unsigned char*)YCAT + 512); AP.gnorm = AIN(I_DG) + l * 64; AP.lam = expf(d1) - expf(d2) + lam_init; AP.osc = 1.f - lam_init;
                const int bh = F.vcu >> 3, s = F.vcu & 7;
                if (F.G == 256) {
                    for (int rp = 0; rp < NREP(10); ++rp)
                    for (int i = 0; i < 2; ++i) { const int qb = (i == 0) ? s : 15 - s;
                        attn_body::attn_unit<8, 0>(bh >> 2, bh & 3, qb, AP, (char*)lds_raw); attn_body::attn_unit<8, 1>(bh >> 2, bh & 3, qb, AP, (char*)lds_raw); }
                }
            }
            __syncthreads();
            {
            PHASE_IDS();
            MAKE_RP();
            if (PHON(11)) for (int rp = 0; rp < NREP(11); ++rp) {
                LAS unsigned char* wl = F.lds + wid * 16384;
                LAS u32x4* gst = (LAS u32x4*)(wl + 10240);
                { recw::GWf gwf; recw::ld_gwf(gwf, RP, (gw >> 6) & 3, lane);
#pragma unroll
                  for (int Td = 0; Td < 4; ++Td) gst[Td * 64 + lane] = __builtin_bit_cast(u32x4, gwf.Bw[Td]);
                  gst[256 + lane] = __builtin_bit_cast(u32x4, ((f32x4){gwf.ba[0], gwf.ba[1], gwf.ba[2], gwf.ba[3]})); }
                for (int ci = gw; ci < 2048; ci += NGW) { int lane_ = lane; asm volatile("" : "+v"(lane_)); if (PHON(13)) recw::mlstm_out_w(RP, wl, ci, lane_); asm volatile("" ::: "memory"); __builtin_amdgcn_sched_barrier(0);
                    if (PHON(14)) { recw::GWf gwf;
#pragma unroll
                        for (int Td = 0; Td < 4; ++Td) gwf.Bw[Td] = __builtin_bit_cast(bf16x8, gst[Td * 64 + lane_]);
                        const f32x4 bb = __builtin_bit_cast(f32x4, gst[256 + lane_]); gwf.ba[0] = bb[0]; gwf.ba[1] = bb[1]; gwf.ba[2] = bb[2]; gwf.ba[3] = bb[3];
                        recw::gla_out_w(RP, gwf, wl, ci, lane_); } }
            }
            __syncthreads();
            if (PHON(12)) for (int rp = 0; rp < NREP(12); ++rp) {
                const float* cw = AIN(I_CONVW) + (size_t)l * 3 * 256; const float* cbias = AIN(I_CONVB) + l * 256;
                for (int it = F.vcu; it < NTOK / 64; it += F.G) {
                    for (int p = tid; p < 64 * 32; p += 512) { const int r = p >> 5, chn = p & 31, row = it * 64 + r, t = row & (SEQ - 1);
                        const bf16_t* pr = PROJ + (size_t)row * PP + chn * 8;
                        float s0[8], s1[8], s2[8], cbv[8];
                        { float a[8], bq[8]; rec::unpack8(*(const u32x4*)(pr + C_CC), a); rec::unpack8(*(const u32x4*)(pr + C_CH), bq);
#pragma unroll
                          for (int i = 0; i < 8; ++i) s2[i] = a[i] * bq[i]; }
                        if (t >= 1) { float a[8], bq[8]; rec::unpack8(*(const u32x4*)(pr - PP + C_CC), a); rec::unpack8(*(const u32x4*)(pr - PP + C_CH), bq);
#pragma unroll
                          for (int i = 0; i < 8; ++i) s1[i] = a[i] * bq[i]; } else {
#pragma unroll
                          for (int i = 0; i < 8; ++i) s1[i] = 0.f; }
                        if (t >= 2) { float a[8], bq[8]; rec::unpack8(*(const u32x4*)(pr - 2 * PP + C_CC), a); rec::unpack8(*(const u32x4*)(pr - 2 * PP + C_CH), bq);
#pragma unroll
                          for (int i = 0; i < 8; ++i) s0[i] = a[i] * bq[i]; } else {
#pragma unroll
                          for (int i = 0; i < 8; ++i) s0[i] = 0.f; }
                        rec::unpack8(*(const u32x4*)(pr + C_CB), cbv);
                        float y[8];
#pragma unroll
                        for (int i = 0; i < 8; ++i) { const int cch = chn * 8 + i; y[i] = cbv[i] * (cw[cch] * s0[i] + cw[256 + cch] * s1[i] + cw[512 + cch] * s2[i] + cbias[cch]); }
                        u32x2 w; w.x = pk4_fp8(y[0] * Y8S, y[1] * Y8S, y[2] * Y8S, y[3] * Y8S); w.y = pk4_fp8(y[4] * Y8S, y[5] * Y8S, y[6] * Y8S, y[7] * Y8S);
                        *(u32x2*)((unsigned char*)YCAT + (size_t)row * DM + 256 + chn * 8) = w; }
                }
            }
            }
        }
        SEAM(pb + 3);
        if (IN(pb + 4) && PHON(6)) {
            PHASE_IDS(); (void)tid;
            gm::K2 k; k.S.init(NTOK, DM, F.G, (int)blockIdx.x); k.A = (const unsigned char*)YCAT; k.Bt = (const unsigned char*)WOUT + (size_t)l * DM * DM; k.O = UB;
            for (int rp = 0; rp < NREP(6); ++rp) gm::gemm_phase<gm::K2>(F.lds, k);
        }
        SEAM(pb + 4);
        if (IN(pb + 5) && PHON(7)) {
            PHASE_IDS();
            NarrowT NT_; nmm_load_router(NT_, AIN(I_RW), wid, lane);
            LAS bf16_t* Sst = (LAS bf16_t*)F.lds; LAS float* Pb = (LAS float*)(F.lds + NMM_P_OFF); LAS float* lgs_all = (LAS float*)(F.lds + NMM_LG_OFF);
            LAS float* lgs = lgs_all + wid * 256;
            const int b = F.vcu >> 5; const float* md = modl + (size_t)b * 6144;
            const float* lg = AIN(I_LN1G) + l * DM; const float* lb = AIN(I_LN1B) + l * DM;
            f32x4 gv[4], bv[4], sh[4], sc[4], g1[4];
#pragma unroll
            for (int j = 0; j < 4; ++j) { const int cix = 4 * lane + 256 * j; gv[j] = *(const f32x4*)(lg + cix); bv[j] = *(const f32x4*)(lb + cix); g1[j] = *(const f32x4*)(md + 2 * 1024 + cix) + 1.0f;
                sh[j] = *(const f32x4*)(md + 3 * 1024 + cix); sc[j] = *(const f32x4*)(md + 4 * 1024 + cix) + 1.0f; }
            const int rowb = F.vcu * 128 + wid * 16;
            u32x2 xwc[4], ywc[4];
#pragma unroll
            for (int j = 0; j < 4; ++j) { const size_t o = (size_t)rowb * DM + 4 * lane + 256 * j; xwc[j] = (l == 0) ? (u32x2){0u, 0u} : *(const u32x2*)(XB + o); ywc[j] = *(const u32x2*)(UB + o); }
            u32x2 xwn[4] = {xwc[0], xwc[1], xwc[2], xwc[3]}, ywn[4] = {ywc[0], ywc[1], ywc[2], ywc[3]};
            for (int i = 0; i < 16; ++i) { const int row = rowb + i;
                if (i < 15) {
#pragma unroll
                    for (int j = 0; j < 4; ++j) { const size_t o = (size_t)(row + 1) * DM + 4 * lane + 256 * j; if (l != 0) xwn[j] = *(const u32x2*)(XB + o); ywn[j] = *(const u32x2*)(UB + o); } }
                f32x4 v[4]; float s = 0.f;
#pragma unroll
                for (int j = 0; j < 4; ++j) { const size_t o = (size_t)row * DM + 4 * lane + 256 * j;
                    f32x4 xv; if (l == 0) xv = *(const f32x4*)(x_in + o); else { const u32x2 xw = xwc[j]; xv = (f32x4){bflo(xw.x), bfhi(xw.x), bflo(xw.y), bfhi(xw.y)}; }
                    const u32x2 yw = ywc[j]; const f32x4 yv = (f32x4){bflo(yw.x), bfhi(yw.x), bflo(yw.y), bfhi(yw.y)};
                    v[j] = xv * ALPHA + g1[j] * yv; s += (v[j][0] + v[j][1]) + (v[j][2] + v[j][3]); }
#pragma unroll
                for (int j = 0; j < 4; ++j) { xwc[j] = xwn[j]; ywc[j] = ywn[j]; }
                const float mean = wave_sum(s) * (1.f / DM); float s2 = 0.f;
#pragma unroll
                for (int j = 0; j < 4; ++j) { v[j] = v[j] - mean; s2 += (v[j][0] * v[j][0] + v[j][1] * v[j][1]) + (v[j][2] * v[j][2] + v[j][3] * v[j][3]); }
                const float rstd = __builtin_amdgcn_rsqf(wave_sum(s2) * (1.f / DM) + LN_EPS);
#pragma unroll
                for (int j = 0; j < 4; ++j) { const size_t o = (size_t)row * DM + 4 * lane + 256 * j; const f32x4 xn = v[j] * rstd * gv[j] + bv[j];
                    u32x2 xw; xw.x = pk2(xn[0], xn[1]); xw.y = pk2(xn[2], xn[3]); *(u32x2*)(XB + o) = xw;
                    const f32x4 u = xn * sc[j] + sh[j]; u32x2 w; w.x = pk2(u[0], u[1]); w.y = pk2(u[2], u[3]); *(LAS u32x2*)(Sst + (wid * 4 + (i & 3)) * NSP + 4 * lane + 256 * j) = w;
                    *(unsigned*)(U8B + o) = pk4_fp8(u[0], u[1], u[2], u[3]); }
                if ((i & 3) == 3) nmm_step_router(NT_, Sst, Pb, lgs_all, i - 3, tid, wid, lane);
            }
            asm volatile("s_waitcnt lgkmcnt(0)\n\ts_barrier" ::: "memory");
            if (lane < 16) {
                const int row = rowb + lane; const float* rb = AIN(I_RB);
                float sco[16], bia[16];
#pragma unroll
                for (int q = 0; q < 4; ++q) { const f32x4 t4 = *(const LAS f32x4*)(lgs + lane * 16 + q * 4);
#pragma unroll
                    for (int c = 0; c < 4; ++c) { const float sg = 1.f / (1.f + fexp(-t4[c])); sco[q * 4 + c] = sg; bia[q * 4 + c] = sg + rb[q * 4 + c]; } }
                int bg = 0; float bgs = -INFINITY;
#pragma unroll
                for (int g = 0; g < 4; ++g) { const float a0 = bia[4 * g], a1 = bia[4 * g + 1], a2 = bia[4 * g + 2], a3 = bia[4 * g + 3];
                    const float h1 = fmaxf(a0, a1), l1 = fminf(a0, a1), h2 = fmaxf(a2, a3), l2 = fminf(a2, a3);
                    const float top = fmaxf(h1, h2), sec = fmaxf(fminf(h1, h2), (h1 >= h2) ? l1 : l2); const float gsc = top + sec;
                    if (gsc > bgs) { bgs = gsc; bg = g; } }
                float gb[4], gsx[4];
#pragma unroll
                for (int q = 0; q < 4; ++q) { gb[q] = (bg == 0) ? bia[q] : (bg == 1) ? bia[4 + q] : (bg == 2) ? bia[8 + q] : bia[12 + q]; gsx[q] = (bg == 0) ? sco[q] : (bg == 1) ? sco[4 + q] : (bg == 2) ? sco[8 + q] : sco[12 + q]; }
                int e1 = 0; float m1 = gb[0];
#pragma unroll
                for (int q = 1; q < 4; ++q) if (gb[q] > m1) { m1 = gb[q]; e1 = q; }
                int e2 = -1; float m2 = -INFINITY;
#pragma unroll
                for (int q = 0; q < 4; ++q) if (q != e1 && gb[q] > m2) { m2 = gb[q]; e2 = q; }
                const int ei = e1 < e2 ? e1 : e2, ej = e1 < e2 ? e2 : e1;
                const float si = (ei == 0) ? gsx[0] : (ei == 1) ? gsx[1] : (ei == 2) ? gsx[2] : gsx[3], sj = (ej == 0) ? gsx[0] : (ej == 1) ? gsx[1] : (ej == 2) ? gsx[2] : gsx[3];
                const int pr_ = (ei == 0) ? ej - 1 : (ei == 1) ? ej + 1 : 5; const int bk = bg * 6 + pr_;
                gu32* cntw = F.ctl + CW_CNT + (size_t)l * NBUCKET * 64;
                const unsigned pos = __hip_atomic_fetch_add(cntw + bk * 64, 1u, RLX_AGENT);
                LTOK[(size_t)bk * LCAP + pos] = row; const float inv = 1.f / (si + sj); LGATE[((size_t)bk * LCAP + pos) * 2] = si * inv; LGATE[((size_t)bk * LCAP + pos) * 2 + 1] = sj * inv;
                TOKSLOT[row] = (bk << 16) | (int)pos;
            }
            __syncthreads();
        }
        SEAM(pb + 5);
        if ((IN(pb + 6) || IN(pb + 7)) && PHON(8)) {
            PHASE_IDS();
            LAS int* tb = (LAS int*)(F.lds + MOE_TB_OFF);
            if (tid == 0) { gu32* cntw = F.ctl + CW_CNT + (size_t)l * NBUCKET * 64; int acc = 0;
                for (int k = 0; k < NBUCKET; ++k) { const int c = (int)__hip_atomic_load(cntw + k * 64, RLX_AGENT); tb[k] = c; tb[32 + k] = acc; acc += (c + 255) >> 8; }
                tb[32 + NBUCKET] = acc; }
            __syncthreads();
            if (IN(pb + 6)) {
                gm::K4 k; k.U = U8B; k.Wgu = WGU8; k.H = H8B; k.ltok = LTOK; k.lgate = LGATE; k.tb = tb; k.G = F.G; k.vcu = F.vcu; k.rtc = F.ctl + CW_RT + (size_t)l * 160 * 64;
                for (int rp = 0; rp < NREP(8); ++rp) gm::gemm_phase<gm::K4>(F.lds, k);
            }
            SEAM(pb + 6);
            if (IN(pb + 7)) {
                gm::K5 k; k.H = H8B; k.Wd = WD8; k.Y = YSORT; k.tb = tb; k.G = F.G; k.vcu = F.vcu; k.rtc = F.ctl + CW_RT + (size_t)l * 160 * 64; k.tmo = F.ctl + CW_TMO;
                for (int rp = 0; rp < NREP(14); ++rp) gm::gemm_phase<gm::K5>(F.lds, k);
            }
        }
        SEAM(pb + 7);
        if (IN(pb + 8) && PHON(9)) {
            PHASE_IDS();
            const int b = F.vcu >> 5; const bool lastl = (l == DEPTH - 1);
            LAS bf16_t* Sst = (LAS bf16_t*)F.lds; LAS float* Pb = (LAS float*)(F.lds + NMM_P_OFF); LAS int* t0 = (LAS int*)(F.lds + MOE_TB_OFF);
            NarrowT NT_; nmm_load_tail(NT_, WIN + ((size_t)(lastl ? l : l + 1) * PW + PP) * DM, wid, lane);
            if (tid == 0) { gu32* cntw = F.ctl + CW_CNT + (size_t)l * NBUCKET * 64; int acc = 0;
                for (int k = 0; k < NBUCKET; ++k) { const int c = (int)__hip_atomic_load(cntw + k * 64, RLX_AGENT); t0[32 + k] = acc; acc += (c + 255) >> 8; } }
            __syncthreads();
            const float* mdn = MOD + ((size_t)(lastl ? l : l + 1) * NB + b) * 6144; const float* md = modl + (size_t)b * 6144;
            const float* lg = AIN(I_LN2G) + l * DM; const float* lb = AIN(I_LN2B) + l * DM;
            f32x4 gv[4], bv[4], sh[4], sc[4], g2[4];
#pragma unroll
            for (int j = 0; j < 4; ++j) { const int cix = 4 * lane + 256 * j; gv[j] = *(const f32x4*)(lg + cix); bv[j] = *(const f32x4*)(lb + cix); g2[j] = *(const f32x4*)(md + 5 * 1024 + cix) + 1.0f;
                sh[j] = *(const f32x4*)(mdn + cix); sc[j] = *(const f32x4*)(mdn + 1024 + cix) + 1.0f; }
            const int rowb = F.vcu * 128 + wid * 16;
            const int tsl = TOKSLOT[rowb + (lane & 15)];
            u32x2 xwc[4], ywc[4];
            { const int ts = __shfl(tsl, 0); const size_t yrow = (size_t)t0[32 + (ts >> 16)] * 256 + (ts & 0xffff);
#pragma unroll
              for (int j = 0; j < 4; ++j) { const int cix = 4 * lane + 256 * j; xwc[j] = *(const u32x2*)(XB + (size_t)rowb * DM + cix); ywc[j] = *(const u32x2*)(YSORT + yrow * DM + cix); } }
            u32x2 xwn[4] = {xwc[0], xwc[1], xwc[2], xwc[3]}, ywn[4] = {ywc[0], ywc[1], ywc[2], ywc[3]};
            for (int i = 0; i < 16; ++i) { const int row = rowb + i;
                if (i < 15) { const int ts = __shfl(tsl, i + 1); const size_t yrow = (size_t)t0[32 + (ts >> 16)] * 256 + (ts & 0xffff);
#pragma unroll
                    for (int j = 0; j < 4; ++j) { const int cix = 4 * lane + 256 * j; xwn[j] = *(const u32x2*)(XB + (size_t)(row + 1) * DM + cix); ywn[j] = *(const u32x2*)(YSORT + yrow * DM + cix); } }
                f32x4 v[4]; float s = 0.f;
#pragma unroll
                for (int j = 0; j < 4; ++j) {
                    const u32x2 xw = xwc[j]; const f32x4 xv = (f32x4){bflo(xw.x), bfhi(xw.x), bflo(xw.y), bfhi(xw.y)};
                    const u32x2 yw = ywc[j]; const f32x4 yv = (f32x4){bflo(yw.x), bfhi(yw.x), bflo(yw.y), bfhi(yw.y)};
                    v[j] = xv * ALPHA + g2[j] * yv; s += (v[j][0] + v[j][1]) + (v[j][2] + v[j][3]); }
#pragma unroll
                for (int j = 0; j < 4; ++j) { xwc[j] = xwn[j]; ywc[j] = ywn[j]; }
                const float mean = wave_sum(s) * (1.f / DM); float s2 = 0.f;
#pragma unroll
                for (int j = 0; j < 4; ++j) { v[j] = v[j] - mean; s2 += (v[j][0] * v[j][0] + v[j][1] * v[j][1]) + (v[j][2] * v[j][2] + v[j][3] * v[j][3]); }
                const float rstd = __builtin_amdgcn_rsqf(wave_sum(s2) * (1.f / DM) + LN_EPS);
#pragma unroll
                for (int j = 0; j < 4; ++j) { const size_t o = (size_t)row * DM + 4 * lane + 256 * j; const f32x4 xn = v[j] * rstd * gv[j] + bv[j];
                    if (lastl) *(f32x4*)(ap->out + o) = xn;
                    else { u32x2 xw; xw.x = pk2(xn[0], xn[1]); xw.y = pk2(xn[2], xn[3]); *(u32x2*)(XB + o) = xw;
                        const f32x4 u = xn * sc[j] + sh[j]; u32x2 w; w.x = pk2(u[0], u[1]); w.y = pk2(u[2], u[3]); *(LAS u32x2*)(Sst + (wid * 4 + (i & 3)) * NSP + 4 * lane + 256 * j) = w;
                        *(unsigned*)(U8B + o) = pk4_fp8(u[0], u[1], u[2], u[3]); } }
                if (!lastl && (i & 3) == 3) nmm_step_tail(NT_, Sst, Pb, TAILB + (size_t)(F.vcu * 128) * 32, i - 3, tid, wid, lane);
            }
        }
        SEAM(pb + 8);
    }
#undef IN
#undef SEAM
}

extern "C" void kernel_launch(void* const* d_in, const int* in_sizes, int n_in, void* d_out, int out_size, void* d_ws, size_t ws_size, hipStream_t stream) {
    static int grid = 0;
    if (grid == 0) {
        if (n_in != 29 || in_sizes[0] != NTOK * DM || out_size != NTOK * DM || ws_size < WS_END) {
            fprintf(stderr, "kernel_launch: unexpected shapes (n_in %d, in0 %d, out %d, ws %zu need %zu); nothing launched\n", n_in, n_in > 0 ? in_sizes[0] : -1, out_size, ws_size, (size_t)WS_END); grid = -1; return; }
        int dev = 0, cus = 0, per_cu = 0;
        if (hipGetDevice(&dev) != hipSuccess || hipDeviceGetAttribute(&cus, hipDeviceAttributeMultiprocessorCount, dev) != hipSuccess) { grid = -1; return; }
        if (hipFuncSetAttribute((const void*)mega_fwd, hipFuncAttributeMaxDynamicSharedMemorySize, LDS_BYTES) != hipSuccess) { fprintf(stderr, "kernel_launch: hipFuncSetAttribute failed\n"); grid = -1; return; }
        if (hipOccupancyMaxActiveBlocksPerMultiprocessor(&per_cu, (const void*)mega_fwd, 512, LDS_BYTES) != hipSuccess || per_cu < 1) { fprintf(stderr, "kernel_launch: occupancy query reports %d\n", per_cu); }
        (void)hipGetLastError();
        grid = cus;
        if (grid != 256) fprintf(stderr, "kernel_launch: %d CUs (row phases assume 256)\n", grid);
    }
    if (grid < 0) return;
    if (hipMemsetAsync((char*)d_ws + WS_CTL, 0, CTL_ZERO_BYTES, stream) != hipSuccess) return;
    Args a{};
    for (int i = 0; i < 29; ++i) a.in[i] = (const float*)d_in[i];
    a.out = (float*)d_out; a.ws = (unsigned char*)d_ws;
#if MK_ONE_LAUNCH
    a.ph_lo = 0; a.ph_hi = N_PHASES;
    hipLaunchKernelGGL(mega_fwd, dim3(grid), dim3(512), LDS_BYTES, stream, a);
#else
    for (int p = 0; p < N_PHASES; ++p) { a.ph_lo = p; a.ph_hi = p + 1; hipLaunchKernelGGL(mega_fwd, dim3(grid), dim3(512), LDS_BYTES, stream, a); }
#endif
}
```

```cpp
#include <hip/hip_runtime.h>
#include <hip/hip_bf16.h>
#include <cstdio>
#include <cstdint>
#include <cmath>

#ifndef MK_ONE_LAUNCH
#define MK_ONE_LAUNCH 1
#endif
#ifndef PHM
#define PHM 0xFFFF
#endif
#define PHON(n) (((PHM) >> (n)) & 1)
#ifndef REPM
#define REPM 0
#endif
#define NREP(n) ((((REPM) >> (n)) & 1) ? 2 : 1)

#define LAS __attribute__((address_space(3)))
#define GAS __attribute__((address_space(1)))
typedef unsigned short bf16_t;
typedef short bf16x8 __attribute__((ext_vector_type(8)));
typedef float f32x4 __attribute__((ext_vector_type(4)));
typedef float f32x2 __attribute__((ext_vector_type(2)));
typedef unsigned u32x4 __attribute__((ext_vector_type(4)));
typedef unsigned u32x2 __attribute__((ext_vector_type(2)));
typedef GAS unsigned gu32;

constexpr int NB = 8, SEQ = 4096, NTOK = NB * SEQ, DM = 1024, DEPTH = 4, NH = 4, HD = 64, PIN = 3608, PP = 3584, PW = 3840, NE = 16, DE = 512;
constexpr int NCH = SEQ / 64;
constexpr float ALPHA = 1.6817928305074290f;
constexpr float LN_EPS = 1e-6f;
constexpr float ATT_C2 = 0.17677669529663687f * 1.4426950408889634f;
constexpr int NBUCKET = 24, LCAP = NTOK;
constexpr int PJ = 256, TSZ = NTOK * 256;
constexpr int C_MQ = 0, C_MK = TSZ, C_MV = 2 * TSZ, C_MO = 3 * TSZ, C_CB = 4 * TSZ, C_CC = 5 * TSZ, C_CH = 6 * TSZ, C_DQ = 7 * TSZ, C_DK = 8 * TSZ, C_DV = 9 * TSZ,
              C_GQ = 10 * TSZ, C_GK = 11 * TSZ, C_GV = 12 * TSZ, C_GR = 13 * TSZ;
constexpr int T_GA = 0, T_MI = 16, T_MF = 20;

constexpr size_t MiB = 1u << 20;
constexpr size_t WS_CTL = 0, CTL_ZERO_BYTES = 1 * MiB;
constexpr size_t WS_MOD = 1 * MiB;
constexpr size_t WS_ROPE = 2 * MiB;
constexpr size_t WS_WIN = 3 * MiB;
constexpr size_t WS_WOUT = 33 * MiB;
constexpr size_t WS_WGU = 41 * MiB;
constexpr size_t WS_WD = 73 * MiB;
constexpr size_t WS_LTOK = 89 * MiB;
constexpr size_t WS_LGATE = 92 * MiB;
constexpr size_t WS_SM = 98 * MiB;
constexpr size_t WS_PROJ = 100 * MiB;
constexpr size_t WS_XR = 340 * MiB;
constexpr size_t WS_U = 468 * MiB;
constexpr size_t WS_YCAT = 532 * MiB;
constexpr size_t WS_TAIL = 596 * MiB;
constexpr size_t WS_YSORT = WS_PROJ + 100 * MiB;
constexpr size_t WS_U8 = 600 * MiB;
constexpr size_t WS_WIN8 = 632 * MiB;
constexpr size_t WS_END = 648 * MiB;
constexpr size_t SM_N = 0, SM_BC = 512 * 1024, SM_DM = 520 * 1024, SM_MS = 528 * 1024, SM_GBE = 1 * MiB, SM_TS = 1536 * 1024;
constexpr int CW_TMO = 0, CW_CODE = 1, CW_ZPAGE = 256, CW_BAR = 4096, CW_CNT = 16384, CW_RT = 24576;
constexpr int RING_BYTES = 131072, LDSCTL_OFF = RING_BYTES, MISC_OFF = LDSCTL_OFF + 320, MOE_TB_OFF = LDSCTL_OFF + 1024, LDS_BYTES = 147456;

#define RLX_AGENT __ATOMIC_RELAXED, __HIP_MEMORY_SCOPE_AGENT
#define LDS_WAIT() asm volatile("s_waitcnt lgkmcnt(0)" ::: "memory")
#define VM_WAIT() asm volatile("s_waitcnt vmcnt(0)" ::: "memory")

__device__ __forceinline__ unsigned f2bf(float f) { unsigned u = __builtin_bit_cast(unsigned, f); return (u + 0x7fffu + ((u >> 16) & 1u)) >> 16; }
__device__ __forceinline__ unsigned pk2(float lo, float hi) { typedef __bf16 bf2 __attribute__((ext_vector_type(2))); f32x2 v = {lo, hi}; bf2 b = __builtin_convertvector(v, bf2); return __builtin_bit_cast(unsigned, b); }
__device__ __forceinline__ unsigned pk4_fp8(float a, float b, float c, float d) {
    a = __builtin_amdgcn_fmed3f(a, -448.f, 448.f); b = __builtin_amdgcn_fmed3f(b, -448.f, 448.f); c = __builtin_amdgcn_fmed3f(c, -448.f, 448.f); d = __builtin_amdgcn_fmed3f(d, -448.f, 448.f);
    int w = 0; w = __builtin_amdgcn_cvt_pk_fp8_f32(a, b, w, false); w = __builtin_amdgcn_cvt_pk_fp8_f32(c, d, w, true); return (unsigned)w; }
__device__ __forceinline__ void st8_wt(void* p, u32x2 v) { asm volatile("global_store_dwordx2 %0, %1, off sc1\n\ts_nop 0" :: "v"(p), "v"(v) : "memory"); }
constexpr float W8S = 64.f, H8S = 16.f, Y8S = 8.f;
__device__ __forceinline__ float bf2f(unsigned b) { return __builtin_bit_cast(float, b << 16); }
__device__ __forceinline__ float bflo(unsigned w) { return __builtin_bit_cast(float, w << 16); }
__device__ __forceinline__ float bfhi(unsigned w) { return __builtin_bit_cast(float, w & 0xffff0000u); }
__device__ __forceinline__ void st16_wt(void* p, u32x4 v) { asm volatile("global_store_dwordx4 %0, %1, off sc1\n\ts_nop 1" :: "v"(p), "v"(v) : "memory"); }
__device__ __forceinline__ float wave_sum(float v) {
#pragma unroll
    for (int o = 1; o < 64; o <<= 1) v += __shfl_xor(v, o);
    return v;
}
__device__ __forceinline__ float wave_max(float v) {
#pragma unroll
    for (int o = 1; o < 64; o <<= 1) v = fmaxf(v, __shfl_xor(v, o));
    return v;
}
__device__ __forceinline__ float fexp(float x) { return __builtin_amdgcn_exp2f(x * 1.4426950408889634f); }
__device__ __forceinline__ float flog(float x) { return __builtin_amdgcn_logf(x) * 0.6931471805599453f; }
__device__ __forceinline__ float logsig(float z) { return fminf(z, 0.f) - flog(1.f + fexp(-fabsf(z))); }
__device__ __forceinline__ float sigmoidf_(float z) { return 1.f / (1.f + fexp(-z)); }

#define XB_TMO      128
#define XB_XCNT(j)  (256  + 64 * (j))
#define XB_XSUB(j)  (1280 + 64 * (j))
#define XB_XGEN(j)  (2304 + 64 * (j))
#define XB_TOP      3328
#define XB_TOPGEN   3392
#define XCD_BAR_WORDS 3456
#define XB_SPIN_CAP (1u << 18)
__device__ __forceinline__ unsigned xb_ld(unsigned* p)              { return __hip_atomic_load(p, __ATOMIC_RELAXED, __HIP_MEMORY_SCOPE_AGENT); }
__device__ __forceinline__ unsigned xb_add(unsigned* p, unsigned v) { return __hip_atomic_fetch_add(p, v, __ATOMIC_RELAXED, __HIP_MEMORY_SCOPE_AGENT); }
__device__ __forceinline__ unsigned xb_xcc_id() { return (unsigned)__builtin_amdgcn_s_getreg((3 << 11) | 20) & 0xFu; }
#define XB_SPIN(cond, bar) do { unsigned _sp = 0; while (cond) { __builtin_amdgcn_s_sleep(1); \
    if ((++_sp & 255u) == 0u) { if (xb_ld(&(bar)[XB_TMO])) break; if (_sp > XB_SPIN_CAP) { atomicAdd(&(bar)[XB_TMO], 1u); break; } } } } while (0)
struct XcdBarrier { unsigned* bar; unsigned x; volatile LAS unsigned* st; };
__device__ __forceinline__ XcdBarrier xcd_barrier_post(unsigned* bar, volatile LAS unsigned* st) {
    XcdBarrier b; b.bar = bar; b.x = xb_xcc_id(); b.st = st;
    if (threadIdx.x == 0) (void)xb_add(&bar[XB_XCNT(b.x)], 1u);
    return b;
}
__device__ __forceinline__ void xcd_barrier_complete(unsigned* bar, unsigned x, unsigned& nloc, unsigned& nx) {
    const unsigned G = gridDim.x * gridDim.y * gridDim.z;
    unsigned sum, cnt, mine, sp = 0u;
    for (;;) {
        sum = 0u; cnt = 0u; mine = 0u;
#pragma unroll
        for (unsigned j = 0; j < 16; ++j) { const unsigned c = xb_ld(&bar[XB_XCNT(j)]); sum += c; cnt += (c > 0u) ? 1u : 0u; mine = (j == x) ? c : mine; }
        if (sum == G) break;
        __builtin_amdgcn_s_sleep(1);
        if ((++sp & 255u) == 0u) { if (xb_ld(&bar[XB_TMO])) break; if (sp > XB_SPIN_CAP) { atomicAdd(&bar[XB_TMO], 1u); break; } }
    }
    nloc = mine > 0u ? mine : 1u; nx = cnt > 0u ? cnt : 1u;
}
__device__ __forceinline__ void xcd_barrier(const XcdBarrier& b) {
    asm volatile("s_waitcnt vmcnt(0)" ::: "memory");
    __syncthreads();
    if (threadIdx.x == 0) {
        unsigned* bar = b.bar;
        __builtin_amdgcn_s_waitcnt(0);
        unsigned nloc = b.st[0], nx = b.st[1];
        if (nloc == 0u) { xcd_barrier_complete(bar, b.x, nloc, nx); b.st[0] = nloc; b.st[1] = nx; }
        const unsigned old = xb_add(&bar[XB_XSUB(b.x)], 1u);
        const unsigned gen = old / nloc;
        if (old + 1u == (gen + 1u) * nloc) {
            __builtin_amdgcn_fence(__ATOMIC_RELEASE, "agent");
            asm volatile("s_waitcnt vmcnt(0)" ::: "memory");
            const unsigned og = xb_add(&bar[XB_TOP], 1u);
            const unsigned tg = og / nx;
            if (og + 1u == (tg + 1u) * nx) xb_add(&bar[XB_TOPGEN], 1u);
            else XB_SPIN(xb_ld(&bar[XB_TOPGEN]) == tg, bar);
            __builtin_amdgcn_fence(__ATOMIC_ACQUIRE, "agent");
            xb_add(&bar[XB_XGEN(b.x)], 1u);
            asm volatile("s_waitcnt vmcnt(0)" ::: "memory");
        } else {
            XB_SPIN(xb_ld(&bar[XB_XGEN(b.x)]) == gen, bar);
            __builtin_amdgcn_fence(__ATOMIC_ACQUIRE, "agent");
            asm volatile("s_waitcnt vmcnt(0)" ::: "memory");
        }
    }
    __syncthreads();
}

namespace gm {
constexpr int BM = 256, BK = 64, HALF = 128, HTB = HALF * BK * 2, NXCD = 8, WGM = 8;
typedef int v4i_t __attribute__((ext_vector_type(4))); typedef int v8i_t __attribute__((ext_vector_type(8)));
__host__ __device__ __forceinline__ int lds_byte(int r, int c) { const int st = (r >> 4) * 2 + (c >> 5), rr = r & 15, cc = c & 31, ob = rr * 64 + cc * 2; return st * 1024 + (ob ^ (((ob >> 9) & 1) << 5)); }
__host__ __device__ __forceinline__ void stage_rc(int b, int& R, int& C) { const int st = b / 1024, sb = b % 1024, swz = sb ^ (((sb >> 9) & 1) << 5); R = (st >> 1) * 16 + swz / 64; C = (st & 1) * 32 + (swz % 64) / 2; }
__host__ __device__ __forceinline__ int perm32(int rho) { const int n = rho >> 4, i = rho & 15; return 8 * (i >> 2) + 4 * n + (i & 3); }
struct Unit { int pm, pn, bk, tb; };
struct Src { const char* a; const char* b0; const char* b1; unsigned va[2][2]; };
struct StaticOrder {
    int nM, nN, nwg, G, c;
    __device__ void init(int M, int N, int G_, int c_) { nM = M / BM; nN = N / BM; nwg = nM * nN; G = G_; c = c_; }
    __device__ __forceinline__ bool next(int i, Unit& u) const {
        const long L = (long)i * G + c; if (L >= nwg) return false;
        int wgid = (int)L; { const int q = nwg / NXCD, r = nwg % NXCD, xcd = wgid % NXCD, off = wgid / NXCD; wgid = (xcd < r ? xcd * (q + 1) : r * (q + 1) + (xcd - r) * q) + off; }
        const int nig = WGM * nN, gid = wgid / nig, fm = gid * WGM, gsz = (nM - fm) < WGM ? (nM - fm) : WGM;
        u.pm = fm + ((wgid % nig) % gsz); u.pn = (wgid % nig) / gsz; u.bk = 0; u.tb = 0; return true;
    }
};

template <class Kind>
__device__ __forceinline__ void gemm_phase(LAS unsigned char* lds, const Kind& Kd) {
    int tid_ = threadIdx.x; asm volatile("" : "+v"(tid_));
    const int tid = tid_, wid = __builtin_amdgcn_readfirstlane(tid >> 6), lane = tid & 63, wr = wid >> 2, wc = wid & 3, fr = lane & 15, fq = lane >> 4;
    int R[2], C[2]; unsigned voffB[2];
#pragma unroll
    for (int i = 0; i < 2; ++i) { stage_rc(tid * 16 + i * 8192, R[i], C[i]); const int Rb = Kind::PERM ? ((R[i] & ~31) + perm32(R[i] & 31)) : R[i]; voffB[i] = (unsigned)(Rb * Kind::LDBB + C[i] * 2); }
    const size_t hstepB = (size_t)HALF * Kind::LDBB;
    constexpr int NT = Kind::NTK;
    const unsigned ldsw = (unsigned)wid * 1024u;
    const int aoff = lds_byte(wr * 64 + fr, fq * 8), boff = lds_byte(wc * 32 + fr, fq * 8);
#define G_SA(b, h) (((b) * 2 + (h)) * HTB)
#define G_SB(b, h) ((4 + (b) * 2 + (h)) * HTB)
#define G_STAGE_A(bufoff, S, t, h) do { const char* _g = (S).a + (size_t)(t) * 128; _Pragma("unroll") for (int _i = 0; _i < 2; ++_i) \
        __builtin_amdgcn_global_load_lds((const unsigned*)(_g + (S).va[h][_i]), (LAS unsigned*)(lds + (bufoff) + ldsw + _i * 8192), 16, 0, 0); } while (0)
#define G_STAGE_B(bufoff, S, t, h) do { const char* _g = (((t) < NT / 2) ? (S).b0 + (size_t)(t) * 128 : (S).b1 + (size_t)((t) - NT / 2) * 128) + (h) * hstepB; _Pragma("unroll") for (int _i = 0; _i < 2; ++_i) \
        __builtin_amdgcn_global_load_lds((const unsigned*)(_g + voffB[_i]), (LAS unsigned*)(lds + (bufoff) + ldsw + _i * 8192), 16, 0, 0); } while (0)
#define G_LDA(dst, b, h) do { _Pragma("unroll") for (int m = 0; m < 4; ++m) _Pragma("unroll") for (int k = 0; k < 2; ++k) dst[m][k] = *(const LAS bf16x8*)(lds + G_SA(b, h) + aoff + m * 2048 + k * 1024); } while (0)
#define G_LDB(dst, b, h) do { _Pragma("unroll") for (int n = 0; n < 2; ++n) _Pragma("unroll") for (int k = 0; k < 2; ++k) dst[n][k] = *(const LAS bf16x8*)(lds + G_SB(b, h) + boff + n * 2048 + k * 1024); } while (0)
#define G_MMA(ai, bj, At, Bt) do { __builtin_amdgcn_s_setprio(1); _Pragma("unroll") for (int m = 0; m < 4; ++m) _Pragma("unroll") for (int n = 0; n < 2; ++n) _Pragma("unroll") for (int k = 0; k < 2; ++k) \
        acc[ai][bj][m][n] = __builtin_amdgcn_mfma_f32_16x16x32_bf16(Bt[n][k], At[m][k], acc[ai][bj][m][n], 0, 0, 0); __builtin_amdgcn_s_setprio(0); } while (0)
#define G_LDA8(dst, b, h) do { _Pragma("unroll") for (int m = 0; m < 4; ++m) { const v4i_t _lo = *(const LAS v4i_t*)(lds + G_SA(b, h) + aoff + m * 2048), _hi = *(const LAS v4i_t*)(lds + G_SA(b, h) + aoff + m * 2048 + 1024); \
        dst[m] = __builtin_shufflevector(_lo, _hi, 0, 1, 2, 3, 4, 5, 6, 7); } } while (0)
#define G_LDB8(dst, b, h) do { _Pragma("unroll") for (int n = 0; n < 2; ++n) { const v4i_t _lo = *(const LAS v4i_t*)(lds + G_SB(b, h) + boff + n * 2048), _hi = *(const LAS v4i_t*)(lds + G_SB(b, h) + boff + n * 2048 + 1024); \
        dst[n] = __builtin_shufflevector(_lo, _hi, 0, 1, 2, 3, 4, 5, 6, 7); } } while (0)
#define G_MMA8(ai, bj, A8_, B8_) do { __builtin_amdgcn_s_setprio(1); _Pragma("unroll") for (int m = 0; m < 4; ++m) _Pragma("unroll") for (int n = 0; n < 2; ++n) \
        asm volatile("v_mfma_scale_f32_16x16x128_f8f6f4 %0, %1, %2, %0, %3, %3 op_sel_hi:[0,0,0]" : "+v"(acc[ai][bj][m][n]) : "v"(B8_[n]), "v"(A8_[m]), "v"(sc1v)); __builtin_amdgcn_s_setprio(0); } while (0)
#define X_LDA(b, h) do { if constexpr (Kind::FP8) G_LDA8(A8, b, h); else G_LDA(At, b, h); } while (0)
#define X_LDB0(b, h) do { if constexpr (Kind::FP8) G_LDB8(B08, b, h); else G_LDB(B0, b, h); } while (0)
#define X_LDB1(b, h) do { if constexpr (Kind::FP8) G_LDB8(B18, b, h); else G_LDB(B1, b, h); } while (0)
#define X_MM0(ai, bj) do { if constexpr (Kind::FP8) G_MMA8(ai, bj, A8, B08); else G_MMA(ai, bj, At, B0); } while (0)
#define X_MM1(ai, bj) do { if constexpr (Kind::FP8) G_MMA8(ai, bj, A8, B18); else G_MMA(ai, bj, At, B1); } while (0)
#define G_WAIT_V(n) asm volatile("s_waitcnt vmcnt(" #n ")" ::: "memory")
#define G_WAIT_L(n) asm volatile("s_waitcnt lgkmcnt(" #n ")" ::: "memory")
#define G_BAR __builtin_amdgcn_s_barrier()
#define G_SCHED __builtin_amdgcn_sched_barrier(0)
    Unit cur, nxt; Src sc, sn; int ui = 0; int pend = -1;
    if (!Kd.next(0, cur)) return;
    Kd.src(cur, sc, R, C);
    Kd.a_ready(cur, wid);
    f32x4 acc[2][2][4][2];
#pragma unroll
    for (int a = 0; a < 2; ++a)
#pragma unroll
        for (int b = 0; b < 2; ++b)
#pragma unroll
            for (int m = 0; m < 4; ++m)
#pragma unroll
                for (int n = 0; n < 2; ++n) acc[a][b][m][n] = (f32x4){0.f, 0.f, 0.f, 0.f};
    bf16x8 At[4][2], B0[2][2], B1[2][2]; v8i_t A8[4], B08[2], B18[2]; int sc1v = 0x7f7f7f7f; asm volatile("" : "+v"(sc1v));
    G_STAGE_B(G_SB(0, 0), sc, 0, 0); G_STAGE_B(G_SB(0, 1), sc, 0, 1); G_STAGE_A(G_SA(0, 0), sc, 0, 0); G_STAGE_A(G_SA(0, 1), sc, 0, 1);
    if (wr == 1) G_BAR;
    G_WAIT_V(2); G_BAR;
    G_STAGE_B(G_SB(1, 0), sc, 1, 0); G_STAGE_A(G_SA(1, 0), sc, 1, 0); G_STAGE_B(G_SB(1, 1), sc, 1, 1);
    G_WAIT_V(6); G_BAR;
    for (;;) {
        const bool has_next = Kd.next(ui + 1, nxt);
        if (has_next) Kd.src(nxt, sn, R, C); else sn = sc;
#pragma unroll 1
        for (int t = 0; t < NT; t += 2) {
            const bool last = (t == NT - 2);
            if (last && has_next) Kd.a_ready(nxt, wid);
            Src s2; s2.a = last ? sn.a : sc.a; s2.b0 = last ? sn.b0 : sc.b0; s2.b1 = last ? sn.b1 : sc.b1;
            s2.va[0][0] = last ? sn.va[0][0] : sc.va[0][0]; s2.va[0][1] = last ? sn.va[0][1] : sc.va[0][1]; s2.va[1][0] = last ? sn.va[1][0] : sc.va[1][0]; s2.va[1][1] = last ? sn.va[1][1] : sc.va[1][1];
            const int t2 = last ? 0 : t + 2, t3 = t2 + 1;
            X_LDB0(0, 0); X_LDB1(0, 1); G_SCHED; X_LDA(0, 0); G_STAGE_A(G_SA(1, 1), sc, t + 1, 1);
            G_WAIT_V(8); G_WAIT_L(0); G_BAR; X_MM0(0, 0); X_MM1(0, 1); G_BAR; G_SCHED;
            X_LDA(0, 1); G_STAGE_B(G_SB(0, 0), s2, t2, 0); G_STAGE_B(G_SB(0, 1), s2, t2, 1); G_STAGE_A(G_SA(0, 0), s2, t2, 0);
            G_WAIT_V(8); G_WAIT_L(0); G_BAR; X_MM0(1, 0); X_MM1(1, 1); G_BAR; G_SCHED;
            X_LDB0(1, 0); X_LDB1(1, 1); G_SCHED; X_LDA(1, 0); G_STAGE_A(G_SA(0, 1), s2, t2, 1);
            G_WAIT_V(8); G_WAIT_L(0); G_BAR; X_MM0(0, 0); X_MM1(0, 1); G_BAR; G_SCHED;
            X_LDA(1, 1); G_STAGE_B(G_SB(1, 0), s2, t3, 0); G_STAGE_B(G_SB(1, 1), s2, t3, 1); G_STAGE_A(G_SA(1, 0), s2, t3, 0);
            G_WAIT_V(8); G_WAIT_L(0); G_BAR; X_MM0(1, 0); X_MM1(1, 1); G_BAR; G_SCHED;
        }
        if (wr == 0) G_BAR;
        if (Kind::PUBLISH) { if (pend >= 0) Kd.publish(pend); pend = cur.pm; }
        if (Kind::FP8) asm volatile("s_nop 15\n\ts_nop 15" ::: "memory");
        Kd.epi(acc, cur, wr, wc, fr, fq);
        if (!has_next) break;
#pragma unroll
        for (int a = 0; a < 2; ++a)
#pragma unroll
            for (int b = 0; b < 2; ++b)
#pragma unroll
                for (int m = 0; m < 4; ++m)
#pragma unroll
                    for (int n = 0; n < 2; ++n) acc[a][b][m][n] = (f32x4){0.f, 0.f, 0.f, 0.f};
        cur = nxt; sc = sn; ++ui;
        if (wr == 1) G_BAR;
    }
    G_WAIT_V(0);
    if (Kind::PUBLISH) { if (pend >= 0) Kd.publish(pend); }
    G_BAR;
#undef G_SA
#undef G_SB
#undef G_STAGE_A
#undef G_STAGE_B
#undef G_LDA
#undef G_LDB
#undef G_MMA
#undef G_MMA8
#undef G_LDA8
#undef G_LDB8
#undef X_LDA
#undef X_LDB0
#undef X_LDB1
#undef X_MM0
#undef X_MM1
#undef G_WAIT_V
#undef G_WAIT_L
#undef G_BAR
#undef G_SCHED
}

__device__ __forceinline__ void src_direct(Src& s, const void* A, int row0, const int (&R)[2], const int (&C)[2], int pitchb = 2048) {
    s.a = (const char*)A + (size_t)row0 * pitchb;
#pragma unroll
    for (int h = 0; h < 2; ++h)
#pragma unroll
        for (int i = 0; i < 2; ++i) s.va[h][i] = (unsigned)((h * HALF + R[i]) * pitchb + C[i] * 2);
}

template <bool F8> struct K1 {
    static constexpr bool PERM = true, PUBLISH = false, FP8 = F8; static constexpr int LDBB = F8 ? 1024 : 2048, NTK = F8 ? 8 : 16;
    __device__ __forceinline__ void publish(int) const {}
    __device__ __forceinline__ void a_ready(const Unit&, int) const {}
    __device__ __forceinline__ void done(const Unit&) const {}
    StaticOrder S; const void* A; const void* Bt; bf16_t* O; const float* rope;
    __device__ __forceinline__ bool next(int i, Unit& u) const { return S.next(i, u); }
    __device__ __forceinline__ void src(const Unit& u, Src& s, const int (&R)[2], const int (&C)[2]) const {
        src_direct(s, A, u.pm * BM, R, C, F8 ? 1024 : 2048); s.b0 = (const char*)Bt + (size_t)u.pn * BM * (F8 ? 1024 : 2048); s.b1 = s.b0 + (F8 ? 512 : 1024);
    }
    __device__ __forceinline__ void epi(const f32x4 (&acc)[2][2][4][2], const Unit& u, int wr, int wc, int fr, int fq) const {
        const int row0 = u.pm * BM + wr * 64 + fr, col0 = u.pn * TSZ + wc * 32 + 8 * fq;
        if (u.pn == 7 || u.pn == 8) {
#pragma unroll
            for (int ai = 0; ai < 2; ++ai)
#pragma unroll
                for (int m = 0; m < 4; ++m) {
                    const int row = row0 + ai * HALF + m * 16;
                    const f32x4 cs = *(const f32x4*)(rope + (size_t)row * 8), sn = *(const f32x4*)(rope + (size_t)row * 8 + 4);
                    bf16_t* rowp = O + (size_t)row * PJ + col0;
#pragma unroll
                    for (int bj = 0; bj < 2; ++bj) {
                        f32x4 v0 = acc[ai][bj][m][0], v1 = acc[ai][bj][m][1]; if (F8) { v0 = v0 * (1.f / W8S); v1 = v1 * (1.f / W8S); }
                        if (fq == 0) { const f32x4 x1 = v0, x2 = v1; v0 = x1 * cs - x2 * sn; v1 = x2 * cs + x1 * sn; }
                        u32x4 w; w.x = pk2(v0[0], v0[1]); w.y = pk2(v0[2], v0[3]); w.z = pk2(v1[0], v1[1]); w.w = pk2(v1[2], v1[3]);
                        *(u32x4*)(rowp + bj * HALF) = w;
                    }
                }
        } else {
#pragma unroll
            for (int ai = 0; ai < 2; ++ai)
#pragma unroll
                for (int m = 0; m < 4; ++m) { bf16_t* rowp = O + (size_t)(row0 + ai * HALF + m * 16) * PJ + col0;
#pragma unroll
                    for (int bj = 0; bj < 2; ++bj) { f32x4 v0 = acc[ai][bj][m][0], v1 = acc[ai][bj][m][1]; if (F8) { v0 = v0 * (1.f / W8S); v1 = v1 * (1.f / W8S); }
                        u32x4 w; w.x = pk2(v0[0], v0[1]); w.y = pk2(v0[2], v0[3]); w.z = pk2(v1[0], v1[1]); w.w = pk2(v1[2], v1[3]);
                        *(u32x4*)(rowp + bj * HALF) = w; } }
        }
    }
};
struct K2 {
    static constexpr bool PERM = true, PUBLISH = false, FP8 = true; static constexpr int LDBB = 1024, NTK = 8;
    __device__ __forceinline__ void publish(int) const {}
    __device__ __forceinline__ void a_ready(const Unit&, int) const {}
    __device__ __forceinline__ void done(const Unit&) const {}
    StaticOrder S; const unsigned char* A; const unsigned char* Bt; bf16_t* O;
    __device__ __forceinline__ bool next(int i, Unit& u) const { return S.next(i, u); }
    __device__ __forceinline__ void src(const Unit& u, Src& s, const int (&R)[2], const int (&C)[2]) const {
        src_direct(s, A, u.pm * BM, R, C, 1024); s.b0 = (const char*)(Bt + (size_t)u.pn * BM * 1024); s.b1 = s.b0 + 512;
    }
    __device__ __forceinline__ void epi(const f32x4 (&acc)[2][2][4][2], const Unit& u, int wr, int wc, int fr, int fq) const {
        const int row0 = u.pm * BM + wr * 64 + fr, col0 = u.pn * BM + wc * 32 + 8 * fq;
#pragma unroll
        for (int ai = 0; ai < 2; ++ai)
#pragma unroll
            for (int m = 0; m < 4; ++m) { bf16_t* rowp = O + (size_t)(row0 + ai * HALF + m * 16) * DM + col0;
#pragma unroll
                for (int bj = 0; bj < 2; ++bj) { const f32x4 v0 = acc[ai][bj][m][0] * (1.f / (W8S * Y8S)), v1 = acc[ai][bj][m][1] * (1.f / (W8S * Y8S));
                    u32x4 w; w.x = pk2(v0[0], v0[1]); w.y = pk2(v0[2], v0[3]); w.z = pk2(v1[0], v1[1]); w.w = pk2(v1[2], v1[3]);
                    *(u32x4*)(rowp + bj * HALF) = w; } }
    }
};
__device__ __forceinline__ int pair_i(int p) { return p < 3 ? 0 : (p < 5 ? 1 : 2); }
__device__ __forceinline__ int pair_j(int p) { return p < 3 ? p + 1 : (p < 5 ? p - 1 : 3); }
struct K4 {
    static constexpr bool PERM = true, PUBLISH = false, FP8 = true; static constexpr int LDBB = 1024, NTK = 8;
    const unsigned char* U; const unsigned char* Wgu; unsigned char* H; const int* ltok; const float* lgate; const LAS int* tb; int G, vcu; gu32* rtc;
    __device__ __forceinline__ void a_ready(const Unit&, int) const {}
    __device__ __forceinline__ void done(const Unit&) const {}
    __device__ __forceinline__ void publish(int pm) const { if ((threadIdx.x & 63) == 0) __hip_atomic_fetch_add(rtc + 64 * pm, 1u, RLX_AGENT); }
    __device__ __forceinline__ bool next(int i, Unit& u) const {
        const int L = i * G + vcu; const int nt = tb[32 + NBUCKET]; if (L >= nt * 8) return false;
        const int rt = L >> 3; int k = 0;
        for (int q = 1; q < NBUCKET; ++q) k = (tb[32 + q] <= rt) ? q : k;
        u.pm = rt; u.pn = L & 7; u.bk = k; u.tb = rt - tb[32 + k]; return true;
    }
    __device__ __forceinline__ void src(const Unit& u, Src& s, const int (&R)[2], const int (&C)[2]) const {
        const int cnt = tb[u.bk]; s.a = (const char*)U;
#pragma unroll
        for (int h = 0; h < 2; ++h)
#pragma unroll
            for (int i = 0; i < 2; ++i) { const int pos = u.tb * BM + h * HALF + R[i]; const int tok = ltok[(size_t)u.bk * LCAP + (pos < cnt ? pos : 0)]; s.va[h][i] = (unsigned)(tok * 1024 + C[i] * 2); }
        const int grp = u.bk / 6, p = u.bk % 6, sl = u.pn >> 2; const int e = grp * 4 + (sl ? pair_j(p) : pair_i(p));
        s.b0 = (const char*)(Wgu + ((size_t)e * 1024 + (size_t)(u.pn & 3) * BM) * 1024); s.b1 = s.b0 + 512;
    }
    __device__ __forceinline__ void epi(const f32x4 (&acc)[2][2][4][2], const Unit& u, int wr, int wc, int fr, int fq) const {
        const int cnt = tb[u.bk], sl = u.pn >> 2; const int colo = sl * 512 + (u.pn & 3) * 128 + wc * 32 + 8 * fq;
#pragma unroll
        for (int ai = 0; ai < 2; ++ai)
#pragma unroll
            for (int m = 0; m < 4; ++m) {
                const int r = ai * HALF + wr * 64 + m * 16 + fr, pos = u.tb * BM + r;
                const float gt = (pos < cnt) ? lgate[((size_t)u.bk * LCAP + pos) * 2 + sl] : 0.f;
                float hv[8];
#pragma unroll
                for (int n = 0; n < 2; ++n)
#pragma unroll
                    for (int j = 0; j < 4; ++j) { const float g = acc[ai][0][m][n][j] * (1.f / W8S), up = acc[ai][1][m][n][j] * (1.f / W8S); hv[n * 4 + j] = g * __builtin_amdgcn_rcpf(1.f + fexp(-g)) * up * (gt * H8S); }
                u32x2 w; w.x = pk4_fp8(hv[0], hv[1], hv[2], hv[3]); w.y = pk4_fp8(hv[4], hv[5], hv[6], hv[7]);
                *(u32x2*)(H + (size_t)(u.pm * BM + r) * 1024 + colo) = w;
            }
    }
};
struct K5 {
    static constexpr bool PERM = true, PUBLISH = false, FP8 = true; static constexpr int LDBB = 512, NTK = 8;
    __device__ __forceinline__ void publish(int) const {}
    const unsigned char* H; const unsigned char* Wd; bf16_t* Y; const LAS int* tb; int G, vcu; gu32* rtc; gu32* tmo;
    __device__ __forceinline__ void done(const Unit&) const {}
    __device__ __forceinline__ void a_ready(const Unit& u, int wid) const { return;
        if (wid == 0) {
            const unsigned long long t0 = __builtin_amdgcn_s_memrealtime(); unsigned polls = 0;
            while ((unsigned)__builtin_amdgcn_readfirstlane(__hip_atomic_load(rtc + 64 * u.pm, RLX_AGENT)) < 64u) {
                if ((++polls & 255u) == 0u && __builtin_amdgcn_readfirstlane(__hip_atomic_load(tmo, RLX_AGENT)) != 0u) break;
                if (__builtin_amdgcn_s_memrealtime() - t0 > 2000000ull) { if ((threadIdx.x & 63) == 0) __hip_atomic_store(tmo, 1u, RLX_AGENT); break; }
                __builtin_amdgcn_s_sleep(2); }
            __builtin_amdgcn_fence(__ATOMIC_ACQUIRE, "agent");
            asm volatile("s_waitcnt vmcnt(0)" ::: "memory");
        }
        asm volatile("" ::: "memory"); __builtin_amdgcn_s_barrier(); asm volatile("" ::: "memory");
    }
    __device__ __forceinline__ bool next(int i, Unit& u) const {
        const int nt = tb[32 + NBUCKET]; const int n4 = nt * 8; const int i0 = 0; (void)n4;
        const int L = (i + i0) * G + vcu; if (L >= nt * 4) return false;
        const int rt = L >> 2; int k = 0;
        for (int q = 1; q < NBUCKET; ++q) k = (tb[32 + q] <= rt) ? q : k;
        u.pm = rt; u.pn = L & 3; u.bk = k; u.tb = rt - tb[32 + k]; return true;
    }
    __device__ __forceinline__ void src(const Unit& u, Src& s, const int (&R)[2], const int (&C)[2]) const {
        src_direct(s, H, u.pm * BM, R, C, 1024);
        const int grp = u.bk / 6, p = u.bk % 6;
        s.b0 = (const char*)(Wd + ((size_t)(grp * 4 + pair_i(p)) * 1024 + (size_t)u.pn * BM) * 512);
        s.b1 = (const char*)(Wd + ((size_t)(grp * 4 + pair_j(p)) * 1024 + (size_t)u.pn * BM) * 512);
    }
    __device__ __forceinline__ void epi(const f32x4 (&acc)[2][2][4][2], const Unit& u, int wr, int wc, int fr, int fq) const {
        const int row0 = u.pm * BM + wr * 64 + fr, col0 = u.pn * BM + wc * 32 + 8 * fq;
#pragma unroll
        for (int ai = 0; ai < 2; ++ai)
#pragma unroll
            for (int m = 0; m < 4; ++m) { bf16_t* rowp = Y + (size_t)(row0 + ai * HALF + m * 16) * DM + col0;
#pragma unroll
                for (int bj = 0; bj < 2; ++bj) { const f32x4 v0 = acc[ai][bj][m][0] * (1.f / (W8S * H8S)), v1 = acc[ai][bj][m][1] * (1.f / (W8S * H8S));
                    u32x4 w; w.x = pk2(v0[0], v0[1]); w.y = pk2(v0[2], v0[3]); w.z = pk2(v1[0], v1[1]); w.w = pk2(v1[2], v1[3]);
                    *(u32x4*)(rowp + bj * HALF) = w; } }
    }
};
}

namespace attn_body {
using bf16 = __hip_bfloat16;
using s16x4 = __attribute__((ext_vector_type(4))) short;
using f32x16 = __attribute__((ext_vector_type(16))) float;
constexpr int D = 64, PITCH = PJ;
constexpr int NW = 8, QBLK = 32, QB = QBLK * NW, KVBLK = 64;
__device__ __forceinline__ int crow(int r, int hi) { return (r & 3) + 8 * (r >> 2) + 4 * hi; }
#define SBAR() __builtin_amdgcn_sched_barrier(0)
__device__ __forceinline__ void cmask(f32x16& p0, f32x16& p1, int jb, int qrel, int hi) {
    const float NEG = -INFINITY; int kb = 64 * jb + 4 * hi;
#pragma unroll
    for (int r = 0; r < 16; ++r) { int kv = kb + (r & 3) + 8 * (r >> 2); if (kv > qrel) p0[r] = NEG; if (kv + 32 > qrel) p1[r] = NEG; }
}
constexpr int NSLOT = 3, SLOTB = 8192;
constexpr int LDS_K = 0, LDS_V = NSLOT * SLOTB, LDS_WS = 2 * NSLOT * SLOTB, LDS_OST = LDS_WS + NW * 64 * 4, ATT_LDS_BYTES = LDS_OST + NW * 8192;
__device__ __forceinline__ void glds16(const void* gsrc, unsigned lds_dst) { unsigned keep;
    asm volatile("s_mov_b32 %0, m0\n\ts_mov_b32 m0, %2\n\ts_nop 0\n\tglobal_load_lds_dwordx4 %1, off\n\ts_mov_b32 m0, %0" : "=&s"(keep) : "v"(gsrc), "s"(lds_dst) : "memory"); }
__device__ __forceinline__ float max3f(float a, float b, float c) { float r; asm("v_max3_f32 %0, %1, %2, %3" : "=v"(r) : "v"(a), "v"(b), "v"(c)); return r; }
__device__ __forceinline__ float max2f(float a, float b) { float r; asm("v_max_f32_e32 %0, %1, %2" : "=v"(r) : "v"(a), "v"(b)); return r; }
__device__ __forceinline__ float fadd_s(float a, float b) { float r; asm("v_add_f32_e32 %0, %1, %2" : "=v"(r) : "v"(a), "v"(b)); return r; }
__device__ __forceinline__ float fsub_s(float a, float b) { float r; asm("v_sub_f32_e32 %0, %1, %2" : "=v"(r) : "v"(a), "v"(b)); return r; }
typedef float f32x2_t __attribute__((ext_vector_type(2))); typedef __bf16 bf16x2_t __attribute__((ext_vector_type(2)));
__device__ __forceinline__ unsigned cvtpk_s(float lo, float hi) { f32x2_t v = {lo, hi}; bf16x2_t b = __builtin_convertvector(v, bf16x2_t); return __builtin_bit_cast(unsigned, b); }
#define WAIT_BAR(N) asm volatile("s_waitcnt vmcnt(" #N ") lgkmcnt(0)\n\ts_barrier" ::: "memory")
__device__ __forceinline__ void qkt(f32x16& p0, f32x16& p1, const char* Kslot, const bf16x8* qr, const f32x16& negm, int r32, int hi) {
    const char* kb = Kslot + hi * 1024 + r32 * 16;
#pragma unroll
    for (int d0 = 0; d0 < 2; ++d0) {
        const bf16x8 b0 = *reinterpret_cast<const bf16x8*>(kb + d0 * 2048);
        const bf16x8 b1 = *reinterpret_cast<const bf16x8*>(kb + d0 * 2048 + 512);
        if (d0 == 0) { p0 = __builtin_amdgcn_mfma_f32_32x32x16_bf16(b0, qr[0], negm, 0, 0, 0); p1 = __builtin_amdgcn_mfma_f32_32x32x16_bf16(b1, qr[0], negm, 0, 0, 0); }
        else { p0 = __builtin_amdgcn_mfma_f32_32x32x16_bf16(b0, qr[d0], p0, 0, 0, 0); p1 = __builtin_amdgcn_mfma_f32_32x32x16_bf16(b1, qr[d0], p1, 0, 0, 0); } }
}
typedef __attribute__((address_space(3))) const char* lds_cptr;
typedef short v4i16_t __attribute__((ext_vector_type(4)));
__device__ __forceinline__ void kload8(bf16x8* kf, lds_cptr kp) {
    kf[0] = *(const __attribute__((address_space(3))) bf16x8*)(kp);        kf[1] = *(const __attribute__((address_space(3))) bf16x8*)(kp + 512);
    kf[2] = *(const __attribute__((address_space(3))) bf16x8*)(kp + 2048); kf[3] = *(const __attribute__((address_space(3))) bf16x8*)(kp + 2560);
}
__device__ __forceinline__ void kload2(bf16x8* kf, lds_cptr kp, int j) { kf[2 * j] = *(const __attribute__((address_space(3))) bf16x8*)(kp + j * 2048); kf[2 * j + 1] = *(const __attribute__((address_space(3))) bf16x8*)(kp + j * 2048 + 512); }
__device__ __forceinline__ s16x4 vtr(lds_cptr p) { return __builtin_bit_cast(s16x4, __builtin_amdgcn_ds_read_tr16_b64_v4i16((__attribute__((address_space(3))) v4i16_t*)p)); }
__device__ __forceinline__ float rowmax(const f32x16& p0, const f32x16& p1) {
    float a = max3f(p0[0], p0[1], p1[0]), b = max3f(p0[2], p0[3], p1[1]); a = max3f(a, p1[2], p1[3]);
#pragma unroll
    for (int r = 4; r < 16; r += 4) { a = max3f(a, p0[r], p0[r + 1]); b = max3f(b, p0[r + 2], p0[r + 3]); a = max3f(a, p1[r], p1[r + 1]); b = max3f(b, p1[r + 2], p1[r + 3]); }
    const float m = max2f(a, b);
    auto rr = __builtin_amdgcn_permlane32_swap(__float_as_uint(m), __float_as_uint(m), false, false);
    return max2f(__uint_as_float(rr[0]), __uint_as_float(rr[1]));
}
__device__ __forceinline__ void pv(f32x16* o, int vb, bf16x8 pa0, bf16x8 pa1, bf16x8 pa2, bf16x8 pa3) {
#pragma unroll
    for (int d0 = 0; d0 < 2; ++d0) { s16x4 lo[4], hi[4];
#pragma unroll
        for (int ks = 0; ks < 4; ++ks) {
            asm volatile("ds_read_b64_tr_b16 %0,%1 offset:%c2" : "=&v"(lo[ks]) : "v"(vb), "i"(d0 * 4096 + ks * 1024) : "memory");
            asm volatile("ds_read_b64_tr_b16 %0,%1 offset:%c2" : "=&v"(hi[ks]) : "v"(vb), "i"(d0 * 4096 + ks * 1024 + 512) : "memory"); }
        asm volatile("s_waitcnt lgkmcnt(0)" ::: "memory"); SBAR();
#define PK(k) (bf16x8){lo[k][0], lo[k][1], lo[k][2], lo[k][3], hi[k][0], hi[k][1], hi[k][2], hi[k][3]}
        o[d0] = __builtin_amdgcn_mfma_f32_32x32x16_bf16(pa0, PK(0), o[d0], 0, 0, 0);
        o[d0] = __builtin_amdgcn_mfma_f32_32x32x16_bf16(pa1, PK(1), o[d0], 0, 0, 0);
        o[d0] = __builtin_amdgcn_mfma_f32_32x32x16_bf16(pa2, PK(2), o[d0], 0, 0, 0);
        o[d0] = __builtin_amdgcn_mfma_f32_32x32x16_bf16(pa3, PK(3), o[d0], 0, 0, 0);
#undef PK
    }
}
struct AttnParams { const bf16* Q; const bf16* K; const bf16* V; const bf16* zpage; bf16_t* Y; const float* gnorm; float lam, osc; };
template <int THRL, int comp> __device__ __forceinline__ void attn_unit(int b, int h, int qb, const AttnParams& P, char* shm) {
    const bf16* Q = P.Q; const bf16* __restrict__ K = P.K; const bf16* __restrict__ V = P.V;
    int tid_ = threadIdx.x; asm volatile("" : "+v"(tid_));
    const int tid = tid_, lane = tid & 63, r32 = lane & 31, hi = lane >> 5; const int wid = __builtin_amdgcn_readfirstlane(tid >> 6);
    const long rowbase = (long)b * SEQ; const int q0 = qb * QB;
    const bf16* Qw = Q + (rowbase + q0 + wid * QBLK) * PITCH + h * D;
    const bf16* Kh = K + rowbase * PITCH + h * D, *Vh = V + rowbase * PITCH + h * D;
    const unsigned lds0 = (unsigned)(uintptr_t)shm;
    float* wsf = (float*)(shm + LDS_WS) + wid * 64;
    const bf16* ksrc = Kh + (long)(32 * (wid & 1) + (lane & 31)) * PITCH + comp * 32 + (wid >> 1) * 8;
    const bf16* vsrc = Vh + (long)(16 * (wid & 3) + (lane >> 2)) * PITCH + (wid >> 2) * 32 + (lane & 3) * 8;
    const unsigned kdst = lds0 + LDS_K + (wid >> 1) * 1024 + (wid & 1) * 512, vdst = lds0 + LDS_V + wid * 1024;
#define DMA_K(t, slot) do { if (lane < 32) glds16(ksrc + (long)(t) * KVBLK * PITCH, (unsigned)__builtin_amdgcn_readfirstlane(kdst + (slot))); } while (0)
#define DMA_V(t, slot) glds16(vsrc + (long)(t) * KVBLK * PITCH, (unsigned)__builtin_amdgcn_readfirstlane(vdst + (slot)))
    const int vb0 = (int)(lds0 + LDS_V) + ((lane >> 4) & 1) * 32 + (lane & 3) * 8 + (4 * hi + ((lane & 15) >> 2)) * 64;
    const char* Kbase = shm + LDS_K; bf16x8 kf[4];
    const lds_cptr shm3 = (lds_cptr)shm; const lds_cptr kp0 = shm3 + LDS_K + hi * 1024 + r32 * 16; const lds_cptr vp0 = shm3 + LDS_V + ((lane >> 4) & 1) * 32 + (lane & 3) * 8 + (4 * hi + ((lane & 15) >> 2)) * 64;
    const int NT = (q0 + QB) / KVBLK;
    if (wid >= 4) __builtin_amdgcn_s_setprio(1);
    DMA_K(0, 0); DMA_V(0, 0); DMA_K(1, SLOTB);
    bf16x8 qr[2];
#pragma unroll
    for (int d0 = 0; d0 < 2; ++d0) qr[d0] = *reinterpret_cast<const bf16x8*>(&Qw[(long)r32 * PITCH + comp * 32 + d0 * 16 + hi * 8]);
    float mhat = 0.f, l_reg = 0.f; f32x16 o[2]; o[0] = f32x16{}; o[1] = f32x16{}; f32x16 negm = f32x16{}; asm volatile("" : "+v"(negm));
    const int qrel = wid * QBLK + r32;
#define CMASK(P0, P1, t) do { int jb_ = (t) - (NT - 4); if (jb_ >= 0) cmask(P0, P1, jb_, qrel, hi); } while (0)
    bool resc = false;
#define START(P0, P1) do { const float rm = rowmax(P0, P1); resc = false; \
    { const float dl = rm; mhat = fadd_s(mhat, dl); \
      _Pragma("unroll") for (int r = 0; r < 16; ++r) { P0[r] = fsub_s(P0[r], dl); P1[r] = fsub_s(P1[r], dl); } \
      _Pragma("unroll") for (int r = 0; r < 16; ++r) negm[r] = -mhat; asm volatile("" : "+v"(negm)); } \
    _Pragma("unroll") for (int r = 0; r < 16; ++r) P0[r] = __builtin_amdgcn_exp2f(P0[r]); } while (0)
#define RESC() do { if (resc) { asm volatile("s_waitcnt lgkmcnt(0)" ::: "memory"); \
      _Pragma("unroll") for (int d_ = 0; d_ < 2; ++d_) _Pragma("unroll") for (int r = 0; r < 16; ++r) o[d_][r] *= wsf[crow(r, hi)]; } } while (0)
    f32x16 pA0, pA1, pB0, pB1;
    int sl_prev = 0, sl_cur = 0, sl_next = SLOTB;
#define ROT() do { sl_prev = sl_cur; sl_cur = sl_next; sl_next = (sl_next == (NSLOT - 1) * SLOTB) ? 0 : sl_next + SLOTB; } while (0)
    DMA_K(2, 2 * SLOTB);
    WAIT_BAR(3);
    qkt(pA0, pA1, Kbase, qr, negm, r32, hi); asm volatile("s_nop 15\n\ts_nop 7" : "+v"(pA0), "+v"(pA1)); CMASK(pA0, pA1, 0);
    START(pA0, pA1);
    _Pragma("unroll") for (int r = 0; r < 16; ++r) pA1[r] = __builtin_amdgcn_exp2f(pA1[r]);
    WAIT_BAR(0);
    DMA_K(3, 0); DMA_V(1, SLOTB);
    ROT();
    kload8(kf, kp0 + sl_cur);
    WAIT_BAR(2);
    s16x4 vlo[8], vhi[8]; u32x4 pw0, pw1, pw2, pw3;
#define PKW(P, B) cvtpk_s(P[B], P[B + 1])
#define PAF(k) __builtin_bit_cast(bf16x8, pw##k)
#define VFR(i) (bf16x8){vlo[i][0], vlo[i][1], vlo[i][2], vlo[i][3], vhi[i][0], vhi[i][1], vhi[i][2], vhi[i][3]}
#define PIN(x) asm volatile("" : "+v"(x))
#define MX3(a, b, c) __builtin_fmaxf(__builtin_fmaxf((a), (b)), (c))
#define GAPA(MF, A0, A1, A2, A3, W0, W1, PW) do { MF; sacc += A0; sacc += A1; sacc += A2; sacc += A3; PIN(sacc); W0; W1; PIN(PW); SBAR(); } while (0)
#define EX(v) __builtin_amdgcn_exp2f(v)
#define GAPB(MF, X, B) do { MF; X[B] = EX(X[B]); X[B + 1] = EX(X[B + 1]); X[B + 2] = EX(X[B + 2]); X[B + 3] = EX(X[B + 3]); PIN(X); SBAR(); } while (0)
#define VRD(i) do { vlo[i] = vtr(vp_ + (((i) >> 2) * 4096 + ((i) & 3) * 1024)); vhi[i] = vtr(vp_ + (((i) >> 2) * 4096 + ((i) & 3) * 1024 + 512)); } while (0)
#define KRD(G, j) do { if (G) { kload2(kf, kp0 + sl_next, j); SBAR(); } } while (0)
#define STEP(C0, C1, P0, P1, t, GK, GV, GL) do { SBAR(); \
    const lds_cptr vp_ = vp0 + sl_prev; \
    VRD(0); SBAR(); float sacc = (P0[0] + P0[1]); \
    GAPA(C0 = __builtin_amdgcn_mfma_f32_32x32x16_bf16(kf[0], qr[0], negm, 0, 0, 0), P0[2], P0[3], P0[4], P0[5],     pw0[0] = PKW(P0, 0), pw0[1] = PKW(P0, 2), pw0); \
    VRD(4); SBAR(); GAPA(C1 = __builtin_amdgcn_mfma_f32_32x32x16_bf16(kf[1], qr[0], negm, 0, 0, 0), P0[6], P0[7], P0[8], P0[9],     pw0[2] = PKW(P0, 4), pw0[3] = PKW(P0, 6), pw0); \
    VRD(1); SBAR(); GAPA(C0 = __builtin_amdgcn_mfma_f32_32x32x16_bf16(kf[2], qr[1], C0, 0, 0, 0),   P0[10], P0[11], P0[12], P0[13], pw1[0] = PKW(P0, 8), pw1[1] = PKW(P0, 10), pw1); \
    VRD(5); SBAR(); GAPA(C1 = __builtin_amdgcn_mfma_f32_32x32x16_bf16(kf[3], qr[1], C1, 0, 0, 0),   P0[14], P0[15], P1[0], P1[1],   pw1[2] = PKW(P0, 12), pw1[3] = PKW(P0, 14), pw1); \
    VRD(2); SBAR(); GAPA(,   P1[2], P1[3], P1[4], P1[5],     pw2[0] = PKW(P1, 0), pw2[1] = PKW(P1, 2), pw2); \
    VRD(6); SBAR(); GAPA(,   P1[6], P1[7], P1[8], P1[9],     pw2[2] = PKW(P1, 4), pw2[3] = PKW(P1, 6), pw2); \
    VRD(3); SBAR(); GAPA(,   P1[10], P1[11], P1[12], P1[13], pw3[0] = PKW(P1, 8), pw3[1] = PKW(P1, 10), pw3); \
    VRD(7); SBAR(); GAPA(,   P1[14], P1[15], 0.f, 0.f,       pw3[2] = PKW(P1, 12), pw3[3] = PKW(P1, 14), pw3); \
    l_reg += sacc; \
    if (GK) { DMA_K((t) + 3, sl_cur); } if (GV) { DMA_V((t) + 1, sl_next); } \
    CMASK(C0, C1, t); \
    { float a = MX3(C0[0], C0[1], C1[0]), b = MX3(C0[2], C0[3], C1[1]); a = MX3(a, C1[2], C1[3]); \
      _Pragma("unroll") for (int r = 4; r < 16; r += 4) { a = MX3(a, C0[r], C0[r + 1]); b = MX3(b, C0[r + 2], C0[r + 3]); a = MX3(a, C1[r], C1[r + 1]); b = MX3(b, C1[r + 2], C1[r + 3]); } \
      float rm = __builtin_fmaxf(a, b); { auto rr = __builtin_amdgcn_permlane32_swap(__float_as_uint(rm), __float_as_uint(rm), false, false); rm = __builtin_fmaxf(__uint_as_float(rr[0]), __uint_as_float(rr[1])); } \
      resc = false; \
      if (__builtin_expect(__any(rm > (float)THRL), 0)) { const float dl = __builtin_fmaxf(rm, 0.f); mhat += dl; \
        _Pragma("unroll") for (int r = 0; r < 16; ++r) { C0[r] -= dl; C1[r] -= dl; } \
        _Pragma("unroll") for (int r = 0; r < 16; ++r) negm[r] = -mhat; asm volatile("" : "+v"(negm)); \
        const float f = __builtin_amdgcn_exp2f(-dl); l_reg *= f; if (hi == 0) wsf[r32] = f; resc = true; } } \
    SBAR(); \
    GAPB(o[0] = __builtin_amdgcn_mfma_f32_32x32x16_bf16(PAF(0), VFR(0), o[0], 0, 0, 0), C0, 0); \
    GAPB(o[1] = __builtin_amdgcn_mfma_f32_32x32x16_bf16(PAF(0), VFR(4), o[1], 0, 0, 0), C0, 4); \
    KRD(GL, 0); GAPB(o[0] = __builtin_amdgcn_mfma_f32_32x32x16_bf16(PAF(1), VFR(1), o[0], 0, 0, 0), C0, 8); \
    KRD(GL, 1); GAPB(o[1] = __builtin_amdgcn_mfma_f32_32x32x16_bf16(PAF(1), VFR(5), o[1], 0, 0, 0), C0, 12); \
    GAPB(o[0] = __builtin_amdgcn_mfma_f32_32x32x16_bf16(PAF(2), VFR(2), o[0], 0, 0, 0), C1, 0); \
    GAPB(o[1] = __builtin_amdgcn_mfma_f32_32x32x16_bf16(PAF(2), VFR(6), o[1], 0, 0, 0), C1, 4); \
    GAPB(o[0] = __builtin_amdgcn_mfma_f32_32x32x16_bf16(PAF(3), VFR(3), o[0], 0, 0, 0), C1, 8); \
    GAPB(o[1] = __builtin_amdgcn_mfma_f32_32x32x16_bf16(PAF(3), VFR(7), o[1], 0, 0, 0), C1, 12); \
    } while (0)
    int t = 1;
#undef CMASK
#define CMASK(P0, P1, t) do {} while (0)
    for (; t + 5 < NT; t += 2) {
        STEP(pB0, pB1, pA0, pA1, t, true, true, true);     WAIT_BAR(2); RESC(); ROT();
        STEP(pA0, pA1, pB0, pB1, t + 1, true, true, true); WAIT_BAR(2); RESC(); ROT();
    }
#undef CMASK
#define CMASK(P0, P1, t) do { int jb_ = (t) - (NT - 4); if (jb_ >= 0) cmask(P0, P1, jb_, qrel, hi); } while (0)
#define ENDW(tt) do { if ((tt) + 3 < NT) { WAIT_BAR(2); } else if ((tt) + 2 < NT) { WAIT_BAR(1); } else { WAIT_BAR(0); } } while (0)
    for (; t + 1 < NT; t += 2) {
        STEP(pB0, pB1, pA0, pA1, t, (t + 3 < NT), (t + 1 < NT), (t + 1 < NT));         ENDW(t);     RESC(); ROT();
        STEP(pA0, pA1, pB0, pB1, t + 1, (t + 4 < NT), (t + 2 < NT), (t + 2 < NT));     ENDW(t + 1); RESC(); ROT();
    }
    STEP(pB0, pB1, pA0, pA1, NT - 1, false, false, false); RESC();
    { float sacc = pB0[0] + pB0[1]; _Pragma("unroll") for (int r = 2; r < 16; ++r) sacc += pB0[r]; _Pragma("unroll") for (int r = 0; r < 16; ++r) sacc += pB1[r]; l_reg += sacc;
      pw0 = (u32x4){PKW(pB0, 0), PKW(pB0, 2), PKW(pB0, 4), PKW(pB0, 6)}; pw1 = (u32x4){PKW(pB0, 8), PKW(pB0, 10), PKW(pB0, 12), PKW(pB0, 14)}; pw2 = (u32x4){PKW(pB1, 0), PKW(pB1, 2), PKW(pB1, 4), PKW(pB1, 6)}; pw3 = (u32x4){PKW(pB1, 8), PKW(pB1, 10), PKW(pB1, 12), PKW(pB1, 14)};
      SBAR(); pv(o, vb0 + sl_cur, PAF(0), PAF(1), PAF(2), PAF(3)); }
#undef PKW
#undef PAF
#undef VFR
#undef PIN
#undef MX3
#undef GAPA
#undef GAPB
#undef EX
#undef VRD
#undef KRD
#undef STEP
#undef ENDW
    { auto rr = __builtin_amdgcn_permlane32_swap(__float_as_uint(l_reg), __float_as_uint(l_reg), false, false); l_reg = __uint_as_float(rr[0]) + __uint_as_float(rr[1]); }
    if (hi == 0) wsf[32 + r32] = l_reg; asm volatile("s_waitcnt lgkmcnt(0)" ::: "memory");
    float rli[16];
#pragma unroll
    for (int r = 0; r < 16; ++r) rli[r] = __builtin_amdgcn_rcpf(wsf[32 + crow(r, hi)]);
    float* stg = (float*)(shm + LDS_OST) + wid * 2048;
    if (comp == 0) {
#pragma unroll
        for (int r = 0; r < 16; ++r) { const int orow = crow(r, hi);
#pragma unroll
            for (int d0 = 0; d0 < 2; ++d0) stg[orow * 64 + d0 * 32 + r32] = o[d0][r] * rli[r]; }
    } else {
        const float lam = P.lam;
#pragma unroll
        for (int r = 0; r < 16; ++r) { const int orow = crow(r, hi);
#pragma unroll
            for (int d0 = 0; d0 < 2; ++d0) { const int ix = orow * 64 + d0 * 32 + r32; stg[ix] = stg[ix] - lam * (o[d0][r] * rli[r]); } }
        asm volatile("s_waitcnt lgkmcnt(0)" ::: "memory");
        unsigned char* Yw = (unsigned char*)P.Y + (rowbase + q0 + wid * QBLK) * DM + h * D;
        const int ch = lane & 7;
        const f32x4 g0 = *(const f32x4*)(P.gnorm + ch * 8), g1 = *(const f32x4*)(P.gnorm + ch * 8 + 4);
#pragma unroll
        for (int i = 0; i < 4; ++i) { const int row = i * 8 + (lane >> 3);
            const f32x4 a = *(const f32x4*)(stg + row * 64 + ch * 8), c = *(const f32x4*)(stg + row * 64 + ch * 8 + 4);
            float ss = (a[0] * a[0] + a[1] * a[1]) + (a[2] * a[2] + a[3] * a[3]) + (c[0] * c[0] + c[1] * c[1]) + (c[2] * c[2] + c[3] * c[3]);
            ss += __shfl_xor(ss, 1); ss += __shfl_xor(ss, 2); ss += __shfl_xor(ss, 4);
            const float rs = __builtin_amdgcn_rsqf(ss * (1.f / 64.f) + LN_EPS) * P.osc;
            const float rq = rs * Y8S; u32x2 w; w.x = pk4_fp8(a[0] * rq * g0[0], a[1] * rq * g0[1], a[2] * rq * g0[2], a[3] * rq * g0[3]); w.y = pk4_fp8(c[0] * rq * g1[0], c[1] * rq * g1[1], c[2] * rq * g1[2], c[3] * rq * g1[3]);
            *(u32x2*)(Yw + (long)row * DM + ch * 8) = w; }
    }
    __builtin_amdgcn_s_setprio(0);
    asm volatile("s_waitcnt lgkmcnt(0)\n\ts_barrier" ::: "memory");
#undef DMA_K
#undef DMA_V
#undef CMASK
#undef START
#undef RESC
#undef ROT
}
#undef SBAR
#undef WAIT_BAR
}

struct Frame {
    LAS unsigned char* lds; volatile LAS unsigned* MISC; gu32* ctl;
    int tid, lane, wave, vcu, G;
};
struct Args {
    const float* in[29]; float* out; unsigned char* ws; int ph_lo, ph_hi;
};
enum { I_X = 0, I_C, I_POS, I_WADA, I_BADA, I_WIN, I_WOUT, I_MBI, I_MBF, I_MG, I_CONVW, I_CONVB, I_LQ1, I_LK1, I_LQ2, I_LK2, I_DG, I_WA2, I_BA, I_GG, I_LN1G, I_LN1B, I_LN2G, I_LN2B,
       I_RW, I_RB, I_EWG, I_EWU, I_EWD };

__device__ __forceinline__ void tr_item(const float* W, int ldw, int K, bf16_t* WT, int drow0, int scol, int k0, LAS float* scr, int lane) {
#pragma unroll 8
    for (int i = 0; i < 32; ++i) { const int kk = 2 * i + (lane >> 5); scr[kk * 33 + (lane & 31)] = (scol >= 0) ? W[(size_t)(k0 + kk) * ldw + scol] : 0.f; }
    LDS_WAIT(); asm volatile("" ::: "memory");
    const int c = lane & 7;
#pragma unroll
    for (int j = 0; j < 4; ++j) { const int n = (lane >> 3) + 8 * j; const LAS float* s = scr + (8 * c) * 33 + n;
        u32x4 o; o.x = pk2(s[0 * 33], s[1 * 33]); o.y = pk2(s[2 * 33], s[3 * 33]); o.z = pk2(s[4 * 33], s[5 * 33]); o.w = pk2(s[6 * 33], s[7 * 33]);
        *(GAS u32x4*)(WT + (size_t)(drow0 + n) * K + k0 + 8 * c) = o; }
    LDS_WAIT(); asm volatile("" ::: "memory");
}
__device__ __forceinline__ void tr_item4(const float* W, int ldw, int K, bf16_t* WT, int drow0, int scol0, int k0, LAS float* scr, int lane, float wsc = 1.f) {
    const int kq = lane >> 3, nq = (lane & 7) * 4;
    f32x4 v[8];
#pragma unroll
    for (int i = 0; i < 8; ++i) v[i] = *(const f32x4*)(W + (size_t)(k0 + i * 8 + kq) * ldw + scol0 + nq);
#pragma unroll
    for (int i = 0; i < 8; ++i) { LAS float* d = scr + (i * 8 + kq) * 33 + nq; d[0] = v[i][0] * wsc; d[1] = v[i][1] * wsc; d[2] = v[i][2] * wsc; d[3] = v[i][3] * wsc; }
    LDS_WAIT(); asm volatile("" ::: "memory");
    const int c = lane & 7;
#pragma unroll
    for (int j = 0; j < 4; ++j) { const int n = (lane >> 3) + 8 * j; const LAS float* s = scr + (8 * c) * 33 + n;
        u32x4 o; o.x = pk2(s[0 * 33], s[1 * 33]); o.y = pk2(s[2 * 33], s[3 * 33]); o.z = pk2(s[4 * 33], s[5 * 33]); o.w = pk2(s[6 * 33], s[7 * 33]);
        *(GAS u32x4*)(WT + (size_t)(drow0 + n) * K + k0 + 8 * c) = o; }
    LDS_WAIT(); asm volatile("" ::: "memory");
}
struct TrD { const float* src; bf16_t* dst; unsigned char* dst8; int ldw, K, drow0, k0; float wsc; };
__device__ __forceinline__ void tr_load4(const TrD& d, f32x4 (&v)[8], int lane) {
    const int kq = lane >> 3, nq = (lane & 7) * 4;
#pragma unroll
    for (int i = 0; i < 8; ++i) v[i] = *(const f32x4*)(d.src + (size_t)(i * 8 + kq) * d.ldw + nq);
}
__device__ __forceinline__ void tr_finish4(const TrD& d, const f32x4 (&v)[8], LAS float* scr, int lane) {
    const int kq = lane >> 3, nq = (lane & 7) * 4;
#pragma unroll
    for (int i = 0; i < 8; ++i) { LAS float* p = scr + (i * 8 + kq) * 33 + nq; p[0] = v[i][0] * d.wsc; p[1] = v[i][1] * d.wsc; p[2] = v[i][2] * d.wsc; p[3] = v[i][3] * d.wsc; }
    LDS_WAIT(); asm volatile("" ::: "memory");
    const int c = lane & 7;
#pragma unroll
    for (int j = 0; j < 4; ++j) { const int n = (lane >> 3) + 8 * j; const LAS float* s = scr + (8 * c) * 33 + n;
        u32x4 o; o.x = pk2(s[0 * 33], s[1 * 33]); o.y = pk2(s[2 * 33], s[3 * 33]); o.z = pk2(s[4 * 33], s[5 * 33]); o.w = pk2(s[6 * 33], s[7 * 33]);
        *(GAS u32x4*)(d.dst + (size_t)(d.drow0 + n) * d.K + d.k0 + 8 * c) = o; }
    LDS_WAIT(); asm volatile("" ::: "memory");
}
__device__ __forceinline__ void tr_finish8(const TrD& d, const f32x4 (&v)[8], LAS float* scr, int lane) {
    const int kq = lane >> 3, nq = (lane & 7) * 4;
#pragma unroll
    for (int i = 0; i < 8; ++i) { LAS float* p = scr + (i * 8 + kq) * 33 + nq; p[0] = v[i][0] * d.wsc; p[1] = v[i][1] * d.wsc; p[2] = v[i][2] * d.wsc; p[3] = v[i][3] * d.wsc; }
    LDS_WAIT(); asm volatile("" ::: "memory");
    const int c = lane & 7; unsigned char* dst8 = (unsigned char*)d.dst;
#pragma unroll
    for (int j = 0; j < 4; ++j) { const int n = (lane >> 3) + 8 * j; const LAS float* s = scr + (8 * c) * 33 + n;
        u32x2 o; o.x = pk4_fp8(s[0 * 33], s[1 * 33], s[2 * 33], s[3 * 33]); o.y = pk4_fp8(s[4 * 33], s[5 * 33], s[6 * 33], s[7 * 33]);
        *(GAS u32x2*)(dst8 + (size_t)(d.drow0 + n) * d.K + d.k0 + 8 * c) = o; }
    LDS_WAIT(); asm volatile("" ::: "memory");
}
template <int NTL>
__device__ __forceinline__ void rows16_mm(f32x4 (&acc)[NTL], const bf16_t* A, const LAS bf16_t* Bt, int pitch, int lane) {
    const int lr = lane & 15, lq = lane >> 4;
    const bf16_t* ap = A + (size_t)lr * 1024 + lq * 8;
#pragma unroll 8
    for (int ks = 0; ks < 32; ++ks) {
        const bf16x8 a = *(const bf16x8*)(ap + ks * 32);
#pragma unroll
        for (int t = 0; t < NTL; ++t) { const bf16x8 b = *(const LAS bf16x8*)(Bt + (t * 16 + lr) * pitch + ks * 32 + lq * 8); acc[t] = __builtin_amdgcn_mfma_f32_16x16x32_bf16(a, b, acc[t], 0, 0, 0); }
    }
}
constexpr int TBP = 1056;
__device__ __forceinline__ void tail16(const bf16_t* Urow0, const LAS bf16_t* Wt, float* tail_row0, int lane) {
    f32x4 acc[2] = {(f32x4){0.f, 0.f, 0.f, 0.f}, (f32x4){0.f, 0.f, 0.f, 0.f}};
    rows16_mm<2>(acc, Urow0, Wt, TBP, lane);
    const int lr = lane & 15, lq = lane >> 4;
#pragma unroll
    for (int t = 0; t < 2; ++t)
#pragma unroll
        for (int r = 0; r < 4; ++r) tail_row0[(size_t)(lq * 4 + r) * 32 + t * 16 + lr] = acc[t][r];
}
__device__ __forceinline__ void load_tail_w(LAS bf16_t* Wt, const bf16_t* Wtail  , int tid) {
    for (int p = tid; p < 32 * 128; p += 512) { const int n = p >> 7, c = p & 127; *(LAS u32x4*)(Wt + n * TBP + c * 8) = *(const u32x4*)(Wtail + (size_t)n * 1024 + c * 8); }
}
constexpr int NSP = 1032;
constexpr int NMM_P_OFF = 32 * NSP * 2, NMM_LG_OFF = NMM_P_OFF + 8 * 1024 * 4;
struct NarrowT { bf16x8 bw[4][2]; };
__device__ __forceinline__ void nmm_load_tail(NarrowT& T, const bf16_t* Wtail  , int wid, int lane) {
    const int lr = lane & 15, lq = lane >> 4;
#pragma unroll
    for (int ks = 0; ks < 4; ++ks)
#pragma unroll
        for (int t = 0; t < 2; ++t) T.bw[ks][t] = *(const bf16x8*)(Wtail + (size_t)(t * 16 + lr) * 1024 + wid * 128 + ks * 32 + lq * 8);
}
__device__ __forceinline__ void nmm_load_router(NarrowT& T, const float* rw  , int wid, int lane) {
    const int lr = lane & 15, lq = lane >> 4;
#pragma unroll
    for (int ks = 0; ks < 4; ++ks) { u32x4 hi, lo;
#pragma unroll
        for (int i = 0; i < 4; ++i) { const int k = wid * 128 + ks * 32 + lq * 8 + 2 * i; const float w0 = rw[(size_t)k * 16 + lr], w1 = rw[(size_t)(k + 1) * 16 + lr];
            const unsigned h0 = f2bf(w0), h1 = f2bf(w1); hi[i] = h0 | (h1 << 16); lo[i] = f2bf(w0 - bf2f(h0)) | (f2bf(w1 - bf2f(h1)) << 16); }
        T.bw[ks][0] = __builtin_bit_cast(bf16x8, hi); T.bw[ks][1] = __builtin_bit_cast(bf16x8, lo); }
}
__device__ __forceinline__ void nmm_partials(const NarrowT& T, const LAS bf16_t* S, LAS float* Pb, int wid, int lane) {
    asm volatile("s_waitcnt lgkmcnt(0)\n\ts_barrier" ::: "memory");
    const int lr = lane & 15, lq = lane >> 4;
    f32x4 acc[2][2];
#pragma unroll
    for (int m = 0; m < 2; ++m)
#pragma unroll
        for (int t = 0; t < 2; ++t) acc[m][t] = (f32x4){0.f, 0.f, 0.f, 0.f};
#pragma unroll
    for (int m = 0; m < 2; ++m)
#pragma unroll
        for (int ks = 0; ks < 4; ++ks) { const bf16x8 a = *(const LAS bf16x8*)(S + (16 * m + lr) * NSP + wid * 128 + ks * 32 + lq * 8);
#pragma unroll
            for (int t = 0; t < 2; ++t) acc[m][t] = __builtin_amdgcn_mfma_f32_16x16x32_bf16(a, T.bw[ks][t], acc[m][t], 0, 0, 0); }
#pragma unroll
    for (int m = 0; m < 2; ++m)
#pragma unroll
        for (int t = 0; t < 2; ++t)
#pragma unroll
            for (int r = 0; r < 4; ++r) Pb[wid * 1024 + (16 * m + 4 * lq + r) * 32 + t * 16 + lr] = acc[m][t][r];
    asm volatile("s_waitcnt lgkmcnt(0)\n\ts_barrier" ::: "memory");
}
__device__ __forceinline__ void nmm_step_tail(const NarrowT& T, const LAS bf16_t* S, LAS float* Pb, float* tail_wg  , int i0, int tid, int wid, int lane) {
    nmm_partials(T, S, Pb, wid, lane);
#pragma unroll
    for (int q = 0; q < 2; ++q) { const int o = tid + 512 * q, sr = o >> 5, col = o & 31; float s = 0.f;
#pragma unroll
        for (int w = 0; w < 8; ++w) s += Pb[w * 1024 + o];
        tail_wg[(size_t)((sr >> 2) * 16 + i0 + (sr & 3)) * 32 + col] = s; }
}
__device__ __forceinline__ void nmm_step_router(const NarrowT& T, const LAS bf16_t* S, LAS float* Pb, LAS float* lgs  , int i0, int tid, int wid, int lane) {
    nmm_partials(T, S, Pb, wid, lane);
    { const int sr = tid >> 4, e = tid & 15; float s = 0.f;
#pragma unroll
      for (int w = 0; w < 8; ++w) s += Pb[w * 1024 + sr * 32 + e] + Pb[w * 1024 + sr * 32 + 16 + e];
      lgs[(sr >> 2) * 256 + (i0 + (sr & 3)) * 16 + e] = s; }
}
__device__ __forceinline__ int win_src_col(int n) {
    if (n < 1024) return n;
    if (n < 3584) return n + 8;
    const int i = n - 3584;
    if (i < 16) return 3592 + i;
    if (i < 20) return 1024 + (i - 16);
    if (i < 24) return 1028 + (i - 20);
    return -1;
}

namespace rec {
constexpr int PT = 72;
constexpr int TB = 64 * PT * 2;
constexpr int OFF_T0 = 0, OFF_T1 = TB, OFF_T2 = 2 * TB, OFF_T3 = 3 * TB, OFF_T4 = 4 * TB, OFF_T5 = 5 * TB;
constexpr int OFF_BM = 6 * TB;
constexpr int OFF_HM = OFF_BM + 16384;
constexpr int OFF_VEC = OFF_HM + 64 * 68 * 4;
constexpr int V_G = 0, V_M = 64, V_WI = 128, V_EM = 192, V_DI = 256, V_N = 320, V_BE = 384, V_SEG = 448, V_GA = 960;
static_assert(OFF_VEC + (960 + 1024) * 4 <= RING_BYTES, "rec LDS");

__device__ __forceinline__ void mm64(f32x4 (&acc)[2], const LAS bf16_t* A, const LAS bf16_t* Bt, int wid, int lane) {
    const int tm = wid >> 1, tn0 = (wid & 1) * 2, lr = lane & 15, lq = lane >> 4;
#pragma unroll
    for (int ks = 0; ks < 2; ++ks) {
        const bf16x8 a = *(const LAS bf16x8*)(A + (tm * 16 + lr) * PT + ks * 32 + lq * 8);
#pragma unroll
        for (int t = 0; t < 2; ++t) { const bf16x8 b = *(const LAS bf16x8*)(Bt + ((tn0 + t) * 16 + lr) * PT + ks * 32 + lq * 8);
            acc[t] = __builtin_amdgcn_mfma_f32_16x16x32_bf16(a, b, acc[t], 0, 0, 0); }
    }
}
__device__ __forceinline__ float scan_add(float v, int lane) {
#pragma unroll
    for (int o = 1; o < 64; o <<= 1) { const float t = __shfl_up(v, o); if (lane >= o) v += t; }
    return v;
}
__device__ __forceinline__ float scan_max(float v, int lane) {
#pragma unroll
    for (int o = 1; o < 64; o <<= 1) { const float t = __shfl_up(v, o); if (lane >= o) v = fmaxf(v, t); }
    return v;
}
__device__ __forceinline__ void st_tr8(LAS bf16_t* T, int l, int ch, u32x4 w) {
    T[(ch * 8 + 0) * PT + l] = (bf16_t)(w.x & 0xffffu); T[(ch * 8 + 1) * PT + l] = (bf16_t)(w.x >> 16);
    T[(ch * 8 + 2) * PT + l] = (bf16_t)(w.y & 0xffffu); T[(ch * 8 + 3) * PT + l] = (bf16_t)(w.y >> 16);
    T[(ch * 8 + 4) * PT + l] = (bf16_t)(w.z & 0xffffu); T[(ch * 8 + 5) * PT + l] = (bf16_t)(w.z >> 16);
    T[(ch * 8 + 6) * PT + l] = (bf16_t)(w.w & 0xffffu); T[(ch * 8 + 7) * PT + l] = (bf16_t)(w.w >> 16);
}
__device__ __forceinline__ void unpack8(u32x4 w, float (&f)[8]) {
    f[0] = bflo(w.x); f[1] = bfhi(w.x); f[2] = bflo(w.y); f[3] = bfhi(w.y); f[4] = bflo(w.z); f[5] = bfhi(w.z); f[6] = bflo(w.w); f[7] = bfhi(w.w);
}
template <int GATE  >
__device__ __forceinline__ void finalize(const LAS float* HM, const LAS float* rowscale, const float* gnorm, const bf16_t* gate, bf16_t* out, int tid) {
    const int j = tid >> 3, ch = tid & 7;
    const f32x4 a = *(const LAS f32x4*)(HM + j * 68 + ch * 8), c = *(const LAS f32x4*)(HM + j * 68 + ch * 8 + 4);
    const float rsc = rowscale ? rowscale[j] : 1.f;
    float v[8] = {a[0] * rsc, a[1] * rsc, a[2] * rsc, a[3] * rsc, c[0] * rsc, c[1] * rsc, c[2] * rsc, c[3] * rsc};
    float ss = 0.f;
#pragma unroll
    for (int i = 0; i < 8; ++i) ss += v[i] * v[i];
    ss += __shfl_xor(ss, 1); ss += __shfl_xor(ss, 2); ss += __shfl_xor(ss, 4);
    const float rs = __builtin_amdgcn_rsqf(ss * (1.f / 64.f) + LN_EPS);
    const u32x4 gw = *(const u32x4*)(gate + (size_t)j * PJ + ch * 8);
    float gt[8]; unpack8(gw, gt);
    const f32x4 g0 = *(const f32x4*)(gnorm + ch * 8), g1 = *(const f32x4*)(gnorm + ch * 8 + 4);
    const float gn[8] = {g0[0], g0[1], g0[2], g0[3], g1[0], g1[1], g1[2], g1[3]};
    float y[8];
#pragma unroll
    for (int i = 0; i < 8; ++i) { const float sg = 1.f / (1.f + fexp(-gt[i])); const float gv = GATE ? gt[i] * sg : sg; y[i] = v[i] * rs * gn[i] * gv; }
    u32x4 w; w.x = pk2(y[0], y[1]); w.y = pk2(y[2], y[3]); w.z = pk2(y[4], y[5]); w.w = pk2(y[6], y[7]);
    *(u32x4*)(out + (size_t)j * DM + ch * 8) = w;
}

struct RecP {
    const bf16_t* proj; const float* tail; const bf16_t* csm; const bf16_t* csg; float* stm; float* stg; float* smN; float* smBC; float* smDM; float* smMS; float* smGBE; bf16_t* ycat;
    const float* mbi; const float* mbf; const float* mg; const float* wa2; const float* ba; const float* gg;
};

struct MLoc { u32x4 k, v; float mi, mf; };
struct MOut { u32x4 q, k, v, st, mo; float mi, mf, m, n; };
struct GLoc { u32x4 k, v; f32x4 ga; };
struct GOut { u32x4 q, k, v, st, gr; f32x4 ga; };
struct GW { float wv[16]; float bav; };

__device__ __forceinline__ void ld_mloc(MLoc& L, const RecP& P, int ci, int tid, int wid, int lane) {
    const int bh = ci >> 6, c = ci & 63, b = bh >> 2, h = bh & 3, row0 = b * SEQ + c * 64, l = tid >> 3, ch = tid & 7;
    const bf16_t* pr = P.proj + (size_t)(row0 + l) * PJ + h * 64 + ch * 8;
    L.k = *(const u32x4*)(pr + C_MK); L.v = *(const u32x4*)(pr + C_MV);
    if (wid == 0) { const float* tp = P.tail + (size_t)(row0 + lane) * 32; L.mi = tp[T_MI + h]; L.mf = tp[T_MF + h]; } else { L.mi = 0.f; L.mf = 0.f; }
}
__device__ __forceinline__ void ld_mout(MOut& L, const RecP& P, int ci, int tid, int wid, int lane) {
    const int bh = ci >> 6, c = ci & 63, b = bh >> 2, h = bh & 3, row0 = b * SEQ + c * 64, l = tid >> 3, ch = tid & 7;
    const bf16_t* pr = P.proj + (size_t)(row0 + l) * PJ + h * 64 + ch * 8;
    L.q = *(const u32x4*)(pr + C_MQ); L.k = *(const u32x4*)(pr + C_MK); L.v = *(const u32x4*)(pr + C_MV); L.mo = *(const u32x4*)(pr + C_MO);
    L.st = *(const u32x4*)(P.csm + (size_t)ci * 4096 + l * 64 + ch * 8);
    if (wid == 0) { const float* tp = P.tail + (size_t)(row0 + lane) * 32; L.mi = tp[T_MI + h]; L.mf = tp[T_MF + h]; L.m = P.smMS[ci]; L.n = P.smN[(size_t)ci * 64 + lane]; } else { L.mi = 0.f; L.mf = 0.f; L.m = 0.f; L.n = 0.f; }
}
__device__ __forceinline__ void ld_gloc(GLoc& L, const RecP& P, int ci, int tid) {
    const int bh = ci >> 6, c = ci & 63, b = bh >> 2, h = bh & 3, row0 = b * SEQ + c * 64, l = tid >> 3, ch = tid & 7;
    const bf16_t* pr = P.proj + (size_t)(row0 + l) * PJ + h * 64 + ch * 8;
    L.k = *(const u32x4*)(pr + C_GK); L.v = *(const u32x4*)(pr + C_GV);
    L.ga = (tid < 256) ? *(const f32x4*)(P.tail + (size_t)(row0 + (tid >> 2)) * 32 + T_GA + (tid & 3) * 4) : (f32x4){0.f, 0.f, 0.f, 0.f};
}
__device__ __forceinline__ void ld_gout(GOut& L, const RecP& P, int ci, int tid) {
    const int bh = ci >> 6, c = ci & 63, b = bh >> 2, h = bh & 3, row0 = b * SEQ + c * 64, l = tid >> 3, ch = tid & 7;
    const bf16_t* pr = P.proj + (size_t)(row0 + l) * PJ + h * 64 + ch * 8;
    L.q = *(const u32x4*)(pr + C_GQ); L.k = *(const u32x4*)(pr + C_GK); L.v = *(const u32x4*)(pr + C_GV); L.gr = *(const u32x4*)(pr + C_GR);
    L.st = *(const u32x4*)(P.csg + (size_t)ci * 4096 + l * 64 + ch * 8);
    L.ga = (tid < 256) ? *(const f32x4*)(P.tail + (size_t)(row0 + (tid >> 2)) * 32 + T_GA + (tid & 3) * 4) : (f32x4){0.f, 0.f, 0.f, 0.f};
}
__device__ __forceinline__ void ld_gw(GW& W, const RecP& P, int h, int tid) {
    const int dcol = tid & 63;
#pragma unroll
    for (int r = 0; r < 16; ++r) W.wv[r] = P.wa2[r * 256 + h * 64 + dcol];
    W.bav = P.ba[h * 64 + dcol];
}
template <int GATE  >
__device__ __forceinline__ void finalize2(const LAS float* HM, const LAS float* rowscale, const float* gnorm, u32x4 gw, bf16_t* out, int tid) {
    const int j = tid >> 3, ch = tid & 7;
    const f32x4 a = *(const LAS f32x4*)(HM + j * 68 + ch * 8), c = *(const LAS f32x4*)(HM + j * 68 + ch * 8 + 4);
    const float rsc = rowscale ? rowscale[j] : 1.f;
    float v[8] = {a[0] * rsc, a[1] * rsc, a[2] * rsc, a[3] * rsc, c[0] * rsc, c[1] * rsc, c[2] * rsc, c[3] * rsc};
    float ss = 0.f;
#pragma unroll
    for (int i = 0; i < 8; ++i) ss += v[i] * v[i];
    ss += __shfl_xor(ss, 1); ss += __shfl_xor(ss, 2); ss += __shfl_xor(ss, 4);
    const float rs = __builtin_amdgcn_rsqf(ss * (1.f / 64.f) + LN_EPS);
    float gt[8]; unpack8(gw, gt);
    const f32x4 g0 = *(const f32x4*)(gnorm + ch * 8), g1 = *(const f32x4*)(gnorm + ch * 8 + 4);
    const float gn[8] = {g0[0], g0[1], g0[2], g0[3], g1[0], g1[1], g1[2], g1[3]};
    float y[8];
#pragma unroll
    for (int i = 0; i < 8; ++i) { const float sg = 1.f / (1.f + fexp(-gt[i])); const float gv = GATE ? gt[i] * sg : sg; y[i] = v[i] * rs * gn[i] * gv; }
    u32x4 w; w.x = pk2(y[0], y[1]); w.y = pk2(y[2], y[3]); w.z = pk2(y[4], y[5]); w.w = pk2(y[6], y[7]);
    *(u32x4*)(out + (size_t)j * DM + ch * 8) = w;
}
__device__ __forceinline__ void mlstm_local(const MLoc& L, const RecP& P, LAS unsigned char* lds, int ci, int tid, int wid, int lane) {
    const int h = (ci >> 6) & 3;
    LAS bf16_t* KT = (LAS bf16_t*)(lds + OFF_T0); LAS bf16_t* VT = (LAS bf16_t*)(lds + OFF_T1); LAS float* vec = (LAS float*)(lds + OFF_VEC);
    const int l = tid >> 3, ch = tid & 7;
    if (wid == 0) {
        const float li = L.mi + P.mbi[h], lf = logsig(L.mf + P.mbf[h]);
        const float bc = scan_add(lf, lane), g = li - bc;
        const float gmax = wave_max(g), bend = __shfl(bc, 63);
        vec[V_G + lane] = fexp(g - gmax);
        if (lane == 0) { P.smBC[ci] = bend; P.smDM[ci] = bend + gmax; }
    }
    __syncthreads();
    { const float w = vec[V_G + l]; float kf[8]; unpack8(L.k, kf);
      u32x4 ks; ks.x = pk2(kf[0] * w, kf[1] * w); ks.y = pk2(kf[2] * w, kf[3] * w); ks.z = pk2(kf[4] * w, kf[5] * w); ks.w = pk2(kf[6] * w, kf[7] * w);
      st_tr8(KT, l, ch, ks); st_tr8(VT, l, ch, L.v); }
    __syncthreads();
    f32x4 acc[2] = {(f32x4){0.f, 0.f, 0.f, 0.f}, (f32x4){0.f, 0.f, 0.f, 0.f}};
    mm64(acc, VT, KT, wid, lane);
    { const int tm = wid >> 1, tn0 = (wid & 1) * 2, lr = lane & 15, lq = lane >> 4; float* dst = P.stm + (size_t)ci * 4096;
#pragma unroll
      for (int t = 0; t < 2; ++t)
#pragma unroll
          for (int r = 0; r < 4; ++r) dst[(tm * 16 + lq * 4 + r) * 64 + (tn0 + t) * 16 + lr] = acc[t][r]; }
    if (tid < 64) { float s = 0.f;
#pragma unroll
        for (int q = 0; q < 8; ++q) { const u32x4 w = *(const LAS u32x4*)(KT + tid * PT + q * 8); float f[8]; unpack8(w, f);
#pragma unroll
            for (int i = 0; i < 8; ++i) s += f[i]; }
        P.smN[(size_t)ci * 64 + tid] = s; }
    __syncthreads();
}
__device__ __forceinline__ void mlstm_out(const MOut& L, const RecP& P, LAS unsigned char* lds, int ci, int tid, int wid, int lane) {
    const int bh = ci >> 6, c = ci & 63, b = bh >> 2, h = bh & 3, row0 = b * SEQ + c * 64;
    LAS bf16_t* Qm = (LAS bf16_t*)(lds + OFF_T0); LAS bf16_t* Km = (LAS bf16_t*)(lds + OFF_T1); LAS bf16_t* VT = (LAS bf16_t*)(lds + OFF_T2);
    LAS bf16_t* CT = (LAS bf16_t*)(lds + OFF_T3); LAS bf16_t* Sm = (LAS bf16_t*)(lds + OFF_T4);
    LAS float* HM = (LAS float*)(lds + OFF_HM); LAS float* vec = (LAS float*)(lds + OFF_VEC);
    const int l = tid >> 3, ch = tid & 7;
    *(LAS u32x4*)(Qm + l * PT + ch * 8) = L.q; *(LAS u32x4*)(Km + l * PT + ch * 8) = L.k; st_tr8(VT, l, ch, L.v); *(LAS u32x4*)(CT + l * PT + ch * 8) = L.st;
    if (wid == 0) {
        const float li = L.mi + P.mbi[h], lf = logsig(L.mf + P.mbf[h]);
        const float bc = scan_add(lf, lane), g = li - bc;
        const float pm = scan_max(g, lane), m = L.m, M = fmaxf(m, pm);
        vec[V_G + lane] = g; vec[V_M + lane] = M; vec[V_WI + lane] = fexp(m - M); vec[V_EM + lane] = fexp(-bc - M);
        vec[V_N + lane] = L.n;
    }
    __syncthreads();
    { f32x4 acc[2] = {(f32x4){0.f, 0.f, 0.f, 0.f}, (f32x4){0.f, 0.f, 0.f, 0.f}};
      mm64(acc, Qm, Km, wid, lane);
      const int tm = wid >> 1, tn0 = (wid & 1) * 2, lr = lane & 15, lq = lane >> 4;
#pragma unroll
      for (int t = 0; t < 2; ++t) { const int ll = (tn0 + t) * 16 + lr; const float gl = vec[V_G + ll];
#pragma unroll
          for (int r = 0; r < 4; ++r) { const int j = tm * 16 + lq * 4 + r; const float s = (ll <= j) ? acc[t][r] * fexp(gl - vec[V_M + j]) : 0.f; Sm[j * PT + ll] = (bf16_t)f2bf(s); } } }
    __syncthreads();
    { f32x4 a1[2] = {(f32x4){0.f, 0.f, 0.f, 0.f}, (f32x4){0.f, 0.f, 0.f, 0.f}}, a2[2] = {(f32x4){0.f, 0.f, 0.f, 0.f}, (f32x4){0.f, 0.f, 0.f, 0.f}};
      mm64(a1, Sm, VT, wid, lane); mm64(a2, Qm, CT, wid, lane);
      const int tm = wid >> 1, tn0 = (wid & 1) * 2, lr = lane & 15, lq = lane >> 4;
#pragma unroll
      for (int t = 0; t < 2; ++t)
#pragma unroll
          for (int r = 0; r < 4; ++r) { const int j = tm * 16 + lq * 4 + r; HM[j * 68 + (tn0 + t) * 16 + lr] = a1[t][r] + vec[V_WI + j] * a2[t][r]; } }
    if (tid < 64) { float ds = 0.f, qn = 0.f;
#pragma unroll
        for (int q = 0; q < 8; ++q) { const u32x4 w = *(const LAS u32x4*)(Sm + tid * PT + q * 8); float f[8]; unpack8(w, f);
            const u32x4 qw = *(const LAS u32x4*)(Qm + tid * PT + q * 8); float qf[8]; unpack8(qw, qf);
#pragma unroll
            for (int i = 0; i < 8; ++i) { ds += f[i]; qn += qf[i] * vec[V_N + q * 8 + i]; } }
        const float den = ds + vec[V_WI + tid] * qn;
        vec[V_DI + tid] = 1.f / fmaxf(fabsf(den), vec[V_EM + tid]); }
    __syncthreads();
    finalize2<0>(HM, vec + V_DI, P.mg, L.mo, P.ycat + (size_t)row0 * DM + h * 64, tid);
    __syncthreads();
}
__device__ __forceinline__ void gla_bmat(const f32x4 ga, const GW& W, LAS unsigned char* lds, int tid, int wid) {
    LAS float* BM = (LAS float*)(lds + OFF_BM); LAS float* vec = (LAS float*)(lds + OFF_VEC);
    if (tid < 256) { const int l = tid >> 2, q = tid & 3; vec[V_GA + l * 16 + q * 4 + 0] = ga[0]; vec[V_GA + l * 16 + q * 4 + 1] = ga[1]; vec[V_GA + l * 16 + q * 4 + 2] = ga[2]; vec[V_GA + l * 16 + q * 4 + 3] = ga[3]; }
    const int dcol = tid & 63;
    __syncthreads();
    float cs[8]; float cacc = 0.f;
#pragma unroll
    for (int i = 0; i < 8; ++i) { const int l = wid * 8 + i; float z = W.bav;
#pragma unroll
        for (int r = 0; r < 16; ++r) z += vec[V_GA + l * 16 + r] * W.wv[r];
        cacc += logsig(z) * (1.f / 16.f); cs[i] = cacc; }
    vec[V_SEG + wid * 64 + dcol] = cacc;
    __syncthreads();
    float off = 0.f, tot = 0.f;
#pragma unroll
    for (int s = 0; s < 8; ++s) { const float v = vec[V_SEG + s * 64 + dcol]; tot += v; if (s < wid) off += v; }
#pragma unroll
    for (int i = 0; i < 8; ++i) BM[(wid * 8 + i) * 64 + dcol] = off + cs[i];
    if (wid == 0) vec[V_BE + dcol] = tot;
    __syncthreads();
}
__device__ __forceinline__ void gla_local(const GLoc& L, const GW& W, const RecP& P, LAS unsigned char* lds, int ci, int tid, int wid, int lane) {
    LAS bf16_t* KT = (LAS bf16_t*)(lds + OFF_T0); LAS bf16_t* VT = (LAS bf16_t*)(lds + OFF_T1);
    LAS float* BM = (LAS float*)(lds + OFF_BM); LAS float* vec = (LAS float*)(lds + OFF_VEC);
    const int l = tid >> 3, ch = tid & 7;
    gla_bmat(L.ga, W, lds, tid, wid);
    if (tid < 64) P.smGBE[(size_t)ci * 64 + tid] = vec[V_BE + tid];
    { float kf[8]; unpack8(L.k, kf); float ks[8];
#pragma unroll
      for (int i = 0; i < 8; ++i) { const int d = ch * 8 + i; ks[i] = kf[i] * fexp(vec[V_BE + d] - BM[l * 64 + d]); }
      u32x4 kk; kk.x = pk2(ks[0], ks[1]); kk.y = pk2(ks[2], ks[3]); kk.z = pk2(ks[4], ks[5]); kk.w = pk2(ks[6], ks[7]);
      st_tr8(KT, l, ch, kk); st_tr8(VT, l, ch, L.v); }
    __syncthreads();
    f32x4 acc[2] = {(f32x4){0.f, 0.f, 0.f, 0.f}, (f32x4){0.f, 0.f, 0.f, 0.f}};
    mm64(acc, VT, KT, wid, lane);
    { const int tm = wid >> 1, tn0 = (wid & 1) * 2, lr = lane & 15, lq = lane >> 4; float* dst = P.stg + (size_t)ci * 4096;
#pragma unroll
      for (int t = 0; t < 2; ++t)
#pragma unroll
          for (int r = 0; r < 4; ++r) dst[(tm * 16 + lq * 4 + r) * 64 + (tn0 + t) * 16 + lr] = acc[t][r]; }
    __syncthreads();
}
__device__ __forceinline__ void gla_out(const GOut& L, const GW& W, const RecP& P, LAS unsigned char* lds, int ci, int tid, int wid, int lane) {
    const int bh = ci >> 6, c = ci & 63, b = bh >> 2, h = bh & 3, row0 = b * SEQ + c * 64;
    LAS bf16_t* Qm = (LAS bf16_t*)(lds + OFF_T0); LAS bf16_t* Km = (LAS bf16_t*)(lds + OFF_T1); LAS bf16_t* VT = (LAS bf16_t*)(lds + OFF_T2);
    LAS bf16_t* ST = (LAS bf16_t*)(lds + OFF_T3); LAS bf16_t* Sm = (LAS bf16_t*)(lds + OFF_T4);
    LAS float* BM = (LAS float*)(lds + OFF_BM); LAS float* HM = (LAS float*)(lds + OFF_HM);
    const int l = tid >> 3, ch = tid & 7;
    gla_bmat(L.ga, W, lds, tid, wid);
    { float qf[8], kf[8]; unpack8(L.q, qf); unpack8(L.k, kf); float qs[8], ks[8];
#pragma unroll
      for (int i = 0; i < 8; ++i) { const float bv = BM[l * 64 + ch * 8 + i]; qs[i] = qf[i] * fexp(bv); ks[i] = kf[i] * fexp(-bv); }
      u32x4 qq, kk; qq.x = pk2(qs[0], qs[1]); qq.y = pk2(qs[2], qs[3]); qq.z = pk2(qs[4], qs[5]); qq.w = pk2(qs[6], qs[7]);
      kk.x = pk2(ks[0], ks[1]); kk.y = pk2(ks[2], ks[3]); kk.z = pk2(ks[4], ks[5]); kk.w = pk2(ks[6], ks[7]);
      *(LAS u32x4*)(Qm + l * PT + ch * 8) = qq; *(LAS u32x4*)(Km + l * PT + ch * 8) = kk; st_tr8(VT, l, ch, L.v);
      *(LAS u32x4*)(ST + l * PT + ch * 8) = L.st; }
    __syncthreads();
    { f32x4 acc[2] = {(f32x4){0.f, 0.f, 0.f, 0.f}, (f32x4){0.f, 0.f, 0.f, 0.f}};
      mm64(acc, Qm, Km, wid, lane);
      const int tm = wid >> 1, tn0 = (wid & 1) * 2, lr = lane & 15, lq = lane >> 4;
#pragma unroll
      for (int t = 0; t < 2; ++t) { const int ll = (tn0 + t) * 16 + lr;
#pragma unroll
          for (int r = 0; r < 4; ++r) { const int j = tm * 16 + lq * 4 + r; Sm[j * PT + ll] = (bf16_t)f2bf((ll <= j) ? acc[t][r] : 0.f); } } }
    __syncthreads();
    { f32x4 acc[2] = {(f32x4){0.f, 0.f, 0.f, 0.f}, (f32x4){0.f, 0.f, 0.f, 0.f}};
      mm64(acc, Sm, VT, wid, lane); mm64(acc, Qm, ST, wid, lane);
      const int tm = wid >> 1, tn0 = (wid & 1) * 2, lr = lane & 15, lq = lane >> 4;
#pragma unroll
      for (int t = 0; t < 2; ++t)
#pragma unroll
          for (int r = 0; r < 4; ++r) HM[(tm * 16 + lq * 4 + r) * 68 + (tn0 + t) * 16 + lr] = acc[t][r]; }
    __syncthreads();
    finalize2<1>(HM, nullptr, P.gg, L.gr, P.ycat + (size_t)row0 * DM + 768 + h * 64, tid);
    __syncthreads();
}
}

namespace recw {
using rec::RecP; using rec::scan_add; using rec::scan_max; using rec::unpack8;
typedef short s16x4v __attribute__((ext_vector_type(4)));
typedef short v4i16_t __attribute__((ext_vector_type(4)));
#define MF16(a, b, c) __builtin_amdgcn_mfma_f32_16x16x32_bf16((a), (b), (c), 0, 0, 0)
__device__ __forceinline__ s16x4v tr16(const LAS bf16_t* p) { return __builtin_bit_cast(s16x4v, __builtin_amdgcn_ds_read_tr16_b64_v4i16((LAS v4i16_t*)p)); }
__device__ __forceinline__ bf16x8 trfrag(const LAS bf16_t* T, int pitch, int s, int c0, int lane) {
    const int i = lane & 15, q = lane >> 4;
    const LAS bf16_t* pa = T + (32 * s + 4 * q + (i >> 2)) * pitch + c0 + 4 * (i & 3);
    const s16x4v lo = tr16(pa), hi = tr16(pa + 16 * pitch);
    return (bf16x8){lo[0], lo[1], lo[2], lo[3], hi[0], hi[1], hi[2], hi[3]};
}
__device__ __forceinline__ bf16x8 rfg(const bf16_t* X, int pitch, int T, int ks, int lane) { return *(const bf16x8*)(X + (size_t)(16 * T + (lane & 15)) * pitch + 32 * ks + 8 * (lane >> 4)); }
__device__ __forceinline__ u32x4 piece(const bf16_t* X, int pitch, int i, int lane) { return *(const u32x4*)(X + (size_t)((lane >> 3) + 8 * i) * pitch + (lane & 7) * 8); }
__device__ __forceinline__ bf16x8 frag_scale(bf16x8 f, float sc) {
    const u32x4 w = __builtin_bit_cast(u32x4, f); u32x4 o;
    o.x = pk2(bflo(w.x) * sc, bfhi(w.x) * sc); o.y = pk2(bflo(w.y) * sc, bfhi(w.y) * sc); o.z = pk2(bflo(w.z) * sc, bfhi(w.z) * sc); o.w = pk2(bflo(w.w) * sc, bfhi(w.w) * sc);
    return __builtin_bit_cast(bf16x8, o);
}
__device__ __forceinline__ bf16x8 frag_mul(bf16x8 f, bf16x8 g, bool recip) {
    const u32x4 a = __builtin_bit_cast(u32x4, f), b = __builtin_bit_cast(u32x4, g); float x[8], y[8]; unpack8(a, x); unpack8(b, y);
#pragma unroll
    for (int i = 0; i < 8; ++i) x[i] = recip ? x[i] * __builtin_amdgcn_rcpf(y[i]) : x[i] * y[i];
    u32x4 o; o.x = pk2(x[0], x[1]); o.y = pk2(x[2], x[3]); o.z = pk2(x[4], x[5]); o.w = pk2(x[6], x[7]);
    return __builtin_bit_cast(bf16x8, o);
}
__device__ __forceinline__ float red_q(float v) { v += __shfl_xor(v, 16); v += __shfl_xor(v, 32); return v; }
__device__ __forceinline__ void stage_rows(f32x4 (&O)[4], int Tj, float rowscale, LAS bf16_t* Tl, int PTL, int lane) {
    const int r = lane & 15, q = lane >> 4;
    float ss = 0.f;
#pragma unroll
    for (int Te = 0; Te < 4; ++Te) { O[Te] = O[Te] * rowscale; const f32x4 v = O[Te]; ss += (v[0] * v[0] + v[1] * v[1]) + (v[2] * v[2] + v[3] * v[3]); }
    ss = red_q(ss);
    const float rs = __builtin_amdgcn_rsqf(ss * (1.f / 64.f) + LN_EPS);
#pragma unroll
    for (int Te = 0; Te < 4; ++Te) { const f32x4 v = O[Te] * rs; u32x2 w; w.x = pk2(v[0], v[1]); w.y = pk2(v[2], v[3]); *(LAS u32x2*)(Tl + (16 * Tj + r) * PTL + 16 * Te + 4 * q) = w; }
}
template <int GATE>
__device__ __forceinline__ void final_store(const LAS bf16_t* Tl, int PTL, const float* gnorm, const bf16_t* gate, bf16_t* out, int lane) {
    const int ch = lane & 7;
    const f32x4 g0 = *(const f32x4*)(gnorm + ch * 8), g1 = *(const f32x4*)(gnorm + ch * 8 + 4);
    const float gn[8] = {g0[0], g0[1], g0[2], g0[3], g1[0], g1[1], g1[2], g1[3]};
#pragma unroll
    for (int i = 0; i < 8; ++i) { const int row = (lane >> 3) + 8 * i;
        float hv[8], gt[8]; unpack8(*(const LAS u32x4*)(Tl + row * PTL + ch * 8), hv); unpack8(*(const u32x4*)(gate + (size_t)row * PJ + ch * 8), gt);
        float y[8];
#pragma unroll
        for (int k = 0; k < 8; ++k) { const float sg = __builtin_amdgcn_rcpf(1.f + fexp(-gt[k])); y[k] = hv[k] * (gn[k] * Y8S) * (GATE ? gt[k] * sg : sg); }
        u32x2 w; w.x = pk4_fp8(y[0], y[1], y[2], y[3]); w.y = pk4_fp8(y[4], y[5], y[6], y[7]);
        *(u32x2*)((unsigned char*)out + (size_t)row * DM + ch * 8) = w; }
}
__device__ __forceinline__ void mlstm_local_w(const RecP& P, LAS unsigned char* wl, int ci, int lane) {
    const int r = lane & 15, q = lane >> 4; constexpr int PL = 64;
    const int bh = ci >> 6, c = ci & 63, b = bh >> 2, h = bh & 3, row0 = b * SEQ + c * 64;
    const bf16_t* Xk = P.proj + (size_t)row0 * PJ + C_MK + h * 64; const bf16_t* Xv = P.proj + (size_t)row0 * PJ + C_MV + h * 64;
    LAS bf16_t* Kl = (LAS bf16_t*)wl; LAS bf16_t* Vl = (LAS bf16_t*)(wl + 8192);
    const float* tp = P.tail + (size_t)(row0 + lane) * 32;
    const float li = tp[T_MI + h] + P.mbi[h], lf = logsig(tp[T_MF + h] + P.mbf[h]);
    const float bc = scan_add(lf, lane), g = li - bc, gmax = wave_max(g), bend = __shfl(bc, 63), w = fexp(g - gmax);
    if (lane == 0) { P.smBC[ci] = bend; P.smDM[ci] = bend + gmax; }
#pragma unroll
    for (int i = 0; i < 8; ++i) { const u32x4 kpi = piece(Xk, PJ, i, lane), vpi = piece(Xv, PJ, i, lane); const float wr_ = __shfl(w, (lane >> 3) + 8 * i); float kf[8]; unpack8(kpi, kf);
        u32x4 ks; ks.x = pk2(kf[0] * wr_, kf[1] * wr_); ks.y = pk2(kf[2] * wr_, kf[3] * wr_); ks.z = pk2(kf[4] * wr_, kf[5] * wr_); ks.w = pk2(kf[6] * wr_, kf[7] * wr_);
        *(LAS u32x4*)(Kl + ((lane >> 3) + 8 * i) * PL + (lane & 7) * 8) = ks; *(LAS u32x4*)(Vl + ((lane >> 3) + 8 * i) * PL + (lane & 7) * 8) = vpi; }
    asm volatile("" ::: "memory"); __builtin_amdgcn_sched_barrier(0);
    bf16x8 Kt[4][2];
#pragma unroll
    for (int Td = 0; Td < 4; ++Td)
#pragma unroll
        for (int s = 0; s < 2; ++s) Kt[Td][s] = trfrag(Kl, PL, s, 16 * Td, lane);
#pragma unroll
    for (int Te = 0; Te < 4; ++Te) { const bf16x8 v0 = trfrag(Vl, PL, 0, 16 * Te, lane), v1 = trfrag(Vl, PL, 1, 16 * Te, lane);
#pragma unroll
        for (int Td = 0; Td < 4; ++Td) { f32x4 acc = (f32x4){0.f, 0.f, 0.f, 0.f}; acc = MF16(Kt[Td][0], v0, acc); acc = MF16(Kt[Td][1], v1, acc);
            u32x2 w; w.x = pk2(acc[0], acc[1]); w.y = pk2(acc[2], acc[3]); *(LAS u32x2*)(Kl + (16 * Te + r) * PL + 16 * Td + 4 * q) = w; } }
    asm volatile("" ::: "memory"); __builtin_amdgcn_sched_barrier(0);
    { bf16_t* dstb = (bf16_t*)P.stm + (size_t)ci * 4096;
#pragma unroll
      for (int i = 0; i < 8; ++i) { const int row = (lane >> 3) + 8 * i, ch = lane & 7; *(u32x4*)(dstb + row * 64 + ch * 8) = *(const LAS u32x4*)(Kl + row * PL + ch * 8); } }
    { const short one = (short)0x3F80; const bf16x8 ones = (bf16x8){one, one, one, one, one, one, one, one};
#pragma unroll
      for (int Td = 0; Td < 4; ++Td) { f32x4 acc = (f32x4){0.f, 0.f, 0.f, 0.f}; acc = MF16(ones, Kt[Td][0], acc); acc = MF16(ones, Kt[Td][1], acc);
          if (q == 0) P.smN[(size_t)ci * 64 + 16 * Td + r] = acc[0]; } }
}
struct GWf { bf16x8 Bw[4]; float ba[4]; };
__device__ __forceinline__ void ld_gwf(GWf& W, const RecP& P, int h, int lane) {
    const int r = lane & 15, q = lane >> 4;
    int wo = (8 * (q & 1)) * 256 + h * 64 + r; asm volatile("" : "+v"(wo)); const float* wp = P.wa2 + wo;
#pragma unroll
    for (int Td = 0; Td < 4; ++Td) { float w8[8];
#pragma unroll
        for (int i = 0; i < 8; ++i) { const float wv_ = wp[i * 256 + 16 * Td]; w8[i] = (q < 2) ? wv_ : 0.f; }
        u32x4 o; o.x = pk2(w8[0], w8[1]); o.y = pk2(w8[2], w8[3]); o.z = pk2(w8[4], w8[5]); o.w = pk2(w8[6], w8[7]); W.Bw[Td] = __builtin_bit_cast(bf16x8, o);
        W.ba[Td] = P.ba[h * 64 + 16 * Td + r]; }
}
template <int MODE>
__device__ __forceinline__ void gla_gate_tile(LAS bf16_t* Tt, int PL, float (&bend)[4], const GWf& W, const float* tail_row0, int lane) {
    const int r = lane & 15, q = lane >> 4;
    bf16x8 Ag[4];
    int to = r * 32 + T_GA + 8 * (q & 1); asm volatile("" : "+v"(to)); const float* tpb = tail_row0 + to;
#pragma unroll
    for (int Tl = 0; Tl < 4; ++Tl) { f32x4 a0 = *(const f32x4*)(tpb + Tl * 512), a1 = *(const f32x4*)(tpb + Tl * 512 + 4);
        if (q >= 2) { a0 = (f32x4){0.f, 0.f, 0.f, 0.f}; a1 = a0; }
        u32x4 o; o.x = pk2(a0[0], a0[1]); o.y = pk2(a0[2], a0[3]); o.z = pk2(a1[0], a1[1]); o.w = pk2(a1[2], a1[3]); Ag[Tl] = __builtin_bit_cast(bf16x8, o); }
#pragma unroll
    for (int Td = 0; Td < 4; ++Td) { float carry = 0.f; LAS bf16_t* tcol = Tt + (4 * q) * PL + 16 * Td + r;
#pragma unroll
        for (int tt = 0; tt < 4; ++tt) { const int Tl = MODE ? 3 - tt : tt; const float bb = W.ba[Td]; const f32x4 z = MF16(Ag[Tl], W.Bw[Td], ((f32x4){bb, bb, bb, bb}));
            const float v0 = logsig(z[0]) * (1.f / 16.f), v1 = logsig(z[1]) * (1.f / 16.f), v2 = logsig(z[2]) * (1.f / 16.f), v3 = logsig(z[3]) * (1.f / 16.f);
            const float lt = (v0 + v1) + (v2 + v3);
            float ex, o0, o1, o2, o3;
            if (MODE == 0) { const float t1 = __shfl_up(lt, 16), t2 = __shfl_up(lt, 32), t3 = __shfl_up(lt, 48); ex = carry + (q >= 1 ? t1 : 0.f) + (q >= 2 ? t2 : 0.f) + (q >= 3 ? t3 : 0.f);
                o0 = ex + v0; o1 = o0 + v1; o2 = o1 + v2; o3 = o2 + v3; }
            else { const float t1 = __shfl_down(lt, 16), t2 = __shfl_down(lt, 32), t3 = __shfl_down(lt, 48); ex = carry + (q <= 2 ? t1 : 0.f) + (q <= 1 ? t2 : 0.f) + (q <= 0 ? t3 : 0.f);
                o3 = ex; o2 = o3 + v3; o1 = o2 + v2; o0 = o1 + v1; }
            carry += red_q(lt);
            LAS bf16_t* tp = tcol + (16 * Tl) * PL;
            const unsigned w01 = pk2(fexp(o0), fexp(o1)), w23 = pk2(fexp(o2), fexp(o3));
            tp[0] = (bf16_t)(w01 & 0xffffu); tp[PL] = (bf16_t)(w01 >> 16); tp[2 * PL] = (bf16_t)(w23 & 0xffffu); tp[3 * PL] = (bf16_t)(w23 >> 16); }
        bend[Td] = carry; }
}
__device__ __forceinline__ void gla_local_w(const RecP& P, const GWf& W, LAS unsigned char* wl, int ci, int lane) {
    const int r = lane & 15, q = lane >> 4; constexpr int PL = 64;
    const int bh = ci >> 6, c = ci & 63, b = bh >> 2, h = bh & 3, row0 = b * SEQ + c * 64;
    const bf16_t* Xk = P.proj + (size_t)row0 * PJ + C_GK + h * 64; const bf16_t* Xv = P.proj + (size_t)row0 * PJ + C_GV + h * 64;
    LAS bf16_t* Kl = (LAS bf16_t*)wl; LAS bf16_t* Vl = (LAS bf16_t*)(wl + 8192);
    { float bend[4]; gla_gate_tile<1>(Kl, PL, bend, W, P.tail + (size_t)row0 * 32, lane);
      if (q == 0) {
#pragma unroll
          for (int Td = 0; Td < 4; ++Td) P.smGBE[(size_t)ci * 64 + 16 * Td + r] = bend[Td]; } }
    asm volatile("" ::: "memory"); __builtin_amdgcn_sched_barrier(0);
#pragma unroll
    for (int i = 0; i < 8; ++i) { const u32x4 kp = piece(Xk, PJ, i, lane), vp = piece(Xv, PJ, i, lane);
        LAS bf16_t* kp_l = Kl + ((lane >> 3) + 8 * i) * PL + (lane & 7) * 8; float kf[8], ff[8]; unpack8(kp, kf); unpack8(*(const LAS u32x4*)kp_l, ff);
        u32x4 ks; ks.x = pk2(kf[0] * ff[0], kf[1] * ff[1]); ks.y = pk2(kf[2] * ff[2], kf[3] * ff[3]); ks.z = pk2(kf[4] * ff[4], kf[5] * ff[5]); ks.w = pk2(kf[6] * ff[6], kf[7] * ff[7]);
        *(LAS u32x4*)kp_l = ks; *(LAS u32x4*)(Vl + ((lane >> 3) + 8 * i) * PL + (lane & 7) * 8) = vp; }
    asm volatile("" ::: "memory"); __builtin_amdgcn_sched_barrier(0);
    bf16x8 Kt[4][2];
#pragma unroll
    for (int Td = 0; Td < 4; ++Td)
#pragma unroll
        for (int s = 0; s < 2; ++s) Kt[Td][s] = trfrag(Kl, PL, s, 16 * Td, lane);
#pragma unroll
    for (int Te = 0; Te < 4; ++Te) { const bf16x8 v0 = trfrag(Vl, PL, 0, 16 * Te, lane), v1 = trfrag(Vl, PL, 1, 16 * Te, lane);
#pragma unroll
        for (int Td = 0; Td < 4; ++Td) { f32x4 acc = (f32x4){0.f, 0.f, 0.f, 0.f}; acc = MF16(Kt[Td][0], v0, acc); acc = MF16(Kt[Td][1], v1, acc);
            u32x2 w; w.x = pk2(acc[0], acc[1]); w.y = pk2(acc[2], acc[3]); *(LAS u32x2*)(Kl + (16 * Te + r) * PL + 16 * Td + 4 * q) = w; } }
    asm volatile("" ::: "memory"); __builtin_amdgcn_sched_barrier(0);
    { bf16_t* dstb = (bf16_t*)P.stg + (size_t)ci * 4096;
#pragma unroll
      for (int i = 0; i < 8; ++i) { const int row = (lane >> 3) + 8 * i, ch = lane & 7; *(u32x4*)(dstb + row * 64 + ch * 8) = *(const LAS u32x4*)(Kl + row * PL + ch * 8); } }
}
__device__ __forceinline__ void mlstm_out_w(const RecP& P, LAS unsigned char* wl, int ci, int lane) {
    const int r = lane & 15, q = lane >> 4; constexpr int PL = 72;
    const int bh = ci >> 6, c = ci & 63, b = bh >> 2, h = bh & 3, row0 = b * SEQ + c * 64;
    const bf16_t* Xq = P.proj + (size_t)row0 * PJ + C_MQ + h * 64; const bf16_t* Xk = P.proj + (size_t)row0 * PJ + C_MK + h * 64; const bf16_t* Xv = P.proj + (size_t)row0 * PJ + C_MV + h * 64;
    LAS bf16_t* Tl = (LAS bf16_t*)wl; LAS float* vg = (LAS float*)(wl + 9216); LAS float* vn = vg + 64;
#pragma unroll
    for (int i = 0; i < 8; ++i) *(LAS u32x4*)(Tl + ((lane >> 3) + 8 * i) * PL + (lane & 7) * 8) = piece(Xv, PJ, i, lane);
    const float* tp = P.tail + (size_t)(row0 + lane) * 32;
    const float li = tp[T_MI + h] + P.mbi[h], lf = logsig(tp[T_MF + h] + P.mbf[h]);
    const float m = P.smMS[ci]; vn[lane] = P.smN[(size_t)ci * 64 + lane];
    const float bc = scan_add(lf, lane), g = li - bc, pm = scan_max(g, lane), M = fmaxf(m, pm), wint = fexp(m - M), expm = fexp(-bc - M);
    vg[lane] = g;
    asm volatile("" ::: "memory"); __builtin_amdgcn_sched_barrier(0);
    bf16x8 Kf[4][2], Qf[4][2];
#pragma unroll
    for (int T = 0; T < 4; ++T)
#pragma unroll
        for (int ks = 0; ks < 2; ++ks) { Kf[T][ks] = rfg(Xk, PJ, T, ks, lane); Qf[T][ks] = rfg(Xq, PJ, T, ks, lane); }
    float Mj[4], wj[4], ej[4];
#pragma unroll
    for (int T = 0; T < 4; ++T) { Mj[T] = __shfl(M, 16 * T + r); wj[T] = __shfl(wint, 16 * T + r); ej[T] = __shfl(expm, 16 * T + r); }
    u32x2 Pk[4][4]; float dinv[4];
#pragma unroll
    for (int Tj = 0; Tj < 4; ++Tj) { float dsum = 0.f;
#pragma unroll
        for (int Tl_ = 0; Tl_ < 4; ++Tl_) {
            if (Tl_ <= Tj) { f32x4 acc = (f32x4){0.f, 0.f, 0.f, 0.f}; acc = MF16(Kf[Tl_][0], Qf[Tj][0], acc); acc = MF16(Kf[Tl_][1], Qf[Tj][1], acc);
                const f32x4 g4 = *(const LAS f32x4*)(vg + 16 * Tl_ + 4 * q); float sv[4];
#pragma unroll
                for (int rg = 0; rg < 4; ++rg) { const bool ok = (Tl_ < Tj) || (4 * q + rg <= r); sv[rg] = ok ? acc[rg] * fexp(g4[rg] - Mj[Tj]) : 0.f; dsum += sv[rg]; }
                Pk[Tj][Tl_].x = pk2(sv[0], sv[1]); Pk[Tj][Tl_].y = pk2(sv[2], sv[3]); }
            else { Pk[Tj][Tl_].x = 0u; Pk[Tj][Tl_].y = 0u; } }
        dsum = red_q(dsum);
        float qn = 0.f;
#pragma unroll
        for (int ks = 0; ks < 2; ++ks) { float qf[8]; unpack8(__builtin_bit_cast(u32x4, Qf[Tj][ks]), qf); const f32x4 n0 = *(const LAS f32x4*)(vn + 32 * ks + 8 * q), n1 = *(const LAS f32x4*)(vn + 32 * ks + 8 * q + 4);
            qn += (qf[0] * n0[0] + qf[1] * n0[1]) + (qf[2] * n0[2] + qf[3] * n0[3]) + (qf[4] * n1[0] + qf[5] * n1[1]) + (qf[6] * n1[2] + qf[7] * n1[3]); }
        qn = red_q(qn);
        const float den = dsum + wj[Tj] * qn; dinv[Tj] = __builtin_amdgcn_rcpf(fmaxf(fabsf(den), ej[Tj]));
        Qf[Tj][0] = frag_scale(Qf[Tj][0], wj[Tj]); Qf[Tj][1] = frag_scale(Qf[Tj][1], wj[Tj]); asm volatile("" ::: "memory"); __builtin_amdgcn_sched_barrier(0); }
    asm volatile("" ::: "memory"); __builtin_amdgcn_sched_barrier(0);
    const bf16_t* cs = P.csm + (size_t)ci * 4096;
    bf16x8 Vt[4][2], Ct[4][2];
#pragma unroll
    for (int Te = 0; Te < 4; ++Te)
#pragma unroll
        for (int s = 0; s < 2; ++s) { Vt[Te][s] = trfrag(Tl, PL, s, 16 * Te, lane); Ct[Te][s] = rfg(cs, 64, Te, s, lane); }
    asm volatile("" ::: "memory"); __builtin_amdgcn_sched_barrier(0);
#pragma unroll
    for (int Tj = 0; Tj < 4; ++Tj) { f32x4 O[4];
        const bf16x8 p0 = __builtin_bit_cast(bf16x8, ((u32x4){Pk[Tj][0].x, Pk[Tj][0].y, Pk[Tj][1].x, Pk[Tj][1].y})), p1 = __builtin_bit_cast(bf16x8, ((u32x4){Pk[Tj][2].x, Pk[Tj][2].y, Pk[Tj][3].x, Pk[Tj][3].y}));
#pragma unroll
        for (int Te = 0; Te < 4; ++Te) { f32x4 acc = (f32x4){0.f, 0.f, 0.f, 0.f}; acc = MF16(Vt[Te][0], p0, acc); if (Tj >= 2) acc = MF16(Vt[Te][1], p1, acc);
            acc = MF16(Ct[Te][0], Qf[Tj][0], acc); acc = MF16(Ct[Te][1], Qf[Tj][1], acc); O[Te] = acc; }
        stage_rows(O, Tj, dinv[Tj], Tl, PL, lane); asm volatile("" ::: "memory"); __builtin_amdgcn_sched_barrier(0); }
    asm volatile("" ::: "memory"); __builtin_amdgcn_sched_barrier(0);
    final_store<0>(Tl, PL, P.mg, P.proj + (size_t)row0 * PJ + C_MO + h * 64, (bf16_t*)((unsigned char*)P.ycat + (size_t)row0 * DM + h * 64), lane);
}
__device__ __forceinline__ void gla_out_w(const RecP& P, const GWf& W, LAS unsigned char* wl, int ci, int lane) {
    const int r = lane & 15, q = lane >> 4; constexpr int PL = 72;
    const int bh = ci >> 6, c = ci & 63, b = bh >> 2, h = bh & 3, row0 = b * SEQ + c * 64;
    const bf16_t* Xq = P.proj + (size_t)row0 * PJ + C_GQ + h * 64; const bf16_t* Xk = P.proj + (size_t)row0 * PJ + C_GK + h * 64; const bf16_t* Xv = P.proj + (size_t)row0 * PJ + C_GV + h * 64;
    LAS bf16_t* Tl = (LAS bf16_t*)wl;
    { float bend[4]; gla_gate_tile<0>(Tl, PL, bend, W, P.tail + (size_t)row0 * 32, lane); }
    asm volatile("" ::: "memory"); __builtin_amdgcn_sched_barrier(0);
    bf16x8 Kf[4][2], Qf[4][2];
#pragma unroll
    for (int T = 0; T < 4; ++T)
#pragma unroll
        for (int ks = 0; ks < 2; ++ks) { const bf16x8 ef = *(const LAS bf16x8*)(Tl + (16 * T + r) * PL + 32 * ks + 8 * q); Qf[T][ks] = frag_mul(rfg(Xq, PJ, T, ks, lane), ef, false); Kf[T][ks] = frag_mul(rfg(Xk, PJ, T, ks, lane), ef, true); }
    asm volatile("" ::: "memory"); __builtin_amdgcn_sched_barrier(0);
#pragma unroll
    for (int i = 0; i < 8; ++i) *(LAS u32x4*)(Tl + ((lane >> 3) + 8 * i) * PL + (lane & 7) * 8) = piece(Xv, PJ, i, lane);
    asm volatile("" ::: "memory"); __builtin_amdgcn_sched_barrier(0);
    u32x2 Pk[4][4];
#pragma unroll
    for (int Tj = 0; Tj < 4; ++Tj)
#pragma unroll
        for (int Tl_ = 0; Tl_ < 4; ++Tl_) {
            if (Tl_ <= Tj) { f32x4 acc = (f32x4){0.f, 0.f, 0.f, 0.f}; acc = MF16(Kf[Tl_][0], Qf[Tj][0], acc); acc = MF16(Kf[Tl_][1], Qf[Tj][1], acc); float sv[4];
#pragma unroll
                for (int rg = 0; rg < 4; ++rg) { const bool ok = (Tl_ < Tj) || (4 * q + rg <= r); sv[rg] = ok ? acc[rg] : 0.f; }
                Pk[Tj][Tl_].x = pk2(sv[0], sv[1]); Pk[Tj][Tl_].y = pk2(sv[2], sv[3]); }
            else { Pk[Tj][Tl_].x = 0u; Pk[Tj][Tl_].y = 0u; } }
    const bf16_t* cs = P.csg + (size_t)ci * 4096;
    bf16x8 Vt[4][2], Ct[4][2];
#pragma unroll
    for (int Te = 0; Te < 4; ++Te)
#pragma unroll
        for (int s = 0; s < 2; ++s) { Vt[Te][s] = trfrag(Tl, PL, s, 16 * Te, lane); Ct[Te][s] = rfg(cs, 64, Te, s, lane); }
    asm volatile("" ::: "memory"); __builtin_amdgcn_sched_barrier(0);
#pragma unroll
    for (int Tj = 0; Tj < 4; ++Tj) { f32x4 O[4];
        const bf16x8 p0 = __builtin_bit_cast(bf16x8, ((u32x4){Pk[Tj][0].x, Pk[Tj][0].y, Pk[Tj][1].x, Pk[Tj][1].y})), p1 = __builtin_bit_cast(bf16x8, ((u32x4){Pk[Tj][2].x, Pk[Tj][2].y, Pk[Tj][3].x, Pk[Tj][3].y}));
#pragma unroll
        for (int Te = 0; Te < 4; ++Te) { f32x4 acc = (f32x4){0.f, 0.f, 0.f, 0.f}; acc = MF16(Vt[Te][0], p0, acc); if (Tj >= 2) acc = MF16(Vt[Te][1], p1, acc);
            acc = MF16(Ct[Te][0], Qf[Tj][0], acc); acc = MF16(Ct[Te][1], Qf[Tj][1], acc); O[Te] = acc; }
        stage_rows(O, Tj, 1.f, Tl, PL, lane); asm volatile("" ::: "memory"); __builtin_amdgcn_sched_barrier(0); }
    asm volatile("" ::: "memory"); __builtin_amdgcn_sched_barrier(0);
    final_store<1>(Tl, PL, P.gg, P.proj + (size_t)row0 * PJ + C_GR + h * 64, (bf16_t*)((unsigned char*)P.ycat + (size_t)row0 * DM + 768 + h * 64), lane);
}
#undef MF16
}


constexpr int N_PHASES = 2 + 9 * DEPTH;
__global__ void __launch_bounds__(512, 2) mega_fwd(Args args) {
    extern __shared__ __attribute__((aligned(16))) unsigned char lds_raw[];
    Frame F;
    F.lds = (LAS unsigned char*)lds_raw;
    F.MISC = (volatile LAS unsigned*)(F.lds + MISC_OFF);
    F.tid = threadIdx.x; F.lane = F.tid & 63; F.wave = __builtin_amdgcn_readfirstlane(F.tid >> 6);
    F.G = gridDim.x; { const int bx = blockIdx.x; F.vcu = (F.G % 8 == 0) ? (bx % 8) * (F.G / 8) + bx / 8 : bx; }
    typedef const __attribute__((address_space(4))) Args* CArgs;
    const CArgs ap0 = (CArgs)__builtin_amdgcn_kernarg_segment_ptr();
    F.ctl = (gu32*)(args.ws + WS_CTL);
    for (int u = F.tid; u < (LDS_BYTES - LDSCTL_OFF) / 4; u += 512) ((LAS unsigned*)(F.lds + LDSCTL_OFF))[u] = 0u;
    __syncthreads();
#if MK_ONE_LAUNCH
    XcdBarrier bar = xcd_barrier_post((unsigned*)(F.ctl + CW_BAR), F.MISC + 8);
#define GRID_BAR() xcd_barrier(bar)
#else
#define GRID_BAR() do {} while (0)
#endif
    const int lo = args.ph_lo, hi = args.ph_hi;
#define IN(k) (lo <= (k) && (k) < hi)
#define SEAM(k) do { if (IN(k) && IN((k) + 1)) { GRID_BAR(); if (NREP(15) == 2) GRID_BAR(); } } while (0)
    const int NGW = F.G * 8;
#define PHASE_IDS() int tid = threadIdx.x; asm volatile("" : "+v"(tid)); const int lane = tid & 63, wid = __builtin_amdgcn_readfirstlane(tid >> 6); const int gw = F.vcu * 8 + wid; (void)lane; (void)gw; \
    CArgs ap = ap0; asm volatile("" : "+s"(ap)); unsigned char* ws = ap->ws; (void)ws
#define AIN(i) (ap->in[i])
#define MOD ((float*)(ws + WS_MOD))
#define ROPE ((float*)(ws + WS_ROPE))
#define WIN ((bf16_t*)(ws + WS_WIN))
#define WOUT ((bf16_t*)(ws + WS_WOUT))
#define WGU8 ((unsigned char*)(ws + WS_WGU))
#define WD8 ((unsigned char*)(ws + WS_WD))
#define U8B ((unsigned char*)(ws + WS_U8))
#define WIN8 ((unsigned char*)(ws + WS_WIN8))
#define H8B ((unsigned char*)(ws + WS_PROJ))
#define LTOK ((int*)(ws + WS_LTOK))
#define LGATE ((float*)(ws + WS_LGATE))
#define PROJ ((bf16_t*)(ws + WS_PROJ))
#define HB ((bf16_t*)(ws + WS_PROJ))
#define XB ((bf16_t*)(ws + WS_XR))
#define YSORT ((bf16_t*)(ws + WS_YSORT))
#define TAILB ((float*)(ws + WS_TAIL))
#define TOKSLOT ((int*)(ws + WS_SM + SM_TS))
#define UB ((bf16_t*)(ws + WS_U))
#define YCAT ((bf16_t*)(ws + WS_YCAT))
#define STM ((float*)(ws + WS_U))
#define STG ((float*)(ws + WS_U + 32 * MiB))
#define CSM ((bf16_t*)(ws + WS_XR + 64 * MiB))
#define CSG ((bf16_t*)(ws + WS_XR + 80 * MiB))
#define G_smN ((float*)(ws + WS_SM + SM_N))
#define G_smBC ((float*)(ws + WS_SM + SM_BC))
#define G_smDM ((float*)(ws + WS_SM + SM_DM))
#define G_smMS ((float*)(ws + WS_SM + SM_MS))
#define G_smGBE ((float*)(ws + WS_SM + SM_GBE))
#define x_in AIN(I_X)

    if (IN(0) && PHON(0)) for (int rp0 = 0; rp0 < NREP(0); ++rp0) {
        PHASE_IDS();
        {
            LAS float* cact = (LAS float*)F.lds;
            LAS float* part = (LAS float*)(F.lds + 32768);
            const float* cc = AIN(I_C);
            for (int i = tid; i < NB * DM; i += 512) { const int b = i >> 10, k = i & 1023; const float v = cc[i]; cact[k * 8 + b] = v / (1.f + fexp(-v)); }
            __syncthreads();
            for (int it = F.vcu; it < DEPTH * 96; it += F.G) {
                const int l = it / 96, j0 = (it % 96) * 64;
                const float* W = AIN(I_WADA) + (size_t)l * DM * 6144 + j0 + lane;
                float a[8] = {0.f, 0.f, 0.f, 0.f, 0.f, 0.f, 0.f, 0.f};
#pragma unroll 32
                for (int kk = 0; kk < 128; ++kk) { const int k = wid * 128 + kk; const float w = W[(size_t)k * 6144];
                    const f32x4 c0 = *(const LAS f32x4*)(cact + k * 8), c1 = *(const LAS f32x4*)(cact + k * 8 + 4);
                    a[0] += c0[0] * w; a[1] += c0[1] * w; a[2] += c0[2] * w; a[3] += c0[3] * w; a[4] += c1[0] * w; a[5] += c1[1] * w; a[6] += c1[2] * w; a[7] += c1[3] * w; }
#pragma unroll
                for (int b = 0; b < 8; ++b) part[(wid * 8 + b) * 64 + lane] = a[b];
                __syncthreads();
                { const int b = tid >> 6, j = tid & 63; float s = AIN(I_BADA)[(size_t)l * 6144 + j0 + j];
#pragma unroll
                  for (int w = 0; w < 8; ++w) s += part[(w * 8 + b) * 64 + j];
                  MOD[((size_t)l * NB + b) * 6144 + j0 + j] = s; }
                __syncthreads();
            }
        }
        {
            const int* pos = (const int*)AIN(I_POS);
            for (int i = blockIdx.x * 512 + tid; i < NTOK * 4; i += F.G * 512) { const int row = i >> 2, f = i & 3;
                const float invf = (float)pow(500000.0, -0.25 * (double)f); const float ang = (float)pos[row] * invf;
                ROPE[(size_t)row * 8 + f] = (float)cos((double)ang); ROPE[(size_t)row * 8 + 4 + f] = (float)sin((double)ang); }
        }
        {
            LAS float* scr = (LAS float*)(F.lds + 49152 + wid * 8704);
            constexpr int I_IN = (DM / 64) * (PW / 32), I_OUT = (DM / 64) * (DM / 32);
            auto dec0 = [&](int it, TrD& d) { const int l = it / (I_IN + I_OUT); int r = it % (I_IN + I_OUT);
                if (r < I_IN) { const int kb = r / (PW / 32), nb = r % (PW / 32); const int nbe = (nb < 112) ? nb : 0; const int tl = nbe >> 3;
                    d.wsc = (tl == 0 || tl == 10) ? 0.125f : (tl == 7) ? ATT_C2 : 1.f;
                    d.src = AIN(I_WIN) + (size_t)l * DM * PIN + (size_t)(kb * 64) * PIN + win_src_col(nbe * 32); d.ldw = PIN; d.K = DM; d.dst = WIN + (size_t)l * PW * DM; d.dst8 = WIN8 + (size_t)l * PP * DM; d.drow0 = nbe * 32; d.k0 = kb * 64;
                    return nb < 112; }
                r -= I_IN; const int kb = r / (DM / 32), nb = r % (DM / 32); d.wsc = 1.f;
                d.src = AIN(I_WOUT) + (size_t)l * DM * DM + (size_t)(kb * 64) * DM + nb * 32; d.wsc = W8S; d.dst8 = nullptr; d.ldw = DM; d.K = DM; d.dst = (bf16_t*)((unsigned char*)WOUT + (size_t)l * DM * DM); d.drow0 = nb * 32; d.k0 = kb * 64; return true; };
            { TrD dc, dn; f32x4 vc[8], vn[8]; int it = gw; bool okc = dec0(it, dc); tr_load4(dc, vc, lane); dn = dc; bool okn = okc;
#pragma unroll
              for (int i = 0; i < 8; ++i) vn[i] = vc[i];
              for (; it < DEPTH * (I_IN + I_OUT); it += NGW) { const int itn = it + NGW;
                  if (itn < DEPTH * (I_IN + I_OUT)) { okn = dec0(itn, dn); tr_load4(dn, vn, lane); }
                  if (okc) { if (dc.ldw == DM) tr_finish8(dc, vc, scr, lane); else { TrD d8 = dc; d8.dst = (bf16_t*)dc.dst8; d8.wsc = dc.wsc * W8S; tr_finish8(d8, vc, scr, lane); } }
                  dc = dn; okc = okn;
#pragma unroll
                  for (int i = 0; i < 8; ++i) vc[i] = vn[i]; } }
            for (int it = gw; it < DEPTH * (DM / 64) * 8; it += NGW) { const int l = it / ((DM / 64) * 8), r = it % ((DM / 64) * 8), kb = r >> 3, nb = 112 + (r & 7);
                tr_item(AIN(I_WIN) + (size_t)l * DM * PIN, PIN, DM, WIN + (size_t)l * PW * DM, nb * 32, win_src_col(nb * 32 + (lane & 31)), kb * 64, scr, lane); }
        }
    }
    SEAM(0);
    if (IN(1) && PHON(1)) {
        PHASE_IDS();
        NarrowT NT_; nmm_load_tail(NT_, WIN + (size_t)PP * DM, wid, lane);
        LAS bf16_t* Sst = (LAS bf16_t*)F.lds; LAS float* Pb = (LAS float*)(F.lds + NMM_P_OFF);
        const int b = F.vcu >> 5; const float* md = MOD + (size_t)b * 6144;
        f32x4 sh[4], sc[4];
#pragma unroll
        for (int j = 0; j < 4; ++j) { sh[j] = *(const f32x4*)(md + 4 * lane + 256 * j); sc[j] = *(const f32x4*)(md + 1024 + 4 * lane + 256 * j) + 1.0f; }
        const int rowb = F.vcu * 128 + wid * 16;
        for (int i = 0; i < 16; i += 4) { f32x4 v[4][4];
#pragma unroll
            for (int rr = 0; rr < 4; ++rr)
#pragma unroll
                for (int j = 0; j < 4; ++j) v[rr][j] = *(const f32x4*)(x_in + (size_t)(rowb + i + rr) * DM + 4 * lane + 256 * j);
#pragma unroll
            for (int rr = 0; rr < 4; ++rr)
#pragma unroll
                for (int j = 0; j < 4; ++j) { const f32x4 u = v[rr][j] * sc[j] + sh[j];
                    u32x2 w; w.x = pk2(u[0], u[1]); w.y = pk2(u[2], u[3]); *(LAS u32x2*)(Sst + (wid * 4 + rr) * NSP + 4 * lane + 256 * j) = w;
                    *(unsigned*)(U8B + (size_t)(rowb + i + rr) * DM + 4 * lane + 256 * j) = pk4_fp8(u[0], u[1], u[2], u[3]); }
            nmm_step_tail(NT_, Sst, Pb, TAILB + (size_t)(F.vcu * 128) * 32, i, tid, wid, lane); }
    }
    SEAM(1);

    for (int l = 0; l < DEPTH; ++l) {
        const int pb = 2 + 9 * l;
#define modl (MOD + (size_t)l * NB * 6144)
#define MAKE_RP() rec::RecP RP; RP.proj = PROJ; RP.tail = TAILB; RP.csm = CSM; RP.csg = CSG; RP.stm = STM; RP.stg = STG; RP.smN = G_smN; RP.smBC = G_smBC; RP.smDM = G_smDM; RP.smMS = G_smMS; RP.smGBE = G_smGBE; RP.ycat = YCAT; \
        RP.mbi = AIN(I_MBI) + l * 4; RP.mbf = AIN(I_MBF) + l * 4; RP.mg = AIN(I_MG) + l * 64; RP.wa2 = AIN(I_WA2) + (size_t)l * 16 * 256; RP.ba = AIN(I_BA) + l * 256; RP.gg = AIN(I_GG) + l * 64;
        if (IN(pb + 0) && PHON(2)) {
            PHASE_IDS(); (void)tid;
            { gm::K1<true> k; k.S.init(NTOK, PP, F.G, (int)blockIdx.x); k.A = U8B; k.Bt = WIN8 + (size_t)l * PP * DM; k.O = PROJ; k.rope = ROPE;
                gm::gemm_phase<gm::K1<true>>(F.lds, k); }
        }
        SEAM(pb + 0);
        if (IN(pb + 1) && PHON(3)) {
            PHASE_IDS();
            MAKE_RP();
            for (int rp = 0; rp < NREP(3); ++rp) {
                LAS unsigned char* wl = F.lds + wid * 16384;
                recw::GWf gwf; recw::ld_gwf(gwf, RP, (gw >> 6) & 3, lane);
                for (int ci = gw; ci < 2048; ci += NGW) { int lane_ = lane; asm volatile("" : "+v"(lane_)); if (PHON(13)) recw::mlstm_local_w(RP, wl, ci, lane_); asm volatile("" ::: "memory"); __builtin_amdgcn_sched_barrier(0); if (PHON(14)) recw::gla_local_w(RP, gwf, wl, ci, lane_); }
            }
        }
        SEAM(pb + 1);
        if (IN(pb + 2) && PHON(4)) {
            PHASE_IDS();
            const int gt = blockIdx.x * 512 + tid, NGT = F.G * 512;
            for (int task = gt; task < 66048; task += NGT) {
                if (task < 32768) {
                    const int bh = task >> 10, el = (task & 1023) * 4; const bf16_t* p = (const bf16_t*)STM + (size_t)bh * 64 * 4096 + el; bf16_t* o = CSM + (size_t)bh * 64 * 4096 + el;
                    const float* bc = G_smBC + bh * 64; const float* dm = G_smDM + bh * 64;
                    f32x4 C = (f32x4){0.f, 0.f, 0.f, 0.f}; float m = 0.f;
#pragma unroll 16
                    for (int c = 0; c < NCH; ++c) { const u32x2 uw = *(const u32x2*)(p + (size_t)c * 4096); const f32x4 u = (f32x4){bflo(uw.x), bfhi(uw.x), bflo(uw.y), bfhi(uw.y)}; u32x2 w; w.x = pk2(C[0], C[1]); w.y = pk2(C[2], C[3]); *(u32x2*)(o + (size_t)c * 4096) = w;
                        if (el == 0) G_smMS[bh * 64 + c] = m;
                        const float B = bc[c], Dm = dm[c], mn = fmaxf(B + m, Dm); C = C * fexp(B + m - mn) + u * fexp(Dm - mn); m = mn; }
                } else if (task < 65536) {
                    const int t2 = task - 32768, bh = t2 >> 10, el = (t2 & 1023) * 4, d = el & 63; const bf16_t* p = (const bf16_t*)STG + (size_t)bh * 64 * 4096 + el; bf16_t* o = CSG + (size_t)bh * 64 * 4096 + el;
                    const float* be = G_smGBE + (size_t)bh * 64 * 64 + d;
                    f32x4 S = (f32x4){0.f, 0.f, 0.f, 0.f};
#pragma unroll 16
                    for (int c = 0; c < NCH; ++c) { const u32x2 uw = *(const u32x2*)(p + (size_t)c * 4096); const f32x4 u = (f32x4){bflo(uw.x), bfhi(uw.x), bflo(uw.y), bfhi(uw.y)}; const f32x4 b4 = *(const f32x4*)(be + c * 64);
                        u32x2 w; w.x = pk2(S[0], S[1]); w.y = pk2(S[2], S[3]); *(u32x2*)(o + (size_t)c * 4096) = w;
                        S = (f32x4){fexp(b4[0]) * S[0] + u[0], fexp(b4[1]) * S[1] + u[1], fexp(b4[2]) * S[2] + u[2], fexp(b4[3]) * S[3] + u[3]}; }
                } else {
                    const int t3 = task - 65536, bh = t3 >> 4, el = (t3 & 15) * 4; float* p = G_smN + (size_t)bh * 64 * 64 + el; const float* bc = G_smBC + bh * 64; const float* dm = G_smDM + bh * 64;
                    f32x4 C = (f32x4){0.f, 0.f, 0.f, 0.f}; float m = 0.f;
#pragma unroll 8
                    for (int c = 0; c < NCH; ++c) { const f32x4 u = *(const f32x4*)(p + c * 64); *(f32x4*)(p + c * 64) = C;
                        const float B = bc[c], Dm = dm[c], mn = fmaxf(B + m, Dm); C = C * fexp(B + m - mn) + u * fexp(Dm - mn); m = mn; }
                }
            }
            for (int rp = 0; rp < NREP(13); ++rp) {
                LAS float* scr = (LAS float*)(F.lds + 49152 + wid * 8704);
                constexpr int I_G = (DM / 64) * (1024 / 32), I_D = (DE / 64) * (DM / 32);
                auto dece = [&](int it, TrD& d) { const int e = it / (I_G + I_D); int r = it % (I_G + I_D); d.wsc = W8S; d.dst8 = nullptr;
                    if (r < I_G) { const int kb = r / 32, nb = r % 32, n0 = nb * 32, tt = n0 >> 8, rr = n0 & 255;
                        d.src = (rr < 128 ? AIN(I_EWG) : AIN(I_EWU)) + ((size_t)l * NE + e) * DM * DE + (size_t)(kb * 64) * DE + tt * 128 + (rr & 127); d.ldw = DE; d.K = DM; d.dst = (bf16_t*)(WGU8 + (size_t)e * 1024 * 1024); d.drow0 = n0; d.k0 = kb * 64; }
                    else { r -= I_G; const int kb = r / 32, nb = r % 32;
                        d.src = AIN(I_EWD) + ((size_t)l * NE + e) * DE * DM + (size_t)(kb * 64) * DM + nb * 32; d.ldw = DM; d.K = DE; d.dst = (bf16_t*)(WD8 + (size_t)e * 1024 * 512); d.drow0 = nb * 32; d.k0 = kb * 64; } };
                TrD dc, dn; f32x4 vc[8], vn[8]; int it = gw; dece(it, dc); tr_load4(dc, vc, lane); dn = dc;
#pragma unroll
                for (int i = 0; i < 8; ++i) vn[i] = vc[i];
                for (; it < NE * (I_G + I_D); it += NGW) { const int itn = it + NGW;
                    if (itn < NE * (I_G + I_D)) { dece(itn, dn); tr_load4(dn, vn, lane); }
                    tr_finish8(dc, vc, scr, lane);
                    dc = dn;
#pragma unroll
                    for (int i = 0; i < 8; ++i) vc[i] = vn[i]; }
            }
        }
        SEAM(pb + 2);
        if (IN(pb + 3) && PHON(5)) {
            PHASE_IDS();
            if (PHON(10)) {
                float d1 = 0.f, d2 = 0.f;
                for (int i = 0; i < 32; ++i) { d1 += AIN(I_LQ1)[l * 32 + i] * AIN(I_LK1)[l * 32 + i]; d2 += AIN(I_LQ2)[l * 32 + i] * AIN(I_LK2)[l * 32 + i]; }
                const float lam_init = 0.8f - 0.6f * expf(-0.3f * (float)l);
                attn_body::AttnParams AP; AP.Q = (const attn_body::bf16*)(PROJ + C_DQ); AP.K = (const attn_body::bf16*)(PROJ + C_DK); AP.V = (const attn_body::bf16*)(PROJ + C_DV);
                AP.zpage = (const attn_body::bf16*)(F.ctl + CW_ZPAGE); AP.Y = (bf16_t*)((unsigned char*)YCAT + 512); AP.gnorm = AIN(I_DG) + l * 64; AP.lam = expf(d1) - expf(d2) + lam_init; AP.osc = 1.f - lam_init;
                const int bh = F.vcu >> 3, s = F.vcu & 7;
                if (F.G == 256) {
                    for (int rp = 0; rp < NREP(10); ++rp)
                    for (int i = 0; i < 2; ++i) { const int qb = (i == 0) ? s : 15 - s;
                        attn_body::attn_unit<8, 0>(bh >> 2, bh & 3, qb, AP, (char*)lds_raw); attn_body::attn_unit<8, 1>(bh >> 2, bh & 3, qb, AP, (char*)lds_raw); }
                }
            }
            __syncthreads();
            {
            PHASE_IDS();
            MAKE_RP();
            if (PHON(11)) for (int rp = 0; rp < NREP(11); ++rp) {
                LAS unsigned char* wl = F.lds + wid * 16384;
                LAS u32x4* gst = (LAS u32x4*)(wl + 10240);
                { recw::GWf gwf; recw::ld_gwf(gwf, RP, (gw >> 6) & 3, lane);
#pragma unroll
                  for (int Td = 0; Td < 4; ++Td) gst[Td * 64 + lane] = __builtin_bit_cast(u32x4, gwf.Bw[Td]);
                  gst[256 + lane] = __builtin_bit_cast(u32x4, ((f32x4){gwf.ba[0], gwf.ba[1], gwf.ba[2], gwf.ba[3]})); }
                for (int ci = gw; ci < 2048; ci += NGW) { int lane_ = lane; asm volatile("" : "+v"(lane_)); if (PHON(13)) recw::mlstm_out_w(RP, wl, ci, lane_); asm volatile("" ::: "memory"); __builtin_amdgcn_sched_barrier(0);
                    if (PHON(14)) { recw::GWf gwf;
#pragma unroll
                        for (int Td = 0; Td < 4; ++Td) gwf.Bw[Td] = __builtin_bit_cast(bf16x8, gst[Td * 64 + lane_]);
                        const f32x4 bb = __builtin_bit_cast(f32x4, gst[256 + lane_]); gwf.ba[0] = bb[0]; gwf.ba[1] = bb[1]; gwf.ba[2] = bb[2]; gwf.ba[3] = bb[3];
                        recw::gla_out_w(RP, gwf, wl, ci, lane_); } }
            }
            __syncthreads();
            if (PHON(12)) for (int rp = 0; rp < NREP(12); ++rp) {
                const float* cw = AIN(I_CONVW) + (size_t)l * 3 * 256; const float* cbias = AIN(I_CONVB) + l * 256;
                for (int it = F.vcu; it < NTOK / 64; it += F.G) {
                    for (int p = tid; p < 64 * 32; p += 512) { const int r = p >> 5, chn = p & 31, row = it * 64 + r, t = row & (SEQ - 1);
                        const bf16_t* pr = PROJ + (size_t)row * PJ + chn * 8;
                        float s0[8], s1[8], s2[8], cbv[8];
                        { float a[8], bq[8]; rec::unpack8(*(const u32x4*)(pr + C_CC), a); rec::unpack8(*(const u32x4*)(pr + C_CH), bq);
#pragma unroll
                          for (int i = 0; i < 8; ++i) s2[i] = a[i] * bq[i]; }
                        if (t >= 1) { float a[8], bq[8]; rec::unpack8(*(const u32x4*)(pr - PJ + C_CC), a); rec::unpack8(*(const u32x4*)(pr - PJ + C_CH), bq);
#pragma unroll
                          for (int i = 0; i < 8; ++i) s1[i] = a[i] * bq[i]; } else {
#pragma unroll
                          for (int i = 0; i < 8; ++i) s1[i] = 0.f; }
                        if (t >= 2) { float a[8], bq[8]; rec::unpack8(*(const u32x4*)(pr - 2 * PJ + C_CC), a); rec::unpack8(*(const u32x4*)(pr - 2 * PJ + C_CH), bq);
#pragma unroll
                          for (int i = 0; i < 8; ++i) s0[i] = a[i] * bq[i]; } else {
#pragma unroll
                          for (int i = 0; i < 8; ++i) s0[i] = 0.f; }
                        rec::unpack8(*(const u32x4*)(pr + C_CB), cbv);
                        float y[8];
#pragma unroll
                        for (int i = 0; i < 8; ++i) { const int cch = chn * 8 + i; y[i] = cbv[i] * (cw[cch] * s0[i] + cw[256 + cch] * s1[i] + cw[512 + cch] * s2[i] + cbias[cch]); }
                        u32x2 w; w.x = pk4_fp8(y[0] * Y8S, y[1] * Y8S, y[2] * Y8S, y[3] * Y8S); w.y = pk4_fp8(y[4] * Y8S, y[5] * Y8S, y[6] * Y8S, y[7] * Y8S);
                        *(u32x2*)((unsigned char*)YCAT + (size_t)row * DM + 256 + chn * 8) = w; }
                }
            }
            }
        }
        SEAM(pb + 3);
        if (IN(pb + 4) && PHON(6)) {
            PHASE_IDS(); (void)tid;
            gm::K2 k; k.S.init(NTOK, DM, F.G, (int)blockIdx.x); k.A = (const unsigned char*)YCAT; k.Bt = (const unsigned char*)WOUT + (size_t)l * DM * DM; k.O = UB;
            for (int rp = 0; rp < NREP(6); ++rp) gm::gemm_phase<gm::K2>(F.lds, k);
        }
        SEAM(pb + 4);
        if (IN(pb + 5) && PHON(7)) {
            PHASE_IDS();
            NarrowT NT_; nmm_load_router(NT_, AIN(I_RW), wid, lane);
            LAS bf16_t* Sst = (LAS bf16_t*)F.lds; LAS float* Pb = (LAS float*)(F.lds + NMM_P_OFF); LAS float* lgs_all = (LAS float*)(F.lds + NMM_LG_OFF);
            LAS float* lgs = lgs_all + wid * 256;
            const int b = F.vcu >> 5; const float* md = modl + (size_t)b * 6144;
            const float* lg = AIN(I_LN1G) + l * DM; const float* lb = AIN(I_LN1B) + l * DM;
            f32x4 gv[4], bv[4], sh[4], sc[4], g1[4];
#pragma unroll
            for (int j = 0; j < 4; ++j) { const int cix = 4 * lane + 256 * j; gv[j] = *(const f32x4*)(lg + cix); bv[j] = *(const f32x4*)(lb + cix); g1[j] = *(const f32x4*)(md + 2 * 1024 + cix) + 1.0f;
                sh[j] = *(const f32x4*)(md + 3 * 1024 + cix); sc[j] = *(const f32x4*)(md + 4 * 1024 + cix) + 1.0f; }
            const int rowb = F.vcu * 128 + wid * 16;
            u32x2 xwc[4], ywc[4];
#pragma unroll
            for (int j = 0; j < 4; ++j) { const size_t o = (size_t)rowb * DM + 4 * lane + 256 * j; xwc[j] = (l == 0) ? (u32x2){0u, 0u} : *(const u32x2*)(XB + o); ywc[j] = *(const u32x2*)(UB + o); }
            u32x2 xwn[4] = {xwc[0], xwc[1], xwc[2], xwc[3]}, ywn[4] = {ywc[0], ywc[1], ywc[2], ywc[3]};
            for (int i = 0; i < 16; ++i) { const int row = rowb + i;
                if (i < 15) {
#pragma unroll
                    for (int j = 0; j < 4; ++j) { const size_t o = (size_t)(row + 1) * DM + 4 * lane + 256 * j; if (l != 0) xwn[j] = *(const u32x2*)(XB + o); ywn[j] = *(const u32x2*)(UB + o); } }
                f32x4 v[4]; float s = 0.f;
#pragma unroll
                for (int j = 0; j < 4; ++j) { const size_t o = (size_t)row * DM + 4 * lane + 256 * j;
                    f32x4 xv; if (l == 0) xv = *(const f32x4*)(x_in + o); else { const u32x2 xw = xwc[j]; xv = (f32x4){bflo(xw.x), bfhi(xw.x), bflo(xw.y), bfhi(xw.y)}; }
                    const u32x2 yw = ywc[j]; const f32x4 yv = (f32x4){bflo(yw.x), bfhi(yw.x), bflo(yw.y), bfhi(yw.y)};
                    v[j] = xv * ALPHA + g1[j] * yv; s += (v[j][0] + v[j][1]) + (v[j][2] + v[j][3]); }
#pragma unroll
                for (int j = 0; j < 4; ++j) { xwc[j] = xwn[j]; ywc[j] = ywn[j]; }
                const float mean = wave_sum(s) * (1.f / DM); float s2 = 0.f;
#pragma unroll
                for (int j = 0; j < 4; ++j) { v[j] = v[j] - mean; s2 += (v[j][0] * v[j][0] + v[j][1] * v[j][1]) + (v[j][2] * v[j][2] + v[j][3] * v[j][3]); }
                const float rstd = __builtin_amdgcn_rsqf(wave_sum(s2) * (1.f / DM) + LN_EPS);
#pragma unroll
                for (int j = 0; j < 4; ++j) { const size_t o = (size_t)row * DM + 4 * lane + 256 * j; const f32x4 xn = v[j] * rstd * gv[j] + bv[j];
                    u32x2 xw; xw.x = pk2(xn[0], xn[1]); xw.y = pk2(xn[2], xn[3]); *(u32x2*)(XB + o) = xw;
                    const f32x4 u = xn * sc[j] + sh[j]; u32x2 w; w.x = pk2(u[0], u[1]); w.y = pk2(u[2], u[3]); *(LAS u32x2*)(Sst + (wid * 4 + (i & 3)) * NSP + 4 * lane + 256 * j) = w;
                    *(unsigned*)(U8B + o) = pk4_fp8(u[0], u[1], u[2], u[3]); }
                if ((i & 3) == 3) nmm_step_router(NT_, Sst, Pb, lgs_all, i - 3, tid, wid, lane);
            }
            asm volatile("s_waitcnt lgkmcnt(0)\n\ts_barrier" ::: "memory");
            if (lane < 16) {
                const int row = rowb + lane; const float* rb = AIN(I_RB);
                float sco[16], bia[16];
#pragma unroll
                for (int q = 0; q < 4; ++q) { const f32x4 t4 = *(const LAS f32x4*)(lgs + lane * 16 + q * 4);
#pragma unroll
                    for (int c = 0; c < 4; ++c) { const float sg = 1.f / (1.f + fexp(-t4[c])); sco[q * 4 + c] = sg; bia[q * 4 + c] = sg + rb[q * 4 + c]; } }
                int bg = 0; float bgs = -INFINITY;
#pragma unroll
                for (int g = 0; g < 4; ++g) { const float a0 = bia[4 * g], a1 = bia[4 * g + 1], a2 = bia[4 * g + 2], a3 = bia[4 * g + 3];
                    const float h1 = fmaxf(a0, a1), l1 = fminf(a0, a1), h2 = fmaxf(a2, a3), l2 = fminf(a2, a3);
                    const float top = fmaxf(h1, h2), sec = fmaxf(fminf(h1, h2), (h1 >= h2) ? l1 : l2); const float gsc = top + sec;
                    if (gsc > bgs) { bgs = gsc; bg = g; } }
                float gb[4], gsx[4];
#pragma unroll
                for (int q = 0; q < 4; ++q) { gb[q] = (bg == 0) ? bia[q] : (bg == 1) ? bia[4 + q] : (bg == 2) ? bia[8 + q] : bia[12 + q]; gsx[q] = (bg == 0) ? sco[q] : (bg == 1) ? sco[4 + q] : (bg == 2) ? sco[8 + q] : sco[12 + q]; }
                int e1 = 0; float m1 = gb[0];
#pragma unroll
                for (int q = 1; q < 4; ++q) if (gb[q] > m1) { m1 = gb[q]; e1 = q; }
                int e2 = -1; float m2 = -INFINITY;
#pragma unroll
                for (int q = 0; q < 4; ++q) if (q != e1 && gb[q] > m2) { m2 = gb[q]; e2 = q; }
                const int ei = e1 < e2 ? e1 : e2, ej = e1 < e2 ? e2 : e1;
                const float si = (ei == 0) ? gsx[0] : (ei == 1) ? gsx[1] : (ei == 2) ? gsx[2] : gsx[3], sj = (ej == 0) ? gsx[0] : (ej == 1) ? gsx[1] : (ej == 2) ? gsx[2] : gsx[3];
                const int pr_ = (ei == 0) ? ej - 1 : (ei == 1) ? ej + 1 : 5; const int bk = bg * 6 + pr_;
                gu32* cntw = F.ctl + CW_CNT + (size_t)l * NBUCKET * 64;
                const unsigned pos = __hip_atomic_fetch_add(cntw + bk * 64, 1u, RLX_AGENT);
                LTOK[(size_t)bk * LCAP + pos] = row; const float inv = 1.f / (si + sj); LGATE[((size_t)bk * LCAP + pos) * 2] = si * inv; LGATE[((size_t)bk * LCAP + pos) * 2 + 1] = sj * inv;
                TOKSLOT[row] = (bk << 16) | (int)pos;
            }
            __syncthreads();
        }
        SEAM(pb + 5);
        if ((IN(pb + 6) || IN(pb + 7)) && PHON(8)) {
            PHASE_IDS();
            LAS int* tb = (LAS int*)(F.lds + MOE_TB_OFF);
            if (tid == 0) { gu32* cntw = F.ctl + CW_CNT + (size_t)l * NBUCKET * 64; int acc = 0;
                for (int k = 0; k < NBUCKET; ++k) { const int c = (int)__hip_atomic_load(cntw + k * 64, RLX_AGENT); tb[k] = c; tb[32 + k] = acc; acc += (c + 255) >> 8; }
                tb[32 + NBUCKET] = acc; }
            __syncthreads();
            if (IN(pb + 6)) {
                gm::K4 k; k.U = U8B; k.Wgu = WGU8; k.H = H8B; k.ltok = LTOK; k.lgate = LGATE; k.tb = tb; k.G = F.G; k.vcu = F.vcu; k.rtc = F.ctl + CW_RT + (size_t)l * 160 * 64;
                for (int rp = 0; rp < NREP(8); ++rp) gm::gemm_phase<gm::K4>(F.lds, k);
            }
            SEAM(pb + 6);
            if (IN(pb + 7)) {
                gm::K5 k; k.H = H8B; k.Wd = WD8; k.Y = YSORT; k.tb = tb; k.G = F.G; k.vcu = F.vcu; k.rtc = F.ctl + CW_RT + (size_t)l * 160 * 64; k.tmo = F.ctl + CW_TMO;
                for (int rp = 0; rp < NREP(14); ++rp) gm::gemm_phase<gm::K5>(F.lds, k);
            }
        }
        SEAM(pb + 7);
        if (IN(pb + 8) && PHON(9)) {
            PHASE_IDS();
            const int b = F.vcu >> 5; const bool lastl = (l == DEPTH - 1);
            LAS bf16_t* Sst = (LAS bf16_t*)F.lds; LAS float* Pb = (LAS float*)(F.lds + NMM_P_OFF); LAS int* t0 = (LAS int*)(F.lds + MOE_TB_OFF);
            NarrowT NT_; nmm_load_tail(NT_, WIN + ((size_t)(lastl ? l : l + 1) * PW + PP) * DM, wid, lane);
            if (tid == 0) { gu32* cntw = F.ctl + CW_CNT + (size_t)l * NBUCKET * 64; int acc = 0;
                for (int k = 0; k < NBUCKET; ++k) { const int c = (int)__hip_atomic_load(cntw + k * 64, RLX_AGENT); t0[32 + k] = acc; acc += (c + 255) >> 8; } }
            __syncthreads();
            const float* mdn = MOD + ((size_t)(lastl ? l : l + 1) * NB + b) * 6144; const float* md = modl + (size_t)b * 6144;
            const float* lg = AIN(I_LN2G) + l * DM; const float* lb = AIN(I_LN2B) + l * DM;
            f32x4 gv[4], bv[4], sh[4], sc[4], g2[4];
#pragma unroll
            for (int j = 0; j < 4; ++j) { const int cix = 4 * lane + 256 * j; gv[j] = *(const f32x4*)(lg + cix); bv[j] = *(const f32x4*)(lb + cix); g2[j] = *(const f32x4*)(md + 5 * 1024 + cix) + 1.0f;
                sh[j] = *(const f32x4*)(mdn + cix); sc[j] = *(const f32x4*)(mdn + 1024 + cix) + 1.0f; }
            const int rowb = F.vcu * 128 + wid * 16;
            const int tsl = TOKSLOT[rowb + (lane & 15)];
            u32x2 xwc[4], ywc[4];
            { const int ts = __shfl(tsl, 0); const size_t yrow = (size_t)t0[32 + (ts >> 16)] * 256 + (ts & 0xffff);
#pragma unroll
              for (int j = 0; j < 4; ++j) { const int cix = 4 * lane + 256 * j; xwc[j] = *(const u32x2*)(XB + (size_t)rowb * DM + cix); ywc[j] = *(const u32x2*)(YSORT + yrow * DM + cix); } }
            u32x2 xwn[4] = {xwc[0], xwc[1], xwc[2], xwc[3]}, ywn[4] = {ywc[0], ywc[1], ywc[2], ywc[3]};
            for (int i = 0; i < 16; ++i) { const int row = rowb + i;
                if (i < 15) { const int ts = __shfl(tsl, i + 1); const size_t yrow = (size_t)t0[32 + (ts >> 16)] * 256 + (ts & 0xffff);
#pragma unroll
                    for (int j = 0; j < 4; ++j) { const int cix = 4 * lane + 256 * j; xwn[j] = *(const u32x2*)(XB + (size_t)(row + 1) * DM + cix); ywn[j] = *(const u32x2*)(YSORT + yrow * DM + cix); } }
                f32x4 v[4]; float s = 0.f;
#pragma unroll
                for (int j = 0; j < 4; ++j) {
                    const u32x2 xw = xwc[j]; const f32x4 xv = (f32x4){bflo(xw.x), bfhi(xw.x), bflo(xw.y), bfhi(xw.y)};
                    const u32x2 yw = ywc[j]; const f32x4 yv = (f32x4){bflo(yw.x), bfhi(yw.x), bflo(yw.y), bfhi(yw.y)};
                    v[j] = xv * ALPHA + g2[j] * yv; s += (v[j][0] + v[j][1]) + (v[j][2] + v[j][3]); }
#pragma unroll
                for (int j = 0; j < 4; ++j) { xwc[j] = xwn[j]; ywc[j] = ywn[j]; }
                const float mean = wave_sum(s) * (1.f / DM); float s2 = 0.f;
#pragma unroll
                for (int j = 0; j < 4; ++j) { v[j] = v[j] - mean; s2 += (v[j][0] * v[j][0] + v[j][1] * v[j][1]) + (v[j][2] * v[j][2] + v[j][3] * v[j][3]); }
                const float rstd = __builtin_amdgcn_rsqf(wave_sum(s2) * (1.f / DM) + LN_EPS);
#pragma unroll
                for (int j = 0; j < 4; ++j) { const size_t o = (size_t)row * DM + 4 * lane + 256 * j; const f32x4 xn = v[j] * rstd * gv[j] + bv[j];
                    if (lastl) *(f32x4*)(ap->out + o) = xn;
                    else { u32x2 xw; xw.x = pk2(xn[0], xn[1]); xw.y = pk2(xn[2], xn[3]); *(u32x2*)(XB + o) = xw;
                        const f32x4 u = xn * sc[j] + sh[j]; u32x2 w; w.x = pk2(u[0], u[1]); w.y = pk2(u[2], u[3]); *(LAS u32x2*)(Sst + (wid * 4 + (i & 3)) * NSP + 4 * lane + 256 * j) = w;
                        *(unsigned*)(U8B + o) = pk4_fp8(u[0], u[1], u[2], u[3]); } }
                if (!lastl && (i & 3) == 3) nmm_step_tail(NT_, Sst, Pb, TAILB + (size_t)(F.vcu * 128) * 32, i - 3, tid, wid, lane);
            }
        }
        SEAM(pb + 8);
    }
#undef IN
#undef SEAM
}

extern "C" void kernel_launch(void* const* d_in, const int* in_sizes, int n_in, void* d_out, int out_size, void* d_ws, size_t ws_size, hipStream_t stream) {
    static int grid = 0;
    if (grid == 0) {
        if (n_in != 29 || in_sizes[0] != NTOK * DM || out_size != NTOK * DM || ws_size < WS_END) {
            fprintf(stderr, "kernel_launch: unexpected shapes (n_in %d, in0 %d, out %d, ws %zu need %zu); nothing launched\n", n_in, n_in > 0 ? in_sizes[0] : -1, out_size, ws_size, (size_t)WS_END); grid = -1; return; }
        int dev = 0, cus = 0, per_cu = 0;
        if (hipGetDevice(&dev) != hipSuccess || hipDeviceGetAttribute(&cus, hipDeviceAttributeMultiprocessorCount, dev) != hipSuccess) { grid = -1; return; }
        if (hipFuncSetAttribute((const void*)mega_fwd, hipFuncAttributeMaxDynamicSharedMemorySize, LDS_BYTES) != hipSuccess) { fprintf(stderr, "kernel_launch: hipFuncSetAttribute failed\n"); grid = -1; return; }
        if (hipOccupancyMaxActiveBlocksPerMultiprocessor(&per_cu, (const void*)mega_fwd, 512, LDS_BYTES) != hipSuccess || per_cu < 1) { fprintf(stderr, "kernel_launch: occupancy query reports %d\n", per_cu); }
        (void)hipGetLastError();
        grid = cus;
        if (grid != 256) fprintf(stderr, "kernel_launch: %d CUs (row phases assume 256)\n", grid);
    }
    if (grid < 0) return;
    if (hipMemsetAsync((char*)d_ws + WS_CTL, 0, CTL_ZERO_BYTES, stream) != hipSuccess) return;
    Args a{};
    for (int i = 0; i < 29; ++i) a.in[i] = (const float*)d_in[i];
    a.out = (float*)d_out; a.ws = (unsigned char*)d_ws;
#if MK_ONE_LAUNCH
    a.ph_lo = 0; a.ph_hi = N_PHASES;
    hipLaunchKernelGGL(mega_fwd, dim3(grid), dim3(512), LDS_BYTES, stream, a);
#else
    for (int p = 0; p < N_PHASES; ++p) { a.ph_lo = p; a.ph_hi = p + 1; hipLaunchKernelGGL(mega_fwd, dim3(grid), dim3(512), LDS_BYTES, stream, a); }
#endif
}
```

```cpp
#include <hip/hip_runtime.h>
#include <hip/hip_bf16.h>
#include <cstdio>
#include <cstdint>
#include <cmath>

#ifndef MK_ONE_LAUNCH
#define MK_ONE_LAUNCH 1
#endif
#ifndef PHM
#define PHM 0xFFFF
#endif
#define PHON(n) (((PHM) >> (n)) & 1)
#ifndef REPM
#define REPM 0
#endif
#define NREP(n) ((((REPM) >> (n)) & 1) ? 2 : 1)

#define LAS __attribute__((address_space(3)))
#define GAS __attribute__((address_space(1)))
typedef unsigned short bf16_t;
typedef short bf16x8 __attribute__((ext_vector_type(8)));
typedef float f32x4 __attribute__((ext_vector_type(4)));
typedef float f32x2 __attribute__((ext_vector_type(2)));
typedef unsigned u32x4 __attribute__((ext_vector_type(4)));
typedef unsigned u32x2 __attribute__((ext_vector_type(2)));
typedef GAS unsigned gu32;

constexpr int NB = 8, SEQ = 4096, NTOK = NB * SEQ, DM = 1024, DEPTH = 4, NH = 4, HD = 64, PIN = 3608, PP = 3584, PW = 3840, NE = 16, DE = 512;
constexpr int NCH = SEQ / 64;
constexpr float ALPHA = 1.6817928305074290f;
constexpr float LN_EPS = 1e-6f;
constexpr float ATT_C2 = 0.17677669529663687f * 1.4426950408889634f;
constexpr int NBUCKET = 24, LCAP = NTOK;
constexpr int PJ = 256, TSZ = NTOK * 256;
constexpr int C_MQ = 0, C_MK = TSZ, C_MV = 2 * TSZ, C_MO = 3 * TSZ, C_CB = 4 * TSZ, C_CC = 5 * TSZ, C_CH = 6 * TSZ, C_DQ = 7 * TSZ, C_DK = 8 * TSZ, C_DV = 9 * TSZ,
              C_GQ = 10 * TSZ, C_GK = 11 * TSZ, C_GV = 12 * TSZ, C_GR = 13 * TSZ;
constexpr int T_GA = 0, T_MI = 16, T_MF = 20;

constexpr size_t MiB = 1u << 20;
constexpr size_t WS_CTL = 0, CTL_ZERO_BYTES = 1 * MiB;
constexpr size_t WS_MOD = 1 * MiB;
constexpr size_t WS_ROPE = 2 * MiB;
constexpr size_t WS_WIN = 3 * MiB;
constexpr size_t WS_WOUT = 33 * MiB;
constexpr size_t WS_WGU = 41 * MiB;
constexpr size_t WS_WD = 73 * MiB;
constexpr size_t WS_LTOK = 89 * MiB;
constexpr size_t WS_LGATE = 92 * MiB;
constexpr size_t WS_SM = 98 * MiB;
constexpr size_t WS_PROJ = 100 * MiB;
constexpr size_t WS_XR = 340 * MiB;
constexpr size_t WS_U = 468 * MiB;
constexpr size_t WS_YCAT = 532 * MiB;
constexpr size_t WS_TAIL = 596 * MiB;
constexpr size_t WS_YSORT = WS_PROJ + 100 * MiB;
constexpr size_t WS_U8 = 600 * MiB;
constexpr size_t WS_WIN8 = 632 * MiB;
constexpr size_t WS_END = 648 * MiB;
constexpr size_t SM_N = 0, SM_BC = 512 * 1024, SM_DM = 520 * 1024, SM_MS = 528 * 1024, SM_GBE = 1 * MiB, SM_TS = 1536 * 1024;
constexpr int CW_TMO = 0, CW_CODE = 1, CW_ZPAGE = 256, CW_BAR = 4096, CW_CNT = 16384, CW_RT = 24576;
constexpr int RING_BYTES = 131072, LDSCTL_OFF = RING_BYTES, MISC_OFF = LDSCTL_OFF + 320, MOE_TB_OFF = LDSCTL_OFF + 1024, LDS_BYTES = 147456;

#define RLX_AGENT __ATOMIC_RELAXED, __HIP_MEMORY_SCOPE_AGENT
#define LDS_WAIT() asm volatile("s_waitcnt lgkmcnt(0)" ::: "memory")
#define VM_WAIT() asm volatile("s_waitcnt vmcnt(0)" ::: "memory")

__device__ __forceinline__ unsigned f2bf(float f) { unsigned u = __builtin_bit_cast(unsigned, f); return (u + 0x7fffu + ((u >> 16) & 1u)) >> 16; }
__device__ __forceinline__ unsigned pk2(float lo, float hi) { typedef __bf16 bf2 __attribute__((ext_vector_type(2))); f32x2 v = {lo, hi}; bf2 b = __builtin_convertvector(v, bf2); return __builtin_bit_cast(unsigned, b); }
__device__ __forceinline__ unsigned pk4_fp8(float a, float b, float c, float d) {
    a = __builtin_amdgcn_fmed3f(a, -448.f, 448.f); b = __builtin_amdgcn_fmed3f(b, -448.f, 448.f); c = __builtin_amdgcn_fmed3f(c, -448.f, 448.f); d = __builtin_amdgcn_fmed3f(d, -448.f, 448.f);
    int w = 0; w = __builtin_amdgcn_cvt_pk_fp8_f32(a, b, w, false); w = __builtin_amdgcn_cvt_pk_fp8_f32(c, d, w, true); return (unsigned)w; }
__device__ __forceinline__ void st8_wt(void* p, u32x2 v) { asm volatile("global_store_dwordx2 %0, %1, off sc1\n\ts_nop 0" :: "v"(p), "v"(v) : "memory"); }
constexpr float W8S = 64.f, H8S = 16.f, Y8S = 8.f;
__device__ __forceinline__ float bf2f(unsigned b) { return __builtin_bit_cast(float, b << 16); }
__device__ __forceinline__ float bflo(unsigned w) { return __builtin_bit_cast(float, w << 16); }
__device__ __forceinline__ float bfhi(unsigned w) { return __builtin_bit_cast(float, w & 0xffff0000u); }
__device__ __forceinline__ void st16_wt(void* p, u32x4 v) { asm volatile("global_store_dwordx4 %0, %1, off sc1\n\ts_nop 1" :: "v"(p), "v"(v) : "memory"); }
__device__ __forceinline__ float wave_sum(float v) {
#pragma unroll
    for (int o = 1; o < 64; o <<= 1) v += __shfl_xor(v, o);
    return v;
}
__device__ __forceinline__ float wave_max(float v) {
#pragma unroll
    for (int o = 1; o < 64; o <<= 1) v = fmaxf(v, __shfl_xor(v, o));
    return v;
}
__device__ __forceinline__ float fexp(float x) { return __builtin_amdgcn_exp2f(x * 1.4426950408889634f); }
__device__ __forceinline__ float flog(float x) { return __builtin_amdgcn_logf(x) * 0.6931471805599453f; }
__device__ __forceinline__ float logsig(float z) { return fminf(z, 0.f) - flog(1.f + fexp(-fabsf(z))); }
__device__ __forceinline__ float sigmoidf_(float z) { return 1.f / (1.f + fexp(-z)); }

#define XB_TMO      128
#define XB_XCNT(j)  (256  + 64 * (j))
#define XB_XSUB(j)  (1280 + 64 * (j))
#define XB_XGEN(j)  (2304 + 64 * (j))
#define XB_TOP      3328
#define XB_TOPGEN   3392
#define XCD_BAR_WORDS 3456
#define XB_SPIN_CAP (1u << 18)
__device__ __forceinline__ unsigned xb_ld(unsigned* p)              { return __hip_atomic_load(p, __ATOMIC_RELAXED, __HIP_MEMORY_SCOPE_AGENT); }
__device__ __forceinline__ unsigned xb_add(unsigned* p, unsigned v) { return __hip_atomic_fetch_add(p, v, __ATOMIC_RELAXED, __HIP_MEMORY_SCOPE_AGENT); }
__device__ __forceinline__ unsigned xb_xcc_id() { return (unsigned)__builtin_amdgcn_s_getreg((3 << 11) | 20) & 0xFu; }
#define XB_SPIN(cond, bar) do { unsigned _sp = 0; while (cond) { __builtin_amdgcn_s_sleep(1); \
    if ((++_sp & 255u) == 0u) { if (xb_ld(&(bar)[XB_TMO])) break; if (_sp > XB_SPIN_CAP) { atomicAdd(&(bar)[XB_TMO], 1u); break; } } } } while (0)
struct XcdBarrier { unsigned* bar; unsigned x; volatile LAS unsigned* st; };
__device__ __forceinline__ XcdBarrier xcd_barrier_post(unsigned* bar, volatile LAS unsigned* st) {
    XcdBarrier b; b.bar = bar; b.x = xb_xcc_id(); b.st = st;
    if (threadIdx.x == 0) (void)xb_add(&bar[XB_XCNT(b.x)], 1u);
    return b;
}
__device__ __forceinline__ void xcd_barrier_complete(unsigned* bar, unsigned x, unsigned& nloc, unsigned& nx) {
    const unsigned G = gridDim.x * gridDim.y * gridDim.z;
    unsigned sum, cnt, mine, sp = 0u;
    for (;;) {
        sum = 0u; cnt = 0u; mine = 0u;
#pragma unroll
        for (unsigned j = 0; j < 16; ++j) { const unsigned c = xb_ld(&bar[XB_XCNT(j)]); sum += c; cnt += (c > 0u) ? 1u : 0u; mine = (j == x) ? c : mine; }
        if (sum == G) break;
        __builtin_amdgcn_s_sleep(1);
        if ((++sp & 255u) == 0u) { if (xb_ld(&bar[XB_TMO])) break; if (sp > XB_SPIN_CAP) { atomicAdd(&bar[XB_TMO], 1u); break; } }
    }
    nloc = mine > 0u ? mine : 1u; nx = cnt > 0u ? cnt : 1u;
}
__device__ __forceinline__ void xcd_barrier(const XcdBarrier& b) {
    asm volatile("s_waitcnt vmcnt(0)" ::: "memory");
    __syncthreads();
    if (threadIdx.x == 0) {
        unsigned* bar = b.bar;
        __builtin_amdgcn_s_waitcnt(0);
        unsigned nloc = b.st[0], nx = b.st[1];
        if (nloc == 0u) { xcd_barrier_complete(bar, b.x, nloc, nx); b.st[0] = nloc; b.st[1] = nx; }
        const unsigned old = xb_add(&bar[XB_XSUB(b.x)], 1u);
        const unsigned gen = old / nloc;
        if (old + 1u == (gen + 1u) * nloc) {
            __builtin_amdgcn_fence(__ATOMIC_RELEASE, "agent");
            asm volatile("s_waitcnt vmcnt(0)" ::: "memory");
            const unsigned og = xb_add(&bar[XB_TOP], 1u);
            const unsigned tg = og / nx;
            if (og + 1u == (tg + 1u) * nx) xb_add(&bar[XB_TOPGEN], 1u);
            else XB_SPIN(xb_ld(&bar[XB_TOPGEN]) == tg, bar);
            __builtin_amdgcn_fence(__ATOMIC_ACQUIRE, "agent");
            xb_add(&bar[XB_XGEN(b.x)], 1u);
            asm volatile("s_waitcnt vmcnt(0)" ::: "memory");
        } else {
            XB_SPIN(xb_ld(&bar[XB_XGEN(b.x)]) == gen, bar);
            __builtin_amdgcn_fence(__ATOMIC_ACQUIRE, "agent");
            asm volatile("s_waitcnt vmcnt(0)" ::: "memory");
        }
    }
    __syncthreads();
}

namespace gm {
constexpr int BM = 256, BK = 64, HALF = 128, HTB = HALF * BK * 2, NXCD = 8, WGM = 8;
typedef int v4i_t __attribute__((ext_vector_type(4))); typedef int v8i_t __attribute__((ext_vector_type(8)));
__host__ __device__ __forceinline__ int lds_byte(int r, int c) { const int st = (r >> 4) * 2 + (c >> 5), rr = r & 15, cc = c & 31, ob = rr * 64 + cc * 2; return st * 1024 + (ob ^ (((ob >> 9) & 1) << 5)); }
__host__ __device__ __forceinline__ void stage_rc(int b, int& R, int& C) { const int st = b / 1024, sb = b % 1024, swz = sb ^ (((sb >> 9) & 1) << 5); R = (st >> 1) * 16 + swz / 64; C = (st & 1) * 32 + (swz % 64) / 2; }
__host__ __device__ __forceinline__ int perm32(int rho) { const int n = rho >> 4, i = rho & 15; return 8 * (i >> 2) + 4 * n + (i & 3); }
struct Unit { int pm, pn, bk, tb; };
struct Src { const char* a; const char* b0; const char* b1; unsigned va[2][2]; };
struct StaticOrder {
    int nM, nN, nwg, G, c;
    __device__ void init(int M, int N, int G_, int c_) { nM = M / BM; nN = N / BM; nwg = nM * nN; G = G_; c = c_; }
    __device__ __forceinline__ bool next(int i, Unit& u) const {
        const long L = (long)i * G + c; if (L >= nwg) return false;
        int wgid = (int)L; { const int q = nwg / NXCD, r = nwg % NXCD, xcd = wgid % NXCD, off = wgid / NXCD; wgid = (xcd < r ? xcd * (q + 1) : r * (q + 1) + (xcd - r) * q) + off; }
        const int nig = WGM * nN, gid = wgid / nig, fm = gid * WGM, gsz = (nM - fm) < WGM ? (nM - fm) : WGM;
        u.pm = fm + ((wgid % nig) % gsz); u.pn = (wgid % nig) / gsz; u.bk = 0; u.tb = 0; return true;
    }
};

template <class Kind>
__device__ __forceinline__ void gemm_phase(LAS unsigned char* lds, const Kind& Kd) {
    int tid_ = threadIdx.x; asm volatile("" : "+v"(tid_));
    const int tid = tid_, wid = __builtin_amdgcn_readfirstlane(tid >> 6), lane = tid & 63, wr = wid >> 2, wc = wid & 3, fr = lane & 15, fq = lane >> 4;
    int R[2], C[2]; unsigned voffB[2];
#pragma unroll
    for (int i = 0; i < 2; ++i) { stage_rc(tid * 16 + i * 8192, R[i], C[i]); const int Rb = Kind::PERM ? ((R[i] & ~31) + perm32(R[i] & 31)) : R[i]; voffB[i] = (unsigned)(Rb * Kind::LDBB + C[i] * 2); }
    const size_t hstepB = (size_t)HALF * Kind::LDBB;
    constexpr int NT = Kind::NTK;
    const unsigned ldsw = (unsigned)wid * 1024u;
    const int aoff = lds_byte(wr * 64 + fr, fq * 8), boff = lds_byte(wc * 32 + fr, fq * 8);
#define G_SA(b, h) (((b) * 2 + (h)) * HTB)
#define G_SB(b, h) ((4 + (b) * 2 + (h)) * HTB)
#define G_STAGE_A(bufoff, S, t, h) do { const char* _g = (S).a + (size_t)(t) * 128; _Pragma("unroll") for (int _i = 0; _i < 2; ++_i) \
        __builtin_amdgcn_global_load_lds((const unsigned*)(_g + (S).va[h][_i]), (LAS unsigned*)(lds + (bufoff) + ldsw + _i * 8192), 16, 0, 0); } while (0)
#define G_STAGE_B(bufoff, S, t, h) do { const char* _g = (((t) < NT / 2) ? (S).b0 + (size_t)(t) * 128 : (S).b1 + (size_t)((t) - NT / 2) * 128) + (h) * hstepB; _Pragma("unroll") for (int _i = 0; _i < 2; ++_i) \
        __builtin_amdgcn_global_load_lds((const unsigned*)(_g + voffB[_i]), (LAS unsigned*)(lds + (bufoff) + ldsw + _i * 8192), 16, 0, 0); } while (0)
#define G_LDA(dst, b, h) do { _Pragma("unroll") for (int m = 0; m < 4; ++m) _Pragma("unroll") for (int k = 0; k < 2; ++k) dst[m][k] = *(const LAS bf16x8*)(lds + G_SA(b, h) + aoff + m * 2048 + k * 1024); } while (0)
#define G_LDB(dst, b, h) do { _Pragma("unroll") for (int n = 0; n < 2; ++n) _Pragma("unroll") for (int k = 0; k < 2; ++k) dst[n][k] = *(const LAS bf16x8*)(lds + G_SB(b, h) + boff + n * 2048 + k * 1024); } while (0)
#define G_MMA(ai, bj, At, Bt) do { __builtin_amdgcn_s_setprio(1); _Pragma("unroll") for (int m = 0; m < 4; ++m) _Pragma("unroll") for (int n = 0; n < 2; ++n) _Pragma("unroll") for (int k = 0; k < 2; ++k) \
        acc[ai][bj][m][n] = __builtin_amdgcn_mfma_f32_16x16x32_bf16(Bt[n][k], At[m][k], acc[ai][bj][m][n], 0, 0, 0); __builtin_amdgcn_s_setprio(0); } while (0)
#define G_LDA8(dst, b, h) do { _Pragma("unroll") for (int m = 0; m < 4; ++m) { const v4i_t _lo = *(const LAS v4i_t*)(lds + G_SA(b, h) + aoff + m * 2048), _hi = *(const LAS v4i_t*)(lds + G_SA(b, h) + aoff + m * 2048 + 1024); \
        dst[m] = __builtin_shufflevector(_lo, _hi, 0, 1, 2, 3, 4, 5, 6, 7); } } while (0)
#define G_LDB8(dst, b, h) do { _Pragma("unroll") for (int n = 0; n < 2; ++n) { const v4i_t _lo = *(const LAS v4i_t*)(lds + G_SB(b, h) + boff + n * 2048), _hi = *(const LAS v4i_t*)(lds + G_SB(b, h) + boff + n * 2048 + 1024); \
        dst[n] = __builtin_shufflevector(_lo, _hi, 0, 1, 2, 3, 4, 5, 6, 7); } } while (0)
#define G_MMA8(ai, bj, A8_, B8_) do { __builtin_amdgcn_s_setprio(1); _Pragma("unroll") for (int m = 0; m < 4; ++m) _Pragma("unroll") for (int n = 0; n < 2; ++n) \
        asm volatile("v_mfma_scale_f32_16x16x128_f8f6f4 %0, %1, %2, %0, %3, %3 op_sel_hi:[0,0,0]" : "+v"(acc[ai][bj][m][n]) : "v"(B8_[n]), "v"(A8_[m]), "v"(sc1v)); __builtin_amdgcn_s_setprio(0); } while (0)
#define X_LDA(b, h) do { if constexpr (Kind::FP8) G_LDA8(A8, b, h); else G_LDA(At, b, h); } while (0)
#define X_LDB0(b, h) do { if constexpr (Kind::FP8) G_LDB8(B08, b, h); else G_LDB(B0, b, h); } while (0)
#define X_LDB1(b, h) do { if constexpr (Kind::FP8) G_LDB8(B18, b, h); else G_LDB(B1, b, h); } while (0)
#define X_MM0(ai, bj) do { if constexpr (Kind::FP8) G_MMA8(ai, bj, A8, B08); else G_MMA(ai, bj, At, B0); } while (0)
#define X_MM1(ai, bj) do { if constexpr (Kind::FP8) G_MMA8(ai, bj, A8, B18); else G_MMA(ai, bj, At, B1); } while (0)
#define G_WAIT_V(n) asm volatile("s_waitcnt vmcnt(" #n ")" ::: "memory")
#define G_WAIT_L(n) asm volatile("s_waitcnt lgkmcnt(" #n ")" ::: "memory")
#define G_BAR __builtin_amdgcn_s_barrier()
#define G_SCHED __builtin_amdgcn_sched_barrier(0)
    Unit cur, nxt; Src sc, sn; int ui = 0; int pend = -1;
    if (!Kd.next(0, cur)) return;
    Kd.src(cur, sc, R, C);
    Kd.a_ready(cur, wid);
    f32x4 acc[2][2][4][2];
#pragma unroll
    for (int a = 0; a < 2; ++a)
#pragma unroll
        for (int b = 0; b < 2; ++b)
#pragma unroll
            for (int m = 0; m < 4; ++m)
#pragma unroll
                for (int n = 0; n < 2; ++n) acc[a][b][m][n] = (f32x4){0.f, 0.f, 0.f, 0.f};
    bf16x8 At[4][2], B0[2][2], B1[2][2]; v8i_t A8[4], B08[2], B18[2]; int sc1v = 0x7f7f7f7f; asm volatile("" : "+v"(sc1v));
    G_STAGE_B(G_SB(0, 0), sc, 0, 0); G_STAGE_B(G_SB(0, 1), sc, 0, 1); G_STAGE_A(G_SA(0, 0), sc, 0, 0); G_STAGE_A(G_SA(0, 1), sc, 0, 1);
    if (wr == 1) G_BAR;
    G_WAIT_V(2); G_BAR;
    G_STAGE_B(G_SB(1, 0), sc, 1, 0); G_STAGE_A(G_SA(1, 0), sc, 1, 0); G_STAGE_B(G_SB(1, 1), sc, 1, 1);
    G_WAIT_V(6); G_BAR;
    for (;;) {
        const bool has_next = Kd.next(ui + 1, nxt);
        if (has_next) Kd.src(nxt, sn, R, C); else sn = sc;
#pragma unroll 1
        for (int t = 0; t < NT; t += 2) {
            const bool last = (t == NT - 2);
            if (last && has_next) Kd.a_ready(nxt, wid);
            Src s2; s2.a = last ? sn.a : sc.a; s2.b0 = last ? sn.b0 : sc.b0; s2.b1 = last ? sn.b1 : sc.b1;
            s2.va[0][0] = last ? sn.va[0][0] : sc.va[0][0]; s2.va[0][1] = last ? sn.va[0][1] : sc.va[0][1]; s2.va[1][0] = last ? sn.va[1][0] : sc.va[1][0]; s2.va[1][1] = last ? sn.va[1][1] : sc.va[1][1];
            const int t2 = last ? 0 : t + 2, t3 = t2 + 1;
            X_LDB0(0, 0); X_LDB1(0, 1); G_SCHED; X_LDA(0, 0); G_STAGE_A(G_SA(1, 1), sc, t + 1, 1);
            G_WAIT_V(8); G_WAIT_L(0); G_BAR; X_MM0(0, 0); X_MM1(0, 1); G_BAR; G_SCHED;
            X_LDA(0, 1); G_STAGE_B(G_SB(0, 0), s2, t2, 0); G_STAGE_B(G_SB(0, 1), s2, t2, 1); G_STAGE_A(G_SA(0, 0), s2, t2, 0);
            G_WAIT_V(8); G_WAIT_L(0); G_BAR; X_MM0(1, 0); X_MM1(1, 1); G_BAR; G_SCHED;
            X_LDB0(1, 0); X_LDB1(1, 1); G_SCHED; X_LDA(1, 0); G_STAGE_A(G_SA(0, 1), s2, t2, 1);
            G_WAIT_V(8); G_WAIT_L(0); G_BAR; X_MM0(0, 0); X_MM1(0, 1); G_BAR; G_SCHED;
            X_LDA(1, 1); G_STAGE_B(G_SB(1, 0), s2, t3, 0); G_STAGE_B(G_SB(1, 1), s2, t3, 1); G_STAGE_A(G_SA(1, 0), s2, t3, 0);
            G_WAIT_V(8); G_WAIT_L(0); G_BAR; X_MM0(1, 0); X_MM1(1, 1); G_BAR; G_SCHED;
        }
        if (wr == 0) G_BAR;
        if (Kind::PUBLISH) { if (pend >= 0) Kd.publish(pend); pend = cur.pm; }
        if (Kind::FP8) asm volatile("s_nop 15\n\ts_nop 15" ::: "memory");
        Kd.epi(acc, cur, wr, wc, fr, fq);
        if (!has_next) break;
#pragma unroll
        for (int a = 0; a < 2; ++a)
#pragma unroll
            for (int b = 0; b < 2; ++b)
#pragma unroll
                for (int m = 0; m < 4; ++m)
#pragma unroll
                    for (int n = 0; n < 2; ++n) acc[a][b][m][n] = (f32x4){0.f, 0.f, 0.f, 0.f};
        cur = nxt; sc = sn; ++ui;
        if (wr == 1) G_BAR;
    }
    G_WAIT_V(0);
    if (Kind::PUBLISH) { if (pend >= 0) Kd.publish(pend); }
    G_BAR;
#undef G_SA
#undef G_SB
#undef G_STAGE_A
#undef G_STAGE_B
#undef G_LDA
#undef G_LDB
#undef G_MMA
#undef G_MMA8
#undef G_LDA8
#undef G_LDB8
#undef X_LDA
#undef X_LDB0
#undef X_LDB1
#undef X_MM0
#undef X_MM1
#undef G_WAIT_V
#undef G_WAIT_L
#undef G_BAR
#undef G_SCHED
}

__device__ __forceinline__ void src_direct(Src& s, const void* A, int row0, const int (&R)[2], const int (&C)[2], int pitchb = 2048) {
    s.a = (const char*)A + (size_t)row0 * pitchb;
#pragma unroll
    for (int h = 0; h < 2; ++h)
#pragma unroll
        for (int i = 0; i < 2; ++i) s.va[h][i] = (unsigned)((h * HALF + R[i]) * pitchb + C[i] * 2);
}

template <bool F8> struct K1 {
    static constexpr bool PERM = true, PUBLISH = false, FP8 = F8; static constexpr int LDBB = F8 ? 1024 : 2048, NTK = F8 ? 8 : 16;
    __device__ __forceinline__ void publish(int) const {}
    __device__ __forceinline__ void a_ready(const Unit&, int) const {}
    __device__ __forceinline__ void done(const Unit&) const {}
    StaticOrder S; const void* A; const void* Bt; bf16_t* O; const float* rope;
    __device__ __forceinline__ bool next(int i, Unit& u) const { return S.next(i, u); }
    __device__ __forceinline__ void src(const Unit& u, Src& s, const int (&R)[2], const int (&C)[2]) const {
        src_direct(s, A, u.pm * BM, R, C, F8 ? 1024 : 2048); s.b0 = (const char*)Bt + (size_t)u.pn * BM * (F8 ? 1024 : 2048); s.b1 = s.b0 + (F8 ? 512 : 1024);
    }
    __device__ __forceinline__ void epi(const f32x4 (&acc)[2][2][4][2], const Unit& u, int wr, int wc, int fr, int fq) const {
        const int row0 = u.pm * BM + wr * 64 + fr, col0 = u.pn * TSZ + wc * 32 + 8 * fq;
        if (u.pn == 7 || u.pn == 8) {
#pragma unroll
            for (int ai = 0; ai < 2; ++ai)
#pragma unroll
                for (int m = 0; m < 4; ++m) {
                    const int row = row0 + ai * HALF + m * 16;
                    const f32x4 cs = *(const f32x4*)(rope + (size_t)row * 8), sn = *(const f32x4*)(rope + (size_t)row * 8 + 4);
                    bf16_t* rowp = O + (size_t)row * PJ + col0;
#pragma unroll
                    for (int bj = 0; bj < 2; ++bj) {
                        f32x4 v0 = acc[ai][bj][m][0], v1 = acc[ai][bj][m][1]; if (F8) { v0 = v0 * (1.f / W8S); v1 = v1 * (1.f / W8S); }
                        if (fq == 0) { const f32x4 x1 = v0, x2 = v1; v0 = x1 * cs - x2 * sn; v1 = x2 * cs + x1 * sn; }
                        u32x4 w; w.x = pk2(v0[0], v0[1]); w.y = pk2(v0[2], v0[3]); w.z = pk2(v1[0], v1[1]); w.w = pk2(v1[2], v1[3]);
                        *(u32x4*)(rowp + bj * HALF) = w;
                    }
                }
        } else {
#pragma unroll
            for (int ai = 0; ai < 2; ++ai)
#pragma unroll
                for (int m = 0; m < 4; ++m) { bf16_t* rowp = O + (size_t)(row0 + ai * HALF + m * 16) * PJ + col0;
#pragma unroll
                    for (int bj = 0; bj < 2; ++bj) { f32x4 v0 = acc[ai][bj][m][0], v1 = acc[ai][bj][m][1]; if (F8) { v0 = v0 * (1.f / W8S); v1 = v1 * (1.f / W8S); }
                        u32x4 w; w.x = pk2(v0[0], v0[1]); w.y = pk2(v0[2], v0[3]); w.z = pk2(v1[0], v1[1]); w.w = pk2(v1[2], v1[3]);
                        *(u32x4*)(rowp + bj * HALF) = w; } }
        }
    }
};
struct K2 {
    static constexpr bool PERM = true, PUBLISH = false, FP8 = true; static constexpr int LDBB = 1024, NTK = 8;
    __device__ __forceinline__ void publish(int) const {}
    __device__ __forceinline__ void a_ready(const Unit&, int) const {}
    __device__ __forceinline__ void done(const Unit&) const {}
    StaticOrder S; const unsigned char* A; const unsigned char* Bt; bf16_t* O;
    __device__ __forceinline__ bool next(int i, Unit& u) const { return S.next(i, u); }
    __device__ __forceinline__ void src(const Unit& u, Src& s, const int (&R)[2], const int (&C)[2]) const {
        src_direct(s, A, u.pm * BM, R, C, 1024); s.b0 = (const char*)(Bt + (size_t)u.pn * BM * 1024); s.b1 = s.b0 + 512;
    }
    __device__ __forceinline__ void epi(const f32x4 (&acc)[2][2][4][2], const Unit& u, int wr, int wc, int fr, int fq) const {
        const int row0 = u.pm * BM + wr * 64 + fr, col0 = u.pn * BM + wc * 32 + 8 * fq;
#pragma unroll
        for (int ai = 0; ai < 2; ++ai)
#pragma unroll
            for (int m = 0; m < 4; ++m) { bf16_t* rowp = O + (size_t)(row0 + ai * HALF + m * 16) * DM + col0;
#pragma unroll
                for (int bj = 0; bj < 2; ++bj) { const f32x4 v0 = acc[ai][bj][m][0] * (1.f / (W8S * Y8S)), v1 = acc[ai][bj][m][1] * (1.f / (W8S * Y8S));
                    u32x4 w; w.x = pk2(v0[0], v0[1]); w.y = pk2(v0[2], v0[3]); w.z = pk2(v1[0], v1[1]); w.w = pk2(v1[2], v1[3]);
                    *(u32x4*)(rowp + bj * HALF) = w; } }
    }
};
__device__ __forceinline__ int pair_i(int p) { return p < 3 ? 0 : (p < 5 ? 1 : 2); }
__device__ __forceinline__ int pair_j(int p) { return p < 3 ? p + 1 : (p < 5 ? p - 1 : 3); }
struct K4 {
    static constexpr bool PERM = true, PUBLISH = false, FP8 = true; static constexpr int LDBB = 1024, NTK = 8;
    const unsigned char* U; const unsigned char* Wgu; unsigned char* H; const int* ltok; const float* lgate; const LAS int* tb; int G, vcu; gu32* rtc;
    __device__ __forceinline__ void a_ready(const Unit&, int) const {}
    __device__ __forceinline__ void done(const Unit&) const {}
    __device__ __forceinline__ void publish(int pm) const { if ((threadIdx.x & 63) == 0) __hip_atomic_fetch_add(rtc + 64 * pm, 1u, RLX_AGENT); }
    __device__ __forceinline__ bool next(int i, Unit& u) const {
        const int L = i * G + vcu; const int nt = tb[32 + NBUCKET]; if (L >= nt * 8) return false;
        const int rt = L >> 3; int k = 0;
        for (int q = 1; q < NBUCKET; ++q) k = (tb[32 + q] <= rt) ? q : k;
        u.pm = rt; u.pn = L & 7; u.bk = k; u.tb = rt - tb[32 + k]; return true;
    }
    __device__ __forceinline__ void src(const Unit& u, Src& s, const int (&R)[2], const int (&C)[2]) const {
        const int cnt = tb[u.bk]; s.a = (const char*)U;
#pragma unroll
        for (int h = 0; h < 2; ++h)
#pragma unroll
            for (int i = 0; i < 2; ++i) { const int pos = u.tb * BM + h * HALF + R[i]; const int tok = ltok[(size_t)u.bk * LCAP + (pos < cnt ? pos : 0)]; s.va[h][i] = (unsigned)(tok * 1024 + C[i] * 2); }
        const int grp = u.bk / 6, p = u.bk % 6, sl = u.pn >> 2; const int e = grp * 4 + (sl ? pair_j(p) : pair_i(p));
        s.b0 = (const char*)(Wgu + ((size_t)e * 1024 + (size_t)(u.pn & 3) * BM) * 1024); s.b1 = s.b0 + 512;
    }
    __device__ __forceinline__ void epi(const f32x4 (&acc)[2][2][4][2], const Unit& u, int wr, int wc, int fr, int fq) const {
        const int cnt = tb[u.bk], sl = u.pn >> 2; const int colo = sl * 512 + (u.pn & 3) * 128 + wc * 32 + 8 * fq;
#pragma unroll
        for (int ai = 0; ai < 2; ++ai)
#pragma unroll
            for (int m = 0; m < 4; ++m) {
                const int r = ai * HALF + wr * 64 + m * 16 + fr, pos = u.tb * BM + r;
                const float gt = (pos < cnt) ? lgate[((size_t)u.bk * LCAP + pos) * 2 + sl] : 0.f;
                float hv[8];
#pragma unroll
                for (int n = 0; n < 2; ++n)
#pragma unroll
                    for (int j = 0; j < 4; ++j) { const float g = acc[ai][0][m][n][j] * (1.f / W8S), up = acc[ai][1][m][n][j] * (1.f / W8S); hv[n * 4 + j] = g * __builtin_amdgcn_rcpf(1.f + fexp(-g)) * up * (gt * H8S); }
                u32x2 w; w.x = pk4_fp8(hv[0], hv[1], hv[2], hv[3]); w.y = pk4_fp8(hv[4], hv[5], hv[6], hv[7]);
                *(u32x2*)(H + (size_t)(u.pm * BM + r) * 1024 + colo) = w;
            }
    }
};
struct K5 {
    static constexpr bool PERM = true, PUBLISH = false, FP8 = true; static constexpr int LDBB = 512, NTK = 8;
    __device__ __forceinline__ void publish(int) const {}
    const unsigned char* H; const unsigned char* Wd; bf16_t* Y; const LAS int* tb; int G, vcu; gu32* rtc; gu32* tmo;
    __device__ __forceinline__ void done(const Unit&) const {}
    __device__ __forceinline__ void a_ready(const Unit& u, int wid) const { return;
        if (wid == 0) {
            const unsigned long long t0 = __builtin_amdgcn_s_memrealtime(); unsigned polls = 0;
            while ((unsigned)__builtin_amdgcn_readfirstlane(__hip_atomic_load(rtc + 64 * u.pm, RLX_AGENT)) < 64u) {
                if ((++polls & 255u) == 0u && __builtin_amdgcn_readfirstlane(__hip_atomic_load(tmo, RLX_AGENT)) != 0u) break;
                if (__builtin_amdgcn_s_memrealtime() - t0 > 2000000ull) { if ((threadIdx.x & 63) == 0) __hip_atomic_store(tmo, 1u, RLX_AGENT); break; }
                __builtin_amdgcn_s_sleep(2); }
            __builtin_amdgcn_fence(__ATOMIC_ACQUIRE, "agent");
            asm volatile("s_waitcnt vmcnt(0)" ::: "memory");
        }
        asm volatile("" ::: "memory"); __builtin_amdgcn_s_barrier(); asm volatile("" ::: "memory");
    }
    __device__ __forceinline__ bool next(int i, Unit& u) const {
        const int nt = tb[32 + NBUCKET]; const int n4 = nt * 8; const int i0 = 0; (void)n4;
        const int L = (i + i0) * G + vcu; if (L >= nt * 4) return false;
        const int rt = L >> 2; int k = 0;
        for (int q = 1; q < NBUCKET; ++q) k = (tb[32 + q] <= rt) ? q : k;
        u.pm = rt; u.pn = L & 3; u.bk = k; u.tb = rt - tb[32 + k]; return true;
    }
    __device__ __forceinline__ void src(const Unit& u, Src& s, const int (&R)[2], const int (&C)[2]) const {
        src_direct(s, H, u.pm * BM, R, C, 1024);
        const int grp = u.bk / 6, p = u.bk % 6;
        s.b0 = (const char*)(Wd + ((size_t)(grp * 4 + pair_i(p)) * 1024 + (size_t)u.pn * BM) * 512);
        s.b1 = (const char*)(Wd + ((size_t)(grp * 4 + pair_j(p)) * 1024 + (size_t)u.pn * BM) * 512);
    }
    __device__ __forceinline__ void epi(const f32x4 (&acc)[2][2][4][2], const Unit& u, int wr, int wc, int fr, int fq) const {
        const int row0 = u.pm * BM + wr * 64 + fr, col0 = u.pn * BM + wc * 32 + 8 * fq;
#pragma unroll
        for (int ai = 0; ai < 2; ++ai)
#pragma unroll
            for (int m = 0; m < 4; ++m) { bf16_t* rowp = Y + (size_t)(row0 + ai * HALF + m * 16) * DM + col0;
#pragma unroll
                for (int bj = 0; bj < 2; ++bj) { const f32x4 v0 = acc[ai][bj][m][0] * (1.f / (W8S * H8S)), v1 = acc[ai][bj][m][1] * (1.f / (W8S * H8S));
                    u32x4 w; w.x = pk2(v0[0], v0[1]); w.y = pk2(v0[2], v0[3]); w.z = pk2(v1[0], v1[1]); w.w = pk2(v1[2], v1[3]);
                    *(u32x4*)(rowp + bj * HALF) = w; } }
    }
};
}

namespace attn_body {
using bf16 = __hip_bfloat16;
using s16x4 = __attribute__((ext_vector_type(4))) short;
using f32x16 = __attribute__((ext_vector_type(16))) float;
constexpr int D = 64, PITCH = PJ;
constexpr int NW = 8, QBLK = 32, QB = QBLK * NW, KVBLK = 64;
__device__ __forceinline__ int crow(int r, int hi) { return (r & 3) + 8 * (r >> 2) + 4 * hi; }
#define SBAR() __builtin_amdgcn_sched_barrier(0)
__device__ __forceinline__ void cmask(f32x16& p0, f32x16& p1, int jb, int qrel, int hi) {
    const float NEG = -INFINITY; int kb = 64 * jb + 4 * hi;
#pragma unroll
    for (int r = 0; r < 16; ++r) { int kv = kb + (r & 3) + 8 * (r >> 2); if (kv > qrel) p0[r] = NEG; if (kv + 32 > qrel) p1[r] = NEG; }
}
constexpr int NSLOT = 3, SLOTB = 8192;
constexpr int LDS_K = 0, LDS_V = NSLOT * SLOTB, LDS_WS = 2 * NSLOT * SLOTB, LDS_OST = LDS_WS + NW * 64 * 4, ATT_LDS_BYTES = LDS_OST + NW * 8192;
__device__ __forceinline__ void glds16(const void* gsrc, unsigned lds_dst) { unsigned keep;
    asm volatile("s_mov_b32 %0, m0\n\ts_mov_b32 m0, %2\n\ts_nop 0\n\tglobal_load_lds_dwordx4 %1, off\n\ts_mov_b32 m0, %0" : "=&s"(keep) : "v"(gsrc), "s"(lds_dst) : "memory"); }
__device__ __forceinline__ float max3f(float a, float b, float c) { float r; asm("v_max3_f32 %0, %1, %2, %3" : "=v"(r) : "v"(a), "v"(b), "v"(c)); return r; }
__device__ __forceinline__ float max2f(float a, float b) { float r; asm("v_max_f32_e32 %0, %1, %2" : "=v"(r) : "v"(a), "v"(b)); return r; }
__device__ __forceinline__ float fadd_s(float a, float b) { float r; asm("v_add_f32_e32 %0, %1, %2" : "=v"(r) : "v"(a), "v"(b)); return r; }
__device__ __forceinline__ float fsub_s(float a, float b) { float r; asm("v_sub_f32_e32 %0, %1, %2" : "=v"(r) : "v"(a), "v"(b)); return r; }
typedef float f32x2_t __attribute__((ext_vector_type(2))); typedef __bf16 bf16x2_t __attribute__((ext_vector_type(2)));
__device__ __forceinline__ unsigned cvtpk_s(float lo, float hi) { f32x2_t v = {lo, hi}; bf16x2_t b = __builtin_convertvector(v, bf16x2_t); return __builtin_bit_cast(unsigned, b); }
#define WAIT_BAR(N) asm volatile("s_waitcnt vmcnt(" #N ") lgkmcnt(0)\n\ts_barrier" ::: "memory")
__device__ __forceinline__ void qkt(f32x16& p0, f32x16& p1, const char* Kslot, const bf16x8* qr, const f32x16& negm, int r32, int hi) {
    const char* kb = Kslot + hi * 1024 + r32 * 16;
#pragma unroll
    for (int d0 = 0; d0 < 2; ++d0) {
        const bf16x8 b0 = *reinterpret_cast<const bf16x8*>(kb + d0 * 2048);
        const bf16x8 b1 = *reinterpret_cast<const bf16x8*>(kb + d0 * 2048 + 512);
        if (d0 == 0) { p0 = __builtin_amdgcn_mfma_f32_32x32x16_bf16(b0, qr[0], negm, 0, 0, 0); p1 = __builtin_amdgcn_mfma_f32_32x32x16_bf16(b1, qr[0], negm, 0, 0, 0); }
        else { p0 = __builtin_amdgcn_mfma_f32_32x32x16_bf16(b0, qr[d0], p0, 0, 0, 0); p1 = __builtin_amdgcn_mfma_f32_32x32x16_bf16(b1, qr[d0], p1, 0, 0, 0); } }
}
typedef __attribute__((address_space(3))) const char* lds_cptr;
typedef short v4i16_t __attribute__((ext_vector_type(4)));
__device__ __forceinline__ void kload8(bf16x8* kf, lds_cptr kp) {
    kf[0] = *(const __attribute__((address_space(3))) bf16x8*)(kp);        kf[1] = *(const __attribute__((address_space(3))) bf16x8*)(kp + 512);
    kf[2] = *(const __attribute__((address_space(3))) bf16x8*)(kp + 2048); kf[3] = *(const __attribute__((address_space(3))) bf16x8*)(kp + 2560);
}
__device__ __forceinline__ void kload2(bf16x8* kf, lds_cptr kp, int j) { kf[2 * j] = *(const __attribute__((address_space(3))) bf16x8*)(kp + j * 2048); kf[2 * j + 1] = *(const __attribute__((address_space(3))) bf16x8*)(kp + j * 2048 + 512); }
__device__ __forceinline__ s16x4 vtr(lds_cptr p) { return __builtin_bit_cast(s16x4, __builtin_amdgcn_ds_read_tr16_b64_v4i16((__attribute__((address_space(3))) v4i16_t*)p)); }
__device__ __forceinline__ float rowmax(const f32x16& p0, const f32x16& p1) {
    float a = max3f(p0[0], p0[1], p1[0]), b = max3f(p0[2], p0[3], p1[1]); a = max3f(a, p1[2], p1[3]);
#pragma unroll
    for (int r = 4; r < 16; r += 4) { a = max3f(a, p0[r], p0[r + 1]); b = max3f(b, p0[r + 2], p0[r + 3]); a = max3f(a, p1[r], p1[r + 1]); b = max3f(b, p1[r + 2], p1[r + 3]); }
    const float m = max2f(a, b);
    auto rr = __builtin_amdgcn_permlane32_swap(__float_as_uint(m), __float_as_uint(m), false, false);
    return max2f(__uint_as_float(rr[0]), __uint_as_float(rr[1]));
}
__device__ __forceinline__ void pv(f32x16* o, int vb, bf16x8 pa0, bf16x8 pa1, bf16x8 pa2, bf16x8 pa3) {
#pragma unroll
    for (int d0 = 0; d0 < 2; ++d0) { s16x4 lo[4], hi[4];
#pragma unroll
        for (int ks = 0; ks < 4; ++ks) {
            asm volatile("ds_read_b64_tr_b16 %0,%1 offset:%c2" : "=&v"(lo[ks]) : "v"(vb), "i"(d0 * 4096 + ks * 1024) : "memory");
            asm volatile("ds_read_b64_tr_b16 %0,%1 offset:%c2" : "=&v"(hi[ks]) : "v"(vb), "i"(d0 * 4096 + ks * 1024 + 512) : "memory"); }
        asm volatile("s_waitcnt lgkmcnt(0)" ::: "memory"); SBAR();
#define PK(k) (bf16x8){lo[k][0], lo[k][1], lo[k][2], lo[k][3], hi[k][0], hi[k][1], hi[k][2], hi[k][3]}
        o[d0] = __builtin_amdgcn_mfma_f32_32x32x16_bf16(pa0, PK(0), o[d0], 0, 0, 0);
        o[d0] = __builtin_amdgcn_mfma_f32_32x32x16_bf16(pa1, PK(1), o[d0], 0, 0, 0);
        o[d0] = __builtin_amdgcn_mfma_f32_32x32x16_bf16(pa2, PK(2), o[d0], 0, 0, 0);
        o[d0] = __builtin_amdgcn_mfma_f32_32x32x16_bf16(pa3, PK(3), o[d0], 0, 0, 0);
#undef PK
    }
}
struct AttnParams { const bf16* Q; const bf16* K; const bf16* V; const bf16* zpage; bf16_t* Y; const float* gnorm; float lam, osc; };
template <int THRL, int comp> __device__ __forceinline__ void attn_unit(int b, int h, int qb, const AttnParams& P, char* shm) {
    const bf16* Q = P.Q; const bf16* __restrict__ K = P.K; const bf16* __restrict__ V = P.V;
    int tid_ = threadIdx.x; asm volatile("" : "+v"(tid_));
    const int tid = tid_, lane = tid & 63, r32 = lane & 31, hi = lane >> 5; const int wid = __builtin_amdgcn_readfirstlane(tid >> 6);
    const long rowbase = (long)b * SEQ; const int q0 = qb * QB;
    const bf16* Qw = Q + (rowbase + q0 + wid * QBLK) * PITCH + h * D;
    const bf16* Kh = K + rowbase * PITCH + h * D, *Vh = V + rowbase * PITCH + h * D;
    const unsigned lds0 = (unsigned)(uintptr_t)shm;
    float* wsf = (float*)(shm + LDS_WS) + wid * 64;
    const bf16* ksrc = Kh + (long)(32 * (wid & 1) + (lane & 31)) * PITCH + comp * 32 + (wid >> 1) * 8;
    const bf16* vsrc = Vh + (long)(16 * (wid & 3) + (lane >> 2)) * PITCH + (wid >> 2) * 32 + (lane & 3) * 8;
    const unsigned kdst = lds0 + LDS_K + (wid >> 1) * 1024 + (wid & 1) * 512, vdst = lds0 + LDS_V + wid * 1024;
#define DMA_K(t, slot) do { if (lane < 32) glds16(ksrc + (long)(t) * KVBLK * PITCH, (unsigned)__builtin_amdgcn_readfirstlane(kdst + (slot))); } while (0)
#define DMA_V(t, slot) glds16(vsrc + (long)(t) * KVBLK * PITCH, (unsigned)__builtin_amdgcn_readfirstlane(vdst + (slot)))
    const int vb0 = (int)(lds0 + LDS_V) + ((lane >> 4) & 1) * 32 + (lane & 3) * 8 + (4 * hi + ((lane & 15) >> 2)) * 64;
    const char* Kbase = shm + LDS_K; bf16x8 kf[4];
    const lds_cptr shm3 = (lds_cptr)shm; const lds_cptr kp0 = shm3 + LDS_K + hi * 1024 + r32 * 16; const lds_cptr vp0 = shm3 + LDS_V + ((lane >> 4) & 1) * 32 + (lane & 3) * 8 + (4 * hi + ((lane & 15) >> 2)) * 64;
    const int NT = (q0 + QB) / KVBLK;
    if (wid >= 4) __builtin_amdgcn_s_setprio(1);
    DMA_K(0, 0); DMA_V(0, 0); DMA_K(1, SLOTB);
    bf16x8 qr[2];
#pragma unroll
    for (int d0 = 0; d0 < 2; ++d0) qr[d0] = *reinterpret_cast<const bf16x8*>(&Qw[(long)r32 * PITCH + comp * 32 + d0 * 16 + hi * 8]);
    float mhat = 0.f, l_reg = 0.f; f32x16 o[2]; o[0] = f32x16{}; o[1] = f32x16{}; f32x16 negm = f32x16{}; asm volatile("" : "+v"(negm));
    const int qrel = wid * QBLK + r32;
#define CMASK(P0, P1, t) do { int jb_ = (t) - (NT - 4); if (jb_ >= 0) cmask(P0, P1, jb_, qrel, hi); } while (0)
    bool resc = false;
#define START(P0, P1) do { const float rm = rowmax(P0, P1); resc = false; \
    { const float dl = rm; mhat = fadd_s(mhat, dl); \
      _Pragma("unroll") for (int r = 0; r < 16; ++r) { P0[r] = fsub_s(P0[r], dl); P1[r] = fsub_s(P1[r], dl); } \
      _Pragma("unroll") for (int r = 0; r < 16; ++r) negm[r] = -mhat; asm volatile("" : "+v"(negm)); } \
    _Pragma("unroll") for (int r = 0; r < 16; ++r) P0[r] = __builtin_amdgcn_exp2f(P0[r]); } while (0)
#define RESC() do { if (resc) { asm volatile("s_waitcnt lgkmcnt(0)" ::: "memory"); \
      _Pragma("unroll") for (int d_ = 0; d_ < 2; ++d_) _Pragma("unroll") for (int r = 0; r < 16; ++r) o[d_][r] *= wsf[crow(r, hi)]; } } while (0)
    f32x16 pA0, pA1, pB0, pB1;
    int sl_prev = 0, sl_cur = 0, sl_next = SLOTB;
#define ROT() do { sl_prev = sl_cur; sl_cur = sl_next; sl_next = (sl_next == (NSLOT - 1) * SLOTB) ? 0 : sl_next + SLOTB; } while (0)
    DMA_K(2, 2 * SLOTB);
    WAIT_BAR(3);
    qkt(pA0, pA1, Kbase, qr, negm, r32, hi); asm volatile("s_nop 15\n\ts_nop 7" : "+v"(pA0), "+v"(pA1)); CMASK(pA0, pA1, 0);
    START(pA0, pA1);
    _Pragma("unroll") for (int r = 0; r < 16; ++r) pA1[r] = __builtin_amdgcn_exp2f(pA1[r]);
    WAIT_BAR(0);
    DMA_K(3, 0); DMA_V(1, SLOTB);
    ROT();
    kload8(kf, kp0 + sl_cur);
    WAIT_BAR(2);
    s16x4 vlo[8], vhi[8]; u32x4 pw0, pw1, pw2, pw3;
#define PKW(P, B) cvtpk_s(P[B], P[B + 1])
#define PAF(k) __builtin_bit_cast(bf16x8, pw##k)
#define VFR(i) (bf16x8){vlo[i][0], vlo[i][1], vlo[i][2], vlo[i][3], vhi[i][0], vhi[i][1], vhi[i][2], vhi[i][3]}
#define PIN(x) asm volatile("" : "+v"(x))
#define MX3(a, b, c) __builtin_fmaxf(__builtin_fmaxf((a), (b)), (c))
#define GAPA(MF, A0, A1, A2, A3, W0, W1, PW) do { MF; sacc += A0; sacc += A1; sacc += A2; sacc += A3; PIN(sacc); W0; W1; PIN(PW); SBAR(); } while (0)
#define EX(v) __builtin_amdgcn_exp2f(v)
#define GAPB(MF, X, B) do { MF; X[B] = EX(X[B]); X[B + 1] = EX(X[B + 1]); X[B + 2] = EX(X[B + 2]); X[B + 3] = EX(X[B + 3]); PIN(X); SBAR(); } while (0)
#define VRD(i) do { vlo[i] = vtr(vp_ + (((i) >> 2) * 4096 + ((i) & 3) * 1024)); vhi[i] = vtr(vp_ + (((i) >> 2) * 4096 + ((i) & 3) * 1024 + 512)); } while (0)
#define KRD(G, j) do { if (G) { kload2(kf, kp0 + sl_next, j); SBAR(); } } while (0)
#define STEP(C0, C1, P0, P1, t, GK, GV, GL) do { SBAR(); \
    const lds_cptr vp_ = vp0 + sl_prev; \
    VRD(0); SBAR(); float sacc = (P0[0] + P0[1]); \
    GAPA(C0 = __builtin_amdgcn_mfma_f32_32x32x16_bf16(kf[0], qr[0], negm, 0, 0, 0), P0[2], P0[3], P0[4], P0[5],     pw0[0] = PKW(P0, 0), pw0[1] = PKW(P0, 2), pw0); \
    VRD(4); SBAR(); GAPA(C1 = __builtin_amdgcn_mfma_f32_32x32x16_bf16(kf[1], qr[0], negm, 0, 0, 0), P0[6], P0[7], P0[8], P0[9],     pw0[2] = PKW(P0, 4), pw0[3] = PKW(P0, 6), pw0); \
    VRD(1); SBAR(); GAPA(C0 = __builtin_amdgcn_mfma_f32_32x32x16_bf16(kf[2], qr[1], C0, 0, 0, 0),   P0[10], P0[11], P0[12], P0[13], pw1[0] = PKW(P0, 8), pw1[1] = PKW(P0, 10), pw1); \
    VRD(5); SBAR(); GAPA(C1 = __builtin_amdgcn_mfma_f32_32x32x16_bf16(kf[3], qr[1], C1, 0, 0, 0),   P0[14], P0[15], P1[0], P1[1],   pw1[2] = PKW(P0, 12), pw1[3] = PKW(P0, 14), pw1); \
    VRD(2); SBAR(); GAPA(,   P1[2], P1[3], P1[4], P1[5],     pw2[0] = PKW(P1, 0), pw2[1] = PKW(P1, 2), pw2); \
    VRD(6); SBAR(); GAPA(,   P1[6], P1[7], P1[8], P1[9],     pw2[2] = PKW(P1, 4), pw2[3] = PKW(P1, 6), pw2); \
    VRD(3); SBAR(); GAPA(,   P1[10], P1[11], P1[12], P1[13], pw3[0] = PKW(P1, 8), pw3[1] = PKW(P1, 10), pw3); \
    VRD(7); SBAR(); GAPA(,   P1[14], P1[15], 0.f, 0.f,       pw3[2] = PKW(P1, 12), pw3[3] = PKW(P1, 14), pw3); \
    l_reg += sacc; \
    if (GK) { DMA_K((t) + 3, sl_cur); } if (GV) { DMA_V((t) + 1, sl_next); } \
    CMASK(C0, C1, t); \
    { float a = MX3(C0[0], C0[1], C1[0]), b = MX3(C0[2], C0[3], C1[1]); a = MX3(a, C1[2], C1[3]); \
      _Pragma("unroll") for (int r = 4; r < 16; r += 4) { a = MX3(a, C0[r], C0[r + 1]); b = MX3(b, C0[r + 2], C0[r + 3]); a = MX3(a, C1[r], C1[r + 1]); b = MX3(b, C1[r + 2], C1[r + 3]); } \
      float rm = __builtin_fmaxf(a, b); { auto rr = __builtin_amdgcn_permlane32_swap(__float_as_uint(rm), __float_as_uint(rm), false, false); rm = __builtin_fmaxf(__uint_as_float(rr[0]), __uint_as_float(rr[1])); } \
      resc = false; \
      if (__builtin_expect(__any(rm > (float)THRL), 0)) { const float dl = __builtin_fmaxf(rm, 0.f); mhat += dl; \
        _Pragma("unroll") for (int r = 0; r < 16; ++r) { C0[r] -= dl; C1[r] -= dl; } \
        _Pragma("unroll") for (int r = 0; r < 16; ++r) negm[r] = -mhat; asm volatile("" : "+v"(negm)); \
        const float f = __builtin_amdgcn_exp2f(-dl); l_reg *= f; if (hi == 0) wsf[r32] = f; resc = true; } } \
    SBAR(); \
    GAPB(o[0] = __builtin_amdgcn_mfma_f32_32x32x16_bf16(PAF(0), VFR(0), o[0], 0, 0, 0), C0, 0); \
    GAPB(o[1] = __builtin_amdgcn_mfma_f32_32x32x16_bf16(PAF(0), VFR(4), o[1], 0, 0, 0), C0, 4); \
    KRD(GL, 0); GAPB(o[0] = __builtin_amdgcn_mfma_f32_32x32x16_bf16(PAF(1), VFR(1), o[0], 0, 0, 0), C0, 8); \
    KRD(GL, 1); GAPB(o[1] = __builtin_amdgcn_mfma_f32_32x32x16_bf16(PAF(1), VFR(5), o[1], 0, 0, 0), C0, 12); \
    GAPB(o[0] = __builtin_amdgcn_mfma_f32_32x32x16_bf16(PAF(2), VFR(2), o[0], 0, 0, 0), C1, 0); \
    GAPB(o[1] = __builtin_amdgcn_mfma_f32_32x32x16_bf16(PAF(2), VFR(6), o[1], 0, 0, 0), C1, 4); \
    GAPB(o[0] = __builtin_amdgcn_mfma_f32_32x32x16_bf16(PAF(3), VFR(3), o[0], 0, 0, 0), C1, 8); \
    GAPB(o[1] = __builtin_amdgcn_mfma_f32_32x32x16_bf16(PAF(3), VFR(7), o[1], 0, 0, 0), C1, 12); \
    } while (0)
    int t = 1;
#undef CMASK
#define CMASK(P0, P1, t) do {} while (0)
    for (; t + 5 < NT; t += 2) {
        STEP(pB0, pB1, pA0, pA1, t, true, true, true);     WAIT_BAR(2); RESC(); ROT();
        STEP(pA0, pA1, pB0, pB1, t + 1, true, true, true); WAIT_BAR(2); RESC(); ROT();
    }
#undef CMASK
#define CMASK(P0, P1, t) do { int jb_ = (t) - (NT - 4); if (jb_ >= 0) cmask(P0, P1, jb_, qrel, hi); } while (0)
#define ENDW(tt) do { if ((tt) + 3 < NT) { WAIT_BAR(2); } else if ((tt) + 2 < NT) { WAIT_BAR(1); } else { WAIT_BAR(0); } } while (0)
    for (; t + 1 < NT; t += 2) {
        STEP(pB0, pB1, pA0, pA1, t, (t + 3 < NT), (t + 1 < NT), (t + 1 < NT));         ENDW(t);     RESC(); ROT();
        STEP(pA0, pA1, pB0, pB1, t + 1, (t + 4 < NT), (t + 2 < NT), (t + 2 < NT));     ENDW(t + 1); RESC(); ROT();
    }
    STEP(pB0, pB1, pA0, pA1, NT - 1, false, false, false); RESC();
    { float sacc = pB0[0] + pB0[1]; _Pragma("unroll") for (int r = 2; r < 16; ++r) sacc += pB0[r]; _Pragma("unroll") for (int r = 0; r < 16; ++r) sacc += pB1[r]; l_reg += sacc;
      pw0 = (u32x4){PKW(pB0, 0), PKW(pB0, 2), PKW(pB0, 4), PKW(pB0, 6)}; pw1 = (u32x4){PKW(pB0, 8), PKW(pB0, 10), PKW(pB0, 12), PKW(pB0, 14)}; pw2 = (u32x4){PKW(pB1, 0), PKW(pB1, 2), PKW(pB1, 4), PKW(pB1, 6)}; pw3 = (u32x4){PKW(pB1, 8), PKW(pB1, 10), PKW(pB1, 12), PKW(pB1, 14)};
      SBAR(); pv(o, vb0 + sl_cur, PAF(0), PAF(1), PAF(2), PAF(3)); }
#undef PKW
#undef PAF
#undef VFR
#undef PIN
#undef MX3
#undef GAPA
#undef GAPB
#undef EX
#undef VRD
#undef KRD
#undef STEP
#undef ENDW
    { auto rr = __builtin_amdgcn_permlane32_swap(__float_as_uint(l_reg), __float_as_uint(l_reg), false, false); l_reg = __uint_as_float(rr[0]) + __uint_as_float(rr[1]); }
    if (hi == 0) wsf[32 + r32] = l_reg; asm volatile("s_waitcnt lgkmcnt(0)" ::: "memory");
    float rli[16];
#pragma unroll
    for (int r = 0; r < 16; ++r) rli[r] = __builtin_amdgcn_rcpf(wsf[32 + crow(r, hi)]);
    float* stg = (float*)(shm + LDS_OST) + wid * 2048;
    if (comp == 0) {
#pragma unroll
        for (int r = 0; r < 16; ++r) { const int orow = crow(r, hi);
#pragma unroll
            for (int d0 = 0; d0 < 2; ++d0) stg[orow * 64 + d0 * 32 + r32] = o[d0][r] * rli[r]; }
    } else {
        const float lam = P.lam;
#pragma unroll
        for (int r = 0; r < 16; ++r) { const int orow = crow(r, hi);
#pragma unroll
            for (int d0 = 0; d0 < 2; ++d0) { const int ix = orow * 64 + d0 * 32 + r32; stg[ix] = stg[ix] - lam * (o[d0][r] * rli[r]); } }
        asm volatile("s_waitcnt lgkmcnt(0)" ::: "memory");
        unsigned char* Yw = (unsigned char*)P.Y + (rowbase + q0 + wid * QBLK) * DM + h * D;
        const int ch = lane & 7;
        const f32x4 g0 = *(const f32x4*)(P.gnorm + ch * 8), g1 = *(const f32x4*)(P.gnorm + ch * 8 + 4);
#pragma unroll
        for (int i = 0; i < 4; ++i) { const int row = i * 8 + (lane >> 3);
            const f32x4 a = *(const f32x4*)(stg + row * 64 + ch * 8), c = *(const f32x4*)(stg + row * 64 + ch * 8 + 4);
            float ss = (a[0] * a[0] + a[1] * a[1]) + (a[2] * a[2] + a[3] * a[3]) + (c[0] * c[0] + c[1] * c[1]) + (c[2] * c[2] + c[3] * c[3]);
            ss += __shfl_xor(ss, 1); ss += __shfl_xor(ss, 2); ss += __shfl_xor(ss, 4);
            const float rs = __builtin_amdgcn_rsqf(ss * (1.f / 64.f) + LN_EPS) * P.osc;
            const float rq = rs * Y8S; u32x2 w; w.x = pk4_fp8(a[0] * rq * g0[0], a[1] * rq * g0[1], a[2] * rq * g0[2], a[3] * rq * g0[3]); w.y = pk4_fp8(c[0] * rq * g1[0], c[1] * rq * g1[1], c[2] * rq * g1[2], c[3] * rq * g1[3]);
            *(u32x2*)(Yw + (long)row * DM + ch * 8) = w; }
    }
    __builtin_amdgcn_s_setprio(0);
    asm volatile("s_waitcnt lgkmcnt(0)\n\ts_barrier" ::: "memory");
#undef DMA_K
#undef DMA_V
#undef CMASK
#undef START
#undef RESC
#undef ROT
}
#undef SBAR
#undef WAIT_BAR
}

struct Frame {
    LAS unsigned char* lds; volatile LAS unsigned* MISC; gu32* ctl;
    int tid, lane, wave, vcu, G;
};
struct Args {
    const float* in[29]; float* out; unsigned char* ws; int ph_lo, ph_hi;
};
enum { I_X = 0, I_C, I_POS, I_WADA, I_BADA, I_WIN, I_WOUT, I_MBI, I_MBF, I_MG, I_CONVW, I_CONVB, I_LQ1, I_LK1, I_LQ2, I_LK2, I_DG, I_WA2, I_BA, I_GG, I_LN1G, I_LN1B, I_LN2G, I_LN2B,
       I_RW, I_RB, I_EWG, I_EWU, I_EWD };

__device__ __forceinline__ void tr_item(const float* W, int ldw, int K, bf16_t* WT, int drow0, int scol, int k0, LAS float* scr, int lane) {
#pragma unroll 8
    for (int i = 0; i < 32; ++i) { const int kk = 2 * i + (lane >> 5); scr[kk * 33 + (lane & 31)] = (scol >= 0) ? W[(size_t)(k0 + kk) * ldw + scol] : 0.f; }
    LDS_WAIT(); asm volatile("" ::: "memory");
    const int c = lane & 7;
#pragma unroll
    for (int j = 0; j < 4; ++j) { const int n = (lane >> 3) + 8 * j; const LAS float* s = scr + (8 * c) * 33 + n;
        u32x4 o; o.x = pk2(s[0 * 33], s[1 * 33]); o.y = pk2(s[2 * 33], s[3 * 33]); o.z = pk2(s[4 * 33], s[5 * 33]); o.w = pk2(s[6 * 33], s[7 * 33]);
        *(GAS u32x4*)(WT + (size_t)(drow0 + n) * K + k0 + 8 * c) = o; }
    LDS_WAIT(); asm volatile("" ::: "memory");
}
__device__ __forceinline__ void tr_item4(const float* W, int ldw, int K, bf16_t* WT, int drow0, int scol0, int k0, LAS float* scr, int lane, float wsc = 1.f) {
    const int kq = lane >> 3, nq = (lane & 7) * 4;
    f32x4 v[8];
#pragma unroll
    for (int i = 0; i < 8; ++i) v[i] = *(const f32x4*)(W + (size_t)(k0 + i * 8 + kq) * ldw + scol0 + nq);
#pragma unroll
    for (int i = 0; i < 8; ++i) { LAS float* d = scr + (i * 8 + kq) * 33 + nq; d[0] = v[i][0] * wsc; d[1] = v[i][1] * wsc; d[2] = v[i][2] * wsc; d[3] = v[i][3] * wsc; }
    LDS_WAIT(); asm volatile("" ::: "memory");
    const int c = lane & 7;
#pragma unroll
    for (int j = 0; j < 4; ++j) { const int n = (lane >> 3) + 8 * j; const LAS float* s = scr + (8 * c) * 33 + n;
        u32x4 o; o.x = pk2(s[0 * 33], s[1 * 33]); o.y = pk2(s[2 * 33], s[3 * 33]); o.z = pk2(s[4 * 33], s[5 * 33]); o.w = pk2(s[6 * 33], s[7 * 33]);
        *(GAS u32x4*)(WT + (size_t)(drow0 + n) * K + k0 + 8 * c) = o; }
    LDS_WAIT(); asm volatile("" ::: "memory");
}
struct TrD { const float* src; bf16_t* dst; unsigned char* dst8; int ldw, K, drow0, k0; float wsc; };
__device__ __forceinline__ void tr_load4(const TrD& d, f32x4 (&v)[8], int lane) {
    const int kq = lane >> 3, nq = (lane & 7) * 4;
#pragma unroll
    for (int i = 0; i < 8; ++i) v[i] = *(const f32x4*)(d.src + (size_t)(i * 8 + kq) * d.ldw + nq);
}
__device__ __forceinline__ void tr_finish4(const TrD& d, const f32x4 (&v)[8], LAS float* scr, int lane) {
    const int kq = lane >> 3, nq = (lane & 7) * 4;
#pragma unroll
    for (int i = 0; i < 8; ++i) { LAS float* p = scr + (i * 8 + kq) * 33 + nq; p[0] = v[i][0] * d.wsc; p[1] = v[i][1] * d.wsc; p[2] = v[i][2] * d.wsc; p[3] = v[i][3] * d.wsc; }
    LDS_WAIT(); asm volatile("" ::: "memory");
    const int c = lane & 7;
#pragma unroll
    for (int j = 0; j < 4; ++j) { const int n = (lane >> 3) + 8 * j; const LAS float* s = scr + (8 * c) * 33 + n;
        u32x4 o; o.x = pk2(s[0 * 33], s[1 * 33]); o.y = pk2(s[2 * 33], s[3 * 33]); o.z = pk2(s[4 * 33], s[5 * 33]); o.w = pk2(s[6 * 33], s[7 * 33]);
        *(GAS u32x4*)(d.dst + (size_t)(d.drow0 + n) * d.K + d.k0 + 8 * c) = o; }
    LDS_WAIT(); asm volatile("" ::: "memory");
}
__device__ __forceinline__ void tr_finish8(const TrD& d, const f32x4 (&v)[8], LAS float* scr, int lane) {
    const int kq = lane >> 3, nq = (lane & 7) * 4;
#pragma unroll
    for (int i = 0; i < 8; ++i) { LAS float* p = scr + (i * 8 + kq) * 33 + nq; p[0] = v[i][0] * d.wsc; p[1] = v[i][1] * d.wsc; p[2] = v[i][2] * d.wsc; p[3] = v[i][3] * d.wsc; }
    LDS_WAIT(); asm volatile("" ::: "memory");
    const int c = lane & 7; unsigned char* dst8 = (unsigned char*)d.dst;
#pragma unroll
    for (int j = 0; j < 4; ++j) { const int n = (lane >> 3) + 8 * j; const LAS float* s = scr + (8 * c) * 33 + n;
        u32x2 o; o.x = pk4_fp8(s[0 * 33], s[1 * 33], s[2 * 33], s[3 * 33]); o.y = pk4_fp8(s[4 * 33], s[5 * 33], s[6 * 33], s[7 * 33]);
        *(GAS u32x2*)(dst8 + (size_t)(d.drow0 + n) * d.K + d.k0 + 8 * c) = o; }
    LDS_WAIT(); asm volatile("" ::: "memory");
}
template <int NTL>
__device__ __forceinline__ void rows16_mm(f32x4 (&acc)[NTL], const bf16_t* A, const LAS bf16_t* Bt, int pitch, int lane) {
    const int lr = lane & 15, lq = lane >> 4;
    const bf16_t* ap = A + (size_t)lr * 1024 + lq * 8;
#pragma unroll 8
    for (int ks = 0; ks < 32; ++ks) {
        const bf16x8 a = *(const bf16x8*)(ap + ks * 32);
#pragma unroll
        for (int t = 0; t < NTL; ++t) { const bf16x8 b = *(const LAS bf16x8*)(Bt + (t * 16 + lr) * pitch + ks * 32 + lq * 8); acc[t] = __builtin_amdgcn_mfma_f32_16x16x32_bf16(a, b, acc[t], 0, 0, 0); }
    }
}
constexpr int TBP = 1056;
__device__ __forceinline__ void tail16(const bf16_t* Urow0, const LAS bf16_t* Wt, float* tail_row0, int lane) {
    f32x4 acc[2] = {(f32x4){0.f, 0.f, 0.f, 0.f}, (f32x4){0.f, 0.f, 0.f, 0.f}};
    rows16_mm<2>(acc, Urow0, Wt, TBP, lane);
    const int lr = lane & 15, lq = lane >> 4;
#pragma unroll
    for (int t = 0; t < 2; ++t)
#pragma unroll
        for (int r = 0; r < 4; ++r) tail_row0[(size_t)(lq * 4 + r) * 32 + t * 16 + lr] = acc[t][r];
}
__device__ __forceinline__ void load_tail_w(LAS bf16_t* Wt, const bf16_t* Wtail  , int tid) {
    for (int p = tid; p < 32 * 128; p += 512) { const int n = p >> 7, c = p & 127; *(LAS u32x4*)(Wt + n * TBP + c * 8) = *(const u32x4*)(Wtail + (size_t)n * 1024 + c * 8); }
}
constexpr int NSP = 1032;
constexpr int NMM_P_OFF = 32 * NSP * 2, NMM_LG_OFF = NMM_P_OFF + 8 * 1024 * 4;
struct NarrowT { bf16x8 bw[4][2]; };
__device__ __forceinline__ void nmm_load_tail(NarrowT& T, const bf16_t* Wtail  , int wid, int lane) {
    const int lr = lane & 15, lq = lane >> 4;
#pragma unroll
    for (int ks = 0; ks < 4; ++ks)
#pragma unroll
        for (int t = 0; t < 2; ++t) T.bw[ks][t] = *(const bf16x8*)(Wtail + (size_t)(t * 16 + lr) * 1024 + wid * 128 + ks * 32 + lq * 8);
}
__device__ __forceinline__ void nmm_load_router(NarrowT& T, const float* rw  , int wid, int lane) {
    const int lr = lane & 15, lq = lane >> 4;
#pragma unroll
    for (int ks = 0; ks < 4; ++ks) { u32x4 hi, lo;
#pragma unroll
        for (int i = 0; i < 4; ++i) { const int k = wid * 128 + ks * 32 + lq * 8 + 2 * i; const float w0 = rw[(size_t)k * 16 + lr], w1 = rw[(size_t)(k + 1) * 16 + lr];
            const unsigned h0 = f2bf(w0), h1 = f2bf(w1); hi[i] = h0 | (h1 << 16); lo[i] = f2bf(w0 - bf2f(h0)) | (f2bf(w1 - bf2f(h1)) << 16); }
        T.bw[ks][0] = __builtin_bit_cast(bf16x8, hi); T.bw[ks][1] = __builtin_bit_cast(bf16x8, lo); }
}
__device__ __forceinline__ void nmm_partials(const NarrowT& T, const LAS bf16_t* S, LAS float* Pb, int wid, int lane) {
    asm volatile("s_waitcnt lgkmcnt(0)\n\ts_barrier" ::: "memory");
    const int lr = lane & 15, lq = lane >> 4;
    f32x4 acc[2][2];
#pragma unroll
    for (int m = 0; m < 2; ++m)
#pragma unroll
        for (int t = 0; t < 2; ++t) acc[m][t] = (f32x4){0.f, 0.f, 0.f, 0.f};
#pragma unroll
    for (int m = 0; m < 2; ++m)
#pragma unroll
        for (int ks = 0; ks < 4; ++ks) { const bf16x8 a = *(const LAS bf16x8*)(S + (16 * m + lr) * NSP + wid * 128 + ks * 32 + lq * 8);
#pragma unroll
            for (int t = 0; t < 2; ++t) acc[m][t] = __builtin_amdgcn_mfma_f32_16x16x32_bf16(a, T.bw[ks][t], acc[m][t], 0, 0, 0); }
#pragma unroll
    for (int m = 0; m < 2; ++m)
#pragma unroll
        for (int t = 0; t < 2; ++t)
#pragma unroll
            for (int r = 0; r < 4; ++r) Pb[wid * 1024 + (16 * m + 4 * lq + r) * 32 + t * 16 + lr] = acc[m][t][r];
    asm volatile("s_waitcnt lgkmcnt(0)\n\ts_barrier" ::: "memory");
}
__device__ __forceinline__ void nmm_step_tail(const NarrowT& T, const LAS bf16_t* S, LAS float* Pb, float* tail_wg  , int i0, int tid, int wid, int lane) {
    nmm_partials(T, S, Pb, wid, lane);
#pragma unroll
    for (int q = 0; q < 2; ++q) { const int o = tid + 512 * q, sr = o >> 5, col = o & 31; float s = 0.f;
#pragma unroll
        for (int w = 0; w < 8; ++w) s += Pb[w * 1024 + o];
        tail_wg[(size_t)((sr >> 2) * 16 + i0 + (sr & 3)) * 32 + col] = s; }
}
__device__ __forceinline__ void nmm_step_router(const NarrowT& T, const LAS bf16_t* S, LAS float* Pb, LAS float* lgs  , int i0, int tid, int wid, int lane) {
    nmm_partials(T, S, Pb, wid, lane);
    { const int sr = tid >> 4, e = tid & 15; float s = 0.f;
#pragma unroll
      for (int w = 0; w < 8; ++w) s += Pb[w * 1024 + sr * 32 + e] + Pb[w * 1024 + sr * 32 + 16 + e];
      lgs[(sr >> 2) * 256 + (i0 + (sr & 3)) * 16 + e] = s; }
}
__device__ __forceinline__ int win_src_col(int n) {
    if (n < 1024) return n;
    if (n < 3584) return n + 8;
    const int i = n - 3584;
    if (i < 16) return 3592 + i;
    if (i < 20) return 1024 + (i - 16);
    if (i < 24) return 1028 + (i - 20);
    return -1;
}

namespace rec {
constexpr int PT = 72;
constexpr int TB = 64 * PT * 2;
constexpr int OFF_T0 = 0, OFF_T1 = TB, OFF_T2 = 2 * TB, OFF_T3 = 3 * TB, OFF_T4 = 4 * TB, OFF_T5 = 5 * TB;
constexpr int OFF_BM = 6 * TB;
constexpr int OFF_HM = OFF_BM + 16384;
constexpr int OFF_VEC = OFF_HM + 64 * 68 * 4;
constexpr int V_G = 0, V_M = 64, V_WI = 128, V_EM = 192, V_DI = 256, V_N = 320, V_BE = 384, V_SEG = 448, V_GA = 960;
static_assert(OFF_VEC + (960 + 1024) * 4 <= RING_BYTES, "rec LDS");

__device__ __forceinline__ void mm64(f32x4 (&acc)[2], const LAS bf16_t* A, const LAS bf16_t* Bt, int wid, int lane) {
    const int tm = wid >> 1, tn0 = (wid & 1) * 2, lr = lane & 15, lq = lane >> 4;
#pragma unroll
    for (int ks = 0; ks < 2; ++ks) {
        const bf16x8 a = *(const LAS bf16x8*)(A + (tm * 16 + lr) * PT + ks * 32 + lq * 8);
#pragma unroll
        for (int t = 0; t < 2; ++t) { const bf16x8 b = *(const LAS bf16x8*)(Bt + ((tn0 + t) * 16 + lr) * PT + ks * 32 + lq * 8);
            acc[t] = __builtin_amdgcn_mfma_f32_16x16x32_bf16(a, b, acc[t], 0, 0, 0); }
    }
}
__device__ __forceinline__ float scan_add(float v, int lane) {
#pragma unroll
    for (int o = 1; o < 64; o <<= 1) { const float t = __shfl_up(v, o); if (lane >= o) v += t; }
    return v;
}
__device__ __forceinline__ float scan_max(float v, int lane) {
#pragma unroll
    for (int o = 1; o < 64; o <<= 1) { const float t = __shfl_up(v, o); if (lane >= o) v = fmaxf(v, t); }
    return v;
}
__device__ __forceinline__ void st_tr8(LAS bf16_t* T, int l, int ch, u32x4 w) {
    T[(ch * 8 + 0) * PT + l] = (bf16_t)(w.x & 0xffffu); T[(ch * 8 + 1) * PT + l] = (bf16_t)(w.x >> 16);
    T[(ch * 8 + 2) * PT + l] = (bf16_t)(w.y & 0xffffu); T[(ch * 8 + 3) * PT + l] = (bf16_t)(w.y >> 16);
    T[(ch * 8 + 4) * PT + l] = (bf16_t)(w.z & 0xffffu); T[(ch * 8 + 5) * PT + l] = (bf16_t)(w.z >> 16);
    T[(ch * 8 + 6) * PT + l] = (bf16_t)(w.w & 0xffffu); T[(ch * 8 + 7) * PT + l] = (bf16_t)(w.w >> 16);
}
__device__ __forceinline__ void unpack8(u32x4 w, float (&f)[8]) {
    f[0] = bflo(w.x); f[1] = bfhi(w.x); f[2] = bflo(w.y); f[3] = bfhi(w.y); f[4] = bflo(w.z); f[5] = bfhi(w.z); f[6] = bflo(w.w); f[7] = bfhi(w.w);
}
template <int GATE  >
__device__ __forceinline__ void finalize(const LAS float* HM, const LAS float* rowscale, const float* gnorm, const bf16_t* gate, bf16_t* out, int tid) {
    const int j = tid >> 3, ch = tid & 7;
    const f32x4 a = *(const LAS f32x4*)(HM + j * 68 + ch * 8), c = *(const LAS f32x4*)(HM + j * 68 + ch * 8 + 4);
    const float rsc = rowscale ? rowscale[j] : 1.f;
    float v[8] = {a[0] * rsc, a[1] * rsc, a[2] * rsc, a[3] * rsc, c[0] * rsc, c[1] * rsc, c[2] * rsc, c[3] * rsc};
    float ss = 0.f;
#pragma unroll
    for (int i = 0; i < 8; ++i) ss += v[i] * v[i];
    ss += __shfl_xor(ss, 1); ss += __shfl_xor(ss, 2); ss += __shfl_xor(ss, 4);
    const float rs = __builtin_amdgcn_rsqf(ss * (1.f / 64.f) + LN_EPS);
    const u32x4 gw = *(const u32x4*)(gate + (size_t)j * PJ + ch * 8);
    float gt[8]; unpack8(gw, gt);
    const f32x4 g0 = *(const f32x4*)(gnorm + ch * 8), g1 = *(const f32x4*)(gnorm + ch * 8 + 4);
    const float gn[8] = {g0[0], g0[1], g0[2], g0[3], g1[0], g1[1], g1[2], g1[3]};
    float y[8];
#pragma unroll
    for (int i = 0; i < 8; ++i) { const float sg = 1.f / (1.f + fexp(-gt[i])); const float gv = GATE ? gt[i] * sg : sg; y[i] = v[i] * rs * gn[i] * gv; }
    u32x4 w; w.x = pk2(y[0], y[1]); w.y = pk2(y[2], y[3]); w.z = pk2(y[4], y[5]); w.w = pk2(y[6], y[7]);
    *(u32x4*)(out + (size_t)j * DM + ch * 8) = w;
}

struct RecP {
    const bf16_t* proj; const float* tail; const bf16_t* csm; const bf16_t* csg; float* stm; float* stg; float* smN; float* smBC; float* smDM; float* smMS; float* smGBE; bf16_t* ycat;
    const float* mbi; const float* mbf; const float* mg; const float* wa2; const float* ba; const float* gg;
};

struct MLoc { u32x4 k, v; float mi, mf; };
struct MOut { u32x4 q, k, v, st, mo; float mi, mf, m, n; };
struct GLoc { u32x4 k, v; f32x4 ga; };
struct GOut { u32x4 q, k, v, st, gr; f32x4 ga; };
struct GW { float wv[16]; float bav; };

__device__ __forceinline__ void ld_mloc(MLoc& L, const RecP& P, int ci, int tid, int wid, int lane) {
    const int bh = ci >> 6, c = ci & 63, b = bh >> 2, h = bh & 3, row0 = b * SEQ + c * 64, l = tid >> 3, ch = tid & 7;
    const bf16_t* pr = P.proj + (size_t)(row0 + l) * PJ + h * 64 + ch * 8;
    L.k = *(const u32x4*)(pr + C_MK); L.v = *(const u32x4*)(pr + C_MV);
    if (wid == 0) { const float* tp = P.tail + (size_t)(row0 + lane) * 32; L.mi = tp[T_MI + h]; L.mf = tp[T_MF + h]; } else { L.mi = 0.f; L.mf = 0.f; }
}
__device__ __forceinline__ void ld_mout(MOut& L, const RecP& P, int ci, int tid, int wid, int lane) {
    const int bh = ci >> 6, c = ci & 63, b = bh >> 2, h = bh & 3, row0 = b * SEQ + c * 64, l = tid >> 3, ch = tid & 7;
    const bf16_t* pr = P.proj + (size_t)(row0 + l) * PJ + h * 64 + ch * 8;
    L.q = *(const u32x4*)(pr + C_MQ); L.k = *(const u32x4*)(pr + C_MK); L.v = *(const u32x4*)(pr + C_MV); L.mo = *(const u32x4*)(pr + C_MO);
    L.st = *(const u32x4*)(P.csm + (size_t)ci * 4096 + l * 64 + ch * 8);
    if (wid == 0) { const float* tp = P.tail + (size_t)(row0 + lane) * 32; L.mi = tp[T_MI + h]; L.mf = tp[T_MF + h]; L.m = P.smMS[ci]; L.n = P.smN[(size_t)ci * 64 + lane]; } else { L.mi = 0.f; L.mf = 0.f; L.m = 0.f; L.n = 0.f; }
}
__device__ __forceinline__ void ld_gloc(GLoc& L, const RecP& P, int ci, int tid) {
    const int bh = ci >> 6, c = ci & 63, b = bh >> 2, h = bh & 3, row0 = b * SEQ + c * 64, l = tid >> 3, ch = tid & 7;
    const bf16_t* pr = P.proj + (size_t)(row0 + l) * PJ + h * 64 + ch * 8;
    L.k = *(const u32x4*)(pr + C_GK); L.v = *(const u32x4*)(pr + C_GV);
    L.ga = (tid < 256) ? *(const f32x4*)(P.tail + (size_t)(row0 + (tid >> 2)) * 32 + T_GA + (tid & 3) * 4) : (f32x4){0.f, 0.f, 0.f, 0.f};
}
__device__ __forceinline__ void ld_gout(GOut& L, const RecP& P, int ci, int tid) {
    const int bh = ci >> 6, c = ci & 63, b = bh >> 2, h = bh & 3, row0 = b * SEQ + c * 64, l = tid >> 3, ch = tid & 7;
    const bf16_t* pr = P.proj + (size_t)(row0 + l) * PJ + h * 64 + ch * 8;
    L.q = *(const u32x4*)(pr + C_GQ); L.k = *(const u32x4*)(pr + C_GK); L.v = *(const u32x4*)(pr + C_GV); L.gr = *(const u32x4*)(pr + C_GR);
    L.st = *(const u32x4*)(P.csg + (size_t)ci * 4096 + l * 64 + ch * 8);
    L.ga = (tid < 256) ? *(const f32x4*)(P.tail + (size_t)(row0 + (tid >> 2)) * 32 + T_GA + (tid & 3) * 4) : (f32x4){0.f, 0.f, 0.f, 0.f};
}
__device__ __forceinline__ void ld_gw(GW& W, const RecP& P, int h, int tid) {
    const int dcol = tid & 63;
#pragma unroll
    for (int r = 0; r < 16; ++r) W.wv[r] = P.wa2[r * 256 + h * 64 + dcol];
    W.bav = P.ba[h * 64 + dcol];
}
template <int GATE  >
__device__ __forceinline__ void finalize2(const LAS float* HM, const LAS float* rowscale, const float* gnorm, u32x4 gw, bf16_t* out, int tid) {
    const int j = tid >> 3, ch = tid & 7;
    const f32x4 a = *(const LAS f32x4*)(HM + j * 68 + ch * 8), c = *(const LAS f32x4*)(HM + j * 68 + ch * 8 + 4);
    const float rsc = rowscale ? rowscale[j] : 1.f;
    float v[8] = {a[0] * rsc, a[1] * rsc, a[2] * rsc, a[3] * rsc, c[0] * rsc, c[1] * rsc, c[2] * rsc, c[3] * rsc};
    float ss = 0.f;
#pragma unroll
    for (int i = 0; i < 8; ++i) ss += v[i] * v[i];
    ss += __shfl_xor(ss, 1); ss += __shfl_xor(ss, 2); ss += __shfl_xor(ss, 4);
    const float rs = __builtin_amdgcn_rsqf(ss * (1.f / 64.f) + LN_EPS);
    float gt[8]; unpack8(gw, gt);
    const f32x4 g0 = *(const f32x4*)(gnorm + ch * 8), g1 = *(const f32x4*)(gnorm + ch * 8 + 4);
    const float gn[8] = {g0[0], g0[1], g0[2], g0[3], g1[0], g1[1], g1[2], g1[3]};
    float y[8];
#pragma unroll
    for (int i = 0; i < 8; ++i) { const float sg = 1.f / (1.f + fexp(-gt[i])); const float gv = GATE ? gt[i] * sg : sg; y[i] = v[i] * rs * gn[i] * gv; }
    u32x4 w; w.x = pk2(y[0], y[1]); w.y = pk2(y[2], y[3]); w.z = pk2(y[4], y[5]); w.w = pk2(y[6], y[7]);
    *(u32x4*)(out + (size_t)j * DM + ch * 8) = w;
}
__device__ __forceinline__ void mlstm_local(const MLoc& L, const RecP& P, LAS unsigned char* lds, int ci, int tid, int wid, int lane) {
    const int h = (ci >> 6) & 3;
    LAS bf16_t* KT = (LAS bf16_t*)(lds + OFF_T0); LAS bf16_t* VT = (LAS bf16_t*)(lds + OFF_T1); LAS float* vec = (LAS float*)(lds + OFF_VEC);
    const int l = tid >> 3, ch = tid & 7;
    if (wid == 0) {
        const float li = L.mi + P.mbi[h], lf = logsig(L.mf + P.mbf[h]);
        const float bc = scan_add(lf, lane), g = li - bc;
        const float gmax = wave_max(g), bend = __shfl(bc, 63);
        vec[V_G + lane] = fexp(g - gmax);
        if (lane == 0) { P.smBC[ci] = bend; P.smDM[ci] = bend + gmax; }
    }
    __syncthreads();
    { const float w = vec[V_G + l]; float kf[8]; unpack8(L.k, kf);
      u32x4 ks; ks.x = pk2(kf[0] * w, kf[1] * w); ks.y = pk2(kf[2] * w, kf[3] * w); ks.z = pk2(kf[4] * w, kf[5] * w); ks.w = pk2(kf[6] * w, kf[7] * w);
      st_tr8(KT, l, ch, ks); st_tr8(VT, l, ch, L.v); }
    __syncthreads();
    f32x4 acc[2] = {(f32x4){0.f, 0.f, 0.f, 0.f}, (f32x4){0.f, 0.f, 0.f, 0.f}};
    mm64(acc, VT, KT, wid, lane);
    { const int tm = wid >> 1, tn0 = (wid & 1) * 2, lr = lane & 15, lq = lane >> 4; float* dst = P.stm + (size_t)ci * 4096;
#pragma unroll
      for (int t = 0; t < 2; ++t)
#pragma unroll
          for (int r = 0; r < 4; ++r) dst[(tm * 16 + lq * 4 + r) * 64 + (tn0 + t) * 16 + lr] = acc[t][r]; }
    if (tid < 64) { float s = 0.f;
#pragma unroll
        for (int q = 0; q < 8; ++q) { const u32x4 w = *(const LAS u32x4*)(KT + tid * PT + q * 8); float f[8]; unpack8(w, f);
#pragma unroll
            for (int i = 0; i < 8; ++i) s += f[i]; }
        P.smN[(size_t)ci * 64 + tid] = s; }
    __syncthreads();
}
__device__ __forceinline__ void mlstm_out(const MOut& L, const RecP& P, LAS unsigned char* lds, int ci, int tid, int wid, int lane) {
    const int bh = ci >> 6, c = ci & 63, b = bh >> 2, h = bh & 3, row0 = b * SEQ + c * 64;
    LAS bf16_t* Qm = (LAS bf16_t*)(lds + OFF_T0); LAS bf16_t* Km = (LAS bf16_t*)(lds + OFF_T1); LAS bf16_t* VT = (LAS bf16_t*)(lds + OFF_T2);
    LAS bf16_t* CT = (LAS bf16_t*)(lds + OFF_T3); LAS bf16_t* Sm = (LAS bf16_t*)(lds + OFF_T4);
    LAS float* HM = (LAS float*)(lds + OFF_HM); LAS float* vec = (LAS float*)(lds + OFF_VEC);
    const int l = tid >> 3, ch = tid & 7;
    *(LAS u32x4*)(Qm + l * PT + ch * 8) = L.q; *(LAS u32x4*)(Km + l * PT + ch * 8) = L.k; st_tr8(VT, l, ch, L.v); *(LAS u32x4*)(CT + l * PT + ch * 8) = L.st;
    if (wid == 0) {
        const float li = L.mi + P.mbi[h], lf = logsig(L.mf + P.mbf[h]);
        const float bc = scan_add(lf, lane), g = li - bc;
        const float pm = scan_max(g, lane), m = L.m, M = fmaxf(m, pm);
        vec[V_G + lane] = g; vec[V_M + lane] = M; vec[V_WI + lane] = fexp(m - M); vec[V_EM + lane] = fexp(-bc - M);
        vec[V_N + lane] = L.n;
    }
    __syncthreads();
    { f32x4 acc[2] = {(f32x4){0.f, 0.f, 0.f, 0.f}, (f32x4){0.f, 0.f, 0.f, 0.f}};
      mm64(acc, Qm, Km, wid, lane);
      const int tm = wid >> 1, tn0 = (wid & 1) * 2, lr = lane & 15, lq = lane >> 4;
#pragma unroll
      for (int t = 0; t < 2; ++t) { const int ll = (tn0 + t) * 16 + lr; const float gl = vec[V_G + ll];
#pragma unroll
          for (int r = 0; r < 4; ++r) { const int j = tm * 16 + lq * 4 + r; const float s = (ll <= j) ? acc[t][r] * fexp(gl - vec[V_M + j]) : 0.f; Sm[j * PT + ll] = (bf16_t)f2bf(s); } } }
    __syncthreads();
    { f32x4 a1[2] = {(f32x4){0.f, 0.f, 0.f, 0.f}, (f32x4){0.f, 0.f, 0.f, 0.f}}, a2[2] = {(f32x4){0.f, 0.f, 0.f, 0.f}, (f32x4){0.f, 0.f, 0.f, 0.f}};
      mm64(a1, Sm, VT, wid, lane); mm64(a2, Qm, CT, wid, lane);
      const int tm = wid >> 1, tn0 = (wid & 1) * 2, lr = lane & 15, lq = lane >> 4;
#pragma unroll
      for (int t = 0; t < 2; ++t)
#pragma unroll
          for (int r = 0; r < 4; ++r) { const int j = tm * 16 + lq * 4 + r; HM[j * 68 + (tn0 + t) * 16 + lr] = a1[t][r] + vec[V_WI + j] * a2[t][r]; } }
    if (tid < 64) { float ds = 0.f, qn = 0.f;
#pragma unroll
        for (int q = 0; q < 8; ++q) { const u32x4 w = *(const LAS u32x4*)(Sm + tid * PT + q * 8); float f[8]; unpack8(w, f);
            const u32x4 qw = *(const LAS u32x4*)(Qm + tid * PT + q * 8); float qf[8]; unpack8(qw, qf);
#pragma unroll
            for (int i = 0; i < 8; ++i) { ds += f[i]; qn += qf[i] * vec[V_N + q * 8 + i]; } }
        const float den = ds + vec[V_WI + tid] * qn;
        vec[V_DI + tid] = 1.f / fmaxf(fabsf(den), vec[V_EM + tid]); }
    __syncthreads();
    finalize2<0>(HM, vec + V_DI, P.mg, L.mo, P.ycat + (size_t)row0 * DM + h * 64, tid);
    __syncthreads();
}
__device__ __forceinline__ void gla_bmat(const f32x4 ga, const GW& W, LAS unsigned char* lds, int tid, int wid) {
    LAS float* BM = (LAS float*)(lds + OFF_BM); LAS float* vec = (LAS float*)(lds + OFF_VEC);
    if (tid < 256) { const int l = tid >> 2, q = tid & 3; vec[V_GA + l * 16 + q * 4 + 0] = ga[0]; vec[V_GA + l * 16 + q * 4 + 1] = ga[1]; vec[V_GA + l * 16 + q * 4 + 2] = ga[2]; vec[V_GA + l * 16 + q * 4 + 3] = ga[3]; }
    const int dcol = tid & 63;
    __syncthreads();
    float cs[8]; float cacc = 0.f;
#pragma unroll
    for (int i = 0; i < 8; ++i) { const int l = wid * 8 + i; float z = W.bav;
#pragma unroll
        for (int r = 0; r < 16; ++r) z += vec[V_GA + l * 16 + r] * W.wv[r];
        cacc += logsig(z) * (1.f / 16.f); cs[i] = cacc; }
    vec[V_SEG + wid * 64 + dcol] = cacc;
    __syncthreads();
    float off = 0.f, tot = 0.f;
#pragma unroll
    for (int s = 0; s < 8; ++s) { const float v = vec[V_SEG + s * 64 + dcol]; tot += v; if (s < wid) off += v; }
#pragma unroll
    for (int i = 0; i < 8; ++i) BM[(wid * 8 + i) * 64 + dcol] = off + cs[i];
    if (wid == 0) vec[V_BE + dcol] = tot;
    __syncthreads();
}
__device__ __forceinline__ void gla_local(const GLoc& L, const GW& W, const RecP& P, LAS unsigned char* lds, int ci, int tid, int wid, int lane) {
    LAS bf16_t* KT = (LAS bf16_t*)(lds + OFF_T0); LAS bf16_t* VT = (LAS bf16_t*)(lds + OFF_T1);
    LAS float* BM = (LAS float*)(lds + OFF_BM); LAS float* vec = (LAS float*)(lds + OFF_VEC);
    const int l = tid >> 3, ch = tid & 7;
    gla_bmat(L.ga, W, lds, tid, wid);
    if (tid < 64) P.smGBE[(size_t)ci * 64 + tid] = vec[V_BE + tid];
    { float kf[8]; unpack8(L.k, kf); float ks[8];
#pragma unroll
      for (int i = 0; i < 8; ++i) { const int d = ch * 8 + i; ks[i] = kf[i] * fexp(vec[V_BE + d] - BM[l * 64 + d]); }
      u32x4 kk; kk.x = pk2(ks[0], ks[1]); kk.y = pk2(ks[2], ks[3]); kk.z = pk2(ks[4], ks[5]); kk.w = pk2(ks[6], ks[7]);
      st_tr8(KT, l, ch, kk); st_tr8(VT, l, ch, L.v); }
    __syncthreads();
    f32x4 acc[2] = {(f32x4){0.f, 0.f, 0.f, 0.f}, (f32x4){0.f, 0.f, 0.f, 0.f}};
    mm64(acc, VT, KT, wid, lane);
    { const int tm = wid >> 1, tn0 = (wid & 1) * 2, lr = lane & 15, lq = lane >> 4; float* dst = P.stg + (size_t)ci * 4096;
#pragma unroll
      for (int t = 0; t < 2; ++t)
#pragma unroll
          for (int r = 0; r < 4; ++r) dst[(tm * 16 + lq * 4 + r) * 64 + (tn0 + t) * 16 + lr] = acc[t][r]; }
    __syncthreads();
}
__device__ __forceinline__ void gla_out(const GOut& L, const GW& W, const RecP& P, LAS unsigned char* lds, int ci, int tid, int wid, int lane) {
    const int bh = ci >> 6, c = ci & 63, b = bh >> 2, h = bh & 3, row0 = b * SEQ + c * 64;
    LAS bf16_t* Qm = (LAS bf16_t*)(lds + OFF_T0); LAS bf16_t* Km = (LAS bf16_t*)(lds + OFF_T1); LAS bf16_t* VT = (LAS bf16_t*)(lds + OFF_T2);
    LAS bf16_t* ST = (LAS bf16_t*)(lds + OFF_T3); LAS bf16_t* Sm = (LAS bf16_t*)(lds + OFF_T4);
    LAS float* BM = (LAS float*)(lds + OFF_BM); LAS float* HM = (LAS float*)(lds + OFF_HM);
    const int l = tid >> 3, ch = tid & 7;
    gla_bmat(L.ga, W, lds, tid, wid);
    { float qf[8], kf[8]; unpack8(L.q, qf); unpack8(L.k, kf); float qs[8], ks[8];
#pragma unroll
      for (int i = 0; i < 8; ++i) { const float bv = BM[l * 64 + ch * 8 + i]; qs[i] = qf[i] * fexp(bv); ks[i] = kf[i] * fexp(-bv); }
      u32x4 qq, kk; qq.x = pk2(qs[0], qs[1]); qq.y = pk2(qs[2], qs[3]); qq.z = pk2(qs[4], qs[5]); qq.w = pk2(qs[6], qs[7]);
      kk.x = pk2(ks[0], ks[1]); kk.y = pk2(ks[2], ks[3]); kk.z = pk2(ks[4], ks[5]); kk.w = pk2(ks[6], ks[7]);
      *(LAS u32x4*)(Qm + l * PT + ch * 8) = qq; *(LAS u32x4*)(Km + l * PT + ch * 8) = kk; st_tr8(VT, l, ch, L.v);
      *(LAS u32x4*)(ST + l * PT + ch * 8) = L.st; }
    __syncthreads();
    { f32x4 acc[2] = {(f32x4){0.f, 0.f, 0.f, 0.f}, (f32x4){0.f, 0.f, 0.f, 0.f}};
      mm64(acc, Qm, Km, wid, lane);
      const int tm = wid >> 1, tn0 = (wid & 1) * 2, lr = lane & 15, lq = lane >> 4;
#pragma unroll
      for (int t = 0; t < 2; ++t) { const int ll = (tn0 + t) * 16 + lr;
#pragma unroll
          for (int r = 0; r < 4; ++r) { const int j = tm * 16 + lq * 4 + r; Sm[j * PT + ll] = (bf16_t)f2bf((ll <= j) ? acc[t][r] : 0.f); } } }
    __syncthreads();
    { f32x4 acc[2] = {(f32x4){0.f, 0.f, 0.f, 0.f}, (f32x4){0.f, 0.f, 0.f, 0.f}};
      mm64(acc, Sm, VT, wid, lane); mm64(acc, Qm, ST, wid, lane);
      const int tm = wid >> 1, tn0 = (wid & 1) * 2, lr = lane & 15, lq = lane >> 4;
#pragma unroll
      for (int t = 0; t < 2; ++t)
#pragma unroll
          for (int r = 0; r < 4; ++r) HM[(tm * 16 + lq * 4 + r) * 68 + (tn0 + t) * 16 + lr] = acc[t][r]; }
    __syncthreads();
    finalize2<1>(HM, nullptr, P.gg, L.gr, P.ycat + (size_t)row0 * DM + 768 + h * 64, tid);
    __syncthreads();
}
}

namespace recw {
using rec::RecP; using rec::scan_add; using rec::scan_max; using rec::unpack8;
typedef short s16x4v __attribute__((ext_vector_type(4)));
typedef short v4i16_t __attribute__((ext_vector_type(4)));
#define MF16(a, b, c) __builtin_amdgcn_mfma_f32_16x16x32_bf16((a), (b), (c), 0, 0, 0)
__device__ __forceinline__ s16x4v tr16(const LAS bf16_t* p) { return __builtin_bit_cast(s16x4v, __builtin_amdgcn_ds_read_tr16_b64_v4i16((LAS v4i16_t*)p)); }
__device__ __forceinline__ bf16x8 trfrag(const LAS bf16_t* T, int pitch, int s, int c0, int lane) {
    const int i = lane & 15, q = lane >> 4;
    const LAS bf16_t* pa = T + (32 * s + 4 * q + (i >> 2)) * pitch + c0 + 4 * (i & 3);
    const s16x4v lo = tr16(pa), hi = tr16(pa + 16 * pitch);
    return (bf16x8){lo[0], lo[1], lo[2], lo[3], hi[0], hi[1], hi[2], hi[3]};
}
__device__ __forceinline__ bf16x8 rfg(const bf16_t* X, int pitch, int T, int ks, int lane) { return *(const bf16x8*)(X + (size_t)(16 * T + (lane & 15)) * pitch + 32 * ks + 8 * (lane >> 4)); }
__device__ __forceinline__ u32x4 piece(const bf16_t* X, int pitch, int i, int lane) { return *(const u32x4*)(X + (size_t)((lane >> 3) + 8 * i) * pitch + (lane & 7) * 8); }
__device__ __forceinline__ bf16x8 frag_scale(bf16x8 f, float sc) {
    const u32x4 w = __builtin_bit_cast(u32x4, f); u32x4 o;
    o.x = pk2(bflo(w.x) * sc, bfhi(w.x) * sc); o.y = pk2(bflo(w.y) * sc, bfhi(w.y) * sc); o.z = pk2(bflo(w.z) * sc, bfhi(w.z) * sc); o.w = pk2(bflo(w.w) * sc, bfhi(w.w) * sc);
    return __builtin_bit_cast(bf16x8, o);
}
__device__ __forceinline__ bf16x8 frag_mul(bf16x8 f, bf16x8 g, bool recip) {
    const u32x4 a = __builtin_bit_cast(u32x4, f), b = __builtin_bit_cast(u32x4, g); float x[8], y[8]; unpack8(a, x); unpack8(b, y);
#pragma unroll
    for (int i = 0; i < 8; ++i) x[i] = recip ? x[i] * __builtin_amdgcn_rcpf(y[i]) : x[i] * y[i];
    u32x4 o; o.x = pk2(x[0], x[1]); o.y = pk2(x[2], x[3]); o.z = pk2(x[4], x[5]); o.w = pk2(x[6], x[7]);
    return __builtin_bit_cast(bf16x8, o);
}
__device__ __forceinline__ float red_q(float v) { v += __shfl_xor(v, 16); v += __shfl_xor(v, 32); return v; }
__device__ __forceinline__ void stage_rows(f32x4 (&O)[4], int Tj, float rowscale, LAS bf16_t* Tl, int PTL, int lane) {
    const int r = lane & 15, q = lane >> 4;
    float ss = 0.f;
#pragma unroll
    for (int Te = 0; Te < 4; ++Te) { O[Te] = O[Te] * rowscale; const f32x4 v = O[Te]; ss += (v[0] * v[0] + v[1] * v[1]) + (v[2] * v[2] + v[3] * v[3]); }
    ss = red_q(ss);
    const float rs = __builtin_amdgcn_rsqf(ss * (1.f / 64.f) + LN_EPS);
#pragma unroll
    for (int Te = 0; Te < 4; ++Te) { const f32x4 v = O[Te] * rs; u32x2 w; w.x = pk2(v[0], v[1]); w.y = pk2(v[2], v[3]); *(LAS u32x2*)(Tl + (16 * Tj + r) * PTL + 16 * Te + 4 * q) = w; }
}
template <int GATE>
__device__ __forceinline__ void final_store(const LAS bf16_t* Tl, int PTL, const float* gnorm, const bf16_t* gate, bf16_t* out, int lane) {
    const int ch = lane & 7;
    const f32x4 g0 = *(const f32x4*)(gnorm + ch * 8), g1 = *(const f32x4*)(gnorm + ch * 8 + 4);
    const float gn[8] = {g0[0], g0[1], g0[2], g0[3], g1[0], g1[1], g1[2], g1[3]};
#pragma unroll
    for (int i = 0; i < 8; ++i) { const int row = (lane >> 3) + 8 * i;
        float hv[8], gt[8]; unpack8(*(const LAS u32x4*)(Tl + row * PTL + ch * 8), hv); unpack8(*(const u32x4*)(gate + (size_t)row * PJ + ch * 8), gt);
        float y[8];
#pragma unroll
        for (int k = 0; k < 8; ++k) { const float sg = __builtin_amdgcn_rcpf(1.f + fexp(-gt[k])); y[k] = hv[k] * (gn[k] * Y8S) * (GATE ? gt[k] * sg : sg); }
        u32x2 w; w.x = pk4_fp8(y[0], y[1], y[2], y[3]); w.y = pk4_fp8(y[4], y[5], y[6], y[7]);
        *(u32x2*)((unsigned char*)out + (size_t)row * DM + ch * 8) = w; }
}
__device__ __forceinline__ void mlstm_local_w(const RecP& P, LAS unsigned char* wl, int ci, int lane) {
    const int r = lane & 15, q = lane >> 4; constexpr int PL = 64;
    const int bh = ci >> 6, c = ci & 63, b = bh >> 2, h = bh & 3, row0 = b * SEQ + c * 64;
    const bf16_t* Xk = P.proj + (size_t)row0 * PJ + C_MK + h * 64; const bf16_t* Xv = P.proj + (size_t)row0 * PJ + C_MV + h * 64;
    LAS bf16_t* Kl = (LAS bf16_t*)wl; LAS bf16_t* Vl = (LAS bf16_t*)(wl + 8192);
    const float* tp = P.tail + (size_t)(row0 + lane) * 32;
    const float li = tp[T_MI + h] + P.mbi[h], lf = logsig(tp[T_MF + h] + P.mbf[h]);
    const float bc = scan_add(lf, lane), g = li - bc, gmax = wave_max(g), bend = __shfl(bc, 63), w = fexp(g - gmax);
    if (lane == 0) { P.smBC[ci] = bend; P.smDM[ci] = bend + gmax; }
#pragma unroll
    for (int i = 0; i < 8; ++i) { const u32x4 kpi = piece(Xk, PJ, i, lane), vpi = piece(Xv, PJ, i, lane); const float wr_ = __shfl(w, (lane >> 3) + 8 * i); float kf[8]; unpack8(kpi, kf);
        u32x4 ks; ks.x = pk2(kf[0] * wr_, kf[1] * wr_); ks.y = pk2(kf[2] * wr_, kf[3] * wr_); ks.z = pk2(kf[4] * wr_, kf[5] * wr_); ks.w = pk2(kf[6] * wr_, kf[7] * wr_);
        *(LAS u32x4*)(Kl + ((lane >> 3) + 8 * i) * PL + (lane & 7) * 8) = ks; *(LAS u32x4*)(Vl + ((lane >> 3) + 8 * i) * PL + (lane & 7) * 8) = vpi; }
    asm volatile("" ::: "memory"); __builtin_amdgcn_sched_barrier(0);
    bf16x8 Kt[4][2];
#pragma unroll
    for (int Td = 0; Td < 4; ++Td)
#pragma unroll
        for (int s = 0; s < 2; ++s) Kt[Td][s] = trfrag(Kl, PL, s, 16 * Td, lane);
#pragma unroll
    for (int Te = 0; Te < 4; ++Te) { const bf16x8 v0 = trfrag(Vl, PL, 0, 16 * Te, lane), v1 = trfrag(Vl, PL, 1, 16 * Te, lane);
#pragma unroll
        for (int Td = 0; Td < 4; ++Td) { f32x4 acc = (f32x4){0.f, 0.f, 0.f, 0.f}; acc = MF16(Kt[Td][0], v0, acc); acc = MF16(Kt[Td][1], v1, acc);
            u32x2 w; w.x = pk2(acc[0], acc[1]); w.y = pk2(acc[2], acc[3]); *(LAS u32x2*)(Kl + (16 * Te + r) * PL + 16 * Td + 4 * q) = w; } }
    asm volatile("" ::: "memory"); __builtin_amdgcn_sched_barrier(0);
    { bf16_t* dstb = (bf16_t*)P.stm + (size_t)ci * 4096;
#pragma unroll
      for (int i = 0; i < 8; ++i) { const int row = (lane >> 3) + 8 * i, ch = lane & 7; *(u32x4*)(dstb + row * 64 + ch * 8) = *(const LAS u32x4*)(Kl + row * PL + ch * 8); } }
    { const short one = (short)0x3F80; const bf16x8 ones = (bf16x8){one, one, one, one, one, one, one, one};
#pragma unroll
      for (int Td = 0; Td < 4; ++Td) { f32x4 acc = (f32x4){0.f, 0.f, 0.f, 0.f}; acc = MF16(ones, Kt[Td][0], acc); acc = MF16(ones, Kt[Td][1], acc);
          if (q == 0) P.smN[(size_t)ci * 64 + 16 * Td + r] = acc[0]; } }
}
struct GWf { bf16x8 Bw[4]; float ba[4]; };
__device__ __forceinline__ void ld_gwf(GWf& W, const RecP& P, int h, int lane) {
    const int r = lane & 15, q = lane >> 4;
    int wo = (8 * (q & 1)) * 256 + h * 64 + r; asm volatile("" : "+v"(wo)); const float* wp = P.wa2 + wo;
#pragma unroll
    for (int Td = 0; Td < 4; ++Td) { float w8[8];
#pragma unroll
        for (int i = 0; i < 8; ++i) { const float wv_ = wp[i * 256 + 16 * Td]; w8[i] = (q < 2) ? wv_ : 0.f; }
        u32x4 o; o.x = pk2(w8[0], w8[1]); o.y = pk2(w8[2], w8[3]); o.z = pk2(w8[4], w8[5]); o.w = pk2(w8[6], w8[7]); W.Bw[Td] = __builtin_bit_cast(bf16x8, o);
        W.ba[Td] = P.ba[h * 64 + 16 * Td + r]; }
}
template <int MODE>
__device__ __forceinline__ void gla_gate_tile(LAS bf16_t* Tt, int PL, float (&bend)[4], const GWf& W, const float* tail_row0, int lane) {
    const int r = lane & 15, q = lane >> 4;
    bf16x8 Ag[4];
    int to = r * 32 + T_GA + 8 * (q & 1); asm volatile("" : "+v"(to)); const float* tpb = tail_row0 + to;
#pragma unroll
    for (int Tl = 0; Tl < 4; ++Tl) { f32x4 a0 = *(const f32x4*)(tpb + Tl * 512), a1 = *(const f32x4*)(tpb + Tl * 512 + 4);
        if (q >= 2) { a0 = (f32x4){0.f, 0.f, 0.f, 0.f}; a1 = a0; }
        u32x4 o; o.x = pk2(a0[0], a0[1]); o.y = pk2(a0[2], a0[3]); o.z = pk2(a1[0], a1[1]); o.w = pk2(a1[2], a1[3]); Ag[Tl] = __builtin_bit_cast(bf16x8, o); }
#pragma unroll
    for (int Td = 0; Td < 4; ++Td) { float carry = 0.f; LAS bf16_t* tcol = Tt + (4 * q) * PL + 16 * Td + r;
#pragma unroll
        for (int tt = 0; tt < 4; ++tt) { const int Tl = MODE ? 3 - tt : tt; const float bb = W.ba[Td]; const f32x4 z = MF16(Ag[Tl], W.Bw[Td], ((f32x4){bb, bb, bb, bb}));
            const float v0 = logsig(z[0]) * (1.f / 16.f), v1 = logsig(z[1]) * (1.f / 16.f), v2 = logsig(z[2]) * (1.f / 16.f), v3 = logsig(z[3]) * (1.f / 16.f);
            const float lt = (v0 + v1) + (v2 + v3);
            float ex, o0, o1, o2, o3;
            if (MODE == 0) { const float t1 = __shfl_up(lt, 16), t2 = __shfl_up(lt, 32), t3 = __shfl_up(lt, 48); ex = carry + (q >= 1 ? t1 : 0.f) + (q >= 2 ? t2 : 0.f) + (q >= 3 ? t3 : 0.f);
                o0 = ex + v0; o1 = o0 + v1; o2 = o1 + v2; o3 = o2 + v3; }
            else { const float t1 = __shfl_down(lt, 16), t2 = __shfl_down(lt, 32), t3 = __shfl_down(lt, 48); ex = carry + (q <= 2 ? t1 : 0.f) + (q <= 1 ? t2 : 0.f) + (q <= 0 ? t3 : 0.f);
                o3 = ex; o2 = o3 + v3; o1 = o2 + v2; o0 = o1 + v1; }
            carry += red_q(lt);
            LAS bf16_t* tp = tcol + (16 * Tl) * PL;
            const unsigned w01 = pk2(fexp(o0), fexp(o1)), w23 = pk2(fexp(o2), fexp(o3));
            tp[0] = (bf16_t)(w01 & 0xffffu); tp[PL] = (bf16_t)(w01 >> 16); tp[2 * PL] = (bf16_t)(w23 & 0xffffu); tp[3 * PL] = (bf16_t)(w23 >> 16); }
        bend[Td] = carry; }
}
__device__ __forceinline__ void gla_local_w(const RecP& P, const GWf& W, LAS unsigned char* wl, int ci, int lane) {
    const int r = lane & 15, q = lane >> 4; constexpr int PL = 64;
    const int bh = ci >> 6, c = ci & 63, b = bh >> 2, h = bh & 3, row0 = b * SEQ + c * 64;
    const bf16_t* Xk = P.proj + (size_t)row0 * PJ + C_GK + h * 64; const bf16_t* Xv = P.proj + (size_t)row0 * PJ + C_GV + h * 64;
    LAS bf16_t* Kl = (LAS bf16_t*)wl; LAS bf16_t* Vl = (LAS bf16_t*)(wl + 8192);
    { float bend[4]; gla_gate_tile<1>(Kl, PL, bend, W, P.tail + (size_t)row0 * 32, lane);
      if (q == 0) {
#pragma unroll
          for (int Td = 0; Td < 4; ++Td) P.smGBE[(size_t)ci * 64 + 16 * Td + r] = bend[Td]; } }
    asm volatile("" ::: "memory"); __builtin_amdgcn_sched_barrier(0);
#pragma unroll
    for (int i = 0; i < 8; ++i) { const u32x4 kp = piece(Xk, PJ, i, lane), vp = piece(Xv, PJ, i, lane);
        LAS bf16_t* kp_l = Kl + ((lane >> 3) + 8 * i) * PL + (lane & 7) * 8; float kf[8], ff[8]; unpack8(kp, kf); unpack8(*(const LAS u32x4*)kp_l, ff);
        u32x4 ks; ks.x = pk2(kf[0] * ff[0], kf[1] * ff[1]); ks.y = pk2(kf[2] * ff[2], kf[3] * ff[3]); ks.z = pk2(kf[4] * ff[4], kf[5] * ff[5]); ks.w = pk2(kf[6] * ff[6], kf[7] * ff[7]);
        *(LAS u32x4*)kp_l = ks; *(LAS u32x4*)(Vl + ((lane >> 3) + 8 * i) * PL + (lane & 7) * 8) = vp; }
    asm volatile("" ::: "memory"); __builtin_amdgcn_sched_barrier(0);
    bf16x8 Kt[4][2];
#pragma unroll
    for (int Td = 0; Td < 4; ++Td)
#pragma unroll
        for (int s = 0; s < 2; ++s) Kt[Td][s] = trfrag(Kl, PL, s, 16 * Td, lane);
#pragma unroll
    for (int Te = 0; Te < 4; ++Te) { const bf16x8 v0 = trfrag(Vl, PL, 0, 16 * Te, lane), v1 = trfrag(Vl, PL, 1, 16 * Te, lane);
#pragma unroll
        for (int Td = 0; Td < 4; ++Td) { f32x4 acc = (f32x4){0.f, 0.f, 0.f, 0.f}; acc = MF16(Kt[Td][0], v0, acc); acc = MF16(Kt[Td][1], v1, acc);
            u32x2 w; w.x = pk2(acc[0], acc[1]); w.y = pk2(acc[2], acc[3]); *(LAS u32x2*)(Kl + (16 * Te + r) * PL + 16 * Td + 4 * q) = w; } }
    asm volatile("" ::: "memory"); __builtin_amdgcn_sched_barrier(0);
    { bf16_t* dstb = (bf16_t*)P.stg + (size_t)ci * 4096;
#pragma unroll
      for (int i = 0; i < 8; ++i) { const int row = (lane >> 3) + 8 * i, ch = lane & 7; *(u32x4*)(dstb + row * 64 + ch * 8) = *(const LAS u32x4*)(Kl + row * PL + ch * 8); } }
}
__device__ __forceinline__ void mlstm_out_w(const RecP& P, LAS unsigned char* wl, int ci, int lane) {
    const int r = lane & 15, q = lane >> 4; constexpr int PL = 72;
    const int bh = ci >> 6, c = ci & 63, b = bh >> 2, h = bh & 3, row0 = b * SEQ + c * 64;
    const bf16_t* Xq = P.proj + (size_t)row0 * PJ + C_MQ + h * 64; const bf16_t* Xk = P.proj + (size_t)row0 * PJ + C_MK + h * 64; const bf16_t* Xv = P.proj + (size_t)row0 * PJ + C_MV + h * 64;
    LAS bf16_t* Tl = (LAS bf16_t*)wl; LAS float* vg = (LAS float*)(wl + 9216); LAS float* vn = vg + 64;
#pragma unroll
    for (int i = 0; i < 8; ++i) *(LAS u32x4*)(Tl + ((lane >> 3) + 8 * i) * PL + (lane & 7) * 8) = piece(Xv, PJ, i, lane);
    const float* tp = P.tail + (size_t)(row0 + lane) * 32;
    const float li = tp[T_MI + h] + P.mbi[h], lf = logsig(tp[T_MF + h] + P.mbf[h]);
    const float m = P.smMS[ci]; vn[lane] = P.smN[(size_t)ci * 64 + lane];
    const float bc = scan_add(lf, lane), g = li - bc, pm = scan_max(g, lane), M = fmaxf(m, pm), wint = fexp(m - M), expm = fexp(-bc - M);
    vg[lane] = g;
    asm volatile("" ::: "memory"); __builtin_amdgcn_sched_barrier(0);
    bf16x8 Kf[4][2], Qf[4][2];
#pragma unroll
    for (int T = 0; T < 4; ++T)
#pragma unroll
        for (int ks = 0; ks < 2; ++ks) { Kf[T][ks] = rfg(Xk, PJ, T, ks, lane); Qf[T][ks] = rfg(Xq, PJ, T, ks, lane); }
    float Mj[4], wj[4], ej[4];
#pragma unroll
    for (int T = 0; T < 4; ++T) { Mj[T] = __shfl(M, 16 * T + r); wj[T] = __shfl(wint, 16 * T + r); ej[T] = __shfl(expm, 16 * T + r); }
    u32x2 Pk[4][4]; float dinv[4];
#pragma unroll
    for (int Tj = 0; Tj < 4; ++Tj) { float dsum = 0.f;
#pragma unroll
        for (int Tl_ = 0; Tl_ < 4; ++Tl_) {
            if (Tl_ <= Tj) { f32x4 acc = (f32x4){0.f, 0.f, 0.f, 0.f}; acc = MF16(Kf[Tl_][0], Qf[Tj][0], acc); acc = MF16(Kf[Tl_][1], Qf[Tj][1], acc);
                const f32x4 g4 = *(const LAS f32x4*)(vg + 16 * Tl_ + 4 * q); float sv[4];
#pragma unroll
                for (int rg = 0; rg < 4; ++rg) { const bool ok = (Tl_ < Tj) || (4 * q + rg <= r); sv[rg] = ok ? acc[rg] * fexp(g4[rg] - Mj[Tj]) : 0.f; dsum += sv[rg]; }
                Pk[Tj][Tl_].x = pk2(sv[0], sv[1]); Pk[Tj][Tl_].y = pk2(sv[2], sv[3]); }
            else { Pk[Tj][Tl_].x = 0u; Pk[Tj][Tl_].y = 0u; } }
        dsum = red_q(dsum);
        float qn = 0.f;
#pragma unroll
        for (int ks = 0; ks < 2; ++ks) { float qf[8]; unpack8(__builtin_bit_cast(u32x4, Qf[Tj][ks]), qf); const f32x4 n0 = *(const LAS f32x4*)(vn + 32 * ks + 8 * q), n1 = *(const LAS f32x4*)(vn + 32 * ks + 8 * q + 4);
            qn += (qf[0] * n0[0] + qf[1] * n0[1]) + (qf[2] * n0[2] + qf[3] * n0[3]) + (qf[4] * n1[0] + qf[5] * n1[1]) + (qf[6] * n1[2] + qf[7] * n1[3]); }
        qn = red_q(qn);
        const float den = dsum + wj[Tj] * qn; dinv[Tj] = __builtin_amdgcn_rcpf(fmaxf(fabsf(den), ej[Tj]));
        Qf[Tj][0] = frag_scale(Qf[Tj][0], wj[Tj]); Qf[Tj][1] = frag_scale(Qf[Tj][1], wj[Tj]); asm volatile("" ::: "memory"); __builtin_amdgcn_sched_barrier(0); }
    asm volatile("" ::: "memory"); __builtin_amdgcn_sched_barrier(0);
    const bf16_t* cs = P.csm + (size_t)ci * 4096;
    bf16x8 Vt[4][2], Ct[4][2];
#pragma unroll
    for (int Te = 0; Te < 4; ++Te)
#pragma unroll
        for (int s = 0; s < 2; ++s) { Vt[Te][s] = trfrag(Tl, PL, s, 16 * Te, lane); Ct[Te][s] = rfg(cs, 64, Te, s, lane); }
    asm volatile("" ::: "memory"); __builtin_amdgcn_sched_barrier(0);
#pragma unroll
    for (int Tj = 0; Tj < 4; ++Tj) { f32x4 O[4];
        const bf16x8 p0 = __builtin_bit_cast(bf16x8, ((u32x4){Pk[Tj][0].x, Pk[Tj][0].y, Pk[Tj][1].x, Pk[Tj][1].y})), p1 = __builtin_bit_cast(bf16x8, ((u32x4){Pk[Tj][2].x, Pk[Tj][2].y, Pk[Tj][3].x, Pk[Tj][3].y}));
#pragma unroll
        for (int Te = 0; Te < 4; ++Te) { f32x4 acc = (f32x4){0.f, 0.f, 0.f, 0.f}; acc = MF16(Vt[Te][0], p0, acc); if (Tj >= 2) acc = MF16(Vt[Te][1], p1, acc);
            acc = MF16(Ct[Te][0], Qf[Tj][0], acc); acc = MF16(Ct[Te][1], Qf[Tj][1], acc); O[Te] = acc; }
        stage_rows(O, Tj, dinv[Tj], Tl, PL, lane); asm volatile("" ::: "memory"); __builtin_amdgcn_sched_barrier(0); }
    asm volatile("" ::: "memory"); __builtin_amdgcn_sched_barrier(0);
    final_store<0>(Tl, PL, P.mg, P.proj + (size_t)row0 * PJ + C_MO + h * 64, (bf16_t*)((unsigned char*)P.ycat + (size_t)row0 * DM + h * 64), lane);
}
__device__ __forceinline__ void gla_out_w(const RecP& P, const GWf& W, LAS unsigned char* wl, int ci, int lane) {
    const int r = lane & 15, q = lane >> 4; constexpr int PL = 72;
    const int bh = ci >> 6, c = ci & 63, b = bh >> 2, h = bh & 3, row0 = b * SEQ + c * 64;
    const bf16_t* Xq = P.proj + (size_t)row0 * PJ + C_GQ + h * 64; const bf16_t* Xk = P.proj + (size_t)row0 * PJ + C_GK + h * 64; const bf16_t* Xv = P.proj + (size_t)row0 * PJ + C_GV + h * 64;
    LAS bf16_t* Tl = (LAS bf16_t*)wl;
    { float bend[4]; gla_gate_tile<0>(Tl, PL, bend, W, P.tail + (size_t)row0 * 32, lane); }
    asm volatile("" ::: "memory"); __builtin_amdgcn_sched_barrier(0);
    bf16x8 Kf[4][2], Qf[4][2];
#pragma unroll
    for (int T = 0; T < 4; ++T)
#pragma unroll
        for (int ks = 0; ks < 2; ++ks) { const bf16x8 ef = *(const LAS bf16x8*)(Tl + (16 * T + r) * PL + 32 * ks + 8 * q); Qf[T][ks] = frag_mul(rfg(Xq, PJ, T, ks, lane), ef, false); Kf[T][ks] = frag_mul(rfg(Xk, PJ, T, ks, lane), ef, true); }
    asm volatile("" ::: "memory"); __builtin_amdgcn_sched_barrier(0);
#pragma unroll
    for (int i = 0; i < 8; ++i) *(LAS u32x4*)(Tl + ((lane >> 3) + 8 * i) * PL + (lane & 7) * 8) = piece(Xv, PJ, i, lane);
    asm volatile("" ::: "memory"); __builtin_amdgcn_sched_barrier(0);
    u32x2 Pk[4][4];
#pragma unroll
    for (int Tj = 0; Tj < 4; ++Tj)
#pragma unroll
        for (int Tl_ = 0; Tl_ < 4; ++Tl_) {
            if (Tl_ <= Tj) { f32x4 acc = (f32x4){0.f, 0.f, 0.f, 0.f}; acc = MF16(Kf[Tl_][0], Qf[Tj][0], acc); acc = MF16(Kf[Tl_][1], Qf[Tj][1], acc); float sv[4];
#pragma unroll
                for (int rg = 0; rg < 4; ++rg) { const bool ok = (Tl_ < Tj) || (4 * q + rg <= r); sv[rg] = ok ? acc[rg] : 0.f; }
                Pk[Tj][Tl_].x = pk2(sv[0], sv[1]); Pk[Tj][Tl_].y = pk2(sv[2], sv[3]); }
            else { Pk[Tj][Tl_].x = 0u; Pk[Tj][Tl_].y = 0u; } }
    const bf16_t* cs = P.csg + (size_t)ci * 4096;
    bf16x8 Vt[4][2], Ct[4][2];
#pragma unroll
    for (int Te = 0; Te < 4; ++Te)
#pragma unroll
        for (int s = 0; s < 2; ++s) { Vt[Te][s] = trfrag(Tl, PL, s, 16 * Te, lane); Ct[Te][s] = rfg(cs, 64, Te, s, lane); }
    asm volatile("" ::: "memory"); __builtin_amdgcn_sched_barrier(0);
#pragma unroll
    for (int Tj = 0; Tj < 4; ++Tj) { f32x4 O[4];
        const bf16x8 p0 = __builtin_bit_cast(bf16x8, ((u32x4){Pk[Tj][0].x, Pk[Tj][0].y, Pk[Tj][1].x, Pk[Tj][1].y})), p1 = __builtin_bit_cast(bf16x8, ((u32x4){Pk[Tj][2].x, Pk[Tj][2].y, Pk[Tj][3].x, Pk[Tj][3].y}));
#pragma unroll
        for (int Te = 0; Te < 4; ++Te) { f32x4 acc = (f32x4){0.f, 0.f, 0.f, 0.f}; acc = MF16(Vt[Te][0], p0, acc); if (Tj >= 2) acc = MF16(Vt[Te][1], p1, acc);
            acc = MF16(Ct[Te][0], Qf[Tj][0], acc); acc = MF16(Ct[Te][1], Qf[Tj][1], acc); O[Te] = acc; }
        stage_rows(O, Tj, 1.f, Tl, PL, lane); asm volatile("" ::: "memory"); __builtin_amdgcn_sched_barrier(0); }
    asm volatile("" ::: "memory"); __builtin_amdgcn_sched_barrier(0);
    final_store<1>(Tl, PL, P.gg, P.proj + (size_t)row0 * PJ + C_GR + h * 64, (bf16_t*)((unsigned char*)P.ycat + (size_t)row0 * DM + 768 + h * 64), lane);
}
#undef MF16
}


constexpr int N_PHASES = 2 + 9 * DEPTH;
__global__ void __launch_bounds__(512, 2) mega_fwd(Args args) {
    extern __shared__ __attribute__((aligned(16))) unsigned char lds_raw[];
    Frame F;
    F.lds = (LAS unsigned char*)lds_raw;
    F.MISC = (volatile LAS unsigned*)(F.lds + MISC_OFF);
    F.tid = threadIdx.x; F.lane = F.tid & 63; F.wave = __builtin_amdgcn_readfirstlane(F.tid >> 6);
    F.G = gridDim.x; { const int bx = blockIdx.x; F.vcu = (F.G % 8 == 0) ? (bx % 8) * (F.G / 8) + bx / 8 : bx; }
    typedef const __attribute__((address_space(4))) Args* CArgs;
    const CArgs ap0 = (CArgs)__builtin_amdgcn_kernarg_segment_ptr();
    F.ctl = (gu32*)(args.ws + WS_CTL);
    for (int u = F.tid; u < (LDS_BYTES - LDSCTL_OFF) / 4; u += 512) ((LAS unsigned*)(F.lds + LDSCTL_OFF))[u] = 0u;
    __syncthreads();
#if MK_ONE_LAUNCH
    XcdBarrier bar = xcd_barrier_post((unsigned*)(F.ctl + CW_BAR), F.MISC + 8);
#define GRID_BAR() xcd_barrier(bar)
#else
#define GRID_BAR() do {} while (0)
#endif
    const int lo = args.ph_lo, hi = args.ph_hi;
#define IN(k) (lo <= (k) && (k) < hi)
#define SEAM(k) do { if (IN(k) && IN((k) + 1)) { GRID_BAR(); if (NREP(15) == 2) GRID_BAR(); } } while (0)
    const int NGW = F.G * 8;
#define PHASE_IDS() int tid = threadIdx.x; asm volatile("" : "+v"(tid)); const int lane = tid & 63, wid = __builtin_amdgcn_readfirstlane(tid >> 6); const int gw = F.vcu * 8 + wid; (void)lane; (void)gw; \
    CArgs ap = ap0; asm volatile("" : "+s"(ap)); unsigned char* ws = ap->ws; (void)ws
#define AIN(i) (ap->in[i])
#define MOD ((float*)(ws + WS_MOD))
#define ROPE ((float*)(ws + WS_ROPE))
#define WIN ((bf16_t*)(ws + WS_WIN))
#define WOUT ((bf16_t*)(ws + WS_WOUT))
#define WGU8 ((unsigned char*)(ws + WS_WGU))
#define WD8 ((unsigned char*)(ws + WS_WD))
#define U8B ((unsigned char*)(ws + WS_U8))
#define WIN8 ((unsigned char*)(ws + WS_WIN8))
#define H8B ((unsigned char*)(ws + WS_PROJ))
#define LTOK ((int*)(ws + WS_LTOK))
#define LGATE ((float*)(ws + WS_LGATE))
#define PROJ ((bf16_t*)(ws + WS_PROJ))
#define HB ((bf16_t*)(ws + WS_PROJ))
#define XB ((bf16_t*)(ws + WS_XR))
#define YSORT ((bf16_t*)(ws + WS_YSORT))
#define TAILB ((float*)(ws + WS_TAIL))
#define TOKSLOT ((int*)(ws + WS_SM + SM_TS))
#define UB ((bf16_t*)(ws + WS_U))
#define YCAT ((bf16_t*)(ws + WS_YCAT))
#define STM ((float*)(ws + WS_U))
#define STG ((float*)(ws + WS_U + 32 * MiB))
#define CSM ((bf16_t*)(ws + WS_XR + 64 * MiB))
#define CSG ((bf16_t*)(ws + WS_XR + 80 * MiB))
#define G_smN ((float*)(ws + WS_SM + SM_N))
#define G_smBC ((float*)(ws + WS_SM + SM_BC))
#define G_smDM ((float*)(ws + WS_SM + SM_DM))
#define G_smMS ((float*)(ws + WS_SM + SM_MS))
#define G_smGBE ((float*)(ws + WS_SM + SM_GBE))
#define x_in AIN(I_X)

    if (IN(0) && PHON(0)) for (int rp0 = 0; rp0 < NREP(0); ++rp0) {
        PHASE_IDS();
        {
            LAS float* cact = (LAS float*)F.lds;
            LAS float* part = (LAS float*)(F.lds + 32768);
            const float* cc = AIN(I_C);
            for (int i = tid; i < NB * DM; i += 512) { const int b = i >> 10, k = i & 1023; const float v = cc[i]; cact[k * 8 + b] = v / (1.f + fexp(-v)); }
            __syncthreads();
            for (int it = F.vcu; it < DEPTH * 96; it += F.G) {
                const int l = it / 96, j0 = (it % 96) * 64;
                const float* W = AIN(I_WADA) + (size_t)l * DM * 6144 + j0 + lane;
                float a[8] = {0.f, 0.f, 0.f, 0.f, 0.f, 0.f, 0.f, 0.f};
#pragma unroll 32
                for (int kk = 0; kk < 128; ++kk) { const int k = wid * 128 + kk; const float w = W[(size_t)k * 6144];
                    const f32x4 c0 = *(const LAS f32x4*)(cact + k * 8), c1 = *(const LAS f32x4*)(cact + k * 8 + 4);
                    a[0] += c0[0] * w; a[1] += c0[1] * w; a[2] += c0[2] * w; a[3] += c0[3] * w; a[4] += c1[0] * w; a[5] += c1[1] * w; a[6] += c1[2] * w; a[7] += c1[3] * w; }
#pragma unroll
                for (int b = 0; b < 8; ++b) part[(wid * 8 + b) * 64 + lane] = a[b];
                __syncthreads();
                { const int b = tid >> 6, j = tid & 63; float s = AIN(I_BADA)[(size_t)l * 6144 + j0 + j];
#pragma unroll
                  for (int w = 0; w < 8; ++w) s += part[(w * 8 + b) * 64 + j];
                  MOD[((size_t)l * NB + b) * 6144 + j0 + j] = s; }
                __syncthreads();
            }
        }
        {
            const int* pos = (const int*)AIN(I_POS);
            for (int i = blockIdx.x * 512 + tid; i < NTOK * 4; i += F.G * 512) { const int row = i >> 2, f = i & 3;
                const float invf = (float)pow(500000.0, -0.25 * (double)f); const float ang = (float)pos[row] * invf;
                ROPE[(size_t)row * 8 + f] = (float)cos((double)ang); ROPE[(size_t)row * 8 + 4 + f] = (float)sin((double)ang); }
        }
        {
            LAS float* scr = (LAS float*)(F.lds + 49152 + wid * 8704);
            constexpr int I_IN = (DM / 64) * (PW / 32), I_OUT = (DM / 64) * (DM / 32);
            auto dec0 = [&](int it, TrD& d) { const int l = it / (I_IN + I_OUT); int r = it % (I_IN + I_OUT);
                if (r < I_IN) { const int kb = r / (PW / 32), nb = r % (PW / 32); const int nbe = (nb < 112) ? nb : 0; const int tl = nbe >> 3;
                    d.wsc = (tl == 0 || tl == 10) ? 0.125f : (tl == 7) ? ATT_C2 : 1.f;
                    d.src = AIN(I_WIN) + (size_t)l * DM * PIN + (size_t)(kb * 64) * PIN + win_src_col(nbe * 32); d.ldw = PIN; d.K = DM; d.dst = WIN + (size_t)l * PW * DM; d.dst8 = WIN8 + (size_t)l * PP * DM; d.drow0 = nbe * 32; d.k0 = kb * 64;
                    return nb < 112; }
                r -= I_IN; const int kb = r / (DM / 32), nb = r % (DM / 32); d.wsc = 1.f;
                d.src = AIN(I_WOUT) + (size_t)l * DM * DM + (size_t)(kb * 64) * DM + nb * 32; d.wsc = W8S; d.dst8 = nullptr; d.ldw = DM; d.K = DM; d.dst = (bf16_t*)((unsigned char*)WOUT + (size_t)l * DM * DM); d.drow0 = nb * 32; d.k0 = kb * 64; return true; };
            { TrD dc, dn; f32x4 vc[8], vn[8]; int it = gw; bool okc = dec0(it, dc); tr_load4(dc, vc, lane); dn = dc; bool okn = okc;
#pragma unroll
              for (int i = 0; i < 8; ++i) vn[i] = vc[i];
              for (; it < DEPTH * (I_IN + I_OUT); it += NGW) { const int itn = it + NGW;
                  if (itn < DEPTH * (I_IN + I_OUT)) { okn = dec0(itn, dn); tr_load4(dn, vn, lane); }
                  if (okc) { if (dc.ldw == DM) tr_finish8(dc, vc, scr, lane); else { TrD d8 = dc; d8.dst = (bf16_t*)dc.dst8; d8.wsc = dc.wsc * W8S; tr_finish8(d8, vc, scr, lane); } }
                  dc = dn; okc = okn;
#pragma unroll
                  for (int i = 0; i < 8; ++i) vc[i] = vn[i]; } }
            for (int it = gw; it < DEPTH * (DM / 64) * 8; it += NGW) { const int l = it / ((DM / 64) * 8), r = it % ((DM / 64) * 8), kb = r >> 3, nb = 112 + (r & 7);
                tr_item(AIN(I_WIN) + (size_t)l * DM * PIN, PIN, DM, WIN + (size_t)l * PW * DM, nb * 32, win_src_col(nb * 32 + (lane & 31)), kb * 64, scr, lane); }
        }
    }
    SEAM(0);
    if (IN(1) && PHON(1)) {
        PHASE_IDS();
        NarrowT NT_; nmm_load_tail(NT_, WIN + (size_t)PP * DM, wid, lane);
        LAS bf16_t* Sst = (LAS bf16_t*)F.lds; LAS float* Pb = (LAS float*)(F.lds + NMM_P_OFF);
        const int b = F.vcu >> 5; const float* md = MOD + (size_t)b * 6144;
        f32x4 sh[4], sc[4];
#pragma unroll
        for (int j = 0; j < 4; ++j) { sh[j] = *(const f32x4*)(md + 4 * lane + 256 * j); sc[j] = *(const f32x4*)(md + 1024 + 4 * lane + 256 * j) + 1.0f; }
        const int rowb = F.vcu * 128 + wid * 16;
        for (int i = 0; i < 16; i += 4) { f32x4 v[4][4];
#pragma unroll
            for (int rr = 0; rr < 4; ++rr)
#pragma unroll
                for (int j = 0; j < 4; ++j) v[rr][j] = *(const f32x4*)(x_in + (size_t)(rowb + i + rr) * DM + 4 * lane + 256 * j);
#pragma unroll
            for (int rr = 0; rr < 4; ++rr)
#pragma unroll
                for (int j = 0; j < 4; ++j) { const f32x4 u = v[rr][j] * sc[j] + sh[j];
                    u32x2 w; w.x = pk2(u[0], u[1]); w.y = pk2(u[2], u[3]); *(LAS u32x2*)(Sst + (wid * 4 + rr) * NSP + 4 * lane + 256 * j) = w;
                    *(unsigned*)(U8B + (size_t)(rowb + i + rr) * DM + 4 * lane + 256 * j) = pk4_fp8(u[0], u[1], u[2], u[3]); }
            nmm_step_tail(NT_, Sst, Pb, TAILB + (size_t)(F.vcu * 128) * 32, i, tid, wid, lane); }
    }
    SEAM(1);

    for (int l = 0; l < DEPTH; ++l) {
        const int pb = 2 + 9 * l;
#define modl (MOD + (size_t)l * NB * 6144)
#define MAKE_RP() rec::RecP RP; RP.proj = PROJ; RP.tail = TAILB; RP.csm = CSM; RP.csg = CSG; RP.stm = STM; RP.stg = STG; RP.smN = G_smN; RP.smBC = G_smBC; RP.smDM = G_smDM; RP.smMS = G_smMS; RP.smGBE = G_smGBE; RP.ycat = YCAT; \
        RP.mbi = AIN(I_MBI) + l * 4; RP.mbf = AIN(I_MBF) + l * 4; RP.mg = AIN(I_MG) + l * 64; RP.wa2 = AIN(I_WA2) + (size_t)l * 16 * 256; RP.ba = AIN(I_BA) + l * 256; RP.gg = AIN(I_GG) + l * 64;
        if (IN(pb + 0) && PHON(2)) {
            PHASE_IDS(); (void)tid;
            { gm::K1<true> k; k.S.init(NTOK, PP, F.G, (int)blockIdx.x); k.A = U8B; k.Bt = WIN8 + (size_t)l * PP * DM; k.O = PROJ; k.rope = ROPE;
                gm::gemm_phase<gm::K1<true>>(F.lds, k); }
        }
        SEAM(pb + 0);
        if (IN(pb + 1) && PHON(3)) {
            PHASE_IDS();
            MAKE_RP();
            for (int rp = 0; rp < NREP(3); ++rp) {
                LAS unsigned char* wl = F.lds + wid * 16384;
                recw::GWf gwf; recw::ld_gwf(gwf, RP, (gw >> 6) & 3, lane);
                for (int ci = gw; ci < 2048; ci += NGW) { int lane_ = lane; asm volatile("" : "+v"(lane_)); if (PHON(13)) recw::mlstm_local_w(RP, wl, ci, lane_); asm volatile("" ::: "memory"); __builtin_amdgcn_sched_barrier(0); if (PHON(14)) recw::gla_local_w(RP, gwf, wl, ci, lane_); }
            }
        }
        SEAM(pb + 1);
        if (IN(pb + 2) && PHON(4)) {
            PHASE_IDS();
            const int gt = blockIdx.x * 512 + tid, NGT = F.G * 512;
            for (int task = gt; task < 66048; task += NGT) {
                if (task < 32768) {
                    const int bh = task >> 10, el = (task & 1023) * 4; const bf16_t* p = (const bf16_t*)STM + (size_t)bh * 64 * 4096 + el; bf16_t* o = CSM + (size_t)bh * 64 * 4096 + el;
                    const float* bc = G_smBC + bh * 64; const float* dm = G_smDM + bh * 64;
                    f32x4 C = (f32x4){0.f, 0.f, 0.f, 0.f}; float m = 0.f;
#pragma unroll 16
                    for (int c = 0; c < NCH; ++c) { const u32x2 uw = *(const u32x2*)(p + (size_t)c * 4096); const f32x4 u = (f32x4){bflo(uw.x), bfhi(uw.x), bflo(uw.y), bfhi(uw.y)}; u32x2 w; w.x = pk2(C[0], C[1]); w.y = pk2(C[2], C[3]); *(u32x2*)(o + (size_t)c * 4096) = w;
                        if (el == 0) G_smMS[bh * 64 + c] = m;
                        const float B = bc[c], Dm = dm[c], mn = fmaxf(B + m, Dm); C = C * fexp(B + m - mn) + u * fexp(Dm - mn); m = mn; }
                } else if (task < 65536) {
                    const int t2 = task - 32768, bh = t2 >> 10, el = (t2 & 1023) * 4, d = el & 63; const bf16_t* p = (const bf16_t*)STG + (size_t)bh * 64 * 4096 + el; bf16_t* o = CSG + (size_t)bh * 64 * 4096 + el;
                    const float* be = G_smGBE + (size_t)bh * 64 * 64 + d;
                    f32x4 S = (f32x4){0.f, 0.f, 0.f, 0.f};
#pragma unroll 16
                    for (int c = 0; c < NCH; ++c) { const u32x2 uw = *(const u32x2*)(p + (size_t)c * 4096); const f32x4 u = (f32x4){bflo(uw.x), bfhi(uw.x), bflo(uw.y), bfhi(uw.y)}; const f32x4 b4 = *(const f32x4*)(be + c * 64);
                        u32x2 w; w.x = pk2(S[0], S[1]); w.y = pk2(S[2], S[3]); *(u32x2*)(o + (size_t)c * 4096) = w;
                        S = (f32x4){fexp(b4[0]) * S[0] + u[0], fexp(b4[1]) * S[1] + u[1], fexp(b4[2]) * S[2] + u[2], fexp(b4[3]) * S[3] + u[3]}; }
                } else {
                    const int t3 = task - 65536, bh = t3 >> 4, el = (t3 & 15) * 4; float* p = G_smN + (size_t)bh * 64 * 64 + el; const float* bc = G_smBC + bh * 64; const float* dm = G_smDM + bh * 64;
                    f32x4 C = (f32x4){0.f, 0.f, 0.f, 0.f}; float m = 0.f;
#pragma unroll 8
                    for (int c = 0; c < NCH; ++c) { const f32x4 u = *(const f32x4*)(p + c * 64); *(f32x4*)(p + c * 64) = C;
                        const float B = bc[c], Dm = dm[c], mn = fmaxf(B + m, Dm); C = C * fexp(B + m - mn) + u * fexp(Dm - mn); m = mn; }
                }
            }
            for (int rp = 0; rp < NREP(13); ++rp) {
                LAS float* scr = (LAS float*)(F.lds + 49152 + wid * 8704);
                constexpr int I_G = (DM / 64) * (1024 / 32), I_D = (DE / 64) * (DM / 32);
                auto dece = [&](int it, TrD& d) { const int e = it / (I_G + I_D); int r = it % (I_G + I_D); d.wsc = W8S; d.dst8 = nullptr;
                    if (r < I_G) { const int kb = r / 32, nb = r % 32, n0 = nb * 32, tt = n0 >> 8, rr = n0 & 255;
                        d.src = (rr < 128 ? AIN(I_EWG) : AIN(I_EWU)) + ((size_t)l * NE + e) * DM * DE + (size_t)(kb * 64) * DE + tt * 128 + (rr & 127); d.ldw = DE; d.K = DM; d.dst = (bf16_t*)(WGU8 + (size_t)e * 1024 * 1024); d.drow0 = n0; d.k0 = kb * 64; }
                    else { r -= I_G; const int kb = r / 32, nb = r % 32;
                        d.src = AIN(I_EWD) + ((size_t)l * NE + e) * DE * DM + (size_t)(kb * 64) * DM + nb * 32; d.ldw = DM; d.K = DE; d.dst = (bf16_t*)(WD8 + (size_t)e * 1024 * 512); d.drow0 = nb * 32; d.k0 = kb * 64; } };
                TrD dc, dn; f32x4 vc[8], vn[8]; int it = gw; dece(it, dc); tr_load4(dc, vc, lane); dn = dc;
#pragma unroll
                for (int i = 0; i < 8; ++i) vn[i] = vc[i];
                for (; it < NE * (I_G + I_D); it += NGW) { const int itn = it + NGW;
                    if (itn < NE * (I_G + I_D)) { dece(itn, dn); tr_load4(dn, vn, lane); }
                    tr_finish8(dc, vc, scr, lane);
                    dc = dn;
#pragma unroll
                    for (int i = 0; i < 8; ++i) vc[i] = vn[i]; }
            }
        }
        SEAM(pb + 2);
        if (IN(pb + 3) && PHON(5)) {
            PHASE_IDS();
            if (PHON(10)) {
                float d1 = 0.f, d2 = 0.f;
                for (int i = 0; i < 32; ++i) { d1 += AIN(I_LQ1)[l * 32 + i] * AIN(I_LK1)[l * 32 + i]; d2 += AIN(I_LQ2)[l * 32 + i] * AIN(I_LK2)[l * 32 + i]; }
                const float lam_init = 0.8f - 0.6f * expf(-0.3f * (float)l);
                attn_body::AttnParams AP; AP.Q = (const attn_body::bf16*)(PROJ + C_DQ); AP.K = (const attn_body::bf16*)(PROJ + C_DK); AP.V = (const attn_body::bf16*)(PROJ + C_DV);
                AP.zpage = (const attn_body::bf16*)(F.ctl + CW_ZPAGE); AP.Y = (bf16_t*)((unsigned char*)YCAT + 512); AP.gnorm = AIN(I_DG) + l * 64; AP.lam = expf(d1) - expf(d2) + lam_init; AP.osc = 1.f - lam_init;
                const int bh = F.vcu >> 3, s = F.vcu & 7;
                if (F.G == 256) {
                    for (int rp = 0; rp < NREP(10); ++rp)
                    for (int i = 0; i < 2; ++i) { const int qb = (i == 0) ? s : 15 - s;
                        attn_body::attn_unit<8, 0>(bh >> 2, bh & 3, qb, AP, (char*)lds_raw); attn_body::attn_unit<8, 1>(bh >> 2, bh & 3, qb, AP, (char*)lds_raw); }
                }
            }
            __syncthreads();
            {
            PHASE_IDS();
            MAKE_RP();
            if (PHON(11)) for (int rp = 0; rp < NREP(11); ++rp) {
                LAS unsigned char* wl = F.lds + wid * 16384;
                LAS u32x4* gst = (LAS u32x4*)(wl + 10240);
                { recw::GWf gwf; recw::ld_gwf(gwf, RP, (gw >> 6) & 3, lane);
#pragma unroll
                  for (int Td = 0; Td < 4; ++Td) gst[Td * 64 + lane] = __builtin_bit_cast(u32x4, gwf.Bw[Td]);
                  gst[256 + lane] = __builtin_bit_cast(u32x4, ((f32x4){gwf.ba[0], gwf.ba[1], gwf.ba[2], gwf.ba[3]})); }
                for (int ci = gw; ci < 2048; ci += NGW) { int lane_ = lane; asm volatile("" : "+v"(lane_)); if (PHON(13)) recw::mlstm_out_w(RP, wl, ci, lane_); asm volatile("" ::: "memory"); __builtin_amdgcn_sched_barrier(0);
                    if (PHON(14)) { recw::GWf gwf;
#pragma unroll
                        for (int Td = 0; Td < 4; ++Td) gwf.Bw[Td] = __builtin_bit_cast(bf16x8, gst[Td * 64 + lane_]);
                        const f32x4 bb = __builtin_bit_cast(f32x4, gst[256 + lane_]); gwf.ba[0] = bb[0]; gwf.ba[1] = bb[1]; gwf.ba[2] = bb[2]; gwf.ba[3] = bb[3];
                        recw::gla_out_w(RP, gwf, wl, ci, lane_); } }
            }
            __syncthreads();
            if (PHON(12)) for (int rp = 0; rp < NREP(12); ++rp) {
                const float* cw = AIN(I_CONVW) + (size_t)l * 3 * 256; const float* cbias = AIN(I_CONVB) + l * 256;
                for (int it = F.vcu; it < NTOK / 64; it += F.G) {
                    for (int p = tid; p < 64 * 32; p += 512) { const int r = p >> 5, chn = p & 31, row = it * 64 + r, t = row & (SEQ - 1);
                        const bf16_t* pr = PROJ + (size_t)row * PJ + chn * 8;
                        float s0[8], s1[8], s2[8], cbv[8];
                        { float a[8], bq[8]; rec::unpack8(*(const u32x4*)(pr + C_CC), a); rec::unpack8(*(const u32x4*)(pr + C_CH), bq);
#pragma unroll
                          for (int i = 0; i < 8; ++i) s2[i] = a[i] * bq[i]; }
                        if (t >= 1) { float a[8], bq[8]; rec::unpack8(*(const u32x4*)(pr - PJ + C_CC), a); rec::unpack8(*(const u32x4*)(pr - PJ + C_CH), bq);
#pragma unroll
                          for (int i = 0; i < 8; ++i) s1[i] = a[i] * bq[i]; } else {
#pragma unroll
                          for (int i = 0; i < 8; ++i) s1[i] = 0.f; }
                        if (t >= 2) { float a[8], bq[8]; rec::unpack8(*(const u32x4*)(pr - 2 * PJ + C_CC), a); rec::unpack8(*(const u32x4*)(pr - 2 * PJ + C_CH), bq);
#pragma unroll
                          for (int i = 0; i < 8; ++i) s0[i] = a[i] * bq[i]; } else {
#pragma unroll
                          for (int i = 0; i < 8; ++i) s0[i] = 0.f; }
                        rec::unpack8(*(const u32x4*)(pr + C_CB), cbv);
                        float y[8];
#pragma unroll
                        for (int i = 0; i < 8; ++i) { const int cch = chn * 8 + i; y[i] = cbv[i] * (cw[cch] * s0[i] + cw[256 + cch] * s1[i] + cw[512 + cch] * s2[i] + cbias[cch]); }
                        u32x2 w; w.x = pk4_fp8(y[0] * Y8S, y[1] * Y8S, y[2] * Y8S, y[3] * Y8S); w.y = pk4_fp8(y[4] * Y8S, y[5] * Y8S, y[6] * Y8S, y[7] * Y8S);
                        *(u32x2*)((unsigned char*)YCAT + (size_t)row * DM + 256 + chn * 8) = w; }
                }
            }
            }
        }
        SEAM(pb + 3);
        if (IN(pb + 4) && PHON(6)) {
            PHASE_IDS(); (void)tid;
            gm::K2 k; k.S.init(NTOK, DM, F.G, (int)blockIdx.x); k.A = (const unsigned char*)YCAT; k.Bt = (const unsigned char*)WOUT + (size_t)l * DM * DM; k.O = UB;
            for (int rp = 0; rp < NREP(6); ++rp) gm::gemm_phase<gm::K2>(F.lds, k);
        }
        SEAM(pb + 4);
        if (IN(pb + 5) && PHON(7)) {
            PHASE_IDS();
            NarrowT NT_; nmm_load_router(NT_, AIN(I_RW), wid, lane);
            LAS bf16_t* Sst = (LAS bf16_t*)F.lds; LAS float* Pb = (LAS float*)(F.lds + NMM_P_OFF); LAS float* lgs_all = (LAS float*)(F.lds + NMM_LG_OFF);
            LAS float* lgs = lgs_all + wid * 256;
            LAS int* wcnt = (LAS int*)(F.lds + NMM_LG_OFF + 8192); LAS int* wbase = wcnt + 32;
            if (tid < 32) wcnt[tid] = 0;
            const int b = F.vcu >> 5; const float* md = modl + (size_t)b * 6144;
            const float* lg = AIN(I_LN1G) + l * DM; const float* lb = AIN(I_LN1B) + l * DM;
            f32x4 gv[4], bv[4], sh[4], sc[4], g1[4];
#pragma unroll
            for (int j = 0; j < 4; ++j) { const int cix = 4 * lane + 256 * j; gv[j] = *(const f32x4*)(lg + cix); bv[j] = *(const f32x4*)(lb + cix); g1[j] = *(const f32x4*)(md + 2 * 1024 + cix) + 1.0f;
                sh[j] = *(const f32x4*)(md + 3 * 1024 + cix); sc[j] = *(const f32x4*)(md + 4 * 1024 + cix) + 1.0f; }
            const int rowb = F.vcu * 128 + wid * 16;
            u32x2 xwc[4], ywc[4];
#pragma unroll
            for (int j = 0; j < 4; ++j) { const size_t o = (size_t)rowb * DM + 4 * lane + 256 * j; xwc[j] = (l == 0) ? (u32x2){0u, 0u} : *(const u32x2*)(XB + o); ywc[j] = *(const u32x2*)(UB + o); }
            u32x2 xwn[4] = {xwc[0], xwc[1], xwc[2], xwc[3]}, ywn[4] = {ywc[0], ywc[1], ywc[2], ywc[3]};
            for (int i = 0; i < 16; ++i) { const int row = rowb + i;
                if (i < 15) {
#pragma unroll
                    for (int j = 0; j < 4; ++j) { const size_t o = (size_t)(row + 1) * DM + 4 * lane + 256 * j; if (l != 0) xwn[j] = *(const u32x2*)(XB + o); ywn[j] = *(const u32x2*)(UB + o); } }
                f32x4 v[4]; float s = 0.f;
#pragma unroll
                for (int j = 0; j < 4; ++j) { const size_t o = (size_t)row * DM + 4 * lane + 256 * j;
                    f32x4 xv; if (l == 0) xv = *(const f32x4*)(x_in + o); else { const u32x2 xw = xwc[j]; xv = (f32x4){bflo(xw.x), bfhi(xw.x), bflo(xw.y), bfhi(xw.y)}; }
                    const u32x2 yw = ywc[j]; const f32x4 yv = (f32x4){bflo(yw.x), bfhi(yw.x), bflo(yw.y), bfhi(yw.y)};
                    v[j] = xv * ALPHA + g1[j] * yv; s += (v[j][0] + v[j][1]) + (v[j][2] + v[j][3]); }
#pragma unroll
                for (int j = 0; j < 4; ++j) { xwc[j] = xwn[j]; ywc[j] = ywn[j]; }
                const float mean = wave_sum(s) * (1.f / DM); float s2 = 0.f;
#pragma unroll
                for (int j = 0; j < 4; ++j) { v[j] = v[j] - mean; s2 += (v[j][0] * v[j][0] + v[j][1] * v[j][1]) + (v[j][2] * v[j][2] + v[j][3] * v[j][3]); }
                const float rstd = __builtin_amdgcn_rsqf(wave_sum(s2) * (1.f / DM) + LN_EPS);
#pragma unroll
                for (int j = 0; j < 4; ++j) { const size_t o = (size_t)row * DM + 4 * lane + 256 * j; const f32x4 xn = v[j] * rstd * gv[j] + bv[j];
                    u32x2 xw; xw.x = pk2(xn[0], xn[1]); xw.y = pk2(xn[2], xn[3]); *(u32x2*)(XB + o) = xw;
                    const f32x4 u = xn * sc[j] + sh[j]; u32x2 w; w.x = pk2(u[0], u[1]); w.y = pk2(u[2], u[3]); *(LAS u32x2*)(Sst + (wid * 4 + (i & 3)) * NSP + 4 * lane + 256 * j) = w;
                    *(unsigned*)(U8B + o) = pk4_fp8(u[0], u[1], u[2], u[3]); }
                if ((i & 3) == 3) nmm_step_router(NT_, Sst, Pb, lgs_all, i - 3, tid, wid, lane);
            }
            asm volatile("s_waitcnt lgkmcnt(0)\n\ts_barrier" ::: "memory");
            int bk_ = 0; unsigned lpos_ = 0u; float gi_ = 0.f, gj_ = 0.f;
            if (lane < 16) {
                const float* rb = AIN(I_RB);
                float sco[16], bia[16];
#pragma unroll
                for (int q = 0; q < 4; ++q) { const f32x4 t4 = *(const LAS f32x4*)(lgs + lane * 16 + q * 4);
#pragma unroll
                    for (int c = 0; c < 4; ++c) { const float sg = 1.f / (1.f + fexp(-t4[c])); sco[q * 4 + c] = sg; bia[q * 4 + c] = sg + rb[q * 4 + c]; } }
                int bg = 0; float bgs = -INFINITY;
#pragma unroll
                for (int g = 0; g < 4; ++g) { const float a0 = bia[4 * g], a1 = bia[4 * g + 1], a2 = bia[4 * g + 2], a3 = bia[4 * g + 3];
                    const float h1 = fmaxf(a0, a1), l1 = fminf(a0, a1), h2 = fmaxf(a2, a3), l2 = fminf(a2, a3);
                    const float top = fmaxf(h1, h2), sec = fmaxf(fminf(h1, h2), (h1 >= h2) ? l1 : l2); const float gsc = top + sec;
                    if (gsc > bgs) { bgs = gsc; bg = g; } }
                float gb[4], gsx[4];
#pragma unroll
                for (int q = 0; q < 4; ++q) { gb[q] = (bg == 0) ? bia[q] : (bg == 1) ? bia[4 + q] : (bg == 2) ? bia[8 + q] : bia[12 + q]; gsx[q] = (bg == 0) ? sco[q] : (bg == 1) ? sco[4 + q] : (bg == 2) ? sco[8 + q] : sco[12 + q]; }
                int e1 = 0; float m1 = gb[0];
#pragma unroll
                for (int q = 1; q < 4; ++q) if (gb[q] > m1) { m1 = gb[q]; e1 = q; }
                int e2 = -1; float m2 = -INFINITY;
#pragma unroll
                for (int q = 0; q < 4; ++q) if (q != e1 && gb[q] > m2) { m2 = gb[q]; e2 = q; }
                const int ei = e1 < e2 ? e1 : e2, ej = e1 < e2 ? e2 : e1;
                const float si = (ei == 0) ? gsx[0] : (ei == 1) ? gsx[1] : (ei == 2) ? gsx[2] : gsx[3], sj = (ej == 0) ? gsx[0] : (ej == 1) ? gsx[1] : (ej == 2) ? gsx[2] : gsx[3];
                const int pr_ = (ei == 0) ? ej - 1 : (ei == 1) ? ej + 1 : 5; const int bk = bg * 6 + pr_;
                bk_ = bk; lpos_ = (unsigned)__hip_atomic_fetch_add(wcnt + bk, 1, __ATOMIC_RELAXED, __HIP_MEMORY_SCOPE_WORKGROUP); const float inv = 1.f / (si + sj); gi_ = si * inv; gj_ = sj * inv;
            }
            asm volatile("s_waitcnt lgkmcnt(0)\n\ts_barrier" ::: "memory");
            if (tid < NBUCKET) { gu32* cntw = F.ctl + CW_CNT + (size_t)l * NBUCKET * 64; const int c = wcnt[tid]; wbase[tid] = (c > 0) ? (int)__hip_atomic_fetch_add(cntw + tid * 64, (unsigned)c, RLX_AGENT) : 0; }
            asm volatile("s_waitcnt vmcnt(0) lgkmcnt(0)\n\ts_barrier" ::: "memory");
            if (lane < 16) { const int row = rowb + lane; const unsigned pos = (unsigned)wbase[bk_] + lpos_;
                LTOK[(size_t)bk_ * LCAP + pos] = row; LGATE[((size_t)bk_ * LCAP + pos) * 2] = gi_; LGATE[((size_t)bk_ * LCAP + pos) * 2 + 1] = gj_;
                TOKSLOT[row] = (bk_ << 16) | (int)pos;
            }
            __syncthreads();
        }
        SEAM(pb + 5);
        if ((IN(pb + 6) || IN(pb + 7)) && PHON(8)) {
            PHASE_IDS();
            LAS int* tb = (LAS int*)(F.lds + MOE_TB_OFF);
            if (tid == 0) { gu32* cntw = F.ctl + CW_CNT + (size_t)l * NBUCKET * 64; int acc = 0;
                for (int k = 0; k < NBUCKET; ++k) { const int c = (int)__hip_atomic_load(cntw + k * 64, RLX_AGENT); tb[k] = c; tb[32 + k] = acc; acc += (c + 255) >> 8; }
                tb[32 + NBUCKET] = acc; }
            __syncthreads();
            if (IN(pb + 6)) {
                gm::K4 k; k.U = U8B; k.Wgu = WGU8; k.H = H8B; k.ltok = LTOK; k.lgate = LGATE; k.tb = tb; k.G = F.G; k.vcu = F.vcu; k.rtc = F.ctl + CW_RT + (size_t)l * 160 * 64;
                for (int rp = 0; rp < NREP(8); ++rp) gm::gemm_phase<gm::K4>(F.lds, k);
            }
            SEAM(pb + 6);
            if (IN(pb + 7)) {
                gm::K5 k; k.H = H8B; k.Wd = WD8; k.Y = YSORT; k.tb = tb; k.G = F.G; k.vcu = F.vcu; k.rtc = F.ctl + CW_RT + (size_t)l * 160 * 64; k.tmo = F.ctl + CW_TMO;
                for (int rp = 0; rp < NREP(14); ++rp) gm::gemm_phase<gm::K5>(F.lds, k);
            }
        }
        SEAM(pb + 7);
        if (IN(pb + 8) && PHON(9)) {
            PHASE_IDS();
            const int b = F.vcu >> 5; const bool lastl = (l == DEPTH - 1);
            LAS bf16_t* Sst = (LAS bf16_t*)F.lds; LAS float* Pb = (LAS float*)(F.lds + NMM_P_OFF); LAS int* t0 = (LAS int*)(F.lds + MOE_TB_OFF);
            NarrowT NT_; nmm_load_tail(NT_, WIN + ((size_t)(lastl ? l : l + 1) * PW + PP) * DM, wid, lane);
            if (tid == 0) { gu32* cntw = F.ctl + CW_CNT + (size_t)l * NBUCKET * 64; int acc = 0;
                for (int k = 0; k < NBUCKET; ++k) { const int c = (int)__hip_atomic_load(cntw + k * 64, RLX_AGENT); t0[32 + k] = acc; acc += (c + 255) >> 8; } }
            __syncthreads();
            const float* mdn = MOD + ((size_t)(lastl ? l : l + 1) * NB + b) * 6144; const float* md = modl + (size_t)b * 6144;
            const float* lg = AIN(I_LN2G) + l * DM; const float* lb = AIN(I_LN2B) + l * DM;
            f32x4 gv[4], bv[4], sh[4], sc[4], g2[4];
#pragma unroll
            for (int j = 0; j < 4; ++j) { const int cix = 4 * lane + 256 * j; gv[j] = *(const f32x4*)(lg + cix); bv[j] = *(const f32x4*)(lb + cix); g2[j] = *(const f32x4*)(md + 5 * 1024 + cix) + 1.0f;
                sh[j] = *(const f32x4*)(mdn + cix); sc[j] = *(const f32x4*)(mdn + 1024 + cix) + 1.0f; }
            const int rowb = F.vcu * 128 + wid * 16;
            const int tsl = TOKSLOT[rowb + (lane & 15)];
            u32x2 xwc[4], ywc[4];
            { const int ts = __shfl(tsl, 0); const size_t yrow = (size_t)t0[32 + (ts >> 16)] * 256 + (ts & 0xffff);
#pragma unroll
              for (int j = 0; j < 4; ++j) { const int cix = 4 * lane + 256 * j; xwc[j] = *(const u32x2*)(XB + (size_t)rowb * DM + cix); ywc[j] = *(const u32x2*)(YSORT + yrow * DM + cix); } }
            u32x2 xwn[4] = {xwc[0], xwc[1], xwc[2], xwc[3]}, ywn[4] = {ywc[0], ywc[1], ywc[2], ywc[3]};
            for (int i = 0; i < 16; ++i) { const int row = rowb + i;
                if (i < 15) { const int ts = __shfl(tsl, i + 1); const size_t yrow = (size_t)t0[32 + (ts >> 16)] * 256 + (ts & 0xffff);
#pragma unroll
                    for (int j = 0; j < 4; ++j) { const int cix = 4 * lane + 256 * j; xwn[j] = *(const u32x2*)(XB + (size_t)(row + 1) * DM + cix); ywn[j] = *(const u32x2*)(YSORT + yrow * DM + cix); } }
                f32x4 v[4]; float s = 0.f;
#pragma unroll
                for (int j = 0; j < 4; ++j) {
                    const u32x2 xw = xwc[j]; const f32x4 xv = (f32x4){bflo(xw.x), bfhi(xw.x), bflo(xw.y), bfhi(xw.y)};
                    const u32x2 yw = ywc[j]; const f32x4 yv = (f32x4){bflo(yw.x), bfhi(yw.x), bflo(yw.y), bfhi(yw.y)};
                    v[j] = xv * ALPHA + g2[j] * yv; s += (v[j][0] + v[j][1]) + (v[j][2] + v[j][3]); }
#pragma unroll
                for (int j = 0; j < 4; ++j) { xwc[j] = xwn[j]; ywc[j] = ywn[j]; }
                const float mean = wave_sum(s) * (1.f / DM); float s2 = 0.f;
#pragma unroll
                for (int j = 0; j < 4; ++j) { v[j] = v[j] - mean; s2 += (v[j][0] * v[j][0] + v[j][1] * v[j][1]) + (v[j][2] * v[j][2] + v[j][3] * v[j][3]); }
                const float rstd = __builtin_amdgcn_rsqf(wave_sum(s2) * (1.f / DM) + LN_EPS);
#pragma unroll
                for (int j = 0; j < 4; ++j) { const size_t o = (size_t)row * DM + 4 * lane + 256 * j; const f32x4 xn = v[j] * rstd * gv[j] + bv[j];
                    if (lastl) *(f32x4*)(ap->out + o) = xn;
                    else { u32x2 xw; xw.x = pk2(xn[0], xn[1]); xw.y = pk2(xn[2], xn[3]); *(u32x2*)(XB + o) = xw;
                        const f32x4 u = xn * sc[j] + sh[j]; u32x2 w; w.x = pk2(u[0], u[1]); w.y = pk2(u[2], u[3]); *(LAS u32x2*)(Sst + (wid * 4 + (i & 3)) * NSP + 4 * lane + 256 * j) = w;
                        *(unsigned*)(U8B + o) = pk4_fp8(u[0], u[1], u[2], u[3]); } }
                if (!lastl && (i & 3) == 3) nmm_step_tail(NT_, Sst, Pb, TAILB + (size_t)(F.vcu * 128) * 32, i - 3, tid, wid, lane);
            }
        }
        SEAM(pb + 8);
    }
#undef IN
#undef SEAM
}

extern "C" void kernel_launch(void* const* d_in, const int* in_sizes, int n_in, void* d_out, int out_size, void* d_ws, size_t ws_size, hipStream_t stream) {
    static int grid = 0;
    if (grid == 0) {
        if (n_in != 29 || in_sizes[0] != NTOK * DM || out_size != NTOK * DM || ws_size < WS_END) {
            fprintf(stderr, "kernel_launch: unexpected shapes (n_in %d, in0 %d, out %d, ws %zu need %zu); nothing launched\n", n_in, n_in > 0 ? in_sizes[0] : -1, out_size, ws_size, (size_t)WS_END); grid = -1; return; }
        int dev = 0, cus = 0, per_cu = 0;
        if (hipGetDevice(&dev) != hipSuccess || hipDeviceGetAttribute(&cus, hipDeviceAttributeMultiprocessorCount, dev) != hipSuccess) { grid = -1; return; }
        if (hipFuncSetAttribute((const void*)mega_fwd, hipFuncAttributeMaxDynamicSharedMemorySize, LDS_BYTES) != hipSuccess) { fprintf(stderr, "kernel_launch: hipFuncSetAttribute failed\n"); grid = -1; return; }
        if (hipOccupancyMaxActiveBlocksPerMultiprocessor(&per_cu, (const void*)mega_fwd, 512, LDS_BYTES) != hipSuccess || per_cu < 1) { fprintf(stderr, "kernel_launch: occupancy query reports %d\n", per_cu); }
        (void)hipGetLastError();
        grid = cus;
        if (grid != 256) fprintf(stderr, "kernel_launch: %d CUs (row phases assume 256)\n", grid);
    }
    if (grid < 0) return;
    if (hipMemsetAsync((char*)d_ws + WS_CTL, 0, CTL_ZERO_BYTES, stream) != hipSuccess) return;
    Args a{};
    for (int i = 0; i < 29; ++i) a.in[i] = (const float*)d_in[i];
    a.out = (float*)d_out; a.ws = (unsigned char*)d_ws;
#if MK_ONE_LAUNCH
    a.ph_lo = 0; a.ph_hi = N_PHASES;
    hipLaunchKernelGGL(mega_fwd, dim3(grid), dim3(512), LDS_BYTES, stream, a);
#else
    for (int p = 0; p < N_PHASES; ++p) { a.ph_lo = p; a.ph_hi = p + 1; hipLaunchKernelGGL(mega_fwd, dim3(grid), dim3(512), LDS_BYTES, stream, a); }
#endif
}
```

```cpp
#include <hip/hip_runtime.h>
#include <hip/hip_bf16.h>
#include <cstdio>
#include <cstdint>
#include <cmath>

#ifndef MK_ONE_LAUNCH
#define MK_ONE_LAUNCH 1
#endif
#ifndef PHM
#define PHM 0xFFFF
#endif
#define PHON(n) (((PHM) >> (n)) & 1)
#ifndef REPM
#define REPM 0
#endif
#define NREP(n) ((((REPM) >> (n)) & 1) ? 2 : 1)

#define LAS __attribute__((address_space(3)))
#define GAS __attribute__((address_space(1)))
typedef unsigned short bf16_t;
typedef short bf16x8 __attribute__((ext_vector_type(8)));
typedef float f32x4 __attribute__((ext_vector_type(4)));
typedef float f32x2 __attribute__((ext_vector_type(2)));
typedef unsigned u32x4 __attribute__((ext_vector_type(4)));
typedef unsigned u32x2 __attribute__((ext_vector_type(2)));
typedef GAS unsigned gu32;

constexpr int NB = 8, SEQ = 4096, NTOK = NB * SEQ, DM = 1024, DEPTH = 4, NH = 4, HD = 64, PIN = 3608, PP = 3584, PW = 3840, NE = 16, DE = 512;
constexpr int NCH = SEQ / 64;
constexpr float ALPHA = 1.6817928305074290f;
constexpr float LN_EPS = 1e-6f;
constexpr float ATT_C2 = 0.17677669529663687f * 1.4426950408889634f;
constexpr int NBUCKET = 24, LCAP = NTOK;
constexpr int PJ = 256, TSZ = NTOK * 256;
constexpr int C_MQ = 0, C_MK = TSZ, C_MV = 2 * TSZ, C_MO = 3 * TSZ, C_CB = 4 * TSZ, C_CC = 5 * TSZ, C_CH = 6 * TSZ, C_DQ = 7 * TSZ, C_DK = 8 * TSZ, C_DV = 9 * TSZ,
              C_GQ = 10 * TSZ, C_GK = 11 * TSZ, C_GV = 12 * TSZ, C_GR = 13 * TSZ;
constexpr int T_GA = 0, T_MI = 16, T_MF = 20;

constexpr size_t MiB = 1u << 20;
constexpr size_t WS_CTL = 0, CTL_ZERO_BYTES = 1 * MiB;
constexpr size_t WS_MOD = 1 * MiB;
constexpr size_t WS_ROPE = 2 * MiB;
constexpr size_t WS_WIN = 3 * MiB;
constexpr size_t WS_WOUT = 33 * MiB;
constexpr size_t WS_WGU = 41 * MiB;
constexpr size_t WS_WD = 73 * MiB;
constexpr size_t WS_LTOK = 89 * MiB;
constexpr size_t WS_LGATE = 92 * MiB;
constexpr size_t WS_SM = 98 * MiB;
constexpr size_t WS_PROJ = 100 * MiB;
constexpr size_t WS_XR = 340 * MiB;
constexpr size_t WS_U = 468 * MiB;
constexpr size_t WS_YCAT = 532 * MiB;
constexpr size_t WS_TAIL = 596 * MiB;
constexpr size_t WS_YSORT = WS_PROJ + 100 * MiB;
constexpr size_t WS_U8 = 600 * MiB;
constexpr size_t WS_WIN8 = 632 * MiB;
constexpr size_t WS_END = 648 * MiB;
constexpr size_t SM_N = 0, SM_BC = 512 * 1024, SM_DM = 520 * 1024, SM_MS = 528 * 1024, SM_GBE = 1 * MiB, SM_TS = 1536 * 1024;
constexpr int CW_TMO = 0, CW_CODE = 1, CW_ZPAGE = 256, CW_BAR = 4096, CW_CNT = 16384, CW_RT = 24576;
constexpr int RING_BYTES = 131072, LDSCTL_OFF = RING_BYTES, MISC_OFF = LDSCTL_OFF + 320, MOE_TB_OFF = LDSCTL_OFF + 1024, LDS_BYTES = 147456;

#define RLX_AGENT __ATOMIC_RELAXED, __HIP_MEMORY_SCOPE_AGENT
#define LDS_WAIT() asm volatile("s_waitcnt lgkmcnt(0)" ::: "memory")
#define VM_WAIT() asm volatile("s_waitcnt vmcnt(0)" ::: "memory")

__device__ __forceinline__ unsigned f2bf(float f) { unsigned u = __builtin_bit_cast(unsigned, f); return (u + 0x7fffu + ((u >> 16) & 1u)) >> 16; }
__device__ __forceinline__ unsigned pk2(float lo, float hi) { typedef __bf16 bf2 __attribute__((ext_vector_type(2))); f32x2 v = {lo, hi}; bf2 b = __builtin_convertvector(v, bf2); return __builtin_bit_cast(unsigned, b); }
__device__ __forceinline__ unsigned pk4_fp8(float a, float b, float c, float d) {
    a = __builtin_amdgcn_fmed3f(a, -448.f, 448.f); b = __builtin_amdgcn_fmed3f(b, -448.f, 448.f); c = __builtin_amdgcn_fmed3f(c, -448.f, 448.f); d = __builtin_amdgcn_fmed3f(d, -448.f, 448.f);
    int w = 0; w = __builtin_amdgcn_cvt_pk_fp8_f32(a, b, w, false); w = __builtin_amdgcn_cvt_pk_fp8_f32(c, d, w, true); return (unsigned)w; }
__device__ __forceinline__ void st8_wt(void* p, u32x2 v) { asm volatile("global_store_dwordx2 %0, %1, off sc1\n\ts_nop 0" :: "v"(p), "v"(v) : "memory"); }
constexpr float W8S = 64.f, H8S = 16.f, Y8S = 8.f;
__device__ __forceinline__ float bf2f(unsigned b) { return __builtin_bit_cast(float, b << 16); }
__device__ __forceinline__ float bflo(unsigned w) { return __builtin_bit_cast(float, w << 16); }
__device__ __forceinline__ float bfhi(unsigned w) { return __builtin_bit_cast(float, w & 0xffff0000u); }
__device__ __forceinline__ void st16_wt(void* p, u32x4 v) { asm volatile("global_store_dwordx4 %0, %1, off sc1\n\ts_nop 1" :: "v"(p), "v"(v) : "memory"); }
__device__ __forceinline__ float wave_sum(float v) {
#pragma unroll
    for (int o = 1; o < 64; o <<= 1) v += __shfl_xor(v, o);
    return v;
}
__device__ __forceinline__ float wave_max(float v) {
#pragma unroll
    for (int o = 1; o < 64; o <<= 1) v = fmaxf(v, __shfl_xor(v, o));
    return v;
}
__device__ __forceinline__ float fexp(float x) { return __builtin_amdgcn_exp2f(x * 1.4426950408889634f); }
__device__ __forceinline__ float flog(float x) { return __builtin_amdgcn_logf(x) * 0.6931471805599453f; }
__device__ __forceinline__ float logsig(float z) { return fminf(z, 0.f) - flog(1.f + fexp(-fabsf(z))); }
__device__ __forceinline__ float sigmoidf_(float z) { return 1.f / (1.f + fexp(-z)); }

#define XB_TMO      128
#define XB_XCNT(j)  (256  + 64 * (j))
#define XB_XSUB(j)  (1280 + 64 * (j))
#define XB_XGEN(j)  (2304 + 64 * (j))
#define XB_TOP      3328
#define XB_TOPGEN   3392
#define XCD_BAR_WORDS 3456
#define XB_SPIN_CAP (1u << 18)
__device__ __forceinline__ unsigned xb_ld(unsigned* p)              { return __hip_atomic_load(p, __ATOMIC_RELAXED, __HIP_MEMORY_SCOPE_AGENT); }
__device__ __forceinline__ unsigned xb_add(unsigned* p, unsigned v) { return __hip_atomic_fetch_add(p, v, __ATOMIC_RELAXED, __HIP_MEMORY_SCOPE_AGENT); }
__device__ __forceinline__ unsigned xb_xcc_id() { return (unsigned)__builtin_amdgcn_s_getreg((3 << 11) | 20) & 0xFu; }
#define XB_SPIN(cond, bar) do { unsigned _sp = 0; while (cond) { __builtin_amdgcn_s_sleep(1); \
    if ((++_sp & 255u) == 0u) { if (xb_ld(&(bar)[XB_TMO])) break; if (_sp > XB_SPIN_CAP) { atomicAdd(&(bar)[XB_TMO], 1u); break; } } } } while (0)
struct XcdBarrier { unsigned* bar; unsigned x; volatile LAS unsigned* st; };
__device__ __forceinline__ XcdBarrier xcd_barrier_post(unsigned* bar, volatile LAS unsigned* st) {
    XcdBarrier b; b.bar = bar; b.x = xb_xcc_id(); b.st = st;
    if (threadIdx.x == 0) (void)xb_add(&bar[XB_XCNT(b.x)], 1u);
    return b;
}
__device__ __forceinline__ void xcd_barrier_complete(unsigned* bar, unsigned x, unsigned& nloc, unsigned& nx) {
    const unsigned G = gridDim.x * gridDim.y * gridDim.z;
    unsigned sum, cnt, mine, sp = 0u;
    for (;;) {
        sum = 0u; cnt = 0u; mine = 0u;
#pragma unroll
        for (unsigned j = 0; j < 16; ++j) { const unsigned c = xb_ld(&bar[XB_XCNT(j)]); sum += c; cnt += (c > 0u) ? 1u : 0u; mine = (j == x) ? c : mine; }
        if (sum == G) break;
        __builtin_amdgcn_s_sleep(1);
        if ((++sp & 255u) == 0u) { if (xb_ld(&bar[XB_TMO])) break; if (sp > XB_SPIN_CAP) { atomicAdd(&bar[XB_TMO], 1u); break; } }
    }
    nloc = mine > 0u ? mine : 1u; nx = cnt > 0u ? cnt : 1u;
}
__device__ __forceinline__ void xcd_barrier(const XcdBarrier& b) {
    asm volatile("s_waitcnt vmcnt(0)" ::: "memory");
    __syncthreads();
    if (threadIdx.x == 0) {
        unsigned* bar = b.bar;
        __builtin_amdgcn_s_waitcnt(0);
        unsigned nloc = b.st[0], nx = b.st[1];
        if (nloc == 0u) { xcd_barrier_complete(bar, b.x, nloc, nx); b.st[0] = nloc; b.st[1] = nx; }
        const unsigned old = xb_add(&bar[XB_XSUB(b.x)], 1u);
        const unsigned gen = old / nloc;
        if (old + 1u == (gen + 1u) * nloc) {
            __builtin_amdgcn_fence(__ATOMIC_RELEASE, "agent");
            asm volatile("s_waitcnt vmcnt(0)" ::: "memory");
            const unsigned og = xb_add(&bar[XB_TOP], 1u);
            const unsigned tg = og / nx;
            if (og + 1u == (tg + 1u) * nx) xb_add(&bar[XB_TOPGEN], 1u);
            else XB_SPIN(xb_ld(&bar[XB_TOPGEN]) == tg, bar);
            __builtin_amdgcn_fence(__ATOMIC_ACQUIRE, "agent");
            xb_add(&bar[XB_XGEN(b.x)], 1u);
            asm volatile("s_waitcnt vmcnt(0)" ::: "memory");
        } else {
            XB_SPIN(xb_ld(&bar[XB_XGEN(b.x)]) == gen, bar);
            __builtin_amdgcn_fence(__ATOMIC_ACQUIRE, "agent");
            asm volatile("s_waitcnt vmcnt(0)" ::: "memory");
        }
    }
    __syncthreads();
}

namespace gm {
constexpr int BM = 256, BK = 64, HALF = 128, HTB = HALF * BK * 2, NXCD = 8, WGM = 8;
typedef int v4i_t __attribute__((ext_vector_type(4))); typedef int v8i_t __attribute__((ext_vector_type(8)));
__host__ __device__ __forceinline__ int lds_byte(int r, int c) { const int st = (r >> 4) * 2 + (c >> 5), rr = r & 15, cc = c & 31, ob = rr * 64 + cc * 2; return st * 1024 + (ob ^ (((ob >> 9) & 1) << 5)); }
__host__ __device__ __forceinline__ void stage_rc(int b, int& R, int& C) { const int st = b / 1024, sb = b % 1024, swz = sb ^ (((sb >> 9) & 1) << 5); R = (st >> 1) * 16 + swz / 64; C = (st & 1) * 32 + (swz % 64) / 2; }
__host__ __device__ __forceinline__ int perm32(int rho) { const int n = rho >> 4, i = rho & 15; return 8 * (i >> 2) + 4 * n + (i & 3); }
struct Unit { int pm, pn, bk, tb; };
struct Src { const char* a; const char* b0; const char* b1; unsigned va[2][2]; };
struct StaticOrder {
    int nM, nN, nwg, G, c;
    __device__ void init(int M, int N, int G_, int c_) { nM = M / BM; nN = N / BM; nwg = nM * nN; G = G_; c = c_; }
    __device__ __forceinline__ bool next(int i, Unit& u) const {
        const long L = (long)i * G + c; if (L >= nwg) return false;
        int wgid = (int)L; { const int q = nwg / NXCD, r = nwg % NXCD, xcd = wgid % NXCD, off = wgid / NXCD; wgid = (xcd < r ? xcd * (q + 1) : r * (q + 1) + (xcd - r) * q) + off; }
        const int nig = WGM * nN, gid = wgid / nig, fm = gid * WGM, gsz = (nM - fm) < WGM ? (nM - fm) : WGM;
        u.pm = fm + ((wgid % nig) % gsz); u.pn = (wgid % nig) / gsz; u.bk = 0; u.tb = 0; return true;
    }
};

template <class Kind>
__device__ __forceinline__ void gemm_phase(LAS unsigned char* lds, const Kind& Kd) {
    int tid_ = threadIdx.x; asm volatile("" : "+v"(tid_));
    const int tid = tid_, wid = __builtin_amdgcn_readfirstlane(tid >> 6), lane = tid & 63, wr = wid >> 2, wc = wid & 3, fr = lane & 15, fq = lane >> 4;
    int R[2], C[2]; unsigned voffB[2];
#pragma unroll
    for (int i = 0; i < 2; ++i) { stage_rc(tid * 16 + i * 8192, R[i], C[i]); const int Rb = Kind::PERM ? ((R[i] & ~31) + perm32(R[i] & 31)) : R[i]; voffB[i] = (unsigned)(Rb * Kind::LDBB + C[i] * 2); }
    const size_t hstepB = (size_t)HALF * Kind::LDBB;
    constexpr int NT = Kind::NTK;
    const unsigned ldsw = (unsigned)wid * 1024u;
    const int aoff = lds_byte(wr * 64 + fr, fq * 8), boff = lds_byte(wc * 32 + fr, fq * 8);
#define G_SA(b, h) (((b) * 2 + (h)) * HTB)
#define G_SB(b, h) ((4 + (b) * 2 + (h)) * HTB)
#define G_STAGE_A(bufoff, S, t, h) do { const char* _g = (S).a + (size_t)(t) * 128; _Pragma("unroll") for (int _i = 0; _i < 2; ++_i) \
        __builtin_amdgcn_global_load_lds((const unsigned*)(_g + (S).va[h][_i]), (LAS unsigned*)(lds + (bufoff) + ldsw + _i * 8192), 16, 0, 0); } while (0)
#define G_STAGE_B(bufoff, S, t, h) do { const char* _g = (((t) < NT / 2) ? (S).b0 + (size_t)(t) * 128 : (S).b1 + (size_t)((t) - NT / 2) * 128) + (h) * hstepB; _Pragma("unroll") for (int _i = 0; _i < 2; ++_i) \
        __builtin_amdgcn_global_load_lds((const unsigned*)(_g + voffB[_i]), (LAS unsigned*)(lds + (bufoff) + ldsw + _i * 8192), 16, 0, 0); } while (0)
#define G_LDA(dst, b, h) do { _Pragma("unroll") for (int m = 0; m < 4; ++m) _Pragma("unroll") for (int k = 0; k < 2; ++k) dst[m][k] = *(const LAS bf16x8*)(lds + G_SA(b, h) + aoff + m * 2048 + k * 1024); } while (0)
#define G_LDB(dst, b, h) do { _Pragma("unroll") for (int n = 0; n < 2; ++n) _Pragma("unroll") for (int k = 0; k < 2; ++k) dst[n][k] = *(const LAS bf16x8*)(lds + G_SB(b, h) + boff + n * 2048 + k * 1024); } while (0)
#define G_MMA(ai, bj, At, Bt) do { __builtin_amdgcn_s_setprio(1); _Pragma("unroll") for (int m = 0; m < 4; ++m) _Pragma("unroll") for (int n = 0; n < 2; ++n) _Pragma("unroll") for (int k = 0; k < 2; ++k) \
        acc[ai][bj][m][n] = __builtin_amdgcn_mfma_f32_16x16x32_bf16(Bt[n][k], At[m][k], acc[ai][bj][m][n], 0, 0, 0); __builtin_amdgcn_s_setprio(0); } while (0)
#define G_LDA8(dst, b, h) do { _Pragma("unroll") for (int m = 0; m < 4; ++m) { const v4i_t _lo = *(const LAS v4i_t*)(lds + G_SA(b, h) + aoff + m * 2048), _hi = *(const LAS v4i_t*)(lds + G_SA(b, h) + aoff + m * 2048 + 1024); \
        dst[m] = __builtin_shufflevector(_lo, _hi, 0, 1, 2, 3, 4, 5, 6, 7); } } while (0)
#define G_LDB8(dst, b, h) do { _Pragma("unroll") for (int n = 0; n < 2; ++n) { const v4i_t _lo = *(const LAS v4i_t*)(lds + G_SB(b, h) + boff + n * 2048), _hi = *(const LAS v4i_t*)(lds + G_SB(b, h) + boff + n * 2048 + 1024); \
        dst[n] = __builtin_shufflevector(_lo, _hi, 0, 1, 2, 3, 4, 5, 6, 7); } } while (0)
#define G_MMA8(ai, bj, A8_, B8_) do { __builtin_amdgcn_s_setprio(1); _Pragma("unroll") for (int m = 0; m < 4; ++m) _Pragma("unroll") for (int n = 0; n < 2; ++n) \
        asm volatile("v_mfma_scale_f32_16x16x128_f8f6f4 %0, %1, %2, %0, %3, %3 op_sel_hi:[0,0,0]" : "+v"(acc[ai][bj][m][n]) : "v"(B8_[n]), "v"(A8_[m]), "v"(sc1v)); __builtin_amdgcn_s_setprio(0); } while (0)
#define X_LDA(b, h) do { if constexpr (Kind::FP8) G_LDA8(A8, b, h); else G_LDA(At, b, h); } while (0)
#define X_LDB0(b, h) do { if constexpr (Kind::FP8) G_LDB8(B08, b, h); else G_LDB(B0, b, h); } while (0)
#define X_LDB1(b, h) do { if constexpr (Kind::FP8) G_LDB8(B18, b, h); else G_LDB(B1, b, h); } while (0)
#define X_MM0(ai, bj) do { if constexpr (Kind::FP8) G_MMA8(ai, bj, A8, B08); else G_MMA(ai, bj, At, B0); } while (0)
#define X_MM1(ai, bj) do { if constexpr (Kind::FP8) G_MMA8(ai, bj, A8, B18); else G_MMA(ai, bj, At, B1); } while (0)
#define G_WAIT_V(n) asm volatile("s_waitcnt vmcnt(" #n ")" ::: "memory")
#define G_WAIT_L(n) asm volatile("s_waitcnt lgkmcnt(" #n ")" ::: "memory")
#define G_BAR __builtin_amdgcn_s_barrier()
#define G_SCHED __builtin_amdgcn_sched_barrier(0)
    Unit cur, nxt; Src sc, sn; int ui = 0; int pend = -1;
    if (!Kd.next(0, cur)) return;
    Kd.src(cur, sc, R, C);
    Kd.a_ready(cur, wid);
    f32x4 acc[2][2][4][2];
#pragma unroll
    for (int a = 0; a < 2; ++a)
#pragma unroll
        for (int b = 0; b < 2; ++b)
#pragma unroll
            for (int m = 0; m < 4; ++m)
#pragma unroll
                for (int n = 0; n < 2; ++n) acc[a][b][m][n] = (f32x4){0.f, 0.f, 0.f, 0.f};
    bf16x8 At[4][2], B0[2][2], B1[2][2]; v8i_t A8[4], B08[2], B18[2]; int sc1v = 0x7f7f7f7f; asm volatile("" : "+v"(sc1v));
    G_STAGE_B(G_SB(0, 0), sc, 0, 0); G_STAGE_B(G_SB(0, 1), sc, 0, 1); G_STAGE_A(G_SA(0, 0), sc, 0, 0); G_STAGE_A(G_SA(0, 1), sc, 0, 1);
    if (wr == 1) G_BAR;
    G_WAIT_V(2); G_BAR;
    G_STAGE_B(G_SB(1, 0), sc, 1, 0); G_STAGE_A(G_SA(1, 0), sc, 1, 0); G_STAGE_B(G_SB(1, 1), sc, 1, 1);
    G_WAIT_V(6); G_BAR;
    for (;;) {
        const bool has_next = Kd.next(ui + 1, nxt);
        if (has_next) Kd.src(nxt, sn, R, C); else sn = sc;
#pragma unroll 1
        for (int t = 0; t < NT; t += 2) {
            const bool last = (t == NT - 2);
            if (last && has_next) Kd.a_ready(nxt, wid);
            Src s2; s2.a = last ? sn.a : sc.a; s2.b0 = last ? sn.b0 : sc.b0; s2.b1 = last ? sn.b1 : sc.b1;
            s2.va[0][0] = last ? sn.va[0][0] : sc.va[0][0]; s2.va[0][1] = last ? sn.va[0][1] : sc.va[0][1]; s2.va[1][0] = last ? sn.va[1][0] : sc.va[1][0]; s2.va[1][1] = last ? sn.va[1][1] : sc.va[1][1];
            const int t2 = last ? 0 : t + 2, t3 = t2 + 1;
            X_LDB0(0, 0); X_LDB1(0, 1); G_SCHED; X_LDA(0, 0); G_STAGE_A(G_SA(1, 1), sc, t + 1, 1);
            G_WAIT_V(8); G_WAIT_L(0); G_BAR; X_MM0(0, 0); X_MM1(0, 1); G_BAR; G_SCHED;
            X_LDA(0, 1); G_STAGE_B(G_SB(0, 0), s2, t2, 0); G_STAGE_B(G_SB(0, 1), s2, t2, 1); G_STAGE_A(G_SA(0, 0), s2, t2, 0);
            G_WAIT_V(8); G_WAIT_L(0); G_BAR; X_MM0(1, 0); X_MM1(1, 1); G_BAR; G_SCHED;
            X_LDB0(1, 0); X_LDB1(1, 1); G_SCHED; X_LDA(1, 0); G_STAGE_A(G_SA(0, 1), s2, t2, 1);
            G_WAIT_V(8); G_WAIT_L(0); G_BAR; X_MM0(0, 0); X_MM1(0, 1); G_BAR; G_SCHED;
            X_LDA(1, 1); G_STAGE_B(G_SB(1, 0), s2, t3, 0); G_STAGE_B(G_SB(1, 1), s2, t3, 1); G_STAGE_A(G_SA(1, 0), s2, t3, 0);
            G_WAIT_V(8); G_WAIT_L(0); G_BAR; X_MM0(1, 0); X_MM1(1, 1); G_BAR; G_SCHED;
        }
        if (wr == 0) G_BAR;
        if (Kind::PUBLISH) { if (pend >= 0) Kd.publish(pend); pend = cur.pm; }
        if (Kind::FP8) asm volatile("s_nop 15\n\ts_nop 15" ::: "memory");
        Kd.epi(acc, cur, wr, wc, fr, fq);
        if (!has_next) break;
#pragma unroll
        for (int a = 0; a < 2; ++a)
#pragma unroll
            for (int b = 0; b < 2; ++b)
#pragma unroll
                for (int m = 0; m < 4; ++m)
#pragma unroll
                    for (int n = 0; n < 2; ++n) acc[a][b][m][n] = (f32x4){0.f, 0.f, 0.f, 0.f};
        cur = nxt; sc = sn; ++ui;
        if (wr == 1) G_BAR;
    }
    G_WAIT_V(0);
    if (Kind::PUBLISH) { if (pend >= 0) Kd.publish(pend); }
    G_BAR;
#undef G_SA
#undef G_SB
#undef G_STAGE_A
#undef G_STAGE_B
#undef G_LDA
#undef G_LDB
#undef G_MMA
#undef G_MMA8
#undef G_LDA8
#undef G_LDB8
#undef X_LDA
#undef X_LDB0
#undef X_LDB1
#undef X_MM0
#undef X_MM1
#undef G_WAIT_V
#undef G_WAIT_L
#undef G_BAR
#undef G_SCHED
}

__device__ __forceinline__ void src_direct(Src& s, const void* A, int row0, const int (&R)[2], const int (&C)[2], int pitchb = 2048) {
    s.a = (const char*)A + (size_t)row0 * pitchb;
#pragma unroll
    for (int h = 0; h < 2; ++h)
#pragma unroll
        for (int i = 0; i < 2; ++i) s.va[h][i] = (unsigned)((h * HALF + R[i]) * pitchb + C[i] * 2);
}

template <bool F8> struct K1 {
    static constexpr bool PERM = true, PUBLISH = false, FP8 = F8; static constexpr int LDBB = F8 ? 1024 : 2048, NTK = F8 ? 8 : 16;
    __device__ __forceinline__ void publish(int) const {}
    __device__ __forceinline__ void a_ready(const Unit&, int) const {}
    __device__ __forceinline__ void done(const Unit&) const {}
    StaticOrder S; const void* A; const void* Bt; bf16_t* O; const float* rope;
    __device__ __forceinline__ bool next(int i, Unit& u) const { return S.next(i, u); }
    __device__ __forceinline__ void src(const Unit& u, Src& s, const int (&R)[2], const int (&C)[2]) const {
        src_direct(s, A, u.pm * BM, R, C, F8 ? 1024 : 2048); s.b0 = (const char*)Bt + (size_t)u.pn * BM * (F8 ? 1024 : 2048); s.b1 = s.b0 + (F8 ? 512 : 1024);
    }
    __device__ __forceinline__ void epi(const f32x4 (&acc)[2][2][4][2], const Unit& u, int wr, int wc, int fr, int fq) const {
        const int row0 = u.pm * BM + wr * 64 + fr, col0 = u.pn * TSZ + wc * 32 + 8 * fq;
        if (u.pn == 7 || u.pn == 8) {
#pragma unroll
            for (int ai = 0; ai < 2; ++ai)
#pragma unroll
                for (int m = 0; m < 4; ++m) {
                    const int row = row0 + ai * HALF + m * 16;
                    const f32x4 cs = *(const f32x4*)(rope + (size_t)row * 8), sn = *(const f32x4*)(rope + (size_t)row * 8 + 4);
                    bf16_t* rowp = O + (size_t)row * PJ + col0;
#pragma unroll
                    for (int bj = 0; bj < 2; ++bj) {
                        f32x4 v0 = acc[ai][bj][m][0], v1 = acc[ai][bj][m][1]; if (F8) { v0 = v0 * (1.f / W8S); v1 = v1 * (1.f / W8S); }
                        if (fq == 0) { const f32x4 x1 = v0, x2 = v1; v0 = x1 * cs - x2 * sn; v1 = x2 * cs + x1 * sn; }
                        u32x4 w; w.x = pk2(v0[0], v0[1]); w.y = pk2(v0[2], v0[3]); w.z = pk2(v1[0], v1[1]); w.w = pk2(v1[2], v1[3]);
                        *(u32x4*)(rowp + bj * HALF) = w;
                    }
                }
        } else {
#pragma unroll
            for (int ai = 0; ai < 2; ++ai)
#pragma unroll
                for (int m = 0; m < 4; ++m) { bf16_t* rowp = O + (size_t)(row0 + ai * HALF + m * 16) * PJ + col0;
#pragma unroll
                    for (int bj = 0; bj < 2; ++bj) { f32x4 v0 = acc[ai][bj][m][0], v1 = acc[ai][bj][m][1]; if (F8) { v0 = v0 * (1.f / W8S); v1 = v1 * (1.f / W8S); }
                        u32x4 w; w.x = pk2(v0[0], v0[1]); w.y = pk2(v0[2], v0[3]); w.z = pk2(v1[0], v1[1]); w.w = pk2(v1[2], v1[3]);
                        *(u32x4*)(rowp + bj * HALF) = w; } }
        }
    }
};
struct K2 {
    static constexpr bool PERM = true, PUBLISH = false, FP8 = true; static constexpr int LDBB = 1024, NTK = 8;
    __device__ __forceinline__ void publish(int) const {}
    __device__ __forceinline__ void a_ready(const Unit&, int) const {}
    __device__ __forceinline__ void done(const Unit&) const {}
    StaticOrder S; const unsigned char* A; const unsigned char* Bt; bf16_t* O;
    __device__ __forceinline__ bool next(int i, Unit& u) const { return S.next(i, u); }
    __device__ __forceinline__ void src(const Unit& u, Src& s, const int (&R)[2], const int (&C)[2]) const {
        src_direct(s, A, u.pm * BM, R, C, 1024); s.b0 = (const char*)(Bt + (size_t)u.pn * BM * 1024); s.b1 = s.b0 + 512;
    }
    __device__ __forceinline__ void epi(const f32x4 (&acc)[2][2][4][2], const Unit& u, int wr, int wc, int fr, int fq) const {
        const int row0 = u.pm * BM + wr * 64 + fr, col0 = u.pn * BM + wc * 32 + 8 * fq;
#pragma unroll
        for (int ai = 0; ai < 2; ++ai)
#pragma unroll
            for (int m = 0; m < 4; ++m) { bf16_t* rowp = O + (size_t)(row0 + ai * HALF + m * 16) * DM + col0;
#pragma unroll
                for (int bj = 0; bj < 2; ++bj) { const f32x4 v0 = acc[ai][bj][m][0] * (1.f / (W8S * Y8S)), v1 = acc[ai][bj][m][1] * (1.f / (W8S * Y8S));
                    u32x4 w; w.x = pk2(v0[0], v0[1]); w.y = pk2(v0[2], v0[3]); w.z = pk2(v1[0], v1[1]); w.w = pk2(v1[2], v1[3]);
                    *(u32x4*)(rowp + bj * HALF) = w; } }
    }
};
__device__ __forceinline__ int pair_i(int p) { return p < 3 ? 0 : (p < 5 ? 1 : 2); }
__device__ __forceinline__ int pair_j(int p) { return p < 3 ? p + 1 : (p < 5 ? p - 1 : 3); }
struct K4 {
    static constexpr bool PERM = true, PUBLISH = false, FP8 = true; static constexpr int LDBB = 1024, NTK = 8;
    const unsigned char* U; const unsigned char* Wgu; unsigned char* H; const int* ltok; const float* lgate; const LAS int* tb; int G, vcu; gu32* rtc;
    __device__ __forceinline__ void a_ready(const Unit&, int) const {}
    __device__ __forceinline__ void done(const Unit&) const {}
    __device__ __forceinline__ void publish(int pm) const { if ((threadIdx.x & 63) == 0) __hip_atomic_fetch_add(rtc + 64 * pm, 1u, RLX_AGENT); }
    __device__ __forceinline__ bool next(int i, Unit& u) const {
        const int L = i * G + vcu; const int nt = tb[32 + NBUCKET]; if (L >= nt * 8) return false;
        const int rt = L >> 3; int k = 0;
        for (int q = 1; q < NBUCKET; ++q) k = (tb[32 + q] <= rt) ? q : k;
        u.pm = rt; u.pn = L & 7; u.bk = k; u.tb = rt - tb[32 + k]; return true;
    }
    __device__ __forceinline__ void src(const Unit& u, Src& s, const int (&R)[2], const int (&C)[2]) const {
        const int cnt = tb[u.bk]; s.a = (const char*)U;
#pragma unroll
        for (int h = 0; h < 2; ++h)
#pragma unroll
            for (int i = 0; i < 2; ++i) { const int pos = u.tb * BM + h * HALF + R[i]; const int tok = ltok[(size_t)u.bk * LCAP + (pos < cnt ? pos : 0)]; s.va[h][i] = (unsigned)(tok * 1024 + C[i] * 2); }
        const int grp = u.bk / 6, p = u.bk % 6, sl = u.pn >> 2; const int e = grp * 4 + (sl ? pair_j(p) : pair_i(p));
        s.b0 = (const char*)(Wgu + ((size_t)e * 1024 + (size_t)(u.pn & 3) * BM) * 1024); s.b1 = s.b0 + 512;
    }
    __device__ __forceinline__ void epi(const f32x4 (&acc)[2][2][4][2], const Unit& u, int wr, int wc, int fr, int fq) const {
        const int cnt = tb[u.bk], sl = u.pn >> 2; const int colo = sl * 512 + (u.pn & 3) * 128 + wc * 32 + 8 * fq;
#pragma unroll
        for (int ai = 0; ai < 2; ++ai)
#pragma unroll
            for (int m = 0; m < 4; ++m) {
                const int r = ai * HALF + wr * 64 + m * 16 + fr, pos = u.tb * BM + r;
                const float gt = (pos < cnt) ? lgate[((size_t)u.bk * LCAP + pos) * 2 + sl] : 0.f;
                float hv[8];
#pragma unroll
                for (int n = 0; n < 2; ++n)
#pragma unroll
                    for (int j = 0; j < 4; ++j) { const float g = acc[ai][0][m][n][j] * (1.f / W8S), up = acc[ai][1][m][n][j] * (1.f / W8S); hv[n * 4 + j] = g * __builtin_amdgcn_rcpf(1.f + fexp(-g)) * up * (gt * H8S); }
                u32x2 w; w.x = pk4_fp8(hv[0], hv[1], hv[2], hv[3]); w.y = pk4_fp8(hv[4], hv[5], hv[6], hv[7]);
                *(u32x2*)(H + (size_t)(u.pm * BM + r) * 1024 + colo) = w;
            }
    }
};
struct K5 {
    static constexpr bool PERM = true, PUBLISH = false, FP8 = true; static constexpr int LDBB = 512, NTK = 8;
    __device__ __forceinline__ void publish(int) const {}
    const unsigned char* H; const unsigned char* Wd; bf16_t* Y; const LAS int* tb; int G, vcu; gu32* rtc; gu32* tmo;
    __device__ __forceinline__ void done(const Unit&) const {}
    __device__ __forceinline__ void a_ready(const Unit& u, int wid) const { return;
        if (wid == 0) {
            const unsigned long long t0 = __builtin_amdgcn_s_memrealtime(); unsigned polls = 0;
            while ((unsigned)__builtin_amdgcn_readfirstlane(__hip_atomic_load(rtc + 64 * u.pm, RLX_AGENT)) < 64u) {
                if ((++polls & 255u) == 0u && __builtin_amdgcn_readfirstlane(__hip_atomic_load(tmo, RLX_AGENT)) != 0u) break;
                if (__builtin_amdgcn_s_memrealtime() - t0 > 2000000ull) { if ((threadIdx.x & 63) == 0) __hip_atomic_store(tmo, 1u, RLX_AGENT); break; }
                __builtin_amdgcn_s_sleep(2); }
            __builtin_amdgcn_fence(__ATOMIC_ACQUIRE, "agent");
            asm volatile("s_waitcnt vmcnt(0)" ::: "memory");
        }
        asm volatile("" ::: "memory"); __builtin_amdgcn_s_barrier(); asm volatile("" ::: "memory");
    }
    __device__ __forceinline__ bool next(int i, Unit& u) const {
        const int nt = tb[32 + NBUCKET]; const int n4 = nt * 8; const int i0 = 0; (void)n4;
        const int L = (i + i0) * G + vcu; if (L >= nt * 4) return false;
        const int rt = L >> 2; int k = 0;
        for (int q = 1; q < NBUCKET; ++q) k = (tb[32 + q] <= rt) ? q : k;
        u.pm = rt; u.pn = L & 3; u.bk = k; u.tb = rt - tb[32 + k]; return true;
    }
    __device__ __forceinline__ void src(const Unit& u, Src& s, const int (&R)[2], const int (&C)[2]) const {
        src_direct(s, H, u.pm * BM, R, C, 1024);
        const int grp = u.bk / 6, p = u.bk % 6;
        s.b0 = (const char*)(Wd + ((size_t)(grp * 4 + pair_i(p)) * 1024 + (size_t)u.pn * BM) * 512);
        s.b1 = (const char*)(Wd + ((size_t)(grp * 4 + pair_j(p)) * 1024 + (size_t)u.pn * BM) * 512);
    }
    __device__ __forceinline__ void epi(const f32x4 (&acc)[2][2][4][2], const Unit& u, int wr, int wc, int fr, int fq) const {
        const int row0 = u.pm * BM + wr * 64 + fr, col0 = u.pn * BM + wc * 32 + 8 * fq;
#pragma unroll
        for (int ai = 0; ai < 2; ++ai)
#pragma unroll
            for (int m = 0; m < 4; ++m) { bf16_t* rowp = Y + (size_t)(row0 + ai * HALF + m * 16) * DM + col0;
#pragma unroll
                for (int bj = 0; bj < 2; ++bj) { const f32x4 v0 = acc[ai][bj][m][0] * (1.f / (W8S * H8S)), v1 = acc[ai][bj][m][1] * (1.f / (W8S * H8S));
                    u32x4 w; w.x = pk2(v0[0], v0[1]); w.y = pk2(v0[2], v0[3]); w.z = pk2(v1[0], v1[1]); w.w = pk2(v1[2], v1[3]);
                    *(u32x4*)(rowp + bj * HALF) = w; } }
    }
};
}

namespace attn_body {
using bf16 = __hip_bfloat16;
using s16x4 = __attribute__((ext_vector_type(4))) short;
using f32x16 = __attribute__((ext_vector_type(16))) float;
constexpr int D = 64, PITCH = PJ;
constexpr int NW = 8, QBLK = 32, QB = QBLK * NW, KVBLK = 64;
__device__ __forceinline__ int crow(int r, int hi) { return (r & 3) + 8 * (r >> 2) + 4 * hi; }
#define SBAR() __builtin_amdgcn_sched_barrier(0)
__device__ __forceinline__ void cmask(f32x16& p0, f32x16& p1, int jb, int qrel, int hi) {
    const float NEG = -INFINITY; int kb = 64 * jb + 4 * hi;
#pragma unroll
    for (int r = 0; r < 16; ++r) { int kv = kb + (r & 3) + 8 * (r >> 2); if (kv > qrel) p0[r] = NEG; if (kv + 32 > qrel) p1[r] = NEG; }
}
constexpr int NSLOT = 3, SLOTB = 8192;
constexpr int LDS_K = 0, LDS_V = NSLOT * SLOTB, LDS_WS = 2 * NSLOT * SLOTB, LDS_OST = LDS_WS + NW * 64 * 4, ATT_LDS_BYTES = LDS_OST + NW * 8192;
__device__ __forceinline__ void glds16(const void* gsrc, unsigned lds_dst) { unsigned keep;
    asm volatile("s_mov_b32 %0, m0\n\ts_mov_b32 m0, %2\n\ts_nop 0\n\tglobal_load_lds_dwordx4 %1, off\n\ts_mov_b32 m0, %0" : "=&s"(keep) : "v"(gsrc), "s"(lds_dst) : "memory"); }
__device__ __forceinline__ float max3f(float a, float b, float c) { float r; asm("v_max3_f32 %0, %1, %2, %3" : "=v"(r) : "v"(a), "v"(b), "v"(c)); return r; }
__device__ __forceinline__ float max2f(float a, float b) { float r; asm("v_max_f32_e32 %0, %1, %2" : "=v"(r) : "v"(a), "v"(b)); return r; }
__device__ __forceinline__ float fadd_s(float a, float b) { float r; asm("v_add_f32_e32 %0, %1, %2" : "=v"(r) : "v"(a), "v"(b)); return r; }
__device__ __forceinline__ float fsub_s(float a, float b) { float r; asm("v_sub_f32_e32 %0, %1, %2" : "=v"(r) : "v"(a), "v"(b)); return r; }
typedef float f32x2_t __attribute__((ext_vector_type(2))); typedef __bf16 bf16x2_t __attribute__((ext_vector_type(2)));
__device__ __forceinline__ unsigned cvtpk_s(float lo, float hi) { f32x2_t v = {lo, hi}; bf16x2_t b = __builtin_convertvector(v, bf16x2_t); return __builtin_bit_cast(unsigned, b); }
#define WAIT_BAR(N) asm volatile("s_waitcnt vmcnt(" #N ") lgkmcnt(0)\n\ts_barrier" ::: "memory")
__device__ __forceinline__ void qkt(f32x16& p0, f32x16& p1, const char* Kslot, const bf16x8* qr, const f32x16& negm, int r32, int hi) {
    const char* kb = Kslot + hi * 1024 + r32 * 16;
#pragma unroll
    for (int d0 = 0; d0 < 2; ++d0) {
        const bf16x8 b0 = *reinterpret_cast<const bf16x8*>(kb + d0 * 2048);
        const bf16x8 b1 = *reinterpret_cast<const bf16x8*>(kb + d0 * 2048 + 512);
        if (d0 == 0) { p0 = __builtin_amdgcn_mfma_f32_32x32x16_bf16(b0, qr[0], negm, 0, 0, 0); p1 = __builtin_amdgcn_mfma_f32_32x32x16_bf16(b1, qr[0], negm, 0, 0, 0); }
        else { p0 = __builtin_amdgcn_mfma_f32_32x32x16_bf16(b0, qr[d0], p0, 0, 0, 0); p1 = __builtin_amdgcn_mfma_f32_32x32x16_bf16(b1, qr[d0], p1, 0, 0, 0); } }
}
typedef __attribute__((address_space(3))) const char* lds_cptr;
typedef short v4i16_t __attribute__((ext_vector_type(4)));
__device__ __forceinline__ void kload8(bf16x8* kf, lds_cptr kp) {
    kf[0] = *(const __attribute__((address_space(3))) bf16x8*)(kp);        kf[1] = *(const __attribute__((address_space(3))) bf16x8*)(kp + 512);
    kf[2] = *(const __attribute__((address_space(3))) bf16x8*)(kp + 2048); kf[3] = *(const __attribute__((address_space(3))) bf16x8*)(kp + 2560);
}
__device__ __forceinline__ void kload2(bf16x8* kf, lds_cptr kp, int j) { kf[2 * j] = *(const __attribute__((address_space(3))) bf16x8*)(kp + j * 2048); kf[2 * j + 1] = *(const __attribute__((address_space(3))) bf16x8*)(kp + j * 2048 + 512); }
__device__ __forceinline__ s16x4 vtr(lds_cptr p) { return __builtin_bit_cast(s16x4, __builtin_amdgcn_ds_read_tr16_b64_v4i16((__attribute__((address_space(3))) v4i16_t*)p)); }
__device__ __forceinline__ float rowmax(const f32x16& p0, const f32x16& p1) {
    float a = max3f(p0[0], p0[1], p1[0]), b = max3f(p0[2], p0[3], p1[1]); a = max3f(a, p1[2], p1[3]);
#pragma unroll
    for (int r = 4; r < 16; r += 4) { a = max3f(a, p0[r], p0[r + 1]); b = max3f(b, p0[r + 2], p0[r + 3]); a = max3f(a, p1[r], p1[r + 1]); b = max3f(b, p1[r + 2], p1[r + 3]); }
    const float m = max2f(a, b);
    auto rr = __builtin_amdgcn_permlane32_swap(__float_as_uint(m), __float_as_uint(m), false, false);
    return max2f(__uint_as_float(rr[0]), __uint_as_float(rr[1]));
}
__device__ __forceinline__ void pv(f32x16* o, int vb, bf16x8 pa0, bf16x8 pa1, bf16x8 pa2, bf16x8 pa3) {
#pragma unroll
    for (int d0 = 0; d0 < 2; ++d0) { s16x4 lo[4], hi[4];
#pragma unroll
        for (int ks = 0; ks < 4; ++ks) {
            asm volatile("ds_read_b64_tr_b16 %0,%1 offset:%c2" : "=&v"(lo[ks]) : "v"(vb), "i"(d0 * 4096 + ks * 1024) : "memory");
            asm volatile("ds_read_b64_tr_b16 %0,%1 offset:%c2" : "=&v"(hi[ks]) : "v"(vb), "i"(d0 * 4096 + ks * 1024 + 512) : "memory"); }
        asm volatile("s_waitcnt lgkmcnt(0)" ::: "memory"); SBAR();
#define PK(k) (bf16x8){lo[k][0], lo[k][1], lo[k][2], lo[k][3], hi[k][0], hi[k][1], hi[k][2], hi[k][3]}
        o[d0] = __builtin_amdgcn_mfma_f32_32x32x16_bf16(pa0, PK(0), o[d0], 0, 0, 0);
        o[d0] = __builtin_amdgcn_mfma_f32_32x32x16_bf16(pa1, PK(1), o[d0], 0, 0, 0);
        o[d0] = __builtin_amdgcn_mfma_f32_32x32x16_bf16(pa2, PK(2), o[d0], 0, 0, 0);
        o[d0] = __builtin_amdgcn_mfma_f32_32x32x16_bf16(pa3, PK(3), o[d0], 0, 0, 0);
#undef PK
    }
}
struct AttnParams { const bf16* Q; const bf16* K; const bf16* V; const bf16* zpage; bf16_t* Y; const float* gnorm; float lam, osc; };
template <int THRL, int comp> __device__ __forceinline__ void attn_unit(int b, int h, int qb, const AttnParams& P, char* shm) {
    const bf16* Q = P.Q; const bf16* __restrict__ K = P.K; const bf16* __restrict__ V = P.V;
    int tid_ = threadIdx.x; asm volatile("" : "+v"(tid_));
    const int tid = tid_, lane = tid & 63, r32 = lane & 31, hi = lane >> 5; const int wid = __builtin_amdgcn_readfirstlane(tid >> 6);
    const long rowbase = (long)b * SEQ; const int q0 = qb * QB;
    const bf16* Qw = Q + (rowbase + q0 + wid * QBLK) * PITCH + h * D;
    const bf16* Kh = K + rowbase * PITCH + h * D, *Vh = V + rowbase * PITCH + h * D;
    const unsigned lds0 = (unsigned)(uintptr_t)shm;
    float* wsf = (float*)(shm + LDS_WS) + wid * 64;
    const bf16* ksrc = Kh + (long)(32 * (wid & 1) + (lane & 31)) * PITCH + comp * 32 + (wid >> 1) * 8;
    const bf16* vsrc = Vh + (long)(16 * (wid & 3) + (lane >> 2)) * PITCH + (wid >> 2) * 32 + (lane & 3) * 8;
    const unsigned kdst = lds0 + LDS_K + (wid >> 1) * 1024 + (wid & 1) * 512, vdst = lds0 + LDS_V + wid * 1024;
#define DMA_K(t, slot) do { if (lane < 32) glds16(ksrc + (long)(t) * KVBLK * PITCH, (unsigned)__builtin_amdgcn_readfirstlane(kdst + (slot))); } while (0)
#define DMA_V(t, slot) glds16(vsrc + (long)(t) * KVBLK * PITCH, (unsigned)__builtin_amdgcn_readfirstlane(vdst + (slot)))
    const int vb0 = (int)(lds0 + LDS_V) + ((lane >> 4) & 1) * 32 + (lane & 3) * 8 + (4 * hi + ((lane & 15) >> 2)) * 64;
    const char* Kbase = shm + LDS_K; bf16x8 kf[4];
    const lds_cptr shm3 = (lds_cptr)shm; const lds_cptr kp0 = shm3 + LDS_K + hi * 1024 + r32 * 16; const lds_cptr vp0 = shm3 + LDS_V + ((lane >> 4) & 1) * 32 + (lane & 3) * 8 + (4 * hi + ((lane & 15) >> 2)) * 64;
    const int NT = (q0 + QB) / KVBLK;
    if (wid >= 4) __builtin_amdgcn_s_setprio(1);
    DMA_K(0, 0); DMA_V(0, 0); DMA_K(1, SLOTB);
    bf16x8 qr[2];
#pragma unroll
    for (int d0 = 0; d0 < 2; ++d0) qr[d0] = *reinterpret_cast<const bf16x8*>(&Qw[(long)r32 * PITCH + comp * 32 + d0 * 16 + hi * 8]);
    float mhat = 0.f, l_reg = 0.f; f32x16 o[2]; o[0] = f32x16{}; o[1] = f32x16{}; f32x16 negm = f32x16{}; asm volatile("" : "+v"(negm));
    const int qrel = wid * QBLK + r32;
#define CMASK(P0, P1, t) do { int jb_ = (t) - (NT - 4); if (jb_ >= 0) cmask(P0, P1, jb_, qrel, hi); } while (0)
    bool resc = false;
#define START(P0, P1) do { const float rm = rowmax(P0, P1); resc = false; \
    { const float dl = rm; mhat = fadd_s(mhat, dl); \
      _Pragma("unroll") for (int r = 0; r < 16; ++r) { P0[r] = fsub_s(P0[r], dl); P1[r] = fsub_s(P1[r], dl); } \
      _Pragma("unroll") for (int r = 0; r < 16; ++r) negm[r] = -mhat; asm volatile("" : "+v"(negm)); } \
    _Pragma("unroll") for (int r = 0; r < 16; ++r) P0[r] = __builtin_amdgcn_exp2f(P0[r]); } while (0)
#define RESC() do { if (resc) { asm volatile("s_waitcnt lgkmcnt(0)" ::: "memory"); \
      _Pragma("unroll") for (int d_ = 0; d_ < 2; ++d_) _Pragma("unroll") for (int r = 0; r < 16; ++r) o[d_][r] *= wsf[crow(r, hi)]; } } while (0)
    f32x16 pA0, pA1, pB0, pB1;
    int sl_prev = 0, sl_cur = 0, sl_next = SLOTB;
#define ROT() do { sl_prev = sl_cur; sl_cur = sl_next; sl_next = (sl_next == (NSLOT - 1) * SLOTB) ? 0 : sl_next + SLOTB; } while (0)
    DMA_K(2, 2 * SLOTB);
    WAIT_BAR(3);
    qkt(pA0, pA1, Kbase, qr, negm, r32, hi); asm volatile("s_nop 15\n\ts_nop 7" : "+v"(pA0), "+v"(pA1)); CMASK(pA0, pA1, 0);
    START(pA0, pA1);
    _Pragma("unroll") for (int r = 0; r < 16; ++r) pA1[r] = __builtin_amdgcn_exp2f(pA1[r]);
    WAIT_BAR(0);
    DMA_K(3, 0); DMA_V(1, SLOTB);
    ROT();
    kload8(kf, kp0 + sl_cur);
    WAIT_BAR(2);
    s16x4 vlo[8], vhi[8]; u32x4 pw0, pw1, pw2, pw3;
#define PKW(P, B) cvtpk_s(P[B], P[B + 1])
#define PAF(k) __builtin_bit_cast(bf16x8, pw##k)
#define VFR(i) (bf16x8){vlo[i][0], vlo[i][1], vlo[i][2], vlo[i][3], vhi[i][0], vhi[i][1], vhi[i][2], vhi[i][3]}
#define PIN(x) asm volatile("" : "+v"(x))
#define MX3(a, b, c) __builtin_fmaxf(__builtin_fmaxf((a), (b)), (c))
#define GAPA(MF, A0, A1, A2, A3, W0, W1, PW) do { MF; sacc += A0; sacc += A1; sacc += A2; sacc += A3; PIN(sacc); W0; W1; PIN(PW); SBAR(); } while (0)
#define EX(v) __builtin_amdgcn_exp2f(v)
#define GAPB(MF, X, B) do { MF; X[B] = EX(X[B]); X[B + 1] = EX(X[B + 1]); X[B + 2] = EX(X[B + 2]); X[B + 3] = EX(X[B + 3]); PIN(X); SBAR(); } while (0)
#define VRD(i) do { vlo[i] = vtr(vp_ + (((i) >> 2) * 4096 + ((i) & 3) * 1024)); vhi[i] = vtr(vp_ + (((i) >> 2) * 4096 + ((i) & 3) * 1024 + 512)); } while (0)
#define KRD(G, j) do { if (G) { kload2(kf, kp0 + sl_next, j); SBAR(); } } while (0)
#define STEP(C0, C1, P0, P1, t, GK, GV, GL) do { SBAR(); \
    const lds_cptr vp_ = vp0 + sl_prev; \
    VRD(0); SBAR(); float sacc = (P0[0] + P0[1]); \
    GAPA(C0 = __builtin_amdgcn_mfma_f32_32x32x16_bf16(kf[0], qr[0], negm, 0, 0, 0), P0[2], P0[3], P0[4], P0[5],     pw0[0] = PKW(P0, 0), pw0[1] = PKW(P0, 2), pw0); \
    VRD(4); SBAR(); GAPA(C1 = __builtin_amdgcn_mfma_f32_32x32x16_bf16(kf[1], qr[0], negm, 0, 0, 0), P0[6], P0[7], P0[8], P0[9],     pw0[2] = PKW(P0, 4), pw0[3] = PKW(P0, 6), pw0); \
    VRD(1); SBAR(); GAPA(C0 = __builtin_amdgcn_mfma_f32_32x32x16_bf16(kf[2], qr[1], C0, 0, 0, 0),   P0[10], P0[11], P0[12], P0[13], pw1[0] = PKW(P0, 8), pw1[1] = PKW(P0, 10), pw1); \
    VRD(5); SBAR(); GAPA(C1 = __builtin_amdgcn_mfma_f32_32x32x16_bf16(kf[3], qr[1], C1, 0, 0, 0),   P0[14], P0[15], P1[0], P1[1],   pw1[2] = PKW(P0, 12), pw1[3] = PKW(P0, 14), pw1); \
    VRD(2); SBAR(); GAPA(,   P1[2], P1[3], P1[4], P1[5],     pw2[0] = PKW(P1, 0), pw2[1] = PKW(P1, 2), pw2); \
    VRD(6); SBAR(); GAPA(,   P1[6], P1[7], P1[8], P1[9],     pw2[2] = PKW(P1, 4), pw2[3] = PKW(P1, 6), pw2); \
    VRD(3); SBAR(); GAPA(,   P1[10], P1[11], P1[12], P1[13], pw3[0] = PKW(P1, 8), pw3[1] = PKW(P1, 10), pw3); \
    VRD(7); SBAR(); GAPA(,   P1[14], P1[15], 0.f, 0.f,       pw3[2] = PKW(P1, 12), pw3[3] = PKW(P1, 14), pw3); \
    l_reg += sacc; \
    if (GK) { DMA_K((t) + 3, sl_cur); } if (GV) { DMA_V((t) + 1, sl_next); } \
    CMASK(C0, C1, t); \
    { float a = MX3(C0[0], C0[1], C1[0]), b = MX3(C0[2], C0[3], C1[1]); a = MX3(a, C1[2], C1[3]); \
      _Pragma("unroll") for (int r = 4; r < 16; r += 4) { a = MX3(a, C0[r], C0[r + 1]); b = MX3(b, C0[r + 2], C0[r + 3]); a = MX3(a, C1[r], C1[r + 1]); b = MX3(b, C1[r + 2], C1[r + 3]); } \
      float rm = __builtin_fmaxf(a, b); { auto rr = __builtin_amdgcn_permlane32_swap(__float_as_uint(rm), __float_as_uint(rm), false, false); rm = __builtin_fmaxf(__uint_as_float(rr[0]), __uint_as_float(rr[1])); } \
      resc = false; \
      if (__builtin_expect(__any(rm > (float)THRL), 0)) { const float dl = __builtin_fmaxf(rm, 0.f); mhat += dl; \
        _Pragma("unroll") for (int r = 0; r < 16; ++r) { C0[r] -= dl; C1[r] -= dl; } \
        _Pragma("unroll") for (int r = 0; r < 16; ++r) negm[r] = -mhat; asm volatile("" : "+v"(negm)); \
        const float f = __builtin_amdgcn_exp2f(-dl); l_reg *= f; if (hi == 0) wsf[r32] = f; resc = true; } } \
    SBAR(); \
    GAPB(o[0] = __builtin_amdgcn_mfma_f32_32x32x16_bf16(PAF(0), VFR(0), o[0], 0, 0, 0), C0, 0); \
    GAPB(o[1] = __builtin_amdgcn_mfma_f32_32x32x16_bf16(PAF(0), VFR(4), o[1], 0, 0, 0), C0, 4); \
    KRD(GL, 0); GAPB(o[0] = __builtin_amdgcn_mfma_f32_32x32x16_bf16(PAF(1), VFR(1), o[0], 0, 0, 0), C0, 8); \
    KRD(GL, 1); GAPB(o[1] = __builtin_amdgcn_mfma_f32_32x32x16_bf16(PAF(1), VFR(5), o[1], 0, 0, 0), C0, 12); \
    GAPB(o[0] = __builtin_amdgcn_mfma_f32_32x32x16_bf16(PAF(2), VFR(2), o[0], 0, 0, 0), C1, 0); \
    GAPB(o[1] = __builtin_amdgcn_mfma_f32_32x32x16_bf16(PAF(2), VFR(6), o[1], 0, 0, 0), C1, 4); \
    GAPB(o[0] = __builtin_amdgcn_mfma_f32_32x32x16_bf16(PAF(3), VFR(3), o[0], 0, 0, 0), C1, 8); \
    GAPB(o[1] = __builtin_amdgcn_mfma_f32_32x32x16_bf16(PAF(3), VFR(7), o[1], 0, 0, 0), C1, 12); \
    } while (0)
    int t = 1;
#undef CMASK
#define CMASK(P0, P1, t) do {} while (0)
    for (; t + 5 < NT; t += 2) {
        STEP(pB0, pB1, pA0, pA1, t, true, true, true);     WAIT_BAR(2); RESC(); ROT();
        STEP(pA0, pA1, pB0, pB1, t + 1, true, true, true); WAIT_BAR(2); RESC(); ROT();
    }
#undef CMASK
#define CMASK(P0, P1, t) do { int jb_ = (t) - (NT - 4); if (jb_ >= 0) cmask(P0, P1, jb_, qrel, hi); } while (0)
#define ENDW(tt) do { if ((tt) + 3 < NT) { WAIT_BAR(2); } else if ((tt) + 2 < NT) { WAIT_BAR(1); } else { WAIT_BAR(0); } } while (0)
    for (; t + 1 < NT; t += 2) {
        STEP(pB0, pB1, pA0, pA1, t, (t + 3 < NT), (t + 1 < NT), (t + 1 < NT));         ENDW(t);     RESC(); ROT();
        STEP(pA0, pA1, pB0, pB1, t + 1, (t + 4 < NT), (t + 2 < NT), (t + 2 < NT));     ENDW(t + 1); RESC(); ROT();
    }
    STEP(pB0, pB1, pA0, pA1, NT - 1, false, false, false); RESC();
    { float sacc = pB0[0] + pB0[1]; _Pragma("unroll") for (int r = 2; r < 16; ++r) sacc += pB0[r]; _Pragma("unroll") for (int r = 0; r < 16; ++r) sacc += pB1[r]; l_reg += sacc;
      pw0 = (u32x4){PKW(pB0, 0), PKW(pB0, 2), PKW(pB0, 4), PKW(pB0, 6)}; pw1 = (u32x4){PKW(pB0, 8), PKW(pB0, 10), PKW(pB0, 12), PKW(pB0, 14)}; pw2 = (u32x4){PKW(pB1, 0), PKW(pB1, 2), PKW(pB1, 4), PKW(pB1, 6)}; pw3 = (u32x4){PKW(pB1, 8), PKW(pB1, 10), PKW(pB1, 12), PKW(pB1, 14)};
      SBAR(); pv(o, vb0 + sl_cur, PAF(0), PAF(1), PAF(2), PAF(3)); }
#undef PKW
#undef PAF
#undef VFR
#undef PIN
#undef MX3
#undef GAPA
#undef GAPB
#undef EX
#undef VRD
#undef KRD
#undef STEP
#undef ENDW
    { auto rr = __builtin_amdgcn_permlane32_swap(__float_as_uint(l_reg), __float_as_uint(l_reg), false, false); l_reg = __uint_as_float(rr[0]) + __uint_as_float(rr[1]); }
    if (hi == 0) wsf[32 + r32] = l_reg; asm volatile("s_waitcnt lgkmcnt(0)" ::: "memory");
    float rli[16];
#pragma unroll
    for (int r = 0; r < 16; ++r) rli[r] = __builtin_amdgcn_rcpf(wsf[32 + crow(r, hi)]);
    float* stg = (float*)(shm + LDS_OST) + wid * 2048;
    if (comp == 0) {
#pragma unroll
        for (int r = 0; r < 16; ++r) { const int orow = crow(r, hi);
#pragma unroll
            for (int d0 = 0; d0 < 2; ++d0) stg[orow * 64 + d0 * 32 + r32] = o[d0][r] * rli[r]; }
    } else {
        const float lam = P.lam;
#pragma unroll
        for (int r = 0; r < 16; ++r) { const int orow = crow(r, hi);
#pragma unroll
            for (int d0 = 0; d0 < 2; ++d0) { const int ix = orow * 64 + d0 * 32 + r32; stg[ix] = stg[ix] - lam * (o[d0][r] * rli[r]); } }
        asm volatile("s_waitcnt lgkmcnt(0)" ::: "memory");
        unsigned char* Yw = (unsigned char*)P.Y + (rowbase + q0 + wid * QBLK) * DM + h * D;
        const int ch = lane & 7;
        const f32x4 g0 = *(const f32x4*)(P.gnorm + ch * 8), g1 = *(const f32x4*)(P.gnorm + ch * 8 + 4);
#pragma unroll
        for (int i = 0; i < 4; ++i) { const int row = i * 8 + (lane >> 3);
            const f32x4 a = *(const f32x4*)(stg + row * 64 + ch * 8), c = *(const f32x4*)(stg + row * 64 + ch * 8 + 4);
            float ss = (a[0] * a[0] + a[1] * a[1]) + (a[2] * a[2] + a[3] * a[3]) + (c[0] * c[0] + c[1] * c[1]) + (c[2] * c[2] + c[3] * c[3]);
            ss += __shfl_xor(ss, 1); ss += __shfl_xor(ss, 2); ss += __shfl_xor(ss, 4);
            const float rs = __builtin_amdgcn_rsqf(ss * (1.f / 64.f) + LN_EPS) * P.osc;
            const float rq = rs * Y8S; u32x2 w; w.x = pk4_fp8(a[0] * rq * g0[0], a[1] * rq * g0[1], a[2] * rq * g0[2], a[3] * rq * g0[3]); w.y = pk4_fp8(c[0] * rq * g1[0], c[1] * rq * g1[1], c[2] * rq * g1[2], c[3] * rq * g1[3]);
            *(u32x2*)(Yw + (long)row * DM + ch * 8) = w; }
    }
    __builtin_amdgcn_s_setprio(0);
    asm volatile("s_waitcnt lgkmcnt(0)\n\ts_barrier" ::: "memory");
#undef DMA_K
#undef DMA_V
#undef CMASK
#undef START
#undef RESC
#undef ROT
}
#undef SBAR
#undef WAIT_BAR
}

struct Frame {
    LAS unsigned char* lds; volatile LAS unsigned* MISC; gu32* ctl;
    int tid, lane, wave, vcu, G;
};
struct Args {
    const float* in[29]; float* out; unsigned char* ws; int ph_lo, ph_hi;
};
enum { I_X = 0, I_C, I_POS, I_WADA, I_BADA, I_WIN, I_WOUT, I_MBI, I_MBF, I_MG, I_CONVW, I_CONVB, I_LQ1, I_LK1, I_LQ2, I_LK2, I_DG, I_WA2, I_BA, I_GG, I_LN1G, I_LN1B, I_LN2G, I_LN2B,
       I_RW, I_RB, I_EWG, I_EWU, I_EWD };

__device__ __forceinline__ void tr_item(const float* W, int ldw, int K, bf16_t* WT, int drow0, int scol, int k0, LAS float* scr, int lane) {
#pragma unroll 8
    for (int i = 0; i < 32; ++i) { const int kk = 2 * i + (lane >> 5); scr[kk * 33 + (lane & 31)] = (scol >= 0) ? W[(size_t)(k0 + kk) * ldw + scol] : 0.f; }
    LDS_WAIT(); asm volatile("" ::: "memory");
    const int c = lane & 7;
#pragma unroll
    for (int j = 0; j < 4; ++j) { const int n = (lane >> 3) + 8 * j; const LAS float* s = scr + (8 * c) * 33 + n;
        u32x4 o; o.x = pk2(s[0 * 33], s[1 * 33]); o.y = pk2(s[2 * 33], s[3 * 33]); o.z = pk2(s[4 * 33], s[5 * 33]); o.w = pk2(s[6 * 33], s[7 * 33]);
        *(GAS u32x4*)(WT + (size_t)(drow0 + n) * K + k0 + 8 * c) = o; }
    LDS_WAIT(); asm volatile("" ::: "memory");
}
__device__ __forceinline__ void tr_item4(const float* W, int ldw, int K, bf16_t* WT, int drow0, int scol0, int k0, LAS float* scr, int lane, float wsc = 1.f) {
    const int kq = lane >> 3, nq = (lane & 7) * 4;
    f32x4 v[8];
#pragma unroll
    for (int i = 0; i < 8; ++i) v[i] = *(const f32x4*)(W + (size_t)(k0 + i * 8 + kq) * ldw + scol0 + nq);
#pragma unroll
    for (int i = 0; i < 8; ++i) { LAS float* d = scr + (i * 8 + kq) * 33 + nq; d[0] = v[i][0] * wsc; d[1] = v[i][1] * wsc; d[2] = v[i][2] * wsc; d[3] = v[i][3] * wsc; }
    LDS_WAIT(); asm volatile("" ::: "memory");
    const int c = lane & 7;
#pragma unroll
    for (int j = 0; j < 4; ++j) { const int n = (lane >> 3) + 8 * j; const LAS float* s = scr + (8 * c) * 33 + n;
        u32x4 o; o.x = pk2(s[0 * 33], s[1 * 33]); o.y = pk2(s[2 * 33], s[3 * 33]); o.z = pk2(s[4 * 33], s[5 * 33]); o.w = pk2(s[6 * 33], s[7 * 33]);
        *(GAS u32x4*)(WT + (size_t)(drow0 + n) * K + k0 + 8 * c) = o; }
    LDS_WAIT(); asm volatile("" ::: "memory");
}
struct TrD { const float* src; bf16_t* dst; unsigned char* dst8; int ldw, K, drow0, k0; float wsc; };
__device__ __forceinline__ void tr_load4(const TrD& d, f32x4 (&v)[8], int lane) {
    const int kq = lane >> 3, nq = (lane & 7) * 4;
#pragma unroll
    for (int i = 0; i < 8; ++i) v[i] = *(const f32x4*)(d.src + (size_t)(i * 8 + kq) * d.ldw + nq);
}
__device__ __forceinline__ void tr_finish4(const TrD& d, const f32x4 (&v)[8], LAS float* scr, int lane) {
    const int kq = lane >> 3, nq = (lane & 7) * 4;
#pragma unroll
    for (int i = 0; i < 8; ++i) { LAS float* p = scr + (i * 8 + kq) * 33 + nq; p[0] = v[i][0] * d.wsc; p[1] = v[i][1] * d.wsc; p[2] = v[i][2] * d.wsc; p[3] = v[i][3] * d.wsc; }
    LDS_WAIT(); asm volatile("" ::: "memory");
    const int c = lane & 7;
#pragma unroll
    for (int j = 0; j < 4; ++j) { const int n = (lane >> 3) + 8 * j; const LAS float* s = scr + (8 * c) * 33 + n;
        u32x4 o; o.x = pk2(s[0 * 33], s[1 * 33]); o.y = pk2(s[2 * 33], s[3 * 33]); o.z = pk2(s[4 * 33], s[5 * 33]); o.w = pk2(s[6 * 33], s[7 * 33]);
        *(GAS u32x4*)(d.dst + (size_t)(d.drow0 + n) * d.K + d.k0 + 8 * c) = o; }
    LDS_WAIT(); asm volatile("" ::: "memory");
}
__device__ __forceinline__ void tr_finish8(const TrD& d, const f32x4 (&v)[8], LAS float* scr, int lane) {
    const int kq = lane >> 3, nq = (lane & 7) * 4;
#pragma unroll
    for (int i = 0; i < 8; ++i) { LAS float* p = scr + (i * 8 + kq) * 33 + nq; p[0] = v[i][0] * d.wsc; p[1] = v[i][1] * d.wsc; p[2] = v[i][2] * d.wsc; p[3] = v[i][3] * d.wsc; }
    LDS_WAIT(); asm volatile("" ::: "memory");
    const int c = lane & 7; unsigned char* dst8 = (unsigned char*)d.dst;
#pragma unroll
    for (int j = 0; j < 4; ++j) { const int n = (lane >> 3) + 8 * j; const LAS float* s = scr + (8 * c) * 33 + n;
        u32x2 o; o.x = pk4_fp8(s[0 * 33], s[1 * 33], s[2 * 33], s[3 * 33]); o.y = pk4_fp8(s[4 * 33], s[5 * 33], s[6 * 33], s[7 * 33]);
        *(GAS u32x2*)(dst8 + (size_t)(d.drow0 + n) * d.K + d.k0 + 8 * c) = o; }
    LDS_WAIT(); asm volatile("" ::: "memory");
}
template <int NTL>
__device__ __forceinline__ void rows16_mm(f32x4 (&acc)[NTL], const bf16_t* A, const LAS bf16_t* Bt, int pitch, int lane) {
    const int lr = lane & 15, lq = lane >> 4;
    const bf16_t* ap = A + (size_t)lr * 1024 + lq * 8;
#pragma unroll 8
    for (int ks = 0; ks < 32; ++ks) {
        const bf16x8 a = *(const bf16x8*)(ap + ks * 32);
#pragma unroll
        for (int t = 0; t < NTL; ++t) { const bf16x8 b = *(const LAS bf16x8*)(Bt + (t * 16 + lr) * pitch + ks * 32 + lq * 8); acc[t] = __builtin_amdgcn_mfma_f32_16x16x32_bf16(a, b, acc[t], 0, 0, 0); }
    }
}
constexpr int TBP = 1056;
__device__ __forceinline__ void tail16(const bf16_t* Urow0, const LAS bf16_t* Wt, float* tail_row0, int lane) {
    f32x4 acc[2] = {(f32x4){0.f, 0.f, 0.f, 0.f}, (f32x4){0.f, 0.f, 0.f, 0.f}};
    rows16_mm<2>(acc, Urow0, Wt, TBP, lane);
    const int lr = lane & 15, lq = lane >> 4;
#pragma unroll
    for (int t = 0; t < 2; ++t)
#pragma unroll
        for (int r = 0; r < 4; ++r) tail_row0[(size_t)(lq * 4 + r) * 32 + t * 16 + lr] = acc[t][r];
}
__device__ __forceinline__ void load_tail_w(LAS bf16_t* Wt, const bf16_t* Wtail  , int tid) {
    for (int p = tid; p < 32 * 128; p += 512) { const int n = p >> 7, c = p & 127; *(LAS u32x4*)(Wt + n * TBP + c * 8) = *(const u32x4*)(Wtail + (size_t)n * 1024 + c * 8); }
}
constexpr int NSP = 1032;
constexpr int NMM_P_OFF = 32 * NSP * 2, NMM_LG_OFF = NMM_P_OFF + 8 * 1024 * 4;
struct NarrowT { bf16x8 bw[4][2]; };
__device__ __forceinline__ void nmm_load_tail(NarrowT& T, const bf16_t* Wtail  , int wid, int lane) {
    const int lr = lane & 15, lq = lane >> 4;
#pragma unroll
    for (int ks = 0; ks < 4; ++ks)
#pragma unroll
        for (int t = 0; t < 2; ++t) T.bw[ks][t] = *(const bf16x8*)(Wtail + (size_t)(t * 16 + lr) * 1024 + wid * 128 + ks * 32 + lq * 8);
}
__device__ __forceinline__ void nmm_load_router(NarrowT& T, const float* rw  , int wid, int lane) {
    const int lr = lane & 15, lq = lane >> 4;
#pragma unroll
    for (int ks = 0; ks < 4; ++ks) { u32x4 hi, lo;
#pragma unroll
        for (int i = 0; i < 4; ++i) { const int k = wid * 128 + ks * 32 + lq * 8 + 2 * i; const float w0 = rw[(size_t)k * 16 + lr], w1 = rw[(size_t)(k + 1) * 16 + lr];
            const unsigned h0 = f2bf(w0), h1 = f2bf(w1); hi[i] = h0 | (h1 << 16); lo[i] = f2bf(w0 - bf2f(h0)) | (f2bf(w1 - bf2f(h1)) << 16); }
        T.bw[ks][0] = __builtin_bit_cast(bf16x8, hi); T.bw[ks][1] = __builtin_bit_cast(bf16x8, lo); }
}
__device__ __forceinline__ void nmm_partials(const NarrowT& T, const LAS bf16_t* S, LAS float* Pb, int wid, int lane) {
    asm volatile("s_waitcnt lgkmcnt(0)\n\ts_barrier" ::: "memory");
    const int lr = lane & 15, lq = lane >> 4;
    f32x4 acc[2][2];
#pragma unroll
    for (int m = 0; m < 2; ++m)
#pragma unroll
        for (int t = 0; t < 2; ++t) acc[m][t] = (f32x4){0.f, 0.f, 0.f, 0.f};
#pragma unroll
    for (int m = 0; m < 2; ++m)
#pragma unroll
        for (int ks = 0; ks < 4; ++ks) { const bf16x8 a = *(const LAS bf16x8*)(S + (16 * m + lr) * NSP + wid * 128 + ks * 32 + lq * 8);
#pragma unroll
            for (int t = 0; t < 2; ++t) acc[m][t] = __builtin_amdgcn_mfma_f32_16x16x32_bf16(a, T.bw[ks][t], acc[m][t], 0, 0, 0); }
#pragma unroll
    for (int m = 0; m < 2; ++m)
#pragma unroll
        for (int t = 0; t < 2; ++t)
#pragma unroll
            for (int r = 0; r < 4; ++r) Pb[wid * 1024 + (16 * m + 4 * lq + r) * 32 + t * 16 + lr] = acc[m][t][r];
    asm volatile("s_waitcnt lgkmcnt(0)\n\ts_barrier" ::: "memory");
}
__device__ __forceinline__ void nmm_step_tail(const NarrowT& T, const LAS bf16_t* S, LAS float* Pb, float* tail_wg  , int i0, int tid, int wid, int lane) {
    nmm_partials(T, S, Pb, wid, lane);
#pragma unroll
    for (int q = 0; q < 2; ++q) { const int o = tid + 512 * q, sr = o >> 5, col = o & 31; float s = 0.f;
#pragma unroll
        for (int w = 0; w < 8; ++w) s += Pb[w * 1024 + o];
        tail_wg[(size_t)((sr >> 2) * 16 + i0 + (sr & 3)) * 32 + col] = s; }
}
__device__ __forceinline__ void nmm_step_router(const NarrowT& T, const LAS bf16_t* S, LAS float* Pb, LAS float* lgs  , int i0, int tid, int wid, int lane) {
    nmm_partials(T, S, Pb, wid, lane);
    { const int sr = tid >> 4, e = tid & 15; float s = 0.f;
#pragma unroll
      for (int w = 0; w < 8; ++w) s += Pb[w * 1024 + sr * 32 + e] + Pb[w * 1024 + sr * 32 + 16 + e];
      lgs[(sr >> 2) * 256 + (i0 + (sr & 3)) * 16 + e] = s; }
}
__device__ __forceinline__ int win_src_col(int n) {
    if (n < 1024) return n;
    if (n < 3584) return n + 8;
    const int i = n - 3584;
    if (i < 16) return 3592 + i;
    if (i < 20) return 1024 + (i - 16);
    if (i < 24) return 1028 + (i - 20);
    return -1;
}

namespace rec {
constexpr int PT = 72;
constexpr int TB = 64 * PT * 2;
constexpr int OFF_T0 = 0, OFF_T1 = TB, OFF_T2 = 2 * TB, OFF_T3 = 3 * TB, OFF_T4 = 4 * TB, OFF_T5 = 5 * TB;
constexpr int OFF_BM = 6 * TB;
constexpr int OFF_HM = OFF_BM + 16384;
constexpr int OFF_VEC = OFF_HM + 64 * 68 * 4;
constexpr int V_G = 0, V_M = 64, V_WI = 128, V_EM = 192, V_DI = 256, V_N = 320, V_BE = 384, V_SEG = 448, V_GA = 960;
static_assert(OFF_VEC + (960 + 1024) * 4 <= RING_BYTES, "rec LDS");

__device__ __forceinline__ void mm64(f32x4 (&acc)[2], const LAS bf16_t* A, const LAS bf16_t* Bt, int wid, int lane) {
    const int tm = wid >> 1, tn0 = (wid & 1) * 2, lr = lane & 15, lq = lane >> 4;
#pragma unroll
    for (int ks = 0; ks < 2; ++ks) {
        const bf16x8 a = *(const LAS bf16x8*)(A + (tm * 16 + lr) * PT + ks * 32 + lq * 8);
#pragma unroll
        for (int t = 0; t < 2; ++t) { const bf16x8 b = *(const LAS bf16x8*)(Bt + ((tn0 + t) * 16 + lr) * PT + ks * 32 + lq * 8);
            acc[t] = __builtin_amdgcn_mfma_f32_16x16x32_bf16(a, b, acc[t], 0, 0, 0); }
    }
}
__device__ __forceinline__ float scan_add(float v, int lane) {
#pragma unroll
    for (int o = 1; o < 64; o <<= 1) { const float t = __shfl_up(v, o); if (lane >= o) v += t; }
    return v;
}
__device__ __forceinline__ float scan_max(float v, int lane) {
#pragma unroll
    for (int o = 1; o < 64; o <<= 1) { const float t = __shfl_up(v, o); if (lane >= o) v = fmaxf(v, t); }
    return v;
}
__device__ __forceinline__ void st_tr8(LAS bf16_t* T, int l, int ch, u32x4 w) {
    T[(ch * 8 + 0) * PT + l] = (bf16_t)(w.x & 0xffffu); T[(ch * 8 + 1) * PT + l] = (bf16_t)(w.x >> 16);
    T[(ch * 8 + 2) * PT + l] = (bf16_t)(w.y & 0xffffu); T[(ch * 8 + 3) * PT + l] = (bf16_t)(w.y >> 16);
    T[(ch * 8 + 4) * PT + l] = (bf16_t)(w.z & 0xffffu); T[(ch * 8 + 5) * PT + l] = (bf16_t)(w.z >> 16);
    T[(ch * 8 + 6) * PT + l] = (bf16_t)(w.w & 0xffffu); T[(ch * 8 + 7) * PT + l] = (bf16_t)(w.w >> 16);
}
__device__ __forceinline__ void unpack8(u32x4 w, float (&f)[8]) {
    f[0] = bflo(w.x); f[1] = bfhi(w.x); f[2] = bflo(w.y); f[3] = bfhi(w.y); f[4] = bflo(w.z); f[5] = bfhi(w.z); f[6] = bflo(w.w); f[7] = bfhi(w.w);
}
template <int GATE  >
__device__ __forceinline__ void finalize(const LAS float* HM, const LAS float* rowscale, const float* gnorm, const bf16_t* gate, bf16_t* out, int tid) {
    const int j = tid >> 3, ch = tid & 7;
    const f32x4 a = *(const LAS f32x4*)(HM + j * 68 + ch * 8), c = *(const LAS f32x4*)(HM + j * 68 + ch * 8 + 4);
    const float rsc = rowscale ? rowscale[j] : 1.f;
    float v[8] = {a[0] * rsc, a[1] * rsc, a[2] * rsc, a[3] * rsc, c[0] * rsc, c[1] * rsc, c[2] * rsc, c[3] * rsc};
    float ss = 0.f;
#pragma unroll
    for (int i = 0; i < 8; ++i) ss += v[i] * v[i];
    ss += __shfl_xor(ss, 1); ss += __shfl_xor(ss, 2); ss += __shfl_xor(ss, 4);
    const float rs = __builtin_amdgcn_rsqf(ss * (1.f / 64.f) + LN_EPS);
    const u32x4 gw = *(const u32x4*)(gate + (size_t)j * PJ + ch * 8);
    float gt[8]; unpack8(gw, gt);
    const f32x4 g0 = *(const f32x4*)(gnorm + ch * 8), g1 = *(const f32x4*)(gnorm + ch * 8 + 4);
    const float gn[8] = {g0[0], g0[1], g0[2], g0[3], g1[0], g1[1], g1[2], g1[3]};
    float y[8];
#pragma unroll
    for (int i = 0; i < 8; ++i) { const float sg = 1.f / (1.f + fexp(-gt[i])); const float gv = GATE ? gt[i] * sg : sg; y[i] = v[i] * rs * gn[i] * gv; }
    u32x4 w; w.x = pk2(y[0], y[1]); w.y = pk2(y[2], y[3]); w.z = pk2(y[4], y[5]); w.w = pk2(y[6], y[7]);
    *(u32x4*)(out + (size_t)j * DM + ch * 8) = w;
}

struct RecP {
    const bf16_t* proj; const float* tail; const bf16_t* csm; const bf16_t* csg; float* stm; float* stg; float* smN; float* smBC; float* smDM; float* smMS; float* smGBE; bf16_t* ycat;
    const float* mbi; const float* mbf; const float* mg; const float* wa2; const float* ba; const float* gg;
};

struct MLoc { u32x4 k, v; float mi, mf; };
struct MOut { u32x4 q, k, v, st, mo; float mi, mf, m, n; };
struct GLoc { u32x4 k, v; f32x4 ga; };
struct GOut { u32x4 q, k, v, st, gr; f32x4 ga; };
struct GW { float wv[16]; float bav; };

__device__ __forceinline__ void ld_mloc(MLoc& L, const RecP& P, int ci, int tid, int wid, int lane) {
    const int bh = ci >> 6, c = ci & 63, b = bh >> 2, h = bh & 3, row0 = b * SEQ + c * 64, l = tid >> 3, ch = tid & 7;
    const bf16_t* pr = P.proj + (size_t)(row0 + l) * PJ + h * 64 + ch * 8;
    L.k = *(const u32x4*)(pr + C_MK); L.v = *(const u32x4*)(pr + C_MV);
    if (wid == 0) { const float* tp = P.tail + (size_t)(row0 + lane) * 32; L.mi = tp[T_MI + h]; L.mf = tp[T_MF + h]; } else { L.mi = 0.f; L.mf = 0.f; }
}
__device__ __forceinline__ void ld_mout(MOut& L, const RecP& P, int ci, int tid, int wid, int lane) {
    const int bh = ci >> 6, c = ci & 63, b = bh >> 2, h = bh & 3, row0 = b * SEQ + c * 64, l = tid >> 3, ch = tid & 7;
    const bf16_t* pr = P.proj + (size_t)(row0 + l) * PJ + h * 64 + ch * 8;
    L.q = *(const u32x4*)(pr + C_MQ); L.k = *(const u32x4*)(pr + C_MK); L.v = *(const u32x4*)(pr + C_MV); L.mo = *(const u32x4*)(pr + C_MO);
    L.st = *(const u32x4*)(P.csm + (size_t)ci * 4096 + l * 64 + ch * 8);
    if (wid == 0) { const float* tp = P.tail + (size_t)(row0 + lane) * 32; L.mi = tp[T_MI + h]; L.mf = tp[T_MF + h]; L.m = P.smMS[ci]; L.n = P.smN[(size_t)ci * 64 + lane]; } else { L.mi = 0.f; L.mf = 0.f; L.m = 0.f; L.n = 0.f; }
}
__device__ __forceinline__ void ld_gloc(GLoc& L, const RecP& P, int ci, int tid) {
    const int bh = ci >> 6, c = ci & 63, b = bh >> 2, h = bh & 3, row0 = b * SEQ + c * 64, l = tid >> 3, ch = tid & 7;
    const bf16_t* pr = P.proj + (size_t)(row0 + l) * PJ + h * 64 + ch * 8;
    L.k = *(const u32x4*)(pr + C_GK); L.v = *(const u32x4*)(pr + C_GV);
    L.ga = (tid < 256) ? *(const f32x4*)(P.tail + (size_t)(row0 + (tid >> 2)) * 32 + T_GA + (tid & 3) * 4) : (f32x4){0.f, 0.f, 0.f, 0.f};
}
__device__ __forceinline__ void ld_gout(GOut& L, const RecP& P, int ci, int tid) {
    const int bh = ci >> 6, c = ci & 63, b = bh >> 2, h = bh & 3, row0 = b * SEQ + c * 64, l = tid >> 3, ch = tid & 7;
    const bf16_t* pr = P.proj + (size_t)(row0 + l) * PJ + h * 64 + ch * 8;
    L.q = *(const u32x4*)(pr + C_GQ); L.k = *(const u32x4*)(pr + C_GK); L.v = *(const u32x4*)(pr + C_GV); L.gr = *(const u32x4*)(pr + C_GR);
    L.st = *(const u32x4*)(P.csg + (size_t)ci * 4096 + l * 64 + ch * 8);
    L.ga = (tid < 256) ? *(const f32x4*)(P.tail + (size_t)(row0 + (tid >> 2)) * 32 + T_GA + (tid & 3) * 4) : (f32x4){0.f, 0.f, 0.f, 0.f};
}
__device__ __forceinline__ void ld_gw(GW& W, const RecP& P, int h, int tid) {
    const int dcol = tid & 63;
#pragma unroll
    for (int r = 0; r < 16; ++r) W.wv[r] = P.wa2[r * 256 + h * 64 + dcol];
    W.bav = P.ba[h * 64 + dcol];
}
template <int GATE  >
__device__ __forceinline__ void finalize2(const LAS float* HM, const LAS float* rowscale, const float* gnorm, u32x4 gw, bf16_t* out, int tid) {
    const int j = tid >> 3, ch = tid & 7;
    const f32x4 a = *(const LAS f32x4*)(HM + j * 68 + ch * 8), c = *(const LAS f32x4*)(HM + j * 68 + ch * 8 + 4);
    const float rsc = rowscale ? rowscale[j] : 1.f;
    float v[8] = {a[0] * rsc, a[1] * rsc, a[2] * rsc, a[3] * rsc, c[0] * rsc, c[1] * rsc, c[2] * rsc, c[3] * rsc};
    float ss = 0.f;
#pragma unroll
    for (int i = 0; i < 8; ++i) ss += v[i] * v[i];
    ss += __shfl_xor(ss, 1); ss += __shfl_xor(ss, 2); ss += __shfl_xor(ss, 4);
    const float rs = __builtin_amdgcn_rsqf(ss * (1.f / 64.f) + LN_EPS);
    float gt[8]; unpack8(gw, gt);
    const f32x4 g0 = *(const f32x4*)(gnorm + ch * 8), g1 = *(const f32x4*)(gnorm + ch * 8 + 4);
    const float gn[8] = {g0[0], g0[1], g0[2], g0[3], g1[0], g1[1], g1[2], g1[3]};
    float y[8];
#pragma unroll
    for (int i = 0; i < 8; ++i) { const float sg = 1.f / (1.f + fexp(-gt[i])); const float gv = GATE ? gt[i] * sg : sg; y[i] = v[i] * rs * gn[i] * gv; }
    u32x4 w; w.x = pk2(y[0], y[1]); w.y = pk2(y[2], y[3]); w.z = pk2(y[4], y[5]); w.w = pk2(y[6], y[7]);
    *(u32x4*)(out + (size_t)j * DM + ch * 8) = w;
}
__device__ __forceinline__ void mlstm_local(const MLoc& L, const RecP& P, LAS unsigned char* lds, int ci, int tid, int wid, int lane) {
    const int h = (ci >> 6) & 3;
    LAS bf16_t* KT = (LAS bf16_t*)(lds + OFF_T0); LAS bf16_t* VT = (LAS bf16_t*)(lds + OFF_T1); LAS float* vec = (LAS float*)(lds + OFF_VEC);
    const int l = tid >> 3, ch = tid & 7;
    if (wid == 0) {
        const float li = L.mi + P.mbi[h], lf = logsig(L.mf + P.mbf[h]);
        const float bc = scan_add(lf, lane), g = li - bc;
        const float gmax = wave_max(g), bend = __shfl(bc, 63);
        vec[V_G + lane] = fexp(g - gmax);
        if (lane == 0) { P.smBC[ci] = bend; P.smDM[ci] = bend + gmax; }
    }
    __syncthreads();
    { const float w = vec[V_G + l]; float kf[8]; unpack8(L.k, kf);
      u32x4 ks; ks.x = pk2(kf[0] * w, kf[1] * w); ks.y = pk2(kf[2] * w, kf[3] * w); ks.z = pk2(kf[4] * w, kf[5] * w); ks.w = pk2(kf[6] * w, kf[7] * w);
      st_tr8(KT, l, ch, ks); st_tr8(VT, l, ch, L.v); }
    __syncthreads();
    f32x4 acc[2] = {(f32x4){0.f, 0.f, 0.f, 0.f}, (f32x4){0.f, 0.f, 0.f, 0.f}};
    mm64(acc, VT, KT, wid, lane);
    { const int tm = wid >> 1, tn0 = (wid & 1) * 2, lr = lane & 15, lq = lane >> 4; float* dst = P.stm + (size_t)ci * 4096;
#pragma unroll
      for (int t = 0; t < 2; ++t)
#pragma unroll
          for (int r = 0; r < 4; ++r) dst[(tm * 16 + lq * 4 + r) * 64 + (tn0 + t) * 16 + lr] = acc[t][r]; }
    if (tid < 64) { float s = 0.f;
#pragma unroll
        for (int q = 0; q < 8; ++q) { const u32x4 w = *(const LAS u32x4*)(KT + tid * PT + q * 8); float f[8]; unpack8(w, f);
#pragma unroll
            for (int i = 0; i < 8; ++i) s += f[i]; }
        P.smN[(size_t)ci * 64 + tid] = s; }
    __syncthreads();
}
__device__ __forceinline__ void mlstm_out(const MOut& L, const RecP& P, LAS unsigned char* lds, int ci, int tid, int wid, int lane) {
    const int bh = ci >> 6, c = ci & 63, b = bh >> 2, h = bh & 3, row0 = b * SEQ + c * 64;
    LAS bf16_t* Qm = (LAS bf16_t*)(lds + OFF_T0); LAS bf16_t* Km = (LAS bf16_t*)(lds + OFF_T1); LAS bf16_t* VT = (LAS bf16_t*)(lds + OFF_T2);
    LAS bf16_t* CT = (LAS bf16_t*)(lds + OFF_T3); LAS bf16_t* Sm = (LAS bf16_t*)(lds + OFF_T4);
    LAS float* HM = (LAS float*)(lds + OFF_HM); LAS float* vec = (LAS float*)(lds + OFF_VEC);
    const int l = tid >> 3, ch = tid & 7;
    *(LAS u32x4*)(Qm + l * PT + ch * 8) = L.q; *(LAS u32x4*)(Km + l * PT + ch * 8) = L.k; st_tr8(VT, l, ch, L.v); *(LAS u32x4*)(CT + l * PT + ch * 8) = L.st;
    if (wid == 0) {
        const float li = L.mi + P.mbi[h], lf = logsig(L.mf + P.mbf[h]);
        const float bc = scan_add(lf, lane), g = li - bc;
        const float pm = scan_max(g, lane), m = L.m, M = fmaxf(m, pm);
        vec[V_G + lane] = g; vec[V_M + lane] = M; vec[V_WI + lane] = fexp(m - M); vec[V_EM + lane] = fexp(-bc - M);
        vec[V_N + lane] = L.n;
    }
    __syncthreads();
    { f32x4 acc[2] = {(f32x4){0.f, 0.f, 0.f, 0.f}, (f32x4){0.f, 0.f, 0.f, 0.f}};
      mm64(acc, Qm, Km, wid, lane);
      const int tm = wid >> 1, tn0 = (wid & 1) * 2, lr = lane & 15, lq = lane >> 4;
#pragma unroll
      for (int t = 0; t < 2; ++t) { const int ll = (tn0 + t) * 16 + lr; const float gl = vec[V_G + ll];
#pragma unroll
          for (int r = 0; r < 4; ++r) { const int j = tm * 16 + lq * 4 + r; const float s = (ll <= j) ? acc[t][r] * fexp(gl - vec[V_M + j]) : 0.f; Sm[j * PT + ll] = (bf16_t)f2bf(s); } } }
    __syncthreads();
    { f32x4 a1[2] = {(f32x4){0.f, 0.f, 0.f, 0.f}, (f32x4){0.f, 0.f, 0.f, 0.f}}, a2[2] = {(f32x4){0.f, 0.f, 0.f, 0.f}, (f32x4){0.f, 0.f, 0.f, 0.f}};
      mm64(a1, Sm, VT, wid, lane); mm64(a2, Qm, CT, wid, lane);
      const int tm = wid >> 1, tn0 = (wid & 1) * 2, lr = lane & 15, lq = lane >> 4;
#pragma unroll
      for (int t = 0; t < 2; ++t)
#pragma unroll
          for (int r = 0; r < 4; ++r) { const int j = tm * 16 + lq * 4 + r; HM[j * 68 + (tn0 + t) * 16 + lr] = a1[t][r] + vec[V_WI + j] * a2[t][r]; } }
    if (tid < 64) { float ds = 0.f, qn = 0.f;
#pragma unroll
        for (int q = 0; q < 8; ++q) { const u32x4 w = *(const LAS u32x4*)(Sm + tid * PT + q * 8); float f[8]; unpack8(w, f);
            const u32x4 qw = *(const LAS u32x4*)(Qm + tid * PT + q * 8); float qf[8]; unpack8(qw, qf);
#pragma unroll
            for (int i = 0; i < 8; ++i) { ds += f[i]; qn += qf[i] * vec[V_N + q * 8 + i]; } }
        const float den = ds + vec[V_WI + tid] * qn;
        vec[V_DI + tid] = 1.f / fmaxf(fabsf(den), vec[V_EM + tid]); }
    __syncthreads();
    finalize2<0>(HM, vec + V_DI, P.mg, L.mo, P.ycat + (size_t)row0 * DM + h * 64, tid);
    __syncthreads();
}
__device__ __forceinline__ void gla_bmat(const f32x4 ga, const GW& W, LAS unsigned char* lds, int tid, int wid) {
    LAS float* BM = (LAS float*)(lds + OFF_BM); LAS float* vec = (LAS float*)(lds + OFF_VEC);
    if (tid < 256) { const int l = tid >> 2, q = tid & 3; vec[V_GA + l * 16 + q * 4 + 0] = ga[0]; vec[V_GA + l * 16 + q * 4 + 1] = ga[1]; vec[V_GA + l * 16 + q * 4 + 2] = ga[2]; vec[V_GA + l * 16 + q * 4 + 3] = ga[3]; }
    const int dcol = tid & 63;
    __syncthreads();
    float cs[8]; float cacc = 0.f;
#pragma unroll
    for (int i = 0; i < 8; ++i) { const int l = wid * 8 + i; float z = W.bav;
#pragma unroll
        for (int r = 0; r < 16; ++r) z += vec[V_GA + l * 16 + r] * W.wv[r];
        cacc += logsig(z) * (1.f / 16.f); cs[i] = cacc; }
    vec[V_SEG + wid * 64 + dcol] = cacc;
    __syncthreads();
    float off = 0.f, tot = 0.f;
#pragma unroll
    for (int s = 0; s < 8; ++s) { const float v = vec[V_SEG + s * 64 + dcol]; tot += v; if (s < wid) off += v; }
#pragma unroll
    for (int i = 0; i < 8; ++i) BM[(wid * 8 + i) * 64 + dcol] = off + cs[i];
    if (wid == 0) vec[V_BE + dcol] = tot;
    __syncthreads();
}
__device__ __forceinline__ void gla_local(const GLoc& L, const GW& W, const RecP& P, LAS unsigned char* lds, int ci, int tid, int wid, int lane) {
    LAS bf16_t* KT = (LAS bf16_t*)(lds + OFF_T0); LAS bf16_t* VT = (LAS bf16_t*)(lds + OFF_T1);
    LAS float* BM = (LAS float*)(lds + OFF_BM); LAS float* vec = (LAS float*)(lds + OFF_VEC);
    const int l = tid >> 3, ch = tid & 7;
    gla_bmat(L.ga, W, lds, tid, wid);
    if (tid < 64) P.smGBE[(size_t)ci * 64 + tid] = vec[V_BE + tid];
    { float kf[8]; unpack8(L.k, kf); float ks[8];
#pragma unroll
      for (int i = 0; i < 8; ++i) { const int d = ch * 8 + i; ks[i] = kf[i] * fexp(vec[V_BE + d] - BM[l * 64 + d]); }
      u32x4 kk; kk.x = pk2(ks[0], ks[1]); kk.y = pk2(ks[2], ks[3]); kk.z = pk2(ks[4], ks[5]); kk.w = pk2(ks[6], ks[7]);
      st_tr8(KT, l, ch, kk); st_tr8(VT, l, ch, L.v); }
    __syncthreads();
    f32x4 acc[2] = {(f32x4){0.f, 0.f, 0.f, 0.f}, (f32x4){0.f, 0.f, 0.f, 0.f}};
    mm64(acc, VT, KT, wid, lane);
    { const int tm = wid >> 1, tn0 = (wid & 1) * 2, lr = lane & 15, lq = lane >> 4; float* dst = P.stg + (size_t)ci * 4096;
#pragma unroll
      for (int t = 0; t < 2; ++t)
#pragma unroll
          for (int r = 0; r < 4; ++r) dst[(tm * 16 + lq * 4 + r) * 64 + (tn0 + t) * 16 + lr] = acc[t][r]; }
    __syncthreads();
}
__device__ __forceinline__ void gla_out(const GOut& L, const GW& W, const RecP& P, LAS unsigned char* lds, int ci, int tid, int wid, int lane) {
    const int bh = ci >> 6, c = ci & 63, b = bh >> 2, h = bh & 3, row0 = b * SEQ + c * 64;
    LAS bf16_t* Qm = (LAS bf16_t*)(lds + OFF_T0); LAS bf16_t* Km = (LAS bf16_t*)(lds + OFF_T1); LAS bf16_t* VT = (LAS bf16_t*)(lds + OFF_T2);
    LAS bf16_t* ST = (LAS bf16_t*)(lds + OFF_T3); LAS bf16_t* Sm = (LAS bf16_t*)(lds + OFF_T4);
    LAS float* BM = (LAS float*)(lds + OFF_BM); LAS float* HM = (LAS float*)(lds + OFF_HM);
    const int l = tid >> 3, ch = tid & 7;
    gla_bmat(L.ga, W, lds, tid, wid);
    { float qf[8], kf[8]; unpack8(L.q, qf); unpack8(L.k, kf); float qs[8], ks[8];
#pragma unroll
      for (int i = 0; i < 8; ++i) { const float bv = BM[l * 64 + ch * 8 + i]; qs[i] = qf[i] * fexp(bv); ks[i] = kf[i] * fexp(-bv); }
      u32x4 qq, kk; qq.x = pk2(qs[0], qs[1]); qq.y = pk2(qs[2], qs[3]); qq.z = pk2(qs[4], qs[5]); qq.w = pk2(qs[6], qs[7]);
      kk.x = pk2(ks[0], ks[1]); kk.y = pk2(ks[2], ks[3]); kk.z = pk2(ks[4], ks[5]); kk.w = pk2(ks[6], ks[7]);
      *(LAS u32x4*)(Qm + l * PT + ch * 8) = qq; *(LAS u32x4*)(Km + l * PT + ch * 8) = kk; st_tr8(VT, l, ch, L.v);
      *(LAS u32x4*)(ST + l * PT + ch * 8) = L.st; }
    __syncthreads();
    { f32x4 acc[2] = {(f32x4){0.f, 0.f, 0.f, 0.f}, (f32x4){0.f, 0.f, 0.f, 0.f}};
      mm64(acc, Qm, Km, wid, lane);
      const int tm = wid >> 1, tn0 = (wid & 1) * 2, lr = lane & 15, lq = lane >> 4;
#pragma unroll
      for (int t = 0; t < 2; ++t) { const int ll = (tn0 + t) * 16 + lr;
#pragma unroll
          for (int r = 0; r < 4; ++r) { const int j = tm * 16 + lq * 4 + r; Sm[j * PT + ll] = (bf16_t)f2bf((ll <= j) ? acc[t][r] : 0.f); } } }
    __syncthreads();
    { f32x4 acc[2] = {(f32x4){0.f, 0.f, 0.f, 0.f}, (f32x4){0.f, 0.f, 0.f, 0.f}};
      mm64(acc, Sm, VT, wid, lane); mm64(acc, Qm, ST, wid, lane);
      const int tm = wid >> 1, tn0 = (wid & 1) * 2, lr = lane & 15, lq = lane >> 4;
#pragma unroll
      for (int t = 0; t < 2; ++t)
#pragma unroll
          for (int r = 0; r < 4; ++r) HM[(tm * 16 + lq * 4 + r) * 68 + (tn0 + t) * 16 + lr] = acc[t][r]; }
    __syncthreads();
    finalize2<1>(HM, nullptr, P.gg, L.gr, P.ycat + (size_t)row0 * DM + 768 + h * 64, tid);
    __syncthreads();
}
}

namespace recw {
using rec::RecP; using rec::scan_add; using rec::scan_max; using rec::unpack8;
typedef short s16x4v __attribute__((ext_vector_type(4)));
typedef short v4i16_t __attribute__((ext_vector_type(4)));
#define MF16(a, b, c) __builtin_amdgcn_mfma_f32_16x16x32_bf16((a), (b), (c), 0, 0, 0)
__device__ __forceinline__ s16x4v tr16(const LAS bf16_t* p) { return __builtin_bit_cast(s16x4v, __builtin_amdgcn_ds_read_tr16_b64_v4i16((LAS v4i16_t*)p)); }
__device__ __forceinline__ bf16x8 trfrag(const LAS bf16_t* T, int pitch, int s, int c0, int lane) {
    const int i = lane & 15, q = lane >> 4;
    const LAS bf16_t* pa = T + (32 * s + 4 * q + (i >> 2)) * pitch + c0 + 4 * (i & 3);
    const s16x4v lo = tr16(pa), hi = tr16(pa + 16 * pitch);
    return (bf16x8){lo[0], lo[1], lo[2], lo[3], hi[0], hi[1], hi[2], hi[3]};
}
__device__ __forceinline__ bf16x8 rfg(const bf16_t* X, int pitch, int T, int ks, int lane) { return *(const bf16x8*)(X + (size_t)(16 * T + (lane & 15)) * pitch + 32 * ks + 8 * (lane >> 4)); }
__device__ __forceinline__ u32x4 piece(const bf16_t* X, int pitch, int i, int lane) { return *(const u32x4*)(X + (size_t)((lane >> 3) + 8 * i) * pitch + (lane & 7) * 8); }
__device__ __forceinline__ bf16x8 frag_scale(bf16x8 f, float sc) {
    const u32x4 w = __builtin_bit_cast(u32x4, f); u32x4 o;
    o.x = pk2(bflo(w.x) * sc, bfhi(w.x) * sc); o.y = pk2(bflo(w.y) * sc, bfhi(w.y) * sc); o.z = pk2(bflo(w.z) * sc, bfhi(w.z) * sc); o.w = pk2(bflo(w.w) * sc, bfhi(w.w) * sc);
    return __builtin_bit_cast(bf16x8, o);
}
__device__ __forceinline__ bf16x8 frag_mul(bf16x8 f, bf16x8 g, bool recip) {
    const u32x4 a = __builtin_bit_cast(u32x4, f), b = __builtin_bit_cast(u32x4, g); float x[8], y[8]; unpack8(a, x); unpack8(b, y);
#pragma unroll
    for (int i = 0; i < 8; ++i) x[i] = recip ? x[i] * __builtin_amdgcn_rcpf(y[i]) : x[i] * y[i];
    u32x4 o; o.x = pk2(x[0], x[1]); o.y = pk2(x[2], x[3]); o.z = pk2(x[4], x[5]); o.w = pk2(x[6], x[7]);
    return __builtin_bit_cast(bf16x8, o);
}
__device__ __forceinline__ float red_q(float v) { v += __shfl_xor(v, 16); v += __shfl_xor(v, 32); return v; }
__device__ __forceinline__ void stage_rows(f32x4 (&O)[4], int Tj, float rowscale, LAS bf16_t* Tl, int PTL, int lane) {
    const int r = lane & 15, q = lane >> 4;
    float ss = 0.f;
#pragma unroll
    for (int Te = 0; Te < 4; ++Te) { O[Te] = O[Te] * rowscale; const f32x4 v = O[Te]; ss += (v[0] * v[0] + v[1] * v[1]) + (v[2] * v[2] + v[3] * v[3]); }
    ss = red_q(ss);
    const float rs = __builtin_amdgcn_rsqf(ss * (1.f / 64.f) + LN_EPS);
#pragma unroll
    for (int Te = 0; Te < 4; ++Te) { const f32x4 v = O[Te] * rs; u32x2 w; w.x = pk2(v[0], v[1]); w.y = pk2(v[2], v[3]); *(LAS u32x2*)(Tl + (16 * Tj + r) * PTL + 16 * Te + 4 * q) = w; }
}
template <int GATE>
__device__ __forceinline__ void final_store(const LAS bf16_t* Tl, int PTL, const float* gnorm, const bf16_t* gate, bf16_t* out, int lane) {
    const int ch = lane & 7;
    const f32x4 g0 = *(const f32x4*)(gnorm + ch * 8), g1 = *(const f32x4*)(gnorm + ch * 8 + 4);
    const float gn[8] = {g0[0], g0[1], g0[2], g0[3], g1[0], g1[1], g1[2], g1[3]};
#pragma unroll
    for (int i = 0; i < 8; ++i) { const int row = (lane >> 3) + 8 * i;
        float hv[8], gt[8]; unpack8(*(const LAS u32x4*)(Tl + row * PTL + ch * 8), hv); unpack8(*(const u32x4*)(gate + (size_t)row * PJ + ch * 8), gt);
        float y[8];
#pragma unroll
        for (int k = 0; k < 8; ++k) { const float sg = __builtin_amdgcn_rcpf(1.f + fexp(-gt[k])); y[k] = hv[k] * (gn[k] * Y8S) * (GATE ? gt[k] * sg : sg); }
        u32x2 w; w.x = pk4_fp8(y[0], y[1], y[2], y[3]); w.y = pk4_fp8(y[4], y[5], y[6], y[7]);
        *(u32x2*)((unsigned char*)out + (size_t)row * DM + ch * 8) = w; }
}
__device__ __forceinline__ void mlstm_local_w(const RecP& P, LAS unsigned char* wl, int ci, int lane) {
    const int r = lane & 15, q = lane >> 4; constexpr int PL = 64;
    const int bh = ci >> 6, c = ci & 63, b = bh >> 2, h = bh & 3, row0 = b * SEQ + c * 64;
    const bf16_t* Xk = P.proj + (size_t)row0 * PJ + C_MK + h * 64; const bf16_t* Xv = P.proj + (size_t)row0 * PJ + C_MV + h * 64;
    LAS bf16_t* Kl = (LAS bf16_t*)wl; LAS bf16_t* Vl = (LAS bf16_t*)(wl + 8192);
    const float* tp = P.tail + (size_t)(row0 + lane) * 32;
    const float li = tp[T_MI + h] + P.mbi[h], lf = logsig(tp[T_MF + h] + P.mbf[h]);
    const float bc = scan_add(lf, lane), g = li - bc, gmax = wave_max(g), bend = __shfl(bc, 63), w = fexp(g - gmax);
    if (lane == 0) { P.smBC[ci] = bend; P.smDM[ci] = bend + gmax; }
#pragma unroll
    for (int i = 0; i < 8; ++i) { const u32x4 kpi = piece(Xk, PJ, i, lane), vpi = piece(Xv, PJ, i, lane); const float wr_ = __shfl(w, (lane >> 3) + 8 * i); float kf[8]; unpack8(kpi, kf);
        u32x4 ks; ks.x = pk2(kf[0] * wr_, kf[1] * wr_); ks.y = pk2(kf[2] * wr_, kf[3] * wr_); ks.z = pk2(kf[4] * wr_, kf[5] * wr_); ks.w = pk2(kf[6] * wr_, kf[7] * wr_);
        *(LAS u32x4*)(Kl + ((lane >> 3) + 8 * i) * PL + (lane & 7) * 8) = ks; *(LAS u32x4*)(Vl + ((lane >> 3) + 8 * i) * PL + (lane & 7) * 8) = vpi; }
    asm volatile("" ::: "memory"); __builtin_amdgcn_sched_barrier(0);
    bf16x8 Kt[4][2];
#pragma unroll
    for (int Td = 0; Td < 4; ++Td)
#pragma unroll
        for (int s = 0; s < 2; ++s) Kt[Td][s] = trfrag(Kl, PL, s, 16 * Td, lane);
#pragma unroll
    for (int Te = 0; Te < 4; ++Te) { const bf16x8 v0 = trfrag(Vl, PL, 0, 16 * Te, lane), v1 = trfrag(Vl, PL, 1, 16 * Te, lane);
#pragma unroll
        for (int Td = 0; Td < 4; ++Td) { f32x4 acc = (f32x4){0.f, 0.f, 0.f, 0.f}; acc = MF16(Kt[Td][0], v0, acc); acc = MF16(Kt[Td][1], v1, acc);
            u32x2 w; w.x = pk2(acc[0], acc[1]); w.y = pk2(acc[2], acc[3]); *(LAS u32x2*)(Kl + (16 * Te + r) * PL + 16 * Td + 4 * q) = w; } }
    asm volatile("" ::: "memory"); __builtin_amdgcn_sched_barrier(0);
    { bf16_t* dstb = (bf16_t*)P.stm + (size_t)ci * 4096;
#pragma unroll
      for (int i = 0; i < 8; ++i) { const int row = (lane >> 3) + 8 * i, ch = lane & 7; *(u32x4*)(dstb + row * 64 + ch * 8) = *(const LAS u32x4*)(Kl + row * PL + ch * 8); } }
    { const short one = (short)0x3F80; const bf16x8 ones = (bf16x8){one, one, one, one, one, one, one, one};
#pragma unroll
      for (int Td = 0; Td < 4; ++Td) { f32x4 acc = (f32x4){0.f, 0.f, 0.f, 0.f}; acc = MF16(ones, Kt[Td][0], acc); acc = MF16(ones, Kt[Td][1], acc);
          if (q == 0) P.smN[(size_t)ci * 64 + 16 * Td + r] = acc[0]; } }
}
struct GWf { bf16x8 Bw[4]; float ba[4]; };
__device__ __forceinline__ void ld_gwf(GWf& W, const RecP& P, int h, int lane) {
    const int r = lane & 15, q = lane >> 4;
    int wo = (8 * (q & 1)) * 256 + h * 64 + r; asm volatile("" : "+v"(wo)); const float* wp = P.wa2 + wo;
#pragma unroll
    for (int Td = 0; Td < 4; ++Td) { float w8[8];
#pragma unroll
        for (int i = 0; i < 8; ++i) { const float wv_ = wp[i * 256 + 16 * Td]; w8[i] = (q < 2) ? wv_ : 0.f; }
        u32x4 o; o.x = pk2(w8[0], w8[1]); o.y = pk2(w8[2], w8[3]); o.z = pk2(w8[4], w8[5]); o.w = pk2(w8[6], w8[7]); W.Bw[Td] = __builtin_bit_cast(bf16x8, o);
        W.ba[Td] = P.ba[h * 64 + 16 * Td + r]; }
}
template <int MODE>
__device__ __forceinline__ void gla_gate_tile(LAS bf16_t* Tt, int PL, float (&bend)[4], const GWf& W, const float* tail_row0, int lane) {
    const int r = lane & 15, q = lane >> 4;
    bf16x8 Ag[4];
    int to = r * 32 + T_GA + 8 * (q & 1); asm volatile("" : "+v"(to)); const float* tpb = tail_row0 + to;
#pragma unroll
    for (int Tl = 0; Tl < 4; ++Tl) { f32x4 a0 = *(const f32x4*)(tpb + Tl * 512), a1 = *(const f32x4*)(tpb + Tl * 512 + 4);
        if (q >= 2) { a0 = (f32x4){0.f, 0.f, 0.f, 0.f}; a1 = a0; }
        u32x4 o; o.x = pk2(a0[0], a0[1]); o.y = pk2(a0[2], a0[3]); o.z = pk2(a1[0], a1[1]); o.w = pk2(a1[2], a1[3]); Ag[Tl] = __builtin_bit_cast(bf16x8, o); }
#pragma unroll
    for (int Td = 0; Td < 4; ++Td) { float carry = 0.f; LAS bf16_t* tcol = Tt + (4 * q) * PL + 16 * Td + r;
#pragma unroll
        for (int tt = 0; tt < 4; ++tt) { const int Tl = MODE ? 3 - tt : tt; const float bb = W.ba[Td]; const f32x4 z = MF16(Ag[Tl], W.Bw[Td], ((f32x4){bb, bb, bb, bb}));
            const float v0 = logsig(z[0]) * (1.f / 16.f), v1 = logsig(z[1]) * (1.f / 16.f), v2 = logsig(z[2]) * (1.f / 16.f), v3 = logsig(z[3]) * (1.f / 16.f);
            const float lt = (v0 + v1) + (v2 + v3);
            float ex, o0, o1, o2, o3;
            if (MODE == 0) { const float t1 = __shfl_up(lt, 16), t2 = __shfl_up(lt, 32), t3 = __shfl_up(lt, 48); ex = carry + (q >= 1 ? t1 : 0.f) + (q >= 2 ? t2 : 0.f) + (q >= 3 ? t3 : 0.f);
                o0 = ex + v0; o1 = o0 + v1; o2 = o1 + v2; o3 = o2 + v3; }
            else { const float t1 = __shfl_down(lt, 16), t2 = __shfl_down(lt, 32), t3 = __shfl_down(lt, 48); ex = carry + (q <= 2 ? t1 : 0.f) + (q <= 1 ? t2 : 0.f) + (q <= 0 ? t3 : 0.f);
                o3 = ex; o2 = o3 + v3; o1 = o2 + v2; o0 = o1 + v1; }
            carry += red_q(lt);
            LAS bf16_t* tp = tcol + (16 * Tl) * PL;
            const unsigned w01 = pk2(fexp(o0), fexp(o1)), w23 = pk2(fexp(o2), fexp(o3));
            tp[0] = (bf16_t)(w01 & 0xffffu); tp[PL] = (bf16_t)(w01 >> 16); tp[2 * PL] = (bf16_t)(w23 & 0xffffu); tp[3 * PL] = (bf16_t)(w23 >> 16); }
        bend[Td] = carry; }
}
__device__ __forceinline__ void gla_local_w(const RecP& P, const GWf& W, LAS unsigned char* wl, int ci, int lane) {
    const int r = lane & 15, q = lane >> 4; constexpr int PL = 64;
    const int bh = ci >> 6, c = ci & 63, b = bh >> 2, h = bh & 3, row0 = b * SEQ + c * 64;
    const bf16_t* Xk = P.proj + (size_t)row0 * PJ + C_GK + h * 64; const bf16_t* Xv = P.proj + (size_t)row0 * PJ + C_GV + h * 64;
    LAS bf16_t* Kl = (LAS bf16_t*)wl; LAS bf16_t* Vl = (LAS bf16_t*)(wl + 8192);
    { float bend[4]; gla_gate_tile<1>(Kl, PL, bend, W, P.tail + (size_t)row0 * 32, lane);
      if (q == 0) {
#pragma unroll
          for (int Td = 0; Td < 4; ++Td) P.smGBE[(size_t)ci * 64 + 16 * Td + r] = bend[Td]; } }
    asm volatile("" ::: "memory"); __builtin_amdgcn_sched_barrier(0);
#pragma unroll
    for (int i = 0; i < 8; ++i) { const u32x4 kp = piece(Xk, PJ, i, lane), vp = piece(Xv, PJ, i, lane);
        LAS bf16_t* kp_l = Kl + ((lane >> 3) + 8 * i) * PL + (lane & 7) * 8; float kf[8], ff[8]; unpack8(kp, kf); unpack8(*(const LAS u32x4*)kp_l, ff);
        u32x4 ks; ks.x = pk2(kf[0] * ff[0], kf[1] * ff[1]); ks.y = pk2(kf[2] * ff[2], kf[3] * ff[3]); ks.z = pk2(kf[4] * ff[4], kf[5] * ff[5]); ks.w = pk2(kf[6] * ff[6], kf[7] * ff[7]);
        *(LAS u32x4*)kp_l = ks; *(LAS u32x4*)(Vl + ((lane >> 3) + 8 * i) * PL + (lane & 7) * 8) = vp; }
    asm volatile("" ::: "memory"); __builtin_amdgcn_sched_barrier(0);
    bf16x8 Kt[4][2];
#pragma unroll
    for (int Td = 0; Td < 4; ++Td)
#pragma unroll
        for (int s = 0; s < 2; ++s) Kt[Td][s] = trfrag(Kl, PL, s, 16 * Td, lane);
#pragma unroll
    for (int Te = 0; Te < 4; ++Te) { const bf16x8 v0 = trfrag(Vl, PL, 0, 16 * Te, lane), v1 = trfrag(Vl, PL, 1, 16 * Te, lane);
#pragma unroll
        for (int Td = 0; Td < 4; ++Td) { f32x4 acc = (f32x4){0.f, 0.f, 0.f, 0.f}; acc = MF16(Kt[Td][0], v0, acc); acc = MF16(Kt[Td][1], v1, acc);
            u32x2 w; w.x = pk2(acc[0], acc[1]); w.y = pk2(acc[2], acc[3]); *(LAS u32x2*)(Kl + (16 * Te + r) * PL + 16 * Td + 4 * q) = w; } }
    asm volatile("" ::: "memory"); __builtin_amdgcn_sched_barrier(0);
    { bf16_t* dstb = (bf16_t*)P.stg + (size_t)ci * 4096;
#pragma unroll
      for (int i = 0; i < 8; ++i) { const int row = (lane >> 3) + 8 * i, ch = lane & 7; *(u32x4*)(dstb + row * 64 + ch * 8) = *(const LAS u32x4*)(Kl + row * PL + ch * 8); } }
}
__device__ __forceinline__ void mlstm_out_w(const RecP& P, LAS unsigned char* wl, int ci, int lane) {
    const int r = lane & 15, q = lane >> 4; constexpr int PL = 72;
    const int bh = ci >> 6, c = ci & 63, b = bh >> 2, h = bh & 3, row0 = b * SEQ + c * 64;
    const bf16_t* Xq = P.proj + (size_t)row0 * PJ + C_MQ + h * 64; const bf16_t* Xk = P.proj + (size_t)row0 * PJ + C_MK + h * 64; const bf16_t* Xv = P.proj + (size_t)row0 * PJ + C_MV + h * 64;
    LAS bf16_t* Tl = (LAS bf16_t*)wl; LAS float* vg = (LAS float*)(wl + 9216); LAS float* vn = vg + 64;
#pragma unroll
    for (int i = 0; i < 8; ++i) *(LAS u32x4*)(Tl + ((lane >> 3) + 8 * i) * PL + (lane & 7) * 8) = piece(Xv, PJ, i, lane);
    const float* tp = P.tail + (size_t)(row0 + lane) * 32;
    const float li = tp[T_MI + h] + P.mbi[h], lf = logsig(tp[T_MF + h] + P.mbf[h]);
    const float m = P.smMS[ci]; vn[lane] = P.smN[(size_t)ci * 64 + lane];
    const float bc = scan_add(lf, lane), g = li - bc, pm = scan_max(g, lane), M = fmaxf(m, pm), wint = fexp(m - M), expm = fexp(-bc - M);
    vg[lane] = g;
    asm volatile("" ::: "memory"); __builtin_amdgcn_sched_barrier(0);
    bf16x8 Kf[4][2], Qf[4][2];
#pragma unroll
    for (int T = 0; T < 4; ++T)
#pragma unroll
        for (int ks = 0; ks < 2; ++ks) { Kf[T][ks] = rfg(Xk, PJ, T, ks, lane); Qf[T][ks] = rfg(Xq, PJ, T, ks, lane); }
    float Mj[4], wj[4], ej[4];
#pragma unroll
    for (int T = 0; T < 4; ++T) { Mj[T] = __shfl(M, 16 * T + r); wj[T] = __shfl(wint, 16 * T + r); ej[T] = __shfl(expm, 16 * T + r); }
    u32x2 Pk[4][4]; float dinv[4];
#pragma unroll
    for (int Tj = 0; Tj < 4; ++Tj) { float dsum = 0.f;
#pragma unroll
        for (int Tl_ = 0; Tl_ < 4; ++Tl_) {
            if (Tl_ <= Tj) { f32x4 acc = (f32x4){0.f, 0.f, 0.f, 0.f}; acc = MF16(Kf[Tl_][0], Qf[Tj][0], acc); acc = MF16(Kf[Tl_][1], Qf[Tj][1], acc);
                const f32x4 g4 = *(const LAS f32x4*)(vg + 16 * Tl_ + 4 * q); float sv[4];
#pragma unroll
                for (int rg = 0; rg < 4; ++rg) { const bool ok = (Tl_ < Tj) || (4 * q + rg <= r); sv[rg] = ok ? acc[rg] * fexp(g4[rg] - Mj[Tj]) : 0.f; dsum += sv[rg]; }
                Pk[Tj][Tl_].x = pk2(sv[0], sv[1]); Pk[Tj][Tl_].y = pk2(sv[2], sv[3]); }
            else { Pk[Tj][Tl_].x = 0u; Pk[Tj][Tl_].y = 0u; } }
        dsum = red_q(dsum);
        float qn = 0.f;
#pragma unroll
        for (int ks = 0; ks < 2; ++ks) { float qf[8]; unpack8(__builtin_bit_cast(u32x4, Qf[Tj][ks]), qf); const f32x4 n0 = *(const LAS f32x4*)(vn + 32 * ks + 8 * q), n1 = *(const LAS f32x4*)(vn + 32 * ks + 8 * q + 4);
            qn += (qf[0] * n0[0] + qf[1] * n0[1]) + (qf[2] * n0[2] + qf[3] * n0[3]) + (qf[4] * n1[0] + qf[5] * n1[1]) + (qf[6] * n1[2] + qf[7] * n1[3]); }
        qn = red_q(qn);
        const float den = dsum + wj[Tj] * qn; dinv[Tj] = __builtin_amdgcn_rcpf(fmaxf(fabsf(den), ej[Tj]));
        Qf[Tj][0] = frag_scale(Qf[Tj][0], wj[Tj]); Qf[Tj][1] = frag_scale(Qf[Tj][1], wj[Tj]); asm volatile("" ::: "memory"); __builtin_amdgcn_sched_barrier(0); }
    asm volatile("" ::: "memory"); __builtin_amdgcn_sched_barrier(0);
    const bf16_t* cs = P.csm + (size_t)ci * 4096;
    bf16x8 Vt[4][2], Ct[4][2];
#pragma unroll
    for (int Te = 0; Te < 4; ++Te)
#pragma unroll
        for (int s = 0; s < 2; ++s) { Vt[Te][s] = trfrag(Tl, PL, s, 16 * Te, lane); Ct[Te][s] = rfg(cs, 64, Te, s, lane); }
    asm volatile("" ::: "memory"); __builtin_amdgcn_sched_barrier(0);
#pragma unroll
    for (int Tj = 0; Tj < 4; ++Tj) { f32x4 O[4];
        const bf16x8 p0 = __builtin_bit_cast(bf16x8, ((u32x4){Pk[Tj][0].x, Pk[Tj][0].y, Pk[Tj][1].x, Pk[Tj][1].y})), p1 = __builtin_bit_cast(bf16x8, ((u32x4){Pk[Tj][2].x, Pk[Tj][2].y, Pk[Tj][3].x, Pk[Tj][3].y}));
#pragma unroll
        for (int Te = 0; Te < 4; ++Te) { f32x4 acc = (f32x4){0.f, 0.f, 0.f, 0.f}; acc = MF16(Vt[Te][0], p0, acc); if (Tj >= 2) acc = MF16(Vt[Te][1], p1, acc);
            acc = MF16(Ct[Te][0], Qf[Tj][0], acc); acc = MF16(Ct[Te][1], Qf[Tj][1], acc); O[Te] = acc; }
        stage_rows(O, Tj, dinv[Tj], Tl, PL, lane); asm volatile("" ::: "memory"); __builtin_amdgcn_sched_barrier(0); }
    asm volatile("" ::: "memory"); __builtin_amdgcn_sched_barrier(0);
    final_store<0>(Tl, PL, P.mg, P.proj + (size_t)row0 * PJ + C_MO + h * 64, (bf16_t*)((unsigned char*)P.ycat + (size_t)row0 * DM + h * 64), lane);
}
__device__ __forceinline__ void gla_out_w(const RecP& P, const GWf& W, LAS unsigned char* wl, int ci, int lane) {
    const int r = lane & 15, q = lane >> 4; constexpr int PL = 72;
    const int bh = ci >> 6, c = ci & 63, b = bh >> 2, h = bh & 3, row0 = b * SEQ + c * 64;
    const bf16_t* Xq = P.proj + (size_t)row0 * PJ + C_GQ + h * 64; const bf16_t* Xk = P.proj + (size_t)row0 * PJ + C_GK + h * 64; const bf16_t* Xv = P.proj + (size_t)row0 * PJ + C_GV + h * 64;
    LAS bf16_t* Tl = (LAS bf16_t*)wl;
    { float bend[4]; gla_gate_tile<0>(Tl, PL, bend, W, P.tail + (size_t)row0 * 32, lane); }
    asm volatile("" ::: "memory"); __builtin_amdgcn_sched_barrier(0);
    bf16x8 Kf[4][2], Qf[4][2];
#pragma unroll
    for (int T = 0; T < 4; ++T)
#pragma unroll
        for (int ks = 0; ks < 2; ++ks) { const bf16x8 ef = *(const LAS bf16x8*)(Tl + (16 * T + r) * PL + 32 * ks + 8 * q); Qf[T][ks] = frag_mul(rfg(Xq, PJ, T, ks, lane), ef, false); Kf[T][ks] = frag_mul(rfg(Xk, PJ, T, ks, lane), ef, true); }
    asm volatile("" ::: "memory"); __builtin_amdgcn_sched_barrier(0);
#pragma unroll
    for (int i = 0; i < 8; ++i) *(LAS u32x4*)(Tl + ((lane >> 3) + 8 * i) * PL + (lane & 7) * 8) = piece(Xv, PJ, i, lane);
    asm volatile("" ::: "memory"); __builtin_amdgcn_sched_barrier(0);
    u32x2 Pk[4][4];
#pragma unroll
    for (int Tj = 0; Tj < 4; ++Tj)
#pragma unroll
        for (int Tl_ = 0; Tl_ < 4; ++Tl_) {
            if (Tl_ <= Tj) { f32x4 acc = (f32x4){0.f, 0.f, 0.f, 0.f}; acc = MF16(Kf[Tl_][0], Qf[Tj][0], acc); acc = MF16(Kf[Tl_][1], Qf[Tj][1], acc); float sv[4];
#pragma unroll
                for (int rg = 0; rg < 4; ++rg) { const bool ok = (Tl_ < Tj) || (4 * q + rg <= r); sv[rg] = ok ? acc[rg] : 0.f; }
                Pk[Tj][Tl_].x = pk2(sv[0], sv[1]); Pk[Tj][Tl_].y = pk2(sv[2], sv[3]); }
            else { Pk[Tj][Tl_].x = 0u; Pk[Tj][Tl_].y = 0u; } }
    const bf16_t* cs = P.csg + (size_t)ci * 4096;
    bf16x8 Vt[4][2], Ct[4][2];
#pragma unroll
    for (int Te = 0; Te < 4; ++Te)
#pragma unroll
        for (int s = 0; s < 2; ++s) { Vt[Te][s] = trfrag(Tl, PL, s, 16 * Te, lane); Ct[Te][s] = rfg(cs, 64, Te, s, lane); }
    asm volatile("" ::: "memory"); __builtin_amdgcn_sched_barrier(0);
#pragma unroll
    for (int Tj = 0; Tj < 4; ++Tj) { f32x4 O[4];
        const bf16x8 p0 = __builtin_bit_cast(bf16x8, ((u32x4){Pk[Tj][0].x, Pk[Tj][0].y, Pk[Tj][1].x, Pk[Tj][1].y})), p1 = __builtin_bit_cast(bf16x8, ((u32x4){Pk[Tj][2].x, Pk[Tj][2].y, Pk[Tj][3].x, Pk[Tj][3].y}));
#pragma unroll
        for (int Te = 0; Te < 4; ++Te) { f32x4 acc = (f32x4){0.f, 0.f, 0.f, 0.f}; acc = MF16(Vt[Te][0], p0, acc); if (Tj >= 2) acc = MF16(Vt[Te][1], p1, acc);
            acc = MF16(Ct[Te][0], Qf[Tj][0], acc); acc = MF16(Ct[Te][1], Qf[Tj][1], acc); O[Te] = acc; }
        stage_rows(O, Tj, 1.f, Tl, PL, lane); asm volatile("" ::: "memory"); __builtin_amdgcn_sched_barrier(0); }
    asm volatile("" ::: "memory"); __builtin_amdgcn_sched_barrier(0);
    final_store<1>(Tl, PL, P.gg, P.proj + (size_t)row0 * PJ + C_GR + h * 64, (bf16_t*)((unsigned char*)P.ycat + (size_t)row0 * DM + 768 + h * 64), lane);
}
#undef MF16
}


constexpr int N_PHASES = 2 + 9 * DEPTH;
__global__ void __launch_bounds__(512, 2) mega_fwd(Args args) {
    extern __shared__ __attribute__((aligned(16))) unsigned char lds_raw[];
    Frame F;
    F.lds = (LAS unsigned char*)lds_raw;
    F.MISC = (volatile LAS unsigned*)(F.lds + MISC_OFF);
    F.tid = threadIdx.x; F.lane = F.tid & 63; F.wave = __builtin_amdgcn_readfirstlane(F.tid >> 6);
    F.G = gridDim.x; { const int bx = blockIdx.x; F.vcu = (F.G % 8 == 0) ? (bx % 8) * (F.G / 8) + bx / 8 : bx; }
    typedef const __attribute__((address_space(4))) Args* CArgs;
    const CArgs ap0 = (CArgs)__builtin_amdgcn_kernarg_segment_ptr();
    F.ctl = (gu32*)(args.ws + WS_CTL);
    for (int u = F.tid; u < (LDS_BYTES - LDSCTL_OFF) / 4; u += 512) ((LAS unsigned*)(F.lds + LDSCTL_OFF))[u] = 0u;
    __syncthreads();
#if MK_ONE_LAUNCH
    XcdBarrier bar = xcd_barrier_post((unsigned*)(F.ctl + CW_BAR), F.MISC + 8);
#define GRID_BAR() xcd_barrier(bar)
#else
#define GRID_BAR() do {} while (0)
#endif
    const int lo = args.ph_lo, hi = args.ph_hi;
#define IN(k) (lo <= (k) && (k) < hi)
#define SEAM(k) do { if (IN(k) && IN((k) + 1)) { GRID_BAR(); if (NREP(15) == 2) GRID_BAR(); } } while (0)
    const int NGW = F.G * 8;
#define PHASE_IDS() int tid = threadIdx.x; asm volatile("" : "+v"(tid)); const int lane = tid & 63, wid = __builtin_amdgcn_readfirstlane(tid >> 6); const int gw = F.vcu * 8 + wid; (void)lane; (void)gw; \
    CArgs ap = ap0; asm volatile("" : "+s"(ap)); unsigned char* ws = ap->ws; (void)ws
#define AIN(i) (ap->in[i])
#define MOD ((float*)(ws + WS_MOD))
#define ROPE ((float*)(ws + WS_ROPE))
#define WIN ((bf16_t*)(ws + WS_WIN))
#define WOUT ((bf16_t*)(ws + WS_WOUT))
#define WGU8 ((unsigned char*)(ws + WS_WGU))
#define WD8 ((unsigned char*)(ws + WS_WD))
#define U8B ((unsigned char*)(ws + WS_U8))
#define WIN8 ((unsigned char*)(ws + WS_WIN8))
#define H8B ((unsigned char*)(ws + WS_PROJ))
#define LTOK ((int*)(ws + WS_LTOK))
#define LGATE ((float*)(ws + WS_LGATE))
#define PROJ ((bf16_t*)(ws + WS_PROJ))
#define HB ((bf16_t*)(ws + WS_PROJ))
#define XB ((bf16_t*)(ws + WS_XR))
#define YSORT ((bf16_t*)(ws + WS_YSORT))
#define TAILB ((float*)(ws + WS_TAIL))
#define TOKSLOT ((int*)(ws + WS_SM + SM_TS))
#define UB ((bf16_t*)(ws + WS_U))
#define YCAT ((bf16_t*)(ws + WS_YCAT))
#define STM ((float*)(ws + WS_U))
#define STG ((float*)(ws + WS_U + 32 * MiB))
#define CSM ((bf16_t*)(ws + WS_XR + 64 * MiB))
#define CSG ((bf16_t*)(ws + WS_XR + 80 * MiB))
#define G_smN ((float*)(ws + WS_SM + SM_N))
#define G_smBC ((float*)(ws + WS_SM + SM_BC))
#define G_smDM ((float*)(ws + WS_SM + SM_DM))
#define G_smMS ((float*)(ws + WS_SM + SM_MS))
#define G_smGBE ((float*)(ws + WS_SM + SM_GBE))
#define x_in AIN(I_X)

    if (IN(0) && PHON(0)) for (int rp0 = 0; rp0 < NREP(0); ++rp0) {
        PHASE_IDS();
        {
            LAS float* cact = (LAS float*)F.lds;
            LAS float* part = (LAS float*)(F.lds + 32768);
            const float* cc = AIN(I_C);
            for (int i = tid; i < NB * DM; i += 512) { const int b = i >> 10, k = i & 1023; const float v = cc[i]; cact[k * 8 + b] = v / (1.f + fexp(-v)); }
            __syncthreads();
            for (int it = F.vcu; it < DEPTH * 96; it += F.G) {
                const int l = it / 96, j0 = (it % 96) * 64;
                const float* W = AIN(I_WADA) + (size_t)l * DM * 6144 + j0 + lane;
                float a[8] = {0.f, 0.f, 0.f, 0.f, 0.f, 0.f, 0.f, 0.f};
#pragma unroll 32
                for (int kk = 0; kk < 128; ++kk) { const int k = wid * 128 + kk; const float w = W[(size_t)k * 6144];
                    const f32x4 c0 = *(const LAS f32x4*)(cact + k * 8), c1 = *(const LAS f32x4*)(cact + k * 8 + 4);
                    a[0] += c0[0] * w; a[1] += c0[1] * w; a[2] += c0[2] * w; a[3] += c0[3] * w; a[4] += c1[0] * w; a[5] += c1[1] * w; a[6] += c1[2] * w; a[7] += c1[3] * w; }
#pragma unroll
                for (int b = 0; b < 8; ++b) part[(wid * 8 + b) * 64 + lane] = a[b];
                __syncthreads();
                { const int b = tid >> 6, j = tid & 63; float s = AIN(I_BADA)[(size_t)l * 6144 + j0 + j];
#pragma unroll
                  for (int w = 0; w < 8; ++w) s += part[(w * 8 + b) * 64 + j];
                  MOD[((size_t)l * NB + b) * 6144 + j0 + j] = s; }
                __syncthreads();
            }
        }
        {
            const int* pos = (const int*)AIN(I_POS);
            for (int i = blockIdx.x * 512 + tid; i < NTOK * 4; i += F.G * 512) { const int row = i >> 2, f = i & 3;
                const float invf = (float)pow(500000.0, -0.25 * (double)f); const float ang = (float)pos[row] * invf;
                ROPE[(size_t)row * 8 + f] = (float)cos((double)ang); ROPE[(size_t)row * 8 + 4 + f] = (float)sin((double)ang); }
        }
        {
            LAS float* scr = (LAS float*)(F.lds + 49152 + wid * 8704);
            constexpr int I_IN = (DM / 64) * (PW / 32), I_OUT = (DM / 64) * (DM / 32);
            auto dec0 = [&](int it, TrD& d) { const int l = it / (I_IN + I_OUT); int r = it % (I_IN + I_OUT);
                if (r < I_IN) { const int kb = r / (PW / 32), nb = r % (PW / 32); const int nbe = (nb < 112) ? nb : 0; const int tl = nbe >> 3;
                    d.wsc = (tl == 0 || tl == 10) ? 0.125f : (tl == 7) ? ATT_C2 : 1.f;
                    d.src = AIN(I_WIN) + (size_t)l * DM * PIN + (size_t)(kb * 64) * PIN + win_src_col(nbe * 32); d.ldw = PIN; d.K = DM; d.dst = WIN + (size_t)l * PW * DM; d.dst8 = WIN8 + (size_t)l * PP * DM; d.drow0 = nbe * 32; d.k0 = kb * 64;
                    return nb < 112; }
                r -= I_IN; const int kb = r / (DM / 32), nb = r % (DM / 32); d.wsc = 1.f;
                d.src = AIN(I_WOUT) + (size_t)l * DM * DM + (size_t)(kb * 64) * DM + nb * 32; d.wsc = W8S; d.dst8 = nullptr; d.ldw = DM; d.K = DM; d.dst = (bf16_t*)((unsigned char*)WOUT + (size_t)l * DM * DM); d.drow0 = nb * 32; d.k0 = kb * 64; return true; };
            { TrD dc, dn; f32x4 vc[8], vn[8]; int it = gw; bool okc = dec0(it, dc); tr_load4(dc, vc, lane); dn = dc; bool okn = okc;
#pragma unroll
              for (int i = 0; i < 8; ++i) vn[i] = vc[i];
              for (; it < DEPTH * (I_IN + I_OUT); it += NGW) { const int itn = it + NGW;
                  if (itn < DEPTH * (I_IN + I_OUT)) { okn = dec0(itn, dn); tr_load4(dn, vn, lane); }
                  if (okc) { if (dc.ldw == DM) tr_finish8(dc, vc, scr, lane); else { TrD d8 = dc; d8.dst = (bf16_t*)dc.dst8; d8.wsc = dc.wsc * W8S; tr_finish8(d8, vc, scr, lane); } }
                  dc = dn; okc = okn;
#pragma unroll
                  for (int i = 0; i < 8; ++i) vc[i] = vn[i]; } }
            for (int it = gw; it < DEPTH * (DM / 64) * 8; it += NGW) { const int l = it / ((DM / 64) * 8), r = it % ((DM / 64) * 8), kb = r >> 3, nb = 112 + (r & 7);
                tr_item(AIN(I_WIN) + (size_t)l * DM * PIN, PIN, DM, WIN + (size_t)l * PW * DM, nb * 32, win_src_col(nb * 32 + (lane & 31)), kb * 64, scr, lane); }
        }
    }
    SEAM(0);
    if (IN(1) && PHON(1)) {
        PHASE_IDS();
        NarrowT NT_; nmm_load_tail(NT_, WIN + (size_t)PP * DM, wid, lane);
        LAS bf16_t* Sst = (LAS bf16_t*)F.lds; LAS float* Pb = (LAS float*)(F.lds + NMM_P_OFF);
        const int b = F.vcu >> 5; const float* md = MOD + (size_t)b * 6144;
        f32x4 sh[4], sc[4];
#pragma unroll
        for (int j = 0; j < 4; ++j) { sh[j] = *(const f32x4*)(md + 4 * lane + 256 * j); sc[j] = *(const f32x4*)(md + 1024 + 4 * lane + 256 * j) + 1.0f; }
        const int rowb = F.vcu * 128 + wid * 16;
        for (int i = 0; i < 16; i += 4) { f32x4 v[4][4];
#pragma unroll
            for (int rr = 0; rr < 4; ++rr)
#pragma unroll
                for (int j = 0; j < 4; ++j) v[rr][j] = *(const f32x4*)(x_in + (size_t)(rowb + i + rr) * DM + 4 * lane + 256 * j);
#pragma unroll
            for (int rr = 0; rr < 4; ++rr)
#pragma unroll
                for (int j = 0; j < 4; ++j) { const f32x4 u = v[rr][j] * sc[j] + sh[j];
                    u32x2 w; w.x = pk2(u[0], u[1]); w.y = pk2(u[2], u[3]); *(LAS u32x2*)(Sst + (wid * 4 + rr) * NSP + 4 * lane + 256 * j) = w;
                    *(unsigned*)(U8B + (size_t)(rowb + i + rr) * DM + 4 * lane + 256 * j) = pk4_fp8(u[0], u[1], u[2], u[3]); }
            nmm_step_tail(NT_, Sst, Pb, TAILB + (size_t)(F.vcu * 128) * 32, i, tid, wid, lane); }
    }
    SEAM(1);

    for (int l = 0; l < DEPTH; ++l) {
        const int pb = 2 + 9 * l;
#define modl (MOD + (size_t)l * NB * 6144)
#define MAKE_RP() rec::RecP RP; RP.proj = PROJ; RP.tail = TAILB; RP.csm = CSM; RP.csg = CSG; RP.stm = STM; RP.stg = STG; RP.smN = G_smN; RP.smBC = G_smBC; RP.smDM = G_smDM; RP.smMS = G_smMS; RP.smGBE = G_smGBE; RP.ycat = YCAT; \
        RP.mbi = AIN(I_MBI) + l * 4; RP.mbf = AIN(I_MBF) + l * 4; RP.mg = AIN(I_MG) + l * 64; RP.wa2 = AIN(I_WA2) + (size_t)l * 16 * 256; RP.ba = AIN(I_BA) + l * 256; RP.gg = AIN(I_GG) + l * 64;
        if (IN(pb + 0) && PHON(2)) {
            PHASE_IDS(); (void)tid;
            { gm::K1<true> k; k.S.init(NTOK, PP, F.G, (int)blockIdx.x); k.A = U8B; k.Bt = WIN8 + (size_t)l * PP * DM; k.O = PROJ; k.rope = ROPE;
                gm::gemm_phase<gm::K1<true>>(F.lds, k); }
        }
        SEAM(pb + 0);
        if (IN(pb + 1) && PHON(3)) {
            PHASE_IDS();
            MAKE_RP();
            for (int rp = 0; rp < NREP(3); ++rp) {
                LAS unsigned char* wl = F.lds + wid * 16384;
                recw::GWf gwf; recw::ld_gwf(gwf, RP, (gw >> 6) & 3, lane);
                for (int ci = gw; ci < 2048; ci += NGW) { int lane_ = lane; asm volatile("" : "+v"(lane_)); if (PHON(13)) recw::mlstm_local_w(RP, wl, ci, lane_); asm volatile("" ::: "memory"); __builtin_amdgcn_sched_barrier(0); if (PHON(14)) recw::gla_local_w(RP, gwf, wl, ci, lane_); }
            }
        }
        SEAM(pb + 1);
        if (IN(pb + 2) && PHON(4)) {
            PHASE_IDS();
            const int gt = blockIdx.x * 512 + tid, NGT = F.G * 512;
            for (int task = gt; task < 66048; task += NGT) {
                if (task < 32768) {
                    const int bh = task >> 10, el = (task & 1023) * 4; const bf16_t* p = (const bf16_t*)STM + (size_t)bh * 64 * 4096 + el; bf16_t* o = CSM + (size_t)bh * 64 * 4096 + el;
                    const float* bc = G_smBC + bh * 64; const float* dm = G_smDM + bh * 64;
                    f32x4 C = (f32x4){0.f, 0.f, 0.f, 0.f}; float m = 0.f;
#pragma unroll 16
                    for (int c = 0; c < NCH; ++c) { const u32x2 uw = *(const u32x2*)(p + (size_t)c * 4096); const f32x4 u = (f32x4){bflo(uw.x), bfhi(uw.x), bflo(uw.y), bfhi(uw.y)}; u32x2 w; w.x = pk2(C[0], C[1]); w.y = pk2(C[2], C[3]); *(u32x2*)(o + (size_t)c * 4096) = w;
                        if (el == 0) G_smMS[bh * 64 + c] = m;
                        const float B = bc[c], Dm = dm[c], mn = fmaxf(B + m, Dm); C = C * fexp(B + m - mn) + u * fexp(Dm - mn); m = mn; }
                } else if (task < 65536) {
                    const int t2 = task - 32768, bh = t2 >> 10, el = (t2 & 1023) * 4, d = el & 63; const bf16_t* p = (const bf16_t*)STG + (size_t)bh * 64 * 4096 + el; bf16_t* o = CSG + (size_t)bh * 64 * 4096 + el;
                    const float* be = G_smGBE + (size_t)bh * 64 * 64 + d;
                    f32x4 S = (f32x4){0.f, 0.f, 0.f, 0.f};
#pragma unroll 16
                    for (int c = 0; c < NCH; ++c) { const u32x2 uw = *(const u32x2*)(p + (size_t)c * 4096); const f32x4 u = (f32x4){bflo(uw.x), bfhi(uw.x), bflo(uw.y), bfhi(uw.y)}; const f32x4 b4 = *(const f32x4*)(be + c * 64);
                        u32x2 w; w.x = pk2(S[0], S[1]); w.y = pk2(S[2], S[3]); *(u32x2*)(o + (size_t)c * 4096) = w;
                        S = (f32x4){fexp(b4[0]) * S[0] + u[0], fexp(b4[1]) * S[1] + u[1], fexp(b4[2]) * S[2] + u[2], fexp(b4[3]) * S[3] + u[3]}; }
                } else {
                    const int t3 = task - 65536, bh = t3 >> 4, el = (t3 & 15) * 4; float* p = G_smN + (size_t)bh * 64 * 64 + el; const float* bc = G_smBC + bh * 64; const float* dm = G_smDM + bh * 64;
                    f32x4 C = (f32x4){0.f, 0.f, 0.f, 0.f}; float m = 0.f;
#pragma unroll 8
                    for (int c = 0; c < NCH; ++c) { const f32x4 u = *(const f32x4*)(p + c * 64); *(f32x4*)(p + c * 64) = C;
                        const float B = bc[c], Dm = dm[c], mn = fmaxf(B + m, Dm); C = C * fexp(B + m - mn) + u * fexp(Dm - mn); m = mn; }
                }
            }
            for (int rp = 0; rp < NREP(13); ++rp) {
                LAS float* scr = (LAS float*)(F.lds + 49152 + wid * 8704);
                constexpr int I_G = (DM / 64) * (1024 / 32), I_D = (DE / 64) * (DM / 32);
                auto dece = [&](int it, TrD& d) { const int e = it / (I_G + I_D); int r = it % (I_G + I_D); d.wsc = W8S; d.dst8 = nullptr;
                    if (r < I_G) { const int kb = r / 32, nb = r % 32, n0 = nb * 32, tt = n0 >> 8, rr = n0 & 255;
                        d.src = (rr < 128 ? AIN(I_EWG) : AIN(I_EWU)) + ((size_t)l * NE + e) * DM * DE + (size_t)(kb * 64) * DE + tt * 128 + (rr & 127); d.ldw = DE; d.K = DM; d.dst = (bf16_t*)(WGU8 + (size_t)e * 1024 * 1024); d.drow0 = n0; d.k0 = kb * 64; }
                    else { r -= I_G; const int kb = r / 32, nb = r % 32;
                        d.src = AIN(I_EWD) + ((size_t)l * NE + e) * DE * DM + (size_t)(kb * 64) * DM + nb * 32; d.ldw = DM; d.K = DE; d.dst = (bf16_t*)(WD8 + (size_t)e * 1024 * 512); d.drow0 = nb * 32; d.k0 = kb * 64; } };
                TrD dc, dn; f32x4 vc[8], vn[8]; int it = gw; dece(it, dc); tr_load4(dc, vc, lane); dn = dc;
#pragma unroll
                for (int i = 0; i < 8; ++i) vn[i] = vc[i];
                for (; it < NE * (I_G + I_D); it += NGW) { const int itn = it + NGW;
                    if (itn < NE * (I_G + I_D)) { dece(itn, dn); tr_load4(dn, vn, lane); }
                    tr_finish8(dc, vc, scr, lane);
                    dc = dn;
#pragma unroll
                    for (int i = 0; i < 8; ++i) vc[i] = vn[i]; }
            }
        }
        SEAM(pb + 2);
        if (IN(pb + 3) && PHON(5)) {
            PHASE_IDS();
            if (PHON(10)) {
                float d1 = 0.f, d2 = 0.f;
                for (int i = 0; i < 32; ++i) { d1 += AIN(I_LQ1)[l * 32 + i] * AIN(I_LK1)[l * 32 + i]; d2 += AIN(I_LQ2)[l * 32 + i] * AIN(I_LK2)[l * 32 + i]; }
                const float lam_init = 0.8f - 0.6f * expf(-0.3f * (float)l);
                attn_body::AttnParams AP; AP.Q = (const attn_body::bf16*)(PROJ + C_DQ); AP.K = (const attn_body::bf16*)(PROJ + C_DK); AP.V = (const attn_body::bf16*)(PROJ + C_DV);
                AP.zpage = (const attn_body::bf16*)(F.ctl + CW_ZPAGE); AP.Y = (bf16_t*)((unsigned char*)YCAT + 512); AP.gnorm = AIN(I_DG) + l * 64; AP.lam = expf(d1) - expf(d2) + lam_init; AP.osc = 1.f - lam_init;
                const int bh = F.vcu >> 3, s = F.vcu & 7;
                if (F.G == 256) {
                    for (int rp = 0; rp < NREP(10); ++rp)
                    for (int i = 0; i < 2; ++i) { const int qb = (i == 0) ? s : 15 - s;
                        attn_body::attn_unit<8, 0>(bh >> 2, bh & 3, qb, AP, (char*)lds_raw); attn_body::attn_unit<8, 1>(bh >> 2, bh & 3, qb, AP, (char*)lds_raw); }
                }
            }
            __syncthreads();
            {
            PHASE_IDS();
            MAKE_RP();
            if (PHON(11)) for (int rp = 0; rp < NREP(11); ++rp) {
                LAS unsigned char* wl = F.lds + wid * 16384;
                LAS u32x4* gst = (LAS u32x4*)(wl + 10240);
                { recw::GWf gwf; recw::ld_gwf(gwf, RP, (gw >> 6) & 3, lane);
#pragma unroll
                  for (int Td = 0; Td < 4; ++Td) gst[Td * 64 + lane] = __builtin_bit_cast(u32x4, gwf.Bw[Td]);
                  gst[256 + lane] = __builtin_bit_cast(u32x4, ((f32x4){gwf.ba[0], gwf.ba[1], gwf.ba[2], gwf.ba[3]})); }
                for (int ci = gw; ci < 2048; ci += NGW) { int lane_ = lane; asm volatile("" : "+v"(lane_)); if (PHON(13)) recw::mlstm_out_w(RP, wl, ci, lane_); asm volatile("" ::: "memory"); __builtin_amdgcn_sched_barrier(0);
                    if (PHON(14)) { recw::GWf gwf;
#pragma unroll
                        for (int Td = 0; Td < 4; ++Td) gwf.Bw[Td] = __builtin_bit_cast(bf16x8, gst[Td * 64 + lane_]);
                        const f32x4 bb = __builtin_bit_cast(f32x4, gst[256 + lane_]); gwf.ba[0] = bb[0]; gwf.ba[1] = bb[1]; gwf.ba[2] = bb[2]; gwf.ba[3] = bb[3];
                        recw::gla_out_w(RP, gwf, wl, ci, lane_); } }
            }
            __syncthreads();
            if (PHON(12)) for (int rp = 0; rp < NREP(12); ++rp) {
                const float* cw = AIN(I_CONVW) + (size_t)l * 3 * 256; const float* cbias = AIN(I_CONVB) + l * 256;
                for (int it = F.vcu; it < NTOK / 64; it += F.G) {
                    for (int p = tid; p < 64 * 32; p += 512) { const int r = p >> 5, chn = p & 31, row = it * 64 + r, t = row & (SEQ - 1);
                        const bf16_t* pr = PROJ + (size_t)row * PJ + chn * 8;
                        float s0[8], s1[8], s2[8], cbv[8];
                        { float a[8], bq[8]; rec::unpack8(*(const u32x4*)(pr + C_CC), a); rec::unpack8(*(const u32x4*)(pr + C_CH), bq);
#pragma unroll
                          for (int i = 0; i < 8; ++i) s2[i] = a[i] * bq[i]; }
                        if (t >= 1) { float a[8], bq[8]; rec::unpack8(*(const u32x4*)(pr - PJ + C_CC), a); rec::unpack8(*(const u32x4*)(pr - PJ + C_CH), bq);
#pragma unroll
                          for (int i = 0; i < 8; ++i) s1[i] = a[i] * bq[i]; } else {
#pragma unroll
                          for (int i = 0; i < 8; ++i) s1[i] = 0.f; }
                        if (t >= 2) { float a[8], bq[8]; rec::unpack8(*(const u32x4*)(pr - 2 * PJ + C_CC), a); rec::unpack8(*(const u32x4*)(pr - 2 * PJ + C_CH), bq);
#pragma unroll
                          for (int i = 0; i < 8; ++i) s0[i] = a[i] * bq[i]; } else {
#pragma unroll
                          for (int i = 0; i < 8; ++i) s0[i] = 0.f; }
                        rec::unpack8(*(const u32x4*)(pr + C_CB), cbv);
                        float y[8];
#pragma unroll
                        for (int i = 0; i < 8; ++i) { const int cch = chn * 8 + i; y[i] = cbv[i] * (cw[cch] * s0[i] + cw[256 + cch] * s1[i] + cw[512 + cch] * s2[i] + cbias[cch]); }
                        u32x2 w; w.x = pk4_fp8(y[0] * Y8S, y[1] * Y8S, y[2] * Y8S, y[3] * Y8S); w.y = pk4_fp8(y[4] * Y8S, y[5] * Y8S, y[6] * Y8S, y[7] * Y8S);
                        *(u32x2*)((unsigned char*)YCAT + (size_t)row * DM + 256 + chn * 8) = w; }
                }
            }
            }
        }
        SEAM(pb + 3);
        if (IN(pb + 4) && PHON(6)) {
            PHASE_IDS(); (void)tid;
            gm::K2 k; k.S.init(NTOK, DM, F.G, (int)blockIdx.x); k.A = (const unsigned char*)YCAT; k.Bt = (const unsigned char*)WOUT + (size_t)l * DM * DM; k.O = UB;
            for (int rp = 0; rp < NREP(6); ++rp) gm::gemm_phase<gm::K2>(F.lds, k);
        }
        SEAM(pb + 4);
        if (IN(pb + 5) && PHON(7)) {
            PHASE_IDS();
            NarrowT NT_; nmm_load_router(NT_, AIN(I_RW), wid, lane);
            LAS bf16_t* Sst = (LAS bf16_t*)F.lds; LAS float* Pb = (LAS float*)(F.lds + NMM_P_OFF); LAS float* lgs_all = (LAS float*)(F.lds + NMM_LG_OFF);
            LAS float* lgs = lgs_all + wid * 256;
            LAS int* wcnt = (LAS int*)(F.lds + NMM_LG_OFF + 8192); LAS int* wbase = wcnt + 32;
            if (tid < 32) wcnt[tid] = 0;
            const int b = F.vcu >> 5; const float* md = modl + (size_t)b * 6144;
            const float* lg = AIN(I_LN1G) + l * DM; const float* lb = AIN(I_LN1B) + l * DM;
            f32x4 gv[4], bv[4], sh[4], sc[4], g1[4];
#pragma unroll
            for (int j = 0; j < 4; ++j) { const int cix = 4 * lane + 256 * j; gv[j] = *(const f32x4*)(lg + cix); bv[j] = *(const f32x4*)(lb + cix); g1[j] = *(const f32x4*)(md + 2 * 1024 + cix) + 1.0f;
                sh[j] = *(const f32x4*)(md + 3 * 1024 + cix); sc[j] = *(const f32x4*)(md + 4 * 1024 + cix) + 1.0f; }
            const int rowb = F.vcu * 128 + wid * 16;
            u32x2 xwc[4], ywc[4];
#pragma unroll
            for (int j = 0; j < 4; ++j) { const size_t o = (size_t)rowb * DM + 4 * lane + 256 * j; xwc[j] = (l == 0) ? (u32x2){0u, 0u} : *(const u32x2*)(XB + o); ywc[j] = *(const u32x2*)(UB + o); }
            u32x2 xwn[4] = {xwc[0], xwc[1], xwc[2], xwc[3]}, ywn[4] = {ywc[0], ywc[1], ywc[2], ywc[3]};
            for (int i = 0; i < 16; ++i) { const int row = rowb + i;
                if (i < 15) {
#pragma unroll
                    for (int j = 0; j < 4; ++j) { const size_t o = (size_t)(row + 1) * DM + 4 * lane + 256 * j; if (l != 0) xwn[j] = *(const u32x2*)(XB + o); ywn[j] = *(const u32x2*)(UB + o); } }
                f32x4 v[4]; float s = 0.f;
#pragma unroll
                for (int j = 0; j < 4; ++j) { const size_t o = (size_t)row * DM + 4 * lane + 256 * j;
                    f32x4 xv; if (l == 0) xv = *(const f32x4*)(x_in + o); else { const u32x2 xw = xwc[j]; xv = (f32x4){bflo(xw.x), bfhi(xw.x), bflo(xw.y), bfhi(xw.y)}; }
                    const u32x2 yw = ywc[j]; const f32x4 yv = (f32x4){bflo(yw.x), bfhi(yw.x), bflo(yw.y), bfhi(yw.y)};
                    v[j] = xv * ALPHA + g1[j] * yv; s += (v[j][0] + v[j][1]) + (v[j][2] + v[j][3]); }
#pragma unroll
                for (int j = 0; j < 4; ++j) { xwc[j] = xwn[j]; ywc[j] = ywn[j]; }
                const float mean = wave_sum(s) * (1.f / DM); float s2 = 0.f;
#pragma unroll
                for (int j = 0; j < 4; ++j) { v[j] = v[j] - mean; s2 += (v[j][0] * v[j][0] + v[j][1] * v[j][1]) + (v[j][2] * v[j][2] + v[j][3] * v[j][3]); }
                const float rstd = __builtin_amdgcn_rsqf(wave_sum(s2) * (1.f / DM) + LN_EPS);
#pragma unroll
                for (int j = 0; j < 4; ++j) { const size_t o = (size_t)row * DM + 4 * lane + 256 * j; const f32x4 xn = v[j] * rstd * gv[j] + bv[j];
                    u32x2 xw; xw.x = pk2(xn[0], xn[1]); xw.y = pk2(xn[2], xn[3]); *(u32x2*)(XB + o) = xw;
                    const f32x4 u = xn * sc[j] + sh[j]; u32x2 w; w.x = pk2(u[0], u[1]); w.y = pk2(u[2], u[3]); *(LAS u32x2*)(Sst + (wid * 4 + (i & 3)) * NSP + 4 * lane + 256 * j) = w;
                    *(unsigned*)(U8B + o) = pk4_fp8(u[0], u[1], u[2], u[3]); }
                if ((i & 3) == 3) nmm_step_router(NT_, Sst, Pb, lgs_all, i - 3, tid, wid, lane);
            }
            asm volatile("s_waitcnt lgkmcnt(0)\n\ts_barrier" ::: "memory");
            int bk_ = 0; unsigned lpos_ = 0u; float gi_ = 0.f, gj_ = 0.f;
            if (lane < 16) {
                const float* rb = AIN(I_RB);
                float sco[16], bia[16];
#pragma unroll
                for (int q = 0; q < 4; ++q) { const f32x4 t4 = *(const LAS f32x4*)(lgs + lane * 16 + q * 4);
#pragma unroll
                    for (int c = 0; c < 4; ++c) { const float sg = 1.f / (1.f + fexp(-t4[c])); sco[q * 4 + c] = sg; bia[q * 4 + c] = sg + rb[q * 4 + c]; } }
                int bg = 0; float bgs = -INFINITY;
#pragma unroll
                for (int g = 0; g < 4; ++g) { const float a0 = bia[4 * g], a1 = bia[4 * g + 1], a2 = bia[4 * g + 2], a3 = bia[4 * g + 3];
                    const float h1 = fmaxf(a0, a1), l1 = fminf(a0, a1), h2 = fmaxf(a2, a3), l2 = fminf(a2, a3);
                    const float top = fmaxf(h1, h2), sec = fmaxf(fminf(h1, h2), (h1 >= h2) ? l1 : l2); const float gsc = top + sec;
                    if (gsc > bgs) { bgs = gsc; bg = g; } }
                float gb[4], gsx[4];
#pragma unroll
                for (int q = 0; q < 4; ++q) { gb[q] = (bg == 0) ? bia[q] : (bg == 1) ? bia[4 + q] : (bg == 2) ? bia[8 + q] : bia[12 + q]; gsx[q] = (bg == 0) ? sco[q] : (bg == 1) ? sco[4 + q] : (bg == 2) ? sco[8 + q] : sco[12 + q]; }
                int e1 = 0; float m1 = gb[0];
#pragma unroll
                for (int q = 1; q < 4; ++q) if (gb[q] > m1) { m1 = gb[q]; e1 = q; }
                int e2 = -1; float m2 = -INFINITY;
#pragma unroll
                for (int q = 0; q < 4; ++q) if (q != e1 && gb[q] > m2) { m2 = gb[q]; e2 = q; }
                const int ei = e1 < e2 ? e1 : e2, ej = e1 < e2 ? e2 : e1;
                const float si = (ei == 0) ? gsx[0] : (ei == 1) ? gsx[1] : (ei == 2) ? gsx[2] : gsx[3], sj = (ej == 0) ? gsx[0] : (ej == 1) ? gsx[1] : (ej == 2) ? gsx[2] : gsx[3];
                const int pr_ = (ei == 0) ? ej - 1 : (ei == 1) ? ej + 1 : 5; const int bk = bg * 6 + pr_;
                bk_ = bk; lpos_ = (unsigned)__hip_atomic_fetch_add(wcnt + bk, 1, __ATOMIC_RELAXED, __HIP_MEMORY_SCOPE_WORKGROUP); const float inv = 1.f / (si + sj); gi_ = si * inv; gj_ = sj * inv;
            }
            asm volatile("s_waitcnt lgkmcnt(0)\n\ts_barrier" ::: "memory");
            if (tid < NBUCKET) { gu32* cntw = F.ctl + CW_CNT + (size_t)l * NBUCKET * 64; const int c = wcnt[tid]; wbase[tid] = (c > 0) ? (int)__hip_atomic_fetch_add(cntw + tid * 64, (unsigned)c, RLX_AGENT) : 0; }
            asm volatile("s_waitcnt vmcnt(0) lgkmcnt(0)\n\ts_barrier" ::: "memory");
            if (lane < 16) { const int row = rowb + lane; const unsigned pos = (unsigned)wbase[bk_] + lpos_;
                LTOK[(size_t)bk_ * LCAP + pos] = row; LGATE[((size_t)bk_ * LCAP + pos) * 2] = gi_; LGATE[((size_t)bk_ * LCAP + pos) * 2 + 1] = gj_;
                TOKSLOT[row] = (bk_ << 16) | (int)pos;
            }
            __syncthreads();
        }
        SEAM(pb + 5);
        if ((IN(pb + 6) || IN(pb + 7)) && PHON(8)) {
            PHASE_IDS();
            LAS int* tb = (LAS int*)(F.lds + MOE_TB_OFF);
            if (wid == 0) { gu32* cntw = F.ctl + CW_CNT + (size_t)l * NBUCKET * 64;
                const int c = (lane < NBUCKET) ? (int)__hip_atomic_load(cntw + lane * 64, RLX_AGENT) : 0; const int ntl = (c + 255) >> 8; int incl = ntl;
#pragma unroll
                for (int o = 1; o < 32; o <<= 1) { const int t_ = __shfl_up(incl, o); if (lane >= o) incl += t_; }
                if (lane < NBUCKET) { tb[lane] = c; tb[32 + lane] = incl - ntl; }
                if (lane == NBUCKET - 1) tb[32 + NBUCKET] = incl; }
            __syncthreads();
            if (IN(pb + 6)) {
                gm::K4 k; k.U = U8B; k.Wgu = WGU8; k.H = H8B; k.ltok = LTOK; k.lgate = LGATE; k.tb = tb; k.G = F.G; k.vcu = F.vcu; k.rtc = F.ctl + CW_RT + (size_t)l * 160 * 64;
                for (int rp = 0; rp < NREP(8); ++rp) gm::gemm_phase<gm::K4>(F.lds, k);
            }
            SEAM(pb + 6);
            if (IN(pb + 7)) {
                gm::K5 k; k.H = H8B; k.Wd = WD8; k.Y = YSORT; k.tb = tb; k.G = F.G; k.vcu = F.vcu; k.rtc = F.ctl + CW_RT + (size_t)l * 160 * 64; k.tmo = F.ctl + CW_TMO;
                for (int rp = 0; rp < NREP(14); ++rp) gm::gemm_phase<gm::K5>(F.lds, k);
            }
        }
        SEAM(pb + 7);
        if (IN(pb + 8) && PHON(9)) {
            PHASE_IDS();
            const int b = F.vcu >> 5; const bool lastl = (l == DEPTH - 1);
            LAS bf16_t* Sst = (LAS bf16_t*)F.lds; LAS float* Pb = (LAS float*)(F.lds + NMM_P_OFF); LAS int* t0 = (LAS int*)(F.lds + MOE_TB_OFF);
            NarrowT NT_; nmm_load_tail(NT_, WIN + ((size_t)(lastl ? l : l + 1) * PW + PP) * DM, wid, lane);
            if (wid == 0) { gu32* cntw = F.ctl + CW_CNT + (size_t)l * NBUCKET * 64;
                const int c = (lane < NBUCKET) ? (int)__hip_atomic_load(cntw + lane * 64, RLX_AGENT) : 0; const int ntl = (c + 255) >> 8; int incl = ntl;
#pragma unroll
                for (int o = 1; o < 32; o <<= 1) { const int t_ = __shfl_up(incl, o); if (lane >= o) incl += t_; }
                if (lane < NBUCKET) t0[32 + lane] = incl - ntl; }
            __syncthreads();
            const float* mdn = MOD + ((size_t)(lastl ? l : l + 1) * NB + b) * 6144; const float* md = modl + (size_t)b * 6144;
            const float* lg = AIN(I_LN2G) + l * DM; const float* lb = AIN(I_LN2B) + l * DM;
            f32x4 gv[4], bv[4], sh[4], sc[4], g2[4];
#pragma unroll
            for (int j = 0; j < 4; ++j) { const int cix = 4 * lane + 256 * j; gv[j] = *(const f32x4*)(lg + cix); bv[j] = *(const f32x4*)(lb + cix); g2[j] = *(const f32x4*)(md + 5 * 1024 + cix) + 1.0f;
                sh[j] = *(const f32x4*)(mdn + cix); sc[j] = *(const f32x4*)(mdn + 1024 + cix) + 1.0f; }
            const int rowb = F.vcu * 128 + wid * 16;
            const int tsl = TOKSLOT[rowb + (lane & 15)];
            u32x2 xwc[4], ywc[4];
            { const int ts = __shfl(tsl, 0); const size_t yrow = (size_t)t0[32 + (ts >> 16)] * 256 + (ts & 0xffff);
#pragma unroll
              for (int j = 0; j < 4; ++j) { const int cix = 4 * lane + 256 * j; xwc[j] = *(const u32x2*)(XB + (size_t)rowb * DM + cix); ywc[j] = *(const u32x2*)(YSORT + yrow * DM + cix); } }
            u32x2 xwn[4] = {xwc[0], xwc[1], xwc[2], xwc[3]}, ywn[4] = {ywc[0], ywc[1], ywc[2], ywc[3]};
            for (int i = 0; i < 16; ++i) { const int row = rowb + i;
                if (i < 15) { const int ts = __shfl(tsl, i + 1); const size_t yrow = (size_t)t0[32 + (ts >> 16)] * 256 + (ts & 0xffff);
#pragma unroll
                    for (int j = 0; j < 4; ++j) { const int cix = 4 * lane + 256 * j; xwn[j] = *(const u32x2*)(XB + (size_t)(row + 1) * DM + cix); ywn[j] = *(const u32x2*)(YSORT + yrow * DM + cix); } }
                f32x4 v[4]; float s = 0.f;
#pragma unroll
                for (int j = 0; j < 4; ++j) {
                    const u32x2 xw = xwc[j]; const f32x4 xv = (f32x4){bflo(xw.x), bfhi(xw.x), bflo(xw.y), bfhi(xw.y)};
                    const u32x2 yw = ywc[j]; const f32x4 yv = (f32x4){bflo(yw.x), bfhi(yw.x), bflo(yw.y), bfhi(yw.y)};
                    v[j] = xv * ALPHA + g2[j] * yv; s += (v[j][0] + v[j][1]) + (v[j][2] + v[j][3]); }
#pragma unroll
                for (int j = 0; j < 4; ++j) { xwc[j] = xwn[j]; ywc[j] = ywn[j]; }
                const float mean = wave_sum(s) * (1.f / DM); float s2 = 0.f;
#pragma unroll
                for (int j = 0; j < 4; ++j) { v[j] = v[j] - mean; s2 += (v[j][0] * v[j][0] + v[j][1] * v[j][1]) + (v[j][2] * v[j][2] + v[j][3] * v[j][3]); }
                const float rstd = __builtin_amdgcn_rsqf(wave_sum(s2) * (1.f / DM) + LN_EPS);
#pragma unroll
                for (int j = 0; j < 4; ++j) { const size_t o = (size_t)row * DM + 4 * lane + 256 * j; const f32x4 xn = v[j] * rstd * gv[j] + bv[j];
                    if (lastl) *(f32x4*)(ap->out + o) = xn;
                    else { u32x2 xw; xw.x = pk2(xn[0], xn[1]); xw.y = pk2(xn[2], xn[3]); *(u32x2*)(XB + o) = xw;
                        const f32x4 u = xn * sc[j] + sh[j]; u32x2 w; w.x = pk2(u[0], u[1]); w.y = pk2(u[2], u[3]); *(LAS u32x2*)(Sst + (wid * 4 + (i & 3)) * NSP + 4 * lane + 256 * j) = w;
                        *(unsigned*)(U8B + o) = pk4_fp8(u[0], u[1], u[2], u[3]); } }
                if (!lastl && (i & 3) == 3) nmm_step_tail(NT_, Sst, Pb, TAILB + (size_t)(F.vcu * 128) * 32, i - 3, tid, wid, lane);
            }
        }
        SEAM(pb + 8);
    }
#undef IN
#undef SEAM
}

extern "C" void kernel_launch(void* const* d_in, const int* in_sizes, int n_in, void* d_out, int out_size, void* d_ws, size_t ws_size, hipStream_t stream) {
    static int grid = 0;
    if (grid == 0) {
        if (n_in != 29 || in_sizes[0] != NTOK * DM || out_size != NTOK * DM || ws_size < WS_END) {
            fprintf(stderr, "kernel_launch: unexpected shapes (n_in %d, in0 %d, out %d, ws %zu need %zu); nothing launched\n", n_in, n_in > 0 ? in_sizes[0] : -1, out_size, ws_size, (size_t)WS_END); grid = -1; return; }
        int dev = 0, cus = 0, per_cu = 0;
        if (hipGetDevice(&dev) != hipSuccess || hipDeviceGetAttribute(&cus, hipDeviceAttributeMultiprocessorCount, dev) != hipSuccess) { grid = -1; return; }
        if (hipFuncSetAttribute((const void*)mega_fwd, hipFuncAttributeMaxDynamicSharedMemorySize, LDS_BYTES) != hipSuccess) { fprintf(stderr, "kernel_launch: hipFuncSetAttribute failed\n"); grid = -1; return; }
        if (hipOccupancyMaxActiveBlocksPerMultiprocessor(&per_cu, (const void*)mega_fwd, 512, LDS_BYTES) != hipSuccess || per_cu < 1) { fprintf(stderr, "kernel_launch: occupancy query reports %d\n", per_cu); }
        (void)hipGetLastError();
        grid = cus;
        if (grid != 256) fprintf(stderr, "kernel_launch: %d CUs (row phases assume 256)\n", grid);
    }
    if (grid < 0) return;
    if (hipMemsetAsync((char*)d_ws + WS_CTL, 0, CTL_ZERO_BYTES, stream) != hipSuccess) return;
    Args a{};
    for (int i = 0; i < 29; ++i) a.in[i] = (const float*)d_in[i];
    a.out = (float*)d_out; a.ws = (unsigned char*)d_ws;
#if MK_ONE_LAUNCH
    a.ph_lo = 0; a.ph_hi = N_PHASES;
    hipLaunchKernelGGL(mega_fwd, dim3(grid), dim3(512), LDS_BYTES, stream, a);
#else
    for (int p = 0; p < N_PHASES; ++p) { a.ph_lo = p; a.ph_hi = p + 1; hipLaunchKernelGGL(mega_fwd, dim3(grid), dim3(512), LDS_BYTES, stream, a); }
#endif
}
```

```cpp
#include <hip/hip_runtime.h>
#include <hip/hip_bf16.h>
#include <cstdio>
#include <cstdint>
#include <cmath>

#ifndef MK_ONE_LAUNCH
#define MK_ONE_LAUNCH 1
#endif
#ifndef PHM
#define PHM 0xFFFF
#endif
#define PHON(n) (((PHM) >> (n)) & 1)
#ifndef REPM
#define REPM 0
#endif
#define NREP(n) ((((REPM) >> (n)) & 1) ? 2 : 1)

#define LAS __attribute__((address_space(3)))
#define GAS __attribute__((address_space(1)))
typedef unsigned short bf16_t;
typedef short bf16x8 __attribute__((ext_vector_type(8)));
typedef float f32x4 __attribute__((ext_vector_type(4)));
typedef float f32x2 __attribute__((ext_vector_type(2)));
typedef unsigned u32x4 __attribute__((ext_vector_type(4)));
typedef unsigned u32x2 __attribute__((ext_vector_type(2)));
typedef GAS unsigned gu32;

constexpr int NB = 8, SEQ = 4096, NTOK = NB * SEQ, DM = 1024, DEPTH = 4, NH = 4, HD = 64, PIN = 3608, PP = 3584, PW = 3840, NE = 16, DE = 512;
constexpr int NCH = SEQ / 64;
constexpr float ALPHA = 1.6817928305074290f;
constexpr float LN_EPS = 1e-6f;
constexpr float ATT_C2 = 0.17677669529663687f * 1.4426950408889634f;
constexpr int NBUCKET = 24, LCAP = NTOK;
constexpr int PJ = 256, TSZ = NTOK * 256;
constexpr int C_MQ = 0, C_MK = TSZ, C_MV = 2 * TSZ, C_MO = 3 * TSZ, C_CB = 4 * TSZ, C_CC = 5 * TSZ, C_CH = 6 * TSZ, C_DQ = 7 * TSZ, C_DK = 8 * TSZ, C_DV = 9 * TSZ,
              C_GQ = 10 * TSZ, C_GK = 11 * TSZ, C_GV = 12 * TSZ, C_GR = 13 * TSZ;
constexpr int T_GA = 0, T_MI = 16, T_MF = 20;

constexpr size_t MiB = 1u << 20;
constexpr size_t WS_CTL = 0, CTL_ZERO_BYTES = 1 * MiB;
constexpr size_t WS_MOD = 1 * MiB;
constexpr size_t WS_ROPE = 2 * MiB;
constexpr size_t WS_WIN = 3 * MiB;
constexpr size_t WS_WOUT = 33 * MiB;
constexpr size_t WS_WGU = 41 * MiB;
constexpr size_t WS_WD = 73 * MiB;
constexpr size_t WS_LTOK = 89 * MiB;
constexpr size_t WS_LGATE = 92 * MiB;
constexpr size_t WS_SM = 98 * MiB;
constexpr size_t WS_PROJ = 100 * MiB;
constexpr size_t WS_XR = 340 * MiB;
constexpr size_t WS_U = 468 * MiB;
constexpr size_t WS_YCAT = 532 * MiB;
constexpr size_t WS_TAIL = 596 * MiB;
constexpr size_t WS_YSORT = WS_PROJ + 100 * MiB;
constexpr size_t WS_U8 = 600 * MiB;
constexpr size_t WS_WIN8 = 632 * MiB;
constexpr size_t WS_END = 648 * MiB;
constexpr size_t SM_N = 0, SM_BC = 512 * 1024, SM_DM = 520 * 1024, SM_MS = 528 * 1024, SM_GBE = 1 * MiB, SM_TS = 1536 * 1024;
constexpr int CW_TMO = 0, CW_CODE = 1, CW_ZPAGE = 256, CW_BAR = 4096, CW_CNT = 16384, CW_RT = 24576;
constexpr int RING_BYTES = 131072, LDSCTL_OFF = RING_BYTES, MISC_OFF = LDSCTL_OFF + 320, MOE_TB_OFF = LDSCTL_OFF + 1024, LDS_BYTES = 147456;

#define RLX_AGENT __ATOMIC_RELAXED, __HIP_MEMORY_SCOPE_AGENT
#define LDS_WAIT() asm volatile("s_waitcnt lgkmcnt(0)" ::: "memory")
#define VM_WAIT() asm volatile("s_waitcnt vmcnt(0)" ::: "memory")

__device__ __forceinline__ unsigned f2bf(float f) { unsigned u = __builtin_bit_cast(unsigned, f); return (u + 0x7fffu + ((u >> 16) & 1u)) >> 16; }
__device__ __forceinline__ unsigned pk2(float lo, float hi) { typedef __bf16 bf2 __attribute__((ext_vector_type(2))); f32x2 v = {lo, hi}; bf2 b = __builtin_convertvector(v, bf2); return __builtin_bit_cast(unsigned, b); }
__device__ __forceinline__ unsigned pk4_fp8(float a, float b, float c, float d) {
    a = __builtin_amdgcn_fmed3f(a, -448.f, 448.f); b = __builtin_amdgcn_fmed3f(b, -448.f, 448.f); c = __builtin_amdgcn_fmed3f(c, -448.f, 448.f); d = __builtin_amdgcn_fmed3f(d, -448.f, 448.f);
    int w = 0; w = __builtin_amdgcn_cvt_pk_fp8_f32(a, b, w, false); w = __builtin_amdgcn_cvt_pk_fp8_f32(c, d, w, true); return (unsigned)w; }
__device__ __forceinline__ void st8_wt(void* p, u32x2 v) { asm volatile("global_store_dwordx2 %0, %1, off sc1\n\ts_nop 0" :: "v"(p), "v"(v) : "memory"); }
constexpr float W8S = 64.f, H8S = 16.f, Y8S = 8.f;
__device__ __forceinline__ float bf2f(unsigned b) { return __builtin_bit_cast(float, b << 16); }
__device__ __forceinline__ float bflo(unsigned w) { return __builtin_bit_cast(float, w << 16); }
__device__ __forceinline__ float bfhi(unsigned w) { return __builtin_bit_cast(float, w & 0xffff0000u); }
__device__ __forceinline__ void st16_wt(void* p, u32x4 v) { asm volatile("global_store_dwordx4 %0, %1, off sc1\n\ts_nop 1" :: "v"(p), "v"(v) : "memory"); }
__device__ __forceinline__ float wave_sum(float v) {
#pragma unroll
    for (int o = 1; o < 64; o <<= 1) v += __shfl_xor(v, o);
    return v;
}
__device__ __forceinline__ float wave_max(float v) {
#pragma unroll
    for (int o = 1; o < 64; o <<= 1) v = fmaxf(v, __shfl_xor(v, o));
    return v;
}
__device__ __forceinline__ float fexp(float x) { return __builtin_amdgcn_exp2f(x * 1.4426950408889634f); }
__device__ __forceinline__ float flog(float x) { return __builtin_amdgcn_logf(x) * 0.6931471805599453f; }
__device__ __forceinline__ float logsig(float z) { return fminf(z, 0.f) - flog(1.f + fexp(-fabsf(z))); }
__device__ __forceinline__ float sigmoidf_(float z) { return 1.f / (1.f + fexp(-z)); }

__device__ __forceinline__ int lane_id_() { int l_; asm volatile("v_mbcnt_lo_u32_b32 %0, -1, 0\n\tv_mbcnt_hi_u32_b32 %0, -1, %0" : "=v"(l_)); return l_; }
__device__ __forceinline__ int mk_tid(int wave) { return (wave << 6) | lane_id_(); }
#define XB_TMO      128
#define XB_XCNT(j)  (256  + 64 * (j))
#define XB_XSUB(j)  (1280 + 64 * (j))
#define XB_XGEN(j)  (2304 + 64 * (j))
#define XB_TOP      3328
#define XB_TOPGEN   3392
#define XCD_BAR_WORDS 3456
#define XB_SPIN_CAP (1u << 18)
__device__ __forceinline__ unsigned xb_ld(unsigned* p)              { return __hip_atomic_load(p, __ATOMIC_RELAXED, __HIP_MEMORY_SCOPE_AGENT); }
__device__ __forceinline__ unsigned xb_add(unsigned* p, unsigned v) { return __hip_atomic_fetch_add(p, v, __ATOMIC_RELAXED, __HIP_MEMORY_SCOPE_AGENT); }
__device__ __forceinline__ unsigned xb_xcc_id() { return (unsigned)__builtin_amdgcn_s_getreg((3 << 11) | 20) & 0xFu; }
#define XB_SPIN(cond, bar) do { unsigned _sp = 0; while (cond) { __builtin_amdgcn_s_sleep(1); \
    if ((++_sp & 255u) == 0u) { if (xb_ld(&(bar)[XB_TMO])) break; if (_sp > XB_SPIN_CAP) { atomicAdd(&(bar)[XB_TMO], 1u); break; } } } } while (0)
struct XcdBarrier { unsigned* bar; unsigned x; volatile LAS unsigned* st; };
__device__ __forceinline__ XcdBarrier xcd_barrier_post(unsigned* bar, volatile LAS unsigned* st, bool t0) {
    XcdBarrier b; b.bar = bar; b.x = xb_xcc_id(); b.st = st;
    if (t0) (void)xb_add(&bar[XB_XCNT(b.x)], 1u);
    return b;
}
__device__ __forceinline__ void xcd_barrier_complete(unsigned* bar, unsigned x, unsigned& nloc, unsigned& nx) {
    const unsigned G = gridDim.x * gridDim.y * gridDim.z;
    unsigned sum, cnt, mine, sp = 0u;
    for (;;) {
        sum = 0u; cnt = 0u; mine = 0u;
#pragma unroll
        for (unsigned j = 0; j < 16; ++j) { const unsigned c = xb_ld(&bar[XB_XCNT(j)]); sum += c; cnt += (c > 0u) ? 1u : 0u; mine = (j == x) ? c : mine; }
        if (sum == G) break;
        __builtin_amdgcn_s_sleep(1);
        if ((++sp & 255u) == 0u) { if (xb_ld(&bar[XB_TMO])) break; if (sp > XB_SPIN_CAP) { atomicAdd(&bar[XB_TMO], 1u); break; } }
    }
    nloc = mine > 0u ? mine : 1u; nx = cnt > 0u ? cnt : 1u;
}
__device__ __forceinline__ void xcd_barrier(const XcdBarrier& b, bool t0) {
    asm volatile("s_waitcnt vmcnt(0)" ::: "memory");
    __syncthreads();
    if (t0) {
        unsigned* bar = b.bar;
        __builtin_amdgcn_s_waitcnt(0);
        unsigned nloc = b.st[0], nx = b.st[1];
        if (nloc == 0u) { xcd_barrier_complete(bar, b.x, nloc, nx); b.st[0] = nloc; b.st[1] = nx; }
        const unsigned old = xb_add(&bar[XB_XSUB(b.x)], 1u);
        const unsigned gen = old / nloc;
        if (old + 1u == (gen + 1u) * nloc) {
            __builtin_amdgcn_fence(__ATOMIC_RELEASE, "agent");
            asm volatile("s_waitcnt vmcnt(0)" ::: "memory");
            const unsigned og = xb_add(&bar[XB_TOP], 1u);
            const unsigned tg = og / nx;
            if (og + 1u == (tg + 1u) * nx) xb_add(&bar[XB_TOPGEN], 1u);
            else XB_SPIN(xb_ld(&bar[XB_TOPGEN]) == tg, bar);
            __builtin_amdgcn_fence(__ATOMIC_ACQUIRE, "agent");
            xb_add(&bar[XB_XGEN(b.x)], 1u);
            asm volatile("s_waitcnt vmcnt(0)" ::: "memory");
        } else {
            XB_SPIN(xb_ld(&bar[XB_XGEN(b.x)]) == gen, bar);
            __builtin_amdgcn_fence(__ATOMIC_ACQUIRE, "agent");
            asm volatile("s_waitcnt vmcnt(0)" ::: "memory");
        }
    }
    __syncthreads();
}

namespace gm {
constexpr int BM = 256, BK = 64, HALF = 128, HTB = HALF * BK * 2, NXCD = 8, WGM = 8;
typedef int v4i_t __attribute__((ext_vector_type(4))); typedef int v8i_t __attribute__((ext_vector_type(8)));
__host__ __device__ __forceinline__ int lds_byte(int r, int c) { const int st = (r >> 4) * 2 + (c >> 5), rr = r & 15, cc = c & 31, ob = rr * 64 + cc * 2; return st * 1024 + (ob ^ (((ob >> 9) & 1) << 5)); }
__host__ __device__ __forceinline__ void stage_rc(int b, int& R, int& C) { const int st = b / 1024, sb = b % 1024, swz = sb ^ (((sb >> 9) & 1) << 5); R = (st >> 1) * 16 + swz / 64; C = (st & 1) * 32 + (swz % 64) / 2; }
__host__ __device__ __forceinline__ int perm32(int rho) { const int n = rho >> 4, i = rho & 15; return 8 * (i >> 2) + 4 * n + (i & 3); }
struct Unit { int pm, pn, bk, tb; };
struct Src { const char* a; const char* b0; const char* b1; unsigned va[2][2]; };
struct StaticOrder {
    int nM, nN, nwg, G, c;
    __device__ void init(int M, int N, int G_, int c_) { nM = M / BM; nN = N / BM; nwg = nM * nN; G = G_; c = c_; }
    __device__ __forceinline__ bool next(int i, Unit& u) const {
        const long L = (long)i * G + c; if (L >= nwg) return false;
        int wgid = (int)L; { const int q = nwg / NXCD, r = nwg % NXCD, xcd = wgid % NXCD, off = wgid / NXCD; wgid = (xcd < r ? xcd * (q + 1) : r * (q + 1) + (xcd - r) * q) + off; }
        const int nig = WGM * nN, gid = wgid / nig, fm = gid * WGM, gsz = (nM - fm) < WGM ? (nM - fm) : WGM;
        u.pm = fm + ((wgid % nig) % gsz); u.pn = (wgid % nig) / gsz; u.bk = 0; u.tb = 0; return true;
    }
};

template <class Kind>
__device__ __forceinline__ void gemm_phase(LAS unsigned char* lds, const Kind& Kd, int wave) {
    int tid_ = mk_tid(wave); asm volatile("" : "+v"(tid_));
    const int tid = tid_, wid = __builtin_amdgcn_readfirstlane(tid >> 6), lane = tid & 63, wr = wid >> 2, wc = wid & 3, fr = lane & 15, fq = lane >> 4;
    int R[2], C[2]; unsigned voffB[2];
#pragma unroll
    for (int i = 0; i < 2; ++i) { stage_rc(tid * 16 + i * 8192, R[i], C[i]); const int Rb = Kind::PERM ? ((R[i] & ~31) + perm32(R[i] & 31)) : R[i]; voffB[i] = (unsigned)(Rb * Kind::LDBB + C[i] * 2); }
    const size_t hstepB = (size_t)HALF * Kind::LDBB;
    constexpr int NT = Kind::NTK;
    const unsigned ldsw = (unsigned)wid * 1024u;
    const int aoff = lds_byte(wr * 64 + fr, fq * 8), boff = lds_byte(wc * 32 + fr, fq * 8);
#define G_SA(b, h) (((b) * 2 + (h)) * HTB)
#define G_SB(b, h) ((4 + (b) * 2 + (h)) * HTB)
#define G_STAGE_A(bufoff, S, t, h) do { const char* _g = (S).a + (size_t)(t) * 128; _Pragma("unroll") for (int _i = 0; _i < 2; ++_i) \
        __builtin_amdgcn_global_load_lds((const unsigned*)(_g + (S).va[h][_i]), (LAS unsigned*)(lds + (bufoff) + ldsw + _i * 8192), 16, 0, 0); } while (0)
#define G_STAGE_B(bufoff, S, t, h) do { const char* _g = (((t) < NT / 2) ? (S).b0 + (size_t)(t) * 128 : (S).b1 + (size_t)((t) - NT / 2) * 128) + (h) * hstepB; _Pragma("unroll") for (int _i = 0; _i < 2; ++_i) \
        __builtin_amdgcn_global_load_lds((const unsigned*)(_g + voffB[_i]), (LAS unsigned*)(lds + (bufoff) + ldsw + _i * 8192), 16, 0, 0); } while (0)
#define G_LDA(dst, b, h) do { _Pragma("unroll") for (int m = 0; m < 4; ++m) _Pragma("unroll") for (int k = 0; k < 2; ++k) dst[m][k] = *(const LAS bf16x8*)(lds + G_SA(b, h) + aoff + m * 2048 + k * 1024); } while (0)
#define G_LDB(dst, b, h) do { _Pragma("unroll") for (int n = 0; n < 2; ++n) _Pragma("unroll") for (int k = 0; k < 2; ++k) dst[n][k] = *(const LAS bf16x8*)(lds + G_SB(b, h) + boff + n * 2048 + k * 1024); } while (0)
#define G_MMA(ai, bj, At, Bt) do { __builtin_amdgcn_s_setprio(1); _Pragma("unroll") for (int m = 0; m < 4; ++m) _Pragma("unroll") for (int n = 0; n < 2; ++n) _Pragma("unroll") for (int k = 0; k < 2; ++k) \
        acc[ai][bj][m][n] = __builtin_amdgcn_mfma_f32_16x16x32_bf16(Bt[n][k], At[m][k], acc[ai][bj][m][n], 0, 0, 0); __builtin_amdgcn_s_setprio(0); } while (0)
#define G_LDA8(dst, b, h) do { _Pragma("unroll") for (int m = 0; m < 4; ++m) { const v4i_t _lo = *(const LAS v4i_t*)(lds + G_SA(b, h) + aoff + m * 2048), _hi = *(const LAS v4i_t*)(lds + G_SA(b, h) + aoff + m * 2048 + 1024); \
        dst[m] = __builtin_shufflevector(_lo, _hi, 0, 1, 2, 3, 4, 5, 6, 7); } } while (0)
#define G_LDB8(dst, b, h) do { _Pragma("unroll") for (int n = 0; n < 2; ++n) { const v4i_t _lo = *(const LAS v4i_t*)(lds + G_SB(b, h) + boff + n * 2048), _hi = *(const LAS v4i_t*)(lds + G_SB(b, h) + boff + n * 2048 + 1024); \
        dst[n] = __builtin_shufflevector(_lo, _hi, 0, 1, 2, 3, 4, 5, 6, 7); } } while (0)
#define G_MMA8(ai, bj, A8_, B8_) do { __builtin_amdgcn_s_setprio(1); _Pragma("unroll") for (int m = 0; m < 4; ++m) _Pragma("unroll") for (int n = 0; n < 2; ++n) \
        asm volatile("v_mfma_scale_f32_16x16x128_f8f6f4 %0, %1, %2, %0, %3, %3 op_sel_hi:[0,0,0]" : "+v"(acc[ai][bj][m][n]) : "v"(B8_[n]), "v"(A8_[m]), "v"(sc1v)); __builtin_amdgcn_s_setprio(0); } while (0)
#define X_LDA(b, h) do { if constexpr (Kind::FP8) G_LDA8(A8, b, h); else G_LDA(At, b, h); } while (0)
#define X_LDB0(b, h) do { if constexpr (Kind::FP8) G_LDB8(B08, b, h); else G_LDB(B0, b, h); } while (0)
#define X_LDB1(b, h) do { if constexpr (Kind::FP8) G_LDB8(B18, b, h); else G_LDB(B1, b, h); } while (0)
#define X_MM0(ai, bj) do { if constexpr (Kind::FP8) G_MMA8(ai, bj, A8, B08); else G_MMA(ai, bj, At, B0); } while (0)
#define X_MM1(ai, bj) do { if constexpr (Kind::FP8) G_MMA8(ai, bj, A8, B18); else G_MMA(ai, bj, At, B1); } while (0)
#define G_WAIT_V(n) asm volatile("s_waitcnt vmcnt(" #n ")" ::: "memory")
#define G_WAIT_L(n) asm volatile("s_waitcnt lgkmcnt(" #n ")" ::: "memory")
#define G_BAR __builtin_amdgcn_s_barrier()
#define G_SCHED __builtin_amdgcn_sched_barrier(0)
    Unit cur, nxt; Src sc, sn; int ui = 0; int pend = -1;
    if (!Kd.next(0, cur)) return;
    Kd.src(cur, sc, R, C);
    Kd.a_ready(cur, wid);
    f32x4 acc[2][2][4][2];
#pragma unroll
    for (int a = 0; a < 2; ++a)
#pragma unroll
        for (int b = 0; b < 2; ++b)
#pragma unroll
            for (int m = 0; m < 4; ++m)
#pragma unroll
                for (int n = 0; n < 2; ++n) acc[a][b][m][n] = (f32x4){0.f, 0.f, 0.f, 0.f};
    bf16x8 At[4][2], B0[2][2], B1[2][2]; v8i_t A8[4], B08[2], B18[2]; int sc1v = 0x7f7f7f7f; asm volatile("" : "+v"(sc1v));
    G_STAGE_B(G_SB(0, 0), sc, 0, 0); G_STAGE_B(G_SB(0, 1), sc, 0, 1); G_STAGE_A(G_SA(0, 0), sc, 0, 0); G_STAGE_A(G_SA(0, 1), sc, 0, 1);
    if (wr == 1) G_BAR;
    G_WAIT_V(2); G_BAR;
    G_STAGE_B(G_SB(1, 0), sc, 1, 0); G_STAGE_A(G_SA(1, 0), sc, 1, 0); G_STAGE_B(G_SB(1, 1), sc, 1, 1);
    G_WAIT_V(6); G_BAR;
    for (;;) {
        const bool has_next = Kd.next(ui + 1, nxt);
        if (has_next) Kd.src(nxt, sn, R, C); else sn = sc;
#pragma unroll 1
        for (int t = 0; t < NT; t += 2) {
            const bool last = (t == NT - 2);
            if (last && has_next) Kd.a_ready(nxt, wid);
            Src s2; s2.a = last ? sn.a : sc.a; s2.b0 = last ? sn.b0 : sc.b0; s2.b1 = last ? sn.b1 : sc.b1;
            s2.va[0][0] = last ? sn.va[0][0] : sc.va[0][0]; s2.va[0][1] = last ? sn.va[0][1] : sc.va[0][1]; s2.va[1][0] = last ? sn.va[1][0] : sc.va[1][0]; s2.va[1][1] = last ? sn.va[1][1] : sc.va[1][1];
            const int t2 = last ? 0 : t + 2, t3 = t2 + 1;
            X_LDB0(0, 0); X_LDB1(0, 1); G_SCHED; X_LDA(0, 0); G_STAGE_A(G_SA(1, 1), sc, t + 1, 1);
            G_WAIT_V(8); G_WAIT_L(0); G_BAR; X_MM0(0, 0); X_MM1(0, 1); G_BAR; G_SCHED;
            X_LDA(0, 1); G_STAGE_B(G_SB(0, 0), s2, t2, 0); G_STAGE_B(G_SB(0, 1), s2, t2, 1); G_STAGE_A(G_SA(0, 0), s2, t2, 0);
            G_WAIT_V(8); G_WAIT_L(0); G_BAR; X_MM0(1, 0); X_MM1(1, 1); G_BAR; G_SCHED;
            X_LDB0(1, 0); X_LDB1(1, 1); G_SCHED; X_LDA(1, 0); G_STAGE_A(G_SA(0, 1), s2, t2, 1);
            G_WAIT_V(8); G_WAIT_L(0); G_BAR; X_MM0(0, 0); X_MM1(0, 1); G_BAR; G_SCHED;
            X_LDA(1, 1); G_STAGE_B(G_SB(1, 0), s2, t3, 0); G_STAGE_B(G_SB(1, 1), s2, t3, 1); G_STAGE_A(G_SA(1, 0), s2, t3, 0);
            G_WAIT_V(8); G_WAIT_L(0); G_BAR; X_MM0(1, 0); X_MM1(1, 1); G_BAR; G_SCHED;
        }
        if (wr == 0) G_BAR;
        if (Kind::PUBLISH) { if (pend >= 0) Kd.publish(pend); pend = cur.pm; }
        if (Kind::FP8) asm volatile("s_nop 15\n\ts_nop 15" ::: "memory");
        Kd.epi(acc, cur, wr, wc, fr, fq);
        if (!has_next) break;
#pragma unroll
        for (int a = 0; a < 2; ++a)
#pragma unroll
            for (int b = 0; b < 2; ++b)
#pragma unroll
                for (int m = 0; m < 4; ++m)
#pragma unroll
                    for (int n = 0; n < 2; ++n) acc[a][b][m][n] = (f32x4){0.f, 0.f, 0.f, 0.f};
        cur = nxt; sc = sn; ++ui;
        if (wr == 1) G_BAR;
    }
    G_WAIT_V(0);
    if (Kind::PUBLISH) { if (pend >= 0) Kd.publish(pend); }
    G_BAR;
#undef G_SA
#undef G_SB
#undef G_STAGE_A
#undef G_STAGE_B
#undef G_LDA
#undef G_LDB
#undef G_MMA
#undef G_MMA8
#undef G_LDA8
#undef G_LDB8
#undef X_LDA
#undef X_LDB0
#undef X_LDB1
#undef X_MM0
#undef X_MM1
#undef G_WAIT_V
#undef G_WAIT_L
#undef G_BAR
#undef G_SCHED
}

__device__ __forceinline__ void src_direct(Src& s, const void* A, int row0, const int (&R)[2], const int (&C)[2], int pitchb = 2048) {
    s.a = (const char*)A + (size_t)row0 * pitchb;
#pragma unroll
    for (int h = 0; h < 2; ++h)
#pragma unroll
        for (int i = 0; i < 2; ++i) s.va[h][i] = (unsigned)((h * HALF + R[i]) * pitchb + C[i] * 2);
}

template <bool F8> struct K1 {
    static constexpr bool PERM = true, PUBLISH = false, FP8 = F8; static constexpr int LDBB = F8 ? 1024 : 2048, NTK = F8 ? 8 : 16;
    __device__ __forceinline__ void publish(int) const {}
    __device__ __forceinline__ void a_ready(const Unit&, int) const {}
    __device__ __forceinline__ void done(const Unit&) const {}
    StaticOrder S; const void* A; const void* Bt; bf16_t* O; const float* rope;
    __device__ __forceinline__ bool next(int i, Unit& u) const { return S.next(i, u); }
    __device__ __forceinline__ void src(const Unit& u, Src& s, const int (&R)[2], const int (&C)[2]) const {
        src_direct(s, A, u.pm * BM, R, C, F8 ? 1024 : 2048); s.b0 = (const char*)Bt + (size_t)u.pn * BM * (F8 ? 1024 : 2048); s.b1 = s.b0 + (F8 ? 512 : 1024);
    }
    __device__ __forceinline__ void epi(const f32x4 (&acc)[2][2][4][2], const Unit& u, int wr, int wc, int fr, int fq) const {
        const int row0 = u.pm * BM + wr * 64 + fr, col0 = u.pn * TSZ + wc * 32 + 8 * fq;
        if (u.pn == 7 || u.pn == 8) {
#pragma unroll
            for (int ai = 0; ai < 2; ++ai)
#pragma unroll
                for (int m = 0; m < 4; ++m) {
                    const int row = row0 + ai * HALF + m * 16;
                    const f32x4 cs = *(const f32x4*)(rope + (size_t)row * 8), sn = *(const f32x4*)(rope + (size_t)row * 8 + 4);
                    bf16_t* rowp = O + (size_t)row * PJ + col0;
#pragma unroll
                    for (int bj = 0; bj < 2; ++bj) {
                        f32x4 v0 = acc[ai][bj][m][0], v1 = acc[ai][bj][m][1]; if (F8) { v0 = v0 * (1.f / W8S); v1 = v1 * (1.f / W8S); }
                        if (fq == 0) { const f32x4 x1 = v0, x2 = v1; v0 = x1 * cs - x2 * sn; v1 = x2 * cs + x1 * sn; }
                        u32x4 w; w.x = pk2(v0[0], v0[1]); w.y = pk2(v0[2], v0[3]); w.z = pk2(v1[0], v1[1]); w.w = pk2(v1[2], v1[3]);
                        *(u32x4*)(rowp + bj * HALF) = w;
                    }
                }
        } else {
#pragma unroll
            for (int ai = 0; ai < 2; ++ai)
#pragma unroll
                for (int m = 0; m < 4; ++m) { bf16_t* rowp = O + (size_t)(row0 + ai * HALF + m * 16) * PJ + col0;
#pragma unroll
                    for (int bj = 0; bj < 2; ++bj) { f32x4 v0 = acc[ai][bj][m][0], v1 = acc[ai][bj][m][1]; if (F8) { v0 = v0 * (1.f / W8S); v1 = v1 * (1.f / W8S); }
                        u32x4 w; w.x = pk2(v0[0], v0[1]); w.y = pk2(v0[2], v0[3]); w.z = pk2(v1[0], v1[1]); w.w = pk2(v1[2], v1[3]);
                        *(u32x4*)(rowp + bj * HALF) = w; } }
        }
    }
};
struct K2 {
    static constexpr bool PERM = true, PUBLISH = false, FP8 = true; static constexpr int LDBB = 1024, NTK = 8;
    __device__ __forceinline__ void publish(int) const {}
    __device__ __forceinline__ void a_ready(const Unit&, int) const {}
    __device__ __forceinline__ void done(const Unit&) const {}
    StaticOrder S; const unsigned char* A; const unsigned char* Bt; bf16_t* O;
    __device__ __forceinline__ bool next(int i, Unit& u) const { return S.next(i, u); }
    __device__ __forceinline__ void src(const Unit& u, Src& s, const int (&R)[2], const int (&C)[2]) const {
        src_direct(s, A, u.pm * BM, R, C, 1024); s.b0 = (const char*)(Bt + (size_t)u.pn * BM * 1024); s.b1 = s.b0 + 512;
    }
    __device__ __forceinline__ void epi(const f32x4 (&acc)[2][2][4][2], const Unit& u, int wr, int wc, int fr, int fq) const {
        const int row0 = u.pm * BM + wr * 64 + fr, col0 = u.pn * BM + wc * 32 + 8 * fq;
#pragma unroll
        for (int ai = 0; ai < 2; ++ai)
#pragma unroll
            for (int m = 0; m < 4; ++m) { bf16_t* rowp = O + (size_t)(row0 + ai * HALF + m * 16) * DM + col0;
#pragma unroll
                for (int bj = 0; bj < 2; ++bj) { const f32x4 v0 = acc[ai][bj][m][0] * (1.f / (W8S * Y8S)), v1 = acc[ai][bj][m][1] * (1.f / (W8S * Y8S));
                    u32x4 w; w.x = pk2(v0[0], v0[1]); w.y = pk2(v0[2], v0[3]); w.z = pk2(v1[0], v1[1]); w.w = pk2(v1[2], v1[3]);
                    *(u32x4*)(rowp + bj * HALF) = w; } }
    }
};
__device__ __forceinline__ int pair_i(int p) { return p < 3 ? 0 : (p < 5 ? 1 : 2); }
__device__ __forceinline__ int pair_j(int p) { return p < 3 ? p + 1 : (p < 5 ? p - 1 : 3); }
struct K4 {
    static constexpr bool PERM = true, PUBLISH = false, FP8 = true; static constexpr int LDBB = 1024, NTK = 8;
    const unsigned char* U; const unsigned char* Wgu; unsigned char* H; const int* ltok; const float* lgate; const LAS int* tb; int G, vcu; gu32* rtc;
    __device__ __forceinline__ void a_ready(const Unit&, int) const {}
    __device__ __forceinline__ void done(const Unit&) const {}
    __device__ __forceinline__ void publish(int pm) const { if (lane_id_() == 0) __hip_atomic_fetch_add(rtc + 64 * pm, 1u, RLX_AGENT); }
    __device__ __forceinline__ bool next(int i, Unit& u) const {
        const int L = i * G + vcu; const int nt = tb[32 + NBUCKET]; if (L >= nt * 8) return false;
        const int rt = L >> 3; int k = 0;
        for (int q = 1; q < NBUCKET; ++q) k = (tb[32 + q] <= rt) ? q : k;
        u.pm = rt; u.pn = L & 7; u.bk = k; u.tb = (rt - tb[32 + k]) | (i << 16); return true;
    }
    __device__ __forceinline__ void src(const Unit& u, Src& s, const int (&R)[2], const int (&C)[2]) const {
        const int cnt = tb[u.bk]; s.a = (const char*)U;
#pragma unroll
        for (int h = 0; h < 2; ++h)
#pragma unroll
            for (int i = 0; i < 2; ++i) { const int pos = (u.tb & 0xffff) * BM + h * HALF + R[i]; const int tok = ltok[(size_t)u.bk * LCAP + (pos < cnt ? pos : 0)]; s.va[h][i] = (unsigned)(tok * 1024 + C[i] * 2); }
        const int grp = u.bk / 6, p = u.bk % 6, sl = u.pn >> 2; const int e = grp * 4 + (sl ? pair_j(p) : pair_i(p));
        s.b0 = (const char*)(Wgu + ((size_t)e * 1024 + (size_t)(u.pn & 3) * BM) * 1024); s.b1 = s.b0 + 512;
    }
    __device__ __forceinline__ void epi(const f32x4 (&acc)[2][2][4][2], const Unit& u, int wr, int wc, int fr, int fq) const {
        const int cnt = tb[u.bk], sl = u.pn >> 2; int colo = sl * 512 + (u.pn & 3) * 128 + wc * 32 + 8 * fq; asm volatile("" : "+v"(colo));
        int gofs = 256 + (u.tb >> 16) * 256 + wr * 64 + fr; asm volatile("" : "+v"(gofs));
        const LAS float* gl = (const LAS float*)tb + gofs;
#pragma unroll
        for (int ai = 0; ai < 2; ++ai)
#pragma unroll
            for (int m = 0; m < 4; ++m) {
                const int r = ai * HALF + wr * 64 + m * 16 + fr, pos = (u.tb & 0xffff) * BM + r;
                const float gt = (pos < cnt) ? gl[ai * HALF + m * 16] : 0.f;
                float hv[8];
#pragma unroll
                for (int n = 0; n < 2; ++n)
#pragma unroll
                    for (int j = 0; j < 4; ++j) { const float g = acc[ai][0][m][n][j] * (1.f / W8S), up = acc[ai][1][m][n][j] * (1.f / W8S); hv[n * 4 + j] = g * __builtin_amdgcn_rcpf(1.f + fexp(-g)) * up * (gt * H8S); }
                u32x2 w; w.x = pk4_fp8(hv[0], hv[1], hv[2], hv[3]); w.y = pk4_fp8(hv[4], hv[5], hv[6], hv[7]);
                *(u32x2*)(H + (size_t)(u.pm * BM + r) * 1024 + colo) = w;
            }
    }
};
struct K5 {
    static constexpr bool PERM = true, PUBLISH = false, FP8 = true; static constexpr int LDBB = 512, NTK = 8;
    __device__ __forceinline__ void publish(int) const {}
    const unsigned char* H; const unsigned char* Wd; bf16_t* Y; const LAS int* tb; int G, vcu; gu32* rtc; gu32* tmo;
    __device__ __forceinline__ void done(const Unit&) const {}
    __device__ __forceinline__ void a_ready(const Unit& u, int wid) const { return;
        if (wid == 0) {
            const unsigned long long t0 = __builtin_amdgcn_s_memrealtime(); unsigned polls = 0;
            while ((unsigned)__builtin_amdgcn_readfirstlane(__hip_atomic_load(rtc + 64 * u.pm, RLX_AGENT)) < 64u) {
                if ((++polls & 255u) == 0u && __builtin_amdgcn_readfirstlane(__hip_atomic_load(tmo, RLX_AGENT)) != 0u) break;
                if (__builtin_amdgcn_s_memrealtime() - t0 > 2000000ull) { if (lane_id_() == 0) __hip_atomic_store(tmo, 1u, RLX_AGENT); break; }
                __builtin_amdgcn_s_sleep(2); }
            __builtin_amdgcn_fence(__ATOMIC_ACQUIRE, "agent");
            asm volatile("s_waitcnt vmcnt(0)" ::: "memory");
        }
        asm volatile("" ::: "memory"); __builtin_amdgcn_s_barrier(); asm volatile("" ::: "memory");
    }
    __device__ __forceinline__ bool next(int i, Unit& u) const {
        const int nt = tb[32 + NBUCKET]; const int n4 = nt * 8; const int i0 = 0; (void)n4;
        const int L = (i + i0) * G + vcu; if (L >= nt * 4) return false;
        const int rt = L >> 2; int k = 0;
        for (int q = 1; q < NBUCKET; ++q) k = (tb[32 + q] <= rt) ? q : k;
        u.pm = rt; u.pn = L & 3; u.bk = k; u.tb = rt - tb[32 + k]; return true;
    }
    __device__ __forceinline__ void src(const Unit& u, Src& s, const int (&R)[2], const int (&C)[2]) const {
        src_direct(s, H, u.pm * BM, R, C, 1024);
        const int grp = u.bk / 6, p = u.bk % 6;
        s.b0 = (const char*)(Wd + ((size_t)(grp * 4 + pair_i(p)) * 1024 + (size_t)u.pn * BM) * 512);
        s.b1 = (const char*)(Wd + ((size_t)(grp * 4 + pair_j(p)) * 1024 + (size_t)u.pn * BM) * 512);
    }
    __device__ __forceinline__ void epi(const f32x4 (&acc)[2][2][4][2], const Unit& u, int wr, int wc, int fr, int fq) const {
        const int row0 = u.pm * BM + wr * 64 + fr, col0 = u.pn * BM + wc * 32 + 8 * fq;
#pragma unroll
        for (int ai = 0; ai < 2; ++ai)
#pragma unroll
            for (int m = 0; m < 4; ++m) { bf16_t* rowp = Y + (size_t)(row0 + ai * HALF + m * 16) * DM + col0;
#pragma unroll
                for (int bj = 0; bj < 2; ++bj) { const f32x4 v0 = acc[ai][bj][m][0] * (1.f / (W8S * H8S)), v1 = acc[ai][bj][m][1] * (1.f / (W8S * H8S));
                    u32x4 w; w.x = pk2(v0[0], v0[1]); w.y = pk2(v0[2], v0[3]); w.z = pk2(v1[0], v1[1]); w.w = pk2(v1[2], v1[3]);
                    *(u32x4*)(rowp + bj * HALF) = w; } }
    }
};
}

namespace attn_body {
using bf16 = __hip_bfloat16;
using s16x4 = __attribute__((ext_vector_type(4))) short;
using f32x16 = __attribute__((ext_vector_type(16))) float;
constexpr int D = 64, PITCH = PJ;
constexpr int NW = 8, QBLK = 32, QB = QBLK * NW, KVBLK = 64;
__device__ __forceinline__ int crow(int r, int hi) { return (r & 3) + 8 * (r >> 2) + 4 * hi; }
#define SBAR() __builtin_amdgcn_sched_barrier(0)
__device__ __forceinline__ void cmask(f32x16& p0, f32x16& p1, int jb, int qrel, int hi) {
    const float NEG = -INFINITY; int kb = 64 * jb + 4 * hi;
#pragma unroll
    for (int r = 0; r < 16; ++r) { int kv = kb + (r & 3) + 8 * (r >> 2); if (kv > qrel) p0[r] = NEG; if (kv + 32 > qrel) p1[r] = NEG; }
}
constexpr int NSLOT = 3, SLOTB = 8192;
constexpr int LDS_K = 0, LDS_V = NSLOT * SLOTB, LDS_WS = 2 * NSLOT * SLOTB, LDS_OST = LDS_WS + NW * 64 * 4, ATT_LDS_BYTES = LDS_OST + NW * 8192;
__device__ __forceinline__ void glds16(const void* gsrc, unsigned lds_dst) { unsigned keep;
    asm volatile("s_mov_b32 %0, m0\n\ts_mov_b32 m0, %2\n\ts_nop 0\n\tglobal_load_lds_dwordx4 %1, off\n\ts_mov_b32 m0, %0" : "=&s"(keep) : "v"(gsrc), "s"(lds_dst) : "memory"); }
__device__ __forceinline__ float max3f(float a, float b, float c) { float r; asm("v_max3_f32 %0, %1, %2, %3" : "=v"(r) : "v"(a), "v"(b), "v"(c)); return r; }
__device__ __forceinline__ float max2f(float a, float b) { float r; asm("v_max_f32_e32 %0, %1, %2" : "=v"(r) : "v"(a), "v"(b)); return r; }
__device__ __forceinline__ float fadd_s(float a, float b) { float r; asm("v_add_f32_e32 %0, %1, %2" : "=v"(r) : "v"(a), "v"(b)); return r; }
__device__ __forceinline__ float fsub_s(float a, float b) { float r; asm("v_sub_f32_e32 %0, %1, %2" : "=v"(r) : "v"(a), "v"(b)); return r; }
typedef float f32x2_t __attribute__((ext_vector_type(2))); typedef __bf16 bf16x2_t __attribute__((ext_vector_type(2)));
__device__ __forceinline__ unsigned cvtpk_s(float lo, float hi) { f32x2_t v = {lo, hi}; bf16x2_t b = __builtin_convertvector(v, bf16x2_t); return __builtin_bit_cast(unsigned, b); }
#define WAIT_BAR(N) asm volatile("s_waitcnt vmcnt(" #N ") lgkmcnt(0)\n\ts_barrier" ::: "memory")
__device__ __forceinline__ void qkt(f32x16& p0, f32x16& p1, const char* Kslot, const bf16x8* qr, const f32x16& negm, int r32, int hi) {
    const char* kb = Kslot + hi * 1024 + r32 * 16;
#pragma unroll
    for (int d0 = 0; d0 < 2; ++d0) {
        const bf16x8 b0 = *reinterpret_cast<const bf16x8*>(kb + d0 * 2048);
        const bf16x8 b1 = *reinterpret_cast<const bf16x8*>(kb + d0 * 2048 + 512);
        if (d0 == 0) { p0 = __builtin_amdgcn_mfma_f32_32x32x16_bf16(b0, qr[0], negm, 0, 0, 0); p1 = __builtin_amdgcn_mfma_f32_32x32x16_bf16(b1, qr[0], negm, 0, 0, 0); }
        else { p0 = __builtin_amdgcn_mfma_f32_32x32x16_bf16(b0, qr[d0], p0, 0, 0, 0); p1 = __builtin_amdgcn_mfma_f32_32x32x16_bf16(b1, qr[d0], p1, 0, 0, 0); } }
}
typedef __attribute__((address_space(3))) const char* lds_cptr;
typedef short v4i16_t __attribute__((ext_vector_type(4)));
__device__ __forceinline__ void kload8(bf16x8* kf, lds_cptr kp) {
    kf[0] = *(const __attribute__((address_space(3))) bf16x8*)(kp);        kf[1] = *(const __attribute__((address_space(3))) bf16x8*)(kp + 512);
    kf[2] = *(const __attribute__((address_space(3))) bf16x8*)(kp + 2048); kf[3] = *(const __attribute__((address_space(3))) bf16x8*)(kp + 2560);
}
__device__ __forceinline__ void kload2(bf16x8* kf, lds_cptr kp, int j) { kf[2 * j] = *(const __attribute__((address_space(3))) bf16x8*)(kp + j * 2048); kf[2 * j + 1] = *(const __attribute__((address_space(3))) bf16x8*)(kp + j * 2048 + 512); }
__device__ __forceinline__ s16x4 vtr(lds_cptr p) { return __builtin_bit_cast(s16x4, __builtin_amdgcn_ds_read_tr16_b64_v4i16((__attribute__((address_space(3))) v4i16_t*)p)); }
__device__ __forceinline__ float rowmax(const f32x16& p0, const f32x16& p1) {
    float a = max3f(p0[0], p0[1], p1[0]), b = max3f(p0[2], p0[3], p1[1]); a = max3f(a, p1[2], p1[3]);
#pragma unroll
    for (int r = 4; r < 16; r += 4) { a = max3f(a, p0[r], p0[r + 1]); b = max3f(b, p0[r + 2], p0[r + 3]); a = max3f(a, p1[r], p1[r + 1]); b = max3f(b, p1[r + 2], p1[r + 3]); }
    const float m = max2f(a, b);
    auto rr = __builtin_amdgcn_permlane32_swap(__float_as_uint(m), __float_as_uint(m), false, false);
    return max2f(__uint_as_float(rr[0]), __uint_as_float(rr[1]));
}
__device__ __forceinline__ void pv(f32x16* o, int vb, bf16x8 pa0, bf16x8 pa1, bf16x8 pa2, bf16x8 pa3) {
#pragma unroll
    for (int d0 = 0; d0 < 2; ++d0) { s16x4 lo[4], hi[4];
#pragma unroll
        for (int ks = 0; ks < 4; ++ks) {
            asm volatile("ds_read_b64_tr_b16 %0,%1 offset:%c2" : "=&v"(lo[ks]) : "v"(vb), "i"(d0 * 4096 + ks * 1024) : "memory");
            asm volatile("ds_read_b64_tr_b16 %0,%1 offset:%c2" : "=&v"(hi[ks]) : "v"(vb), "i"(d0 * 4096 + ks * 1024 + 512) : "memory"); }
        asm volatile("s_waitcnt lgkmcnt(0)" ::: "memory"); SBAR();
#define PK(k) (bf16x8){lo[k][0], lo[k][1], lo[k][2], lo[k][3], hi[k][0], hi[k][1], hi[k][2], hi[k][3]}
        o[d0] = __builtin_amdgcn_mfma_f32_32x32x16_bf16(pa0, PK(0), o[d0], 0, 0, 0);
        o[d0] = __builtin_amdgcn_mfma_f32_32x32x16_bf16(pa1, PK(1), o[d0], 0, 0, 0);
        o[d0] = __builtin_amdgcn_mfma_f32_32x32x16_bf16(pa2, PK(2), o[d0], 0, 0, 0);
        o[d0] = __builtin_amdgcn_mfma_f32_32x32x16_bf16(pa3, PK(3), o[d0], 0, 0, 0);
#undef PK
    }
}
struct AttnParams { const bf16* Q; const bf16* K; const bf16* V; const bf16* zpage; bf16_t* Y; const float* gnorm; float lam, osc; };
template <int THRL, int comp> __device__ __forceinline__ void attn_unit(int b, int h, int qb, const AttnParams& P, char* shm, int wave) {
    const bf16* Q = P.Q; const bf16* __restrict__ K = P.K; const bf16* __restrict__ V = P.V;
    int tid_ = mk_tid(wave); asm volatile("" : "+v"(tid_));
    const int tid = tid_, lane = tid & 63, r32 = lane & 31, hi = lane >> 5; const int wid = __builtin_amdgcn_readfirstlane(tid >> 6);
    const long rowbase = (long)b * SEQ; const int q0 = qb * QB;
    const bf16* Qw = Q + (rowbase + q0 + wid * QBLK) * PITCH + h * D;
    const bf16* Kh = K + rowbase * PITCH + h * D, *Vh = V + rowbase * PITCH + h * D;
    const unsigned lds0 = (unsigned)(uintptr_t)shm;
    float* wsf = (float*)(shm + LDS_WS) + wid * 64;
    const bf16* ksrc = Kh + (long)(32 * (wid & 1) + (lane & 31)) * PITCH + comp * 32 + (wid >> 1) * 8;
    const bf16* vsrc = Vh + (long)(16 * (wid & 3) + (lane >> 2)) * PITCH + (wid >> 2) * 32 + (lane & 3) * 8;
    const unsigned kdst = lds0 + LDS_K + (wid >> 1) * 1024 + (wid & 1) * 512, vdst = lds0 + LDS_V + wid * 1024;
#define DMA_K(t, slot) do { if (lane < 32) glds16(ksrc + (long)(t) * KVBLK * PITCH, (unsigned)__builtin_amdgcn_readfirstlane(kdst + (slot))); } while (0)
#define DMA_V(t, slot) glds16(vsrc + (long)(t) * KVBLK * PITCH, (unsigned)__builtin_amdgcn_readfirstlane(vdst + (slot)))
    const int vb0 = (int)(lds0 + LDS_V) + ((lane >> 4) & 1) * 32 + (lane & 3) * 8 + (4 * hi + ((lane & 15) >> 2)) * 64;
    const char* Kbase = shm + LDS_K; bf16x8 kf[4];
    const lds_cptr shm3 = (lds_cptr)shm; const lds_cptr kp0 = shm3 + LDS_K + hi * 1024 + r32 * 16; const lds_cptr vp0 = shm3 + LDS_V + ((lane >> 4) & 1) * 32 + (lane & 3) * 8 + (4 * hi + ((lane & 15) >> 2)) * 64;
    const int NT = (q0 + QB) / KVBLK;
    if (wid >= 4) __builtin_amdgcn_s_setprio(1);
    DMA_K(0, 0); DMA_V(0, 0); DMA_K(1, SLOTB);
    bf16x8 qr[2];
#pragma unroll
    for (int d0 = 0; d0 < 2; ++d0) qr[d0] = *reinterpret_cast<const bf16x8*>(&Qw[(long)r32 * PITCH + comp * 32 + d0 * 16 + hi * 8]);
    float mhat = 0.f, l_reg = 0.f; f32x16 o[2]; o[0] = f32x16{}; o[1] = f32x16{}; f32x16 negm = f32x16{}; asm volatile("" : "+v"(negm));
    const int qrel = wid * QBLK + r32;
#define CMASK(P0, P1, t) do { int jb_ = (t) - (NT - 4); if (jb_ >= 0) cmask(P0, P1, jb_, qrel, hi); } while (0)
    bool resc = false;
#define START(P0, P1) do { const float rm = rowmax(P0, P1); resc = false; \
    { const float dl = rm; mhat = fadd_s(mhat, dl); \
      _Pragma("unroll") for (int r = 0; r < 16; ++r) { P0[r] = fsub_s(P0[r], dl); P1[r] = fsub_s(P1[r], dl); } \
      _Pragma("unroll") for (int r = 0; r < 16; ++r) negm[r] = -mhat; asm volatile("" : "+v"(negm)); } \
    _Pragma("unroll") for (int r = 0; r < 16; ++r) P0[r] = __builtin_amdgcn_exp2f(P0[r]); } while (0)
#define RESC() do { if (resc) { asm volatile("s_waitcnt lgkmcnt(0)" ::: "memory"); \
      _Pragma("unroll") for (int d_ = 0; d_ < 2; ++d_) _Pragma("unroll") for (int r = 0; r < 16; ++r) o[d_][r] *= wsf[crow(r, hi)]; } } while (0)
    f32x16 pA0, pA1, pB0, pB1;
    int sl_prev = 0, sl_cur = 0, sl_next = SLOTB;
#define ROT() do { sl_prev = sl_cur; sl_cur = sl_next; sl_next = (sl_next == (NSLOT - 1) * SLOTB) ? 0 : sl_next + SLOTB; } while (0)
    DMA_K(2, 2 * SLOTB);
    WAIT_BAR(3);
    qkt(pA0, pA1, Kbase, qr, negm, r32, hi); asm volatile("s_nop 15\n\ts_nop 7" : "+v"(pA0), "+v"(pA1)); CMASK(pA0, pA1, 0);
    START(pA0, pA1);
    _Pragma("unroll") for (int r = 0; r < 16; ++r) pA1[r] = __builtin_amdgcn_exp2f(pA1[r]);
    WAIT_BAR(0);
    DMA_K(3, 0); DMA_V(1, SLOTB);
    ROT();
    kload8(kf, kp0 + sl_cur);
    WAIT_BAR(2);
    s16x4 vlo[8], vhi[8]; u32x4 pw0, pw1, pw2, pw3;
#define PKW(P, B) cvtpk_s(P[B], P[B + 1])
#define PAF(k) __builtin_bit_cast(bf16x8, pw##k)
#define VFR(i) (bf16x8){vlo[i][0], vlo[i][1], vlo[i][2], vlo[i][3], vhi[i][0], vhi[i][1], vhi[i][2], vhi[i][3]}
#define PIN(x) asm volatile("" : "+v"(x))
#define MX3(a, b, c) __builtin_fmaxf(__builtin_fmaxf((a), (b)), (c))
#define GAPA(MF, A0, A1, A2, A3, W0, W1, PW) do { MF; sacc += A0; sacc += A1; sacc += A2; sacc += A3; PIN(sacc); W0; W1; PIN(PW); SBAR(); } while (0)
#define EX(v) __builtin_amdgcn_exp2f(v)
#define GAPB(MF, X, B) do { MF; X[B] = EX(X[B]); X[B + 1] = EX(X[B + 1]); X[B + 2] = EX(X[B + 2]); X[B + 3] = EX(X[B + 3]); PIN(X); SBAR(); } while (0)
#define VRD(i) do { vlo[i] = vtr(vp_ + (((i) >> 2) * 4096 + ((i) & 3) * 1024)); vhi[i] = vtr(vp_ + (((i) >> 2) * 4096 + ((i) & 3) * 1024 + 512)); } while (0)
#define KRD(G, j) do { if (G) { kload2(kf, kp0 + sl_next, j); SBAR(); } } while (0)
#define STEP(C0, C1, P0, P1, t, GK, GV, GL) do { SBAR(); \
    const lds_cptr vp_ = vp0 + sl_prev; \
    VRD(0); SBAR(); float sacc = (P0[0] + P0[1]); \
    GAPA(C0 = __builtin_amdgcn_mfma_f32_32x32x16_bf16(kf[0], qr[0], negm, 0, 0, 0), P0[2], P0[3], P0[4], P0[5],     pw0[0] = PKW(P0, 0), pw0[1] = PKW(P0, 2), pw0); \
    VRD(4); SBAR(); GAPA(C1 = __builtin_amdgcn_mfma_f32_32x32x16_bf16(kf[1], qr[0], negm, 0, 0, 0), P0[6], P0[7], P0[8], P0[9],     pw0[2] = PKW(P0, 4), pw0[3] = PKW(P0, 6), pw0); \
    VRD(1); SBAR(); GAPA(C0 = __builtin_amdgcn_mfma_f32_32x32x16_bf16(kf[2], qr[1], C0, 0, 0, 0),   P0[10], P0[11], P0[12], P0[13], pw1[0] = PKW(P0, 8), pw1[1] = PKW(P0, 10), pw1); \
    VRD(5); SBAR(); GAPA(C1 = __builtin_amdgcn_mfma_f32_32x32x16_bf16(kf[3], qr[1], C1, 0, 0, 0),   P0[14], P0[15], P1[0], P1[1],   pw1[2] = PKW(P0, 12), pw1[3] = PKW(P0, 14), pw1); \
    VRD(2); SBAR(); GAPA(,   P1[2], P1[3], P1[4], P1[5],     pw2[0] = PKW(P1, 0), pw2[1] = PKW(P1, 2), pw2); \
    VRD(6); SBAR(); GAPA(,   P1[6], P1[7], P1[8], P1[9],     pw2[2] = PKW(P1, 4), pw2[3] = PKW(P1, 6), pw2); \
    VRD(3); SBAR(); GAPA(,   P1[10], P1[11], P1[12], P1[13], pw3[0] = PKW(P1, 8), pw3[1] = PKW(P1, 10), pw3); \
    VRD(7); SBAR(); GAPA(,   P1[14], P1[15], 0.f, 0.f,       pw3[2] = PKW(P1, 12), pw3[3] = PKW(P1, 14), pw3); \
    l_reg += sacc; \
    if (GK) { DMA_K((t) + 3, sl_cur); } if (GV) { DMA_V((t) + 1, sl_next); } \
    CMASK(C0, C1, t); \
    { float a = MX3(C0[0], C0[1], C1[0]), b = MX3(C0[2], C0[3], C1[1]); a = MX3(a, C1[2], C1[3]); \
      _Pragma("unroll") for (int r = 4; r < 16; r += 4) { a = MX3(a, C0[r], C0[r + 1]); b = MX3(b, C0[r + 2], C0[r + 3]); a = MX3(a, C1[r], C1[r + 1]); b = MX3(b, C1[r + 2], C1[r + 3]); } \
      float rm = __builtin_fmaxf(a, b); { auto rr = __builtin_amdgcn_permlane32_swap(__float_as_uint(rm), __float_as_uint(rm), false, false); rm = __builtin_fmaxf(__uint_as_float(rr[0]), __uint_as_float(rr[1])); } \
      resc = false; \
      if (__builtin_expect(__any(rm > (float)THRL), 0)) { const float dl = __builtin_fmaxf(rm, 0.f); mhat += dl; \
        _Pragma("unroll") for (int r = 0; r < 16; ++r) { C0[r] -= dl; C1[r] -= dl; } \
        _Pragma("unroll") for (int r = 0; r < 16; ++r) negm[r] = -mhat; asm volatile("" : "+v"(negm)); \
        const float f = __builtin_amdgcn_exp2f(-dl); l_reg *= f; if (hi == 0) wsf[r32] = f; resc = true; } } \
    SBAR(); \
    GAPB(o[0] = __builtin_amdgcn_mfma_f32_32x32x16_bf16(PAF(0), VFR(0), o[0], 0, 0, 0), C0, 0); \
    GAPB(o[1] = __builtin_amdgcn_mfma_f32_32x32x16_bf16(PAF(0), VFR(4), o[1], 0, 0, 0), C0, 4); \
    KRD(GL, 0); GAPB(o[0] = __builtin_amdgcn_mfma_f32_32x32x16_bf16(PAF(1), VFR(1), o[0], 0, 0, 0), C0, 8); \
    KRD(GL, 1); GAPB(o[1] = __builtin_amdgcn_mfma_f32_32x32x16_bf16(PAF(1), VFR(5), o[1], 0, 0, 0), C0, 12); \
    GAPB(o[0] = __builtin_amdgcn_mfma_f32_32x32x16_bf16(PAF(2), VFR(2), o[0], 0, 0, 0), C1, 0); \
    GAPB(o[1] = __builtin_amdgcn_mfma_f32_32x32x16_bf16(PAF(2), VFR(6), o[1], 0, 0, 0), C1, 4); \
    GAPB(o[0] = __builtin_amdgcn_mfma_f32_32x32x16_bf16(PAF(3), VFR(3), o[0], 0, 0, 0), C1, 8); \
    GAPB(o[1] = __builtin_amdgcn_mfma_f32_32x32x16_bf16(PAF(3), VFR(7), o[1], 0, 0, 0), C1, 12); \
    } while (0)
    int t = 1;
#undef CMASK
#define CMASK(P0, P1, t) do {} while (0)
    for (; t + 5 < NT; t += 2) {
        STEP(pB0, pB1, pA0, pA1, t, true, true, true);     WAIT_BAR(2); RESC(); ROT();
        STEP(pA0, pA1, pB0, pB1, t + 1, true, true, true); WAIT_BAR(2); RESC(); ROT();
    }
#undef CMASK
#define CMASK(P0, P1, t) do { int jb_ = (t) - (NT - 4); if (jb_ >= 0) cmask(P0, P1, jb_, qrel, hi); } while (0)
#define ENDW(tt) do { if ((tt) + 3 < NT) { WAIT_BAR(2); } else if ((tt) + 2 < NT) { WAIT_BAR(1); } else { WAIT_BAR(0); } } while (0)
    for (; t + 1 < NT; t += 2) {
        STEP(pB0, pB1, pA0, pA1, t, (t + 3 < NT), (t + 1 < NT), (t + 1 < NT));         ENDW(t);     RESC(); ROT();
        STEP(pA0, pA1, pB0, pB1, t + 1, (t + 4 < NT), (t + 2 < NT), (t + 2 < NT));     ENDW(t + 1); RESC(); ROT();
    }
    STEP(pB0, pB1, pA0, pA1, NT - 1, false, false, false); RESC();
    { float sacc = pB0[0] + pB0[1]; _Pragma("unroll") for (int r = 2; r < 16; ++r) sacc += pB0[r]; _Pragma("unroll") for (int r = 0; r < 16; ++r) sacc += pB1[r]; l_reg += sacc;
      pw0 = (u32x4){PKW(pB0, 0), PKW(pB0, 2), PKW(pB0, 4), PKW(pB0, 6)}; pw1 = (u32x4){PKW(pB0, 8), PKW(pB0, 10), PKW(pB0, 12), PKW(pB0, 14)}; pw2 = (u32x4){PKW(pB1, 0), PKW(pB1, 2), PKW(pB1, 4), PKW(pB1, 6)}; pw3 = (u32x4){PKW(pB1, 8), PKW(pB1, 10), PKW(pB1, 12), PKW(pB1, 14)};
      SBAR(); pv(o, vb0 + sl_cur, PAF(0), PAF(1), PAF(2), PAF(3)); }
#undef PKW
#undef PAF
#undef VFR
#undef PIN
#undef MX3
#undef GAPA
#undef GAPB
#undef EX
#undef VRD
#undef KRD
#undef STEP
#undef ENDW
    { auto rr = __builtin_amdgcn_permlane32_swap(__float_as_uint(l_reg), __float_as_uint(l_reg), false, false); l_reg = __uint_as_float(rr[0]) + __uint_as_float(rr[1]); }
    if (hi == 0) wsf[32 + r32] = l_reg; asm volatile("s_waitcnt lgkmcnt(0)" ::: "memory");
    float rli[16];
#pragma unroll
    for (int r = 0; r < 16; ++r) rli[r] = __builtin_amdgcn_rcpf(wsf[32 + crow(r, hi)]);
    float* stg = (float*)(shm + LDS_OST) + wid * 2048;
    if (comp == 0) {
#pragma unroll
        for (int r = 0; r < 16; ++r) { const int orow = crow(r, hi);
#pragma unroll
            for (int d0 = 0; d0 < 2; ++d0) stg[orow * 64 + d0 * 32 + r32] = o[d0][r] * rli[r]; }
    } else {
        const float lam = P.lam;
#pragma unroll
        for (int r = 0; r < 16; ++r) { const int orow = crow(r, hi);
#pragma unroll
            for (int d0 = 0; d0 < 2; ++d0) { const int ix = orow * 64 + d0 * 32 + r32; stg[ix] = stg[ix] - lam * (o[d0][r] * rli[r]); } }
        asm volatile("s_waitcnt lgkmcnt(0)" ::: "memory");
        unsigned char* Yw = (unsigned char*)P.Y + (rowbase + q0 + wid * QBLK) * DM + h * D;
        const int ch = lane & 7;
        const f32x4 g0 = *(const f32x4*)(P.gnorm + ch * 8), g1 = *(const f32x4*)(P.gnorm + ch * 8 + 4);
#pragma unroll
        for (int i = 0; i < 4; ++i) { const int row = i * 8 + (lane >> 3);
            const f32x4 a = *(const f32x4*)(stg + row * 64 + ch * 8), c = *(const f32x4*)(stg + row * 64 + ch * 8 + 4);
            float ss = (a[0] * a[0] + a[1] * a[1]) + (a[2] * a[2] + a[3] * a[3]) + (c[0] * c[0] + c[1] * c[1]) + (c[2] * c[2] + c[3] * c[3]);
            ss += __shfl_xor(ss, 1); ss += __shfl_xor(ss, 2); ss += __shfl_xor(ss, 4);
            const float rs = __builtin_amdgcn_rsqf(ss * (1.f / 64.f) + LN_EPS) * P.osc;
            const float rq = rs * Y8S; u32x2 w; w.x = pk4_fp8(a[0] * rq * g0[0], a[1] * rq * g0[1], a[2] * rq * g0[2], a[3] * rq * g0[3]); w.y = pk4_fp8(c[0] * rq * g1[0], c[1] * rq * g1[1], c[2] * rq * g1[2], c[3] * rq * g1[3]);
            *(u32x2*)(Yw + (long)row * DM + ch * 8) = w; }
    }
    __builtin_amdgcn_s_setprio(0);
    asm volatile("s_waitcnt lgkmcnt(0)\n\ts_barrier" ::: "memory");
#undef DMA_K
#undef DMA_V
#undef CMASK
#undef START
#undef RESC
#undef ROT
}
#undef SBAR
#undef WAIT_BAR
}

struct Frame {
    LAS unsigned char* lds; volatile LAS unsigned* MISC; gu32* ctl;
    int tid, lane, wave, vcu, G;
};
struct Args {
    const float* in[29]; float* out; unsigned char* ws; int ph_lo, ph_hi;
};
enum { I_X = 0, I_C, I_POS, I_WADA, I_BADA, I_WIN, I_WOUT, I_MBI, I_MBF, I_MG, I_CONVW, I_CONVB, I_LQ1, I_LK1, I_LQ2, I_LK2, I_DG, I_WA2, I_BA, I_GG, I_LN1G, I_LN1B, I_LN2G, I_LN2B,
       I_RW, I_RB, I_EWG, I_EWU, I_EWD };

__device__ __forceinline__ void tr_item(const float* W, int ldw, int K, bf16_t* WT, int drow0, int scol, int k0, LAS float* scr, int lane) {
    const int sc_ = (scol >= 0) ? scol : 0; float v_[32];
#pragma unroll
    for (int i = 0; i < 32; ++i) v_[i] = W[(size_t)(k0 + 2 * i + (lane >> 5)) * ldw + sc_];
#pragma unroll
    for (int i = 0; i < 32; ++i) { const int kk = 2 * i + (lane >> 5); scr[kk * 33 + (lane & 31)] = (scol >= 0) ? v_[i] : 0.f; }
    LDS_WAIT(); asm volatile("" ::: "memory");
    const int c = lane & 7;
#pragma unroll
    for (int j = 0; j < 4; ++j) { const int n = (lane >> 3) + 8 * j; const LAS float* s = scr + (8 * c) * 33 + n;
        u32x4 o; o.x = pk2(s[0 * 33], s[1 * 33]); o.y = pk2(s[2 * 33], s[3 * 33]); o.z = pk2(s[4 * 33], s[5 * 33]); o.w = pk2(s[6 * 33], s[7 * 33]);
        *(GAS u32x4*)(WT + (size_t)(drow0 + n) * K + k0 + 8 * c) = o; }
    LDS_WAIT(); asm volatile("" ::: "memory");
}
__device__ __forceinline__ void tr_item4(const float* W, int ldw, int K, bf16_t* WT, int drow0, int scol0, int k0, LAS float* scr, int lane, float wsc = 1.f) {
    const int kq = lane >> 3, nq = (lane & 7) * 4;
    f32x4 v[8];
#pragma unroll
    for (int i = 0; i < 8; ++i) v[i] = *(const f32x4*)(W + (size_t)(k0 + i * 8 + kq) * ldw + scol0 + nq);
#pragma unroll
    for (int i = 0; i < 8; ++i) { LAS float* d = scr + (i * 8 + kq) * 33 + nq; d[0] = v[i][0] * wsc; d[1] = v[i][1] * wsc; d[2] = v[i][2] * wsc; d[3] = v[i][3] * wsc; }
    LDS_WAIT(); asm volatile("" ::: "memory");
    const int c = lane & 7;
#pragma unroll
    for (int j = 0; j < 4; ++j) { const int n = (lane >> 3) + 8 * j; const LAS float* s = scr + (8 * c) * 33 + n;
        u32x4 o; o.x = pk2(s[0 * 33], s[1 * 33]); o.y = pk2(s[2 * 33], s[3 * 33]); o.z = pk2(s[4 * 33], s[5 * 33]); o.w = pk2(s[6 * 33], s[7 * 33]);
        *(GAS u32x4*)(WT + (size_t)(drow0 + n) * K + k0 + 8 * c) = o; }
    LDS_WAIT(); asm volatile("" ::: "memory");
}
struct TrD { const float* src; bf16_t* dst; unsigned char* dst8; int ldw, K, drow0, k0; float wsc; };
__device__ __forceinline__ void tr_load4(const TrD& d, f32x4 (&v)[8], int lane) {
    const int kq = lane >> 3, nq = (lane & 7) * 4;
#pragma unroll
    for (int i = 0; i < 8; ++i) v[i] = *(const f32x4*)(d.src + (size_t)(i * 8 + kq) * d.ldw + nq);
}
__device__ __forceinline__ void tr_finish4(const TrD& d, const f32x4 (&v)[8], LAS float* scr, int lane) {
    const int kq = lane >> 3, nq = (lane & 7) * 4;
#pragma unroll
    for (int i = 0; i < 8; ++i) { LAS float* p = scr + (i * 8 + kq) * 33 + nq; p[0] = v[i][0] * d.wsc; p[1] = v[i][1] * d.wsc; p[2] = v[i][2] * d.wsc; p[3] = v[i][3] * d.wsc; }
    LDS_WAIT(); asm volatile("" ::: "memory");
    const int c = lane & 7;
#pragma unroll
    for (int j = 0; j < 4; ++j) { const int n = (lane >> 3) + 8 * j; const LAS float* s = scr + (8 * c) * 33 + n;
        u32x4 o; o.x = pk2(s[0 * 33], s[1 * 33]); o.y = pk2(s[2 * 33], s[3 * 33]); o.z = pk2(s[4 * 33], s[5 * 33]); o.w = pk2(s[6 * 33], s[7 * 33]);
        *(GAS u32x4*)(d.dst + (size_t)(d.drow0 + n) * d.K + d.k0 + 8 * c) = o; }
    LDS_WAIT(); asm volatile("" ::: "memory");
}
__device__ __forceinline__ void tr_finish8(const TrD& d, const f32x4 (&v)[8], LAS float* scr, int lane) {
    const int kq = lane >> 3, nq = (lane & 7) * 4;
#pragma unroll
    for (int i = 0; i < 8; ++i) { LAS float* p = scr + (i * 8 + kq) * 33 + nq; p[0] = v[i][0] * d.wsc; p[1] = v[i][1] * d.wsc; p[2] = v[i][2] * d.wsc; p[3] = v[i][3] * d.wsc; }
    LDS_WAIT(); asm volatile("" ::: "memory");
    const int c = lane & 7; unsigned char* dst8 = (unsigned char*)d.dst;
#pragma unroll
    for (int j = 0; j < 4; ++j) { const int n = (lane >> 3) + 8 * j; const LAS float* s = scr + (8 * c) * 33 + n;
        u32x2 o; o.x = pk4_fp8(s[0 * 33], s[1 * 33], s[2 * 33], s[3 * 33]); o.y = pk4_fp8(s[4 * 33], s[5 * 33], s[6 * 33], s[7 * 33]);
        *(GAS u32x2*)(dst8 + (size_t)(d.drow0 + n) * d.K + d.k0 + 8 * c) = o; }
    LDS_WAIT(); asm volatile("" ::: "memory");
}
template <int NTL>
__device__ __forceinline__ void rows16_mm(f32x4 (&acc)[NTL], const bf16_t* A, const LAS bf16_t* Bt, int pitch, int lane) {
    const int lr = lane & 15, lq = lane >> 4;
    const bf16_t* ap = A + (size_t)lr * 1024 + lq * 8;
#pragma unroll 8
    for (int ks = 0; ks < 32; ++ks) {
        const bf16x8 a = *(const bf16x8*)(ap + ks * 32);
#pragma unroll
        for (int t = 0; t < NTL; ++t) { const bf16x8 b = *(const LAS bf16x8*)(Bt + (t * 16 + lr) * pitch + ks * 32 + lq * 8); acc[t] = __builtin_amdgcn_mfma_f32_16x16x32_bf16(a, b, acc[t], 0, 0, 0); }
    }
}
constexpr int TBP = 1056;
__device__ __forceinline__ void tail16(const bf16_t* Urow0, const LAS bf16_t* Wt, float* tail_row0, int lane) {
    f32x4 acc[2] = {(f32x4){0.f, 0.f, 0.f, 0.f}, (f32x4){0.f, 0.f, 0.f, 0.f}};
    rows16_mm<2>(acc, Urow0, Wt, TBP, lane);
    const int lr = lane & 15, lq = lane >> 4;
#pragma unroll
    for (int t = 0; t < 2; ++t)
#pragma unroll
        for (int r = 0; r < 4; ++r) tail_row0[(size_t)(lq * 4 + r) * 32 + t * 16 + lr] = acc[t][r];
}
__device__ __forceinline__ void load_tail_w(LAS bf16_t* Wt, const bf16_t* Wtail  , int tid) {
    for (int p = tid; p < 32 * 128; p += 512) { const int n = p >> 7, c = p & 127; *(LAS u32x4*)(Wt + n * TBP + c * 8) = *(const u32x4*)(Wtail + (size_t)n * 1024 + c * 8); }
}
constexpr int NSP = 1032;
constexpr int NMM_P_OFF = 32 * NSP * 2, NMM_LG_OFF = NMM_P_OFF + 8 * 1024 * 4;
struct NarrowT { bf16x8 bw[4][2]; };
__device__ __forceinline__ void nmm_load_tail(NarrowT& T, const bf16_t* Wtail  , int wid, int lane) {
    const int lr = lane & 15, lq = lane >> 4;
#pragma unroll
    for (int ks = 0; ks < 4; ++ks)
#pragma unroll
        for (int t = 0; t < 2; ++t) T.bw[ks][t] = *(const bf16x8*)(Wtail + (size_t)(t * 16 + lr) * 1024 + wid * 128 + ks * 32 + lq * 8);
}
__device__ __forceinline__ void nmm_load_router(NarrowT& T, const float* rw  , int wid, int lane) {
    const int lr = lane & 15, lq = lane >> 4;
#pragma unroll
    for (int ks = 0; ks < 4; ++ks) { u32x4 hi, lo;
#pragma unroll
        for (int i = 0; i < 4; ++i) { const int k = wid * 128 + ks * 32 + lq * 8 + 2 * i; const float w0 = rw[(size_t)k * 16 + lr], w1 = rw[(size_t)(k + 1) * 16 + lr];
            const unsigned h0 = f2bf(w0), h1 = f2bf(w1); hi[i] = h0 | (h1 << 16); lo[i] = f2bf(w0 - bf2f(h0)) | (f2bf(w1 - bf2f(h1)) << 16); }
        T.bw[ks][0] = __builtin_bit_cast(bf16x8, hi); T.bw[ks][1] = __builtin_bit_cast(bf16x8, lo); }
}
__device__ __forceinline__ void nmm_partials(const NarrowT& T, const LAS bf16_t* S, LAS float* Pb, int wid, int lane) {
    asm volatile("s_waitcnt lgkmcnt(0)\n\ts_barrier" ::: "memory");
    const int lr = lane & 15, lq = lane >> 4;
    f32x4 acc[2][2];
#pragma unroll
    for (int m = 0; m < 2; ++m)
#pragma unroll
        for (int t = 0; t < 2; ++t) acc[m][t] = (f32x4){0.f, 0.f, 0.f, 0.f};
#pragma unroll
    for (int m = 0; m < 2; ++m)
#pragma unroll
        for (int ks = 0; ks < 4; ++ks) { const bf16x8 a = *(const LAS bf16x8*)(S + (16 * m + lr) * NSP + wid * 128 + ks * 32 + lq * 8);
#pragma unroll
            for (int t = 0; t < 2; ++t) acc[m][t] = __builtin_amdgcn_mfma_f32_16x16x32_bf16(a, T.bw[ks][t], acc[m][t], 0, 0, 0); }
#pragma unroll
    for (int m = 0; m < 2; ++m)
#pragma unroll
        for (int t = 0; t < 2; ++t)
#pragma unroll
            for (int r = 0; r < 4; ++r) Pb[wid * 1024 + (16 * m + 4 * lq + r) * 32 + t * 16 + lr] = acc[m][t][r];
    asm volatile("s_waitcnt lgkmcnt(0)\n\ts_barrier" ::: "memory");
}
__device__ __forceinline__ void nmm_step_tail(const NarrowT& T, const LAS bf16_t* S, LAS float* Pb, float* tail_wg  , int i0, int tid, int wid, int lane) {
    nmm_partials(T, S, Pb, wid, lane);
#pragma unroll
    for (int q = 0; q < 2; ++q) { const int o = tid + 512 * q, sr = o >> 5, col = o & 31; float s = 0.f;
#pragma unroll
        for (int w = 0; w < 8; ++w) s += Pb[w * 1024 + o];
        tail_wg[(size_t)((sr >> 2) * 16 + i0 + (sr & 3)) * 32 + col] = s; }
}
__device__ __forceinline__ void nmm_step_router(const NarrowT& T, const LAS bf16_t* S, LAS float* Pb, LAS float* lgs  , int i0, int tid, int wid, int lane) {
    nmm_partials(T, S, Pb, wid, lane);
    { const int sr = tid >> 4, e = tid & 15; float s = 0.f;
#pragma unroll
      for (int w = 0; w < 8; ++w) s += Pb[w * 1024 + sr * 32 + e] + Pb[w * 1024 + sr * 32 + 16 + e];
      lgs[(sr >> 2) * 256 + (i0 + (sr & 3)) * 16 + e] = s; }
}
__device__ __forceinline__ int win_src_col(int n) {
    if (n < 1024) return n;
    if (n < 3584) return n + 8;
    const int i = n - 3584;
    if (i < 16) return 3592 + i;
    if (i < 20) return 1024 + (i - 16);
    if (i < 24) return 1028 + (i - 20);
    return -1;
}

namespace rec {
constexpr int PT = 72;
constexpr int TB = 64 * PT * 2;
constexpr int OFF_T0 = 0, OFF_T1 = TB, OFF_T2 = 2 * TB, OFF_T3 = 3 * TB, OFF_T4 = 4 * TB, OFF_T5 = 5 * TB;
constexpr int OFF_BM = 6 * TB;
constexpr int OFF_HM = OFF_BM + 16384;
constexpr int OFF_VEC = OFF_HM + 64 * 68 * 4;
constexpr int V_G = 0, V_M = 64, V_WI = 128, V_EM = 192, V_DI = 256, V_N = 320, V_BE = 384, V_SEG = 448, V_GA = 960;
static_assert(OFF_VEC + (960 + 1024) * 4 <= RING_BYTES, "rec LDS");

__device__ __forceinline__ void mm64(f32x4 (&acc)[2], const LAS bf16_t* A, const LAS bf16_t* Bt, int wid, int lane) {
    const int tm = wid >> 1, tn0 = (wid & 1) * 2, lr = lane & 15, lq = lane >> 4;
#pragma unroll
    for (int ks = 0; ks < 2; ++ks) {
        const bf16x8 a = *(const LAS bf16x8*)(A + (tm * 16 + lr) * PT + ks * 32 + lq * 8);
#pragma unroll
        for (int t = 0; t < 2; ++t) { const bf16x8 b = *(const LAS bf16x8*)(Bt + ((tn0 + t) * 16 + lr) * PT + ks * 32 + lq * 8);
            acc[t] = __builtin_amdgcn_mfma_f32_16x16x32_bf16(a, b, acc[t], 0, 0, 0); }
    }
}
__device__ __forceinline__ float scan_add(float v, int lane) {
#pragma unroll
    for (int o = 1; o < 64; o <<= 1) { const float t = __shfl_up(v, o); if (lane >= o) v += t; }
    return v;
}
__device__ __forceinline__ float scan_max(float v, int lane) {
#pragma unroll
    for (int o = 1; o < 64; o <<= 1) { const float t = __shfl_up(v, o); if (lane >= o) v = fmaxf(v, t); }
    return v;
}
__device__ __forceinline__ void st_tr8(LAS bf16_t* T, int l, int ch, u32x4 w) {
    T[(ch * 8 + 0) * PT + l] = (bf16_t)(w.x & 0xffffu); T[(ch * 8 + 1) * PT + l] = (bf16_t)(w.x >> 16);
    T[(ch * 8 + 2) * PT + l] = (bf16_t)(w.y & 0xffffu); T[(ch * 8 + 3) * PT + l] = (bf16_t)(w.y >> 16);
    T[(ch * 8 + 4) * PT + l] = (bf16_t)(w.z & 0xffffu); T[(ch * 8 + 5) * PT + l] = (bf16_t)(w.z >> 16);
    T[(ch * 8 + 6) * PT + l] = (bf16_t)(w.w & 0xffffu); T[(ch * 8 + 7) * PT + l] = (bf16_t)(w.w >> 16);
}
__device__ __forceinline__ void unpack8(u32x4 w, float (&f)[8]) {
    f[0] = bflo(w.x); f[1] = bfhi(w.x); f[2] = bflo(w.y); f[3] = bfhi(w.y); f[4] = bflo(w.z); f[5] = bfhi(w.z); f[6] = bflo(w.w); f[7] = bfhi(w.w);
}
template <int GATE  >
__device__ __forceinline__ void finalize(const LAS float* HM, const LAS float* rowscale, const float* gnorm, const bf16_t* gate, bf16_t* out, int tid) {
    const int j = tid >> 3, ch = tid & 7;
    const f32x4 a = *(const LAS f32x4*)(HM + j * 68 + ch * 8), c = *(const LAS f32x4*)(HM + j * 68 + ch * 8 + 4);
    const float rsc = rowscale ? rowscale[j] : 1.f;
    float v[8] = {a[0] * rsc, a[1] * rsc, a[2] * rsc, a[3] * rsc, c[0] * rsc, c[1] * rsc, c[2] * rsc, c[3] * rsc};
    float ss = 0.f;
#pragma unroll
    for (int i = 0; i < 8; ++i) ss += v[i] * v[i];
    ss += __shfl_xor(ss, 1); ss += __shfl_xor(ss, 2); ss += __shfl_xor(ss, 4);
    const float rs = __builtin_amdgcn_rsqf(ss * (1.f / 64.f) + LN_EPS);
    const u32x4 gw = *(const u32x4*)(gate + (size_t)j * PJ + ch * 8);
    float gt[8]; unpack8(gw, gt);
    const f32x4 g0 = *(const f32x4*)(gnorm + ch * 8), g1 = *(const f32x4*)(gnorm + ch * 8 + 4);
    const float gn[8] = {g0[0], g0[1], g0[2], g0[3], g1[0], g1[1], g1[2], g1[3]};
    float y[8];
#pragma unroll
    for (int i = 0; i < 8; ++i) { const float sg = 1.f / (1.f + fexp(-gt[i])); const float gv = GATE ? gt[i] * sg : sg; y[i] = v[i] * rs * gn[i] * gv; }
    u32x4 w; w.x = pk2(y[0], y[1]); w.y = pk2(y[2], y[3]); w.z = pk2(y[4], y[5]); w.w = pk2(y[6], y[7]);
    *(u32x4*)(out + (size_t)j * DM + ch * 8) = w;
}

struct RecP {
    const bf16_t* proj; const float* tail; const bf16_t* csm; const bf16_t* csg; float* stm; float* stg; float* smN; float* smBC; float* smDM; float* smMS; float* smGBE; bf16_t* ycat;
    const float* mbi; const float* mbf; const float* mg; const float* wa2; const float* ba; const float* gg;
};

struct MLoc { u32x4 k, v; float mi, mf; };
struct MOut { u32x4 q, k, v, st, mo; float mi, mf, m, n; };
struct GLoc { u32x4 k, v; f32x4 ga; };
struct GOut { u32x4 q, k, v, st, gr; f32x4 ga; };
struct GW { float wv[16]; float bav; };

__device__ __forceinline__ void ld_mloc(MLoc& L, const RecP& P, int ci, int tid, int wid, int lane) {
    const int bh = ci >> 6, c = ci & 63, b = bh >> 2, h = bh & 3, row0 = b * SEQ + c * 64, l = tid >> 3, ch = tid & 7;
    const bf16_t* pr = P.proj + (size_t)(row0 + l) * PJ + h * 64 + ch * 8;
    L.k = *(const u32x4*)(pr + C_MK); L.v = *(const u32x4*)(pr + C_MV);
    if (wid == 0) { const float* tp = P.tail + (size_t)(row0 + lane) * 32; L.mi = tp[T_MI + h]; L.mf = tp[T_MF + h]; } else { L.mi = 0.f; L.mf = 0.f; }
}
__device__ __forceinline__ void ld_mout(MOut& L, const RecP& P, int ci, int tid, int wid, int lane) {
    const int bh = ci >> 6, c = ci & 63, b = bh >> 2, h = bh & 3, row0 = b * SEQ + c * 64, l = tid >> 3, ch = tid & 7;
    const bf16_t* pr = P.proj + (size_t)(row0 + l) * PJ + h * 64 + ch * 8;
    L.q = *(const u32x4*)(pr + C_MQ); L.k = *(const u32x4*)(pr + C_MK); L.v = *(const u32x4*)(pr + C_MV); L.mo = *(const u32x4*)(pr + C_MO);
    L.st = *(const u32x4*)(P.csm + (size_t)ci * 4096 + l * 64 + ch * 8);
    if (wid == 0) { const float* tp = P.tail + (size_t)(row0 + lane) * 32; L.mi = tp[T_MI + h]; L.mf = tp[T_MF + h]; L.m = P.smMS[ci]; L.n = P.smN[(size_t)ci * 64 + lane]; } else { L.mi = 0.f; L.mf = 0.f; L.m = 0.f; L.n = 0.f; }
}
__device__ __forceinline__ void ld_gloc(GLoc& L, const RecP& P, int ci, int tid) {
    const int bh = ci >> 6, c = ci & 63, b = bh >> 2, h = bh & 3, row0 = b * SEQ + c * 64, l = tid >> 3, ch = tid & 7;
    const bf16_t* pr = P.proj + (size_t)(row0 + l) * PJ + h * 64 + ch * 8;
    L.k = *(const u32x4*)(pr + C_GK); L.v = *(const u32x4*)(pr + C_GV);
    L.ga = (tid < 256) ? *(const f32x4*)(P.tail + (size_t)(row0 + (tid >> 2)) * 32 + T_GA + (tid & 3) * 4) : (f32x4){0.f, 0.f, 0.f, 0.f};
}
__device__ __forceinline__ void ld_gout(GOut& L, const RecP& P, int ci, int tid) {
    const int bh = ci >> 6, c = ci & 63, b = bh >> 2, h = bh & 3, row0 = b * SEQ + c * 64, l = tid >> 3, ch = tid & 7;
    const bf16_t* pr = P.proj + (size_t)(row0 + l) * PJ + h * 64 + ch * 8;
    L.q = *(const u32x4*)(pr + C_GQ); L.k = *(const u32x4*)(pr + C_GK); L.v = *(const u32x4*)(pr + C_GV); L.gr = *(const u32x4*)(pr + C_GR);
    L.st = *(const u32x4*)(P.csg + (size_t)ci * 4096 + l * 64 + ch * 8);
    L.ga = (tid < 256) ? *(const f32x4*)(P.tail + (size_t)(row0 + (tid >> 2)) * 32 + T_GA + (tid & 3) * 4) : (f32x4){0.f, 0.f, 0.f, 0.f};
}
__device__ __forceinline__ void ld_gw(GW& W, const RecP& P, int h, int tid) {
    const int dcol = tid & 63;
#pragma unroll
    for (int r = 0; r < 16; ++r) W.wv[r] = P.wa2[r * 256 + h * 64 + dcol];
    W.bav = P.ba[h * 64 + dcol];
}
template <int GATE  >
__device__ __forceinline__ void finalize2(const LAS float* HM, const LAS float* rowscale, const float* gnorm, u32x4 gw, bf16_t* out, int tid) {
    const int j = tid >> 3, ch = tid & 7;
    const f32x4 a = *(const LAS f32x4*)(HM + j * 68 + ch * 8), c = *(const LAS f32x4*)(HM + j * 68 + ch * 8 + 4);
    const float rsc = rowscale ? rowscale[j] : 1.f;
    float v[8] = {a[0] * rsc, a[1] * rsc, a[2] * rsc, a[3] * rsc, c[0] * rsc, c[1] * rsc, c[2] * rsc, c[3] * rsc};
    float ss = 0.f;
#pragma unroll
    for (int i = 0; i < 8; ++i) ss += v[i] * v[i];
    ss += __shfl_xor(ss, 1); ss += __shfl_xor(ss, 2); ss += __shfl_xor(ss, 4);
    const float rs = __builtin_amdgcn_rsqf(ss * (1.f / 64.f) + LN_EPS);
    float gt[8]; unpack8(gw, gt);
    const f32x4 g0 = *(const f32x4*)(gnorm + ch * 8), g1 = *(const f32x4*)(gnorm + ch * 8 + 4);
    const float gn[8] = {g0[0], g0[1], g0[2], g0[3], g1[0], g1[1], g1[2], g1[3]};
    float y[8];
#pragma unroll
    for (int i = 0; i < 8; ++i) { const float sg = 1.f / (1.f + fexp(-gt[i])); const float gv = GATE ? gt[i] * sg : sg; y[i] = v[i] * rs * gn[i] * gv; }
    u32x4 w; w.x = pk2(y[0], y[1]); w.y = pk2(y[2], y[3]); w.z = pk2(y[4], y[5]); w.w = pk2(y[6], y[7]);
    *(u32x4*)(out + (size_t)j * DM + ch * 8) = w;
}
__device__ __forceinline__ void mlstm_local(const MLoc& L, const RecP& P, LAS unsigned char* lds, int ci, int tid, int wid, int lane) {
    const int h = (ci >> 6) & 3;
    LAS bf16_t* KT = (LAS bf16_t*)(lds + OFF_T0); LAS bf16_t* VT = (LAS bf16_t*)(lds + OFF_T1); LAS float* vec = (LAS float*)(lds + OFF_VEC);
    const int l = tid >> 3, ch = tid & 7;
    if (wid == 0) {
        const float li = L.mi + P.mbi[h], lf = logsig(L.mf + P.mbf[h]);
        const float bc = scan_add(lf, lane), g = li - bc;
        const float gmax = wave_max(g), bend = __shfl(bc, 63);
        vec[V_G + lane] = fexp(g - gmax);
        if (lane == 0) { P.smBC[ci] = bend; P.smDM[ci] = bend + gmax; }
    }
    __syncthreads();
    { const float w = vec[V_G + l]; float kf[8]; unpack8(L.k, kf);
      u32x4 ks; ks.x = pk2(kf[0] * w, kf[1] * w); ks.y = pk2(kf[2] * w, kf[3] * w); ks.z = pk2(kf[4] * w, kf[5] * w); ks.w = pk2(kf[6] * w, kf[7] * w);
      st_tr8(KT, l, ch, ks); st_tr8(VT, l, ch, L.v); }
    __syncthreads();
    f32x4 acc[2] = {(f32x4){0.f, 0.f, 0.f, 0.f}, (f32x4){0.f, 0.f, 0.f, 0.f}};
    mm64(acc, VT, KT, wid, lane);
    { const int tm = wid >> 1, tn0 = (wid & 1) * 2, lr = lane & 15, lq = lane >> 4; float* dst = P.stm + (size_t)ci * 4096;
#pragma unroll
      for (int t = 0; t < 2; ++t)
#pragma unroll
          for (int r = 0; r < 4; ++r) dst[(tm * 16 + lq * 4 + r) * 64 + (tn0 + t) * 16 + lr] = acc[t][r]; }
    if (tid < 64) { float s = 0.f;
#pragma unroll
        for (int q = 0; q < 8; ++q) { const u32x4 w = *(const LAS u32x4*)(KT + tid * PT + q * 8); float f[8]; unpack8(w, f);
#pragma unroll
            for (int i = 0; i < 8; ++i) s += f[i]; }
        P.smN[(size_t)ci * 64 + tid] = s; }
    __syncthreads();
}
__device__ __forceinline__ void mlstm_out(const MOut& L, const RecP& P, LAS unsigned char* lds, int ci, int tid, int wid, int lane) {
    const int bh = ci >> 6, c = ci & 63, b = bh >> 2, h = bh & 3, row0 = b * SEQ + c * 64;
    LAS bf16_t* Qm = (LAS bf16_t*)(lds + OFF_T0); LAS bf16_t* Km = (LAS bf16_t*)(lds + OFF_T1); LAS bf16_t* VT = (LAS bf16_t*)(lds + OFF_T2);
    LAS bf16_t* CT = (LAS bf16_t*)(lds + OFF_T3); LAS bf16_t* Sm = (LAS bf16_t*)(lds + OFF_T4);
    LAS float* HM = (LAS float*)(lds + OFF_HM); LAS float* vec = (LAS float*)(lds + OFF_VEC);
    const int l = tid >> 3, ch = tid & 7;
    *(LAS u32x4*)(Qm + l * PT + ch * 8) = L.q; *(LAS u32x4*)(Km + l * PT + ch * 8) = L.k; st_tr8(VT, l, ch, L.v); *(LAS u32x4*)(CT + l * PT + ch * 8) = L.st;
    if (wid == 0) {
        const float li = L.mi + P.mbi[h], lf = logsig(L.mf + P.mbf[h]);
        const float bc = scan_add(lf, lane), g = li - bc;
        const float pm = scan_max(g, lane), m = L.m, M = fmaxf(m, pm);
        vec[V_G + lane] = g; vec[V_M + lane] = M; vec[V_WI + lane] = fexp(m - M); vec[V_EM + lane] = fexp(-bc - M);
        vec[V_N + lane] = L.n;
    }
    __syncthreads();
    { f32x4 acc[2] = {(f32x4){0.f, 0.f, 0.f, 0.f}, (f32x4){0.f, 0.f, 0.f, 0.f}};
      mm64(acc, Qm, Km, wid, lane);
      const int tm = wid >> 1, tn0 = (wid & 1) * 2, lr = lane & 15, lq = lane >> 4;
#pragma unroll
      for (int t = 0; t < 2; ++t) { const int ll = (tn0 + t) * 16 + lr; const float gl = vec[V_G + ll];
#pragma unroll
          for (int r = 0; r < 4; ++r) { const int j = tm * 16 + lq * 4 + r; const float s = (ll <= j) ? acc[t][r] * fexp(gl - vec[V_M + j]) : 0.f; Sm[j * PT + ll] = (bf16_t)f2bf(s); } } }
    __syncthreads();
    { f32x4 a1[2] = {(f32x4){0.f, 0.f, 0.f, 0.f}, (f32x4){0.f, 0.f, 0.f, 0.f}}, a2[2] = {(f32x4){0.f, 0.f, 0.f, 0.f}, (f32x4){0.f, 0.f, 0.f, 0.f}};
      mm64(a1, Sm, VT, wid, lane); mm64(a2, Qm, CT, wid, lane);
      const int tm = wid >> 1, tn0 = (wid & 1) * 2, lr = lane & 15, lq = lane >> 4;
#pragma unroll
      for (int t = 0; t < 2; ++t)
#pragma unroll
          for (int r = 0; r < 4; ++r) { const int j = tm * 16 + lq * 4 + r; HM[j * 68 + (tn0 + t) * 16 + lr] = a1[t][r] + vec[V_WI + j] * a2[t][r]; } }
    if (tid < 64) { float ds = 0.f, qn = 0.f;
#pragma unroll
        for (int q = 0; q < 8; ++q) { const u32x4 w = *(const LAS u32x4*)(Sm + tid * PT + q * 8); float f[8]; unpack8(w, f);
            const u32x4 qw = *(const LAS u32x4*)(Qm + tid * PT + q * 8); float qf[8]; unpack8(qw, qf);
#pragma unroll
            for (int i = 0; i < 8; ++i) { ds += f[i]; qn += qf[i] * vec[V_N + q * 8 + i]; } }
        const float den = ds + vec[V_WI + tid] * qn;
        vec[V_DI + tid] = 1.f / fmaxf(fabsf(den), vec[V_EM + tid]); }
    __syncthreads();
    finalize2<0>(HM, vec + V_DI, P.mg, L.mo, P.ycat + (size_t)row0 * DM + h * 64, tid);
    __syncthreads();
}
__device__ __forceinline__ void gla_bmat(const f32x4 ga, const GW& W, LAS unsigned char* lds, int tid, int wid) {
    LAS float* BM = (LAS float*)(lds + OFF_BM); LAS float* vec = (LAS float*)(lds + OFF_VEC);
    if (tid < 256) { const int l = tid >> 2, q = tid & 3; vec[V_GA + l * 16 + q * 4 + 0] = ga[0]; vec[V_GA + l * 16 + q * 4 + 1] = ga[1]; vec[V_GA + l * 16 + q * 4 + 2] = ga[2]; vec[V_GA + l * 16 + q * 4 + 3] = ga[3]; }
    const int dcol = tid & 63;
    __syncthreads();
    float cs[8]; float cacc = 0.f;
#pragma unroll
    for (int i = 0; i < 8; ++i) { const int l = wid * 8 + i; float z = W.bav;
#pragma unroll
        for (int r = 0; r < 16; ++r) z += vec[V_GA + l * 16 + r] * W.wv[r];
        cacc += logsig(z) * (1.f / 16.f); cs[i] = cacc; }
    vec[V_SEG + wid * 64 + dcol] = cacc;
    __syncthreads();
    float off = 0.f, tot = 0.f;
#pragma unroll
    for (int s = 0; s < 8; ++s) { const float v = vec[V_SEG + s * 64 + dcol]; tot += v; if (s < wid) off += v; }
#pragma unroll
    for (int i = 0; i < 8; ++i) BM[(wid * 8 + i) * 64 + dcol] = off + cs[i];
    if (wid == 0) vec[V_BE + dcol] = tot;
    __syncthreads();
}
__device__ __forceinline__ void gla_local(const GLoc& L, const GW& W, const RecP& P, LAS unsigned char* lds, int ci, int tid, int wid, int lane) {
    LAS bf16_t* KT = (LAS bf16_t*)(lds + OFF_T0); LAS bf16_t* VT = (LAS bf16_t*)(lds + OFF_T1);
    LAS float* BM = (LAS float*)(lds + OFF_BM); LAS float* vec = (LAS float*)(lds + OFF_VEC);
    const int l = tid >> 3, ch = tid & 7;
    gla_bmat(L.ga, W, lds, tid, wid);
    if (tid < 64) P.smGBE[(size_t)ci * 64 + tid] = vec[V_BE + tid];
    { float kf[8]; unpack8(L.k, kf); float ks[8];
#pragma unroll
      for (int i = 0; i < 8; ++i) { const int d = ch * 8 + i; ks[i] = kf[i] * fexp(vec[V_BE + d] - BM[l * 64 + d]); }
      u32x4 kk; kk.x = pk2(ks[0], ks[1]); kk.y = pk2(ks[2], ks[3]); kk.z = pk2(ks[4], ks[5]); kk.w = pk2(ks[6], ks[7]);
      st_tr8(KT, l, ch, kk); st_tr8(VT, l, ch, L.v); }
    __syncthreads();
    f32x4 acc[2] = {(f32x4){0.f, 0.f, 0.f, 0.f}, (f32x4){0.f, 0.f, 0.f, 0.f}};
    mm64(acc, VT, KT, wid, lane);
    { const int tm = wid >> 1, tn0 = (wid & 1) * 2, lr = lane & 15, lq = lane >> 4; float* dst = P.stg + (size_t)ci * 4096;
#pragma unroll
      for (int t = 0; t < 2; ++t)
#pragma unroll
          for (int r = 0; r < 4; ++r) dst[(tm * 16 + lq * 4 + r) * 64 + (tn0 + t) * 16 + lr] = acc[t][r]; }
    __syncthreads();
}
__device__ __forceinline__ void gla_out(const GOut& L, const GW& W, const RecP& P, LAS unsigned char* lds, int ci, int tid, int wid, int lane) {
    const int bh = ci >> 6, c = ci & 63, b = bh >> 2, h = bh & 3, row0 = b * SEQ + c * 64;
    LAS bf16_t* Qm = (LAS bf16_t*)(lds + OFF_T0); LAS bf16_t* Km = (LAS bf16_t*)(lds + OFF_T1); LAS bf16_t* VT = (LAS bf16_t*)(lds + OFF_T2);
    LAS bf16_t* ST = (LAS bf16_t*)(lds + OFF_T3); LAS bf16_t* Sm = (LAS bf16_t*)(lds + OFF_T4);
    LAS float* BM = (LAS float*)(lds + OFF_BM); LAS float* HM = (LAS float*)(lds + OFF_HM);
    const int l = tid >> 3, ch = tid & 7;
    gla_bmat(L.ga, W, lds, tid, wid);
    { float qf[8], kf[8]; unpack8(L.q, qf); unpack8(L.k, kf); float qs[8], ks[8];
#pragma unroll
      for (int i = 0; i < 8; ++i) { const float bv = BM[l * 64 + ch * 8 + i]; qs[i] = qf[i] * fexp(bv); ks[i] = kf[i] * fexp(-bv); }
      u32x4 qq, kk; qq.x = pk2(qs[0], qs[1]); qq.y = pk2(qs[2], qs[3]); qq.z = pk2(qs[4], qs[5]); qq.w = pk2(qs[6], qs[7]);
      kk.x = pk2(ks[0], ks[1]); kk.y = pk2(ks[2], ks[3]); kk.z = pk2(ks[4], ks[5]); kk.w = pk2(ks[6], ks[7]);
      *(LAS u32x4*)(Qm + l * PT + ch * 8) = qq; *(LAS u32x4*)(Km + l * PT + ch * 8) = kk; st_tr8(VT, l, ch, L.v);
      *(LAS u32x4*)(ST + l * PT + ch * 8) = L.st; }
    __syncthreads();
    { f32x4 acc[2] = {(f32x4){0.f, 0.f, 0.f, 0.f}, (f32x4){0.f, 0.f, 0.f, 0.f}};
      mm64(acc, Qm, Km, wid, lane);
      const int tm = wid >> 1, tn0 = (wid & 1) * 2, lr = lane & 15, lq = lane >> 4;
#pragma unroll
      for (int t = 0; t < 2; ++t) { const int ll = (tn0 + t) * 16 + lr;
#pragma unroll
          for (int r = 0; r < 4; ++r) { const int j = tm * 16 + lq * 4 + r; Sm[j * PT + ll] = (bf16_t)f2bf((ll <= j) ? acc[t][r] : 0.f); } } }
    __syncthreads();
    { f32x4 acc[2] = {(f32x4){0.f, 0.f, 0.f, 0.f}, (f32x4){0.f, 0.f, 0.f, 0.f}};
      mm64(acc, Sm, VT, wid, lane); mm64(acc, Qm, ST, wid, lane);
      const int tm = wid >> 1, tn0 = (wid & 1) * 2, lr = lane & 15, lq = lane >> 4;
#pragma unroll
      for (int t = 0; t < 2; ++t)
#pragma unroll
          for (int r = 0; r < 4; ++r) HM[(tm * 16 + lq * 4 + r) * 68 + (tn0 + t) * 16 + lr] = acc[t][r]; }
    __syncthreads();
    finalize2<1>(HM, nullptr, P.gg, L.gr, P.ycat + (size_t)row0 * DM + 768 + h * 64, tid);
    __syncthreads();
}
}

namespace recw {
using rec::RecP; using rec::scan_add; using rec::scan_max; using rec::unpack8;
typedef short s16x4v __attribute__((ext_vector_type(4)));
typedef short v4i16_t __attribute__((ext_vector_type(4)));
#define MF16(a, b, c) __builtin_amdgcn_mfma_f32_16x16x32_bf16((a), (b), (c), 0, 0, 0)
__device__ __forceinline__ s16x4v tr16(const LAS bf16_t* p) { return __builtin_bit_cast(s16x4v, __builtin_amdgcn_ds_read_tr16_b64_v4i16((LAS v4i16_t*)p)); }
__device__ __forceinline__ bf16x8 trfrag(const LAS bf16_t* T, int pitch, int s, int c0, int lane) {
    const int i = lane & 15, q = lane >> 4;
    const LAS bf16_t* pa = T + (32 * s + 4 * q + (i >> 2)) * pitch + c0 + 4 * (i & 3);
    const s16x4v lo = tr16(pa), hi = tr16(pa + 16 * pitch);
    return (bf16x8){lo[0], lo[1], lo[2], lo[3], hi[0], hi[1], hi[2], hi[3]};
}
__device__ __forceinline__ bf16x8 rfg(const bf16_t* X, int pitch, int T, int ks, int lane) { return *(const bf16x8*)(X + (size_t)(16 * T + (lane & 15)) * pitch + 32 * ks + 8 * (lane >> 4)); }
__device__ __forceinline__ u32x4 piece(const bf16_t* X, int pitch, int i, int lane) { return *(const u32x4*)(X + (size_t)((lane >> 3) + 8 * i) * pitch + (lane & 7) * 8); }
__device__ __forceinline__ bf16x8 frag_scale(bf16x8 f, float sc) {
    const u32x4 w = __builtin_bit_cast(u32x4, f); u32x4 o;
    o.x = pk2(bflo(w.x) * sc, bfhi(w.x) * sc); o.y = pk2(bflo(w.y) * sc, bfhi(w.y) * sc); o.z = pk2(bflo(w.z) * sc, bfhi(w.z) * sc); o.w = pk2(bflo(w.w) * sc, bfhi(w.w) * sc);
    return __builtin_bit_cast(bf16x8, o);
}
__device__ __forceinline__ bf16x8 frag_mul(bf16x8 f, bf16x8 g, bool recip) {
    const u32x4 a = __builtin_bit_cast(u32x4, f), b = __builtin_bit_cast(u32x4, g); float x[8], y[8]; unpack8(a, x); unpack8(b, y);
#pragma unroll
    for (int i = 0; i < 8; ++i) x[i] = recip ? x[i] * __builtin_amdgcn_rcpf(y[i]) : x[i] * y[i];
    u32x4 o; o.x = pk2(x[0], x[1]); o.y = pk2(x[2], x[3]); o.z = pk2(x[4], x[5]); o.w = pk2(x[6], x[7]);
    return __builtin_bit_cast(bf16x8, o);
}
__device__ __forceinline__ float red_q(float v) { v += __shfl_xor(v, 16); v += __shfl_xor(v, 32); return v; }
__device__ __forceinline__ void stage_rows(f32x4 (&O)[4], int Tj, float rowscale, LAS bf16_t* Tl, int PTL, int lane) {
    const int r = lane & 15, q = lane >> 4;
    float ss = 0.f;
#pragma unroll
    for (int Te = 0; Te < 4; ++Te) { O[Te] = O[Te] * rowscale; const f32x4 v = O[Te]; ss += (v[0] * v[0] + v[1] * v[1]) + (v[2] * v[2] + v[3] * v[3]); }
    ss = red_q(ss);
    const float rs = __builtin_amdgcn_rsqf(ss * (1.f / 64.f) + LN_EPS);
#pragma unroll
    for (int Te = 0; Te < 4; ++Te) { const f32x4 v = O[Te] * rs; u32x2 w; w.x = pk2(v[0], v[1]); w.y = pk2(v[2], v[3]); *(LAS u32x2*)(Tl + (16 * Tj + r) * PTL + 16 * Te + 4 * q) = w; }
}
template <int GATE>
__device__ __forceinline__ void final_store(const LAS bf16_t* Tl, int PTL, const float* gnorm, const bf16_t* gate, bf16_t* out, int lane) {
    const int ch = lane & 7;
    const f32x4 g0 = *(const f32x4*)(gnorm + ch * 8), g1 = *(const f32x4*)(gnorm + ch * 8 + 4);
    const float gn[8] = {g0[0], g0[1], g0[2], g0[3], g1[0], g1[1], g1[2], g1[3]};
#pragma unroll
    for (int i = 0; i < 8; ++i) { const int row = (lane >> 3) + 8 * i;
        float hv[8], gt[8]; unpack8(*(const LAS u32x4*)(Tl + row * PTL + ch * 8), hv); unpack8(*(const u32x4*)(gate + (size_t)row * PJ + ch * 8), gt);
        float y[8];
#pragma unroll
        for (int k = 0; k < 8; ++k) { const float sg = __builtin_amdgcn_rcpf(1.f + fexp(-gt[k])); y[k] = hv[k] * (gn[k] * Y8S) * (GATE ? gt[k] * sg : sg); }
        u32x2 w; w.x = pk4_fp8(y[0], y[1], y[2], y[3]); w.y = pk4_fp8(y[4], y[5], y[6], y[7]);
        *(u32x2*)((unsigned char*)out + (size_t)row * DM + ch * 8) = w; }
}
__device__ __forceinline__ void mlstm_local_w(const RecP& P, LAS unsigned char* wl, int ci, int lane) {
    const int r = lane & 15, q = lane >> 4; constexpr int PL = 64;
    const int bh = ci >> 6, c = ci & 63, b = bh >> 2, h = bh & 3, row0 = b * SEQ + c * 64;
    const bf16_t* Xk = P.proj + (size_t)row0 * PJ + C_MK + h * 64; const bf16_t* Xv = P.proj + (size_t)row0 * PJ + C_MV + h * 64;
    LAS bf16_t* Kl = (LAS bf16_t*)wl; LAS bf16_t* Vl = (LAS bf16_t*)(wl + 8192);
    const float* tp = P.tail + (size_t)(row0 + lane) * 32;
    const float li = tp[T_MI + h] + P.mbi[h], lf = logsig(tp[T_MF + h] + P.mbf[h]);
    const float bc = scan_add(lf, lane), g = li - bc, gmax = wave_max(g), bend = __shfl(bc, 63), w = fexp(g - gmax);
    if (lane == 0) { P.smBC[ci] = bend; P.smDM[ci] = bend + gmax; }
    u32x4 kp8_[8], vp8_[8];
#pragma unroll
    for (int i = 0; i < 8; ++i) { kp8_[i] = piece(Xk, PJ, i, lane); vp8_[i] = piece(Xv, PJ, i, lane); }
    __builtin_amdgcn_sched_barrier(0);
#pragma unroll
    for (int i = 0; i < 8; ++i) { const u32x4 kpi = kp8_[i], vpi = vp8_[i]; const float wr_ = __shfl(w, (lane >> 3) + 8 * i); float kf[8]; unpack8(kpi, kf);
        u32x4 ks; ks.x = pk2(kf[0] * wr_, kf[1] * wr_); ks.y = pk2(kf[2] * wr_, kf[3] * wr_); ks.z = pk2(kf[4] * wr_, kf[5] * wr_); ks.w = pk2(kf[6] * wr_, kf[7] * wr_);
        *(LAS u32x4*)(Kl + ((lane >> 3) + 8 * i) * PL + (lane & 7) * 8) = ks; *(LAS u32x4*)(Vl + ((lane >> 3) + 8 * i) * PL + (lane & 7) * 8) = vpi; }
    asm volatile("" ::: "memory"); __builtin_amdgcn_sched_barrier(0);
    bf16x8 Kt[4][2];
#pragma unroll
    for (int Td = 0; Td < 4; ++Td)
#pragma unroll
        for (int s = 0; s < 2; ++s) Kt[Td][s] = trfrag(Kl, PL, s, 16 * Td, lane);
#pragma unroll
    for (int Te = 0; Te < 4; ++Te) { const bf16x8 v0 = trfrag(Vl, PL, 0, 16 * Te, lane), v1 = trfrag(Vl, PL, 1, 16 * Te, lane);
#pragma unroll
        for (int Td = 0; Td < 4; ++Td) { f32x4 acc = (f32x4){0.f, 0.f, 0.f, 0.f}; acc = MF16(Kt[Td][0], v0, acc); acc = MF16(Kt[Td][1], v1, acc);
            u32x2 w; w.x = pk2(acc[0], acc[1]); w.y = pk2(acc[2], acc[3]); *(LAS u32x2*)(Kl + (16 * Te + r) * PL + 16 * Td + 4 * q) = w; } }
    asm volatile("" ::: "memory"); __builtin_amdgcn_sched_barrier(0);
    { bf16_t* dstb = (bf16_t*)P.stm + (size_t)ci * 4096;
#pragma unroll
      for (int i = 0; i < 8; ++i) { const int row = (lane >> 3) + 8 * i, ch = lane & 7; *(u32x4*)(dstb + row * 64 + ch * 8) = *(const LAS u32x4*)(Kl + row * PL + ch * 8); } }
    { const short one = (short)0x3F80; const bf16x8 ones = (bf16x8){one, one, one, one, one, one, one, one};
#pragma unroll
      for (int Td = 0; Td < 4; ++Td) { f32x4 acc = (f32x4){0.f, 0.f, 0.f, 0.f}; acc = MF16(ones, Kt[Td][0], acc); acc = MF16(ones, Kt[Td][1], acc);
          if (q == 0) P.smN[(size_t)ci * 64 + 16 * Td + r] = acc[0]; } }
}
struct GWf { bf16x8 Bw[4]; float ba[4]; };
__device__ __forceinline__ void ld_gwf(GWf& W, const RecP& P, int h, int lane) {
    const int r = lane & 15, q = lane >> 4;
    int wo = (8 * (q & 1)) * 256 + h * 64 + r; asm volatile("" : "+v"(wo)); const float* wp = P.wa2 + wo;
#pragma unroll
    for (int Td = 0; Td < 4; ++Td) { float w8[8];
#pragma unroll
        for (int i = 0; i < 8; ++i) { const float wv_ = wp[i * 256 + 16 * Td]; w8[i] = (q < 2) ? wv_ : 0.f; }
        u32x4 o; o.x = pk2(w8[0], w8[1]); o.y = pk2(w8[2], w8[3]); o.z = pk2(w8[4], w8[5]); o.w = pk2(w8[6], w8[7]); W.Bw[Td] = __builtin_bit_cast(bf16x8, o);
        W.ba[Td] = P.ba[h * 64 + 16 * Td + r]; }
}
template <int MODE>
__device__ __forceinline__ void gla_gate_tile(LAS bf16_t* Tt, int PL, float (&bend)[4], const GWf& W, const float* tail_row0, int lane) {
    const int r = lane & 15, q = lane >> 4;
    bf16x8 Ag[4];
    int to = r * 32 + T_GA + 8 * (q & 1); asm volatile("" : "+v"(to)); const float* tpb = tail_row0 + to;
#pragma unroll
    for (int Tl = 0; Tl < 4; ++Tl) { f32x4 a0 = *(const f32x4*)(tpb + Tl * 512), a1 = *(const f32x4*)(tpb + Tl * 512 + 4);
        if (q >= 2) { a0 = (f32x4){0.f, 0.f, 0.f, 0.f}; a1 = a0; }
        u32x4 o; o.x = pk2(a0[0], a0[1]); o.y = pk2(a0[2], a0[3]); o.z = pk2(a1[0], a1[1]); o.w = pk2(a1[2], a1[3]); Ag[Tl] = __builtin_bit_cast(bf16x8, o); }
#pragma unroll
    for (int Td = 0; Td < 4; ++Td) { float carry = 0.f; LAS bf16_t* tcol = Tt + (4 * q) * PL + 16 * Td + r;
#pragma unroll
        for (int tt = 0; tt < 4; ++tt) { const int Tl = MODE ? 3 - tt : tt; const float bb = W.ba[Td]; const f32x4 z = MF16(Ag[Tl], W.Bw[Td], ((f32x4){bb, bb, bb, bb}));
            const float v0 = logsig(z[0]) * (1.f / 16.f), v1 = logsig(z[1]) * (1.f / 16.f), v2 = logsig(z[2]) * (1.f / 16.f), v3 = logsig(z[3]) * (1.f / 16.f);
            const float lt = (v0 + v1) + (v2 + v3);
            float ex, o0, o1, o2, o3;
            if (MODE == 0) { const float t1 = __shfl_up(lt, 16), t2 = __shfl_up(lt, 32), t3 = __shfl_up(lt, 48); ex = carry + (q >= 1 ? t1 : 0.f) + (q >= 2 ? t2 : 0.f) + (q >= 3 ? t3 : 0.f);
                o0 = ex + v0; o1 = o0 + v1; o2 = o1 + v2; o3 = o2 + v3; }
            else { const float t1 = __shfl_down(lt, 16), t2 = __shfl_down(lt, 32), t3 = __shfl_down(lt, 48); ex = carry + (q <= 2 ? t1 : 0.f) + (q <= 1 ? t2 : 0.f) + (q <= 0 ? t3 : 0.f);
                o3 = ex; o2 = o3 + v3; o1 = o2 + v2; o0 = o1 + v1; }
            carry += red_q(lt);
            LAS bf16_t* tp = tcol + (16 * Tl) * PL;
            const unsigned w01 = pk2(fexp(o0), fexp(o1)), w23 = pk2(fexp(o2), fexp(o3));
            tp[0] = (bf16_t)(w01 & 0xffffu); tp[PL] = (bf16_t)(w01 >> 16); tp[2 * PL] = (bf16_t)(w23 & 0xffffu); tp[3 * PL] = (bf16_t)(w23 >> 16); }
        bend[Td] = carry; }
}
__device__ __forceinline__ void gla_local_w(const RecP& P, const GWf& W, LAS unsigned char* wl, int ci, int lane) {
    const int r = lane & 15, q = lane >> 4; constexpr int PL = 64;
    const int bh = ci >> 6, c = ci & 63, b = bh >> 2, h = bh & 3, row0 = b * SEQ + c * 64;
    const bf16_t* Xk = P.proj + (size_t)row0 * PJ + C_GK + h * 64; const bf16_t* Xv = P.proj + (size_t)row0 * PJ + C_GV + h * 64;
    LAS bf16_t* Kl = (LAS bf16_t*)wl; LAS bf16_t* Vl = (LAS bf16_t*)(wl + 8192);
    { float bend[4]; gla_gate_tile<1>(Kl, PL, bend, W, P.tail + (size_t)row0 * 32, lane);
      if (q == 0) {
#pragma unroll
          for (int Td = 0; Td < 4; ++Td) P.smGBE[(size_t)ci * 64 + 16 * Td + r] = bend[Td]; } }
    asm volatile("" ::: "memory"); __builtin_amdgcn_sched_barrier(0);
    u32x4 kp8_[8], vp8_[8];
#pragma unroll
    for (int i = 0; i < 8; ++i) { kp8_[i] = piece(Xk, PJ, i, lane); vp8_[i] = piece(Xv, PJ, i, lane); }
    __builtin_amdgcn_sched_barrier(0);
#pragma unroll
    for (int i = 0; i < 8; ++i) { const u32x4 kp = kp8_[i], vp = vp8_[i];
        LAS bf16_t* kp_l = Kl + ((lane >> 3) + 8 * i) * PL + (lane & 7) * 8; float kf[8], ff[8]; unpack8(kp, kf); unpack8(*(const LAS u32x4*)kp_l, ff);
        u32x4 ks; ks.x = pk2(kf[0] * ff[0], kf[1] * ff[1]); ks.y = pk2(kf[2] * ff[2], kf[3] * ff[3]); ks.z = pk2(kf[4] * ff[4], kf[5] * ff[5]); ks.w = pk2(kf[6] * ff[6], kf[7] * ff[7]);
        *(LAS u32x4*)kp_l = ks; *(LAS u32x4*)(Vl + ((lane >> 3) + 8 * i) * PL + (lane & 7) * 8) = vp; }
    asm volatile("" ::: "memory"); __builtin_amdgcn_sched_barrier(0);
    bf16x8 Kt[4][2];
#pragma unroll
    for (int Td = 0; Td < 4; ++Td)
#pragma unroll
        for (int s = 0; s < 2; ++s) Kt[Td][s] = trfrag(Kl, PL, s, 16 * Td, lane);
#pragma unroll
    for (int Te = 0; Te < 4; ++Te) { const bf16x8 v0 = trfrag(Vl, PL, 0, 16 * Te, lane), v1 = trfrag(Vl, PL, 1, 16 * Te, lane);
#pragma unroll
        for (int Td = 0; Td < 4; ++Td) { f32x4 acc = (f32x4){0.f, 0.f, 0.f, 0.f}; acc = MF16(Kt[Td][0], v0, acc); acc = MF16(Kt[Td][1], v1, acc);
            u32x2 w; w.x = pk2(acc[0], acc[1]); w.y = pk2(acc[2], acc[3]); *(LAS u32x2*)(Kl + (16 * Te + r) * PL + 16 * Td + 4 * q) = w; } }
    asm volatile("" ::: "memory"); __builtin_amdgcn_sched_barrier(0);
    { bf16_t* dstb = (bf16_t*)P.stg + (size_t)ci * 4096;
#pragma unroll
      for (int i = 0; i < 8; ++i) { const int row = (lane >> 3) + 8 * i, ch = lane & 7; *(u32x4*)(dstb + row * 64 + ch * 8) = *(const LAS u32x4*)(Kl + row * PL + ch * 8); } }
}
__device__ __forceinline__ void mlstm_out_w(const RecP& P, LAS unsigned char* wl, int ci, int lane) {
    const int r = lane & 15, q = lane >> 4; constexpr int PL = 72;
    const int bh = ci >> 6, c = ci & 63, b = bh >> 2, h = bh & 3, row0 = b * SEQ + c * 64;
    const bf16_t* Xq = P.proj + (size_t)row0 * PJ + C_MQ + h * 64; const bf16_t* Xk = P.proj + (size_t)row0 * PJ + C_MK + h * 64; const bf16_t* Xv = P.proj + (size_t)row0 * PJ + C_MV + h * 64;
    LAS bf16_t* Tl = (LAS bf16_t*)wl; LAS float* vg = (LAS float*)(wl + 9216); LAS float* vn = vg + 64;
    { u32x4 tv_[8];
#pragma unroll
      for (int i = 0; i < 8; ++i) tv_[i] = piece(Xv, PJ, i, lane);
      __builtin_amdgcn_sched_barrier(0);
#pragma unroll
      for (int i = 0; i < 8; ++i) *(LAS u32x4*)(Tl + ((lane >> 3) + 8 * i) * PL + (lane & 7) * 8) = tv_[i]; }
    const float* tp = P.tail + (size_t)(row0 + lane) * 32;
    const float li = tp[T_MI + h] + P.mbi[h], lf = logsig(tp[T_MF + h] + P.mbf[h]);
    const float m = P.smMS[ci]; vn[lane] = P.smN[(size_t)ci * 64 + lane];
    const float bc = scan_add(lf, lane), g = li - bc, pm = scan_max(g, lane), M = fmaxf(m, pm), wint = fexp(m - M), expm = fexp(-bc - M);
    vg[lane] = g;
    asm volatile("" ::: "memory"); __builtin_amdgcn_sched_barrier(0);
    bf16x8 Kf[4][2], Qf[4][2];
#pragma unroll
    for (int T = 0; T < 4; ++T)
#pragma unroll
        for (int ks = 0; ks < 2; ++ks) { Kf[T][ks] = rfg(Xk, PJ, T, ks, lane); Qf[T][ks] = rfg(Xq, PJ, T, ks, lane); }
    float Mj[4], wj[4], ej[4];
#pragma unroll
    for (int T = 0; T < 4; ++T) { Mj[T] = __shfl(M, 16 * T + r); wj[T] = __shfl(wint, 16 * T + r); ej[T] = __shfl(expm, 16 * T + r); }
    u32x2 Pk[4][4]; float dinv[4];
#pragma unroll
    for (int Tj = 0; Tj < 4; ++Tj) { float dsum = 0.f;
#pragma unroll
        for (int Tl_ = 0; Tl_ < 4; ++Tl_) {
            if (Tl_ <= Tj) { f32x4 acc = (f32x4){0.f, 0.f, 0.f, 0.f}; acc = MF16(Kf[Tl_][0], Qf[Tj][0], acc); acc = MF16(Kf[Tl_][1], Qf[Tj][1], acc);
                const f32x4 g4 = *(const LAS f32x4*)(vg + 16 * Tl_ + 4 * q); float sv[4];
#pragma unroll
                for (int rg = 0; rg < 4; ++rg) { const bool ok = (Tl_ < Tj) || (4 * q + rg <= r); sv[rg] = ok ? acc[rg] * fexp(g4[rg] - Mj[Tj]) : 0.f; dsum += sv[rg]; }
                Pk[Tj][Tl_].x = pk2(sv[0], sv[1]); Pk[Tj][Tl_].y = pk2(sv[2], sv[3]); }
            else { Pk[Tj][Tl_].x = 0u; Pk[Tj][Tl_].y = 0u; } }
        dsum = red_q(dsum);
        float qn = 0.f;
#pragma unroll
        for (int ks = 0; ks < 2; ++ks) { float qf[8]; unpack8(__builtin_bit_cast(u32x4, Qf[Tj][ks]), qf); const f32x4 n0 = *(const LAS f32x4*)(vn + 32 * ks + 8 * q), n1 = *(const LAS f32x4*)(vn + 32 * ks + 8 * q + 4);
            qn += (qf[0] * n0[0] + qf[1] * n0[1]) + (qf[2] * n0[2] + qf[3] * n0[3]) + (qf[4] * n1[0] + qf[5] * n1[1]) + (qf[6] * n1[2] + qf[7] * n1[3]); }
        qn = red_q(qn);
        const float den = dsum + wj[Tj] * qn; dinv[Tj] = __builtin_amdgcn_rcpf(fmaxf(fabsf(den), ej[Tj]));
        Qf[Tj][0] = frag_scale(Qf[Tj][0], wj[Tj]); Qf[Tj][1] = frag_scale(Qf[Tj][1], wj[Tj]); asm volatile("" ::: "memory"); __builtin_amdgcn_sched_barrier(0); }
    asm volatile("" ::: "memory"); __builtin_amdgcn_sched_barrier(0);
    const bf16_t* cs = P.csm + (size_t)ci * 4096;
    bf16x8 Vt[4][2], Ct[4][2];
#pragma unroll
    for (int Te = 0; Te < 4; ++Te)
#pragma unroll
        for (int s = 0; s < 2; ++s) { Vt[Te][s] = trfrag(Tl, PL, s, 16 * Te, lane); Ct[Te][s] = rfg(cs, 64, Te, s, lane); }
    asm volatile("" ::: "memory"); __builtin_amdgcn_sched_barrier(0);
#pragma unroll
    for (int Tj = 0; Tj < 4; ++Tj) { f32x4 O[4];
        const bf16x8 p0 = __builtin_bit_cast(bf16x8, ((u32x4){Pk[Tj][0].x, Pk[Tj][0].y, Pk[Tj][1].x, Pk[Tj][1].y})), p1 = __builtin_bit_cast(bf16x8, ((u32x4){Pk[Tj][2].x, Pk[Tj][2].y, Pk[Tj][3].x, Pk[Tj][3].y}));
#pragma unroll
        for (int Te = 0; Te < 4; ++Te) { f32x4 acc = (f32x4){0.f, 0.f, 0.f, 0.f}; acc = MF16(Vt[Te][0], p0, acc); if (Tj >= 2) acc = MF16(Vt[Te][1], p1, acc);
            acc = MF16(Ct[Te][0], Qf[Tj][0], acc); acc = MF16(Ct[Te][1], Qf[Tj][1], acc); O[Te] = acc; }
        stage_rows(O, Tj, dinv[Tj], Tl, PL, lane); asm volatile("" ::: "memory"); __builtin_amdgcn_sched_barrier(0); }
    asm volatile("" ::: "memory"); __builtin_amdgcn_sched_barrier(0);
    final_store<0>(Tl, PL, P.mg, P.proj + (size_t)row0 * PJ + C_MO + h * 64, (bf16_t*)((unsigned char*)P.ycat + (size_t)row0 * DM + h * 64), lane);
}
__device__ __forceinline__ void gla_out_w(const RecP& P, const GWf& W, LAS unsigned char* wl, int ci, int lane) {
    const int r = lane & 15, q = lane >> 4; constexpr int PL = 72;
    const int bh = ci >> 6, c = ci & 63, b = bh >> 2, h = bh & 3, row0 = b * SEQ + c * 64;
    const bf16_t* Xq = P.proj + (size_t)row0 * PJ + C_GQ + h * 64; const bf16_t* Xk = P.proj + (size_t)row0 * PJ + C_GK + h * 64; const bf16_t* Xv = P.proj + (size_t)row0 * PJ + C_GV + h * 64;
    LAS bf16_t* Tl = (LAS bf16_t*)wl;
    { float bend[4]; gla_gate_tile<0>(Tl, PL, bend, W, P.tail + (size_t)row0 * 32, lane); }
    asm volatile("" ::: "memory"); __builtin_amdgcn_sched_barrier(0);
    bf16x8 Kf[4][2], Qf[4][2];
#pragma unroll
    for (int T = 0; T < 4; ++T)
#pragma unroll
        for (int ks = 0; ks < 2; ++ks) { const bf16x8 ef = *(const LAS bf16x8*)(Tl + (16 * T + r) * PL + 32 * ks + 8 * q); Qf[T][ks] = frag_mul(rfg(Xq, PJ, T, ks, lane), ef, false); Kf[T][ks] = frag_mul(rfg(Xk, PJ, T, ks, lane), ef, true); }
    asm volatile("" ::: "memory"); __builtin_amdgcn_sched_barrier(0);
    { u32x4 tv_[8];
#pragma unroll
      for (int i = 0; i < 8; ++i) tv_[i] = piece(Xv, PJ, i, lane);
      __builtin_amdgcn_sched_barrier(0);
#pragma unroll
      for (int i = 0; i < 8; ++i) *(LAS u32x4*)(Tl + ((lane >> 3) + 8 * i) * PL + (lane & 7) * 8) = tv_[i]; }
    asm volatile("" ::: "memory"); __builtin_amdgcn_sched_barrier(0);
    u32x2 Pk[4][4];
#pragma unroll
    for (int Tj = 0; Tj < 4; ++Tj)
#pragma unroll
        for (int Tl_ = 0; Tl_ < 4; ++Tl_) {
            if (Tl_ <= Tj) { f32x4 acc = (f32x4){0.f, 0.f, 0.f, 0.f}; acc = MF16(Kf[Tl_][0], Qf[Tj][0], acc); acc = MF16(Kf[Tl_][1], Qf[Tj][1], acc); float sv[4];
#pragma unroll
                for (int rg = 0; rg < 4; ++rg) { const bool ok = (Tl_ < Tj) || (4 * q + rg <= r); sv[rg] = ok ? acc[rg] : 0.f; }
                Pk[Tj][Tl_].x = pk2(sv[0], sv[1]); Pk[Tj][Tl_].y = pk2(sv[2], sv[3]); }
            else { Pk[Tj][Tl_].x = 0u; Pk[Tj][Tl_].y = 0u; } }
    const bf16_t* cs = P.csg + (size_t)ci * 4096;
    bf16x8 Vt[4][2], Ct[4][2];
#pragma unroll
    for (int Te = 0; Te < 4; ++Te)
#pragma unroll
        for (int s = 0; s < 2; ++s) { Vt[Te][s] = trfrag(Tl, PL, s, 16 * Te, lane); Ct[Te][s] = rfg(cs, 64, Te, s, lane); }
    asm volatile("" ::: "memory"); __builtin_amdgcn_sched_barrier(0);
#pragma unroll
    for (int Tj = 0; Tj < 4; ++Tj) { f32x4 O[4];
        const bf16x8 p0 = __builtin_bit_cast(bf16x8, ((u32x4){Pk[Tj][0].x, Pk[Tj][0].y, Pk[Tj][1].x, Pk[Tj][1].y})), p1 = __builtin_bit_cast(bf16x8, ((u32x4){Pk[Tj][2].x, Pk[Tj][2].y, Pk[Tj][3].x, Pk[Tj][3].y}));
#pragma unroll
        for (int Te = 0; Te < 4; ++Te) { f32x4 acc = (f32x4){0.f, 0.f, 0.f, 0.f}; acc = MF16(Vt[Te][0], p0, acc); if (Tj >= 2) acc = MF16(Vt[Te][1], p1, acc);
            acc = MF16(Ct[Te][0], Qf[Tj][0], acc); acc = MF16(Ct[Te][1], Qf[Tj][1], acc); O[Te] = acc; }
        stage_rows(O, Tj, 1.f, Tl, PL, lane); asm volatile("" ::: "memory"); __builtin_amdgcn_sched_barrier(0); }
    asm volatile("" ::: "memory"); __builtin_amdgcn_sched_barrier(0);
    final_store<1>(Tl, PL, P.gg, P.proj + (size_t)row0 * PJ + C_GR + h * 64, (bf16_t*)((unsigned char*)P.ycat + (size_t)row0 * DM + 768 + h * 64), lane);
}
#undef MF16
}


constexpr int N_PHASES = 2 + 9 * DEPTH;
__global__ void __launch_bounds__(512, 2) mega_fwd(Args args) {
    extern __shared__ __attribute__((aligned(16))) unsigned char lds_raw[];
    Frame F;
    F.lds = (LAS unsigned char*)lds_raw;
    F.MISC = (volatile LAS unsigned*)(F.lds + MISC_OFF);
    F.tid = threadIdx.x; F.lane = F.tid & 63; F.wave = __builtin_amdgcn_readfirstlane(F.tid >> 6);
    F.G = gridDim.x; { const int bx = blockIdx.x; F.vcu = (F.G % 8 == 0) ? (bx % 8) * (F.G / 8) + bx / 8 : bx; }
    typedef const __attribute__((address_space(4))) Args* CArgs;
    const CArgs ap0 = (CArgs)__builtin_amdgcn_kernarg_segment_ptr();
    F.ctl = (gu32*)(args.ws + WS_CTL);
    for (int u = F.tid; u < (LDS_BYTES - LDSCTL_OFF) / 4; u += 512) ((LAS unsigned*)(F.lds + LDSCTL_OFF))[u] = 0u;
    __syncthreads();
#if MK_ONE_LAUNCH
    XcdBarrier bar = xcd_barrier_post((unsigned*)(F.ctl + CW_BAR), F.MISC + 8, F.tid == 0);
#define GRID_BAR() xcd_barrier(bar, F.wave == 0 && lane_id_() == 0)
#else
#define GRID_BAR() do {} while (0)
#endif
    const int lo = args.ph_lo, hi = args.ph_hi;
#define IN(k) (lo <= (k) && (k) < hi)
#define SEAM(k) do { if (IN(k) && IN((k) + 1)) { GRID_BAR(); if (NREP(15) == 2) GRID_BAR(); } } while (0)
    const int NGW = F.G * 8;
#define PHASE_IDS() int tid = mk_tid(F.wave); asm volatile("" : "+v"(tid)); const int lane = tid & 63, wid = __builtin_amdgcn_readfirstlane(tid >> 6); const int gw = F.vcu * 8 + wid; (void)lane; (void)gw; \
    CArgs ap = ap0; asm volatile("" : "+s"(ap)); unsigned char* ws = ap->ws; (void)ws
#define AIN(i) (ap->in[i])
#define MOD ((float*)(ws + WS_MOD))
#define ROPE ((float*)(ws + WS_ROPE))
#define WIN ((bf16_t*)(ws + WS_WIN))
#define WOUT ((bf16_t*)(ws + WS_WOUT))
#define WGU8 ((unsigned char*)(ws + WS_WGU))
#define WD8 ((unsigned char*)(ws + WS_WD))
#define U8B ((unsigned char*)(ws + WS_U8))
#define WIN8 ((unsigned char*)(ws + WS_WIN8))
#define H8B ((unsigned char*)(ws + WS_PROJ))
#define LTOK ((int*)(ws + WS_LTOK))
#define LGATE ((float*)(ws + WS_LGATE))
#define PROJ ((bf16_t*)(ws + WS_PROJ))
#define HB ((bf16_t*)(ws + WS_PROJ))
#define XB ((bf16_t*)(ws + WS_XR))
#define YSORT ((bf16_t*)(ws + WS_YSORT))
#define TAILB ((float*)(ws + WS_TAIL))
#define TOKSLOT ((int*)(ws + WS_SM + SM_TS))
#define UB ((bf16_t*)(ws + WS_U))
#define YCAT ((bf16_t*)(ws + WS_YCAT))
#define STM ((float*)(ws + WS_U))
#define STG ((float*)(ws + WS_U + 32 * MiB))
#define CSM ((bf16_t*)(ws + WS_XR + 64 * MiB))
#define CSG ((bf16_t*)(ws + WS_XR + 80 * MiB))
#define G_smN ((float*)(ws + WS_SM + SM_N))
#define G_smBC ((float*)(ws + WS_SM + SM_BC))
#define G_smDM ((float*)(ws + WS_SM + SM_DM))
#define G_smMS ((float*)(ws + WS_SM + SM_MS))
#define G_smGBE ((float*)(ws + WS_SM + SM_GBE))
#define x_in AIN(I_X)

    if (IN(0) && PHON(0)) for (int rp0 = 0; rp0 < NREP(0); ++rp0) {
        PHASE_IDS();
        {
            LAS float* cact = (LAS float*)F.lds;
            LAS float* part = (LAS float*)(F.lds + 32768);
            const float* cc = AIN(I_C);
            for (int i = tid; i < NB * DM; i += 512) { const int b = i >> 10, k = i & 1023; const float v = cc[i]; cact[k * 8 + b] = v / (1.f + fexp(-v)); }
            __syncthreads();
            for (int it = F.vcu; it < DEPTH * 96; it += F.G) {
                const int l = it / 96, j0 = (it % 96) * 64;
                const float* W = AIN(I_WADA) + (size_t)l * DM * 6144 + j0 + lane;
                float a[8] = {0.f, 0.f, 0.f, 0.f, 0.f, 0.f, 0.f, 0.f};
#pragma unroll 32
                for (int kk = 0; kk < 128; ++kk) { const int k = wid * 128 + kk; const float w = W[(size_t)k * 6144];
                    const f32x4 c0 = *(const LAS f32x4*)(cact + k * 8), c1 = *(const LAS f32x4*)(cact + k * 8 + 4);
                    a[0] += c0[0] * w; a[1] += c0[1] * w; a[2] += c0[2] * w; a[3] += c0[3] * w; a[4] += c1[0] * w; a[5] += c1[1] * w; a[6] += c1[2] * w; a[7] += c1[3] * w; }
#pragma unroll
                for (int b = 0; b < 8; ++b) part[(wid * 8 + b) * 64 + lane] = a[b];
                __syncthreads();
                { const int b = tid >> 6, j = tid & 63; float s = AIN(I_BADA)[(size_t)l * 6144 + j0 + j];
#pragma unroll
                  for (int w = 0; w < 8; ++w) s += part[(w * 8 + b) * 64 + j];
                  MOD[((size_t)l * NB + b) * 6144 + j0 + j] = s; }
                __syncthreads();
            }
        }
        {
            const int* pos = (const int*)AIN(I_POS);
            for (int i = blockIdx.x * 512 + tid; i < NTOK * 4; i += F.G * 512) { const int row = i >> 2, f = i & 3;
                const float invf = (float)pow(500000.0, -0.25 * (double)f); const float ang = (float)pos[row] * invf;
                ROPE[(size_t)row * 8 + f] = (float)cos((double)ang); ROPE[(size_t)row * 8 + 4 + f] = (float)sin((double)ang); }
        }
        {
            LAS float* scr = (LAS float*)(F.lds + 49152 + wid * 8704);
            constexpr int I_IN = (DM / 64) * (PW / 32), I_OUT = (DM / 64) * (DM / 32);
            auto dec0 = [&](int it, TrD& d) { const int l = it / (I_IN + I_OUT); int r = it % (I_IN + I_OUT);
                if (r < I_IN) { const int kb = r / (PW / 32), nb = r % (PW / 32); const int nbe = (nb < 112) ? nb : 0; const int tl = nbe >> 3;
                    d.wsc = (tl == 0 || tl == 10) ? 0.125f : (tl == 7) ? ATT_C2 : 1.f;
                    d.src = AIN(I_WIN) + (size_t)l * DM * PIN + (size_t)(kb * 64) * PIN + win_src_col(nbe * 32); d.ldw = PIN; d.K = DM; d.dst = WIN + (size_t)l * PW * DM; d.dst8 = WIN8 + (size_t)l * PP * DM; d.drow0 = nbe * 32; d.k0 = kb * 64;
                    return nb < 112; }
                r -= I_IN; const int kb = r / (DM / 32), nb = r % (DM / 32); d.wsc = 1.f;
                d.src = AIN(I_WOUT) + (size_t)l * DM * DM + (size_t)(kb * 64) * DM + nb * 32; d.wsc = W8S; d.dst8 = nullptr; d.ldw = DM; d.K = DM; d.dst = (bf16_t*)((unsigned char*)WOUT + (size_t)l * DM * DM); d.drow0 = nb * 32; d.k0 = kb * 64; return true; };
            { TrD dc, dn; f32x4 vc[8], vn[8]; int it = gw; bool okc = dec0(it, dc); tr_load4(dc, vc, lane); dn = dc; bool okn = okc;
#pragma unroll
              for (int i = 0; i < 8; ++i) vn[i] = vc[i];
              for (; it < DEPTH * (I_IN + I_OUT); it += NGW) { const int itn = it + NGW;
                  if (itn < DEPTH * (I_IN + I_OUT)) { okn = dec0(itn, dn); tr_load4(dn, vn, lane); }
                  if (okc) { if (dc.ldw == DM) tr_finish8(dc, vc, scr, lane); else { TrD d8 = dc; d8.dst = (bf16_t*)dc.dst8; d8.wsc = dc.wsc * W8S; tr_finish8(d8, vc, scr, lane); } }
                  dc = dn; okc = okn;
#pragma unroll
                  for (int i = 0; i < 8; ++i) vc[i] = vn[i]; } }
            for (int it = gw; it < DEPTH * (DM / 64) * 8; it += NGW) { const int l = it / ((DM / 64) * 8), r = it % ((DM / 64) * 8), kb = r >> 3, nb = 112 + (r & 7);
                tr_item(AIN(I_WIN) + (size_t)l * DM * PIN, PIN, DM, WIN + (size_t)l * PW * DM, nb * 32, win_src_col(nb * 32 + (lane & 31)), kb * 64, scr, lane); }
        }
    }
    SEAM(0);
    if (IN(1) && PHON(1)) {
        PHASE_IDS();
        NarrowT NT_; nmm_load_tail(NT_, WIN + (size_t)PP * DM, wid, lane);
        LAS bf16_t* Sst = (LAS bf16_t*)F.lds; LAS float* Pb = (LAS float*)(F.lds + NMM_P_OFF);
        const int b = F.vcu >> 5; const float* md = MOD + (size_t)b * 6144;
        f32x4 sh[4], sc[4];
#pragma unroll
        for (int j = 0; j < 4; ++j) { sh[j] = *(const f32x4*)(md + 4 * lane + 256 * j); sc[j] = *(const f32x4*)(md + 1024 + 4 * lane + 256 * j) + 1.0f; }
        const int rowb = F.vcu * 128 + wid * 16;
        for (int i = 0; i < 16; i += 4) { f32x4 v[4][4];
#pragma unroll
            for (int rr = 0; rr < 4; ++rr)
#pragma unroll
                for (int j = 0; j < 4; ++j) v[rr][j] = *(const f32x4*)(x_in + (size_t)(rowb + i + rr) * DM + 4 * lane + 256 * j);
#pragma unroll
            for (int rr = 0; rr < 4; ++rr)
#pragma unroll
                for (int j = 0; j < 4; ++j) { const f32x4 u = v[rr][j] * sc[j] + sh[j];
                    u32x2 w; w.x = pk2(u[0], u[1]); w.y = pk2(u[2], u[3]); *(LAS u32x2*)(Sst + (wid * 4 + rr) * NSP + 4 * lane + 256 * j) = w;
                    *(unsigned*)(U8B + (size_t)(rowb + i + rr) * DM + 4 * lane + 256 * j) = pk4_fp8(u[0], u[1], u[2], u[3]); }
            nmm_step_tail(NT_, Sst, Pb, TAILB + (size_t)(F.vcu * 128) * 32, i, tid, wid, lane); }
    }
    SEAM(1);

    for (int l = 0; l < DEPTH; ++l) {
        const int pb = 2 + 9 * l;
#define modl (MOD + (size_t)l * NB * 6144)
#define MAKE_RP() rec::RecP RP; RP.proj = PROJ; RP.tail = TAILB; RP.csm = CSM; RP.csg = CSG; RP.stm = STM; RP.stg = STG; RP.smN = G_smN; RP.smBC = G_smBC; RP.smDM = G_smDM; RP.smMS = G_smMS; RP.smGBE = G_smGBE; RP.ycat = YCAT; \
        RP.mbi = AIN(I_MBI) + l * 4; RP.mbf = AIN(I_MBF) + l * 4; RP.mg = AIN(I_MG) + l * 64; RP.wa2 = AIN(I_WA2) + (size_t)l * 16 * 256; RP.ba = AIN(I_BA) + l * 256; RP.gg = AIN(I_GG) + l * 64;
        if (IN(pb + 0) && PHON(2)) {
            PHASE_IDS(); (void)tid;
            { gm::K1<true> k; k.S.init(NTOK, PP, F.G, (int)blockIdx.x); k.A = U8B; k.Bt = WIN8 + (size_t)l * PP * DM; k.O = PROJ; k.rope = ROPE;
                gm::gemm_phase<gm::K1<true>>(F.lds, k, F.wave); }
        }
        SEAM(pb + 0);
        if (IN(pb + 1) && PHON(3)) {
            PHASE_IDS();
            MAKE_RP();
            for (int rp = 0; rp < NREP(3); ++rp) {
                LAS unsigned char* wl = F.lds + wid * 16384;
                recw::GWf gwf; recw::ld_gwf(gwf, RP, (gw >> 6) & 3, lane);
                for (int ci = gw; ci < 2048; ci += NGW) { int lane_ = lane; asm volatile("" : "+v"(lane_)); if (PHON(13)) recw::mlstm_local_w(RP, wl, ci, lane_); asm volatile("" ::: "memory"); __builtin_amdgcn_sched_barrier(0); if (PHON(14)) recw::gla_local_w(RP, gwf, wl, ci, lane_); }
            }
        }
        SEAM(pb + 1);
        if (IN(pb + 2) && PHON(4)) {
            PHASE_IDS();
            const int gt = blockIdx.x * 512 + tid, NGT = F.G * 512;
            for (int task = gt; task < 65536 + 2048; task += NGT) {
                if (task < 32768) {
                    const int bh = task >> 10, el = (task & 1023) * 4; const bf16_t* p = (const bf16_t*)STM + (size_t)bh * 64 * 4096 + el; bf16_t* o = CSM + (size_t)bh * 64 * 4096 + el;
                    const float bcv = G_smBC[bh * 64 + lane], dmv = G_smDM[bh * 64 + lane];
                    f32x4 C = (f32x4){0.f, 0.f, 0.f, 0.f}; float m = 0.f;
#pragma unroll 16
                    for (int c = 0; c < NCH; ++c) { const u32x2 uw = *(const u32x2*)(p + (size_t)c * 4096); const f32x4 u = (f32x4){bflo(uw.x), bfhi(uw.x), bflo(uw.y), bfhi(uw.y)}; u32x2 w; w.x = pk2(C[0], C[1]); w.y = pk2(C[2], C[3]); *(u32x2*)(o + (size_t)c * 4096) = w;
                        if (el == 0) G_smMS[bh * 64 + c] = m;
                        const float B = __builtin_bit_cast(float, __builtin_amdgcn_readlane(__builtin_bit_cast(int, bcv), c)), Dm = __builtin_bit_cast(float, __builtin_amdgcn_readlane(__builtin_bit_cast(int, dmv), c)), mn = fmaxf(B + m, Dm); C = C * fexp(B + m - mn) + u * fexp(Dm - mn); m = mn; }
                } else if (task < 65536) {
                    const int t2 = task - 32768, bh = t2 >> 10, el = (t2 & 1023) * 4, d = el & 63; const bf16_t* p = (const bf16_t*)STG + (size_t)bh * 64 * 4096 + el; bf16_t* o = CSG + (size_t)bh * 64 * 4096 + el;
                    const float* be = G_smGBE + (size_t)bh * 64 * 64 + d;
                    f32x4 S = (f32x4){0.f, 0.f, 0.f, 0.f};
#pragma unroll 16
                    for (int c = 0; c < NCH; ++c) { const u32x2 uw = *(const u32x2*)(p + (size_t)c * 4096); const f32x4 u = (f32x4){bflo(uw.x), bfhi(uw.x), bflo(uw.y), bfhi(uw.y)}; const f32x4 b4 = *(const f32x4*)(be + c * 64);
                        u32x2 w; w.x = pk2(S[0], S[1]); w.y = pk2(S[2], S[3]); *(u32x2*)(o + (size_t)c * 4096) = w;
                        S = (f32x4){fexp(b4[0]) * S[0] + u[0], fexp(b4[1]) * S[1] + u[1], fexp(b4[2]) * S[2] + u[2], fexp(b4[3]) * S[3] + u[3]}; }
                } else {
                    const int t3 = task - 65536, bh = t3 >> 6, el = t3 & 63; float* p = G_smN + (size_t)bh * 64 * 64 + el;
                    const float bcv = G_smBC[bh * 64 + lane], dmv = G_smDM[bh * 64 + lane];
                    float C = 0.f, m = 0.f;
#pragma unroll 16
                    for (int c = 0; c < NCH; ++c) { const float u = p[c * 64]; p[c * 64] = C;
                        const float B = __builtin_bit_cast(float, __builtin_amdgcn_readlane(__builtin_bit_cast(int, bcv), c)), Dm = __builtin_bit_cast(float, __builtin_amdgcn_readlane(__builtin_bit_cast(int, dmv), c)), mn = fmaxf(B + m, Dm); C = C * fexp(B + m - mn) + u * fexp(Dm - mn); m = mn; }
                }
            }
            for (int rp = 0; rp < NREP(13); ++rp) {
                LAS float* scr = (LAS float*)(F.lds + 49152 + wid * 8704);
                constexpr int I_G = (DM / 64) * (1024 / 32), I_D = (DE / 64) * (DM / 32);
                auto dece = [&](int it, TrD& d) { const int e = it / (I_G + I_D); int r = it % (I_G + I_D); d.wsc = W8S; d.dst8 = nullptr;
                    if (r < I_G) { const int kb = r / 32, nb = r % 32, n0 = nb * 32, tt = n0 >> 8, rr = n0 & 255;
                        d.src = (rr < 128 ? AIN(I_EWG) : AIN(I_EWU)) + ((size_t)l * NE + e) * DM * DE + (size_t)(kb * 64) * DE + tt * 128 + (rr & 127); d.ldw = DE; d.K = DM; d.dst = (bf16_t*)(WGU8 + (size_t)e * 1024 * 1024); d.drow0 = n0; d.k0 = kb * 64; }
                    else { r -= I_G; const int kb = r / 32, nb = r % 32;
                        d.src = AIN(I_EWD) + ((size_t)l * NE + e) * DE * DM + (size_t)(kb * 64) * DM + nb * 32; d.ldw = DM; d.K = DE; d.dst = (bf16_t*)(WD8 + (size_t)e * 1024 * 512); d.drow0 = nb * 32; d.k0 = kb * 64; } };
                TrD dc, dn; f32x4 vc[8], vn[8]; int it = gw; dece(it, dc); tr_load4(dc, vc, lane); dn = dc;
#pragma unroll
                for (int i = 0; i < 8; ++i) vn[i] = vc[i];
                for (; it < NE * (I_G + I_D); it += NGW) { const int itn = it + NGW;
                    if (itn < NE * (I_G + I_D)) { dece(itn, dn); tr_load4(dn, vn, lane); }
                    tr_finish8(dc, vc, scr, lane);
                    dc = dn;
#pragma unroll
                    for (int i = 0; i < 8; ++i) vc[i] = vn[i]; }
            }
        }
        SEAM(pb + 2);
        if (IN(pb + 3) && PHON(5)) {
            PHASE_IDS();
            if (PHON(10)) {
                float d1 = 0.f, d2 = 0.f;
                for (int i = 0; i < 32; ++i) { d1 += AIN(I_LQ1)[l * 32 + i] * AIN(I_LK1)[l * 32 + i]; d2 += AIN(I_LQ2)[l * 32 + i] * AIN(I_LK2)[l * 32 + i]; }
                const float lam_init = 0.8f - 0.6f * expf(-0.3f * (float)l);
                attn_body::AttnParams AP; AP.Q = (const attn_body::bf16*)(PROJ + C_DQ); AP.K = (const attn_body::bf16*)(PROJ + C_DK); AP.V = (const attn_body::bf16*)(PROJ + C_DV);
                AP.zpage = (const attn_body::bf16*)(F.ctl + CW_ZPAGE); AP.Y = (bf16_t*)((unsigned char*)YCAT + 512); AP.gnorm = AIN(I_DG) + l * 64; AP.lam = expf(d1) - expf(d2) + lam_init; AP.osc = 1.f - lam_init;
                const int bh = F.vcu >> 3, s = F.vcu & 7;
                if (F.G == 256) {
                    for (int rp = 0; rp < NREP(10); ++rp)
                    for (int i = 0; i < 2; ++i) { const int qb = (i == 0) ? s : 15 - s;
                        attn_body::attn_unit<8, 0>(bh >> 2, bh & 3, qb, AP, (char*)lds_raw, F.wave); attn_body::attn_unit<8, 1>(bh >> 2, bh & 3, qb, AP, (char*)lds_raw, F.wave); }
                }
            }
            __syncthreads();
            {
            PHASE_IDS();
            MAKE_RP();
            if (PHON(11)) for (int rp = 0; rp < NREP(11); ++rp) {
                LAS unsigned char* wl = F.lds + wid * 16384;
                LAS u32x4* gst = (LAS u32x4*)(wl + 10240);
                { recw::GWf gwf; recw::ld_gwf(gwf, RP, (gw >> 6) & 3, lane);
#pragma unroll
                  for (int Td = 0; Td < 4; ++Td) gst[Td * 64 + lane] = __builtin_bit_cast(u32x4, gwf.Bw[Td]);
                  gst[256 + lane] = __builtin_bit_cast(u32x4, ((f32x4){gwf.ba[0], gwf.ba[1], gwf.ba[2], gwf.ba[3]})); }
                for (int ci = gw; ci < 2048; ci += NGW) { int lane_ = lane; asm volatile("" : "+v"(lane_)); if (PHON(13)) recw::mlstm_out_w(RP, wl, ci, lane_); asm volatile("" ::: "memory"); __builtin_amdgcn_sched_barrier(0);
                    if (PHON(14)) { recw::GWf gwf;
#pragma unroll
                        for (int Td = 0; Td < 4; ++Td) gwf.Bw[Td] = __builtin_bit_cast(bf16x8, gst[Td * 64 + lane_]);
                        const f32x4 bb = __builtin_bit_cast(f32x4, gst[256 + lane_]); gwf.ba[0] = bb[0]; gwf.ba[1] = bb[1]; gwf.ba[2] = bb[2]; gwf.ba[3] = bb[3];
                        recw::gla_out_w(RP, gwf, wl, ci, lane_); } }
            }
            __syncthreads();
            if (PHON(12)) for (int rp = 0; rp < NREP(12); ++rp) {
                const float* cw = AIN(I_CONVW) + (size_t)l * 3 * 256; const float* cbias = AIN(I_CONVB) + l * 256;
                for (int it = F.vcu; it < NTOK / 64; it += F.G) {
                    for (int p = tid; p < 64 * 32; p += 512) { const int r = p >> 5, chn = p & 31, row = it * 64 + r, t = row & (SEQ - 1);
                        const bf16_t* pr = PROJ + (size_t)row * PJ + chn * 8;
                        float s0[8], s1[8], s2[8], cbv[8];
                        { float a[8], bq[8]; rec::unpack8(*(const u32x4*)(pr + C_CC), a); rec::unpack8(*(const u32x4*)(pr + C_CH), bq);
#pragma unroll
                          for (int i = 0; i < 8; ++i) s2[i] = a[i] * bq[i]; }
                        if (t >= 1) { float a[8], bq[8]; rec::unpack8(*(const u32x4*)(pr - PJ + C_CC), a); rec::unpack8(*(const u32x4*)(pr - PJ + C_CH), bq);
#pragma unroll
                          for (int i = 0; i < 8; ++i) s1[i] = a[i] * bq[i]; } else {
#pragma unroll
                          for (int i = 0; i < 8; ++i) s1[i] = 0.f; }
                        if (t >= 2) { float a[8], bq[8]; rec::unpack8(*(const u32x4*)(pr - 2 * PJ + C_CC), a); rec::unpack8(*(const u32x4*)(pr - 2 * PJ + C_CH), bq);
#pragma unroll
                          for (int i = 0; i < 8; ++i) s0[i] = a[i] * bq[i]; } else {
#pragma unroll
                          for (int i = 0; i < 8; ++i) s0[i] = 0.f; }
                        rec::unpack8(*(const u32x4*)(pr + C_CB), cbv);
                        float y[8];
#pragma unroll
                        for (int i = 0; i < 8; ++i) { const int cch = chn * 8 + i; y[i] = cbv[i] * (cw[cch] * s0[i] + cw[256 + cch] * s1[i] + cw[512 + cch] * s2[i] + cbias[cch]); }
                        u32x2 w; w.x = pk4_fp8(y[0] * Y8S, y[1] * Y8S, y[2] * Y8S, y[3] * Y8S); w.y = pk4_fp8(y[4] * Y8S, y[5] * Y8S, y[6] * Y8S, y[7] * Y8S);
                        *(u32x2*)((unsigned char*)YCAT + (size_t)row * DM + 256 + chn * 8) = w; }
                }
            }
            }
        }
        SEAM(pb + 3);
        if (IN(pb + 4) && PHON(6)) {
            PHASE_IDS(); (void)tid;
            gm::K2 k; k.S.init(NTOK, DM, F.G, (int)blockIdx.x); k.A = (const unsigned char*)YCAT; k.Bt = (const unsigned char*)WOUT + (size_t)l * DM * DM; k.O = UB;
            for (int rp = 0; rp < NREP(6); ++rp) gm::gemm_phase<gm::K2>(F.lds, k, F.wave);
        }
        SEAM(pb + 4);
        if (IN(pb + 5) && PHON(7)) {
            PHASE_IDS();
            NarrowT NT_; nmm_load_router(NT_, AIN(I_RW), wid, lane);
            LAS bf16_t* Sst = (LAS bf16_t*)F.lds; LAS float* Pb = (LAS float*)(F.lds + NMM_P_OFF); LAS float* lgs_all = (LAS float*)(F.lds + NMM_LG_OFF);
            LAS float* lgs = lgs_all + wid * 256;
            LAS int* wcnt = (LAS int*)(F.lds + NMM_LG_OFF + 8192); LAS int* wbase = wcnt + 32;
            if (tid < 32) wcnt[tid] = 0;
            const int b = F.vcu >> 5; const float* md = modl + (size_t)b * 6144;
            const float* lg = AIN(I_LN1G) + l * DM; const float* lb = AIN(I_LN1B) + l * DM;
            f32x4 gv[4], bv[4], sh[4], sc[4], g1[4];
#pragma unroll
            for (int j = 0; j < 4; ++j) { const int cix = 4 * lane + 256 * j; gv[j] = *(const f32x4*)(lg + cix); bv[j] = *(const f32x4*)(lb + cix); g1[j] = *(const f32x4*)(md + 2 * 1024 + cix) + 1.0f;
                sh[j] = *(const f32x4*)(md + 3 * 1024 + cix); sc[j] = *(const f32x4*)(md + 4 * 1024 + cix) + 1.0f; }
            const int rowb = F.vcu * 128 + wid * 16;
            u32x2 xwc[4], ywc[4];
#pragma unroll
            for (int j = 0; j < 4; ++j) { const size_t o = (size_t)rowb * DM + 4 * lane + 256 * j; xwc[j] = (l == 0) ? (u32x2){0u, 0u} : *(const u32x2*)(XB + o); ywc[j] = *(const u32x2*)(UB + o); }
            u32x2 xwn[4] = {xwc[0], xwc[1], xwc[2], xwc[3]}, ywn[4] = {ywc[0], ywc[1], ywc[2], ywc[3]};
            for (int i = 0; i < 16; ++i) { const int row = rowb + i;
                if (i < 15) {
#pragma unroll
                    for (int j = 0; j < 4; ++j) { const size_t o = (size_t)(row + 1) * DM + 4 * lane + 256 * j; if (l != 0) xwn[j] = *(const u32x2*)(XB + o); ywn[j] = *(const u32x2*)(UB + o); } }
                f32x4 v[4]; float s = 0.f;
#pragma unroll
                for (int j = 0; j < 4; ++j) { const size_t o = (size_t)row * DM + 4 * lane + 256 * j;
                    f32x4 xv; if (l == 0) xv = *(const f32x4*)(x_in + o); else { const u32x2 xw = xwc[j]; xv = (f32x4){bflo(xw.x), bfhi(xw.x), bflo(xw.y), bfhi(xw.y)}; }
                    const u32x2 yw = ywc[j]; const f32x4 yv = (f32x4){bflo(yw.x), bfhi(yw.x), bflo(yw.y), bfhi(yw.y)};
                    v[j] = xv * ALPHA + g1[j] * yv; s += (v[j][0] + v[j][1]) + (v[j][2] + v[j][3]); }
#pragma unroll
                for (int j = 0; j < 4; ++j) { xwc[j] = xwn[j]; ywc[j] = ywn[j]; }
                const float mean = wave_sum(s) * (1.f / DM); float s2 = 0.f;
#pragma unroll
                for (int j = 0; j < 4; ++j) { v[j] = v[j] - mean; s2 += (v[j][0] * v[j][0] + v[j][1] * v[j][1]) + (v[j][2] * v[j][2] + v[j][3] * v[j][3]); }
                const float rstd = __builtin_amdgcn_rsqf(wave_sum(s2) * (1.f / DM) + LN_EPS);
#pragma unroll
                for (int j = 0; j < 4; ++j) { const size_t o = (size_t)row * DM + 4 * lane + 256 * j; const f32x4 xn = v[j] * rstd * gv[j] + bv[j];
                    u32x2 xw; xw.x = pk2(xn[0], xn[1]); xw.y = pk2(xn[2], xn[3]); *(u32x2*)(XB + o) = xw;
                    const f32x4 u = xn * sc[j] + sh[j]; u32x2 w; w.x = pk2(u[0], u[1]); w.y = pk2(u[2], u[3]); *(LAS u32x2*)(Sst + (wid * 4 + (i & 3)) * NSP + 4 * lane + 256 * j) = w;
                    *(unsigned*)(U8B + o) = pk4_fp8(u[0], u[1], u[2], u[3]); }
                if ((i & 3) == 3) nmm_step_router(NT_, Sst, Pb, lgs_all, i - 3, tid, wid, lane);
            }
            asm volatile("s_waitcnt lgkmcnt(0)\n\ts_barrier" ::: "memory");
            int bk_ = 0; unsigned lpos_ = 0u; float gi_ = 0.f, gj_ = 0.f;
            if (lane < 16) {
                const float* rb = AIN(I_RB);
                float sco[16], bia[16];
#pragma unroll
                for (int q = 0; q < 4; ++q) { const f32x4 t4 = *(const LAS f32x4*)(lgs + lane * 16 + q * 4);
#pragma unroll
                    for (int c = 0; c < 4; ++c) { const float sg = 1.f / (1.f + fexp(-t4[c])); sco[q * 4 + c] = sg; bia[q * 4 + c] = sg + rb[q * 4 + c]; } }
                int bg = 0; float bgs = -INFINITY;
#pragma unroll
                for (int g = 0; g < 4; ++g) { const float a0 = bia[4 * g], a1 = bia[4 * g + 1], a2 = bia[4 * g + 2], a3 = bia[4 * g + 3];
                    const float h1 = fmaxf(a0, a1), l1 = fminf(a0, a1), h2 = fmaxf(a2, a3), l2 = fminf(a2, a3);
                    const float top = fmaxf(h1, h2), sec = fmaxf(fminf(h1, h2), (h1 >= h2) ? l1 : l2); const float gsc = top + sec;
                    if (gsc > bgs) { bgs = gsc; bg = g; } }
                float gb[4], gsx[4];
#pragma unroll
                for (int q = 0; q < 4; ++q) { gb[q] = (bg == 0) ? bia[q] : (bg == 1) ? bia[4 + q] : (bg == 2) ? bia[8 + q] : bia[12 + q]; gsx[q] = (bg == 0) ? sco[q] : (bg == 1) ? sco[4 + q] : (bg == 2) ? sco[8 + q] : sco[12 + q]; }
                int e1 = 0; float m1 = gb[0];
#pragma unroll
                for (int q = 1; q < 4; ++q) if (gb[q] > m1) { m1 = gb[q]; e1 = q; }
                int e2 = -1; float m2 = -INFINITY;
#pragma unroll
                for (int q = 0; q < 4; ++q) if (q != e1 && gb[q] > m2) { m2 = gb[q]; e2 = q; }
                const int ei = e1 < e2 ? e1 : e2, ej = e1 < e2 ? e2 : e1;
                const float si = (ei == 0) ? gsx[0] : (ei == 1) ? gsx[1] : (ei == 2) ? gsx[2] : gsx[3], sj = (ej == 0) ? gsx[0] : (ej == 1) ? gsx[1] : (ej == 2) ? gsx[2] : gsx[3];
                const int pr_ = (ei == 0) ? ej - 1 : (ei == 1) ? ej + 1 : 5; const int bk = bg * 6 + pr_;
                bk_ = bk; lpos_ = (unsigned)__hip_atomic_fetch_add(wcnt + bk, 1, __ATOMIC_RELAXED, __HIP_MEMORY_SCOPE_WORKGROUP); const float inv = 1.f / (si + sj); gi_ = si * inv; gj_ = sj * inv;
            }
            asm volatile("s_waitcnt lgkmcnt(0)\n\ts_barrier" ::: "memory");
            if (tid < NBUCKET) { gu32* cntw = F.ctl + CW_CNT + (size_t)l * NBUCKET * 64; const int c = wcnt[tid]; wbase[tid] = (c > 0) ? (int)__hip_atomic_fetch_add(cntw + tid * 64, (unsigned)c, RLX_AGENT) : 0; }
            asm volatile("s_waitcnt vmcnt(0) lgkmcnt(0)\n\ts_barrier" ::: "memory");
            if (lane < 16) { const int row = rowb + lane; const unsigned pos = (unsigned)wbase[bk_] + lpos_;
                LTOK[(size_t)bk_ * LCAP + pos] = row; LGATE[((size_t)bk_ * LCAP + pos) * 2] = gi_; LGATE[((size_t)bk_ * LCAP + pos) * 2 + 1] = gj_;
                TOKSLOT[row] = (bk_ << 16) | (int)pos;
            }
            __syncthreads();
        }
        SEAM(pb + 5);
        if ((IN(pb + 6) || IN(pb + 7)) && PHON(8)) {
            PHASE_IDS();
            LAS int* tb = (LAS int*)(F.lds + MOE_TB_OFF);
            if (wid == 0) { gu32* cntw = F.ctl + CW_CNT + (size_t)l * NBUCKET * 64;
                const int c = (lane < NBUCKET) ? (int)__hip_atomic_load(cntw + lane * 64, RLX_AGENT) : 0; const int ntl = (c + 255) >> 8; int incl = ntl;
#pragma unroll
                for (int o = 1; o < 32; o <<= 1) { const int t_ = __shfl_up(incl, o); if (lane >= o) incl += t_; }
                if (lane < NBUCKET) { tb[lane] = c; tb[32 + lane] = incl - ntl; }
                if (lane == NBUCKET - 1) tb[32 + NBUCKET] = incl; }
            __syncthreads();
            if (IN(pb + 6)) {
                {
                    LAS float* gtab = (LAS float*)tb + 256; const int nt_ = tb[32 + NBUCKET]; const int half = tid >> 8, tl = tid & 255;
                    float gv_[3];
#pragma unroll
                    for (int j = 0; j < 3; ++j) { const int i = 2 * j + half; const int L = i * F.G + F.vcu; const bool ok = L < nt_ * 8; const int Lc = ok ? L : F.vcu;
                        const int rt = Lc >> 3; int kq = 0;
                        for (int q = 1; q < NBUCKET; ++q) kq = (tb[32 + q] <= rt) ? q : kq;
                        gv_[j] = (F.vcu < nt_ * 8) ? LGATE[((size_t)kq * LCAP + (size_t)(rt - tb[32 + kq]) * 256 + tl) * 2 + ((Lc & 7) >> 2)] : 0.f; }
#pragma unroll
                    for (int j = 0; j < 3; ++j) { const int i = 2 * j + half; if (i * F.G + F.vcu < nt_ * 8) gtab[i * 256 + tl] = gv_[j]; }
                    __syncthreads(); }
                gm::K4 k; k.U = U8B; k.Wgu = WGU8; k.H = H8B; k.ltok = LTOK; k.lgate = LGATE; k.tb = tb; k.G = F.G; k.vcu = F.vcu; k.rtc = F.ctl + CW_RT + (size_t)l * 160 * 64;
                for (int rp = 0; rp < NREP(8); ++rp) gm::gemm_phase<gm::K4>(F.lds, k, F.wave);
            }
            SEAM(pb + 6);
            if (IN(pb + 7)) {
                gm::K5 k; k.H = H8B; k.Wd = WD8; k.Y = YSORT; k.tb = tb; k.G = F.G; k.vcu = F.vcu; k.rtc = F.ctl + CW_RT + (size_t)l * 160 * 64; k.tmo = F.ctl + CW_TMO;
                for (int rp = 0; rp < NREP(14); ++rp) gm::gemm_phase<gm::K5>(F.lds, k, F.wave);
            }
        }
        SEAM(pb + 7);
        if (IN(pb + 8) && PHON(9)) {
            PHASE_IDS();
            const int b = F.vcu >> 5; const bool lastl = (l == DEPTH - 1);
            LAS bf16_t* Sst = (LAS bf16_t*)F.lds; LAS float* Pb = (LAS float*)(F.lds + NMM_P_OFF); LAS int* t0 = (LAS int*)(F.lds + MOE_TB_OFF);
            NarrowT NT_; nmm_load_tail(NT_, WIN + ((size_t)(lastl ? l : l + 1) * PW + PP) * DM, wid, lane);
            if (wid == 0) { gu32* cntw = F.ctl + CW_CNT + (size_t)l * NBUCKET * 64;
                const int c = (lane < NBUCKET) ? (int)__hip_atomic_load(cntw + lane * 64, RLX_AGENT) : 0; const int ntl = (c + 255) >> 8; int incl = ntl;
#pragma unroll
                for (int o = 1; o < 32; o <<= 1) { const int t_ = __shfl_up(incl, o); if (lane >= o) incl += t_; }
                if (lane < NBUCKET) t0[32 + lane] = incl - ntl; }
            __syncthreads();
            const float* mdn = MOD + ((size_t)(lastl ? l : l + 1) * NB + b) * 6144; const float* md = modl + (size_t)b * 6144;
            const float* lg = AIN(I_LN2G) + l * DM; const float* lb = AIN(I_LN2B) + l * DM;
            f32x4 gv[4], bv[4], sh[4], sc[4], g2[4];
#pragma unroll
            for (int j = 0; j < 4; ++j) { const int cix = 4 * lane + 256 * j; gv[j] = *(const f32x4*)(lg + cix); bv[j] = *(const f32x4*)(lb + cix); g2[j] = *(const f32x4*)(md + 5 * 1024 + cix) + 1.0f;
                sh[j] = *(const f32x4*)(mdn + cix); sc[j] = *(const f32x4*)(mdn + 1024 + cix) + 1.0f; }
            const int rowb = F.vcu * 128 + wid * 16;
            const int tsl = TOKSLOT[rowb + (lane & 15)];
            u32x2 xwc[4], ywc[4];
            { const int ts = __shfl(tsl, 0); const size_t yrow = (size_t)t0[32 + (ts >> 16)] * 256 + (ts & 0xffff);
#pragma unroll
              for (int j = 0; j < 4; ++j) { const int cix = 4 * lane + 256 * j; xwc[j] = *(const u32x2*)(XB + (size_t)rowb * DM + cix); ywc[j] = *(const u32x2*)(YSORT + yrow * DM + cix); } }
            u32x2 xwn[4] = {xwc[0], xwc[1], xwc[2], xwc[3]}, ywn[4] = {ywc[0], ywc[1], ywc[2], ywc[3]};
            for (int i = 0; i < 16; ++i) { const int row = rowb + i;
                if (i < 15) { const int ts = __shfl(tsl, i + 1); const size_t yrow = (size_t)t0[32 + (ts >> 16)] * 256 + (ts & 0xffff);
#pragma unroll
                    for (int j = 0; j < 4; ++j) { const int cix = 4 * lane + 256 * j; xwn[j] = *(const u32x2*)(XB + (size_t)(row + 1) * DM + cix); ywn[j] = *(const u32x2*)(YSORT + yrow * DM + cix); } }
                f32x4 v[4]; float s = 0.f;
#pragma unroll
                for (int j = 0; j < 4; ++j) {
                    const u32x2 xw = xwc[j]; const f32x4 xv = (f32x4){bflo(xw.x), bfhi(xw.x), bflo(xw.y), bfhi(xw.y)};
                    const u32x2 yw = ywc[j]; const f32x4 yv = (f32x4){bflo(yw.x), bfhi(yw.x), bflo(yw.y), bfhi(yw.y)};
                    v[j] = xv * ALPHA + g2[j] * yv; s += (v[j][0] + v[j][1]) + (v[j][2] + v[j][3]); }
#pragma unroll
                for (int j = 0; j < 4; ++j) { xwc[j] = xwn[j]; ywc[j] = ywn[j]; }
                const float mean = wave_sum(s) * (1.f / DM); float s2 = 0.f;
#pragma unroll
                for (int j = 0; j < 4; ++j) { v[j] = v[j] - mean; s2 += (v[j][0] * v[j][0] + v[j][1] * v[j][1]) + (v[j][2] * v[j][2] + v[j][3] * v[j][3]); }
                const float rstd = __builtin_amdgcn_rsqf(wave_sum(s2) * (1.f / DM) + LN_EPS);
#pragma unroll
                for (int j = 0; j < 4; ++j) { const size_t o = (size_t)row * DM + 4 * lane + 256 * j; const f32x4 xn = v[j] * rstd * gv[j] + bv[j];
                    if (lastl) *(f32x4*)(ap->out + o) = xn;
                    else { u32x2 xw; xw.x = pk2(xn[0], xn[1]); xw.y = pk2(xn[2], xn[3]); *(u32x2*)(XB + o) = xw;
                        const f32x4 u = xn * sc[j] + sh[j]; u32x2 w; w.x = pk2(u[0], u[1]); w.y = pk2(u[2], u[3]); *(LAS u32x2*)(Sst + (wid * 4 + (i & 3)) * NSP + 4 * lane + 256 * j) = w;
                        *(unsigned*)(U8B + o) = pk4_fp8(u[0], u[1], u[2], u[3]); } }
                if (!lastl && (i & 3) == 3) nmm_step_tail(NT_, Sst, Pb, TAILB + (size_t)(F.vcu * 128) * 32, i - 3, tid, wid, lane);
            }
        }
        SEAM(pb + 8);
    }
#undef IN
#undef SEAM
}

extern "C" void kernel_launch(void* const* d_in, const int* in_sizes, int n_in, void* d_out, int out_size, void* d_ws, size_t ws_size, hipStream_t stream) {
    static int grid = 0;
    if (grid == 0) {
        if (n_in != 29 || in_sizes[0] != NTOK * DM || out_size != NTOK * DM || ws_size < WS_END) {
            fprintf(stderr, "kernel_launch: unexpected shapes (n_in %d, in0 %d, out %d, ws %zu need %zu); nothing launched\n", n_in, n_in > 0 ? in_sizes[0] : -1, out_size, ws_size, (size_t)WS_END); grid = -1; return; }
        int dev = 0, cus = 0, per_cu = 0;
        if (hipGetDevice(&dev) != hipSuccess || hipDeviceGetAttribute(&cus, hipDeviceAttributeMultiprocessorCount, dev) != hipSuccess) { grid = -1; return; }
        if (hipFuncSetAttribute((const void*)mega_fwd, hipFuncAttributeMaxDynamicSharedMemorySize, LDS_BYTES) != hipSuccess) { fprintf(stderr, "kernel_launch: hipFuncSetAttribute failed\n"); grid = -1; return; }
        if (hipOccupancyMaxActiveBlocksPerMultiprocessor(&per_cu, (const void*)mega_fwd, 512, LDS_BYTES) != hipSuccess || per_cu < 1) { fprintf(stderr, "kernel_launch: occupancy query reports %d\n", per_cu); }
        (void)hipGetLastError();
        grid = cus;
        if (grid != 256) fprintf(stderr, "kernel_launch: %d CUs (row phases assume 256)\n", grid);
    }
    if (grid < 0) return;
    if (hipMemsetAsync((char*)d_ws + WS_CTL, 0, CTL_ZERO_BYTES, stream) != hipSuccess) return;
    Args a{};
    for (int i = 0; i < 29; ++i) a.in[i] = (const float*)d_in[i];
    a.out = (float*)d_out; a.ws = (unsigned char*)d_ws;
#if MK_ONE_LAUNCH
    a.ph_lo = 0; a.ph_hi = N_PHASES;
    hipLaunchKernelGGL(mega_fwd, dim3(grid), dim3(512), LDS_BYTES, stream, a);
#else
    for (int p = 0; p < N_PHASES; ++p) { a.ph_lo = p; a.ph_hi = p + 1; hipLaunchKernelGGL(mega_fwd, dim3(grid), dim3(512), LDS_BYTES, stream, a); }
#endif
}
```

```cpp
#include <hip/hip_runtime.h>
#include <hip/hip_bf16.h>
#include <cstdio>
#include <cstdint>
#include <cmath>

#ifndef MK_ONE_LAUNCH
#define MK_ONE_LAUNCH 1
#endif
#ifndef PHM
#define PHM 0xFFFF
#endif
#define PHON(n) (((PHM) >> (n)) & 1)
#ifndef REPM
#define REPM 0
#endif
#define NREP(n) ((((REPM) >> (n)) & 1) ? 2 : 1)

#define LAS __attribute__((address_space(3)))
#define GAS __attribute__((address_space(1)))
typedef unsigned short bf16_t;
typedef short bf16x8 __attribute__((ext_vector_type(8)));
typedef float f32x4 __attribute__((ext_vector_type(4)));
typedef float f32x2 __attribute__((ext_vector_type(2)));
typedef unsigned u32x4 __attribute__((ext_vector_type(4)));
typedef unsigned u32x2 __attribute__((ext_vector_type(2)));
typedef GAS unsigned gu32;

constexpr int NB = 8, SEQ = 4096, NTOK = NB * SEQ, DM = 1024, DEPTH = 4, NH = 4, HD = 64, PIN = 3608, PP = 3584, PW = 3840, NE = 16, DE = 512;
constexpr int NCH = SEQ / 64;
constexpr float ALPHA = 1.6817928305074290f;
constexpr float LN_EPS = 1e-6f;
constexpr float ATT_C2 = 0.17677669529663687f * 1.4426950408889634f;
constexpr int NBUCKET = 24, LCAP = NTOK;
constexpr int PJ = 256, TSZ = NTOK * 256;
constexpr int C_MQ = 0, C_MK = TSZ, C_MV = 2 * TSZ, C_MO = 3 * TSZ, C_CB = 4 * TSZ, C_CC = 5 * TSZ, C_CH = 6 * TSZ, C_DQ = 7 * TSZ, C_DK = 8 * TSZ, C_DV = 9 * TSZ,
              C_GQ = 10 * TSZ, C_GK = 11 * TSZ, C_GV = 12 * TSZ, C_GR = 13 * TSZ;
constexpr int T_GA = 0, T_MI = 16, T_MF = 20;

constexpr size_t MiB = 1u << 20;
constexpr size_t WS_CTL = 0, CTL_ZERO_BYTES = 1 * MiB;
constexpr size_t WS_MOD = 1 * MiB;
constexpr size_t WS_ROPE = 2 * MiB;
constexpr size_t WS_WIN = 3 * MiB;
constexpr size_t WS_WOUT = 33 * MiB;
constexpr size_t WS_WGU = 41 * MiB;
constexpr size_t WS_WD = 73 * MiB;
constexpr size_t WS_LTOK = 89 * MiB;
constexpr size_t WS_LGATE = 92 * MiB;
constexpr size_t WS_SM = 98 * MiB;
constexpr size_t WS_PROJ = 100 * MiB;
constexpr size_t WS_XR = 340 * MiB;
constexpr size_t WS_U = 468 * MiB;
constexpr size_t WS_YCAT = 532 * MiB;
constexpr size_t WS_TAIL = 596 * MiB;
constexpr size_t WS_YSORT = WS_PROJ + 100 * MiB;
constexpr size_t WS_U8 = 600 * MiB;
constexpr size_t WS_WIN8 = 632 * MiB;
constexpr size_t WS_END = 648 * MiB;
constexpr size_t SM_N = 0, SM_BC = 512 * 1024, SM_DM = 520 * 1024, SM_MS = 528 * 1024, SM_GBE = 1 * MiB, SM_TS = 1536 * 1024;
constexpr int CW_TMO = 0, CW_CODE = 1, CW_ZPAGE = 256, CW_BAR = 4096, CW_CNT = 16384, CW_RT = 24576;
constexpr int RING_BYTES = 131072, LDSCTL_OFF = RING_BYTES, MISC_OFF = LDSCTL_OFF + 320, MOE_TB_OFF = LDSCTL_OFF + 1024, LDS_BYTES = 147456;

#define RLX_AGENT __ATOMIC_RELAXED, __HIP_MEMORY_SCOPE_AGENT
#define LDS_WAIT() asm volatile("s_waitcnt lgkmcnt(0)" ::: "memory")
#define VM_WAIT() asm volatile("s_waitcnt vmcnt(0)" ::: "memory")

__device__ __forceinline__ unsigned f2bf(float f) { unsigned u = __builtin_bit_cast(unsigned, f); return (u + 0x7fffu + ((u >> 16) & 1u)) >> 16; }
__device__ __forceinline__ unsigned pk2(float lo, float hi) { typedef __bf16 bf2 __attribute__((ext_vector_type(2))); f32x2 v = {lo, hi}; bf2 b = __builtin_convertvector(v, bf2); return __builtin_bit_cast(unsigned, b); }
__device__ __forceinline__ unsigned pk4_fp8(float a, float b, float c, float d) {
    a = __builtin_amdgcn_fmed3f(a, -448.f, 448.f); b = __builtin_amdgcn_fmed3f(b, -448.f, 448.f); c = __builtin_amdgcn_fmed3f(c, -448.f, 448.f); d = __builtin_amdgcn_fmed3f(d, -448.f, 448.f);
    int w = 0; w = __builtin_amdgcn_cvt_pk_fp8_f32(a, b, w, false); w = __builtin_amdgcn_cvt_pk_fp8_f32(c, d, w, true); return (unsigned)w; }
__device__ __forceinline__ void st8_wt(void* p, u32x2 v) { asm volatile("global_store_dwordx2 %0, %1, off sc1\n\ts_nop 0" :: "v"(p), "v"(v) : "memory"); }
constexpr float W8S = 64.f, H8S = 16.f, Y8S = 8.f;
__device__ __forceinline__ float bf2f(unsigned b) { return __builtin_bit_cast(float, b << 16); }
__device__ __forceinline__ float bflo(unsigned w) { return __builtin_bit_cast(float, w << 16); }
__device__ __forceinline__ float bfhi(unsigned w) { return __builtin_bit_cast(float, w & 0xffff0000u); }
__device__ __forceinline__ void st16_wt(void* p, u32x4 v) { asm volatile("global_store_dwordx4 %0, %1, off sc1\n\ts_nop 1" :: "v"(p), "v"(v) : "memory"); }
__device__ __forceinline__ float wave_sum(float v) {
#pragma unroll
    for (int o = 1; o < 64; o <<= 1) v += __shfl_xor(v, o);
    return v;
}
__device__ __forceinline__ float wave_max(float v) {
#pragma unroll
    for (int o = 1; o < 64; o <<= 1) v = fmaxf(v, __shfl_xor(v, o));
    return v;
}
__device__ __forceinline__ float fexp(float x) { return __builtin_amdgcn_exp2f(x * 1.4426950408889634f); }
__device__ __forceinline__ float flog(float x) { return __builtin_amdgcn_logf(x) * 0.6931471805599453f; }
__device__ __forceinline__ float logsig(float z) { return fminf(z, 0.f) - flog(1.f + fexp(-fabsf(z))); }
__device__ __forceinline__ float sigmoidf_(float z) { return 1.f / (1.f + fexp(-z)); }

__device__ __forceinline__ int lane_id_() { int l_; asm volatile("v_mbcnt_lo_u32_b32 %0, -1, 0\n\tv_mbcnt_hi_u32_b32 %0, -1, %0" : "=v"(l_)); return l_; }
__device__ __forceinline__ int mk_tid(int wave) { return (wave << 6) | lane_id_(); }
#define XB_TMO      128
#define XB_XCNT(j)  (256  + 64 * (j))
#define XB_XSUB(j)  (1280 + 64 * (j))
#define XB_XGEN(j)  (2304 + 64 * (j))
#define XB_TOP      3328
#define XB_TOPGEN   3392
#define XCD_BAR_WORDS 3456
#define XB_SPIN_CAP (1u << 18)
__device__ __forceinline__ unsigned xb_ld(unsigned* p)              { return __hip_atomic_load(p, __ATOMIC_RELAXED, __HIP_MEMORY_SCOPE_AGENT); }
__device__ __forceinline__ unsigned xb_add(unsigned* p, unsigned v) { return __hip_atomic_fetch_add(p, v, __ATOMIC_RELAXED, __HIP_MEMORY_SCOPE_AGENT); }
__device__ __forceinline__ unsigned xb_xcc_id() { return (unsigned)__builtin_amdgcn_s_getreg((3 << 11) | 20) & 0xFu; }
#define XB_SPIN(cond, bar) do { unsigned _sp = 0; while (cond) { __builtin_amdgcn_s_sleep(1); \
    if ((++_sp & 255u) == 0u) { if (xb_ld(&(bar)[XB_TMO])) break; if (_sp > XB_SPIN_CAP) { atomicAdd(&(bar)[XB_TMO], 1u); break; } } } } while (0)
struct XcdBarrier { unsigned* bar; unsigned x; volatile LAS unsigned* st; };
__device__ __forceinline__ XcdBarrier xcd_barrier_post(unsigned* bar, volatile LAS unsigned* st, bool t0) {
    XcdBarrier b; b.bar = bar; b.x = xb_xcc_id(); b.st = st;
    if (t0) (void)xb_add(&bar[XB_XCNT(b.x)], 1u);
    return b;
}
__device__ __forceinline__ void xcd_barrier_complete(unsigned* bar, unsigned x, unsigned& nloc, unsigned& nx) {
    const unsigned G = gridDim.x * gridDim.y * gridDim.z;
    unsigned sum, cnt, mine, sp = 0u;
    for (;;) {
        sum = 0u; cnt = 0u; mine = 0u;
#pragma unroll
        for (unsigned j = 0; j < 16; ++j) { const unsigned c = xb_ld(&bar[XB_XCNT(j)]); sum += c; cnt += (c > 0u) ? 1u : 0u; mine = (j == x) ? c : mine; }
        if (sum == G) break;
        __builtin_amdgcn_s_sleep(1);
        if ((++sp & 255u) == 0u) { if (xb_ld(&bar[XB_TMO])) break; if (sp > XB_SPIN_CAP) { atomicAdd(&bar[XB_TMO], 1u); break; } }
    }
    nloc = mine > 0u ? mine : 1u; nx = cnt > 0u ? cnt : 1u;
}
__device__ __forceinline__ void xcd_barrier(const XcdBarrier& b, bool t0) {
    asm volatile("s_waitcnt vmcnt(0)" ::: "memory");
    __syncthreads();
    if (t0) {
        unsigned* bar = b.bar;
        __builtin_amdgcn_s_waitcnt(0);
        unsigned nloc = b.st[0], nx = b.st[1];
        if (nloc == 0u) { xcd_barrier_complete(bar, b.x, nloc, nx); b.st[0] = nloc; b.st[1] = nx; }
        const unsigned old = xb_add(&bar[XB_XSUB(b.x)], 1u);
        const unsigned gen = old / nloc;
        if (old + 1u == (gen + 1u) * nloc) {
            __builtin_amdgcn_fence(__ATOMIC_RELEASE, "agent");
            asm volatile("s_waitcnt vmcnt(0)" ::: "memory");
            const unsigned og = xb_add(&bar[XB_TOP], 1u);
            const unsigned tg = og / nx;
            if (og + 1u == (tg + 1u) * nx) xb_add(&bar[XB_TOPGEN], 1u);
            else XB_SPIN(xb_ld(&bar[XB_TOPGEN]) == tg, bar);
            __builtin_amdgcn_fence(__ATOMIC_ACQUIRE, "agent");
            xb_add(&bar[XB_XGEN(b.x)], 1u);
            asm volatile("s_waitcnt vmcnt(0)" ::: "memory");
        } else {
            XB_SPIN(xb_ld(&bar[XB_XGEN(b.x)]) == gen, bar);
            __builtin_amdgcn_fence(__ATOMIC_ACQUIRE, "agent");
            asm volatile("s_waitcnt vmcnt(0)" ::: "memory");
        }
    }
    __syncthreads();
}

namespace gm {
constexpr int BM = 256, BK = 64, HALF = 128, HTB = HALF * BK * 2, NXCD = 8, WGM = 8;
typedef int v4i_t __attribute__((ext_vector_type(4))); typedef int v8i_t __attribute__((ext_vector_type(8)));
__host__ __device__ __forceinline__ int lds_byte(int r, int c) { const int st = (r >> 4) * 2 + (c >> 5), rr = r & 15, cc = c & 31, ob = rr * 64 + cc * 2; return st * 1024 + (ob ^ (((ob >> 9) & 1) << 5)); }
__host__ __device__ __forceinline__ void stage_rc(int b, int& R, int& C) { const int st = b / 1024, sb = b % 1024, swz = sb ^ (((sb >> 9) & 1) << 5); R = (st >> 1) * 16 + swz / 64; C = (st & 1) * 32 + (swz % 64) / 2; }
__host__ __device__ __forceinline__ int perm32(int rho) { const int n = rho >> 4, i = rho & 15; return 8 * (i >> 2) + 4 * n + (i & 3); }
struct Unit { int pm, pn, bk, tb; };
struct Src { const char* a; const char* b0; const char* b1; unsigned va[2][2]; };
struct StaticOrder {
    int nM, nN, nwg, G, c;
    __device__ void init(int M, int N, int G_, int c_) { nM = M / BM; nN = N / BM; nwg = nM * nN; G = G_; c = c_; }
    __device__ __forceinline__ bool next(int i, Unit& u) const {
        const long L = (long)i * G + c; if (L >= nwg) return false;
        int wgid = (int)L; { const int q = nwg / NXCD, r = nwg % NXCD, xcd = wgid % NXCD, off = wgid / NXCD; wgid = (xcd < r ? xcd * (q + 1) : r * (q + 1) + (xcd - r) * q) + off; }
        const int nig = WGM * nN, gid = wgid / nig, fm = gid * WGM, gsz = (nM - fm) < WGM ? (nM - fm) : WGM;
        u.pm = fm + ((wgid % nig) % gsz); u.pn = (wgid % nig) / gsz; u.bk = 0; u.tb = 0; return true;
    }
};

template <class Kind>
__device__ __forceinline__ void gemm_phase(LAS unsigned char* lds, const Kind& Kd, int wave) {
    int tid_ = mk_tid(wave); asm volatile("" : "+v"(tid_));
    const int tid = tid_, wid = __builtin_amdgcn_readfirstlane(tid >> 6), lane = tid & 63, wr = wid >> 2, wc = wid & 3, fr = lane & 15, fq = lane >> 4;
    int R[2], C[2]; unsigned voffB[2];
#pragma unroll
    for (int i = 0; i < 2; ++i) { stage_rc(tid * 16 + i * 8192, R[i], C[i]); const int Rb = Kind::PERM ? ((R[i] & ~31) + perm32(R[i] & 31)) : R[i]; voffB[i] = (unsigned)(Rb * Kind::LDBB + C[i] * 2); }
    const size_t hstepB = (size_t)HALF * Kind::LDBB;
    constexpr int NT = Kind::NTK;
    const unsigned ldsw = (unsigned)wid * 1024u;
    const int aoff = lds_byte(wr * 64 + fr, fq * 8), boff = lds_byte(wc * 32 + fr, fq * 8);
#define G_SA(b, h) (((b) * 2 + (h)) * HTB)
#define G_SB(b, h) ((4 + (b) * 2 + (h)) * HTB)
#define G_STAGE_A(bufoff, S, t, h) do { const char* _g = (S).a + (size_t)(t) * 128; _Pragma("unroll") for (int _i = 0; _i < 2; ++_i) \
        __builtin_amdgcn_global_load_lds((const unsigned*)(_g + (S).va[h][_i]), (LAS unsigned*)(lds + (bufoff) + ldsw + _i * 8192), 16, 0, 0); } while (0)
#define G_STAGE_B(bufoff, S, t, h) do { const char* _g = (((t) < NT / 2) ? (S).b0 + (size_t)(t) * 128 : (S).b1 + (size_t)((t) - NT / 2) * 128) + (h) * hstepB; _Pragma("unroll") for (int _i = 0; _i < 2; ++_i) \
        __builtin_amdgcn_global_load_lds((const unsigned*)(_g + voffB[_i]), (LAS unsigned*)(lds + (bufoff) + ldsw + _i * 8192), 16, 0, 0); } while (0)
#define G_LDA(dst, b, h) do { _Pragma("unroll") for (int m = 0; m < 4; ++m) _Pragma("unroll") for (int k = 0; k < 2; ++k) dst[m][k] = *(const LAS bf16x8*)(lds + G_SA(b, h) + aoff + m * 2048 + k * 1024); } while (0)
#define G_LDB(dst, b, h) do { _Pragma("unroll") for (int n = 0; n < 2; ++n) _Pragma("unroll") for (int k = 0; k < 2; ++k) dst[n][k] = *(const LAS bf16x8*)(lds + G_SB(b, h) + boff + n * 2048 + k * 1024); } while (0)
#define G_MMA(ai, bj, At, Bt) do { __builtin_amdgcn_s_setprio(1); _Pragma("unroll") for (int m = 0; m < 4; ++m) _Pragma("unroll") for (int n = 0; n < 2; ++n) _Pragma("unroll") for (int k = 0; k < 2; ++k) \
        acc[ai][bj][m][n] = __builtin_amdgcn_mfma_f32_16x16x32_bf16(Bt[n][k], At[m][k], acc[ai][bj][m][n], 0, 0, 0); __builtin_amdgcn_s_setprio(0); } while (0)
#define G_LDA8(dst, b, h) do { _Pragma("unroll") for (int m = 0; m < 4; ++m) { const v4i_t _lo = *(const LAS v4i_t*)(lds + G_SA(b, h) + aoff + m * 2048), _hi = *(const LAS v4i_t*)(lds + G_SA(b, h) + aoff + m * 2048 + 1024); \
        dst[m] = __builtin_shufflevector(_lo, _hi, 0, 1, 2, 3, 4, 5, 6, 7); } } while (0)
#define G_LDB8(dst, b, h) do { _Pragma("unroll") for (int n = 0; n < 2; ++n) { const v4i_t _lo = *(const LAS v4i_t*)(lds + G_SB(b, h) + boff + n * 2048), _hi = *(const LAS v4i_t*)(lds + G_SB(b, h) + boff + n * 2048 + 1024); \
        dst[n] = __builtin_shufflevector(_lo, _hi, 0, 1, 2, 3, 4, 5, 6, 7); } } while (0)
#define G_MMA8(ai, bj, A8_, B8_) do { __builtin_amdgcn_s_setprio(1); _Pragma("unroll") for (int m = 0; m < 4; ++m) _Pragma("unroll") for (int n = 0; n < 2; ++n) \
        asm volatile("v_mfma_scale_f32_16x16x128_f8f6f4 %0, %1, %2, %0, %3, %3 op_sel_hi:[0,0,0]" : "+v"(acc[ai][bj][m][n]) : "v"(B8_[n]), "v"(A8_[m]), "v"(sc1v)); __builtin_amdgcn_s_setprio(0); } while (0)
#define X_LDA(b, h) do { if constexpr (Kind::FP8) G_LDA8(A8, b, h); else G_LDA(At, b, h); } while (0)
#define X_LDB0(b, h) do { if constexpr (Kind::FP8) G_LDB8(B08, b, h); else G_LDB(B0, b, h); } while (0)
#define X_LDB1(b, h) do { if constexpr (Kind::FP8) G_LDB8(B18, b, h); else G_LDB(B1, b, h); } while (0)
#define X_MM0(ai, bj) do { if constexpr (Kind::FP8) G_MMA8(ai, bj, A8, B08); else G_MMA(ai, bj, At, B0); } while (0)
#define X_MM1(ai, bj) do { if constexpr (Kind::FP8) G_MMA8(ai, bj, A8, B18); else G_MMA(ai, bj, At, B1); } while (0)
#define G_WAIT_V(n) asm volatile("s_waitcnt vmcnt(" #n ")" ::: "memory")
#define G_WAIT_L(n) asm volatile("s_waitcnt lgkmcnt(" #n ")" ::: "memory")
#define G_BAR __builtin_amdgcn_s_barrier()
#define G_SCHED __builtin_amdgcn_sched_barrier(0)
    Unit cur, nxt; Src sc, sn; int ui = 0; int pend = -1;
    if (!Kd.next(0, cur)) return;
    Kd.src(cur, sc, R, C);
    Kd.a_ready(cur, wid);
    f32x4 acc[2][2][4][2];
#pragma unroll
    for (int a = 0; a < 2; ++a)
#pragma unroll
        for (int b = 0; b < 2; ++b)
#pragma unroll
            for (int m = 0; m < 4; ++m)
#pragma unroll
                for (int n = 0; n < 2; ++n) acc[a][b][m][n] = (f32x4){0.f, 0.f, 0.f, 0.f};
    bf16x8 At[4][2], B0[2][2], B1[2][2]; v8i_t A8[4], B08[2], B18[2]; int sc1v = 0x7f7f7f7f; asm volatile("" : "+v"(sc1v));
    G_STAGE_B(G_SB(0, 0), sc, 0, 0); G_STAGE_B(G_SB(0, 1), sc, 0, 1); G_STAGE_A(G_SA(0, 0), sc, 0, 0); G_STAGE_A(G_SA(0, 1), sc, 0, 1);
    if (wr == 1) G_BAR;
    G_WAIT_V(2); G_BAR;
    G_STAGE_B(G_SB(1, 0), sc, 1, 0); G_STAGE_A(G_SA(1, 0), sc, 1, 0); G_STAGE_B(G_SB(1, 1), sc, 1, 1);
    G_WAIT_V(6); G_BAR;
    for (;;) {
        const bool has_next = Kd.next(ui + 1, nxt);
        if (has_next) Kd.src(nxt, sn, R, C); else sn = sc;
#pragma unroll 1
        for (int t = 0; t < NT; t += 2) {
            const bool last = (t == NT - 2);
            if (last && has_next) Kd.a_ready(nxt, wid);
            Src s2; s2.a = last ? sn.a : sc.a; s2.b0 = last ? sn.b0 : sc.b0; s2.b1 = last ? sn.b1 : sc.b1;
            s2.va[0][0] = last ? sn.va[0][0] : sc.va[0][0]; s2.va[0][1] = last ? sn.va[0][1] : sc.va[0][1]; s2.va[1][0] = last ? sn.va[1][0] : sc.va[1][0]; s2.va[1][1] = last ? sn.va[1][1] : sc.va[1][1];
            const int t2 = last ? 0 : t + 2, t3 = t2 + 1;
            X_LDB0(0, 0); X_LDB1(0, 1); G_SCHED; X_LDA(0, 0); G_STAGE_A(G_SA(1, 1), sc, t + 1, 1);
            G_WAIT_V(8); G_WAIT_L(0); G_BAR; X_MM0(0, 0); X_MM1(0, 1); G_BAR; G_SCHED;
            X_LDA(0, 1); G_STAGE_B(G_SB(0, 0), s2, t2, 0); G_STAGE_B(G_SB(0, 1), s2, t2, 1); G_STAGE_A(G_SA(0, 0), s2, t2, 0);
            G_WAIT_V(8); G_WAIT_L(0); G_BAR; X_MM0(1, 0); X_MM1(1, 1); G_BAR; G_SCHED;
            X_LDB0(1, 0); X_LDB1(1, 1); G_SCHED; X_LDA(1, 0); G_STAGE_A(G_SA(0, 1), s2, t2, 1);
            G_WAIT_V(8); G_WAIT_L(0); G_BAR; X_MM0(0, 0); X_MM1(0, 1); G_BAR; G_SCHED;
            X_LDA(1, 1); G_STAGE_B(G_SB(1, 0), s2, t3, 0); G_STAGE_B(G_SB(1, 1), s2, t3, 1); G_STAGE_A(G_SA(1, 0), s2, t3, 0);
            G_WAIT_V(8); G_WAIT_L(0); G_BAR; X_MM0(1, 0); X_MM1(1, 1); G_BAR; G_SCHED;
        }
        if (wr == 0) G_BAR;
        if (Kind::PUBLISH) { if (pend >= 0) Kd.publish(pend); pend = cur.pm; }
        if (Kind::FP8) asm volatile("s_nop 15\n\ts_nop 15" ::: "memory");
        Kd.epi(acc, cur, wr, wc, fr, fq);
        if (!has_next) break;
#pragma unroll
        for (int a = 0; a < 2; ++a)
#pragma unroll
            for (int b = 0; b < 2; ++b)
#pragma unroll
                for (int m = 0; m < 4; ++m)
#pragma unroll
                    for (int n = 0; n < 2; ++n) acc[a][b][m][n] = (f32x4){0.f, 0.f, 0.f, 0.f};
        cur = nxt; sc = sn; ++ui;
        if (wr == 1) G_BAR;
    }
    G_WAIT_V(0);
    if (Kind::PUBLISH) { if (pend >= 0) Kd.publish(pend); }
    G_BAR;
#undef G_SA
#undef G_SB
#undef G_STAGE_A
#undef G_STAGE_B
#undef G_LDA
#undef G_LDB
#undef G_MMA
#undef G_MMA8
#undef G_LDA8
#undef G_LDB8
#undef X_LDA
#undef X_LDB0
#undef X_LDB1
#undef X_MM0
#undef X_MM1
#undef G_WAIT_V
#undef G_WAIT_L
#undef G_BAR
#undef G_SCHED
}

__device__ __forceinline__ void src_direct(Src& s, const void* A, int row0, const int (&R)[2], const int (&C)[2], int pitchb = 2048) {
    s.a = (const char*)A + (size_t)row0 * pitchb;
#pragma unroll
    for (int h = 0; h < 2; ++h)
#pragma unroll
        for (int i = 0; i < 2; ++i) s.va[h][i] = (unsigned)((h * HALF + R[i]) * pitchb + C[i] * 2);
}

template <bool F8> struct K1 {
    static constexpr bool PERM = true, PUBLISH = false, FP8 = F8; static constexpr int LDBB = F8 ? 1024 : 2048, NTK = F8 ? 8 : 16;
    __device__ __forceinline__ void publish(int) const {}
    __device__ __forceinline__ void a_ready(const Unit&, int) const {}
    __device__ __forceinline__ void done(const Unit&) const {}
    StaticOrder S; const void* A; const void* Bt; bf16_t* O; const float* rope;
    __device__ __forceinline__ bool next(int i, Unit& u) const { return S.next(i, u); }
    __device__ __forceinline__ void src(const Unit& u, Src& s, const int (&R)[2], const int (&C)[2]) const {
        src_direct(s, A, u.pm * BM, R, C, F8 ? 1024 : 2048); s.b0 = (const char*)Bt + (size_t)u.pn * BM * (F8 ? 1024 : 2048); s.b1 = s.b0 + (F8 ? 512 : 1024);
    }
    __device__ __forceinline__ void epi(const f32x4 (&acc)[2][2][4][2], const Unit& u, int wr, int wc, int fr, int fq) const {
        const int row0 = u.pm * BM + wr * 64 + fr, col0 = u.pn * TSZ + wc * 32 + 8 * fq;
        if (u.pn == 7 || u.pn == 8) {
#pragma unroll
            for (int ai = 0; ai < 2; ++ai)
#pragma unroll
                for (int m = 0; m < 4; ++m) {
                    const int row = row0 + ai * HALF + m * 16;
                    const f32x4 cs = *(const f32x4*)(rope + (size_t)row * 8), sn = *(const f32x4*)(rope + (size_t)row * 8 + 4);
                    bf16_t* rowp = O + (size_t)row * PJ + col0;
#pragma unroll
                    for (int bj = 0; bj < 2; ++bj) {
                        f32x4 v0 = acc[ai][bj][m][0], v1 = acc[ai][bj][m][1]; if (F8) { v0 = v0 * (1.f / W8S); v1 = v1 * (1.f / W8S); }
                        if (fq == 0) { const f32x4 x1 = v0, x2 = v1; v0 = x1 * cs - x2 * sn; v1 = x2 * cs + x1 * sn; }
                        u32x4 w; w.x = pk2(v0[0], v0[1]); w.y = pk2(v0[2], v0[3]); w.z = pk2(v1[0], v1[1]); w.w = pk2(v1[2], v1[3]);
                        *(u32x4*)(rowp + bj * HALF) = w;
                    }
                }
        } else {
#pragma unroll
            for (int ai = 0; ai < 2; ++ai)
#pragma unroll
                for (int m = 0; m < 4; ++m) { bf16_t* rowp = O + (size_t)(row0 + ai * HALF + m * 16) * PJ + col0;
#pragma unroll
                    for (int bj = 0; bj < 2; ++bj) { f32x4 v0 = acc[ai][bj][m][0], v1 = acc[ai][bj][m][1]; if (F8) { v0 = v0 * (1.f / W8S); v1 = v1 * (1.f / W8S); }
                        u32x4 w; w.x = pk2(v0[0], v0[1]); w.y = pk2(v0[2], v0[3]); w.z = pk2(v1[0], v1[1]); w.w = pk2(v1[2], v1[3]);
                        *(u32x4*)(rowp + bj * HALF) = w; } }
        }
    }
};
struct K2 {
    static constexpr bool PERM = true, PUBLISH = false, FP8 = true; static constexpr int LDBB = 1024, NTK = 8;
    __device__ __forceinline__ void publish(int) const {}
    __device__ __forceinline__ void a_ready(const Unit&, int) const {}
    __device__ __forceinline__ void done(const Unit&) const {}
    StaticOrder S; const unsigned char* A; const unsigned char* Bt; bf16_t* O;
    __device__ __forceinline__ bool next(int i, Unit& u) const { return S.next(i, u); }
    __device__ __forceinline__ void src(const Unit& u, Src& s, const int (&R)[2], const int (&C)[2]) const {
        src_direct(s, A, u.pm * BM, R, C, 1024); s.b0 = (const char*)(Bt + (size_t)u.pn * BM * 1024); s.b1 = s.b0 + 512;
    }
    __device__ __forceinline__ void epi(const f32x4 (&acc)[2][2][4][2], const Unit& u, int wr, int wc, int fr, int fq) const {
        const int row0 = u.pm * BM + wr * 64 + fr, col0 = u.pn * BM + wc * 32 + 8 * fq;
#pragma unroll
        for (int ai = 0; ai < 2; ++ai)
#pragma unroll
            for (int m = 0; m < 4; ++m) { bf16_t* rowp = O + (size_t)(row0 + ai * HALF + m * 16) * DM + col0;
#pragma unroll
                for (int bj = 0; bj < 2; ++bj) { const f32x4 v0 = acc[ai][bj][m][0] * (1.f / (W8S * Y8S)), v1 = acc[ai][bj][m][1] * (1.f / (W8S * Y8S));
                    u32x4 w; w.x = pk2(v0[0], v0[1]); w.y = pk2(v0[2], v0[3]); w.z = pk2(v1[0], v1[1]); w.w = pk2(v1[2], v1[3]);
                    *(u32x4*)(rowp + bj * HALF) = w; } }
    }
};
__device__ __forceinline__ int pair_i(int p) { return p < 3 ? 0 : (p < 5 ? 1 : 2); }
__device__ __forceinline__ int pair_j(int p) { return p < 3 ? p + 1 : (p < 5 ? p - 1 : 3); }
struct K4 {
    static constexpr bool PERM = true, PUBLISH = false, FP8 = true; static constexpr int LDBB = 1024, NTK = 8;
    const unsigned char* U; const unsigned char* Wgu; unsigned char* H; const int* ltok; const float* lgate; const LAS int* tb; int G, vcu; gu32* rtc;
    __device__ __forceinline__ void a_ready(const Unit&, int) const {}
    __device__ __forceinline__ void done(const Unit&) const {}
    __device__ __forceinline__ void publish(int pm) const { if (lane_id_() == 0) __hip_atomic_fetch_add(rtc + 64 * pm, 1u, RLX_AGENT); }
    __device__ __forceinline__ bool next(int i, Unit& u) const {
        const int L = i * G + vcu; const int nt = tb[32 + NBUCKET]; if (L >= nt * 8) return false;
        const int rt = L >> 3; int k = 0;
        for (int q = 1; q < NBUCKET; ++q) k = (tb[32 + q] <= rt) ? q : k;
        u.pm = rt; u.pn = L & 7; u.bk = k; u.tb = (rt - tb[32 + k]) | (i << 16); return true;
    }
    __device__ __forceinline__ void src(const Unit& u, Src& s, const int (&R)[2], const int (&C)[2]) const {
        const int cnt = tb[u.bk]; s.a = (const char*)U;
#pragma unroll
        for (int h = 0; h < 2; ++h)
#pragma unroll
            for (int i = 0; i < 2; ++i) { const int pos = (u.tb & 0xffff) * BM + h * HALF + R[i]; const int tok = ltok[(size_t)u.bk * LCAP + (pos < cnt ? pos : 0)]; s.va[h][i] = (unsigned)(tok * 1024 + C[i] * 2); }
        const int grp = u.bk / 6, p = u.bk % 6, sl = u.pn >> 2; const int e = grp * 4 + (sl ? pair_j(p) : pair_i(p));
        s.b0 = (const char*)(Wgu + ((size_t)e * 1024 + (size_t)(u.pn & 3) * BM) * 1024); s.b1 = s.b0 + 512;
    }
    __device__ __forceinline__ void epi(const f32x4 (&acc)[2][2][4][2], const Unit& u, int wr, int wc, int fr, int fq) const {
        const int cnt = tb[u.bk], sl = u.pn >> 2; int colo = sl * 512 + (u.pn & 3) * 128 + wc * 32 + 8 * fq; asm volatile("" : "+v"(colo));
        int gofs = 256 + (u.tb >> 16) * 256 + wr * 64 + fr; asm volatile("" : "+v"(gofs));
        const LAS float* gl = (const LAS float*)tb + gofs;
#pragma unroll
        for (int ai = 0; ai < 2; ++ai)
#pragma unroll
            for (int m = 0; m < 4; ++m) {
                const int r = ai * HALF + wr * 64 + m * 16 + fr, pos = (u.tb & 0xffff) * BM + r;
                const float gt = (pos < cnt) ? gl[ai * HALF + m * 16] : 0.f;
                float hv[8];
#pragma unroll
                for (int n = 0; n < 2; ++n)
#pragma unroll
                    for (int j = 0; j < 4; ++j) { const float g = acc[ai][0][m][n][j] * (1.f / W8S), up = acc[ai][1][m][n][j] * (1.f / W8S); hv[n * 4 + j] = g * __builtin_amdgcn_rcpf(1.f + fexp(-g)) * up * (gt * H8S); }
                u32x2 w; w.x = pk4_fp8(hv[0], hv[1], hv[2], hv[3]); w.y = pk4_fp8(hv[4], hv[5], hv[6], hv[7]);
                *(u32x2*)(H + (size_t)(u.pm * BM + r) * 1024 + colo) = w;
            }
    }
};
struct K5 {
    static constexpr bool PERM = true, PUBLISH = false, FP8 = true; static constexpr int LDBB = 512, NTK = 8;
    __device__ __forceinline__ void publish(int) const {}
    const unsigned char* H; const unsigned char* Wd; bf16_t* Y; const LAS int* tb; int G, vcu; gu32* rtc; gu32* tmo;
    __device__ __forceinline__ void done(const Unit&) const {}
    __device__ __forceinline__ void a_ready(const Unit& u, int wid) const { return;
        if (wid == 0) {
            const unsigned long long t0 = __builtin_amdgcn_s_memrealtime(); unsigned polls = 0;
            while ((unsigned)__builtin_amdgcn_readfirstlane(__hip_atomic_load(rtc + 64 * u.pm, RLX_AGENT)) < 64u) {
                if ((++polls & 255u) == 0u && __builtin_amdgcn_readfirstlane(__hip_atomic_load(tmo, RLX_AGENT)) != 0u) break;
                if (__builtin_amdgcn_s_memrealtime() - t0 > 2000000ull) { if (lane_id_() == 0) __hip_atomic_store(tmo, 1u, RLX_AGENT); break; }
                __builtin_amdgcn_s_sleep(2); }
            __builtin_amdgcn_fence(__ATOMIC_ACQUIRE, "agent");
            asm volatile("s_waitcnt vmcnt(0)" ::: "memory");
        }
        asm volatile("" ::: "memory"); __builtin_amdgcn_s_barrier(); asm volatile("" ::: "memory");
    }
    __device__ __forceinline__ bool next(int i, Unit& u) const {
        const int nt = tb[32 + NBUCKET]; const int n4 = nt * 8; const int i0 = 0; (void)n4;
        const int L = (i + i0) * G + vcu; if (L >= nt * 4) return false;
        const int rt = L >> 2; int k = 0;
        for (int q = 1; q < NBUCKET; ++q) k = (tb[32 + q] <= rt) ? q : k;
        u.pm = rt; u.pn = L & 3; u.bk = k; u.tb = rt - tb[32 + k]; return true;
    }
    __device__ __forceinline__ void src(const Unit& u, Src& s, const int (&R)[2], const int (&C)[2]) const {
        src_direct(s, H, u.pm * BM, R, C, 1024);
        const int grp = u.bk / 6, p = u.bk % 6;
        s.b0 = (const char*)(Wd + ((size_t)(grp * 4 + pair_i(p)) * 1024 + (size_t)u.pn * BM) * 512);
        s.b1 = (const char*)(Wd + ((size_t)(grp * 4 + pair_j(p)) * 1024 + (size_t)u.pn * BM) * 512);
    }
    __device__ __forceinline__ void epi(const f32x4 (&acc)[2][2][4][2], const Unit& u, int wr, int wc, int fr, int fq) const {
        const int row0 = u.pm * BM + wr * 64 + fr, col0 = u.pn * BM + wc * 32 + 8 * fq;
#pragma unroll
        for (int ai = 0; ai < 2; ++ai)
#pragma unroll
            for (int m = 0; m < 4; ++m) { bf16_t* rowp = Y + (size_t)(row0 + ai * HALF + m * 16) * DM + col0;
#pragma unroll
                for (int bj = 0; bj < 2; ++bj) { const f32x4 v0 = acc[ai][bj][m][0] * (1.f / (W8S * H8S)), v1 = acc[ai][bj][m][1] * (1.f / (W8S * H8S));
                    u32x4 w; w.x = pk2(v0[0], v0[1]); w.y = pk2(v0[2], v0[3]); w.z = pk2(v1[0], v1[1]); w.w = pk2(v1[2], v1[3]);
                    *(u32x4*)(rowp + bj * HALF) = w; } }
    }
};
}

namespace attn_body {
using bf16 = __hip_bfloat16;
using s16x4 = __attribute__((ext_vector_type(4))) short;
using f32x16 = __attribute__((ext_vector_type(16))) float;
constexpr int D = 64, PITCH = PJ;
constexpr int NW = 8, QBLK = 32, QB = QBLK * NW, KVBLK = 64;
__device__ __forceinline__ int crow(int r, int hi) { return (r & 3) + 8 * (r >> 2) + 4 * hi; }
#define SBAR() __builtin_amdgcn_sched_barrier(0)
__device__ __forceinline__ void cmask(f32x16& p0, f32x16& p1, int jb, int qrel, int hi) {
    const float NEG = -INFINITY; int kb = 64 * jb + 4 * hi;
#pragma unroll
    for (int r = 0; r < 16; ++r) { int kv = kb + (r & 3) + 8 * (r >> 2); if (kv > qrel) p0[r] = NEG; if (kv + 32 > qrel) p1[r] = NEG; }
}
constexpr int NSLOT = 3, SLOTB = 8192;
constexpr int LDS_K = 0, LDS_V = NSLOT * SLOTB, LDS_WS = 2 * NSLOT * SLOTB, LDS_OST = LDS_WS + NW * 64 * 4, ATT_LDS_BYTES = LDS_OST + NW * 8192;
__device__ __forceinline__ void glds16(const void* gsrc, unsigned lds_dst) { unsigned keep;
    asm volatile("s_mov_b32 %0, m0\n\ts_mov_b32 m0, %2\n\ts_nop 0\n\tglobal_load_lds_dwordx4 %1, off\n\ts_mov_b32 m0, %0" : "=&s"(keep) : "v"(gsrc), "s"(lds_dst) : "memory"); }
__device__ __forceinline__ float max3f(float a, float b, float c) { float r; asm("v_max3_f32 %0, %1, %2, %3" : "=v"(r) : "v"(a), "v"(b), "v"(c)); return r; }
__device__ __forceinline__ float max2f(float a, float b) { float r; asm("v_max_f32_e32 %0, %1, %2" : "=v"(r) : "v"(a), "v"(b)); return r; }
__device__ __forceinline__ float fadd_s(float a, float b) { float r; asm("v_add_f32_e32 %0, %1, %2" : "=v"(r) : "v"(a), "v"(b)); return r; }
__device__ __forceinline__ float fsub_s(float a, float b) { float r; asm("v_sub_f32_e32 %0, %1, %2" : "=v"(r) : "v"(a), "v"(b)); return r; }
typedef float f32x2_t __attribute__((ext_vector_type(2))); typedef __bf16 bf16x2_t __attribute__((ext_vector_type(2)));
__device__ __forceinline__ unsigned cvtpk_s(float lo, float hi) { f32x2_t v = {lo, hi}; bf16x2_t b = __builtin_convertvector(v, bf16x2_t); return __builtin_bit_cast(unsigned, b); }
#define WAIT_BAR(N) asm volatile("s_waitcnt vmcnt(" #N ") lgkmcnt(0)\n\ts_barrier" ::: "memory")
__device__ __forceinline__ void qkt(f32x16& p0, f32x16& p1, const char* Kslot, const bf16x8* qr, const f32x16& negm, int r32, int hi) {
    const char* kb = Kslot + hi * 1024 + r32 * 16;
#pragma unroll
    for (int d0 = 0; d0 < 2; ++d0) {
        const bf16x8 b0 = *reinterpret_cast<const bf16x8*>(kb + d0 * 2048);
        const bf16x8 b1 = *reinterpret_cast<const bf16x8*>(kb + d0 * 2048 + 512);
        if (d0 == 0) { p0 = __builtin_amdgcn_mfma_f32_32x32x16_bf16(b0, qr[0], negm, 0, 0, 0); p1 = __builtin_amdgcn_mfma_f32_32x32x16_bf16(b1, qr[0], negm, 0, 0, 0); }
        else { p0 = __builtin_amdgcn_mfma_f32_32x32x16_bf16(b0, qr[d0], p0, 0, 0, 0); p1 = __builtin_amdgcn_mfma_f32_32x32x16_bf16(b1, qr[d0], p1, 0, 0, 0); } }
}
typedef __attribute__((address_space(3))) const char* lds_cptr;
typedef short v4i16_t __attribute__((ext_vector_type(4)));
__device__ __forceinline__ void kload8(bf16x8* kf, lds_cptr kp) {
    kf[0] = *(const __attribute__((address_space(3))) bf16x8*)(kp);        kf[1] = *(const __attribute__((address_space(3))) bf16x8*)(kp + 512);
    kf[2] = *(const __attribute__((address_space(3))) bf16x8*)(kp + 2048); kf[3] = *(const __attribute__((address_space(3))) bf16x8*)(kp + 2560);
}
__device__ __forceinline__ void kload2(bf16x8* kf, lds_cptr kp, int j) { kf[2 * j] = *(const __attribute__((address_space(3))) bf16x8*)(kp + j * 2048); kf[2 * j + 1] = *(const __attribute__((address_space(3))) bf16x8*)(kp + j * 2048 + 512); }
__device__ __forceinline__ s16x4 vtr(lds_cptr p) { return __builtin_bit_cast(s16x4, __builtin_amdgcn_ds_read_tr16_b64_v4i16((__attribute__((address_space(3))) v4i16_t*)p)); }
__device__ __forceinline__ float rowmax(const f32x16& p0, const f32x16& p1) {
    float a = max3f(p0[0], p0[1], p1[0]), b = max3f(p0[2], p0[3], p1[1]); a = max3f(a, p1[2], p1[3]);
#pragma unroll
    for (int r = 4; r < 16; r += 4) { a = max3f(a, p0[r], p0[r + 1]); b = max3f(b, p0[r + 2], p0[r + 3]); a = max3f(a, p1[r], p1[r + 1]); b = max3f(b, p1[r + 2], p1[r + 3]); }
    const float m = max2f(a, b);
    auto rr = __builtin_amdgcn_permlane32_swap(__float_as_uint(m), __float_as_uint(m), false, false);
    return max2f(__uint_as_float(rr[0]), __uint_as_float(rr[1]));
}
__device__ __forceinline__ void pv(f32x16* o, int vb, bf16x8 pa0, bf16x8 pa1, bf16x8 pa2, bf16x8 pa3) {
#pragma unroll
    for (int d0 = 0; d0 < 2; ++d0) { s16x4 lo[4], hi[4];
#pragma unroll
        for (int ks = 0; ks < 4; ++ks) {
            asm volatile("ds_read_b64_tr_b16 %0,%1 offset:%c2" : "=&v"(lo[ks]) : "v"(vb), "i"(d0 * 4096 + ks * 1024) : "memory");
            asm volatile("ds_read_b64_tr_b16 %0,%1 offset:%c2" : "=&v"(hi[ks]) : "v"(vb), "i"(d0 * 4096 + ks * 1024 + 512) : "memory"); }
        asm volatile("s_waitcnt lgkmcnt(0)" ::: "memory"); SBAR();
#define PK(k) (bf16x8){lo[k][0], lo[k][1], lo[k][2], lo[k][3], hi[k][0], hi[k][1], hi[k][2], hi[k][3]}
        o[d0] = __builtin_amdgcn_mfma_f32_32x32x16_bf16(pa0, PK(0), o[d0], 0, 0, 0);
        o[d0] = __builtin_amdgcn_mfma_f32_32x32x16_bf16(pa1, PK(1), o[d0], 0, 0, 0);
        o[d0] = __builtin_amdgcn_mfma_f32_32x32x16_bf16(pa2, PK(2), o[d0], 0, 0, 0);
        o[d0] = __builtin_amdgcn_mfma_f32_32x32x16_bf16(pa3, PK(3), o[d0], 0, 0, 0);
#undef PK
    }
}
struct AttnParams { const bf16* Q; const bf16* K; const bf16* V; const bf16* zpage; bf16_t* Y; const float* gnorm; float lam, osc; };
template <int THRL, int comp> __device__ __forceinline__ void attn_unit(int b, int h, int qb, const AttnParams& P, char* shm, int wave) {
    const bf16* Q = P.Q; const bf16* __restrict__ K = P.K; const bf16* __restrict__ V = P.V;
    int tid_ = mk_tid(wave); asm volatile("" : "+v"(tid_));
    const int tid = tid_, lane = tid & 63, r32 = lane & 31, hi = lane >> 5; const int wid = __builtin_amdgcn_readfirstlane(tid >> 6);
    const long rowbase = (long)b * SEQ; const int q0 = qb * QB;
    const bf16* Qw = Q + (rowbase + q0 + wid * QBLK) * PITCH + h * D;
    const bf16* Kh = K + rowbase * PITCH + h * D, *Vh = V + rowbase * PITCH + h * D;
    const unsigned lds0 = (unsigned)(uintptr_t)shm;
    float* wsf = (float*)(shm + LDS_WS) + wid * 64;
    const bf16* ksrc = Kh + (long)(32 * (wid & 1) + (lane & 31)) * PITCH + comp * 32 + (wid >> 1) * 8;
    const bf16* vsrc = Vh + (long)(16 * (wid & 3) + (lane >> 2)) * PITCH + (wid >> 2) * 32 + (lane & 3) * 8;
    const unsigned kdst = lds0 + LDS_K + (wid >> 1) * 1024 + (wid & 1) * 512, vdst = lds0 + LDS_V + wid * 1024;
#define DMA_K(t, slot) do { if (lane < 32) glds16(ksrc + (long)(t) * KVBLK * PITCH, (unsigned)__builtin_amdgcn_readfirstlane(kdst + (slot))); } while (0)
#define DMA_V(t, slot) glds16(vsrc + (long)(t) * KVBLK * PITCH, (unsigned)__builtin_amdgcn_readfirstlane(vdst + (slot)))
    const int vb0 = (int)(lds0 + LDS_V) + ((lane >> 4) & 1) * 32 + (lane & 3) * 8 + (4 * hi + ((lane & 15) >> 2)) * 64;
    const char* Kbase = shm + LDS_K; bf16x8 kf[4];
    const lds_cptr shm3 = (lds_cptr)shm; const lds_cptr kp0 = shm3 + LDS_K + hi * 1024 + r32 * 16; const lds_cptr vp0 = shm3 + LDS_V + ((lane >> 4) & 1) * 32 + (lane & 3) * 8 + (4 * hi + ((lane & 15) >> 2)) * 64;
    const int NT = (q0 + QB) / KVBLK;
    if (wid >= 4) __builtin_amdgcn_s_setprio(1);
    DMA_K(0, 0); DMA_V(0, 0); DMA_K(1, SLOTB);
    bf16x8 qr[2];
#pragma unroll
    for (int d0 = 0; d0 < 2; ++d0) qr[d0] = *reinterpret_cast<const bf16x8*>(&Qw[(long)r32 * PITCH + comp * 32 + d0 * 16 + hi * 8]);
    float mhat = 0.f, l_reg = 0.f; f32x16 o[2]; o[0] = f32x16{}; o[1] = f32x16{}; f32x16 negm = f32x16{}; asm volatile("" : "+v"(negm));
    const int qrel = wid * QBLK + r32;
#define CMASK(P0, P1, t) do { int jb_ = (t) - (NT - 4); if (jb_ >= 0) cmask(P0, P1, jb_, qrel, hi); } while (0)
    bool resc = false;
#define START(P0, P1) do { const float rm = rowmax(P0, P1); resc = false; \
    { const float dl = rm; mhat = fadd_s(mhat, dl); \
      _Pragma("unroll") for (int r = 0; r < 16; ++r) { P0[r] = fsub_s(P0[r], dl); P1[r] = fsub_s(P1[r], dl); } \
      _Pragma("unroll") for (int r = 0; r < 16; ++r) negm[r] = -mhat; asm volatile("" : "+v"(negm)); } \
    _Pragma("unroll") for (int r = 0; r < 16; ++r) P0[r] = __builtin_amdgcn_exp2f(P0[r]); } while (0)
#define RESC() do { if (resc) { asm volatile("s_waitcnt lgkmcnt(0)" ::: "memory"); \
      _Pragma("unroll") for (int d_ = 0; d_ < 2; ++d_) _Pragma("unroll") for (int r = 0; r < 16; ++r) o[d_][r] *= wsf[crow(r, hi)]; } } while (0)
    f32x16 pA0, pA1, pB0, pB1;
    int sl_prev = 0, sl_cur = 0, sl_next = SLOTB;
#define ROT() do { sl_prev = sl_cur; sl_cur = sl_next; sl_next = (sl_next == (NSLOT - 1) * SLOTB) ? 0 : sl_next + SLOTB; } while (0)
    DMA_K(2, 2 * SLOTB);
    WAIT_BAR(3);
    qkt(pA0, pA1, Kbase, qr, negm, r32, hi); asm volatile("s_nop 15\n\ts_nop 7" : "+v"(pA0), "+v"(pA1)); CMASK(pA0, pA1, 0);
    START(pA0, pA1);
    _Pragma("unroll") for (int r = 0; r < 16; ++r) pA1[r] = __builtin_amdgcn_exp2f(pA1[r]);
    WAIT_BAR(0);
    DMA_K(3, 0); DMA_V(1, SLOTB);
    ROT();
    kload8(kf, kp0 + sl_cur);
    WAIT_BAR(2);
    s16x4 vlo[8], vhi[8]; u32x4 pw0, pw1, pw2, pw3;
#define PKW(P, B) cvtpk_s(P[B], P[B + 1])
#define PAF(k) __builtin_bit_cast(bf16x8, pw##k)
#define VFR(i) (bf16x8){vlo[i][0], vlo[i][1], vlo[i][2], vlo[i][3], vhi[i][0], vhi[i][1], vhi[i][2], vhi[i][3]}
#define PIN(x) asm volatile("" : "+v"(x))
#define MX3(a, b, c) __builtin_fmaxf(__builtin_fmaxf((a), (b)), (c))
#define GAPA(MF, A0, A1, A2, A3, W0, W1, PW) do { MF; sacc += A0; sacc += A1; sacc += A2; sacc += A3; PIN(sacc); W0; W1; PIN(PW); SBAR(); } while (0)
#define EX(v) __builtin_amdgcn_exp2f(v)
#define GAPB(MF, X, B) do { MF; X[B] = EX(X[B]); X[B + 1] = EX(X[B + 1]); X[B + 2] = EX(X[B + 2]); X[B + 3] = EX(X[B + 3]); PIN(X); SBAR(); } while (0)
#define VRD(i) do { vlo[i] = vtr(vp_ + (((i) >> 2) * 4096 + ((i) & 3) * 1024)); vhi[i] = vtr(vp_ + (((i) >> 2) * 4096 + ((i) & 3) * 1024 + 512)); } while (0)
#define KRD(G, j) do { if (G) { kload2(kf, kp0 + sl_next, j); SBAR(); } } while (0)
#define STEP(C0, C1, P0, P1, t, GK, GV, GL) do { SBAR(); \
    const lds_cptr vp_ = vp0 + sl_prev; \
    VRD(0); SBAR(); float sacc = (P0[0] + P0[1]); \
    GAPA(C0 = __builtin_amdgcn_mfma_f32_32x32x16_bf16(kf[0], qr[0], negm, 0, 0, 0), P0[2], P0[3], P0[4], P0[5],     pw0[0] = PKW(P0, 0), pw0[1] = PKW(P0, 2), pw0); \
    VRD(4); SBAR(); GAPA(C1 = __builtin_amdgcn_mfma_f32_32x32x16_bf16(kf[1], qr[0], negm, 0, 0, 0), P0[6], P0[7], P0[8], P0[9],     pw0[2] = PKW(P0, 4), pw0[3] = PKW(P0, 6), pw0); \
    VRD(1); SBAR(); GAPA(C0 = __builtin_amdgcn_mfma_f32_32x32x16_bf16(kf[2], qr[1], C0, 0, 0, 0),   P0[10], P0[11], P0[12], P0[13], pw1[0] = PKW(P0, 8), pw1[1] = PKW(P0, 10), pw1); \
    VRD(5); SBAR(); GAPA(C1 = __builtin_amdgcn_mfma_f32_32x32x16_bf16(kf[3], qr[1], C1, 0, 0, 0),   P0[14], P0[15], P1[0], P1[1],   pw1[2] = PKW(P0, 12), pw1[3] = PKW(P0, 14), pw1); \
    VRD(2); SBAR(); GAPA(,   P1[2], P1[3], P1[4], P1[5],     pw2[0] = PKW(P1, 0), pw2[1] = PKW(P1, 2), pw2); \
    VRD(6); SBAR(); GAPA(,   P1[6], P1[7], P1[8], P1[9],     pw2[2] = PKW(P1, 4), pw2[3] = PKW(P1, 6), pw2); \
    VRD(3); SBAR(); GAPA(,   P1[10], P1[11], P1[12], P1[13], pw3[0] = PKW(P1, 8), pw3[1] = PKW(P1, 10), pw3); \
    VRD(7); SBAR(); GAPA(,   P1[14], P1[15], 0.f, 0.f,       pw3[2] = PKW(P1, 12), pw3[3] = PKW(P1, 14), pw3); \
    l_reg += sacc; \
    if (GK) { DMA_K((t) + 3, sl_cur); } if (GV) { DMA_V((t) + 1, sl_next); } \
    CMASK(C0, C1, t); \
    { float a = MX3(C0[0], C0[1], C1[0]), b = MX3(C0[2], C0[3], C1[1]); a = MX3(a, C1[2], C1[3]); \
      _Pragma("unroll") for (int r = 4; r < 16; r += 4) { a = MX3(a, C0[r], C0[r + 1]); b = MX3(b, C0[r + 2], C0[r + 3]); a = MX3(a, C1[r], C1[r + 1]); b = MX3(b, C1[r + 2], C1[r + 3]); } \
      float rm = __builtin_fmaxf(a, b); { auto rr = __builtin_amdgcn_permlane32_swap(__float_as_uint(rm), __float_as_uint(rm), false, false); rm = __builtin_fmaxf(__uint_as_float(rr[0]), __uint_as_float(rr[1])); } \
      resc = false; \
      if (__builtin_expect(__any(rm > (float)THRL), 0)) { const float dl = __builtin_fmaxf(rm, 0.f); mhat += dl; \
        _Pragma("unroll") for (int r = 0; r < 16; ++r) { C0[r] -= dl; C1[r] -= dl; } \
        _Pragma("unroll") for (int r = 0; r < 16; ++r) negm[r] = -mhat; asm volatile("" : "+v"(negm)); \
        const float f = __builtin_amdgcn_exp2f(-dl); l_reg *= f; if (hi == 0) wsf[r32] = f; resc = true; } } \
    SBAR(); \
    GAPB(o[0] = __builtin_amdgcn_mfma_f32_32x32x16_bf16(PAF(0), VFR(0), o[0], 0, 0, 0), C0, 0); \
    GAPB(o[1] = __builtin_amdgcn_mfma_f32_32x32x16_bf16(PAF(0), VFR(4), o[1], 0, 0, 0), C0, 4); \
    KRD(GL, 0); GAPB(o[0] = __builtin_amdgcn_mfma_f32_32x32x16_bf16(PAF(1), VFR(1), o[0], 0, 0, 0), C0, 8); \
    KRD(GL, 1); GAPB(o[1] = __builtin_amdgcn_mfma_f32_32x32x16_bf16(PAF(1), VFR(5), o[1], 0, 0, 0), C0, 12); \
    GAPB(o[0] = __builtin_amdgcn_mfma_f32_32x32x16_bf16(PAF(2), VFR(2), o[0], 0, 0, 0), C1, 0); \
    GAPB(o[1] = __builtin_amdgcn_mfma_f32_32x32x16_bf16(PAF(2), VFR(6), o[1], 0, 0, 0), C1, 4); \
    GAPB(o[0] = __builtin_amdgcn_mfma_f32_32x32x16_bf16(PAF(3), VFR(3), o[0], 0, 0, 0), C1, 8); \
    GAPB(o[1] = __builtin_amdgcn_mfma_f32_32x32x16_bf16(PAF(3), VFR(7), o[1], 0, 0, 0), C1, 12); \
    } while (0)
    int t = 1;
#undef CMASK
#define CMASK(P0, P1, t) do {} while (0)
    for (; t + 5 < NT; t += 2) {
        STEP(pB0, pB1, pA0, pA1, t, true, true, true);     WAIT_BAR(2); RESC(); ROT();
        STEP(pA0, pA1, pB0, pB1, t + 1, true, true, true); WAIT_BAR(2); RESC(); ROT();
    }
#undef CMASK
#define CMASK(P0, P1, t) do { int jb_ = (t) - (NT - 4); if (jb_ >= 0) cmask(P0, P1, jb_, qrel, hi); } while (0)
#define ENDW(tt) do { if ((tt) + 3 < NT) { WAIT_BAR(2); } else if ((tt) + 2 < NT) { WAIT_BAR(1); } else { WAIT_BAR(0); } } while (0)
    for (; t + 1 < NT; t += 2) {
        STEP(pB0, pB1, pA0, pA1, t, (t + 3 < NT), (t + 1 < NT), (t + 1 < NT));         ENDW(t);     RESC(); ROT();
        STEP(pA0, pA1, pB0, pB1, t + 1, (t + 4 < NT), (t + 2 < NT), (t + 2 < NT));     ENDW(t + 1); RESC(); ROT();
    }
    STEP(pB0, pB1, pA0, pA1, NT - 1, false, false, false); RESC();
    { float sacc = pB0[0] + pB0[1]; _Pragma("unroll") for (int r = 2; r < 16; ++r) sacc += pB0[r]; _Pragma("unroll") for (int r = 0; r < 16; ++r) sacc += pB1[r]; l_reg += sacc;
      pw0 = (u32x4){PKW(pB0, 0), PKW(pB0, 2), PKW(pB0, 4), PKW(pB0, 6)}; pw1 = (u32x4){PKW(pB0, 8), PKW(pB0, 10), PKW(pB0, 12), PKW(pB0, 14)}; pw2 = (u32x4){PKW(pB1, 0), PKW(pB1, 2), PKW(pB1, 4), PKW(pB1, 6)}; pw3 = (u32x4){PKW(pB1, 8), PKW(pB1, 10), PKW(pB1, 12), PKW(pB1, 14)};
      SBAR(); pv(o, vb0 + sl_cur, PAF(0), PAF(1), PAF(2), PAF(3)); }
#undef PKW
#undef PAF
#undef VFR
#undef PIN
#undef MX3
#undef GAPA
#undef GAPB
#undef EX
#undef VRD
#undef KRD
#undef STEP
#undef ENDW
    { auto rr = __builtin_amdgcn_permlane32_swap(__float_as_uint(l_reg), __float_as_uint(l_reg), false, false); l_reg = __uint_as_float(rr[0]) + __uint_as_float(rr[1]); }
    if (hi == 0) wsf[32 + r32] = l_reg; asm volatile("s_waitcnt lgkmcnt(0)" ::: "memory");
    float rli[16];
#pragma unroll
    for (int r = 0; r < 16; ++r) rli[r] = __builtin_amdgcn_rcpf(wsf[32 + crow(r, hi)]);
    float* stg = (float*)(shm + LDS_OST) + wid * 2048;
    if (comp == 0) {
#pragma unroll
        for (int r = 0; r < 16; ++r) { const int orow = crow(r, hi);
#pragma unroll
            for (int d0 = 0; d0 < 2; ++d0) stg[orow * 64 + d0 * 32 + r32] = o[d0][r] * rli[r]; }
    } else {
        const float lam = P.lam;
#pragma unroll
        for (int r = 0; r < 16; ++r) { const int orow = crow(r, hi);
#pragma unroll
            for (int d0 = 0; d0 < 2; ++d0) { const int ix = orow * 64 + d0 * 32 + r32; stg[ix] = stg[ix] - lam * (o[d0][r] * rli[r]); } }
        asm volatile("s_waitcnt lgkmcnt(0)" ::: "memory");
        unsigned char* Yw = (unsigned char*)P.Y + (rowbase + q0 + wid * QBLK) * DM + h * D;
        const int ch = lane & 7;
        const f32x4 g0 = *(const f32x4*)(P.gnorm + ch * 8), g1 = *(const f32x4*)(P.gnorm + ch * 8 + 4);
#pragma unroll
        for (int i = 0; i < 4; ++i) { const int row = i * 8 + (lane >> 3);
            const f32x4 a = *(const f32x4*)(stg + row * 64 + ch * 8), c = *(const f32x4*)(stg + row * 64 + ch * 8 + 4);
            float ss = (a[0] * a[0] + a[1] * a[1]) + (a[2] * a[2] + a[3] * a[3]) + (c[0] * c[0] + c[1] * c[1]) + (c[2] * c[2] + c[3] * c[3]);
            ss += __shfl_xor(ss, 1); ss += __shfl_xor(ss, 2); ss += __shfl_xor(ss, 4);
            const float rs = __builtin_amdgcn_rsqf(ss * (1.f / 64.f) + LN_EPS) * P.osc;
            const float rq = rs * Y8S; u32x2 w; w.x = pk4_fp8(a[0] * rq * g0[0], a[1] * rq * g0[1], a[2] * rq * g0[2], a[3] * rq * g0[3]); w.y = pk4_fp8(c[0] * rq * g1[0], c[1] * rq * g1[1], c[2] * rq * g1[2], c[3] * rq * g1[3]);
            *(u32x2*)(Yw + (long)row * DM + ch * 8) = w; }
    }
    __builtin_amdgcn_s_setprio(0);
    asm volatile("s_waitcnt lgkmcnt(0)\n\ts_barrier" ::: "memory");
#undef DMA_K
#undef DMA_V
#undef CMASK
#undef START
#undef RESC
#undef ROT
}
#undef SBAR
#undef WAIT_BAR
}

struct Frame {
    LAS unsigned char* lds; volatile LAS unsigned* MISC; gu32* ctl;
    int tid, lane, wave, vcu, G;
};
struct Args {
    const float* in[29]; float* out; unsigned char* ws; int ph_lo, ph_hi;
};
enum { I_X = 0, I_C, I_POS, I_WADA, I_BADA, I_WIN, I_WOUT, I_MBI, I_MBF, I_MG, I_CONVW, I_CONVB, I_LQ1, I_LK1, I_LQ2, I_LK2, I_DG, I_WA2, I_BA, I_GG, I_LN1G, I_LN1B, I_LN2G, I_LN2B,
       I_RW, I_RB, I_EWG, I_EWU, I_EWD };

__device__ __forceinline__ void tr_item(const float* W, int ldw, int K, bf16_t* WT, int drow0, int scol, int k0, LAS float* scr, int lane) {
    const int sc_ = (scol >= 0) ? scol : 0; float v_[32];
#pragma unroll
    for (int i = 0; i < 32; ++i) v_[i] = W[(size_t)(k0 + 2 * i + (lane >> 5)) * ldw + sc_];
#pragma unroll
    for (int i = 0; i < 32; ++i) { const int kk = 2 * i + (lane >> 5); scr[kk * 33 + (lane & 31)] = (scol >= 0) ? v_[i] : 0.f; }
    LDS_WAIT(); asm volatile("" ::: "memory");
    const int c = lane & 7;
#pragma unroll
    for (int j = 0; j < 4; ++j) { const int n = (lane >> 3) + 8 * j; const LAS float* s = scr + (8 * c) * 33 + n;
        u32x4 o; o.x = pk2(s[0 * 33], s[1 * 33]); o.y = pk2(s[2 * 33], s[3 * 33]); o.z = pk2(s[4 * 33], s[5 * 33]); o.w = pk2(s[6 * 33], s[7 * 33]);
        *(GAS u32x4*)(WT + (size_t)(drow0 + n) * K + k0 + 8 * c) = o; }
    LDS_WAIT(); asm volatile("" ::: "memory");
}
__device__ __forceinline__ void tr_item4(const float* W, int ldw, int K, bf16_t* WT, int drow0, int scol0, int k0, LAS float* scr, int lane, float wsc = 1.f) {
    const int kq = lane >> 3, nq = (lane & 7) * 4;
    f32x4 v[8];
#pragma unroll
    for (int i = 0; i < 8; ++i) v[i] = *(const f32x4*)(W + (size_t)(k0 + i * 8 + kq) * ldw + scol0 + nq);
#pragma unroll
    for (int i = 0; i < 8; ++i) { LAS float* d = scr + (i * 8 + kq) * 33 + nq; d[0] = v[i][0] * wsc; d[1] = v[i][1] * wsc; d[2] = v[i][2] * wsc; d[3] = v[i][3] * wsc; }
    LDS_WAIT(); asm volatile("" ::: "memory");
    const int c = lane & 7;
#pragma unroll
    for (int j = 0; j < 4; ++j) { const int n = (lane >> 3) + 8 * j; const LAS float* s = scr + (8 * c) * 33 + n;
        u32x4 o; o.x = pk2(s[0 * 33], s[1 * 33]); o.y = pk2(s[2 * 33], s[3 * 33]); o.z = pk2(s[4 * 33], s[5 * 33]); o.w = pk2(s[6 * 33], s[7 * 33]);
        *(GAS u32x4*)(WT + (size_t)(drow0 + n) * K + k0 + 8 * c) = o; }
    LDS_WAIT(); asm volatile("" ::: "memory");
}
struct TrD { const float* src; bf16_t* dst; unsigned char* dst8; int ldw, K, drow0, k0; float wsc; };
__device__ __forceinline__ void tr_load4(const TrD& d, f32x4 (&v)[8], int lane) {
    const int kq = lane >> 3, nq = (lane & 7) * 4;
#pragma unroll
    for (int i = 0; i < 8; ++i) v[i] = *(const f32x4*)(d.src + (size_t)(i * 8 + kq) * d.ldw + nq);
}
__device__ __forceinline__ void tr_finish4(const TrD& d, const f32x4 (&v)[8], LAS float* scr, int lane) {
    const int kq = lane >> 3, nq = (lane & 7) * 4;
#pragma unroll
    for (int i = 0; i < 8; ++i) { LAS float* p = scr + (i * 8 + kq) * 33 + nq; p[0] = v[i][0] * d.wsc; p[1] = v[i][1] * d.wsc; p[2] = v[i][2] * d.wsc; p[3] = v[i][3] * d.wsc; }
    LDS_WAIT(); asm volatile("" ::: "memory");
    const int c = lane & 7;
#pragma unroll
    for (int j = 0; j < 4; ++j) { const int n = (lane >> 3) + 8 * j; const LAS float* s = scr + (8 * c) * 33 + n;
        u32x4 o; o.x = pk2(s[0 * 33], s[1 * 33]); o.y = pk2(s[2 * 33], s[3 * 33]); o.z = pk2(s[4 * 33], s[5 * 33]); o.w = pk2(s[6 * 33], s[7 * 33]);
        *(GAS u32x4*)(d.dst + (size_t)(d.drow0 + n) * d.K + d.k0 + 8 * c) = o; }
    LDS_WAIT(); asm volatile("" ::: "memory");
}
__device__ __forceinline__ void tr_finish8(const TrD& d, const f32x4 (&v)[8], LAS float* scr, int lane) {
    const int kq = lane >> 3, nq = (lane & 7) * 4;
#pragma unroll
    for (int i = 0; i < 8; ++i) { LAS float* p = scr + (i * 8 + kq) * 33 + nq; p[0] = v[i][0] * d.wsc; p[1] = v[i][1] * d.wsc; p[2] = v[i][2] * d.wsc; p[3] = v[i][3] * d.wsc; }
    LDS_WAIT(); asm volatile("" ::: "memory");
    const int c = lane & 7; unsigned char* dst8 = (unsigned char*)d.dst;
#pragma unroll
    for (int j = 0; j < 4; ++j) { const int n = (lane >> 3) + 8 * j; const LAS float* s = scr + (8 * c) * 33 + n;
        u32x2 o; o.x = pk4_fp8(s[0 * 33], s[1 * 33], s[2 * 33], s[3 * 33]); o.y = pk4_fp8(s[4 * 33], s[5 * 33], s[6 * 33], s[7 * 33]);
        *(GAS u32x2*)(dst8 + (size_t)(d.drow0 + n) * d.K + d.k0 + 8 * c) = o; }
    LDS_WAIT(); asm volatile("" ::: "memory");
}
template <int NTL>
__device__ __forceinline__ void rows16_mm(f32x4 (&acc)[NTL], const bf16_t* A, const LAS bf16_t* Bt, int pitch, int lane) {
    const int lr = lane & 15, lq = lane >> 4;
    const bf16_t* ap = A + (size_t)lr * 1024 + lq * 8;
#pragma unroll 8
    for (int ks = 0; ks < 32; ++ks) {
        const bf16x8 a = *(const bf16x8*)(ap + ks * 32);
#pragma unroll
        for (int t = 0; t < NTL; ++t) { const bf16x8 b = *(const LAS bf16x8*)(Bt + (t * 16 + lr) * pitch + ks * 32 + lq * 8); acc[t] = __builtin_amdgcn_mfma_f32_16x16x32_bf16(a, b, acc[t], 0, 0, 0); }
    }
}
constexpr int TBP = 1056;
__device__ __forceinline__ void tail16(const bf16_t* Urow0, const LAS bf16_t* Wt, float* tail_row0, int lane) {
    f32x4 acc[2] = {(f32x4){0.f, 0.f, 0.f, 0.f}, (f32x4){0.f, 0.f, 0.f, 0.f}};
    rows16_mm<2>(acc, Urow0, Wt, TBP, lane);
    const int lr = lane & 15, lq = lane >> 4;
#pragma unroll
    for (int t = 0; t < 2; ++t)
#pragma unroll
        for (int r = 0; r < 4; ++r) tail_row0[(size_t)(lq * 4 + r) * 32 + t * 16 + lr] = acc[t][r];
}
__device__ __forceinline__ void load_tail_w(LAS bf16_t* Wt, const bf16_t* Wtail  , int tid) {
    for (int p = tid; p < 32 * 128; p += 512) { const int n = p >> 7, c = p & 127; *(LAS u32x4*)(Wt + n * TBP + c * 8) = *(const u32x4*)(Wtail + (size_t)n * 1024 + c * 8); }
}
constexpr int NSP = 1032;
constexpr int NMM_P_OFF = 32 * NSP * 2, NMM_LG_OFF = NMM_P_OFF + 8 * 1024 * 4;
struct NarrowT { bf16x8 bw[4][2]; };
__device__ __forceinline__ void nmm_load_tail(NarrowT& T, const bf16_t* Wtail  , int wid, int lane) {
    const int lr = lane & 15, lq = lane >> 4;
#pragma unroll
    for (int ks = 0; ks < 4; ++ks)
#pragma unroll
        for (int t = 0; t < 2; ++t) T.bw[ks][t] = *(const bf16x8*)(Wtail + (size_t)(t * 16 + lr) * 1024 + wid * 128 + ks * 32 + lq * 8);
}
__device__ __forceinline__ void nmm_load_router(NarrowT& T, const float* rw  , int wid, int lane) {
    const int lr = lane & 15, lq = lane >> 4;
#pragma unroll
    for (int ks = 0; ks < 4; ++ks) { u32x4 hi, lo;
#pragma unroll
        for (int i = 0; i < 4; ++i) { const int k = wid * 128 + ks * 32 + lq * 8 + 2 * i; const float w0 = rw[(size_t)k * 16 + lr], w1 = rw[(size_t)(k + 1) * 16 + lr];
            const unsigned h0 = f2bf(w0), h1 = f2bf(w1); hi[i] = h0 | (h1 << 16); lo[i] = f2bf(w0 - bf2f(h0)) | (f2bf(w1 - bf2f(h1)) << 16); }
        T.bw[ks][0] = __builtin_bit_cast(bf16x8, hi); T.bw[ks][1] = __builtin_bit_cast(bf16x8, lo); }
}
__device__ __forceinline__ void nmm_partials(const NarrowT& T, const LAS bf16_t* S, LAS float* Pb, int wid, int lane) {
    asm volatile("s_waitcnt lgkmcnt(0)\n\ts_barrier" ::: "memory");
    const int lr = lane & 15, lq = lane >> 4;
    f32x4 acc[2][2];
#pragma unroll
    for (int m = 0; m < 2; ++m)
#pragma unroll
        for (int t = 0; t < 2; ++t) acc[m][t] = (f32x4){0.f, 0.f, 0.f, 0.f};
#pragma unroll
    for (int m = 0; m < 2; ++m)
#pragma unroll
        for (int ks = 0; ks < 4; ++ks) { const bf16x8 a = *(const LAS bf16x8*)(S + (16 * m + lr) * NSP + wid * 128 + ks * 32 + lq * 8);
#pragma unroll
            for (int t = 0; t < 2; ++t) acc[m][t] = __builtin_amdgcn_mfma_f32_16x16x32_bf16(a, T.bw[ks][t], acc[m][t], 0, 0, 0); }
#pragma unroll
    for (int m = 0; m < 2; ++m)
#pragma unroll
        for (int t = 0; t < 2; ++t)
#pragma unroll
            for (int r = 0; r < 4; ++r) Pb[wid * 1024 + (16 * m + 4 * lq + r) * 32 + t * 16 + lr] = acc[m][t][r];
    asm volatile("s_waitcnt lgkmcnt(0)\n\ts_barrier" ::: "memory");
}
__device__ __forceinline__ void nmm_step_tail(const NarrowT& T, const LAS bf16_t* S, LAS float* Pb, float* tail_wg  , int i0, int tid, int wid, int lane) {
    nmm_partials(T, S, Pb, wid, lane);
#pragma unroll
    for (int q = 0; q < 2; ++q) { const int o = tid + 512 * q, sr = o >> 5, col = o & 31; float s = 0.f;
#pragma unroll
        for (int w = 0; w < 8; ++w) s += Pb[w * 1024 + o];
        tail_wg[(size_t)((sr >> 2) * 16 + i0 + (sr & 3)) * 32 + col] = s; }
}
__device__ __forceinline__ void nmm_step_router(const NarrowT& T, const LAS bf16_t* S, LAS float* Pb, LAS float* lgs  , int i0, int tid, int wid, int lane) {
    nmm_partials(T, S, Pb, wid, lane);
    { const int sr = tid >> 4, e = tid & 15; float s = 0.f;
#pragma unroll
      for (int w = 0; w < 8; ++w) s += Pb[w * 1024 + sr * 32 + e] + Pb[w * 1024 + sr * 32 + 16 + e];
      lgs[(sr >> 2) * 256 + (i0 + (sr & 3)) * 16 + e] = s; }
}
__device__ __forceinline__ int win_src_col(int n) {
    if (n < 1024) return n;
    if (n < 3584) return n + 8;
    const int i = n - 3584;
    if (i < 16) return 3592 + i;
    if (i < 20) return 1024 + (i - 16);
    if (i < 24) return 1028 + (i - 20);
    return -1;
}

namespace rec {
constexpr int PT = 72;
constexpr int TB = 64 * PT * 2;
constexpr int OFF_T0 = 0, OFF_T1 = TB, OFF_T2 = 2 * TB, OFF_T3 = 3 * TB, OFF_T4 = 4 * TB, OFF_T5 = 5 * TB;
constexpr int OFF_BM = 6 * TB;
constexpr int OFF_HM = OFF_BM + 16384;
constexpr int OFF_VEC = OFF_HM + 64 * 68 * 4;
constexpr int V_G = 0, V_M = 64, V_WI = 128, V_EM = 192, V_DI = 256, V_N = 320, V_BE = 384, V_SEG = 448, V_GA = 960;
static_assert(OFF_VEC + (960 + 1024) * 4 <= RING_BYTES, "rec LDS");

__device__ __forceinline__ void mm64(f32x4 (&acc)[2], const LAS bf16_t* A, const LAS bf16_t* Bt, int wid, int lane) {
    const int tm = wid >> 1, tn0 = (wid & 1) * 2, lr = lane & 15, lq = lane >> 4;
#pragma unroll
    for (int ks = 0; ks < 2; ++ks) {
        const bf16x8 a = *(const LAS bf16x8*)(A + (tm * 16 + lr) * PT + ks * 32 + lq * 8);
#pragma unroll
        for (int t = 0; t < 2; ++t) { const bf16x8 b = *(const LAS bf16x8*)(Bt + ((tn0 + t) * 16 + lr) * PT + ks * 32 + lq * 8);
            acc[t] = __builtin_amdgcn_mfma_f32_16x16x32_bf16(a, b, acc[t], 0, 0, 0); }
    }
}
__device__ __forceinline__ float scan_add(float v, int lane) {
#pragma unroll
    for (int o = 1; o < 64; o <<= 1) { const float t = __shfl_up(v, o); if (lane >= o) v += t; }
    return v;
}
__device__ __forceinline__ float scan_max(float v, int lane) {
#pragma unroll
    for (int o = 1; o < 64; o <<= 1) { const float t = __shfl_up(v, o); if (lane >= o) v = fmaxf(v, t); }
    return v;
}
__device__ __forceinline__ void st_tr8(LAS bf16_t* T, int l, int ch, u32x4 w) {
    T[(ch * 8 + 0) * PT + l] = (bf16_t)(w.x & 0xffffu); T[(ch * 8 + 1) * PT + l] = (bf16_t)(w.x >> 16);
    T[(ch * 8 + 2) * PT + l] = (bf16_t)(w.y & 0xffffu); T[(ch * 8 + 3) * PT + l] = (bf16_t)(w.y >> 16);
    T[(ch * 8 + 4) * PT + l] = (bf16_t)(w.z & 0xffffu); T[(ch * 8 + 5) * PT + l] = (bf16_t)(w.z >> 16);
    T[(ch * 8 + 6) * PT + l] = (bf16_t)(w.w & 0xffffu); T[(ch * 8 + 7) * PT + l] = (bf16_t)(w.w >> 16);
}
__device__ __forceinline__ void unpack8(u32x4 w, float (&f)[8]) {
    f[0] = bflo(w.x); f[1] = bfhi(w.x); f[2] = bflo(w.y); f[3] = bfhi(w.y); f[4] = bflo(w.z); f[5] = bfhi(w.z); f[6] = bflo(w.w); f[7] = bfhi(w.w);
}
template <int GATE  >
__device__ __forceinline__ void finalize(const LAS float* HM, const LAS float* rowscale, const float* gnorm, const bf16_t* gate, bf16_t* out, int tid) {
    const int j = tid >> 3, ch = tid & 7;
    const f32x4 a = *(const LAS f32x4*)(HM + j * 68 + ch * 8), c = *(const LAS f32x4*)(HM + j * 68 + ch * 8 + 4);
    const float rsc = rowscale ? rowscale[j] : 1.f;
    float v[8] = {a[0] * rsc, a[1] * rsc, a[2] * rsc, a[3] * rsc, c[0] * rsc, c[1] * rsc, c[2] * rsc, c[3] * rsc};
    float ss = 0.f;
#pragma unroll
    for (int i = 0; i < 8; ++i) ss += v[i] * v[i];
    ss += __shfl_xor(ss, 1); ss += __shfl_xor(ss, 2); ss += __shfl_xor(ss, 4);
    const float rs = __builtin_amdgcn_rsqf(ss * (1.f / 64.f) + LN_EPS);
    const u32x4 gw = *(const u32x4*)(gate + (size_t)j * PJ + ch * 8);
    float gt[8]; unpack8(gw, gt);
    const f32x4 g0 = *(const f32x4*)(gnorm + ch * 8), g1 = *(const f32x4*)(gnorm + ch * 8 + 4);
    const float gn[8] = {g0[0], g0[1], g0[2], g0[3], g1[0], g1[1], g1[2], g1[3]};
    float y[8];
#pragma unroll
    for (int i = 0; i < 8; ++i) { const float sg = 1.f / (1.f + fexp(-gt[i])); const float gv = GATE ? gt[i] * sg : sg; y[i] = v[i] * rs * gn[i] * gv; }
    u32x4 w; w.x = pk2(y[0], y[1]); w.y = pk2(y[2], y[3]); w.z = pk2(y[4], y[5]); w.w = pk2(y[6], y[7]);
    *(u32x4*)(out + (size_t)j * DM + ch * 8) = w;
}

struct RecP {
    const bf16_t* proj; const float* tail; const bf16_t* csm; const bf16_t* csg; float* stm; float* stg; float* smN; float* smBC; float* smDM; float* smMS; float* smGBE; bf16_t* ycat;
    const float* mbi; const float* mbf; const float* mg; const float* wa2; const float* ba; const float* gg;
};

struct MLoc { u32x4 k, v; float mi, mf; };
struct MOut { u32x4 q, k, v, st, mo; float mi, mf, m, n; };
struct GLoc { u32x4 k, v; f32x4 ga; };
struct GOut { u32x4 q, k, v, st, gr; f32x4 ga; };
struct GW { float wv[16]; float bav; };

__device__ __forceinline__ void ld_mloc(MLoc& L, const RecP& P, int ci, int tid, int wid, int lane) {
    const int bh = ci >> 6, c = ci & 63, b = bh >> 2, h = bh & 3, row0 = b * SEQ + c * 64, l = tid >> 3, ch = tid & 7;
    const bf16_t* pr = P.proj + (size_t)(row0 + l) * PJ + h * 64 + ch * 8;
    L.k = *(const u32x4*)(pr + C_MK); L.v = *(const u32x4*)(pr + C_MV);
    if (wid == 0) { const float* tp = P.tail + (size_t)(row0 + lane) * 32; L.mi = tp[T_MI + h]; L.mf = tp[T_MF + h]; } else { L.mi = 0.f; L.mf = 0.f; }
}
__device__ __forceinline__ void ld_mout(MOut& L, const RecP& P, int ci, int tid, int wid, int lane) {
    const int bh = ci >> 6, c = ci & 63, b = bh >> 2, h = bh & 3, row0 = b * SEQ + c * 64, l = tid >> 3, ch = tid & 7;
    const bf16_t* pr = P.proj + (size_t)(row0 + l) * PJ + h * 64 + ch * 8;
    L.q = *(const u32x4*)(pr + C_MQ); L.k = *(const u32x4*)(pr + C_MK); L.v = *(const u32x4*)(pr + C_MV); L.mo = *(const u32x4*)(pr + C_MO);
    L.st = *(const u32x4*)(P.csm + (size_t)ci * 4096 + l * 64 + ch * 8);
    if (wid == 0) { const float* tp = P.tail + (size_t)(row0 + lane) * 32; L.mi = tp[T_MI + h]; L.mf = tp[T_MF + h]; L.m = P.smMS[ci]; L.n = P.smN[(size_t)ci * 64 + lane]; } else { L.mi = 0.f; L.mf = 0.f; L.m = 0.f; L.n = 0.f; }
}
__device__ __forceinline__ void ld_gloc(GLoc& L, const RecP& P, int ci, int tid) {
    const int bh = ci >> 6, c = ci & 63, b = bh >> 2, h = bh & 3, row0 = b * SEQ + c * 64, l = tid >> 3, ch = tid & 7;
    const bf16_t* pr = P.proj + (size_t)(row0 + l) * PJ + h * 64 + ch * 8;
    L.k = *(const u32x4*)(pr + C_GK); L.v = *(const u32x4*)(pr + C_GV);
    L.ga = (tid < 256) ? *(const f32x4*)(P.tail + (size_t)(row0 + (tid >> 2)) * 32 + T_GA + (tid & 3) * 4) : (f32x4){0.f, 0.f, 0.f, 0.f};
}
__device__ __forceinline__ void ld_gout(GOut& L, const RecP& P, int ci, int tid) {
    const int bh = ci >> 6, c = ci & 63, b = bh >> 2, h = bh & 3, row0 = b * SEQ + c * 64, l = tid >> 3, ch = tid & 7;
    const bf16_t* pr = P.proj + (size_t)(row0 + l) * PJ + h * 64 + ch * 8;
    L.q = *(const u32x4*)(pr + C_GQ); L.k = *(const u32x4*)(pr + C_GK); L.v = *(const u32x4*)(pr + C_GV); L.gr = *(const u32x4*)(pr + C_GR);
    L.st = *(const u32x4*)(P.csg + (size_t)ci * 4096 + l * 64 + ch * 8);
    L.ga = (tid < 256) ? *(const f32x4*)(P.tail + (size_t)(row0 + (tid >> 2)) * 32 + T_GA + (tid & 3) * 4) : (f32x4){0.f, 0.f, 0.f, 0.f};
}
__device__ __forceinline__ void ld_gw(GW& W, const RecP& P, int h, int tid) {
    const int dcol = tid & 63;
#pragma unroll
    for (int r = 0; r < 16; ++r) W.wv[r] = P.wa2[r * 256 + h * 64 + dcol];
    W.bav = P.ba[h * 64 + dcol];
}
template <int GATE  >
__device__ __forceinline__ void finalize2(const LAS float* HM, const LAS float* rowscale, const float* gnorm, u32x4 gw, bf16_t* out, int tid) {
    const int j = tid >> 3, ch = tid & 7;
    const f32x4 a = *(const LAS f32x4*)(HM + j * 68 + ch * 8), c = *(const LAS f32x4*)(HM + j * 68 + ch * 8 + 4);
    const float rsc = rowscale ? rowscale[j] : 1.f;
    float v[8] = {a[0] * rsc, a[1] * rsc, a[2] * rsc, a[3] * rsc, c[0] * rsc, c[1] * rsc, c[2] * rsc, c[3] * rsc};
    float ss = 0.f;
#pragma unroll
    for (int i = 0; i < 8; ++i) ss += v[i] * v[i];
    ss += __shfl_xor(ss, 1); ss += __shfl_xor(ss, 2); ss += __shfl_xor(ss, 4);
    const float rs = __builtin_amdgcn_rsqf(ss * (1.f / 64.f) + LN_EPS);
    float gt[8]; unpack8(gw, gt);
    const f32x4 g0 = *(const f32x4*)(gnorm + ch * 8), g1 = *(const f32x4*)(gnorm + ch * 8 + 4);
    const float gn[8] = {g0[0], g0[1], g0[2], g0[3], g1[0], g1[1], g1[2], g1[3]};
    float y[8];
#pragma unroll
    for (int i = 0; i < 8; ++i) { const float sg = 1.f / (1.f + fexp(-gt[i])); const float gv = GATE ? gt[i] * sg : sg; y[i] = v[i] * rs * gn[i] * gv; }
    u32x4 w; w.x = pk2(y[0], y[1]); w.y = pk2(y[2], y[3]); w.z = pk2(y[4], y[5]); w.w = pk2(y[6], y[7]);
    *(u32x4*)(out + (size_t)j * DM + ch * 8) = w;
}
__device__ __forceinline__ void mlstm_local(const MLoc& L, const RecP& P, LAS unsigned char* lds, int ci, int tid, int wid, int lane) {
    const int h = (ci >> 6) & 3;
    LAS bf16_t* KT = (LAS bf16_t*)(lds + OFF_T0); LAS bf16_t* VT = (LAS bf16_t*)(lds + OFF_T1); LAS float* vec = (LAS float*)(lds + OFF_VEC);
    const int l = tid >> 3, ch = tid & 7;
    if (wid == 0) {
        const float li = L.mi + P.mbi[h], lf = logsig(L.mf + P.mbf[h]);
        const float bc = scan_add(lf, lane), g = li - bc;
        const float gmax = wave_max(g), bend = __shfl(bc, 63);
        vec[V_G + lane] = fexp(g - gmax);
        if (lane == 0) { P.smBC[ci] = bend; P.smDM[ci] = bend + gmax; }
    }
    __syncthreads();
    { const float w = vec[V_G + l]; float kf[8]; unpack8(L.k, kf);
      u32x4 ks; ks.x = pk2(kf[0] * w, kf[1] * w); ks.y = pk2(kf[2] * w, kf[3] * w); ks.z = pk2(kf[4] * w, kf[5] * w); ks.w = pk2(kf[6] * w, kf[7] * w);
      st_tr8(KT, l, ch, ks); st_tr8(VT, l, ch, L.v); }
    __syncthreads();
    f32x4 acc[2] = {(f32x4){0.f, 0.f, 0.f, 0.f}, (f32x4){0.f, 0.f, 0.f, 0.f}};
    mm64(acc, VT, KT, wid, lane);
    { const int tm = wid >> 1, tn0 = (wid & 1) * 2, lr = lane & 15, lq = lane >> 4; float* dst = P.stm + (size_t)ci * 4096;
#pragma unroll
      for (int t = 0; t < 2; ++t)
#pragma unroll
          for (int r = 0; r < 4; ++r) dst[(tm * 16 + lq * 4 + r) * 64 + (tn0 + t) * 16 + lr] = acc[t][r]; }
    if (tid < 64) { float s = 0.f;
#pragma unroll
        for (int q = 0; q < 8; ++q) { const u32x4 w = *(const LAS u32x4*)(KT + tid * PT + q * 8); float f[8]; unpack8(w, f);
#pragma unroll
            for (int i = 0; i < 8; ++i) s += f[i]; }
        P.smN[(size_t)ci * 64 + tid] = s; }
    __syncthreads();
}
__device__ __forceinline__ void mlstm_out(const MOut& L, const RecP& P, LAS unsigned char* lds, int ci, int tid, int wid, int lane) {
    const int bh = ci >> 6, c = ci & 63, b = bh >> 2, h = bh & 3, row0 = b * SEQ + c * 64;
    LAS bf16_t* Qm = (LAS bf16_t*)(lds + OFF_T0); LAS bf16_t* Km = (LAS bf16_t*)(lds + OFF_T1); LAS bf16_t* VT = (LAS bf16_t*)(lds + OFF_T2);
    LAS bf16_t* CT = (LAS bf16_t*)(lds + OFF_T3); LAS bf16_t* Sm = (LAS bf16_t*)(lds + OFF_T4);
    LAS float* HM = (LAS float*)(lds + OFF_HM); LAS float* vec = (LAS float*)(lds + OFF_VEC);
    const int l = tid >> 3, ch = tid & 7;
    *(LAS u32x4*)(Qm + l * PT + ch * 8) = L.q; *(LAS u32x4*)(Km + l * PT + ch * 8) = L.k; st_tr8(VT, l, ch, L.v); *(LAS u32x4*)(CT + l * PT + ch * 8) = L.st;
    if (wid == 0) {
        const float li = L.mi + P.mbi[h], lf = logsig(L.mf + P.mbf[h]);
        const float bc = scan_add(lf, lane), g = li - bc;
        const float pm = scan_max(g, lane), m = L.m, M = fmaxf(m, pm);
        vec[V_G + lane] = g; vec[V_M + lane] = M; vec[V_WI + lane] = fexp(m - M); vec[V_EM + lane] = fexp(-bc - M);
        vec[V_N + lane] = L.n;
    }
    __syncthreads();
    { f32x4 acc[2] = {(f32x4){0.f, 0.f, 0.f, 0.f}, (f32x4){0.f, 0.f, 0.f, 0.f}};
      mm64(acc, Qm, Km, wid, lane);
      const int tm = wid >> 1, tn0 = (wid & 1) * 2, lr = lane & 15, lq = lane >> 4;
#pragma unroll
      for (int t = 0; t < 2; ++t) { const int ll = (tn0 + t) * 16 + lr; const float gl = vec[V_G + ll];
#pragma unroll
          for (int r = 0; r < 4; ++r) { const int j = tm * 16 + lq * 4 + r; const float s = (ll <= j) ? acc[t][r] * fexp(gl - vec[V_M + j]) : 0.f; Sm[j * PT + ll] = (bf16_t)f2bf(s); } } }
    __syncthreads();
    { f32x4 a1[2] = {(f32x4){0.f, 0.f, 0.f, 0.f}, (f32x4){0.f, 0.f, 0.f, 0.f}}, a2[2] = {(f32x4){0.f, 0.f, 0.f, 0.f}, (f32x4){0.f, 0.f, 0.f, 0.f}};
      mm64(a1, Sm, VT, wid, lane); mm64(a2, Qm, CT, wid, lane);
      const int tm = wid >> 1, tn0 = (wid & 1) * 2, lr = lane & 15, lq = lane >> 4;
#pragma unroll
      for (int t = 0; t < 2; ++t)
#pragma unroll
          for (int r = 0; r < 4; ++r) { const int j = tm * 16 + lq * 4 + r; HM[j * 68 + (tn0 + t) * 16 + lr] = a1[t][r] + vec[V_WI + j] * a2[t][r]; } }
    if (tid < 64) { float ds = 0.f, qn = 0.f;
#pragma unroll
        for (int q = 0; q < 8; ++q) { const u32x4 w = *(const LAS u32x4*)(Sm + tid * PT + q * 8); float f[8]; unpack8(w, f);
            const u32x4 qw = *(const LAS u32x4*)(Qm + tid * PT + q * 8); float qf[8]; unpack8(qw, qf);
#pragma unroll
            for (int i = 0; i < 8; ++i) { ds += f[i]; qn += qf[i] * vec[V_N + q * 8 + i]; } }
        const float den = ds + vec[V_WI + tid] * qn;
        vec[V_DI + tid] = 1.f / fmaxf(fabsf(den), vec[V_EM + tid]); }
    __syncthreads();
    finalize2<0>(HM, vec + V_DI, P.mg, L.mo, P.ycat + (size_t)row0 * DM + h * 64, tid);
    __syncthreads();
}
__device__ __forceinline__ void gla_bmat(const f32x4 ga, const GW& W, LAS unsigned char* lds, int tid, int wid) {
    LAS float* BM = (LAS float*)(lds + OFF_BM); LAS float* vec = (LAS float*)(lds + OFF_VEC);
    if (tid < 256) { const int l = tid >> 2, q = tid & 3; vec[V_GA + l * 16 + q * 4 + 0] = ga[0]; vec[V_GA + l * 16 + q * 4 + 1] = ga[1]; vec[V_GA + l * 16 + q * 4 + 2] = ga[2]; vec[V_GA + l * 16 + q * 4 + 3] = ga[3]; }
    const int dcol = tid & 63;
    __syncthreads();
    float cs[8]; float cacc = 0.f;
#pragma unroll
    for (int i = 0; i < 8; ++i) { const int l = wid * 8 + i; float z = W.bav;
#pragma unroll
        for (int r = 0; r < 16; ++r) z += vec[V_GA + l * 16 + r] * W.wv[r];
        cacc += logsig(z) * (1.f / 16.f); cs[i] = cacc; }
    vec[V_SEG + wid * 64 + dcol] = cacc;
    __syncthreads();
    float off = 0.f, tot = 0.f;
#pragma unroll
    for (int s = 0; s < 8; ++s) { const float v = vec[V_SEG + s * 64 + dcol]; tot += v; if (s < wid) off += v; }
#pragma unroll
    for (int i = 0; i < 8; ++i) BM[(wid * 8 + i) * 64 + dcol] = off + cs[i];
    if (wid == 0) vec[V_BE + dcol] = tot;
    __syncthreads();
}
__device__ __forceinline__ void gla_local(const GLoc& L, const GW& W, const RecP& P, LAS unsigned char* lds, int ci, int tid, int wid, int lane) {
    LAS bf16_t* KT = (LAS bf16_t*)(lds + OFF_T0); LAS bf16_t* VT = (LAS bf16_t*)(lds + OFF_T1);
    LAS float* BM = (LAS float*)(lds + OFF_BM); LAS float* vec = (LAS float*)(lds + OFF_VEC);
    const int l = tid >> 3, ch = tid & 7;
    gla_bmat(L.ga, W, lds, tid, wid);
    if (tid < 64) P.smGBE[(size_t)ci * 64 + tid] = vec[V_BE + tid];
    { float kf[8]; unpack8(L.k, kf); float ks[8];
#pragma unroll
      for (int i = 0; i < 8; ++i) { const int d = ch * 8 + i; ks[i] = kf[i] * fexp(vec[V_BE + d] - BM[l * 64 + d]); }
      u32x4 kk; kk.x = pk2(ks[0], ks[1]); kk.y = pk2(ks[2], ks[3]); kk.z = pk2(ks[4], ks[5]); kk.w = pk2(ks[6], ks[7]);
      st_tr8(KT, l, ch, kk); st_tr8(VT, l, ch, L.v); }
    __syncthreads();
    f32x4 acc[2] = {(f32x4){0.f, 0.f, 0.f, 0.f}, (f32x4){0.f, 0.f, 0.f, 0.f}};
    mm64(acc, VT, KT, wid, lane);
    { const int tm = wid >> 1, tn0 = (wid & 1) * 2, lr = lane & 15, lq = lane >> 4; float* dst = P.stg + (size_t)ci * 4096;
#pragma unroll
      for (int t = 0; t < 2; ++t)
#pragma unroll
          for (int r = 0; r < 4; ++r) dst[(tm * 16 + lq * 4 + r) * 64 + (tn0 + t) * 16 + lr] = acc[t][r]; }
    __syncthreads();
}
__device__ __forceinline__ void gla_out(const GOut& L, const GW& W, const RecP& P, LAS unsigned char* lds, int ci, int tid, int wid, int lane) {
    const int bh = ci >> 6, c = ci & 63, b = bh >> 2, h = bh & 3, row0 = b * SEQ + c * 64;
    LAS bf16_t* Qm = (LAS bf16_t*)(lds + OFF_T0); LAS bf16_t* Km = (LAS bf16_t*)(lds + OFF_T1); LAS bf16_t* VT = (LAS bf16_t*)(lds + OFF_T2);
    LAS bf16_t* ST = (LAS bf16_t*)(lds + OFF_T3); LAS bf16_t* Sm = (LAS bf16_t*)(lds + OFF_T4);
    LAS float* BM = (LAS float*)(lds + OFF_BM); LAS float* HM = (LAS float*)(lds + OFF_HM);
    const int l = tid >> 3, ch = tid & 7;
    gla_bmat(L.ga, W, lds, tid, wid);
    { float qf[8], kf[8]; unpack8(L.q, qf); unpack8(L.k, kf); float qs[8], ks[8];
#pragma unroll
      for (int i = 0; i < 8; ++i) { const float bv = BM[l * 64 + ch * 8 + i]; qs[i] = qf[i] * fexp(bv); ks[i] = kf[i] * fexp(-bv); }
      u32x4 qq, kk; qq.x = pk2(qs[0], qs[1]); qq.y = pk2(qs[2], qs[3]); qq.z = pk2(qs[4], qs[5]); qq.w = pk2(qs[6], qs[7]);
      kk.x = pk2(ks[0], ks[1]); kk.y = pk2(ks[2], ks[3]); kk.z = pk2(ks[4], ks[5]); kk.w = pk2(ks[6], ks[7]);
      *(LAS u32x4*)(Qm + l * PT + ch * 8) = qq; *(LAS u32x4*)(Km + l * PT + ch * 8) = kk; st_tr8(VT, l, ch, L.v);
      *(LAS u32x4*)(ST + l * PT + ch * 8) = L.st; }
    __syncthreads();
    { f32x4 acc[2] = {(f32x4){0.f, 0.f, 0.f, 0.f}, (f32x4){0.f, 0.f, 0.f, 0.f}};
      mm64(acc, Qm, Km, wid, lane);
      const int tm = wid >> 1, tn0 = (wid & 1) * 2, lr = lane & 15, lq = lane >> 4;
#pragma unroll
      for (int t = 0; t < 2; ++t) { const int ll = (tn0 + t) * 16 + lr;
#pragma unroll
          for (int r = 0; r < 4; ++r) { const int j = tm * 16 + lq * 4 + r; Sm[j * PT + ll] = (bf16_t)f2bf((ll <= j) ? acc[t][r] : 0.f); } } }
    __syncthreads();
    { f32x4 acc[2] = {(f32x4){0.f, 0.f, 0.f, 0.f}, (f32x4){0.f, 0.f, 0.f, 0.f}};
      mm64(acc, Sm, VT, wid, lane); mm64(acc, Qm, ST, wid, lane);
      const int tm = wid >> 1, tn0 = (wid & 1) * 2, lr = lane & 15, lq = lane >> 4;
#pragma unroll
      for (int t = 0; t < 2; ++t)
#pragma unroll
          for (int r = 0; r < 4; ++r) HM[(tm * 16 + lq * 4 + r) * 68 + (tn0 + t) * 16 + lr] = acc[t][r]; }
    __syncthreads();
    finalize2<1>(HM, nullptr, P.gg, L.gr, P.ycat + (size_t)row0 * DM + 768 + h * 64, tid);
    __syncthreads();
}
}

namespace recw {
using rec::RecP; using rec::scan_add; using rec::scan_max; using rec::unpack8;
typedef short s16x4v __attribute__((ext_vector_type(4)));
typedef short v4i16_t __attribute__((ext_vector_type(4)));
#define MF16(a, b, c) __builtin_amdgcn_mfma_f32_16x16x32_bf16((a), (b), (c), 0, 0, 0)
__device__ __forceinline__ s16x4v tr16(const LAS bf16_t* p) { return __builtin_bit_cast(s16x4v, __builtin_amdgcn_ds_read_tr16_b64_v4i16((LAS v4i16_t*)p)); }
__device__ __forceinline__ bf16x8 trfrag(const LAS bf16_t* T, int pitch, int s, int c0, int lane) {
    const int i = lane & 15, q = lane >> 4;
    const LAS bf16_t* pa = T + (32 * s + 4 * q + (i >> 2)) * pitch + c0 + 4 * (i & 3);
    const s16x4v lo = tr16(pa), hi = tr16(pa + 16 * pitch);
    return (bf16x8){lo[0], lo[1], lo[2], lo[3], hi[0], hi[1], hi[2], hi[3]};
}
__device__ __forceinline__ bf16x8 rfg(const bf16_t* X, int pitch, int T, int ks, int lane) { return *(const bf16x8*)(X + (size_t)(16 * T + (lane & 15)) * pitch + 32 * ks + 8 * (lane >> 4)); }
__device__ __forceinline__ u32x4 piece(const bf16_t* X, int pitch, int i, int lane) { return *(const u32x4*)(X + (size_t)((lane >> 3) + 8 * i) * pitch + (lane & 7) * 8); }
__device__ __forceinline__ bf16x8 frag_scale(bf16x8 f, float sc) {
    const u32x4 w = __builtin_bit_cast(u32x4, f); u32x4 o;
    o.x = pk2(bflo(w.x) * sc, bfhi(w.x) * sc); o.y = pk2(bflo(w.y) * sc, bfhi(w.y) * sc); o.z = pk2(bflo(w.z) * sc, bfhi(w.z) * sc); o.w = pk2(bflo(w.w) * sc, bfhi(w.w) * sc);
    return __builtin_bit_cast(bf16x8, o);
}
__device__ __forceinline__ bf16x8 frag_mul(bf16x8 f, bf16x8 g, bool recip) {
    const u32x4 a = __builtin_bit_cast(u32x4, f), b = __builtin_bit_cast(u32x4, g); float x[8], y[8]; unpack8(a, x); unpack8(b, y);
#pragma unroll
    for (int i = 0; i < 8; ++i) x[i] = recip ? x[i] * __builtin_amdgcn_rcpf(y[i]) : x[i] * y[i];
    u32x4 o; o.x = pk2(x[0], x[1]); o.y = pk2(x[2], x[3]); o.z = pk2(x[4], x[5]); o.w = pk2(x[6], x[7]);
    return __builtin_bit_cast(bf16x8, o);
}
__device__ __forceinline__ float red_q(float v) { v += __shfl_xor(v, 16); v += __shfl_xor(v, 32); return v; }
__device__ __forceinline__ void stage_rows(f32x4 (&O)[4], int Tj, float rowscale, LAS bf16_t* Tl, int PTL, int lane) {
    const int r = lane & 15, q = lane >> 4;
    float ss = 0.f;
#pragma unroll
    for (int Te = 0; Te < 4; ++Te) { O[Te] = O[Te] * rowscale; const f32x4 v = O[Te]; ss += (v[0] * v[0] + v[1] * v[1]) + (v[2] * v[2] + v[3] * v[3]); }
    ss = red_q(ss);
    const float rs = __builtin_amdgcn_rsqf(ss * (1.f / 64.f) + LN_EPS);
#pragma unroll
    for (int Te = 0; Te < 4; ++Te) { const f32x4 v = O[Te] * rs; u32x2 w; w.x = pk2(v[0], v[1]); w.y = pk2(v[2], v[3]); *(LAS u32x2*)(Tl + (16 * Tj + r) * PTL + 16 * Te + 4 * q) = w; }
}
template <int GATE>
__device__ __forceinline__ void final_store(const LAS bf16_t* Tl, int PTL, const float* gnorm, const bf16_t* gate, bf16_t* out, int lane) {
    const int ch = lane & 7;
    const f32x4 g0 = *(const f32x4*)(gnorm + ch * 8), g1 = *(const f32x4*)(gnorm + ch * 8 + 4);
    const float gn[8] = {g0[0], g0[1], g0[2], g0[3], g1[0], g1[1], g1[2], g1[3]};
    u32x4 gw8[8];
#pragma unroll
    for (int i = 0; i < 8; ++i) gw8[i] = *(const u32x4*)(gate + (size_t)((lane >> 3) + 8 * i) * PJ + ch * 8);
    __builtin_amdgcn_sched_barrier(0);
#pragma unroll
    for (int i = 0; i < 8; ++i) { const int row = (lane >> 3) + 8 * i;
        float hv[8], gt[8]; unpack8(*(const LAS u32x4*)(Tl + row * PTL + ch * 8), hv); unpack8(gw8[i], gt);
        float y[8];
#pragma unroll
        for (int k = 0; k < 8; ++k) { const float sg = __builtin_amdgcn_rcpf(1.f + fexp(-gt[k])); y[k] = hv[k] * (gn[k] * Y8S) * (GATE ? gt[k] * sg : sg); }
        u32x2 w; w.x = pk4_fp8(y[0], y[1], y[2], y[3]); w.y = pk4_fp8(y[4], y[5], y[6], y[7]);
        *(u32x2*)((unsigned char*)out + (size_t)row * DM + ch * 8) = w; }
}
__device__ __forceinline__ void mlstm_local_w(const RecP& P, LAS unsigned char* wl, int ci, int lane) {
    const int r = lane & 15, q = lane >> 4; constexpr int PL = 64;
    const int bh = ci >> 6, c = ci & 63, b = bh >> 2, h = bh & 3, row0 = b * SEQ + c * 64;
    const bf16_t* Xk = P.proj + (size_t)row0 * PJ + C_MK + h * 64; const bf16_t* Xv = P.proj + (size_t)row0 * PJ + C_MV + h * 64;
    LAS bf16_t* Kl = (LAS bf16_t*)wl; LAS bf16_t* Vl = (LAS bf16_t*)(wl + 8192);
    const float* tp = P.tail + (size_t)(row0 + lane) * 32;
    const float li = tp[T_MI + h] + P.mbi[h], lf = logsig(tp[T_MF + h] + P.mbf[h]);
    const float bc = scan_add(lf, lane), g = li - bc, gmax = wave_max(g), bend = __shfl(bc, 63), w = fexp(g - gmax);
    if (lane == 0) { P.smBC[ci] = bend; P.smDM[ci] = bend + gmax; }
    u32x4 kp8_[8], vp8_[8];
#pragma unroll
    for (int i = 0; i < 8; ++i) { kp8_[i] = piece(Xk, PJ, i, lane); vp8_[i] = piece(Xv, PJ, i, lane); }
    __builtin_amdgcn_sched_barrier(0);
#pragma unroll
    for (int i = 0; i < 8; ++i) { const u32x4 kpi = kp8_[i], vpi = vp8_[i]; const float wr_ = __shfl(w, (lane >> 3) + 8 * i); float kf[8]; unpack8(kpi, kf);
        u32x4 ks; ks.x = pk2(kf[0] * wr_, kf[1] * wr_); ks.y = pk2(kf[2] * wr_, kf[3] * wr_); ks.z = pk2(kf[4] * wr_, kf[5] * wr_); ks.w = pk2(kf[6] * wr_, kf[7] * wr_);
        *(LAS u32x4*)(Kl + ((lane >> 3) + 8 * i) * PL + (lane & 7) * 8) = ks; *(LAS u32x4*)(Vl + ((lane >> 3) + 8 * i) * PL + (lane & 7) * 8) = vpi; }
    asm volatile("" ::: "memory"); __builtin_amdgcn_sched_barrier(0);
    bf16x8 Kt[4][2];
#pragma unroll
    for (int Td = 0; Td < 4; ++Td)
#pragma unroll
        for (int s = 0; s < 2; ++s) Kt[Td][s] = trfrag(Kl, PL, s, 16 * Td, lane);
#pragma unroll
    for (int Te = 0; Te < 4; ++Te) { const bf16x8 v0 = trfrag(Vl, PL, 0, 16 * Te, lane), v1 = trfrag(Vl, PL, 1, 16 * Te, lane);
#pragma unroll
        for (int Td = 0; Td < 4; ++Td) { f32x4 acc = (f32x4){0.f, 0.f, 0.f, 0.f}; acc = MF16(Kt[Td][0], v0, acc); acc = MF16(Kt[Td][1], v1, acc);
            u32x2 w; w.x = pk2(acc[0], acc[1]); w.y = pk2(acc[2], acc[3]); *(LAS u32x2*)(Kl + (16 * Te + r) * PL + 16 * Td + 4 * q) = w; } }
    asm volatile("" ::: "memory"); __builtin_amdgcn_sched_barrier(0);
    { bf16_t* dstb = (bf16_t*)P.stm + (size_t)ci * 4096;
#pragma unroll
      for (int i = 0; i < 8; ++i) { const int row = (lane >> 3) + 8 * i, ch = lane & 7; *(u32x4*)(dstb + row * 64 + ch * 8) = *(const LAS u32x4*)(Kl + row * PL + ch * 8); } }
    { const short one = (short)0x3F80; const bf16x8 ones = (bf16x8){one, one, one, one, one, one, one, one};
#pragma unroll
      for (int Td = 0; Td < 4; ++Td) { f32x4 acc = (f32x4){0.f, 0.f, 0.f, 0.f}; acc = MF16(ones, Kt[Td][0], acc); acc = MF16(ones, Kt[Td][1], acc);
          if (q == 0) P.smN[(size_t)ci * 64 + 16 * Td + r] = acc[0]; } }
}
struct GWf { bf16x8 Bw[4]; float ba[4]; };
__device__ __forceinline__ void ld_gwf(GWf& W, const RecP& P, int h, int lane) {
    const int r = lane & 15, q = lane >> 4;
    int wo = (8 * (q & 1)) * 256 + h * 64 + r; asm volatile("" : "+v"(wo)); const float* wp = P.wa2 + wo;
#pragma unroll
    for (int Td = 0; Td < 4; ++Td) { float w8[8];
#pragma unroll
        for (int i = 0; i < 8; ++i) { const float wv_ = wp[i * 256 + 16 * Td]; w8[i] = (q < 2) ? wv_ : 0.f; }
        u32x4 o; o.x = pk2(w8[0], w8[1]); o.y = pk2(w8[2], w8[3]); o.z = pk2(w8[4], w8[5]); o.w = pk2(w8[6], w8[7]); W.Bw[Td] = __builtin_bit_cast(bf16x8, o);
        W.ba[Td] = P.ba[h * 64 + 16 * Td + r]; }
}
template <int MODE>
__device__ __forceinline__ void gla_gate_tile(LAS bf16_t* Tt, int PL, float (&bend)[4], const GWf& W, const float* tail_row0, int lane) {
    const int r = lane & 15, q = lane >> 4;
    bf16x8 Ag[4];
    int to = r * 32 + T_GA + 8 * (q & 1); asm volatile("" : "+v"(to)); const float* tpb = tail_row0 + to;
    f32x4 ar0[4], ar1[4];
#pragma unroll
    for (int Tl = 0; Tl < 4; ++Tl) { ar0[Tl] = *(const f32x4*)(tpb + Tl * 512); ar1[Tl] = *(const f32x4*)(tpb + Tl * 512 + 4); }
    __builtin_amdgcn_sched_barrier(0);
#pragma unroll
    for (int Tl = 0; Tl < 4; ++Tl) { f32x4 a0 = ar0[Tl], a1 = ar1[Tl];
        if (q >= 2) { a0 = (f32x4){0.f, 0.f, 0.f, 0.f}; a1 = a0; }
        u32x4 o; o.x = pk2(a0[0], a0[1]); o.y = pk2(a0[2], a0[3]); o.z = pk2(a1[0], a1[1]); o.w = pk2(a1[2], a1[3]); Ag[Tl] = __builtin_bit_cast(bf16x8, o); }
#pragma unroll
    for (int Td = 0; Td < 4; ++Td) { float carry = 0.f; LAS bf16_t* tcol = Tt + (4 * q) * PL + 16 * Td + r;
#pragma unroll
        for (int tt = 0; tt < 4; ++tt) { const int Tl = MODE ? 3 - tt : tt; const float bb = W.ba[Td]; const f32x4 z = MF16(Ag[Tl], W.Bw[Td], ((f32x4){bb, bb, bb, bb}));
            const float v0 = logsig(z[0]) * (1.f / 16.f), v1 = logsig(z[1]) * (1.f / 16.f), v2 = logsig(z[2]) * (1.f / 16.f), v3 = logsig(z[3]) * (1.f / 16.f);
            const float lt = (v0 + v1) + (v2 + v3);
            float ex, o0, o1, o2, o3;
            if (MODE == 0) { const float t1 = __shfl_up(lt, 16), t2 = __shfl_up(lt, 32), t3 = __shfl_up(lt, 48); ex = carry + (q >= 1 ? t1 : 0.f) + (q >= 2 ? t2 : 0.f) + (q >= 3 ? t3 : 0.f);
                o0 = ex + v0; o1 = o0 + v1; o2 = o1 + v2; o3 = o2 + v3; }
            else { const float t1 = __shfl_down(lt, 16), t2 = __shfl_down(lt, 32), t3 = __shfl_down(lt, 48); ex = carry + (q <= 2 ? t1 : 0.f) + (q <= 1 ? t2 : 0.f) + (q <= 0 ? t3 : 0.f);
                o3 = ex; o2 = o3 + v3; o1 = o2 + v2; o0 = o1 + v1; }
            carry += red_q(lt);
            LAS bf16_t* tp = tcol + (16 * Tl) * PL;
            const unsigned w01 = pk2(fexp(o0), fexp(o1)), w23 = pk2(fexp(o2), fexp(o3));
            tp[0] = (bf16_t)(w01 & 0xffffu); tp[PL] = (bf16_t)(w01 >> 16); tp[2 * PL] = (bf16_t)(w23 & 0xffffu); tp[3 * PL] = (bf16_t)(w23 >> 16); }
        bend[Td] = carry; }
}
__device__ __forceinline__ void gla_local_w(const RecP& P, const GWf& W, LAS unsigned char* wl, int ci, int lane) {
    const int r = lane & 15, q = lane >> 4; constexpr int PL = 64;
    const int bh = ci >> 6, c = ci & 63, b = bh >> 2, h = bh & 3, row0 = b * SEQ + c * 64;
    const bf16_t* Xk = P.proj + (size_t)row0 * PJ + C_GK + h * 64; const bf16_t* Xv = P.proj + (size_t)row0 * PJ + C_GV + h * 64;
    LAS bf16_t* Kl = (LAS bf16_t*)wl; LAS bf16_t* Vl = (LAS bf16_t*)(wl + 8192);
    { float bend[4]; gla_gate_tile<1>(Kl, PL, bend, W, P.tail + (size_t)row0 * 32, lane);
      if (q == 0) {
#pragma unroll
          for (int Td = 0; Td < 4; ++Td) P.smGBE[(size_t)ci * 64 + 16 * Td + r] = bend[Td]; } }
    asm volatile("" ::: "memory"); __builtin_amdgcn_sched_barrier(0);
    u32x4 kp8_[8], vp8_[8];
#pragma unroll
    for (int i = 0; i < 8; ++i) { kp8_[i] = piece(Xk, PJ, i, lane); vp8_[i] = piece(Xv, PJ, i, lane); }
    __builtin_amdgcn_sched_barrier(0);
#pragma unroll
    for (int i = 0; i < 8; ++i) { const u32x4 kp = kp8_[i], vp = vp8_[i];
        LAS bf16_t* kp_l = Kl + ((lane >> 3) + 8 * i) * PL + (lane & 7) * 8; float kf[8], ff[8]; unpack8(kp, kf); unpack8(*(const LAS u32x4*)kp_l, ff);
        u32x4 ks; ks.x = pk2(kf[0] * ff[0], kf[1] * ff[1]); ks.y = pk2(kf[2] * ff[2], kf[3] * ff[3]); ks.z = pk2(kf[4] * ff[4], kf[5] * ff[5]); ks.w = pk2(kf[6] * ff[6], kf[7] * ff[7]);
        *(LAS u32x4*)kp_l = ks; *(LAS u32x4*)(Vl + ((lane >> 3) + 8 * i) * PL + (lane & 7) * 8) = vp; }
    asm volatile("" ::: "memory"); __builtin_amdgcn_sched_barrier(0);
    bf16x8 Kt[4][2];
#pragma unroll
    for (int Td = 0; Td < 4; ++Td)
#pragma unroll
        for (int s = 0; s < 2; ++s) Kt[Td][s] = trfrag(Kl, PL, s, 16 * Td, lane);
#pragma unroll
    for (int Te = 0; Te < 4; ++Te) { const bf16x8 v0 = trfrag(Vl, PL, 0, 16 * Te, lane), v1 = trfrag(Vl, PL, 1, 16 * Te, lane);
#pragma unroll
        for (int Td = 0; Td < 4; ++Td) { f32x4 acc = (f32x4){0.f, 0.f, 0.f, 0.f}; acc = MF16(Kt[Td][0], v0, acc); acc = MF16(Kt[Td][1], v1, acc);
            u32x2 w; w.x = pk2(acc[0], acc[1]); w.y = pk2(acc[2], acc[3]); *(LAS u32x2*)(Kl + (16 * Te + r) * PL + 16 * Td + 4 * q) = w; } }
    asm volatile("" ::: "memory"); __builtin_amdgcn_sched_barrier(0);
    { bf16_t* dstb = (bf16_t*)P.stg + (size_t)ci * 4096;
#pragma unroll
      for (int i = 0; i < 8; ++i) { const int row = (lane >> 3) + 8 * i, ch = lane & 7; *(u32x4*)(dstb + row * 64 + ch * 8) = *(const LAS u32x4*)(Kl + row * PL + ch * 8); } }
}
__device__ __forceinline__ void mlstm_out_w(const RecP& P, LAS unsigned char* wl, int ci, int lane) {
    const int r = lane & 15, q = lane >> 4; constexpr int PL = 72;
    const int bh = ci >> 6, c = ci & 63, b = bh >> 2, h = bh & 3, row0 = b * SEQ + c * 64;
    const bf16_t* Xq = P.proj + (size_t)row0 * PJ + C_MQ + h * 64; const bf16_t* Xk = P.proj + (size_t)row0 * PJ + C_MK + h * 64; const bf16_t* Xv = P.proj + (size_t)row0 * PJ + C_MV + h * 64;
    LAS bf16_t* Tl = (LAS bf16_t*)wl; LAS float* vg = (LAS float*)(wl + 9216); LAS float* vn = vg + 64;
    { u32x4 tv_[8];
#pragma unroll
      for (int i = 0; i < 8; ++i) tv_[i] = piece(Xv, PJ, i, lane);
      __builtin_amdgcn_sched_barrier(0);
#pragma unroll
      for (int i = 0; i < 8; ++i) *(LAS u32x4*)(Tl + ((lane >> 3) + 8 * i) * PL + (lane & 7) * 8) = tv_[i]; }
    const float* tp = P.tail + (size_t)(row0 + lane) * 32;
    const float li = tp[T_MI + h] + P.mbi[h], lf = logsig(tp[T_MF + h] + P.mbf[h]);
    const float m = P.smMS[ci]; vn[lane] = P.smN[(size_t)ci * 64 + lane];
    const float bc = scan_add(lf, lane), g = li - bc, pm = scan_max(g, lane), M = fmaxf(m, pm), wint = fexp(m - M), expm = fexp(-bc - M);
    vg[lane] = g;
    asm volatile("" ::: "memory"); __builtin_amdgcn_sched_barrier(0);
    bf16x8 Kf[4][2], Qf[4][2];
#pragma unroll
    for (int T = 0; T < 4; ++T)
#pragma unroll
        for (int ks = 0; ks < 2; ++ks) { Kf[T][ks] = rfg(Xk, PJ, T, ks, lane); Qf[T][ks] = rfg(Xq, PJ, T, ks, lane); }
    float Mj[4], wj[4], ej[4];
#pragma unroll
    for (int T = 0; T < 4; ++T) { Mj[T] = __shfl(M, 16 * T + r); wj[T] = __shfl(wint, 16 * T + r); ej[T] = __shfl(expm, 16 * T + r); }
    u32x2 Pk[4][4]; float dinv[4];
#pragma unroll
    for (int Tj = 0; Tj < 4; ++Tj) { float dsum = 0.f;
#pragma unroll
        for (int Tl_ = 0; Tl_ < 4; ++Tl_) {
            if (Tl_ <= Tj) { f32x4 acc = (f32x4){0.f, 0.f, 0.f, 0.f}; acc = MF16(Kf[Tl_][0], Qf[Tj][0], acc); acc = MF16(Kf[Tl_][1], Qf[Tj][1], acc);
                const f32x4 g4 = *(const LAS f32x4*)(vg + 16 * Tl_ + 4 * q); float sv[4];
#pragma unroll
                for (int rg = 0; rg < 4; ++rg) { const bool ok = (Tl_ < Tj) || (4 * q + rg <= r); sv[rg] = ok ? acc[rg] * fexp(g4[rg] - Mj[Tj]) : 0.f; dsum += sv[rg]; }
                Pk[Tj][Tl_].x = pk2(sv[0], sv[1]); Pk[Tj][Tl_].y = pk2(sv[2], sv[3]); }
            else { Pk[Tj][Tl_].x = 0u; Pk[Tj][Tl_].y = 0u; } }
        dsum = red_q(dsum);
        float qn = 0.f;
#pragma unroll
        for (int ks = 0; ks < 2; ++ks) { float qf[8]; unpack8(__builtin_bit_cast(u32x4, Qf[Tj][ks]), qf); const f32x4 n0 = *(const LAS f32x4*)(vn + 32 * ks + 8 * q), n1 = *(const LAS f32x4*)(vn + 32 * ks + 8 * q + 4);
            qn += (qf[0] * n0[0] + qf[1] * n0[1]) + (qf[2] * n0[2] + qf[3] * n0[3]) + (qf[4] * n1[0] + qf[5] * n1[1]) + (qf[6] * n1[2] + qf[7] * n1[3]); }
        qn = red_q(qn);
        const float den = dsum + wj[Tj] * qn; dinv[Tj] = __builtin_amdgcn_rcpf(fmaxf(fabsf(den), ej[Tj]));
        Qf[Tj][0] = frag_scale(Qf[Tj][0], wj[Tj]); Qf[Tj][1] = frag_scale(Qf[Tj][1], wj[Tj]); asm volatile("" ::: "memory"); __builtin_amdgcn_sched_barrier(0); }
    asm volatile("" ::: "memory"); __builtin_amdgcn_sched_barrier(0);
    const bf16_t* cs = P.csm + (size_t)ci * 4096;
    bf16x8 Vt[4][2], Ct[4][2];
#pragma unroll
    for (int Te = 0; Te < 4; ++Te)
#pragma unroll
        for (int s = 0; s < 2; ++s) { Vt[Te][s] = trfrag(Tl, PL, s, 16 * Te, lane); Ct[Te][s] = rfg(cs, 64, Te, s, lane); }
    asm volatile("" ::: "memory"); __builtin_amdgcn_sched_barrier(0);
#pragma unroll
    for (int Tj = 0; Tj < 4; ++Tj) { f32x4 O[4];
        const bf16x8 p0 = __builtin_bit_cast(bf16x8, ((u32x4){Pk[Tj][0].x, Pk[Tj][0].y, Pk[Tj][1].x, Pk[Tj][1].y})), p1 = __builtin_bit_cast(bf16x8, ((u32x4){Pk[Tj][2].x, Pk[Tj][2].y, Pk[Tj][3].x, Pk[Tj][3].y}));
#pragma unroll
        for (int Te = 0; Te < 4; ++Te) { f32x4 acc = (f32x4){0.f, 0.f, 0.f, 0.f}; acc = MF16(Vt[Te][0], p0, acc); if (Tj >= 2) acc = MF16(Vt[Te][1], p1, acc);
            acc = MF16(Ct[Te][0], Qf[Tj][0], acc); acc = MF16(Ct[Te][1], Qf[Tj][1], acc); O[Te] = acc; }
        stage_rows(O, Tj, dinv[Tj], Tl, PL, lane); asm volatile("" ::: "memory"); __builtin_amdgcn_sched_barrier(0); }
    asm volatile("" ::: "memory"); __builtin_amdgcn_sched_barrier(0);
    final_store<0>(Tl, PL, P.mg, P.proj + (size_t)row0 * PJ + C_MO + h * 64, (bf16_t*)((unsigned char*)P.ycat + (size_t)row0 * DM + h * 64), lane);
}
__device__ __forceinline__ void gla_out_w(const RecP& P, const GWf& W, LAS unsigned char* wl, int ci, int lane) {
    const int r = lane & 15, q = lane >> 4; constexpr int PL = 72;
    const int bh = ci >> 6, c = ci & 63, b = bh >> 2, h = bh & 3, row0 = b * SEQ + c * 64;
    const bf16_t* Xq = P.proj + (size_t)row0 * PJ + C_GQ + h * 64; const bf16_t* Xk = P.proj + (size_t)row0 * PJ + C_GK + h * 64; const bf16_t* Xv = P.proj + (size_t)row0 * PJ + C_GV + h * 64;
    LAS bf16_t* Tl = (LAS bf16_t*)wl;
    { float bend[4]; gla_gate_tile<0>(Tl, PL, bend, W, P.tail + (size_t)row0 * 32, lane); }
    asm volatile("" ::: "memory"); __builtin_amdgcn_sched_barrier(0);
    bf16x8 Kf[4][2], Qf[4][2];
#pragma unroll
    for (int T = 0; T < 4; ++T)
#pragma unroll
        for (int ks = 0; ks < 2; ++ks) { Qf[T][ks] = rfg(Xq, PJ, T, ks, lane); Kf[T][ks] = rfg(Xk, PJ, T, ks, lane); }
    __builtin_amdgcn_sched_barrier(0);
#pragma unroll
    for (int T = 0; T < 4; ++T)
#pragma unroll
        for (int ks = 0; ks < 2; ++ks) { const bf16x8 ef = *(const LAS bf16x8*)(Tl + (16 * T + r) * PL + 32 * ks + 8 * q); Qf[T][ks] = frag_mul(Qf[T][ks], ef, false); Kf[T][ks] = frag_mul(Kf[T][ks], ef, true); }
    asm volatile("" ::: "memory"); __builtin_amdgcn_sched_barrier(0);
    { u32x4 tv_[8];
#pragma unroll
      for (int i = 0; i < 8; ++i) tv_[i] = piece(Xv, PJ, i, lane);
      __builtin_amdgcn_sched_barrier(0);
#pragma unroll
      for (int i = 0; i < 8; ++i) *(LAS u32x4*)(Tl + ((lane >> 3) + 8 * i) * PL + (lane & 7) * 8) = tv_[i]; }
    asm volatile("" ::: "memory"); __builtin_amdgcn_sched_barrier(0);
    u32x2 Pk[4][4];
#pragma unroll
    for (int Tj = 0; Tj < 4; ++Tj)
#pragma unroll
        for (int Tl_ = 0; Tl_ < 4; ++Tl_) {
            if (Tl_ <= Tj) { f32x4 acc = (f32x4){0.f, 0.f, 0.f, 0.f}; acc = MF16(Kf[Tl_][0], Qf[Tj][0], acc); acc = MF16(Kf[Tl_][1], Qf[Tj][1], acc); float sv[4];
#pragma unroll
                for (int rg = 0; rg < 4; ++rg) { const bool ok = (Tl_ < Tj) || (4 * q + rg <= r); sv[rg] = ok ? acc[rg] : 0.f; }
                Pk[Tj][Tl_].x = pk2(sv[0], sv[1]); Pk[Tj][Tl_].y = pk2(sv[2], sv[3]); }
            else { Pk[Tj][Tl_].x = 0u; Pk[Tj][Tl_].y = 0u; } }
    const bf16_t* cs = P.csg + (size_t)ci * 4096;
    bf16x8 Vt[4][2], Ct[4][2];
#pragma unroll
    for (int Te = 0; Te < 4; ++Te)
#pragma unroll
        for (int s = 0; s < 2; ++s) { Vt[Te][s] = trfrag(Tl, PL, s, 16 * Te, lane); Ct[Te][s] = rfg(cs, 64, Te, s, lane); }
    asm volatile("" ::: "memory"); __builtin_amdgcn_sched_barrier(0);
#pragma unroll
    for (int Tj = 0; Tj < 4; ++Tj) { f32x4 O[4];
        const bf16x8 p0 = __builtin_bit_cast(bf16x8, ((u32x4){Pk[Tj][0].x, Pk[Tj][0].y, Pk[Tj][1].x, Pk[Tj][1].y})), p1 = __builtin_bit_cast(bf16x8, ((u32x4){Pk[Tj][2].x, Pk[Tj][2].y, Pk[Tj][3].x, Pk[Tj][3].y}));
#pragma unroll
        for (int Te = 0; Te < 4; ++Te) { f32x4 acc = (f32x4){0.f, 0.f, 0.f, 0.f}; acc = MF16(Vt[Te][0], p0, acc); if (Tj >= 2) acc = MF16(Vt[Te][1], p1, acc);
            acc = MF16(Ct[Te][0], Qf[Tj][0], acc); acc = MF16(Ct[Te][1], Qf[Tj][1], acc); O[Te] = acc; }
        stage_rows(O, Tj, 1.f, Tl, PL, lane); asm volatile("" ::: "memory"); __builtin_amdgcn_sched_barrier(0); }
    asm volatile("" ::: "memory"); __builtin_amdgcn_sched_barrier(0);
    final_store<1>(Tl, PL, P.gg, P.proj + (size_t)row0 * PJ + C_GR + h * 64, (bf16_t*)((unsigned char*)P.ycat + (size_t)row0 * DM + 768 + h * 64), lane);
}
#undef MF16
}


constexpr int N_PHASES = 2 + 9 * DEPTH;
__global__ void __launch_bounds__(512, 2) mega_fwd(Args args) {
    extern __shared__ __attribute__((aligned(16))) unsigned char lds_raw[];
    Frame F;
    F.lds = (LAS unsigned char*)lds_raw;
    F.MISC = (volatile LAS unsigned*)(F.lds + MISC_OFF);
    F.tid = threadIdx.x; F.lane = F.tid & 63; F.wave = __builtin_amdgcn_readfirstlane(F.tid >> 6);
    F.G = gridDim.x; { const int bx = blockIdx.x; F.vcu = (F.G % 8 == 0) ? (bx % 8) * (F.G / 8) + bx / 8 : bx; }
    typedef const __attribute__((address_space(4))) Args* CArgs;
    const CArgs ap0 = (CArgs)__builtin_amdgcn_kernarg_segment_ptr();
    F.ctl = (gu32*)(args.ws + WS_CTL);
    for (int u = F.tid; u < (LDS_BYTES - LDSCTL_OFF) / 4; u += 512) ((LAS unsigned*)(F.lds + LDSCTL_OFF))[u] = 0u;
    __syncthreads();
#if MK_ONE_LAUNCH
    XcdBarrier bar = xcd_barrier_post((unsigned*)(F.ctl + CW_BAR), F.MISC + 8, F.tid == 0);
#define GRID_BAR() xcd_barrier(bar, F.wave == 0 && lane_id_() == 0)
#else
#define GRID_BAR() do {} while (0)
#endif
    const int lo = args.ph_lo, hi = args.ph_hi;
#define IN(k) (lo <= (k) && (k) < hi)
#define SEAM(k) do { if (IN(k) && IN((k) + 1)) { GRID_BAR(); if (NREP(15) == 2) GRID_BAR(); } } while (0)
    const int NGW = F.G * 8;
#define PHASE_IDS() int tid = mk_tid(F.wave); asm volatile("" : "+v"(tid)); const int lane = tid & 63, wid = __builtin_amdgcn_readfirstlane(tid >> 6); const int gw = F.vcu * 8 + wid; (void)lane; (void)gw; \
    CArgs ap = ap0; asm volatile("" : "+s"(ap)); unsigned char* ws = ap->ws; (void)ws
#define AIN(i) (ap->in[i])
#define MOD ((float*)(ws + WS_MOD))
#define ROPE ((float*)(ws + WS_ROPE))
#define WIN ((bf16_t*)(ws + WS_WIN))
#define WOUT ((bf16_t*)(ws + WS_WOUT))
#define WGU8 ((unsigned char*)(ws + WS_WGU))
#define WD8 ((unsigned char*)(ws + WS_WD))
#define U8B ((unsigned char*)(ws + WS_U8))
#define WIN8 ((unsigned char*)(ws + WS_WIN8))
#define H8B ((unsigned char*)(ws + WS_PROJ))
#define LTOK ((int*)(ws + WS_LTOK))
#define LGATE ((float*)(ws + WS_LGATE))
#define PROJ ((bf16_t*)(ws + WS_PROJ))
#define HB ((bf16_t*)(ws + WS_PROJ))
#define XB ((bf16_t*)(ws + WS_XR))
#define YSORT ((bf16_t*)(ws + WS_YSORT))
#define TAILB ((float*)(ws + WS_TAIL))
#define TOKSLOT ((int*)(ws + WS_SM + SM_TS))
#define UB ((bf16_t*)(ws + WS_U))
#define YCAT ((bf16_t*)(ws + WS_YCAT))
#define STM ((float*)(ws + WS_U))
#define STG ((float*)(ws + WS_U + 32 * MiB))
#define CSM ((bf16_t*)(ws + WS_XR + 64 * MiB))
#define CSG ((bf16_t*)(ws + WS_XR + 80 * MiB))
#define G_smN ((float*)(ws + WS_SM + SM_N))
#define G_smBC ((float*)(ws + WS_SM + SM_BC))
#define G_smDM ((float*)(ws + WS_SM + SM_DM))
#define G_smMS ((float*)(ws + WS_SM + SM_MS))
#define G_smGBE ((float*)(ws + WS_SM + SM_GBE))
#define x_in AIN(I_X)

    if (IN(0) && PHON(0)) for (int rp0 = 0; rp0 < NREP(0); ++rp0) {
        PHASE_IDS();
        {
            LAS float* cact = (LAS float*)F.lds;
            LAS float* part = (LAS float*)(F.lds + 32768);
            const float* cc = AIN(I_C);
            for (int i = tid; i < NB * DM; i += 512) { const int b = i >> 10, k = i & 1023; const float v = cc[i]; cact[k * 8 + b] = v / (1.f + fexp(-v)); }
            __syncthreads();
            for (int it = F.vcu; it < DEPTH * 96; it += F.G) {
                const int l = it / 96, j0 = (it % 96) * 64;
                const float* W = AIN(I_WADA) + (size_t)l * DM * 6144 + j0 + lane;
                float a[8] = {0.f, 0.f, 0.f, 0.f, 0.f, 0.f, 0.f, 0.f};
#pragma unroll 32
                for (int kk = 0; kk < 128; ++kk) { const int k = wid * 128 + kk; const float w = W[(size_t)k * 6144];
                    const f32x4 c0 = *(const LAS f32x4*)(cact + k * 8), c1 = *(const LAS f32x4*)(cact + k * 8 + 4);
                    a[0] += c0[0] * w; a[1] += c0[1] * w; a[2] += c0[2] * w; a[3] += c0[3] * w; a[4] += c1[0] * w; a[5] += c1[1] * w; a[6] += c1[2] * w; a[7] += c1[3] * w; }
#pragma unroll
                for (int b = 0; b < 8; ++b) part[(wid * 8 + b) * 64 + lane] = a[b];
                __syncthreads();
                { const int b = tid >> 6, j = tid & 63; float s = AIN(I_BADA)[(size_t)l * 6144 + j0 + j];
#pragma unroll
                  for (int w = 0; w < 8; ++w) s += part[(w * 8 + b) * 64 + j];
                  MOD[((size_t)l * NB + b) * 6144 + j0 + j] = s; }
                __syncthreads();
            }
        }
        {
            const int* pos = (const int*)AIN(I_POS);
            for (int i = blockIdx.x * 512 + tid; i < NTOK * 4; i += F.G * 512) { const int row = i >> 2, f = i & 3;
                const float invf = (float)pow(500000.0, -0.25 * (double)f); const float ang = (float)pos[row] * invf;
                ROPE[(size_t)row * 8 + f] = (float)cos((double)ang); ROPE[(size_t)row * 8 + 4 + f] = (float)sin((double)ang); }
        }
        {
            LAS float* scr = (LAS float*)(F.lds + 49152 + wid * 8704);
            constexpr int I_IN = (DM / 64) * (PW / 32), I_OUT = (DM / 64) * (DM / 32);
            auto dec0 = [&](int it, TrD& d) { const int l = it / (I_IN + I_OUT); int r = it % (I_IN + I_OUT);
                if (r < I_IN) { const int kb = r / (PW / 32), nb = r % (PW / 32); const int nbe = (nb < 112) ? nb : 0; const int tl = nbe >> 3;
                    d.wsc = (tl == 0 || tl == 10) ? 0.125f : (tl == 7) ? ATT_C2 : 1.f;
                    d.src = AIN(I_WIN) + (size_t)l * DM * PIN + (size_t)(kb * 64) * PIN + win_src_col(nbe * 32); d.ldw = PIN; d.K = DM; d.dst = WIN + (size_t)l * PW * DM; d.dst8 = WIN8 + (size_t)l * PP * DM; d.drow0 = nbe * 32; d.k0 = kb * 64;
                    return nb < 112; }
                r -= I_IN; const int kb = r / (DM / 32), nb = r % (DM / 32); d.wsc = 1.f;
                d.src = AIN(I_WOUT) + (size_t)l * DM * DM + (size_t)(kb * 64) * DM + nb * 32; d.wsc = W8S; d.dst8 = nullptr; d.ldw = DM; d.K = DM; d.dst = (bf16_t*)((unsigned char*)WOUT + (size_t)l * DM * DM); d.drow0 = nb * 32; d.k0 = kb * 64; return true; };
            { TrD dc, dn; f32x4 vc[8], vn[8]; int it = gw; bool okc = dec0(it, dc); tr_load4(dc, vc, lane); dn = dc; bool okn = okc;
#pragma unroll
              for (int i = 0; i < 8; ++i) vn[i] = vc[i];
              for (; it < DEPTH * (I_IN + I_OUT); it += NGW) { const int itn = it + NGW;
                  if (itn < DEPTH * (I_IN + I_OUT)) { okn = dec0(itn, dn); tr_load4(dn, vn, lane); }
                  if (okc) { if (dc.ldw == DM) tr_finish8(dc, vc, scr, lane); else { TrD d8 = dc; d8.dst = (bf16_t*)dc.dst8; d8.wsc = dc.wsc * W8S; tr_finish8(d8, vc, scr, lane); } }
                  dc = dn; okc = okn;
#pragma unroll
                  for (int i = 0; i < 8; ++i) vc[i] = vn[i]; } }
            for (int it = gw; it < DEPTH * (DM / 64) * 8; it += NGW) { const int l = it / ((DM / 64) * 8), r = it % ((DM / 64) * 8), kb = r >> 3, nb = 112 + (r & 7);
                tr_item(AIN(I_WIN) + (size_t)l * DM * PIN, PIN, DM, WIN + (size_t)l * PW * DM, nb * 32, win_src_col(nb * 32 + (lane & 31)), kb * 64, scr, lane); }
        }
    }
    SEAM(0);
    if (IN(1) && PHON(1)) {
        PHASE_IDS();
        NarrowT NT_; nmm_load_tail(NT_, WIN + (size_t)PP * DM, wid, lane);
        LAS bf16_t* Sst = (LAS bf16_t*)F.lds; LAS float* Pb = (LAS float*)(F.lds + NMM_P_OFF);
        const int b = F.vcu >> 5; const float* md = MOD + (size_t)b * 6144;
        f32x4 sh[4], sc[4];
#pragma unroll
        for (int j = 0; j < 4; ++j) { sh[j] = *(const f32x4*)(md + 4 * lane + 256 * j); sc[j] = *(const f32x4*)(md + 1024 + 4 * lane + 256 * j) + 1.0f; }
        const int rowb = F.vcu * 128 + wid * 16;
        for (int i = 0; i < 16; i += 4) { f32x4 v[4][4];
#pragma unroll
            for (int rr = 0; rr < 4; ++rr)
#pragma unroll
                for (int j = 0; j < 4; ++j) v[rr][j] = *(const f32x4*)(x_in + (size_t)(rowb + i + rr) * DM + 4 * lane + 256 * j);
#pragma unroll
            for (int rr = 0; rr < 4; ++rr)
#pragma unroll
                for (int j = 0; j < 4; ++j) { const f32x4 u = v[rr][j] * sc[j] + sh[j];
                    u32x2 w; w.x = pk2(u[0], u[1]); w.y = pk2(u[2], u[3]); *(LAS u32x2*)(Sst + (wid * 4 + rr) * NSP + 4 * lane + 256 * j) = w;
                    *(unsigned*)(U8B + (size_t)(rowb + i + rr) * DM + 4 * lane + 256 * j) = pk4_fp8(u[0], u[1], u[2], u[3]); }
            nmm_step_tail(NT_, Sst, Pb, TAILB + (size_t)(F.vcu * 128) * 32, i, tid, wid, lane); }
    }
    SEAM(1);

    for (int l = 0; l < DEPTH; ++l) {
        const int pb = 2 + 9 * l;
#define modl (MOD + (size_t)l * NB * 6144)
#define MAKE_RP() rec::RecP RP; RP.proj = PROJ; RP.tail = TAILB; RP.csm = CSM; RP.csg = CSG; RP.stm = STM; RP.stg = STG; RP.smN = G_smN; RP.smBC = G_smBC; RP.smDM = G_smDM; RP.smMS = G_smMS; RP.smGBE = G_smGBE; RP.ycat = YCAT; \
        RP.mbi = AIN(I_MBI) + l * 4; RP.mbf = AIN(I_MBF) + l * 4; RP.mg = AIN(I_MG) + l * 64; RP.wa2 = AIN(I_WA2) + (size_t)l * 16 * 256; RP.ba = AIN(I_BA) + l * 256; RP.gg = AIN(I_GG) + l * 64;
        if (IN(pb + 0) && PHON(2)) {
            PHASE_IDS(); (void)tid;
            { gm::K1<true> k; k.S.init(NTOK, PP, F.G, (int)blockIdx.x); k.A = U8B; k.Bt = WIN8 + (size_t)l * PP * DM; k.O = PROJ; k.rope = ROPE;
                gm::gemm_phase<gm::K1<true>>(F.lds, k, F.wave); }
        }
        SEAM(pb + 0);
        if (IN(pb + 1) && PHON(3)) {
            PHASE_IDS();
            MAKE_RP();
            for (int rp = 0; rp < NREP(3); ++rp) {
                LAS unsigned char* wl = F.lds + wid * 16384;
                recw::GWf gwf; recw::ld_gwf(gwf, RP, (gw >> 6) & 3, lane);
                for (int ci = gw; ci < 2048; ci += NGW) { int lane_ = lane; asm volatile("" : "+v"(lane_)); if (PHON(13)) recw::mlstm_local_w(RP, wl, ci, lane_); asm volatile("" ::: "memory"); __builtin_amdgcn_sched_barrier(0); if (PHON(14)) recw::gla_local_w(RP, gwf, wl, ci, lane_); }
            }
        }
        SEAM(pb + 1);
        if (IN(pb + 2) && PHON(4)) {
            PHASE_IDS();
            const int gt = blockIdx.x * 512 + tid, NGT = F.G * 512;
            for (int task = gt; task < 65536 + 2048; task += NGT) {
                if (task < 32768) {
                    const int bh = task >> 10, el = (task & 1023) * 4; const bf16_t* p = (const bf16_t*)STM + (size_t)bh * 64 * 4096 + el; bf16_t* o = CSM + (size_t)bh * 64 * 4096 + el;
                    const float bcv = G_smBC[bh * 64 + lane], dmv = G_smDM[bh * 64 + lane];
                    f32x4 C = (f32x4){0.f, 0.f, 0.f, 0.f}; float m = 0.f;
#pragma unroll 16
                    for (int c = 0; c < NCH; ++c) { const u32x2 uw = *(const u32x2*)(p + (size_t)c * 4096); const f32x4 u = (f32x4){bflo(uw.x), bfhi(uw.x), bflo(uw.y), bfhi(uw.y)}; u32x2 w; w.x = pk2(C[0], C[1]); w.y = pk2(C[2], C[3]); *(u32x2*)(o + (size_t)c * 4096) = w;
                        if (el == 0) G_smMS[bh * 64 + c] = m;
                        const float B = __builtin_bit_cast(float, __builtin_amdgcn_readlane(__builtin_bit_cast(int, bcv), c)), Dm = __builtin_bit_cast(float, __builtin_amdgcn_readlane(__builtin_bit_cast(int, dmv), c)), mn = fmaxf(B + m, Dm); C = C * fexp(B + m - mn) + u * fexp(Dm - mn); m = mn; }
                } else if (task < 65536) {
                    const int t2 = task - 32768, bh = t2 >> 10, el = (t2 & 1023) * 4, d = el & 63; const bf16_t* p = (const bf16_t*)STG + (size_t)bh * 64 * 4096 + el; bf16_t* o = CSG + (size_t)bh * 64 * 4096 + el;
                    const float* be = G_smGBE + (size_t)bh * 64 * 64 + d;
                    f32x4 S = (f32x4){0.f, 0.f, 0.f, 0.f};
#pragma unroll 16
                    for (int c = 0; c < NCH; ++c) { const u32x2 uw = *(const u32x2*)(p + (size_t)c * 4096); const f32x4 u = (f32x4){bflo(uw.x), bfhi(uw.x), bflo(uw.y), bfhi(uw.y)}; const f32x4 b4 = *(const f32x4*)(be + c * 64);
                        u32x2 w; w.x = pk2(S[0], S[1]); w.y = pk2(S[2], S[3]); *(u32x2*)(o + (size_t)c * 4096) = w;
                        S = (f32x4){fexp(b4[0]) * S[0] + u[0], fexp(b4[1]) * S[1] + u[1], fexp(b4[2]) * S[2] + u[2], fexp(b4[3]) * S[3] + u[3]}; }
                } else {
                    const int t3 = task - 65536, bh = t3 >> 6, el = t3 & 63; float* p = G_smN + (size_t)bh * 64 * 64 + el;
                    const float bcv = G_smBC[bh * 64 + lane], dmv = G_smDM[bh * 64 + lane];
                    float C = 0.f, m = 0.f;
#pragma unroll 16
                    for (int c = 0; c < NCH; ++c) { const float u = p[c * 64]; p[c * 64] = C;
                        const float B = __builtin_bit_cast(float, __builtin_amdgcn_readlane(__builtin_bit_cast(int, bcv), c)), Dm = __builtin_bit_cast(float, __builtin_amdgcn_readlane(__builtin_bit_cast(int, dmv), c)), mn = fmaxf(B + m, Dm); C = C * fexp(B + m - mn) + u * fexp(Dm - mn); m = mn; }
                }
            }
            for (int rp = 0; rp < NREP(13); ++rp) {
                LAS float* scr = (LAS float*)(F.lds + 49152 + wid * 8704);
                constexpr int I_G = (DM / 64) * (1024 / 32), I_D = (DE / 64) * (DM / 32);
                auto dece = [&](int it, TrD& d) { const int e = it / (I_G + I_D); int r = it % (I_G + I_D); d.wsc = W8S; d.dst8 = nullptr;
                    if (r < I_G) { const int kb = r / 32, nb = r % 32, n0 = nb * 32, tt = n0 >> 8, rr = n0 & 255;
                        d.src = (rr < 128 ? AIN(I_EWG) : AIN(I_EWU)) + ((size_t)l * NE + e) * DM * DE + (size_t)(kb * 64) * DE + tt * 128 + (rr & 127); d.ldw = DE; d.K = DM; d.dst = (bf16_t*)(WGU8 + (size_t)e * 1024 * 1024); d.drow0 = n0; d.k0 = kb * 64; }
                    else { r -= I_G; const int kb = r / 32, nb = r % 32;
                        d.src = AIN(I_EWD) + ((size_t)l * NE + e) * DE * DM + (size_t)(kb * 64) * DM + nb * 32; d.ldw = DM; d.K = DE; d.dst = (bf16_t*)(WD8 + (size_t)e * 1024 * 512); d.drow0 = nb * 32; d.k0 = kb * 64; } };
                TrD dc, dn; f32x4 vc[8], vn[8]; int it = gw; dece(it, dc); tr_load4(dc, vc, lane); dn = dc;
#pragma unroll
                for (int i = 0; i < 8; ++i) vn[i] = vc[i];
                for (; it < NE * (I_G + I_D); it += NGW) { const int itn = it + NGW;
                    if (itn < NE * (I_G + I_D)) { dece(itn, dn); tr_load4(dn, vn, lane); }
                    tr_finish8(dc, vc, scr, lane);
                    dc = dn;
#pragma unroll
                    for (int i = 0; i < 8; ++i) vc[i] = vn[i]; }
            }
        }
        SEAM(pb + 2);
        if (IN(pb + 3) && PHON(5)) {
            PHASE_IDS();
            if (PHON(10)) {
                float d1 = 0.f, d2 = 0.f;
                for (int i = 0; i < 32; ++i) { d1 += AIN(I_LQ1)[l * 32 + i] * AIN(I_LK1)[l * 32 + i]; d2 += AIN(I_LQ2)[l * 32 + i] * AIN(I_LK2)[l * 32 + i]; }
                const float lam_init = 0.8f - 0.6f * expf(-0.3f * (float)l);
                attn_body::AttnParams AP; AP.Q = (const attn_body::bf16*)(PROJ + C_DQ); AP.K = (const attn_body::bf16*)(PROJ + C_DK); AP.V = (const attn_body::bf16*)(PROJ + C_DV);
                AP.zpage = (const attn_body::bf16*)(F.ctl + CW_ZPAGE); AP.Y = (bf16_t*)((unsigned char*)YCAT + 512); AP.gnorm = AIN(I_DG) + l * 64; AP.lam = expf(d1) - expf(d2) + lam_init; AP.osc = 1.f - lam_init;
                const int bh = F.vcu >> 3, s = F.vcu & 7;
                if (F.G == 256) {
                    for (int rp = 0; rp < NREP(10); ++rp)
                    for (int i = 0; i < 2; ++i) { const int qb = (i == 0) ? s : 15 - s;
                        attn_body::attn_unit<8, 0>(bh >> 2, bh & 3, qb, AP, (char*)lds_raw, F.wave); attn_body::attn_unit<8, 1>(bh >> 2, bh & 3, qb, AP, (char*)lds_raw, F.wave); }
                }
            }
            __syncthreads();
            {
            PHASE_IDS();
            MAKE_RP();
            if (PHON(11)) for (int rp = 0; rp < NREP(11); ++rp) {
                LAS unsigned char* wl = F.lds + wid * 16384;
                LAS u32x4* gst = (LAS u32x4*)(wl + 10240);
                { recw::GWf gwf; recw::ld_gwf(gwf, RP, (gw >> 6) & 3, lane);
#pragma unroll
                  for (int Td = 0; Td < 4; ++Td) gst[Td * 64 + lane] = __builtin_bit_cast(u32x4, gwf.Bw[Td]);
                  gst[256 + lane] = __builtin_bit_cast(u32x4, ((f32x4){gwf.ba[0], gwf.ba[1], gwf.ba[2], gwf.ba[3]})); }
                for (int ci = gw; ci < 2048; ci += NGW) { int lane_ = lane; asm volatile("" : "+v"(lane_)); if (PHON(13)) recw::mlstm_out_w(RP, wl, ci, lane_); asm volatile("" ::: "memory"); __builtin_amdgcn_sched_barrier(0);
                    if (PHON(14)) { recw::GWf gwf;
#pragma unroll
                        for (int Td = 0; Td < 4; ++Td) gwf.Bw[Td] = __builtin_bit_cast(bf16x8, gst[Td * 64 + lane_]);
                        const f32x4 bb = __builtin_bit_cast(f32x4, gst[256 + lane_]); gwf.ba[0] = bb[0]; gwf.ba[1] = bb[1]; gwf.ba[2] = bb[2]; gwf.ba[3] = bb[3];
                        recw::gla_out_w(RP, gwf, wl, ci, lane_); } }
            }
            __syncthreads();
            if (PHON(12)) for (int rp = 0; rp < NREP(12); ++rp) {
                const float* cw = AIN(I_CONVW) + (size_t)l * 3 * 256; const float* cbias = AIN(I_CONVB) + l * 256;
                for (int it = F.vcu; it < NTOK / 64; it += F.G) {
                    for (int p = tid; p < 64 * 32; p += 512) { const int r = p >> 5, chn = p & 31, row = it * 64 + r, t = row & (SEQ - 1);
                        const bf16_t* pr = PROJ + (size_t)row * PJ + chn * 8;
                        float s0[8], s1[8], s2[8], cbv[8];
                        const int o1 = (t >= 1) ? PJ : 0, o2 = (t >= 2) ? 2 * PJ : 0;
                        const u32x4 c2 = *(const u32x4*)(pr + C_CC), h2 = *(const u32x4*)(pr + C_CH), c1 = *(const u32x4*)(pr - o1 + C_CC), h1 = *(const u32x4*)(pr - o1 + C_CH),
                                    c0 = *(const u32x4*)(pr - o2 + C_CC), h0 = *(const u32x4*)(pr - o2 + C_CH), cbw = *(const u32x4*)(pr + C_CB);
                        { float a[8], bq[8]; rec::unpack8(c2, a); rec::unpack8(h2, bq);
#pragma unroll
                          for (int i = 0; i < 8; ++i) s2[i] = a[i] * bq[i]; }
                        { float a[8], bq[8]; rec::unpack8(c1, a); rec::unpack8(h1, bq); const float f1 = (t >= 1) ? 1.f : 0.f;
#pragma unroll
                          for (int i = 0; i < 8; ++i) s1[i] = a[i] * bq[i] * f1; }
                        { float a[8], bq[8]; rec::unpack8(c0, a); rec::unpack8(h0, bq); const float f0 = (t >= 2) ? 1.f : 0.f;
#pragma unroll
                          for (int i = 0; i < 8; ++i) s0[i] = a[i] * bq[i] * f0; }
                        rec::unpack8(cbw, cbv);
                        float y[8];
#pragma unroll
                        for (int i = 0; i < 8; ++i) { const int cch = chn * 8 + i; y[i] = cbv[i] * (cw[cch] * s0[i] + cw[256 + cch] * s1[i] + cw[512 + cch] * s2[i] + cbias[cch]); }
                        u32x2 w; w.x = pk4_fp8(y[0] * Y8S, y[1] * Y8S, y[2] * Y8S, y[3] * Y8S); w.y = pk4_fp8(y[4] * Y8S, y[5] * Y8S, y[6] * Y8S, y[7] * Y8S);
                        *(u32x2*)((unsigned char*)YCAT + (size_t)row * DM + 256 + chn * 8) = w; }
                }
            }
            }
        }
        SEAM(pb + 3);
        if (IN(pb + 4) && PHON(6)) {
            PHASE_IDS(); (void)tid;
            gm::K2 k; k.S.init(NTOK, DM, F.G, (int)blockIdx.x); k.A = (const unsigned char*)YCAT; k.Bt = (const unsigned char*)WOUT + (size_t)l * DM * DM; k.O = UB;
            for (int rp = 0; rp < NREP(6); ++rp) gm::gemm_phase<gm::K2>(F.lds, k, F.wave);
        }
        SEAM(pb + 4);
        if (IN(pb + 5) && PHON(7)) {
            PHASE_IDS();
            NarrowT NT_; nmm_load_router(NT_, AIN(I_RW), wid, lane);
            LAS bf16_t* Sst = (LAS bf16_t*)F.lds; LAS float* Pb = (LAS float*)(F.lds + NMM_P_OFF); LAS float* lgs_all = (LAS float*)(F.lds + NMM_LG_OFF);
            LAS float* lgs = lgs_all + wid * 256;
            LAS int* wcnt = (LAS int*)(F.lds + NMM_LG_OFF + 8192); LAS int* wbase = wcnt + 32;
            if (tid < 32) wcnt[tid] = 0;
            const int b = F.vcu >> 5; const float* md = modl + (size_t)b * 6144;
            const float* lg = AIN(I_LN1G) + l * DM; const float* lb = AIN(I_LN1B) + l * DM;
            f32x4 gv[4], bv[4], sh[4], sc[4], g1[4];
#pragma unroll
            for (int j = 0; j < 4; ++j) { const int cix = 4 * lane + 256 * j; gv[j] = *(const f32x4*)(lg + cix); bv[j] = *(const f32x4*)(lb + cix); g1[j] = *(const f32x4*)(md + 2 * 1024 + cix) + 1.0f;
                sh[j] = *(const f32x4*)(md + 3 * 1024 + cix); sc[j] = *(const f32x4*)(md + 4 * 1024 + cix) + 1.0f; }
            const int rowb = F.vcu * 128 + wid * 16;
            u32x2 xwc[4], ywc[4];
#pragma unroll
            for (int j = 0; j < 4; ++j) { const size_t o = (size_t)rowb * DM + 4 * lane + 256 * j; xwc[j] = (l == 0) ? (u32x2){0u, 0u} : *(const u32x2*)(XB + o); ywc[j] = *(const u32x2*)(UB + o); }
            u32x2 xwn[4] = {xwc[0], xwc[1], xwc[2], xwc[3]}, ywn[4] = {ywc[0], ywc[1], ywc[2], ywc[3]};
            for (int i = 0; i < 16; ++i) { const int row = rowb + i;
                if (i < 15) {
#pragma unroll
                    for (int j = 0; j < 4; ++j) { const size_t o = (size_t)(row + 1) * DM + 4 * lane + 256 * j; if (l != 0) xwn[j] = *(const u32x2*)(XB + o); ywn[j] = *(const u32x2*)(UB + o); } }
                f32x4 v[4]; float s = 0.f;
#pragma unroll
                for (int j = 0; j < 4; ++j) { const size_t o = (size_t)row * DM + 4 * lane + 256 * j;
                    f32x4 xv; if (l == 0) xv = *(const f32x4*)(x_in + o); else { const u32x2 xw = xwc[j]; xv = (f32x4){bflo(xw.x), bfhi(xw.x), bflo(xw.y), bfhi(xw.y)}; }
                    const u32x2 yw = ywc[j]; const f32x4 yv = (f32x4){bflo(yw.x), bfhi(yw.x), bflo(yw.y), bfhi(yw.y)};
                    v[j] = xv * ALPHA + g1[j] * yv; s += (v[j][0] + v[j][1]) + (v[j][2] + v[j][3]); }
#pragma unroll
                for (int j = 0; j < 4; ++j) { xwc[j] = xwn[j]; ywc[j] = ywn[j]; }
                const float mean = wave_sum(s) * (1.f / DM); float s2 = 0.f;
#pragma unroll
                for (int j = 0; j < 4; ++j) { v[j] = v[j] - mean; s2 += (v[j][0] * v[j][0] + v[j][1] * v[j][1]) + (v[j][2] * v[j][2] + v[j][3] * v[j][3]); }
                const float rstd = __builtin_amdgcn_rsqf(wave_sum(s2) * (1.f / DM) + LN_EPS);
#pragma unroll
                for (int j = 0; j < 4; ++j) { const size_t o = (size_t)row * DM + 4 * lane + 256 * j; const f32x4 xn = v[j] * rstd * gv[j] + bv[j];
                    u32x2 xw; xw.x = pk2(xn[0], xn[1]); xw.y = pk2(xn[2], xn[3]); *(u32x2*)(XB + o) = xw;
                    const f32x4 u = xn * sc[j] + sh[j]; u32x2 w; w.x = pk2(u[0], u[1]); w.y = pk2(u[2], u[3]); *(LAS u32x2*)(Sst + (wid * 4 + (i & 3)) * NSP + 4 * lane + 256 * j) = w;
                    *(unsigned*)(U8B + o) = pk4_fp8(u[0], u[1], u[2], u[3]); }
                if ((i & 3) == 3) nmm_step_router(NT_, Sst, Pb, lgs_all, i - 3, tid, wid, lane);
            }
            asm volatile("s_waitcnt lgkmcnt(0)\n\ts_barrier" ::: "memory");
            int bk_ = 0; unsigned lpos_ = 0u; float gi_ = 0.f, gj_ = 0.f;
            if (lane < 16) {
                const float* rb = AIN(I_RB);
                float sco[16], bia[16];
#pragma unroll
                for (int q = 0; q < 4; ++q) { const f32x4 t4 = *(const LAS f32x4*)(lgs + lane * 16 + q * 4);
#pragma unroll
                    for (int c = 0; c < 4; ++c) { const float sg = 1.f / (1.f + fexp(-t4[c])); sco[q * 4 + c] = sg; bia[q * 4 + c] = sg + rb[q * 4 + c]; } }
                int bg = 0; float bgs = -INFINITY;
#pragma unroll
                for (int g = 0; g < 4; ++g) { const float a0 = bia[4 * g], a1 = bia[4 * g + 1], a2 = bia[4 * g + 2], a3 = bia[4 * g + 3];
                    const float h1 = fmaxf(a0, a1), l1 = fminf(a0, a1), h2 = fmaxf(a2, a3), l2 = fminf(a2, a3);
                    const float top = fmaxf(h1, h2), sec = fmaxf(fminf(h1, h2), (h1 >= h2) ? l1 : l2); const float gsc = top + sec;
                    if (gsc > bgs) { bgs = gsc; bg = g; } }
                float gb[4], gsx[4];
#pragma unroll
                for (int q = 0; q < 4; ++q) { gb[q] = (bg == 0) ? bia[q] : (bg == 1) ? bia[4 + q] : (bg == 2) ? bia[8 + q] : bia[12 + q]; gsx[q] = (bg == 0) ? sco[q] : (bg == 1) ? sco[4 + q] : (bg == 2) ? sco[8 + q] : sco[12 + q]; }
                int e1 = 0; float m1 = gb[0];
#pragma unroll
                for (int q = 1; q < 4; ++q) if (gb[q] > m1) { m1 = gb[q]; e1 = q; }
                int e2 = -1; float m2 = -INFINITY;
#pragma unroll
                for (int q = 0; q < 4; ++q) if (q != e1 && gb[q] > m2) { m2 = gb[q]; e2 = q; }
                const int ei = e1 < e2 ? e1 : e2, ej = e1 < e2 ? e2 : e1;
                const float si = (ei == 0) ? gsx[0] : (ei == 1) ? gsx[1] : (ei == 2) ? gsx[2] : gsx[3], sj = (ej == 0) ? gsx[0] : (ej == 1) ? gsx[1] : (ej == 2) ? gsx[2] : gsx[3];
                const int pr_ = (ei == 0) ? ej - 1 : (ei == 1) ? ej + 1 : 5; const int bk = bg * 6 + pr_;
                bk_ = bk; lpos_ = (unsigned)__hip_atomic_fetch_add(wcnt + bk, 1, __ATOMIC_RELAXED, __HIP_MEMORY_SCOPE_WORKGROUP); const float inv = 1.f / (si + sj); gi_ = si * inv; gj_ = sj * inv;
            }
            asm volatile("s_waitcnt lgkmcnt(0)\n\ts_barrier" ::: "memory");
            if (tid < NBUCKET) { gu32* cntw = F.ctl + CW_CNT + (size_t)l * NBUCKET * 64; const int c = wcnt[tid]; wbase[tid] = (c > 0) ? (int)__hip_atomic_fetch_add(cntw + tid * 64, (unsigned)c, RLX_AGENT) : 0; }
            asm volatile("s_waitcnt vmcnt(0) lgkmcnt(0)\n\ts_barrier" ::: "memory");
            if (lane < 16) { const int row = rowb + lane; const unsigned pos = (unsigned)wbase[bk_] + lpos_;
                LTOK[(size_t)bk_ * LCAP + pos] = row; LGATE[((size_t)bk_ * LCAP + pos) * 2] = gi_; LGATE[((size_t)bk_ * LCAP + pos) * 2 + 1] = gj_;
                TOKSLOT[row] = (bk_ << 16) | (int)pos;
            }
            __syncthreads();
        }
        SEAM(pb + 5);
        if ((IN(pb + 6) || IN(pb + 7)) && PHON(8)) {
            PHASE_IDS();
            LAS int* tb = (LAS int*)(F.lds + MOE_TB_OFF);
            if (wid == 0) { gu32* cntw = F.ctl + CW_CNT + (size_t)l * NBUCKET * 64;
                const int c = (lane < NBUCKET) ? (int)__hip_atomic_load(cntw + lane * 64, RLX_AGENT) : 0; const int ntl = (c + 255) >> 8; int incl = ntl;
#pragma unroll
                for (int o = 1; o < 32; o <<= 1) { const int t_ = __shfl_up(incl, o); if (lane >= o) incl += t_; }
                if (lane < NBUCKET) { tb[lane] = c; tb[32 + lane] = incl - ntl; }
                if (lane == NBUCKET - 1) tb[32 + NBUCKET] = incl; }
            __syncthreads();
            if (IN(pb + 6)) {
                {
                    LAS float* gtab = (LAS float*)tb + 256; const int nt_ = tb[32 + NBUCKET]; const int half = tid >> 8, tl = tid & 255;
                    float gv_[3];
#pragma unroll
                    for (int j = 0; j < 3; ++j) { const int i = 2 * j + half; const int L = i * F.G + F.vcu; const bool ok = L < nt_ * 8; const int Lc = ok ? L : F.vcu;
                        const int rt = Lc >> 3; int kq = 0;
                        for (int q = 1; q < NBUCKET; ++q) kq = (tb[32 + q] <= rt) ? q : kq;
                        gv_[j] = (F.vcu < nt_ * 8) ? LGATE[((size_t)kq * LCAP + (size_t)(rt - tb[32 + kq]) * 256 + tl) * 2 + ((Lc & 7) >> 2)] : 0.f; }
#pragma unroll
                    for (int j = 0; j < 3; ++j) { const int i = 2 * j + half; if (i * F.G + F.vcu < nt_ * 8) gtab[i * 256 + tl] = gv_[j]; }
                    __syncthreads(); }
                gm::K4 k; k.U = U8B; k.Wgu = WGU8; k.H = H8B; k.ltok = LTOK; k.lgate = LGATE; k.tb = tb; k.G = F.G; k.vcu = F.vcu; k.rtc = F.ctl + CW_RT + (size_t)l * 160 * 64;
                for (int rp = 0; rp < NREP(8); ++rp) gm::gemm_phase<gm::K4>(F.lds, k, F.wave);
            }
            SEAM(pb + 6);
            if (IN(pb + 7)) {
                gm::K5 k; k.H = H8B; k.Wd = WD8; k.Y = YSORT; k.tb = tb; k.G = F.G; k.vcu = F.vcu; k.rtc = F.ctl + CW_RT + (size_t)l * 160 * 64; k.tmo = F.ctl + CW_TMO;
                for (int rp = 0; rp < NREP(14); ++rp) gm::gemm_phase<gm::K5>(F.lds, k, F.wave);
            }
        }
        SEAM(pb + 7);
        if (IN(pb + 8) && PHON(9)) {
            PHASE_IDS();
            const int b = F.vcu >> 5; const bool lastl = (l == DEPTH - 1);
            LAS bf16_t* Sst = (LAS bf16_t*)F.lds; LAS float* Pb = (LAS float*)(F.lds + NMM_P_OFF); LAS int* t0 = (LAS int*)(F.lds + MOE_TB_OFF);
            NarrowT NT_; nmm_load_tail(NT_, WIN + ((size_t)(lastl ? l : l + 1) * PW + PP) * DM, wid, lane);
            if (wid == 0) { gu32* cntw = F.ctl + CW_CNT + (size_t)l * NBUCKET * 64;
                const int c = (lane < NBUCKET) ? (int)__hip_atomic_load(cntw + lane * 64, RLX_AGENT) : 0; const int ntl = (c + 255) >> 8; int incl = ntl;
#pragma unroll
                for (int o = 1; o < 32; o <<= 1) { const int t_ = __shfl_up(incl, o); if (lane >= o) incl += t_; }
                if (lane < NBUCKET) t0[32 + lane] = incl - ntl; }
            __syncthreads();
            const float* mdn = MOD + ((size_t)(lastl ? l : l + 1) * NB + b) * 6144; const float* md = modl + (size_t)b * 6144;
            const float* lg = AIN(I_LN2G) + l * DM; const float* lb = AIN(I_LN2B) + l * DM;
            f32x4 gv[4], bv[4], sh[4], sc[4], g2[4];
#pragma unroll
            for (int j = 0; j < 4; ++j) { const int cix = 4 * lane + 256 * j; gv[j] = *(const f32x4*)(lg + cix); bv[j] = *(const f32x4*)(lb + cix); g2[j] = *(const f32x4*)(md + 5 * 1024 + cix) + 1.0f;
                sh[j] = *(const f32x4*)(mdn + cix); sc[j] = *(const f32x4*)(mdn + 1024 + cix) + 1.0f; }
            const int rowb = F.vcu * 128 + wid * 16;
            const int tsl = TOKSLOT[rowb + (lane & 15)];
            u32x2 xwc[4], ywc[4];
            { const int ts = __shfl(tsl, 0); const size_t yrow = (size_t)t0[32 + (ts >> 16)] * 256 + (ts & 0xffff);
#pragma unroll
              for (int j = 0; j < 4; ++j) { const int cix = 4 * lane + 256 * j; xwc[j] = *(const u32x2*)(XB + (size_t)rowb * DM + cix); ywc[j] = *(const u32x2*)(YSORT + yrow * DM + cix); } }
            u32x2 xwn[4] = {xwc[0], xwc[1], xwc[2], xwc[3]}, ywn[4] = {ywc[0], ywc[1], ywc[2], ywc[3]};
            for (int i = 0; i < 16; ++i) { const int row = rowb + i;
                if (i < 15) { const int ts = __shfl(tsl, i + 1); const size_t yrow = (size_t)t0[32 + (ts >> 16)] * 256 + (ts & 0xffff);
#pragma unroll
                    for (int j = 0; j < 4; ++j) { const int cix = 4 * lane + 256 * j; xwn[j] = *(const u32x2*)(XB + (size_t)(row + 1) * DM + cix); ywn[j] = *(const u32x2*)(YSORT + yrow * DM + cix); } }
                f32x4 v[4]; float s = 0.f;
#pragma unroll
                for (int j = 0; j < 4; ++j) {
                    const u32x2 xw = xwc[j]; const f32x4 xv = (f32x4){bflo(xw.x), bfhi(xw.x), bflo(xw.y), bfhi(xw.y)};
                    const u32x2 yw = ywc[j]; const f32x4 yv = (f32x4){bflo(yw.x), bfhi(yw.x), bflo(yw.y), bfhi(yw.y)};
                    v[j] = xv * ALPHA + g2[j] * yv; s += (v[j][0] + v[j][1]) + (v[j][2] + v[j][3]); }
#pragma unroll
                for (int j = 0; j < 4; ++j) { xwc[j] = xwn[j]; ywc[j] = ywn[j]; }
                const float mean = wave_sum(s) * (1.f / DM); float s2 = 0.f;
#pragma unroll
                for (int j = 0; j < 4; ++j) { v[j] = v[j] - mean; s2 += (v[j][0] * v[j][0] + v[j][1] * v[j][1]) + (v[j][2] * v[j][2] + v[j][3] * v[j][3]); }
                const float rstd = __builtin_amdgcn_rsqf(wave_sum(s2) * (1.f / DM) + LN_EPS);
#pragma unroll
                for (int j = 0; j < 4; ++j) { const size_t o = (size_t)row * DM + 4 * lane + 256 * j; const f32x4 xn = v[j] * rstd * gv[j] + bv[j];
                    if (lastl) *(f32x4*)(ap->out + o) = xn;
                    else { u32x2 xw; xw.x = pk2(xn[0], xn[1]); xw.y = pk2(xn[2], xn[3]); *(u32x2*)(XB + o) = xw;
                        const f32x4 u = xn * sc[j] + sh[j]; u32x2 w; w.x = pk2(u[0], u[1]); w.y = pk2(u[2], u[3]); *(LAS u32x2*)(Sst + (wid * 4 + (i & 3)) * NSP + 4 * lane + 256 * j) = w;
                        *(unsigned*)(U8B + o) = pk4_fp8(u[0], u[1], u[2], u[3]); } }
                if (!lastl && (i & 3) == 3) nmm_step_tail(NT_, Sst, Pb, TAILB + (size_t)(F.vcu * 128) * 32, i - 3, tid, wid, lane);
            }
        }
        SEAM(pb + 8);
    }
#undef IN
#undef SEAM
}

extern "C" void kernel_launch(void* const* d_in, const int* in_sizes, int n_in, void* d_out, int out_size, void* d_ws, size_t ws_size, hipStream_t stream) {
    static int grid = 0;
    if (grid == 0) {
        if (n_in != 29 || in_sizes[0] != NTOK * DM || out_size != NTOK * DM || ws_size < WS_END) {
            fprintf(stderr, "kernel_launch: unexpected shapes (n_in %d, in0 %d, out %d, ws %zu need %zu); nothing launched\n", n_in, n_in > 0 ? in_sizes[0] : -1, out_size, ws_size, (size_t)WS_END); grid = -1; return; }
        int dev = 0, cus = 0, per_cu = 0;
        if (hipGetDevice(&dev) != hipSuccess || hipDeviceGetAttribute(&cus, hipDeviceAttributeMultiprocessorCount, dev) != hipSuccess) { grid = -1; return; }
        if (hipFuncSetAttribute((const void*)mega_fwd, hipFuncAttributeMaxDynamicSharedMemorySize, LDS_BYTES) != hipSuccess) { fprintf(stderr, "kernel_launch: hipFuncSetAttribute failed\n"); grid = -1; return; }
        if (hipOccupancyMaxActiveBlocksPerMultiprocessor(&per_cu, (const void*)mega_fwd, 512, LDS_BYTES) != hipSuccess || per_cu < 1) { fprintf(stderr, "kernel_launch: occupancy query reports %d\n", per_cu); }
        (void)hipGetLastError();
        grid = cus;
        if (grid != 256) fprintf(stderr, "kernel_launch: %d CUs (row phases assume 256)\n", grid);
    }
    if (grid < 0) return;
    if (hipMemsetAsync((char*)d_ws + WS_CTL, 0, CTL_ZERO_BYTES, stream) != hipSuccess) return;
    Args a{};
    for (int i = 0; i < 29; ++i) a.in[i] = (const float*)d_in[i];
    a.out = (float*)d_out; a.ws = (unsigned char*)d_ws;
#if MK_ONE_LAUNCH
    a.ph_lo = 0; a.ph_hi = N_PHASES;
    hipLaunchKernelGGL(mega_fwd, dim3(grid), dim3(512), LDS_BYTES, stream, a);
#else
    for (int p = 0; p < N_PHASES; ++p) { a.ph_lo = p; a.ph_hi = p + 1; hipLaunchKernelGGL(mega_fwd, dim3(grid), dim3(512), LDS_BYTES, stream, a); }
#endif
}
```

```cpp
#include <hip/hip_runtime.h>
#include <hip/hip_bf16.h>
#include <cstdio>
#include <cstdint>
#include <cmath>

#ifndef MK_ONE_LAUNCH
#define MK_ONE_LAUNCH 1
#endif
#ifndef PHM
#define PHM 0xFFFF
#endif
#define PHON(n) (((PHM) >> (n)) & 1)
#ifndef REPM
#define REPM 0
#endif
#define NREP(n) ((((REPM) >> (n)) & 1) ? 2 : 1)

#define LAS __attribute__((address_space(3)))
#define GAS __attribute__((address_space(1)))
typedef unsigned short bf16_t;
typedef short bf16x8 __attribute__((ext_vector_type(8)));
typedef float f32x4 __attribute__((ext_vector_type(4)));
typedef float f32x2 __attribute__((ext_vector_type(2)));
typedef unsigned u32x4 __attribute__((ext_vector_type(4)));
typedef unsigned u32x2 __attribute__((ext_vector_type(2)));
typedef GAS unsigned gu32;

constexpr int NB = 8, SEQ = 4096, NTOK = NB * SEQ, DM = 1024, DEPTH = 4, NH = 4, HD = 64, PIN = 3608, PP = 3584, PW = 3840, NE = 16, DE = 512;
constexpr int NCH = SEQ / 64;
constexpr float ALPHA = 1.6817928305074290f;
constexpr float LN_EPS = 1e-6f;
constexpr float ATT_C2 = 0.17677669529663687f * 1.4426950408889634f;
constexpr int NBUCKET = 24, LCAP = NTOK;
constexpr int CONV_B4 = 4, CONV_B5 = 3;
__host__ __device__ __forceinline__ int tail_short(int nu, int G) { const int mx = (nu + G - 1) / G; const int r = nu - (mx - 1) * G; return G - r; }
__host__ __device__ __forceinline__ int tail_items(int nu, int G, int B) { return tail_short(nu, G) * 8 * B; }
constexpr int PJ = 256, TSZ = NTOK * 256;
constexpr int C_MQ = 0, C_MK = TSZ, C_MV = 2 * TSZ, C_MO = 3 * TSZ, C_CB = 4 * TSZ, C_CC = 5 * TSZ, C_CH = 6 * TSZ, C_DQ = 7 * TSZ, C_DK = 8 * TSZ, C_DV = 9 * TSZ,
              C_GQ = 10 * TSZ, C_GK = 11 * TSZ, C_GV = 12 * TSZ, C_GR = 13 * TSZ;
constexpr int T_GA = 0, T_MI = 16, T_MF = 20;

constexpr size_t MiB = 1u << 20;
constexpr size_t WS_CTL = 0, CTL_ZERO_BYTES = 1 * MiB;
constexpr size_t WS_MOD = 1 * MiB;
constexpr size_t WS_ROPE = 2 * MiB;
constexpr size_t WS_WIN = 3 * MiB;
constexpr size_t WS_WOUT = 33 * MiB;
constexpr size_t WS_WGU = 41 * MiB;
constexpr size_t WS_WD = 73 * MiB;
constexpr size_t WS_LTOK = 89 * MiB;
constexpr size_t WS_LGATE = 92 * MiB;
constexpr size_t WS_SM = 98 * MiB;
constexpr size_t WS_PROJ = 100 * MiB;
constexpr size_t WS_XR = 340 * MiB;
constexpr size_t WS_U = 468 * MiB;
constexpr size_t WS_YCAT = 532 * MiB;
constexpr size_t WS_TAIL = 596 * MiB;
constexpr size_t WS_YSORT = WS_PROJ + 100 * MiB;
constexpr size_t WS_U8 = 600 * MiB;
constexpr size_t WS_WIN8 = 632 * MiB;
constexpr size_t WS_END = 648 * MiB;
constexpr size_t SM_N = 0, SM_BC = 512 * 1024, SM_DM = 520 * 1024, SM_MS = 528 * 1024, SM_GBE = 1 * MiB, SM_TS = 1536 * 1024;
constexpr int CW_TMO = 0, CW_CODE = 1, CW_ZPAGE = 256, CW_BAR = 4096, CW_CNT = 16384, CW_RT = 24576;
constexpr int RING_BYTES = 131072, LDSCTL_OFF = RING_BYTES, MISC_OFF = LDSCTL_OFF + 320, MOE_TB_OFF = LDSCTL_OFF + 1024, LDS_BYTES = 147456;

#define RLX_AGENT __ATOMIC_RELAXED, __HIP_MEMORY_SCOPE_AGENT
#define LDS_WAIT() asm volatile("s_waitcnt lgkmcnt(0)" ::: "memory")
#define VM_WAIT() asm volatile("s_waitcnt vmcnt(0)" ::: "memory")

__device__ __forceinline__ unsigned f2bf(float f) { unsigned u = __builtin_bit_cast(unsigned, f); return (u + 0x7fffu + ((u >> 16) & 1u)) >> 16; }
__device__ __forceinline__ unsigned pk2(float lo, float hi) { typedef __bf16 bf2 __attribute__((ext_vector_type(2))); f32x2 v = {lo, hi}; bf2 b = __builtin_convertvector(v, bf2); return __builtin_bit_cast(unsigned, b); }
__device__ __forceinline__ unsigned pk4_fp8(float a, float b, float c, float d) {
    a = __builtin_amdgcn_fmed3f(a, -448.f, 448.f); b = __builtin_amdgcn_fmed3f(b, -448.f, 448.f); c = __builtin_amdgcn_fmed3f(c, -448.f, 448.f); d = __builtin_amdgcn_fmed3f(d, -448.f, 448.f);
    int w = 0; w = __builtin_amdgcn_cvt_pk_fp8_f32(a, b, w, false); w = __builtin_amdgcn_cvt_pk_fp8_f32(c, d, w, true); return (unsigned)w; }
__device__ __forceinline__ void st8_wt(void* p, u32x2 v) { asm volatile("global_store_dwordx2 %0, %1, off sc1\n\ts_nop 0" :: "v"(p), "v"(v) : "memory"); }
constexpr float W8S = 64.f, H8S = 16.f, Y8S = 8.f;
__device__ __forceinline__ float bf2f(unsigned b) { return __builtin_bit_cast(float, b << 16); }
__device__ __forceinline__ float bflo(unsigned w) { return __builtin_bit_cast(float, w << 16); }
__device__ __forceinline__ float bfhi(unsigned w) { return __builtin_bit_cast(float, w & 0xffff0000u); }
__device__ __forceinline__ void st16_wt(void* p, u32x4 v) { asm volatile("global_store_dwordx4 %0, %1, off sc1\n\ts_nop 1" :: "v"(p), "v"(v) : "memory"); }
#define DPP_F(x, ctrl) __builtin_bit_cast(float, __builtin_amdgcn_update_dpp(0, __builtin_bit_cast(int, (x)), (ctrl), 0xf, 0xf, true))
__device__ __forceinline__ float wave_sum(float v) {
    v += DPP_F(v, 0xB1); v += DPP_F(v, 0x4E); v += DPP_F(v, 0x141); v += DPP_F(v, 0x140);
    { auto r = __builtin_amdgcn_permlane16_swap(__float_as_uint(v), __float_as_uint(v), false, false); v = __uint_as_float(r[0]) + __uint_as_float(r[1]); }
    { auto r = __builtin_amdgcn_permlane32_swap(__float_as_uint(v), __float_as_uint(v), false, false); v = __uint_as_float(r[0]) + __uint_as_float(r[1]); }
    return v;
}
__device__ __forceinline__ float wave_max(float v) {
    v = fmaxf(v, DPP_F(v, 0xB1)); v = fmaxf(v, DPP_F(v, 0x4E)); v = fmaxf(v, DPP_F(v, 0x141)); v = fmaxf(v, DPP_F(v, 0x140));
    { auto r = __builtin_amdgcn_permlane16_swap(__float_as_uint(v), __float_as_uint(v), false, false); v = fmaxf(__uint_as_float(r[0]), __uint_as_float(r[1])); }
    { auto r = __builtin_amdgcn_permlane32_swap(__float_as_uint(v), __float_as_uint(v), false, false); v = fmaxf(__uint_as_float(r[0]), __uint_as_float(r[1])); }
    return v;
}
__device__ __forceinline__ float fexp(float x) { return __builtin_amdgcn_exp2f(x * 1.4426950408889634f); }
__device__ __forceinline__ float flog(float x) { return __builtin_amdgcn_logf(x) * 0.6931471805599453f; }
__device__ __forceinline__ float logsig(float z) { return fminf(z, 0.f) - flog(1.f + fexp(-fabsf(z))); }
__device__ __forceinline__ float sigmoidf_(float z) { return 1.f / (1.f + fexp(-z)); }

__device__ __forceinline__ int lane_id_() { int l_; asm volatile("v_mbcnt_lo_u32_b32 %0, -1, 0\n\tv_mbcnt_hi_u32_b32 %0, -1, %0" : "=v"(l_)); return l_; }
__device__ __forceinline__ int mk_tid(int wave) { return (wave << 6) | lane_id_(); }
#define XB_TMO      128
#define XB_XCNT(j)  (256  + 64 * (j))
#define XB_XSUB(j)  (1280 + 64 * (j))
#define XB_XGEN(j)  (2304 + 64 * (j))
#define XB_TOP      3328
#define XB_TOPGEN   3392
#define XCD_BAR_WORDS 3456
#define XB_SPIN_CAP (1u << 18)
__device__ __forceinline__ unsigned xb_ld(unsigned* p)              { return __hip_atomic_load(p, __ATOMIC_RELAXED, __HIP_MEMORY_SCOPE_AGENT); }
__device__ __forceinline__ unsigned xb_add(unsigned* p, unsigned v) { return __hip_atomic_fetch_add(p, v, __ATOMIC_RELAXED, __HIP_MEMORY_SCOPE_AGENT); }
__device__ __forceinline__ unsigned xb_xcc_id() { return (unsigned)__builtin_amdgcn_s_getreg((3 << 11) | 20) & 0xFu; }
#define XB_SPIN(cond, bar) do { unsigned _sp = 0; while (cond) { __builtin_amdgcn_s_sleep(1); \
    if ((++_sp & 255u) == 0u) { if (xb_ld(&(bar)[XB_TMO])) break; if (_sp > XB_SPIN_CAP) { atomicAdd(&(bar)[XB_TMO], 1u); break; } } } } while (0)
struct XcdBarrier { unsigned* bar; unsigned x; volatile LAS unsigned* st; };
__device__ __forceinline__ XcdBarrier xcd_barrier_post(unsigned* bar, volatile LAS unsigned* st, bool t0) {
    XcdBarrier b; b.bar = bar; b.x = xb_xcc_id(); b.st = st;
    if (t0) (void)xb_add(&bar[XB_XCNT(b.x)], 1u);
    return b;
}
__device__ __forceinline__ void xcd_barrier_complete(unsigned* bar, unsigned x, unsigned& nloc, unsigned& nx) {
    const unsigned G = gridDim.x * gridDim.y * gridDim.z;
    unsigned sum, cnt, mine, sp = 0u;
    for (;;) {
        sum = 0u; cnt = 0u; mine = 0u;
#pragma unroll
        for (unsigned j = 0; j < 16; ++j) { const unsigned c = xb_ld(&bar[XB_XCNT(j)]); sum += c; cnt += (c > 0u) ? 1u : 0u; mine = (j == x) ? c : mine; }
        if (sum == G) break;
        __builtin_amdgcn_s_sleep(1);
        if ((++sp & 255u) == 0u) { if (xb_ld(&bar[XB_TMO])) break; if (sp > XB_SPIN_CAP) { atomicAdd(&bar[XB_TMO], 1u); break; } }
    }
    nloc = mine > 0u ? mine : 1u; nx = cnt > 0u ? cnt : 1u;
}
__device__ __forceinline__ void xcd_barrier(const XcdBarrier& b, bool t0) {
    asm volatile("s_waitcnt vmcnt(0)" ::: "memory");
    __syncthreads();
    if (t0) {
        unsigned* bar = b.bar;
        __builtin_amdgcn_s_waitcnt(0);
        unsigned nloc = b.st[0], nx = b.st[1];
        if (nloc == 0u) { xcd_barrier_complete(bar, b.x, nloc, nx); b.st[0] = nloc; b.st[1] = nx; }
        const unsigned old = xb_add(&bar[XB_XSUB(b.x)], 1u);
        const unsigned gen = old / nloc;
        if (old + 1u == (gen + 1u) * nloc) {
            __builtin_amdgcn_fence(__ATOMIC_RELEASE, "agent");
            asm volatile("s_waitcnt vmcnt(0)" ::: "memory");
            const unsigned og = xb_add(&bar[XB_TOP], 1u);
            const unsigned tg = og / nx;
            if (og + 1u == (tg + 1u) * nx) xb_add(&bar[XB_TOPGEN], 1u);
            else XB_SPIN(xb_ld(&bar[XB_TOPGEN]) == tg, bar);
            __builtin_amdgcn_fence(__ATOMIC_ACQUIRE, "agent");
            asm volatile("s_waitcnt vmcnt(0)" ::: "memory");
        } else {
            XB_SPIN(xb_ld(&bar[XB_TOPGEN]) == gen, bar);
            __builtin_amdgcn_fence(__ATOMIC_ACQUIRE, "agent");
            asm volatile("s_waitcnt vmcnt(0)" ::: "memory");
        }
    }
    __syncthreads();
}

namespace gm {
constexpr int BM = 256, BK = 64, HALF = 128, HTB = HALF * BK * 2, NXCD = 8, WGM = 8;
typedef int v4i_t __attribute__((ext_vector_type(4))); typedef int v8i_t __attribute__((ext_vector_type(8)));
__host__ __device__ __forceinline__ int lds_byte(int r, int c) { const int st = (r >> 4) * 2 + (c >> 5), rr = r & 15, cc = c & 31, ob = rr * 64 + cc * 2; return st * 1024 + (ob ^ (((ob >> 9) & 1) << 5)); }
__host__ __device__ __forceinline__ void stage_rc(int b, int& R, int& C) { const int st = b / 1024, sb = b % 1024, swz = sb ^ (((sb >> 9) & 1) << 5); R = (st >> 1) * 16 + swz / 64; C = (st & 1) * 32 + (swz % 64) / 2; }
__host__ __device__ __forceinline__ int perm32(int rho) { const int n = rho >> 4, i = rho & 15; return 8 * (i >> 2) + 4 * n + (i & 3); }
struct Unit { int pm, pn, bk, tb; };
struct Src { const char* a; const char* b0; const char* b1; unsigned va[2][2]; };
struct StaticOrder {
    int nM, nN, nwg, G, c;
    __device__ void init(int M, int N, int G_, int c_) { nM = M / BM; nN = N / BM; nwg = nM * nN; G = G_; c = c_; }
    __device__ __forceinline__ bool next(int i, Unit& u) const {
        const long L = (long)i * G + c; if (L >= nwg) return false;
        int wgid = (int)L; { const int q = nwg / NXCD, r = nwg % NXCD, xcd = wgid % NXCD, off = wgid / NXCD; wgid = (xcd < r ? xcd * (q + 1) : r * (q + 1) + (xcd - r) * q) + off; }
        const int nig = WGM * nN, gid = wgid / nig, fm = gid * WGM, gsz = (nM - fm) < WGM ? (nM - fm) : WGM;
        u.pm = fm + ((wgid % nig) % gsz); u.pn = (wgid % nig) / gsz; u.bk = 0; u.tb = 0; return true;
    }
};

template <class Kind>
__device__ __forceinline__ void gemm_phase(LAS unsigned char* lds, const Kind& Kd, int wave) {
    int tid_ = mk_tid(wave); asm volatile("" : "+v"(tid_));
    const int tid = tid_, wid = __builtin_amdgcn_readfirstlane(tid >> 6), lane = tid & 63, wr = wid >> 2, wc = wid & 3, fr = lane & 15, fq = lane >> 4;
    int R[2], C[2]; unsigned voffB[2];
#pragma unroll
    for (int i = 0; i < 2; ++i) { stage_rc(tid * 16 + i * 8192, R[i], C[i]); const int Rb = Kind::PERM ? ((R[i] & ~31) + perm32(R[i] & 31)) : R[i]; voffB[i] = (unsigned)(Rb * Kind::LDBB + C[i] * 2); }
    const size_t hstepB = (size_t)HALF * Kind::LDBB;
    constexpr int NT = Kind::NTK;
    const unsigned ldsw = (unsigned)wid * 1024u;
    const int aoff = lds_byte(wr * 64 + fr, fq * 8), boff = lds_byte(wc * 32 + fr, fq * 8);
#define G_SA(b, h) (((b) * 2 + (h)) * HTB)
#define G_SB(b, h) ((4 + (b) * 2 + (h)) * HTB)
#define G_STAGE_A(bufoff, S, t, h) do { const char* _g = (S).a + (size_t)(t) * 128; _Pragma("unroll") for (int _i = 0; _i < 2; ++_i) \
        __builtin_amdgcn_global_load_lds((const unsigned*)(_g + (S).va[h][_i]), (LAS unsigned*)(lds + (bufoff) + ldsw + _i * 8192), 16, 0, 0); } while (0)
#define G_STAGE_B(bufoff, S, t, h) do { const char* _g = (((t) < NT / 2) ? (S).b0 + (size_t)(t) * 128 : (S).b1 + (size_t)((t) - NT / 2) * 128) + (h) * hstepB; _Pragma("unroll") for (int _i = 0; _i < 2; ++_i) \
        __builtin_amdgcn_global_load_lds((const unsigned*)(_g + voffB[_i]), (LAS unsigned*)(lds + (bufoff) + ldsw + _i * 8192), 16, 0, 0); } while (0)
#define G_LDA(dst, b, h) do { _Pragma("unroll") for (int m = 0; m < 4; ++m) _Pragma("unroll") for (int k = 0; k < 2; ++k) dst[m][k] = *(const LAS bf16x8*)(lds + G_SA(b, h) + aoff + m * 2048 + k * 1024); } while (0)
#define G_LDB(dst, b, h) do { _Pragma("unroll") for (int n = 0; n < 2; ++n) _Pragma("unroll") for (int k = 0; k < 2; ++k) dst[n][k] = *(const LAS bf16x8*)(lds + G_SB(b, h) + boff + n * 2048 + k * 1024); } while (0)
#define G_MMA(ai, bj, At, Bt) do { __builtin_amdgcn_s_setprio(1); _Pragma("unroll") for (int m = 0; m < 4; ++m) _Pragma("unroll") for (int n = 0; n < 2; ++n) _Pragma("unroll") for (int k = 0; k < 2; ++k) \
        acc[ai][bj][m][n] = __builtin_amdgcn_mfma_f32_16x16x32_bf16(Bt[n][k], At[m][k], acc[ai][bj][m][n], 0, 0, 0); __builtin_amdgcn_s_setprio(0); } while (0)
#define G_LDA8(dst, b, h) do { _Pragma("unroll") for (int m = 0; m < 4; ++m) { const v4i_t _lo = *(const LAS v4i_t*)(lds + G_SA(b, h) + aoff + m * 2048), _hi = *(const LAS v4i_t*)(lds + G_SA(b, h) + aoff + m * 2048 + 1024); \
        dst[m] = __builtin_shufflevector(_lo, _hi, 0, 1, 2, 3, 4, 5, 6, 7); } } while (0)
#define G_LDB8(dst, b, h) do { _Pragma("unroll") for (int n = 0; n < 2; ++n) { const v4i_t _lo = *(const LAS v4i_t*)(lds + G_SB(b, h) + boff + n * 2048), _hi = *(const LAS v4i_t*)(lds + G_SB(b, h) + boff + n * 2048 + 1024); \
        dst[n] = __builtin_shufflevector(_lo, _hi, 0, 1, 2, 3, 4, 5, 6, 7); } } while (0)
#define G_MMA8(ai, bj, A8_, B8_) do { __builtin_amdgcn_s_setprio(1); _Pragma("unroll") for (int m = 0; m < 4; ++m) _Pragma("unroll") for (int n = 0; n < 2; ++n) \
        asm volatile("v_mfma_scale_f32_16x16x128_f8f6f4 %0, %1, %2, %0, %3, %3 op_sel_hi:[0,0,0]" : "+v"(acc[ai][bj][m][n]) : "v"(B8_[n]), "v"(A8_[m]), "v"(sc1v)); __builtin_amdgcn_s_setprio(0); } while (0)
#define G_MMA8Z(ai, bj, A8_, B8_) do { __builtin_amdgcn_s_setprio(1); _Pragma("unroll") for (int m = 0; m < 4; ++m) _Pragma("unroll") for (int n = 0; n < 2; ++n) \
        asm volatile("v_mfma_scale_f32_16x16x128_f8f6f4 %0, %1, %2, 0, %3, %3 op_sel_hi:[0,0,0]" : "=&v"(acc[ai][bj][m][n]) : "v"(B8_[n]), "v"(A8_[m]), "v"(sc1v)); __builtin_amdgcn_s_setprio(0); } while (0)
#define X_LDA(b, h) do { if constexpr (Kind::FP8) G_LDA8(A8, b, h); else G_LDA(At, b, h); } while (0)
#define X_LDB0(b, h) do { if constexpr (Kind::FP8) G_LDB8(B08, b, h); else G_LDB(B0, b, h); } while (0)
#define X_LDB1(b, h) do { if constexpr (Kind::FP8) G_LDB8(B18, b, h); else G_LDB(B1, b, h); } while (0)
#define X_MM0(ai, bj) do { if constexpr (Kind::FP8) G_MMA8(ai, bj, A8, B08); else G_MMA(ai, bj, At, B0); } while (0)
#define X_MM1(ai, bj) do { if constexpr (Kind::FP8) G_MMA8(ai, bj, A8, B18); else G_MMA(ai, bj, At, B1); } while (0)
#define X_MM0F(ai, bj) do { if constexpr (Kind::FP8) { if (t == 0) G_MMA8Z(ai, bj, A8, B08); else G_MMA8(ai, bj, A8, B08); } else G_MMA(ai, bj, At, B0); } while (0)
#define X_MM1F(ai, bj) do { if constexpr (Kind::FP8) { if (t == 0) G_MMA8Z(ai, bj, A8, B18); else G_MMA8(ai, bj, A8, B18); } else G_MMA(ai, bj, At, B1); } while (0)
#define G_WAIT_V(n) asm volatile("s_waitcnt vmcnt(" #n ")" ::: "memory")
#define G_WAIT_L(n) asm volatile("s_waitcnt lgkmcnt(" #n ")" ::: "memory")
#define G_BAR __builtin_amdgcn_s_barrier()
#define G_SCHED __builtin_amdgcn_sched_barrier(0)
    Unit cur, nxt; Src sc, sn; int ui = 0; int pend = -1;
    if (!Kd.next(0, cur)) return;
    Kd.src(cur, sc, R, C);
    Kd.a_ready(cur, wid);
    f32x4 acc[2][2][4][2];
#pragma unroll
    for (int a = 0; a < 2; ++a)
#pragma unroll
        for (int b = 0; b < 2; ++b)
#pragma unroll
            for (int m = 0; m < 4; ++m)
#pragma unroll
                for (int n = 0; n < 2; ++n) acc[a][b][m][n] = (f32x4){0.f, 0.f, 0.f, 0.f};
    bf16x8 At[4][2], B0[2][2], B1[2][2]; v8i_t A8[4], B08[2], B18[2]; int sc1v = 0x7f7f7f7f; asm volatile("" : "+v"(sc1v));
    G_STAGE_B(G_SB(0, 0), sc, 0, 0); G_STAGE_B(G_SB(0, 1), sc, 0, 1); G_STAGE_A(G_SA(0, 0), sc, 0, 0); G_STAGE_A(G_SA(0, 1), sc, 0, 1);
    if (wr == 1) G_BAR;
    G_WAIT_V(2); G_BAR;
    G_STAGE_B(G_SB(1, 0), sc, 1, 0); G_STAGE_A(G_SA(1, 0), sc, 1, 0); G_STAGE_B(G_SB(1, 1), sc, 1, 1);
    G_WAIT_V(6); G_BAR;
    for (;;) {
        const bool has_next = Kd.next(ui + 1, nxt);
        if (has_next) Kd.src(nxt, sn, R, C); else sn = sc;
#pragma unroll 1
        for (int t = 0; t < NT; t += 2) {
            const bool last = (t == NT - 2);
            if (last && has_next) Kd.a_ready(nxt, wid);
            Src s2; s2.a = last ? sn.a : sc.a; s2.b0 = last ? sn.b0 : sc.b0; s2.b1 = last ? sn.b1 : sc.b1;
            s2.va[0][0] = last ? sn.va[0][0] : sc.va[0][0]; s2.va[0][1] = last ? sn.va[0][1] : sc.va[0][1]; s2.va[1][0] = last ? sn.va[1][0] : sc.va[1][0]; s2.va[1][1] = last ? sn.va[1][1] : sc.va[1][1];
            const int t2 = last ? 0 : t + 2, t3 = t2 + 1;
            X_LDB0(0, 0); X_LDB1(0, 1); G_SCHED; X_LDA(0, 0); G_STAGE_A(G_SA(1, 1), sc, t + 1, 1);
            G_WAIT_V(8); G_WAIT_L(0); G_BAR; X_MM0F(0, 0); X_MM1F(0, 1); G_BAR; G_SCHED;
            X_LDA(0, 1); G_STAGE_B(G_SB(0, 0), s2, t2, 0); G_STAGE_B(G_SB(0, 1), s2, t2, 1); G_STAGE_A(G_SA(0, 0), s2, t2, 0);
            G_WAIT_V(8); G_WAIT_L(0); G_BAR; X_MM0F(1, 0); X_MM1F(1, 1); G_BAR; G_SCHED;
            X_LDB0(1, 0); X_LDB1(1, 1); G_SCHED; X_LDA(1, 0); G_STAGE_A(G_SA(0, 1), s2, t2, 1);
            G_WAIT_V(8); G_WAIT_L(0); G_BAR; X_MM0(0, 0); X_MM1(0, 1); G_BAR; G_SCHED;
            X_LDA(1, 1); G_STAGE_B(G_SB(1, 0), s2, t3, 0); G_STAGE_B(G_SB(1, 1), s2, t3, 1); G_STAGE_A(G_SA(1, 0), s2, t3, 0);
            G_WAIT_V(8); G_WAIT_L(0); G_BAR; X_MM0(1, 0); X_MM1(1, 1); G_BAR; G_SCHED;
        }
        if (wr == 0) G_BAR;
        if (Kind::PUBLISH) { if (pend >= 0) Kd.publish(pend); pend = cur.pm; }
        if (Kind::FP8) asm volatile("s_nop 15\n\ts_nop 15" ::: "memory");
        Kd.epi(acc, cur, wr, wc, fr, fq);
        if (!has_next) break;
        if constexpr (!Kind::FP8) {
#pragma unroll
        for (int a = 0; a < 2; ++a)
#pragma unroll
            for (int b = 0; b < 2; ++b)
#pragma unroll
                for (int m = 0; m < 4; ++m)
#pragma unroll
                    for (int n = 0; n < 2; ++n) acc[a][b][m][n] = (f32x4){0.f, 0.f, 0.f, 0.f};
        }
        cur = nxt; sc = sn; ++ui;
        if (wr == 1) G_BAR;
    }
    G_WAIT_V(0);
    if (Kind::PUBLISH) { if (pend >= 0) Kd.publish(pend); }
    G_BAR;
#undef G_SA
#undef G_SB
#undef G_STAGE_A
#undef G_STAGE_B
#undef G_LDA
#undef G_LDB
#undef G_MMA
#undef G_MMA8
#undef G_LDA8
#undef G_LDB8
#undef X_LDA
#undef X_LDB0
#undef X_LDB1
#undef X_MM0
#undef X_MM1
#undef X_MM0F
#undef X_MM1F
#undef G_MMA8Z
#undef G_WAIT_V
#undef G_WAIT_L
#undef G_BAR
#undef G_SCHED
}

__device__ __forceinline__ void src_direct(Src& s, const void* A, int row0, const int (&R)[2], const int (&C)[2], int pitchb = 2048) {
    s.a = (const char*)A + (size_t)row0 * pitchb;
#pragma unroll
    for (int h = 0; h < 2; ++h)
#pragma unroll
        for (int i = 0; i < 2; ++i) s.va[h][i] = (unsigned)((h * HALF + R[i]) * pitchb + C[i] * 2);
}

template <bool F8> struct K1 {
    static constexpr bool PERM = true, PUBLISH = false, FP8 = F8; static constexpr int LDBB = F8 ? 1024 : 2048, NTK = F8 ? 8 : 16;
    __device__ __forceinline__ void publish(int) const {}
    __device__ __forceinline__ void a_ready(const Unit&, int) const {}
    __device__ __forceinline__ void done(const Unit&) const {}
    StaticOrder S; const void* A; const void* Bt; bf16_t* O; const float* rope;
    __device__ __forceinline__ bool next(int i, Unit& u) const { return S.next(i, u); }
    __device__ __forceinline__ void src(const Unit& u, Src& s, const int (&R)[2], const int (&C)[2]) const {
        src_direct(s, A, u.pm * BM, R, C, F8 ? 1024 : 2048); s.b0 = (const char*)Bt + (size_t)u.pn * BM * (F8 ? 1024 : 2048); s.b1 = s.b0 + (F8 ? 512 : 1024);
    }
    __device__ __forceinline__ void epi(const f32x4 (&acc)[2][2][4][2], const Unit& u, int wr, int wc, int fr, int fq) const {
        const int row0 = u.pm * BM + wr * 64 + fr, col0 = u.pn * TSZ + wc * 32 + 8 * fq;
        if (u.pn == 7 || u.pn == 8) {
#pragma unroll
            for (int ai = 0; ai < 2; ++ai)
#pragma unroll
                for (int m = 0; m < 4; ++m) {
                    const int row = row0 + ai * HALF + m * 16;
                    const f32x4 cs = *(const f32x4*)(rope + (size_t)row * 8), sn = *(const f32x4*)(rope + (size_t)row * 8 + 4);
                    bf16_t* rowp = O + (size_t)row * PJ + col0;
#pragma unroll
                    for (int bj = 0; bj < 2; ++bj) {
                        f32x4 v0 = acc[ai][bj][m][0], v1 = acc[ai][bj][m][1]; if (F8) { v0 = v0 * (1.f / W8S); v1 = v1 * (1.f / W8S); }
                        if (fq == 0) { const f32x4 x1 = v0, x2 = v1; v0 = x1 * cs - x2 * sn; v1 = x2 * cs + x1 * sn; }
                        u32x4 w; w.x = pk2(v0[0], v0[1]); w.y = pk2(v0[2], v0[3]); w.z = pk2(v1[0], v1[1]); w.w = pk2(v1[2], v1[3]);
                        *(u32x4*)(rowp + bj * HALF) = w;
                    }
                }
        } else {
#pragma unroll
            for (int ai = 0; ai < 2; ++ai)
#pragma unroll
                for (int m = 0; m < 4; ++m) { bf16_t* rowp = O + (size_t)(row0 + ai * HALF + m * 16) * PJ + col0;
#pragma unroll
                    for (int bj = 0; bj < 2; ++bj) { f32x4 v0 = acc[ai][bj][m][0], v1 = acc[ai][bj][m][1]; if (F8) { v0 = v0 * (1.f / W8S); v1 = v1 * (1.f / W8S); }
                        u32x4 w; w.x = pk2(v0[0], v0[1]); w.y = pk2(v0[2], v0[3]); w.z = pk2(v1[0], v1[1]); w.w = pk2(v1[2], v1[3]);
                        *(u32x4*)(rowp + bj * HALF) = w; } }
        }
    }
};
struct K2 {
    static constexpr bool PERM = true, PUBLISH = false, FP8 = true; static constexpr int LDBB = 1024, NTK = 8;
    __device__ __forceinline__ void publish(int) const {}
    __device__ __forceinline__ void a_ready(const Unit&, int) const {}
    __device__ __forceinline__ void done(const Unit&) const {}
    StaticOrder S; const unsigned char* A; const unsigned char* Bt; bf16_t* O;
    __device__ __forceinline__ bool next(int i, Unit& u) const { return S.next(i, u); }
    __device__ __forceinline__ void src(const Unit& u, Src& s, const int (&R)[2], const int (&C)[2]) const {
        src_direct(s, A, u.pm * BM, R, C, 1024); s.b0 = (const char*)(Bt + (size_t)u.pn * BM * 1024); s.b1 = s.b0 + 512;
    }
    __device__ __forceinline__ void epi(const f32x4 (&acc)[2][2][4][2], const Unit& u, int wr, int wc, int fr, int fq) const {
        const int row0 = u.pm * BM + wr * 64 + fr, col0 = u.pn * BM + wc * 32 + 8 * fq;
#pragma unroll
        for (int ai = 0; ai < 2; ++ai)
#pragma unroll
            for (int m = 0; m < 4; ++m) { bf16_t* rowp = O + (size_t)(row0 + ai * HALF + m * 16) * DM + col0;
#pragma unroll
                for (int bj = 0; bj < 2; ++bj) { const f32x4 v0 = acc[ai][bj][m][0] * (1.f / (W8S * Y8S)), v1 = acc[ai][bj][m][1] * (1.f / (W8S * Y8S));
                    u32x4 w; w.x = pk2(v0[0], v0[1]); w.y = pk2(v0[2], v0[3]); w.z = pk2(v1[0], v1[1]); w.w = pk2(v1[2], v1[3]);
                    *(u32x4*)(rowp + bj * HALF) = w; } }
    }
};
__device__ __forceinline__ int pair_i(int p) { return p < 3 ? 0 : (p < 5 ? 1 : 2); }
__device__ __forceinline__ int pair_j(int p) { return p < 3 ? p + 1 : (p < 5 ? p - 1 : 3); }
struct K4 {
    static constexpr bool PERM = true, PUBLISH = false, FP8 = true; static constexpr int LDBB = 1024, NTK = 8;
    const unsigned char* U; const unsigned char* Wgu; unsigned char* H; const int* ltok; const float* lgate; const LAS int* tb; int G, vcu; gu32* rtc;
    __device__ __forceinline__ void a_ready(const Unit&, int) const {}
    __device__ __forceinline__ void done(const Unit&) const {}
    __device__ __forceinline__ void publish(int pm) const { if (lane_id_() == 0) __hip_atomic_fetch_add(rtc + 64 * pm, 1u, RLX_AGENT); }
    __device__ __forceinline__ bool next(int i, Unit& u) const {
        const int L = i * G + vcu; const int nt = tb[32 + NBUCKET]; if (L >= nt * 8) return false;
        const int rt = L >> 3; int k = 0;
        for (int q = 1; q < NBUCKET; ++q) k = (tb[32 + q] <= rt) ? q : k;
        u.pm = rt; u.pn = L & 7; u.bk = k; u.tb = (rt - tb[32 + k]) | (i << 16); return true;
    }
    __device__ __forceinline__ void src(const Unit& u, Src& s, const int (&R)[2], const int (&C)[2]) const {
        const int cnt = tb[u.bk]; s.a = (const char*)U;
#pragma unroll
        for (int h = 0; h < 2; ++h)
#pragma unroll
            for (int i = 0; i < 2; ++i) { const int pos = (u.tb & 0xffff) * BM + h * HALF + R[i]; const int tok = ltok[(size_t)u.bk * LCAP + (pos < cnt ? pos : 0)]; s.va[h][i] = (unsigned)(tok * 1024 + C[i] * 2); }
        const int grp = u.bk / 6, p = u.bk % 6, sl = u.pn >> 2; const int e = grp * 4 + (sl ? pair_j(p) : pair_i(p));
        s.b0 = (const char*)(Wgu + ((size_t)e * 1024 + (size_t)(u.pn & 3) * BM) * 1024); s.b1 = s.b0 + 512;
    }
    __device__ __forceinline__ void epi(const f32x4 (&acc)[2][2][4][2], const Unit& u, int wr, int wc, int fr, int fq) const {
        const int cnt = tb[u.bk], sl = u.pn >> 2; int colo = sl * 512 + (u.pn & 3) * 128 + wc * 32 + 8 * fq; asm volatile("" : "+v"(colo));
        int gofs = 256 + (u.tb >> 16) * 256 + wr * 64 + fr; asm volatile("" : "+v"(gofs));
        const LAS float* gl = (const LAS float*)tb + gofs;
#pragma unroll
        for (int ai = 0; ai < 2; ++ai)
#pragma unroll
            for (int m = 0; m < 4; ++m) {
                const int r = ai * HALF + wr * 64 + m * 16 + fr, pos = (u.tb & 0xffff) * BM + r;
                const float gt = (pos < cnt) ? gl[ai * HALF + m * 16] : 0.f;
                float hv[8];
#pragma unroll
                for (int n = 0; n < 2; ++n)
#pragma unroll
                    for (int j = 0; j < 4; ++j) { const float g = acc[ai][0][m][n][j] * (1.f / W8S), up = acc[ai][1][m][n][j] * (1.f / W8S); hv[n * 4 + j] = g * __builtin_amdgcn_rcpf(1.f + fexp(-g)) * up * (gt * H8S); }
                u32x2 w; w.x = pk4_fp8(hv[0], hv[1], hv[2], hv[3]); w.y = pk4_fp8(hv[4], hv[5], hv[6], hv[7]);
                *(u32x2*)(H + (size_t)(u.pm * BM + r) * 1024 + colo) = w;
            }
    }
};
struct K5 {
    static constexpr bool PERM = true, PUBLISH = false, FP8 = true; static constexpr int LDBB = 512, NTK = 8;
    __device__ __forceinline__ void publish(int) const {}
    const unsigned char* H; const unsigned char* Wd; bf16_t* Y; const LAS int* tb; int G, vcu; gu32* rtc; gu32* tmo;
    __device__ __forceinline__ void done(const Unit&) const {}
    __device__ __forceinline__ void a_ready(const Unit& u, int wid) const { return;
        if (wid == 0) {
            const unsigned long long t0 = __builtin_amdgcn_s_memrealtime(); unsigned polls = 0;
            while ((unsigned)__builtin_amdgcn_readfirstlane(__hip_atomic_load(rtc + 64 * u.pm, RLX_AGENT)) < 64u) {
                if ((++polls & 255u) == 0u && __builtin_amdgcn_readfirstlane(__hip_atomic_load(tmo, RLX_AGENT)) != 0u) break;
                if (__builtin_amdgcn_s_memrealtime() - t0 > 2000000ull) { if (lane_id_() == 0) __hip_atomic_store(tmo, 1u, RLX_AGENT); break; }
                __builtin_amdgcn_s_sleep(2); }
            __builtin_amdgcn_fence(__ATOMIC_ACQUIRE, "agent");
            asm volatile("s_waitcnt vmcnt(0)" ::: "memory");
        }
        asm volatile("" ::: "memory"); __builtin_amdgcn_s_barrier(); asm volatile("" ::: "memory");
    }
    __device__ __forceinline__ bool next(int i, Unit& u) const {
        const int nt = tb[32 + NBUCKET]; const int n4 = nt * 8; const int i0 = 0; (void)n4;
        const int L = (i + i0) * G + vcu; if (L >= nt * 4) return false;
        const int rt = L >> 2; int k = 0;
        for (int q = 1; q < NBUCKET; ++q) k = (tb[32 + q] <= rt) ? q : k;
        u.pm = rt; u.pn = L & 3; u.bk = k; u.tb = rt - tb[32 + k]; return true;
    }
    __device__ __forceinline__ void src(const Unit& u, Src& s, const int (&R)[2], const int (&C)[2]) const {
        src_direct(s, H, u.pm * BM, R, C, 1024);
        const int grp = u.bk / 6, p = u.bk % 6;
        s.b0 = (const char*)(Wd + ((size_t)(grp * 4 + pair_i(p)) * 1024 + (size_t)u.pn * BM) * 512);
        s.b1 = (const char*)(Wd + ((size_t)(grp * 4 + pair_j(p)) * 1024 + (size_t)u.pn * BM) * 512);
    }
    __device__ __forceinline__ void epi(const f32x4 (&acc)[2][2][4][2], const Unit& u, int wr, int wc, int fr, int fq) const {
        const int row0 = u.pm * BM + wr * 64 + fr, col0 = u.pn * BM + wc * 32 + 8 * fq;
#pragma unroll
        for (int ai = 0; ai < 2; ++ai)
#pragma unroll
            for (int m = 0; m < 4; ++m) { bf16_t* rowp = Y + (size_t)(row0 + ai * HALF + m * 16) * DM + col0;
#pragma unroll
                for (int bj = 0; bj < 2; ++bj) { const f32x4 v0 = acc[ai][bj][m][0] * (1.f / (W8S * H8S)), v1 = acc[ai][bj][m][1] * (1.f / (W8S * H8S));
                    u32x4 w; w.x = pk2(v0[0], v0[1]); w.y = pk2(v0[2], v0[3]); w.z = pk2(v1[0], v1[1]); w.w = pk2(v1[2], v1[3]);
                    *(u32x4*)(rowp + bj * HALF) = w; } }
    }
};
}

namespace attn_body {
using bf16 = __hip_bfloat16;
using s16x4 = __attribute__((ext_vector_type(4))) short;
using f32x16 = __attribute__((ext_vector_type(16))) float;
constexpr int D = 64, PITCH = PJ;
constexpr int NW = 8, QBLK = 32, QB = QBLK * NW, KVBLK = 64;
__device__ __forceinline__ int crow(int r, int hi) { return (r & 3) + 8 * (r >> 2) + 4 * hi; }
#define SBAR() __builtin_amdgcn_sched_barrier(0)
__device__ __forceinline__ void cmask(f32x16& p0, f32x16& p1, int jb, int qrel, int hi) {
    const float NEG = -INFINITY; int kb = 64 * jb + 4 * hi;
#pragma unroll
    for (int r = 0; r < 16; ++r) { int kv = kb + (r & 3) + 8 * (r >> 2); if (kv > qrel) p0[r] = NEG; if (kv + 32 > qrel) p1[r] = NEG; }
}
constexpr int NSLOT = 3, SLOTB = 8192;
constexpr int LDS_K = 0, LDS_V = NSLOT * SLOTB, LDS_WS = 2 * NSLOT * SLOTB, LDS_OST = LDS_WS + NW * 64 * 4, ATT_LDS_BYTES = LDS_OST + NW * 8192;
__device__ __forceinline__ void glds16(const void* gsrc, unsigned lds_dst) { unsigned keep;
    asm volatile("s_mov_b32 %0, m0\n\ts_mov_b32 m0, %2\n\ts_nop 0\n\tglobal_load_lds_dwordx4 %1, off\n\ts_mov_b32 m0, %0" : "=&s"(keep) : "v"(gsrc), "s"(lds_dst) : "memory"); }
__device__ __forceinline__ float max3f(float a, float b, float c) { float r; asm("v_max3_f32 %0, %1, %2, %3" : "=v"(r) : "v"(a), "v"(b), "v"(c)); return r; }
__device__ __forceinline__ float max2f(float a, float b) { float r; asm("v_max_f32_e32 %0, %1, %2" : "=v"(r) : "v"(a), "v"(b)); return r; }
__device__ __forceinline__ float fadd_s(float a, float b) { float r; asm("v_add_f32_e32 %0, %1, %2" : "=v"(r) : "v"(a), "v"(b)); return r; }
__device__ __forceinline__ float fsub_s(float a, float b) { float r; asm("v_sub_f32_e32 %0, %1, %2" : "=v"(r) : "v"(a), "v"(b)); return r; }
typedef float f32x2_t __attribute__((ext_vector_type(2))); typedef __bf16 bf16x2_t __attribute__((ext_vector_type(2)));
__device__ __forceinline__ unsigned cvtpk_s(float lo, float hi) { f32x2_t v = {lo, hi}; bf16x2_t b = __builtin_convertvector(v, bf16x2_t); return __builtin_bit_cast(unsigned, b); }
#define WAIT_BAR(N) asm volatile("s_waitcnt vmcnt(" #N ") lgkmcnt(0)\n\ts_barrier" ::: "memory")
__device__ __forceinline__ void qkt(f32x16& p0, f32x16& p1, const char* Kslot, const bf16x8* qr, const f32x16& negm, int r32, int hi) {
    const char* kb = Kslot + hi * 1024 + r32 * 16;
#pragma unroll
    for (int d0 = 0; d0 < 2; ++d0) {
        const bf16x8 b0 = *reinterpret_cast<const bf16x8*>(kb + d0 * 2048);
        const bf16x8 b1 = *reinterpret_cast<const bf16x8*>(kb + d0 * 2048 + 512);
        if (d0 == 0) { p0 = __builtin_amdgcn_mfma_f32_32x32x16_bf16(b0, qr[0], negm, 0, 0, 0); p1 = __builtin_amdgcn_mfma_f32_32x32x16_bf16(b1, qr[0], negm, 0, 0, 0); }
        else { p0 = __builtin_amdgcn_mfma_f32_32x32x16_bf16(b0, qr[d0], p0, 0, 0, 0); p1 = __builtin_amdgcn_mfma_f32_32x32x16_bf16(b1, qr[d0], p1, 0, 0, 0); } }
}
typedef __attribute__((address_space(3))) const char* lds_cptr;
typedef short v4i16_t __attribute__((ext_vector_type(4)));
__device__ __forceinline__ void kload8(bf16x8* kf, lds_cptr kp) {
    kf[0] = *(const __attribute__((address_space(3))) bf16x8*)(kp);        kf[1] = *(const __attribute__((address_space(3))) bf16x8*)(kp + 512);
    kf[2] = *(const __attribute__((address_space(3))) bf16x8*)(kp + 2048); kf[3] = *(const __attribute__((address_space(3))) bf16x8*)(kp + 2560);
}
__device__ __forceinline__ void kload2(bf16x8* kf, lds_cptr kp, int j) { kf[2 * j] = *(const __attribute__((address_space(3))) bf16x8*)(kp + j * 2048); kf[2 * j + 1] = *(const __attribute__((address_space(3))) bf16x8*)(kp + j * 2048 + 512); }
__device__ __forceinline__ s16x4 vtr(lds_cptr p) { return __builtin_bit_cast(s16x4, __builtin_amdgcn_ds_read_tr16_b64_v4i16((__attribute__((address_space(3))) v4i16_t*)p)); }
__device__ __forceinline__ float rowmax(const f32x16& p0, const f32x16& p1) {
    float a = max3f(p0[0], p0[1], p1[0]), b = max3f(p0[2], p0[3], p1[1]); a = max3f(a, p1[2], p1[3]);
#pragma unroll
    for (int r = 4; r < 16; r += 4) { a = max3f(a, p0[r], p0[r + 1]); b = max3f(b, p0[r + 2], p0[r + 3]); a = max3f(a, p1[r], p1[r + 1]); b = max3f(b, p1[r + 2], p1[r + 3]); }
    const float m = max2f(a, b);
    auto rr = __builtin_amdgcn_permlane32_swap(__float_as_uint(m), __float_as_uint(m), false, false);
    return max2f(__uint_as_float(rr[0]), __uint_as_float(rr[1]));
}
__device__ __forceinline__ void pv(f32x16* o, int vb, bf16x8 pa0, bf16x8 pa1, bf16x8 pa2, bf16x8 pa3) {
#pragma unroll
    for (int d0 = 0; d0 < 2; ++d0) { s16x4 lo[4], hi[4];
#pragma unroll
        for (int ks = 0; ks < 4; ++ks) {
            asm volatile("ds_read_b64_tr_b16 %0,%1 offset:%c2" : "=&v"(lo[ks]) : "v"(vb), "i"(d0 * 4096 + ks * 1024) : "memory");
            asm volatile("ds_read_b64_tr_b16 %0,%1 offset:%c2" : "=&v"(hi[ks]) : "v"(vb), "i"(d0 * 4096 + ks * 1024 + 512) : "memory"); }
        asm volatile("s_waitcnt lgkmcnt(0)" ::: "memory"); SBAR();
#define PK(k) (bf16x8){lo[k][0], lo[k][1], lo[k][2], lo[k][3], hi[k][0], hi[k][1], hi[k][2], hi[k][3]}
        o[d0] = __builtin_amdgcn_mfma_f32_32x32x16_bf16(pa0, PK(0), o[d0], 0, 0, 0);
        o[d0] = __builtin_amdgcn_mfma_f32_32x32x16_bf16(pa1, PK(1), o[d0], 0, 0, 0);
        o[d0] = __builtin_amdgcn_mfma_f32_32x32x16_bf16(pa2, PK(2), o[d0], 0, 0, 0);
        o[d0] = __builtin_amdgcn_mfma_f32_32x32x16_bf16(pa3, PK(3), o[d0], 0, 0, 0);
#undef PK
    }
}
struct AttnParams { const bf16* Q; const bf16* K; const bf16* V; const bf16* zpage; bf16_t* Y; const float* gnorm; float lam, osc; };
template <int THRL, int comp> __device__ __forceinline__ void attn_unit(int b, int h, int qb, const AttnParams& P, char* shm, int wave) {
    const bf16* Q = P.Q; const bf16* __restrict__ K = P.K; const bf16* __restrict__ V = P.V;
    int tid_ = mk_tid(wave); asm volatile("" : "+v"(tid_));
    const int tid = tid_, lane = tid & 63, r32 = lane & 31, hi = lane >> 5; const int wid = __builtin_amdgcn_readfirstlane(tid >> 6);
    const long rowbase = (long)b * SEQ; const int q0 = qb * QB;
    const bf16* Qw = Q + (rowbase + q0 + wid * QBLK) * PITCH + h * D;
    const bf16* Kh = K + rowbase * PITCH + h * D, *Vh = V + rowbase * PITCH + h * D;
    const unsigned lds0 = (unsigned)(uintptr_t)shm;
    float* wsf = (float*)(shm + LDS_WS) + wid * 64;
    const bf16* ksrc = Kh + (long)(32 * (wid & 1) + (lane & 31)) * PITCH + comp * 32 + (wid >> 1) * 8;
    const bf16* vsrc = Vh + (long)(16 * (wid & 3) + (lane >> 2)) * PITCH + (wid >> 2) * 32 + (lane & 3) * 8;
    const unsigned kdst = lds0 + LDS_K + (wid >> 1) * 1024 + (wid & 1) * 512, vdst = lds0 + LDS_V + wid * 1024;
#define DMA_K(t, slot) do { if (lane < 32) glds16(ksrc + (long)(t) * KVBLK * PITCH, (unsigned)__builtin_amdgcn_readfirstlane(kdst + (slot))); } while (0)
#define DMA_V(t, slot) glds16(vsrc + (long)(t) * KVBLK * PITCH, (unsigned)__builtin_amdgcn_readfirstlane(vdst + (slot)))
    const int vb0 = (int)(lds0 + LDS_V) + ((lane >> 4) & 1) * 32 + (lane & 3) * 8 + (4 * hi + ((lane & 15) >> 2)) * 64;
    const char* Kbase = shm + LDS_K; bf16x8 kf[4];
    const lds_cptr shm3 = (lds_cptr)shm; const lds_cptr kp0 = shm3 + LDS_K + hi * 1024 + r32 * 16; const lds_cptr vp0 = shm3 + LDS_V + ((lane >> 4) & 1) * 32 + (lane & 3) * 8 + (4 * hi + ((lane & 15) >> 2)) * 64;
    const int NT = (q0 + QB) / KVBLK;
    if (wid >= 4) __builtin_amdgcn_s_setprio(1);
    DMA_K(0, 0); DMA_V(0, 0); DMA_K(1, SLOTB);
    bf16x8 qr[2];
#pragma unroll
    for (int d0 = 0; d0 < 2; ++d0) qr[d0] = *reinterpret_cast<const bf16x8*>(&Qw[(long)r32 * PITCH + comp * 32 + d0 * 16 + hi * 8]);
    float mhat = 0.f, l_reg = 0.f; f32x16 o[2]; o[0] = f32x16{}; o[1] = f32x16{}; f32x16 negm = f32x16{}; asm volatile("" : "+v"(negm));
    const int qrel = wid * QBLK + r32;
#define CMASK(P0, P1, t) do { int jb_ = (t) - (NT - 4); if (jb_ >= 0) cmask(P0, P1, jb_, qrel, hi); } while (0)
    bool resc = false;
#define START(P0, P1) do { const float rm = rowmax(P0, P1); resc = false; \
    { const float dl = rm; mhat = fadd_s(mhat, dl); \
      _Pragma("unroll") for (int r = 0; r < 16; ++r) { P0[r] = fsub_s(P0[r], dl); P1[r] = fsub_s(P1[r], dl); } \
      _Pragma("unroll") for (int r = 0; r < 16; ++r) negm[r] = -mhat; asm volatile("" : "+v"(negm)); } \
    _Pragma("unroll") for (int r = 0; r < 16; ++r) P0[r] = __builtin_amdgcn_exp2f(P0[r]); } while (0)
#define RESC() do { if (resc) { asm volatile("s_waitcnt lgkmcnt(0)" ::: "memory"); \
      _Pragma("unroll") for (int d_ = 0; d_ < 2; ++d_) _Pragma("unroll") for (int r = 0; r < 16; ++r) o[d_][r] *= wsf[crow(r, hi)]; } } while (0)
    f32x16 pA0, pA1, pB0, pB1;
    int sl_prev = 0, sl_cur = 0, sl_next = SLOTB;
#define ROT() do { sl_prev = sl_cur; sl_cur = sl_next; sl_next = (sl_next == (NSLOT - 1) * SLOTB) ? 0 : sl_next + SLOTB; } while (0)
    DMA_K(2, 2 * SLOTB);
    WAIT_BAR(3);
    qkt(pA0, pA1, Kbase, qr, negm, r32, hi); asm volatile("s_nop 15\n\ts_nop 7" : "+v"(pA0), "+v"(pA1)); CMASK(pA0, pA1, 0);
    START(pA0, pA1);
    _Pragma("unroll") for (int r = 0; r < 16; ++r) pA1[r] = __builtin_amdgcn_exp2f(pA1[r]);
    WAIT_BAR(0);
    DMA_K(3, 0); DMA_V(1, SLOTB);
    ROT();
    kload8(kf, kp0 + sl_cur);
    WAIT_BAR(2);
    s16x4 vlo[8], vhi[8]; u32x4 pw0, pw1, pw2, pw3;
#define PKW(P, B) cvtpk_s(P[B], P[B + 1])
#define PAF(k) __builtin_bit_cast(bf16x8, pw##k)
#define VFR(i) (bf16x8){vlo[i][0], vlo[i][1], vlo[i][2], vlo[i][3], vhi[i][0], vhi[i][1], vhi[i][2], vhi[i][3]}
#define PIN(x) asm volatile("" : "+v"(x))
#define MX3(a, b, c) max3f((a), (b), (c))
#define GAPA(MF, A0, A1, A2, A3, W0, W1, PW) do { MF; sacc += (f32x2_t){A0, A1}; sacc += (f32x2_t){A2, A3}; PIN(sacc); W0; W1; PIN(PW); SBAR(); } while (0)
#define EX(v) __builtin_amdgcn_exp2f(v)
#define GAPB(MF, X, B) do { MF; X[B] = EX(X[B]); X[B + 1] = EX(X[B + 1]); X[B + 2] = EX(X[B + 2]); X[B + 3] = EX(X[B + 3]); PIN(X); SBAR(); } while (0)
#define VRD(i) do { vlo[i] = vtr(vp_ + (((i) >> 2) * 4096 + ((i) & 3) * 1024)); vhi[i] = vtr(vp_ + (((i) >> 2) * 4096 + ((i) & 3) * 1024 + 512)); } while (0)
#define KRD(G, j) do { if (G) { kload2(kf, kp0 + sl_next, j); SBAR(); } } while (0)
#define STEP(C0, C1, P0, P1, t, GK, GV, GL) do { SBAR(); \
    const lds_cptr vp_ = vp0 + sl_prev; \
    VRD(0); SBAR(); f32x2_t sacc = (f32x2_t){P0[0], P0[1]}; \
    GAPA(C0 = __builtin_amdgcn_mfma_f32_32x32x16_bf16(kf[0], qr[0], negm, 0, 0, 0), P0[2], P0[3], P0[4], P0[5],     pw0[0] = PKW(P0, 0), pw0[1] = PKW(P0, 2), pw0); \
    VRD(4); SBAR(); GAPA(C1 = __builtin_amdgcn_mfma_f32_32x32x16_bf16(kf[1], qr[0], negm, 0, 0, 0), P0[6], P0[7], P0[8], P0[9],     pw0[2] = PKW(P0, 4), pw0[3] = PKW(P0, 6), pw0); \
    VRD(1); SBAR(); GAPA(C0 = __builtin_amdgcn_mfma_f32_32x32x16_bf16(kf[2], qr[1], C0, 0, 0, 0),   P0[10], P0[11], P0[12], P0[13], pw1[0] = PKW(P0, 8), pw1[1] = PKW(P0, 10), pw1); \
    VRD(5); SBAR(); GAPA(C1 = __builtin_amdgcn_mfma_f32_32x32x16_bf16(kf[3], qr[1], C1, 0, 0, 0),   P0[14], P0[15], P1[0], P1[1],   pw1[2] = PKW(P0, 12), pw1[3] = PKW(P0, 14), pw1); \
    VRD(2); SBAR(); GAPA(,   P1[2], P1[3], P1[4], P1[5],     pw2[0] = PKW(P1, 0), pw2[1] = PKW(P1, 2), pw2); \
    VRD(6); SBAR(); GAPA(,   P1[6], P1[7], P1[8], P1[9],     pw2[2] = PKW(P1, 4), pw2[3] = PKW(P1, 6), pw2); \
    VRD(3); SBAR(); GAPA(,   P1[10], P1[11], P1[12], P1[13], pw3[0] = PKW(P1, 8), pw3[1] = PKW(P1, 10), pw3); \
    VRD(7); SBAR(); sacc += (f32x2_t){P1[14], P1[15]}; PIN(sacc); pw3[2] = PKW(P1, 12); pw3[3] = PKW(P1, 14); PIN(pw3); SBAR(); \
    l_reg += sacc[0] + sacc[1]; \
    CMASK(C0, C1, t); \
    { float a = MX3(C0[0], C0[1], C1[0]), b = MX3(C0[2], C0[3], C1[1]); a = MX3(a, C1[2], C1[3]); \
      _Pragma("unroll") for (int r = 4; r < 16; r += 4) { a = MX3(a, C0[r], C0[r + 1]); b = MX3(b, C0[r + 2], C0[r + 3]); a = MX3(a, C1[r], C1[r + 1]); b = MX3(b, C1[r + 2], C1[r + 3]); } \
      float rm = max2f(a, b); { auto rr = __builtin_amdgcn_permlane32_swap(__float_as_uint(rm), __float_as_uint(rm), false, false); rm = max2f(__uint_as_float(rr[0]), __uint_as_float(rr[1])); } \
      resc = false; \
      if (__builtin_expect(__any(rm > (float)THRL), 0)) { const float dl = __builtin_fmaxf(rm, 0.f); mhat += dl; \
        _Pragma("unroll") for (int r = 0; r < 16; ++r) { C0[r] -= dl; C1[r] -= dl; } \
        _Pragma("unroll") for (int r = 0; r < 16; ++r) negm[r] = -mhat; asm volatile("" : "+v"(negm)); \
        const float f = __builtin_amdgcn_exp2f(-dl); l_reg *= f; if (hi == 0) wsf[r32] = f; resc = true; } } \
    SBAR(); \
    if (GV) { DMA_V((t) + 1, sl_next); } SBAR();        \
    GAPB(o[0] = __builtin_amdgcn_mfma_f32_32x32x16_bf16(PAF(0), VFR(0), o[0], 0, 0, 0), C0, 0); \
    GAPB(o[1] = __builtin_amdgcn_mfma_f32_32x32x16_bf16(PAF(0), VFR(4), o[1], 0, 0, 0), C0, 4); \
    KRD(GL, 0); GAPB(o[0] = __builtin_amdgcn_mfma_f32_32x32x16_bf16(PAF(1), VFR(1), o[0], 0, 0, 0), C0, 8); \
    KRD(GL, 1); GAPB(o[1] = __builtin_amdgcn_mfma_f32_32x32x16_bf16(PAF(1), VFR(5), o[1], 0, 0, 0), C0, 12); \
    GAPB(o[0] = __builtin_amdgcn_mfma_f32_32x32x16_bf16(PAF(2), VFR(2), o[0], 0, 0, 0), C1, 0); \
    GAPB(o[1] = __builtin_amdgcn_mfma_f32_32x32x16_bf16(PAF(2), VFR(6), o[1], 0, 0, 0), C1, 4); \
    GAPB(o[0] = __builtin_amdgcn_mfma_f32_32x32x16_bf16(PAF(3), VFR(3), o[0], 0, 0, 0), C1, 8); \
    GAPB(o[1] = __builtin_amdgcn_mfma_f32_32x32x16_bf16(PAF(3), VFR(7), o[1], 0, 0, 0), C1, 12); \
    if (GK) { DMA_K((t) + 3, sl_cur); } \
    } while (0)
    int t = 1;
#undef CMASK
#define CMASK(P0, P1, t) do {} while (0)
    for (; t + 5 < NT; t += 2) {
        STEP(pB0, pB1, pA0, pA1, t, true, true, true);     WAIT_BAR(2); RESC(); ROT();
        STEP(pA0, pA1, pB0, pB1, t + 1, true, true, true); WAIT_BAR(2); RESC(); ROT();
    }
#undef CMASK
#define CMASK(P0, P1, t) do { int jb_ = (t) - (NT - 4); if (jb_ >= 0) cmask(P0, P1, jb_, qrel, hi); } while (0)
#define ENDW(tt) do { if ((tt) + 3 < NT) { WAIT_BAR(2); } else if ((tt) + 2 < NT) { WAIT_BAR(1); } else { WAIT_BAR(0); } } while (0)
    for (; t + 1 < NT; t += 2) {
        STEP(pB0, pB1, pA0, pA1, t, (t + 3 < NT), (t + 1 < NT), (t + 1 < NT));         ENDW(t);     RESC(); ROT();
        STEP(pA0, pA1, pB0, pB1, t + 1, (t + 4 < NT), (t + 2 < NT), (t + 2 < NT));     ENDW(t + 1); RESC(); ROT();
    }
    STEP(pB0, pB1, pA0, pA1, NT - 1, false, false, false); RESC();
    { float sacc = pB0[0] + pB0[1]; _Pragma("unroll") for (int r = 2; r < 16; ++r) sacc += pB0[r]; _Pragma("unroll") for (int r = 0; r < 16; ++r) sacc += pB1[r]; l_reg += sacc;
      pw0 = (u32x4){PKW(pB0, 0), PKW(pB0, 2), PKW(pB0, 4), PKW(pB0, 6)}; pw1 = (u32x4){PKW(pB0, 8), PKW(pB0, 10), PKW(pB0, 12), PKW(pB0, 14)}; pw2 = (u32x4){PKW(pB1, 0), PKW(pB1, 2), PKW(pB1, 4), PKW(pB1, 6)}; pw3 = (u32x4){PKW(pB1, 8), PKW(pB1, 10), PKW(pB1, 12), PKW(pB1, 14)};
      SBAR(); pv(o, vb0 + sl_cur, PAF(0), PAF(1), PAF(2), PAF(3)); }
#undef PKW
#undef PAF
#undef VFR
#undef PIN
#undef MX3
#undef GAPA
#undef GAPB
#undef EX
#undef VRD
#undef KRD
#undef STEP
#undef ENDW
    { auto rr = __builtin_amdgcn_permlane32_swap(__float_as_uint(l_reg), __float_as_uint(l_reg), false, false); l_reg = __uint_as_float(rr[0]) + __uint_as_float(rr[1]); }
    if (hi == 0) wsf[32 + r32] = l_reg; asm volatile("s_waitcnt lgkmcnt(0)" ::: "memory");
    float rli[16];
#pragma unroll
    for (int r = 0; r < 16; ++r) rli[r] = __builtin_amdgcn_rcpf(wsf[32 + crow(r, hi)]);
    float* stg = (float*)(shm + LDS_OST) + wid * 2048;
    if (comp == 0) {
#pragma unroll
        for (int r = 0; r < 16; ++r) { const int orow = crow(r, hi);
#pragma unroll
            for (int d0 = 0; d0 < 2; ++d0) stg[orow * 64 + d0 * 32 + r32] = o[d0][r] * rli[r]; }
    } else {
        const float lam = P.lam;
#pragma unroll
        for (int r = 0; r < 16; ++r) { const int orow = crow(r, hi);
#pragma unroll
            for (int d0 = 0; d0 < 2; ++d0) { const int ix = orow * 64 + d0 * 32 + r32; stg[ix] = stg[ix] - lam * (o[d0][r] * rli[r]); } }
        asm volatile("s_waitcnt lgkmcnt(0)" ::: "memory");
        unsigned char* Yw = (unsigned char*)P.Y + (rowbase + q0 + wid * QBLK) * DM + h * D;
        const int ch = lane & 7;
        const f32x4 g0 = *(const f32x4*)(P.gnorm + ch * 8), g1 = *(const f32x4*)(P.gnorm + ch * 8 + 4);
#pragma unroll
        for (int i = 0; i < 4; ++i) { const int row = i * 8 + (lane >> 3);
            const f32x4 a = *(const f32x4*)(stg + row * 64 + ch * 8), c = *(const f32x4*)(stg + row * 64 + ch * 8 + 4);
            float ss = (a[0] * a[0] + a[1] * a[1]) + (a[2] * a[2] + a[3] * a[3]) + (c[0] * c[0] + c[1] * c[1]) + (c[2] * c[2] + c[3] * c[3]);
            ss += DPP_F(ss, 0xB1); ss += DPP_F(ss, 0x4E); ss += DPP_F(ss, 0x141);
            const float rs = __builtin_amdgcn_rsqf(ss * (1.f / 64.f) + LN_EPS) * P.osc;
            const float rq = rs * Y8S; u32x2 w; w.x = pk4_fp8(a[0] * rq * g0[0], a[1] * rq * g0[1], a[2] * rq * g0[2], a[3] * rq * g0[3]); w.y = pk4_fp8(c[0] * rq * g1[0], c[1] * rq * g1[1], c[2] * rq * g1[2], c[3] * rq * g1[3]);
            *(u32x2*)(Yw + (long)row * DM + ch * 8) = w; }
    }
    __builtin_amdgcn_s_setprio(0);
    asm volatile("s_waitcnt lgkmcnt(0)\n\ts_barrier" ::: "memory");
#undef DMA_K
#undef DMA_V
#undef CMASK
#undef START
#undef RESC
#undef ROT
}
#undef SBAR
#undef WAIT_BAR
}

struct Frame {
    LAS unsigned char* lds; volatile LAS unsigned* MISC; gu32* ctl;
    int tid, lane, wave, vcu, G;
};
struct Args {
    const float* in[29]; float* out; unsigned char* ws; int ph_lo, ph_hi;
};
enum { I_X = 0, I_C, I_POS, I_WADA, I_BADA, I_WIN, I_WOUT, I_MBI, I_MBF, I_MG, I_CONVW, I_CONVB, I_LQ1, I_LK1, I_LQ2, I_LK2, I_DG, I_WA2, I_BA, I_GG, I_LN1G, I_LN1B, I_LN2G, I_LN2B,
       I_RW, I_RB, I_EWG, I_EWU, I_EWD };

__device__ __forceinline__ void tr_item(const float* W, int ldw, int K, bf16_t* WT, int drow0, int scol, int k0, LAS float* scr, int lane) {
    const int sc_ = (scol >= 0) ? scol : 0; float v_[32];
#pragma unroll
    for (int i = 0; i < 32; ++i) v_[i] = W[(size_t)(k0 + 2 * i + (lane >> 5)) * ldw + sc_];
#pragma unroll
    for (int i = 0; i < 32; ++i) { const int kk = 2 * i + (lane >> 5); scr[kk * 33 + (lane & 31)] = (scol >= 0) ? v_[i] : 0.f; }
    LDS_WAIT(); asm volatile("" ::: "memory");
    const int c = lane & 7;
#pragma unroll
    for (int j = 0; j < 4; ++j) { const int n = (lane >> 3) + 8 * j; const LAS float* s = scr + (8 * c) * 33 + n;
        u32x4 o; o.x = pk2(s[0 * 33], s[1 * 33]); o.y = pk2(s[2 * 33], s[3 * 33]); o.z = pk2(s[4 * 33], s[5 * 33]); o.w = pk2(s[6 * 33], s[7 * 33]);
        *(GAS u32x4*)(WT + (size_t)(drow0 + n) * K + k0 + 8 * c) = o; }
    LDS_WAIT(); asm volatile("" ::: "memory");
}
__device__ __forceinline__ void tr_item4(const float* W, int ldw, int K, bf16_t* WT, int drow0, int scol0, int k0, LAS float* scr, int lane, float wsc = 1.f) {
    const int kq = lane >> 3, nq = (lane & 7) * 4;
    f32x4 v[8];
#pragma unroll
    for (int i = 0; i < 8; ++i) v[i] = *(const f32x4*)(W + (size_t)(k0 + i * 8 + kq) * ldw + scol0 + nq);
#pragma unroll
    for (int i = 0; i < 8; ++i) { LAS float* d = scr + (i * 8 + kq) * 33 + nq; d[0] = v[i][0] * wsc; d[1] = v[i][1] * wsc; d[2] = v[i][2] * wsc; d[3] = v[i][3] * wsc; }
    LDS_WAIT(); asm volatile("" ::: "memory");
    const int c = lane & 7;
#pragma unroll
    for (int j = 0; j < 4; ++j) { const int n = (lane >> 3) + 8 * j; const LAS float* s = scr + (8 * c) * 33 + n;
        u32x4 o; o.x = pk2(s[0 * 33], s[1 * 33]); o.y = pk2(s[2 * 33], s[3 * 33]); o.z = pk2(s[4 * 33], s[5 * 33]); o.w = pk2(s[6 * 33], s[7 * 33]);
        *(GAS u32x4*)(WT + (size_t)(drow0 + n) * K + k0 + 8 * c) = o; }
    LDS_WAIT(); asm volatile("" ::: "memory");
}
struct TrD { const float* src; bf16_t* dst; unsigned char* dst8; int ldw, K, drow0, k0; float wsc; };
__device__ __forceinline__ void tr_load4(const TrD& d, f32x4 (&v)[8], int lane) {
    const int kq = lane >> 3, nq = (lane & 7) * 4;
#pragma unroll
    for (int i = 0; i < 8; ++i) v[i] = *(const f32x4*)(d.src + (size_t)(i * 8 + kq) * d.ldw + nq);
}
__device__ __forceinline__ void tr_finish4(const TrD& d, const f32x4 (&v)[8], LAS float* scr, int lane) {
    const int kq = lane >> 3, nq = (lane & 7) * 4;
#pragma unroll
    for (int i = 0; i < 8; ++i) { LAS float* p = scr + (i * 8 + kq) * 33 + nq; p[0] = v[i][0] * d.wsc; p[1] = v[i][1] * d.wsc; p[2] = v[i][2] * d.wsc; p[3] = v[i][3] * d.wsc; }
    LDS_WAIT(); asm volatile("" ::: "memory");
    const int c = lane & 7;
#pragma unroll
    for (int j = 0; j < 4; ++j) { const int n = (lane >> 3) + 8 * j; const LAS float* s = scr + (8 * c) * 33 + n;
        u32x4 o; o.x = pk2(s[0 * 33], s[1 * 33]); o.y = pk2(s[2 * 33], s[3 * 33]); o.z = pk2(s[4 * 33], s[5 * 33]); o.w = pk2(s[6 * 33], s[7 * 33]);
        *(GAS u32x4*)(d.dst + (size_t)(d.drow0 + n) * d.K + d.k0 + 8 * c) = o; }
    LDS_WAIT(); asm volatile("" ::: "memory");
}
__device__ __forceinline__ void tr_finish8(const TrD& d, const f32x4 (&v)[8], LAS float* scr, int lane) {
    const int kq = lane >> 3, nq = (lane & 7) * 4;
#pragma unroll
    for (int i = 0; i < 8; ++i) { LAS float* p = scr + (i * 8 + kq) * 33 + nq; p[0] = v[i][0] * d.wsc; p[1] = v[i][1] * d.wsc; p[2] = v[i][2] * d.wsc; p[3] = v[i][3] * d.wsc; }
    LDS_WAIT(); asm volatile("" ::: "memory");
    const int c = lane & 7; unsigned char* dst8 = (unsigned char*)d.dst;
#pragma unroll
    for (int j = 0; j < 4; ++j) { const int n = (lane >> 3) + 8 * j; const LAS float* s = scr + (8 * c) * 33 + n;
        u32x2 o; o.x = pk4_fp8(s[0 * 33], s[1 * 33], s[2 * 33], s[3 * 33]); o.y = pk4_fp8(s[4 * 33], s[5 * 33], s[6 * 33], s[7 * 33]);
        *(GAS u32x2*)(dst8 + (size_t)(d.drow0 + n) * d.K + d.k0 + 8 * c) = o; }
    LDS_WAIT(); asm volatile("" ::: "memory");
}
template <int NTL>
__device__ __forceinline__ void rows16_mm(f32x4 (&acc)[NTL], const bf16_t* A, const LAS bf16_t* Bt, int pitch, int lane) {
    const int lr = lane & 15, lq = lane >> 4;
    const bf16_t* ap = A + (size_t)lr * 1024 + lq * 8;
#pragma unroll 8
    for (int ks = 0; ks < 32; ++ks) {
        const bf16x8 a = *(const bf16x8*)(ap + ks * 32);
#pragma unroll
        for (int t = 0; t < NTL; ++t) { const bf16x8 b = *(const LAS bf16x8*)(Bt + (t * 16 + lr) * pitch + ks * 32 + lq * 8); acc[t] = __builtin_amdgcn_mfma_f32_16x16x32_bf16(a, b, acc[t], 0, 0, 0); }
    }
}
constexpr int TBP = 1056;
__device__ __forceinline__ void tail16(const bf16_t* Urow0, const LAS bf16_t* Wt, float* tail_row0, int lane) {
    f32x4 acc[2] = {(f32x4){0.f, 0.f, 0.f, 0.f}, (f32x4){0.f, 0.f, 0.f, 0.f}};
    rows16_mm<2>(acc, Urow0, Wt, TBP, lane);
    const int lr = lane & 15, lq = lane >> 4;
#pragma unroll
    for (int t = 0; t < 2; ++t)
#pragma unroll
        for (int r = 0; r < 4; ++r) tail_row0[(size_t)(lq * 4 + r) * 32 + t * 16 + lr] = acc[t][r];
}
__device__ __forceinline__ void load_tail_w(LAS bf16_t* Wt, const bf16_t* Wtail  , int tid) {
    for (int p = tid; p < 32 * 128; p += 512) { const int n = p >> 7, c = p & 127; *(LAS u32x4*)(Wt + n * TBP + c * 8) = *(const u32x4*)(Wtail + (size_t)n * 1024 + c * 8); }
}
constexpr int NSP = 1032;
constexpr int NMM_P_OFF = 32 * NSP * 2, NMM_LG_OFF = NMM_P_OFF + 8 * 1024 * 4;
struct NarrowT { bf16x8 bw[4][2]; };
__device__ __forceinline__ void nmm_load_tail(NarrowT& T, const bf16_t* Wtail  , int wid, int lane) {
    const int lr = lane & 15, lq = lane >> 4;
#pragma unroll
    for (int ks = 0; ks < 4; ++ks)
#pragma unroll
        for (int t = 0; t < 2; ++t) T.bw[ks][t] = *(const bf16x8*)(Wtail + (size_t)(t * 16 + lr) * 1024 + wid * 128 + ks * 32 + lq * 8);
}
__device__ __forceinline__ void nmm_load_router(NarrowT& T, const float* rw  , int wid, int lane) {
    const int lr = lane & 15, lq = lane >> 4;
#pragma unroll
    for (int ks = 0; ks < 4; ++ks) { u32x4 hi, lo;
#pragma unroll
        for (int i = 0; i < 4; ++i) { const int k = wid * 128 + ks * 32 + lq * 8 + 2 * i; const float w0 = rw[(size_t)k * 16 + lr], w1 = rw[(size_t)(k + 1) * 16 + lr];
            const unsigned h0 = f2bf(w0), h1 = f2bf(w1); hi[i] = h0 | (h1 << 16); lo[i] = f2bf(w0 - bf2f(h0)) | (f2bf(w1 - bf2f(h1)) << 16); }
        T.bw[ks][0] = __builtin_bit_cast(bf16x8, hi); T.bw[ks][1] = __builtin_bit_cast(bf16x8, lo); }
}
__device__ __forceinline__ void nmm_partials(const NarrowT& T, const LAS bf16_t* S, LAS float* Pb, int wid, int lane) {
    asm volatile("s_waitcnt lgkmcnt(0)\n\ts_barrier" ::: "memory");
    const int lr = lane & 15, lq = lane >> 4;
    f32x4 acc[2][2];
#pragma unroll
    for (int m = 0; m < 2; ++m)
#pragma unroll
        for (int t = 0; t < 2; ++t) acc[m][t] = (f32x4){0.f, 0.f, 0.f, 0.f};
#pragma unroll
    for (int m = 0; m < 2; ++m)
#pragma unroll
        for (int ks = 0; ks < 4; ++ks) { const bf16x8 a = *(const LAS bf16x8*)(S + (16 * m + lr) * NSP + wid * 128 + ks * 32 + lq * 8);
#pragma unroll
            for (int t = 0; t < 2; ++t) acc[m][t] = __builtin_amdgcn_mfma_f32_16x16x32_bf16(a, T.bw[ks][t], acc[m][t], 0, 0, 0); }
#pragma unroll
    for (int m = 0; m < 2; ++m)
#pragma unroll
        for (int t = 0; t < 2; ++t)
#pragma unroll
            for (int r = 0; r < 4; ++r) Pb[wid * 1024 + (16 * m + 4 * lq + r) * 32 + t * 16 + lr] = acc[m][t][r];
    asm volatile("s_waitcnt lgkmcnt(0)\n\ts_barrier" ::: "memory");
}
__device__ __forceinline__ void nmm_step_tail(const NarrowT& T, const LAS bf16_t* S, LAS float* Pb, float* tail_wg  , int i0, int tid, int wid, int lane) {
    nmm_partials(T, S, Pb, wid, lane);
#pragma unroll
    for (int q = 0; q < 2; ++q) { const int o = tid + 512 * q, sr = o >> 5, col = o & 31; float s = 0.f;
#pragma unroll
        for (int w = 0; w < 8; ++w) s += Pb[w * 1024 + o];
        tail_wg[(size_t)((sr >> 2) * 16 + i0 + (sr & 3)) * 32 + col] = s; }
}
__device__ __forceinline__ void nmm_step_router(const NarrowT& T, const LAS bf16_t* S, LAS float* Pb, LAS float* lgs  , int i0, int tid, int wid, int lane) {
    nmm_partials(T, S, Pb, wid, lane);
    { const int sr = tid >> 4, e = tid & 15; float s = 0.f;
#pragma unroll
      for (int w = 0; w < 8; ++w) s += Pb[w * 1024 + sr * 32 + e] + Pb[w * 1024 + sr * 32 + 16 + e];
      lgs[(sr >> 2) * 256 + (i0 + (sr & 3)) * 16 + e] = s; }
}
__device__ __forceinline__ int win_src_col(int n) {
    if (n < 1024) return n;
    if (n < 3584) return n + 8;
    const int i = n - 3584;
    if (i < 16) return 3592 + i;
    if (i < 20) return 1024 + (i - 16);
    if (i < 24) return 1028 + (i - 20);
    return -1;
}

namespace rec {
constexpr int PT = 72;
constexpr int TB = 64 * PT * 2;
constexpr int OFF_T0 = 0, OFF_T1 = TB, OFF_T2 = 2 * TB, OFF_T3 = 3 * TB, OFF_T4 = 4 * TB, OFF_T5 = 5 * TB;
constexpr int OFF_BM = 6 * TB;
constexpr int OFF_HM = OFF_BM + 16384;
constexpr int OFF_VEC = OFF_HM + 64 * 68 * 4;
constexpr int V_G = 0, V_M = 64, V_WI = 128, V_EM = 192, V_DI = 256, V_N = 320, V_BE = 384, V_SEG = 448, V_GA = 960;
static_assert(OFF_VEC + (960 + 1024) * 4 <= RING_BYTES, "rec LDS");

__device__ __forceinline__ void mm64(f32x4 (&acc)[2], const LAS bf16_t* A, const LAS bf16_t* Bt, int wid, int lane) {
    const int tm = wid >> 1, tn0 = (wid & 1) * 2, lr = lane & 15, lq = lane >> 4;
#pragma unroll
    for (int ks = 0; ks < 2; ++ks) {
        const bf16x8 a = *(const LAS bf16x8*)(A + (tm * 16 + lr) * PT + ks * 32 + lq * 8);
#pragma unroll
        for (int t = 0; t < 2; ++t) { const bf16x8 b = *(const LAS bf16x8*)(Bt + ((tn0 + t) * 16 + lr) * PT + ks * 32 + lq * 8);
            acc[t] = __builtin_amdgcn_mfma_f32_16x16x32_bf16(a, b, acc[t], 0, 0, 0); }
    }
}
#define DPP_FO(old, x, ctrl, rmask) __builtin_bit_cast(float, __builtin_amdgcn_update_dpp(__builtin_bit_cast(int, (float)(old)), __builtin_bit_cast(int, (x)), (ctrl), (rmask), 0xf, false))
__device__ __forceinline__ float scan_add(float v, int lane) { (void)lane;
    v += DPP_FO(0.f, v, 0x111, 0xf); v += DPP_FO(0.f, v, 0x112, 0xf); v += DPP_FO(0.f, v, 0x114, 0xf); v += DPP_FO(0.f, v, 0x118, 0xf);
    v += DPP_FO(0.f, v, 0x142, 0xa); v += DPP_FO(0.f, v, 0x143, 0xc);
    return v;
}
__device__ __forceinline__ float scan_max(float v, int lane) { (void)lane;
    v = fmaxf(v, DPP_FO(-INFINITY, v, 0x111, 0xf)); v = fmaxf(v, DPP_FO(-INFINITY, v, 0x112, 0xf)); v = fmaxf(v, DPP_FO(-INFINITY, v, 0x114, 0xf)); v = fmaxf(v, DPP_FO(-INFINITY, v, 0x118, 0xf));
    v = fmaxf(v, DPP_FO(-INFINITY, v, 0x142, 0xa)); v = fmaxf(v, DPP_FO(-INFINITY, v, 0x143, 0xc));
    return v;
}
__device__ __forceinline__ void st_tr8(LAS bf16_t* T, int l, int ch, u32x4 w) {
    T[(ch * 8 + 0) * PT + l] = (bf16_t)(w.x & 0xffffu); T[(ch * 8 + 1) * PT + l] = (bf16_t)(w.x >> 16);
    T[(ch * 8 + 2) * PT + l] = (bf16_t)(w.y & 0xffffu); T[(ch * 8 + 3) * PT + l] = (bf16_t)(w.y >> 16);
    T[(ch * 8 + 4) * PT + l] = (bf16_t)(w.z & 0xffffu); T[(ch * 8 + 5) * PT + l] = (bf16_t)(w.z >> 16);
    T[(ch * 8 + 6) * PT + l] = (bf16_t)(w.w & 0xffffu); T[(ch * 8 + 7) * PT + l] = (bf16_t)(w.w >> 16);
}
__device__ __forceinline__ void unpack8(u32x4 w, float (&f)[8]) {
    f[0] = bflo(w.x); f[1] = bfhi(w.x); f[2] = bflo(w.y); f[3] = bfhi(w.y); f[4] = bflo(w.z); f[5] = bfhi(w.z); f[6] = bflo(w.w); f[7] = bfhi(w.w);
}
template <int GATE  >
__device__ __forceinline__ void finalize(const LAS float* HM, const LAS float* rowscale, const float* gnorm, const bf16_t* gate, bf16_t* out, int tid) {
    const int j = tid >> 3, ch = tid & 7;
    const f32x4 a = *(const LAS f32x4*)(HM + j * 68 + ch * 8), c = *(const LAS f32x4*)(HM + j * 68 + ch * 8 + 4);
    const float rsc = rowscale ? rowscale[j] : 1.f;
    float v[8] = {a[0] * rsc, a[1] * rsc, a[2] * rsc, a[3] * rsc, c[0] * rsc, c[1] * rsc, c[2] * rsc, c[3] * rsc};
    float ss = 0.f;
#pragma unroll
    for (int i = 0; i < 8; ++i) ss += v[i] * v[i];
    ss += DPP_F(ss, 0xB1); ss += DPP_F(ss, 0x4E); ss += DPP_F(ss, 0x141);
    const float rs = __builtin_amdgcn_rsqf(ss * (1.f / 64.f) + LN_EPS);
    const u32x4 gw = *(const u32x4*)(gate + (size_t)j * PJ + ch * 8);
    float gt[8]; unpack8(gw, gt);
    const f32x4 g0 = *(const f32x4*)(gnorm + ch * 8), g1 = *(const f32x4*)(gnorm + ch * 8 + 4);
    const float gn[8] = {g0[0], g0[1], g0[2], g0[3], g1[0], g1[1], g1[2], g1[3]};
    float y[8];
#pragma unroll
    for (int i = 0; i < 8; ++i) { const float sg = 1.f / (1.f + fexp(-gt[i])); const float gv = GATE ? gt[i] * sg : sg; y[i] = v[i] * rs * gn[i] * gv; }
    u32x4 w; w.x = pk2(y[0], y[1]); w.y = pk2(y[2], y[3]); w.z = pk2(y[4], y[5]); w.w = pk2(y[6], y[7]);
    *(u32x4*)(out + (size_t)j * DM + ch * 8) = w;
}

struct RecP {
    const bf16_t* proj; const float* tail; const bf16_t* csm; const bf16_t* csg; float* stm; float* stg; float* smN; float* smBC; float* smDM; float* smMS; float* smGBE; bf16_t* ycat;
    const float* mbi; const float* mbf; const float* mg; const float* wa2; const float* ba; const float* gg;
};

struct MLoc { u32x4 k, v; float mi, mf; };
struct MOut { u32x4 q, k, v, st, mo; float mi, mf, m, n; };
struct GLoc { u32x4 k, v; f32x4 ga; };
struct GOut { u32x4 q, k, v, st, gr; f32x4 ga; };
struct GW { float wv[16]; float bav; };

__device__ __forceinline__ void ld_mloc(MLoc& L, const RecP& P, int ci, int tid, int wid, int lane) {
    const int bh = ci >> 6, c = ci & 63, b = bh >> 2, h = bh & 3, row0 = b * SEQ + c * 64, l = tid >> 3, ch = tid & 7;
    const bf16_t* pr = P.proj + (size_t)(row0 + l) * PJ + h * 64 + ch * 8;
    L.k = *(const u32x4*)(pr + C_MK); L.v = *(const u32x4*)(pr + C_MV);
    if (wid == 0) { const float* tp = P.tail + (size_t)(row0 + lane) * 32; L.mi = tp[T_MI + h]; L.mf = tp[T_MF + h]; } else { L.mi = 0.f; L.mf = 0.f; }
}
__device__ __forceinline__ void ld_mout(MOut& L, const RecP& P, int ci, int tid, int wid, int lane) {
    const int bh = ci >> 6, c = ci & 63, b = bh >> 2, h = bh & 3, row0 = b * SEQ + c * 64, l = tid >> 3, ch = tid & 7;
    const bf16_t* pr = P.proj + (size_t)(row0 + l) * PJ + h * 64 + ch * 8;
    L.q = *(const u32x4*)(pr + C_MQ); L.k = *(const u32x4*)(pr + C_MK); L.v = *(const u32x4*)(pr + C_MV); L.mo = *(const u32x4*)(pr + C_MO);
    L.st = *(const u32x4*)(P.csm + (size_t)ci * 4096 + l * 64 + ch * 8);
    if (wid == 0) { const float* tp = P.tail + (size_t)(row0 + lane) * 32; L.mi = tp[T_MI + h]; L.mf = tp[T_MF + h]; L.m = P.smMS[ci]; L.n = P.smN[(size_t)ci * 64 + lane]; } else { L.mi = 0.f; L.mf = 0.f; L.m = 0.f; L.n = 0.f; }
}
__device__ __forceinline__ void ld_gloc(GLoc& L, const RecP& P, int ci, int tid) {
    const int bh = ci >> 6, c = ci & 63, b = bh >> 2, h = bh & 3, row0 = b * SEQ + c * 64, l = tid >> 3, ch = tid & 7;
    const bf16_t* pr = P.proj + (size_t)(row0 + l) * PJ + h * 64 + ch * 8;
    L.k = *(const u32x4*)(pr + C_GK); L.v = *(const u32x4*)(pr + C_GV);
    L.ga = (tid < 256) ? *(const f32x4*)(P.tail + (size_t)(row0 + (tid >> 2)) * 32 + T_GA + (tid & 3) * 4) : (f32x4){0.f, 0.f, 0.f, 0.f};
}
__device__ __forceinline__ void ld_gout(GOut& L, const RecP& P, int ci, int tid) {
    const int bh = ci >> 6, c = ci & 63, b = bh >> 2, h = bh & 3, row0 = b * SEQ + c * 64, l = tid >> 3, ch = tid & 7;
    const bf16_t* pr = P.proj + (size_t)(row0 + l) * PJ + h * 64 + ch * 8;
    L.q = *(const u32x4*)(pr + C_GQ); L.k = *(const u32x4*)(pr + C_GK); L.v = *(const u32x4*)(pr + C_GV); L.gr = *(const u32x4*)(pr + C_GR);
    L.st = *(const u32x4*)(P.csg + (size_t)ci * 4096 + l * 64 + ch * 8);
    L.ga = (tid < 256) ? *(const f32x4*)(P.tail + (size_t)(row0 + (tid >> 2)) * 32 + T_GA + (tid & 3) * 4) : (f32x4){0.f, 0.f, 0.f, 0.f};
}
__device__ __forceinline__ void ld_gw(GW& W, const RecP& P, int h, int tid) {
    const int dcol = tid & 63;
#pragma unroll
    for (int r = 0; r < 16; ++r) W.wv[r] = P.wa2[r * 256 + h * 64 + dcol];
    W.bav = P.ba[h * 64 + dcol];
}
template <int GATE  >
__device__ __forceinline__ void finalize2(const LAS float* HM, const LAS float* rowscale, const float* gnorm, u32x4 gw, bf16_t* out, int tid) {
    const int j = tid >> 3, ch = tid & 7;
    const f32x4 a = *(const LAS f32x4*)(HM + j * 68 + ch * 8), c = *(const LAS f32x4*)(HM + j * 68 + ch * 8 + 4);
    const float rsc = rowscale ? rowscale[j] : 1.f;
    float v[8] = {a[0] * rsc, a[1] * rsc, a[2] * rsc, a[3] * rsc, c[0] * rsc, c[1] * rsc, c[2] * rsc, c[3] * rsc};
    float ss = 0.f;
#pragma unroll
    for (int i = 0; i < 8; ++i) ss += v[i] * v[i];
    ss += DPP_F(ss, 0xB1); ss += DPP_F(ss, 0x4E); ss += DPP_F(ss, 0x141);
    const float rs = __builtin_amdgcn_rsqf(ss * (1.f / 64.f) + LN_EPS);
    float gt[8]; unpack8(gw, gt);
    const f32x4 g0 = *(const f32x4*)(gnorm + ch * 8), g1 = *(const f32x4*)(gnorm + ch * 8 + 4);
    const float gn[8] = {g0[0], g0[1], g0[2], g0[3], g1[0], g1[1], g1[2], g1[3]};
    float y[8];
#pragma unroll
    for (int i = 0; i < 8; ++i) { const float sg = 1.f / (1.f + fexp(-gt[i])); const float gv = GATE ? gt[i] * sg : sg; y[i] = v[i] * rs * gn[i] * gv; }
    u32x4 w; w.x = pk2(y[0], y[1]); w.y = pk2(y[2], y[3]); w.z = pk2(y[4], y[5]); w.w = pk2(y[6], y[7]);
    *(u32x4*)(out + (size_t)j * DM + ch * 8) = w;
}
__device__ __forceinline__ void mlstm_local(const MLoc& L, const RecP& P, LAS unsigned char* lds, int ci, int tid, int wid, int lane) {
    const int h = (ci >> 6) & 3;
    LAS bf16_t* KT = (LAS bf16_t*)(lds + OFF_T0); LAS bf16_t* VT = (LAS bf16_t*)(lds + OFF_T1); LAS float* vec = (LAS float*)(lds + OFF_VEC);
    const int l = tid >> 3, ch = tid & 7;
    if (wid == 0) {
        const float li = L.mi + P.mbi[h], lf = logsig(L.mf + P.mbf[h]);
        const float bc = scan_add(lf, lane), g = li - bc;
        const float gmax = wave_max(g), bend = __builtin_bit_cast(float, __builtin_amdgcn_readlane(__builtin_bit_cast(int, bc), 63));
        vec[V_G + lane] = fexp(g - gmax);
        if (lane == 0) { P.smBC[ci] = bend; P.smDM[ci] = bend + gmax; }
    }
    __syncthreads();
    { const float w = vec[V_G + l]; float kf[8]; unpack8(L.k, kf);
      u32x4 ks; ks.x = pk2(kf[0] * w, kf[1] * w); ks.y = pk2(kf[2] * w, kf[3] * w); ks.z = pk2(kf[4] * w, kf[5] * w); ks.w = pk2(kf[6] * w, kf[7] * w);
      st_tr8(KT, l, ch, ks); st_tr8(VT, l, ch, L.v); }
    __syncthreads();
    f32x4 acc[2] = {(f32x4){0.f, 0.f, 0.f, 0.f}, (f32x4){0.f, 0.f, 0.f, 0.f}};
    mm64(acc, VT, KT, wid, lane);
    { const int tm = wid >> 1, tn0 = (wid & 1) * 2, lr = lane & 15, lq = lane >> 4; float* dst = P.stm + (size_t)ci * 4096;
#pragma unroll
      for (int t = 0; t < 2; ++t)
#pragma unroll
          for (int r = 0; r < 4; ++r) dst[(tm * 16 + lq * 4 + r) * 64 + (tn0 + t) * 16 + lr] = acc[t][r]; }
    if (tid < 64) { float s = 0.f;
#pragma unroll
        for (int q = 0; q < 8; ++q) { const u32x4 w = *(const LAS u32x4*)(KT + tid * PT + q * 8); float f[8]; unpack8(w, f);
#pragma unroll
            for (int i = 0; i < 8; ++i) s += f[i]; }
        P.smN[(size_t)ci * 64 + tid] = s; }
    __syncthreads();
}
__device__ __forceinline__ void mlstm_out(const MOut& L, const RecP& P, LAS unsigned char* lds, int ci, int tid, int wid, int lane) {
    const int bh = ci >> 6, c = ci & 63, b = bh >> 2, h = bh & 3, row0 = b * SEQ + c * 64;
    LAS bf16_t* Qm = (LAS bf16_t*)(lds + OFF_T0); LAS bf16_t* Km = (LAS bf16_t*)(lds + OFF_T1); LAS bf16_t* VT = (LAS bf16_t*)(lds + OFF_T2);
    LAS bf16_t* CT = (LAS bf16_t*)(lds + OFF_T3); LAS bf16_t* Sm = (LAS bf16_t*)(lds + OFF_T4);
    LAS float* HM = (LAS float*)(lds + OFF_HM); LAS float* vec = (LAS float*)(lds + OFF_VEC);
    const int l = tid >> 3, ch = tid & 7;
    *(LAS u32x4*)(Qm + l * PT + ch * 8) = L.q; *(LAS u32x4*)(Km + l * PT + ch * 8) = L.k; st_tr8(VT, l, ch, L.v); *(LAS u32x4*)(CT + l * PT + ch * 8) = L.st;
    if (wid == 0) {
        const float li = L.mi + P.mbi[h], lf = logsig(L.mf + P.mbf[h]);
        const float bc = scan_add(lf, lane), g = li - bc;
        const float pm = scan_max(g, lane), m = L.m, M = fmaxf(m, pm);
        vec[V_G + lane] = g; vec[V_M + lane] = M; vec[V_WI + lane] = fexp(m - M); vec[V_EM + lane] = fexp(-bc - M);
        vec[V_N + lane] = L.n;
    }
    __syncthreads();
    { f32x4 acc[2] = {(f32x4){0.f, 0.f, 0.f, 0.f}, (f32x4){0.f, 0.f, 0.f, 0.f}};
      mm64(acc, Qm, Km, wid, lane);
      const int tm = wid >> 1, tn0 = (wid & 1) * 2, lr = lane & 15, lq = lane >> 4;
#pragma unroll
      for (int t = 0; t < 2; ++t) { const int ll = (tn0 + t) * 16 + lr; const float gl = vec[V_G + ll];
#pragma unroll
          for (int r = 0; r < 4; ++r) { const int j = tm * 16 + lq * 4 + r; const float s = (ll <= j) ? acc[t][r] * fexp(gl - vec[V_M + j]) : 0.f; Sm[j * PT + ll] = (bf16_t)f2bf(s); } } }
    __syncthreads();
    { f32x4 a1[2] = {(f32x4){0.f, 0.f, 0.f, 0.f}, (f32x4){0.f, 0.f, 0.f, 0.f}}, a2[2] = {(f32x4){0.f, 0.f, 0.f, 0.f}, (f32x4){0.f, 0.f, 0.f, 0.f}};
      mm64(a1, Sm, VT, wid, lane); mm64(a2, Qm, CT, wid, lane);
      const int tm = wid >> 1, tn0 = (wid & 1) * 2, lr = lane & 15, lq = lane >> 4;
#pragma unroll
      for (int t = 0; t < 2; ++t)
#pragma unroll
          for (int r = 0; r < 4; ++r) { const int j = tm * 16 + lq * 4 + r; HM[j * 68 + (tn0 + t) * 16 + lr] = a1[t][r] + vec[V_WI + j] * a2[t][r]; } }
    if (tid < 64) { float ds = 0.f, qn = 0.f;
#pragma unroll
        for (int q = 0; q < 8; ++q) { const u32x4 w = *(const LAS u32x4*)(Sm + tid * PT + q * 8); float f[8]; unpack8(w, f);
            const u32x4 qw = *(const LAS u32x4*)(Qm + tid * PT + q * 8); float qf[8]; unpack8(qw, qf);
#pragma unroll
            for (int i = 0; i < 8; ++i) { ds += f[i]; qn += qf[i] * vec[V_N + q * 8 + i]; } }
        const float den = ds + vec[V_WI + tid] * qn;
        vec[V_DI + tid] = 1.f / fmaxf(fabsf(den), vec[V_EM + tid]); }
    __syncthreads();
    finalize2<0>(HM, vec + V_DI, P.mg, L.mo, P.ycat + (size_t)row0 * DM + h * 64, tid);
    __syncthreads();
}
__device__ __forceinline__ void gla_bmat(const f32x4 ga, const GW& W, LAS unsigned char* lds, int tid, int wid) {
    LAS float* BM = (LAS float*)(lds + OFF_BM); LAS float* vec = (LAS float*)(lds + OFF_VEC);
    if (tid < 256) { const int l = tid >> 2, q = tid & 3; vec[V_GA + l * 16 + q * 4 + 0] = ga[0]; vec[V_GA + l * 16 + q * 4 + 1] = ga[1]; vec[V_GA + l * 16 + q * 4 + 2] = ga[2]; vec[V_GA + l * 16 + q * 4 + 3] = ga[3]; }
    const int dcol = tid & 63;
    __syncthreads();
    float cs[8]; float cacc = 0.f;
#pragma unroll
    for (int i = 0; i < 8; ++i) { const int l = wid * 8 + i; float z = W.bav;
#pragma unroll
        for (int r = 0; r < 16; ++r) z += vec[V_GA + l * 16 + r] * W.wv[r];
        cacc += logsig(z) * (1.f / 16.f); cs[i] = cacc; }
    vec[V_SEG + wid * 64 + dcol] = cacc;
    __syncthreads();
    float off = 0.f, tot = 0.f;
#pragma unroll
    for (int s = 0; s < 8; ++s) { const float v = vec[V_SEG + s * 64 + dcol]; tot += v; if (s < wid) off += v; }
#pragma unroll
    for (int i = 0; i < 8; ++i) BM[(wid * 8 + i) * 64 + dcol] = off + cs[i];
    if (wid == 0) vec[V_BE + dcol] = tot;
    __syncthreads();
}
__device__ __forceinline__ void gla_local(const GLoc& L, const GW& W, const RecP& P, LAS unsigned char* lds, int ci, int tid, int wid, int lane) {
    LAS bf16_t* KT = (LAS bf16_t*)(lds + OFF_T0); LAS bf16_t* VT = (LAS bf16_t*)(lds + OFF_T1);
    LAS float* BM = (LAS float*)(lds + OFF_BM); LAS float* vec = (LAS float*)(lds + OFF_VEC);
    const int l = tid >> 3, ch = tid & 7;
    gla_bmat(L.ga, W, lds, tid, wid);
    if (tid < 64) P.smGBE[(size_t)ci * 64 + tid] = vec[V_BE + tid];
    { float kf[8]; unpack8(L.k, kf); float ks[8];
#pragma unroll
      for (int i = 0; i < 8; ++i) { const int d = ch * 8 + i; ks[i] = kf[i] * fexp(vec[V_BE + d] - BM[l * 64 + d]); }
      u32x4 kk; kk.x = pk2(ks[0], ks[1]); kk.y = pk2(ks[2], ks[3]); kk.z = pk2(ks[4], ks[5]); kk.w = pk2(ks[6], ks[7]);
      st_tr8(KT, l, ch, kk); st_tr8(VT, l, ch, L.v); }
    __syncthreads();
    f32x4 acc[2] = {(f32x4){0.f, 0.f, 0.f, 0.f}, (f32x4){0.f, 0.f, 0.f, 0.f}};
    mm64(acc, VT, KT, wid, lane);
    { const int tm = wid >> 1, tn0 = (wid & 1) * 2, lr = lane & 15, lq = lane >> 4; float* dst = P.stg + (size_t)ci * 4096;
#pragma unroll
      for (int t = 0; t < 2; ++t)
#pragma unroll
          for (int r = 0; r < 4; ++r) dst[(tm * 16 + lq * 4 + r) * 64 + (tn0 + t) * 16 + lr] = acc[t][r]; }
    __syncthreads();
}
__device__ __forceinline__ void gla_out(const GOut& L, const GW& W, const RecP& P, LAS unsigned char* lds, int ci, int tid, int wid, int lane) {
    const int bh = ci >> 6, c = ci & 63, b = bh >> 2, h = bh & 3, row0 = b * SEQ + c * 64;
    LAS bf16_t* Qm = (LAS bf16_t*)(lds + OFF_T0); LAS bf16_t* Km = (LAS bf16_t*)(lds + OFF_T1); LAS bf16_t* VT = (LAS bf16_t*)(lds + OFF_T2);
    LAS bf16_t* ST = (LAS bf16_t*)(lds + OFF_T3); LAS bf16_t* Sm = (LAS bf16_t*)(lds + OFF_T4);
    LAS float* BM = (LAS float*)(lds + OFF_BM); LAS float* HM = (LAS float*)(lds + OFF_HM);
    const int l = tid >> 3, ch = tid & 7;
    gla_bmat(L.ga, W, lds, tid, wid);
    { float qf[8], kf[8]; unpack8(L.q, qf); unpack8(L.k, kf); float qs[8], ks[8];
#pragma unroll
      for (int i = 0; i < 8; ++i) { const float bv = BM[l * 64 + ch * 8 + i]; qs[i] = qf[i] * fexp(bv); ks[i] = kf[i] * fexp(-bv); }
      u32x4 qq, kk; qq.x = pk2(qs[0], qs[1]); qq.y = pk2(qs[2], qs[3]); qq.z = pk2(qs[4], qs[5]); qq.w = pk2(qs[6], qs[7]);
      kk.x = pk2(ks[0], ks[1]); kk.y = pk2(ks[2], ks[3]); kk.z = pk2(ks[4], ks[5]); kk.w = pk2(ks[6], ks[7]);
      *(LAS u32x4*)(Qm + l * PT + ch * 8) = qq; *(LAS u32x4*)(Km + l * PT + ch * 8) = kk; st_tr8(VT, l, ch, L.v);
      *(LAS u32x4*)(ST + l * PT + ch * 8) = L.st; }
    __syncthreads();
    { f32x4 acc[2] = {(f32x4){0.f, 0.f, 0.f, 0.f}, (f32x4){0.f, 0.f, 0.f, 0.f}};
      mm64(acc, Qm, Km, wid, lane);
      const int tm = wid >> 1, tn0 = (wid & 1) * 2, lr = lane & 15, lq = lane >> 4;
#pragma unroll
      for (int t = 0; t < 2; ++t) { const int ll = (tn0 + t) * 16 + lr;
#pragma unroll
          for (int r = 0; r < 4; ++r) { const int j = tm * 16 + lq * 4 + r; Sm[j * PT + ll] = (bf16_t)f2bf((ll <= j) ? acc[t][r] : 0.f); } } }
    __syncthreads();
    { f32x4 acc[2] = {(f32x4){0.f, 0.f, 0.f, 0.f}, (f32x4){0.f, 0.f, 0.f, 0.f}};
      mm64(acc, Sm, VT, wid, lane); mm64(acc, Qm, ST, wid, lane);
      const int tm = wid >> 1, tn0 = (wid & 1) * 2, lr = lane & 15, lq = lane >> 4;
#pragma unroll
      for (int t = 0; t < 2; ++t)
#pragma unroll
          for (int r = 0; r < 4; ++r) HM[(tm * 16 + lq * 4 + r) * 68 + (tn0 + t) * 16 + lr] = acc[t][r]; }
    __syncthreads();
    finalize2<1>(HM, nullptr, P.gg, L.gr, P.ycat + (size_t)row0 * DM + 768 + h * 64, tid);
    __syncthreads();
}
}

namespace recw {
using rec::RecP; using rec::scan_add; using rec::scan_max; using rec::unpack8;
typedef short s16x4v __attribute__((ext_vector_type(4)));
typedef short v4i16_t __attribute__((ext_vector_type(4)));
#define MF16(a, b, c) __builtin_amdgcn_mfma_f32_16x16x32_bf16((a), (b), (c), 0, 0, 0)
__device__ __forceinline__ s16x4v tr16(const LAS bf16_t* p) { return __builtin_bit_cast(s16x4v, __builtin_amdgcn_ds_read_tr16_b64_v4i16((LAS v4i16_t*)p)); }
__device__ __forceinline__ bf16x8 trfrag(const LAS bf16_t* T, int pitch, int s, int c0, int lane) {
    const int i = lane & 15, q = lane >> 4;
    const LAS bf16_t* pa = T + (32 * s + 4 * q + (i >> 2)) * pitch + c0 + 4 * (i & 3);
    const s16x4v lo = tr16(pa), hi = tr16(pa + 16 * pitch);
    return (bf16x8){lo[0], lo[1], lo[2], lo[3], hi[0], hi[1], hi[2], hi[3]};
}
__device__ __forceinline__ bf16x8 rfg(const bf16_t* X, int pitch, int T, int ks, int lane) { return *(const bf16x8*)(X + (size_t)(16 * T + (lane & 15)) * pitch + 32 * ks + 8 * (lane >> 4)); }
__device__ __forceinline__ u32x4 piece(const bf16_t* X, int pitch, int i, int lane) { return *(const u32x4*)(X + (size_t)((lane >> 3) + 8 * i) * pitch + (lane & 7) * 8); }
__device__ __forceinline__ bf16x8 frag_scale(bf16x8 f, float sc) {
    const u32x4 w = __builtin_bit_cast(u32x4, f); u32x4 o;
    o.x = pk2(bflo(w.x) * sc, bfhi(w.x) * sc); o.y = pk2(bflo(w.y) * sc, bfhi(w.y) * sc); o.z = pk2(bflo(w.z) * sc, bfhi(w.z) * sc); o.w = pk2(bflo(w.w) * sc, bfhi(w.w) * sc);
    return __builtin_bit_cast(bf16x8, o);
}
__device__ __forceinline__ bf16x8 frag_mul(bf16x8 f, bf16x8 g, bool recip) {
    const u32x4 a = __builtin_bit_cast(u32x4, f), b = __builtin_bit_cast(u32x4, g); float x[8], y[8]; unpack8(a, x); unpack8(b, y);
#pragma unroll
    for (int i = 0; i < 8; ++i) x[i] = recip ? x[i] * __builtin_amdgcn_rcpf(y[i]) : x[i] * y[i];
    u32x4 o; o.x = pk2(x[0], x[1]); o.y = pk2(x[2], x[3]); o.z = pk2(x[4], x[5]); o.w = pk2(x[6], x[7]);
    return __builtin_bit_cast(bf16x8, o);
}
__device__ __forceinline__ float red_q(float v) {
    { auto r = __builtin_amdgcn_permlane16_swap(__float_as_uint(v), __float_as_uint(v), false, false); v = __uint_as_float(r[0]) + __uint_as_float(r[1]); }
    { auto r = __builtin_amdgcn_permlane32_swap(__float_as_uint(v), __float_as_uint(v), false, false); v = __uint_as_float(r[0]) + __uint_as_float(r[1]); }
    return v; }
__device__ __forceinline__ void stage_rows(f32x4 (&O)[4], int Tj, float rowscale, LAS bf16_t* Tl, int PTL, int lane) {
    const int r = lane & 15, q = lane >> 4;
    float ss = 0.f;
#pragma unroll
    for (int Te = 0; Te < 4; ++Te) { O[Te] = O[Te] * rowscale; const f32x4 v = O[Te]; ss += (v[0] * v[0] + v[1] * v[1]) + (v[2] * v[2] + v[3] * v[3]); }
    ss = red_q(ss);
    const float rs = __builtin_amdgcn_rsqf(ss * (1.f / 64.f) + LN_EPS);
#pragma unroll
    for (int Te = 0; Te < 4; ++Te) { const f32x4 v = O[Te] * rs; u32x2 w; w.x = pk2(v[0], v[1]); w.y = pk2(v[2], v[3]); *(LAS u32x2*)(Tl + (16 * Tj + r) * PTL + 16 * Te + 4 * q) = w; }
}
template <int GATE>
__device__ __forceinline__ void final_store(const LAS bf16_t* Tl, int PTL, const float* gnorm, const bf16_t* gate, bf16_t* out, int lane) {
    const int ch = lane & 7;
    const f32x4 g0 = *(const f32x4*)(gnorm + ch * 8), g1 = *(const f32x4*)(gnorm + ch * 8 + 4);
    const float gn[8] = {g0[0], g0[1], g0[2], g0[3], g1[0], g1[1], g1[2], g1[3]};
    u32x4 gw8[8];
#pragma unroll
    for (int i = 0; i < 8; ++i) gw8[i] = *(const u32x4*)(gate + (size_t)((lane >> 3) + 8 * i) * PJ + ch * 8);
    __builtin_amdgcn_sched_barrier(0);
#pragma unroll
    for (int i = 0; i < 8; ++i) { const int row = (lane >> 3) + 8 * i;
        float hv[8], gt[8]; unpack8(*(const LAS u32x4*)(Tl + row * PTL + ch * 8), hv); unpack8(gw8[i], gt);
        float y[8];
#pragma unroll
        for (int k = 0; k < 8; ++k) { const float sg = __builtin_amdgcn_rcpf(1.f + fexp(-gt[k])); y[k] = hv[k] * (gn[k] * Y8S) * (GATE ? gt[k] * sg : sg); }
        u32x2 w; w.x = pk4_fp8(y[0], y[1], y[2], y[3]); w.y = pk4_fp8(y[4], y[5], y[6], y[7]);
        *(u32x2*)((unsigned char*)out + (size_t)row * DM + ch * 8) = w; }
}
__device__ __forceinline__ void mlstm_local_w(const RecP& P, LAS unsigned char* wl, int ci, int lane) {
    const int r = lane & 15, q = lane >> 4; constexpr int PL = 64;
    const int bh = ci >> 6, c = ci & 63, b = bh >> 2, h = bh & 3, row0 = b * SEQ + c * 64;
    const bf16_t* Xk = P.proj + (size_t)row0 * PJ + C_MK + h * 64; const bf16_t* Xv = P.proj + (size_t)row0 * PJ + C_MV + h * 64;
    LAS bf16_t* Kl = (LAS bf16_t*)wl; LAS bf16_t* Vl = (LAS bf16_t*)(wl + 8192);
    u32x4 kp8_[8], vp8_[8];
#pragma unroll
    for (int i = 0; i < 8; ++i) { kp8_[i] = piece(Xk, PJ, i, lane); vp8_[i] = piece(Xv, PJ, i, lane); }
    const float* tp = P.tail + (size_t)(row0 + lane) * 32;
    const float tmi_ = tp[T_MI + h], tmf_ = tp[T_MF + h];
    __builtin_amdgcn_sched_barrier(0);
    const float li = tmi_ + P.mbi[h], lf = logsig(tmf_ + P.mbf[h]);
    const float bc = scan_add(lf, lane), g = li - bc, gmax = wave_max(g), bend = __builtin_bit_cast(float, __builtin_amdgcn_readlane(__builtin_bit_cast(int, bc), 63)), w = fexp(g - gmax);
    if (lane == 0) { P.smBC[ci] = bend; P.smDM[ci] = bend + gmax; }
#pragma unroll
    for (int i = 0; i < 8; ++i) { const u32x4 kpi = kp8_[i], vpi = vp8_[i]; const float wr_ = __shfl(w, (lane >> 3) + 8 * i); float kf[8]; unpack8(kpi, kf);
        u32x4 ks; ks.x = pk2(kf[0] * wr_, kf[1] * wr_); ks.y = pk2(kf[2] * wr_, kf[3] * wr_); ks.z = pk2(kf[4] * wr_, kf[5] * wr_); ks.w = pk2(kf[6] * wr_, kf[7] * wr_);
        *(LAS u32x4*)(Kl + ((lane >> 3) + 8 * i) * PL + (lane & 7) * 8) = ks; *(LAS u32x4*)(Vl + ((lane >> 3) + 8 * i) * PL + (lane & 7) * 8) = vpi; }
    asm volatile("" ::: "memory"); __builtin_amdgcn_sched_barrier(0);
    bf16x8 Kt[4][2];
#pragma unroll
    for (int Td = 0; Td < 4; ++Td)
#pragma unroll
        for (int s = 0; s < 2; ++s) Kt[Td][s] = trfrag(Kl, PL, s, 16 * Td, lane);
#pragma unroll
    for (int Te = 0; Te < 4; ++Te) { const bf16x8 v0 = trfrag(Vl, PL, 0, 16 * Te, lane), v1 = trfrag(Vl, PL, 1, 16 * Te, lane);
#pragma unroll
        for (int Td = 0; Td < 4; ++Td) { f32x4 acc = (f32x4){0.f, 0.f, 0.f, 0.f}; acc = MF16(Kt[Td][0], v0, acc); acc = MF16(Kt[Td][1], v1, acc);
            u32x2 w; w.x = pk2(acc[0], acc[1]); w.y = pk2(acc[2], acc[3]); *(LAS u32x2*)(Kl + (16 * Te + r) * PL + 16 * Td + 4 * q) = w; } }
    asm volatile("" ::: "memory"); __builtin_amdgcn_sched_barrier(0);
    { bf16_t* dstb = (bf16_t*)P.stm + (size_t)ci * 4096;
#pragma unroll
      for (int i = 0; i < 8; ++i) { const int row = (lane >> 3) + 8 * i, ch = lane & 7; *(u32x4*)(dstb + row * 64 + ch * 8) = *(const LAS u32x4*)(Kl + row * PL + ch * 8); } }
    { const short one = (short)0x3F80; const bf16x8 ones = (bf16x8){one, one, one, one, one, one, one, one};
#pragma unroll
      for (int Td = 0; Td < 4; ++Td) { f32x4 acc = (f32x4){0.f, 0.f, 0.f, 0.f}; acc = MF16(ones, Kt[Td][0], acc); acc = MF16(ones, Kt[Td][1], acc);
          if (q == 0) P.smN[(size_t)ci * 64 + 16 * Td + r] = acc[0]; } }
}
struct GWf { bf16x8 Bw[4]; float ba[4]; };
__device__ __forceinline__ void ld_gwf(GWf& W, const RecP& P, int h, int lane) {
    const int r = lane & 15, q = lane >> 4;
    int wo = (8 * (q & 1)) * 256 + h * 64 + r; asm volatile("" : "+v"(wo)); const float* wp = P.wa2 + wo;
#pragma unroll
    for (int Td = 0; Td < 4; ++Td) { float w8[8];
#pragma unroll
        for (int i = 0; i < 8; ++i) { const float wv_ = wp[i * 256 + 16 * Td]; w8[i] = (q < 2) ? wv_ : 0.f; }
        u32x4 o; o.x = pk2(w8[0], w8[1]); o.y = pk2(w8[2], w8[3]); o.z = pk2(w8[4], w8[5]); o.w = pk2(w8[6], w8[7]); W.Bw[Td] = __builtin_bit_cast(bf16x8, o);
        W.ba[Td] = P.ba[h * 64 + 16 * Td + r]; }
}
template <int MODE>
__device__ __forceinline__ void gla_gate_tile(LAS bf16_t* Tt, int PL, float (&bend)[4], const GWf& W, const float* tail_row0, int lane) {
    const int r = lane & 15, q = lane >> 4;
    bf16x8 Ag[4];
    int to = r * 32 + T_GA + 8 * (q & 1); asm volatile("" : "+v"(to)); const float* tpb = tail_row0 + to;
    f32x4 ar0[4], ar1[4];
#pragma unroll
    for (int Tl = 0; Tl < 4; ++Tl) { ar0[Tl] = *(const f32x4*)(tpb + Tl * 512); ar1[Tl] = *(const f32x4*)(tpb + Tl * 512 + 4); }
    __builtin_amdgcn_sched_barrier(0);
#pragma unroll
    for (int Tl = 0; Tl < 4; ++Tl) { f32x4 a0 = ar0[Tl], a1 = ar1[Tl];
        if (q >= 2) { a0 = (f32x4){0.f, 0.f, 0.f, 0.f}; a1 = a0; }
        u32x4 o; o.x = pk2(a0[0], a0[1]); o.y = pk2(a0[2], a0[3]); o.z = pk2(a1[0], a1[1]); o.w = pk2(a1[2], a1[3]); Ag[Tl] = __builtin_bit_cast(bf16x8, o); }
#pragma unroll
    for (int Td = 0; Td < 4; ++Td) { float carry = 0.f; LAS bf16_t* tcol = Tt + (4 * q) * PL + 16 * Td + r;
#pragma unroll
        for (int tt = 0; tt < 4; ++tt) { const int Tl = MODE ? 3 - tt : tt; const float bb = W.ba[Td]; const f32x4 z = MF16(Ag[Tl], W.Bw[Td], ((f32x4){bb, bb, bb, bb}));
            const float v0 = logsig(z[0]) * (1.f / 16.f), v1 = logsig(z[1]) * (1.f / 16.f), v2 = logsig(z[2]) * (1.f / 16.f), v3 = logsig(z[3]) * (1.f / 16.f);
            const float lt = (v0 + v1) + (v2 + v3);
            float ex, o0, o1, o2, o3;
            if (MODE == 0) { const float t1 = __shfl_up(lt, 16), t2 = __shfl_up(lt, 32), t3 = __shfl_up(lt, 48); ex = carry + (q >= 1 ? t1 : 0.f) + (q >= 2 ? t2 : 0.f) + (q >= 3 ? t3 : 0.f);
                o0 = ex + v0; o1 = o0 + v1; o2 = o1 + v2; o3 = o2 + v3; }
            else { const float t1 = __shfl_down(lt, 16), t2 = __shfl_down(lt, 32), t3 = __shfl_down(lt, 48); ex = carry + (q <= 2 ? t1 : 0.f) + (q <= 1 ? t2 : 0.f) + (q <= 0 ? t3 : 0.f);
                o3 = ex; o2 = o3 + v3; o1 = o2 + v2; o0 = o1 + v1; }
            carry += red_q(lt);
            LAS bf16_t* tp = tcol + (16 * Tl) * PL;
            const unsigned w01 = pk2(fexp(o0), fexp(o1)), w23 = pk2(fexp(o2), fexp(o3));
            tp[0] = (bf16_t)(w01 & 0xffffu); tp[PL] = (bf16_t)(w01 >> 16); tp[2 * PL] = (bf16_t)(w23 & 0xffffu); tp[3 * PL] = (bf16_t)(w23 >> 16); }
        bend[Td] = carry; }
}
__device__ __forceinline__ void gla_local_w(const RecP& P, const GWf& W, LAS unsigned char* wl, int ci, int lane) {
    const int r = lane & 15, q = lane >> 4; constexpr int PL = 64;
    const int bh = ci >> 6, c = ci & 63, b = bh >> 2, h = bh & 3, row0 = b * SEQ + c * 64;
    const bf16_t* Xk = P.proj + (size_t)row0 * PJ + C_GK + h * 64; const bf16_t* Xv = P.proj + (size_t)row0 * PJ + C_GV + h * 64;
    LAS bf16_t* Kl = (LAS bf16_t*)wl; LAS bf16_t* Vl = (LAS bf16_t*)(wl + 8192);
    u32x4 kp8_[8], vp8_[8];
#pragma unroll
    for (int i = 0; i < 8; ++i) { kp8_[i] = piece(Xk, PJ, i, lane); vp8_[i] = piece(Xv, PJ, i, lane); }
    __builtin_amdgcn_sched_barrier(0);
    { float bend[4]; gla_gate_tile<1>(Kl, PL, bend, W, P.tail + (size_t)row0 * 32, lane);
      if (q == 0) {
#pragma unroll
          for (int Td = 0; Td < 4; ++Td) P.smGBE[(size_t)ci * 64 + 16 * Td + r] = bend[Td]; } }
    asm volatile("" ::: "memory"); __builtin_amdgcn_sched_barrier(0);
#pragma unroll
    for (int i = 0; i < 8; ++i) { const u32x4 kp = kp8_[i], vp = vp8_[i];
        LAS bf16_t* kp_l = Kl + ((lane >> 3) + 8 * i) * PL + (lane & 7) * 8; float kf[8], ff[8]; unpack8(kp, kf); unpack8(*(const LAS u32x4*)kp_l, ff);
        u32x4 ks; ks.x = pk2(kf[0] * ff[0], kf[1] * ff[1]); ks.y = pk2(kf[2] * ff[2], kf[3] * ff[3]); ks.z = pk2(kf[4] * ff[4], kf[5] * ff[5]); ks.w = pk2(kf[6] * ff[6], kf[7] * ff[7]);
        *(LAS u32x4*)kp_l = ks; *(LAS u32x4*)(Vl + ((lane >> 3) + 8 * i) * PL + (lane & 7) * 8) = vp; }
    asm volatile("" ::: "memory"); __builtin_amdgcn_sched_barrier(0);
    bf16x8 Kt[4][2];
#pragma unroll
    for (int Td = 0; Td < 4; ++Td)
#pragma unroll
        for (int s = 0; s < 2; ++s) Kt[Td][s] = trfrag(Kl, PL, s, 16 * Td, lane);
#pragma unroll
    for (int Te = 0; Te < 4; ++Te) { const bf16x8 v0 = trfrag(Vl, PL, 0, 16 * Te, lane), v1 = trfrag(Vl, PL, 1, 16 * Te, lane);
#pragma unroll
        for (int Td = 0; Td < 4; ++Td) { f32x4 acc = (f32x4){0.f, 0.f, 0.f, 0.f}; acc = MF16(Kt[Td][0], v0, acc); acc = MF16(Kt[Td][1], v1, acc);
            u32x2 w; w.x = pk2(acc[0], acc[1]); w.y = pk2(acc[2], acc[3]); *(LAS u32x2*)(Kl + (16 * Te + r) * PL + 16 * Td + 4 * q) = w; } }
    asm volatile("" ::: "memory"); __builtin_amdgcn_sched_barrier(0);
    { bf16_t* dstb = (bf16_t*)P.stg + (size_t)ci * 4096;
#pragma unroll
      for (int i = 0; i < 8; ++i) { const int row = (lane >> 3) + 8 * i, ch = lane & 7; *(u32x4*)(dstb + row * 64 + ch * 8) = *(const LAS u32x4*)(Kl + row * PL + ch * 8); } }
}
__device__ __forceinline__ void mlstm_out_w(const RecP& P, LAS unsigned char* wl, int ci, int lane) {
    const int r = lane & 15, q = lane >> 4; constexpr int PL = 72;
    const int bh = ci >> 6, c = ci & 63, b = bh >> 2, h = bh & 3, row0 = b * SEQ + c * 64;
    const bf16_t* Xq = P.proj + (size_t)row0 * PJ + C_MQ + h * 64; const bf16_t* Xk = P.proj + (size_t)row0 * PJ + C_MK + h * 64; const bf16_t* Xv = P.proj + (size_t)row0 * PJ + C_MV + h * 64;
    LAS bf16_t* Tl = (LAS bf16_t*)wl; LAS float* vg = (LAS float*)(wl + 9216); LAS float* vn = vg + 64;
    bf16x8 Kf[4][2], Qf[4][2];
#pragma unroll
    for (int T = 0; T < 4; ++T)
#pragma unroll
        for (int ks = 0; ks < 2; ++ks) { Kf[T][ks] = rfg(Xk, PJ, T, ks, lane); Qf[T][ks] = rfg(Xq, PJ, T, ks, lane); }
    const float* tp = P.tail + (size_t)(row0 + lane) * 32;
    const float tmi_ = tp[T_MI + h], tmf_ = tp[T_MF + h], m = P.smMS[ci], vn_in = P.smN[(size_t)ci * 64 + lane];
    { u32x4 tv_[8];
#pragma unroll
      for (int i = 0; i < 8; ++i) tv_[i] = piece(Xv, PJ, i, lane);
      __builtin_amdgcn_sched_barrier(0);
#pragma unroll
      for (int i = 0; i < 8; ++i) *(LAS u32x4*)(Tl + ((lane >> 3) + 8 * i) * PL + (lane & 7) * 8) = tv_[i]; }
    const float li = tmi_ + P.mbi[h], lf = logsig(tmf_ + P.mbf[h]);
    vn[lane] = vn_in;
    const float bc = scan_add(lf, lane), g = li - bc, pm = scan_max(g, lane), M = fmaxf(m, pm), wint = fexp(m - M), expm = fexp(-bc - M);
    vg[lane] = g;
    asm volatile("" ::: "memory"); __builtin_amdgcn_sched_barrier(0);
    float Mj[4], wj[4], ej[4];
#pragma unroll
    for (int T = 0; T < 4; ++T) { Mj[T] = __shfl(M, 16 * T + r); wj[T] = __shfl(wint, 16 * T + r); ej[T] = __shfl(expm, 16 * T + r); }
    u32x2 Pk[4][4]; float dinv[4];
#pragma unroll
    for (int Tj = 0; Tj < 4; ++Tj) { float dsum = 0.f;
#pragma unroll
        for (int Tl_ = 0; Tl_ < 4; ++Tl_) {
            if (Tl_ <= Tj) { f32x4 acc = (f32x4){0.f, 0.f, 0.f, 0.f}; acc = MF16(Kf[Tl_][0], Qf[Tj][0], acc); acc = MF16(Kf[Tl_][1], Qf[Tj][1], acc);
                const f32x4 g4 = *(const LAS f32x4*)(vg + 16 * Tl_ + 4 * q); float sv[4];
#pragma unroll
                for (int rg = 0; rg < 4; ++rg) { const bool ok = (Tl_ < Tj) || (4 * q + rg <= r); sv[rg] = ok ? acc[rg] * fexp(g4[rg] - Mj[Tj]) : 0.f; dsum += sv[rg]; }
                Pk[Tj][Tl_].x = pk2(sv[0], sv[1]); Pk[Tj][Tl_].y = pk2(sv[2], sv[3]); }
            else { Pk[Tj][Tl_].x = 0u; Pk[Tj][Tl_].y = 0u; } }
        dsum = red_q(dsum);
        float qn = 0.f;
#pragma unroll
        for (int ks = 0; ks < 2; ++ks) { float qf[8]; unpack8(__builtin_bit_cast(u32x4, Qf[Tj][ks]), qf); const f32x4 n0 = *(const LAS f32x4*)(vn + 32 * ks + 8 * q), n1 = *(const LAS f32x4*)(vn + 32 * ks + 8 * q + 4);
            qn += (qf[0] * n0[0] + qf[1] * n0[1]) + (qf[2] * n0[2] + qf[3] * n0[3]) + (qf[4] * n1[0] + qf[5] * n1[1]) + (qf[6] * n1[2] + qf[7] * n1[3]); }
        qn = red_q(qn);
        const float den = dsum + wj[Tj] * qn; dinv[Tj] = __builtin_amdgcn_rcpf(fmaxf(fabsf(den), ej[Tj]));
        Qf[Tj][0] = frag_scale(Qf[Tj][0], wj[Tj]); Qf[Tj][1] = frag_scale(Qf[Tj][1], wj[Tj]); asm volatile("" ::: "memory"); __builtin_amdgcn_sched_barrier(0); }
    asm volatile("" ::: "memory"); __builtin_amdgcn_sched_barrier(0);
    const bf16_t* cs = P.csm + (size_t)ci * 4096;
    bf16x8 Vt[4][2], Ct[4][2];
#pragma unroll
    for (int Te = 0; Te < 4; ++Te)
#pragma unroll
        for (int s = 0; s < 2; ++s) { Vt[Te][s] = trfrag(Tl, PL, s, 16 * Te, lane); Ct[Te][s] = rfg(cs, 64, Te, s, lane); }
    asm volatile("" ::: "memory"); __builtin_amdgcn_sched_barrier(0);
#pragma unroll
    for (int Tj = 0; Tj < 4; ++Tj) { f32x4 O[4];
        const bf16x8 p0 = __builtin_bit_cast(bf16x8, ((u32x4){Pk[Tj][0].x, Pk[Tj][0].y, Pk[Tj][1].x, Pk[Tj][1].y})), p1 = __builtin_bit_cast(bf16x8, ((u32x4){Pk[Tj][2].x, Pk[Tj][2].y, Pk[Tj][3].x, Pk[Tj][3].y}));
#pragma unroll
        for (int Te = 0; Te < 4; ++Te) { f32x4 acc = (f32x4){0.f, 0.f, 0.f, 0.f}; acc = MF16(Vt[Te][0], p0, acc); if (Tj >= 2) acc = MF16(Vt[Te][1], p1, acc);
            acc = MF16(Ct[Te][0], Qf[Tj][0], acc); acc = MF16(Ct[Te][1], Qf[Tj][1], acc); O[Te] = acc; }
        stage_rows(O, Tj, dinv[Tj], Tl, PL, lane); asm volatile("" ::: "memory"); __builtin_amdgcn_sched_barrier(0); }
    asm volatile("" ::: "memory"); __builtin_amdgcn_sched_barrier(0);
    final_store<0>(Tl, PL, P.mg, P.proj + (size_t)row0 * PJ + C_MO + h * 64, (bf16_t*)((unsigned char*)P.ycat + (size_t)row0 * DM + h * 64), lane);
}
__device__ __forceinline__ void gla_out_w(const RecP& P, const GWf& W, LAS unsigned char* wl, int ci, int lane) {
    const int r = lane & 15, q = lane >> 4; constexpr int PL = 72;
    const int bh = ci >> 6, c = ci & 63, b = bh >> 2, h = bh & 3, row0 = b * SEQ + c * 64;
    const bf16_t* Xq = P.proj + (size_t)row0 * PJ + C_GQ + h * 64; const bf16_t* Xk = P.proj + (size_t)row0 * PJ + C_GK + h * 64; const bf16_t* Xv = P.proj + (size_t)row0 * PJ + C_GV + h * 64;
    LAS bf16_t* Tl = (LAS bf16_t*)wl;
    bf16x8 Kf[4][2], Qf[4][2]; u32x4 tv_[8];
#pragma unroll
    for (int T = 0; T < 4; ++T)
#pragma unroll
        for (int ks = 0; ks < 2; ++ks) { Qf[T][ks] = rfg(Xq, PJ, T, ks, lane); Kf[T][ks] = rfg(Xk, PJ, T, ks, lane); }
#pragma unroll
    for (int i = 0; i < 8; ++i) tv_[i] = piece(Xv, PJ, i, lane);
    __builtin_amdgcn_sched_barrier(0);
    { float bend[4]; gla_gate_tile<0>(Tl, PL, bend, W, P.tail + (size_t)row0 * 32, lane); }
    asm volatile("" ::: "memory"); __builtin_amdgcn_sched_barrier(0);
#pragma unroll
    for (int T = 0; T < 4; ++T)
#pragma unroll
        for (int ks = 0; ks < 2; ++ks) { const bf16x8 ef = *(const LAS bf16x8*)(Tl + (16 * T + r) * PL + 32 * ks + 8 * q); Qf[T][ks] = frag_mul(Qf[T][ks], ef, false); Kf[T][ks] = frag_mul(Kf[T][ks], ef, true); }
    asm volatile("" ::: "memory"); __builtin_amdgcn_sched_barrier(0);
    {
#pragma unroll
      for (int i = 0; i < 8; ++i) *(LAS u32x4*)(Tl + ((lane >> 3) + 8 * i) * PL + (lane & 7) * 8) = tv_[i]; }
    asm volatile("" ::: "memory"); __builtin_amdgcn_sched_barrier(0);
    u32x2 Pk[4][4];
#pragma unroll
    for (int Tj = 0; Tj < 4; ++Tj)
#pragma unroll
        for (int Tl_ = 0; Tl_ < 4; ++Tl_) {
            if (Tl_ <= Tj) { f32x4 acc = (f32x4){0.f, 0.f, 0.f, 0.f}; acc = MF16(Kf[Tl_][0], Qf[Tj][0], acc); acc = MF16(Kf[Tl_][1], Qf[Tj][1], acc); float sv[4];
#pragma unroll
                for (int rg = 0; rg < 4; ++rg) { const bool ok = (Tl_ < Tj) || (4 * q + rg <= r); sv[rg] = ok ? acc[rg] : 0.f; }
                Pk[Tj][Tl_].x = pk2(sv[0], sv[1]); Pk[Tj][Tl_].y = pk2(sv[2], sv[3]); }
            else { Pk[Tj][Tl_].x = 0u; Pk[Tj][Tl_].y = 0u; } }
    const bf16_t* cs = P.csg + (size_t)ci * 4096;
    bf16x8 Vt[4][2], Ct[4][2];
#pragma unroll
    for (int Te = 0; Te < 4; ++Te)
#pragma unroll
        for (int s = 0; s < 2; ++s) { Vt[Te][s] = trfrag(Tl, PL, s, 16 * Te, lane); Ct[Te][s] = rfg(cs, 64, Te, s, lane); }
    asm volatile("" ::: "memory"); __builtin_amdgcn_sched_barrier(0);
#pragma unroll
    for (int Tj = 0; Tj < 4; ++Tj) { f32x4 O[4];
        const bf16x8 p0 = __builtin_bit_cast(bf16x8, ((u32x4){Pk[Tj][0].x, Pk[Tj][0].y, Pk[Tj][1].x, Pk[Tj][1].y})), p1 = __builtin_bit_cast(bf16x8, ((u32x4){Pk[Tj][2].x, Pk[Tj][2].y, Pk[Tj][3].x, Pk[Tj][3].y}));
#pragma unroll
        for (int Te = 0; Te < 4; ++Te) { f32x4 acc = (f32x4){0.f, 0.f, 0.f, 0.f}; acc = MF16(Vt[Te][0], p0, acc); if (Tj >= 2) acc = MF16(Vt[Te][1], p1, acc);
            acc = MF16(Ct[Te][0], Qf[Tj][0], acc); acc = MF16(Ct[Te][1], Qf[Tj][1], acc); O[Te] = acc; }
        stage_rows(O, Tj, 1.f, Tl, PL, lane); asm volatile("" ::: "memory"); __builtin_amdgcn_sched_barrier(0); }
    asm volatile("" ::: "memory"); __builtin_amdgcn_sched_barrier(0);
    final_store<1>(Tl, PL, P.gg, P.proj + (size_t)row0 * PJ + C_GR + h * 64, (bf16_t*)((unsigned char*)P.ycat + (size_t)row0 * DM + 768 + h * 64), lane);
}
#undef MF16
}


constexpr int N_PHASES = 2 + 9 * DEPTH;
__global__ void __launch_bounds__(512, 2) mega_fwd(Args args) {
    extern __shared__ __attribute__((aligned(16))) unsigned char lds_raw[];
    Frame F;
    F.lds = (LAS unsigned char*)lds_raw;
    F.MISC = (volatile LAS unsigned*)(F.lds + MISC_OFF);
    F.tid = threadIdx.x; F.lane = F.tid & 63; F.wave = __builtin_amdgcn_readfirstlane(F.tid >> 6);
    F.G = gridDim.x; { const int bx = blockIdx.x; F.vcu = (F.G % 8 == 0) ? (bx % 8) * (F.G / 8) + bx / 8 : bx; }
    typedef const __attribute__((address_space(4))) Args* CArgs;
    const CArgs ap0 = (CArgs)__builtin_amdgcn_kernarg_segment_ptr();
    F.ctl = (gu32*)(args.ws + WS_CTL);
    for (int u = F.tid; u < (LDS_BYTES - LDSCTL_OFF) / 4; u += 512) ((LAS unsigned*)(F.lds + LDSCTL_OFF))[u] = 0u;
    __syncthreads();
#if MK_ONE_LAUNCH
    XcdBarrier bar = xcd_barrier_post((unsigned*)(F.ctl + CW_BAR), F.MISC + 8, F.tid == 0);
#define GRID_BAR() xcd_barrier(bar, F.wave == 0 && lane_id_() == 0)
#else
#define GRID_BAR() do {} while (0)
#endif
    const int lo = args.ph_lo, hi = args.ph_hi;
#define IN(k) (lo <= (k) && (k) < hi)
#define SEAM(k) do { if (IN(k) && IN((k) + 1)) { GRID_BAR(); if (NREP(15) == 2) GRID_BAR(); } } while (0)
    const int NGW = F.G * 8;
#define PHASE_IDS() int tid = mk_tid(F.wave); asm volatile("" : "+v"(tid)); const int lane = tid & 63, wid = __builtin_amdgcn_readfirstlane(tid >> 6); const int gw = F.vcu * 8 + wid; (void)lane; (void)gw; \
    CArgs ap = ap0; asm volatile("" : "+s"(ap)); unsigned char* ws = ap->ws; (void)ws
#define AIN(i) (ap->in[i])
#define MOD ((float*)(ws + WS_MOD))
#define ROPE ((float*)(ws + WS_ROPE))
#define WIN ((bf16_t*)(ws + WS_WIN))
#define WOUT ((bf16_t*)(ws + WS_WOUT))
#define WGU8 ((unsigned char*)(ws + WS_WGU))
#define WD8 ((unsigned char*)(ws + WS_WD))
#define U8B ((unsigned char*)(ws + WS_U8))
#define WIN8 ((unsigned char*)(ws + WS_WIN8))
#define H8B ((unsigned char*)(ws + WS_PROJ))
#define LTOK ((int*)(ws + WS_LTOK))
#define LGATE ((float*)(ws + WS_LGATE))
#define PROJ ((bf16_t*)(ws + WS_PROJ))
#define HB ((bf16_t*)(ws + WS_PROJ))
#define XB ((bf16_t*)(ws + WS_XR))
#define YSORT ((bf16_t*)(ws + WS_YSORT))
#define TAILB ((float*)(ws + WS_TAIL))
#define TOKSLOT ((int*)(ws + WS_SM + SM_TS))
#define UB ((bf16_t*)(ws + WS_U))
#define YCAT ((bf16_t*)(ws + WS_YCAT))
#define STM ((float*)(ws + WS_U))
#define STG ((float*)(ws + WS_U + 32 * MiB))
#define CSM ((bf16_t*)(ws + WS_XR + 64 * MiB))
#define CSG ((bf16_t*)(ws + WS_XR + 80 * MiB))
#define G_smN ((float*)(ws + WS_SM + SM_N))
#define G_smBC ((float*)(ws + WS_SM + SM_BC))
#define G_smDM ((float*)(ws + WS_SM + SM_DM))
#define G_smMS ((float*)(ws + WS_SM + SM_MS))
#define G_smGBE ((float*)(ws + WS_SM + SM_GBE))
#define x_in AIN(I_X)

    if (IN(0) && PHON(0)) for (int rp0 = 0; rp0 < NREP(0); ++rp0) {
        PHASE_IDS();
        {
            LAS float* cact = (LAS float*)F.lds;
            LAS float* part = (LAS float*)(F.lds + 32768);
            const float* cc = AIN(I_C);
            { float cv[16];
#pragma unroll
              for (int j = 0; j < 16; ++j) cv[j] = cc[tid + 512 * j];
#pragma unroll
              for (int j = 0; j < 16; ++j) { const int i = tid + 512 * j, b = i >> 10, k = i & 1023; const float v = cv[j]; cact[k * 8 + b] = v / (1.f + fexp(-v)); } }
            __syncthreads();
            for (int it = F.vcu; it < DEPTH * 96; it += F.G) {
                const int l = it / 96, j0 = (it % 96) * 64;
                const float* W = AIN(I_WADA) + (size_t)l * DM * 6144 + j0 + lane;
                float a[8] = {0.f, 0.f, 0.f, 0.f, 0.f, 0.f, 0.f, 0.f};
                for (int k0 = 0; k0 < 128; k0 += 16) { float wv[16];
#pragma unroll
                    for (int kk = 0; kk < 16; ++kk) wv[kk] = W[(size_t)(wid * 128 + k0 + kk) * 6144];
                    __builtin_amdgcn_sched_barrier(0);
#pragma unroll
                    for (int kk = 0; kk < 16; ++kk) { const int k = wid * 128 + k0 + kk; const float w = wv[kk];
                        const f32x4 c0 = *(const LAS f32x4*)(cact + k * 8), c1 = *(const LAS f32x4*)(cact + k * 8 + 4);
                        a[0] += c0[0] * w; a[1] += c0[1] * w; a[2] += c0[2] * w; a[3] += c0[3] * w; a[4] += c1[0] * w; a[5] += c1[1] * w; a[6] += c1[2] * w; a[7] += c1[3] * w; } }
#pragma unroll
                for (int b = 0; b < 8; ++b) part[(wid * 8 + b) * 64 + lane] = a[b];
                __syncthreads();
                { const int b = tid >> 6, j = tid & 63; float s = AIN(I_BADA)[(size_t)l * 6144 + j0 + j];
#pragma unroll
                  for (int w = 0; w < 8; ++w) s += part[(w * 8 + b) * 64 + j];
                  MOD[((size_t)l * NB + b) * 6144 + j0 + j] = s; }
                __syncthreads();
            }
        }
        {
            const int* pos = (const int*)AIN(I_POS);
            for (int i = blockIdx.x * 512 + tid; i < NTOK * 4; i += F.G * 512) { const int row = i >> 2, f = i & 3;
                const float invf = (float)pow(500000.0, -0.25 * (double)f); const float ang = (float)pos[row] * invf;
                ROPE[(size_t)row * 8 + f] = (float)cos((double)ang); ROPE[(size_t)row * 8 + 4 + f] = (float)sin((double)ang); }
        }
        {
            LAS float* scr = (LAS float*)(F.lds + 49152 + wid * 8704);
            constexpr int I_IN = (DM / 64) * (PW / 32), I_OUT = (DM / 64) * (DM / 32);
            auto dec0 = [&](int it, TrD& d) { const int l = it / (I_IN + I_OUT); int r = it % (I_IN + I_OUT);
                if (r < I_IN) { const int kb = r / (PW / 32), nb = r % (PW / 32); const int nbe = (nb < 112) ? nb : 0; const int tl = nbe >> 3;
                    d.wsc = (tl == 0 || tl == 10) ? 0.125f : (tl == 7) ? ATT_C2 : 1.f;
                    d.src = AIN(I_WIN) + (size_t)l * DM * PIN + (size_t)(kb * 64) * PIN + win_src_col(nbe * 32); d.ldw = PIN; d.K = DM; d.dst = WIN + (size_t)l * PW * DM; d.dst8 = WIN8 + (size_t)l * PP * DM; d.drow0 = nbe * 32; d.k0 = kb * 64;
                    return nb < 112; }
                r -= I_IN; const int kb = r / (DM / 32), nb = r % (DM / 32); d.wsc = 1.f;
                d.src = AIN(I_WOUT) + (size_t)l * DM * DM + (size_t)(kb * 64) * DM + nb * 32; d.wsc = W8S; d.dst8 = nullptr; d.ldw = DM; d.K = DM; d.dst = (bf16_t*)((unsigned char*)WOUT + (size_t)l * DM * DM); d.drow0 = nb * 32; d.k0 = kb * 64; return true; };
            { TrD dc, dn; f32x4 vc[8], vn[8]; int it = gw; bool okc = dec0(it, dc); tr_load4(dc, vc, lane); dn = dc; bool okn = okc;
#pragma unroll
              for (int i = 0; i < 8; ++i) vn[i] = vc[i];
              for (; it < DEPTH * (I_IN + I_OUT); it += NGW) { const int itn = it + NGW;
                  if (itn < DEPTH * (I_IN + I_OUT)) { okn = dec0(itn, dn); tr_load4(dn, vn, lane); }
                  if (okc) { if (dc.ldw == DM) tr_finish8(dc, vc, scr, lane); else { TrD d8 = dc; d8.dst = (bf16_t*)dc.dst8; d8.wsc = dc.wsc * W8S; tr_finish8(d8, vc, scr, lane); } }
                  dc = dn; okc = okn;
#pragma unroll
                  for (int i = 0; i < 8; ++i) vc[i] = vn[i]; } }
            for (int it = gw; it < DEPTH * (DM / 64) * 8; it += NGW) { const int l = it / ((DM / 64) * 8), r = it % ((DM / 64) * 8), kb = r >> 3, nb = 112 + (r & 7);
                tr_item(AIN(I_WIN) + (size_t)l * DM * PIN, PIN, DM, WIN + (size_t)l * PW * DM, nb * 32, win_src_col(nb * 32 + (lane & 31)), kb * 64, scr, lane); }
        }
    }
    SEAM(0);
    if (IN(1) && PHON(1)) {
        PHASE_IDS();
        NarrowT NT_; nmm_load_tail(NT_, WIN + (size_t)PP * DM, wid, lane);
        LAS bf16_t* Sst = (LAS bf16_t*)F.lds; LAS float* Pb = (LAS float*)(F.lds + NMM_P_OFF);
        const int b = F.vcu >> 5; const float* md = MOD + (size_t)b * 6144;
        f32x4 sh[4], sc[4];
#pragma unroll
        for (int j = 0; j < 4; ++j) { sh[j] = *(const f32x4*)(md + 4 * lane + 256 * j); sc[j] = *(const f32x4*)(md + 1024 + 4 * lane + 256 * j) + 1.0f; }
        const int rowb = F.vcu * 128 + wid * 16;
        for (int i = 0; i < 16; i += 4) { f32x4 v[4][4];
#pragma unroll
            for (int rr = 0; rr < 4; ++rr)
#pragma unroll
                for (int j = 0; j < 4; ++j) v[rr][j] = *(const f32x4*)(x_in + (size_t)(rowb + i + rr) * DM + 4 * lane + 256 * j);
#pragma unroll
            for (int rr = 0; rr < 4; ++rr)
#pragma unroll
                for (int j = 0; j < 4; ++j) { const f32x4 u = v[rr][j] * sc[j] + sh[j];
                    u32x2 w; w.x = pk2(u[0], u[1]); w.y = pk2(u[2], u[3]); *(LAS u32x2*)(Sst + (wid * 4 + rr) * NSP + 4 * lane + 256 * j) = w;
                    *(unsigned*)(U8B + (size_t)(rowb + i + rr) * DM + 4 * lane + 256 * j) = pk4_fp8(u[0], u[1], u[2], u[3]); }
            nmm_step_tail(NT_, Sst, Pb, TAILB + (size_t)(F.vcu * 128) * 32, i, tid, wid, lane); }
    }
    SEAM(1);

#define CONV_ITEMS(LYR, IT0, STEP, NJ) do { \
        LAS float* scr_ = (LAS float*)(F.lds + 49152 + wid * 8704); \
        constexpr int I_G = (DM / 64) * (1024 / 32), I_D = (DE / 64) * (DM / 32), NIT_ = NE * (I_G + I_D); \
        const int lyr_ = (LYR); unsigned char* wgu_ = WGU8 + (size_t)(lyr_ & 1) * 16 * MiB; unsigned char* wd_ = WD8 + (size_t)(lyr_ & 1) * 8 * MiB; \
        auto dece_ = [&](int it, TrD& d) { const int e = it / (I_G + I_D); int r = it % (I_G + I_D); d.wsc = W8S; d.dst8 = nullptr; \
            if (r < I_G) { const int kb = r / 32, nb = r % 32, n0 = nb * 32, tt = n0 >> 8, rr = n0 & 255; \
                d.src = (rr < 128 ? AIN(I_EWG) : AIN(I_EWU)) + ((size_t)lyr_ * NE + e) * DM * DE + (size_t)(kb * 64) * DE + tt * 128 + (rr & 127); d.ldw = DE; d.K = DM; d.dst = (bf16_t*)(wgu_ + (size_t)e * 1024 * 1024); d.drow0 = n0; d.k0 = kb * 64; } \
            else { r -= I_G; const int kb = r / 32, nb = r % 32; \
                d.src = AIN(I_EWD) + ((size_t)lyr_ * NE + e) * DE * DM + (size_t)(kb * 64) * DM + nb * 32; d.ldw = DM; d.K = DE; d.dst = (bf16_t*)(wd_ + (size_t)e * 1024 * 512); d.drow0 = nb * 32; d.k0 = kb * 64; } }; \
        int it_ = (IT0); const int stp_ = (STEP); int nj_ = (NJ); \
        if (nj_ > 0 && it_ < NIT_) { TrD dc, dn; f32x4 vc[8], vn[8]; dece_(it_, dc); tr_load4(dc, vc, lane); dn = dc; \
            _Pragma("unroll") for (int i = 0; i < 8; ++i) vn[i] = vc[i]; \
            for (; nj_ > 0 && it_ < NIT_; --nj_, it_ += stp_) { const int itn = it_ + stp_; \
                if (nj_ > 1 && itn < NIT_) { dece_(itn, dn); tr_load4(dn, vn, lane); } \
                tr_finish8(dc, vc, scr_, lane); dc = dn; \
                _Pragma("unroll") for (int i = 0; i < 8; ++i) vc[i] = vn[i]; } } \
    } while (0)
    for (int l = 0; l < DEPTH; ++l) {
        const int pb = 2 + 9 * l;
#define modl (MOD + (size_t)l * NB * 6144)
#define MAKE_RP() rec::RecP RP; RP.proj = PROJ; RP.tail = TAILB; RP.csm = CSM; RP.csg = CSG; RP.stm = STM; RP.stg = STG; RP.smN = G_smN; RP.smBC = G_smBC; RP.smDM = G_smDM; RP.smMS = G_smMS; RP.smGBE = G_smGBE; RP.ycat = YCAT; \
        RP.mbi = AIN(I_MBI) + l * 4; RP.mbf = AIN(I_MBF) + l * 4; RP.mg = AIN(I_MG) + l * 64; RP.wa2 = AIN(I_WA2) + (size_t)l * 16 * 256; RP.ba = AIN(I_BA) + l * 256; RP.gg = AIN(I_GG) + l * 64;
        if (IN(pb + 0) && PHON(2)) {
            PHASE_IDS(); (void)tid;
            { gm::K1<true> k; k.S.init(NTOK, PP, F.G, (int)blockIdx.x); k.A = U8B; k.Bt = WIN8 + (size_t)l * PP * DM; k.O = PROJ; k.rope = ROPE;
                gm::gemm_phase<gm::K1<true>>(F.lds, k, F.wave); }
        }
        SEAM(pb + 0);
        if (IN(pb + 1) && PHON(3)) {
            PHASE_IDS();
            MAKE_RP();
            for (int rp = 0; rp < NREP(3); ++rp) {
                LAS unsigned char* wl = F.lds + wid * 16384;
                recw::GWf gwf; recw::ld_gwf(gwf, RP, (gw >> 6) & 3, lane);
                for (int ci = gw; ci < 2048; ci += NGW) { int lane_ = lane; asm volatile("" : "+v"(lane_)); if (PHON(13)) recw::mlstm_local_w(RP, wl, ci, lane_); asm volatile("" ::: "memory"); __builtin_amdgcn_sched_barrier(0); if (PHON(14)) recw::gla_local_w(RP, gwf, wl, ci, lane_); }
            }
        }
        SEAM(pb + 1);
        if (IN(pb + 2) && PHON(4)) {
            PHASE_IDS();
            const int gt = blockIdx.x * 512 + tid, NGT = F.G * 512;
            for (int task = gt; task < 65536 + 2048; task += NGT) {
                if (task < 32768) {
                    const int bh = task >> 10, el = (task & 1023) * 4; const bf16_t* p = (const bf16_t*)STM + (size_t)bh * 64 * 4096 + el; bf16_t* o = CSM + (size_t)bh * 64 * 4096 + el;
                    const float bcv = G_smBC[bh * 64 + lane], dmv = G_smDM[bh * 64 + lane];
                    u32x2 ua[NCH];
#pragma unroll
                    for (int c = 0; c < NCH; ++c) ua[c] = *(const u32x2*)(p + (size_t)c * 4096);
                    f32x4 C = (f32x4){0.f, 0.f, 0.f, 0.f}; float m = 0.f; asm volatile("" : "+v"(C));
#pragma unroll
                    for (int c = 0; c < NCH; ++c) { const u32x2 uw = ua[c]; const f32x4 u = (f32x4){bflo(uw.x), bfhi(uw.x), bflo(uw.y), bfhi(uw.y)}; u32x2 w; w.x = pk2(C[0], C[1]); w.y = pk2(C[2], C[3]); *(u32x2*)(o + (size_t)c * 4096) = w;
                        if (el == 0) G_smMS[bh * 64 + c] = m;
                        const float B = __builtin_bit_cast(float, __builtin_amdgcn_readlane(__builtin_bit_cast(int, bcv), c)), Dm = __builtin_bit_cast(float, __builtin_amdgcn_readlane(__builtin_bit_cast(int, dmv), c)), mn = fmaxf(B + m, Dm); C = C * fexp(B + m - mn) + u * fexp(Dm - mn); m = mn; }
                } else if (task < 65536) {
                    const int t2 = task - 32768, bh = t2 >> 10, el = (t2 & 1023) * 4, d = el & 63; const bf16_t* p = (const bf16_t*)STG + (size_t)bh * 64 * 4096 + el; bf16_t* o = CSG + (size_t)bh * 64 * 4096 + el;
                    u32x2 ua[NCH];
#pragma unroll
                    for (int c = 0; c < NCH; ++c) ua[c] = *(const u32x2*)(p + (size_t)c * 4096);
                    LAS float* betab = (LAS float*)F.lds;
                    { f32x4 tb_[2];
#pragma unroll
                      for (int k = 0; k < 2; ++k) tb_[k] = *(const f32x4*)(G_smGBE + (size_t)bh * 4096 + (tid + 512 * k) * 4);
#pragma unroll
                      for (int k = 0; k < 2; ++k) *(LAS f32x4*)(betab + (tid + 512 * k) * 4) = tb_[k]; }
                    __syncthreads();
                    f32x4 S = (f32x4){0.f, 0.f, 0.f, 0.f}; asm volatile("" : "+v"(S));
#pragma unroll
                    for (int c = 0; c < NCH; ++c) { const u32x2 uw = ua[c]; const f32x4 u = (f32x4){bflo(uw.x), bfhi(uw.x), bflo(uw.y), bfhi(uw.y)}; const f32x4 b4 = *(const LAS f32x4*)(betab + c * 64 + d);
                        u32x2 w; w.x = pk2(S[0], S[1]); w.y = pk2(S[2], S[3]); *(u32x2*)(o + (size_t)c * 4096) = w;
                        S = (f32x4){fexp(b4[0]) * S[0] + u[0], fexp(b4[1]) * S[1] + u[1], fexp(b4[2]) * S[2] + u[2], fexp(b4[3]) * S[3] + u[3]}; }
                } else {
                    const int t3 = task - 65536, bh = t3 >> 6, el = t3 & 63; float* p = G_smN + (size_t)bh * 64 * 64 + el;
                    const float bcv = G_smBC[bh * 64 + lane], dmv = G_smDM[bh * 64 + lane];
                    float un[NCH];
#pragma unroll
                    for (int c = 0; c < NCH; ++c) un[c] = p[c * 64];
                    float C = 0.f, m = 0.f;
#pragma unroll
                    for (int c = 0; c < NCH; ++c) { const float u = un[c]; p[c * 64] = C;
                        const float B = __builtin_bit_cast(float, __builtin_amdgcn_readlane(__builtin_bit_cast(int, bcv), c)), Dm = __builtin_bit_cast(float, __builtin_amdgcn_readlane(__builtin_bit_cast(int, dmv), c)), mn = fmaxf(B + m, Dm); C = C * fexp(B + m - mn) + u * fexp(Dm - mn); m = mn; }
                }
            }
            __syncthreads();
            {
                int ndone = 0;
                if (l > 0) { gu32* cntp = F.ctl + CW_CNT + (size_t)(l - 1) * NBUCKET * 64;
                    const int c = (lane < NBUCKET) ? (int)__hip_atomic_load(cntp + lane * 64, RLX_AGENT) : 0; int ntp = (c + 255) >> 8;
#pragma unroll
                    for (int o = 1; o < 64; o <<= 1) ntp += __shfl_xor(ntp, o);
                    ntp = __builtin_amdgcn_readfirstlane(ntp);
                    ndone = tail_items(ntp * 8, F.G, CONV_B4) + tail_items(ntp * 4, F.G, CONV_B5); }
                constexpr int NSCANWG = (65536 + 2048 + 511) / 512;
                if (l == 0 || (int)F.G <= NSCANWG) CONV_ITEMS(l, ndone + gw, NGW, 1 << 28);
                else if ((int)blockIdx.x >= NSCANWG) CONV_ITEMS(l, ndone + ((int)blockIdx.x - NSCANWG) * 8 + wid, ((int)F.G - NSCANWG) * 8, 1 << 28);
            }
        }
        SEAM(pb + 2);
        if (IN(pb + 3) && PHON(5)) {
            PHASE_IDS();
            if (PHON(10)) {
                float d1 = 0.f, d2 = 0.f;
                for (int i = 0; i < 32; ++i) { d1 += AIN(I_LQ1)[l * 32 + i] * AIN(I_LK1)[l * 32 + i]; d2 += AIN(I_LQ2)[l * 32 + i] * AIN(I_LK2)[l * 32 + i]; }
                const float lam_init = 0.8f - 0.6f * expf(-0.3f * (float)l);
                attn_body::AttnParams AP; AP.Q = (const attn_body::bf16*)(PROJ + C_DQ); AP.K = (const attn_body::bf16*)(PROJ + C_DK); AP.V = (const attn_body::bf16*)(PROJ + C_DV);
                AP.zpage = (const attn_body::bf16*)(F.ctl + CW_ZPAGE); AP.Y = (bf16_t*)((unsigned char*)YCAT + 512); AP.gnorm = AIN(I_DG) + l * 64; AP.lam = expf(d1) - expf(d2) + lam_init; AP.osc = 1.f - lam_init;
                const int bh = F.vcu >> 3, s = F.vcu & 7;
                if (F.G == 256) {
                    for (int rp = 0; rp < NREP(10); ++rp)
                    for (int i = 0; i < 2; ++i) { const int qb = (i == 0) ? s : 15 - s;
                        attn_body::attn_unit<8, 0>(bh >> 2, bh & 3, qb, AP, (char*)lds_raw, F.wave); attn_body::attn_unit<8, 1>(bh >> 2, bh & 3, qb, AP, (char*)lds_raw, F.wave); }
                }
            }
            __syncthreads();
            {
            PHASE_IDS();
            MAKE_RP();
            if (PHON(11)) for (int rp = 0; rp < NREP(11); ++rp) {
                LAS unsigned char* wl = F.lds + wid * 16384;
                LAS u32x4* gst = (LAS u32x4*)(wl + 10240);
                { recw::GWf gwf; recw::ld_gwf(gwf, RP, (gw >> 6) & 3, lane);
#pragma unroll
                  for (int Td = 0; Td < 4; ++Td) gst[Td * 64 + lane] = __builtin_bit_cast(u32x4, gwf.Bw[Td]);
                  gst[256 + lane] = __builtin_bit_cast(u32x4, ((f32x4){gwf.ba[0], gwf.ba[1], gwf.ba[2], gwf.ba[3]})); }
                for (int ci = gw; ci < 2048; ci += NGW) { int lane_ = lane; asm volatile("" : "+v"(lane_)); if (PHON(13)) recw::mlstm_out_w(RP, wl, ci, lane_); asm volatile("" ::: "memory"); __builtin_amdgcn_sched_barrier(0);
                    if (PHON(14)) { recw::GWf gwf;
#pragma unroll
                        for (int Td = 0; Td < 4; ++Td) gwf.Bw[Td] = __builtin_bit_cast(bf16x8, gst[Td * 64 + lane_]);
                        const f32x4 bb = __builtin_bit_cast(f32x4, gst[256 + lane_]); gwf.ba[0] = bb[0]; gwf.ba[1] = bb[1]; gwf.ba[2] = bb[2]; gwf.ba[3] = bb[3];
                        recw::gla_out_w(RP, gwf, wl, ci, lane_); } }
            }
            __syncthreads();
            if (PHON(12)) for (int rp = 0; rp < NREP(12); ++rp) {
                const float* cw = AIN(I_CONVW) + (size_t)l * 3 * 256; const float* cbias = AIN(I_CONVB) + l * 256;
                const int nst = ((NTOK / 64 - F.vcu + F.G - 1) / F.G) * 4; const int chn = tid & 31;
                u32x4 pc[7], pn[7]; int rowc = 0, rown = 0;
                auto cload = [&](int st, u32x4 (&q)[7], int& rowo) { const int it = F.vcu + (st >> 2) * F.G, r = (tid >> 5) + (st & 3) * 16, row = it * 64 + r, t = row & (SEQ - 1); rowo = row;
                    const bf16_t* pr = PROJ + (size_t)row * PJ + chn * 8; const int o1 = (t >= 1) ? PJ : 0, o2 = (t >= 2) ? 2 * PJ : 0;
                    q[0] = *(const u32x4*)(pr + C_CC); q[1] = *(const u32x4*)(pr + C_CH); q[2] = *(const u32x4*)(pr - o1 + C_CC); q[3] = *(const u32x4*)(pr - o1 + C_CH);
                    q[4] = *(const u32x4*)(pr - o2 + C_CC); q[5] = *(const u32x4*)(pr - o2 + C_CH); q[6] = *(const u32x4*)(pr + C_CB); };
                cload(0, pc, rowc);
#pragma unroll
                for (int i = 0; i < 7; ++i) pn[i] = pc[i];
                rown = rowc;
                for (int st = 0; st < nst; ++st) {
                    if (st + 1 < nst) cload(st + 1, pn, rown);
                    const int row = rowc, t = row & (SEQ - 1);
                    float s0[8], s1[8], s2[8], cbv[8];
                    { float a[8], bq[8]; rec::unpack8(pc[0], a); rec::unpack8(pc[1], bq);
#pragma unroll
                      for (int i = 0; i < 8; ++i) s2[i] = a[i] * bq[i]; }
                    { float a[8], bq[8]; rec::unpack8(pc[2], a); rec::unpack8(pc[3], bq); const float f1 = (t >= 1) ? 1.f : 0.f;
#pragma unroll
                      for (int i = 0; i < 8; ++i) s1[i] = a[i] * bq[i] * f1; }
                    { float a[8], bq[8]; rec::unpack8(pc[4], a); rec::unpack8(pc[5], bq); const float f0 = (t >= 2) ? 1.f : 0.f;
#pragma unroll
                      for (int i = 0; i < 8; ++i) s0[i] = a[i] * bq[i] * f0; }
                    rec::unpack8(pc[6], cbv);
                    float y[8];
#pragma unroll
                    for (int i = 0; i < 8; ++i) { const int cch = chn * 8 + i; y[i] = cbv[i] * (cw[cch] * s0[i] + cw[256 + cch] * s1[i] + cw[512 + cch] * s2[i] + cbias[cch]); }
                    u32x2 w; w.x = pk4_fp8(y[0] * Y8S, y[1] * Y8S, y[2] * Y8S, y[3] * Y8S); w.y = pk4_fp8(y[4] * Y8S, y[5] * Y8S, y[6] * Y8S, y[7] * Y8S);
                    *(u32x2*)((unsigned char*)YCAT + (size_t)row * DM + 256 + chn * 8) = w;
#pragma unroll
                    for (int i = 0; i < 7; ++i) pc[i] = pn[i];
                    rowc = rown; }
            }
            }
        }
        SEAM(pb + 3);
        if (IN(pb + 4) && PHON(6)) {
            PHASE_IDS(); (void)tid;
            gm::K2 k; k.S.init(NTOK, DM, F.G, (int)blockIdx.x); k.A = (const unsigned char*)YCAT; k.Bt = (const unsigned char*)WOUT + (size_t)l * DM * DM; k.O = UB;
            for (int rp = 0; rp < NREP(6); ++rp) gm::gemm_phase<gm::K2>(F.lds, k, F.wave);
        }
        SEAM(pb + 4);
        if (IN(pb + 5) && PHON(7)) {
            PHASE_IDS();
            NarrowT NT_; nmm_load_router(NT_, AIN(I_RW), wid, lane);
            LAS bf16_t* Sst = (LAS bf16_t*)F.lds; LAS float* Pb = (LAS float*)(F.lds + NMM_P_OFF); LAS float* lgs_all = (LAS float*)(F.lds + NMM_LG_OFF);
            LAS float* lgs = lgs_all + wid * 256;
            LAS int* wcnt = (LAS int*)(F.lds + NMM_LG_OFF + 8192); LAS int* wbase = wcnt + 32;
            if (tid < 32) wcnt[tid] = 0;
            const int b = F.vcu >> 5; const float* md = modl + (size_t)b * 6144;
            const float* lg = AIN(I_LN1G) + l * DM; const float* lb = AIN(I_LN1B) + l * DM;
            f32x4 gv[4], bv[4], sh[4], sc[4], g1[4];
#pragma unroll
            for (int j = 0; j < 4; ++j) { const int cix = 4 * lane + 256 * j; gv[j] = *(const f32x4*)(lg + cix); bv[j] = *(const f32x4*)(lb + cix); g1[j] = *(const f32x4*)(md + 2 * 1024 + cix) + 1.0f;
                sh[j] = *(const f32x4*)(md + 3 * 1024 + cix); sc[j] = *(const f32x4*)(md + 4 * 1024 + cix) + 1.0f; }
            const int rowb = F.vcu * 128 + wid * 16;
            u32x2 xwc[4], ywc[4];
#pragma unroll
            for (int j = 0; j < 4; ++j) { const size_t o = (size_t)rowb * DM + 4 * lane + 256 * j; xwc[j] = (l == 0) ? (u32x2){0u, 0u} : *(const u32x2*)(XB + o); ywc[j] = *(const u32x2*)(UB + o); }
            u32x2 xwn[4] = {xwc[0], xwc[1], xwc[2], xwc[3]}, ywn[4] = {ywc[0], ywc[1], ywc[2], ywc[3]};
            for (int i = 0; i < 16; ++i) { const int row = rowb + i;
                if (i < 15) {
#pragma unroll
                    for (int j = 0; j < 4; ++j) { const size_t o = (size_t)(row + 1) * DM + 4 * lane + 256 * j; if (l != 0) xwn[j] = *(const u32x2*)(XB + o); ywn[j] = *(const u32x2*)(UB + o); } }
                f32x4 v[4]; float s = 0.f;
#pragma unroll
                for (int j = 0; j < 4; ++j) { const size_t o = (size_t)row * DM + 4 * lane + 256 * j;
                    f32x4 xv; if (l == 0) xv = *(const f32x4*)(x_in + o); else { const u32x2 xw = xwc[j]; xv = (f32x4){bflo(xw.x), bfhi(xw.x), bflo(xw.y), bfhi(xw.y)}; }
                    const u32x2 yw = ywc[j]; const f32x4 yv = (f32x4){bflo(yw.x), bfhi(yw.x), bflo(yw.y), bfhi(yw.y)};
                    v[j] = xv * ALPHA + g1[j] * yv; s += (v[j][0] + v[j][1]) + (v[j][2] + v[j][3]); }
#pragma unroll
                for (int j = 0; j < 4; ++j) { xwc[j] = xwn[j]; ywc[j] = ywn[j]; }
                const float mean = wave_sum(s) * (1.f / DM); float s2 = 0.f;
#pragma unroll
                for (int j = 0; j < 4; ++j) { v[j] = v[j] - mean; s2 += (v[j][0] * v[j][0] + v[j][1] * v[j][1]) + (v[j][2] * v[j][2] + v[j][3] * v[j][3]); }
                const float rstd = __builtin_amdgcn_rsqf(wave_sum(s2) * (1.f / DM) + LN_EPS);
#pragma unroll
                for (int j = 0; j < 4; ++j) { const size_t o = (size_t)row * DM + 4 * lane + 256 * j; const f32x4 xn = v[j] * rstd * gv[j] + bv[j];
                    u32x2 xw; xw.x = pk2(xn[0], xn[1]); xw.y = pk2(xn[2], xn[3]); *(u32x2*)(XB + o) = xw;
                    const f32x4 u = xn * sc[j] + sh[j]; u32x2 w; w.x = pk2(u[0], u[1]); w.y = pk2(u[2], u[3]); *(LAS u32x2*)(Sst + (wid * 4 + (i & 3)) * NSP + 4 * lane + 256 * j) = w;
                    *(unsigned*)(U8B + o) = pk4_fp8(u[0], u[1], u[2], u[3]); }
                if ((i & 3) == 3) nmm_step_router(NT_, Sst, Pb, lgs_all, i - 3, tid, wid, lane);
            }
            asm volatile("s_waitcnt lgkmcnt(0)\n\ts_barrier" ::: "memory");
            int bk_ = 0; unsigned lpos_ = 0u; float gi_ = 0.f, gj_ = 0.f;
            if (lane < 16) {
                const float* rb = AIN(I_RB);
                float sco[16], bia[16];
#pragma unroll
                for (int q = 0; q < 4; ++q) { const f32x4 t4 = *(const LAS f32x4*)(lgs + lane * 16 + q * 4);
#pragma unroll
                    for (int c = 0; c < 4; ++c) { const float sg = 1.f / (1.f + fexp(-t4[c])); sco[q * 4 + c] = sg; bia[q * 4 + c] = sg + rb[q * 4 + c]; } }
                int bg = 0; float bgs = -INFINITY;
#pragma unroll
                for (int g = 0; g < 4; ++g) { const float a0 = bia[4 * g], a1 = bia[4 * g + 1], a2 = bia[4 * g + 2], a3 = bia[4 * g + 3];
                    const float h1 = fmaxf(a0, a1), l1 = fminf(a0, a1), h2 = fmaxf(a2, a3), l2 = fminf(a2, a3);
                    const float top = fmaxf(h1, h2), sec = fmaxf(fminf(h1, h2), (h1 >= h2) ? l1 : l2); const float gsc = top + sec;
                    if (gsc > bgs) { bgs = gsc; bg = g; } }
                float gb[4], gsx[4];
#pragma unroll
                for (int q = 0; q < 4; ++q) { gb[q] = (bg == 0) ? bia[q] : (bg == 1) ? bia[4 + q] : (bg == 2) ? bia[8 + q] : bia[12 + q]; gsx[q] = (bg == 0) ? sco[q] : (bg == 1) ? sco[4 + q] : (bg == 2) ? sco[8 + q] : sco[12 + q]; }
                int e1 = 0; float m1 = gb[0];
#pragma unroll
                for (int q = 1; q < 4; ++q) if (gb[q] > m1) { m1 = gb[q]; e1 = q; }
                int e2 = -1; float m2 = -INFINITY;
#pragma unroll
                for (int q = 0; q < 4; ++q) if (q != e1 && gb[q] > m2) { m2 = gb[q]; e2 = q; }
                const int ei = e1 < e2 ? e1 : e2, ej = e1 < e2 ? e2 : e1;
                const float si = (ei == 0) ? gsx[0] : (ei == 1) ? gsx[1] : (ei == 2) ? gsx[2] : gsx[3], sj = (ej == 0) ? gsx[0] : (ej == 1) ? gsx[1] : (ej == 2) ? gsx[2] : gsx[3];
                const int pr_ = (ei == 0) ? ej - 1 : (ei == 1) ? ej + 1 : 5; const int bk = bg * 6 + pr_;
                bk_ = bk; lpos_ = (unsigned)__hip_atomic_fetch_add(wcnt + bk, 1, __ATOMIC_RELAXED, __HIP_MEMORY_SCOPE_WORKGROUP); const float inv = 1.f / (si + sj); gi_ = si * inv; gj_ = sj * inv;
            }
            asm volatile("s_waitcnt lgkmcnt(0)\n\ts_barrier" ::: "memory");
            if (tid < NBUCKET) { gu32* cntw = F.ctl + CW_CNT + (size_t)l * NBUCKET * 64; const int c = wcnt[tid]; wbase[tid] = (c > 0) ? (int)__hip_atomic_fetch_add(cntw + tid * 64, (unsigned)c, RLX_AGENT) : 0; }
            asm volatile("s_waitcnt vmcnt(0) lgkmcnt(0)\n\ts_barrier" ::: "memory");
            if (lane < 16) { const int row = rowb + lane; const unsigned pos = (unsigned)wbase[bk_] + lpos_;
                LTOK[(size_t)bk_ * LCAP + pos] = row; LGATE[((size_t)bk_ * LCAP + pos) * 2] = gi_; LGATE[((size_t)bk_ * LCAP + pos) * 2 + 1] = gj_;
                TOKSLOT[row] = (bk_ << 16) | (int)pos;
            }
            __syncthreads();
        }
        SEAM(pb + 5);
        if ((IN(pb + 6) || IN(pb + 7)) && PHON(8)) {
            PHASE_IDS();
            LAS int* tb = (LAS int*)(F.lds + MOE_TB_OFF);
            if (wid == 0) { gu32* cntw = F.ctl + CW_CNT + (size_t)l * NBUCKET * 64;
                const int c = (lane < NBUCKET) ? (int)__hip_atomic_load(cntw + lane * 64, RLX_AGENT) : 0; const int ntl = (c + 255) >> 8; int incl = ntl;
#pragma unroll
                for (int o = 1; o < 32; o <<= 1) { const int t_ = __shfl_up(incl, o); if (lane >= o) incl += t_; }
                if (lane < NBUCKET) { tb[lane] = c; tb[32 + lane] = incl - ntl; }
                if (lane == NBUCKET - 1) tb[32 + NBUCKET] = incl; }
            __syncthreads();
            if (IN(pb + 6)) {
                {
                    LAS float* gtab = (LAS float*)tb + 256; const int nt_ = tb[32 + NBUCKET]; const int half = tid >> 8, tl = tid & 255;
                    float gv_[3];
#pragma unroll
                    for (int j = 0; j < 3; ++j) { const int i = 2 * j + half; const int L = i * F.G + F.vcu; const bool ok = L < nt_ * 8; const int Lc = ok ? L : F.vcu;
                        const int rt = Lc >> 3; int kq = 0;
                        for (int q = 1; q < NBUCKET; ++q) kq = (tb[32 + q] <= rt) ? q : kq;
                        gv_[j] = (F.vcu < nt_ * 8) ? LGATE[((size_t)kq * LCAP + (size_t)(rt - tb[32 + kq]) * 256 + tl) * 2 + ((Lc & 7) >> 2)] : 0.f; }
#pragma unroll
                    for (int j = 0; j < 3; ++j) { const int i = 2 * j + half; if (i * F.G + F.vcu < nt_ * 8) gtab[i * 256 + tl] = gv_[j]; }
                    __syncthreads(); }
                gm::K4 k; k.U = U8B; k.Wgu = WGU8 + (size_t)(l & 1) * 16 * MiB; k.H = H8B; k.ltok = LTOK; k.lgate = LGATE; k.tb = tb; k.G = F.G; k.vcu = F.vcu; k.rtc = F.ctl + CW_RT + (size_t)l * 160 * 64;
                for (int rp = 0; rp < NREP(8); ++rp) gm::gemm_phase<gm::K4>(F.lds, k, F.wave);
                if (l < DEPTH - 1) { const int nu = tb[32 + NBUCKET] * 8, nsh = tail_short(nu, F.G), r_ = F.G - nsh;
                    if (F.vcu >= r_) { const int lane = lane_id_(), wid = F.wave; CONV_ITEMS(l + 1, (F.vcu - r_) * 8 + wid, nsh * 8, CONV_B4); } }
            }
            SEAM(pb + 6);
            if (IN(pb + 7)) {
                gm::K5 k; k.H = H8B; k.Wd = WD8 + (size_t)(l & 1) * 8 * MiB; k.Y = YSORT; k.tb = tb; k.G = F.G; k.vcu = F.vcu; k.rtc = F.ctl + CW_RT + (size_t)l * 160 * 64; k.tmo = F.ctl + CW_TMO;
                for (int rp = 0; rp < NREP(14); ++rp) gm::gemm_phase<gm::K5>(F.lds, k, F.wave);
                if (l < DEPTH - 1) { const int ntl_ = tb[32 + NBUCKET]; const int n4 = tail_items(ntl_ * 8, F.G, CONV_B4), nsh = tail_short(ntl_ * 4, F.G), r_ = F.G - nsh;
                    if (F.vcu >= r_) { const int lane = lane_id_(), wid = F.wave; CONV_ITEMS(l + 1, n4 + (F.vcu - r_) * 8 + wid, nsh * 8, CONV_B5); } }
            }
        }
        SEAM(pb + 7);
        if (IN(pb + 8) && PHON(9)) {
            PHASE_IDS();
            const int b = F.vcu >> 5; const bool lastl = (l == DEPTH - 1);
            LAS bf16_t* Sst = (LAS bf16_t*)F.lds; LAS float* Pb = (LAS float*)(F.lds + NMM_P_OFF); LAS int* t0 = (LAS int*)(F.lds + MOE_TB_OFF);
            NarrowT NT_; nmm_load_tail(NT_, WIN + ((size_t)(lastl ? l : l + 1) * PW + PP) * DM, wid, lane);
            if (wid == 0) { gu32* cntw = F.ctl + CW_CNT + (size_t)l * NBUCKET * 64;
                const int c = (lane < NBUCKET) ? (int)__hip_atomic_load(cntw + lane * 64, RLX_AGENT) : 0; const int ntl = (c + 255) >> 8; int incl = ntl;
#pragma unroll
                for (int o = 1; o < 32; o <<= 1) { const int t_ = __shfl_up(incl, o); if (lane >= o) incl += t_; }
                if (lane < NBUCKET) t0[32 + lane] = incl - ntl; }
            __syncthreads();
            const float* mdn = MOD + ((size_t)(lastl ? l : l + 1) * NB + b) * 6144; const float* md = modl + (size_t)b * 6144;
            const float* lg = AIN(I_LN2G) + l * DM; const float* lb = AIN(I_LN2B) + l * DM;
            f32x4 gv[4], bv[4], sh[4], sc[4], g2[4];
#pragma unroll
            for (int j = 0; j < 4; ++j) { const int cix = 4 * lane + 256 * j; gv[j] = *(const f32x4*)(lg + cix); bv[j] = *(const f32x4*)(lb + cix); g2[j] = *(const f32x4*)(md + 5 * 1024 + cix) + 1.0f;
                sh[j] = *(const f32x4*)(mdn + cix); sc[j] = *(const f32x4*)(mdn + 1024 + cix) + 1.0f; }
            const int rowb = F.vcu * 128 + wid * 16;
            const int tsl = TOKSLOT[rowb + (lane & 15)];
            u32x2 xwc[4], ywc[4];
            { const int ts = __builtin_amdgcn_readlane(tsl, 0); const size_t yrow = (size_t)t0[32 + (ts >> 16)] * 256 + (ts & 0xffff);
#pragma unroll
              for (int j = 0; j < 4; ++j) { const int cix = 4 * lane + 256 * j; xwc[j] = *(const u32x2*)(XB + (size_t)rowb * DM + cix); ywc[j] = *(const u32x2*)(YSORT + yrow * DM + cix); } }
            u32x2 xwn[4] = {xwc[0], xwc[1], xwc[2], xwc[3]}, ywn[4] = {ywc[0], ywc[1], ywc[2], ywc[3]};
            for (int i = 0; i < 16; ++i) { const int row = rowb + i;
                if (i < 15) { const int ts = __builtin_amdgcn_readlane(tsl, i + 1); const size_t yrow = (size_t)t0[32 + (ts >> 16)] * 256 + (ts & 0xffff);
#pragma unroll
                    for (int j = 0; j < 4; ++j) { const int cix = 4 * lane + 256 * j; xwn[j] = *(const u32x2*)(XB + (size_t)(row + 1) * DM + cix); ywn[j] = *(const u32x2*)(YSORT + yrow * DM + cix); } }
                f32x4 v[4]; float s = 0.f;
#pragma unroll
                for (int j = 0; j < 4; ++j) {
                    const u32x2 xw = xwc[j]; const f32x4 xv = (f32x4){bflo(xw.x), bfhi(xw.x), bflo(xw.y), bfhi(xw.y)};
                    const u32x2 yw = ywc[j]; const f32x4 yv = (f32x4){bflo(yw.x), bfhi(yw.x), bflo(yw.y), bfhi(yw.y)};
                    v[j] = xv * ALPHA + g2[j] * yv; s += (v[j][0] + v[j][1]) + (v[j][2] + v[j][3]); }
#pragma unroll
                for (int j = 0; j < 4; ++j) { xwc[j] = xwn[j]; ywc[j] = ywn[j]; }
                const float mean = wave_sum(s) * (1.f / DM); float s2 = 0.f;
#pragma unroll
                for (int j = 0; j < 4; ++j) { v[j] = v[j] - mean; s2 += (v[j][0] * v[j][0] + v[j][1] * v[j][1]) + (v[j][2] * v[j][2] + v[j][3] * v[j][3]); }
                const float rstd = __builtin_amdgcn_rsqf(wave_sum(s2) * (1.f / DM) + LN_EPS);
#pragma unroll
                for (int j = 0; j < 4; ++j) { const size_t o = (size_t)row * DM + 4 * lane + 256 * j; const f32x4 xn = v[j] * rstd * gv[j] + bv[j];
                    if (lastl) *(f32x4*)(ap->out + o) = xn;
                    else { u32x2 xw; xw.x = pk2(xn[0], xn[1]); xw.y = pk2(xn[2], xn[3]); *(u32x2*)(XB + o) = xw;
                        const f32x4 u = xn * sc[j] + sh[j]; u32x2 w; w.x = pk2(u[0], u[1]); w.y = pk2(u[2], u[3]); *(LAS u32x2*)(Sst + (wid * 4 + (i & 3)) * NSP + 4 * lane + 256 * j) = w;
                        *(unsigned*)(U8B + o) = pk4_fp8(u[0], u[1], u[2], u[3]); } }
                if (!lastl && (i & 3) == 3) nmm_step_tail(NT_, Sst, Pb, TAILB + (size_t)(F.vcu * 128) * 32, i - 3, tid, wid, lane);
            }
        }
        SEAM(pb + 8);
    }
#undef IN
#undef SEAM
}

extern "C" void kernel_launch(void* const* d_in, const int* in_sizes, int n_in, void* d_out, int out_size, void* d_ws, size_t ws_size, hipStream_t stream) {
    static int grid = 0;
    if (grid == 0) {
        if (n_in != 29 || in_sizes[0] != NTOK * DM || out_size != NTOK * DM || ws_size < WS_END) {
            fprintf(stderr, "kernel_launch: unexpected shapes (n_in %d, in0 %d, out %d, ws %zu need %zu); nothing launched\n", n_in, n_in > 0 ? in_sizes[0] : -1, out_size, ws_size, (size_t)WS_END); grid = -1; return; }
        int dev = 0, cus = 0, per_cu = 0;
        if (hipGetDevice(&dev) != hipSuccess || hipDeviceGetAttribute(&cus, hipDeviceAttributeMultiprocessorCount, dev) != hipSuccess) { grid = -1; return; }
        if (hipFuncSetAttribute((const void*)mega_fwd, hipFuncAttributeMaxDynamicSharedMemorySize, LDS_BYTES) != hipSuccess) { fprintf(stderr, "kernel_launch: hipFuncSetAttribute failed\n"); grid = -1; return; }
        if (hipOccupancyMaxActiveBlocksPerMultiprocessor(&per_cu, (const void*)mega_fwd, 512, LDS_BYTES) != hipSuccess || per_cu < 1) { fprintf(stderr, "kernel_launch: occupancy query reports %d\n", per_cu); }
        (void)hipGetLastError();
        grid = cus;
        if (grid != 256) fprintf(stderr, "kernel_launch: %d CUs (row phases assume 256)\n", grid);
    }
    if (grid < 0) return;
    if (hipMemsetAsync((char*)d_ws + WS_CTL, 0, CTL_ZERO_BYTES, stream) != hipSuccess) return;
    Args a{};
    for (int i = 0; i < 29; ++i) a.in[i] = (const float*)d_in[i];
    a.out = (float*)d_out; a.ws = (unsigned char*)d_ws;
#if MK_ONE_LAUNCH
    a.ph_lo = 0; a.ph_hi = N_PHASES;
    hipLaunchKernelGGL(mega_fwd, dim3(grid), dim3(512), LDS_BYTES, stream, a);
#else
    for (int p = 0; p < N_PHASES; ++p) { a.ph_lo = p; a.ph_hi = p + 1; hipLaunchKernelGGL(mega_fwd, dim3(grid), dim3(512), LDS_BYTES, stream, a); }
#endif
}
```
